# Optimizing an MI355X kernel written in HIP

```python
import jax, jax.numpy as jnp
from jax import lax
import numpy as np

D_MODEL = 1024
BATCH = 4
SEQ = 8192
DEPTH = 1

D_MIX = D_MODEL
D_HGRN = D_MIX // 2
D_CONV = D_MIX - D_HGRN
HGRN_HEAD_DIM = 128
HGRN_HEADS = D_HGRN // HGRN_HEAD_DIM
CHUNK = 64
CONV_WIDTH = 31
CONV_PAD = CONV_WIDTH // 2
N_IN = 5 * D_HGRN + 2 * D_CONV
PEER_HEADS = 8
PEER_KEYS = 128
PEER_EXPERTS = PEER_KEYS * PEER_KEYS
PEER_TOPK = 16
PEER_DKEY = 256
PEER_HALF = PEER_DKEY // 2
PEER_BLOCK = 128
EPS = 1e-6

kernel_name = 'hgrn2_conformer_peer_hybrid_encoder'


def _rmsnorm(x, g):
    xf = x.astype(jnp.float32)
    y = xf * lax.rsqrt(jnp.mean(xf * xf, axis=-1, keepdims=True) + EPS)
    return (y * g.astype(jnp.float32)).astype(x.dtype)


def _modulate(h, shift, scale):
    return h * (1 + scale[:, None, :]) + shift[:, None, :]


def _chunk_recurrence(q, k, v, logf):
    nb, nh, L, dk = q.shape
    dv = v.shape[-1]
    nc = L // CHUNK
    q = q.reshape(nb, nh, nc, CHUNK, dk)
    k = k.reshape(nb, nh, nc, CHUNK, dk)
    logf = logf.reshape(nb, nh, nc, CHUNK, dk)
    v = v.reshape(nb, nh, nc, CHUNK, dv)
    b = jnp.cumsum(logf, axis=3)
    b_ref = b[:, :, :, CHUNK // 2 - 1:CHUNK // 2, :]
    b_last = b[:, :, :, -1:, :]
    qr = q * jnp.exp(b - b_ref)
    kr = k * jnp.exp(b_ref - b)
    scores = jnp.einsum('bhntd,bhnsd->bhnts', qr, kr)
    incl = jnp.tril(jnp.ones((CHUNK, CHUNK), dtype=bool))
    scores = jnp.where(incl, scores, 0.0)
    o_intra = jnp.einsum('bhnts,bhnsv->bhntv', scores, v)
    u = jnp.einsum('bhnsd,bhnsv->bhndv', k * jnp.exp(b_last - b), v)
    a = jnp.exp(b_last[:, :, :, 0, :])

    def step(S, inp):
        a_n, u_n = inp
        return a_n[..., None] * S + u_n, S

    S0 = jnp.zeros((nb, nh, dk, dv), jnp.float32)
    _, S_prev = lax.scan(step, S0, (jnp.moveaxis(a, 2, 0), jnp.moveaxis(u, 2, 0)))
    S_prev = jnp.moveaxis(S_prev, 0, 2)
    o_inter = jnp.einsum('bhntd,bhndv->bhntv', q * jnp.exp(b), S_prev)
    return (o_intra + o_inter).reshape(nb, nh, L, dv)


def _hgrn2(q_raw, ff_raw, fb_raw, i_raw, g_raw, lb_fwd, lb_bwd, norm_g):
    nb, L, _ = q_raw.shape
    f32 = jnp.float32

    def heads(t):
        return t.astype(f32).reshape(nb, L, HGRN_HEADS, HGRN_HEAD_DIM).transpose(0, 2, 1, 3)

    q = jax.nn.silu(heads(q_raw))
    v = heads(i_raw)

    def gates(f_raw, lb):
        z = heads(f_raw)
        lbh = lb.astype(f32).reshape(1, HGRN_HEADS, 1, HGRN_HEAD_DIM)
        logf = jnp.log(lbh + (1 - lbh) * jax.nn.sigmoid(z))
        k = (1 - lbh) * jax.nn.sigmoid(-z)
        return k, logf

    k_f, logf_f = gates(ff_raw, lb_fwd)
    k_b, logf_b = gates(fb_raw, lb_bwd)
    o_f = _chunk_recurrence(q, k_f, v, logf_f)
    flip = lambda t: jnp.flip(t, axis=2)
    o_b = flip(_chunk_recurrence(flip(q), flip(k_b), flip(v), flip(logf_b)))
    o = (o_f + o_b).transpose(0, 2, 1, 3)
    o = o * lax.rsqrt(jnp.mean(o * o, axis=-1, keepdims=True) + EPS)
    o = o * norm_g.astype(f32).reshape(HGRN_HEADS, HGRN_HEAD_DIM)
    o = o.reshape(nb, L, D_HGRN) * jax.nn.silu(g_raw.astype(f32))
    return o.astype(q_raw.dtype)


def _conv_module(a, gate, w, bias, ln_g, ln_b):
    h = a * jax.nn.sigmoid(gate)
    h = lax.conv_general_dilated(
        h, w[:, None, :].astype(h.dtype), window_strides=(1,),
        padding=[(CONV_PAD, CONV_PAD)], dimension_numbers=('NWC', 'WIO', 'NWC'),
        feature_group_count=D_CONV) + bias
    hf = h.astype(jnp.float32)
    mu = jnp.mean(hf, axis=-1, keepdims=True)
    var = jnp.mean(jnp.square(hf - mu), axis=-1, keepdims=True)
    hf = (hf - mu) * lax.rsqrt(var + EPS) * ln_g.astype(jnp.float32) + ln_b.astype(jnp.float32)
    return jax.nn.silu(hf).astype(a.dtype)


def _peer(h, wq, keys1, keys2, u_tab, v_tab):
    nb, L, D = h.shape
    q = (h @ wq).reshape(nb, L, PEER_HEADS, PEER_DKEY)
    q1, q2 = q[..., :PEER_HALF], q[..., PEER_HALF:]
    s1 = jnp.einsum('blhd,kd->blhk', q1, keys1).astype(jnp.float32)
    s2 = jnp.einsum('blhd,kd->blhk', q2, keys2).astype(jnp.float32)
    v1, i1 = lax.top_k(s1, PEER_TOPK)
    v2, i2 = lax.top_k(s2, PEER_TOPK)
    cand = (v1[..., :, None] + v2[..., None, :]).reshape(nb, L, PEER_HEADS, PEER_TOPK * PEER_TOPK)
    sc, ci = lax.top_k(cand, PEER_TOPK)
    e = (jnp.take_along_axis(i1, ci // PEER_TOPK, axis=-1) * PEER_KEYS
         + jnp.take_along_axis(i2, ci % PEER_TOPK, axis=-1))
    w = jax.nn.softmax(sc, axis=-1)
    T = nb * L
    nsel = PEER_HEADS * PEER_TOPK
    hb = h.reshape(T // PEER_BLOCK, PEER_BLOCK, D)
    eb = e.reshape(T // PEER_BLOCK, PEER_BLOCK, nsel)
    wb = w.reshape(T // PEER_BLOCK, PEER_BLOCK, nsel)

    def block(args):
        hx, ex, wx = args
        u_sel = u_tab[ex]
        act = jax.nn.gelu(jnp.einsum('td,tjd->tj', hx, u_sel).astype(jnp.float32), approximate=False)
        coef = (wx * act).astype(hx.dtype)
        return jnp.einsum('tj,tjd->td', coef, v_tab[ex])

    y = lax.map(block, (hb, eb, wb))
    return y.reshape(nb, L, D)


def setup_inputs(seed: int = 0) -> dict:
    key = jax.random.key(seed)
    ks = jax.random.split(key, 24)
    nrm = jax.random.normal
    f32 = jnp.float32
    Dm = D_MODEL
    return {
        'x': nrm(ks[0], (BATCH, SEQ, Dm), f32),
        'c': nrm(ks[1], (BATCH, Dm), f32),
        'ada_w': nrm(ks[2], (DEPTH, Dm, 6 * Dm), f32) * (0.5 * Dm ** -0.5),
        'ada_b': nrm(ks[3], (DEPTH, 6 * Dm), f32) * 0.02,
        'norm_mix_g': 1.0 + 0.05 * nrm(ks[4], (DEPTH, Dm), f32),
        'w_in': nrm(ks[5], (DEPTH, Dm, N_IN), f32) * Dm ** -0.5,
        'lb_gamma_fwd': 0.1 * nrm(ks[6], (DEPTH + 1, D_HGRN), f32),
        'lb_gamma_bwd': 0.1 * nrm(ks[7], (DEPTH + 1, D_HGRN), f32),
        'hgrn_norm_g': 1.0 + 0.05 * nrm(ks[8], (DEPTH, D_HGRN), f32),
        'conv_w': nrm(ks[9], (DEPTH, CONV_WIDTH, D_CONV), f32) * CONV_WIDTH ** -0.5,
        'conv_b': 0.02 * nrm(ks[10], (DEPTH, D_CONV), f32),
        'conv_ln_g': 1.0 + 0.05 * nrm(ks[11], (DEPTH, D_CONV), f32),
        'conv_ln_b': 0.02 * nrm(ks[12], (DEPTH, D_CONV), f32),
        'w_out': nrm(ks[13], (DEPTH, D_MIX, Dm), f32) * D_MIX ** -0.5,
        'norm_ffn_g': 1.0 + 0.05 * nrm(ks[14], (DEPTH, Dm), f32),
        'peer_wq': nrm(ks[15], (DEPTH, Dm, PEER_HEADS * PEER_DKEY), f32) * Dm ** -0.5,
        'peer_keys1': nrm(ks[16], (DEPTH, PEER_KEYS, PEER_HALF), f32) * PEER_HALF ** -0.5,
        'peer_keys2': nrm(ks[17], (DEPTH, PEER_KEYS, PEER_HALF), f32) * PEER_HALF ** -0.5,
        'peer_u': nrm(ks[18], (DEPTH, PEER_EXPERTS, Dm), f32) * Dm ** -0.5,
        'peer_v': nrm(ks[19], (DEPTH, PEER_EXPERTS, Dm), f32),
        'final_ada_w': nrm(ks[20], (Dm, 2 * Dm), f32) * (0.5 * Dm ** -0.5),
        'final_ada_b': 0.02 * nrm(ks[21], (2 * Dm,), f32),
        'final_norm_g': 1.0 + 0.05 * nrm(ks[22], (Dm,), f32),
    }


def reference(x, c, ada_w, ada_b, norm_mix_g, w_in, lb_gamma_fwd, lb_gamma_bwd, hgrn_norm_g,
              conv_w, conv_b, conv_ln_g, conv_ln_b, w_out, norm_ffn_g, peer_wq, peer_keys1,
              peer_keys2, peer_u, peer_v, final_ada_w, final_ada_b, final_norm_g):
    c_act = jax.nn.silu(c)
    lb_fwd_all = jnp.cumsum(jax.nn.softmax(lb_gamma_fwd.astype(jnp.float32), axis=0), axis=0)
    lb_bwd_all = jnp.cumsum(jax.nn.softmax(lb_gamma_bwd.astype(jnp.float32), axis=0), axis=0)
    splits = [D_HGRN, 2 * D_HGRN, 3 * D_HGRN, 4 * D_HGRN, 5 * D_HGRN, 5 * D_HGRN + D_CONV]
    h = x
    for l in range(DEPTH):
        mod = c_act @ ada_w[l] + ada_b[l]
        sh1, sc1, g1, sh2, sc2, g2 = jnp.split(mod, 6, axis=-1)
        hn = _modulate(_rmsnorm(h, norm_mix_g[l]), sh1, sc1)
        proj = hn @ w_in[l]
        q_r, ff_r, fb_r, i_r, g_r, c_a, c_g = jnp.split(proj, splits, axis=-1)
        o_h = _hgrn2(q_r, ff_r, fb_r, i_r, g_r, lb_fwd_all[l], lb_bwd_all[l], hgrn_norm_g[l])
        o_c = _conv_module(c_a, c_g, conv_w[l], conv_b[l], conv_ln_g[l], conv_ln_b[l])
        mix = jnp.concatenate([o_h, o_c], axis=-1) @ w_out[l]
        h = h + g1[:, None, :] * mix
        hn2 = _modulate(_rmsnorm(h, norm_ffn_g[l]), sh2, sc2)
        ffn = _peer(hn2, peer_wq[l], peer_keys1[l], peer_keys2[l], peer_u[l], peer_v[l])
        h = h + g2[:, None, :] * ffn
    fsh, fsc = jnp.split(c_act @ final_ada_w + final_ada_b, 2, axis=-1)
    return _modulate(_rmsnorm(h, final_norm_g), fsh, fsc)
```

```cpp
#include <hip/hip_runtime.h>
#include <cstdio>
#include <cstdint>
namespace pg8 {
#define PG8_LAS __attribute__((address_space(3)))
typedef unsigned short bf16_t;
typedef short bf16x8 __attribute__((ext_vector_type(8)));
typedef float f32x4 __attribute__((ext_vector_type(4)));
typedef unsigned u32x4 __attribute__((ext_vector_type(4)));
constexpr int BM = 256, BK = 64, HALF = 128, HTB = HALF * BK * 2  , STAGE_BYTES = 8 * HTB, NXCD = 8, WGM = 8;

__host__ __device__ __forceinline__ int lds_byte(int r, int c) { const int st = (r >> 4) * 2 + (c >> 5), rr = r & 15, cc = c & 31, ob = rr * 64 + cc * 2; return st * 1024 + (ob ^ (((ob >> 9) & 1) << 5)); }
__host__ __device__ __forceinline__ void stage_rc(int b, int& R, int& C) { const int st = b / 1024, sb = b % 1024, swz = sb ^ (((sb >> 9) & 1) << 5); R = (st >> 1) * 16 + swz / 64; C = (st & 1) * 32 + (swz % 64) / 2; }
__host__ __device__ __forceinline__ int perm32(int rho) { const int n = rho >> 4, i = rho & 15; return 8 * (i >> 2) + 4 * n + (i & 3); }

struct Unit { int pm, pn; };
struct Gemm { const bf16_t* A; const bf16_t* Bt; int M, N, K; };

struct StaticOrder {
    int nM, nN, nwg, G, c;
    __host__ __device__ void init(int M, int N, int G_, int c_) { nM = M / BM; nN = N / BM; nwg = nM * nN; G = G_; c = c_; }
    __host__ __device__ bool next(int i, Unit& u) const {
        const long L = (long)i * G + c; if (L >= nwg) return false;
        int wgid = (int)L; { const int q = nwg / NXCD, r = nwg % NXCD, xcd = wgid % NXCD, off = wgid / NXCD; wgid = (xcd < r ? xcd * (q + 1) : r * (q + 1) + (xcd - r) * q) + off; }
        const int nig = WGM * nN, gid = wgid / nig, fm = gid * WGM, gsz = (nM - fm) < WGM ? (nM - fm) : WGM;
        u.pm = fm + ((wgid % nig) % gsz); u.pn = (wgid % nig) / gsz; return true;
    }
    __device__ __forceinline__ void a_ready(const Unit&) const {}
    __device__ __forceinline__ void done(const Unit&) const {}
};
__device__ __forceinline__ unsigned cvt_pk_bf16(float lo, float hi) { unsigned r; asm volatile("v_cvt_pk_bf16_f32 %0, %1, %2" : "=v"(r) : "v"(lo), "v"(hi)); return r; }
typedef float f32x2 __attribute__((ext_vector_type(2)));
__device__ __forceinline__ f32x2 gelu_pk(f32x2 v) {
    const f32x2 av = __builtin_elementwise_abs(v), d = av * 0.2316418882f + 1.0f;
    f32x2 t; t.x = __builtin_amdgcn_rcpf(d.x); t.y = __builtin_amdgcn_rcpf(d.y);
    f32x2 q = t * 0.5307027145f + (-0.7265760135f); q = q * t + 0.7107068705f; q = q * t + (-0.142248368f); q = q * t + 0.127414796f; q = q * t;
    const f32x2 s = (v * v) * (-0.72134752044f);
    f32x2 e; e.x = __builtin_amdgcn_exp2f(s.x); e.y = __builtin_amdgcn_exp2f(s.y);
    const f32x2 m = v * (q * e), r = v - m;
    f32x2 o; o.x = v.x < 0.f ? m.x : r.x; o.y = v.y < 0.f ? m.y : r.y; return o;
}

template <int ACT  > struct EpiBf16 {
    static constexpr bool PERM = true, AFTER_DRAIN = false; static_assert(ACT == 0 || ACT == 1, "EpiBf16: ACT is 0 (none) or 1 (gelu_pk)");
    bf16_t* O; int ldc; const float* bias; int split_cols; size_t split_stride; float scale0;
    __device__ __forceinline__ void operator()(const f32x4 (&acc)[2][2][4][2], const Unit& u, int wr, int wc, int fr, int fq) const {
        const int row0 = u.pm * BM + wr * 64 + fr; int colt = u.pn * BM; bf16_t* base = O;
        float sc = 1.f; if (split_cols) { const int t = colt / split_cols; base += (size_t)t * split_stride; colt -= t * split_cols; if (t == 0) sc = scale0; }
        const int col0 = colt + wc * 32 + 8 * fq, bcol0 = u.pn * BM + wc * 32 + 8 * fq;
        f32x4 bv[2][2];
#pragma unroll
        for (int bj = 0; bj < 2; ++bj)
#pragma unroll
            for (int n = 0; n < 2; ++n) bv[bj][n] = bias ? *(const f32x4*)(bias + bcol0 + bj * HALF + 4 * n) : (f32x4){0.f, 0.f, 0.f, 0.f};
#pragma unroll
        for (int ai = 0; ai < 2; ++ai)
#pragma unroll
            for (int m = 0; m < 4; ++m) { bf16_t* rowp = base + (size_t)(row0 + ai * HALF + m * 16) * ldc + col0;
#pragma unroll
                for (int bj = 0; bj < 2; ++bj) { f32x4 v0 = acc[ai][bj][m][0] + bv[bj][0], v1 = acc[ai][bj][m][1] + bv[bj][1];
                    if (ACT == 1) { f32x2 a = gelu_pk((f32x2){v0[0], v0[1]}), b = gelu_pk((f32x2){v0[2], v0[3]}), c = gelu_pk((f32x2){v1[0], v1[1]}), d = gelu_pk((f32x2){v1[2], v1[3]});
                        v0 = (f32x4){a.x, a.y, b.x, b.y}; v1 = (f32x4){c.x, c.y, d.x, d.y}; }
                    v0 = v0 * sc; v1 = v1 * sc; u32x4 w; w.x = cvt_pk_bf16(v0[0], v0[1]); w.y = cvt_pk_bf16(v0[2], v0[3]); w.z = cvt_pk_bf16(v1[0], v1[1]); w.w = cvt_pk_bf16(v1[2], v1[3]);
                    *(u32x4*)(rowp + bj * HALF) = w; } }
    }
};

struct EpiOut {
    static constexpr bool PERM = true, AFTER_DRAIN = false;
    const float* X; float* Hout; bf16_t* HG; const float* mod; const float* gffn; float* ssqp;
    __device__ __forceinline__ void operator()(const f32x4 (&acc)[2][2][4][2], const Unit& u, int wr, int wc, int fr, int fq) const {
        const int row0 = u.pm * BM + wr * 64 + fr, col0 = u.pn * BM + wc * 32 + 8 * fq;
        const int b = (u.pm * BM) >> 13;
        const float* mb = mod + b * 6144;
        f32x4 g1v[2][2], gv2[2][2];
#pragma unroll
        for (int bj = 0; bj < 2; ++bj)
#pragma unroll
            for (int n = 0; n < 2; ++n) { const int c = col0 + bj * HALF + 4 * n;
                g1v[bj][n] = *(const f32x4*)(mb + 2048 + c);
                const f32x4 s2 = *(const f32x4*)(mb + 4096 + c), gf = *(const f32x4*)(gffn + c);
                gv2[bj][n] = gf * (s2 + 1.0f); }
#pragma unroll
        for (int ai = 0; ai < 2; ++ai)
#pragma unroll
            for (int m = 0; m < 4; ++m) { const int row = row0 + ai * HALF + m * 16; const size_t ro = (size_t)row * 1024 + col0; float ss = 0.f;
#pragma unroll
                for (int bj = 0; bj < 2; ++bj) {
                    const f32x4 x0 = *(const f32x4*)(X + ro + bj * HALF), x1 = *(const f32x4*)(X + ro + bj * HALF + 4);
                    const f32x4 h0 = x0 + g1v[bj][0] * acc[ai][bj][m][0], h1 = x1 + g1v[bj][1] * acc[ai][bj][m][1];
                    *(f32x4*)(Hout + ro + bj * HALF) = h0; *(f32x4*)(Hout + ro + bj * HALF + 4) = h1;
                    ss += h0[0] * h0[0] + h0[1] * h0[1] + h0[2] * h0[2] + h0[3] * h0[3] + h1[0] * h1[0] + h1[1] * h1[1] + h1[2] * h1[2] + h1[3] * h1[3];
                    const f32x4 q0 = h0 * gv2[bj][0], q1 = h1 * gv2[bj][1];
                    u32x4 w; w.x = cvt_pk_bf16(q0[0], q0[1]); w.y = cvt_pk_bf16(q0[2], q0[3]); w.z = cvt_pk_bf16(q1[0], q1[1]); w.w = cvt_pk_bf16(q1[2], q1[3]);
                    *(u32x4*)(HG + ro + bj * HALF) = w; }
                ss += __shfl_xor(ss, 16); ss += __shfl_xor(ss, 32);
                if (fq == 0) ssqp[(size_t)row * 16 + u.pn * 4 + wc] = ss; }
    }
};
struct EpiScore {
    static constexpr bool PERM = false, AFTER_DRAIN = false;
    float* S; const float* ssqp; const float* biasq;
    __device__ __forceinline__ void operator()(const f32x4 (&acc)[2][2][4][2], const Unit& u, int wr, int wc, int fr, int fq) const {
        const int row0 = u.pm * BM + wr * 64 + fr, col0 = u.pn * BM + wc * 32 + 4 * fq;
        const int b = (u.pm * BM) >> 13;
        f32x4 bv[2][2];
#pragma unroll
        for (int bj = 0; bj < 2; ++bj)
#pragma unroll
            for (int n = 0; n < 2; ++n) bv[bj][n] = *(const f32x4*)(biasq + b * 2048 + col0 + bj * HALF + n * 16);
#pragma unroll
        for (int ai = 0; ai < 2; ++ai)
#pragma unroll
            for (int m = 0; m < 4; ++m) { const int row = row0 + ai * HALF + m * 16;
                const f32x4* sp = (const f32x4*)(ssqp + (size_t)row * 16);
                const f32x4 p0 = sp[0], p1 = sp[1], p2 = sp[2], p3 = sp[3];
                const float tot = (p0[0] + p0[1] + p0[2] + p0[3]) + (p1[0] + p1[1] + p1[2] + p1[3]) + (p2[0] + p2[1] + p2[2] + p2[3]) + (p3[0] + p3[1] + p3[2] + p3[3]);
                const float rstd = __builtin_amdgcn_rsqf(tot * (1.0f / 1024.0f) + 1e-6f);
                float* rowp = S + (size_t)row * 2048 + col0;
#pragma unroll
                for (int bj = 0; bj < 2; ++bj)
#pragma unroll
                    for (int n = 0; n < 2; ++n) *(f32x4*)(rowp + bj * HALF + n * 16) = acc[ai][bj][m][n] * rstd + bv[bj][n]; }
    }
};
template <class Epi, class Sched, bool ALIGN_EPI = false, bool SP2 = false>
__device__ __forceinline__ void gemm_phase(PG8_LAS unsigned char* lds, const Gemm g, const Sched& S, const Epi& E) {
    const int tid = threadIdx.x, wid = __builtin_amdgcn_readfirstlane(tid >> 6), lane = tid & 63, wr = wid >> 2, wc = wid & 3, fr = lane & 15, fq = lane >> 4;
    const int K = g.K, nt = K / BK;
    unsigned voffA[2], voffB[2];
#pragma unroll
    for (int i = 0; i < 2; ++i) { int R, C; stage_rc(tid * 16 + i * 8192, R, C); const int Rb = Epi::PERM ? ((R & ~31) + perm32(R & 31)) : R;
        voffA[i] = (unsigned)(R * K + C) * 2u; voffB[i] = (unsigned)(Rb * K + C) * 2u; }
    const size_t kstep = (size_t)(BK * 2);
    const size_t hstep = (size_t)HALF * K * 2;
    const size_t tstep = 2 * hstep;
    const unsigned ldsw = (unsigned)wid * 1024u;
    const int aoff = lds_byte(wr * 64 + fr, fq * 8), boff = lds_byte(wc * 32 + fr, fq * 8);
#define PG8_SA(b, h) (((b) * 2 + (h)) * HTB)
#define PG8_SB(b, h) ((4 + (b) * 2 + (h)) * HTB)
#define PG8_STAGE(bufoff, gbase, voff) do { _Pragma("unroll") for (int _i = 0; _i < 2; ++_i) \
        __builtin_amdgcn_global_load_lds((const unsigned*)((const char*)(gbase) + (voff)[_i]), (PG8_LAS unsigned*)(lds + (bufoff) + ldsw + _i * 8192), 16, 0, 0); } while (0)
#define PG8_LDA(dst, b, h) do { _Pragma("unroll") for (int m = 0; m < 4; ++m) _Pragma("unroll") for (int k = 0; k < 2; ++k) dst[m][k] = *(const PG8_LAS bf16x8*)(lds + PG8_SA(b, h) + aoff + m * 2048 + k * 1024); } while (0)
#define PG8_LDB(dst, b, h) do { _Pragma("unroll") for (int n = 0; n < 2; ++n) _Pragma("unroll") for (int k = 0; k < 2; ++k) dst[n][k] = *(const PG8_LAS bf16x8*)(lds + PG8_SB(b, h) + boff + n * 2048 + k * 1024); } while (0)
#define PG8_MMA(ai, bj, At, Bt) do { __builtin_amdgcn_s_setprio(1); _Pragma("unroll") for (int m = 0; m < 4; ++m) _Pragma("unroll") for (int n = 0; n < 2; ++n) _Pragma("unroll") for (int k = 0; k < 2; ++k) \
        acc[ai][bj][m][n] = __builtin_amdgcn_mfma_f32_16x16x32_bf16(Bt[n][k], At[m][k], acc[ai][bj][m][n], 0, 0, 0); __builtin_amdgcn_s_setprio(0); } while (0)
#define PG8_WAIT_V(n) asm volatile("s_waitcnt vmcnt(" #n ")" ::: "memory")
#define PG8_WAIT_L(n) asm volatile("s_waitcnt lgkmcnt(" #n ")" ::: "memory")
#define PG8_BAR __builtin_amdgcn_s_barrier()
#define PG8_SCHED __builtin_amdgcn_sched_barrier(0)
    Unit cur, nxt; int ui = 0;
    if (!S.next(0, cur)) return;
    f32x4 acc[2][2][4][2];
#pragma unroll
    for (int a = 0; a < 2; ++a)
#pragma unroll
        for (int b = 0; b < 2; ++b)
#pragma unroll
            for (int m = 0; m < 4; ++m)
#pragma unroll
                for (int n = 0; n < 2; ++n) acc[a][b][m][n] = (f32x4){0.f, 0.f, 0.f, 0.f};
    bf16x8 At[4][2], B0[2][2], B1[2][2];
    const char* cA = (const char*)g.A + (size_t)cur.pm * tstep; const char* cB = (const char*)g.Bt + (size_t)cur.pn * tstep;
    S.a_ready(cur);
    if constexpr (SP2) {
        PG8_STAGE(PG8_SB(0, 0), cB, voffB); PG8_STAGE(PG8_SB(0, 1), cB + hstep, voffB); PG8_STAGE(PG8_SA(0, 0), cA, voffA); PG8_STAGE(PG8_SA(0, 1), cA + hstep, voffA);
        if (wr == 1) PG8_BAR;
        PG8_WAIT_V(2); PG8_BAR;
        PG8_STAGE(PG8_SB(1, 0), cB + kstep, voffB); PG8_STAGE(PG8_SA(1, 0), cA + kstep, voffA); PG8_STAGE(PG8_SB(1, 1), cB + hstep + kstep, voffB);
        PG8_WAIT_V(6); PG8_BAR;
    } else {
        PG8_STAGE(PG8_SB(0, 0), cB, voffB); PG8_STAGE(PG8_SA(0, 0), cA, voffA); PG8_STAGE(PG8_SB(0, 1), cB + hstep, voffB); PG8_STAGE(PG8_SA(0, 1), cA + hstep, voffA);
        if (wr == 1) PG8_BAR;
        PG8_WAIT_V(4); PG8_BAR;
        PG8_STAGE(PG8_SB(1, 0), cB + kstep, voffB); PG8_STAGE(PG8_SA(1, 0), cA + kstep, voffA); PG8_STAGE(PG8_SB(1, 1), cB + hstep + kstep, voffB);
        PG8_WAIT_V(6); PG8_BAR;
    }
    for (;;) {
        const bool has_next = S.next(ui + 1, nxt);
        const char* nA = has_next ? (const char*)g.A + (size_t)nxt.pm * tstep : cA; const char* nB = has_next ? (const char*)g.Bt + (size_t)nxt.pn * tstep : cB;
        for (int t = 0; t < nt; t += 2) {
            const bool last = (t == nt - 2);
            const char* a1 = cA + (size_t)(t + 1) * kstep;
            const char* a2 = last ? nA : cA + (size_t)(t + 2) * kstep; const char* b2 = last ? nB : cB + (size_t)(t + 2) * kstep;
            const char* a3 = a2 + kstep; const char* b3 = b2 + kstep;
            if (last && has_next) S.a_ready(nxt);
            if constexpr (SP2) {
            PG8_LDB(B0, 0, 0); PG8_LDB(B1, 0, 1); PG8_SCHED; PG8_LDA(At, 0, 0); PG8_STAGE(PG8_SA(1, 1), a1 + hstep, voffA);
            PG8_WAIT_V(8); PG8_WAIT_L(0); PG8_BAR; PG8_MMA(0, 0, At, B0); PG8_MMA(0, 1, At, B1); PG8_BAR; PG8_SCHED;
            PG8_LDA(At, 0, 1); PG8_STAGE(PG8_SB(0, 0), b2, voffB); PG8_STAGE(PG8_SB(0, 1), b2 + hstep, voffB); PG8_STAGE(PG8_SA(0, 0), a2, voffA);
            PG8_WAIT_V(8); PG8_WAIT_L(0); PG8_BAR; PG8_MMA(1, 0, At, B0); PG8_MMA(1, 1, At, B1); PG8_BAR; PG8_SCHED;
            PG8_LDB(B0, 1, 0); PG8_LDB(B1, 1, 1); PG8_SCHED; PG8_LDA(At, 1, 0); PG8_STAGE(PG8_SA(0, 1), a2 + hstep, voffA);
            PG8_WAIT_V(8); PG8_WAIT_L(0); PG8_BAR; PG8_MMA(0, 0, At, B0); PG8_MMA(0, 1, At, B1); PG8_BAR; PG8_SCHED;
            PG8_LDA(At, 1, 1); PG8_STAGE(PG8_SB(1, 0), b3, voffB); PG8_STAGE(PG8_SB(1, 1), b3 + hstep, voffB); PG8_STAGE(PG8_SA(1, 0), a3, voffA);
            PG8_WAIT_V(8); PG8_WAIT_L(0); PG8_BAR; PG8_MMA(1, 0, At, B0); PG8_MMA(1, 1, At, B1); PG8_BAR; PG8_SCHED;
            } else {
            PG8_LDB(B0, 0, 0); PG8_SCHED; PG8_LDA(At, 0, 0); PG8_STAGE(PG8_SA(1, 1), a1 + hstep, voffA);
            PG8_WAIT_L(8); PG8_BAR; PG8_WAIT_L(0); PG8_MMA(0, 0, At, B0); PG8_BAR; PG8_SCHED;
            PG8_LDB(B1, 0, 1); PG8_STAGE(PG8_SB(0, 0), b2, voffB);
            PG8_BAR; PG8_WAIT_L(0); PG8_MMA(0, 1, At, B1); PG8_BAR;
            PG8_LDA(At, 0, 1); PG8_STAGE(PG8_SA(0, 0), a2, voffA);
            PG8_BAR; PG8_WAIT_L(0); PG8_MMA(1, 0, At, B0); PG8_BAR; PG8_SCHED;
            PG8_STAGE(PG8_SB(0, 1), b2 + hstep, voffB);
            PG8_WAIT_V(6); PG8_BAR; PG8_MMA(1, 1, At, B1); PG8_BAR;
            PG8_LDB(B0, 1, 0); PG8_SCHED; PG8_LDA(At, 1, 0); PG8_STAGE(PG8_SA(0, 1), a2 + hstep, voffA);
            PG8_WAIT_L(8); PG8_BAR; PG8_WAIT_L(0); PG8_MMA(0, 0, At, B0); PG8_BAR; PG8_SCHED;
            PG8_LDB(B1, 1, 1); PG8_STAGE(PG8_SB(1, 0), b3, voffB);
            PG8_BAR; PG8_WAIT_L(0); PG8_MMA(0, 1, At, B1); PG8_BAR;
            PG8_LDA(At, 1, 1); PG8_STAGE(PG8_SA(1, 0), a3, voffA);
            PG8_BAR; PG8_WAIT_L(0); PG8_MMA(1, 0, At, B0); PG8_BAR; PG8_SCHED;
            PG8_STAGE(PG8_SB(1, 1), b3 + hstep, voffB);
            PG8_WAIT_V(6); PG8_BAR; PG8_MMA(1, 1, At, B1); PG8_BAR;
            }
        }
        if constexpr (ALIGN_EPI) { if (wr == 0) PG8_BAR; }
        if constexpr (!Epi::AFTER_DRAIN) { E(acc, cur, wr, wc, fr, fq); S.done(cur); }
        if (!has_next) break;
#pragma unroll
        for (int a = 0; a < 2; ++a)
#pragma unroll
            for (int b = 0; b < 2; ++b)
#pragma unroll
                for (int m = 0; m < 4; ++m)
#pragma unroll
                    for (int n = 0; n < 2; ++n) acc[a][b][m][n] = (f32x4){0.f, 0.f, 0.f, 0.f};
        cur = nxt; cA = nA; cB = nB; ++ui;
        if constexpr (ALIGN_EPI) { if (wr == 1) PG8_BAR; }
    }
    PG8_WAIT_V(0);
    if constexpr (!ALIGN_EPI) { if (wr == 0) PG8_BAR; }
    PG8_BAR;
    if constexpr (Epi::AFTER_DRAIN) { E.fused(acc, cur, wr, wc, fr, fq, lds, wid, lane); S.done(cur); }
#undef PG8_SA
#undef PG8_SB
#undef PG8_STAGE
#undef PG8_LDA
#undef PG8_LDB
#undef PG8_MMA
#undef PG8_WAIT_V
#undef PG8_WAIT_L
#undef PG8_BAR
#undef PG8_SCHED
}
}
#define MK_ONE_LAUNCH 1

constexpr int NB = 4, SEQ = 8192, T = NB * SEQ, D = 1024;
constexpr int NIN = 3584, DH = 512, HD = 128, NHH = 4, CHK = 64;
constexpr int NSEG = 16, SEGC = 8;
constexpr int CW = 31, CPAD = 15, DC = 512;
constexpr int PHEADS = 8, NQK = 2048, NSEL = 128;
constexpr float EPS = 1e-6f;
constexpr int NWAVES = 8, NTHR = 512;

constexpr size_t MiB = 1u << 20;
constexpr size_t WS_CTL = 0, CTL_ZERO_BYTES = 65536;
constexpr size_t WS_MOD = 1 * MiB, WS_FMOD = WS_MOD + 131072, WS_LB = WS_MOD + 196608, WS_BIASQ = WS_MOD + 262144;
constexpr size_t WS_WIN = 2 * MiB, WS_WOUT = 10 * MiB, WS_WQK = 12 * MiB;
constexpr size_t WS_UT = 16 * MiB, WS_VT = 48 * MiB;
constexpr size_t WS_BUFA = 80 * MiB;
constexpr size_t WS_BUFB = 144 * MiB;
constexpr size_t WS_SEG = 208 * MiB;
constexpr size_t WS_E = 208 * MiB, WS_W = 224 * MiB;
constexpr size_t WS_BIG = 240 * MiB;
constexpr size_t WS_SSQ = 496 * MiB;
constexpr size_t WS_SEGA = 498 * MiB;
constexpr size_t WS_END = 499 * MiB;
constexpr int CW_BAR = 1024;

constexpr int LDS_BYTES = 155648;
constexpr int MISC_OFF = LDS_BYTES - 256;

#define GAS __attribute__((address_space(1)))
#define LAS __attribute__((address_space(3)))
typedef unsigned short bf16;
typedef unsigned v4u __attribute__((ext_vector_type(4)));
typedef unsigned v2u __attribute__((ext_vector_type(2)));
typedef float f32x4 __attribute__((ext_vector_type(4)));
typedef float f32x16 __attribute__((ext_vector_type(16)));
typedef short bf16x8 __attribute__((ext_vector_type(8)));

__device__ __forceinline__ float bf2f(unsigned h) { return __builtin_bit_cast(float, h << 16); }
__device__ __forceinline__ float bflo(unsigned u) { return __builtin_bit_cast(float, u << 16); }
__device__ __forceinline__ float bfhi(unsigned u) { return __builtin_bit_cast(float, u & 0xffff0000u); }
__device__ __forceinline__ unsigned f2bf(float f) { unsigned u = __builtin_bit_cast(unsigned, f); return (u + 0x7fffu + ((u >> 16) & 1u)) >> 16; }
__device__ __forceinline__ unsigned pk2(float lo, float hi) { return f2bf(lo) | (f2bf(hi) << 16); }
__device__ __forceinline__ float sigmoidf_(float x) { return __builtin_amdgcn_rcpf(1.0f + __expf(-x)); }
__device__ __forceinline__ float wave_sum(float v) {
#pragma unroll
    for (int o = 1; o < 64; o <<= 1) v += __shfl_xor(v, o);
    return v;
}

#define XB_TMO      128
#define XB_XCNT(j)  (256  + 64 * (j))
#define XB_XSUB(j)  (1280 + 64 * (j))
#define XB_XGEN(j)  (2304 + 64 * (j))
#define XB_TOP      3328
#define XB_TOPGEN   3392
#define XCD_BAR_WORDS 3456
#define XB_SPIN_CAP (1u << 18)
__device__ __forceinline__ unsigned xb_ld(unsigned* p)              { return __hip_atomic_load(p, __ATOMIC_RELAXED, __HIP_MEMORY_SCOPE_AGENT); }
__device__ __forceinline__ unsigned xb_add(unsigned* p, unsigned v) { return __hip_atomic_fetch_add(p, v, __ATOMIC_RELAXED, __HIP_MEMORY_SCOPE_AGENT); }
__device__ __forceinline__ unsigned xb_xcc_id() { return (unsigned)__builtin_amdgcn_s_getreg((3 << 11) | 20) & 0xFu; }
#define XB_SPIN(cond, bar) do { unsigned _sp = 0; while (cond) { __builtin_amdgcn_s_sleep(1); \
    if ((++_sp & 255u) == 0u) { if (xb_ld(&(bar)[XB_TMO])) break; if (_sp > XB_SPIN_CAP) { atomicAdd(&(bar)[XB_TMO], 1u); break; } } } } while (0)
struct XcdBarrier { unsigned* bar; unsigned x; volatile LAS unsigned* st; };
__device__ __forceinline__ XcdBarrier xcd_barrier_post(unsigned* bar, volatile LAS unsigned* st) {
    XcdBarrier b; b.bar = bar; b.x = xb_xcc_id(); b.st = st;
    if (threadIdx.x == 0) (void)xb_add(&bar[XB_XCNT(b.x)], 1u);
    return b;
}
__device__ __forceinline__ void xcd_barrier_complete(unsigned* bar, unsigned x, unsigned& nloc, unsigned& nx) {
    const unsigned G = gridDim.x * gridDim.y * gridDim.z;
    unsigned sum, cnt, mine, sp = 0u;
    for (;;) {
        sum = 0u; cnt = 0u; mine = 0u;
#pragma unroll
        for (unsigned j = 0; j < 16; ++j) { const unsigned c = xb_ld(&bar[XB_XCNT(j)]); sum += c; cnt += (c > 0u) ? 1u : 0u; mine = (j == x) ? c : mine; }
        if (sum == G) break;
        __builtin_amdgcn_s_sleep(1);
        if ((++sp & 255u) == 0u) { if (xb_ld(&bar[XB_TMO])) break; if (sp > XB_SPIN_CAP) { atomicAdd(&bar[XB_TMO], 1u); break; } }
    }
    nloc = mine > 0u ? mine : 1u; nx = cnt > 0u ? cnt : 1u;
}
__device__ __forceinline__ void xcd_barrier(const XcdBarrier& b) {
    asm volatile("s_waitcnt vmcnt(0)" ::: "memory");
    __syncthreads();
    if (threadIdx.x == 0) {
        unsigned* bar = b.bar;
        __builtin_amdgcn_s_waitcnt(0);
        unsigned nloc = b.st[0], nx = b.st[1];
        if (nloc == 0u) { xcd_barrier_complete(bar, b.x, nloc, nx); b.st[0] = nloc; b.st[1] = nx; }
        const unsigned old = xb_add(&bar[XB_XSUB(b.x)], 1u);
        const unsigned gen = old / nloc;
        if (old + 1u == (gen + 1u) * nloc) {
            __builtin_amdgcn_fence(__ATOMIC_RELEASE, "agent");
            asm volatile("s_waitcnt vmcnt(0)" ::: "memory");
            const unsigned og = xb_add(&bar[XB_TOP], 1u);
            const unsigned tg = og / nx;
            if (og + 1u == (tg + 1u) * nx) xb_add(&bar[XB_TOPGEN], 1u);
            else XB_SPIN(xb_ld(&bar[XB_TOPGEN]) == tg, bar);
            __builtin_amdgcn_fence(__ATOMIC_ACQUIRE, "agent");
            xb_add(&bar[XB_XGEN(b.x)], 1u);
            asm volatile("s_waitcnt vmcnt(0)" ::: "memory");
        } else {
            XB_SPIN(xb_ld(&bar[XB_XGEN(b.x)]) == gen, bar);
            __builtin_amdgcn_fence(__ATOMIC_ACQUIRE, "agent");
            asm volatile("s_waitcnt vmcnt(0)" ::: "memory");
        }
    }
    __syncthreads();
}

struct Args { const float* in[23]; float* out; unsigned char* ws; int ph_lo, ph_hi; };
struct Frame {
    LAS unsigned char* lds;
    int tid, lane, wave, G, bid;
    const Args* a;
    __device__ __forceinline__ const float* x() const { return a->in[0]; }
    __device__ __forceinline__ const float* c() const { return a->in[1]; }
    __device__ __forceinline__ const float* ada_w() const { return a->in[2]; }
    __device__ __forceinline__ const float* ada_b() const { return a->in[3]; }
    __device__ __forceinline__ const float* g_mix() const { return a->in[4]; }
    __device__ __forceinline__ const float* w_in() const { return a->in[5]; }
    __device__ __forceinline__ const float* lbg_f() const { return a->in[6]; }
    __device__ __forceinline__ const float* lbg_b() const { return a->in[7]; }
    __device__ __forceinline__ const float* hnorm_g() const { return a->in[8]; }
    __device__ __forceinline__ const float* conv_w() const { return a->in[9]; }
    __device__ __forceinline__ const float* conv_b() const { return a->in[10]; }
    __device__ __forceinline__ const float* cln_g() const { return a->in[11]; }
    __device__ __forceinline__ const float* cln_b() const { return a->in[12]; }
    __device__ __forceinline__ const float* w_out() const { return a->in[13]; }
    __device__ __forceinline__ const float* g_ffn() const { return a->in[14]; }
    __device__ __forceinline__ const float* wq() const { return a->in[15]; }
    __device__ __forceinline__ const float* keys1() const { return a->in[16]; }
    __device__ __forceinline__ const float* keys2() const { return a->in[17]; }
    __device__ __forceinline__ const float* utab() const { return a->in[18]; }
    __device__ __forceinline__ const float* vtab() const { return a->in[19]; }
    __device__ __forceinline__ const float* fada_w() const { return a->in[20]; }
    __device__ __forceinline__ const float* fada_b() const { return a->in[21]; }
    __device__ __forceinline__ const float* fnorm_g() const { return a->in[22]; }
    __device__ __forceinline__ float* out() const { return a->out; }
    __device__ __forceinline__ float* mod() const { return (float*)(a->ws + WS_MOD); }
    __device__ __forceinline__ float* fmod() const { return (float*)(a->ws + WS_FMOD); }
    __device__ __forceinline__ float* lb() const { return (float*)(a->ws + WS_LB); }
    __device__ __forceinline__ float* biasq() const { return (float*)(a->ws + WS_BIASQ); }
    __device__ __forceinline__ float* ssqp() const { return (float*)(a->ws + WS_SSQ); }
    __device__ __forceinline__ float* sega() const { return (float*)(a->ws + WS_SEGA); }
    __device__ __forceinline__ float* segu() const { return (float*)(a->ws + WS_SEG); }
    __device__ __forceinline__ float* of() const { return (float*)(a->ws + WS_BUFB); }
    __device__ __forceinline__ float* scores() const { return (float*)(a->ws + WS_BIG); }
    __device__ __forceinline__ float* wsel() const { return (float*)(a->ws + WS_W); }
    __device__ __forceinline__ int* esel() const { return (int*)(a->ws + WS_E); }
    __device__ __forceinline__ bf16* Win_t() const { return (bf16*)(a->ws + WS_WIN); }
    __device__ __forceinline__ bf16* Wout_t() const { return (bf16*)(a->ws + WS_WOUT); }
    __device__ __forceinline__ bf16* Wqk_t() const { return (bf16*)(a->ws + WS_WQK); }
    __device__ __forceinline__ bf16* Ub() const { return (bf16*)(a->ws + WS_UT); }
    __device__ __forceinline__ bf16* Vb() const { return (bf16*)(a->ws + WS_VT); }
    __device__ __forceinline__ bf16* bufA() const { return (bf16*)(a->ws + WS_BUFA); }
    __device__ __forceinline__ bf16* hg() const { return (bf16*)(a->ws + WS_BUFB); }
    __device__ __forceinline__ bf16* proj() const { return (bf16*)(a->ws + WS_BIG); }
};

__device__ __forceinline__ void p0_gemv(Frame& F) {
    LAS float* cact = (LAS float*)(F.lds);
    LAS float* red = (LAS float*)(F.lds + 16384);
    for (int i = F.tid; i < 4096; i += NTHR) { const float c = F.c()[i]; cact[i] = c * sigmoidf_(c); }
    __syncthreads();
    for (int item = F.bid; item < 128; item += F.G) {
        const int col0 = item * 64; const float* W; int N, cc;
        if (col0 < 6144) { W = F.ada_w(); N = 6144; cc = col0; } else { W = F.fada_w(); N = 2048; cc = col0 - 6144; }
        const float* wp = W + (size_t)(F.wave * 128) * N + cc + F.lane;
        float a0 = 0.f, a1 = 0.f, a2 = 0.f, a3 = 0.f;
#pragma unroll 8
        for (int k = 0; k < 128; ++k) { const float w = wp[(size_t)k * N]; const int kk = F.wave * 128 + k;
            a0 += cact[kk] * w; a1 += cact[1024 + kk] * w; a2 += cact[2048 + kk] * w; a3 += cact[3072 + kk] * w; }
        red[(F.wave * 4 + 0) * 64 + F.lane] = a0; red[(F.wave * 4 + 1) * 64 + F.lane] = a1; red[(F.wave * 4 + 2) * 64 + F.lane] = a2; red[(F.wave * 4 + 3) * 64 + F.lane] = a3;
        __syncthreads();
        if (F.tid < 256) { const int b = F.tid >> 6, l = F.tid & 63; float s = 0.f;
#pragma unroll
            for (int w = 0; w < 8; ++w) s += red[(w * 4 + b) * 64 + l];
            if (col0 < 6144) F.mod()[b * 6144 + cc + l] = s + F.ada_b()[cc + l]; else F.fmod()[b * 2048 + cc + l] = s + F.fada_b()[cc + l]; }
        __syncthreads();
    }
}
__device__ __forceinline__ void p0_transpose_item(const float* W, int K, int N, bf16* WT, LAS float* scr, int item, int lane) {
    const int nblk = N / 32, kb = item / nblk, nb = item % nblk, k0 = 64 * kb, n0 = 32 * nb;
#pragma unroll 8
    for (int i = 0; i < 32; ++i) { const int kk = 2 * i + (lane >> 5); scr[kk * 33 + (lane & 31)] = W[(size_t)(k0 + kk) * N + n0 + (lane & 31)]; }
    asm volatile("s_waitcnt lgkmcnt(0)" ::: "memory");
    const int c = lane & 7;
#pragma unroll
    for (int j = 0; j < 4; ++j) { const int n = (lane >> 3) + 8 * j; const LAS float* s = scr + (8 * c) * 33 + n;
        v4u o; o.x = pk2(s[0 * 33], s[1 * 33]); o.y = pk2(s[2 * 33], s[3 * 33]); o.z = pk2(s[4 * 33], s[5 * 33]); o.w = pk2(s[6 * 33], s[7 * 33]);
        *(v4u*)(WT + (size_t)(n0 + n) * K + k0 + 8 * c) = o; }
    asm volatile("s_waitcnt lgkmcnt(0)" ::: "memory");
}
__device__ __forceinline__ void p0_wqk_item(Frame& F, int item) {
    const int jh = item & 1, kb = (item >> 1) & 15, hh = item >> 5, h = hh >> 1, half = hh & 1;
    const float* keys = (half ? F.keys2() : F.keys1()) + (size_t)(jh * 64) * 128;
    const int k = kb * 64 + F.lane;
    const float* wrow = F.wq() + (size_t)k * 2048 + h * 256 + half * 128;
    float acc[64];
#pragma unroll
    for (int j = 0; j < 64; ++j) acc[j] = 0.f;
    for (int d = 0; d < 128; d += 4) {
        const f32x4 a = *(const f32x4*)(wrow + d);
#pragma unroll
        for (int j = 0; j < 64; ++j) { const float* kp = keys + j * 128 + d; acc[j] += a[0] * kp[0] + a[1] * kp[1] + a[2] * kp[2] + a[3] * kp[3]; }
    }
    bf16* o = F.Wqk_t() + (size_t)(h * 256 + half * 128 + jh * 64) * 1024 + k;
#pragma unroll
    for (int j = 0; j < 64; ++j) o[(size_t)j * 1024] = (bf16)f2bf(acc[j]);
}
__device__ __forceinline__ void p0_prologue(Frame& F) {
    if (F.bid < 128) p0_gemv(F);
    if (F.bid == 128 % F.G) { const int i = F.tid;
        F.lb()[i] = __builtin_amdgcn_rcpf(1.0f + __expf(F.lbg_f()[512 + i] - F.lbg_f()[i]));
        F.lb()[512 + i] = __builtin_amdgcn_rcpf(1.0f + __expf(F.lbg_b()[512 + i] - F.lbg_b()[i])); }
    LAS float* scr = (LAS float*)(F.lds + 32768 + F.wave * 8704);
    const int gw = F.wave * F.G + F.bid, NGW = F.G * NWAVES;
    constexpr int I_QK = 512, I_IN = (D / 64) * (NIN / 32), I_OUT = (D / 64) * (D / 32), I_TAB = 2 * 16384 / 4;
    constexpr int NITEMS = I_QK + I_IN + I_OUT + I_TAB;
    for (int it = gw; it < NITEMS; it += NGW) {
        int r = it;
        if (r < I_QK) { p0_wqk_item(F, r); continue; } r -= I_QK;
        if (r < I_IN) { p0_transpose_item(F.w_in(), D, NIN, F.Win_t(), scr, r, F.lane); continue; } r -= I_IN;
        if (r < I_OUT) { p0_transpose_item(F.w_out(), D, D, F.Wout_t(), scr, r, F.lane); continue; } r -= I_OUT;
        { const int tab = r >= 4096, rr = (tab ? r - 4096 : r) * 4; const float* src = (tab ? F.vtab() : F.utab()) + (size_t)rr * 1024; bf16* dst = (tab ? F.Vb() : F.Ub()) + (size_t)rr * 1024;
#pragma unroll
          for (int q = 0; q < 16; ++q) { const f32x4 v = *(const f32x4*)(src + q * 256 + 4 * F.lane); v2u o; o.x = pk2(v[0], v[1]); o.y = pk2(v[2], v[3]); *(v2u*)(dst + q * 256 + 4 * F.lane) = o; } }
    }
}

__device__ __forceinline__ void p1_norm(Frame& F) {
    const int gwc = F.bid * NWAVES + F.wave, NGW = F.G * NWAVES;
    for (int row0 = gwc * 16; row0 < T; row0 += NGW * 16) {
        const int b = row0 >> 13; const float* mb = F.mod() + b * 6144;
        f32x4 ca[4], cb[4];
#pragma unroll
        for (int j = 0; j < 4; ++j) { const int k = 256 * j + 4 * F.lane; const f32x4 g = *(const f32x4*)(F.g_mix() + k), s = *(const f32x4*)(mb + 1024 + k); ca[j] = g * (s + 1.0f); cb[j] = *(const f32x4*)(mb + k); }
        for (int r = 0; r < 16; ++r) { const float* xr = F.x() + (size_t)(row0 + r) * D;
            f32x4 v[4]; float ss = 0.f;
#pragma unroll
            for (int j = 0; j < 4; ++j) { v[j] = *(const f32x4*)(xr + 256 * j + 4 * F.lane); ss += v[j][0] * v[j][0] + v[j][1] * v[j][1] + v[j][2] * v[j][2] + v[j][3] * v[j][3]; }
            const float rstd = __builtin_amdgcn_rsqf(wave_sum(ss) * (1.0f / D) + EPS);
            bf16* o = F.bufA() + (size_t)(row0 + r) * D;
#pragma unroll
            for (int j = 0; j < 4; ++j) { const f32x4 y = v[j] * rstd * ca[j] + cb[j]; v2u w; w.x = pk2(y[0], y[1]); w.y = pk2(y[2], y[3]); *(v2u*)(o + 256 * j + 4 * F.lane) = w; } }
    }
    const int gw = F.wave * F.G + F.bid;
    for (int n = gw; n < NQK; n += NGW) {
        const v4u w0 = *(const v4u*)(F.Wqk_t() + (size_t)n * 1024 + 8 * F.lane), w1 = *(const v4u*)(F.Wqk_t() + (size_t)n * 1024 + 512 + 8 * F.lane);
        float wv[16];
#pragma unroll
        for (int i = 0; i < 4; ++i) { wv[2 * i] = bflo(w0[i]); wv[2 * i + 1] = bfhi(w0[i]); wv[8 + 2 * i] = bflo(w1[i]); wv[8 + 2 * i + 1] = bfhi(w1[i]); }
#pragma unroll
        for (int b = 0; b < 4; ++b) { const float* sh2 = F.mod() + b * 6144 + 3072; float s = 0.f;
#pragma unroll
            for (int i = 0; i < 8; ++i) s += wv[i] * sh2[8 * F.lane + i] + wv[8 + i] * sh2[512 + 8 * F.lane + i];
            s = wave_sum(s); if (F.lane == 0) F.biasq()[b * 2048 + n] = s; }
    }
}

__device__ __forceinline__ void conv_item(Frame& F, int item, const float (&cw)[CW], float cbias) {
    LAS bf16* hbuf = (LAS bf16*)(F.lds);
    LAS float* ybuf = (LAS float*)(F.lds + 65536);
    const int tok0 = item * 32, b = tok0 >> 13, t0 = tok0 & (SEQ - 1), c = F.tid;
    for (int r = 0; r < 62; ++r) { const int t = t0 - CPAD + r; float h = 0.f;
        if (t >= 0 && t < SEQ) { const bf16* pr = F.proj() + (size_t)(b * SEQ + t) * NIN; const float a = bf2f(pr[2560 + c]), g = bf2f(pr[3072 + c]); h = a * sigmoidf_(g); }
        hbuf[r * 512 + c] = (bf16)f2bf(h); }
    __syncthreads();
    float hv[62];
#pragma unroll
    for (int r = 0; r < 62; ++r) hv[r] = bf2f(hbuf[r * 512 + c]);
#pragma unroll
    for (int tt = 0; tt < 32; ++tt) { float acc = cbias;
#pragma unroll
        for (int j = 0; j < CW; ++j) acc += cw[j] * hv[tt + j];
        ybuf[tt * 512 + c] = acc; }
    __syncthreads();
#pragma unroll
    for (int q = 0; q < 4; ++q) { const int tt = F.wave * 4 + q;
        const f32x4 y0 = *(LAS const f32x4*)(ybuf + tt * 512 + 4 * F.lane), y1 = *(LAS const f32x4*)(ybuf + tt * 512 + 256 + 4 * F.lane);
        const float mean = wave_sum((y0[0] + y0[1] + y0[2] + y0[3]) + (y1[0] + y1[1] + y1[2] + y1[3])) * (1.0f / DC);
        const f32x4 d0 = y0 - mean, d1 = y1 - mean;
        const float var = wave_sum((d0[0] * d0[0] + d0[1] * d0[1] + d0[2] * d0[2] + d0[3] * d0[3]) + (d1[0] * d1[0] + d1[1] * d1[1] + d1[2] * d1[2] + d1[3] * d1[3])) * (1.0f / DC);
        const float rstd = __builtin_amdgcn_rsqf(var + EPS);
        const f32x4 g0 = *(const f32x4*)(F.cln_g() + 4 * F.lane), g1 = *(const f32x4*)(F.cln_g() + 256 + 4 * F.lane), b0 = *(const f32x4*)(F.cln_b() + 4 * F.lane), b1 = *(const f32x4*)(F.cln_b() + 256 + 4 * F.lane);
        f32x4 z0 = d0 * rstd * g0 + b0, z1 = d1 * rstd * g1 + b1;
#pragma unroll
        for (int i = 0; i < 4; ++i) { z0[i] = z0[i] * sigmoidf_(z0[i]); z1[i] = z1[i] * sigmoidf_(z1[i]); }
        bf16* o = F.bufA() + (size_t)(tok0 + tt) * D + 512;
        v2u w0, w1; w0.x = pk2(z0[0], z0[1]); w0.y = pk2(z0[2], z0[3]); w1.x = pk2(z1[0], z1[1]); w1.y = pk2(z1[2], z1[3]);
        *(v2u*)(o + 4 * F.lane) = w0; *(v2u*)(o + 256 + 4 * F.lane) = w1; }
    __syncthreads();
}

constexpr int PQ = 272, PT = 144;
constexpr int HL_QR = 0, HL_KR = 17408, HL_QE = 34816, HL_KET = 52224, HL_VT = 70656, HL_SCM = 89088, HL_ST = 98304, HL_PBLK = 133120, HL_AV = 135168, HL_RS = 135680;
__device__ __forceinline__ bf16x8 ldf(LAS const unsigned char* base, int row, int pitch, int kbyte) { return *(LAS const bf16x8*)(base + row * pitch + kbyte); }
#define MFMA32(a, b, c) __builtin_amdgcn_mfma_f32_32x32x16_bf16((a), (b), (c), 0, 0, 0)

template <bool FULL, int MODE>
__device__ __forceinline__ void hgrn_chunk(Frame& F, int b, int h, int dir, int chunk, f32x16 (&accS)[2], float lbv) {
    LAS unsigned char* lds = F.lds;
    const int w = F.wave, r = F.lane & 31, hh = F.lane >> 5;
    const int col = (w & 1) * 64 + F.lane, pb4 = w >> 1, p0 = pb4 * 16;
    const size_t tokbase = (size_t)b * SEQ + (size_t)chunk * CHK;
    {
        const int zoff = dir ? 1024 : 512;
        float fz[16], cp[16]; unsigned vraw[16]; float qv[16];
#pragma unroll
        for (int i = 0; i < 16; ++i) { const int p = p0 + i, tr = dir ? (63 - p) : p; const bf16* q = F.proj() + (tokbase + tr) * NIN + h * HD;
            fz[i] = bf2f(q[zoff + col]); vraw[i] = q[1536 + col]; if (FULL) qv[i] = bf2f(q[col]); }
        float run = 1.f;
#pragma unroll
        for (int i = 0; i < 16; ++i) { const float f = lbv + (1.0f - lbv) * sigmoidf_(fz[i]); fz[i] = f; run *= f; cp[i] = run; }
        LAS float* pblk = (LAS float*)(lds + HL_PBLK);
        pblk[pb4 * 128 + col] = run;
        __syncthreads();
        const float b0 = pblk[col], b1 = pblk[128 + col], b2 = pblk[256 + col], b3 = pblk[384 + col];
        const float pre = pb4 == 0 ? 1.f : (pb4 == 1 ? b0 : (pb4 == 2 ? b0 * b1 : b0 * b1 * b2));
        const float pref = b0 * b1, tot = pref * b2 * b3, ipref = __builtin_amdgcn_rcpf(pref);
        if (pb4 == 0) ((LAS float*)(lds + HL_AV))[col] = tot;
        float ke[16];
#pragma unroll
        for (int i = 0; i < 16; ++i) { const float P = pre * cp[i], iP = __builtin_amdgcn_rcpf(P), k = 1.0f - fz[i];
            ke[i] = k * tot * iP;
            if (FULL) { const int p = p0 + i; const float qs = qv[i] * sigmoidf_(qv[i]), qe = qs * P;
                *(LAS bf16*)(lds + HL_QE + p * PQ + col * 2) = (bf16)f2bf(qe);
                *(LAS bf16*)(lds + HL_QR + p * PQ + col * 2) = (bf16)f2bf(qe * ipref);
                *(LAS bf16*)(lds + HL_KR + p * PQ + col * 2) = (bf16)f2bf(k * pref * iP); } }
        v4u k0, k1, v0, v1;
        k0.x = pk2(ke[0], ke[1]); k0.y = pk2(ke[2], ke[3]); k0.z = pk2(ke[4], ke[5]); k0.w = pk2(ke[6], ke[7]);
        k1.x = pk2(ke[8], ke[9]); k1.y = pk2(ke[10], ke[11]); k1.z = pk2(ke[12], ke[13]); k1.w = pk2(ke[14], ke[15]);
        v0.x = vraw[0] | (vraw[1] << 16); v0.y = vraw[2] | (vraw[3] << 16); v0.z = vraw[4] | (vraw[5] << 16); v0.w = vraw[6] | (vraw[7] << 16);
        v1.x = vraw[8] | (vraw[9] << 16); v1.y = vraw[10] | (vraw[11] << 16); v1.z = vraw[12] | (vraw[13] << 16); v1.w = vraw[14] | (vraw[15] << 16);
        *(LAS v4u*)(lds + HL_KET + col * PT + p0 * 2) = k0; *(LAS v4u*)(lds + HL_KET + col * PT + p0 * 2 + 16) = k1;
        *(LAS v4u*)(lds + HL_VT + col * PT + p0 * 2) = v0; *(LAS v4u*)(lds + HL_VT + col * PT + p0 * 2 + 16) = v1;
    }
    __syncthreads();
    const int pbO = w & 1, vb = w >> 1;
    f32x16 accO, accU[2];
#pragma unroll
    for (int i = 0; i < 16; ++i) { accO[i] = 0.f; accU[0][i] = 0.f; accU[1][i] = 0.f; }
    if (FULL) {
        if (w < 3) { const int pbS = (w + 1) >> 1, sbS = (w == 2) ? 1 : 0; f32x16 sc;
#pragma unroll
            for (int i = 0; i < 16; ++i) sc[i] = 0.f;
#pragma unroll
            for (int s = 0; s < 8; ++s) sc = MFMA32(ldf(lds + HL_QR, pbS * 32 + r, PQ, 32 * s + 16 * hh), ldf(lds + HL_KR, sbS * 32 + r, PQ, 32 * s + 16 * hh), sc);
#pragma unroll
            for (int i = 0; i < 16; ++i) { const int p = pbS * 32 + (i & 3) + 8 * (i >> 2) + 4 * hh, s = sbS * 32 + r;
                *(LAS bf16*)(lds + HL_SCM + p * PT + s * 2) = (bf16)f2bf(s <= p ? sc[i] : 0.f); } }
        __builtin_amdgcn_sched_barrier(0);
#pragma unroll
        for (int s = 0; s < 8; ++s) accO = MFMA32(ldf(lds + HL_QE, pbO * 32 + r, PQ, 32 * s + 16 * hh), ldf(lds + HL_ST, vb * 32 + r, PQ, 32 * s + 16 * hh), accO);
        __builtin_amdgcn_sched_barrier(0);
    }
#pragma unroll
    for (int i = 0; i < 2; ++i) { const int db = 2 * (w & 1) + i;
#pragma unroll
        for (int s = 0; s < 4; ++s) accU[i] = MFMA32(ldf(lds + HL_VT, vb * 32 + r, PT, 32 * s + 16 * hh), ldf(lds + HL_KET, db * 32 + r, PT, 32 * s + 16 * hh), accU[i]); }
    __builtin_amdgcn_sched_barrier(0);
    if (FULL) __syncthreads();
    if (FULL) {
        for (int sb = 0; sb <= pbO; ++sb)
#pragma unroll
            for (int s2 = 0; s2 < 2; ++s2) accO = MFMA32(ldf(lds + HL_SCM, pbO * 32 + r, PT, 64 * sb + 32 * s2 + 16 * hh), ldf(lds + HL_VT, vb * 32 + r, PT, 64 * sb + 32 * s2 + 16 * hh), accO);
        const int v = vb * 32 + r;
        const long loff = (MODE == 0 ? 4 * hh : -4 * hh);
        if (MODE == 0) {
            float* ob = F.of() + (tokbase + pbO * 32) * DH + h * HD;
#pragma unroll
            for (int i = 0; i < 16; ++i) { const int ci = (i & 3) + 8 * (i >> 2); (ob + (size_t)ci * DH)[loff * DH + v] = accO[i]; }
        } else {
            LAS float* rs = (LAS float*)(lds + HL_RS);
            const size_t tb = tokbase + 63 - pbO * 32;
            float ov[16];
#pragma unroll
            for (int i = 0; i < 16; ++i) { const int ci = (i & 3) + 8 * (i >> 2), p = pbO * 32 + ci + 4 * hh;
                ov[i] = accO[i] + (F.of() + (tb - ci) * DH + h * HD)[loff * DH + v]; float ss = ov[i] * ov[i];
                ss += __shfl_xor(ss, 1); ss += __shfl_xor(ss, 2); ss += __shfl_xor(ss, 4); ss += __shfl_xor(ss, 8); ss += __shfl_xor(ss, 16);
                if (r == 0) rs[p * 4 + vb] = ss; }
            __syncthreads();
            const float ng = F.hnorm_g()[h * HD + v];
#pragma unroll
            for (int i = 0; i < 16; ++i) { const int ci = (i & 3) + 8 * (i >> 2), p = pbO * 32 + ci + 4 * hh;
                const f32x4 q = *(LAS const f32x4*)(rs + p * 4);
                const float rstd = __builtin_amdgcn_rsqf((q[0] + q[1] + q[2] + q[3]) * (1.0f / HD) + EPS);
                const float g = bf2f((F.proj() + (tb - ci) * NIN + 2048 + h * HD)[loff * NIN + v]);
                (F.bufA() + (tb - ci) * D + h * HD)[loff * D + v] = (bf16)f2bf(ov[i] * rstd * ng * g * sigmoidf_(g)); }
        }
    }
    {
        const LAS float* av = (const LAS float*)(lds + HL_AV);
#pragma unroll
        for (int i = 0; i < 2; ++i) { const int db = 2 * (w & 1) + i; const float a = av[db * 32 + r];
#pragma unroll
            for (int j = 0; j < 16; ++j) { const float sn = accS[i][j] * a + accU[i][j]; accS[i][j] = sn;
                if (FULL) { const int vv = vb * 32 + (j & 3) + 8 * (j >> 2) + 4 * hh; *(LAS bf16*)(lds + HL_ST + vv * PQ + (db * 32 + r) * 2) = (bf16)f2bf(sn); } } }
    }
    __syncthreads();
}
__device__ __forceinline__ void h1_item(Frame& F, int item) {
    const int seg = item & 15, dir = (item >> 4) & 1, h = (item >> 5) & 3, b = item >> 7;
    const int col = F.tid & 127; const float lbv = F.lb()[dir * 512 + h * HD + col];
    f32x16 accS[2];
#pragma unroll
    for (int i = 0; i < 16; ++i) { accS[0][i] = 0.f; accS[1][i] = 0.f; }
    float atot = 1.f;
    for (int c = 0; c < SEGC; ++c) { const int chunk = seg * SEGC + (dir ? (SEGC - 1 - c) : c);
        hgrn_chunk<false, 0>(F, b, h, dir, chunk, accS, lbv);
        atot *= ((const LAS float*)(F.lds + HL_AV))[col]; }
    if (F.tid < 128) F.sega()[(size_t)item * 128 + col] = atot;
    const int w = F.wave, r = F.lane & 31, hh = F.lane >> 5, vb = w >> 1;
    float* U = F.segu() + (size_t)item * 16384;
#pragma unroll
    for (int i = 0; i < 2; ++i)
#pragma unroll
        for (int j = 0; j < 16; ++j) (U + (i * 16 + j) * NTHR)[F.tid] = accS[i][j];
}
__device__ __forceinline__ void h2_init_state(Frame& F, int b, int h, int dir, int seg, f32x16 (&accS)[2]) {
    const int w = F.wave, r = F.lane & 31, hh = F.lane >> 5, vb = w >> 1;
#pragma unroll
    for (int i = 0; i < 16; ++i) { accS[0][i] = 0.f; accS[1][i] = 0.f; }
    const int base = ((b * 4 + h) * 2 + dir) * 16;
    const int n = dir ? (NSEG - 1 - seg) : seg;
    for (int q = 0; q < n; ++q) { const int s = dir ? (NSEG - 1 - q) : q;
        const float* U = F.segu() + (size_t)(base + s) * 16384; const float* A = F.sega() + (size_t)(base + s) * 128;
#pragma unroll
        for (int i = 0; i < 2; ++i) { const int db = 2 * (w & 1) + i; const float a = A[db * 32 + r];
#pragma unroll
            for (int j = 0; j < 16; ++j) accS[i][j] = accS[i][j] * a + (U + (i * 16 + j) * NTHR)[F.tid]; } }
#pragma unroll
    for (int i = 0; i < 2; ++i) { const int db = 2 * (w & 1) + i;
#pragma unroll
        for (int j = 0; j < 16; ++j) { const int vv = vb * 32 + (j & 3) + 8 * (j >> 2) + 4 * hh; *(LAS bf16*)(F.lds + HL_ST + vv * PQ + (db * 32 + r) * 2) = (bf16)f2bf(accS[i][j]); } }
    __syncthreads();
}
__device__ __forceinline__ void h2_item(Frame& F, int item) {
    const int seg = item & 15, h = (item >> 4) & 3, b = item >> 6;
    const int col = F.tid & 127;
    f32x16 accS[2];
    { const float lbv = F.lb()[h * HD + col];
      h2_init_state(F, b, h, 0, seg, accS);
      for (int c = 0; c < SEGC; ++c) hgrn_chunk<true, 0>(F, b, h, 0, seg * SEGC + c, accS, lbv); }
    asm volatile("s_waitcnt vmcnt(0)" ::: "memory");
    __syncthreads();
    { const float lbv = F.lb()[512 + h * HD + col];
      h2_init_state(F, b, h, 1, seg, accS);
      for (int c = 0; c < SEGC; ++c) hgrn_chunk<true, 1>(F, b, h, 1, seg * SEGC + (SEGC - 1 - c), accS, lbv); }
}

__device__ __forceinline__ unsigned f2key(float f) { const unsigned u = __builtin_bit_cast(unsigned, f); return (u & 0x80000000u) ? ~u : (u | 0x80000000u); }
__device__ __forceinline__ float key2f(unsigned k) { const unsigned u = (k & 0x80000000u) ? (k & 0x7fffffffu) : ~k; return __builtin_bit_cast(float, u); }
__device__ __forceinline__ unsigned umax_(unsigned a, unsigned b) { return a > b ? a : b; }
__device__ __forceinline__ unsigned umin_(unsigned a, unsigned b) { return a < b ? a : b; }
__device__ __forceinline__ void sort16(unsigned (&a)[16]) {
#pragma unroll
    for (int k = 2; k <= 16; k <<= 1)
#pragma unroll
        for (int j = k >> 1; j > 0; j >>= 1)
#pragma unroll
            for (int i = 0; i < 16; ++i) { const int l = i ^ j; if (l > i) { const bool desc = ((i & k) == 0); const unsigned x = a[i], y = a[l], mx = umax_(x, y), mn = umin_(x, y); a[i] = desc ? mx : mn; a[l] = desc ? mn : mx; } }
}
__device__ __forceinline__ void merge16(unsigned (&a)[16], const unsigned (&b)[16]) {
#pragma unroll
    for (int i = 0; i < 16; ++i) a[i] = umax_(a[i], b[15 - i]);
#pragma unroll
    for (int j = 8; j > 0; j >>= 1)
#pragma unroll
        for (int i = 0; i < 16; ++i) { const int l = i ^ j; if (l > i) { const unsigned x = a[i], y = a[l]; a[i] = umax_(x, y); a[l] = umin_(x, y); } }
}
__device__ __forceinline__ unsigned dpp_swap1(unsigned v) { return (unsigned)__builtin_amdgcn_update_dpp(0, (int)v, 0xB1, 0xF, 0xF, false); }
__device__ __forceinline__ unsigned pick_byte(const unsigned (&pk)[4], unsigned a) {
    const unsigned wsel = a >> 2; unsigned v = wsel == 0 ? pk[0] : (wsel == 1 ? pk[1] : (wsel == 2 ? pk[2] : pk[3]));
    return (v >> ((a & 3u) * 8u)) & 0xffu;
}
__device__ __forceinline__ void p7_topk(Frame& F) {
    const int NT = T * PHEADS * 2;
    for (int g0 = (F.bid * NWAVES + F.wave) * 64; g0 < NT; g0 += F.G * NTHR) {
        const int g = g0 + F.lane; const float* sp = F.scores() + (size_t)g * 128;
        unsigned top[16];
#pragma unroll
        for (int grp = 0; grp < 8; ++grp) { unsigned k[16];
#pragma unroll
            for (int q = 0; q < 4; ++q) { const f32x4 v = *(const f32x4*)(sp + grp * 16 + q * 4);
#pragma unroll
                for (int e = 0; e < 4; ++e) { const int j = grp * 16 + q * 4 + e; k[q * 4 + e] = (f2key(v[e]) & ~0x7fu) | (unsigned)(127 - j); } }
            sort16(k);
            if (grp == 0) {
#pragma unroll
                for (int i = 0; i < 16; ++i) top[i] = k[i];
            } else merge16(top, k); }
        float vO[16], vP[16]; unsigned iOpk[4] = {0u, 0u, 0u, 0u}, iPpk[4] = {0u, 0u, 0u, 0u};
#pragma unroll
        for (int i = 0; i < 16; ++i) { const unsigned t = top[i], tp = dpp_swap1(t);
            vO[i] = key2f(t & ~0x7fu); vP[i] = key2f(tp & ~0x7fu);
            iOpk[i >> 2] |= (127u - (t & 0x7fu)) << ((i & 3) * 8); iPpk[i >> 2] |= (127u - (tp & 0x7fu)) << ((i & 3) * 8); }
        unsigned R[16], G1[16], G2[16], G3[16];
#define CAND(a, b) ((f2key(vO[a] + vP[b]) & ~0xffu) | (unsigned)(((a) << 4) | (b)))
#pragma unroll
        for (int i = 0; i < 16; ++i) R[i] = CAND(0, i);
        G1[0] = CAND(1, 0); G1[1] = CAND(1, 1); G1[2] = CAND(1, 2); G1[3] = CAND(1, 3); G1[4] = CAND(1, 4); G1[5] = CAND(1, 5); G1[6] = CAND(1, 6); G1[7] = CAND(1, 7);
        G1[8] = CAND(2, 0); G1[9] = CAND(2, 1); G1[10] = CAND(2, 2); G1[11] = CAND(2, 3); G1[12] = CAND(2, 4); G1[13] = CAND(3, 0); G1[14] = CAND(3, 1); G1[15] = CAND(3, 2);
        G2[0] = CAND(3, 3); G2[1] = CAND(4, 0); G2[2] = CAND(4, 1); G2[3] = CAND(4, 2); G2[4] = CAND(5, 0); G2[5] = CAND(5, 1); G2[6] = CAND(6, 0); G2[7] = CAND(6, 1);
        G2[8] = CAND(7, 0); G2[9] = CAND(7, 1); G2[10] = CAND(8, 0); G2[11] = CAND(9, 0); G2[12] = CAND(10, 0); G2[13] = CAND(11, 0); G2[14] = CAND(12, 0); G2[15] = CAND(13, 0);
        G3[0] = CAND(14, 0); G3[1] = CAND(15, 0);
#pragma unroll
        for (int i = 2; i < 16; ++i) G3[i] = 0u;
#undef CAND
        sort16(G1); sort16(G2); sort16(G3);
        merge16(R, G1); merge16(R, G2); merge16(R, G3);
        float sc[16], ex[16]; float sum = 0.f; unsigned eid[16];
        const bool tab0 = ((g & 1) == 0);
#pragma unroll
        for (int i = 0; i < 16; ++i) { sc[i] = key2f(R[i] & ~0xffu); const unsigned a = (R[i] >> 4) & 15u, bb = R[i] & 15u;
            const unsigned io = pick_byte(iOpk, a), ip = pick_byte(iPpk, bb);
            eid[i] = tab0 ? (io * 128u + ip) : (ip * 128u + io); }
#pragma unroll
        for (int i = 0; i < 16; ++i) { ex[i] = __expf(sc[i] - sc[0]); sum += ex[i]; }
        const float inv = 1.0f / sum;
        if (tab0) { const size_t o = (size_t)(g >> 1) * 16;
#pragma unroll
            for (int q = 0; q < 4; ++q) { v4u ev; ev.x = eid[4 * q]; ev.y = eid[4 * q + 1]; ev.z = eid[4 * q + 2]; ev.w = eid[4 * q + 3]; *(v4u*)(F.esel() + o + 4 * q) = ev;
                f32x4 wv; wv[0] = ex[4 * q] * inv; wv[1] = ex[4 * q + 1] * inv; wv[2] = ex[4 * q + 2] * inv; wv[3] = ex[4 * q + 3] * inv; *(f32x4*)(F.wsel() + o + 4 * q) = wv; } }
    }
}

__device__ __forceinline__ void unpack8(const v4u& u, float (&f)[8]) {
#pragma unroll
    for (int i = 0; i < 4; ++i) { f[2 * i] = bflo(u[i]); f[2 * i + 1] = bfhi(u[i]); }
}
__device__ __forceinline__ void p8_peer(Frame& F) {
    for (int t = F.bid * NWAVES + F.wave; t < T; t += F.G * NWAVES) {
        const int b = t >> 13; const float* mb = F.mod() + b * 6144; const int k0 = 8 * F.lane;
        float hn[16];
        { const f32x4* sq = (const f32x4*)(F.ssqp() + (size_t)t * 16); const f32x4 p0 = sq[0], p1 = sq[1], p2 = sq[2], p3 = sq[3];
          const float tot = (p0[0] + p0[1] + p0[2] + p0[3]) + (p1[0] + p1[1] + p1[2] + p1[3]) + (p2[0] + p2[1] + p2[2] + p2[3]) + (p3[0] + p3[1] + p3[2] + p3[3]);
          const float rstd = __builtin_amdgcn_rsqf(tot * (1.0f / D) + EPS);
          const v4u a0 = *(const v4u*)(F.hg() + (size_t)t * D + k0), a1 = *(const v4u*)(F.hg() + (size_t)t * D + 512 + k0);
          float f0[8], f1[8]; unpack8(a0, f0); unpack8(a1, f1);
#pragma unroll
          for (int i = 0; i < 8; ++i) { hn[i] = f0[i] * rstd + mb[3072 + k0 + i]; hn[8 + i] = f1[i] * rstd + mb[3072 + 512 + k0 + i]; } }
        const int e0 = F.esel()[(size_t)t * NSEL + F.lane], e1 = F.esel()[(size_t)t * NSEL + 64 + F.lane];
        const float w0 = F.wsel()[(size_t)t * NSEL + F.lane], w1 = F.wsel()[(size_t)t * NSEL + 64 + F.lane];
        float act0 = 0.f, act1 = 0.f;
        for (int j = 0; j < NSEL; j += 4) {
            float part[4];
#pragma unroll
            for (int q = 0; q < 4; ++q) { const int jj = j + q; const int e = __builtin_amdgcn_readlane(jj < 64 ? e0 : e1, jj & 63);
                const bf16* ur = F.Ub() + (size_t)e * D; const v4u u0 = *(const v4u*)(ur + k0), u1 = *(const v4u*)(ur + 512 + k0);
                float f0[8], f1[8]; unpack8(u0, f0); unpack8(u1, f1); float s = 0.f;
#pragma unroll
                for (int i = 0; i < 8; ++i) s += f0[i] * hn[i] + f1[i] * hn[8 + i];
                part[q] = s; }
#pragma unroll
            for (int q = 0; q < 4; ++q) { const float s = wave_sum(part[q]); const int jj = j + q; if (F.lane == (jj & 63)) { if (jj < 64) act0 = s; else act1 = s; } }
        }
        const float c0 = w0 * 0.5f * act0 * (1.0f + erff(act0 * 0.70710678f)), c1 = w1 * 0.5f * act1 * (1.0f + erff(act1 * 0.70710678f));
        float y[16];
#pragma unroll
        for (int i = 0; i < 16; ++i) y[i] = 0.f;
        for (int j = 0; j < NSEL; j += 4) {
#pragma unroll
            for (int q = 0; q < 4; ++q) { const int jj = j + q; const int e = __builtin_amdgcn_readlane(jj < 64 ? e0 : e1, jj & 63);
                const float cf = __builtin_bit_cast(float, __builtin_amdgcn_readlane(__builtin_bit_cast(int, jj < 64 ? c0 : c1), jj & 63));
                const bf16* vr = F.Vb() + (size_t)e * D; const v4u u0 = *(const v4u*)(vr + k0), u1 = *(const v4u*)(vr + 512 + k0);
                float f0[8], f1[8]; unpack8(u0, f0); unpack8(u1, f1);
#pragma unroll
                for (int i = 0; i < 8; ++i) { y[i] += cf * f0[i]; y[8 + i] += cf * f1[i]; } }
        }
        float* hrow = F.out() + (size_t)t * D; const float* fm = F.fmod() + b * 2048;
        float z[16]; float ss = 0.f;
#pragma unroll
        for (int half = 0; half < 2; ++half) { const int kk = half * 512 + k0;
            const f32x4 ha = *(const f32x4*)(hrow + kk), hb = *(const f32x4*)(hrow + kk + 4);
#pragma unroll
            for (int i = 0; i < 4; ++i) { z[half * 8 + i] = ha[i] + mb[5120 + kk + i] * y[half * 8 + i]; z[half * 8 + 4 + i] = hb[i] + mb[5120 + kk + 4 + i] * y[half * 8 + 4 + i]; } }
#pragma unroll
        for (int i = 0; i < 16; ++i) ss += z[i] * z[i];
        const float rstd = __builtin_amdgcn_rsqf(wave_sum(ss) * (1.0f / D) + EPS);
#pragma unroll
        for (int half = 0; half < 2; ++half) { const int kk = half * 512 + k0; f32x4 oa, ob;
#pragma unroll
            for (int i = 0; i < 4; ++i) { oa[i] = z[half * 8 + i] * rstd * F.fnorm_g()[kk + i] * (1.0f + fm[1024 + kk + i]) + fm[kk + i];
                ob[i] = z[half * 8 + 4 + i] * rstd * F.fnorm_g()[kk + 4 + i] * (1.0f + fm[1024 + kk + 4 + i]) + fm[kk + 4 + i]; }
            *(f32x4*)(hrow + kk) = oa; *(f32x4*)(hrow + kk + 4) = ob; }
    }
}

constexpr int NPHASE = 9;
__global__ void __launch_bounds__(NTHR, 2) fwd_kernel(Args args) {
    extern __shared__ __attribute__((aligned(16))) unsigned char lds_raw[];
    Frame F;
    F.lds = (LAS unsigned char*)lds_raw;
    F.tid = threadIdx.x; F.lane = F.tid & 63; F.wave = __builtin_amdgcn_readfirstlane(F.tid >> 6); F.G = gridDim.x; F.bid = blockIdx.x;
    unsigned char* ws = args.ws; F.a = &args;
    volatile LAS unsigned* misc = (volatile LAS unsigned*)(F.lds + MISC_OFF);
    if (F.tid < 64) misc[F.tid] = 0u;
    __syncthreads();
    const int lo = args.ph_lo, hi = args.ph_hi;
    const bool multi = (hi - lo) > 1;
    XcdBarrier bar; bar.bar = (unsigned*)(ws + WS_CTL) + CW_BAR; bar.x = 0; bar.st = nullptr;
    if (multi) bar = xcd_barrier_post((unsigned*)(ws + WS_CTL) + CW_BAR, misc + 8);
#ifndef PHMASK
#define PHMASK 0x1ff
#endif
#define IN(k) (((PHMASK >> (k)) & 1) && lo <= (k) && (k) < hi)
#define SEAM(k) do { if (IN(k) && IN((k) + 1)) xcd_barrier(bar); } while (0)

    if (IN(0)) { p0_prologue(F); } SEAM(0);
    if (IN(1)) { p1_norm(F); } SEAM(1);
    if (IN(2)) { pg8::Gemm g{F.bufA(), F.Win_t(), T, NIN, D}; pg8::StaticOrder S; S.init(T, NIN, F.G, F.bid);
        pg8::EpiBf16<0> E{F.proj(), NIN, nullptr, 0, 0, 1.f};
        pg8::gemm_phase<pg8::EpiBf16<0>, pg8::StaticOrder, true, true>(F.lds, g, S, E); } SEAM(2);
    if (IN(3)) {
        for (int it = F.bid; it < NB * NHH * 2 * NSEG; it += F.G) h1_item(F, it);
        float cw[CW];
#pragma unroll
        for (int j = 0; j < CW; ++j) cw[j] = F.conv_w()[j * DC + F.tid];
        const float cbias = F.conv_b()[F.tid];
        for (int it = F.bid; it < T / 32; it += F.G) conv_item(F, it, cw, cbias);
    } SEAM(3);
    if (IN(4)) { for (int it = F.bid; it < NB * NHH * NSEG; it += F.G) h2_item(F, it); } SEAM(4);
    if (IN(5)) { pg8::Gemm g{F.bufA(), F.Wout_t(), T, D, D}; pg8::StaticOrder S; S.init(T, D, F.G, F.bid);
        pg8::EpiOut E{F.x(), F.out(), F.hg(), F.mod(), F.g_ffn(), F.ssqp()};
        pg8::gemm_phase<pg8::EpiOut, pg8::StaticOrder, true, true>(F.lds, g, S, E); } SEAM(5);
    if (IN(6)) { pg8::Gemm g{F.hg(), F.Wqk_t(), T, NQK, D}; pg8::StaticOrder S; S.init(T, NQK, F.G, F.bid);
        pg8::EpiScore E{F.scores(), F.ssqp(), F.biasq()};
        pg8::gemm_phase<pg8::EpiScore, pg8::StaticOrder, true, true>(F.lds, g, S, E); } SEAM(6);
    if (IN(7)) { p7_topk(F); } SEAM(7);
    if (IN(8)) { p8_peer(F); }
#undef IN
#undef SEAM
}

#ifndef MK_ONE_LAUNCH
#define MK_ONE_LAUNCH 0
#endif
extern "C" void kernel_launch(void* const* d_in, const int* in_sizes, int n_in, void* d_out, int out_size, void* d_ws, size_t ws_size, hipStream_t stream) {
    static int grid = 0;
    if (grid == 0) {
        if (n_in != 23 || out_size != T * D || ws_size < WS_END) { fprintf(stderr, "kernel_launch: unexpected shapes (n_in %d, out %d, ws %zu)\n", n_in, out_size, ws_size); grid = -1; return; }
        int dev = 0, cus = 0, per_cu = 0;
        if (hipGetDevice(&dev) != hipSuccess || hipDeviceGetAttribute(&cus, hipDeviceAttributeMultiprocessorCount, dev) != hipSuccess) { grid = -1; return; }
        if (hipFuncSetAttribute((const void*)fwd_kernel, hipFuncAttributeMaxDynamicSharedMemorySize, LDS_BYTES) != hipSuccess) { fprintf(stderr, "kernel_launch: hipFuncSetAttribute failed\n"); grid = -1; return; }
        if (hipOccupancyMaxActiveBlocksPerMultiprocessor(&per_cu, (const void*)fwd_kernel, NTHR, LDS_BYTES) != hipSuccess || per_cu < 1) { fprintf(stderr, "kernel_launch: occupancy query reports %d\n", per_cu); }
        (void)hipGetLastError();
        grid = cus;
    }
    if (grid < 0) return;
    (void)hipMemsetAsync((char*)d_ws + WS_CTL, 0, CTL_ZERO_BYTES, stream);
    Args a{};
    for (int i = 0; i < 23; ++i) a.in[i] = (const float*)d_in[i];
    a.out = (float*)d_out; a.ws = (unsigned char*)d_ws;
#if MK_ONE_LAUNCH
    a.ph_lo = 0; a.ph_hi = NPHASE;
    hipLaunchKernelGGL(fwd_kernel, dim3(grid), dim3(NTHR), LDS_BYTES, stream, a);
#else
    for (int p = 0; p < NPHASE; ++p) { a.ph_lo = p; a.ph_hi = p + 1; hipLaunchKernelGGL(fwd_kernel, dim3(grid), dim3(NTHR), LDS_BYTES, stream, a); }
#endif
}
```

```cpp
#include <hip/hip_runtime.h>
#include <cstdio>
#include <cstdint>
namespace pg8 {
#define PG8_LAS __attribute__((address_space(3)))
typedef unsigned short bf16_t;
typedef short bf16x8 __attribute__((ext_vector_type(8)));
typedef float f32x4 __attribute__((ext_vector_type(4)));
typedef unsigned u32x4 __attribute__((ext_vector_type(4)));
constexpr int BM = 256, BK = 64, HALF = 128, HTB = HALF * BK * 2  , STAGE_BYTES = 8 * HTB, NXCD = 8, WGM = 8;

__host__ __device__ __forceinline__ int lds_byte(int r, int c) { const int st = (r >> 4) * 2 + (c >> 5), rr = r & 15, cc = c & 31, ob = rr * 64 + cc * 2; return st * 1024 + (ob ^ (((ob >> 9) & 1) << 5)); }
__host__ __device__ __forceinline__ void stage_rc(int b, int& R, int& C) { const int st = b / 1024, sb = b % 1024, swz = sb ^ (((sb >> 9) & 1) << 5); R = (st >> 1) * 16 + swz / 64; C = (st & 1) * 32 + (swz % 64) / 2; }
__host__ __device__ __forceinline__ int perm32(int rho) { const int n = rho >> 4, i = rho & 15; return 8 * (i >> 2) + 4 * n + (i & 3); }

struct Unit { int pm, pn; };
struct Gemm { const bf16_t* A; const bf16_t* Bt; int M, N, K; };

struct StaticOrder {
    int nM, nN, nwg, G, c;
    __host__ __device__ void init(int M, int N, int G_, int c_) { nM = M / BM; nN = N / BM; nwg = nM * nN; G = G_; c = c_; }
    __host__ __device__ bool next(int i, Unit& u) const {
        const long L = (long)i * G + c; if (L >= nwg) return false;
        int wgid = (int)L; { const int q = nwg / NXCD, r = nwg % NXCD, xcd = wgid % NXCD, off = wgid / NXCD; wgid = (xcd < r ? xcd * (q + 1) : r * (q + 1) + (xcd - r) * q) + off; }
        const int nig = WGM * nN, gid = wgid / nig, fm = gid * WGM, gsz = (nM - fm) < WGM ? (nM - fm) : WGM;
        u.pm = fm + ((wgid % nig) % gsz); u.pn = (wgid % nig) / gsz; return true;
    }
    __device__ __forceinline__ void a_ready(const Unit&) const {}
    __device__ __forceinline__ void done(const Unit&) const {}
};
__device__ __forceinline__ unsigned cvt_pk_bf16(float lo, float hi) { unsigned r; asm volatile("v_cvt_pk_bf16_f32 %0, %1, %2" : "=v"(r) : "v"(lo), "v"(hi)); return r; }
typedef float f32x2 __attribute__((ext_vector_type(2)));
__device__ __forceinline__ f32x2 gelu_pk(f32x2 v) {
    const f32x2 av = __builtin_elementwise_abs(v), d = av * 0.2316418882f + 1.0f;
    f32x2 t; t.x = __builtin_amdgcn_rcpf(d.x); t.y = __builtin_amdgcn_rcpf(d.y);
    f32x2 q = t * 0.5307027145f + (-0.7265760135f); q = q * t + 0.7107068705f; q = q * t + (-0.142248368f); q = q * t + 0.127414796f; q = q * t;
    const f32x2 s = (v * v) * (-0.72134752044f);
    f32x2 e; e.x = __builtin_amdgcn_exp2f(s.x); e.y = __builtin_amdgcn_exp2f(s.y);
    const f32x2 m = v * (q * e), r = v - m;
    f32x2 o; o.x = v.x < 0.f ? m.x : r.x; o.y = v.y < 0.f ? m.y : r.y; return o;
}

template <int ACT  > struct EpiBf16 {
    static constexpr bool PERM = true, AFTER_DRAIN = false; static_assert(ACT == 0 || ACT == 1, "EpiBf16: ACT is 0 (none) or 1 (gelu_pk)");
    bf16_t* O; int ldc; const float* bias; int split_cols; size_t split_stride; float scale0;
    __device__ __forceinline__ void operator()(const f32x4 (&acc)[2][2][4][2], const Unit& u, int wr, int wc, int fr, int fq) const {
        const int row0 = u.pm * BM + wr * 64 + fr; int colt = u.pn * BM; bf16_t* base = O;
        float sc = 1.f; if (split_cols) { const int t = colt / split_cols; base += (size_t)t * split_stride; colt -= t * split_cols; if (t == 0) sc = scale0; }
        const int col0 = colt + wc * 32 + 8 * fq, bcol0 = u.pn * BM + wc * 32 + 8 * fq;
        f32x4 bv[2][2];
#pragma unroll
        for (int bj = 0; bj < 2; ++bj)
#pragma unroll
            for (int n = 0; n < 2; ++n) bv[bj][n] = bias ? *(const f32x4*)(bias + bcol0 + bj * HALF + 4 * n) : (f32x4){0.f, 0.f, 0.f, 0.f};
#pragma unroll
        for (int ai = 0; ai < 2; ++ai)
#pragma unroll
            for (int m = 0; m < 4; ++m) { bf16_t* rowp = base + (size_t)(row0 + ai * HALF + m * 16) * ldc + col0;
#pragma unroll
                for (int bj = 0; bj < 2; ++bj) { f32x4 v0 = acc[ai][bj][m][0] + bv[bj][0], v1 = acc[ai][bj][m][1] + bv[bj][1];
                    if (ACT == 1) { f32x2 a = gelu_pk((f32x2){v0[0], v0[1]}), b = gelu_pk((f32x2){v0[2], v0[3]}), c = gelu_pk((f32x2){v1[0], v1[1]}), d = gelu_pk((f32x2){v1[2], v1[3]});
                        v0 = (f32x4){a.x, a.y, b.x, b.y}; v1 = (f32x4){c.x, c.y, d.x, d.y}; }
                    v0 = v0 * sc; v1 = v1 * sc; u32x4 w; w.x = cvt_pk_bf16(v0[0], v0[1]); w.y = cvt_pk_bf16(v0[2], v0[3]); w.z = cvt_pk_bf16(v1[0], v1[1]); w.w = cvt_pk_bf16(v1[2], v1[3]);
                    *(u32x4*)(rowp + bj * HALF) = w; } }
    }
};

struct EpiOut {
    static constexpr bool PERM = true, AFTER_DRAIN = false;
    const float* X; float* Hout; bf16_t* HG; const float* mod; const float* gffn; float* ssqp;
    __device__ __forceinline__ void operator()(const f32x4 (&acc)[2][2][4][2], const Unit& u, int wr, int wc, int fr, int fq) const {
        const int row0 = u.pm * BM + wr * 64 + fr, col0 = u.pn * BM + wc * 32 + 8 * fq;
        const int b = (u.pm * BM) >> 13;
        const float* mb = mod + b * 6144;
        f32x4 g1v[2][2], gv2[2][2];
#pragma unroll
        for (int bj = 0; bj < 2; ++bj)
#pragma unroll
            for (int n = 0; n < 2; ++n) { const int c = col0 + bj * HALF + 4 * n;
                g1v[bj][n] = *(const f32x4*)(mb + 2048 + c);
                const f32x4 s2 = *(const f32x4*)(mb + 4096 + c), gf = *(const f32x4*)(gffn + c);
                gv2[bj][n] = gf * (s2 + 1.0f); }
#pragma unroll
        for (int ai = 0; ai < 2; ++ai)
#pragma unroll
            for (int m = 0; m < 4; ++m) { const int row = row0 + ai * HALF + m * 16; const size_t ro = (size_t)row * 1024 + col0; float ss = 0.f;
#pragma unroll
                for (int bj = 0; bj < 2; ++bj) {
                    const f32x4 x0 = *(const f32x4*)(X + ro + bj * HALF), x1 = *(const f32x4*)(X + ro + bj * HALF + 4);
                    const f32x4 h0 = x0 + g1v[bj][0] * acc[ai][bj][m][0], h1 = x1 + g1v[bj][1] * acc[ai][bj][m][1];
                    *(f32x4*)(Hout + ro + bj * HALF) = h0; *(f32x4*)(Hout + ro + bj * HALF + 4) = h1;
                    ss += h0[0] * h0[0] + h0[1] * h0[1] + h0[2] * h0[2] + h0[3] * h0[3] + h1[0] * h1[0] + h1[1] * h1[1] + h1[2] * h1[2] + h1[3] * h1[3];
                    const f32x4 q0 = h0 * gv2[bj][0], q1 = h1 * gv2[bj][1];
                    u32x4 w; w.x = cvt_pk_bf16(q0[0], q0[1]); w.y = cvt_pk_bf16(q0[2], q0[3]); w.z = cvt_pk_bf16(q1[0], q1[1]); w.w = cvt_pk_bf16(q1[2], q1[3]);
                    *(u32x4*)(HG + ro + bj * HALF) = w; }
                ss += __shfl_xor(ss, 16); ss += __shfl_xor(ss, 32);
                if (fq == 0) ssqp[(size_t)row * 16 + u.pn * 4 + wc] = ss; }
    }
};
struct EpiScore {
    static constexpr bool PERM = false, AFTER_DRAIN = false;
    float* S; const float* ssqp; const float* biasq; float* rstd_out;
    __device__ __forceinline__ void operator()(const f32x4 (&acc)[2][2][4][2], const Unit& u, int wr, int wc, int fr, int fq) const {
        const int row0 = u.pm * BM + wr * 64 + fr, col0 = u.pn * BM + wc * 32 + 4 * fq;
        const int b = (u.pm * BM) >> 13;
        f32x4 bv[2][2];
#pragma unroll
        for (int bj = 0; bj < 2; ++bj)
#pragma unroll
            for (int n = 0; n < 2; ++n) bv[bj][n] = *(const f32x4*)(biasq + b * 2048 + col0 + bj * HALF + n * 16);
#pragma unroll
        for (int ai = 0; ai < 2; ++ai)
#pragma unroll
            for (int m = 0; m < 4; ++m) { const int row = row0 + ai * HALF + m * 16;
                const f32x4* sp = (const f32x4*)(ssqp + (size_t)row * 16);
                const f32x4 p0 = sp[0], p1 = sp[1], p2 = sp[2], p3 = sp[3];
                const float tot = (p0[0] + p0[1] + p0[2] + p0[3]) + (p1[0] + p1[1] + p1[2] + p1[3]) + (p2[0] + p2[1] + p2[2] + p2[3]) + (p3[0] + p3[1] + p3[2] + p3[3]);
                const float rstd = __builtin_amdgcn_rsqf(tot * (1.0f / 1024.0f) + 1e-6f);
                if (u.pn == 0 && wc == 0 && fq == 0) rstd_out[row] = rstd;
                float* rowp = S + (size_t)row * 2048 + col0;
#pragma unroll
                for (int bj = 0; bj < 2; ++bj)
#pragma unroll
                    for (int n = 0; n < 2; ++n) *(f32x4*)(rowp + bj * HALF + n * 16) = acc[ai][bj][m][n] * rstd + bv[bj][n]; }
    }
};
template <class Epi, class Sched, bool ALIGN_EPI = false, bool SP2 = false>
__device__ __forceinline__ void gemm_phase(PG8_LAS unsigned char* lds, const Gemm g, const Sched& S, const Epi& E) {
    const int tid = threadIdx.x, wid = __builtin_amdgcn_readfirstlane(tid >> 6), lane = tid & 63, wr = wid >> 2, wc = wid & 3, fr = lane & 15, fq = lane >> 4;
    const int K = g.K, nt = K / BK;
    unsigned voffA[2], voffB[2];
#pragma unroll
    for (int i = 0; i < 2; ++i) { int R, C; stage_rc(tid * 16 + i * 8192, R, C); const int Rb = Epi::PERM ? ((R & ~31) + perm32(R & 31)) : R;
        voffA[i] = (unsigned)(R * K + C) * 2u; voffB[i] = (unsigned)(Rb * K + C) * 2u; }
    const size_t kstep = (size_t)(BK * 2);
    const size_t hstep = (size_t)HALF * K * 2;
    const size_t tstep = 2 * hstep;
    const unsigned ldsw = (unsigned)wid * 1024u;
    const int aoff = lds_byte(wr * 64 + fr, fq * 8), boff = lds_byte(wc * 32 + fr, fq * 8);
#define PG8_SA(b, h) (((b) * 2 + (h)) * HTB)
#define PG8_SB(b, h) ((4 + (b) * 2 + (h)) * HTB)
#define PG8_STAGE(bufoff, gbase, voff) do { _Pragma("unroll") for (int _i = 0; _i < 2; ++_i) \
        __builtin_amdgcn_global_load_lds((const unsigned*)((const char*)(gbase) + (voff)[_i]), (PG8_LAS unsigned*)(lds + (bufoff) + ldsw + _i * 8192), 16, 0, 0); } while (0)
#define PG8_LDA(dst, b, h) do { _Pragma("unroll") for (int m = 0; m < 4; ++m) _Pragma("unroll") for (int k = 0; k < 2; ++k) dst[m][k] = *(const PG8_LAS bf16x8*)(lds + PG8_SA(b, h) + aoff + m * 2048 + k * 1024); } while (0)
#define PG8_LDB(dst, b, h) do { _Pragma("unroll") for (int n = 0; n < 2; ++n) _Pragma("unroll") for (int k = 0; k < 2; ++k) dst[n][k] = *(const PG8_LAS bf16x8*)(lds + PG8_SB(b, h) + boff + n * 2048 + k * 1024); } while (0)
#define PG8_MMA(ai, bj, At, Bt) do { __builtin_amdgcn_s_setprio(1); _Pragma("unroll") for (int m = 0; m < 4; ++m) _Pragma("unroll") for (int n = 0; n < 2; ++n) _Pragma("unroll") for (int k = 0; k < 2; ++k) \
        acc[ai][bj][m][n] = __builtin_amdgcn_mfma_f32_16x16x32_bf16(Bt[n][k], At[m][k], acc[ai][bj][m][n], 0, 0, 0); __builtin_amdgcn_s_setprio(0); } while (0)
#define PG8_WAIT_V(n) asm volatile("s_waitcnt vmcnt(" #n ")" ::: "memory")
#define PG8_WAIT_L(n) asm volatile("s_waitcnt lgkmcnt(" #n ")" ::: "memory")
#define PG8_BAR __builtin_amdgcn_s_barrier()
#define PG8_SCHED __builtin_amdgcn_sched_barrier(0)
    Unit cur, nxt; int ui = 0;
    if (!S.next(0, cur)) return;
    f32x4 acc[2][2][4][2];
#pragma unroll
    for (int a = 0; a < 2; ++a)
#pragma unroll
        for (int b = 0; b < 2; ++b)
#pragma unroll
            for (int m = 0; m < 4; ++m)
#pragma unroll
                for (int n = 0; n < 2; ++n) acc[a][b][m][n] = (f32x4){0.f, 0.f, 0.f, 0.f};
    bf16x8 At[4][2], B0[2][2], B1[2][2];
    const char* cA = (const char*)g.A + (size_t)cur.pm * tstep; const char* cB = (const char*)g.Bt + (size_t)cur.pn * tstep;
    S.a_ready(cur);
    if constexpr (SP2) {
        PG8_STAGE(PG8_SB(0, 0), cB, voffB); PG8_STAGE(PG8_SB(0, 1), cB + hstep, voffB); PG8_STAGE(PG8_SA(0, 0), cA, voffA); PG8_STAGE(PG8_SA(0, 1), cA + hstep, voffA);
        if (wr == 1) PG8_BAR;
        PG8_WAIT_V(2); PG8_BAR;
        PG8_STAGE(PG8_SB(1, 0), cB + kstep, voffB); PG8_STAGE(PG8_SA(1, 0), cA + kstep, voffA); PG8_STAGE(PG8_SB(1, 1), cB + hstep + kstep, voffB);
        PG8_WAIT_V(6); PG8_BAR;
    } else {
        PG8_STAGE(PG8_SB(0, 0), cB, voffB); PG8_STAGE(PG8_SA(0, 0), cA, voffA); PG8_STAGE(PG8_SB(0, 1), cB + hstep, voffB); PG8_STAGE(PG8_SA(0, 1), cA + hstep, voffA);
        if (wr == 1) PG8_BAR;
        PG8_WAIT_V(4); PG8_BAR;
        PG8_STAGE(PG8_SB(1, 0), cB + kstep, voffB); PG8_STAGE(PG8_SA(1, 0), cA + kstep, voffA); PG8_STAGE(PG8_SB(1, 1), cB + hstep + kstep, voffB);
        PG8_WAIT_V(6); PG8_BAR;
    }
    for (;;) {
        const bool has_next = S.next(ui + 1, nxt);
        const char* nA = has_next ? (const char*)g.A + (size_t)nxt.pm * tstep : cA; const char* nB = has_next ? (const char*)g.Bt + (size_t)nxt.pn * tstep : cB;
        for (int t = 0; t < nt; t += 2) {
            const bool last = (t == nt - 2);
            const char* a1 = cA + (size_t)(t + 1) * kstep;
            const char* a2 = last ? nA : cA + (size_t)(t + 2) * kstep; const char* b2 = last ? nB : cB + (size_t)(t + 2) * kstep;
            const char* a3 = a2 + kstep; const char* b3 = b2 + kstep;
            if (last && has_next) S.a_ready(nxt);
            if constexpr (SP2) {
            PG8_LDB(B0, 0, 0); PG8_LDB(B1, 0, 1); PG8_SCHED; PG8_LDA(At, 0, 0); PG8_STAGE(PG8_SA(1, 1), a1 + hstep, voffA);
            PG8_WAIT_V(8); PG8_WAIT_L(0); PG8_BAR; PG8_MMA(0, 0, At, B0); PG8_MMA(0, 1, At, B1); PG8_BAR; PG8_SCHED;
            PG8_LDA(At, 0, 1); PG8_STAGE(PG8_SB(0, 0), b2, voffB); PG8_STAGE(PG8_SB(0, 1), b2 + hstep, voffB); PG8_STAGE(PG8_SA(0, 0), a2, voffA);
            PG8_WAIT_V(8); PG8_WAIT_L(0); PG8_BAR; PG8_MMA(1, 0, At, B0); PG8_MMA(1, 1, At, B1); PG8_BAR; PG8_SCHED;
            PG8_LDB(B0, 1, 0); PG8_LDB(B1, 1, 1); PG8_SCHED; PG8_LDA(At, 1, 0); PG8_STAGE(PG8_SA(0, 1), a2 + hstep, voffA);
            PG8_WAIT_V(8); PG8_WAIT_L(0); PG8_BAR; PG8_MMA(0, 0, At, B0); PG8_MMA(0, 1, At, B1); PG8_BAR; PG8_SCHED;
            PG8_LDA(At, 1, 1); PG8_STAGE(PG8_SB(1, 0), b3, voffB); PG8_STAGE(PG8_SB(1, 1), b3 + hstep, voffB); PG8_STAGE(PG8_SA(1, 0), a3, voffA);
            PG8_WAIT_V(8); PG8_WAIT_L(0); PG8_BAR; PG8_MMA(1, 0, At, B0); PG8_MMA(1, 1, At, B1); PG8_BAR; PG8_SCHED;
            } else {
            PG8_LDB(B0, 0, 0); PG8_SCHED; PG8_LDA(At, 0, 0); PG8_STAGE(PG8_SA(1, 1), a1 + hstep, voffA);
            PG8_WAIT_L(8); PG8_BAR; PG8_WAIT_L(0); PG8_MMA(0, 0, At, B0); PG8_BAR; PG8_SCHED;
            PG8_LDB(B1, 0, 1); PG8_STAGE(PG8_SB(0, 0), b2, voffB);
            PG8_BAR; PG8_WAIT_L(0); PG8_MMA(0, 1, At, B1); PG8_BAR;
            PG8_LDA(At, 0, 1); PG8_STAGE(PG8_SA(0, 0), a2, voffA);
            PG8_BAR; PG8_WAIT_L(0); PG8_MMA(1, 0, At, B0); PG8_BAR; PG8_SCHED;
            PG8_STAGE(PG8_SB(0, 1), b2 + hstep, voffB);
            PG8_WAIT_V(6); PG8_BAR; PG8_MMA(1, 1, At, B1); PG8_BAR;
            PG8_LDB(B0, 1, 0); PG8_SCHED; PG8_LDA(At, 1, 0); PG8_STAGE(PG8_SA(0, 1), a2 + hstep, voffA);
            PG8_WAIT_L(8); PG8_BAR; PG8_WAIT_L(0); PG8_MMA(0, 0, At, B0); PG8_BAR; PG8_SCHED;
            PG8_LDB(B1, 1, 1); PG8_STAGE(PG8_SB(1, 0), b3, voffB);
            PG8_BAR; PG8_WAIT_L(0); PG8_MMA(0, 1, At, B1); PG8_BAR;
            PG8_LDA(At, 1, 1); PG8_STAGE(PG8_SA(1, 0), a3, voffA);
            PG8_BAR; PG8_WAIT_L(0); PG8_MMA(1, 0, At, B0); PG8_BAR; PG8_SCHED;
            PG8_STAGE(PG8_SB(1, 1), b3 + hstep, voffB);
            PG8_WAIT_V(6); PG8_BAR; PG8_MMA(1, 1, At, B1); PG8_BAR;
            }
        }
        if constexpr (ALIGN_EPI) { if (wr == 0) PG8_BAR; }
        if constexpr (!Epi::AFTER_DRAIN) { E(acc, cur, wr, wc, fr, fq); S.done(cur); }
        if (!has_next) break;
#pragma unroll
        for (int a = 0; a < 2; ++a)
#pragma unroll
            for (int b = 0; b < 2; ++b)
#pragma unroll
                for (int m = 0; m < 4; ++m)
#pragma unroll
                    for (int n = 0; n < 2; ++n) acc[a][b][m][n] = (f32x4){0.f, 0.f, 0.f, 0.f};
        cur = nxt; cA = nA; cB = nB; ++ui;
        if constexpr (ALIGN_EPI) { if (wr == 1) PG8_BAR; }
    }
    PG8_WAIT_V(0);
    if constexpr (!ALIGN_EPI) { if (wr == 0) PG8_BAR; }
    PG8_BAR;
    if constexpr (Epi::AFTER_DRAIN) { E.fused(acc, cur, wr, wc, fr, fq, lds, wid, lane); S.done(cur); }
#undef PG8_SA
#undef PG8_SB
#undef PG8_STAGE
#undef PG8_LDA
#undef PG8_LDB
#undef PG8_MMA
#undef PG8_WAIT_V
#undef PG8_WAIT_L
#undef PG8_BAR
#undef PG8_SCHED
}
}
#define MK_ONE_LAUNCH 1

constexpr int NB = 4, SEQ = 8192, T = NB * SEQ, D = 1024;
constexpr int NIN = 3584, DH = 512, HD = 128, NHH = 4, CHK = 64;
constexpr int NSEG = 16, SEGC = 8;
constexpr int CW = 31, CPAD = 15, DC = 512;
constexpr int PHEADS = 8, NQK = 2048, NSEL = 128;
constexpr float EPS = 1e-6f;
constexpr int NWAVES = 8, NTHR = 512;

constexpr size_t MiB = 1u << 20;
constexpr size_t WS_CTL = 0, CTL_ZERO_BYTES = 65536;
constexpr size_t WS_MOD = 1 * MiB, WS_FMOD = WS_MOD + 131072, WS_LB = WS_MOD + 196608, WS_BIASQ = WS_MOD + 262144;
constexpr size_t WS_WIN = 2 * MiB, WS_WOUT = 10 * MiB, WS_WQK = 12 * MiB;
constexpr size_t WS_UT = 16 * MiB, WS_VT = 48 * MiB;
constexpr size_t WS_BUFA = 80 * MiB;
constexpr size_t WS_BUFB = 144 * MiB;
constexpr size_t WS_SEG = 208 * MiB;
constexpr size_t WS_E = 208 * MiB, WS_W = 224 * MiB;
constexpr size_t WS_BIG = 240 * MiB;
constexpr size_t WS_SSQ = 496 * MiB;
constexpr size_t WS_SEGA = 498 * MiB;
constexpr size_t WS_RSTD = 499 * MiB;
constexpr size_t WS_END = 500 * MiB;
constexpr size_t WS_PACT = 240 * MiB;
constexpr size_t WS_Y = 368 * MiB;
constexpr int NSL = 8, CSL = 128;
constexpr float USCALE = 64.0f, VSCALE = 16.0f;
constexpr int CW_QU = 8192, CW_QV = 8192 + 64 * 16;
constexpr int CW_BAR = 1024;

constexpr int LDS_BYTES = 155648;
constexpr int MISC_OFF = LDS_BYTES - 256;

#define GAS __attribute__((address_space(1)))
#define LAS __attribute__((address_space(3)))
typedef unsigned short bf16;
typedef unsigned v4u __attribute__((ext_vector_type(4)));
typedef unsigned v2u __attribute__((ext_vector_type(2)));
typedef float f32x4 __attribute__((ext_vector_type(4)));
typedef float f32x16 __attribute__((ext_vector_type(16)));
typedef short bf16x8 __attribute__((ext_vector_type(8)));
typedef float f32x2_ __attribute__((ext_vector_type(2)));

__device__ __forceinline__ float bf2f(unsigned h) { return __builtin_bit_cast(float, h << 16); }
__device__ __forceinline__ float bflo(unsigned u) { return __builtin_bit_cast(float, u << 16); }
__device__ __forceinline__ float bfhi(unsigned u) { return __builtin_bit_cast(float, u & 0xffff0000u); }
__device__ __forceinline__ unsigned f2bf(float f) { unsigned u = __builtin_bit_cast(unsigned, f); return (u + 0x7fffu + ((u >> 16) & 1u)) >> 16; }
__device__ __forceinline__ unsigned pk2(float lo, float hi) { return f2bf(lo) | (f2bf(hi) << 16); }
__device__ __forceinline__ float sigmoidf_(float x) { return __builtin_amdgcn_rcpf(1.0f + __expf(-x)); }
__device__ __forceinline__ float wave_sum(float v) {
#pragma unroll
    for (int o = 1; o < 64; o <<= 1) v += __shfl_xor(v, o);
    return v;
}

#define XB_TMO      128
#define XB_XCNT(j)  (256  + 64 * (j))
#define XB_XSUB(j)  (1280 + 64 * (j))
#define XB_XGEN(j)  (2304 + 64 * (j))
#define XB_TOP      3328
#define XB_TOPGEN   3392
#define XCD_BAR_WORDS 3456
#define XB_SPIN_CAP (1u << 18)
__device__ __forceinline__ unsigned xb_ld(unsigned* p)              { return __hip_atomic_load(p, __ATOMIC_RELAXED, __HIP_MEMORY_SCOPE_AGENT); }
__device__ __forceinline__ unsigned xb_add(unsigned* p, unsigned v) { return __hip_atomic_fetch_add(p, v, __ATOMIC_RELAXED, __HIP_MEMORY_SCOPE_AGENT); }
__device__ __forceinline__ unsigned xb_xcc_id() { return (unsigned)__builtin_amdgcn_s_getreg((3 << 11) | 20) & 0xFu; }
#define XB_SPIN(cond, bar) do { unsigned _sp = 0; while (cond) { __builtin_amdgcn_s_sleep(1); \
    if ((++_sp & 255u) == 0u) { if (xb_ld(&(bar)[XB_TMO])) break; if (_sp > XB_SPIN_CAP) { atomicAdd(&(bar)[XB_TMO], 1u); break; } } } } while (0)
struct XcdBarrier { unsigned* bar; unsigned x; volatile LAS unsigned* st; };
__device__ __forceinline__ XcdBarrier xcd_barrier_post(unsigned* bar, volatile LAS unsigned* st) {
    XcdBarrier b; b.bar = bar; b.x = xb_xcc_id(); b.st = st;
    if (threadIdx.x == 0) (void)xb_add(&bar[XB_XCNT(b.x)], 1u);
    return b;
}
__device__ __forceinline__ void xcd_barrier_complete(unsigned* bar, unsigned x, unsigned& nloc, unsigned& nx) {
    const unsigned G = gridDim.x * gridDim.y * gridDim.z;
    unsigned sum, cnt, mine, sp = 0u;
    for (;;) {
        sum = 0u; cnt = 0u; mine = 0u;
#pragma unroll
        for (unsigned j = 0; j < 16; ++j) { const unsigned c = xb_ld(&bar[XB_XCNT(j)]); sum += c; cnt += (c > 0u) ? 1u : 0u; mine = (j == x) ? c : mine; }
        if (sum == G) break;
        __builtin_amdgcn_s_sleep(1);
        if ((++sp & 255u) == 0u) { if (xb_ld(&bar[XB_TMO])) break; if (sp > XB_SPIN_CAP) { atomicAdd(&bar[XB_TMO], 1u); break; } }
    }
    nloc = mine > 0u ? mine : 1u; nx = cnt > 0u ? cnt : 1u;
}
__device__ __forceinline__ void xcd_barrier(const XcdBarrier& b) {
    asm volatile("s_waitcnt vmcnt(0)" ::: "memory");
    __syncthreads();
    if (threadIdx.x == 0) {
        unsigned* bar = b.bar;
        __builtin_amdgcn_s_waitcnt(0);
        unsigned nloc = b.st[0], nx = b.st[1];
        if (nloc == 0u) { xcd_barrier_complete(bar, b.x, nloc, nx); b.st[0] = nloc; b.st[1] = nx; }
        const unsigned old = xb_add(&bar[XB_XSUB(b.x)], 1u);
        const unsigned gen = old / nloc;
        if (old + 1u == (gen + 1u) * nloc) {
            __builtin_amdgcn_fence(__ATOMIC_RELEASE, "agent");
            asm volatile("s_waitcnt vmcnt(0)" ::: "memory");
            const unsigned og = xb_add(&bar[XB_TOP], 1u);
            const unsigned tg = og / nx;
            if (og + 1u == (tg + 1u) * nx) xb_add(&bar[XB_TOPGEN], 1u);
            else XB_SPIN(xb_ld(&bar[XB_TOPGEN]) == tg, bar);
            __builtin_amdgcn_fence(__ATOMIC_ACQUIRE, "agent");
            xb_add(&bar[XB_XGEN(b.x)], 1u);
            asm volatile("s_waitcnt vmcnt(0)" ::: "memory");
        } else {
            XB_SPIN(xb_ld(&bar[XB_XGEN(b.x)]) == gen, bar);
            __builtin_amdgcn_fence(__ATOMIC_ACQUIRE, "agent");
            asm volatile("s_waitcnt vmcnt(0)" ::: "memory");
        }
    }
    __syncthreads();
}

struct Args { const float* in[23]; float* out; unsigned char* ws; int ph_lo, ph_hi; };
struct Frame {
    LAS unsigned char* lds;
    int tid, lane, wave, G, bid;
    const Args* a;
    __device__ __forceinline__ const float* x() const { return a->in[0]; }
    __device__ __forceinline__ const float* c() const { return a->in[1]; }
    __device__ __forceinline__ const float* ada_w() const { return a->in[2]; }
    __device__ __forceinline__ const float* ada_b() const { return a->in[3]; }
    __device__ __forceinline__ const float* g_mix() const { return a->in[4]; }
    __device__ __forceinline__ const float* w_in() const { return a->in[5]; }
    __device__ __forceinline__ const float* lbg_f() const { return a->in[6]; }
    __device__ __forceinline__ const float* lbg_b() const { return a->in[7]; }
    __device__ __forceinline__ const float* hnorm_g() const { return a->in[8]; }
    __device__ __forceinline__ const float* conv_w() const { return a->in[9]; }
    __device__ __forceinline__ const float* conv_b() const { return a->in[10]; }
    __device__ __forceinline__ const float* cln_g() const { return a->in[11]; }
    __device__ __forceinline__ const float* cln_b() const { return a->in[12]; }
    __device__ __forceinline__ const float* w_out() const { return a->in[13]; }
    __device__ __forceinline__ const float* g_ffn() const { return a->in[14]; }
    __device__ __forceinline__ const float* wq() const { return a->in[15]; }
    __device__ __forceinline__ const float* keys1() const { return a->in[16]; }
    __device__ __forceinline__ const float* keys2() const { return a->in[17]; }
    __device__ __forceinline__ const float* utab() const { return a->in[18]; }
    __device__ __forceinline__ const float* vtab() const { return a->in[19]; }
    __device__ __forceinline__ const float* fada_w() const { return a->in[20]; }
    __device__ __forceinline__ const float* fada_b() const { return a->in[21]; }
    __device__ __forceinline__ const float* fnorm_g() const { return a->in[22]; }
    __device__ __forceinline__ float* out() const { return a->out; }
    __device__ __forceinline__ float* mod() const { return (float*)(a->ws + WS_MOD); }
    __device__ __forceinline__ float* fmod() const { return (float*)(a->ws + WS_FMOD); }
    __device__ __forceinline__ float* lb() const { return (float*)(a->ws + WS_LB); }
    __device__ __forceinline__ float* biasq() const { return (float*)(a->ws + WS_BIASQ); }
    __device__ __forceinline__ float* ssqp() const { return (float*)(a->ws + WS_SSQ); }
    __device__ __forceinline__ float* sega() const { return (float*)(a->ws + WS_SEGA); }
    __device__ __forceinline__ float* segu() const { return (float*)(a->ws + WS_SEG); }
    __device__ __forceinline__ float* of() const { return (float*)(a->ws + WS_BUFB); }
    __device__ __forceinline__ float* scores() const { return (float*)(a->ws + WS_BIG); }
    __device__ __forceinline__ float* wsel() const { return (float*)(a->ws + WS_W); }
    __device__ __forceinline__ int* esel() const { return (int*)(a->ws + WS_E); }
    __device__ __forceinline__ bf16* Win_t() const { return (bf16*)(a->ws + WS_WIN); }
    __device__ __forceinline__ bf16* Wout_t() const { return (bf16*)(a->ws + WS_WOUT); }
    __device__ __forceinline__ bf16* Wqk_t() const { return (bf16*)(a->ws + WS_WQK); }
    __device__ __forceinline__ bf16* Ub() const { return (bf16*)(a->ws + WS_UT); }
    __device__ __forceinline__ bf16* Vb() const { return (bf16*)(a->ws + WS_VT); }
    __device__ __forceinline__ bf16* bufA() const { return (bf16*)(a->ws + WS_BUFA); }
    __device__ __forceinline__ bf16* hg() const { return (bf16*)(a->ws + WS_BUFB); }
    __device__ __forceinline__ bf16* proj() const { return (bf16*)(a->ws + WS_BIG); }
    __device__ __forceinline__ float* rstd() const { return (float*)(a->ws + WS_RSTD); }
    __device__ __forceinline__ float* pact() const { return (float*)(a->ws + WS_PACT); }
    __device__ __forceinline__ float* ybuf() const { return (float*)(a->ws + WS_Y); }
    __device__ __forceinline__ unsigned char* U8() const { return (unsigned char*)(a->ws + WS_UT); }
    __device__ __forceinline__ unsigned char* V8() const { return (unsigned char*)(a->ws + WS_VT); }
    __device__ __forceinline__ unsigned* ctl() const { return (unsigned*)(a->ws + WS_CTL); }
};

__device__ __forceinline__ void p0_gemv(Frame& F) {
    LAS float* cact = (LAS float*)(F.lds);
    LAS float* red = (LAS float*)(F.lds + 16384);
    for (int i = F.tid; i < 4096; i += NTHR) { const float c = F.c()[i]; cact[i] = c * sigmoidf_(c); }
    __syncthreads();
    for (int item = F.bid; item < 128; item += F.G) {
        const int col0 = item * 64; const float* W; int N, cc;
        if (col0 < 6144) { W = F.ada_w(); N = 6144; cc = col0; } else { W = F.fada_w(); N = 2048; cc = col0 - 6144; }
        const float* wp = W + (size_t)(F.wave * 128) * N + cc + F.lane;
        float a0 = 0.f, a1 = 0.f, a2 = 0.f, a3 = 0.f;
#pragma unroll 8
        for (int k = 0; k < 128; ++k) { const float w = wp[(size_t)k * N]; const int kk = F.wave * 128 + k;
            a0 += cact[kk] * w; a1 += cact[1024 + kk] * w; a2 += cact[2048 + kk] * w; a3 += cact[3072 + kk] * w; }
        red[(F.wave * 4 + 0) * 64 + F.lane] = a0; red[(F.wave * 4 + 1) * 64 + F.lane] = a1; red[(F.wave * 4 + 2) * 64 + F.lane] = a2; red[(F.wave * 4 + 3) * 64 + F.lane] = a3;
        __syncthreads();
        if (F.tid < 256) { const int b = F.tid >> 6, l = F.tid & 63; float s = 0.f;
#pragma unroll
            for (int w = 0; w < 8; ++w) s += red[(w * 4 + b) * 64 + l];
            if (col0 < 6144) F.mod()[b * 6144 + cc + l] = s + F.ada_b()[cc + l]; else F.fmod()[b * 2048 + cc + l] = s + F.fada_b()[cc + l]; }
        __syncthreads();
    }
}
__device__ __forceinline__ void p0_transpose_item(const float* W, int K, int N, bf16* WT, LAS float* scr, int item, int lane) {
    const int nblk = N / 32, kb = item / nblk, nb = item % nblk, k0 = 64 * kb, n0 = 32 * nb;
#pragma unroll 8
    for (int i = 0; i < 32; ++i) { const int kk = 2 * i + (lane >> 5); scr[kk * 33 + (lane & 31)] = W[(size_t)(k0 + kk) * N + n0 + (lane & 31)]; }
    asm volatile("s_waitcnt lgkmcnt(0)" ::: "memory");
    const int c = lane & 7;
#pragma unroll
    for (int j = 0; j < 4; ++j) { const int n = (lane >> 3) + 8 * j; const LAS float* s = scr + (8 * c) * 33 + n;
        v4u o; o.x = pk2(s[0 * 33], s[1 * 33]); o.y = pk2(s[2 * 33], s[3 * 33]); o.z = pk2(s[4 * 33], s[5 * 33]); o.w = pk2(s[6 * 33], s[7 * 33]);
        *(v4u*)(WT + (size_t)(n0 + n) * K + k0 + 8 * c) = o; }
    asm volatile("s_waitcnt lgkmcnt(0)" ::: "memory");
}
__device__ __forceinline__ void p0_wqk_item(Frame& F, int item) {
    const int jh = item & 1, kb = (item >> 1) & 15, hh = item >> 5, h = hh >> 1, half = hh & 1;
    const float* keys = (half ? F.keys2() : F.keys1()) + (size_t)(jh * 64) * 128;
    const int k = kb * 64 + F.lane;
    const float* wrow = F.wq() + (size_t)k * 2048 + h * 256 + half * 128;
    float acc[64];
#pragma unroll
    for (int j = 0; j < 64; ++j) acc[j] = 0.f;
    for (int d = 0; d < 128; d += 4) {
        const f32x4 a = *(const f32x4*)(wrow + d);
#pragma unroll
        for (int j = 0; j < 64; ++j) { const float* kp = keys + j * 128 + d; acc[j] += a[0] * kp[0] + a[1] * kp[1] + a[2] * kp[2] + a[3] * kp[3]; }
    }
    bf16* o = F.Wqk_t() + (size_t)(h * 256 + half * 128 + jh * 64) * 1024 + k;
#pragma unroll
    for (int j = 0; j < 64; ++j) o[(size_t)j * 1024] = (bf16)f2bf(acc[j]);
}
__device__ __forceinline__ void p0_prologue(Frame& F) {
    if (F.bid < 128) p0_gemv(F);
    if (F.bid == 128 % F.G) { const int i = F.tid;
        F.lb()[i] = __builtin_amdgcn_rcpf(1.0f + __expf(F.lbg_f()[512 + i] - F.lbg_f()[i]));
        F.lb()[512 + i] = __builtin_amdgcn_rcpf(1.0f + __expf(F.lbg_b()[512 + i] - F.lbg_b()[i])); }
    LAS float* scr = (LAS float*)(F.lds + 32768 + F.wave * 8704);
    const int gw = F.wave * F.G + F.bid, NGW = F.G * NWAVES;
    constexpr int I_QK = 512, I_IN = (D / 64) * (NIN / 32), I_OUT = (D / 64) * (D / 32), I_TAB = 2 * 16384 / 4;
    constexpr int NITEMS = I_QK + I_IN + I_OUT + I_TAB;
    for (int it = gw; it < NITEMS; it += NGW) {
        int r = it;
        if (r < I_QK) { p0_wqk_item(F, r); continue; } r -= I_QK;
        if (r < I_IN) { p0_transpose_item(F.w_in(), D, NIN, F.Win_t(), scr, r, F.lane); continue; } r -= I_IN;
        if (r < I_OUT) { p0_transpose_item(F.w_out(), D, D, F.Wout_t(), scr, r, F.lane); continue; } r -= I_OUT;
        { const int tab = r >= 4096, rr = (tab ? r - 4096 : r) * 4; const float* src = (tab ? F.vtab() : F.utab()) + (size_t)rr * 1024; unsigned char* dst = tab ? F.V8() : F.U8();
          const float sc = tab ? VSCALE : USCALE;
#pragma unroll
          for (int q = 0; q < 16; ++q) { const int row = rr + (q >> 2), qq = q & 3; const f32x4 v = *(const f32x4*)(src + (q >> 2) * 1024 + qq * 256 + 4 * F.lane) * sc;
              int pk = __builtin_amdgcn_cvt_pk_fp8_f32(v[0], v[1], 0, false); pk = __builtin_amdgcn_cvt_pk_fp8_f32(v[2], v[3], pk, true);
              const int sl = 2 * qq + (F.lane >> 5);
              *(int*)(dst + ((size_t)sl * 16384 + row) * CSL + 4 * (F.lane & 31)) = pk; } }
    }
}

__device__ __forceinline__ void p1_norm(Frame& F) {
    const int gwc = F.bid * NWAVES + F.wave, NGW = F.G * NWAVES;
    for (int row0 = gwc * 16; row0 < T; row0 += NGW * 16) {
        const int b = row0 >> 13; const float* mb = F.mod() + b * 6144;
        f32x4 ca[4], cb[4];
#pragma unroll
        for (int j = 0; j < 4; ++j) { const int k = 256 * j + 4 * F.lane; const f32x4 g = *(const f32x4*)(F.g_mix() + k), s = *(const f32x4*)(mb + 1024 + k); ca[j] = g * (s + 1.0f); cb[j] = *(const f32x4*)(mb + k); }
        for (int r = 0; r < 16; ++r) { const float* xr = F.x() + (size_t)(row0 + r) * D;
            f32x4 v[4]; float ss = 0.f;
#pragma unroll
            for (int j = 0; j < 4; ++j) { v[j] = *(const f32x4*)(xr + 256 * j + 4 * F.lane); ss += v[j][0] * v[j][0] + v[j][1] * v[j][1] + v[j][2] * v[j][2] + v[j][3] * v[j][3]; }
            const float rstd = __builtin_amdgcn_rsqf(wave_sum(ss) * (1.0f / D) + EPS);
            bf16* o = F.bufA() + (size_t)(row0 + r) * D;
#pragma unroll
            for (int j = 0; j < 4; ++j) { const f32x4 y = v[j] * rstd * ca[j] + cb[j]; v2u w; w.x = pk2(y[0], y[1]); w.y = pk2(y[2], y[3]); *(v2u*)(o + 256 * j + 4 * F.lane) = w; } }
    }
    const int gw = F.wave * F.G + F.bid;
    for (int n = gw; n < NQK; n += NGW) {
        const v4u w0 = *(const v4u*)(F.Wqk_t() + (size_t)n * 1024 + 8 * F.lane), w1 = *(const v4u*)(F.Wqk_t() + (size_t)n * 1024 + 512 + 8 * F.lane);
        float wv[16];
#pragma unroll
        for (int i = 0; i < 4; ++i) { wv[2 * i] = bflo(w0[i]); wv[2 * i + 1] = bfhi(w0[i]); wv[8 + 2 * i] = bflo(w1[i]); wv[8 + 2 * i + 1] = bfhi(w1[i]); }
#pragma unroll
        for (int b = 0; b < 4; ++b) { const float* sh2 = F.mod() + b * 6144 + 3072; float s = 0.f;
#pragma unroll
            for (int i = 0; i < 8; ++i) s += wv[i] * sh2[8 * F.lane + i] + wv[8 + i] * sh2[512 + 8 * F.lane + i];
            s = wave_sum(s); if (F.lane == 0) F.biasq()[b * 2048 + n] = s; }
    }
}

__device__ __forceinline__ void conv_item(Frame& F, int item, const float (&cw)[CW], float cbias) {
    LAS bf16* hbuf = (LAS bf16*)(F.lds);
    LAS float* ybuf = (LAS float*)(F.lds + 65536);
    const int tok0 = item * 32, b = tok0 >> 13, t0 = tok0 & (SEQ - 1), c = F.tid;
    for (int r = 0; r < 62; ++r) { const int t = t0 - CPAD + r; float h = 0.f;
        if (t >= 0 && t < SEQ) { const bf16* pr = F.proj() + (size_t)(b * SEQ + t) * NIN; const float a = bf2f(pr[2560 + c]), g = bf2f(pr[3072 + c]); h = a * sigmoidf_(g); }
        hbuf[r * 512 + c] = (bf16)f2bf(h); }
    __syncthreads();
    float hv[62];
#pragma unroll
    for (int r = 0; r < 62; ++r) hv[r] = bf2f(hbuf[r * 512 + c]);
#pragma unroll
    for (int tt = 0; tt < 32; ++tt) { float acc = cbias;
#pragma unroll
        for (int j = 0; j < CW; ++j) acc += cw[j] * hv[tt + j];
        ybuf[tt * 512 + c] = acc; }
    __syncthreads();
#pragma unroll
    for (int q = 0; q < 4; ++q) { const int tt = F.wave * 4 + q;
        const f32x4 y0 = *(LAS const f32x4*)(ybuf + tt * 512 + 4 * F.lane), y1 = *(LAS const f32x4*)(ybuf + tt * 512 + 256 + 4 * F.lane);
        const float mean = wave_sum((y0[0] + y0[1] + y0[2] + y0[3]) + (y1[0] + y1[1] + y1[2] + y1[3])) * (1.0f / DC);
        const f32x4 d0 = y0 - mean, d1 = y1 - mean;
        const float var = wave_sum((d0[0] * d0[0] + d0[1] * d0[1] + d0[2] * d0[2] + d0[3] * d0[3]) + (d1[0] * d1[0] + d1[1] * d1[1] + d1[2] * d1[2] + d1[3] * d1[3])) * (1.0f / DC);
        const float rstd = __builtin_amdgcn_rsqf(var + EPS);
        const f32x4 g0 = *(const f32x4*)(F.cln_g() + 4 * F.lane), g1 = *(const f32x4*)(F.cln_g() + 256 + 4 * F.lane), b0 = *(const f32x4*)(F.cln_b() + 4 * F.lane), b1 = *(const f32x4*)(F.cln_b() + 256 + 4 * F.lane);
        f32x4 z0 = d0 * rstd * g0 + b0, z1 = d1 * rstd * g1 + b1;
#pragma unroll
        for (int i = 0; i < 4; ++i) { z0[i] = z0[i] * sigmoidf_(z0[i]); z1[i] = z1[i] * sigmoidf_(z1[i]); }
        bf16* o = F.bufA() + (size_t)(tok0 + tt) * D + 512;
        v2u w0, w1; w0.x = pk2(z0[0], z0[1]); w0.y = pk2(z0[2], z0[3]); w1.x = pk2(z1[0], z1[1]); w1.y = pk2(z1[2], z1[3]);
        *(v2u*)(o + 4 * F.lane) = w0; *(v2u*)(o + 256 + 4 * F.lane) = w1; }
    __syncthreads();
}

constexpr int PQ = 272, PT = 144;
constexpr int HL_QR = 0, HL_KR = 17408, HL_QE = 34816, HL_KET = 52224, HL_VT = 70656, HL_SCM = 89088, HL_ST = 98304, HL_PBLK = 133120, HL_AV = 135168, HL_RS = 135680;
__device__ __forceinline__ bf16x8 ldf(LAS const unsigned char* base, int row, int pitch, int kbyte) { return *(LAS const bf16x8*)(base + row * pitch + kbyte); }
#define MFMA32(a, b, c) __builtin_amdgcn_mfma_f32_32x32x16_bf16((a), (b), (c), 0, 0, 0)

template <bool FULL, int MODE>
__device__ __forceinline__ void hgrn_chunk(Frame& F, int b, int h, int dir, int chunk, f32x16 (&accS)[2], float lbv) {
    LAS unsigned char* lds = F.lds;
    const int w = F.wave, r = F.lane & 31, hh = F.lane >> 5;
    const int col = (w & 1) * 64 + F.lane, pb4 = w >> 1, p0 = pb4 * 16;
    const size_t tokbase = (size_t)b * SEQ + (size_t)chunk * CHK;
    {
        const int zoff = dir ? 1024 : 512;
        float fz[16], cp[16]; unsigned vraw[16]; float qv[16];
#pragma unroll
        for (int i = 0; i < 16; ++i) { const int p = p0 + i, tr = dir ? (63 - p) : p; const bf16* q = F.proj() + (tokbase + tr) * NIN + h * HD;
            fz[i] = bf2f(q[zoff + col]); vraw[i] = q[1536 + col]; if (FULL) qv[i] = bf2f(q[col]); }
        float run = 1.f;
#pragma unroll
        for (int i = 0; i < 16; ++i) { const float f = lbv + (1.0f - lbv) * sigmoidf_(fz[i]); fz[i] = f; run *= f; cp[i] = run; }
        LAS float* pblk = (LAS float*)(lds + HL_PBLK);
        pblk[pb4 * 128 + col] = run;
        __syncthreads();
        const float b0 = pblk[col], b1 = pblk[128 + col], b2 = pblk[256 + col], b3 = pblk[384 + col];
        const float pre = pb4 == 0 ? 1.f : (pb4 == 1 ? b0 : (pb4 == 2 ? b0 * b1 : b0 * b1 * b2));
        const float pref = b0 * b1, tot = pref * b2 * b3, ipref = __builtin_amdgcn_rcpf(pref);
        if (pb4 == 0) ((LAS float*)(lds + HL_AV))[col] = tot;
        float ke[16];
#pragma unroll
        for (int i = 0; i < 16; ++i) { const float P = pre * cp[i], iP = __builtin_amdgcn_rcpf(P), k = 1.0f - fz[i];
            ke[i] = k * tot * iP;
            if (FULL) { const int p = p0 + i; const float qs = qv[i] * sigmoidf_(qv[i]), qe = qs * P;
                *(LAS bf16*)(lds + HL_QE + p * PQ + col * 2) = (bf16)f2bf(qe);
                *(LAS bf16*)(lds + HL_QR + p * PQ + col * 2) = (bf16)f2bf(qe * ipref);
                *(LAS bf16*)(lds + HL_KR + p * PQ + col * 2) = (bf16)f2bf(k * pref * iP); } }
        v4u k0, k1, v0, v1;
        k0.x = pk2(ke[0], ke[1]); k0.y = pk2(ke[2], ke[3]); k0.z = pk2(ke[4], ke[5]); k0.w = pk2(ke[6], ke[7]);
        k1.x = pk2(ke[8], ke[9]); k1.y = pk2(ke[10], ke[11]); k1.z = pk2(ke[12], ke[13]); k1.w = pk2(ke[14], ke[15]);
        v0.x = vraw[0] | (vraw[1] << 16); v0.y = vraw[2] | (vraw[3] << 16); v0.z = vraw[4] | (vraw[5] << 16); v0.w = vraw[6] | (vraw[7] << 16);
        v1.x = vraw[8] | (vraw[9] << 16); v1.y = vraw[10] | (vraw[11] << 16); v1.z = vraw[12] | (vraw[13] << 16); v1.w = vraw[14] | (vraw[15] << 16);
        *(LAS v4u*)(lds + HL_KET + col * PT + p0 * 2) = k0; *(LAS v4u*)(lds + HL_KET + col * PT + p0 * 2 + 16) = k1;
        *(LAS v4u*)(lds + HL_VT + col * PT + p0 * 2) = v0; *(LAS v4u*)(lds + HL_VT + col * PT + p0 * 2 + 16) = v1;
    }
    __syncthreads();
    const int pbO = w & 1, vb = w >> 1;
    f32x16 accO, accU[2];
#pragma unroll
    for (int i = 0; i < 16; ++i) { accO[i] = 0.f; accU[0][i] = 0.f; accU[1][i] = 0.f; }
    if (FULL) {
        if (w < 3) { const int pbS = (w + 1) >> 1, sbS = (w == 2) ? 1 : 0; f32x16 sc;
#pragma unroll
            for (int i = 0; i < 16; ++i) sc[i] = 0.f;
#pragma unroll
            for (int s = 0; s < 8; ++s) sc = MFMA32(ldf(lds + HL_QR, pbS * 32 + r, PQ, 32 * s + 16 * hh), ldf(lds + HL_KR, sbS * 32 + r, PQ, 32 * s + 16 * hh), sc);
#pragma unroll
            for (int i = 0; i < 16; ++i) { const int p = pbS * 32 + (i & 3) + 8 * (i >> 2) + 4 * hh, s = sbS * 32 + r;
                *(LAS bf16*)(lds + HL_SCM + p * PT + s * 2) = (bf16)f2bf(s <= p ? sc[i] : 0.f); } }
        __builtin_amdgcn_sched_barrier(0);
#pragma unroll
        for (int s = 0; s < 8; ++s) accO = MFMA32(ldf(lds + HL_QE, pbO * 32 + r, PQ, 32 * s + 16 * hh), ldf(lds + HL_ST, vb * 32 + r, PQ, 32 * s + 16 * hh), accO);
        __builtin_amdgcn_sched_barrier(0);
    }
#pragma unroll
    for (int i = 0; i < 2; ++i) { const int db = 2 * (w & 1) + i;
#pragma unroll
        for (int s = 0; s < 4; ++s) accU[i] = MFMA32(ldf(lds + HL_VT, vb * 32 + r, PT, 32 * s + 16 * hh), ldf(lds + HL_KET, db * 32 + r, PT, 32 * s + 16 * hh), accU[i]); }
    __builtin_amdgcn_sched_barrier(0);
    if (FULL) __syncthreads();
    if (FULL) {
        for (int sb = 0; sb <= pbO; ++sb)
#pragma unroll
            for (int s2 = 0; s2 < 2; ++s2) accO = MFMA32(ldf(lds + HL_SCM, pbO * 32 + r, PT, 64 * sb + 32 * s2 + 16 * hh), ldf(lds + HL_VT, vb * 32 + r, PT, 64 * sb + 32 * s2 + 16 * hh), accO);
        const int v = vb * 32 + r;
        const long loff = (MODE == 0 ? 4 * hh : -4 * hh);
        if (MODE == 0) {
            float* ob = F.of() + (tokbase + pbO * 32) * DH + h * HD;
#pragma unroll
            for (int i = 0; i < 16; ++i) { const int ci = (i & 3) + 8 * (i >> 2); (ob + (size_t)ci * DH)[loff * DH + v] = accO[i]; }
        } else {
            LAS float* rs = (LAS float*)(lds + HL_RS);
            const size_t tb = tokbase + 63 - pbO * 32;
            float ov[16];
#pragma unroll
            for (int i = 0; i < 16; ++i) { const int ci = (i & 3) + 8 * (i >> 2), p = pbO * 32 + ci + 4 * hh;
                ov[i] = accO[i] + (F.of() + (tb - ci) * DH + h * HD)[loff * DH + v]; float ss = ov[i] * ov[i];
                ss += __shfl_xor(ss, 1); ss += __shfl_xor(ss, 2); ss += __shfl_xor(ss, 4); ss += __shfl_xor(ss, 8); ss += __shfl_xor(ss, 16);
                if (r == 0) rs[p * 4 + vb] = ss; }
            __syncthreads();
            const float ng = F.hnorm_g()[h * HD + v];
#pragma unroll
            for (int i = 0; i < 16; ++i) { const int ci = (i & 3) + 8 * (i >> 2), p = pbO * 32 + ci + 4 * hh;
                const f32x4 q = *(LAS const f32x4*)(rs + p * 4);
                const float rstd = __builtin_amdgcn_rsqf((q[0] + q[1] + q[2] + q[3]) * (1.0f / HD) + EPS);
                const float g = bf2f((F.proj() + (tb - ci) * NIN + 2048 + h * HD)[loff * NIN + v]);
                (F.bufA() + (tb - ci) * D + h * HD)[loff * D + v] = (bf16)f2bf(ov[i] * rstd * ng * g * sigmoidf_(g)); }
        }
    }
    {
        const LAS float* av = (const LAS float*)(lds + HL_AV);
#pragma unroll
        for (int i = 0; i < 2; ++i) { const int db = 2 * (w & 1) + i; const float a = av[db * 32 + r];
#pragma unroll
            for (int j = 0; j < 16; ++j) { const float sn = accS[i][j] * a + accU[i][j]; accS[i][j] = sn;
                if (FULL) { const int vv = vb * 32 + (j & 3) + 8 * (j >> 2) + 4 * hh; *(LAS bf16*)(lds + HL_ST + vv * PQ + (db * 32 + r) * 2) = (bf16)f2bf(sn); } } }
    }
    __syncthreads();
}
__device__ __forceinline__ void h1_item(Frame& F, int item) {
    const int seg = item & 15, dir = (item >> 4) & 1, h = (item >> 5) & 3, b = item >> 7;
    const int col = F.tid & 127; const float lbv = F.lb()[dir * 512 + h * HD + col];
    f32x16 accS[2];
#pragma unroll
    for (int i = 0; i < 16; ++i) { accS[0][i] = 0.f; accS[1][i] = 0.f; }
    float atot = 1.f;
    for (int c = 0; c < SEGC; ++c) { const int chunk = seg * SEGC + (dir ? (SEGC - 1 - c) : c);
        hgrn_chunk<false, 0>(F, b, h, dir, chunk, accS, lbv);
        atot *= ((const LAS float*)(F.lds + HL_AV))[col]; }
    if (F.tid < 128) F.sega()[(size_t)item * 128 + col] = atot;
    const int w = F.wave, r = F.lane & 31, hh = F.lane >> 5, vb = w >> 1;
    float* U = F.segu() + (size_t)item * 16384;
#pragma unroll
    for (int i = 0; i < 2; ++i)
#pragma unroll
        for (int j = 0; j < 16; ++j) (U + (i * 16 + j) * NTHR)[F.tid] = accS[i][j];
}
__device__ __forceinline__ void h2_init_state(Frame& F, int b, int h, int dir, int seg, f32x16 (&accS)[2]) {
    const int w = F.wave, r = F.lane & 31, hh = F.lane >> 5, vb = w >> 1;
#pragma unroll
    for (int i = 0; i < 16; ++i) { accS[0][i] = 0.f; accS[1][i] = 0.f; }
    const int base = ((b * 4 + h) * 2 + dir) * 16;
    const int n = dir ? (NSEG - 1 - seg) : seg;
    for (int q = 0; q < n; ++q) { const int s = dir ? (NSEG - 1 - q) : q;
        const float* U = F.segu() + (size_t)(base + s) * 16384; const float* A = F.sega() + (size_t)(base + s) * 128;
#pragma unroll
        for (int i = 0; i < 2; ++i) { const int db = 2 * (w & 1) + i; const float a = A[db * 32 + r];
#pragma unroll
            for (int j = 0; j < 16; ++j) accS[i][j] = accS[i][j] * a + (U + (i * 16 + j) * NTHR)[F.tid]; } }
#pragma unroll
    for (int i = 0; i < 2; ++i) { const int db = 2 * (w & 1) + i;
#pragma unroll
        for (int j = 0; j < 16; ++j) { const int vv = vb * 32 + (j & 3) + 8 * (j >> 2) + 4 * hh; *(LAS bf16*)(F.lds + HL_ST + vv * PQ + (db * 32 + r) * 2) = (bf16)f2bf(accS[i][j]); } }
    __syncthreads();
}
__device__ __forceinline__ void h2_item(Frame& F, int item) {
    const int seg = item & 15, h = (item >> 4) & 3, b = item >> 6;
    const int col = F.tid & 127;
    f32x16 accS[2];
    { const float lbv = F.lb()[h * HD + col];
      h2_init_state(F, b, h, 0, seg, accS);
      for (int c = 0; c < SEGC; ++c) hgrn_chunk<true, 0>(F, b, h, 0, seg * SEGC + c, accS, lbv); }
    asm volatile("s_waitcnt vmcnt(0)" ::: "memory");
    __syncthreads();
    { const float lbv = F.lb()[512 + h * HD + col];
      h2_init_state(F, b, h, 1, seg, accS);
      for (int c = 0; c < SEGC; ++c) hgrn_chunk<true, 1>(F, b, h, 1, seg * SEGC + (SEGC - 1 - c), accS, lbv); }
}

__device__ __forceinline__ unsigned f2key(float f) { const unsigned u = __builtin_bit_cast(unsigned, f); return (u & 0x80000000u) ? ~u : (u | 0x80000000u); }
__device__ __forceinline__ float key2f(unsigned k) { const unsigned u = (k & 0x80000000u) ? (k & 0x7fffffffu) : ~k; return __builtin_bit_cast(float, u); }
__device__ __forceinline__ unsigned umax_(unsigned a, unsigned b) { return a > b ? a : b; }
__device__ __forceinline__ unsigned umin_(unsigned a, unsigned b) { return a < b ? a : b; }
__device__ __forceinline__ void sort16(unsigned (&a)[16]) {
#pragma unroll
    for (int k = 2; k <= 16; k <<= 1)
#pragma unroll
        for (int j = k >> 1; j > 0; j >>= 1)
#pragma unroll
            for (int i = 0; i < 16; ++i) { const int l = i ^ j; if (l > i) { const bool desc = ((i & k) == 0); const unsigned x = a[i], y = a[l], mx = umax_(x, y), mn = umin_(x, y); a[i] = desc ? mx : mn; a[l] = desc ? mn : mx; } }
}
__device__ __forceinline__ void merge16(unsigned (&a)[16], const unsigned (&b)[16]) {
#pragma unroll
    for (int i = 0; i < 16; ++i) a[i] = umax_(a[i], b[15 - i]);
#pragma unroll
    for (int j = 8; j > 0; j >>= 1)
#pragma unroll
        for (int i = 0; i < 16; ++i) { const int l = i ^ j; if (l > i) { const unsigned x = a[i], y = a[l]; a[i] = umax_(x, y); a[l] = umin_(x, y); } }
}
__device__ __forceinline__ unsigned dpp_swap1(unsigned v) { return (unsigned)__builtin_amdgcn_update_dpp(0, (int)v, 0xB1, 0xF, 0xF, false); }
__device__ __forceinline__ unsigned pick_byte(const unsigned (&pk)[4], unsigned a) {
    const unsigned wsel = a >> 2; unsigned v = wsel == 0 ? pk[0] : (wsel == 1 ? pk[1] : (wsel == 2 ? pk[2] : pk[3]));
    return (v >> ((a & 3u) * 8u)) & 0xffu;
}
__device__ __forceinline__ void p7_topk(Frame& F) {
    const int NT = T * PHEADS * 2;
    for (int g0 = (F.bid * NWAVES + F.wave) * 64; g0 < NT; g0 += F.G * NTHR) {
        const int g = g0 + F.lane; const float* sp = F.scores() + (size_t)g * 128;
        unsigned top[16];
#pragma unroll
        for (int grp = 0; grp < 8; ++grp) { unsigned k[16];
#pragma unroll
            for (int q = 0; q < 4; ++q) { const f32x4 v = *(const f32x4*)(sp + grp * 16 + q * 4);
#pragma unroll
                for (int e = 0; e < 4; ++e) { const int j = grp * 16 + q * 4 + e; k[q * 4 + e] = (f2key(v[e]) & ~0x7fu) | (unsigned)(127 - j); } }
            sort16(k);
            if (grp == 0) {
#pragma unroll
                for (int i = 0; i < 16; ++i) top[i] = k[i];
            } else merge16(top, k); }
        float vO[16], vP[16]; unsigned iOpk[4] = {0u, 0u, 0u, 0u}, iPpk[4] = {0u, 0u, 0u, 0u};
#pragma unroll
        for (int i = 0; i < 16; ++i) { const unsigned t = top[i], tp = dpp_swap1(t);
            vO[i] = key2f(t & ~0x7fu); vP[i] = key2f(tp & ~0x7fu);
            iOpk[i >> 2] |= (127u - (t & 0x7fu)) << ((i & 3) * 8); iPpk[i >> 2] |= (127u - (tp & 0x7fu)) << ((i & 3) * 8); }
        unsigned R[16], G1[16], G2[16], G3[16];
#define CAND(a, b) ((f2key(vO[a] + vP[b]) & ~0xffu) | (unsigned)(((a) << 4) | (b)))
#pragma unroll
        for (int i = 0; i < 16; ++i) R[i] = CAND(0, i);
        G1[0] = CAND(1, 0); G1[1] = CAND(1, 1); G1[2] = CAND(1, 2); G1[3] = CAND(1, 3); G1[4] = CAND(1, 4); G1[5] = CAND(1, 5); G1[6] = CAND(1, 6); G1[7] = CAND(1, 7);
        G1[8] = CAND(2, 0); G1[9] = CAND(2, 1); G1[10] = CAND(2, 2); G1[11] = CAND(2, 3); G1[12] = CAND(2, 4); G1[13] = CAND(3, 0); G1[14] = CAND(3, 1); G1[15] = CAND(3, 2);
        G2[0] = CAND(3, 3); G2[1] = CAND(4, 0); G2[2] = CAND(4, 1); G2[3] = CAND(4, 2); G2[4] = CAND(5, 0); G2[5] = CAND(5, 1); G2[6] = CAND(6, 0); G2[7] = CAND(6, 1);
        G2[8] = CAND(7, 0); G2[9] = CAND(7, 1); G2[10] = CAND(8, 0); G2[11] = CAND(9, 0); G2[12] = CAND(10, 0); G2[13] = CAND(11, 0); G2[14] = CAND(12, 0); G2[15] = CAND(13, 0);
        G3[0] = CAND(14, 0); G3[1] = CAND(15, 0);
#pragma unroll
        for (int i = 2; i < 16; ++i) G3[i] = 0u;
#undef CAND
        sort16(G1); sort16(G2); sort16(G3);
        merge16(R, G1); merge16(R, G2); merge16(R, G3);
        float sc[16], ex[16]; float sum = 0.f; unsigned eid[16];
        const bool tab0 = ((g & 1) == 0);
#pragma unroll
        for (int i = 0; i < 16; ++i) { sc[i] = key2f(R[i] & ~0xffu); const unsigned a = (R[i] >> 4) & 15u, bb = R[i] & 15u;
            const unsigned io = pick_byte(iOpk, a), ip = pick_byte(iPpk, bb);
            eid[i] = tab0 ? (io * 128u + ip) : (ip * 128u + io); }
#pragma unroll
        for (int i = 0; i < 16; ++i) { ex[i] = __expf(sc[i] - sc[0]); sum += ex[i]; }
        const float inv = 1.0f / sum;
        if (tab0) { const size_t o = (size_t)(g >> 1) * 16;
#pragma unroll
            for (int q = 0; q < 4; ++q) { v4u ev; ev.x = eid[4 * q]; ev.y = eid[4 * q + 1]; ev.z = eid[4 * q + 2]; ev.w = eid[4 * q + 3]; *(v4u*)(F.esel() + o + 4 * q) = ev;
                f32x4 wv; wv[0] = ex[4 * q] * inv; wv[1] = ex[4 * q + 1] * inv; wv[2] = ex[4 * q + 2] * inv; wv[3] = ex[4 * q + 3] * inv; *(f32x4*)(F.wsel() + o + 4 * q) = wv; } }
    }
}

#define DPP_ADD(s, ctrl) ((s) + __builtin_bit_cast(float, __builtin_amdgcn_update_dpp(0, __builtin_bit_cast(int, (s)), (ctrl), 0xF, 0xF, false)))
__device__ __forceinline__ void cvt16(const v4u& u, float (&f)[16]) {
#pragma unroll
    for (int i = 0; i < 4; ++i) { const f32x2_ lo = __builtin_amdgcn_cvt_pk_f32_fp8((int)u[i], false), hi = __builtin_amdgcn_cvt_pk_f32_fp8((int)u[i], true);
        f[4 * i] = lo[0]; f[4 * i + 1] = lo[1]; f[4 * i + 2] = hi[0]; f[4 * i + 3] = hi[1]; }
}
constexpr int PITEM = 8, NPITEM = T / PITEM;
__device__ __forceinline__ int peer_next(unsigned* q, int lane) {
    int idx = 0; if (lane == 0) idx = (int)__hip_atomic_fetch_add(q, 1u, __ATOMIC_RELAXED, __HIP_MEMORY_SCOPE_AGENT);
    return __builtin_amdgcn_readfirstlane(idx);
}
__device__ __forceinline__ void p8_item(Frame& F, int sl, int item) {
    const int c8 = F.lane & 7, q8 = F.lane >> 3, t0 = item * PITEM, b = t0 >> 13;
    const float* sh2 = F.mod() + b * 6144 + 3072 + sl * CSL + 16 * c8;
    float shv[16];
#pragma unroll
    for (int k = 0; k < 4; ++k) { const f32x4 v = *(const f32x4*)(sh2 + 4 * k); shv[4 * k] = v[0]; shv[4 * k + 1] = v[1]; shv[4 * k + 2] = v[2]; shv[4 * k + 3] = v[3]; }
    const unsigned char* ub = F.U8() + (size_t)sl * 16384 * CSL + 16 * c8;
    v4u ev[4];
#pragma unroll
    for (int k = 0; k < 4; ++k) ev[k] = *(const v4u*)(F.esel() + (size_t)t0 * NSEL + 16 * q8 + 4 * k);
    for (int tt = 0; tt < PITEM; ++tt) { const int t = t0 + tt;
        v4u ec[4];
#pragma unroll
        for (int k = 0; k < 4; ++k) ec[k] = ev[k];
        if (tt + 1 < PITEM) {
#pragma unroll
            for (int k = 0; k < 4; ++k) ev[k] = *(const v4u*)(F.esel() + (size_t)(t + 1) * NSEL + 16 * q8 + 4 * k); }
        v4u ud[16];
#pragma unroll
        for (int i = 0; i < 16; ++i) ud[i] = *(const v4u*)(ub + (size_t)ec[i >> 2][i & 3] * CSL);
        const float rstd = F.rstd()[t];
        const v4u h0 = *(const v4u*)(F.hg() + (size_t)t * D + sl * CSL + 16 * c8), h1 = *(const v4u*)(F.hg() + (size_t)t * D + sl * CSL + 16 * c8 + 8);
        float hn[16];
#pragma unroll
        for (int k = 0; k < 4; ++k) { hn[2 * k] = bflo(h0[k]) * rstd + shv[2 * k]; hn[2 * k + 1] = bfhi(h0[k]) * rstd + shv[2 * k + 1];
            hn[8 + 2 * k] = bflo(h1[k]) * rstd + shv[8 + 2 * k]; hn[8 + 2 * k + 1] = bfhi(h1[k]) * rstd + shv[8 + 2 * k + 1]; }
        float r0 = 0.f, r1 = 0.f;
#pragma unroll
        for (int i = 0; i < 16; ++i) { float uf[16]; cvt16(ud[i], uf); float sm = 0.f;
#pragma unroll
            for (int k = 0; k < 16; ++k) sm += uf[k] * hn[k];
            sm = DPP_ADD(sm, 0xB1); sm = DPP_ADD(sm, 0x4E); sm = DPP_ADD(sm, 0x141);
            if (i < 8) r0 = (c8 == i) ? sm : r0; else r1 = (c8 == i - 8) ? sm : r1; }
        float* po = F.pact() + ((size_t)t * NSL + sl) * NSEL + 16 * q8 + c8;
        po[0] = r0 * (1.0f / USCALE); po[8] = r1 * (1.0f / USCALE);
    }
}
__device__ __forceinline__ void p9_item(Frame& F, int sl, int item, LAS float* cf  ) {
    const int c8 = F.lane & 7, q8 = F.lane >> 3, t0 = item * PITEM;
    const unsigned char* vb = F.V8() + (size_t)sl * 16384 * CSL + 16 * c8;
    for (int tt = 0; tt < PITEM; ++tt) { const int t = t0 + tt;
        v4u ec[4];
#pragma unroll
        for (int k = 0; k < 4; ++k) ec[k] = *(const v4u*)(F.esel() + (size_t)t * NSEL + 16 * q8 + 4 * k);
        v4u vd[16];
#pragma unroll
        for (int i = 0; i < 16; ++i) vd[i] = *(const v4u*)(vb + (size_t)ec[i >> 2][i & 3] * CSL);
        { const float* pp = F.pact() + (size_t)t * NSL * NSEL + F.lane; float a0 = 0.f, a1 = 0.f;
#pragma unroll
          for (int s = 0; s < NSL; ++s) { a0 += pp[s * NSEL]; a1 += pp[s * NSEL + 64]; }
          const float w0 = F.wsel()[(size_t)t * NSEL + F.lane], w1 = F.wsel()[(size_t)t * NSEL + 64 + F.lane];
          cf[F.lane] = w0 * 0.5f * a0 * (1.0f + erff(a0 * 0.70710678f)); cf[64 + F.lane] = w1 * 0.5f * a1 * (1.0f + erff(a1 * 0.70710678f)); }
        asm volatile("s_waitcnt lgkmcnt(0)" ::: "memory");
        float cv[16];
#pragma unroll
        for (int k = 0; k < 4; ++k) { const f32x4 v = *(LAS const f32x4*)(cf + 16 * q8 + 4 * k); cv[4 * k] = v[0]; cv[4 * k + 1] = v[1]; cv[4 * k + 2] = v[2]; cv[4 * k + 3] = v[3]; }
        float y[16];
#pragma unroll
        for (int k = 0; k < 16; ++k) y[k] = 0.f;
#pragma unroll
        for (int i = 0; i < 16; ++i) { float vf[16]; cvt16(vd[i], vf);
#pragma unroll
            for (int k = 0; k < 16; ++k) y[k] += cv[i] * vf[k]; }
#pragma unroll
        for (int k = 0; k < 16; ++k) { float v = y[k]; v = DPP_ADD(v, 0x128); v += __shfl_xor(v, 16); v += __shfl_xor(v, 32); y[k] = v; }
        if (q8 == 0) { float* yo = F.ybuf() + (size_t)t * D + sl * CSL + 16 * c8;
#pragma unroll
            for (int k = 0; k < 4; ++k) { f32x4 o; o[0] = y[4 * k] * (1.0f / VSCALE); o[1] = y[4 * k + 1] * (1.0f / VSCALE); o[2] = y[4 * k + 2] * (1.0f / VSCALE); o[3] = y[4 * k + 3] * (1.0f / VSCALE); *(f32x4*)(yo + 4 * k) = o; } }
        asm volatile("s_waitcnt lgkmcnt(0)" ::: "memory");
    }
}
template <int SIDE>
__device__ __forceinline__ void peer_phase(Frame& F) {
    const int s0 = (int)(xb_xcc_id() & 7u);
    unsigned* qbase = F.ctl() + (SIDE == 0 ? CW_QU : CW_QV);
    LAS float* cf = (LAS float*)(F.lds) + F.wave * 128;
    for (int k = 0; k < NSL; ++k) { const int sl = (s0 + k) & (NSL - 1);
        for (;;) { const int item = peer_next(qbase + 64 * sl, F.lane); if (item >= NPITEM) break;
            if (SIDE == 0) p8_item(F, sl, item); else p9_item(F, sl, item, cf); } }
}
__device__ __forceinline__ void p10_final(Frame& F) {
    const int gwc = F.bid * NWAVES + F.wave, NGW = F.G * NWAVES;
    for (int row0 = gwc * 16; row0 < T; row0 += NGW * 16) {
        const int b = row0 >> 13; const float* mb = F.mod() + b * 6144 + 5120; const float* fm = F.fmod() + b * 2048;
        f32x4 g2[4], ca[4], cb[4];
#pragma unroll
        for (int j = 0; j < 4; ++j) { const int k = 256 * j + 4 * F.lane; g2[j] = *(const f32x4*)(mb + k); ca[j] = *(const f32x4*)(F.fnorm_g() + k) * (*(const f32x4*)(fm + 1024 + k) + 1.0f); cb[j] = *(const f32x4*)(fm + k); }
        for (int r = 0; r < 16; ++r) { float* hr = F.out() + (size_t)(row0 + r) * D; const float* yr = F.ybuf() + (size_t)(row0 + r) * D;
            f32x4 z[4]; float ss = 0.f;
#pragma unroll
            for (int j = 0; j < 4; ++j) { z[j] = *(const f32x4*)(hr + 256 * j + 4 * F.lane) + g2[j] * *(const f32x4*)(yr + 256 * j + 4 * F.lane); ss += z[j][0] * z[j][0] + z[j][1] * z[j][1] + z[j][2] * z[j][2] + z[j][3] * z[j][3]; }
            const float rstd = __builtin_amdgcn_rsqf(wave_sum(ss) * (1.0f / D) + EPS);
#pragma unroll
            for (int j = 0; j < 4; ++j) *(f32x4*)(hr + 256 * j + 4 * F.lane) = z[j] * rstd * ca[j] + cb[j]; }
    }
}

constexpr int NPHASE = 11;
__global__ void __launch_bounds__(NTHR, 2) fwd_kernel(Args args) {
    extern __shared__ __attribute__((aligned(16))) unsigned char lds_raw[];
    Frame F;
    F.lds = (LAS unsigned char*)lds_raw;
    F.tid = threadIdx.x; F.lane = F.tid & 63; F.wave = __builtin_amdgcn_readfirstlane(F.tid >> 6); F.G = gridDim.x; F.bid = blockIdx.x;
    unsigned char* ws = args.ws; F.a = &args;
    volatile LAS unsigned* misc = (volatile LAS unsigned*)(F.lds + MISC_OFF);
    if (F.tid < 64) misc[F.tid] = 0u;
    __syncthreads();
    const int lo = args.ph_lo, hi = args.ph_hi;
    const bool multi = (hi - lo) > 1;
    XcdBarrier bar; bar.bar = (unsigned*)(ws + WS_CTL) + CW_BAR; bar.x = 0; bar.st = nullptr;
    if (multi) bar = xcd_barrier_post((unsigned*)(ws + WS_CTL) + CW_BAR, misc + 8);
#ifndef PHMASK
#define PHMASK 0x7ff
#endif
#define IN(k) (((PHMASK >> (k)) & 1) && lo <= (k) && (k) < hi)
#define SEAM(k) do { if (IN(k) && IN((k) + 1)) xcd_barrier(bar); } while (0)

    if (IN(0)) { p0_prologue(F); } SEAM(0);
    if (IN(1)) { p1_norm(F); } SEAM(1);
    if (IN(2)) { pg8::Gemm g{F.bufA(), F.Win_t(), T, NIN, D}; pg8::StaticOrder S; S.init(T, NIN, F.G, F.bid);
        pg8::EpiBf16<0> E{F.proj(), NIN, nullptr, 0, 0, 1.f};
        pg8::gemm_phase<pg8::EpiBf16<0>, pg8::StaticOrder, true, true>(F.lds, g, S, E); } SEAM(2);
    if (IN(3)) {
        for (int it = F.bid; it < NB * NHH * 2 * NSEG; it += F.G) h1_item(F, it);
        float cw[CW];
#pragma unroll
        for (int j = 0; j < CW; ++j) cw[j] = F.conv_w()[j * DC + F.tid];
        const float cbias = F.conv_b()[F.tid];
        for (int it = F.bid; it < T / 32; it += F.G) conv_item(F, it, cw, cbias);
    } SEAM(3);
    if (IN(4)) { for (int it = F.bid; it < NB * NHH * NSEG; it += F.G) h2_item(F, it); } SEAM(4);
    if (IN(5)) { pg8::Gemm g{F.bufA(), F.Wout_t(), T, D, D}; pg8::StaticOrder S; S.init(T, D, F.G, F.bid);
        pg8::EpiOut E{F.x(), F.out(), F.hg(), F.mod(), F.g_ffn(), F.ssqp()};
        pg8::gemm_phase<pg8::EpiOut, pg8::StaticOrder, true, true>(F.lds, g, S, E); } SEAM(5);
    if (IN(6)) { pg8::Gemm g{F.hg(), F.Wqk_t(), T, NQK, D}; pg8::StaticOrder S; S.init(T, NQK, F.G, F.bid);
        pg8::EpiScore E{F.scores(), F.ssqp(), F.biasq(), F.rstd()};
        pg8::gemm_phase<pg8::EpiScore, pg8::StaticOrder, true, true>(F.lds, g, S, E); } SEAM(6);
    if (IN(7)) { p7_topk(F); } SEAM(7);
    if (IN(8)) { peer_phase<0>(F); } SEAM(8);
    if (IN(9)) { peer_phase<1>(F); } SEAM(9);
    if (IN(10)) { p10_final(F); }
#undef IN
#undef SEAM
}

#ifndef MK_ONE_LAUNCH
#define MK_ONE_LAUNCH 0
#endif
extern "C" void kernel_launch(void* const* d_in, const int* in_sizes, int n_in, void* d_out, int out_size, void* d_ws, size_t ws_size, hipStream_t stream) {
    static int grid = 0;
    if (grid == 0) {
        if (n_in != 23 || out_size != T * D || ws_size < WS_END) { fprintf(stderr, "kernel_launch: unexpected shapes (n_in %d, out %d, ws %zu)\n", n_in, out_size, ws_size); grid = -1; return; }
        int dev = 0, cus = 0, per_cu = 0;
        if (hipGetDevice(&dev) != hipSuccess || hipDeviceGetAttribute(&cus, hipDeviceAttributeMultiprocessorCount, dev) != hipSuccess) { grid = -1; return; }
        if (hipFuncSetAttribute((const void*)fwd_kernel, hipFuncAttributeMaxDynamicSharedMemorySize, LDS_BYTES) != hipSuccess) { fprintf(stderr, "kernel_launch: hipFuncSetAttribute failed\n"); grid = -1; return; }
        if (hipOccupancyMaxActiveBlocksPerMultiprocessor(&per_cu, (const void*)fwd_kernel, NTHR, LDS_BYTES) != hipSuccess || per_cu < 1) { fprintf(stderr, "kernel_launch: occupancy query reports %d\n", per_cu); }
        (void)hipGetLastError();
        grid = cus;
    }
    if (grid < 0) return;
    (void)hipMemsetAsync((char*)d_ws + WS_CTL, 0, CTL_ZERO_BYTES, stream);
    Args a{};
    for (int i = 0; i < 23; ++i) a.in[i] = (const float*)d_in[i];
    a.out = (float*)d_out; a.ws = (unsigned char*)d_ws;
#if MK_ONE_LAUNCH
    a.ph_lo = 0; a.ph_hi = NPHASE;
    hipLaunchKernelGGL(fwd_kernel, dim3(grid), dim3(NTHR), LDS_BYTES, stream, a);
#else
    for (int p = 0; p < NPHASE; ++p) { a.ph_lo = p; a.ph_hi = p + 1; hipLaunchKernelGGL(fwd_kernel, dim3(grid), dim3(NTHR), LDS_BYTES, stream, a); }
#endif
}
```

```cpp
#include <hip/hip_runtime.h>
#include <cstdio>
#include <cstdint>
namespace pg8 {
#define PG8_LAS __attribute__((address_space(3)))
typedef unsigned short bf16_t;
typedef short bf16x8 __attribute__((ext_vector_type(8)));
typedef float f32x4 __attribute__((ext_vector_type(4)));
typedef unsigned u32x4 __attribute__((ext_vector_type(4)));
constexpr int BM = 256, BK = 64, HALF = 128, HTB = HALF * BK * 2  , STAGE_BYTES = 8 * HTB, NXCD = 8, WGM = 8;

__host__ __device__ __forceinline__ int lds_byte(int r, int c) { const int st = (r >> 4) * 2 + (c >> 5), rr = r & 15, cc = c & 31, ob = rr * 64 + cc * 2; return st * 1024 + (ob ^ (((ob >> 9) & 1) << 5)); }
__host__ __device__ __forceinline__ void stage_rc(int b, int& R, int& C) { const int st = b / 1024, sb = b % 1024, swz = sb ^ (((sb >> 9) & 1) << 5); R = (st >> 1) * 16 + swz / 64; C = (st & 1) * 32 + (swz % 64) / 2; }
__host__ __device__ __forceinline__ int perm32(int rho) { const int n = rho >> 4, i = rho & 15; return 8 * (i >> 2) + 4 * n + (i & 3); }

struct Unit { int pm, pn; };
struct Gemm { const bf16_t* A; const bf16_t* Bt; int M, N, K; };

struct StaticOrder {
    int nM, nN, nwg, G, c;
    __host__ __device__ void init(int M, int N, int G_, int c_) { nM = M / BM; nN = N / BM; nwg = nM * nN; G = G_; c = c_; }
    __host__ __device__ bool next(int i, Unit& u) const {
        const long L = (long)i * G + c; if (L >= nwg) return false;
        int wgid = (int)L; { const int q = nwg / NXCD, r = nwg % NXCD, xcd = wgid % NXCD, off = wgid / NXCD; wgid = (xcd < r ? xcd * (q + 1) : r * (q + 1) + (xcd - r) * q) + off; }
        const int nig = WGM * nN, gid = wgid / nig, fm = gid * WGM, gsz = (nM - fm) < WGM ? (nM - fm) : WGM;
        u.pm = fm + ((wgid % nig) % gsz); u.pn = (wgid % nig) / gsz; return true;
    }
    __device__ __forceinline__ void a_ready(const Unit&) const {}
    __device__ __forceinline__ void done(const Unit&) const {}
};
__device__ __forceinline__ unsigned cvt_pk_bf16(float lo, float hi) { unsigned r; asm volatile("v_cvt_pk_bf16_f32 %0, %1, %2" : "=v"(r) : "v"(lo), "v"(hi)); return r; }
typedef float f32x2 __attribute__((ext_vector_type(2)));
__device__ __forceinline__ f32x2 gelu_pk(f32x2 v) {
    const f32x2 av = __builtin_elementwise_abs(v), d = av * 0.2316418882f + 1.0f;
    f32x2 t; t.x = __builtin_amdgcn_rcpf(d.x); t.y = __builtin_amdgcn_rcpf(d.y);
    f32x2 q = t * 0.5307027145f + (-0.7265760135f); q = q * t + 0.7107068705f; q = q * t + (-0.142248368f); q = q * t + 0.127414796f; q = q * t;
    const f32x2 s = (v * v) * (-0.72134752044f);
    f32x2 e; e.x = __builtin_amdgcn_exp2f(s.x); e.y = __builtin_amdgcn_exp2f(s.y);
    const f32x2 m = v * (q * e), r = v - m;
    f32x2 o; o.x = v.x < 0.f ? m.x : r.x; o.y = v.y < 0.f ? m.y : r.y; return o;
}

template <int ACT  > struct EpiBf16 {
    static constexpr bool PERM = true, AFTER_DRAIN = false; static_assert(ACT == 0 || ACT == 1, "EpiBf16: ACT is 0 (none) or 1 (gelu_pk)");
    bf16_t* O; int ldc; const float* bias; int split_cols; size_t split_stride; float scale0;
    __device__ __forceinline__ void operator()(const f32x4 (&acc)[2][2][4][2], const Unit& u, int wr, int wc, int fr, int fq) const {
        const int row0 = u.pm * BM + wr * 64 + fr; int colt = u.pn * BM; bf16_t* base = O;
        float sc = 1.f; if (split_cols) { const int t = colt / split_cols; base += (size_t)t * split_stride; colt -= t * split_cols; if (t == 0) sc = scale0; }
        const int col0 = colt + wc * 32 + 8 * fq, bcol0 = u.pn * BM + wc * 32 + 8 * fq;
        f32x4 bv[2][2];
#pragma unroll
        for (int bj = 0; bj < 2; ++bj)
#pragma unroll
            for (int n = 0; n < 2; ++n) bv[bj][n] = bias ? *(const f32x4*)(bias + bcol0 + bj * HALF + 4 * n) : (f32x4){0.f, 0.f, 0.f, 0.f};
#pragma unroll
        for (int ai = 0; ai < 2; ++ai)
#pragma unroll
            for (int m = 0; m < 4; ++m) { bf16_t* rowp = base + (size_t)(row0 + ai * HALF + m * 16) * ldc + col0;
#pragma unroll
                for (int bj = 0; bj < 2; ++bj) { f32x4 v0 = acc[ai][bj][m][0] + bv[bj][0], v1 = acc[ai][bj][m][1] + bv[bj][1];
                    if (ACT == 1) { f32x2 a = gelu_pk((f32x2){v0[0], v0[1]}), b = gelu_pk((f32x2){v0[2], v0[3]}), c = gelu_pk((f32x2){v1[0], v1[1]}), d = gelu_pk((f32x2){v1[2], v1[3]});
                        v0 = (f32x4){a.x, a.y, b.x, b.y}; v1 = (f32x4){c.x, c.y, d.x, d.y}; }
                    v0 = v0 * sc; v1 = v1 * sc; u32x4 w; w.x = cvt_pk_bf16(v0[0], v0[1]); w.y = cvt_pk_bf16(v0[2], v0[3]); w.z = cvt_pk_bf16(v1[0], v1[1]); w.w = cvt_pk_bf16(v1[2], v1[3]);
                    *(u32x4*)(rowp + bj * HALF) = w; } }
    }
};

struct EpiOut {
    static constexpr bool PERM = true, AFTER_DRAIN = false;
    const float* X; float* Hout; bf16_t* HG; const float* mod; const float* gffn; float* ssqp;
    __device__ __forceinline__ void operator()(const f32x4 (&acc)[2][2][4][2], const Unit& u, int wr, int wc, int fr, int fq) const {
        const int row0 = u.pm * BM + wr * 64 + fr, col0 = u.pn * BM + wc * 32 + 8 * fq;
        const int b = (u.pm * BM) >> 13;
        const float* mb = mod + b * 6144;
        f32x4 g1v[2][2], gv2[2][2];
#pragma unroll
        for (int bj = 0; bj < 2; ++bj)
#pragma unroll
            for (int n = 0; n < 2; ++n) { const int c = col0 + bj * HALF + 4 * n;
                g1v[bj][n] = *(const f32x4*)(mb + 2048 + c);
                const f32x4 s2 = *(const f32x4*)(mb + 4096 + c), gf = *(const f32x4*)(gffn + c);
                gv2[bj][n] = gf * (s2 + 1.0f); }
#pragma unroll
        for (int ai = 0; ai < 2; ++ai)
#pragma unroll
            for (int m = 0; m < 4; ++m) { const int row = row0 + ai * HALF + m * 16; const size_t ro = (size_t)row * 1024 + col0; float ss = 0.f;
#pragma unroll
                for (int bj = 0; bj < 2; ++bj) {
                    const f32x4 x0 = *(const f32x4*)(X + ro + bj * HALF), x1 = *(const f32x4*)(X + ro + bj * HALF + 4);
                    const f32x4 h0 = x0 + g1v[bj][0] * acc[ai][bj][m][0], h1 = x1 + g1v[bj][1] * acc[ai][bj][m][1];
                    *(f32x4*)(Hout + ro + bj * HALF) = h0; *(f32x4*)(Hout + ro + bj * HALF + 4) = h1;
                    ss += h0[0] * h0[0] + h0[1] * h0[1] + h0[2] * h0[2] + h0[3] * h0[3] + h1[0] * h1[0] + h1[1] * h1[1] + h1[2] * h1[2] + h1[3] * h1[3];
                    const f32x4 q0 = h0 * gv2[bj][0], q1 = h1 * gv2[bj][1];
                    u32x4 w; w.x = cvt_pk_bf16(q0[0], q0[1]); w.y = cvt_pk_bf16(q0[2], q0[3]); w.z = cvt_pk_bf16(q1[0], q1[1]); w.w = cvt_pk_bf16(q1[2], q1[3]);
                    *(u32x4*)(HG + ro + bj * HALF) = w; }
                ss += __shfl_xor(ss, 16); ss += __shfl_xor(ss, 32);
                if (fq == 0) ssqp[(size_t)row * 16 + u.pn * 4 + wc] = ss; }
    }
};
struct EpiScore {
    static constexpr bool PERM = false, AFTER_DRAIN = false;
    float* S; const float* ssqp; const float* biasq; float* rstd_out;
    __device__ __forceinline__ void operator()(const f32x4 (&acc)[2][2][4][2], const Unit& u, int wr, int wc, int fr, int fq) const {
        const int row0 = u.pm * BM + wr * 64 + fr, col0 = u.pn * BM + wc * 32 + 4 * fq;
        const int b = (u.pm * BM) >> 13;
        f32x4 bv[2][2];
#pragma unroll
        for (int bj = 0; bj < 2; ++bj)
#pragma unroll
            for (int n = 0; n < 2; ++n) bv[bj][n] = *(const f32x4*)(biasq + b * 2048 + col0 + bj * HALF + n * 16);
#pragma unroll
        for (int ai = 0; ai < 2; ++ai)
#pragma unroll
            for (int m = 0; m < 4; ++m) { const int row = row0 + ai * HALF + m * 16;
                const f32x4* sp = (const f32x4*)(ssqp + (size_t)row * 16);
                const f32x4 p0 = sp[0], p1 = sp[1], p2 = sp[2], p3 = sp[3];
                const float tot = (p0[0] + p0[1] + p0[2] + p0[3]) + (p1[0] + p1[1] + p1[2] + p1[3]) + (p2[0] + p2[1] + p2[2] + p2[3]) + (p3[0] + p3[1] + p3[2] + p3[3]);
                const float rstd = __builtin_amdgcn_rsqf(tot * (1.0f / 1024.0f) + 1e-6f);
                if (u.pn == 0 && wc == 0 && fq == 0) rstd_out[row] = rstd;
                float* rowp = S + (size_t)row * 2048 + col0;
#pragma unroll
                for (int bj = 0; bj < 2; ++bj)
#pragma unroll
                    for (int n = 0; n < 2; ++n) *(f32x4*)(rowp + bj * HALF + n * 16) = acc[ai][bj][m][n] * rstd + bv[bj][n]; }
    }
};
template <class Epi, class Sched, bool ALIGN_EPI = false, bool SP2 = false>
__device__ __forceinline__ void gemm_phase(PG8_LAS unsigned char* lds, const Gemm g, const Sched& S, const Epi& E) {
    const int tid = threadIdx.x, wid = __builtin_amdgcn_readfirstlane(tid >> 6), lane = tid & 63, wr = wid >> 2, wc = wid & 3, fr = lane & 15, fq = lane >> 4;
    const int K = g.K, nt = K / BK;
    unsigned voffA[2], voffB[2];
#pragma unroll
    for (int i = 0; i < 2; ++i) { int R, C; stage_rc(tid * 16 + i * 8192, R, C); const int Rb = Epi::PERM ? ((R & ~31) + perm32(R & 31)) : R;
        voffA[i] = (unsigned)(R * K + C) * 2u; voffB[i] = (unsigned)(Rb * K + C) * 2u; }
    const size_t kstep = (size_t)(BK * 2);
    const size_t hstep = (size_t)HALF * K * 2;
    const size_t tstep = 2 * hstep;
    const unsigned ldsw = (unsigned)wid * 1024u;
    const int aoff = lds_byte(wr * 64 + fr, fq * 8), boff = lds_byte(wc * 32 + fr, fq * 8);
#define PG8_SA(b, h) (((b) * 2 + (h)) * HTB)
#define PG8_SB(b, h) ((4 + (b) * 2 + (h)) * HTB)
#define PG8_STAGE(bufoff, gbase, voff) do { _Pragma("unroll") for (int _i = 0; _i < 2; ++_i) \
        __builtin_amdgcn_global_load_lds((const unsigned*)((const char*)(gbase) + (voff)[_i]), (PG8_LAS unsigned*)(lds + (bufoff) + ldsw + _i * 8192), 16, 0, 0); } while (0)
#define PG8_LDA(dst, b, h) do { _Pragma("unroll") for (int m = 0; m < 4; ++m) _Pragma("unroll") for (int k = 0; k < 2; ++k) dst[m][k] = *(const PG8_LAS bf16x8*)(lds + PG8_SA(b, h) + aoff + m * 2048 + k * 1024); } while (0)
#define PG8_LDB(dst, b, h) do { _Pragma("unroll") for (int n = 0; n < 2; ++n) _Pragma("unroll") for (int k = 0; k < 2; ++k) dst[n][k] = *(const PG8_LAS bf16x8*)(lds + PG8_SB(b, h) + boff + n * 2048 + k * 1024); } while (0)
#define PG8_MMA(ai, bj, At, Bt) do { __builtin_amdgcn_s_setprio(1); _Pragma("unroll") for (int m = 0; m < 4; ++m) _Pragma("unroll") for (int n = 0; n < 2; ++n) _Pragma("unroll") for (int k = 0; k < 2; ++k) \
        acc[ai][bj][m][n] = __builtin_amdgcn_mfma_f32_16x16x32_bf16(Bt[n][k], At[m][k], acc[ai][bj][m][n], 0, 0, 0); __builtin_amdgcn_s_setprio(0); } while (0)
#define PG8_WAIT_V(n) asm volatile("s_waitcnt vmcnt(" #n ")" ::: "memory")
#define PG8_WAIT_L(n) asm volatile("s_waitcnt lgkmcnt(" #n ")" ::: "memory")
#define PG8_BAR __builtin_amdgcn_s_barrier()
#define PG8_SCHED __builtin_amdgcn_sched_barrier(0)
    Unit cur, nxt; int ui = 0;
    if (!S.next(0, cur)) return;
    f32x4 acc[2][2][4][2];
#pragma unroll
    for (int a = 0; a < 2; ++a)
#pragma unroll
        for (int b = 0; b < 2; ++b)
#pragma unroll
            for (int m = 0; m < 4; ++m)
#pragma unroll
                for (int n = 0; n < 2; ++n) acc[a][b][m][n] = (f32x4){0.f, 0.f, 0.f, 0.f};
    bf16x8 At[4][2], B0[2][2], B1[2][2];
    const char* cA = (const char*)g.A + (size_t)cur.pm * tstep; const char* cB = (const char*)g.Bt + (size_t)cur.pn * tstep;
    S.a_ready(cur);
    if constexpr (SP2) {
        PG8_STAGE(PG8_SB(0, 0), cB, voffB); PG8_STAGE(PG8_SB(0, 1), cB + hstep, voffB); PG8_STAGE(PG8_SA(0, 0), cA, voffA); PG8_STAGE(PG8_SA(0, 1), cA + hstep, voffA);
        if (wr == 1) PG8_BAR;
        PG8_WAIT_V(2); PG8_BAR;
        PG8_STAGE(PG8_SB(1, 0), cB + kstep, voffB); PG8_STAGE(PG8_SA(1, 0), cA + kstep, voffA); PG8_STAGE(PG8_SB(1, 1), cB + hstep + kstep, voffB);
        PG8_WAIT_V(6); PG8_BAR;
    } else {
        PG8_STAGE(PG8_SB(0, 0), cB, voffB); PG8_STAGE(PG8_SA(0, 0), cA, voffA); PG8_STAGE(PG8_SB(0, 1), cB + hstep, voffB); PG8_STAGE(PG8_SA(0, 1), cA + hstep, voffA);
        if (wr == 1) PG8_BAR;
        PG8_WAIT_V(4); PG8_BAR;
        PG8_STAGE(PG8_SB(1, 0), cB + kstep, voffB); PG8_STAGE(PG8_SA(1, 0), cA + kstep, voffA); PG8_STAGE(PG8_SB(1, 1), cB + hstep + kstep, voffB);
        PG8_WAIT_V(6); PG8_BAR;
    }
    for (;;) {
        const bool has_next = S.next(ui + 1, nxt);
        const char* nA = has_next ? (const char*)g.A + (size_t)nxt.pm * tstep : cA; const char* nB = has_next ? (const char*)g.Bt + (size_t)nxt.pn * tstep : cB;
        for (int t = 0; t < nt; t += 2) {
            const bool last = (t == nt - 2);
            const char* a1 = cA + (size_t)(t + 1) * kstep;
            const char* a2 = last ? nA : cA + (size_t)(t + 2) * kstep; const char* b2 = last ? nB : cB + (size_t)(t + 2) * kstep;
            const char* a3 = a2 + kstep; const char* b3 = b2 + kstep;
            if (last && has_next) S.a_ready(nxt);
            if constexpr (SP2) {
            PG8_LDB(B0, 0, 0); PG8_LDB(B1, 0, 1); PG8_SCHED; PG8_LDA(At, 0, 0); PG8_STAGE(PG8_SA(1, 1), a1 + hstep, voffA);
            PG8_WAIT_V(8); PG8_WAIT_L(0); PG8_BAR; PG8_MMA(0, 0, At, B0); PG8_MMA(0, 1, At, B1); PG8_BAR; PG8_SCHED;
            PG8_LDA(At, 0, 1); PG8_STAGE(PG8_SB(0, 0), b2, voffB); PG8_STAGE(PG8_SB(0, 1), b2 + hstep, voffB); PG8_STAGE(PG8_SA(0, 0), a2, voffA);
            PG8_WAIT_V(8); PG8_WAIT_L(0); PG8_BAR; PG8_MMA(1, 0, At, B0); PG8_MMA(1, 1, At, B1); PG8_BAR; PG8_SCHED;
            PG8_LDB(B0, 1, 0); PG8_LDB(B1, 1, 1); PG8_SCHED; PG8_LDA(At, 1, 0); PG8_STAGE(PG8_SA(0, 1), a2 + hstep, voffA);
            PG8_WAIT_V(8); PG8_WAIT_L(0); PG8_BAR; PG8_MMA(0, 0, At, B0); PG8_MMA(0, 1, At, B1); PG8_BAR; PG8_SCHED;
            PG8_LDA(At, 1, 1); PG8_STAGE(PG8_SB(1, 0), b3, voffB); PG8_STAGE(PG8_SB(1, 1), b3 + hstep, voffB); PG8_STAGE(PG8_SA(1, 0), a3, voffA);
            PG8_WAIT_V(8); PG8_WAIT_L(0); PG8_BAR; PG8_MMA(1, 0, At, B0); PG8_MMA(1, 1, At, B1); PG8_BAR; PG8_SCHED;
            } else {
            PG8_LDB(B0, 0, 0); PG8_SCHED; PG8_LDA(At, 0, 0); PG8_STAGE(PG8_SA(1, 1), a1 + hstep, voffA);
            PG8_WAIT_L(8); PG8_BAR; PG8_WAIT_L(0); PG8_MMA(0, 0, At, B0); PG8_BAR; PG8_SCHED;
            PG8_LDB(B1, 0, 1); PG8_STAGE(PG8_SB(0, 0), b2, voffB);
            PG8_BAR; PG8_WAIT_L(0); PG8_MMA(0, 1, At, B1); PG8_BAR;
            PG8_LDA(At, 0, 1); PG8_STAGE(PG8_SA(0, 0), a2, voffA);
            PG8_BAR; PG8_WAIT_L(0); PG8_MMA(1, 0, At, B0); PG8_BAR; PG8_SCHED;
            PG8_STAGE(PG8_SB(0, 1), b2 + hstep, voffB);
            PG8_WAIT_V(6); PG8_BAR; PG8_MMA(1, 1, At, B1); PG8_BAR;
            PG8_LDB(B0, 1, 0); PG8_SCHED; PG8_LDA(At, 1, 0); PG8_STAGE(PG8_SA(0, 1), a2 + hstep, voffA);
            PG8_WAIT_L(8); PG8_BAR; PG8_WAIT_L(0); PG8_MMA(0, 0, At, B0); PG8_BAR; PG8_SCHED;
            PG8_LDB(B1, 1, 1); PG8_STAGE(PG8_SB(1, 0), b3, voffB);
            PG8_BAR; PG8_WAIT_L(0); PG8_MMA(0, 1, At, B1); PG8_BAR;
            PG8_LDA(At, 1, 1); PG8_STAGE(PG8_SA(1, 0), a3, voffA);
            PG8_BAR; PG8_WAIT_L(0); PG8_MMA(1, 0, At, B0); PG8_BAR; PG8_SCHED;
            PG8_STAGE(PG8_SB(1, 1), b3 + hstep, voffB);
            PG8_WAIT_V(6); PG8_BAR; PG8_MMA(1, 1, At, B1); PG8_BAR;
            }
        }
        if constexpr (ALIGN_EPI) { if (wr == 0) PG8_BAR; }
        if constexpr (!Epi::AFTER_DRAIN) { E(acc, cur, wr, wc, fr, fq); S.done(cur); }
        if (!has_next) break;
#pragma unroll
        for (int a = 0; a < 2; ++a)
#pragma unroll
            for (int b = 0; b < 2; ++b)
#pragma unroll
                for (int m = 0; m < 4; ++m)
#pragma unroll
                    for (int n = 0; n < 2; ++n) acc[a][b][m][n] = (f32x4){0.f, 0.f, 0.f, 0.f};
        cur = nxt; cA = nA; cB = nB; ++ui;
        if constexpr (ALIGN_EPI) { if (wr == 1) PG8_BAR; }
    }
    PG8_WAIT_V(0);
    if constexpr (!ALIGN_EPI) { if (wr == 0) PG8_BAR; }
    PG8_BAR;
    if constexpr (Epi::AFTER_DRAIN) { E.fused(acc, cur, wr, wc, fr, fq, lds, wid, lane); S.done(cur); }
#undef PG8_SA
#undef PG8_SB
#undef PG8_STAGE
#undef PG8_LDA
#undef PG8_LDB
#undef PG8_MMA
#undef PG8_WAIT_V
#undef PG8_WAIT_L
#undef PG8_BAR
#undef PG8_SCHED
}
}
#define MK_ONE_LAUNCH 1

constexpr int NB = 4, SEQ = 8192, T = NB * SEQ, D = 1024;
constexpr int NIN = 3584, DH = 512, HD = 128, NHH = 4, CHK = 64;
constexpr int NSEG = 16, SEGC = 8;
constexpr int CW = 31, CPAD = 15, DC = 512;
constexpr int PHEADS = 8, NQK = 2048, NSEL = 128;
constexpr float EPS = 1e-6f;
constexpr int NWAVES = 8, NTHR = 512;

constexpr size_t MiB = 1u << 20;
constexpr size_t WS_CTL = 0, CTL_ZERO_BYTES = 65536;
constexpr size_t WS_MOD = 1 * MiB, WS_FMOD = WS_MOD + 131072, WS_LB = WS_MOD + 196608, WS_BIASQ = WS_MOD + 262144;
constexpr size_t WS_WIN = 2 * MiB, WS_WOUT = 10 * MiB, WS_WQK = 12 * MiB;
constexpr size_t WS_UT = 16 * MiB, WS_VT = 48 * MiB;
constexpr size_t WS_BUFA = 80 * MiB;
constexpr size_t WS_BUFB = 144 * MiB;
constexpr size_t WS_SEG = 208 * MiB;
constexpr size_t WS_E = 208 * MiB, WS_W = 224 * MiB;
constexpr size_t WS_BIG = 240 * MiB;
constexpr size_t WS_SSQ = 496 * MiB;
constexpr size_t WS_SEGA = 498 * MiB;
constexpr size_t WS_RSTD = 499 * MiB;
constexpr size_t WS_END = 500 * MiB;
constexpr size_t WS_PACT = 240 * MiB;
constexpr size_t WS_Y = 368 * MiB;
constexpr int NSL = 8, CSL = 128;
constexpr float USCALE = 64.0f, VSCALE = 16.0f;
constexpr int CW_QU = 8192, CW_QV = 8192 + 64 * 16;
constexpr int CW_BAR = 1024;

constexpr int LDS_BYTES = 155648;
constexpr int MISC_OFF = LDS_BYTES - 256;

#define GAS __attribute__((address_space(1)))
#define LAS __attribute__((address_space(3)))
typedef unsigned short bf16;
typedef unsigned v4u __attribute__((ext_vector_type(4)));
typedef unsigned v2u __attribute__((ext_vector_type(2)));
typedef float f32x4 __attribute__((ext_vector_type(4)));
typedef float f32x16 __attribute__((ext_vector_type(16)));
typedef short bf16x8 __attribute__((ext_vector_type(8)));
typedef float f32x2_ __attribute__((ext_vector_type(2)));

__device__ __forceinline__ float bf2f(unsigned h) { return __builtin_bit_cast(float, h << 16); }
__device__ __forceinline__ float bflo(unsigned u) { return __builtin_bit_cast(float, u << 16); }
__device__ __forceinline__ float bfhi(unsigned u) { return __builtin_bit_cast(float, u & 0xffff0000u); }
__device__ __forceinline__ unsigned f2bf(float f) { unsigned u = __builtin_bit_cast(unsigned, f); return (u + 0x7fffu + ((u >> 16) & 1u)) >> 16; }
__device__ __forceinline__ unsigned pk2(float lo, float hi) { return f2bf(lo) | (f2bf(hi) << 16); }
__device__ __forceinline__ float sigmoidf_(float x) { return __builtin_amdgcn_rcpf(1.0f + __expf(-x)); }
__device__ __forceinline__ float wave_sum(float v) {
#pragma unroll
    for (int o = 1; o < 64; o <<= 1) v += __shfl_xor(v, o);
    return v;
}

#define XB_TMO      128
#define XB_XCNT(j)  (256  + 64 * (j))
#define XB_XSUB(j)  (1280 + 64 * (j))
#define XB_XGEN(j)  (2304 + 64 * (j))
#define XB_TOP      3328
#define XB_TOPGEN   3392
#define XCD_BAR_WORDS 3456
#define XB_SPIN_CAP (1u << 18)
__device__ __forceinline__ unsigned xb_ld(unsigned* p)              { return __hip_atomic_load(p, __ATOMIC_RELAXED, __HIP_MEMORY_SCOPE_AGENT); }
__device__ __forceinline__ unsigned xb_add(unsigned* p, unsigned v) { return __hip_atomic_fetch_add(p, v, __ATOMIC_RELAXED, __HIP_MEMORY_SCOPE_AGENT); }
__device__ __forceinline__ unsigned xb_xcc_id() { return (unsigned)__builtin_amdgcn_s_getreg((3 << 11) | 20) & 0xFu; }
#define XB_SPIN(cond, bar) do { unsigned _sp = 0; while (cond) { __builtin_amdgcn_s_sleep(1); \
    if ((++_sp & 255u) == 0u) { if (xb_ld(&(bar)[XB_TMO])) break; if (_sp > XB_SPIN_CAP) { atomicAdd(&(bar)[XB_TMO], 1u); break; } } } } while (0)
struct XcdBarrier { unsigned* bar; unsigned x; volatile LAS unsigned* st; };
__device__ __forceinline__ XcdBarrier xcd_barrier_post(unsigned* bar, volatile LAS unsigned* st) {
    XcdBarrier b; b.bar = bar; b.x = xb_xcc_id(); b.st = st;
    if (threadIdx.x == 0) (void)xb_add(&bar[XB_XCNT(b.x)], 1u);
    return b;
}
__device__ __forceinline__ void xcd_barrier_complete(unsigned* bar, unsigned x, unsigned& nloc, unsigned& nx) {
    const unsigned G = gridDim.x * gridDim.y * gridDim.z;
    unsigned sum, cnt, mine, sp = 0u;
    for (;;) {
        sum = 0u; cnt = 0u; mine = 0u;
#pragma unroll
        for (unsigned j = 0; j < 16; ++j) { const unsigned c = xb_ld(&bar[XB_XCNT(j)]); sum += c; cnt += (c > 0u) ? 1u : 0u; mine = (j == x) ? c : mine; }
        if (sum == G) break;
        __builtin_amdgcn_s_sleep(1);
        if ((++sp & 255u) == 0u) { if (xb_ld(&bar[XB_TMO])) break; if (sp > XB_SPIN_CAP) { atomicAdd(&bar[XB_TMO], 1u); break; } }
    }
    nloc = mine > 0u ? mine : 1u; nx = cnt > 0u ? cnt : 1u;
}
__device__ __forceinline__ void xcd_barrier(const XcdBarrier& b) {
    asm volatile("s_waitcnt vmcnt(0)" ::: "memory");
    __syncthreads();
    if (threadIdx.x == 0) {
        unsigned* bar = b.bar;
        __builtin_amdgcn_s_waitcnt(0);
        unsigned nloc = b.st[0], nx = b.st[1];
        if (nloc == 0u) { xcd_barrier_complete(bar, b.x, nloc, nx); b.st[0] = nloc; b.st[1] = nx; }
        const unsigned old = xb_add(&bar[XB_XSUB(b.x)], 1u);
        const unsigned gen = old / nloc;
        if (old + 1u == (gen + 1u) * nloc) {
            __builtin_amdgcn_fence(__ATOMIC_RELEASE, "agent");
            asm volatile("s_waitcnt vmcnt(0)" ::: "memory");
            const unsigned og = xb_add(&bar[XB_TOP], 1u);
            const unsigned tg = og / nx;
            if (og + 1u == (tg + 1u) * nx) xb_add(&bar[XB_TOPGEN], 1u);
            else XB_SPIN(xb_ld(&bar[XB_TOPGEN]) == tg, bar);
            __builtin_amdgcn_fence(__ATOMIC_ACQUIRE, "agent");
            xb_add(&bar[XB_XGEN(b.x)], 1u);
            asm volatile("s_waitcnt vmcnt(0)" ::: "memory");
        } else {
            XB_SPIN(xb_ld(&bar[XB_XGEN(b.x)]) == gen, bar);
            __builtin_amdgcn_fence(__ATOMIC_ACQUIRE, "agent");
            asm volatile("s_waitcnt vmcnt(0)" ::: "memory");
        }
    }
    __syncthreads();
}

struct Args { const float* in[23]; float* out; unsigned char* ws; int ph_lo, ph_hi; };
struct Frame {
    LAS unsigned char* lds;
    int tid, lane, wave, G, bid;
    const Args* a;
    __device__ __forceinline__ const float* x() const { return a->in[0]; }
    __device__ __forceinline__ const float* c() const { return a->in[1]; }
    __device__ __forceinline__ const float* ada_w() const { return a->in[2]; }
    __device__ __forceinline__ const float* ada_b() const { return a->in[3]; }
    __device__ __forceinline__ const float* g_mix() const { return a->in[4]; }
    __device__ __forceinline__ const float* w_in() const { return a->in[5]; }
    __device__ __forceinline__ const float* lbg_f() const { return a->in[6]; }
    __device__ __forceinline__ const float* lbg_b() const { return a->in[7]; }
    __device__ __forceinline__ const float* hnorm_g() const { return a->in[8]; }
    __device__ __forceinline__ const float* conv_w() const { return a->in[9]; }
    __device__ __forceinline__ const float* conv_b() const { return a->in[10]; }
    __device__ __forceinline__ const float* cln_g() const { return a->in[11]; }
    __device__ __forceinline__ const float* cln_b() const { return a->in[12]; }
    __device__ __forceinline__ const float* w_out() const { return a->in[13]; }
    __device__ __forceinline__ const float* g_ffn() const { return a->in[14]; }
    __device__ __forceinline__ const float* wq() const { return a->in[15]; }
    __device__ __forceinline__ const float* keys1() const { return a->in[16]; }
    __device__ __forceinline__ const float* keys2() const { return a->in[17]; }
    __device__ __forceinline__ const float* utab() const { return a->in[18]; }
    __device__ __forceinline__ const float* vtab() const { return a->in[19]; }
    __device__ __forceinline__ const float* fada_w() const { return a->in[20]; }
    __device__ __forceinline__ const float* fada_b() const { return a->in[21]; }
    __device__ __forceinline__ const float* fnorm_g() const { return a->in[22]; }
    __device__ __forceinline__ float* out() const { return a->out; }
    __device__ __forceinline__ float* mod() const { return (float*)(a->ws + WS_MOD); }
    __device__ __forceinline__ float* fmod() const { return (float*)(a->ws + WS_FMOD); }
    __device__ __forceinline__ float* lb() const { return (float*)(a->ws + WS_LB); }
    __device__ __forceinline__ float* biasq() const { return (float*)(a->ws + WS_BIASQ); }
    __device__ __forceinline__ float* ssqp() const { return (float*)(a->ws + WS_SSQ); }
    __device__ __forceinline__ float* sega() const { return (float*)(a->ws + WS_SEGA); }
    __device__ __forceinline__ float* segu() const { return (float*)(a->ws + WS_SEG); }
    __device__ __forceinline__ float* of() const { return (float*)(a->ws + WS_BUFB); }
    __device__ __forceinline__ float* scores() const { return (float*)(a->ws + WS_BIG); }
    __device__ __forceinline__ float* wsel() const { return (float*)(a->ws + WS_W); }
    __device__ __forceinline__ int* esel() const { return (int*)(a->ws + WS_E); }
    __device__ __forceinline__ bf16* Win_t() const { return (bf16*)(a->ws + WS_WIN); }
    __device__ __forceinline__ bf16* Wout_t() const { return (bf16*)(a->ws + WS_WOUT); }
    __device__ __forceinline__ bf16* Wqk_t() const { return (bf16*)(a->ws + WS_WQK); }
    __device__ __forceinline__ bf16* Ub() const { return (bf16*)(a->ws + WS_UT); }
    __device__ __forceinline__ bf16* Vb() const { return (bf16*)(a->ws + WS_VT); }
    __device__ __forceinline__ bf16* bufA() const { return (bf16*)(a->ws + WS_BUFA); }
    __device__ __forceinline__ bf16* hg() const { return (bf16*)(a->ws + WS_BUFB); }
    __device__ __forceinline__ bf16* proj() const { return (bf16*)(a->ws + WS_BIG); }
    __device__ __forceinline__ float* coef() const { return (float*)(a->ws + WS_BUFA); }
    __device__ __forceinline__ float* rstd() const { return (float*)(a->ws + WS_RSTD); }
    __device__ __forceinline__ float* pact() const { return (float*)(a->ws + WS_PACT); }
    __device__ __forceinline__ float* ybuf() const { return (float*)(a->ws + WS_Y); }
    __device__ __forceinline__ unsigned char* U8() const { return (unsigned char*)(a->ws + WS_UT); }
    __device__ __forceinline__ unsigned char* V8() const { return (unsigned char*)(a->ws + WS_VT); }
    __device__ __forceinline__ unsigned* ctl() const { return (unsigned*)(a->ws + WS_CTL); }
};

__device__ __forceinline__ void p0_gemv(Frame& F) {
    LAS float* cact = (LAS float*)(F.lds);
    LAS float* red = (LAS float*)(F.lds + 16384);
    for (int i = F.tid; i < 4096; i += NTHR) { const float c = F.c()[i]; cact[i] = c * sigmoidf_(c); }
    __syncthreads();
    for (int item = F.bid; item < 128; item += F.G) {
        const int col0 = item * 64; const float* W; int N, cc;
        if (col0 < 6144) { W = F.ada_w(); N = 6144; cc = col0; } else { W = F.fada_w(); N = 2048; cc = col0 - 6144; }
        const float* wp = W + (size_t)(F.wave * 128) * N + cc + F.lane;
        float a0 = 0.f, a1 = 0.f, a2 = 0.f, a3 = 0.f;
#pragma unroll 8
        for (int k = 0; k < 128; ++k) { const float w = wp[(size_t)k * N]; const int kk = F.wave * 128 + k;
            a0 += cact[kk] * w; a1 += cact[1024 + kk] * w; a2 += cact[2048 + kk] * w; a3 += cact[3072 + kk] * w; }
        red[(F.wave * 4 + 0) * 64 + F.lane] = a0; red[(F.wave * 4 + 1) * 64 + F.lane] = a1; red[(F.wave * 4 + 2) * 64 + F.lane] = a2; red[(F.wave * 4 + 3) * 64 + F.lane] = a3;
        __syncthreads();
        if (F.tid < 256) { const int b = F.tid >> 6, l = F.tid & 63; float s = 0.f;
#pragma unroll
            for (int w = 0; w < 8; ++w) s += red[(w * 4 + b) * 64 + l];
            if (col0 < 6144) F.mod()[b * 6144 + cc + l] = s + F.ada_b()[cc + l]; else F.fmod()[b * 2048 + cc + l] = s + F.fada_b()[cc + l]; }
        __syncthreads();
    }
}
__device__ __forceinline__ void p0_transpose_item(const float* W, int K, int N, bf16* WT, LAS float* scr, int item, int lane) {
    const int nblk = N / 32, kb = item / nblk, nb = item % nblk, k0 = 64 * kb, n0 = 32 * nb;
#pragma unroll 8
    for (int i = 0; i < 32; ++i) { const int kk = 2 * i + (lane >> 5); scr[kk * 33 + (lane & 31)] = W[(size_t)(k0 + kk) * N + n0 + (lane & 31)]; }
    asm volatile("s_waitcnt lgkmcnt(0)" ::: "memory");
    const int c = lane & 7;
#pragma unroll
    for (int j = 0; j < 4; ++j) { const int n = (lane >> 3) + 8 * j; const LAS float* s = scr + (8 * c) * 33 + n;
        v4u o; o.x = pk2(s[0 * 33], s[1 * 33]); o.y = pk2(s[2 * 33], s[3 * 33]); o.z = pk2(s[4 * 33], s[5 * 33]); o.w = pk2(s[6 * 33], s[7 * 33]);
        *(v4u*)(WT + (size_t)(n0 + n) * K + k0 + 8 * c) = o; }
    asm volatile("s_waitcnt lgkmcnt(0)" ::: "memory");
}
__device__ __forceinline__ void p0_wqk_item(Frame& F, int item) {
    const int jq = item & 7, kb = (item >> 3) & 15, hh = item >> 7, h = hh >> 1, half = hh & 1;
    const float* keys = (half ? F.keys2() : F.keys1()) + (size_t)(jq * 16) * 128;
    const int k = kb * 64 + F.lane;
    const float* wrow = F.wq() + (size_t)k * 2048 + h * 256 + half * 128;
    float acc[16];
#pragma unroll
    for (int j = 0; j < 16; ++j) acc[j] = 0.f;
#pragma unroll 4
    for (int d = 0; d < 128; d += 4) {
        const f32x4 a = *(const f32x4*)(wrow + d);
#pragma unroll
        for (int j = 0; j < 16; ++j) { const float* kp = keys + j * 128 + d; acc[j] += a[0] * kp[0] + a[1] * kp[1] + a[2] * kp[2] + a[3] * kp[3]; }
    }
    bf16* o = F.Wqk_t() + (size_t)(h * 256 + half * 128 + jq * 16) * 1024 + k;
#pragma unroll
    for (int j = 0; j < 16; ++j) o[(size_t)j * 1024] = (bf16)f2bf(acc[j]);
}
__device__ __forceinline__ void p0_prologue(Frame& F) {
    if (F.bid < 128) p0_gemv(F);
    if (F.bid == 128 % F.G) { const int i = F.tid;
        F.lb()[i] = __builtin_amdgcn_rcpf(1.0f + __expf(F.lbg_f()[512 + i] - F.lbg_f()[i]));
        F.lb()[512 + i] = __builtin_amdgcn_rcpf(1.0f + __expf(F.lbg_b()[512 + i] - F.lbg_b()[i])); }
    LAS float* scr = (LAS float*)(F.lds + 32768 + F.wave * 8704);
    const int gw = F.wave * F.G + F.bid, NGW = F.G * NWAVES;
    constexpr int I_QK = 2048, I_IN = (D / 64) * (NIN / 32), I_OUT = (D / 64) * (D / 32), I_TAB = 2 * 16384 / 4;
    constexpr int NITEMS = I_QK + I_IN + I_OUT + I_TAB;
    for (int it = gw; it < NITEMS; it += NGW) {
        int r = it;
        if (r < I_QK) { p0_wqk_item(F, r); continue; } r -= I_QK;
        if (r < I_IN) { p0_transpose_item(F.w_in(), D, NIN, F.Win_t(), scr, r, F.lane); continue; } r -= I_IN;
        if (r < I_OUT) { p0_transpose_item(F.w_out(), D, D, F.Wout_t(), scr, r, F.lane); continue; } r -= I_OUT;
        { const int tab = r >= 4096, rr = (tab ? r - 4096 : r) * 4; const float* src = (tab ? F.vtab() : F.utab()) + (size_t)rr * 1024; unsigned char* dst = tab ? F.V8() : F.U8();
          const float sc = tab ? VSCALE : USCALE;
#pragma unroll
          for (int q = 0; q < 16; ++q) { const int row = rr + (q >> 2), qq = q & 3; const f32x4 v = *(const f32x4*)(src + (q >> 2) * 1024 + qq * 256 + 4 * F.lane) * sc;
              int pk = __builtin_amdgcn_cvt_pk_fp8_f32(v[0], v[1], 0, false); pk = __builtin_amdgcn_cvt_pk_fp8_f32(v[2], v[3], pk, true);
              const int sl = 2 * qq + (F.lane >> 5);
              *(int*)(dst + ((size_t)sl * 16384 + row) * CSL + 4 * (F.lane & 31)) = pk; } }
    }
}

__device__ __forceinline__ void p1_norm(Frame& F) {
    const int gwc = F.bid * NWAVES + F.wave, NGW = F.G * NWAVES;
    for (int row0 = gwc * 16; row0 < T; row0 += NGW * 16) {
        const int b = row0 >> 13; const float* mb = F.mod() + b * 6144;
        f32x4 ca[4], cb[4];
#pragma unroll
        for (int j = 0; j < 4; ++j) { const int k = 256 * j + 4 * F.lane; const f32x4 g = *(const f32x4*)(F.g_mix() + k), s = *(const f32x4*)(mb + 1024 + k); ca[j] = g * (s + 1.0f); cb[j] = *(const f32x4*)(mb + k); }
        for (int r = 0; r < 16; ++r) { const float* xr = F.x() + (size_t)(row0 + r) * D;
            f32x4 v[4]; float ss = 0.f;
#pragma unroll
            for (int j = 0; j < 4; ++j) { v[j] = *(const f32x4*)(xr + 256 * j + 4 * F.lane); ss += v[j][0] * v[j][0] + v[j][1] * v[j][1] + v[j][2] * v[j][2] + v[j][3] * v[j][3]; }
            const float rstd = __builtin_amdgcn_rsqf(wave_sum(ss) * (1.0f / D) + EPS);
            bf16* o = F.bufA() + (size_t)(row0 + r) * D;
#pragma unroll
            for (int j = 0; j < 4; ++j) { const f32x4 y = v[j] * rstd * ca[j] + cb[j]; v2u w; w.x = pk2(y[0], y[1]); w.y = pk2(y[2], y[3]); *(v2u*)(o + 256 * j + 4 * F.lane) = w; } }
    }
    const int gw = F.wave * F.G + F.bid;
    for (int n = gw; n < NQK; n += NGW) {
        const v4u w0 = *(const v4u*)(F.Wqk_t() + (size_t)n * 1024 + 8 * F.lane), w1 = *(const v4u*)(F.Wqk_t() + (size_t)n * 1024 + 512 + 8 * F.lane);
        float wv[16];
#pragma unroll
        for (int i = 0; i < 4; ++i) { wv[2 * i] = bflo(w0[i]); wv[2 * i + 1] = bfhi(w0[i]); wv[8 + 2 * i] = bflo(w1[i]); wv[8 + 2 * i + 1] = bfhi(w1[i]); }
#pragma unroll
        for (int b = 0; b < 4; ++b) { const float* sh2 = F.mod() + b * 6144 + 3072; float s = 0.f;
#pragma unroll
            for (int i = 0; i < 8; ++i) s += wv[i] * sh2[8 * F.lane + i] + wv[8 + i] * sh2[512 + 8 * F.lane + i];
            s = wave_sum(s); if (F.lane == 0) F.biasq()[b * 2048 + n] = s; }
    }
}

__device__ __forceinline__ void conv_item(Frame& F, int item, const float (&cw)[CW], float cbias) {
    LAS bf16* hbuf = (LAS bf16*)(F.lds);
    LAS float* ybuf = (LAS float*)(F.lds + 65536);
    const int tok0 = item * 32, b = tok0 >> 13, t0 = tok0 & (SEQ - 1), c = F.tid;
    for (int r = 0; r < 62; ++r) { const int t = t0 - CPAD + r; float h = 0.f;
        if (t >= 0 && t < SEQ) { const bf16* pr = F.proj() + (size_t)(b * SEQ + t) * NIN; const float a = bf2f(pr[2560 + c]), g = bf2f(pr[3072 + c]); h = a * sigmoidf_(g); }
        hbuf[r * 512 + c] = (bf16)f2bf(h); }
    __syncthreads();
    float hv[62];
#pragma unroll
    for (int r = 0; r < 62; ++r) hv[r] = bf2f(hbuf[r * 512 + c]);
#pragma unroll
    for (int tt = 0; tt < 32; ++tt) { float acc = cbias;
#pragma unroll
        for (int j = 0; j < CW; ++j) acc += cw[j] * hv[tt + j];
        ybuf[tt * 512 + c] = acc; }
    __syncthreads();
#pragma unroll
    for (int q = 0; q < 4; ++q) { const int tt = F.wave * 4 + q;
        const f32x4 y0 = *(LAS const f32x4*)(ybuf + tt * 512 + 4 * F.lane), y1 = *(LAS const f32x4*)(ybuf + tt * 512 + 256 + 4 * F.lane);
        const float mean = wave_sum((y0[0] + y0[1] + y0[2] + y0[3]) + (y1[0] + y1[1] + y1[2] + y1[3])) * (1.0f / DC);
        const f32x4 d0 = y0 - mean, d1 = y1 - mean;
        const float var = wave_sum((d0[0] * d0[0] + d0[1] * d0[1] + d0[2] * d0[2] + d0[3] * d0[3]) + (d1[0] * d1[0] + d1[1] * d1[1] + d1[2] * d1[2] + d1[3] * d1[3])) * (1.0f / DC);
        const float rstd = __builtin_amdgcn_rsqf(var + EPS);
        const f32x4 g0 = *(const f32x4*)(F.cln_g() + 4 * F.lane), g1 = *(const f32x4*)(F.cln_g() + 256 + 4 * F.lane), b0 = *(const f32x4*)(F.cln_b() + 4 * F.lane), b1 = *(const f32x4*)(F.cln_b() + 256 + 4 * F.lane);
        f32x4 z0 = d0 * rstd * g0 + b0, z1 = d1 * rstd * g1 + b1;
#pragma unroll
        for (int i = 0; i < 4; ++i) { z0[i] = z0[i] * sigmoidf_(z0[i]); z1[i] = z1[i] * sigmoidf_(z1[i]); }
        bf16* o = F.bufA() + (size_t)(tok0 + tt) * D + 512;
        v2u w0, w1; w0.x = pk2(z0[0], z0[1]); w0.y = pk2(z0[2], z0[3]); w1.x = pk2(z1[0], z1[1]); w1.y = pk2(z1[2], z1[3]);
        *(v2u*)(o + 4 * F.lane) = w0; *(v2u*)(o + 256 + 4 * F.lane) = w1; }
    __syncthreads();
}

constexpr int PQ = 272, PT = 144;
constexpr int HL_QR = 0, HL_KR = 17408, HL_QE = 34816, HL_KET = 52224, HL_VT = 70656, HL_SCM = 89088, HL_ST = 98304, HL_PBLK = 133120, HL_AV = 135168, HL_RS = 135680;
__device__ __forceinline__ bf16x8 ldf(LAS const unsigned char* base, int row, int pitch, int kbyte) { return *(LAS const bf16x8*)(base + row * pitch + kbyte); }
#define MFMA32(a, b, c) __builtin_amdgcn_mfma_f32_32x32x16_bf16((a), (b), (c), 0, 0, 0)

template <bool FULL, int MODE>
__device__ __forceinline__ void hgrn_chunk(Frame& F, int b, int h, int dir, int chunk, f32x16 (&accS)[2], float lbv) {
    LAS unsigned char* lds = F.lds;
    const int w = F.wave, r = F.lane & 31, hh = F.lane >> 5;
    const int col = (w & 1) * 64 + F.lane, pb4 = w >> 1, p0 = pb4 * 16;
    const size_t tokbase = (size_t)b * SEQ + (size_t)chunk * CHK;
    {
        const int zoff = dir ? 1024 : 512;
        float fz[16], cp[16]; unsigned vraw[16]; float qv[16];
#pragma unroll
        for (int i = 0; i < 16; ++i) { const int p = p0 + i, tr = dir ? (63 - p) : p; const bf16* q = F.proj() + (tokbase + tr) * NIN + h * HD;
            fz[i] = bf2f(q[zoff + col]); vraw[i] = q[1536 + col]; if (FULL) qv[i] = bf2f(q[col]); }
        float run = 1.f;
#pragma unroll
        for (int i = 0; i < 16; ++i) { const float f = lbv + (1.0f - lbv) * sigmoidf_(fz[i]); fz[i] = f; run *= f; cp[i] = run; }
        LAS float* pblk = (LAS float*)(lds + HL_PBLK);
        pblk[pb4 * 128 + col] = run;
        __syncthreads();
        const float b0 = pblk[col], b1 = pblk[128 + col], b2 = pblk[256 + col], b3 = pblk[384 + col];
        const float pre = pb4 == 0 ? 1.f : (pb4 == 1 ? b0 : (pb4 == 2 ? b0 * b1 : b0 * b1 * b2));
        const float pref = b0 * b1, tot = pref * b2 * b3, ipref = __builtin_amdgcn_rcpf(pref);
        if (pb4 == 0) ((LAS float*)(lds + HL_AV))[col] = tot;
        float ke[16];
#pragma unroll
        for (int i = 0; i < 16; ++i) { const float P = pre * cp[i], iP = __builtin_amdgcn_rcpf(P), k = 1.0f - fz[i];
            ke[i] = k * tot * iP;
            if (FULL) { const int p = p0 + i; const float qs = qv[i] * sigmoidf_(qv[i]), qe = qs * P;
                *(LAS bf16*)(lds + HL_QE + p * PQ + col * 2) = (bf16)f2bf(qe);
                *(LAS bf16*)(lds + HL_QR + p * PQ + col * 2) = (bf16)f2bf(qe * ipref);
                *(LAS bf16*)(lds + HL_KR + p * PQ + col * 2) = (bf16)f2bf(k * pref * iP); } }
        v4u k0, k1, v0, v1;
        k0.x = pk2(ke[0], ke[1]); k0.y = pk2(ke[2], ke[3]); k0.z = pk2(ke[4], ke[5]); k0.w = pk2(ke[6], ke[7]);
        k1.x = pk2(ke[8], ke[9]); k1.y = pk2(ke[10], ke[11]); k1.z = pk2(ke[12], ke[13]); k1.w = pk2(ke[14], ke[15]);
        v0.x = vraw[0] | (vraw[1] << 16); v0.y = vraw[2] | (vraw[3] << 16); v0.z = vraw[4] | (vraw[5] << 16); v0.w = vraw[6] | (vraw[7] << 16);
        v1.x = vraw[8] | (vraw[9] << 16); v1.y = vraw[10] | (vraw[11] << 16); v1.z = vraw[12] | (vraw[13] << 16); v1.w = vraw[14] | (vraw[15] << 16);
        *(LAS v4u*)(lds + HL_KET + col * PT + p0 * 2) = k0; *(LAS v4u*)(lds + HL_KET + col * PT + p0 * 2 + 16) = k1;
        *(LAS v4u*)(lds + HL_VT + col * PT + p0 * 2) = v0; *(LAS v4u*)(lds + HL_VT + col * PT + p0 * 2 + 16) = v1;
    }
    __syncthreads();
    const int pbO = w & 1, vb = w >> 1;
    f32x16 accO, accU[2];
#pragma unroll
    for (int i = 0; i < 16; ++i) { accO[i] = 0.f; accU[0][i] = 0.f; accU[1][i] = 0.f; }
    if (FULL) {
        if (w < 3) { const int pbS = (w + 1) >> 1, sbS = (w == 2) ? 1 : 0; f32x16 sc;
#pragma unroll
            for (int i = 0; i < 16; ++i) sc[i] = 0.f;
#pragma unroll
            for (int s = 0; s < 8; ++s) sc = MFMA32(ldf(lds + HL_QR, pbS * 32 + r, PQ, 32 * s + 16 * hh), ldf(lds + HL_KR, sbS * 32 + r, PQ, 32 * s + 16 * hh), sc);
#pragma unroll
            for (int i = 0; i < 16; ++i) { const int p = pbS * 32 + (i & 3) + 8 * (i >> 2) + 4 * hh, s = sbS * 32 + r;
                *(LAS bf16*)(lds + HL_SCM + p * PT + s * 2) = (bf16)f2bf(s <= p ? sc[i] : 0.f); } }
        __builtin_amdgcn_sched_barrier(0);
#pragma unroll
        for (int s = 0; s < 8; ++s) accO = MFMA32(ldf(lds + HL_QE, pbO * 32 + r, PQ, 32 * s + 16 * hh), ldf(lds + HL_ST, vb * 32 + r, PQ, 32 * s + 16 * hh), accO);
        __builtin_amdgcn_sched_barrier(0);
    }
#pragma unroll
    for (int i = 0; i < 2; ++i) { const int db = 2 * (w & 1) + i;
#pragma unroll
        for (int s = 0; s < 4; ++s) accU[i] = MFMA32(ldf(lds + HL_VT, vb * 32 + r, PT, 32 * s + 16 * hh), ldf(lds + HL_KET, db * 32 + r, PT, 32 * s + 16 * hh), accU[i]); }
    __builtin_amdgcn_sched_barrier(0);
    if (FULL) __syncthreads();
    if (FULL) {
        for (int sb = 0; sb <= pbO; ++sb)
#pragma unroll
            for (int s2 = 0; s2 < 2; ++s2) accO = MFMA32(ldf(lds + HL_SCM, pbO * 32 + r, PT, 64 * sb + 32 * s2 + 16 * hh), ldf(lds + HL_VT, vb * 32 + r, PT, 64 * sb + 32 * s2 + 16 * hh), accO);
        const int v = vb * 32 + r;
        const long loff = (MODE == 0 ? 4 * hh : -4 * hh);
        if (MODE == 0) {
            float* ob = F.of() + (tokbase + pbO * 32) * DH + h * HD;
#pragma unroll
            for (int i = 0; i < 16; ++i) { const int ci = (i & 3) + 8 * (i >> 2); (ob + (size_t)ci * DH)[loff * DH + v] = accO[i]; }
        } else {
            LAS float* rs = (LAS float*)(lds + HL_RS);
            const size_t tb = tokbase + 63 - pbO * 32;
            float ov[16];
#pragma unroll
            for (int i = 0; i < 16; ++i) { const int ci = (i & 3) + 8 * (i >> 2), p = pbO * 32 + ci + 4 * hh;
                ov[i] = accO[i] + (F.of() + (tb - ci) * DH + h * HD)[loff * DH + v]; float ss = ov[i] * ov[i];
                ss += __shfl_xor(ss, 1); ss += __shfl_xor(ss, 2); ss += __shfl_xor(ss, 4); ss += __shfl_xor(ss, 8); ss += __shfl_xor(ss, 16);
                if (r == 0) rs[p * 4 + vb] = ss; }
            __syncthreads();
            const float ng = F.hnorm_g()[h * HD + v];
#pragma unroll
            for (int i = 0; i < 16; ++i) { const int ci = (i & 3) + 8 * (i >> 2), p = pbO * 32 + ci + 4 * hh;
                const f32x4 q = *(LAS const f32x4*)(rs + p * 4);
                const float rstd = __builtin_amdgcn_rsqf((q[0] + q[1] + q[2] + q[3]) * (1.0f / HD) + EPS);
                const float g = bf2f((F.proj() + (tb - ci) * NIN + 2048 + h * HD)[loff * NIN + v]);
                (F.bufA() + (tb - ci) * D + h * HD)[loff * D + v] = (bf16)f2bf(ov[i] * rstd * ng * g * sigmoidf_(g)); }
        }
    }
    {
        const LAS float* av = (const LAS float*)(lds + HL_AV);
#pragma unroll
        for (int i = 0; i < 2; ++i) { const int db = 2 * (w & 1) + i; const float a = av[db * 32 + r];
#pragma unroll
            for (int j = 0; j < 16; ++j) { const float sn = accS[i][j] * a + accU[i][j]; accS[i][j] = sn;
                if (FULL) { const int vv = vb * 32 + (j & 3) + 8 * (j >> 2) + 4 * hh; *(LAS bf16*)(lds + HL_ST + vv * PQ + (db * 32 + r) * 2) = (bf16)f2bf(sn); } } }
    }
    __syncthreads();
}
__device__ __forceinline__ void h1_item(Frame& F, int item) {
    const int seg = item & 15, dir = (item >> 4) & 1, h = (item >> 5) & 3, b = item >> 7;
    const int col = F.tid & 127; const float lbv = F.lb()[dir * 512 + h * HD + col];
    f32x16 accS[2];
#pragma unroll
    for (int i = 0; i < 16; ++i) { accS[0][i] = 0.f; accS[1][i] = 0.f; }
    float atot = 1.f;
    for (int c = 0; c < SEGC; ++c) { const int chunk = seg * SEGC + (dir ? (SEGC - 1 - c) : c);
        hgrn_chunk<false, 0>(F, b, h, dir, chunk, accS, lbv);
        atot *= ((const LAS float*)(F.lds + HL_AV))[col]; }
    if (F.tid < 128) F.sega()[(size_t)item * 128 + col] = atot;
    const int w = F.wave, r = F.lane & 31, hh = F.lane >> 5, vb = w >> 1;
    float* U = F.segu() + (size_t)item * 16384;
#pragma unroll
    for (int i = 0; i < 2; ++i)
#pragma unroll
        for (int j = 0; j < 16; ++j) (U + (i * 16 + j) * NTHR)[F.tid] = accS[i][j];
}
__device__ __forceinline__ void h2_init_state(Frame& F, int b, int h, int dir, int seg, f32x16 (&accS)[2]) {
    const int w = F.wave, r = F.lane & 31, hh = F.lane >> 5, vb = w >> 1;
#pragma unroll
    for (int i = 0; i < 16; ++i) { accS[0][i] = 0.f; accS[1][i] = 0.f; }
    const int base = ((b * 4 + h) * 2 + dir) * 16;
    const int n = dir ? (NSEG - 1 - seg) : seg;
    for (int q = 0; q < n; ++q) { const int s = dir ? (NSEG - 1 - q) : q;
        const float* U = F.segu() + (size_t)(base + s) * 16384; const float* A = F.sega() + (size_t)(base + s) * 128;
#pragma unroll
        for (int i = 0; i < 2; ++i) { const int db = 2 * (w & 1) + i; const float a = A[db * 32 + r];
#pragma unroll
            for (int j = 0; j < 16; ++j) accS[i][j] = accS[i][j] * a + (U + (i * 16 + j) * NTHR)[F.tid]; } }
#pragma unroll
    for (int i = 0; i < 2; ++i) { const int db = 2 * (w & 1) + i;
#pragma unroll
        for (int j = 0; j < 16; ++j) { const int vv = vb * 32 + (j & 3) + 8 * (j >> 2) + 4 * hh; *(LAS bf16*)(F.lds + HL_ST + vv * PQ + (db * 32 + r) * 2) = (bf16)f2bf(accS[i][j]); } }
    __syncthreads();
}
__device__ __forceinline__ void h2_item(Frame& F, int item) {
    const int seg = item & 15, h = (item >> 4) & 3, b = item >> 6;
    const int col = F.tid & 127;
    f32x16 accS[2];
    { const float lbv = F.lb()[h * HD + col];
      h2_init_state(F, b, h, 0, seg, accS);
      for (int c = 0; c < SEGC; ++c) hgrn_chunk<true, 0>(F, b, h, 0, seg * SEGC + c, accS, lbv); }
    asm volatile("s_waitcnt vmcnt(0)" ::: "memory");
    __syncthreads();
    { const float lbv = F.lb()[512 + h * HD + col];
      h2_init_state(F, b, h, 1, seg, accS);
      for (int c = 0; c < SEGC; ++c) hgrn_chunk<true, 1>(F, b, h, 1, seg * SEGC + (SEGC - 1 - c), accS, lbv); }
}

__device__ __forceinline__ unsigned f2key(float f) { const unsigned u = __builtin_bit_cast(unsigned, f); return (u & 0x80000000u) ? ~u : (u | 0x80000000u); }
__device__ __forceinline__ float key2f(unsigned k) { const unsigned u = (k & 0x80000000u) ? (k & 0x7fffffffu) : ~k; return __builtin_bit_cast(float, u); }
__device__ __forceinline__ unsigned umax_(unsigned a, unsigned b) { return a > b ? a : b; }
__device__ __forceinline__ unsigned umin_(unsigned a, unsigned b) { return a < b ? a : b; }
__device__ __forceinline__ void sort16(unsigned (&a)[16]) {
#pragma unroll
    for (int k = 2; k <= 16; k <<= 1)
#pragma unroll
        for (int j = k >> 1; j > 0; j >>= 1)
#pragma unroll
            for (int i = 0; i < 16; ++i) { const int l = i ^ j; if (l > i) { const bool desc = ((i & k) == 0); const unsigned x = a[i], y = a[l], mx = umax_(x, y), mn = umin_(x, y); a[i] = desc ? mx : mn; a[l] = desc ? mn : mx; } }
}
__device__ __forceinline__ void merge16(unsigned (&a)[16], const unsigned (&b)[16]) {
#pragma unroll
    for (int i = 0; i < 16; ++i) a[i] = umax_(a[i], b[15 - i]);
#pragma unroll
    for (int j = 8; j > 0; j >>= 1)
#pragma unroll
        for (int i = 0; i < 16; ++i) { const int l = i ^ j; if (l > i) { const unsigned x = a[i], y = a[l]; a[i] = umax_(x, y); a[l] = umin_(x, y); } }
}
__device__ __forceinline__ unsigned dpp_swap1(unsigned v) { return (unsigned)__builtin_amdgcn_update_dpp(0, (int)v, 0xB1, 0xF, 0xF, false); }
__device__ __forceinline__ unsigned pick_byte(const unsigned (&pk)[4], unsigned a) {
    const unsigned wsel = a >> 2; unsigned v = wsel == 0 ? pk[0] : (wsel == 1 ? pk[1] : (wsel == 2 ? pk[2] : pk[3]));
    return (v >> ((a & 3u) * 8u)) & 0xffu;
}
__device__ __forceinline__ void p7_topk(Frame& F) {
    const int NT = T * PHEADS * 2;
    for (int g0 = (F.bid * NWAVES + F.wave) * 64; g0 < NT; g0 += F.G * NTHR) {
        const int g = g0 + F.lane; const float* sp = F.scores() + (size_t)g * 128;
        unsigned top[16];
#pragma unroll
        for (int grp = 0; grp < 8; ++grp) { unsigned k[16];
#pragma unroll
            for (int q = 0; q < 4; ++q) { const f32x4 v = *(const f32x4*)(sp + grp * 16 + q * 4);
#pragma unroll
                for (int e = 0; e < 4; ++e) { const int j = grp * 16 + q * 4 + e; k[q * 4 + e] = (f2key(v[e]) & ~0x7fu) | (unsigned)(127 - j); } }
            sort16(k);
            if (grp == 0) {
#pragma unroll
                for (int i = 0; i < 16; ++i) top[i] = k[i];
            } else merge16(top, k); }
        float vO[16], vP[16]; unsigned iOpk[4] = {0u, 0u, 0u, 0u}, iPpk[4] = {0u, 0u, 0u, 0u};
#pragma unroll
        for (int i = 0; i < 16; ++i) { const unsigned t = top[i], tp = dpp_swap1(t);
            vO[i] = key2f(t & ~0x7fu); vP[i] = key2f(tp & ~0x7fu);
            iOpk[i >> 2] |= (127u - (t & 0x7fu)) << ((i & 3) * 8); iPpk[i >> 2] |= (127u - (tp & 0x7fu)) << ((i & 3) * 8); }
        unsigned R[16], G1[16], G2[16], G3[16];
#define CAND(a, b) ((f2key(vO[a] + vP[b]) & ~0xffu) | (unsigned)(((a) << 4) | (b)))
#pragma unroll
        for (int i = 0; i < 16; ++i) R[i] = CAND(0, i);
        G1[0] = CAND(1, 0); G1[1] = CAND(1, 1); G1[2] = CAND(1, 2); G1[3] = CAND(1, 3); G1[4] = CAND(1, 4); G1[5] = CAND(1, 5); G1[6] = CAND(1, 6); G1[7] = CAND(1, 7);
        G1[8] = CAND(2, 0); G1[9] = CAND(2, 1); G1[10] = CAND(2, 2); G1[11] = CAND(2, 3); G1[12] = CAND(2, 4); G1[13] = CAND(3, 0); G1[14] = CAND(3, 1); G1[15] = CAND(3, 2);
        G2[0] = CAND(3, 3); G2[1] = CAND(4, 0); G2[2] = CAND(4, 1); G2[3] = CAND(4, 2); G2[4] = CAND(5, 0); G2[5] = CAND(5, 1); G2[6] = CAND(6, 0); G2[7] = CAND(6, 1);
        G2[8] = CAND(7, 0); G2[9] = CAND(7, 1); G2[10] = CAND(8, 0); G2[11] = CAND(9, 0); G2[12] = CAND(10, 0); G2[13] = CAND(11, 0); G2[14] = CAND(12, 0); G2[15] = CAND(13, 0);
        G3[0] = CAND(14, 0); G3[1] = CAND(15, 0);
#pragma unroll
        for (int i = 2; i < 16; ++i) G3[i] = 0u;
#undef CAND
        sort16(G1); sort16(G2); sort16(G3);
        merge16(R, G1); merge16(R, G2); merge16(R, G3);
        float sc[16], ex[16]; float sum = 0.f; unsigned eid[16];
        const bool tab0 = ((g & 1) == 0);
#pragma unroll
        for (int i = 0; i < 16; ++i) { sc[i] = key2f(R[i] & ~0xffu); const unsigned a = (R[i] >> 4) & 15u, bb = R[i] & 15u;
            const unsigned io = pick_byte(iOpk, a), ip = pick_byte(iPpk, bb);
            eid[i] = tab0 ? (io * 128u + ip) : (ip * 128u + io); }
#pragma unroll
        for (int i = 0; i < 16; ++i) { ex[i] = __expf(sc[i] - sc[0]); sum += ex[i]; }
        const float inv = 1.0f / sum;
        if (tab0) { const size_t o = (size_t)(g >> 1) * 16;
#pragma unroll
            for (int q = 0; q < 4; ++q) { v4u ev; ev.x = eid[4 * q]; ev.y = eid[4 * q + 1]; ev.z = eid[4 * q + 2]; ev.w = eid[4 * q + 3]; *(v4u*)(F.esel() + o + 4 * q) = ev;
                f32x4 wv; wv[0] = ex[4 * q] * inv; wv[1] = ex[4 * q + 1] * inv; wv[2] = ex[4 * q + 2] * inv; wv[3] = ex[4 * q + 3] * inv; *(f32x4*)(F.wsel() + o + 4 * q) = wv; } }
    }
}

#define DPP_ADD(s, ctrl) ((s) + __builtin_bit_cast(float, __builtin_amdgcn_update_dpp(0, __builtin_bit_cast(int, (s)), (ctrl), 0xF, 0xF, false)))
__device__ __forceinline__ void cvt16(const v4u& u, f32x2_ (&f)[8]) {
#pragma unroll
    for (int i = 0; i < 4; ++i) { f[2 * i] = __builtin_amdgcn_cvt_pk_f32_fp8((int)u[i], false); f[2 * i + 1] = __builtin_amdgcn_cvt_pk_f32_fp8((int)u[i], true); }
}
constexpr int PITEM = 8, NPITEM = T / PITEM;
__device__ __forceinline__ int peer_next(unsigned* q, int lane) {
    int idx = 0; if (lane == 0) idx = (int)__hip_atomic_fetch_add(q, 1u, __ATOMIC_RELAXED, __HIP_MEMORY_SCOPE_AGENT);
    return __builtin_amdgcn_readfirstlane(idx);
}
#define PEER_SB() __builtin_amdgcn_sched_barrier(0)
__device__ __forceinline__ void p8_dots(const v4u (&ud)[16], const f32x2_ (&hn)[8], int c8, float& r0, float& r1) {
#pragma unroll
    for (int i = 0; i < 16; ++i) { f32x2_ uf[8]; cvt16(ud[i], uf); f32x2_ s2 = uf[0] * hn[0];
#pragma unroll
        for (int k = 1; k < 8; ++k) s2 += uf[k] * hn[k];
        float sm = s2[0] + s2[1];
        sm = DPP_ADD(sm, 0xB1); sm = DPP_ADD(sm, 0x4E); sm = DPP_ADD(sm, 0x141);
        if (i < 8) r0 = (c8 == i) ? sm : r0; else r1 = (c8 == i - 8) ? sm : r1;
        PEER_SB(); }
}
__device__ __forceinline__ void p8_item(Frame& F, int sl, int item) {
    const int c8 = F.lane & 7, q8 = F.lane >> 3, t0 = item * PITEM, b = t0 >> 13;
    const float* sh2 = F.mod() + b * 6144 + 3072 + sl * CSL + 16 * c8;
    float shv[16];
#pragma unroll
    for (int k = 0; k < 4; ++k) { const f32x4 v = *(const f32x4*)(sh2 + 4 * k); shv[4 * k] = v[0]; shv[4 * k + 1] = v[1]; shv[4 * k + 2] = v[2]; shv[4 * k + 3] = v[3]; }
    const unsigned char* ub = F.U8() + (size_t)sl * 16384 * CSL + 16 * c8;
    const int* ep = F.esel() + (size_t)t0 * NSEL + 16 * q8;
    const bf16* hp = F.hg() + (size_t)t0 * D + sl * CSL + 16 * c8;
    const float* rp = F.rstd() + t0;
    float* po = F.pact() + ((size_t)t0 * NSL + sl) * NSEL + 16 * q8 + c8;
    v4u ea[4], eb[4], udA[16], udB[16];
#define P8_LDE(dst, tt) do { _Pragma("unroll") for (int k = 0; k < 4; ++k) dst[k] = __builtin_nontemporal_load((const v4u*)(ep + (tt) * NSEL + 4 * k)); } while (0)
#define P8_GATHER(dst, e) do { _Pragma("unroll") for (int i = 0; i < 16; ++i) dst[i] = *(const v4u*)(ub + (size_t)e[i >> 2][i & 3] * CSL); } while (0)
#define P8_HN(tt) f32x2_ hn[8]; { const v4u h0 = __builtin_nontemporal_load((const v4u*)(hp + (size_t)(tt) * D)), h1 = __builtin_nontemporal_load((const v4u*)(hp + (size_t)(tt) * D + 8)); const float rstd = rp[tt]; \
        _Pragma("unroll") for (int k = 0; k < 4; ++k) { hn[k][0] = bflo(h0[k]) * rstd + shv[2 * k]; hn[k][1] = bfhi(h0[k]) * rstd + shv[2 * k + 1]; \
            hn[4 + k][0] = bflo(h1[k]) * rstd + shv[8 + 2 * k]; hn[4 + k][1] = bfhi(h1[k]) * rstd + shv[8 + 2 * k + 1]; } }
    P8_LDE(ea, 0); P8_LDE(eb, 1);
    P8_GATHER(udA, ea);
    for (int tt = 0; tt < PITEM; tt += 2) {
        P8_GATHER(udB, eb);
        if (tt + 2 < PITEM) P8_LDE(ea, tt + 2);
        { P8_HN(tt); float r0 = 0.f, r1 = 0.f; p8_dots(udA, hn, c8, r0, r1);
          __builtin_nontemporal_store(r0 * (1.0f / USCALE), po + (size_t)tt * NSL * NSEL); __builtin_nontemporal_store(r1 * (1.0f / USCALE), po + (size_t)tt * NSL * NSEL + 8); }
        if (tt + 2 < PITEM) { P8_GATHER(udA, ea); P8_LDE(eb, tt + 3); }
        { P8_HN(tt + 1); float r0 = 0.f, r1 = 0.f; p8_dots(udB, hn, c8, r0, r1);
          __builtin_nontemporal_store(r0 * (1.0f / USCALE), po + (size_t)(tt + 1) * NSL * NSEL); __builtin_nontemporal_store(r1 * (1.0f / USCALE), po + (size_t)(tt + 1) * NSL * NSEL + 8); }
    }
#undef P8_LDE
#undef P8_GATHER
#undef P8_HN
}
__device__ __forceinline__ void p8b_coef(Frame& F) {
    const size_t N = (size_t)T * NSEL;
    for (size_t i = (size_t)F.bid * NTHR + F.tid; i < N; i += (size_t)F.G * NTHR) { const size_t t = i >> 7; const int j = (int)(i & 127);
        const float* pp = F.pact() + t * NSL * NSEL + j; float a = 0.f;
#pragma unroll
        for (int s = 0; s < NSL; ++s) a += __builtin_nontemporal_load(pp + s * NSEL);
        F.coef()[i] = F.wsel()[i] * 0.5f * a * (1.0f + erff(a * 0.70710678f)); }
}
__device__ __forceinline__ void p9_token(Frame& F, const v4u (&vd)[16], const float* cp, float* yo, LAS float* red, int c8, int q8) {
    f32x4 cc[4];
#pragma unroll
    for (int k = 0; k < 4; ++k) cc[k] = __builtin_nontemporal_load((const f32x4*)(cp + 4 * k));
    f32x2_ y[8];
#pragma unroll
    for (int k = 0; k < 8; ++k) y[k] = (f32x2_){0.f, 0.f};
#pragma unroll
    for (int i = 0; i < 16; ++i) { f32x2_ vf[8]; cvt16(vd[i], vf); const float c = cc[i >> 2][i & 3]; const f32x2_ c2 = {c, c};
#pragma unroll
        for (int k = 0; k < 8; ++k) y[k] += c2 * vf[k];
        PEER_SB(); }
#pragma unroll
    for (int k = 0; k < 4; ++k) { f32x4 o; o[0] = y[2 * k][0]; o[1] = y[2 * k][1]; o[2] = y[2 * k + 1][0]; o[3] = y[2 * k + 1][1]; *(LAS f32x4*)(red + q8 * 128 + 16 * c8 + 4 * k) = o; }
    asm volatile("s_waitcnt lgkmcnt(0)" ::: "memory");
    float s0 = 0.f, s1 = 0.f;
#pragma unroll
    for (int g = 0; g < 8; ++g) { s0 += red[g * 128 + F.lane]; s1 += red[g * 128 + 64 + F.lane]; }
    __builtin_nontemporal_store(s0 * (1.0f / VSCALE), yo + F.lane); __builtin_nontemporal_store(s1 * (1.0f / VSCALE), yo + 64 + F.lane);
    asm volatile("s_waitcnt lgkmcnt(0)" ::: "memory");
    PEER_SB();
}
__device__ __forceinline__ void p9_item(Frame& F, int sl, int item, LAS float* red  ) {
    const int c8 = F.lane & 7, q8 = F.lane >> 3, t0 = item * PITEM;
    const unsigned char* vb = F.V8() + (size_t)sl * 16384 * CSL + 16 * c8;
    const int* ep = F.esel() + (size_t)t0 * NSEL + 16 * q8; const float* cp = F.coef() + (size_t)t0 * NSEL + 16 * q8;
    float* yo = F.ybuf() + (size_t)t0 * D + sl * CSL;
    v4u ea[4], eb[4], vdA[16], vdB[16];
#define P9_LDE(dst, tt) do { _Pragma("unroll") for (int k = 0; k < 4; ++k) dst[k] = __builtin_nontemporal_load((const v4u*)(ep + (tt) * NSEL + 4 * k)); } while (0)
#define P9_GATHER(dst, e) do { _Pragma("unroll") for (int i = 0; i < 16; ++i) dst[i] = *(const v4u*)(vb + (size_t)e[i >> 2][i & 3] * CSL); } while (0)
    P9_LDE(ea, 0); P9_LDE(eb, 1);
    P9_GATHER(vdA, ea);
    for (int tt = 0; tt < PITEM; tt += 2) {
        P9_GATHER(vdB, eb);
        if (tt + 2 < PITEM) P9_LDE(ea, tt + 2);
        p9_token(F, vdA, cp + tt * NSEL, yo + (size_t)tt * D, red, c8, q8);
        if (tt + 2 < PITEM) { P9_GATHER(vdA, ea); P9_LDE(eb, tt + 3); }
        p9_token(F, vdB, cp + (tt + 1) * NSEL, yo + (size_t)(tt + 1) * D, red, c8, q8);
    }
#undef P9_LDE
#undef P9_GATHER
}
template <int SIDE>
__device__ __forceinline__ void peer_phase(Frame& F0, int rep) {
    Frame F = F0; asm volatile("" : "+v"(F.lane));
    const int s0 = (int)(xb_xcc_id() & 7u);
    unsigned* qbase = F.ctl() + (SIDE == 0 ? CW_QU : CW_QV) + rep * 64 * 32;
    LAS float* cf = (LAS float*)(F.lds) + F.wave * 1024;
    for (int k = 0; k < NSL; ++k) { const int sl = (s0 + k) & (NSL - 1);
        for (;;) { const int item = peer_next(qbase + 64 * sl, F.lane); if (item >= NPITEM) break;
            if (SIDE == 0) p8_item(F, sl, item); else p9_item(F, sl, item, cf); } }
}
__device__ __forceinline__ void p10_final(Frame& F) {
    const int gwc = F.bid * NWAVES + F.wave, NGW = F.G * NWAVES;
    for (int row0 = gwc * 16; row0 < T; row0 += NGW * 16) {
        const int b = row0 >> 13; const float* mb = F.mod() + b * 6144 + 5120; const float* fm = F.fmod() + b * 2048;
        f32x4 g2[4], ca[4], cb[4];
#pragma unroll
        for (int j = 0; j < 4; ++j) { const int k = 256 * j + 4 * F.lane; g2[j] = *(const f32x4*)(mb + k); ca[j] = *(const f32x4*)(F.fnorm_g() + k) * (*(const f32x4*)(fm + 1024 + k) + 1.0f); cb[j] = *(const f32x4*)(fm + k); }
        for (int r = 0; r < 16; ++r) { float* hr = F.out() + (size_t)(row0 + r) * D; const float* yr = F.ybuf() + (size_t)(row0 + r) * D;
            f32x4 z[4]; float ss = 0.f;
#pragma unroll
            for (int j = 0; j < 4; ++j) { z[j] = *(const f32x4*)(hr + 256 * j + 4 * F.lane) + g2[j] * *(const f32x4*)(yr + 256 * j + 4 * F.lane); ss += z[j][0] * z[j][0] + z[j][1] * z[j][1] + z[j][2] * z[j][2] + z[j][3] * z[j][3]; }
            const float rstd = __builtin_amdgcn_rsqf(wave_sum(ss) * (1.0f / D) + EPS);
#pragma unroll
            for (int j = 0; j < 4; ++j) *(f32x4*)(hr + 256 * j + 4 * F.lane) = z[j] * rstd * ca[j] + cb[j]; }
    }
}

constexpr int NPHASE = 12;
__global__ void __launch_bounds__(NTHR, 2) fwd_kernel(Args args) {
    extern __shared__ __attribute__((aligned(16))) unsigned char lds_raw[];
    Frame F;
    F.lds = (LAS unsigned char*)lds_raw;
    F.tid = threadIdx.x; F.lane = F.tid & 63; F.wave = __builtin_amdgcn_readfirstlane(F.tid >> 6); F.G = gridDim.x; F.bid = blockIdx.x;
    unsigned char* ws = args.ws; F.a = &args;
    volatile LAS unsigned* misc = (volatile LAS unsigned*)(F.lds + MISC_OFF);
    if (F.tid < 64) misc[F.tid] = 0u;
    __syncthreads();
    const int lo = args.ph_lo, hi = args.ph_hi;
    const bool multi = (hi - lo) > 1;
    XcdBarrier bar; bar.bar = (unsigned*)(ws + WS_CTL) + CW_BAR; bar.x = 0; bar.st = nullptr;
    if (multi) bar = xcd_barrier_post((unsigned*)(ws + WS_CTL) + CW_BAR, misc + 8);
#ifndef PHMASK
#define PHMASK 0xfff
#endif
#define IN(k) (((PHMASK >> (k)) & 1) && lo <= (k) && (k) < hi)
#define SEAM(k) do { if (IN(k) && IN((k) + 1)) xcd_barrier(bar); } while (0)

#ifndef REPMASK
#define REPMASK 0
#endif
#define REP(k) (((REPMASK) >> (k)) & 1)
#define REPBAR(k) if (REP(k) && rep == 0) xcd_barrier(bar)
    if (IN(0)) { for (int rep = 0; rep <= REP(0); ++rep) { p0_prologue(F); REPBAR(0); } } SEAM(0);
    if (IN(1)) { for (int rep = 0; rep <= REP(1); ++rep) { p1_norm(F); REPBAR(1); } } SEAM(1);
    if (IN(2)) { for (int rep = 0; rep <= REP(2); ++rep) { pg8::Gemm g{F.bufA(), F.Win_t(), T, NIN, D}; pg8::StaticOrder S; S.init(T, NIN, F.G, F.bid);
        pg8::EpiBf16<0> E{F.proj(), NIN, nullptr, 0, 0, 1.f};
        pg8::gemm_phase<pg8::EpiBf16<0>, pg8::StaticOrder, true, true>(F.lds, g, S, E); REPBAR(2); } } SEAM(2);
    if (IN(3)) { for (int rep = 0; rep <= REP(3); ++rep) {
        for (int it = F.bid; it < NB * NHH * 2 * NSEG; it += F.G) h1_item(F, it);
        float cw[CW];
#pragma unroll
        for (int j = 0; j < CW; ++j) cw[j] = F.conv_w()[j * DC + F.tid];
        const float cbias = F.conv_b()[F.tid];
        for (int it = F.bid; it < T / 32; it += F.G) conv_item(F, it, cw, cbias); REPBAR(3); }
    } SEAM(3);
    if (IN(4)) { for (int rep = 0; rep <= REP(4); ++rep) { for (int it = F.bid; it < NB * NHH * NSEG; it += F.G) h2_item(F, it); REPBAR(4); } } SEAM(4);
    if (IN(5)) { for (int rep = 0; rep <= REP(5); ++rep) { pg8::Gemm g{F.bufA(), F.Wout_t(), T, D, D}; pg8::StaticOrder S; S.init(T, D, F.G, F.bid);
        pg8::EpiOut E{F.x(), F.out(), F.hg(), F.mod(), F.g_ffn(), F.ssqp()};
        pg8::gemm_phase<pg8::EpiOut, pg8::StaticOrder, true, true>(F.lds, g, S, E); REPBAR(5); } } SEAM(5);
    if (IN(6)) { for (int rep = 0; rep <= REP(6); ++rep) { pg8::Gemm g{F.hg(), F.Wqk_t(), T, NQK, D}; pg8::StaticOrder S; S.init(T, NQK, F.G, F.bid);
        pg8::EpiScore E{F.scores(), F.ssqp(), F.biasq(), F.rstd()};
        pg8::gemm_phase<pg8::EpiScore, pg8::StaticOrder, true, true>(F.lds, g, S, E); REPBAR(6); } } SEAM(6);
    if (IN(7)) { for (int rep = 0; rep <= REP(7); ++rep) { p7_topk(F); REPBAR(7); } } SEAM(7);
    if (IN(8)) { for (int rep = 0; rep <= REP(8); ++rep) { peer_phase<0>(F, rep); REPBAR(8); } } SEAM(8);
    if (IN(9)) { for (int rep = 0; rep <= REP(9); ++rep) { p8b_coef(F); REPBAR(9); } } SEAM(9);
    if (IN(10)) { for (int rep = 0; rep <= REP(10); ++rep) { peer_phase<1>(F, rep); REPBAR(10); } } SEAM(10);
    if (IN(11)) { p10_final(F); }
#undef IN
#undef SEAM
}

#ifndef MK_ONE_LAUNCH
#define MK_ONE_LAUNCH 0
#endif
extern "C" void kernel_launch(void* const* d_in, const int* in_sizes, int n_in, void* d_out, int out_size, void* d_ws, size_t ws_size, hipStream_t stream) {
    static int grid = 0;
    if (grid == 0) {
        if (n_in != 23 || out_size != T * D || ws_size < WS_END) { fprintf(stderr, "kernel_launch: unexpected shapes (n_in %d, out %d, ws %zu)\n", n_in, out_size, ws_size); grid = -1; return; }
        int dev = 0, cus = 0, per_cu = 0;
        if (hipGetDevice(&dev) != hipSuccess || hipDeviceGetAttribute(&cus, hipDeviceAttributeMultiprocessorCount, dev) != hipSuccess) { grid = -1; return; }
        if (hipFuncSetAttribute((const void*)fwd_kernel, hipFuncAttributeMaxDynamicSharedMemorySize, LDS_BYTES) != hipSuccess) { fprintf(stderr, "kernel_launch: hipFuncSetAttribute failed\n"); grid = -1; return; }
        if (hipOccupancyMaxActiveBlocksPerMultiprocessor(&per_cu, (const void*)fwd_kernel, NTHR, LDS_BYTES) != hipSuccess || per_cu < 1) { fprintf(stderr, "kernel_launch: occupancy query reports %d\n", per_cu); }
        (void)hipGetLastError();
        grid = cus;
    }
    if (grid < 0) return;
    (void)hipMemsetAsync((char*)d_ws + WS_CTL, 0, CTL_ZERO_BYTES, stream);
    Args a{};
    for (int i = 0; i < 23; ++i) a.in[i] = (const float*)d_in[i];
    a.out = (float*)d_out; a.ws = (unsigned char*)d_ws;
#if MK_ONE_LAUNCH
    a.ph_lo = 0; a.ph_hi = NPHASE;
    hipLaunchKernelGGL(fwd_kernel, dim3(grid), dim3(NTHR), LDS_BYTES, stream, a);
#else
    for (int p = 0; p < NPHASE; ++p) { a.ph_lo = p; a.ph_hi = p + 1; hipLaunchKernelGGL(fwd_kernel, dim3(grid), dim3(NTHR), LDS_BYTES, stream, a); }
#endif
}
```

```cpp
#include <hip/hip_runtime.h>
#include <cstdio>
#include <cstdint>
namespace pg8 {
#define PG8_LAS __attribute__((address_space(3)))
typedef unsigned short bf16_t;
typedef short bf16x8 __attribute__((ext_vector_type(8)));
typedef float f32x4 __attribute__((ext_vector_type(4)));
typedef unsigned u32x4 __attribute__((ext_vector_type(4)));
constexpr int BM = 256, BK = 64, HALF = 128, HTB = HALF * BK * 2  , STAGE_BYTES = 8 * HTB, NXCD = 8, WGM = 8;

__host__ __device__ __forceinline__ int lds_byte(int r, int c) { const int st = (r >> 4) * 2 + (c >> 5), rr = r & 15, cc = c & 31, ob = rr * 64 + cc * 2; return st * 1024 + (ob ^ (((ob >> 9) & 1) << 5)); }
__host__ __device__ __forceinline__ void stage_rc(int b, int& R, int& C) { const int st = b / 1024, sb = b % 1024, swz = sb ^ (((sb >> 9) & 1) << 5); R = (st >> 1) * 16 + swz / 64; C = (st & 1) * 32 + (swz % 64) / 2; }
__host__ __device__ __forceinline__ int perm32(int rho) { const int n = rho >> 4, i = rho & 15; return 8 * (i >> 2) + 4 * n + (i & 3); }

struct Unit { int pm, pn; };
struct Gemm { const bf16_t* A; const bf16_t* Bt; int M, N, K; };

struct StaticOrder {
    int nM, nN, nwg, G, c;
    __host__ __device__ void init(int M, int N, int G_, int c_) { nM = M / BM; nN = N / BM; nwg = nM * nN; G = G_; c = c_; }
    __host__ __device__ bool next(int i, Unit& u) const {
        const long L = (long)i * G + c; if (L >= nwg) return false;
        int wgid = (int)L; { const int q = nwg / NXCD, r = nwg % NXCD, xcd = wgid % NXCD, off = wgid / NXCD; wgid = (xcd < r ? xcd * (q + 1) : r * (q + 1) + (xcd - r) * q) + off; }
        const int nig = WGM * nN, gid = wgid / nig, fm = gid * WGM, gsz = (nM - fm) < WGM ? (nM - fm) : WGM;
        u.pm = fm + ((wgid % nig) % gsz); u.pn = (wgid % nig) / gsz; return true;
    }
    __device__ __forceinline__ void a_ready(const Unit&) const {}
    __device__ __forceinline__ void done(const Unit&) const {}
};
__device__ __forceinline__ unsigned cvt_pk_bf16(float lo, float hi) { unsigned r; asm volatile("v_cvt_pk_bf16_f32 %0, %1, %2" : "=v"(r) : "v"(lo), "v"(hi)); return r; }
typedef float f32x2 __attribute__((ext_vector_type(2)));
__device__ __forceinline__ f32x2 gelu_pk(f32x2 v) {
    const f32x2 av = __builtin_elementwise_abs(v), d = av * 0.2316418882f + 1.0f;
    f32x2 t; t.x = __builtin_amdgcn_rcpf(d.x); t.y = __builtin_amdgcn_rcpf(d.y);
    f32x2 q = t * 0.5307027145f + (-0.7265760135f); q = q * t + 0.7107068705f; q = q * t + (-0.142248368f); q = q * t + 0.127414796f; q = q * t;
    const f32x2 s = (v * v) * (-0.72134752044f);
    f32x2 e; e.x = __builtin_amdgcn_exp2f(s.x); e.y = __builtin_amdgcn_exp2f(s.y);
    const f32x2 m = v * (q * e), r = v - m;
    f32x2 o; o.x = v.x < 0.f ? m.x : r.x; o.y = v.y < 0.f ? m.y : r.y; return o;
}

template <int ACT  > struct EpiBf16 {
    static constexpr bool PERM = true, AFTER_DRAIN = false; static_assert(ACT == 0 || ACT == 1, "EpiBf16: ACT is 0 (none) or 1 (gelu_pk)");
    bf16_t* O; int ldc; const float* bias; int split_cols; size_t split_stride; float scale0;
    __device__ __forceinline__ void operator()(const f32x4 (&acc)[2][2][4][2], const Unit& u, int wr, int wc, int fr, int fq) const {
        const int row0 = u.pm * BM + wr * 64 + fr; int colt = u.pn * BM; bf16_t* base = O;
        float sc = 1.f; if (split_cols) { const int t = colt / split_cols; base += (size_t)t * split_stride; colt -= t * split_cols; if (t == 0) sc = scale0; }
        const int col0 = colt + wc * 32 + 8 * fq, bcol0 = u.pn * BM + wc * 32 + 8 * fq;
        f32x4 bv[2][2];
#pragma unroll
        for (int bj = 0; bj < 2; ++bj)
#pragma unroll
            for (int n = 0; n < 2; ++n) bv[bj][n] = bias ? *(const f32x4*)(bias + bcol0 + bj * HALF + 4 * n) : (f32x4){0.f, 0.f, 0.f, 0.f};
#pragma unroll
        for (int ai = 0; ai < 2; ++ai)
#pragma unroll
            for (int m = 0; m < 4; ++m) { bf16_t* rowp = base + (size_t)(row0 + ai * HALF + m * 16) * ldc + col0;
#pragma unroll
                for (int bj = 0; bj < 2; ++bj) { f32x4 v0 = acc[ai][bj][m][0] + bv[bj][0], v1 = acc[ai][bj][m][1] + bv[bj][1];
                    if (ACT == 1) { f32x2 a = gelu_pk((f32x2){v0[0], v0[1]}), b = gelu_pk((f32x2){v0[2], v0[3]}), c = gelu_pk((f32x2){v1[0], v1[1]}), d = gelu_pk((f32x2){v1[2], v1[3]});
                        v0 = (f32x4){a.x, a.y, b.x, b.y}; v1 = (f32x4){c.x, c.y, d.x, d.y}; }
                    v0 = v0 * sc; v1 = v1 * sc; u32x4 w; w.x = cvt_pk_bf16(v0[0], v0[1]); w.y = cvt_pk_bf16(v0[2], v0[3]); w.z = cvt_pk_bf16(v1[0], v1[1]); w.w = cvt_pk_bf16(v1[2], v1[3]);
                    *(u32x4*)(rowp + bj * HALF) = w; } }
    }
};

struct EpiOut {
    static constexpr bool PERM = true, AFTER_DRAIN = false;
    const float* X; float* Hout; bf16_t* HG; const float* mod; const float* gffn; float* ssqp;
    __device__ __forceinline__ void operator()(const f32x4 (&acc)[2][2][4][2], const Unit& u, int wr, int wc, int fr, int fq) const {
        const int row0 = u.pm * BM + wr * 64 + fr, col0 = u.pn * BM + wc * 32 + 8 * fq;
        const int b = (u.pm * BM) >> 13;
        const float* mb = mod + b * 6144;
        f32x4 g1v[2][2], gv2[2][2];
#pragma unroll
        for (int bj = 0; bj < 2; ++bj)
#pragma unroll
            for (int n = 0; n < 2; ++n) { const int c = col0 + bj * HALF + 4 * n;
                g1v[bj][n] = *(const f32x4*)(mb + 2048 + c);
                const f32x4 s2 = *(const f32x4*)(mb + 4096 + c), gf = *(const f32x4*)(gffn + c);
                gv2[bj][n] = gf * (s2 + 1.0f); }
#pragma unroll
        for (int ai = 0; ai < 2; ++ai)
#pragma unroll
            for (int m = 0; m < 4; ++m) { const int row = row0 + ai * HALF + m * 16; const size_t ro = (size_t)row * 1024 + col0; float ss = 0.f;
#pragma unroll
                for (int bj = 0; bj < 2; ++bj) {
                    const f32x4 x0 = *(const f32x4*)(X + ro + bj * HALF), x1 = *(const f32x4*)(X + ro + bj * HALF + 4);
                    const f32x4 h0 = x0 + g1v[bj][0] * acc[ai][bj][m][0], h1 = x1 + g1v[bj][1] * acc[ai][bj][m][1];
                    *(f32x4*)(Hout + ro + bj * HALF) = h0; *(f32x4*)(Hout + ro + bj * HALF + 4) = h1;
                    ss += h0[0] * h0[0] + h0[1] * h0[1] + h0[2] * h0[2] + h0[3] * h0[3] + h1[0] * h1[0] + h1[1] * h1[1] + h1[2] * h1[2] + h1[3] * h1[3];
                    const f32x4 q0 = h0 * gv2[bj][0], q1 = h1 * gv2[bj][1];
                    u32x4 w; w.x = cvt_pk_bf16(q0[0], q0[1]); w.y = cvt_pk_bf16(q0[2], q0[3]); w.z = cvt_pk_bf16(q1[0], q1[1]); w.w = cvt_pk_bf16(q1[2], q1[3]);
                    *(u32x4*)(HG + ro + bj * HALF) = w; }
                ss += __shfl_xor(ss, 16); ss += __shfl_xor(ss, 32);
                if (fq == 0) ssqp[(size_t)row * 16 + u.pn * 4 + wc] = ss; }
    }
};
struct EpiScore {
    static constexpr bool PERM = false, AFTER_DRAIN = false;
    float* S; const float* ssqp; const float* biasq; float* rstd_out;
    __device__ __forceinline__ void operator()(const f32x4 (&acc)[2][2][4][2], const Unit& u, int wr, int wc, int fr, int fq) const {
        const int row0 = u.pm * BM + wr * 64 + fr, col0 = u.pn * BM + wc * 32 + 4 * fq;
        const int b = (u.pm * BM) >> 13;
        f32x4 bv[2][2];
#pragma unroll
        for (int bj = 0; bj < 2; ++bj)
#pragma unroll
            for (int n = 0; n < 2; ++n) bv[bj][n] = *(const f32x4*)(biasq + b * 2048 + col0 + bj * HALF + n * 16);
#pragma unroll
        for (int ai = 0; ai < 2; ++ai)
#pragma unroll
            for (int m = 0; m < 4; ++m) { const int row = row0 + ai * HALF + m * 16;
                const f32x4* sp = (const f32x4*)(ssqp + (size_t)row * 16);
                const f32x4 p0 = sp[0], p1 = sp[1], p2 = sp[2], p3 = sp[3];
                const float tot = (p0[0] + p0[1] + p0[2] + p0[3]) + (p1[0] + p1[1] + p1[2] + p1[3]) + (p2[0] + p2[1] + p2[2] + p2[3]) + (p3[0] + p3[1] + p3[2] + p3[3]);
                const float rstd = __builtin_amdgcn_rsqf(tot * (1.0f / 1024.0f) + 1e-6f);
                if (u.pn == 0 && wc == 0 && fq == 0) rstd_out[row] = rstd;
                float* rowp = S + (size_t)row * 2048 + col0;
#pragma unroll
                for (int bj = 0; bj < 2; ++bj)
#pragma unroll
                    for (int n = 0; n < 2; ++n) *(f32x4*)(rowp + bj * HALF + n * 16) = acc[ai][bj][m][n] * rstd + bv[bj][n]; }
    }
};
template <class Epi, class Sched, bool ALIGN_EPI = false, bool SP2 = false>
__device__ __forceinline__ void gemm_phase(PG8_LAS unsigned char* lds, const Gemm g, const Sched& S, const Epi& E) {
    const int tid = threadIdx.x, wid = __builtin_amdgcn_readfirstlane(tid >> 6), lane = tid & 63, wr = wid >> 2, wc = wid & 3, fr = lane & 15, fq = lane >> 4;
    const int K = g.K, nt = K / BK;
    unsigned voffA[2], voffB[2];
#pragma unroll
    for (int i = 0; i < 2; ++i) { int R, C; stage_rc(tid * 16 + i * 8192, R, C); const int Rb = Epi::PERM ? ((R & ~31) + perm32(R & 31)) : R;
        voffA[i] = (unsigned)(R * K + C) * 2u; voffB[i] = (unsigned)(Rb * K + C) * 2u; }
    const size_t kstep = (size_t)(BK * 2);
    const size_t hstep = (size_t)HALF * K * 2;
    const size_t tstep = 2 * hstep;
    const unsigned ldsw = (unsigned)wid * 1024u;
    const int aoff = lds_byte(wr * 64 + fr, fq * 8), boff = lds_byte(wc * 32 + fr, fq * 8);
#define PG8_SA(b, h) (((b) * 2 + (h)) * HTB)
#define PG8_SB(b, h) ((4 + (b) * 2 + (h)) * HTB)
#define PG8_STAGE(bufoff, gbase, voff) do { _Pragma("unroll") for (int _i = 0; _i < 2; ++_i) \
        __builtin_amdgcn_global_load_lds((const unsigned*)((const char*)(gbase) + (voff)[_i]), (PG8_LAS unsigned*)(lds + (bufoff) + ldsw + _i * 8192), 16, 0, 0); } while (0)
#define PG8_LDA(dst, b, h) do { _Pragma("unroll") for (int m = 0; m < 4; ++m) _Pragma("unroll") for (int k = 0; k < 2; ++k) dst[m][k] = *(const PG8_LAS bf16x8*)(lds + PG8_SA(b, h) + aoff + m * 2048 + k * 1024); } while (0)
#define PG8_LDB(dst, b, h) do { _Pragma("unroll") for (int n = 0; n < 2; ++n) _Pragma("unroll") for (int k = 0; k < 2; ++k) dst[n][k] = *(const PG8_LAS bf16x8*)(lds + PG8_SB(b, h) + boff + n * 2048 + k * 1024); } while (0)
#define PG8_MMA(ai, bj, At, Bt) do { __builtin_amdgcn_s_setprio(1); _Pragma("unroll") for (int m = 0; m < 4; ++m) _Pragma("unroll") for (int n = 0; n < 2; ++n) _Pragma("unroll") for (int k = 0; k < 2; ++k) \
        acc[ai][bj][m][n] = __builtin_amdgcn_mfma_f32_16x16x32_bf16(Bt[n][k], At[m][k], acc[ai][bj][m][n], 0, 0, 0); __builtin_amdgcn_s_setprio(0); } while (0)
#define PG8_WAIT_V(n) asm volatile("s_waitcnt vmcnt(" #n ")" ::: "memory")
#define PG8_WAIT_L(n) asm volatile("s_waitcnt lgkmcnt(" #n ")" ::: "memory")
#define PG8_BAR __builtin_amdgcn_s_barrier()
#define PG8_SCHED __builtin_amdgcn_sched_barrier(0)
    Unit cur, nxt; int ui = 0;
    if (!S.next(0, cur)) return;
    f32x4 acc[2][2][4][2];
#pragma unroll
    for (int a = 0; a < 2; ++a)
#pragma unroll
        for (int b = 0; b < 2; ++b)
#pragma unroll
            for (int m = 0; m < 4; ++m)
#pragma unroll
                for (int n = 0; n < 2; ++n) acc[a][b][m][n] = (f32x4){0.f, 0.f, 0.f, 0.f};
    bf16x8 At[4][2], B0[2][2], B1[2][2];
    const char* cA = (const char*)g.A + (size_t)cur.pm * tstep; const char* cB = (const char*)g.Bt + (size_t)cur.pn * tstep;
    S.a_ready(cur);
    if constexpr (SP2) {
        PG8_STAGE(PG8_SB(0, 0), cB, voffB); PG8_STAGE(PG8_SB(0, 1), cB + hstep, voffB); PG8_STAGE(PG8_SA(0, 0), cA, voffA); PG8_STAGE(PG8_SA(0, 1), cA + hstep, voffA);
        if (wr == 1) PG8_BAR;
        PG8_WAIT_V(2); PG8_BAR;
        PG8_STAGE(PG8_SB(1, 0), cB + kstep, voffB); PG8_STAGE(PG8_SA(1, 0), cA + kstep, voffA); PG8_STAGE(PG8_SB(1, 1), cB + hstep + kstep, voffB);
        PG8_WAIT_V(6); PG8_BAR;
    } else {
        PG8_STAGE(PG8_SB(0, 0), cB, voffB); PG8_STAGE(PG8_SA(0, 0), cA, voffA); PG8_STAGE(PG8_SB(0, 1), cB + hstep, voffB); PG8_STAGE(PG8_SA(0, 1), cA + hstep, voffA);
        if (wr == 1) PG8_BAR;
        PG8_WAIT_V(4); PG8_BAR;
        PG8_STAGE(PG8_SB(1, 0), cB + kstep, voffB); PG8_STAGE(PG8_SA(1, 0), cA + kstep, voffA); PG8_STAGE(PG8_SB(1, 1), cB + hstep + kstep, voffB);
        PG8_WAIT_V(6); PG8_BAR;
    }
    for (;;) {
        const bool has_next = S.next(ui + 1, nxt);
        const char* nA = has_next ? (const char*)g.A + (size_t)nxt.pm * tstep : cA; const char* nB = has_next ? (const char*)g.Bt + (size_t)nxt.pn * tstep : cB;
        for (int t = 0; t < nt; t += 2) {
            const bool last = (t == nt - 2);
            const char* a1 = cA + (size_t)(t + 1) * kstep;
            const char* a2 = last ? nA : cA + (size_t)(t + 2) * kstep; const char* b2 = last ? nB : cB + (size_t)(t + 2) * kstep;
            const char* a3 = a2 + kstep; const char* b3 = b2 + kstep;
            if (last && has_next) S.a_ready(nxt);
            if constexpr (SP2) {
            PG8_LDB(B0, 0, 0); PG8_LDB(B1, 0, 1); PG8_SCHED; PG8_LDA(At, 0, 0); PG8_STAGE(PG8_SA(1, 1), a1 + hstep, voffA);
            PG8_WAIT_V(8); PG8_WAIT_L(0); PG8_BAR; PG8_MMA(0, 0, At, B0); PG8_MMA(0, 1, At, B1); PG8_BAR; PG8_SCHED;
            PG8_LDA(At, 0, 1); PG8_STAGE(PG8_SB(0, 0), b2, voffB); PG8_STAGE(PG8_SB(0, 1), b2 + hstep, voffB); PG8_STAGE(PG8_SA(0, 0), a2, voffA);
            PG8_WAIT_V(8); PG8_WAIT_L(0); PG8_BAR; PG8_MMA(1, 0, At, B0); PG8_MMA(1, 1, At, B1); PG8_BAR; PG8_SCHED;
            PG8_LDB(B0, 1, 0); PG8_LDB(B1, 1, 1); PG8_SCHED; PG8_LDA(At, 1, 0); PG8_STAGE(PG8_SA(0, 1), a2 + hstep, voffA);
            PG8_WAIT_V(8); PG8_WAIT_L(0); PG8_BAR; PG8_MMA(0, 0, At, B0); PG8_MMA(0, 1, At, B1); PG8_BAR; PG8_SCHED;
            PG8_LDA(At, 1, 1); PG8_STAGE(PG8_SB(1, 0), b3, voffB); PG8_STAGE(PG8_SB(1, 1), b3 + hstep, voffB); PG8_STAGE(PG8_SA(1, 0), a3, voffA);
            PG8_WAIT_V(8); PG8_WAIT_L(0); PG8_BAR; PG8_MMA(1, 0, At, B0); PG8_MMA(1, 1, At, B1); PG8_BAR; PG8_SCHED;
            } else {
            PG8_LDB(B0, 0, 0); PG8_SCHED; PG8_LDA(At, 0, 0); PG8_STAGE(PG8_SA(1, 1), a1 + hstep, voffA);
            PG8_WAIT_L(8); PG8_BAR; PG8_WAIT_L(0); PG8_MMA(0, 0, At, B0); PG8_BAR; PG8_SCHED;
            PG8_LDB(B1, 0, 1); PG8_STAGE(PG8_SB(0, 0), b2, voffB);
            PG8_BAR; PG8_WAIT_L(0); PG8_MMA(0, 1, At, B1); PG8_BAR;
            PG8_LDA(At, 0, 1); PG8_STAGE(PG8_SA(0, 0), a2, voffA);
            PG8_BAR; PG8_WAIT_L(0); PG8_MMA(1, 0, At, B0); PG8_BAR; PG8_SCHED;
            PG8_STAGE(PG8_SB(0, 1), b2 + hstep, voffB);
            PG8_WAIT_V(6); PG8_BAR; PG8_MMA(1, 1, At, B1); PG8_BAR;
            PG8_LDB(B0, 1, 0); PG8_SCHED; PG8_LDA(At, 1, 0); PG8_STAGE(PG8_SA(0, 1), a2 + hstep, voffA);
            PG8_WAIT_L(8); PG8_BAR; PG8_WAIT_L(0); PG8_MMA(0, 0, At, B0); PG8_BAR; PG8_SCHED;
            PG8_LDB(B1, 1, 1); PG8_STAGE(PG8_SB(1, 0), b3, voffB);
            PG8_BAR; PG8_WAIT_L(0); PG8_MMA(0, 1, At, B1); PG8_BAR;
            PG8_LDA(At, 1, 1); PG8_STAGE(PG8_SA(1, 0), a3, voffA);
            PG8_BAR; PG8_WAIT_L(0); PG8_MMA(1, 0, At, B0); PG8_BAR; PG8_SCHED;
            PG8_STAGE(PG8_SB(1, 1), b3 + hstep, voffB);
            PG8_WAIT_V(6); PG8_BAR; PG8_MMA(1, 1, At, B1); PG8_BAR;
            }
        }
        if constexpr (ALIGN_EPI) { if (wr == 0) PG8_BAR; }
        if constexpr (!Epi::AFTER_DRAIN) { E(acc, cur, wr, wc, fr, fq); S.done(cur); }
        if (!has_next) break;
#pragma unroll
        for (int a = 0; a < 2; ++a)
#pragma unroll
            for (int b = 0; b < 2; ++b)
#pragma unroll
                for (int m = 0; m < 4; ++m)
#pragma unroll
                    for (int n = 0; n < 2; ++n) acc[a][b][m][n] = (f32x4){0.f, 0.f, 0.f, 0.f};
        cur = nxt; cA = nA; cB = nB; ++ui;
        if constexpr (ALIGN_EPI) { if (wr == 1) PG8_BAR; }
    }
    PG8_WAIT_V(0);
    if constexpr (!ALIGN_EPI) { if (wr == 0) PG8_BAR; }
    PG8_BAR;
    if constexpr (Epi::AFTER_DRAIN) { E.fused(acc, cur, wr, wc, fr, fq, lds, wid, lane); S.done(cur); }
#undef PG8_SA
#undef PG8_SB
#undef PG8_STAGE
#undef PG8_LDA
#undef PG8_LDB
#undef PG8_MMA
#undef PG8_WAIT_V
#undef PG8_WAIT_L
#undef PG8_BAR
#undef PG8_SCHED
}
}
#define MK_ONE_LAUNCH 1

constexpr int NB = 4, SEQ = 8192, T = NB * SEQ, D = 1024;
constexpr int NIN = 3584, DH = 512, HD = 128, NHH = 4, CHK = 64;
constexpr int NSEG = 16, SEGC = 8;
constexpr int CW = 31, CPAD = 15, DC = 512;
constexpr int PHEADS = 8, NQK = 2048, NSEL = 128;
constexpr float EPS = 1e-6f;
constexpr int NWAVES = 8, NTHR = 512;

constexpr size_t MiB = 1u << 20;
constexpr size_t WS_CTL = 0, CTL_ZERO_BYTES = 65536;
constexpr size_t WS_MOD = 1 * MiB, WS_FMOD = WS_MOD + 131072, WS_LB = WS_MOD + 196608, WS_BIASQ = WS_MOD + 262144;
constexpr size_t WS_WIN = 2 * MiB, WS_WOUT = 10 * MiB, WS_WQK = 12 * MiB;
constexpr size_t WS_UT = 16 * MiB, WS_VT = 48 * MiB;
constexpr size_t WS_BUFA = 80 * MiB;
constexpr size_t WS_BUFB = 144 * MiB;
constexpr size_t WS_SEG = 208 * MiB;
constexpr size_t WS_E = 208 * MiB, WS_W = 224 * MiB;
constexpr size_t WS_BIG = 240 * MiB;
constexpr size_t WS_SSQ = 496 * MiB;
constexpr size_t WS_SEGA = 498 * MiB;
constexpr size_t WS_RSTD = 499 * MiB;
constexpr size_t WS_END = 500 * MiB;
constexpr size_t WS_PACT = 240 * MiB;
constexpr size_t WS_Y = 368 * MiB;
constexpr int NSL = 8, CSL = 128;
constexpr float USCALE = 64.0f, VSCALE = 16.0f;
constexpr int CW_QU = 8192, CW_QV = 8192 + 64 * 16;
constexpr int CW_BAR = 1024;

constexpr int LDS_BYTES = 155648;
constexpr int MISC_OFF = LDS_BYTES - 256;

#define GAS __attribute__((address_space(1)))
#define LAS __attribute__((address_space(3)))
typedef unsigned short bf16;
typedef unsigned v4u __attribute__((ext_vector_type(4)));
typedef unsigned v2u __attribute__((ext_vector_type(2)));
typedef float f32x4 __attribute__((ext_vector_type(4)));
typedef float f32x16 __attribute__((ext_vector_type(16)));
typedef short bf16x8 __attribute__((ext_vector_type(8)));
typedef float f32x2_ __attribute__((ext_vector_type(2)));

__device__ __forceinline__ float bf2f(unsigned h) { return __builtin_bit_cast(float, h << 16); }
__device__ __forceinline__ float bflo(unsigned u) { return __builtin_bit_cast(float, u << 16); }
__device__ __forceinline__ float bfhi(unsigned u) { return __builtin_bit_cast(float, u & 0xffff0000u); }
__device__ __forceinline__ unsigned f2bf(float f) { unsigned u = __builtin_bit_cast(unsigned, f); return (u + 0x7fffu + ((u >> 16) & 1u)) >> 16; }
__device__ __forceinline__ unsigned pk2(float lo, float hi) { return f2bf(lo) | (f2bf(hi) << 16); }
__device__ __forceinline__ float sigmoidf_(float x) { return __builtin_amdgcn_rcpf(1.0f + __expf(-x)); }
#define DPP_ADD(s, ctrl) ((s) + __builtin_bit_cast(float, __builtin_amdgcn_update_dpp(0, __builtin_bit_cast(int, (s)), (ctrl), 0xF, 0xF, false)))
__device__ __forceinline__ float wave_sum(float v) {
#pragma unroll
    for (int o = 1; o < 64; o <<= 1) v += __shfl_xor(v, o);
    return v;
}

#define XB_TMO      128
#define XB_XCNT(j)  (256  + 64 * (j))
#define XB_XSUB(j)  (1280 + 64 * (j))
#define XB_XGEN(j)  (2304 + 64 * (j))
#define XB_TOP      3328
#define XB_TOPGEN   3392
#define XCD_BAR_WORDS 3456
#define XB_SPIN_CAP (1u << 18)
__device__ __forceinline__ unsigned xb_ld(unsigned* p)              { return __hip_atomic_load(p, __ATOMIC_RELAXED, __HIP_MEMORY_SCOPE_AGENT); }
__device__ __forceinline__ unsigned xb_add(unsigned* p, unsigned v) { return __hip_atomic_fetch_add(p, v, __ATOMIC_RELAXED, __HIP_MEMORY_SCOPE_AGENT); }
__device__ __forceinline__ unsigned xb_xcc_id() { return (unsigned)__builtin_amdgcn_s_getreg((3 << 11) | 20) & 0xFu; }
#define XB_SPIN(cond, bar) do { unsigned _sp = 0; while (cond) { __builtin_amdgcn_s_sleep(1); \
    if ((++_sp & 255u) == 0u) { if (xb_ld(&(bar)[XB_TMO])) break; if (_sp > XB_SPIN_CAP) { atomicAdd(&(bar)[XB_TMO], 1u); break; } } } } while (0)
struct XcdBarrier { unsigned* bar; unsigned x; volatile LAS unsigned* st; };
__device__ __forceinline__ XcdBarrier xcd_barrier_post(unsigned* bar, volatile LAS unsigned* st) {
    XcdBarrier b; b.bar = bar; b.x = xb_xcc_id(); b.st = st;
    if (threadIdx.x == 0) (void)xb_add(&bar[XB_XCNT(b.x)], 1u);
    return b;
}
__device__ __forceinline__ void xcd_barrier_complete(unsigned* bar, unsigned x, unsigned& nloc, unsigned& nx) {
    const unsigned G = gridDim.x * gridDim.y * gridDim.z;
    unsigned sum, cnt, mine, sp = 0u;
    for (;;) {
        sum = 0u; cnt = 0u; mine = 0u;
#pragma unroll
        for (unsigned j = 0; j < 16; ++j) { const unsigned c = xb_ld(&bar[XB_XCNT(j)]); sum += c; cnt += (c > 0u) ? 1u : 0u; mine = (j == x) ? c : mine; }
        if (sum == G) break;
        __builtin_amdgcn_s_sleep(1);
        if ((++sp & 255u) == 0u) { if (xb_ld(&bar[XB_TMO])) break; if (sp > XB_SPIN_CAP) { atomicAdd(&bar[XB_TMO], 1u); break; } }
    }
    nloc = mine > 0u ? mine : 1u; nx = cnt > 0u ? cnt : 1u;
}
__device__ __forceinline__ void xcd_barrier(const XcdBarrier& b) {
    asm volatile("s_waitcnt vmcnt(0)" ::: "memory");
    __syncthreads();
    if (threadIdx.x == 0) {
        unsigned* bar = b.bar;
        __builtin_amdgcn_s_waitcnt(0);
        unsigned nloc = b.st[0], nx = b.st[1];
        if (nloc == 0u) { xcd_barrier_complete(bar, b.x, nloc, nx); b.st[0] = nloc; b.st[1] = nx; }
        const unsigned old = xb_add(&bar[XB_XSUB(b.x)], 1u);
        const unsigned gen = old / nloc;
        if (old + 1u == (gen + 1u) * nloc) {
            __builtin_amdgcn_fence(__ATOMIC_RELEASE, "agent");
            asm volatile("s_waitcnt vmcnt(0)" ::: "memory");
            const unsigned og = xb_add(&bar[XB_TOP], 1u);
            const unsigned tg = og / nx;
            if (og + 1u == (tg + 1u) * nx) xb_add(&bar[XB_TOPGEN], 1u);
            else XB_SPIN(xb_ld(&bar[XB_TOPGEN]) == tg, bar);
            __builtin_amdgcn_fence(__ATOMIC_ACQUIRE, "agent");
            xb_add(&bar[XB_XGEN(b.x)], 1u);
            asm volatile("s_waitcnt vmcnt(0)" ::: "memory");
        } else {
            XB_SPIN(xb_ld(&bar[XB_XGEN(b.x)]) == gen, bar);
            __builtin_amdgcn_fence(__ATOMIC_ACQUIRE, "agent");
            asm volatile("s_waitcnt vmcnt(0)" ::: "memory");
        }
    }
    __syncthreads();
}

struct Args { const float* in[23]; float* out; unsigned char* ws; int ph_lo, ph_hi; };
struct Frame {
    LAS unsigned char* lds;
    int tid, lane, wave, G, bid;
    const Args* a;
    __device__ __forceinline__ const float* x() const { return a->in[0]; }
    __device__ __forceinline__ const float* c() const { return a->in[1]; }
    __device__ __forceinline__ const float* ada_w() const { return a->in[2]; }
    __device__ __forceinline__ const float* ada_b() const { return a->in[3]; }
    __device__ __forceinline__ const float* g_mix() const { return a->in[4]; }
    __device__ __forceinline__ const float* w_in() const { return a->in[5]; }
    __device__ __forceinline__ const float* lbg_f() const { return a->in[6]; }
    __device__ __forceinline__ const float* lbg_b() const { return a->in[7]; }
    __device__ __forceinline__ const float* hnorm_g() const { return a->in[8]; }
    __device__ __forceinline__ const float* conv_w() const { return a->in[9]; }
    __device__ __forceinline__ const float* conv_b() const { return a->in[10]; }
    __device__ __forceinline__ const float* cln_g() const { return a->in[11]; }
    __device__ __forceinline__ const float* cln_b() const { return a->in[12]; }
    __device__ __forceinline__ const float* w_out() const { return a->in[13]; }
    __device__ __forceinline__ const float* g_ffn() const { return a->in[14]; }
    __device__ __forceinline__ const float* wq() const { return a->in[15]; }
    __device__ __forceinline__ const float* keys1() const { return a->in[16]; }
    __device__ __forceinline__ const float* keys2() const { return a->in[17]; }
    __device__ __forceinline__ const float* utab() const { return a->in[18]; }
    __device__ __forceinline__ const float* vtab() const { return a->in[19]; }
    __device__ __forceinline__ const float* fada_w() const { return a->in[20]; }
    __device__ __forceinline__ const float* fada_b() const { return a->in[21]; }
    __device__ __forceinline__ const float* fnorm_g() const { return a->in[22]; }
    __device__ __forceinline__ float* out() const { return a->out; }
    __device__ __forceinline__ float* mod() const { return (float*)(a->ws + WS_MOD); }
    __device__ __forceinline__ float* fmod() const { return (float*)(a->ws + WS_FMOD); }
    __device__ __forceinline__ float* lb() const { return (float*)(a->ws + WS_LB); }
    __device__ __forceinline__ float* biasq() const { return (float*)(a->ws + WS_BIASQ); }
    __device__ __forceinline__ float* ssqp() const { return (float*)(a->ws + WS_SSQ); }
    __device__ __forceinline__ float* sega() const { return (float*)(a->ws + WS_SEGA); }
    __device__ __forceinline__ float* segu() const { return (float*)(a->ws + WS_SEG); }
    __device__ __forceinline__ float* of() const { return (float*)(a->ws + WS_BUFB); }
    __device__ __forceinline__ float* scores() const { return (float*)(a->ws + WS_BIG); }
    __device__ __forceinline__ float* wsel() const { return (float*)(a->ws + WS_W); }
    __device__ __forceinline__ int* esel() const { return (int*)(a->ws + WS_E); }
    __device__ __forceinline__ bf16* Win_t() const { return (bf16*)(a->ws + WS_WIN); }
    __device__ __forceinline__ bf16* Wout_t() const { return (bf16*)(a->ws + WS_WOUT); }
    __device__ __forceinline__ bf16* Wqk_t() const { return (bf16*)(a->ws + WS_WQK); }
    __device__ __forceinline__ bf16* Ub() const { return (bf16*)(a->ws + WS_UT); }
    __device__ __forceinline__ bf16* Vb() const { return (bf16*)(a->ws + WS_VT); }
    __device__ __forceinline__ bf16* bufA() const { return (bf16*)(a->ws + WS_BUFA); }
    __device__ __forceinline__ bf16* hg() const { return (bf16*)(a->ws + WS_BUFB); }
    __device__ __forceinline__ bf16* proj() const { return (bf16*)(a->ws + WS_BIG); }
    __device__ __forceinline__ float* coef() const { return (float*)(a->ws + WS_BUFA); }
    __device__ __forceinline__ float* rstd() const { return (float*)(a->ws + WS_RSTD); }
    __device__ __forceinline__ float* pact() const { return (float*)(a->ws + WS_PACT); }
    __device__ __forceinline__ float* ybuf() const { return (float*)(a->ws + WS_Y); }
    __device__ __forceinline__ unsigned char* U8() const { return (unsigned char*)(a->ws + WS_UT); }
    __device__ __forceinline__ unsigned char* V8() const { return (unsigned char*)(a->ws + WS_VT); }
    __device__ __forceinline__ unsigned* ctl() const { return (unsigned*)(a->ws + WS_CTL); }
};

__device__ __forceinline__ void p0_gemv(Frame& F) {
    LAS float* cact = (LAS float*)(F.lds);
    LAS float* red = (LAS float*)(F.lds + 16384);
    for (int i = F.tid; i < 4096; i += NTHR) { const float c = F.c()[i]; cact[i] = c * sigmoidf_(c); }
    __syncthreads();
    for (int item = F.bid; item < 128; item += F.G) {
        const int col0 = item * 64; const float* W; int N, cc;
        if (col0 < 6144) { W = F.ada_w(); N = 6144; cc = col0; } else { W = F.fada_w(); N = 2048; cc = col0 - 6144; }
        const float* wp = W + (size_t)(F.wave * 128) * N + cc + F.lane;
        float a0 = 0.f, a1 = 0.f, a2 = 0.f, a3 = 0.f;
#pragma unroll 8
        for (int k = 0; k < 128; ++k) { const float w = wp[(size_t)k * N]; const int kk = F.wave * 128 + k;
            a0 += cact[kk] * w; a1 += cact[1024 + kk] * w; a2 += cact[2048 + kk] * w; a3 += cact[3072 + kk] * w; }
        red[(F.wave * 4 + 0) * 64 + F.lane] = a0; red[(F.wave * 4 + 1) * 64 + F.lane] = a1; red[(F.wave * 4 + 2) * 64 + F.lane] = a2; red[(F.wave * 4 + 3) * 64 + F.lane] = a3;
        __syncthreads();
        if (F.tid < 256) { const int b = F.tid >> 6, l = F.tid & 63; float s = 0.f;
#pragma unroll
            for (int w = 0; w < 8; ++w) s += red[(w * 4 + b) * 64 + l];
            if (col0 < 6144) F.mod()[b * 6144 + cc + l] = s + F.ada_b()[cc + l]; else F.fmod()[b * 2048 + cc + l] = s + F.fada_b()[cc + l]; }
        __syncthreads();
    }
}
__device__ __forceinline__ void p0_transpose_item(const float* W, int K, int N, bf16* WT, LAS float* scr, int item, int lane) {
    const int nblk = N / 32, kb = item / nblk, nb = item % nblk, k0 = 64 * kb, n0 = 32 * nb;
#pragma unroll 8
    for (int i = 0; i < 32; ++i) { const int kk = 2 * i + (lane >> 5); scr[kk * 33 + (lane & 31)] = W[(size_t)(k0 + kk) * N + n0 + (lane & 31)]; }
    asm volatile("s_waitcnt lgkmcnt(0)" ::: "memory");
    const int c = lane & 7;
#pragma unroll
    for (int j = 0; j < 4; ++j) { const int n = (lane >> 3) + 8 * j; const LAS float* s = scr + (8 * c) * 33 + n;
        v4u o; o.x = pk2(s[0 * 33], s[1 * 33]); o.y = pk2(s[2 * 33], s[3 * 33]); o.z = pk2(s[4 * 33], s[5 * 33]); o.w = pk2(s[6 * 33], s[7 * 33]);
        *(v4u*)(WT + (size_t)(n0 + n) * K + k0 + 8 * c) = o; }
    asm volatile("s_waitcnt lgkmcnt(0)" ::: "memory");
}
__device__ __forceinline__ void p0_wqk_item(Frame& F, int item) {
    const int jq = item & 7, kb = (item >> 3) & 15, hh = item >> 7, h = hh >> 1, half = hh & 1;
    const float* keys = (half ? F.keys2() : F.keys1()) + (size_t)(jq * 16) * 128;
    const int k = kb * 64 + F.lane;
    const float* wrow = F.wq() + (size_t)k * 2048 + h * 256 + half * 128;
    float acc[16];
#pragma unroll
    for (int j = 0; j < 16; ++j) acc[j] = 0.f;
#pragma unroll 4
    for (int d = 0; d < 128; d += 4) {
        const f32x4 a = *(const f32x4*)(wrow + d);
#pragma unroll
        for (int j = 0; j < 16; ++j) { const float* kp = keys + j * 128 + d; acc[j] += a[0] * kp[0] + a[1] * kp[1] + a[2] * kp[2] + a[3] * kp[3]; }
    }
    bf16* o = F.Wqk_t() + (size_t)(h * 256 + half * 128 + jq * 16) * 1024 + k;
#pragma unroll
    for (int j = 0; j < 16; ++j) o[(size_t)j * 1024] = (bf16)f2bf(acc[j]);
}
__device__ __forceinline__ void p0_prologue(Frame& F) {
    if (F.bid < 128) p0_gemv(F);
    if (F.bid == 128 % F.G) { const int i = F.tid;
        F.lb()[i] = __builtin_amdgcn_rcpf(1.0f + __expf(F.lbg_f()[512 + i] - F.lbg_f()[i]));
        F.lb()[512 + i] = __builtin_amdgcn_rcpf(1.0f + __expf(F.lbg_b()[512 + i] - F.lbg_b()[i])); }
    LAS float* scr = (LAS float*)(F.lds + 32768 + F.wave * 8704);
    const int gw = F.wave * F.G + F.bid, NGW = F.G * NWAVES;
    constexpr int I_QK = 2048, I_IN = (D / 64) * (NIN / 32), I_OUT = (D / 64) * (D / 32), I_TAB = 2 * 16384 / 4;
    constexpr int NITEMS = I_QK + I_IN + I_OUT + I_TAB;
    for (int it = gw; it < NITEMS; it += NGW) {
        int r = it;
        if (r < I_QK) { p0_wqk_item(F, r); continue; } r -= I_QK;
        if (r < I_IN) { p0_transpose_item(F.w_in(), D, NIN, F.Win_t(), scr, r, F.lane); continue; } r -= I_IN;
        if (r < I_OUT) { p0_transpose_item(F.w_out(), D, D, F.Wout_t(), scr, r, F.lane); continue; } r -= I_OUT;
        { const int tab = r >= 4096, rr = (tab ? r - 4096 : r) * 4; const float* src = (tab ? F.vtab() : F.utab()) + (size_t)rr * 1024; unsigned char* dst = tab ? F.V8() : F.U8();
          const float sc = tab ? VSCALE : USCALE;
#pragma unroll
          for (int q = 0; q < 16; ++q) { const int row = rr + (q >> 2), qq = q & 3; const f32x4 v = *(const f32x4*)(src + (q >> 2) * 1024 + qq * 256 + 4 * F.lane) * sc;
              int pk = __builtin_amdgcn_cvt_pk_fp8_f32(v[0], v[1], 0, false); pk = __builtin_amdgcn_cvt_pk_fp8_f32(v[2], v[3], pk, true);
              const int sl = 2 * qq + (F.lane >> 5);
              *(int*)(dst + ((size_t)sl * 16384 + row) * CSL + 4 * (F.lane & 31)) = pk; } }
    }
}

__device__ __forceinline__ void p1_norm(Frame& F) {
    const int gwc = F.bid * NWAVES + F.wave, NGW = F.G * NWAVES;
    for (int row0 = gwc * 16; row0 < T; row0 += NGW * 16) {
        const int b = row0 >> 13; const float* mb = F.mod() + b * 6144;
        f32x4 ca[4], cb[4];
#pragma unroll
        for (int j = 0; j < 4; ++j) { const int k = 256 * j + 4 * F.lane; const f32x4 g = *(const f32x4*)(F.g_mix() + k), s = *(const f32x4*)(mb + 1024 + k); ca[j] = g * (s + 1.0f); cb[j] = *(const f32x4*)(mb + k); }
        for (int r = 0; r < 16; ++r) { const float* xr = F.x() + (size_t)(row0 + r) * D;
            f32x4 v[4]; float ss = 0.f;
#pragma unroll
            for (int j = 0; j < 4; ++j) { v[j] = *(const f32x4*)(xr + 256 * j + 4 * F.lane); ss += v[j][0] * v[j][0] + v[j][1] * v[j][1] + v[j][2] * v[j][2] + v[j][3] * v[j][3]; }
            const float rstd = __builtin_amdgcn_rsqf(wave_sum(ss) * (1.0f / D) + EPS);
            bf16* o = F.bufA() + (size_t)(row0 + r) * D;
#pragma unroll
            for (int j = 0; j < 4; ++j) { const f32x4 y = v[j] * rstd * ca[j] + cb[j]; v2u w; w.x = pk2(y[0], y[1]); w.y = pk2(y[2], y[3]); *(v2u*)(o + 256 * j + 4 * F.lane) = w; } }
    }
    const int gw = F.wave * F.G + F.bid;
    for (int n = gw; n < NQK; n += NGW) {
        const v4u w0 = *(const v4u*)(F.Wqk_t() + (size_t)n * 1024 + 8 * F.lane), w1 = *(const v4u*)(F.Wqk_t() + (size_t)n * 1024 + 512 + 8 * F.lane);
        float wv[16];
#pragma unroll
        for (int i = 0; i < 4; ++i) { wv[2 * i] = bflo(w0[i]); wv[2 * i + 1] = bfhi(w0[i]); wv[8 + 2 * i] = bflo(w1[i]); wv[8 + 2 * i + 1] = bfhi(w1[i]); }
#pragma unroll
        for (int b = 0; b < 4; ++b) { const float* sh2 = F.mod() + b * 6144 + 3072; float s = 0.f;
#pragma unroll
            for (int i = 0; i < 8; ++i) s += wv[i] * sh2[8 * F.lane + i] + wv[8 + i] * sh2[512 + 8 * F.lane + i];
            s = wave_sum(s); if (F.lane == 0) F.biasq()[b * 2048 + n] = s; }
    }
}

__device__ __forceinline__ void conv_item(Frame& F, int item, const float (&cw)[CW], float cbias) {
    LAS bf16* hbuf = (LAS bf16*)(F.lds);
    LAS float* ybuf = (LAS float*)(F.lds + 65536);
    const int tok0 = item * 32, b = tok0 >> 13, t0 = tok0 & (SEQ - 1), c = F.tid;
    for (int r = 0; r < 62; ++r) { const int t = t0 - CPAD + r; float h = 0.f;
        if (t >= 0 && t < SEQ) { const bf16* pr = F.proj() + (size_t)(b * SEQ + t) * NIN; const float a = bf2f(pr[2560 + c]), g = bf2f(pr[3072 + c]); h = a * sigmoidf_(g); }
        hbuf[r * 512 + c] = (bf16)f2bf(h); }
    __syncthreads();
    float hv[62];
#pragma unroll
    for (int r = 0; r < 62; ++r) hv[r] = bf2f(hbuf[r * 512 + c]);
#pragma unroll
    for (int tt = 0; tt < 32; ++tt) { float acc = cbias;
#pragma unroll
        for (int j = 0; j < CW; ++j) acc += cw[j] * hv[tt + j];
        ybuf[tt * 512 + c] = acc; }
    __syncthreads();
#pragma unroll
    for (int q = 0; q < 4; ++q) { const int tt = F.wave * 4 + q;
        const f32x4 y0 = *(LAS const f32x4*)(ybuf + tt * 512 + 4 * F.lane), y1 = *(LAS const f32x4*)(ybuf + tt * 512 + 256 + 4 * F.lane);
        const float mean = wave_sum((y0[0] + y0[1] + y0[2] + y0[3]) + (y1[0] + y1[1] + y1[2] + y1[3])) * (1.0f / DC);
        const f32x4 d0 = y0 - mean, d1 = y1 - mean;
        const float var = wave_sum((d0[0] * d0[0] + d0[1] * d0[1] + d0[2] * d0[2] + d0[3] * d0[3]) + (d1[0] * d1[0] + d1[1] * d1[1] + d1[2] * d1[2] + d1[3] * d1[3])) * (1.0f / DC);
        const float rstd = __builtin_amdgcn_rsqf(var + EPS);
        const f32x4 g0 = *(const f32x4*)(F.cln_g() + 4 * F.lane), g1 = *(const f32x4*)(F.cln_g() + 256 + 4 * F.lane), b0 = *(const f32x4*)(F.cln_b() + 4 * F.lane), b1 = *(const f32x4*)(F.cln_b() + 256 + 4 * F.lane);
        f32x4 z0 = d0 * rstd * g0 + b0, z1 = d1 * rstd * g1 + b1;
#pragma unroll
        for (int i = 0; i < 4; ++i) { z0[i] = z0[i] * sigmoidf_(z0[i]); z1[i] = z1[i] * sigmoidf_(z1[i]); }
        bf16* o = F.bufA() + (size_t)(tok0 + tt) * D + 512;
        v2u w0, w1; w0.x = pk2(z0[0], z0[1]); w0.y = pk2(z0[2], z0[3]); w1.x = pk2(z1[0], z1[1]); w1.y = pk2(z1[2], z1[3]);
        *(v2u*)(o + 4 * F.lane) = w0; *(v2u*)(o + 256 + 4 * F.lane) = w1; }
    __syncthreads();
}

constexpr int PQ = 272, PT = 144;
constexpr int HL_QR = 0, HL_KR = 17408, HL_QE = 34816, HL_KET = 52224, HL_VT = 70656, HL_SCM = 89088, HL_ST = 98304, HL_PBLK = 133120, HL_AV = 135168, HL_RS = 135680;
__device__ __forceinline__ bf16x8 ldf(LAS const unsigned char* base, int row, int pitch, int kbyte) { return *(LAS const bf16x8*)(base + row * pitch + kbyte); }
#define MFMA32(a, b, c) __builtin_amdgcn_mfma_f32_32x32x16_bf16((a), (b), (c), 0, 0, 0)

__device__ __forceinline__ unsigned cvtpk(float lo, float hi) { unsigned r; asm("v_cvt_pk_bf16_f32 %0, %1, %2" : "=v"(r) : "v"(lo), "v"(hi)); return r; }
template <bool FULL>
__device__ __forceinline__ void hgrn_load(Frame& F, int b, int h, int dir, int chunk, unsigned (&rz)[8], unsigned (&rv)[8], unsigned (&rq)[8]) {
    const size_t tokbase = (size_t)b * SEQ + (size_t)chunk * CHK; const int zoff = dir ? 1024 : 512, c0 = 2 * F.lane;
#pragma unroll
    for (int i = 0; i < 8; ++i) { const int p = 8 * F.wave + i, tr = dir ? (63 - p) : p; const bf16* q = F.proj() + (tokbase + tr) * NIN + h * HD;
        rz[i] = *(const unsigned*)(q + zoff + c0); rv[i] = *(const unsigned*)(q + 1536 + c0); if (FULL) rq[i] = *(const unsigned*)(q + c0); }
}
template <bool FULL, int MODE>
__device__ __forceinline__ void hgrn_chunk(Frame& F, int b, int h, int dir, int chunk, int nchunk, f32x16 (&accS)[2], float lb0, float lb1, unsigned (&rz)[8], unsigned (&rv)[8], unsigned (&rq)[8]) {
    LAS unsigned char* lds = F.lds;
    int r = F.lane & 31, hh = F.lane >> 5, c0 = 2 * F.lane;
    asm volatile("" : "+v"(r), "+v"(hh), "+v"(c0));
    const int w = F.wave, rb = w;
    const size_t tokbase = (size_t)b * SEQ + (size_t)chunk * CHK;
    {
        float f0[8], f1[8], cf0[8], cf1[8], cr0[8], cr1[8];
        float run0 = 1.f, run1 = 1.f;
#pragma unroll
        for (int i = 0; i < 8; ++i) { f0[i] = lb0 + (1.0f - lb0) * sigmoidf_(bflo(rz[i])); f1[i] = lb1 + (1.0f - lb1) * sigmoidf_(bfhi(rz[i])); run0 *= f0[i]; run1 *= f1[i]; cf0[i] = run0; cf1[i] = run1; }
        { float q0 = 1.f, q1 = 1.f;
#pragma unroll
          for (int i = 7; i >= 0; --i) { cr0[i] = q0; cr1[i] = q1; q0 *= f0[i]; q1 *= f1[i]; } }
        LAS float* pblk = (LAS float*)(lds + HL_PBLK);
        { f32x2_ t; t[0] = run0; t[1] = run1; *(LAS f32x2_*)(pblk + rb * 128 + c0) = t; }
        __syncthreads();
        f32x2_ pre = {1.f, 1.f}, post = {1.f, 1.f}, mid = {1.f, 1.f};
#pragma unroll
        for (int q = 0; q < 8; ++q) { const f32x2_ bv = *(LAS const f32x2_*)(pblk + q * 128 + c0);
            if (q < rb) pre *= bv; if (q > rb) post *= bv;
            if (rb < 4 ? (q > rb && q < 4) : (q >= 4 && q < rb)) mid *= bv; }
        if (rb == 0) { f32x2_ t; t[0] = run0 * post[0]; t[1] = run1 * post[1]; *(LAS f32x2_*)((LAS float*)(lds + HL_AV) + c0) = t; }
        float ke0[8], ke1[8];
#pragma unroll
        for (int i = 0; i < 8; ++i) { const float k0 = 1.0f - f0[i], k1 = 1.0f - f1[i];
            ke0[i] = k0 * cr0[i] * post[0]; ke1[i] = k1 * cr1[i] * post[1];
            if (FULL) { const int p = 8 * rb + i; const float q0 = bflo(rq[i]), q1 = bfhi(rq[i]); const float qs0 = q0 * sigmoidf_(q0), qs1 = q1 * sigmoidf_(q1);
                const float G0 = (rb < 4 ? cr0[i] : cf0[i]) * mid[0], G1 = (rb < 4 ? cr1[i] : cf1[i]) * mid[1], iG0 = __builtin_amdgcn_rcpf(G0), iG1 = __builtin_amdgcn_rcpf(G1);
                *(LAS unsigned*)(lds + HL_QE + p * PQ + c0 * 2) = cvtpk(qs0 * pre[0] * cf0[i], qs1 * pre[1] * cf1[i]);
                *(LAS unsigned*)(lds + HL_QR + p * PQ + c0 * 2) = cvtpk(qs0 * (rb < 4 ? iG0 : G0), qs1 * (rb < 4 ? iG1 : G1));
                *(LAS unsigned*)(lds + HL_KR + p * PQ + c0 * 2) = cvtpk(k0 * (rb < 4 ? G0 : iG0), k1 * (rb < 4 ? G1 : iG1)); } }
        v4u ka, kb, va, vb2;
        ka.x = cvtpk(ke0[0], ke0[1]); ka.y = cvtpk(ke0[2], ke0[3]); ka.z = cvtpk(ke0[4], ke0[5]); ka.w = cvtpk(ke0[6], ke0[7]);
        kb.x = cvtpk(ke1[0], ke1[1]); kb.y = cvtpk(ke1[2], ke1[3]); kb.z = cvtpk(ke1[4], ke1[5]); kb.w = cvtpk(ke1[6], ke1[7]);
        va.x = (rv[0] & 0xffffu) | (rv[1] << 16); va.y = (rv[2] & 0xffffu) | (rv[3] << 16); va.z = (rv[4] & 0xffffu) | (rv[5] << 16); va.w = (rv[6] & 0xffffu) | (rv[7] << 16);
        vb2.x = (rv[0] >> 16) | (rv[1] & 0xffff0000u); vb2.y = (rv[2] >> 16) | (rv[3] & 0xffff0000u); vb2.z = (rv[4] >> 16) | (rv[5] & 0xffff0000u); vb2.w = (rv[6] >> 16) | (rv[7] & 0xffff0000u);
        *(LAS v4u*)(lds + HL_KET + c0 * PT + 16 * rb) = ka; *(LAS v4u*)(lds + HL_KET + (c0 + 1) * PT + 16 * rb) = kb;
        *(LAS v4u*)(lds + HL_VT + c0 * PT + 16 * rb) = va; *(LAS v4u*)(lds + HL_VT + (c0 + 1) * PT + 16 * rb) = vb2;
    }
    if (nchunk >= 0) hgrn_load<FULL>(F, b, h, dir, nchunk, rz, rv, rq);
    __syncthreads();
    const int pbO = w & 1, vb = w >> 1;
    f32x16 accO, accU[2];
#pragma unroll
    for (int i = 0; i < 16; ++i) { accO[i] = 0.f; accU[0][i] = 0.f; accU[1][i] = 0.f; }
    if (FULL) {
        if (w < 3) { const int pbS = (w + 1) >> 1, sbS = (w == 2) ? 1 : 0; f32x16 sc;
#pragma unroll
            for (int i = 0; i < 16; ++i) sc[i] = 0.f;
#pragma unroll
            for (int s = 0; s < 8; ++s) sc = MFMA32(ldf(lds + HL_QR, pbS * 32 + r, PQ, 32 * s + 16 * hh), ldf(lds + HL_KR, sbS * 32 + r, PQ, 32 * s + 16 * hh), sc);
#pragma unroll
            for (int i = 0; i < 16; i += 2) { const int p = pbS * 32 + (i & 3) + 8 * (i >> 2) + 4 * hh, s = sbS * 32 + r;
                const unsigned pkd = cvtpk(s <= p ? sc[i] : 0.f, s <= p + 1 ? sc[i + 1] : 0.f);
                *(LAS bf16*)(lds + HL_SCM + p * PT + s * 2) = (bf16)pkd; *(LAS bf16*)(lds + HL_SCM + (p + 1) * PT + s * 2) = (bf16)(pkd >> 16); } }
        __builtin_amdgcn_sched_barrier(0);
#pragma unroll
        for (int s = 0; s < 8; ++s) accO = MFMA32(ldf(lds + HL_QE, pbO * 32 + r, PQ, 32 * s + 16 * hh), ldf(lds + HL_ST, vb * 32 + r, PQ, 32 * s + 16 * hh), accO);
        __builtin_amdgcn_sched_barrier(0);
    }
#pragma unroll
    for (int i = 0; i < 2; ++i) { const int db = 2 * (w & 1) + i;
#pragma unroll
        for (int s = 0; s < 4; ++s) accU[i] = MFMA32(ldf(lds + HL_VT, vb * 32 + r, PT, 32 * s + 16 * hh), ldf(lds + HL_KET, db * 32 + r, PT, 32 * s + 16 * hh), accU[i]); }
    __builtin_amdgcn_sched_barrier(0);
    if (FULL) __syncthreads();
    if (FULL) {
        const unsigned v = vb * 32 + r;
        const unsigned lrow = (MODE == 0 ? (unsigned)hh : (unsigned)(1 - hh)) * 4u;
        const size_t rbase = (MODE == 0) ? (tokbase + pbO * 32) : (tokbase + 63 - pbO * 32 - 4);
        const unsigned lo_of = lrow * DH + v, lo_pr = lrow * NIN + v, lo_a2 = lrow * D + v;
        float ofv[16]; unsigned gv[16];
        if (MODE == 1) {
#pragma unroll
            for (int i = 0; i < 16; ++i) { const int ci = (i & 3) + 8 * (i >> 2); ofv[i] = (F.of() + (rbase - ci) * DH + h * HD)[lo_of]; } }
        for (int sb = 0; sb <= pbO; ++sb)
#pragma unroll
            for (int s2 = 0; s2 < 2; ++s2) accO = MFMA32(ldf(lds + HL_SCM, pbO * 32 + r, PT, 64 * sb + 32 * s2 + 16 * hh), ldf(lds + HL_VT, vb * 32 + r, PT, 64 * sb + 32 * s2 + 16 * hh), accO);
        if (MODE == 0) {
#pragma unroll
            for (int i = 0; i < 16; ++i) { const int ci = (i & 3) + 8 * (i >> 2); (F.of() + (rbase + ci) * DH + h * HD)[lo_of] = accO[i]; }
        } else {
            LAS float* rs = (LAS float*)(lds + HL_RS);
#pragma unroll
            for (int i = 0; i < 16; ++i) { const int ci = (i & 3) + 8 * (i >> 2); gv[i] = (F.proj() + (rbase - ci) * NIN + 2048 + h * HD)[lo_pr]; }
            float ov[16];
#pragma unroll
            for (int i = 0; i < 16; ++i) { const int ci = (i & 3) + 8 * (i >> 2), p = pbO * 32 + ci + 4 * hh;
                ov[i] = accO[i] + ofv[i]; float ss = ov[i] * ov[i];
                ss = DPP_ADD(ss, 0x128); ss = DPP_ADD(ss, 0x124); ss = DPP_ADD(ss, 0x122); ss = DPP_ADD(ss, 0x121); ss += __shfl_xor(ss, 16);
                if (r == 0) rs[p * 4 + vb] = ss; }
            __syncthreads();
            const float ng = F.hnorm_g()[h * HD + v];
#pragma unroll
            for (int i = 0; i < 16; ++i) { const int ci = (i & 3) + 8 * (i >> 2), p = pbO * 32 + ci + 4 * hh;
                const f32x4 q = *(LAS const f32x4*)(rs + p * 4);
                const float rstd = __builtin_amdgcn_rsqf((q[0] + q[1] + q[2] + q[3]) * (1.0f / HD) + EPS);
                const float g = bf2f(gv[i]);
                (F.bufA() + (rbase - ci) * D + h * HD)[lo_a2] = (bf16)cvtpk(ov[i] * rstd * ng * g * sigmoidf_(g), 0.f); }
        }
    }
    {
        const LAS float* av = (const LAS float*)(lds + HL_AV);
#pragma unroll
        for (int i = 0; i < 2; ++i) { const int db = 2 * (w & 1) + i; const float a = av[db * 32 + r];
#pragma unroll
            for (int j = 0; j < 16; j += 2) { const float s0 = accS[i][j] * a + accU[i][j], s1 = accS[i][j + 1] * a + accU[i][j + 1]; accS[i][j] = s0; accS[i][j + 1] = s1;
                if (FULL) { const int vv = vb * 32 + (j & 3) + 8 * (j >> 2) + 4 * hh; const unsigned pkd = cvtpk(s0, s1);
                    *(LAS bf16*)(lds + HL_ST + vv * PQ + (db * 32 + r) * 2) = (bf16)pkd; *(LAS bf16*)(lds + HL_ST + (vv + 1) * PQ + (db * 32 + r) * 2) = (bf16)(pkd >> 16); } } }
    }
    __syncthreads();
}
__device__ __forceinline__ void h1_item(Frame& F, int item) {
    const int seg = item & 15, dir = (item >> 4) & 1, h = (item >> 5) & 3, b = item >> 7;
    const float lb0 = F.lb()[dir * 512 + h * HD + 2 * F.lane], lb1 = F.lb()[dir * 512 + h * HD + 2 * F.lane + 1];
    f32x16 accS[2];
#pragma unroll
    for (int i = 0; i < 16; ++i) { accS[0][i] = 0.f; accS[1][i] = 0.f; }
    float atot = 1.f; const int col = F.tid & 127;
    unsigned rz[8], rv[8], rq[8];
    hgrn_load<false>(F, b, h, dir, seg * SEGC + (dir ? (SEGC - 1) : 0), rz, rv, rq);
    for (int c = 0; c < SEGC; ++c) { const int chunk = seg * SEGC + (dir ? (SEGC - 1 - c) : c), nchunk = (c + 1 < SEGC) ? (seg * SEGC + (dir ? (SEGC - 2 - c) : (c + 1))) : -1;
        hgrn_chunk<false, 0>(F, b, h, dir, chunk, nchunk, accS, lb0, lb1, rz, rv, rq);
        atot *= ((const LAS float*)(F.lds + HL_AV))[col]; }
    if (F.tid < 128) F.sega()[(size_t)item * 128 + col] = atot;
    float* U = F.segu() + (size_t)item * 16384;
#pragma unroll
    for (int i = 0; i < 2; ++i)
#pragma unroll
        for (int j = 0; j < 16; ++j) (U + (i * 16 + j) * NTHR)[F.tid] = accS[i][j];
}
__device__ __forceinline__ void h2_init_state(Frame& F, int b, int h, int dir, int seg, f32x16 (&accS)[2]) {
    const int w = F.wave, r = F.lane & 31, hh = F.lane >> 5, vb = w >> 1;
#pragma unroll
    for (int i = 0; i < 16; ++i) { accS[0][i] = 0.f; accS[1][i] = 0.f; }
    const int base = ((b * 4 + h) * 2 + dir) * 16;
    const int n = dir ? (NSEG - 1 - seg) : seg;
    for (int q = 0; q < n; ++q) { const int s = dir ? (NSEG - 1 - q) : q;
        const float* U = F.segu() + (size_t)(base + s) * 16384; const float* A = F.sega() + (size_t)(base + s) * 128;
#pragma unroll
        for (int i = 0; i < 2; ++i) { const int db = 2 * (w & 1) + i; const float a = (A + db * 32)[r];
#pragma unroll
            for (int j = 0; j < 16; ++j) accS[i][j] = accS[i][j] * a + (U + (i * 16 + j) * NTHR)[F.tid]; } }
#pragma unroll
    for (int i = 0; i < 2; ++i) { const int db = 2 * (w & 1) + i;
#pragma unroll
        for (int j = 0; j < 16; ++j) { const int vv = vb * 32 + (j & 3) + 8 * (j >> 2) + 4 * hh; *(LAS bf16*)(F.lds + HL_ST + vv * PQ + (db * 32 + r) * 2) = (bf16)f2bf(accS[i][j]); } }
    __syncthreads();
}
__device__ __forceinline__ void h2_item(Frame& F, int item) {
    const int seg = item & 15, h = (item >> 4) & 3, b = item >> 6;
    f32x16 accS[2];
    unsigned rz[8], rv[8], rq[8];
    { const float lb0 = F.lb()[h * HD + 2 * F.lane], lb1 = F.lb()[h * HD + 2 * F.lane + 1];
      hgrn_load<true>(F, b, h, 0, seg * SEGC, rz, rv, rq);
      h2_init_state(F, b, h, 0, seg, accS);
      for (int c = 0; c < SEGC; ++c) hgrn_chunk<true, 0>(F, b, h, 0, seg * SEGC + c, (c + 1 < SEGC) ? (seg * SEGC + c + 1) : -1, accS, lb0, lb1, rz, rv, rq); }
    asm volatile("s_waitcnt vmcnt(0)" ::: "memory");
    __syncthreads();
    { const float lb0 = F.lb()[512 + h * HD + 2 * F.lane], lb1 = F.lb()[512 + h * HD + 2 * F.lane + 1];
      hgrn_load<true>(F, b, h, 1, seg * SEGC + SEGC - 1, rz, rv, rq);
      h2_init_state(F, b, h, 1, seg, accS);
      for (int c = 0; c < SEGC; ++c) hgrn_chunk<true, 1>(F, b, h, 1, seg * SEGC + (SEGC - 1 - c), (c + 1 < SEGC) ? (seg * SEGC + SEGC - 2 - c) : -1, accS, lb0, lb1, rz, rv, rq); }
}

__device__ __forceinline__ unsigned f2key(float f) { const unsigned u = __builtin_bit_cast(unsigned, f); return (u & 0x80000000u) ? ~u : (u | 0x80000000u); }
__device__ __forceinline__ float key2f(unsigned k) { const unsigned u = (k & 0x80000000u) ? (k & 0x7fffffffu) : ~k; return __builtin_bit_cast(float, u); }
__device__ __forceinline__ unsigned umax_(unsigned a, unsigned b) { return a > b ? a : b; }
__device__ __forceinline__ unsigned umin_(unsigned a, unsigned b) { return a < b ? a : b; }
__device__ __forceinline__ void sort16(unsigned (&a)[16]) {
#pragma unroll
    for (int k = 2; k <= 16; k <<= 1)
#pragma unroll
        for (int j = k >> 1; j > 0; j >>= 1)
#pragma unroll
            for (int i = 0; i < 16; ++i) { const int l = i ^ j; if (l > i) { const bool desc = ((i & k) == 0); const unsigned x = a[i], y = a[l], mx = umax_(x, y), mn = umin_(x, y); a[i] = desc ? mx : mn; a[l] = desc ? mn : mx; } }
}
__device__ __forceinline__ void merge16(unsigned (&a)[16], const unsigned (&b)[16]) {
#pragma unroll
    for (int i = 0; i < 16; ++i) a[i] = umax_(a[i], b[15 - i]);
#pragma unroll
    for (int j = 8; j > 0; j >>= 1)
#pragma unroll
        for (int i = 0; i < 16; ++i) { const int l = i ^ j; if (l > i) { const unsigned x = a[i], y = a[l]; a[i] = umax_(x, y); a[l] = umin_(x, y); } }
}
__device__ __forceinline__ unsigned dpp_swap1(unsigned v) { return (unsigned)__builtin_amdgcn_update_dpp(0, (int)v, 0xB1, 0xF, 0xF, false); }
__device__ __forceinline__ unsigned pick_byte(const unsigned (&pk)[4], unsigned a) {
    const unsigned wsel = a >> 2; unsigned v = wsel == 0 ? pk[0] : (wsel == 1 ? pk[1] : (wsel == 2 ? pk[2] : pk[3]));
    return (v >> ((a & 3u) * 8u)) & 0xffu;
}
__device__ __forceinline__ void p7_topk(Frame& F) {
    const int NT = T * PHEADS * 2;
    for (int g0 = (F.bid * NWAVES + F.wave) * 64; g0 < NT; g0 += F.G * NTHR) {
        const int g = g0 + F.lane; const float* sp = F.scores() + (size_t)g * 128;
        unsigned top[16];
#pragma unroll
        for (int grp = 0; grp < 8; ++grp) { unsigned k[16];
#pragma unroll
            for (int q = 0; q < 4; ++q) { const f32x4 v = *(const f32x4*)(sp + grp * 16 + q * 4);
#pragma unroll
                for (int e = 0; e < 4; ++e) { const int j = grp * 16 + q * 4 + e; k[q * 4 + e] = (f2key(v[e]) & ~0x7fu) | (unsigned)(127 - j); } }
            sort16(k);
            if (grp == 0) {
#pragma unroll
                for (int i = 0; i < 16; ++i) top[i] = k[i];
            } else merge16(top, k); }
        float vO[16], vP[16]; unsigned iOpk[4] = {0u, 0u, 0u, 0u}, iPpk[4] = {0u, 0u, 0u, 0u};
#pragma unroll
        for (int i = 0; i < 16; ++i) { const unsigned t = top[i], tp = dpp_swap1(t);
            vO[i] = key2f(t & ~0x7fu); vP[i] = key2f(tp & ~0x7fu);
            iOpk[i >> 2] |= (127u - (t & 0x7fu)) << ((i & 3) * 8); iPpk[i >> 2] |= (127u - (tp & 0x7fu)) << ((i & 3) * 8); }
        unsigned R[16], G1[16], G2[16], G3[16];
#define CAND(a, b) ((f2key(vO[a] + vP[b]) & ~0xffu) | (unsigned)(((a) << 4) | (b)))
#pragma unroll
        for (int i = 0; i < 16; ++i) R[i] = CAND(0, i);
        G1[0] = CAND(1, 0); G1[1] = CAND(1, 1); G1[2] = CAND(1, 2); G1[3] = CAND(1, 3); G1[4] = CAND(1, 4); G1[5] = CAND(1, 5); G1[6] = CAND(1, 6); G1[7] = CAND(1, 7);
        G1[8] = CAND(2, 0); G1[9] = CAND(2, 1); G1[10] = CAND(2, 2); G1[11] = CAND(2, 3); G1[12] = CAND(2, 4); G1[13] = CAND(3, 0); G1[14] = CAND(3, 1); G1[15] = CAND(3, 2);
        G2[0] = CAND(3, 3); G2[1] = CAND(4, 0); G2[2] = CAND(4, 1); G2[3] = CAND(4, 2); G2[4] = CAND(5, 0); G2[5] = CAND(5, 1); G2[6] = CAND(6, 0); G2[7] = CAND(6, 1);
        G2[8] = CAND(7, 0); G2[9] = CAND(7, 1); G2[10] = CAND(8, 0); G2[11] = CAND(9, 0); G2[12] = CAND(10, 0); G2[13] = CAND(11, 0); G2[14] = CAND(12, 0); G2[15] = CAND(13, 0);
        G3[0] = CAND(14, 0); G3[1] = CAND(15, 0);
#pragma unroll
        for (int i = 2; i < 16; ++i) G3[i] = 0u;
#undef CAND
        sort16(G1); sort16(G2); sort16(G3);
        merge16(R, G1); merge16(R, G2); merge16(R, G3);
        float sc[16], ex[16]; float sum = 0.f; unsigned eid[16];
        const bool tab0 = ((g & 1) == 0);
#pragma unroll
        for (int i = 0; i < 16; ++i) { sc[i] = key2f(R[i] & ~0xffu); const unsigned a = (R[i] >> 4) & 15u, bb = R[i] & 15u;
            const unsigned io = pick_byte(iOpk, a), ip = pick_byte(iPpk, bb);
            eid[i] = tab0 ? (io * 128u + ip) : (ip * 128u + io); }
#pragma unroll
        for (int i = 0; i < 16; ++i) { ex[i] = __expf(sc[i] - sc[0]); sum += ex[i]; }
        const float inv = 1.0f / sum;
        if (tab0) { const size_t o = (size_t)(g >> 1) * 16;
#pragma unroll
            for (int q = 0; q < 4; ++q) { v4u ev; ev.x = eid[4 * q]; ev.y = eid[4 * q + 1]; ev.z = eid[4 * q + 2]; ev.w = eid[4 * q + 3]; *(v4u*)(F.esel() + o + 4 * q) = ev;
                f32x4 wv; wv[0] = ex[4 * q] * inv; wv[1] = ex[4 * q + 1] * inv; wv[2] = ex[4 * q + 2] * inv; wv[3] = ex[4 * q + 3] * inv; *(f32x4*)(F.wsel() + o + 4 * q) = wv; } }
    }
}

__device__ __forceinline__ void cvt16(const v4u& u, f32x2_ (&f)[8]) {
#pragma unroll
    for (int i = 0; i < 4; ++i) { f[2 * i] = __builtin_amdgcn_cvt_pk_f32_fp8((int)u[i], false); f[2 * i + 1] = __builtin_amdgcn_cvt_pk_f32_fp8((int)u[i], true); }
}
constexpr int PITEM = 8, NPITEM = T / PITEM;
__device__ __forceinline__ int peer_next(unsigned* q, int lane) {
    int idx = 0; if (lane == 0) idx = (int)__hip_atomic_fetch_add(q, 1u, __ATOMIC_RELAXED, __HIP_MEMORY_SCOPE_AGENT);
    return __builtin_amdgcn_readfirstlane(idx);
}
#define PEER_SB() __builtin_amdgcn_sched_barrier(0)
__device__ __forceinline__ void p8_dots(const v4u (&ud)[16], const f32x2_ (&hn)[8], int c8, float& r0, float& r1) {
#pragma unroll
    for (int i = 0; i < 16; ++i) { f32x2_ uf[8]; cvt16(ud[i], uf); f32x2_ s2 = uf[0] * hn[0];
#pragma unroll
        for (int k = 1; k < 8; ++k) s2 += uf[k] * hn[k];
        float sm = s2[0] + s2[1];
        sm = DPP_ADD(sm, 0xB1); sm = DPP_ADD(sm, 0x4E); sm = DPP_ADD(sm, 0x141);
        if (i < 8) r0 = (c8 == i) ? sm : r0; else r1 = (c8 == i - 8) ? sm : r1;
        PEER_SB(); }
}
__device__ __forceinline__ void p8_item(Frame& F, int sl, int item) {
    const int c8 = F.lane & 7, q8 = F.lane >> 3, t0 = item * PITEM, b = t0 >> 13;
    const float* sh2 = F.mod() + b * 6144 + 3072 + sl * CSL + 16 * c8;
    float shv[16];
#pragma unroll
    for (int k = 0; k < 4; ++k) { const f32x4 v = *(const f32x4*)(sh2 + 4 * k); shv[4 * k] = v[0]; shv[4 * k + 1] = v[1]; shv[4 * k + 2] = v[2]; shv[4 * k + 3] = v[3]; }
    const unsigned char* ub = F.U8() + (size_t)sl * 16384 * CSL + 16 * c8;
    const int* ep = F.esel() + (size_t)t0 * NSEL + 16 * q8;
    const bf16* hp = F.hg() + (size_t)t0 * D + sl * CSL + 16 * c8;
    const float* rp = F.rstd() + t0;
    float* po = F.pact() + ((size_t)t0 * NSL + sl) * NSEL + 16 * q8 + c8;
    v4u ea[4], eb[4], udA[16], udB[16];
#define P8_LDE(dst, tt) do { _Pragma("unroll") for (int k = 0; k < 4; ++k) dst[k] = __builtin_nontemporal_load((const v4u*)(ep + (tt) * NSEL + 4 * k)); } while (0)
#define P8_GATHER(dst, e) do { _Pragma("unroll") for (int i = 0; i < 16; ++i) dst[i] = *(const v4u*)(ub + (size_t)e[i >> 2][i & 3] * CSL); } while (0)
#define P8_HN(tt) f32x2_ hn[8]; { const v4u h0 = __builtin_nontemporal_load((const v4u*)(hp + (size_t)(tt) * D)), h1 = __builtin_nontemporal_load((const v4u*)(hp + (size_t)(tt) * D + 8)); const float rstd = rp[tt]; \
        _Pragma("unroll") for (int k = 0; k < 4; ++k) { hn[k][0] = bflo(h0[k]) * rstd + shv[2 * k]; hn[k][1] = bfhi(h0[k]) * rstd + shv[2 * k + 1]; \
            hn[4 + k][0] = bflo(h1[k]) * rstd + shv[8 + 2 * k]; hn[4 + k][1] = bfhi(h1[k]) * rstd + shv[8 + 2 * k + 1]; } }
    P8_LDE(ea, 0); P8_LDE(eb, 1);
    P8_GATHER(udA, ea);
    for (int tt = 0; tt < PITEM; tt += 2) {
        P8_GATHER(udB, eb);
        if (tt + 2 < PITEM) P8_LDE(ea, tt + 2);
        { P8_HN(tt); float r0 = 0.f, r1 = 0.f; p8_dots(udA, hn, c8, r0, r1);
          __builtin_nontemporal_store(r0 * (1.0f / USCALE), po + (size_t)tt * NSL * NSEL); __builtin_nontemporal_store(r1 * (1.0f / USCALE), po + (size_t)tt * NSL * NSEL + 8); }
        if (tt + 2 < PITEM) { P8_GATHER(udA, ea); P8_LDE(eb, tt + 3); }
        { P8_HN(tt + 1); float r0 = 0.f, r1 = 0.f; p8_dots(udB, hn, c8, r0, r1);
          __builtin_nontemporal_store(r0 * (1.0f / USCALE), po + (size_t)(tt + 1) * NSL * NSEL); __builtin_nontemporal_store(r1 * (1.0f / USCALE), po + (size_t)(tt + 1) * NSL * NSEL + 8); }
    }
#undef P8_LDE
#undef P8_GATHER
#undef P8_HN
}
__device__ __forceinline__ void p8b_coef(Frame& F) {
    const size_t N = (size_t)T * NSEL;
    for (size_t i = (size_t)F.bid * NTHR + F.tid; i < N; i += (size_t)F.G * NTHR) { const size_t t = i >> 7; const int j = (int)(i & 127);
        const float* pp = F.pact() + t * NSL * NSEL + j; float a = 0.f;
#pragma unroll
        for (int s = 0; s < NSL; ++s) a += __builtin_nontemporal_load(pp + s * NSEL);
        F.coef()[i] = F.wsel()[i] * 0.5f * a * (1.0f + erff(a * 0.70710678f)); }
}
__device__ __forceinline__ void p9_token(Frame& F, const v4u (&vd)[16], const float* cp, float* yo, LAS float* red, int c8, int q8) {
    f32x4 cc[4];
#pragma unroll
    for (int k = 0; k < 4; ++k) cc[k] = __builtin_nontemporal_load((const f32x4*)(cp + 4 * k));
    f32x2_ y[8];
#pragma unroll
    for (int k = 0; k < 8; ++k) y[k] = (f32x2_){0.f, 0.f};
#pragma unroll
    for (int i = 0; i < 16; ++i) { f32x2_ vf[8]; cvt16(vd[i], vf); const float c = cc[i >> 2][i & 3]; const f32x2_ c2 = {c, c};
#pragma unroll
        for (int k = 0; k < 8; ++k) y[k] += c2 * vf[k];
        PEER_SB(); }
#pragma unroll
    for (int k = 0; k < 4; ++k) { f32x4 o; o[0] = y[2 * k][0]; o[1] = y[2 * k][1]; o[2] = y[2 * k + 1][0]; o[3] = y[2 * k + 1][1]; *(LAS f32x4*)(red + q8 * 128 + 16 * c8 + 4 * k) = o; }
    asm volatile("s_waitcnt lgkmcnt(0)" ::: "memory");
    float s0 = 0.f, s1 = 0.f;
#pragma unroll
    for (int g = 0; g < 8; ++g) { s0 += red[g * 128 + F.lane]; s1 += red[g * 128 + 64 + F.lane]; }
    __builtin_nontemporal_store(s0 * (1.0f / VSCALE), yo + F.lane); __builtin_nontemporal_store(s1 * (1.0f / VSCALE), yo + 64 + F.lane);
    asm volatile("s_waitcnt lgkmcnt(0)" ::: "memory");
    PEER_SB();
}
__device__ __forceinline__ void p9_item(Frame& F, int sl, int item, LAS float* red  ) {
    const int c8 = F.lane & 7, q8 = F.lane >> 3, t0 = item * PITEM;
    const unsigned char* vb = F.V8() + (size_t)sl * 16384 * CSL + 16 * c8;
    const int* ep = F.esel() + (size_t)t0 * NSEL + 16 * q8; const float* cp = F.coef() + (size_t)t0 * NSEL + 16 * q8;
    float* yo = F.ybuf() + (size_t)t0 * D + sl * CSL;
    v4u ea[4], eb[4], vdA[16], vdB[16];
#define P9_LDE(dst, tt) do { _Pragma("unroll") for (int k = 0; k < 4; ++k) dst[k] = __builtin_nontemporal_load((const v4u*)(ep + (tt) * NSEL + 4 * k)); } while (0)
#define P9_GATHER(dst, e) do { _Pragma("unroll") for (int i = 0; i < 16; ++i) dst[i] = *(const v4u*)(vb + (size_t)e[i >> 2][i & 3] * CSL); } while (0)
    P9_LDE(ea, 0); P9_LDE(eb, 1);
    P9_GATHER(vdA, ea);
    for (int tt = 0; tt < PITEM; tt += 2) {
        P9_GATHER(vdB, eb);
        if (tt + 2 < PITEM) P9_LDE(ea, tt + 2);
        p9_token(F, vdA, cp + tt * NSEL, yo + (size_t)tt * D, red, c8, q8);
        if (tt + 2 < PITEM) { P9_GATHER(vdA, ea); P9_LDE(eb, tt + 3); }
        p9_token(F, vdB, cp + (tt + 1) * NSEL, yo + (size_t)(tt + 1) * D, red, c8, q8);
    }
#undef P9_LDE
#undef P9_GATHER
}
template <int SIDE>
__device__ __forceinline__ void peer_phase(Frame& F0, int rep) {
    Frame F = F0; asm volatile("" : "+v"(F.lane));
    const int s0 = (int)(xb_xcc_id() & 7u);
    unsigned* qbase = F.ctl() + (SIDE == 0 ? CW_QU : CW_QV) + rep * 64 * 32;
    LAS float* cf = (LAS float*)(F.lds) + F.wave * 1024;
    for (int k = 0; k < NSL; ++k) { const int sl = (s0 + k) & (NSL - 1);
        for (;;) { const int item = peer_next(qbase + 64 * sl, F.lane); if (item >= NPITEM) break;
            if (SIDE == 0) p8_item(F, sl, item); else p9_item(F, sl, item, cf); } }
}
__device__ __forceinline__ void p10_final(Frame& F) {
    const int gwc = F.bid * NWAVES + F.wave, NGW = F.G * NWAVES;
    for (int row0 = gwc * 16; row0 < T; row0 += NGW * 16) {
        const int b = row0 >> 13; const float* mb = F.mod() + b * 6144 + 5120; const float* fm = F.fmod() + b * 2048;
        f32x4 g2[4], ca[4], cb[4];
#pragma unroll
        for (int j = 0; j < 4; ++j) { const int k = 256 * j + 4 * F.lane; g2[j] = *(const f32x4*)(mb + k); ca[j] = *(const f32x4*)(F.fnorm_g() + k) * (*(const f32x4*)(fm + 1024 + k) + 1.0f); cb[j] = *(const f32x4*)(fm + k); }
        for (int r = 0; r < 16; ++r) { float* hr = F.out() + (size_t)(row0 + r) * D; const float* yr = F.ybuf() + (size_t)(row0 + r) * D;
            f32x4 z[4]; float ss = 0.f;
#pragma unroll
            for (int j = 0; j < 4; ++j) { z[j] = *(const f32x4*)(hr + 256 * j + 4 * F.lane) + g2[j] * *(const f32x4*)(yr + 256 * j + 4 * F.lane); ss += z[j][0] * z[j][0] + z[j][1] * z[j][1] + z[j][2] * z[j][2] + z[j][3] * z[j][3]; }
            const float rstd = __builtin_amdgcn_rsqf(wave_sum(ss) * (1.0f / D) + EPS);
#pragma unroll
            for (int j = 0; j < 4; ++j) *(f32x4*)(hr + 256 * j + 4 * F.lane) = z[j] * rstd * ca[j] + cb[j]; }
    }
}

constexpr int NPHASE = 12;
__global__ void __launch_bounds__(NTHR, 2) fwd_kernel(Args args) {
    extern __shared__ __attribute__((aligned(16))) unsigned char lds_raw[];
    Frame F;
    F.lds = (LAS unsigned char*)lds_raw;
    F.tid = threadIdx.x; F.lane = F.tid & 63; F.wave = __builtin_amdgcn_readfirstlane(F.tid >> 6); F.G = gridDim.x; F.bid = blockIdx.x;
    unsigned char* ws = args.ws; F.a = &args;
    volatile LAS unsigned* misc = (volatile LAS unsigned*)(F.lds + MISC_OFF);
    if (F.tid < 64) misc[F.tid] = 0u;
    __syncthreads();
    const int lo = args.ph_lo, hi = args.ph_hi;
    const bool multi = (hi - lo) > 1;
    XcdBarrier bar; bar.bar = (unsigned*)(ws + WS_CTL) + CW_BAR; bar.x = 0; bar.st = nullptr;
    if (multi) bar = xcd_barrier_post((unsigned*)(ws + WS_CTL) + CW_BAR, misc + 8);
#ifndef PHMASK
#define PHMASK 0xfff
#endif
#define IN(k) (((PHMASK >> (k)) & 1) && lo <= (k) && (k) < hi)
#define SEAM(k) do { if (IN(k) && IN((k) + 1)) xcd_barrier(bar); } while (0)

#ifndef REPMASK
#define REPMASK 0
#endif
#define REP(k) (((REPMASK) >> (k)) & 1)
#define REPBAR(k) if (REP(k) && rep == 0) xcd_barrier(bar)
    if (IN(0)) { for (int rep = 0; rep <= REP(0); ++rep) { p0_prologue(F); REPBAR(0); } } SEAM(0);
    if (IN(1)) { for (int rep = 0; rep <= REP(1); ++rep) { p1_norm(F); REPBAR(1); } } SEAM(1);
    if (IN(2)) { for (int rep = 0; rep <= REP(2); ++rep) { pg8::Gemm g{F.bufA(), F.Win_t(), T, NIN, D}; pg8::StaticOrder S; S.init(T, NIN, F.G, F.bid);
        pg8::EpiBf16<0> E{F.proj(), NIN, nullptr, 0, 0, 1.f};
        pg8::gemm_phase<pg8::EpiBf16<0>, pg8::StaticOrder, true, true>(F.lds, g, S, E); REPBAR(2); } } SEAM(2);
    if (IN(3)) { for (int rep = 0; rep <= REP(3); ++rep) {
        for (int it = F.bid; it < NB * NHH * 2 * NSEG; it += F.G) h1_item(F, it);
        float cw[CW];
#pragma unroll
        for (int j = 0; j < CW; ++j) cw[j] = F.conv_w()[j * DC + F.tid];
        const float cbias = F.conv_b()[F.tid];
        for (int it = F.bid; it < T / 32; it += F.G) conv_item(F, it, cw, cbias); REPBAR(3); }
    } SEAM(3);
    if (IN(4)) { for (int rep = 0; rep <= REP(4); ++rep) { for (int it = F.bid; it < NB * NHH * NSEG; it += F.G) h2_item(F, it); REPBAR(4); } } SEAM(4);
    if (IN(5)) { for (int rep = 0; rep <= REP(5); ++rep) { pg8::Gemm g{F.bufA(), F.Wout_t(), T, D, D}; pg8::StaticOrder S; S.init(T, D, F.G, F.bid);
        pg8::EpiOut E{F.x(), F.out(), F.hg(), F.mod(), F.g_ffn(), F.ssqp()};
        pg8::gemm_phase<pg8::EpiOut, pg8::StaticOrder, true, true>(F.lds, g, S, E); REPBAR(5); } } SEAM(5);
    if (IN(6)) { for (int rep = 0; rep <= REP(6); ++rep) { pg8::Gemm g{F.hg(), F.Wqk_t(), T, NQK, D}; pg8::StaticOrder S; S.init(T, NQK, F.G, F.bid);
        pg8::EpiScore E{F.scores(), F.ssqp(), F.biasq(), F.rstd()};
        pg8::gemm_phase<pg8::EpiScore, pg8::StaticOrder, true, true>(F.lds, g, S, E); REPBAR(6); } } SEAM(6);
    if (IN(7)) { for (int rep = 0; rep <= REP(7); ++rep) { p7_topk(F); REPBAR(7); } } SEAM(7);
    if (IN(8)) { for (int rep = 0; rep <= REP(8); ++rep) { peer_phase<0>(F, rep); REPBAR(8); } } SEAM(8);
    if (IN(9)) { for (int rep = 0; rep <= REP(9); ++rep) { p8b_coef(F); REPBAR(9); } } SEAM(9);
    if (IN(10)) { for (int rep = 0; rep <= REP(10); ++rep) { peer_phase<1>(F, rep); REPBAR(10); } } SEAM(10);
    if (IN(11)) { p10_final(F); }
#undef IN
#undef SEAM
}

#ifndef MK_ONE_LAUNCH
#define MK_ONE_LAUNCH 0
#endif
extern "C" void kernel_launch(void* const* d_in, const int* in_sizes, int n_in, void* d_out, int out_size, void* d_ws, size_t ws_size, hipStream_t stream) {
    static int grid = 0;
    if (grid == 0) {
        if (n_in != 23 || out_size != T * D || ws_size < WS_END) { fprintf(stderr, "kernel_launch: unexpected shapes (n_in %d, out %d, ws %zu)\n", n_in, out_size, ws_size); grid = -1; return; }
        int dev = 0, cus = 0, per_cu = 0;
        if (hipGetDevice(&dev) != hipSuccess || hipDeviceGetAttribute(&cus, hipDeviceAttributeMultiprocessorCount, dev) != hipSuccess) { grid = -1; return; }
        if (hipFuncSetAttribute((const void*)fwd_kernel, hipFuncAttributeMaxDynamicSharedMemorySize, LDS_BYTES) != hipSuccess) { fprintf(stderr, "kernel_launch: hipFuncSetAttribute failed\n"); grid = -1; return; }
        if (hipOccupancyMaxActiveBlocksPerMultiprocessor(&per_cu, (const void*)fwd_kernel, NTHR, LDS_BYTES) != hipSuccess || per_cu < 1) { fprintf(stderr, "kernel_launch: occupancy query reports %d\n", per_cu); }
        (void)hipGetLastError();
        grid = cus;
    }
    if (grid < 0) return;
    (void)hipMemsetAsync((char*)d_ws + WS_CTL, 0, CTL_ZERO_BYTES, stream);
    Args a{};
    for (int i = 0; i < 23; ++i) a.in[i] = (const float*)d_in[i];
    a.out = (float*)d_out; a.ws = (unsigned char*)d_ws;
#if MK_ONE_LAUNCH
    a.ph_lo = 0; a.ph_hi = NPHASE;
    hipLaunchKernelGGL(fwd_kernel, dim3(grid), dim3(NTHR), LDS_BYTES, stream, a);
#else
    for (int p = 0; p < NPHASE; ++p) { a.ph_lo = p; a.ph_hi = p + 1; hipLaunchKernelGGL(fwd_kernel, dim3(grid), dim3(NTHR), LDS_BYTES, stream, a); }
#endif
}
```

```cpp
#include <hip/hip_runtime.h>
#include <cstdio>
#include <cstdint>
namespace pg8 {
#define PG8_LAS __attribute__((address_space(3)))
typedef unsigned short bf16_t;
typedef short bf16x8 __attribute__((ext_vector_type(8)));
typedef float f32x4 __attribute__((ext_vector_type(4)));
typedef unsigned u32x4 __attribute__((ext_vector_type(4)));
constexpr int BM = 256, BK = 64, HALF = 128, HTB = HALF * BK * 2  , STAGE_BYTES = 8 * HTB, NXCD = 8, WGM = 8;

__host__ __device__ __forceinline__ int lds_byte(int r, int c) { const int st = (r >> 4) * 2 + (c >> 5), rr = r & 15, cc = c & 31, ob = rr * 64 + cc * 2; return st * 1024 + (ob ^ (((ob >> 9) & 1) << 5)); }
__host__ __device__ __forceinline__ void stage_rc(int b, int& R, int& C) { const int st = b / 1024, sb = b % 1024, swz = sb ^ (((sb >> 9) & 1) << 5); R = (st >> 1) * 16 + swz / 64; C = (st & 1) * 32 + (swz % 64) / 2; }
__host__ __device__ __forceinline__ int perm32(int rho) { const int n = rho >> 4, i = rho & 15; return 8 * (i >> 2) + 4 * n + (i & 3); }

struct Unit { int pm, pn; };
struct Gemm { const bf16_t* A; const bf16_t* Bt; int M, N, K; };

struct StaticOrder {
    int nM, nN, nwg, G, c;
    __host__ __device__ void init(int M, int N, int G_, int c_) { nM = M / BM; nN = N / BM; nwg = nM * nN; G = G_; c = c_; }
    __host__ __device__ bool next(int i, Unit& u) const {
        const long L = (long)i * G + c; if (L >= nwg) return false;
        int wgid = (int)L; { const int q = nwg / NXCD, r = nwg % NXCD, xcd = wgid % NXCD, off = wgid / NXCD; wgid = (xcd < r ? xcd * (q + 1) : r * (q + 1) + (xcd - r) * q) + off; }
        const int nig = WGM * nN, gid = wgid / nig, fm = gid * WGM, gsz = (nM - fm) < WGM ? (nM - fm) : WGM;
        u.pm = fm + ((wgid % nig) % gsz); u.pn = (wgid % nig) / gsz; return true;
    }
    __device__ __forceinline__ void a_ready(const Unit&) const {}
    __device__ __forceinline__ void done(const Unit&) const {}
};
__device__ __forceinline__ unsigned cvt_pk_bf16(float lo, float hi) { unsigned r; asm volatile("v_cvt_pk_bf16_f32 %0, %1, %2" : "=v"(r) : "v"(lo), "v"(hi)); return r; }
typedef float f32x2 __attribute__((ext_vector_type(2)));
__device__ __forceinline__ f32x2 gelu_pk(f32x2 v) {
    const f32x2 av = __builtin_elementwise_abs(v), d = av * 0.2316418882f + 1.0f;
    f32x2 t; t.x = __builtin_amdgcn_rcpf(d.x); t.y = __builtin_amdgcn_rcpf(d.y);
    f32x2 q = t * 0.5307027145f + (-0.7265760135f); q = q * t + 0.7107068705f; q = q * t + (-0.142248368f); q = q * t + 0.127414796f; q = q * t;
    const f32x2 s = (v * v) * (-0.72134752044f);
    f32x2 e; e.x = __builtin_amdgcn_exp2f(s.x); e.y = __builtin_amdgcn_exp2f(s.y);
    const f32x2 m = v * (q * e), r = v - m;
    f32x2 o; o.x = v.x < 0.f ? m.x : r.x; o.y = v.y < 0.f ? m.y : r.y; return o;
}

template <int ACT  > struct EpiBf16 {
    static constexpr bool PERM = true, AFTER_DRAIN = false; static_assert(ACT == 0 || ACT == 1, "EpiBf16: ACT is 0 (none) or 1 (gelu_pk)");
    bf16_t* O; int ldc; const float* bias; int split_cols; size_t split_stride; float scale0;
    __device__ __forceinline__ void operator()(const f32x4 (&acc)[2][2][4][2], const Unit& u, int wr, int wc, int fr, int fq) const {
        const int row0 = u.pm * BM + wr * 64 + fr; int colt = u.pn * BM; bf16_t* base = O;
        float sc = 1.f; if (split_cols) { const int t = colt / split_cols; base += (size_t)t * split_stride; colt -= t * split_cols; if (t == 0) sc = scale0; }
        const int col0 = colt + wc * 32 + 8 * fq, bcol0 = u.pn * BM + wc * 32 + 8 * fq;
        f32x4 bv[2][2];
#pragma unroll
        for (int bj = 0; bj < 2; ++bj)
#pragma unroll
            for (int n = 0; n < 2; ++n) bv[bj][n] = bias ? *(const f32x4*)(bias + bcol0 + bj * HALF + 4 * n) : (f32x4){0.f, 0.f, 0.f, 0.f};
#pragma unroll
        for (int ai = 0; ai < 2; ++ai)
#pragma unroll
            for (int m = 0; m < 4; ++m) { bf16_t* rowp = base + (size_t)(row0 + ai * HALF + m * 16) * ldc + col0;
#pragma unroll
                for (int bj = 0; bj < 2; ++bj) { f32x4 v0 = acc[ai][bj][m][0] + bv[bj][0], v1 = acc[ai][bj][m][1] + bv[bj][1];
                    if (ACT == 1) { f32x2 a = gelu_pk((f32x2){v0[0], v0[1]}), b = gelu_pk((f32x2){v0[2], v0[3]}), c = gelu_pk((f32x2){v1[0], v1[1]}), d = gelu_pk((f32x2){v1[2], v1[3]});
                        v0 = (f32x4){a.x, a.y, b.x, b.y}; v1 = (f32x4){c.x, c.y, d.x, d.y}; }
                    v0 = v0 * sc; v1 = v1 * sc; u32x4 w; w.x = cvt_pk_bf16(v0[0], v0[1]); w.y = cvt_pk_bf16(v0[2], v0[3]); w.z = cvt_pk_bf16(v1[0], v1[1]); w.w = cvt_pk_bf16(v1[2], v1[3]);
                    *(u32x4*)(rowp + bj * HALF) = w; } }
    }
};

struct EpiOut {
    static constexpr bool PERM = true, AFTER_DRAIN = false;
    const float* X; float* Hout; bf16_t* HG; const float* mod; const float* gffn; float* ssqp;
    __device__ __forceinline__ void operator()(const f32x4 (&acc)[2][2][4][2], const Unit& u, int wr, int wc, int fr, int fq) const {
        const int row0 = u.pm * BM + wr * 64 + fr, col0 = u.pn * BM + wc * 32 + 8 * fq;
        const int b = (u.pm * BM) >> 13;
        const float* mb = mod + b * 6144;
        f32x4 g1v[2][2], gv2[2][2];
#pragma unroll
        for (int bj = 0; bj < 2; ++bj)
#pragma unroll
            for (int n = 0; n < 2; ++n) { const int c = col0 + bj * HALF + 4 * n;
                g1v[bj][n] = *(const f32x4*)(mb + 2048 + c);
                const f32x4 s2 = *(const f32x4*)(mb + 4096 + c), gf = *(const f32x4*)(gffn + c);
                gv2[bj][n] = gf * (s2 + 1.0f); }
#pragma unroll
        for (int ai = 0; ai < 2; ++ai)
#pragma unroll
            for (int m = 0; m < 4; ++m) { const int row = row0 + ai * HALF + m * 16; const size_t ro = (size_t)row * 1024 + col0; float ss = 0.f;
#pragma unroll
                for (int bj = 0; bj < 2; ++bj) {
                    const f32x4 x0 = *(const f32x4*)(X + ro + bj * HALF), x1 = *(const f32x4*)(X + ro + bj * HALF + 4);
                    const f32x4 h0 = x0 + g1v[bj][0] * acc[ai][bj][m][0], h1 = x1 + g1v[bj][1] * acc[ai][bj][m][1];
                    { u32x4 hw; hw.x = cvt_pk_bf16(h0[0], h0[1]); hw.y = cvt_pk_bf16(h0[2], h0[3]); hw.z = cvt_pk_bf16(h1[0], h1[1]); hw.w = cvt_pk_bf16(h1[2], h1[3]);
                      *(u32x4*)((bf16_t*)Hout + (size_t)row * 2048 + col0 + bj * HALF) = hw; }
                    ss += h0[0] * h0[0] + h0[1] * h0[1] + h0[2] * h0[2] + h0[3] * h0[3] + h1[0] * h1[0] + h1[1] * h1[1] + h1[2] * h1[2] + h1[3] * h1[3];
                    const f32x4 q0 = h0 * gv2[bj][0], q1 = h1 * gv2[bj][1];
                    u32x4 w; w.x = cvt_pk_bf16(q0[0], q0[1]); w.y = cvt_pk_bf16(q0[2], q0[3]); w.z = cvt_pk_bf16(q1[0], q1[1]); w.w = cvt_pk_bf16(q1[2], q1[3]);
                    *(u32x4*)(HG + ro + bj * HALF) = w; }
                ss += __shfl_xor(ss, 16); ss += __shfl_xor(ss, 32);
                if (fq == 0) ssqp[((size_t)u.pn * 32768 + row) * 4 + wc] = ss; }
    }
};
struct EpiScore {
    static constexpr bool PERM = false, AFTER_DRAIN = false;
    float* S; const float* ssqp; const float* biasq; float* rstd_out;
    __device__ __forceinline__ void operator()(const f32x4 (&acc)[2][2][4][2], const Unit& u, int wr, int wc, int fr, int fq) const {
        const int row0 = u.pm * BM + wr * 64 + fr, col0 = u.pn * BM + wc * 32 + 4 * fq;
        const int b = (u.pm * BM) >> 13;
        f32x4 bv[2][2];
#pragma unroll
        for (int bj = 0; bj < 2; ++bj)
#pragma unroll
            for (int n = 0; n < 2; ++n) bv[bj][n] = *(const f32x4*)(biasq + b * 2048 + col0 + bj * HALF + n * 16);
#pragma unroll
        for (int ai = 0; ai < 2; ++ai)
#pragma unroll
            for (int m = 0; m < 4; ++m) { const int row = row0 + ai * HALF + m * 16;
                const f32x4 p0 = *(const f32x4*)(ssqp + (size_t)row * 4), p1 = *(const f32x4*)(ssqp + ((size_t)32768 + row) * 4), p2 = *(const f32x4*)(ssqp + ((size_t)65536 + row) * 4), p3 = *(const f32x4*)(ssqp + ((size_t)98304 + row) * 4);
                const float tot = (p0[0] + p0[1] + p0[2] + p0[3]) + (p1[0] + p1[1] + p1[2] + p1[3]) + (p2[0] + p2[1] + p2[2] + p2[3]) + (p3[0] + p3[1] + p3[2] + p3[3]);
                const float rstd = __builtin_amdgcn_rsqf(tot * (1.0f / 1024.0f) + 1e-6f);
                if (u.pn == 0 && wc == 0 && fq == 0) rstd_out[row] = rstd;
                float* rowp = S + (size_t)row * 2048 + col0;
#pragma unroll
                for (int bj = 0; bj < 2; ++bj)
#pragma unroll
                    for (int n = 0; n < 2; ++n) *(f32x4*)(rowp + bj * HALF + n * 16) = acc[ai][bj][m][n] * rstd + bv[bj][n]; }
    }
};
template <class Epi, class Sched, bool ALIGN_EPI = false, bool SP2 = false>
__device__ __forceinline__ void gemm_phase(PG8_LAS unsigned char* lds, const Gemm g, const Sched& S, const Epi& E) {
    const int tid = threadIdx.x, wid = __builtin_amdgcn_readfirstlane(tid >> 6), lane = tid & 63, wr = wid >> 2, wc = wid & 3, fr = lane & 15, fq = lane >> 4;
    const int K = g.K, nt = K / BK;
    unsigned voffA[2], voffB[2];
#pragma unroll
    for (int i = 0; i < 2; ++i) { int R, C; stage_rc(tid * 16 + i * 8192, R, C); const int Rb = Epi::PERM ? ((R & ~31) + perm32(R & 31)) : R;
        voffA[i] = (unsigned)(R * K + C) * 2u; voffB[i] = (unsigned)(Rb * K + C) * 2u; }
    const size_t kstep = (size_t)(BK * 2);
    const size_t hstep = (size_t)HALF * K * 2;
    const size_t tstep = 2 * hstep;
    const unsigned ldsw = (unsigned)wid * 1024u;
    const int aoff = lds_byte(wr * 64 + fr, fq * 8), boff = lds_byte(wc * 32 + fr, fq * 8);
#define PG8_SA(b, h) (((b) * 2 + (h)) * HTB)
#define PG8_SB(b, h) ((4 + (b) * 2 + (h)) * HTB)
#define PG8_STAGE(bufoff, gbase, voff) do { _Pragma("unroll") for (int _i = 0; _i < 2; ++_i) \
        __builtin_amdgcn_global_load_lds((const unsigned*)((const char*)(gbase) + (voff)[_i]), (PG8_LAS unsigned*)(lds + (bufoff) + ldsw + _i * 8192), 16, 0, 0); } while (0)
#define PG8_LDA(dst, b, h) do { _Pragma("unroll") for (int m = 0; m < 4; ++m) _Pragma("unroll") for (int k = 0; k < 2; ++k) dst[m][k] = *(const PG8_LAS bf16x8*)(lds + PG8_SA(b, h) + aoff + m * 2048 + k * 1024); } while (0)
#define PG8_LDB(dst, b, h) do { _Pragma("unroll") for (int n = 0; n < 2; ++n) _Pragma("unroll") for (int k = 0; k < 2; ++k) dst[n][k] = *(const PG8_LAS bf16x8*)(lds + PG8_SB(b, h) + boff + n * 2048 + k * 1024); } while (0)
#define PG8_MMA(ai, bj, At, Bt) do { __builtin_amdgcn_s_setprio(1); _Pragma("unroll") for (int m = 0; m < 4; ++m) _Pragma("unroll") for (int n = 0; n < 2; ++n) _Pragma("unroll") for (int k = 0; k < 2; ++k) \
        acc[ai][bj][m][n] = __builtin_amdgcn_mfma_f32_16x16x32_bf16(Bt[n][k], At[m][k], acc[ai][bj][m][n], 0, 0, 0); __builtin_amdgcn_s_setprio(0); } while (0)
#define PG8_WAIT_V(n) asm volatile("s_waitcnt vmcnt(" #n ")" ::: "memory")
#define PG8_WAIT_L(n) asm volatile("s_waitcnt lgkmcnt(" #n ")" ::: "memory")
#define PG8_BAR __builtin_amdgcn_s_barrier()
#define PG8_SCHED __builtin_amdgcn_sched_barrier(0)
    Unit cur, nxt; int ui = 0;
    if (!S.next(0, cur)) return;
    f32x4 acc[2][2][4][2];
#pragma unroll
    for (int a = 0; a < 2; ++a)
#pragma unroll
        for (int b = 0; b < 2; ++b)
#pragma unroll
            for (int m = 0; m < 4; ++m)
#pragma unroll
                for (int n = 0; n < 2; ++n) acc[a][b][m][n] = (f32x4){0.f, 0.f, 0.f, 0.f};
    bf16x8 At[4][2], B0[2][2], B1[2][2];
    const char* cA = (const char*)g.A + (size_t)cur.pm * tstep; const char* cB = (const char*)g.Bt + (size_t)cur.pn * tstep;
    S.a_ready(cur);
    if constexpr (SP2) {
        PG8_STAGE(PG8_SB(0, 0), cB, voffB); PG8_STAGE(PG8_SB(0, 1), cB + hstep, voffB); PG8_STAGE(PG8_SA(0, 0), cA, voffA); PG8_STAGE(PG8_SA(0, 1), cA + hstep, voffA);
        if (wr == 1) PG8_BAR;
        PG8_WAIT_V(2); PG8_BAR;
        PG8_STAGE(PG8_SB(1, 0), cB + kstep, voffB); PG8_STAGE(PG8_SA(1, 0), cA + kstep, voffA); PG8_STAGE(PG8_SB(1, 1), cB + hstep + kstep, voffB);
        PG8_WAIT_V(6); PG8_BAR;
    } else {
        PG8_STAGE(PG8_SB(0, 0), cB, voffB); PG8_STAGE(PG8_SA(0, 0), cA, voffA); PG8_STAGE(PG8_SB(0, 1), cB + hstep, voffB); PG8_STAGE(PG8_SA(0, 1), cA + hstep, voffA);
        if (wr == 1) PG8_BAR;
        PG8_WAIT_V(4); PG8_BAR;
        PG8_STAGE(PG8_SB(1, 0), cB + kstep, voffB); PG8_STAGE(PG8_SA(1, 0), cA + kstep, voffA); PG8_STAGE(PG8_SB(1, 1), cB + hstep + kstep, voffB);
        PG8_WAIT_V(6); PG8_BAR;
    }
    for (;;) {
        const bool has_next = S.next(ui + 1, nxt);
        const char* nA = has_next ? (const char*)g.A + (size_t)nxt.pm * tstep : cA; const char* nB = has_next ? (const char*)g.Bt + (size_t)nxt.pn * tstep : cB;
        for (int t = 0; t < nt; t += 2) {
            const bool last = (t == nt - 2);
            const char* a1 = cA + (size_t)(t + 1) * kstep;
            const char* a2 = last ? nA : cA + (size_t)(t + 2) * kstep; const char* b2 = last ? nB : cB + (size_t)(t + 2) * kstep;
            const char* a3 = a2 + kstep; const char* b3 = b2 + kstep;
            if (last && has_next) S.a_ready(nxt);
            if constexpr (SP2) {
            PG8_LDB(B0, 0, 0); PG8_LDB(B1, 0, 1); PG8_SCHED; PG8_LDA(At, 0, 0); PG8_STAGE(PG8_SA(1, 1), a1 + hstep, voffA);
            PG8_WAIT_V(8); PG8_WAIT_L(0); PG8_BAR; PG8_MMA(0, 0, At, B0); PG8_MMA(0, 1, At, B1); PG8_BAR; PG8_SCHED;
            PG8_LDA(At, 0, 1); PG8_STAGE(PG8_SB(0, 0), b2, voffB); PG8_STAGE(PG8_SB(0, 1), b2 + hstep, voffB); PG8_STAGE(PG8_SA(0, 0), a2, voffA);
            PG8_WAIT_V(8); PG8_WAIT_L(0); PG8_BAR; PG8_MMA(1, 0, At, B0); PG8_MMA(1, 1, At, B1); PG8_BAR; PG8_SCHED;
            PG8_LDB(B0, 1, 0); PG8_LDB(B1, 1, 1); PG8_SCHED; PG8_LDA(At, 1, 0); PG8_STAGE(PG8_SA(0, 1), a2 + hstep, voffA);
            PG8_WAIT_V(8); PG8_WAIT_L(0); PG8_BAR; PG8_MMA(0, 0, At, B0); PG8_MMA(0, 1, At, B1); PG8_BAR; PG8_SCHED;
            PG8_LDA(At, 1, 1); PG8_STAGE(PG8_SB(1, 0), b3, voffB); PG8_STAGE(PG8_SB(1, 1), b3 + hstep, voffB); PG8_STAGE(PG8_SA(1, 0), a3, voffA);
            PG8_WAIT_V(8); PG8_WAIT_L(0); PG8_BAR; PG8_MMA(1, 0, At, B0); PG8_MMA(1, 1, At, B1); PG8_BAR; PG8_SCHED;
            } else {
            PG8_LDB(B0, 0, 0); PG8_SCHED; PG8_LDA(At, 0, 0); PG8_STAGE(PG8_SA(1, 1), a1 + hstep, voffA);
            PG8_WAIT_L(8); PG8_BAR; PG8_WAIT_L(0); PG8_MMA(0, 0, At, B0); PG8_BAR; PG8_SCHED;
            PG8_LDB(B1, 0, 1); PG8_STAGE(PG8_SB(0, 0), b2, voffB);
            PG8_BAR; PG8_WAIT_L(0); PG8_MMA(0, 1, At, B1); PG8_BAR;
            PG8_LDA(At, 0, 1); PG8_STAGE(PG8_SA(0, 0), a2, voffA);
            PG8_BAR; PG8_WAIT_L(0); PG8_MMA(1, 0, At, B0); PG8_BAR; PG8_SCHED;
            PG8_STAGE(PG8_SB(0, 1), b2 + hstep, voffB);
            PG8_WAIT_V(6); PG8_BAR; PG8_MMA(1, 1, At, B1); PG8_BAR;
            PG8_LDB(B0, 1, 0); PG8_SCHED; PG8_LDA(At, 1, 0); PG8_STAGE(PG8_SA(0, 1), a2 + hstep, voffA);
            PG8_WAIT_L(8); PG8_BAR; PG8_WAIT_L(0); PG8_MMA(0, 0, At, B0); PG8_BAR; PG8_SCHED;
            PG8_LDB(B1, 1, 1); PG8_STAGE(PG8_SB(1, 0), b3, voffB);
            PG8_BAR; PG8_WAIT_L(0); PG8_MMA(0, 1, At, B1); PG8_BAR;
            PG8_LDA(At, 1, 1); PG8_STAGE(PG8_SA(1, 0), a3, voffA);
            PG8_BAR; PG8_WAIT_L(0); PG8_MMA(1, 0, At, B0); PG8_BAR; PG8_SCHED;
            PG8_STAGE(PG8_SB(1, 1), b3 + hstep, voffB);
            PG8_WAIT_V(6); PG8_BAR; PG8_MMA(1, 1, At, B1); PG8_BAR;
            }
        }
        if constexpr (ALIGN_EPI) { if (wr == 0) PG8_BAR; }
        if constexpr (!Epi::AFTER_DRAIN) { E(acc, cur, wr, wc, fr, fq); S.done(cur); }
        if (!has_next) break;
#pragma unroll
        for (int a = 0; a < 2; ++a)
#pragma unroll
            for (int b = 0; b < 2; ++b)
#pragma unroll
                for (int m = 0; m < 4; ++m)
#pragma unroll
                    for (int n = 0; n < 2; ++n) acc[a][b][m][n] = (f32x4){0.f, 0.f, 0.f, 0.f};
        cur = nxt; cA = nA; cB = nB; ++ui;
        if constexpr (ALIGN_EPI) { if (wr == 1) PG8_BAR; }
    }
    PG8_WAIT_V(0);
    if constexpr (!ALIGN_EPI) { if (wr == 0) PG8_BAR; }
    PG8_BAR;
    if constexpr (Epi::AFTER_DRAIN) { E.fused(acc, cur, wr, wc, fr, fq, lds, wid, lane); S.done(cur); }
#undef PG8_SA
#undef PG8_SB
#undef PG8_STAGE
#undef PG8_LDA
#undef PG8_LDB
#undef PG8_MMA
#undef PG8_WAIT_V
#undef PG8_WAIT_L
#undef PG8_BAR
#undef PG8_SCHED
}
}
#define MK_ONE_LAUNCH 1

constexpr int NB = 4, SEQ = 8192, T = NB * SEQ, D = 1024;
constexpr int NIN = 3584, DH = 512, HD = 128, NHH = 4, CHK = 64;
constexpr int NSEG = 16, SEGC = 8;
constexpr int CW = 31, CPAD = 15, DC = 512;
constexpr int PHEADS = 8, NQK = 2048, NSEL = 128;
constexpr float EPS = 1e-6f;
constexpr int NWAVES = 8, NTHR = 512;

constexpr size_t MiB = 1u << 20;
constexpr size_t WS_CTL = 0, CTL_ZERO_BYTES = 65536;
constexpr size_t WS_MOD = 1 * MiB, WS_FMOD = WS_MOD + 131072, WS_LB = WS_MOD + 196608, WS_BIASQ = WS_MOD + 262144;
constexpr size_t WS_WIN = 2 * MiB, WS_WOUT = 10 * MiB, WS_WQK = 12 * MiB;
constexpr size_t WS_UT = 16 * MiB, WS_VT = 48 * MiB;
constexpr size_t WS_BUFA = 80 * MiB;
constexpr size_t WS_BUFB = 144 * MiB;
constexpr size_t WS_SEG = 208 * MiB;
constexpr size_t WS_E = 208 * MiB, WS_W = 224 * MiB;
constexpr size_t WS_BIG = 240 * MiB;
constexpr size_t WS_SSQ = 496 * MiB;
constexpr size_t WS_SEGA = 498 * MiB;
constexpr size_t WS_RSTD = 499 * MiB;
constexpr size_t WS_END = 500 * MiB;
constexpr size_t WS_PACT = 240 * MiB;
constexpr size_t WS_Y = 368 * MiB;
constexpr int NSL = 8, CSL = 128;
constexpr float USCALE = 64.0f, VSCALE = 16.0f;
constexpr int CW_QU = 8192, CW_QV = 8192 + 64 * 16;
constexpr int CW_BAR = 1024;

constexpr int LDS_BYTES = 155648;
constexpr int MISC_OFF = LDS_BYTES - 256;

#define GAS __attribute__((address_space(1)))
#define LAS __attribute__((address_space(3)))
typedef unsigned short bf16;
typedef unsigned v4u __attribute__((ext_vector_type(4)));
typedef unsigned v2u __attribute__((ext_vector_type(2)));
typedef float f32x4 __attribute__((ext_vector_type(4)));
typedef float f32x16 __attribute__((ext_vector_type(16)));
typedef short bf16x8 __attribute__((ext_vector_type(8)));
typedef float f32x2_ __attribute__((ext_vector_type(2)));

__device__ __forceinline__ float bf2f(unsigned h) { return __builtin_bit_cast(float, h << 16); }
__device__ __forceinline__ float bflo(unsigned u) { return __builtin_bit_cast(float, u << 16); }
__device__ __forceinline__ float bfhi(unsigned u) { return __builtin_bit_cast(float, u & 0xffff0000u); }
__device__ __forceinline__ unsigned f2bf(float f) { unsigned u = __builtin_bit_cast(unsigned, f); return (u + 0x7fffu + ((u >> 16) & 1u)) >> 16; }
__device__ __forceinline__ unsigned pk2(float lo, float hi) { return f2bf(lo) | (f2bf(hi) << 16); }
__device__ __forceinline__ unsigned cvtpk(float lo, float hi) { unsigned r; asm("v_cvt_pk_bf16_f32 %0, %1, %2" : "=v"(r) : "v"(lo), "v"(hi)); return r; }
__device__ __forceinline__ float sigmoidf_(float x) { return __builtin_amdgcn_rcpf(1.0f + __expf(-x)); }
#define DPP_ADD(s, ctrl) ((s) + __builtin_bit_cast(float, __builtin_amdgcn_update_dpp(0, __builtin_bit_cast(int, (s)), (ctrl), 0xF, 0xF, false)))
__device__ __forceinline__ float wave_sum(float v) {
#pragma unroll
    for (int o = 1; o < 64; o <<= 1) v += __shfl_xor(v, o);
    return v;
}

#define XB_TMO      128
#define XB_XCNT(j)  (256  + 64 * (j))
#define XB_XSUB(j)  (1280 + 64 * (j))
#define XB_XGEN(j)  (2304 + 64 * (j))
#define XB_TOP      3328
#define XB_TOPGEN   3392
#define XCD_BAR_WORDS 3456
#define XB_SPIN_CAP (1u << 18)
__device__ __forceinline__ unsigned xb_ld(unsigned* p)              { return __hip_atomic_load(p, __ATOMIC_RELAXED, __HIP_MEMORY_SCOPE_AGENT); }
__device__ __forceinline__ unsigned xb_add(unsigned* p, unsigned v) { return __hip_atomic_fetch_add(p, v, __ATOMIC_RELAXED, __HIP_MEMORY_SCOPE_AGENT); }
__device__ __forceinline__ unsigned xb_xcc_id() { return (unsigned)__builtin_amdgcn_s_getreg((3 << 11) | 20) & 0xFu; }
#define XB_SPIN(cond, bar) do { unsigned _sp = 0; while (cond) { __builtin_amdgcn_s_sleep(1); \
    if ((++_sp & 255u) == 0u) { if (xb_ld(&(bar)[XB_TMO])) break; if (_sp > XB_SPIN_CAP) { atomicAdd(&(bar)[XB_TMO], 1u); break; } } } } while (0)
struct XcdBarrier { unsigned* bar; unsigned x; volatile LAS unsigned* st; };
__device__ __forceinline__ XcdBarrier xcd_barrier_post(unsigned* bar, volatile LAS unsigned* st) {
    XcdBarrier b; b.bar = bar; b.x = xb_xcc_id(); b.st = st;
    if (threadIdx.x == 0) (void)xb_add(&bar[XB_XCNT(b.x)], 1u);
    return b;
}
__device__ __forceinline__ void xcd_barrier_complete(unsigned* bar, unsigned x, unsigned& nloc, unsigned& nx) {
    const unsigned G = gridDim.x * gridDim.y * gridDim.z;
    unsigned sum, cnt, mine, sp = 0u;
    for (;;) {
        sum = 0u; cnt = 0u; mine = 0u;
#pragma unroll
        for (unsigned j = 0; j < 16; ++j) { const unsigned c = xb_ld(&bar[XB_XCNT(j)]); sum += c; cnt += (c > 0u) ? 1u : 0u; mine = (j == x) ? c : mine; }
        if (sum == G) break;
        __builtin_amdgcn_s_sleep(1);
        if ((++sp & 255u) == 0u) { if (xb_ld(&bar[XB_TMO])) break; if (sp > XB_SPIN_CAP) { atomicAdd(&bar[XB_TMO], 1u); break; } }
    }
    nloc = mine > 0u ? mine : 1u; nx = cnt > 0u ? cnt : 1u;
}
__device__ __forceinline__ void xcd_barrier(const XcdBarrier& b) {
    asm volatile("s_waitcnt vmcnt(0)" ::: "memory");
    __syncthreads();
    if (threadIdx.x == 0) {
        unsigned* bar = b.bar;
        __builtin_amdgcn_s_waitcnt(0);
        unsigned nloc = b.st[0], nx = b.st[1];
        if (nloc == 0u) { xcd_barrier_complete(bar, b.x, nloc, nx); b.st[0] = nloc; b.st[1] = nx; }
        const unsigned old = xb_add(&bar[XB_XSUB(b.x)], 1u);
        const unsigned gen = old / nloc;
        if (old + 1u == (gen + 1u) * nloc) {
            __builtin_amdgcn_fence(__ATOMIC_RELEASE, "agent");
            asm volatile("s_waitcnt vmcnt(0)" ::: "memory");
            const unsigned og = xb_add(&bar[XB_TOP], 1u);
            const unsigned tg = og / nx;
            if (og + 1u == (tg + 1u) * nx) xb_add(&bar[XB_TOPGEN], 1u);
            else XB_SPIN(xb_ld(&bar[XB_TOPGEN]) == tg, bar);
            __builtin_amdgcn_fence(__ATOMIC_ACQUIRE, "agent");
            xb_add(&bar[XB_XGEN(b.x)], 1u);
            asm volatile("s_waitcnt vmcnt(0)" ::: "memory");
        } else {
            XB_SPIN(xb_ld(&bar[XB_XGEN(b.x)]) == gen, bar);
            __builtin_amdgcn_fence(__ATOMIC_ACQUIRE, "agent");
            asm volatile("s_waitcnt vmcnt(0)" ::: "memory");
        }
    }
    __syncthreads();
}

struct Args { const float* in[23]; float* out; unsigned char* ws; int ph_lo, ph_hi; };
struct Frame {
    LAS unsigned char* lds;
    int tid, lane, wave, G, bid;
    const Args* a;
    __device__ __forceinline__ const float* x() const { return a->in[0]; }
    __device__ __forceinline__ const float* c() const { return a->in[1]; }
    __device__ __forceinline__ const float* ada_w() const { return a->in[2]; }
    __device__ __forceinline__ const float* ada_b() const { return a->in[3]; }
    __device__ __forceinline__ const float* g_mix() const { return a->in[4]; }
    __device__ __forceinline__ const float* w_in() const { return a->in[5]; }
    __device__ __forceinline__ const float* lbg_f() const { return a->in[6]; }
    __device__ __forceinline__ const float* lbg_b() const { return a->in[7]; }
    __device__ __forceinline__ const float* hnorm_g() const { return a->in[8]; }
    __device__ __forceinline__ const float* conv_w() const { return a->in[9]; }
    __device__ __forceinline__ const float* conv_b() const { return a->in[10]; }
    __device__ __forceinline__ const float* cln_g() const { return a->in[11]; }
    __device__ __forceinline__ const float* cln_b() const { return a->in[12]; }
    __device__ __forceinline__ const float* w_out() const { return a->in[13]; }
    __device__ __forceinline__ const float* g_ffn() const { return a->in[14]; }
    __device__ __forceinline__ const float* wq() const { return a->in[15]; }
    __device__ __forceinline__ const float* keys1() const { return a->in[16]; }
    __device__ __forceinline__ const float* keys2() const { return a->in[17]; }
    __device__ __forceinline__ const float* utab() const { return a->in[18]; }
    __device__ __forceinline__ const float* vtab() const { return a->in[19]; }
    __device__ __forceinline__ const float* fada_w() const { return a->in[20]; }
    __device__ __forceinline__ const float* fada_b() const { return a->in[21]; }
    __device__ __forceinline__ const float* fnorm_g() const { return a->in[22]; }
    __device__ __forceinline__ float* out() const { return a->out; }
    __device__ __forceinline__ float* mod() const { return (float*)(a->ws + WS_MOD); }
    __device__ __forceinline__ float* fmod() const { return (float*)(a->ws + WS_FMOD); }
    __device__ __forceinline__ float* lb() const { return (float*)(a->ws + WS_LB); }
    __device__ __forceinline__ float* biasq() const { return (float*)(a->ws + WS_BIASQ); }
    __device__ __forceinline__ float* ssqp() const { return (float*)(a->ws + WS_SSQ); }
    __device__ __forceinline__ float* sega() const { return (float*)(a->ws + WS_SEGA); }
    __device__ __forceinline__ float* segu() const { return (float*)(a->ws + WS_SEG); }
    __device__ __forceinline__ float* of() const { return (float*)(a->ws + WS_BUFB); }
    __device__ __forceinline__ float* scores() const { return (float*)(a->ws + WS_BIG); }
    __device__ __forceinline__ float* wsel() const { return (float*)(a->ws + WS_W); }
    __device__ __forceinline__ int* esel() const { return (int*)(a->ws + WS_E); }
    __device__ __forceinline__ bf16* Win_t() const { return (bf16*)(a->ws + WS_WIN); }
    __device__ __forceinline__ bf16* Wout_t() const { return (bf16*)(a->ws + WS_WOUT); }
    __device__ __forceinline__ bf16* Wqk_t() const { return (bf16*)(a->ws + WS_WQK); }
    __device__ __forceinline__ bf16* Ub() const { return (bf16*)(a->ws + WS_UT); }
    __device__ __forceinline__ bf16* Vb() const { return (bf16*)(a->ws + WS_VT); }
    __device__ __forceinline__ bf16* bufA() const { return (bf16*)(a->ws + WS_BUFA); }
    __device__ __forceinline__ bf16* hg() const { return (bf16*)(a->ws + WS_BUFB); }
    __device__ __forceinline__ bf16* proj() const { return (bf16*)(a->ws + WS_BIG); }
    __device__ __forceinline__ float* coef() const { return (float*)(a->ws + WS_BUFA); }
    __device__ __forceinline__ float* rstd() const { return (float*)(a->ws + WS_RSTD); }
    __device__ __forceinline__ float* pact() const { return (float*)(a->ws + WS_PACT); }
    __device__ __forceinline__ float* ybuf() const { return (float*)(a->ws + WS_Y); }
    __device__ __forceinline__ unsigned char* U8() const { return (unsigned char*)(a->ws + WS_UT); }
    __device__ __forceinline__ unsigned char* V8() const { return (unsigned char*)(a->ws + WS_VT); }
    __device__ __forceinline__ unsigned* ctl() const { return (unsigned*)(a->ws + WS_CTL); }
};

__device__ __forceinline__ void p0_gemv(Frame& F) {
    LAS float* cact = (LAS float*)(F.lds);
    LAS float* red = (LAS float*)(F.lds + 16384);
    for (int i = F.tid; i < 4096; i += NTHR) { const float c = F.c()[i]; cact[i] = c * sigmoidf_(c); }
    __syncthreads();
    for (int item = F.bid; item < 128; item += F.G) {
        const int col0 = item * 64; const float* W; int N, cc;
        if (col0 < 6144) { W = F.ada_w(); N = 6144; cc = col0; } else { W = F.fada_w(); N = 2048; cc = col0 - 6144; }
        const float* wp = W + (size_t)(F.wave * 128) * N + cc + F.lane;
        float a0 = 0.f, a1 = 0.f, a2 = 0.f, a3 = 0.f;
#pragma unroll 32
        for (int k = 0; k < 128; ++k) { const float w = wp[(size_t)k * N]; const int kk = F.wave * 128 + k;
            a0 += cact[kk] * w; a1 += cact[1024 + kk] * w; a2 += cact[2048 + kk] * w; a3 += cact[3072 + kk] * w; }
        red[(F.wave * 4 + 0) * 64 + F.lane] = a0; red[(F.wave * 4 + 1) * 64 + F.lane] = a1; red[(F.wave * 4 + 2) * 64 + F.lane] = a2; red[(F.wave * 4 + 3) * 64 + F.lane] = a3;
        __syncthreads();
        if (F.tid < 256) { const int b = F.tid >> 6, l = F.tid & 63; float s = 0.f;
#pragma unroll
            for (int w = 0; w < 8; ++w) s += red[(w * 4 + b) * 64 + l];
            if (col0 < 6144) F.mod()[b * 6144 + cc + l] = s + F.ada_b()[cc + l]; else F.fmod()[b * 2048 + cc + l] = s + F.fada_b()[cc + l]; }
        __syncthreads();
    }
}
__device__ __forceinline__ void p0_transpose_item(const float* W, int K, int N, bf16* WT, LAS float* scr, int item, int lane) {
    const int nblk = N / 32, kb = item / nblk, nb = item % nblk, k0 = 64 * kb, n0 = 32 * nb;
#pragma unroll 8
    for (int i = 0; i < 32; ++i) { const int kk = 2 * i + (lane >> 5); scr[kk * 33 + (lane & 31)] = W[(size_t)(k0 + kk) * N + n0 + (lane & 31)]; }
    asm volatile("s_waitcnt lgkmcnt(0)" ::: "memory");
    const int c = lane & 7;
#pragma unroll
    for (int j = 0; j < 4; ++j) { const int n = (lane >> 3) + 8 * j; const LAS float* s = scr + (8 * c) * 33 + n;
        v4u o; o.x = pk2(s[0 * 33], s[1 * 33]); o.y = pk2(s[2 * 33], s[3 * 33]); o.z = pk2(s[4 * 33], s[5 * 33]); o.w = pk2(s[6 * 33], s[7 * 33]);
        *(v4u*)(WT + (size_t)(n0 + n) * K + k0 + 8 * c) = o; }
    asm volatile("s_waitcnt lgkmcnt(0)" ::: "memory");
}
__device__ __forceinline__ void p0_wqk_item(Frame& F, int item) {
    const int jq = item & 7, kb = (item >> 3) & 15, hh = item >> 7, h = hh >> 1, half = hh & 1;
    const float* keys = (half ? F.keys2() : F.keys1()) + (size_t)(jq * 16) * 128;
    const int k = kb * 64 + F.lane;
    const float* wrow = F.wq() + (size_t)k * 2048 + h * 256 + half * 128;
    float acc[16];
#pragma unroll
    for (int j = 0; j < 16; ++j) acc[j] = 0.f;
#pragma unroll 4
    for (int d = 0; d < 128; d += 4) {
        const f32x4 a = *(const f32x4*)(wrow + d);
#pragma unroll
        for (int j = 0; j < 16; ++j) { const float* kp = keys + j * 128 + d; acc[j] += a[0] * kp[0] + a[1] * kp[1] + a[2] * kp[2] + a[3] * kp[3]; }
    }
    bf16* o = F.Wqk_t() + (size_t)(h * 256 + half * 128 + jq * 16) * 1024 + k;
#pragma unroll
    for (int j = 0; j < 16; ++j) o[(size_t)j * 1024] = (bf16)f2bf(acc[j]);
}
__device__ __forceinline__ void p0_prologue(Frame& F) {
    if (F.bid < 128) p0_gemv(F);
    if (F.bid == 128 % F.G) { const int i = F.tid;
        F.lb()[i] = __builtin_amdgcn_rcpf(1.0f + __expf(F.lbg_f()[512 + i] - F.lbg_f()[i]));
        F.lb()[512 + i] = __builtin_amdgcn_rcpf(1.0f + __expf(F.lbg_b()[512 + i] - F.lbg_b()[i])); }
    LAS float* scr = (LAS float*)(F.lds + 32768 + F.wave * 8704);
    const int gw = F.wave * F.G + F.bid, NGW = F.G * NWAVES;
    constexpr int I_QK = 2048, I_IN = (D / 64) * (NIN / 32), I_OUT = (D / 64) * (D / 32), I_TAB = 2 * 16384 / 4;
    constexpr int NITEMS = I_QK + I_IN + I_OUT + I_TAB;
    for (int it = gw; it < NITEMS; it += NGW) {
        int r = it;
        if (r < I_QK) { p0_wqk_item(F, r); continue; } r -= I_QK;
        if (r < I_IN) { p0_transpose_item(F.w_in(), D, NIN, F.Win_t(), scr, r, F.lane); continue; } r -= I_IN;
        if (r < I_OUT) { p0_transpose_item(F.w_out(), D, D, F.Wout_t(), scr, r, F.lane); continue; } r -= I_OUT;
        { const int tab = r >= 4096, rr = (tab ? r - 4096 : r) * 4; const float* src = (tab ? F.vtab() : F.utab()) + (size_t)rr * 1024; unsigned char* dst = tab ? F.V8() : F.U8();
          const float sc = tab ? VSCALE : USCALE;
#pragma unroll
          for (int q = 0; q < 16; ++q) { const int row = rr + (q >> 2), qq = q & 3; const f32x4 v = *(const f32x4*)(src + (q >> 2) * 1024 + qq * 256 + 4 * F.lane) * sc;
              int pk = __builtin_amdgcn_cvt_pk_fp8_f32(v[0], v[1], 0, false); pk = __builtin_amdgcn_cvt_pk_fp8_f32(v[2], v[3], pk, true);
              const int sl = 2 * qq + (F.lane >> 5);
              *(int*)(dst + ((size_t)sl * 16384 + row) * CSL + 4 * (F.lane & 31)) = pk; } }
    }
}

__device__ __forceinline__ void p1_norm(Frame& F) {
    const int gwc = F.bid * NWAVES + F.wave, NGW = F.G * NWAVES;
    for (int row0 = gwc * 16; row0 < T; row0 += NGW * 16) {
        const int b = row0 >> 13; const float* mb = F.mod() + b * 6144;
        f32x4 ca[4], cb[4];
#pragma unroll
        for (int j = 0; j < 4; ++j) { const int k = 256 * j + 4 * F.lane; const f32x4 g = *(const f32x4*)(F.g_mix() + k), s = *(const f32x4*)(mb + 1024 + k); ca[j] = g * (s + 1.0f); cb[j] = *(const f32x4*)(mb + k); }
#pragma unroll 4
        for (int r = 0; r < 16; ++r) { const float* xr = F.x() + (size_t)(row0 + r) * D;
            f32x4 v[4]; float ss = 0.f;
#pragma unroll
            for (int j = 0; j < 4; ++j) { v[j] = *(const f32x4*)(xr + 256 * j + 4 * F.lane); ss += v[j][0] * v[j][0] + v[j][1] * v[j][1] + v[j][2] * v[j][2] + v[j][3] * v[j][3]; }
            const float rstd = __builtin_amdgcn_rsqf(wave_sum(ss) * (1.0f / D) + EPS);
            bf16* o = F.bufA() + (size_t)(row0 + r) * D;
#pragma unroll
            for (int j = 0; j < 4; ++j) { const f32x4 y = v[j] * rstd * ca[j] + cb[j]; v2u w; w.x = pk2(y[0], y[1]); w.y = pk2(y[2], y[3]); *(v2u*)(o + 256 * j + 4 * F.lane) = w; } }
    }
    const int gw = F.wave * F.G + F.bid;
    for (int n0 = gw * 32; n0 < NQK; n0 += NGW * 32) {
        float sv[4][16];
#pragma unroll
        for (int b = 0; b < 4; ++b) { const float* sh2 = F.mod() + b * 6144 + 3072;
#pragma unroll
            for (int i = 0; i < 8; ++i) { sv[b][i] = sh2[8 * F.lane + i]; sv[b][8 + i] = sh2[512 + 8 * F.lane + i]; } }
        float res[4] = {0.f, 0.f, 0.f, 0.f};
        for (int q = 0; q < 32; ++q) { const int n = n0 + q;
            const v4u w0 = *(const v4u*)(F.Wqk_t() + (size_t)n * 1024 + 8 * F.lane), w1 = *(const v4u*)(F.Wqk_t() + (size_t)n * 1024 + 512 + 8 * F.lane);
            float wv[16];
#pragma unroll
            for (int i = 0; i < 4; ++i) { wv[2 * i] = bflo(w0[i]); wv[2 * i + 1] = bfhi(w0[i]); wv[8 + 2 * i] = bflo(w1[i]); wv[8 + 2 * i + 1] = bfhi(w1[i]); }
#pragma unroll
            for (int b = 0; b < 4; ++b) { float sm = 0.f;
#pragma unroll
                for (int i = 0; i < 16; ++i) sm += wv[i] * sv[b][i];
                sm = wave_sum(sm); if (F.lane == q) res[b] = sm; } }
        if (F.lane < 32) {
#pragma unroll
            for (int b = 0; b < 4; ++b) F.biasq()[b * 2048 + n0 + F.lane] = res[b]; }
    }
}

__device__ __forceinline__ void conv_item(Frame& F, int item, const float (&cw)[CW], float cbias) {
    LAS bf16* hbuf = (LAS bf16*)(F.lds);
    LAS float* ybuf = (LAS float*)(F.lds + 65536);
    const int tok0 = item * 32, b = tok0 >> 13, t0 = tok0 & (SEQ - 1), c = F.tid;
#pragma unroll
    for (int k = 0; k < 8; ++k) { const int pi = F.tid + NTHR * k; if (pi < 62 * 64) { const int r = pi >> 6, ch = pi & 63, t = t0 - CPAD + r; v4u o = {0u, 0u, 0u, 0u};
            if (t >= 0 && t < SEQ) { const bf16* pr = F.proj() + (size_t)(b * SEQ + t) * NIN + 8 * ch; const v4u a = *(const v4u*)(pr + 2560), g = *(const v4u*)(pr + 3072);
#pragma unroll
                for (int i = 0; i < 4; ++i) o[i] = cvtpk(bflo(a[i]) * sigmoidf_(bflo(g[i])), bfhi(a[i]) * sigmoidf_(bfhi(g[i]))); }
            *(LAS v4u*)(hbuf + r * 512 + 8 * ch) = o; } }
    __syncthreads();
    float hv[62];
#pragma unroll
    for (int r = 0; r < 62; ++r) hv[r] = bf2f(hbuf[r * 512 + c]);
#pragma unroll
    for (int tt = 0; tt < 32; ++tt) { float acc = cbias;
#pragma unroll
        for (int j = 0; j < CW; ++j) acc += cw[j] * hv[tt + j];
        ybuf[tt * 512 + c] = acc; }
    __syncthreads();
#pragma unroll
    for (int q = 0; q < 4; ++q) { const int tt = F.wave * 4 + q;
        const f32x4 y0 = *(LAS const f32x4*)(ybuf + tt * 512 + 8 * F.lane), y1 = *(LAS const f32x4*)(ybuf + tt * 512 + 8 * F.lane + 4);
        const float mean = wave_sum((y0[0] + y0[1] + y0[2] + y0[3]) + (y1[0] + y1[1] + y1[2] + y1[3])) * (1.0f / DC);
        const f32x4 d0 = y0 - mean, d1 = y1 - mean;
        const float var = wave_sum((d0[0] * d0[0] + d0[1] * d0[1] + d0[2] * d0[2] + d0[3] * d0[3]) + (d1[0] * d1[0] + d1[1] * d1[1] + d1[2] * d1[2] + d1[3] * d1[3])) * (1.0f / DC);
        const float rstd = __builtin_amdgcn_rsqf(var + EPS);
        const f32x4 g0 = *(const f32x4*)(F.cln_g() + 8 * F.lane), g1 = *(const f32x4*)(F.cln_g() + 8 * F.lane + 4), b0 = *(const f32x4*)(F.cln_b() + 8 * F.lane), b1 = *(const f32x4*)(F.cln_b() + 8 * F.lane + 4);
        f32x4 z0 = d0 * rstd * g0 + b0, z1 = d1 * rstd * g1 + b1;
#pragma unroll
        for (int i = 0; i < 4; ++i) { z0[i] = z0[i] * sigmoidf_(z0[i]); z1[i] = z1[i] * sigmoidf_(z1[i]); }
        v4u w; w.x = cvtpk(z0[0], z0[1]); w.y = cvtpk(z0[2], z0[3]); w.z = cvtpk(z1[0], z1[1]); w.w = cvtpk(z1[2], z1[3]);
        *(v4u*)(F.bufA() + (size_t)(tok0 + tt) * D + 512 + 8 * F.lane) = w; }
    __syncthreads();
}

constexpr int PQ = 272, PT = 144;
constexpr int HL_QR = 0, HL_KR = 17408, HL_QE = 34816, HL_KET = 52224, HL_VT = 70656, HL_SCM = 89088, HL_ST = 98304, HL_PBLK = 133120, HL_AV = 135168, HL_RS = 135680;
__device__ __forceinline__ bf16x8 ldf(LAS const unsigned char* base, int row, int pitch, int kbyte) { return *(LAS const bf16x8*)(base + row * pitch + kbyte); }
#define MFMA32(a, b, c) __builtin_amdgcn_mfma_f32_32x32x16_bf16((a), (b), (c), 0, 0, 0)

template <bool FULL>
__device__ __forceinline__ void hgrn_load(Frame& F, int b, int h, int dir, int chunk, unsigned (&rz)[8], unsigned (&rv)[8], unsigned (&rq)[8]) {
    const size_t tokbase = (size_t)b * SEQ + (size_t)chunk * CHK; const int zoff = dir ? 1024 : 512, c0 = 2 * F.lane;
#pragma unroll
    for (int i = 0; i < 8; ++i) { const int p = 8 * F.wave + i, tr = dir ? (63 - p) : p; const bf16* q = F.proj() + (tokbase + tr) * NIN + h * HD;
        rz[i] = *(const unsigned*)(q + zoff + c0); rv[i] = *(const unsigned*)(q + 1536 + c0); if (FULL) rq[i] = *(const unsigned*)(q + c0); }
}
template <bool FULL, int MODE>
__device__ __forceinline__ void hgrn_chunk(Frame& F, int b, int h, int dir, int chunk, int nchunk, f32x16 (&accS)[2], float lb0, float lb1, unsigned (&rz)[8], unsigned (&rv)[8], unsigned (&rq)[8]) {
    LAS unsigned char* lds = F.lds;
    int r = F.lane & 31, hh = F.lane >> 5, c0 = 2 * F.lane;
    asm volatile("" : "+v"(r), "+v"(hh), "+v"(c0));
    const int w = F.wave, rb = w;
    const size_t tokbase = (size_t)b * SEQ + (size_t)chunk * CHK;
    {
        float f0[8], f1[8], cf0[8], cf1[8], cr0[8], cr1[8];
        float run0 = 1.f, run1 = 1.f;
#pragma unroll
        for (int i = 0; i < 8; ++i) { f0[i] = lb0 + (1.0f - lb0) * sigmoidf_(bflo(rz[i])); f1[i] = lb1 + (1.0f - lb1) * sigmoidf_(bfhi(rz[i])); run0 *= f0[i]; run1 *= f1[i]; cf0[i] = run0; cf1[i] = run1; }
        { float q0 = 1.f, q1 = 1.f;
#pragma unroll
          for (int i = 7; i >= 0; --i) { cr0[i] = q0; cr1[i] = q1; q0 *= f0[i]; q1 *= f1[i]; } }
        LAS float* pblk = (LAS float*)(lds + HL_PBLK);
        { f32x2_ t; t[0] = run0; t[1] = run1; *(LAS f32x2_*)(pblk + rb * 128 + c0) = t; }
        __syncthreads();
        f32x2_ pre = {1.f, 1.f}, post = {1.f, 1.f}, mid = {1.f, 1.f};
#pragma unroll
        for (int q = 0; q < 8; ++q) { const f32x2_ bv = *(LAS const f32x2_*)(pblk + q * 128 + c0);
            if (q < rb) pre *= bv; if (q > rb) post *= bv;
            if (rb < 4 ? (q > rb && q < 4) : (q >= 4 && q < rb)) mid *= bv; }
        if (rb == 0) { f32x2_ t; t[0] = run0 * post[0]; t[1] = run1 * post[1]; *(LAS f32x2_*)((LAS float*)(lds + HL_AV) + c0) = t; }
        float ke0[8], ke1[8];
#pragma unroll
        for (int i = 0; i < 8; ++i) { const float k0 = 1.0f - f0[i], k1 = 1.0f - f1[i];
            ke0[i] = k0 * cr0[i] * post[0]; ke1[i] = k1 * cr1[i] * post[1];
            if (FULL) { const int p = 8 * rb + i; const float q0 = bflo(rq[i]), q1 = bfhi(rq[i]); const float qs0 = q0 * sigmoidf_(q0), qs1 = q1 * sigmoidf_(q1);
                const float G0 = (rb < 4 ? cr0[i] : cf0[i]) * mid[0], G1 = (rb < 4 ? cr1[i] : cf1[i]) * mid[1], iG0 = __builtin_amdgcn_rcpf(G0), iG1 = __builtin_amdgcn_rcpf(G1);
                *(LAS unsigned*)(lds + HL_QE + p * PQ + c0 * 2) = cvtpk(qs0 * pre[0] * cf0[i], qs1 * pre[1] * cf1[i]);
                *(LAS unsigned*)(lds + HL_QR + p * PQ + c0 * 2) = cvtpk(qs0 * (rb < 4 ? iG0 : G0), qs1 * (rb < 4 ? iG1 : G1));
                *(LAS unsigned*)(lds + HL_KR + p * PQ + c0 * 2) = cvtpk(k0 * (rb < 4 ? G0 : iG0), k1 * (rb < 4 ? G1 : iG1)); } }
        v4u ka, kb, va, vb2;
        ka.x = cvtpk(ke0[0], ke0[1]); ka.y = cvtpk(ke0[2], ke0[3]); ka.z = cvtpk(ke0[4], ke0[5]); ka.w = cvtpk(ke0[6], ke0[7]);
        kb.x = cvtpk(ke1[0], ke1[1]); kb.y = cvtpk(ke1[2], ke1[3]); kb.z = cvtpk(ke1[4], ke1[5]); kb.w = cvtpk(ke1[6], ke1[7]);
        va.x = (rv[0] & 0xffffu) | (rv[1] << 16); va.y = (rv[2] & 0xffffu) | (rv[3] << 16); va.z = (rv[4] & 0xffffu) | (rv[5] << 16); va.w = (rv[6] & 0xffffu) | (rv[7] << 16);
        vb2.x = (rv[0] >> 16) | (rv[1] & 0xffff0000u); vb2.y = (rv[2] >> 16) | (rv[3] & 0xffff0000u); vb2.z = (rv[4] >> 16) | (rv[5] & 0xffff0000u); vb2.w = (rv[6] >> 16) | (rv[7] & 0xffff0000u);
        *(LAS v4u*)(lds + HL_KET + c0 * PT + 16 * rb) = ka; *(LAS v4u*)(lds + HL_KET + (c0 + 1) * PT + 16 * rb) = kb;
        *(LAS v4u*)(lds + HL_VT + c0 * PT + 16 * rb) = va; *(LAS v4u*)(lds + HL_VT + (c0 + 1) * PT + 16 * rb) = vb2;
    }
    if (nchunk >= 0) hgrn_load<FULL>(F, b, h, dir, nchunk, rz, rv, rq);
    __syncthreads();
    const int pbO = w & 1, vb = w >> 1;
    f32x16 accO, accU[2];
#pragma unroll
    for (int i = 0; i < 16; ++i) { accO[i] = 0.f; accU[0][i] = 0.f; accU[1][i] = 0.f; }
    if (FULL) {
        if (w < 3) { const int pbS = (w + 1) >> 1, sbS = (w == 2) ? 1 : 0; f32x16 sc;
#pragma unroll
            for (int i = 0; i < 16; ++i) sc[i] = 0.f;
#pragma unroll
            for (int s = 0; s < 8; ++s) sc = MFMA32(ldf(lds + HL_QR, pbS * 32 + r, PQ, 32 * s + 16 * hh), ldf(lds + HL_KR, sbS * 32 + r, PQ, 32 * s + 16 * hh), sc);
#pragma unroll
            for (int i = 0; i < 16; i += 2) { const int p = pbS * 32 + (i & 3) + 8 * (i >> 2) + 4 * hh, s = sbS * 32 + r;
                const unsigned pkd = cvtpk(s <= p ? sc[i] : 0.f, s <= p + 1 ? sc[i + 1] : 0.f);
                *(LAS bf16*)(lds + HL_SCM + p * PT + s * 2) = (bf16)pkd; *(LAS bf16*)(lds + HL_SCM + (p + 1) * PT + s * 2) = (bf16)(pkd >> 16); } }
        __builtin_amdgcn_sched_barrier(0);
#pragma unroll
        for (int s = 0; s < 8; ++s) accO = MFMA32(ldf(lds + HL_QE, pbO * 32 + r, PQ, 32 * s + 16 * hh), ldf(lds + HL_ST, vb * 32 + r, PQ, 32 * s + 16 * hh), accO);
        __builtin_amdgcn_sched_barrier(0);
    }
#pragma unroll
    for (int i = 0; i < 2; ++i) { const int db = 2 * (w & 1) + i;
#pragma unroll
        for (int s = 0; s < 4; ++s) accU[i] = MFMA32(ldf(lds + HL_VT, vb * 32 + r, PT, 32 * s + 16 * hh), ldf(lds + HL_KET, db * 32 + r, PT, 32 * s + 16 * hh), accU[i]); }
    __builtin_amdgcn_sched_barrier(0);
    if (FULL) __syncthreads();
    if (FULL) {
        const unsigned v = vb * 32 + r;
        const unsigned lrow = (MODE == 0 ? (unsigned)hh : (unsigned)(1 - hh)) * 4u;
        const size_t rbase = (MODE == 0) ? (tokbase + pbO * 32) : (tokbase + 63 - pbO * 32 - 4);
        const unsigned lo_of = lrow * DH + v, lo_pr = lrow * NIN + v, lo_a2 = lrow * D + v;
        float ofv[16]; unsigned gv[16];
        if (MODE == 1) {
#pragma unroll
            for (int i = 0; i < 16; ++i) { const int ci = (i & 3) + 8 * (i >> 2); ofv[i] = (F.of() + (rbase - ci) * DH + h * HD)[lo_of]; } }
        for (int sb = 0; sb <= pbO; ++sb)
#pragma unroll
            for (int s2 = 0; s2 < 2; ++s2) accO = MFMA32(ldf(lds + HL_SCM, pbO * 32 + r, PT, 64 * sb + 32 * s2 + 16 * hh), ldf(lds + HL_VT, vb * 32 + r, PT, 64 * sb + 32 * s2 + 16 * hh), accO);
        if (MODE == 0) {
#pragma unroll
            for (int i = 0; i < 16; ++i) { const int ci = (i & 3) + 8 * (i >> 2); (F.of() + (rbase + ci) * DH + h * HD)[lo_of] = accO[i]; }
        } else {
            LAS float* rs = (LAS float*)(lds + HL_RS);
#pragma unroll
            for (int i = 0; i < 16; ++i) { const int ci = (i & 3) + 8 * (i >> 2); gv[i] = (F.proj() + (rbase - ci) * NIN + 2048 + h * HD)[lo_pr]; }
            float ov[16];
#pragma unroll
            for (int i = 0; i < 16; ++i) { const int ci = (i & 3) + 8 * (i >> 2), p = pbO * 32 + ci + 4 * hh;
                ov[i] = accO[i] + ofv[i]; float ss = ov[i] * ov[i];
                ss = DPP_ADD(ss, 0x128); ss = DPP_ADD(ss, 0x124); ss = DPP_ADD(ss, 0x122); ss = DPP_ADD(ss, 0x121); ss += __shfl_xor(ss, 16);
                if (r == 0) rs[p * 4 + vb] = ss; }
            __syncthreads();
            const float ng = F.hnorm_g()[h * HD + v];
#pragma unroll
            for (int i = 0; i < 16; ++i) { const int ci = (i & 3) + 8 * (i >> 2), p = pbO * 32 + ci + 4 * hh;
                const f32x4 q = *(LAS const f32x4*)(rs + p * 4);
                const float rstd = __builtin_amdgcn_rsqf((q[0] + q[1] + q[2] + q[3]) * (1.0f / HD) + EPS);
                const float g = bf2f(gv[i]);
                (F.bufA() + (rbase - ci) * D + h * HD)[lo_a2] = (bf16)cvtpk(ov[i] * rstd * ng * g * sigmoidf_(g), 0.f); }
        }
    }
    {
        const LAS float* av = (const LAS float*)(lds + HL_AV);
#pragma unroll
        for (int i = 0; i < 2; ++i) { const int db = 2 * (w & 1) + i; const float a = av[db * 32 + r];
#pragma unroll
            for (int j = 0; j < 16; j += 2) { const float s0 = accS[i][j] * a + accU[i][j], s1 = accS[i][j + 1] * a + accU[i][j + 1]; accS[i][j] = s0; accS[i][j + 1] = s1;
                if (FULL) { const int vv = vb * 32 + (j & 3) + 8 * (j >> 2) + 4 * hh; const unsigned pkd = cvtpk(s0, s1);
                    *(LAS bf16*)(lds + HL_ST + vv * PQ + (db * 32 + r) * 2) = (bf16)pkd; *(LAS bf16*)(lds + HL_ST + (vv + 1) * PQ + (db * 32 + r) * 2) = (bf16)(pkd >> 16); } } }
    }
    __syncthreads();
}
__device__ __forceinline__ void h1_item(Frame& F, int item) {
    const int seg = item & 15, dir = (item >> 4) & 1, h = (item >> 5) & 3, b = item >> 7;
    const float lb0 = F.lb()[dir * 512 + h * HD + 2 * F.lane], lb1 = F.lb()[dir * 512 + h * HD + 2 * F.lane + 1];
    f32x16 accS[2];
#pragma unroll
    for (int i = 0; i < 16; ++i) { accS[0][i] = 0.f; accS[1][i] = 0.f; }
    float atot = 1.f; const int col = F.tid & 127;
    unsigned rzA[8], rvA[8], rzB[8], rvB[8], rq[8];
#define H1CH(c) (seg * SEGC + (dir ? (SEGC - 1 - (c)) : (c)))
    hgrn_load<false>(F, b, h, dir, H1CH(0), rzA, rvA, rq); hgrn_load<false>(F, b, h, dir, H1CH(1), rzB, rvB, rq);
    for (int c = 0; c < SEGC; c += 2) {
        hgrn_chunk<false, 0>(F, b, h, dir, H1CH(c), (c + 2 < SEGC) ? H1CH(c + 2) : -1, accS, lb0, lb1, rzA, rvA, rq);
        atot *= ((const LAS float*)(F.lds + HL_AV))[col];
        hgrn_chunk<false, 0>(F, b, h, dir, H1CH(c + 1), (c + 3 < SEGC) ? H1CH(c + 3) : -1, accS, lb0, lb1, rzB, rvB, rq);
        atot *= ((const LAS float*)(F.lds + HL_AV))[col]; }
#undef H1CH
    if (F.tid < 128) F.sega()[(size_t)item * 128 + col] = atot;
    float* U = F.segu() + (size_t)item * 16384;
#pragma unroll
    for (int i = 0; i < 2; ++i)
#pragma unroll
        for (int j = 0; j < 16; j += 4) { f32x4 o; o[0] = accS[i][j]; o[1] = accS[i][j + 1]; o[2] = accS[i][j + 2]; o[3] = accS[i][j + 3]; ((f32x4*)(U + (i * 4 + (j >> 2)) * NTHR * 4))[F.tid] = o; }
}
__device__ __forceinline__ void h2_init_state(Frame& F, int b, int h, int dir, int seg, f32x16 (&accS)[2]) {
    const int w = F.wave, r = F.lane & 31, hh = F.lane >> 5, vb = w >> 1;
#pragma unroll
    for (int i = 0; i < 16; ++i) { accS[0][i] = 0.f; accS[1][i] = 0.f; }
    const int base = ((b * 4 + h) * 2 + dir) * 16;
    const int n = dir ? (NSEG - 1 - seg) : seg;
    for (int q = 0; q < n; ++q) { const int s = dir ? (NSEG - 1 - q) : q;
        const float* U = F.segu() + (size_t)(base + s) * 16384; const float* A = F.sega() + (size_t)(base + s) * 128;
#pragma unroll
        for (int i = 0; i < 2; ++i) { const int db = 2 * (w & 1) + i; const float a = (A + db * 32)[r];
#pragma unroll
            for (int j = 0; j < 16; j += 4) { const f32x4 u4 = ((const f32x4*)(U + (i * 4 + (j >> 2)) * NTHR * 4))[F.tid];
                accS[i][j] = accS[i][j] * a + u4[0]; accS[i][j + 1] = accS[i][j + 1] * a + u4[1]; accS[i][j + 2] = accS[i][j + 2] * a + u4[2]; accS[i][j + 3] = accS[i][j + 3] * a + u4[3]; } } }
#pragma unroll
    for (int i = 0; i < 2; ++i) { const int db = 2 * (w & 1) + i;
#pragma unroll
        for (int j = 0; j < 16; ++j) { const int vv = vb * 32 + (j & 3) + 8 * (j >> 2) + 4 * hh; *(LAS bf16*)(F.lds + HL_ST + vv * PQ + (db * 32 + r) * 2) = (bf16)f2bf(accS[i][j]); } }
    __syncthreads();
}
__device__ __forceinline__ void h2_item(Frame& F, int item) {
    const int seg = item & 15, h = (item >> 4) & 3, b = item >> 6;
    f32x16 accS[2];
    unsigned rzA[8], rvA[8], rqA[8], rzB[8], rvB[8], rqB[8];
    { const float lb0 = F.lb()[h * HD + 2 * F.lane], lb1 = F.lb()[h * HD + 2 * F.lane + 1];
      const int c0 = seg * SEGC;
      hgrn_load<true>(F, b, h, 0, c0, rzA, rvA, rqA); hgrn_load<true>(F, b, h, 0, c0 + 1, rzB, rvB, rqB);
      h2_init_state(F, b, h, 0, seg, accS);
      for (int c = 0; c < SEGC; c += 2) {
          hgrn_chunk<true, 0>(F, b, h, 0, c0 + c, (c + 2 < SEGC) ? (c0 + c + 2) : -1, accS, lb0, lb1, rzA, rvA, rqA);
          hgrn_chunk<true, 0>(F, b, h, 0, c0 + c + 1, (c + 3 < SEGC) ? (c0 + c + 3) : -1, accS, lb0, lb1, rzB, rvB, rqB); } }
    asm volatile("s_waitcnt vmcnt(0)" ::: "memory");
    __syncthreads();
    { const float lb0 = F.lb()[512 + h * HD + 2 * F.lane], lb1 = F.lb()[512 + h * HD + 2 * F.lane + 1];
      const int cl = seg * SEGC + SEGC - 1;
      hgrn_load<true>(F, b, h, 1, cl, rzA, rvA, rqA); hgrn_load<true>(F, b, h, 1, cl - 1, rzB, rvB, rqB);
      h2_init_state(F, b, h, 1, seg, accS);
      for (int c = 0; c < SEGC; c += 2) {
          hgrn_chunk<true, 1>(F, b, h, 1, cl - c, (c + 2 < SEGC) ? (cl - c - 2) : -1, accS, lb0, lb1, rzA, rvA, rqA);
          hgrn_chunk<true, 1>(F, b, h, 1, cl - c - 1, (c + 3 < SEGC) ? (cl - c - 3) : -1, accS, lb0, lb1, rzB, rvB, rqB); } }
}

__device__ __forceinline__ unsigned f2key(float f) { const unsigned u = __builtin_bit_cast(unsigned, f); return (u & 0x80000000u) ? ~u : (u | 0x80000000u); }
__device__ __forceinline__ float key2f(unsigned k) { const unsigned u = (k & 0x80000000u) ? (k & 0x7fffffffu) : ~k; return __builtin_bit_cast(float, u); }
__device__ __forceinline__ unsigned umax_(unsigned a, unsigned b) { return a > b ? a : b; }
__device__ __forceinline__ unsigned umin_(unsigned a, unsigned b) { return a < b ? a : b; }
__device__ __forceinline__ void sort16(unsigned (&a)[16]) {
#pragma unroll
    for (int k = 2; k <= 16; k <<= 1)
#pragma unroll
        for (int j = k >> 1; j > 0; j >>= 1)
#pragma unroll
            for (int i = 0; i < 16; ++i) { const int l = i ^ j; if (l > i) { const bool desc = ((i & k) == 0); const unsigned x = a[i], y = a[l], mx = umax_(x, y), mn = umin_(x, y); a[i] = desc ? mx : mn; a[l] = desc ? mn : mx; } }
}
__device__ __forceinline__ void merge16(unsigned (&a)[16], const unsigned (&b)[16]) {
#pragma unroll
    for (int i = 0; i < 16; ++i) a[i] = umax_(a[i], b[15 - i]);
#pragma unroll
    for (int j = 8; j > 0; j >>= 1)
#pragma unroll
        for (int i = 0; i < 16; ++i) { const int l = i ^ j; if (l > i) { const unsigned x = a[i], y = a[l]; a[i] = umax_(x, y); a[l] = umin_(x, y); } }
}
__device__ __forceinline__ unsigned dpp_swap1(unsigned v) { return (unsigned)__builtin_amdgcn_update_dpp(0, (int)v, 0xB1, 0xF, 0xF, false); }
__device__ __forceinline__ unsigned pick_byte(const unsigned (&pk)[4], unsigned a) {
    const unsigned wsel = a >> 2; unsigned v = wsel == 0 ? pk[0] : (wsel == 1 ? pk[1] : (wsel == 2 ? pk[2] : pk[3]));
    return (v >> ((a & 3u) * 8u)) & 0xffu;
}
__device__ __forceinline__ void p7_topk(Frame& F) {
    const int NT = T * PHEADS * 2;
    for (int g0 = (F.bid * NWAVES + F.wave) * 64; g0 < NT; g0 += F.G * NTHR) {
        const int g = g0 + F.lane; const float* wb = F.scores() + (size_t)g0 * 128;
        LAS float* stg = (LAS float*)(F.lds) + F.wave * (64 * 36);
        unsigned top[16];
#pragma unroll
        for (int sg = 0; sg < 4; ++sg) {
            f32x4 tl[8];
#pragma unroll
            for (int i = 0; i < 8; ++i) tl[i] = __builtin_nontemporal_load((const f32x4*)(wb + (size_t)(8 * i + (F.lane >> 3)) * 128 + sg * 32 + 4 * (F.lane & 7)));
#pragma unroll
            for (int i = 0; i < 8; ++i) *(LAS f32x4*)(stg + (8 * i + (F.lane >> 3)) * 36 + 4 * (F.lane & 7)) = tl[i];
            asm volatile("s_waitcnt lgkmcnt(0)" ::: "memory");
#pragma unroll
            for (int hg2 = 0; hg2 < 2; ++hg2) { const int grp = sg * 2 + hg2; unsigned k[16];
#pragma unroll
                for (int q = 0; q < 4; ++q) { const f32x4 v = *(LAS const f32x4*)(stg + F.lane * 36 + hg2 * 16 + q * 4);
#pragma unroll
                    for (int e = 0; e < 4; ++e) { const int j = grp * 16 + q * 4 + e; k[q * 4 + e] = (f2key(v[e]) & ~0x7fu) | (unsigned)(127 - j); } }
                sort16(k);
                if (grp == 0) {
#pragma unroll
                    for (int i = 0; i < 16; ++i) top[i] = k[i];
                } else merge16(top, k); }
            asm volatile("s_waitcnt lgkmcnt(0)" ::: "memory");
        }
        float vO[16], vP[16]; unsigned iOpk[4] = {0u, 0u, 0u, 0u}, iPpk[4] = {0u, 0u, 0u, 0u};
#pragma unroll
        for (int i = 0; i < 16; ++i) { const unsigned t = top[i], tp = dpp_swap1(t);
            vO[i] = key2f(t & ~0x7fu); vP[i] = key2f(tp & ~0x7fu);
            iOpk[i >> 2] |= (127u - (t & 0x7fu)) << ((i & 3) * 8); iPpk[i >> 2] |= (127u - (tp & 0x7fu)) << ((i & 3) * 8); }
        unsigned R[16], G1[16], G2[16], G3[16];
#define CAND(a, b) ((f2key(vO[a] + vP[b]) & ~0xffu) | (unsigned)(((a) << 4) | (b)))
#pragma unroll
        for (int i = 0; i < 16; ++i) R[i] = CAND(0, i);
        G1[0] = CAND(1, 0); G1[1] = CAND(1, 1); G1[2] = CAND(1, 2); G1[3] = CAND(1, 3); G1[4] = CAND(1, 4); G1[5] = CAND(1, 5); G1[6] = CAND(1, 6); G1[7] = CAND(1, 7);
        G1[8] = CAND(2, 0); G1[9] = CAND(2, 1); G1[10] = CAND(2, 2); G1[11] = CAND(2, 3); G1[12] = CAND(2, 4); G1[13] = CAND(3, 0); G1[14] = CAND(3, 1); G1[15] = CAND(3, 2);
        G2[0] = CAND(3, 3); G2[1] = CAND(4, 0); G2[2] = CAND(4, 1); G2[3] = CAND(4, 2); G2[4] = CAND(5, 0); G2[5] = CAND(5, 1); G2[6] = CAND(6, 0); G2[7] = CAND(6, 1);
        G2[8] = CAND(7, 0); G2[9] = CAND(7, 1); G2[10] = CAND(8, 0); G2[11] = CAND(9, 0); G2[12] = CAND(10, 0); G2[13] = CAND(11, 0); G2[14] = CAND(12, 0); G2[15] = CAND(13, 0);
        G3[0] = CAND(14, 0); G3[1] = CAND(15, 0);
#pragma unroll
        for (int i = 2; i < 16; ++i) G3[i] = 0u;
#undef CAND
        sort16(G1); sort16(G2); sort16(G3);
        merge16(R, G1); merge16(R, G2); merge16(R, G3);
        float sc[16], ex[16]; float sum = 0.f; unsigned eid[16];
        const bool tab0 = ((g & 1) == 0);
#pragma unroll
        for (int i = 0; i < 16; ++i) { sc[i] = key2f(R[i] & ~0xffu); const unsigned a = (R[i] >> 4) & 15u, bb = R[i] & 15u;
            const unsigned io = pick_byte(iOpk, a), ip = pick_byte(iPpk, bb);
            eid[i] = tab0 ? (io * 128u + ip) : (ip * 128u + io); }
#pragma unroll
        for (int i = 0; i < 16; ++i) { ex[i] = __expf(sc[i] - sc[0]); sum += ex[i]; }
        const float inv = 1.0f / sum;
        if (tab0) { const size_t o = (size_t)(g >> 1) * 16;
#pragma unroll
            for (int q = 0; q < 4; ++q) { v4u ev; ev.x = eid[4 * q]; ev.y = eid[4 * q + 1]; ev.z = eid[4 * q + 2]; ev.w = eid[4 * q + 3]; *(v4u*)(F.esel() + o + 4 * q) = ev;
                f32x4 wv; wv[0] = ex[4 * q] * inv; wv[1] = ex[4 * q + 1] * inv; wv[2] = ex[4 * q + 2] * inv; wv[3] = ex[4 * q + 3] * inv; *(f32x4*)(F.wsel() + o + 4 * q) = wv; } }
    }
}

__device__ __forceinline__ void cvt16(const v4u& u, f32x2_ (&f)[8]) {
#pragma unroll
    for (int i = 0; i < 4; ++i) { f[2 * i] = __builtin_amdgcn_cvt_pk_f32_fp8((int)u[i], false); f[2 * i + 1] = __builtin_amdgcn_cvt_pk_f32_fp8((int)u[i], true); }
}
constexpr int PITEM = 8, NPITEM = T / PITEM;
__device__ __forceinline__ int peer_next(unsigned* q, int lane) {
    int idx = 0; if (lane == 0) idx = (int)__hip_atomic_fetch_add(q, 1u, __ATOMIC_RELAXED, __HIP_MEMORY_SCOPE_AGENT);
    return __builtin_amdgcn_readfirstlane(idx);
}
#define PEER_SB() __builtin_amdgcn_sched_barrier(0)
__device__ __forceinline__ void p8_dots(const v4u (&ud)[16], const f32x2_ (&hn)[8], int c8, float& r0, float& r1) {
#pragma unroll
    for (int i = 0; i < 16; ++i) { f32x2_ uf[8]; cvt16(ud[i], uf); f32x2_ s2 = uf[0] * hn[0];
#pragma unroll
        for (int k = 1; k < 8; ++k) s2 += uf[k] * hn[k];
        float sm = s2[0] + s2[1];
        sm = DPP_ADD(sm, 0xB1); sm = DPP_ADD(sm, 0x4E); sm = DPP_ADD(sm, 0x141);
        if ((i & 1) == 0) r0 = (c8 == (i >> 1)) ? sm : r0; else r1 = (c8 == (i >> 1)) ? sm : r1;
        PEER_SB(); }
}
constexpr int PSLAB = 12288;
__device__ __forceinline__ void p8_item(Frame& F, int sl, int item, int nitem, bool filled, LAS unsigned char* slab) {
    const int c8 = F.lane & 7, q8 = F.lane >> 3, t0 = item * PITEM, b = t0 >> 13;
    const float* sh2 = F.mod() + b * 6144 + 3072 + sl * CSL + 16 * c8;
    float shv[16];
#pragma unroll
    for (int k = 0; k < 4; ++k) { const f32x4 v = *(const f32x4*)(sh2 + 4 * k); shv[4 * k] = v[0]; shv[4 * k + 1] = v[1]; shv[4 * k + 2] = v[2]; shv[4 * k + 3] = v[3]; }
    const unsigned char* ub = F.U8() + (size_t)sl * 16384 * CSL + 16 * c8;
    LAS int* eL = (LAS int*)slab; LAS bf16* hL = (LAS bf16*)(slab + 4096);
    v4u t4[4], h2[2];
#define P8_BLK_LOAD(tb) do { const v4u* ep_ = (const v4u*)(F.esel() + (size_t)(tb) * NSEL); \
        _Pragma("unroll") for (int i = 0; i < 4; ++i) t4[i] = __builtin_nontemporal_load(ep_ + i * 64 + F.lane); \
        _Pragma("unroll") for (int i = 0; i < 2; ++i) h2[i] = __builtin_nontemporal_load((const v4u*)(F.hg() + (size_t)((tb) + 4 * i + (F.lane >> 4)) * D + sl * CSL + 8 * (F.lane & 15))); } while (0)
#define P8_BLK_STORE() do { _Pragma("unroll") for (int i = 0; i < 4; ++i) *(LAS v4u*)(eL + (i * 64 + F.lane) * 4) = t4[i]; \
        _Pragma("unroll") for (int i = 0; i < 2; ++i) *(LAS v4u*)(hL + (i * 64 + F.lane) * 8) = h2[i]; asm volatile("s_waitcnt lgkmcnt(0)" ::: "memory"); } while (0)
    if (!filled) { P8_BLK_LOAD(t0); P8_BLK_STORE(); }
    const float* rp = F.rstd() + t0;
    float* po = F.pact() + ((size_t)t0 * NSL + sl) * NSEL + 16 * q8 + 2 * c8;
    v4u udA[16], udB[16];
#define P8_GATHER(dst, tt) do { v4u e_[4]; _Pragma("unroll") for (int k = 0; k < 4; ++k) e_[k] = *(LAS const v4u*)(eL + (tt) * NSEL + 16 * q8 + 4 * k); \
        _Pragma("unroll") for (int i = 0; i < 16; ++i) dst[i] = *(const v4u*)(ub + (size_t)e_[i >> 2][i & 3] * CSL); } while (0)
#define P8_HN(tt) f32x2_ hn[8]; { const v4u h0 = *(LAS const v4u*)(hL + (tt) * NSEL + 16 * c8), h1 = *(LAS const v4u*)(hL + (tt) * NSEL + 16 * c8 + 8); const float rstd = rp[tt]; \
        _Pragma("unroll") for (int k = 0; k < 4; ++k) { hn[k][0] = bflo(h0[k]) * rstd + shv[2 * k]; hn[k][1] = bfhi(h0[k]) * rstd + shv[2 * k + 1]; \
            hn[4 + k][0] = bflo(h1[k]) * rstd + shv[8 + 2 * k]; hn[4 + k][1] = bfhi(h1[k]) * rstd + shv[8 + 2 * k + 1]; } }
#define P8_OUT(tt, r0, r1) do { f32x2_ o_; o_[0] = (r0) * (1.0f / USCALE); o_[1] = (r1) * (1.0f / USCALE); __builtin_nontemporal_store(o_, (f32x2_*)(po + (size_t)(tt) * NSL * NSEL)); } while (0)
    P8_GATHER(udA, 0);
    for (int tt = 0; tt < PITEM - 2; tt += 2) {
        P8_GATHER(udB, tt + 1);
        { P8_HN(tt); float r0 = 0.f, r1 = 0.f; p8_dots(udA, hn, c8, r0, r1); P8_OUT(tt, r0, r1); }
        P8_GATHER(udA, tt + 2);
        { P8_HN(tt + 1); float r0 = 0.f, r1 = 0.f; p8_dots(udB, hn, c8, r0, r1); P8_OUT(tt + 1, r0, r1); }
    }
    {
        P8_GATHER(udB, PITEM - 1);
        { P8_HN(PITEM - 2); float r0 = 0.f, r1 = 0.f; p8_dots(udA, hn, c8, r0, r1); P8_OUT(PITEM - 2, r0, r1); }
        if (nitem >= 0) P8_BLK_LOAD(nitem * PITEM);
        { P8_HN(PITEM - 1); float r0 = 0.f, r1 = 0.f; p8_dots(udB, hn, c8, r0, r1); P8_OUT(PITEM - 1, r0, r1); }
        if (nitem >= 0) P8_BLK_STORE();
    }
#undef P8_GATHER
#undef P8_HN
#undef P8_OUT
#undef P8_BLK_LOAD
#undef P8_BLK_STORE
}
__device__ __forceinline__ void p8b_coef(Frame& F) {
    const size_t N = (size_t)T * NSEL;
    for (size_t i = (size_t)F.bid * NTHR + F.tid; i < N; i += (size_t)F.G * NTHR) { const size_t t = i >> 7; const int j = (int)(i & 127);
        const float* pp = F.pact() + t * NSL * NSEL + j; float a = 0.f;
#pragma unroll
        for (int s = 0; s < NSL; ++s) a += __builtin_nontemporal_load(pp + s * NSEL);
        F.coef()[i] = F.wsel()[i] * 0.5f * a * (1.0f + erff(a * 0.70710678f)); }
}
__device__ __forceinline__ void p9_token(const v4u (&vd)[16], LAS const float* cL, float* yo, LAS float* red, int lane, int c8, int q8) {
    f32x4 cc[4];
#pragma unroll
    for (int k = 0; k < 4; ++k) cc[k] = *(LAS const f32x4*)(cL + 16 * q8 + 4 * k);
    f32x2_ y[8];
#pragma unroll
    for (int k = 0; k < 8; ++k) y[k] = (f32x2_){0.f, 0.f};
#pragma unroll
    for (int i = 0; i < 16; ++i) { f32x2_ vf[8]; cvt16(vd[i], vf); const float c = cc[i >> 2][i & 3]; const f32x2_ c2 = {c, c};
#pragma unroll
        for (int k = 0; k < 8; ++k) y[k] += c2 * vf[k];
        PEER_SB(); }
#pragma unroll
    for (int k = 0; k < 4; ++k) { f32x4 o; o[0] = y[2 * k][0]; o[1] = y[2 * k][1]; o[2] = y[2 * k + 1][0]; o[3] = y[2 * k + 1][1]; *(LAS f32x4*)(red + q8 * 128 + 16 * c8 + 4 * k) = o; }
    asm volatile("s_waitcnt lgkmcnt(0)" ::: "memory");
    f32x2_ sm = {0.f, 0.f};
#pragma unroll
    for (int g = 0; g < 8; ++g) sm += *(LAS const f32x2_*)(red + g * 128 + 2 * lane);
    sm = sm * (1.0f / VSCALE);
    __builtin_nontemporal_store(sm, (f32x2_*)(yo + 2 * lane));
    asm volatile("s_waitcnt lgkmcnt(0)" ::: "memory");
    PEER_SB();
}
__device__ __forceinline__ void p9_item(Frame& F, int sl, int item, int nitem, bool filled, LAS unsigned char* slab) {
    const int c8 = F.lane & 7, q8 = F.lane >> 3, t0 = item * PITEM;
    const unsigned char* vb = F.V8() + (size_t)sl * 16384 * CSL + 16 * c8;
    LAS int* eL = (LAS int*)slab; LAS float* cL = (LAS float*)(slab + 4096); LAS float* red = (LAS float*)(slab + 8192);
    v4u t4[4], c4[4];
#define P9_BLK_LOAD(tb) do { const v4u* ep_ = (const v4u*)(F.esel() + (size_t)(tb) * NSEL); const v4u* cp_ = (const v4u*)(F.coef() + (size_t)(tb) * NSEL); \
        _Pragma("unroll") for (int i = 0; i < 4; ++i) { t4[i] = __builtin_nontemporal_load(ep_ + i * 64 + F.lane); c4[i] = __builtin_nontemporal_load(cp_ + i * 64 + F.lane); } } while (0)
#define P9_BLK_STORE() do { _Pragma("unroll") for (int i = 0; i < 4; ++i) { *(LAS v4u*)(eL + (i * 64 + F.lane) * 4) = t4[i]; *(LAS v4u*)(cL + (i * 64 + F.lane) * 4) = c4[i]; } \
        asm volatile("s_waitcnt lgkmcnt(0)" ::: "memory"); } while (0)
    if (!filled) { P9_BLK_LOAD(t0); P9_BLK_STORE(); }
    float* yo = F.ybuf() + (size_t)t0 * D + sl * CSL;
    v4u vdA[16], vdB[16];
#define P9_GATHER(dst, tt) do { v4u e_[4]; _Pragma("unroll") for (int k = 0; k < 4; ++k) e_[k] = *(LAS const v4u*)(eL + (tt) * NSEL + 16 * q8 + 4 * k); \
        _Pragma("unroll") for (int i = 0; i < 16; ++i) dst[i] = *(const v4u*)(vb + (size_t)e_[i >> 2][i & 3] * CSL); } while (0)
    P9_GATHER(vdA, 0);
    for (int tt = 0; tt < PITEM - 2; tt += 2) {
        P9_GATHER(vdB, tt + 1);
        p9_token(vdA, cL + tt * NSEL, yo + (size_t)tt * D, red, F.lane, c8, q8);
        P9_GATHER(vdA, tt + 2);
        p9_token(vdB, cL + (tt + 1) * NSEL, yo + (size_t)(tt + 1) * D, red, F.lane, c8, q8);
    }
    {
        P9_GATHER(vdB, PITEM - 1);
        p9_token(vdA, cL + (PITEM - 2) * NSEL, yo + (size_t)(PITEM - 2) * D, red, F.lane, c8, q8);
        if (nitem >= 0) P9_BLK_LOAD(nitem * PITEM);
        p9_token(vdB, cL + (PITEM - 1) * NSEL, yo + (size_t)(PITEM - 1) * D, red, F.lane, c8, q8);
        if (nitem >= 0) P9_BLK_STORE();
    }
#undef P9_GATHER
#undef P9_BLK_LOAD
#undef P9_BLK_STORE
}
template <int SIDE>
__device__ __forceinline__ void peer_phase(Frame& F0, int rep) {
    Frame F = F0; asm volatile("" : "+v"(F.lane));
    const int s0 = (int)(xb_xcc_id() & 7u);
    unsigned* qbase = F.ctl() + (SIDE == 0 ? CW_QU : CW_QV) + rep * 64 * 32;
    LAS unsigned char* cf = F.lds + F.wave * PSLAB;
    for (int k = 0; k < NSL; ++k) { const int sl = (s0 + k) & (NSL - 1);
        int item = peer_next(qbase + 64 * sl, F.lane); bool filled = false;
        while (item < NPITEM) { int nitem = peer_next(qbase + 64 * sl, F.lane); if (nitem >= NPITEM) nitem = -1;
            if (SIDE == 0) p8_item(F, sl, item, nitem, filled, cf); else p9_item(F, sl, item, nitem, filled, cf);
            filled = nitem >= 0; item = nitem >= 0 ? nitem : NPITEM; } }
}
__device__ __forceinline__ void p10_final(Frame& F) {
    const int gwc = F.bid * NWAVES + F.wave, NGW = F.G * NWAVES;
    for (int row0 = gwc * 16; row0 < T; row0 += NGW * 16) {
        const int b = row0 >> 13; const float* mb = F.mod() + b * 6144 + 5120; const float* fm = F.fmod() + b * 2048;
        f32x4 g2[4], ca[4], cb[4];
#pragma unroll
        for (int j = 0; j < 4; ++j) { const int k = 256 * j + 4 * F.lane; g2[j] = *(const f32x4*)(mb + k); ca[j] = *(const f32x4*)(F.fnorm_g() + k) * (*(const f32x4*)(fm + 1024 + k) + 1.0f); cb[j] = *(const f32x4*)(fm + k); }
#pragma unroll 4
        for (int r = 0; r < 16; ++r) { float* hr = F.out() + (size_t)(row0 + r) * D; const float* yr = F.ybuf() + (size_t)(row0 + r) * D; const bf16* hb = (const bf16*)hr;
            f32x4 z[4]; float ss = 0.f;
#pragma unroll
            for (int j = 0; j < 4; ++j) { const v2u hq = *(const v2u*)(hb + 256 * j + 4 * F.lane); f32x4 hv; hv[0] = bflo(hq[0]); hv[1] = bfhi(hq[0]); hv[2] = bflo(hq[1]); hv[3] = bfhi(hq[1]);
                z[j] = hv + g2[j] * __builtin_nontemporal_load((const f32x4*)(yr + 256 * j + 4 * F.lane)); ss += z[j][0] * z[j][0] + z[j][1] * z[j][1] + z[j][2] * z[j][2] + z[j][3] * z[j][3]; }
            const float rstd = __builtin_amdgcn_rsqf(wave_sum(ss) * (1.0f / D) + EPS);
#pragma unroll
            for (int j = 0; j < 4; ++j) *(f32x4*)(hr + 256 * j + 4 * F.lane) = z[j] * rstd * ca[j] + cb[j]; }
    }
}

constexpr int NPHASE = 12;
__global__ void __launch_bounds__(NTHR, 2) fwd_kernel(Args args) {
    extern __shared__ __attribute__((aligned(16))) unsigned char lds_raw[];
    Frame F;
    F.lds = (LAS unsigned char*)lds_raw;
    F.tid = threadIdx.x; F.lane = F.tid & 63; F.wave = __builtin_amdgcn_readfirstlane(F.tid >> 6); F.G = gridDim.x; F.bid = blockIdx.x;
    unsigned char* ws = args.ws; F.a = &args;
    volatile LAS unsigned* misc = (volatile LAS unsigned*)(F.lds + MISC_OFF);
    if (F.tid < 64) misc[F.tid] = 0u;
    __syncthreads();
    const int lo = args.ph_lo, hi = args.ph_hi;
    const bool multi = (hi - lo) > 1;
    XcdBarrier bar; bar.bar = (unsigned*)(ws + WS_CTL) + CW_BAR; bar.x = 0; bar.st = nullptr;
    if (multi) bar = xcd_barrier_post((unsigned*)(ws + WS_CTL) + CW_BAR, misc + 8);
#ifndef PHMASK
#define PHMASK 0xfff
#endif
#define IN(k) (((PHMASK >> (k)) & 1) && lo <= (k) && (k) < hi)
#define SEAM(k) do { if (IN(k) && IN((k) + 1)) xcd_barrier(bar); } while (0)

#ifndef REPMASK
#define REPMASK 0
#endif
#define REP(k) (((REPMASK) >> (k)) & 1)
#define REPBAR(k) if (REP(k) && rep == 0) xcd_barrier(bar)
    if (IN(0)) { for (int rep = 0; rep <= REP(0); ++rep) { p0_prologue(F); REPBAR(0); } } SEAM(0);
    if (IN(1)) { for (int rep = 0; rep <= REP(1); ++rep) { p1_norm(F); REPBAR(1); } } SEAM(1);
    if (IN(2)) { { pg8::Gemm g{F.bufA(), F.Win_t(), T, NIN, D}; pg8::StaticOrder S; S.init(T, NIN, F.G, F.bid);
        pg8::EpiBf16<0> E{F.proj(), NIN, nullptr, 0, 0, 1.f};
        pg8::gemm_phase<pg8::EpiBf16<0>, pg8::StaticOrder, true, true>(F.lds, g, S, E); }
#if ((REPMASK) >> 2) & 1
        xcd_barrier(bar); { pg8::Gemm g{F.bufA(), F.Win_t(), T, NIN, D}; pg8::StaticOrder S; S.init(T, NIN, F.G, F.bid);
        pg8::EpiBf16<0> E{F.proj(), NIN, nullptr, 0, 0, 1.f};
        pg8::gemm_phase<pg8::EpiBf16<0>, pg8::StaticOrder, true, true>(F.lds, g, S, E); }
#endif
    } SEAM(2);
    if (IN(3)) { for (int rep = 0; rep <= REP(3); ++rep) {
        for (int it = F.bid; it < NB * NHH * 2 * NSEG; it += F.G) h1_item(F, it);
        float cw[CW];
#pragma unroll
        for (int j = 0; j < CW; ++j) cw[j] = F.conv_w()[j * DC + F.tid];
        const float cbias = F.conv_b()[F.tid];
        for (int it = F.bid; it < T / 32; it += F.G) conv_item(F, it, cw, cbias); REPBAR(3); }
    } SEAM(3);
    if (IN(4)) { for (int rep = 0; rep <= REP(4); ++rep) { for (int it = F.bid; it < NB * NHH * NSEG; it += F.G) h2_item(F, it); REPBAR(4); } } SEAM(4);
    if (IN(5)) { { pg8::Gemm g{F.bufA(), F.Wout_t(), T, D, D}; pg8::StaticOrder S; S.init(T, D, F.G, F.bid);
        pg8::EpiOut E{F.x(), F.out(), F.hg(), F.mod(), F.g_ffn(), F.ssqp()};
        pg8::gemm_phase<pg8::EpiOut, pg8::StaticOrder, true, true>(F.lds, g, S, E); }
#if ((REPMASK) >> 5) & 1
        xcd_barrier(bar); { pg8::Gemm g{F.bufA(), F.Wout_t(), T, D, D}; pg8::StaticOrder S; S.init(T, D, F.G, F.bid);
        pg8::EpiOut E{F.x(), F.out(), F.hg(), F.mod(), F.g_ffn(), F.ssqp()};
        pg8::gemm_phase<pg8::EpiOut, pg8::StaticOrder, true, true>(F.lds, g, S, E); }
#endif
    } SEAM(5);
    if (IN(6)) { { pg8::Gemm g{F.hg(), F.Wqk_t(), T, NQK, D}; pg8::StaticOrder S; S.init(T, NQK, F.G, F.bid);
        pg8::EpiScore E{F.scores(), F.ssqp(), F.biasq(), F.rstd()};
        pg8::gemm_phase<pg8::EpiScore, pg8::StaticOrder, true, true>(F.lds, g, S, E); }
#if ((REPMASK) >> 6) & 1
        xcd_barrier(bar); { pg8::Gemm g{F.hg(), F.Wqk_t(), T, NQK, D}; pg8::StaticOrder S; S.init(T, NQK, F.G, F.bid);
        pg8::EpiScore E{F.scores(), F.ssqp(), F.biasq(), F.rstd()};
        pg8::gemm_phase<pg8::EpiScore, pg8::StaticOrder, true, true>(F.lds, g, S, E); }
#endif
    } SEAM(6);
    if (IN(7)) { for (int rep = 0; rep <= REP(7); ++rep) { p7_topk(F); REPBAR(7); } } SEAM(7);
    if (IN(8)) { for (int rep = 0; rep <= REP(8); ++rep) { peer_phase<0>(F, rep); REPBAR(8); } } SEAM(8);
    if (IN(9)) { for (int rep = 0; rep <= REP(9); ++rep) { p8b_coef(F); REPBAR(9); } } SEAM(9);
    if (IN(10)) { for (int rep = 0; rep <= REP(10); ++rep) { peer_phase<1>(F, rep); REPBAR(10); } } SEAM(10);
    if (IN(11)) { p10_final(F); }
#undef IN
#undef SEAM
}

#ifndef MK_ONE_LAUNCH
#define MK_ONE_LAUNCH 0
#endif
extern "C" void kernel_launch(void* const* d_in, const int* in_sizes, int n_in, void* d_out, int out_size, void* d_ws, size_t ws_size, hipStream_t stream) {
    static int grid = 0;
    if (grid == 0) {
        if (n_in != 23 || out_size != T * D || ws_size < WS_END) { fprintf(stderr, "kernel_launch: unexpected shapes (n_in %d, out %d, ws %zu)\n", n_in, out_size, ws_size); grid = -1; return; }
        int dev = 0, cus = 0, per_cu = 0;
        if (hipGetDevice(&dev) != hipSuccess || hipDeviceGetAttribute(&cus, hipDeviceAttributeMultiprocessorCount, dev) != hipSuccess) { grid = -1; return; }
        if (hipFuncSetAttribute((const void*)fwd_kernel, hipFuncAttributeMaxDynamicSharedMemorySize, LDS_BYTES) != hipSuccess) { fprintf(stderr, "kernel_launch: hipFuncSetAttribute failed\n"); grid = -1; return; }
        if (hipOccupancyMaxActiveBlocksPerMultiprocessor(&per_cu, (const void*)fwd_kernel, NTHR, LDS_BYTES) != hipSuccess || per_cu < 1) { fprintf(stderr, "kernel_launch: occupancy query reports %d\n", per_cu); }
        (void)hipGetLastError();
        grid = cus;
    }
    if (grid < 0) return;
    (void)hipMemsetAsync((char*)d_ws + WS_CTL, 0, CTL_ZERO_BYTES, stream);
    Args a{};
    for (int i = 0; i < 23; ++i) a.in[i] = (const float*)d_in[i];
    a.out = (float*)d_out; a.ws = (unsigned char*)d_ws;
#if MK_ONE_LAUNCH
    a.ph_lo = 0; a.ph_hi = NPHASE;
    hipLaunchKernelGGL(fwd_kernel, dim3(grid), dim3(NTHR), LDS_BYTES, stream, a);
#else
    for (int p = 0; p < NPHASE; ++p) { a.ph_lo = p; a.ph_hi = p + 1; hipLaunchKernelGGL(fwd_kernel, dim3(grid), dim3(NTHR), LDS_BYTES, stream, a); }
#endif
}
```

```cpp
#include <hip/hip_runtime.h>
#include <cstdio>
#include <cstdint>
namespace pg8 {
#define PG8_LAS __attribute__((address_space(3)))
typedef unsigned short bf16_t;
typedef short bf16x8 __attribute__((ext_vector_type(8)));
typedef float f32x4 __attribute__((ext_vector_type(4)));
typedef unsigned u32x4 __attribute__((ext_vector_type(4)));
constexpr int BM = 256, BK = 64, HALF = 128, HTB = HALF * BK * 2  , STAGE_BYTES = 8 * HTB, NXCD = 8, WGM = 8;

__host__ __device__ __forceinline__ int lds_byte(int r, int c) { const int st = (r >> 4) * 2 + (c >> 5), rr = r & 15, cc = c & 31, ob = rr * 64 + cc * 2; return st * 1024 + (ob ^ (((ob >> 9) & 1) << 5)); }
__host__ __device__ __forceinline__ void stage_rc(int b, int& R, int& C) { const int st = b / 1024, sb = b % 1024, swz = sb ^ (((sb >> 9) & 1) << 5); R = (st >> 1) * 16 + swz / 64; C = (st & 1) * 32 + (swz % 64) / 2; }
__host__ __device__ __forceinline__ int perm32(int rho) { const int n = rho >> 4, i = rho & 15; return 8 * (i >> 2) + 4 * n + (i & 3); }

struct Unit { int pm, pn; };
struct Gemm { const bf16_t* A; const bf16_t* Bt; int M, N, K; };

struct StaticOrder {
    int nM, nN, nwg, G, c;
    __host__ __device__ void init(int M, int N, int G_, int c_) { nM = M / BM; nN = N / BM; nwg = nM * nN; G = G_; c = c_; }
    __host__ __device__ bool next(int i, Unit& u) const {
        const long L = (long)i * G + c; if (L >= nwg) return false;
        int wgid = (int)L; { const int q = nwg / NXCD, r = nwg % NXCD, xcd = wgid % NXCD, off = wgid / NXCD; wgid = (xcd < r ? xcd * (q + 1) : r * (q + 1) + (xcd - r) * q) + off; }
        const int nig = WGM * nN, gid = wgid / nig, fm = gid * WGM, gsz = (nM - fm) < WGM ? (nM - fm) : WGM;
        u.pm = fm + ((wgid % nig) % gsz); u.pn = (wgid % nig) / gsz; return true;
    }
    __device__ __forceinline__ void a_ready(const Unit&) const {}
    __device__ __forceinline__ void done(const Unit&) const {}
};
__device__ __forceinline__ unsigned cvt_pk_bf16(float lo, float hi) { unsigned r; asm volatile("v_cvt_pk_bf16_f32 %0, %1, %2" : "=v"(r) : "v"(lo), "v"(hi)); return r; }
typedef float f32x2 __attribute__((ext_vector_type(2)));
__device__ __forceinline__ f32x2 gelu_pk(f32x2 v) {
    const f32x2 av = __builtin_elementwise_abs(v), d = av * 0.2316418882f + 1.0f;
    f32x2 t; t.x = __builtin_amdgcn_rcpf(d.x); t.y = __builtin_amdgcn_rcpf(d.y);
    f32x2 q = t * 0.5307027145f + (-0.7265760135f); q = q * t + 0.7107068705f; q = q * t + (-0.142248368f); q = q * t + 0.127414796f; q = q * t;
    const f32x2 s = (v * v) * (-0.72134752044f);
    f32x2 e; e.x = __builtin_amdgcn_exp2f(s.x); e.y = __builtin_amdgcn_exp2f(s.y);
    const f32x2 m = v * (q * e), r = v - m;
    f32x2 o; o.x = v.x < 0.f ? m.x : r.x; o.y = v.y < 0.f ? m.y : r.y; return o;
}

template <int ACT  > struct EpiBf16 {
    static constexpr bool PERM = true, AFTER_DRAIN = false; static_assert(ACT == 0 || ACT == 1, "EpiBf16: ACT is 0 (none) or 1 (gelu_pk)");
    bf16_t* O; int ldc; const float* bias; int split_cols; size_t split_stride; float scale0;
    __device__ __forceinline__ void operator()(const f32x4 (&acc)[2][2][4][2], const Unit& u, int wr, int wc, int fr, int fq) const {
        const int row0 = u.pm * BM + wr * 64 + fr; int colt = u.pn * BM; bf16_t* base = O;
        float sc = 1.f; if (split_cols) { const int t = colt / split_cols; base += (size_t)t * split_stride; colt -= t * split_cols; if (t == 0) sc = scale0; }
        const int col0 = colt + wc * 32 + 8 * fq, bcol0 = u.pn * BM + wc * 32 + 8 * fq;
        f32x4 bv[2][2];
#pragma unroll
        for (int bj = 0; bj < 2; ++bj)
#pragma unroll
            for (int n = 0; n < 2; ++n) bv[bj][n] = bias ? *(const f32x4*)(bias + bcol0 + bj * HALF + 4 * n) : (f32x4){0.f, 0.f, 0.f, 0.f};
#pragma unroll
        for (int ai = 0; ai < 2; ++ai)
#pragma unroll
            for (int m = 0; m < 4; ++m) { bf16_t* rowp = base + (size_t)(row0 + ai * HALF + m * 16) * ldc + col0;
#pragma unroll
                for (int bj = 0; bj < 2; ++bj) { f32x4 v0 = acc[ai][bj][m][0] + bv[bj][0], v1 = acc[ai][bj][m][1] + bv[bj][1];
                    if (ACT == 1) { f32x2 a = gelu_pk((f32x2){v0[0], v0[1]}), b = gelu_pk((f32x2){v0[2], v0[3]}), c = gelu_pk((f32x2){v1[0], v1[1]}), d = gelu_pk((f32x2){v1[2], v1[3]});
                        v0 = (f32x4){a.x, a.y, b.x, b.y}; v1 = (f32x4){c.x, c.y, d.x, d.y}; }
                    v0 = v0 * sc; v1 = v1 * sc; u32x4 w; w.x = cvt_pk_bf16(v0[0], v0[1]); w.y = cvt_pk_bf16(v0[2], v0[3]); w.z = cvt_pk_bf16(v1[0], v1[1]); w.w = cvt_pk_bf16(v1[2], v1[3]);
                    *(u32x4*)(rowp + bj * HALF) = w; } }
    }
};

struct EpiOut {
    static constexpr bool PERM = true, AFTER_DRAIN = false;
    const float* X; float* Hout; bf16_t* HG; const float* mod; const float* gffn; float* ssqp;
    __device__ __forceinline__ void operator()(const f32x4 (&acc)[2][2][4][2], const Unit& u, int wr, int wc, int fr, int fq) const {
        const int row0 = u.pm * BM + wr * 64 + fr, col0 = u.pn * BM + wc * 32 + 8 * fq;
        const int b = (u.pm * BM) >> 13;
        const float* mb = mod + b * 6144;
        f32x4 g1v[2][2], gv2[2][2];
#pragma unroll
        for (int bj = 0; bj < 2; ++bj)
#pragma unroll
            for (int n = 0; n < 2; ++n) { const int c = col0 + bj * HALF + 4 * n;
                g1v[bj][n] = *(const f32x4*)(mb + 2048 + c);
                const f32x4 s2 = *(const f32x4*)(mb + 4096 + c), gf = *(const f32x4*)(gffn + c);
                gv2[bj][n] = gf * (s2 + 1.0f); }
#pragma unroll
        for (int ai = 0; ai < 2; ++ai)
#pragma unroll
            for (int m = 0; m < 4; ++m) { const int row = row0 + ai * HALF + m * 16; const size_t ro = (size_t)row * 1024 + col0; float ss = 0.f;
#pragma unroll
                for (int bj = 0; bj < 2; ++bj) {
                    const f32x4 x0 = *(const f32x4*)(X + ro + bj * HALF), x1 = *(const f32x4*)(X + ro + bj * HALF + 4);
                    const f32x4 h0 = x0 + g1v[bj][0] * acc[ai][bj][m][0], h1 = x1 + g1v[bj][1] * acc[ai][bj][m][1];
                    { u32x4 hw; hw.x = cvt_pk_bf16(h0[0], h0[1]); hw.y = cvt_pk_bf16(h0[2], h0[3]); hw.z = cvt_pk_bf16(h1[0], h1[1]); hw.w = cvt_pk_bf16(h1[2], h1[3]);
                      *(u32x4*)((bf16_t*)Hout + (size_t)row * 2048 + col0 + bj * HALF) = hw; }
                    ss += h0[0] * h0[0] + h0[1] * h0[1] + h0[2] * h0[2] + h0[3] * h0[3] + h1[0] * h1[0] + h1[1] * h1[1] + h1[2] * h1[2] + h1[3] * h1[3];
                    const f32x4 q0 = h0 * gv2[bj][0], q1 = h1 * gv2[bj][1];
                    u32x4 w; w.x = cvt_pk_bf16(q0[0], q0[1]); w.y = cvt_pk_bf16(q0[2], q0[3]); w.z = cvt_pk_bf16(q1[0], q1[1]); w.w = cvt_pk_bf16(q1[2], q1[3]);
                    *(u32x4*)(HG + ro + bj * HALF) = w; }
                ss += __shfl_xor(ss, 16); ss += __shfl_xor(ss, 32);
                if (fq == 0) ssqp[((size_t)u.pn * 32768 + row) * 4 + wc] = ss; }
    }
};
struct EpiScore {
    static constexpr bool PERM = false, AFTER_DRAIN = false;
    float* S; const float* ssqp; const float* biasq; float* rstd_out;
    __device__ __forceinline__ void operator()(const f32x4 (&acc)[2][2][4][2], const Unit& u, int wr, int wc, int fr, int fq) const {
        const int row0 = u.pm * BM + wr * 64 + fr, col0 = u.pn * BM + wc * 32 + 4 * fq;
        const int b = (u.pm * BM) >> 13;
        f32x4 bv[2][2];
#pragma unroll
        for (int bj = 0; bj < 2; ++bj)
#pragma unroll
            for (int n = 0; n < 2; ++n) bv[bj][n] = *(const f32x4*)(biasq + b * 2048 + col0 + bj * HALF + n * 16);
#pragma unroll
        for (int ai = 0; ai < 2; ++ai)
#pragma unroll
            for (int m = 0; m < 4; ++m) { const int row = row0 + ai * HALF + m * 16;
                const f32x4 p0 = *(const f32x4*)(ssqp + (size_t)row * 4), p1 = *(const f32x4*)(ssqp + ((size_t)32768 + row) * 4), p2 = *(const f32x4*)(ssqp + ((size_t)65536 + row) * 4), p3 = *(const f32x4*)(ssqp + ((size_t)98304 + row) * 4);
                const float tot = (p0[0] + p0[1] + p0[2] + p0[3]) + (p1[0] + p1[1] + p1[2] + p1[3]) + (p2[0] + p2[1] + p2[2] + p2[3]) + (p3[0] + p3[1] + p3[2] + p3[3]);
                const float rstd = __builtin_amdgcn_rsqf(tot * (1.0f / 1024.0f) + 1e-6f);
                if (u.pn == 0 && wc == 0 && fq == 0) rstd_out[row] = rstd;
                float* rowp = S + (size_t)row * 2048 + col0;
#pragma unroll
                for (int bj = 0; bj < 2; ++bj)
#pragma unroll
                    for (int n = 0; n < 2; ++n) *(f32x4*)(rowp + bj * HALF + n * 16) = acc[ai][bj][m][n] * rstd + bv[bj][n]; }
    }
};

struct EpiProj {
    static constexpr bool PERM = true, AFTER_DRAIN = false;
    bf16_t* O; int ldc;
    __device__ __forceinline__ void operator()(const f32x4 (&acc)[2][2][4][2], const Unit& u, int wr, int wc, int fr, int fq) const {
        asm volatile("" : "+v"(fr), "+v"(fq));
        const int row0 = u.pm * BM + wr * 64 + fr, col0 = u.pn * BM + wc * 32 + 8 * fq;
        const int cls = u.pn >> 1;
        const bool ident = (cls == 3) || (cls == 5), mulx = (cls == 0) || (cls == 4);
        const float sgn = (cls == 1 || cls == 2) ? 1.4426950408889634f : -1.4426950408889634f;
#pragma unroll
        for (int ai = 0; ai < 2; ++ai)
#pragma unroll
            for (int m = 0; m < 4; ++m) { bf16_t* rowp = O + (size_t)(row0 + ai * HALF + m * 16) * ldc + col0;
#pragma unroll
                for (int bj = 0; bj < 2; ++bj) { f32x4 v0 = acc[ai][bj][m][0], v1 = acc[ai][bj][m][1];
                    if (!ident) {
#pragma unroll
                        for (int j = 0; j < 4; ++j) { const float r0 = __builtin_amdgcn_rcpf(1.0f + __builtin_amdgcn_exp2f(sgn * v0[j])), r1 = __builtin_amdgcn_rcpf(1.0f + __builtin_amdgcn_exp2f(sgn * v1[j]));
                            v0[j] = mulx ? v0[j] * r0 : r0; v1[j] = mulx ? v1[j] * r1 : r1; } }
                    u32x4 w; w.x = cvt_pk_bf16(v0[0], v0[1]); w.y = cvt_pk_bf16(v0[2], v0[3]); w.z = cvt_pk_bf16(v1[0], v1[1]); w.w = cvt_pk_bf16(v1[2], v1[3]);
                    *(u32x4*)(rowp + bj * HALF) = w; } }
    }
};
template <class Epi, class Sched, bool ALIGN_EPI = false, bool SP2 = false>
__device__ __forceinline__ void gemm_phase(PG8_LAS unsigned char* lds, const Gemm g, const Sched& S, const Epi& E) {
    const int tid = threadIdx.x, wid = __builtin_amdgcn_readfirstlane(tid >> 6), lane = tid & 63, wr = wid >> 2, wc = wid & 3, fr = lane & 15, fq = lane >> 4;
    const int K = g.K, nt = K / BK;
    unsigned voffA[2], voffB[2];
#pragma unroll
    for (int i = 0; i < 2; ++i) { int R, C; stage_rc(tid * 16 + i * 8192, R, C); const int Rb = Epi::PERM ? ((R & ~31) + perm32(R & 31)) : R;
        voffA[i] = (unsigned)(R * K + C) * 2u; voffB[i] = (unsigned)(Rb * K + C) * 2u; }
    const size_t kstep = (size_t)(BK * 2);
    const size_t hstep = (size_t)HALF * K * 2;
    const size_t tstep = 2 * hstep;
    const unsigned ldsw = (unsigned)wid * 1024u;
    const int aoff = lds_byte(wr * 64 + fr, fq * 8), boff = lds_byte(wc * 32 + fr, fq * 8);
#define PG8_SA(b, h) (((b) * 2 + (h)) * HTB)
#define PG8_SB(b, h) ((4 + (b) * 2 + (h)) * HTB)
#define PG8_STAGE(bufoff, gbase, voff) do { _Pragma("unroll") for (int _i = 0; _i < 2; ++_i) \
        __builtin_amdgcn_global_load_lds((const unsigned*)((const char*)(gbase) + (voff)[_i]), (PG8_LAS unsigned*)(lds + (bufoff) + ldsw + _i * 8192), 16, 0, 0); } while (0)
#define PG8_LDA(dst, b, h) do { _Pragma("unroll") for (int m = 0; m < 4; ++m) _Pragma("unroll") for (int k = 0; k < 2; ++k) dst[m][k] = *(const PG8_LAS bf16x8*)(lds + PG8_SA(b, h) + aoff + m * 2048 + k * 1024); } while (0)
#define PG8_LDB(dst, b, h) do { _Pragma("unroll") for (int n = 0; n < 2; ++n) _Pragma("unroll") for (int k = 0; k < 2; ++k) dst[n][k] = *(const PG8_LAS bf16x8*)(lds + PG8_SB(b, h) + boff + n * 2048 + k * 1024); } while (0)
#define PG8_MMA(ai, bj, At, Bt) do { __builtin_amdgcn_s_setprio(1); _Pragma("unroll") for (int m = 0; m < 4; ++m) _Pragma("unroll") for (int n = 0; n < 2; ++n) _Pragma("unroll") for (int k = 0; k < 2; ++k) \
        acc[ai][bj][m][n] = __builtin_amdgcn_mfma_f32_16x16x32_bf16(Bt[n][k], At[m][k], acc[ai][bj][m][n], 0, 0, 0); __builtin_amdgcn_s_setprio(0); } while (0)
#define PG8_WAIT_V(n) asm volatile("s_waitcnt vmcnt(" #n ")" ::: "memory")
#define PG8_WAIT_L(n) asm volatile("s_waitcnt lgkmcnt(" #n ")" ::: "memory")
#define PG8_BAR __builtin_amdgcn_s_barrier()
#define PG8_SCHED __builtin_amdgcn_sched_barrier(0)
    Unit cur, nxt; int ui = 0;
    if (!S.next(0, cur)) return;
    f32x4 acc[2][2][4][2];
#pragma unroll
    for (int a = 0; a < 2; ++a)
#pragma unroll
        for (int b = 0; b < 2; ++b)
#pragma unroll
            for (int m = 0; m < 4; ++m)
#pragma unroll
                for (int n = 0; n < 2; ++n) acc[a][b][m][n] = (f32x4){0.f, 0.f, 0.f, 0.f};
    bf16x8 At[4][2], B0[2][2], B1[2][2];
    const char* cA = (const char*)g.A + (size_t)cur.pm * tstep; const char* cB = (const char*)g.Bt + (size_t)cur.pn * tstep;
    S.a_ready(cur);
    if constexpr (SP2) {
        PG8_STAGE(PG8_SB(0, 0), cB, voffB); PG8_STAGE(PG8_SB(0, 1), cB + hstep, voffB); PG8_STAGE(PG8_SA(0, 0), cA, voffA); PG8_STAGE(PG8_SA(0, 1), cA + hstep, voffA);
        if (wr == 1) PG8_BAR;
        PG8_WAIT_V(2); PG8_BAR;
        PG8_STAGE(PG8_SB(1, 0), cB + kstep, voffB); PG8_STAGE(PG8_SA(1, 0), cA + kstep, voffA); PG8_STAGE(PG8_SB(1, 1), cB + hstep + kstep, voffB);
        PG8_WAIT_V(6); PG8_BAR;
    } else {
        PG8_STAGE(PG8_SB(0, 0), cB, voffB); PG8_STAGE(PG8_SA(0, 0), cA, voffA); PG8_STAGE(PG8_SB(0, 1), cB + hstep, voffB); PG8_STAGE(PG8_SA(0, 1), cA + hstep, voffA);
        if (wr == 1) PG8_BAR;
        PG8_WAIT_V(4); PG8_BAR;
        PG8_STAGE(PG8_SB(1, 0), cB + kstep, voffB); PG8_STAGE(PG8_SA(1, 0), cA + kstep, voffA); PG8_STAGE(PG8_SB(1, 1), cB + hstep + kstep, voffB);
        PG8_WAIT_V(6); PG8_BAR;
    }
    for (;;) {
        const bool has_next = S.next(ui + 1, nxt);
        const char* nA = has_next ? (const char*)g.A + (size_t)nxt.pm * tstep : cA; const char* nB = has_next ? (const char*)g.Bt + (size_t)nxt.pn * tstep : cB;
        for (int t = 0; t < nt; t += 2) {
            const bool last = (t == nt - 2);
            const char* a1 = cA + (size_t)(t + 1) * kstep;
            const char* a2 = last ? nA : cA + (size_t)(t + 2) * kstep; const char* b2 = last ? nB : cB + (size_t)(t + 2) * kstep;
            const char* a3 = a2 + kstep; const char* b3 = b2 + kstep;
            if (last && has_next) S.a_ready(nxt);
            if constexpr (SP2) {
            PG8_LDB(B0, 0, 0); PG8_LDB(B1, 0, 1); PG8_SCHED; PG8_LDA(At, 0, 0); PG8_STAGE(PG8_SA(1, 1), a1 + hstep, voffA);
            PG8_WAIT_V(8); PG8_WAIT_L(0); PG8_BAR; PG8_MMA(0, 0, At, B0); PG8_MMA(0, 1, At, B1); PG8_BAR; PG8_SCHED;
            PG8_LDA(At, 0, 1); PG8_STAGE(PG8_SB(0, 0), b2, voffB); PG8_STAGE(PG8_SB(0, 1), b2 + hstep, voffB); PG8_STAGE(PG8_SA(0, 0), a2, voffA);
            PG8_WAIT_V(8); PG8_WAIT_L(0); PG8_BAR; PG8_MMA(1, 0, At, B0); PG8_MMA(1, 1, At, B1); PG8_BAR; PG8_SCHED;
            PG8_LDB(B0, 1, 0); PG8_LDB(B1, 1, 1); PG8_SCHED; PG8_LDA(At, 1, 0); PG8_STAGE(PG8_SA(0, 1), a2 + hstep, voffA);
            PG8_WAIT_V(8); PG8_WAIT_L(0); PG8_BAR; PG8_MMA(0, 0, At, B0); PG8_MMA(0, 1, At, B1); PG8_BAR; PG8_SCHED;
            PG8_LDA(At, 1, 1); PG8_STAGE(PG8_SB(1, 0), b3, voffB); PG8_STAGE(PG8_SB(1, 1), b3 + hstep, voffB); PG8_STAGE(PG8_SA(1, 0), a3, voffA);
            PG8_WAIT_V(8); PG8_WAIT_L(0); PG8_BAR; PG8_MMA(1, 0, At, B0); PG8_MMA(1, 1, At, B1); PG8_BAR; PG8_SCHED;
            } else {
            PG8_LDB(B0, 0, 0); PG8_SCHED; PG8_LDA(At, 0, 0); PG8_STAGE(PG8_SA(1, 1), a1 + hstep, voffA);
            PG8_WAIT_L(8); PG8_BAR; PG8_WAIT_L(0); PG8_MMA(0, 0, At, B0); PG8_BAR; PG8_SCHED;
            PG8_LDB(B1, 0, 1); PG8_STAGE(PG8_SB(0, 0), b2, voffB);
            PG8_BAR; PG8_WAIT_L(0); PG8_MMA(0, 1, At, B1); PG8_BAR;
            PG8_LDA(At, 0, 1); PG8_STAGE(PG8_SA(0, 0), a2, voffA);
            PG8_BAR; PG8_WAIT_L(0); PG8_MMA(1, 0, At, B0); PG8_BAR; PG8_SCHED;
            PG8_STAGE(PG8_SB(0, 1), b2 + hstep, voffB);
            PG8_WAIT_V(6); PG8_BAR; PG8_MMA(1, 1, At, B1); PG8_BAR;
            PG8_LDB(B0, 1, 0); PG8_SCHED; PG8_LDA(At, 1, 0); PG8_STAGE(PG8_SA(0, 1), a2 + hstep, voffA);
            PG8_WAIT_L(8); PG8_BAR; PG8_WAIT_L(0); PG8_MMA(0, 0, At, B0); PG8_BAR; PG8_SCHED;
            PG8_LDB(B1, 1, 1); PG8_STAGE(PG8_SB(1, 0), b3, voffB);
            PG8_BAR; PG8_WAIT_L(0); PG8_MMA(0, 1, At, B1); PG8_BAR;
            PG8_LDA(At, 1, 1); PG8_STAGE(PG8_SA(1, 0), a3, voffA);
            PG8_BAR; PG8_WAIT_L(0); PG8_MMA(1, 0, At, B0); PG8_BAR; PG8_SCHED;
            PG8_STAGE(PG8_SB(1, 1), b3 + hstep, voffB);
            PG8_WAIT_V(6); PG8_BAR; PG8_MMA(1, 1, At, B1); PG8_BAR;
            }
        }
        if constexpr (ALIGN_EPI) { if (wr == 0) PG8_BAR; }
        if constexpr (!Epi::AFTER_DRAIN) { E(acc, cur, wr, wc, fr, fq); S.done(cur); }
        if (!has_next) break;
#pragma unroll
        for (int a = 0; a < 2; ++a)
#pragma unroll
            for (int b = 0; b < 2; ++b)
#pragma unroll
                for (int m = 0; m < 4; ++m)
#pragma unroll
                    for (int n = 0; n < 2; ++n) acc[a][b][m][n] = (f32x4){0.f, 0.f, 0.f, 0.f};
        cur = nxt; cA = nA; cB = nB; ++ui;
        if constexpr (ALIGN_EPI) { if (wr == 1) PG8_BAR; }
    }
    PG8_WAIT_V(0);
    if constexpr (!ALIGN_EPI) { if (wr == 0) PG8_BAR; }
    PG8_BAR;
    if constexpr (Epi::AFTER_DRAIN) { E.fused(acc, cur, wr, wc, fr, fq, lds, wid, lane); S.done(cur); }
#undef PG8_SA
#undef PG8_SB
#undef PG8_STAGE
#undef PG8_LDA
#undef PG8_LDB
#undef PG8_MMA
#undef PG8_WAIT_V
#undef PG8_WAIT_L
#undef PG8_BAR
#undef PG8_SCHED
}
}
#define MK_ONE_LAUNCH 1

constexpr int NB = 4, SEQ = 8192, T = NB * SEQ, D = 1024;
constexpr int NIN = 3584, DH = 512, HD = 128, NHH = 4, CHK = 64;
constexpr int NSEG = 16, SEGC = 8;
constexpr int CW = 31, CPAD = 15, DC = 512;
constexpr int PHEADS = 8, NQK = 2048, NSEL = 128;
constexpr float EPS = 1e-6f;
constexpr int NWAVES = 8, NTHR = 512;

constexpr size_t MiB = 1u << 20;
constexpr size_t WS_CTL = 0, CTL_ZERO_BYTES = 65536;
constexpr size_t WS_MOD = 1 * MiB, WS_FMOD = WS_MOD + 131072, WS_LB = WS_MOD + 196608, WS_BIASQ = WS_MOD + 262144;
constexpr size_t WS_WIN = 2 * MiB, WS_WOUT = 10 * MiB, WS_WQK = 12 * MiB;
constexpr size_t WS_UT = 16 * MiB, WS_VT = 48 * MiB;
constexpr size_t WS_BUFA = 80 * MiB;
constexpr size_t WS_BUFB = 144 * MiB;
constexpr size_t WS_SEG = 208 * MiB;
constexpr size_t WS_E = 208 * MiB, WS_W = 224 * MiB;
constexpr size_t WS_BIG = 240 * MiB;
constexpr size_t WS_SSQ = 496 * MiB;
constexpr size_t WS_SEGA = 498 * MiB;
constexpr size_t WS_RSTD = 499 * MiB;
constexpr size_t WS_END = 500 * MiB;
constexpr size_t WS_PACT = 240 * MiB;
constexpr size_t WS_Y = 368 * MiB;
constexpr int NSL = 8, CSL = 128;
constexpr float USCALE = 64.0f, VSCALE = 16.0f;
constexpr int CW_QU = 8192, CW_QV = 8192 + 64 * 16;
constexpr int CW_BAR = 1024;

#ifndef LDSFILL
#define LDSFILL 0u
#endif
constexpr int LDS_BYTES = 155648;
constexpr int MISC_OFF = LDS_BYTES - 256;

#define GAS __attribute__((address_space(1)))
#define LAS __attribute__((address_space(3)))
typedef unsigned short bf16;
typedef unsigned v4u __attribute__((ext_vector_type(4)));
typedef unsigned v2u __attribute__((ext_vector_type(2)));
typedef float f32x4 __attribute__((ext_vector_type(4)));
typedef float f32x16 __attribute__((ext_vector_type(16)));
typedef short bf16x8 __attribute__((ext_vector_type(8)));
typedef float f32x2_ __attribute__((ext_vector_type(2)));

__device__ __forceinline__ float bf2f(unsigned h) { return __builtin_bit_cast(float, h << 16); }
__device__ __forceinline__ float bflo(unsigned u) { return __builtin_bit_cast(float, u << 16); }
__device__ __forceinline__ float bfhi(unsigned u) { return __builtin_bit_cast(float, u & 0xffff0000u); }
__device__ __forceinline__ unsigned f2bf(float f) { unsigned u = __builtin_bit_cast(unsigned, f); return (u + 0x7fffu + ((u >> 16) & 1u)) >> 16; }
__device__ __forceinline__ unsigned pk2(float lo, float hi) { return f2bf(lo) | (f2bf(hi) << 16); }
__device__ __forceinline__ unsigned cvtpk(float lo, float hi) { unsigned r; asm("v_cvt_pk_bf16_f32 %0, %1, %2" : "=v"(r) : "v"(lo), "v"(hi)); return r; }
__device__ __forceinline__ float sigmoidf_(float x) { return __builtin_amdgcn_rcpf(1.0f + __expf(-x)); }
#define DPP_ADD(s, ctrl) ((s) + __builtin_bit_cast(float, __builtin_amdgcn_update_dpp(0, __builtin_bit_cast(int, (s)), (ctrl), 0xF, 0xF, false)))
__device__ __forceinline__ float wave_sum(float v) {
#pragma unroll
    for (int o = 1; o < 64; o <<= 1) v += __shfl_xor(v, o);
    return v;
}

#define XB_TMO      128
#define XB_XCNT(j)  (256  + 64 * (j))
#define XB_XSUB(j)  (1280 + 64 * (j))
#define XB_XGEN(j)  (2304 + 64 * (j))
#define XB_TOP      3328
#define XB_TOPGEN   3392
#define XCD_BAR_WORDS 3456
#define XB_SPIN_CAP (1u << 18)
__device__ __forceinline__ unsigned xb_ld(unsigned* p)              { return __hip_atomic_load(p, __ATOMIC_RELAXED, __HIP_MEMORY_SCOPE_AGENT); }
__device__ __forceinline__ unsigned xb_add(unsigned* p, unsigned v) { return __hip_atomic_fetch_add(p, v, __ATOMIC_RELAXED, __HIP_MEMORY_SCOPE_AGENT); }
__device__ __forceinline__ unsigned xb_xcc_id() { return (unsigned)__builtin_amdgcn_s_getreg((3 << 11) | 20) & 0xFu; }
#define XB_SPIN(cond, bar) do { unsigned _sp = 0; while (cond) { __builtin_amdgcn_s_sleep(1); \
    if ((++_sp & 255u) == 0u) { if (xb_ld(&(bar)[XB_TMO])) break; if (_sp > XB_SPIN_CAP) { atomicAdd(&(bar)[XB_TMO], 1u); break; } } } } while (0)
struct XcdBarrier { unsigned* bar; unsigned x; volatile LAS unsigned* st; };
__device__ __forceinline__ XcdBarrier xcd_barrier_post(unsigned* bar, volatile LAS unsigned* st) {
    XcdBarrier b; b.bar = bar; b.x = xb_xcc_id(); b.st = st;
    if (threadIdx.x == 0) (void)xb_add(&bar[XB_XCNT(b.x)], 1u);
    return b;
}
__device__ __forceinline__ void xcd_barrier_complete(unsigned* bar, unsigned x, unsigned& nloc, unsigned& nx) {
    const unsigned G = gridDim.x * gridDim.y * gridDim.z;
    unsigned sum, cnt, mine, sp = 0u;
    for (;;) {
        sum = 0u; cnt = 0u; mine = 0u;
#pragma unroll
        for (unsigned j = 0; j < 16; ++j) { const unsigned c = xb_ld(&bar[XB_XCNT(j)]); sum += c; cnt += (c > 0u) ? 1u : 0u; mine = (j == x) ? c : mine; }
        if (sum == G) break;
        __builtin_amdgcn_s_sleep(1);
        if ((++sp & 255u) == 0u) { if (xb_ld(&bar[XB_TMO])) break; if (sp > XB_SPIN_CAP) { atomicAdd(&bar[XB_TMO], 1u); break; } }
    }
    nloc = mine > 0u ? mine : 1u; nx = cnt > 0u ? cnt : 1u;
}
__device__ __forceinline__ void xcd_barrier(const XcdBarrier& b) {
    asm volatile("s_waitcnt vmcnt(0)" ::: "memory");
    __syncthreads();
    if (threadIdx.x == 0) {
        unsigned* bar = b.bar;
        __builtin_amdgcn_s_waitcnt(0);
        unsigned nloc = b.st[0], nx = b.st[1];
        if (nloc == 0u) { xcd_barrier_complete(bar, b.x, nloc, nx); b.st[0] = nloc; b.st[1] = nx; }
        const unsigned old = xb_add(&bar[XB_XSUB(b.x)], 1u);
        const unsigned gen = old / nloc;
        if (old + 1u == (gen + 1u) * nloc) {
            __builtin_amdgcn_fence(__ATOMIC_RELEASE, "agent");
            asm volatile("s_waitcnt vmcnt(0)" ::: "memory");
            const unsigned og = xb_add(&bar[XB_TOP], 1u);
            const unsigned tg = og / nx;
            if (og + 1u == (tg + 1u) * nx) xb_add(&bar[XB_TOPGEN], 1u);
            else XB_SPIN(xb_ld(&bar[XB_TOPGEN]) == tg, bar);
            __builtin_amdgcn_fence(__ATOMIC_ACQUIRE, "agent");
            xb_add(&bar[XB_XGEN(b.x)], 1u);
            asm volatile("s_waitcnt vmcnt(0)" ::: "memory");
        } else {
            XB_SPIN(xb_ld(&bar[XB_XGEN(b.x)]) == gen, bar);
            __builtin_amdgcn_fence(__ATOMIC_ACQUIRE, "agent");
            asm volatile("s_waitcnt vmcnt(0)" ::: "memory");
        }
    }
    __syncthreads();
}

struct Args { const float* in[23]; float* out; unsigned char* ws; int ph_lo, ph_hi; };
struct Frame {
    LAS unsigned char* lds;
    int tid, lane, wave, G, bid;
    const Args* a;
    __device__ __forceinline__ const float* x() const { return a->in[0]; }
    __device__ __forceinline__ const float* c() const { return a->in[1]; }
    __device__ __forceinline__ const float* ada_w() const { return a->in[2]; }
    __device__ __forceinline__ const float* ada_b() const { return a->in[3]; }
    __device__ __forceinline__ const float* g_mix() const { return a->in[4]; }
    __device__ __forceinline__ const float* w_in() const { return a->in[5]; }
    __device__ __forceinline__ const float* lbg_f() const { return a->in[6]; }
    __device__ __forceinline__ const float* lbg_b() const { return a->in[7]; }
    __device__ __forceinline__ const float* hnorm_g() const { return a->in[8]; }
    __device__ __forceinline__ const float* conv_w() const { return a->in[9]; }
    __device__ __forceinline__ const float* conv_b() const { return a->in[10]; }
    __device__ __forceinline__ const float* cln_g() const { return a->in[11]; }
    __device__ __forceinline__ const float* cln_b() const { return a->in[12]; }
    __device__ __forceinline__ const float* w_out() const { return a->in[13]; }
    __device__ __forceinline__ const float* g_ffn() const { return a->in[14]; }
    __device__ __forceinline__ const float* wq() const { return a->in[15]; }
    __device__ __forceinline__ const float* keys1() const { return a->in[16]; }
    __device__ __forceinline__ const float* keys2() const { return a->in[17]; }
    __device__ __forceinline__ const float* utab() const { return a->in[18]; }
    __device__ __forceinline__ const float* vtab() const { return a->in[19]; }
    __device__ __forceinline__ const float* fada_w() const { return a->in[20]; }
    __device__ __forceinline__ const float* fada_b() const { return a->in[21]; }
    __device__ __forceinline__ const float* fnorm_g() const { return a->in[22]; }
    __device__ __forceinline__ float* out() const { return a->out; }
    __device__ __forceinline__ float* mod() const { return (float*)(a->ws + WS_MOD); }
    __device__ __forceinline__ float* fmod() const { return (float*)(a->ws + WS_FMOD); }
    __device__ __forceinline__ float* lb() const { return (float*)(a->ws + WS_LB); }
    __device__ __forceinline__ float* biasq() const { return (float*)(a->ws + WS_BIASQ); }
    __device__ __forceinline__ float* ssqp() const { return (float*)(a->ws + WS_SSQ); }
    __device__ __forceinline__ float* sega() const { return (float*)(a->ws + WS_SEGA); }
    __device__ __forceinline__ float* segu() const { return (float*)(a->ws + WS_SEG); }
    __device__ __forceinline__ float* of() const { return (float*)(a->ws + WS_BUFB); }
    __device__ __forceinline__ float* scores() const { return (float*)(a->ws + WS_BIG); }
    __device__ __forceinline__ float* wsel() const { return (float*)(a->ws + WS_W); }
    __device__ __forceinline__ int* esel() const { return (int*)(a->ws + WS_E); }
    __device__ __forceinline__ bf16* Win_t() const { return (bf16*)(a->ws + WS_WIN); }
    __device__ __forceinline__ bf16* Wout_t() const { return (bf16*)(a->ws + WS_WOUT); }
    __device__ __forceinline__ bf16* Wqk_t() const { return (bf16*)(a->ws + WS_WQK); }
    __device__ __forceinline__ bf16* Ub() const { return (bf16*)(a->ws + WS_UT); }
    __device__ __forceinline__ bf16* Vb() const { return (bf16*)(a->ws + WS_VT); }
    __device__ __forceinline__ bf16* bufA() const { return (bf16*)(a->ws + WS_BUFA); }
    __device__ __forceinline__ bf16* hg() const { return (bf16*)(a->ws + WS_BUFB); }
    __device__ __forceinline__ bf16* proj() const { return (bf16*)(a->ws + WS_BIG); }
    __device__ __forceinline__ float* coef() const { return (float*)(a->ws + WS_BUFA); }
    __device__ __forceinline__ float* rstd() const { return (float*)(a->ws + WS_RSTD); }
    __device__ __forceinline__ float* pact() const { return (float*)(a->ws + WS_PACT); }
    __device__ __forceinline__ float* ybuf() const { return (float*)(a->ws + WS_Y); }
    __device__ __forceinline__ unsigned char* U8() const { return (unsigned char*)(a->ws + WS_UT); }
    __device__ __forceinline__ unsigned char* V8() const { return (unsigned char*)(a->ws + WS_VT); }
    __device__ __forceinline__ unsigned* ctl() const { return (unsigned*)(a->ws + WS_CTL); }
};

__device__ __forceinline__ void p0_gemv(Frame& F) {
    LAS float* cact = (LAS float*)(F.lds);
    LAS float* red = (LAS float*)(F.lds + 16384);
    for (int i = F.tid; i < 4096; i += NTHR) { const float c = F.c()[i]; cact[i] = c * sigmoidf_(c); }
    __syncthreads();
    for (int item = F.bid; item < 128; item += F.G) {
        const int col0 = item * 64; const float* W; int N, cc;
        if (col0 < 6144) { W = F.ada_w(); N = 6144; cc = col0; } else { W = F.fada_w(); N = 2048; cc = col0 - 6144; }
        const float* wp = W + (size_t)(F.wave * 128) * N + cc + F.lane;
        float a0 = 0.f, a1 = 0.f, a2 = 0.f, a3 = 0.f;
#pragma unroll 32
        for (int k = 0; k < 128; ++k) { const float w = wp[(size_t)k * N]; const int kk = F.wave * 128 + k;
            a0 += cact[kk] * w; a1 += cact[1024 + kk] * w; a2 += cact[2048 + kk] * w; a3 += cact[3072 + kk] * w; }
        red[(F.wave * 4 + 0) * 64 + F.lane] = a0; red[(F.wave * 4 + 1) * 64 + F.lane] = a1; red[(F.wave * 4 + 2) * 64 + F.lane] = a2; red[(F.wave * 4 + 3) * 64 + F.lane] = a3;
        __syncthreads();
        if (F.tid < 256) { const int b = F.tid >> 6, l = F.tid & 63; float s = 0.f;
#pragma unroll
            for (int w = 0; w < 8; ++w) s += red[(w * 4 + b) * 64 + l];
            if (col0 < 6144) F.mod()[b * 6144 + cc + l] = s + F.ada_b()[cc + l]; else F.fmod()[b * 2048 + cc + l] = s + F.fada_b()[cc + l]; }
        __syncthreads();
    }
}
__device__ __forceinline__ void p0_transpose_item(const float* W, int K, int N, bf16* WT, LAS float* scr, int item, int lane) {
    const int nblk = N / 32, kb = item / nblk, nb = item % nblk, k0 = 64 * kb, n0 = 32 * nb;
#pragma unroll 8
    for (int i = 0; i < 32; ++i) { const int kk = 2 * i + (lane >> 5); scr[kk * 33 + (lane & 31)] = W[(size_t)(k0 + kk) * N + n0 + (lane & 31)]; }
    asm volatile("s_waitcnt lgkmcnt(0)" ::: "memory");
    const int c = lane & 7;
#pragma unroll
    for (int j = 0; j < 4; ++j) { const int n = (lane >> 3) + 8 * j; const LAS float* s = scr + (8 * c) * 33 + n;
        v4u o; o.x = pk2(s[0 * 33], s[1 * 33]); o.y = pk2(s[2 * 33], s[3 * 33]); o.z = pk2(s[4 * 33], s[5 * 33]); o.w = pk2(s[6 * 33], s[7 * 33]);
        *(v4u*)(WT + (size_t)(n0 + n) * K + k0 + 8 * c) = o; }
    asm volatile("s_waitcnt lgkmcnt(0)" ::: "memory");
}
__device__ __forceinline__ void p0_wqk_item(Frame& F, int item) {
    const int jq = item & 7, kb = (item >> 3) & 15, hh = item >> 7, h = hh >> 1, half = hh & 1;
    const float* keys = (half ? F.keys2() : F.keys1()) + (size_t)(jq * 16) * 128;
    const int k = kb * 64 + F.lane;
    const float* wrow = F.wq() + (size_t)k * 2048 + h * 256 + half * 128;
    float acc[16];
#pragma unroll
    for (int j = 0; j < 16; ++j) acc[j] = 0.f;
#pragma unroll 4
    for (int d = 0; d < 128; d += 4) {
        const f32x4 a = *(const f32x4*)(wrow + d);
#pragma unroll
        for (int j = 0; j < 16; ++j) { const float* kp = keys + j * 128 + d; acc[j] += a[0] * kp[0] + a[1] * kp[1] + a[2] * kp[2] + a[3] * kp[3]; }
    }
    bf16* o = F.Wqk_t() + (size_t)(h * 256 + half * 128 + jq * 16) * 1024 + k;
#pragma unroll
    for (int j = 0; j < 16; ++j) o[(size_t)j * 1024] = (bf16)f2bf(acc[j]);
}
__device__ __forceinline__ void p0_prologue(Frame& F) {
    if (F.bid < 128) p0_gemv(F);
    if (F.bid == 128 % F.G) { const int i = F.tid;
        F.lb()[i] = __builtin_amdgcn_rcpf(1.0f + __expf(F.lbg_f()[512 + i] - F.lbg_f()[i]));
        F.lb()[512 + i] = __builtin_amdgcn_rcpf(1.0f + __expf(F.lbg_b()[512 + i] - F.lbg_b()[i])); }
    LAS float* scr = (LAS float*)(F.lds + 32768 + F.wave * 8704);
    const int gw = F.wave * F.G + F.bid, NGW = F.G * NWAVES;
    constexpr int I_QK = 2048, I_IN = (D / 64) * (NIN / 32), I_OUT = (D / 64) * (D / 32), I_TAB = 2 * 16384 / 4;
    constexpr int NITEMS = I_QK + I_IN + I_OUT + I_TAB;
    for (int it = gw; it < NITEMS; it += NGW) {
        int r = it;
        if (r < I_QK) { p0_wqk_item(F, r); continue; } r -= I_QK;
        if (r < I_IN) { p0_transpose_item(F.w_in(), D, NIN, F.Win_t(), scr, r, F.lane); continue; } r -= I_IN;
        if (r < I_OUT) { p0_transpose_item(F.w_out(), D, D, F.Wout_t(), scr, r, F.lane); continue; } r -= I_OUT;
        { const int tab = r >= 4096, rr = (tab ? r - 4096 : r) * 4; const float* src = (tab ? F.vtab() : F.utab()) + (size_t)rr * 1024; unsigned char* dst = tab ? F.V8() : F.U8();
          const float sc = tab ? VSCALE : USCALE;
#pragma unroll
          for (int q = 0; q < 16; ++q) { const int row = rr + (q >> 2), qq = q & 3; const f32x4 v = *(const f32x4*)(src + (q >> 2) * 1024 + qq * 256 + 4 * F.lane) * sc;
              int pk = __builtin_amdgcn_cvt_pk_fp8_f32(v[0], v[1], 0, false); pk = __builtin_amdgcn_cvt_pk_fp8_f32(v[2], v[3], pk, true);
              const int sl = 2 * qq + (F.lane >> 5);
              *(int*)(dst + ((size_t)sl * 16384 + row) * CSL + 4 * (F.lane & 31)) = pk; } }
    }
}

__device__ __forceinline__ void p1_norm(Frame& F) {
    const int gwc = F.bid * NWAVES + F.wave, NGW = F.G * NWAVES;
    for (int row0 = gwc * 16; row0 < T; row0 += NGW * 16) {
        const int b = row0 >> 13; const float* mb = F.mod() + b * 6144;
        f32x4 ca[4], cb[4];
#pragma unroll
        for (int j = 0; j < 4; ++j) { const int k = 256 * j + 4 * F.lane; const f32x4 g = *(const f32x4*)(F.g_mix() + k), s = *(const f32x4*)(mb + 1024 + k); ca[j] = g * (s + 1.0f); cb[j] = *(const f32x4*)(mb + k); }
#pragma unroll 4
        for (int r = 0; r < 16; ++r) { const float* xr = F.x() + (size_t)(row0 + r) * D;
            f32x4 v[4]; float ss = 0.f;
#pragma unroll
            for (int j = 0; j < 4; ++j) { v[j] = *(const f32x4*)(xr + 256 * j + 4 * F.lane); ss += v[j][0] * v[j][0] + v[j][1] * v[j][1] + v[j][2] * v[j][2] + v[j][3] * v[j][3]; }
            const float rstd = __builtin_amdgcn_rsqf(wave_sum(ss) * (1.0f / D) + EPS);
            bf16* o = F.bufA() + (size_t)(row0 + r) * D;
#pragma unroll
            for (int j = 0; j < 4; ++j) { const f32x4 y = v[j] * rstd * ca[j] + cb[j]; v2u w; w.x = pk2(y[0], y[1]); w.y = pk2(y[2], y[3]); *(v2u*)(o + 256 * j + 4 * F.lane) = w; } }
    }
    const int gw = F.wave * F.G + F.bid;
    for (int n0 = gw * 32; n0 < NQK; n0 += NGW * 32) {
        float sv[4][16];
#pragma unroll
        for (int b = 0; b < 4; ++b) { const float* sh2 = F.mod() + b * 6144 + 3072;
#pragma unroll
            for (int i = 0; i < 8; ++i) { sv[b][i] = sh2[8 * F.lane + i]; sv[b][8 + i] = sh2[512 + 8 * F.lane + i]; } }
        float res[4] = {0.f, 0.f, 0.f, 0.f};
        for (int q = 0; q < 32; ++q) { const int n = n0 + q;
            const v4u w0 = *(const v4u*)(F.Wqk_t() + (size_t)n * 1024 + 8 * F.lane), w1 = *(const v4u*)(F.Wqk_t() + (size_t)n * 1024 + 512 + 8 * F.lane);
            float wv[16];
#pragma unroll
            for (int i = 0; i < 4; ++i) { wv[2 * i] = bflo(w0[i]); wv[2 * i + 1] = bfhi(w0[i]); wv[8 + 2 * i] = bflo(w1[i]); wv[8 + 2 * i + 1] = bfhi(w1[i]); }
#pragma unroll
            for (int b = 0; b < 4; ++b) { float sm = 0.f;
#pragma unroll
                for (int i = 0; i < 16; ++i) sm += wv[i] * sv[b][i];
                sm = wave_sum(sm); if (F.lane == q) res[b] = sm; } }
        if (F.lane < 32) {
#pragma unroll
            for (int b = 0; b < 4; ++b) F.biasq()[b * 2048 + n0 + F.lane] = res[b]; }
    }
}

__device__ __forceinline__ void conv_item(Frame& F, int item, const float (&cw)[CW], float cbias) {
    LAS bf16* hbuf = (LAS bf16*)(F.lds);
    LAS float* ybuf = (LAS float*)(F.lds + 65536);
    const int tok0 = item * 32, b = tok0 >> 13, t0 = tok0 & (SEQ - 1), c = F.tid;
#pragma unroll
    for (int k = 0; k < 8; ++k) { const int pi = F.tid + NTHR * k; if (pi < 62 * 64) { const int r = pi >> 6, ch = pi & 63, t = t0 - CPAD + r; v4u o = {0u, 0u, 0u, 0u};
            if (t >= 0 && t < SEQ) { const bf16* pr = F.proj() + (size_t)(b * SEQ + t) * NIN + 8 * ch; const v4u a = *(const v4u*)(pr + 2560), g = *(const v4u*)(pr + 3072);
#pragma unroll
                for (int i = 0; i < 4; ++i) o[i] = cvtpk(bflo(a[i]) * bflo(g[i]), bfhi(a[i]) * bfhi(g[i])); }
            *(LAS v4u*)(hbuf + r * 512 + 8 * ch) = o; } }
    __syncthreads();
    float hv[62];
#pragma unroll
    for (int r = 0; r < 62; ++r) hv[r] = bf2f(hbuf[r * 512 + c]);
#pragma unroll
    for (int tt = 0; tt < 32; ++tt) { float acc = cbias;
#pragma unroll
        for (int j = 0; j < CW; ++j) acc += cw[j] * hv[tt + j];
        ybuf[tt * 512 + c] = acc; }
    __syncthreads();
#pragma unroll
    for (int q = 0; q < 4; ++q) { const int tt = F.wave * 4 + q;
        const f32x4 y0 = *(LAS const f32x4*)(ybuf + tt * 512 + 8 * F.lane), y1 = *(LAS const f32x4*)(ybuf + tt * 512 + 8 * F.lane + 4);
        const float mean = wave_sum((y0[0] + y0[1] + y0[2] + y0[3]) + (y1[0] + y1[1] + y1[2] + y1[3])) * (1.0f / DC);
        const f32x4 d0 = y0 - mean, d1 = y1 - mean;
        const float var = wave_sum((d0[0] * d0[0] + d0[1] * d0[1] + d0[2] * d0[2] + d0[3] * d0[3]) + (d1[0] * d1[0] + d1[1] * d1[1] + d1[2] * d1[2] + d1[3] * d1[3])) * (1.0f / DC);
        const float rstd = __builtin_amdgcn_rsqf(var + EPS);
        const f32x4 g0 = *(const f32x4*)(F.cln_g() + 8 * F.lane), g1 = *(const f32x4*)(F.cln_g() + 8 * F.lane + 4), b0 = *(const f32x4*)(F.cln_b() + 8 * F.lane), b1 = *(const f32x4*)(F.cln_b() + 8 * F.lane + 4);
        f32x4 z0 = d0 * rstd * g0 + b0, z1 = d1 * rstd * g1 + b1;
#pragma unroll
        for (int i = 0; i < 4; ++i) { z0[i] = z0[i] * sigmoidf_(z0[i]); z1[i] = z1[i] * sigmoidf_(z1[i]); }
        v4u w; w.x = cvtpk(z0[0], z0[1]); w.y = cvtpk(z0[2], z0[3]); w.z = cvtpk(z1[0], z1[1]); w.w = cvtpk(z1[2], z1[3]);
        *(v4u*)(F.bufA() + (size_t)(tok0 + tt) * D + 512 + 8 * F.lane) = w; }
    __syncthreads();
}

constexpr int PQ = 272, PT = 144;
constexpr int HL_QR = 0, HL_KR = 17408, HL_QE = 34816, HL_KET = 52224, HL_VT = 70656, HL_SCM = 89088, HL_ST = 98304, HL_PBLK = 133120  , HL_AV = 137216, HL_RS = 137728;
static_assert(HL_PBLK + 8 * 128 * 4 <= HL_AV && HL_AV + 512 <= HL_RS && HL_RS + 1024 <= 155648 - 256, "HGRN LDS map");
__device__ __forceinline__ bf16x8 ldf(LAS const unsigned char* base, int row, int pitch, int kbyte) { return *(LAS const bf16x8*)(base + row * pitch + kbyte); }
#define MFMA32(a, b, c) __builtin_amdgcn_mfma_f32_32x32x16_bf16((a), (b), (c), 0, 0, 0)

template <bool FULL>
__device__ __forceinline__ void hgrn_load(Frame& F, int b, int h, int dir, int chunk, unsigned (&rz)[8], unsigned (&rv)[8], unsigned (&rq)[8]) {
    const size_t tokbase = (size_t)b * SEQ + (size_t)chunk * CHK; const int zoff = dir ? 1024 : 512, c0 = 2 * F.lane;
#pragma unroll
    for (int i = 0; i < 8; ++i) { const int p = 8 * F.wave + i, tr = dir ? (63 - p) : p; const bf16* q = F.proj() + (tokbase + tr) * NIN + h * HD;
        rz[i] = *(const unsigned*)(q + zoff + c0); rv[i] = *(const unsigned*)(q + 1536 + c0); if (FULL) rq[i] = *(const unsigned*)(q + c0); }
}
template <bool FULL, int MODE>
__device__ __forceinline__ void hgrn_chunk(Frame& F, int b, int h, int dir, int chunk, int nchunk, f32x16 (&accS)[2], float lb0, float lb1, unsigned (&rz)[8], unsigned (&rv)[8], unsigned (&rq)[8]) {
    LAS unsigned char* lds = F.lds;
    int r = F.lane & 31, hh = F.lane >> 5, c0 = 2 * F.lane;
    asm volatile("" : "+v"(r), "+v"(hh), "+v"(c0));
    const int w = F.wave, rb = w;
    const size_t tokbase = (size_t)b * SEQ + (size_t)chunk * CHK;
    {
        float f0[8], f1[8], cf0[8], cf1[8], cr0[8], cr1[8];
        float run0 = 1.f, run1 = 1.f;
#pragma unroll
        for (int i = 0; i < 8; ++i) { f0[i] = 1.0f - (1.0f - lb0) * bflo(rz[i]); f1[i] = 1.0f - (1.0f - lb1) * bfhi(rz[i]); run0 *= f0[i]; run1 *= f1[i]; cf0[i] = run0; cf1[i] = run1; }
        { float q0 = 1.f, q1 = 1.f;
#pragma unroll
          for (int i = 7; i >= 0; --i) { cr0[i] = q0; cr1[i] = q1; q0 *= f0[i]; q1 *= f1[i]; } }
        LAS float* pblk = (LAS float*)(lds + HL_PBLK);
        { f32x2_ t; t[0] = run0; t[1] = run1; *(LAS f32x2_*)(pblk + rb * 128 + c0) = t; }
        __syncthreads();
        f32x2_ pre = {1.f, 1.f}, post = {1.f, 1.f}, mid = {1.f, 1.f};
#pragma unroll
        for (int q = 0; q < 8; ++q) { const f32x2_ bv = *(LAS const f32x2_*)(pblk + q * 128 + c0);
            if (q < rb) pre *= bv; if (q > rb) post *= bv;
            if (rb < 4 ? (q > rb && q < 4) : (q >= 4 && q < rb)) mid *= bv; }
        if (rb == 0) { f32x2_ t; t[0] = run0 * post[0]; t[1] = run1 * post[1]; *(LAS f32x2_*)((LAS float*)(lds + HL_AV) + c0) = t; }
        float ke0[8], ke1[8];
#pragma unroll
        for (int i = 0; i < 8; ++i) { const float k0 = 1.0f - f0[i], k1 = 1.0f - f1[i];
            ke0[i] = k0 * cr0[i] * post[0]; ke1[i] = k1 * cr1[i] * post[1];
            if (FULL) { const int p = 8 * rb + i; const float qs0 = bflo(rq[i]), qs1 = bfhi(rq[i]);
                const float G0 = (rb < 4 ? cr0[i] : cf0[i]) * mid[0], G1 = (rb < 4 ? cr1[i] : cf1[i]) * mid[1], iG0 = __builtin_amdgcn_rcpf(G0), iG1 = __builtin_amdgcn_rcpf(G1);
                *(LAS unsigned*)(lds + HL_QE + p * PQ + c0 * 2) = cvtpk(qs0 * pre[0] * cf0[i], qs1 * pre[1] * cf1[i]);
                *(LAS unsigned*)(lds + HL_QR + p * PQ + c0 * 2) = cvtpk(qs0 * (rb < 4 ? iG0 : G0), qs1 * (rb < 4 ? iG1 : G1));
                *(LAS unsigned*)(lds + HL_KR + p * PQ + c0 * 2) = cvtpk(k0 * (rb < 4 ? G0 : iG0), k1 * (rb < 4 ? G1 : iG1)); } }
        v4u ka, kb, va, vb2;
        ka.x = cvtpk(ke0[0], ke0[1]); ka.y = cvtpk(ke0[2], ke0[3]); ka.z = cvtpk(ke0[4], ke0[5]); ka.w = cvtpk(ke0[6], ke0[7]);
        kb.x = cvtpk(ke1[0], ke1[1]); kb.y = cvtpk(ke1[2], ke1[3]); kb.z = cvtpk(ke1[4], ke1[5]); kb.w = cvtpk(ke1[6], ke1[7]);
        va.x = (rv[0] & 0xffffu) | (rv[1] << 16); va.y = (rv[2] & 0xffffu) | (rv[3] << 16); va.z = (rv[4] & 0xffffu) | (rv[5] << 16); va.w = (rv[6] & 0xffffu) | (rv[7] << 16);
        vb2.x = (rv[0] >> 16) | (rv[1] & 0xffff0000u); vb2.y = (rv[2] >> 16) | (rv[3] & 0xffff0000u); vb2.z = (rv[4] >> 16) | (rv[5] & 0xffff0000u); vb2.w = (rv[6] >> 16) | (rv[7] & 0xffff0000u);
        *(LAS v4u*)(lds + HL_KET + c0 * PT + 16 * rb) = ka; *(LAS v4u*)(lds + HL_KET + (c0 + 1) * PT + 16 * rb) = kb;
        *(LAS v4u*)(lds + HL_VT + c0 * PT + 16 * rb) = va; *(LAS v4u*)(lds + HL_VT + (c0 + 1) * PT + 16 * rb) = vb2;
    }
    if (nchunk >= 0) hgrn_load<FULL>(F, b, h, dir, nchunk, rz, rv, rq);
    __syncthreads();
    const int pbO = w & 1, vb = w >> 1;
    f32x16 accO, accU[2];
#pragma unroll
    for (int i = 0; i < 16; ++i) { accO[i] = 0.f; accU[0][i] = 0.f; accU[1][i] = 0.f; }
    if (FULL) {
        if (w < 3) { const int pbS = (w + 1) >> 1, sbS = (w == 2) ? 1 : 0; f32x16 sc;
#pragma unroll
            for (int i = 0; i < 16; ++i) sc[i] = 0.f;
#pragma unroll
            for (int s = 0; s < 8; ++s) sc = MFMA32(ldf(lds + HL_QR, pbS * 32 + r, PQ, 32 * s + 16 * hh), ldf(lds + HL_KR, sbS * 32 + r, PQ, 32 * s + 16 * hh), sc);
#pragma unroll
            for (int i = 0; i < 16; i += 2) { const int p = pbS * 32 + (i & 3) + 8 * (i >> 2) + 4 * hh, s = sbS * 32 + r;
                const unsigned pkd = cvtpk(s <= p ? sc[i] : 0.f, s <= p + 1 ? sc[i + 1] : 0.f);
                *(LAS bf16*)(lds + HL_SCM + p * PT + s * 2) = (bf16)pkd; *(LAS bf16*)(lds + HL_SCM + (p + 1) * PT + s * 2) = (bf16)(pkd >> 16); } }
        __builtin_amdgcn_sched_barrier(0);
#pragma unroll
        for (int s = 0; s < 8; ++s) accO = MFMA32(ldf(lds + HL_QE, pbO * 32 + r, PQ, 32 * s + 16 * hh), ldf(lds + HL_ST, vb * 32 + r, PQ, 32 * s + 16 * hh), accO);
        __builtin_amdgcn_sched_barrier(0);
    }
#pragma unroll
    for (int i = 0; i < 2; ++i) { const int db = 2 * (w & 1) + i;
#pragma unroll
        for (int s = 0; s < 4; ++s) accU[i] = MFMA32(ldf(lds + HL_VT, vb * 32 + r, PT, 32 * s + 16 * hh), ldf(lds + HL_KET, db * 32 + r, PT, 32 * s + 16 * hh), accU[i]); }
    __builtin_amdgcn_sched_barrier(0);
    if (FULL) __syncthreads();
    if (FULL) {
        const unsigned v = vb * 32 + r;
        const unsigned lrow = (MODE == 0 ? (unsigned)hh : (unsigned)(1 - hh)) * 4u;
        const size_t rbase = (MODE == 0) ? (tokbase + pbO * 32) : (tokbase + 63 - pbO * 32 - 4);
        const unsigned lo_of = lrow * DH + v, lo_pr = lrow * NIN + v, lo_a2 = lrow * D + v;
        float ofv[16]; unsigned gv[16];
        if (MODE == 1) {
#pragma unroll
            for (int i = 0; i < 16; ++i) { const int ci = (i & 3) + 8 * (i >> 2); ofv[i] = (F.of() + (rbase - ci) * DH + h * HD)[lo_of]; } }
        for (int sb = 0; sb <= pbO; ++sb)
#pragma unroll
            for (int s2 = 0; s2 < 2; ++s2) accO = MFMA32(ldf(lds + HL_SCM, pbO * 32 + r, PT, 64 * sb + 32 * s2 + 16 * hh), ldf(lds + HL_VT, vb * 32 + r, PT, 64 * sb + 32 * s2 + 16 * hh), accO);
        if (MODE == 0) {
#pragma unroll
            for (int i = 0; i < 16; ++i) { const int ci = (i & 3) + 8 * (i >> 2); (F.of() + (rbase + ci) * DH + h * HD)[lo_of] = accO[i]; }
        } else {
            LAS float* rs = (LAS float*)(lds + HL_RS);
#pragma unroll
            for (int i = 0; i < 16; ++i) { const int ci = (i & 3) + 8 * (i >> 2); gv[i] = (F.proj() + (rbase - ci) * NIN + 2048 + h * HD)[lo_pr]; }
            float ov[16];
#pragma unroll
            for (int i = 0; i < 16; ++i) { const int ci = (i & 3) + 8 * (i >> 2), p = pbO * 32 + ci + 4 * hh;
                ov[i] = accO[i] + ofv[i]; float ss = ov[i] * ov[i];
                ss = DPP_ADD(ss, 0x128); ss = DPP_ADD(ss, 0x124); ss = DPP_ADD(ss, 0x122); ss = DPP_ADD(ss, 0x121); ss += __shfl_xor(ss, 16);
                if (r == 0) rs[p * 4 + vb] = ss; }
            __syncthreads();
            const float ng = F.hnorm_g()[h * HD + v];
#pragma unroll
            for (int i = 0; i < 16; ++i) { const int ci = (i & 3) + 8 * (i >> 2), p = pbO * 32 + ci + 4 * hh;
                const f32x4 q = *(LAS const f32x4*)(rs + p * 4);
                const float rstd = __builtin_amdgcn_rsqf((q[0] + q[1] + q[2] + q[3]) * (1.0f / HD) + EPS);
                const float g = bf2f(gv[i]);
                (F.bufA() + (rbase - ci) * D + h * HD)[lo_a2] = (bf16)cvtpk(ov[i] * rstd * ng * g, 0.f); }
        }
    }
    {
        const LAS float* av = (const LAS float*)(lds + HL_AV);
#pragma unroll
        for (int i = 0; i < 2; ++i) { const int db = 2 * (w & 1) + i; const float a = av[db * 32 + r];
#pragma unroll
            for (int j = 0; j < 16; j += 2) { const float s0 = accS[i][j] * a + accU[i][j], s1 = accS[i][j + 1] * a + accU[i][j + 1]; accS[i][j] = s0; accS[i][j + 1] = s1;
                if (FULL) { const int vv = vb * 32 + (j & 3) + 8 * (j >> 2) + 4 * hh; const unsigned pkd = cvtpk(s0, s1);
                    *(LAS bf16*)(lds + HL_ST + vv * PQ + (db * 32 + r) * 2) = (bf16)pkd; *(LAS bf16*)(lds + HL_ST + (vv + 1) * PQ + (db * 32 + r) * 2) = (bf16)(pkd >> 16); } } }
    }
    __syncthreads();
}
__device__ __forceinline__ void h1_item(Frame& F, int item) {
    const int seg = item & 15, dir = (item >> 4) & 1, h = (item >> 5) & 3, b = item >> 7;
    const float lb0 = F.lb()[dir * 512 + h * HD + 2 * F.lane], lb1 = F.lb()[dir * 512 + h * HD + 2 * F.lane + 1];
    f32x16 accS[2];
#pragma unroll
    for (int i = 0; i < 16; ++i) { accS[0][i] = 0.f; accS[1][i] = 0.f; }
    float atot = 1.f; const int col = F.tid & 127;
    unsigned rzA[8], rvA[8], rzB[8], rvB[8], rq[8];
#define H1CH(c) (seg * SEGC + (dir ? (SEGC - 1 - (c)) : (c)))
    hgrn_load<false>(F, b, h, dir, H1CH(0), rzA, rvA, rq); hgrn_load<false>(F, b, h, dir, H1CH(1), rzB, rvB, rq);
    for (int c = 0; c < SEGC; c += 2) {
        hgrn_chunk<false, 0>(F, b, h, dir, H1CH(c), (c + 2 < SEGC) ? H1CH(c + 2) : -1, accS, lb0, lb1, rzA, rvA, rq);
        atot *= ((const LAS float*)(F.lds + HL_AV))[col];
        hgrn_chunk<false, 0>(F, b, h, dir, H1CH(c + 1), (c + 3 < SEGC) ? H1CH(c + 3) : -1, accS, lb0, lb1, rzB, rvB, rq);
        atot *= ((const LAS float*)(F.lds + HL_AV))[col]; }
#undef H1CH
    if (F.tid < 128) F.sega()[(size_t)item * 128 + col] = atot;
    float* U = F.segu() + (size_t)item * 16384;
#pragma unroll
    for (int i = 0; i < 2; ++i)
#pragma unroll
        for (int j = 0; j < 16; j += 4) { f32x4 o; o[0] = accS[i][j]; o[1] = accS[i][j + 1]; o[2] = accS[i][j + 2]; o[3] = accS[i][j + 3]; ((f32x4*)(U + (i * 4 + (j >> 2)) * NTHR * 4))[F.tid] = o; }
}
__device__ __forceinline__ void h2_init_state(Frame& F, int b, int h, int dir, int seg, f32x16 (&accS)[2]) {
    const int w = F.wave, r = F.lane & 31, hh = F.lane >> 5, vb = w >> 1;
#pragma unroll
    for (int i = 0; i < 16; ++i) { accS[0][i] = 0.f; accS[1][i] = 0.f; }
    const int base = ((b * 4 + h) * 2 + dir) * 16;
    const int n = dir ? (NSEG - 1 - seg) : seg;
    for (int q = 0; q < n; ++q) { const int s = dir ? (NSEG - 1 - q) : q;
        const float* U = F.segu() + (size_t)(base + s) * 16384; const float* A = F.sega() + (size_t)(base + s) * 128;
#pragma unroll
        for (int i = 0; i < 2; ++i) { const int db = 2 * (w & 1) + i; const float a = (A + db * 32)[r];
#pragma unroll
            for (int j = 0; j < 16; j += 4) { const f32x4 u4 = ((const f32x4*)(U + (i * 4 + (j >> 2)) * NTHR * 4))[F.tid];
                accS[i][j] = accS[i][j] * a + u4[0]; accS[i][j + 1] = accS[i][j + 1] * a + u4[1]; accS[i][j + 2] = accS[i][j + 2] * a + u4[2]; accS[i][j + 3] = accS[i][j + 3] * a + u4[3]; } } }
#pragma unroll
    for (int i = 0; i < 2; ++i) { const int db = 2 * (w & 1) + i;
#pragma unroll
        for (int j = 0; j < 16; ++j) { const int vv = vb * 32 + (j & 3) + 8 * (j >> 2) + 4 * hh; *(LAS bf16*)(F.lds + HL_ST + vv * PQ + (db * 32 + r) * 2) = (bf16)f2bf(accS[i][j]); } }
    __syncthreads();
}
__device__ __forceinline__ void h2_item(Frame& F, int item) {
    const int seg = item & 15, h = (item >> 4) & 3, b = item >> 6;
    f32x16 accS[2];
    unsigned rzA[8], rvA[8], rqA[8], rzB[8], rvB[8], rqB[8];
    { const float lb0 = F.lb()[h * HD + 2 * F.lane], lb1 = F.lb()[h * HD + 2 * F.lane + 1];
      const int c0 = seg * SEGC;
      hgrn_load<true>(F, b, h, 0, c0, rzA, rvA, rqA); hgrn_load<true>(F, b, h, 0, c0 + 1, rzB, rvB, rqB);
      h2_init_state(F, b, h, 0, seg, accS);
      for (int c = 0; c < SEGC; c += 2) {
          hgrn_chunk<true, 0>(F, b, h, 0, c0 + c, (c + 2 < SEGC) ? (c0 + c + 2) : -1, accS, lb0, lb1, rzA, rvA, rqA);
          hgrn_chunk<true, 0>(F, b, h, 0, c0 + c + 1, (c + 3 < SEGC) ? (c0 + c + 3) : -1, accS, lb0, lb1, rzB, rvB, rqB); } }
    asm volatile("s_waitcnt vmcnt(0)" ::: "memory");
    __syncthreads();
    { const float lb0 = F.lb()[512 + h * HD + 2 * F.lane], lb1 = F.lb()[512 + h * HD + 2 * F.lane + 1];
      const int cl = seg * SEGC + SEGC - 1;
      hgrn_load<true>(F, b, h, 1, cl, rzA, rvA, rqA); hgrn_load<true>(F, b, h, 1, cl - 1, rzB, rvB, rqB);
      h2_init_state(F, b, h, 1, seg, accS);
      for (int c = 0; c < SEGC; c += 2) {
          hgrn_chunk<true, 1>(F, b, h, 1, cl - c, (c + 2 < SEGC) ? (cl - c - 2) : -1, accS, lb0, lb1, rzA, rvA, rqA);
          hgrn_chunk<true, 1>(F, b, h, 1, cl - c - 1, (c + 3 < SEGC) ? (cl - c - 3) : -1, accS, lb0, lb1, rzB, rvB, rqB); } }
}

__device__ __forceinline__ unsigned f2key(float f) { const unsigned u = __builtin_bit_cast(unsigned, f); return (u & 0x80000000u) ? ~u : (u | 0x80000000u); }
__device__ __forceinline__ float key2f(unsigned k) { const unsigned u = (k & 0x80000000u) ? (k & 0x7fffffffu) : ~k; return __builtin_bit_cast(float, u); }
__device__ __forceinline__ unsigned umax_(unsigned a, unsigned b) { return a > b ? a : b; }
__device__ __forceinline__ unsigned umin_(unsigned a, unsigned b) { return a < b ? a : b; }
__device__ __forceinline__ void sort16(unsigned (&a)[16]) {
#pragma unroll
    for (int k = 2; k <= 16; k <<= 1)
#pragma unroll
        for (int j = k >> 1; j > 0; j >>= 1)
#pragma unroll
            for (int i = 0; i < 16; ++i) { const int l = i ^ j; if (l > i) { const bool desc = ((i & k) == 0); const unsigned x = a[i], y = a[l], mx = umax_(x, y), mn = umin_(x, y); a[i] = desc ? mx : mn; a[l] = desc ? mn : mx; } }
}
__device__ __forceinline__ void merge16(unsigned (&a)[16], const unsigned (&b)[16]) {
#pragma unroll
    for (int i = 0; i < 16; ++i) a[i] = umax_(a[i], b[15 - i]);
#pragma unroll
    for (int j = 8; j > 0; j >>= 1)
#pragma unroll
        for (int i = 0; i < 16; ++i) { const int l = i ^ j; if (l > i) { const unsigned x = a[i], y = a[l]; a[i] = umax_(x, y); a[l] = umin_(x, y); } }
}
__device__ __forceinline__ unsigned dpp_swap1(unsigned v) { return (unsigned)__builtin_amdgcn_update_dpp(0, (int)v, 0xB1, 0xF, 0xF, false); }
__device__ __forceinline__ unsigned pick_byte(const unsigned (&pk)[4], unsigned a) {
    const unsigned wsel = a >> 2; unsigned v = wsel == 0 ? pk[0] : (wsel == 1 ? pk[1] : (wsel == 2 ? pk[2] : pk[3]));
    return (v >> ((a & 3u) * 8u)) & 0xffu;
}
__device__ __forceinline__ void topk_stage2(const unsigned (&top)[16], bool tab0, size_t item, int* esel, float* wsel) {
        float vO[16], vP[16]; unsigned iOpk[4] = {0u, 0u, 0u, 0u}, iPpk[4] = {0u, 0u, 0u, 0u};
#pragma unroll
        for (int i = 0; i < 16; ++i) { const unsigned t = top[i], tp = dpp_swap1(t);
            vO[i] = key2f(t & ~0x7fu); vP[i] = key2f(tp & ~0x7fu);
            iOpk[i >> 2] |= (127u - (t & 0x7fu)) << ((i & 3) * 8); iPpk[i >> 2] |= (127u - (tp & 0x7fu)) << ((i & 3) * 8); }
        unsigned R[16], G1[16], G2[16], G3[16];
#define CAND(a, b) ((f2key(vO[a] + vP[b]) & ~0xffu) | (unsigned)(((a) << 4) | (b)))
#pragma unroll
        for (int i = 0; i < 16; ++i) R[i] = CAND(0, i);
        G1[0] = CAND(1, 0); G1[1] = CAND(1, 1); G1[2] = CAND(1, 2); G1[3] = CAND(1, 3); G1[4] = CAND(1, 4); G1[5] = CAND(1, 5); G1[6] = CAND(1, 6); G1[7] = CAND(1, 7);
        G1[8] = CAND(2, 0); G1[9] = CAND(2, 1); G1[10] = CAND(2, 2); G1[11] = CAND(2, 3); G1[12] = CAND(2, 4); G1[13] = CAND(3, 0); G1[14] = CAND(3, 1); G1[15] = CAND(3, 2);
        G2[0] = CAND(3, 3); G2[1] = CAND(4, 0); G2[2] = CAND(4, 1); G2[3] = CAND(4, 2); G2[4] = CAND(5, 0); G2[5] = CAND(5, 1); G2[6] = CAND(6, 0); G2[7] = CAND(6, 1);
        G2[8] = CAND(7, 0); G2[9] = CAND(7, 1); G2[10] = CAND(8, 0); G2[11] = CAND(9, 0); G2[12] = CAND(10, 0); G2[13] = CAND(11, 0); G2[14] = CAND(12, 0); G2[15] = CAND(13, 0);
        G3[0] = CAND(14, 0); G3[1] = CAND(15, 0);
#pragma unroll
        for (int i = 2; i < 16; ++i) G3[i] = 0u;
#undef CAND
        sort16(G1); sort16(G2); sort16(G3);
        merge16(R, G1); merge16(R, G2); merge16(R, G3);
        float sc[16], ex[16]; float sum = 0.f; unsigned eid[16];
        #pragma unroll
        for (int i = 0; i < 16; ++i) { sc[i] = key2f(R[i] & ~0xffu); const unsigned a = (R[i] >> 4) & 15u, bb = R[i] & 15u;
            const unsigned io = pick_byte(iOpk, a), ip = pick_byte(iPpk, bb);
            eid[i] = tab0 ? (io * 128u + ip) : (ip * 128u + io); }
#pragma unroll
        for (int i = 0; i < 16; ++i) { ex[i] = __expf(sc[i] - sc[0]); sum += ex[i]; }
        const float inv = 1.0f / sum;
        if (tab0) { const size_t o = item * 16;
#pragma unroll
            for (int q = 0; q < 4; ++q) { v4u ev; ev.x = eid[4 * q]; ev.y = eid[4 * q + 1]; ev.z = eid[4 * q + 2]; ev.w = eid[4 * q + 3]; *(v4u*)(esel + o + 4 * q) = ev;
                f32x4 wv; wv[0] = ex[4 * q] * inv; wv[1] = ex[4 * q + 1] * inv; wv[2] = ex[4 * q + 2] * inv; wv[3] = ex[4 * q + 3] * inv; *(f32x4*)(wsel + o + 4 * q) = wv; } }
}
__device__ __forceinline__ void p7_topk(Frame& F) {
    const int NT = T * PHEADS * 2;
    for (int g0 = (F.bid * NWAVES + F.wave) * 64; g0 < NT; g0 += F.G * NTHR) {
        const int g = g0 + F.lane; const float* wb = F.scores() + (size_t)g0 * 128;
        LAS float* stg = (LAS float*)(F.lds) + F.wave * (64 * 36);
        unsigned top[16];
#pragma unroll
        for (int sg = 0; sg < 4; ++sg) {
            f32x4 tl[8];
#pragma unroll
            for (int i = 0; i < 8; ++i) tl[i] = __builtin_nontemporal_load((const f32x4*)(wb + (size_t)(8 * i + (F.lane >> 3)) * 128 + sg * 32 + 4 * (F.lane & 7)));
#pragma unroll
            for (int i = 0; i < 8; ++i) *(LAS f32x4*)(stg + (8 * i + (F.lane >> 3)) * 36 + 4 * (F.lane & 7)) = tl[i];
            asm volatile("s_waitcnt lgkmcnt(0)" ::: "memory");
#pragma unroll
            for (int hg2 = 0; hg2 < 2; ++hg2) { const int grp = sg * 2 + hg2; unsigned k[16];
#pragma unroll
                for (int q = 0; q < 4; ++q) { const f32x4 v = *(LAS const f32x4*)(stg + F.lane * 36 + hg2 * 16 + q * 4);
#pragma unroll
                    for (int e = 0; e < 4; ++e) { const int j = grp * 16 + q * 4 + e; k[q * 4 + e] = (f2key(v[e]) & ~0x7fu) | (unsigned)(127 - j); } }
                sort16(k);
                if (grp == 0) {
#pragma unroll
                    for (int i = 0; i < 16; ++i) top[i] = k[i];
                } else merge16(top, k); }
            asm volatile("s_waitcnt lgkmcnt(0)" ::: "memory");
        }
        topk_stage2(top, (g & 1) == 0, (size_t)((g >> 1) & 7) * T + (size_t)(g >> 4), F.esel(), F.wsel());
    }
}


struct EpiScoreTopk {
    static constexpr bool PERM = false, AFTER_DRAIN = false;
    float* scr; const float* ssqp; const float* biasq; float* rstd_out; int* esel; float* wsel;
    __device__ __forceinline__ void operator()(const f32x4 (&acc)[2][2][4][2], const pg8::Unit& u, int wr, int wc, int fr, int fq) const {
        asm volatile("" : "+v"(fr), "+v"(fq));
        const int rl0 = wr * 64 + fr, col0 = wc * 32 + 4 * fq, b = (u.pm * 256) >> 13;
        f32x4 bv[2][2];
#pragma unroll
        for (int bj = 0; bj < 2; ++bj)
#pragma unroll
            for (int n = 0; n < 2; ++n) bv[bj][n] = *(const f32x4*)(biasq + b * 2048 + u.pn * 256 + col0 + bj * 128 + n * 16);
#pragma unroll
        for (int ai = 0; ai < 2; ++ai)
#pragma unroll
            for (int m = 0; m < 4; ++m) { const int rl = rl0 + ai * 128 + m * 16, row = u.pm * 256 + rl;
                const f32x4 p0 = *(const f32x4*)(ssqp + (size_t)row * 4), p1 = *(const f32x4*)(ssqp + ((size_t)32768 + row) * 4), p2 = *(const f32x4*)(ssqp + ((size_t)65536 + row) * 4), p3 = *(const f32x4*)(ssqp + ((size_t)98304 + row) * 4);
                const float tot = (p0[0] + p0[1] + p0[2] + p0[3]) + (p1[0] + p1[1] + p1[2] + p1[3]) + (p2[0] + p2[1] + p2[2] + p2[3]) + (p3[0] + p3[1] + p3[2] + p3[3]);
                const float rstd = __builtin_amdgcn_rsqf(tot * (1.0f / 1024.0f) + 1e-6f);
                if (u.pn == 0 && wc == 0 && fq == 0) rstd_out[row] = rstd;
                float* blk = scr + (2 * wr + 4 * ai + (m >> 1)) * 8192 + 8 * wc * 256 + 32 * (m & 1) * 4;
                const unsigned loff4 = (unsigned)(2 * fr + 64 * fq);
#pragma unroll
                for (int bj = 0; bj < 2; ++bj)
#pragma unroll
                    for (int n = 0; n < 2; ++n) ((f32x4*)(blk + (4 * n * 64 + bj) * 4))[loff4] = acc[ai][bj][m][n] * rstd + bv[bj][n]; }
        asm volatile("s_waitcnt vmcnt(0)" ::: "memory");
        __builtin_amdgcn_s_barrier();
        asm volatile("" ::: "memory");
        int tid = threadIdx.x; asm volatile("" : "+v"(tid));
        const int rl = tid >> 1, tab = tid & 1;
        const float* bp = scr + __builtin_amdgcn_readfirstlane(tid >> 6) * 8192;
        const unsigned lo4 = (unsigned)(tid & 63) * 4u;
        unsigned top[16];
        f32x4 cur[4], nxt[4];
#pragma unroll
        for (int q = 0; q < 4; ++q) cur[q] = *(const f32x4*)(bp + q * 256 + lo4);
#pragma unroll
        for (int grp = 0; grp < 8; ++grp) { unsigned k[16];
            if (grp < 7) {
#pragma unroll
                for (int q = 0; q < 4; ++q) nxt[q] = *(const f32x4*)(bp + ((grp + 1) * 4 + q) * 256 + lo4); }
#pragma unroll
            for (int q = 0; q < 4; ++q) { const f32x4 v = cur[q];
#pragma unroll
                for (int e = 0; e < 4; ++e) { const int j = grp * 16 + q * 4 + e; k[q * 4 + e] = (f2key(v[e]) & ~0x7fu) | (unsigned)(127 - j); } }
            sort16(k);
            if (grp == 0) {
#pragma unroll
                for (int i = 0; i < 16; ++i) top[i] = k[i];
            } else merge16(top, k);
#pragma unroll
            for (int q = 0; q < 4; ++q) cur[q] = nxt[q];
            __builtin_amdgcn_sched_barrier(0); }
        topk_stage2(top, tab == 0, (size_t)u.pn * T + (size_t)(u.pm * 256 + rl), esel, wsel);
    }
};

__device__ __forceinline__ void cvt16(const v4u& u, f32x2_ (&f)[8]) {
#pragma unroll
    for (int i = 0; i < 4; ++i) { f[2 * i] = __builtin_amdgcn_cvt_pk_f32_fp8((int)u[i], false); f[2 * i + 1] = __builtin_amdgcn_cvt_pk_f32_fp8((int)u[i], true); }
}
constexpr int PITEM = 8, NPITEM = T / PITEM;
__device__ __forceinline__ int peer_next(unsigned* q, int lane) {
    int idx = 0; if (lane == 0) idx = (int)__hip_atomic_fetch_add(q, 1u, __ATOMIC_RELAXED, __HIP_MEMORY_SCOPE_AGENT);
    return __builtin_amdgcn_readfirstlane(idx);
}
#define PEER_SB() __builtin_amdgcn_sched_barrier(0)
__device__ __forceinline__ void p8_dots(const v4u (&ud)[16], const f32x2_ (&hn)[8], int c8, float& r0, float& r1) {
#pragma unroll
    for (int i = 0; i < 16; ++i) { f32x2_ uf[8]; cvt16(ud[i], uf); f32x2_ s2 = uf[0] * hn[0];
#pragma unroll
        for (int k = 1; k < 8; ++k) s2 += uf[k] * hn[k];
        float sm = s2[0] + s2[1];
        sm = DPP_ADD(sm, 0xB1); sm = DPP_ADD(sm, 0x4E); sm = DPP_ADD(sm, 0x141);
        if ((i & 1) == 0) r0 = (c8 == (i >> 1)) ? sm : r0; else r1 = (c8 == (i >> 1)) ? sm : r1;
        PEER_SB(); }
}
constexpr int PSLAB = 12288;
__device__ __forceinline__ void p8_item(Frame& F, int sl, int item, int nitem, bool filled, LAS unsigned char* slab) {
    const int c8 = F.lane & 7, q8 = F.lane >> 3, t0 = item * PITEM, b = t0 >> 13;
    const float* sh2 = F.mod() + b * 6144 + 3072 + sl * CSL + 16 * c8;
    float shv[16];
#pragma unroll
    for (int k = 0; k < 4; ++k) { const f32x4 v = *(const f32x4*)(sh2 + 4 * k); shv[4 * k] = v[0]; shv[4 * k + 1] = v[1]; shv[4 * k + 2] = v[2]; shv[4 * k + 3] = v[3]; }
    const unsigned char* ub = F.U8() + (size_t)sl * 16384 * CSL + 16 * c8;
    LAS int* eL = (LAS int*)slab; LAS bf16* hL = (LAS bf16*)(slab + 4096);
    v4u t4[4], h2[2];
#define P8_BLK_LOAD(tb) do { \
        _Pragma("unroll") for (int i = 0; i < 4; ++i) t4[i] = __builtin_nontemporal_load((const v4u*)(F.esel() + ((size_t)(2 * i + (F.lane >> 5)) * T + (tb)) * 16) + (F.lane & 31)); \
        _Pragma("unroll") for (int i = 0; i < 2; ++i) h2[i] = __builtin_nontemporal_load((const v4u*)(F.hg() + (size_t)((tb) + 4 * i + (F.lane >> 4)) * D + sl * CSL + 8 * (F.lane & 15))); } while (0)
#define P8_BLK_STORE() do { _Pragma("unroll") for (int i = 0; i < 4; ++i) *(LAS v4u*)(eL + ((F.lane & 31) >> 2) * NSEL + (2 * i + (F.lane >> 5)) * 16 + 4 * (F.lane & 3)) = t4[i]; \
        _Pragma("unroll") for (int i = 0; i < 2; ++i) *(LAS v4u*)(hL + (i * 64 + F.lane) * 8) = h2[i]; asm volatile("s_waitcnt lgkmcnt(0)" ::: "memory"); } while (0)
    if (!filled) { P8_BLK_LOAD(t0); P8_BLK_STORE(); }
    const float* rp = F.rstd() + t0;
    float* po = F.pact() + ((size_t)t0 * NSL + sl) * NSEL + 16 * q8 + 2 * c8;
    v4u udA[16], udB[16];
#define P8_GATHER(dst, tt) do { v4u e_[4]; _Pragma("unroll") for (int k = 0; k < 4; ++k) e_[k] = *(LAS const v4u*)(eL + (tt) * NSEL + 16 * q8 + 4 * k); \
        _Pragma("unroll") for (int i = 0; i < 16; ++i) dst[i] = *(const v4u*)(ub + (size_t)e_[i >> 2][i & 3] * CSL); } while (0)
#define P8_HN(tt) f32x2_ hn[8]; { const v4u h0 = *(LAS const v4u*)(hL + (tt) * NSEL + 16 * c8), h1 = *(LAS const v4u*)(hL + (tt) * NSEL + 16 * c8 + 8); const float rstd = rp[tt]; \
        _Pragma("unroll") for (int k = 0; k < 4; ++k) { hn[k][0] = bflo(h0[k]) * rstd + shv[2 * k]; hn[k][1] = bfhi(h0[k]) * rstd + shv[2 * k + 1]; \
            hn[4 + k][0] = bflo(h1[k]) * rstd + shv[8 + 2 * k]; hn[4 + k][1] = bfhi(h1[k]) * rstd + shv[8 + 2 * k + 1]; } }
#define P8_OUT(tt, r0, r1) do { f32x2_ o_; o_[0] = (r0) * (1.0f / USCALE); o_[1] = (r1) * (1.0f / USCALE); __builtin_nontemporal_store(o_, (f32x2_*)(po + (size_t)(tt) * NSL * NSEL)); } while (0)
    P8_GATHER(udA, 0);
    for (int tt = 0; tt < PITEM - 2; tt += 2) {
        P8_GATHER(udB, tt + 1);
        { P8_HN(tt); float r0 = 0.f, r1 = 0.f; p8_dots(udA, hn, c8, r0, r1); P8_OUT(tt, r0, r1); }
        P8_GATHER(udA, tt + 2);
        { P8_HN(tt + 1); float r0 = 0.f, r1 = 0.f; p8_dots(udB, hn, c8, r0, r1); P8_OUT(tt + 1, r0, r1); }
    }
    {
        P8_GATHER(udB, PITEM - 1);
        { P8_HN(PITEM - 2); float r0 = 0.f, r1 = 0.f; p8_dots(udA, hn, c8, r0, r1); P8_OUT(PITEM - 2, r0, r1); }
        if (nitem >= 0) P8_BLK_LOAD(nitem * PITEM);
        { P8_HN(PITEM - 1); float r0 = 0.f, r1 = 0.f; p8_dots(udB, hn, c8, r0, r1); P8_OUT(PITEM - 1, r0, r1); }
        if (nitem >= 0) P8_BLK_STORE();
    }
#undef P8_GATHER
#undef P8_HN
#undef P8_OUT
#undef P8_BLK_LOAD
#undef P8_BLK_STORE
}
__device__ __forceinline__ void p8b_coef(Frame& F) {
    const size_t N = (size_t)T * NSEL;
    for (size_t i = (size_t)F.bid * NTHR + F.tid; i < N; i += (size_t)F.G * NTHR) { const size_t t = i >> 7; const int j = (int)(i & 127);
        const float* pp = F.pact() + t * NSL * NSEL + j; float a = 0.f;
#pragma unroll
        for (int s = 0; s < NSL; ++s) a += __builtin_nontemporal_load(pp + s * NSEL);
        F.coef()[i] = F.wsel()[((size_t)(j >> 4) * T + t) * 16 + (j & 15)] * 0.5f * a * (1.0f + erff(a * 0.70710678f)); }
}
__device__ __forceinline__ void p9_token(const v4u (&vd)[16], LAS const float* cL, float* yo, LAS float* red, int lane, int c8, int q8) {
    f32x4 cc[4];
#pragma unroll
    for (int k = 0; k < 4; ++k) cc[k] = *(LAS const f32x4*)(cL + 16 * q8 + 4 * k);
    f32x2_ y[8];
#pragma unroll
    for (int k = 0; k < 8; ++k) y[k] = (f32x2_){0.f, 0.f};
#pragma unroll
    for (int i = 0; i < 16; ++i) { f32x2_ vf[8]; cvt16(vd[i], vf); const float c = cc[i >> 2][i & 3]; const f32x2_ c2 = {c, c};
#pragma unroll
        for (int k = 0; k < 8; ++k) y[k] += c2 * vf[k];
        PEER_SB(); }
#pragma unroll
    for (int k = 0; k < 4; ++k) { f32x4 o; o[0] = y[2 * k][0]; o[1] = y[2 * k][1]; o[2] = y[2 * k + 1][0]; o[3] = y[2 * k + 1][1]; *(LAS f32x4*)(red + q8 * 128 + 16 * c8 + 4 * k) = o; }
    asm volatile("s_waitcnt lgkmcnt(0)" ::: "memory");
    f32x2_ sm = {0.f, 0.f};
#pragma unroll
    for (int g = 0; g < 8; ++g) sm += *(LAS const f32x2_*)(red + g * 128 + 2 * lane);
    sm = sm * (1.0f / VSCALE);
    __builtin_nontemporal_store(sm, (f32x2_*)(yo + 2 * lane));
    asm volatile("s_waitcnt lgkmcnt(0)" ::: "memory");
    PEER_SB();
}
__device__ __forceinline__ void p9_item(Frame& F, int sl, int item, int nitem, bool filled, LAS unsigned char* slab) {
    const int c8 = F.lane & 7, q8 = F.lane >> 3, t0 = item * PITEM;
    const unsigned char* vb = F.V8() + (size_t)sl * 16384 * CSL + 16 * c8;
    LAS int* eL = (LAS int*)slab; LAS float* cL = (LAS float*)(slab + 4096); LAS float* red = (LAS float*)(slab + 8192);
    v4u t4[4], c4[4];
#define P9_BLK_LOAD(tb) do { const v4u* cp_ = (const v4u*)(F.coef() + (size_t)(tb) * NSEL); \
        _Pragma("unroll") for (int i = 0; i < 4; ++i) { t4[i] = __builtin_nontemporal_load((const v4u*)(F.esel() + ((size_t)(2 * i + (F.lane >> 5)) * T + (tb)) * 16) + (F.lane & 31)); c4[i] = __builtin_nontemporal_load(cp_ + i * 64 + F.lane); } } while (0)
#define P9_BLK_STORE() do { _Pragma("unroll") for (int i = 0; i < 4; ++i) { *(LAS v4u*)(eL + ((F.lane & 31) >> 2) * NSEL + (2 * i + (F.lane >> 5)) * 16 + 4 * (F.lane & 3)) = t4[i]; *(LAS v4u*)(cL + (i * 64 + F.lane) * 4) = c4[i]; } \
        asm volatile("s_waitcnt lgkmcnt(0)" ::: "memory"); } while (0)
    if (!filled) { P9_BLK_LOAD(t0); P9_BLK_STORE(); }
    float* yo = F.ybuf() + (size_t)t0 * D + sl * CSL;
    v4u vdA[16], vdB[16];
#define P9_GATHER(dst, tt) do { v4u e_[4]; _Pragma("unroll") for (int k = 0; k < 4; ++k) e_[k] = *(LAS const v4u*)(eL + (tt) * NSEL + 16 * q8 + 4 * k); \
        _Pragma("unroll") for (int i = 0; i < 16; ++i) dst[i] = *(const v4u*)(vb + (size_t)e_[i >> 2][i & 3] * CSL); } while (0)
    P9_GATHER(vdA, 0);
    for (int tt = 0; tt < PITEM - 2; tt += 2) {
        P9_GATHER(vdB, tt + 1);
        p9_token(vdA, cL + tt * NSEL, yo + (size_t)tt * D, red, F.lane, c8, q8);
        P9_GATHER(vdA, tt + 2);
        p9_token(vdB, cL + (tt + 1) * NSEL, yo + (size_t)(tt + 1) * D, red, F.lane, c8, q8);
    }
    {
        P9_GATHER(vdB, PITEM - 1);
        p9_token(vdA, cL + (PITEM - 2) * NSEL, yo + (size_t)(PITEM - 2) * D, red, F.lane, c8, q8);
        if (nitem >= 0) P9_BLK_LOAD(nitem * PITEM);
        p9_token(vdB, cL + (PITEM - 1) * NSEL, yo + (size_t)(PITEM - 1) * D, red, F.lane, c8, q8);
        if (nitem >= 0) P9_BLK_STORE();
    }
#undef P9_GATHER
#undef P9_BLK_LOAD
#undef P9_BLK_STORE
}
template <int SIDE>
__device__ __forceinline__ void peer_phase(Frame& F0, int rep) {
    Frame F = F0; asm volatile("" : "+v"(F.lane));
    const int s0 = (int)(xb_xcc_id() & 7u);
    unsigned* qbase = F.ctl() + (SIDE == 0 ? CW_QU : CW_QV) + rep * 64 * 32;
    LAS unsigned char* cf = F.lds + F.wave * PSLAB;
    for (int k = 0; k < NSL; ++k) { const int sl = (s0 + k) & (NSL - 1);
        int item = peer_next(qbase + 64 * sl, F.lane); bool filled = false;
        while (item < NPITEM) { int nitem = peer_next(qbase + 64 * sl, F.lane); if (nitem >= NPITEM) nitem = -1;
            if (SIDE == 0) p8_item(F, sl, item, nitem, filled, cf); else p9_item(F, sl, item, nitem, filled, cf);
            filled = nitem >= 0; item = nitem >= 0 ? nitem : NPITEM; } }
}
__device__ __forceinline__ void p10_final(Frame& F) {
    const int gwc = F.bid * NWAVES + F.wave, NGW = F.G * NWAVES;
    for (int row0 = gwc * 16; row0 < T; row0 += NGW * 16) {
        const int b = row0 >> 13; const float* mb = F.mod() + b * 6144 + 5120; const float* fm = F.fmod() + b * 2048;
        f32x4 g2[4], ca[4], cb[4];
#pragma unroll
        for (int j = 0; j < 4; ++j) { const int k = 256 * j + 4 * F.lane; g2[j] = *(const f32x4*)(mb + k); ca[j] = *(const f32x4*)(F.fnorm_g() + k) * (*(const f32x4*)(fm + 1024 + k) + 1.0f); cb[j] = *(const f32x4*)(fm + k); }
#pragma unroll 4
        for (int r = 0; r < 16; ++r) { float* hr = F.out() + (size_t)(row0 + r) * D; const float* yr = F.ybuf() + (size_t)(row0 + r) * D; const bf16* hb = (const bf16*)hr;
            f32x4 z[4]; float ss = 0.f;
#pragma unroll
            for (int j = 0; j < 4; ++j) { const v2u hq = *(const v2u*)(hb + 256 * j + 4 * F.lane); f32x4 hv; hv[0] = bflo(hq[0]); hv[1] = bfhi(hq[0]); hv[2] = bflo(hq[1]); hv[3] = bfhi(hq[1]);
                z[j] = hv + g2[j] * __builtin_nontemporal_load((const f32x4*)(yr + 256 * j + 4 * F.lane)); ss += z[j][0] * z[j][0] + z[j][1] * z[j][1] + z[j][2] * z[j][2] + z[j][3] * z[j][3]; }
            const float rstd = __builtin_amdgcn_rsqf(wave_sum(ss) * (1.0f / D) + EPS);
#pragma unroll
            for (int j = 0; j < 4; ++j) *(f32x4*)(hr + 256 * j + 4 * F.lane) = z[j] * rstd * ca[j] + cb[j]; }
    }
}

constexpr int NPHASE = 12;
__global__ void __launch_bounds__(NTHR, 2) fwd_kernel(Args args) {
    extern __shared__ __attribute__((aligned(16))) unsigned char lds_raw[];
    Frame F;
    F.lds = (LAS unsigned char*)lds_raw;
    F.tid = threadIdx.x; F.lane = F.tid & 63; F.wave = __builtin_amdgcn_readfirstlane(F.tid >> 6); F.G = gridDim.x; F.bid = blockIdx.x;
    unsigned char* ws = args.ws; F.a = &args;
    volatile LAS unsigned* misc = (volatile LAS unsigned*)(F.lds + MISC_OFF);
    for (int i = F.tid; i < LDS_BYTES / 16; i += NTHR) ((LAS v4u*)F.lds)[i] = (v4u){LDSFILL, LDSFILL, LDSFILL, LDSFILL};
    __syncthreads();
    if (F.tid < 64) misc[F.tid] = 0u;
    __syncthreads();
    const int lo = args.ph_lo, hi = args.ph_hi;
    const bool multi = (hi - lo) > 1;
    XcdBarrier bar; bar.bar = (unsigned*)(ws + WS_CTL) + CW_BAR; bar.x = 0; bar.st = nullptr;
    if (multi) bar = xcd_barrier_post((unsigned*)(ws + WS_CTL) + CW_BAR, misc + 8);
#ifndef PHMASK
#define PHMASK 0xfff
#endif
#define IN(k) (((PHMASK >> (k)) & 1) && lo <= (k) && (k) < hi)
#define SEAM(k) do { if (IN(k) && IN((k) + 1)) xcd_barrier(bar); } while (0)

#ifndef REPMASK
#define REPMASK 0
#endif
#define REP(k) (((REPMASK) >> (k)) & 1)
#define REPBAR(k) if (REP(k) && rep == 0) xcd_barrier(bar)
    if (IN(0)) { for (int rep = 0; rep <= REP(0); ++rep) { p0_prologue(F); REPBAR(0); } } SEAM(0);
    if (IN(1)) { for (int rep = 0; rep <= REP(1); ++rep) { p1_norm(F); REPBAR(1); } } SEAM(1);
    if (IN(2)) { { pg8::Gemm g{F.bufA(), F.Win_t(), T, NIN, D}; pg8::StaticOrder S; S.init(T, NIN, F.G, F.bid);
        pg8::EpiProj E{F.proj(), NIN};
        pg8::gemm_phase<pg8::EpiProj, pg8::StaticOrder, true, true>(F.lds, g, S, E); }
#if ((REPMASK) >> 2) & 1
        xcd_barrier(bar); { pg8::Gemm g{F.bufA(), F.Win_t(), T, NIN, D}; pg8::StaticOrder S; S.init(T, NIN, F.G, F.bid);
        pg8::EpiProj E{F.proj(), NIN};
        pg8::gemm_phase<pg8::EpiProj, pg8::StaticOrder, true, true>(F.lds, g, S, E); }
#endif
    } SEAM(2);
    if (IN(3)) { for (int rep = 0; rep <= REP(3); ++rep) {
        for (int it = F.bid; it < NB * NHH * 2 * NSEG; it += F.G) h1_item(F, it);
        float cw[CW];
#pragma unroll
        for (int j = 0; j < CW; ++j) cw[j] = F.conv_w()[j * DC + F.tid];
        const float cbias = F.conv_b()[F.tid];
        for (int it = F.bid; it < T / 32; it += F.G) conv_item(F, it, cw, cbias); REPBAR(3); }
    } SEAM(3);
    if (IN(4)) { for (int rep = 0; rep <= REP(4); ++rep) { for (int it = F.bid; it < NB * NHH * NSEG; it += F.G) h2_item(F, it); REPBAR(4); } } SEAM(4);
    if (IN(5)) { { pg8::Gemm g{F.bufA(), F.Wout_t(), T, D, D}; pg8::StaticOrder S; S.init(T, D, F.G, F.bid);
        pg8::EpiOut E{F.x(), F.out(), F.hg(), F.mod(), F.g_ffn(), F.ssqp()};
        pg8::gemm_phase<pg8::EpiOut, pg8::StaticOrder, true, true>(F.lds, g, S, E); }
#if ((REPMASK) >> 5) & 1
        xcd_barrier(bar); { pg8::Gemm g{F.bufA(), F.Wout_t(), T, D, D}; pg8::StaticOrder S; S.init(T, D, F.G, F.bid);
        pg8::EpiOut E{F.x(), F.out(), F.hg(), F.mod(), F.g_ffn(), F.ssqp()};
        pg8::gemm_phase<pg8::EpiOut, pg8::StaticOrder, true, true>(F.lds, g, S, E); }
#endif
    } SEAM(5);
    if (IN(6)) { { pg8::Gemm g{F.hg(), F.Wqk_t(), T, NQK, D}; pg8::StaticOrder S; S.init(T, NQK, F.G, F.bid);
        EpiScoreTopk E{F.scores() + (size_t)F.bid * 65536, F.ssqp(), F.biasq(), F.rstd(), F.esel(), F.wsel()};
        pg8::gemm_phase<EpiScoreTopk, pg8::StaticOrder, true, true>(F.lds, g, S, E); }
    } SEAM(6);
    if (IN(8)) { for (int rep = 0; rep <= REP(8); ++rep) { peer_phase<0>(F, rep); REPBAR(8); } } SEAM(8);
    if (IN(9)) { for (int rep = 0; rep <= REP(9); ++rep) { p8b_coef(F); REPBAR(9); } } SEAM(9);
    if (IN(10)) { for (int rep = 0; rep <= REP(10); ++rep) { peer_phase<1>(F, rep); REPBAR(10); } } SEAM(10);
    if (IN(11)) { p10_final(F); }
#undef IN
#undef SEAM
}

#ifndef MK_ONE_LAUNCH
#define MK_ONE_LAUNCH 0
#endif
extern "C" void kernel_launch(void* const* d_in, const int* in_sizes, int n_in, void* d_out, int out_size, void* d_ws, size_t ws_size, hipStream_t stream) {
    static int grid = 0;
    if (grid == 0) {
        if (n_in != 23 || out_size != T * D || ws_size < WS_END) { fprintf(stderr, "kernel_launch: unexpected shapes (n_in %d, out %d, ws %zu)\n", n_in, out_size, ws_size); grid = -1; return; }
        int dev = 0, cus = 0, per_cu = 0;
        if (hipGetDevice(&dev) != hipSuccess || hipDeviceGetAttribute(&cus, hipDeviceAttributeMultiprocessorCount, dev) != hipSuccess) { grid = -1; return; }
        if (hipFuncSetAttribute((const void*)fwd_kernel, hipFuncAttributeMaxDynamicSharedMemorySize, LDS_BYTES) != hipSuccess) { fprintf(stderr, "kernel_launch: hipFuncSetAttribute failed\n"); grid = -1; return; }
        if (hipOccupancyMaxActiveBlocksPerMultiprocessor(&per_cu, (const void*)fwd_kernel, NTHR, LDS_BYTES) != hipSuccess || per_cu < 1) { fprintf(stderr, "kernel_launch: occupancy query reports %d\n", per_cu); }
        (void)hipGetLastError();
        grid = cus;
    }
    if (grid < 0) return;
    (void)hipMemsetAsync((char*)d_ws + WS_CTL, 0, CTL_ZERO_BYTES, stream);
    Args a{};
    for (int i = 0; i < 23; ++i) a.in[i] = (const float*)d_in[i];
    a.out = (float*)d_out; a.ws = (unsigned char*)d_ws;
#if MK_ONE_LAUNCH
    a.ph_lo = 0; a.ph_hi = NPHASE;
    hipLaunchKernelGGL(fwd_kernel, dim3(grid), dim3(NTHR), LDS_BYTES, stream, a);
#else
    for (int p = 0; p < NPHASE; ++p) { a.ph_lo = p; a.ph_hi = p + 1; hipLaunchKernelGGL(fwd_kernel, dim3(grid), dim3(NTHR), LDS_BYTES, stream, a); }
#endif
}
```

```cpp
#include <hip/hip_runtime.h>
#include <cstdio>
#include <cstdint>
namespace pg8 {
#define PG8_LAS __attribute__((address_space(3)))
typedef unsigned short bf16_t;
typedef short bf16x8 __attribute__((ext_vector_type(8)));
typedef float f32x4 __attribute__((ext_vector_type(4)));
typedef unsigned u32x4 __attribute__((ext_vector_type(4)));
constexpr int BM = 256, BK = 64, HALF = 128, HTB = HALF * BK * 2  , STAGE_BYTES = 8 * HTB, NXCD = 8, WGM = 8;

__host__ __device__ __forceinline__ int lds_byte(int r, int c) { const int st = (r >> 4) * 2 + (c >> 5), rr = r & 15, cc = c & 31, ob = rr * 64 + cc * 2; return st * 1024 + (ob ^ (((ob >> 9) & 1) << 5)); }
__host__ __device__ __forceinline__ void stage_rc(int b, int& R, int& C) { const int st = b / 1024, sb = b % 1024, swz = sb ^ (((sb >> 9) & 1) << 5); R = (st >> 1) * 16 + swz / 64; C = (st & 1) * 32 + (swz % 64) / 2; }
__host__ __device__ __forceinline__ int perm32(int rho) { const int n = rho >> 4, i = rho & 15; return 8 * (i >> 2) + 4 * n + (i & 3); }

struct Unit { int pm, pn; };
struct Gemm { const bf16_t* A; const bf16_t* Bt; int M, N, K; };

struct StaticOrder {
    int nM, nN, nwg, G, c;
    __host__ __device__ void init(int M, int N, int G_, int c_) { nM = M / BM; nN = N / BM; nwg = nM * nN; G = G_; c = c_; }
    __host__ __device__ bool next(int i, Unit& u) const {
        const long L = (long)i * G + c; if (L >= nwg) return false;
        int wgid = (int)L; { const int q = nwg / NXCD, r = nwg % NXCD, xcd = wgid % NXCD, off = wgid / NXCD; wgid = (xcd < r ? xcd * (q + 1) : r * (q + 1) + (xcd - r) * q) + off; }
        const int nig = WGM * nN, gid = wgid / nig, fm = gid * WGM, gsz = (nM - fm) < WGM ? (nM - fm) : WGM;
        u.pm = fm + ((wgid % nig) % gsz); u.pn = (wgid % nig) / gsz; return true;
    }
    __device__ __forceinline__ void a_ready(const Unit&) const {}
    __device__ __forceinline__ void done(const Unit&) const {}
};
__device__ __forceinline__ unsigned cvt_pk_bf16(float lo, float hi) { unsigned r; asm volatile("v_cvt_pk_bf16_f32 %0, %1, %2" : "=v"(r) : "v"(lo), "v"(hi)); return r; }
typedef float f32x2 __attribute__((ext_vector_type(2)));
__device__ __forceinline__ f32x2 gelu_pk(f32x2 v) {
    const f32x2 av = __builtin_elementwise_abs(v), d = av * 0.2316418882f + 1.0f;
    f32x2 t; t.x = __builtin_amdgcn_rcpf(d.x); t.y = __builtin_amdgcn_rcpf(d.y);
    f32x2 q = t * 0.5307027145f + (-0.7265760135f); q = q * t + 0.7107068705f; q = q * t + (-0.142248368f); q = q * t + 0.127414796f; q = q * t;
    const f32x2 s = (v * v) * (-0.72134752044f);
    f32x2 e; e.x = __builtin_amdgcn_exp2f(s.x); e.y = __builtin_amdgcn_exp2f(s.y);
    const f32x2 m = v * (q * e), r = v - m;
    f32x2 o; o.x = v.x < 0.f ? m.x : r.x; o.y = v.y < 0.f ? m.y : r.y; return o;
}

template <int ACT  > struct EpiBf16 {
    static constexpr bool PERM = true, AFTER_DRAIN = false; static_assert(ACT == 0 || ACT == 1, "EpiBf16: ACT is 0 (none) or 1 (gelu_pk)");
    bf16_t* O; int ldc; const float* bias; int split_cols; size_t split_stride; float scale0;
    __device__ __forceinline__ void operator()(const f32x4 (&acc)[2][2][4][2], const Unit& u, int wr, int wc, int fr, int fq) const {
        const int row0 = u.pm * BM + wr * 64 + fr; int colt = u.pn * BM; bf16_t* base = O;
        float sc = 1.f; if (split_cols) { const int t = colt / split_cols; base += (size_t)t * split_stride; colt -= t * split_cols; if (t == 0) sc = scale0; }
        const int col0 = colt + wc * 32 + 8 * fq, bcol0 = u.pn * BM + wc * 32 + 8 * fq;
        f32x4 bv[2][2];
#pragma unroll
        for (int bj = 0; bj < 2; ++bj)
#pragma unroll
            for (int n = 0; n < 2; ++n) bv[bj][n] = bias ? *(const f32x4*)(bias + bcol0 + bj * HALF + 4 * n) : (f32x4){0.f, 0.f, 0.f, 0.f};
#pragma unroll
        for (int ai = 0; ai < 2; ++ai)
#pragma unroll
            for (int m = 0; m < 4; ++m) { bf16_t* rowp = base + (size_t)(row0 + ai * HALF + m * 16) * ldc + col0;
#pragma unroll
                for (int bj = 0; bj < 2; ++bj) { f32x4 v0 = acc[ai][bj][m][0] + bv[bj][0], v1 = acc[ai][bj][m][1] + bv[bj][1];
                    if (ACT == 1) { f32x2 a = gelu_pk((f32x2){v0[0], v0[1]}), b = gelu_pk((f32x2){v0[2], v0[3]}), c = gelu_pk((f32x2){v1[0], v1[1]}), d = gelu_pk((f32x2){v1[2], v1[3]});
                        v0 = (f32x4){a.x, a.y, b.x, b.y}; v1 = (f32x4){c.x, c.y, d.x, d.y}; }
                    v0 = v0 * sc; v1 = v1 * sc; u32x4 w; w.x = cvt_pk_bf16(v0[0], v0[1]); w.y = cvt_pk_bf16(v0[2], v0[3]); w.z = cvt_pk_bf16(v1[0], v1[1]); w.w = cvt_pk_bf16(v1[2], v1[3]);
                    *(u32x4*)(rowp + bj * HALF) = w; } }
    }
};

struct EpiOut {
    static constexpr bool PERM = true, AFTER_DRAIN = false;
    const float* X; float* Hout; bf16_t* HG; const float* mod; const float* gffn; float* ssqp;
    __device__ __forceinline__ void operator()(const f32x4 (&acc)[2][2][4][2], const Unit& u, int wr, int wc, int fr, int fq) const {
        const int row0 = u.pm * BM + wr * 64 + fr, col0 = u.pn * BM + wc * 32 + 8 * fq;
        const int b = (u.pm * BM) >> 13;
        const float* mb = mod + b * 6144;
        f32x4 g1v[2][2], gv2[2][2];
#pragma unroll
        for (int bj = 0; bj < 2; ++bj)
#pragma unroll
            for (int n = 0; n < 2; ++n) { const int c = col0 + bj * HALF + 4 * n;
                g1v[bj][n] = *(const f32x4*)(mb + 2048 + c);
                const f32x4 s2 = *(const f32x4*)(mb + 4096 + c), gf = *(const f32x4*)(gffn + c);
                gv2[bj][n] = gf * (s2 + 1.0f); }
#pragma unroll
        for (int ai = 0; ai < 2; ++ai)
#pragma unroll
            for (int m = 0; m < 4; ++m) { const int row = row0 + ai * HALF + m * 16; const size_t ro = (size_t)row * 1024 + col0; float ss = 0.f;
#pragma unroll
                for (int bj = 0; bj < 2; ++bj) {
                    const f32x4 x0 = *(const f32x4*)(X + ro + bj * HALF), x1 = *(const f32x4*)(X + ro + bj * HALF + 4);
                    const f32x4 h0 = x0 + g1v[bj][0] * acc[ai][bj][m][0], h1 = x1 + g1v[bj][1] * acc[ai][bj][m][1];
                    { u32x4 hw; hw.x = cvt_pk_bf16(h0[0], h0[1]); hw.y = cvt_pk_bf16(h0[2], h0[3]); hw.z = cvt_pk_bf16(h1[0], h1[1]); hw.w = cvt_pk_bf16(h1[2], h1[3]);
                      *(u32x4*)((bf16_t*)Hout + (size_t)row * 2048 + col0 + bj * HALF) = hw; }
                    ss += h0[0] * h0[0] + h0[1] * h0[1] + h0[2] * h0[2] + h0[3] * h0[3] + h1[0] * h1[0] + h1[1] * h1[1] + h1[2] * h1[2] + h1[3] * h1[3];
                    const f32x4 q0 = h0 * gv2[bj][0], q1 = h1 * gv2[bj][1];
                    u32x4 w; w.x = cvt_pk_bf16(q0[0], q0[1]); w.y = cvt_pk_bf16(q0[2], q0[3]); w.z = cvt_pk_bf16(q1[0], q1[1]); w.w = cvt_pk_bf16(q1[2], q1[3]);
                    *(u32x4*)(HG + ro + bj * HALF) = w; }
                ss += __shfl_xor(ss, 16); ss += __shfl_xor(ss, 32);
                if (fq == 0) ssqp[((size_t)u.pn * 32768 + row) * 4 + wc] = ss; }
    }
};
struct EpiScore {
    static constexpr bool PERM = false, AFTER_DRAIN = false;
    float* S; const float* ssqp; const float* biasq; float* rstd_out;
    __device__ __forceinline__ void operator()(const f32x4 (&acc)[2][2][4][2], const Unit& u, int wr, int wc, int fr, int fq) const {
        const int row0 = u.pm * BM + wr * 64 + fr, col0 = u.pn * BM + wc * 32 + 4 * fq;
        const int b = (u.pm * BM) >> 13;
        f32x4 bv[2][2];
#pragma unroll
        for (int bj = 0; bj < 2; ++bj)
#pragma unroll
            for (int n = 0; n < 2; ++n) bv[bj][n] = *(const f32x4*)(biasq + b * 2048 + col0 + bj * HALF + n * 16);
#pragma unroll
        for (int ai = 0; ai < 2; ++ai)
#pragma unroll
            for (int m = 0; m < 4; ++m) { const int row = row0 + ai * HALF + m * 16;
                const f32x4 p0 = *(const f32x4*)(ssqp + (size_t)row * 4), p1 = *(const f32x4*)(ssqp + ((size_t)32768 + row) * 4), p2 = *(const f32x4*)(ssqp + ((size_t)65536 + row) * 4), p3 = *(const f32x4*)(ssqp + ((size_t)98304 + row) * 4);
                const float tot = (p0[0] + p0[1] + p0[2] + p0[3]) + (p1[0] + p1[1] + p1[2] + p1[3]) + (p2[0] + p2[1] + p2[2] + p2[3]) + (p3[0] + p3[1] + p3[2] + p3[3]);
                const float rstd = __builtin_amdgcn_rsqf(tot * (1.0f / 1024.0f) + 1e-6f);
                if (u.pn == 0 && wc == 0 && fq == 0) rstd_out[row] = rstd;
                float* rowp = S + (size_t)row * 2048 + col0;
#pragma unroll
                for (int bj = 0; bj < 2; ++bj)
#pragma unroll
                    for (int n = 0; n < 2; ++n) *(f32x4*)(rowp + bj * HALF + n * 16) = acc[ai][bj][m][n] * rstd + bv[bj][n]; }
    }
};

struct EpiProj {
    static constexpr bool PERM = true, AFTER_DRAIN = false;
    bf16_t* O; int ldc;
    __device__ __forceinline__ void operator()(const f32x4 (&acc)[2][2][4][2], const Unit& u, int wr, int wc, int fr, int fq) const {
        asm volatile("" : "+v"(fr), "+v"(fq));
        const int row0 = u.pm * BM + wr * 64 + fr, col0 = u.pn * BM + wc * 32 + 8 * fq;
        const int cls = u.pn >> 1;
        const bool ident = (cls == 3) || (cls == 5), mulx = (cls == 0) || (cls == 4);
        const float sgn = (cls == 1 || cls == 2) ? 1.4426950408889634f : -1.4426950408889634f;
#pragma unroll
        for (int ai = 0; ai < 2; ++ai)
#pragma unroll
            for (int m = 0; m < 4; ++m) { bf16_t* rowp = O + (size_t)(row0 + ai * HALF + m * 16) * ldc + col0;
#pragma unroll
                for (int bj = 0; bj < 2; ++bj) { f32x4 v0 = acc[ai][bj][m][0], v1 = acc[ai][bj][m][1];
                    if (!ident) {
#pragma unroll
                        for (int j = 0; j < 4; ++j) { const float r0 = __builtin_amdgcn_rcpf(1.0f + __builtin_amdgcn_exp2f(sgn * v0[j])), r1 = __builtin_amdgcn_rcpf(1.0f + __builtin_amdgcn_exp2f(sgn * v1[j]));
                            v0[j] = mulx ? v0[j] * r0 : r0; v1[j] = mulx ? v1[j] * r1 : r1; } }
                    u32x4 w; w.x = cvt_pk_bf16(v0[0], v0[1]); w.y = cvt_pk_bf16(v0[2], v0[3]); w.z = cvt_pk_bf16(v1[0], v1[1]); w.w = cvt_pk_bf16(v1[2], v1[3]);
                    *(u32x4*)(rowp + bj * HALF) = w; } }
    }
};
template <class Epi, class Sched, bool ALIGN_EPI = false, bool SP2 = false>
__device__ __forceinline__ void gemm_phase(PG8_LAS unsigned char* lds, const Gemm g, const Sched& S, const Epi& E) {
    const int tid = threadIdx.x, wid = __builtin_amdgcn_readfirstlane(tid >> 6), lane = tid & 63, wr = wid >> 2, wc = wid & 3, fr = lane & 15, fq = lane >> 4;
    const int K = g.K, nt = K / BK;
    unsigned voffA[2], voffB[2];
#pragma unroll
    for (int i = 0; i < 2; ++i) { int R, C; stage_rc(tid * 16 + i * 8192, R, C); const int Rb = Epi::PERM ? ((R & ~31) + perm32(R & 31)) : R;
        voffA[i] = (unsigned)(R * K + C) * 2u; voffB[i] = (unsigned)(Rb * K + C) * 2u; }
    const size_t kstep = (size_t)(BK * 2);
    const size_t hstep = (size_t)HALF * K * 2;
    const size_t tstep = 2 * hstep;
    const unsigned ldsw = (unsigned)wid * 1024u;
    const int aoff = lds_byte(wr * 64 + fr, fq * 8), boff = lds_byte(wc * 32 + fr, fq * 8);
#define PG8_SA(b, h) (((b) * 2 + (h)) * HTB)
#define PG8_SB(b, h) ((4 + (b) * 2 + (h)) * HTB)
#define PG8_STAGE(bufoff, gbase, voff) do { _Pragma("unroll") for (int _i = 0; _i < 2; ++_i) \
        __builtin_amdgcn_global_load_lds((const unsigned*)((const char*)(gbase) + (voff)[_i]), (PG8_LAS unsigned*)(lds + (bufoff) + ldsw + _i * 8192), 16, 0, 0); } while (0)
#define PG8_LDA(dst, b, h) do { _Pragma("unroll") for (int m = 0; m < 4; ++m) _Pragma("unroll") for (int k = 0; k < 2; ++k) dst[m][k] = *(const PG8_LAS bf16x8*)(lds + PG8_SA(b, h) + aoff + m * 2048 + k * 1024); } while (0)
#define PG8_LDB(dst, b, h) do { _Pragma("unroll") for (int n = 0; n < 2; ++n) _Pragma("unroll") for (int k = 0; k < 2; ++k) dst[n][k] = *(const PG8_LAS bf16x8*)(lds + PG8_SB(b, h) + boff + n * 2048 + k * 1024); } while (0)
#define PG8_MMA(ai, bj, At, Bt) do { __builtin_amdgcn_s_setprio(1); _Pragma("unroll") for (int m = 0; m < 4; ++m) _Pragma("unroll") for (int n = 0; n < 2; ++n) _Pragma("unroll") for (int k = 0; k < 2; ++k) \
        acc[ai][bj][m][n] = __builtin_amdgcn_mfma_f32_16x16x32_bf16(Bt[n][k], At[m][k], acc[ai][bj][m][n], 0, 0, 0); __builtin_amdgcn_s_setprio(0); } while (0)
#define PG8_WAIT_V(n) asm volatile("s_waitcnt vmcnt(" #n ")" ::: "memory")
#define PG8_WAIT_L(n) asm volatile("s_waitcnt lgkmcnt(" #n ")" ::: "memory")
#define PG8_BAR __builtin_amdgcn_s_barrier()
#define PG8_SCHED __builtin_amdgcn_sched_barrier(0)
    Unit cur, nxt; int ui = 0;
    if (!S.next(0, cur)) return;
    f32x4 acc[2][2][4][2];
#pragma unroll
    for (int a = 0; a < 2; ++a)
#pragma unroll
        for (int b = 0; b < 2; ++b)
#pragma unroll
            for (int m = 0; m < 4; ++m)
#pragma unroll
                for (int n = 0; n < 2; ++n) acc[a][b][m][n] = (f32x4){0.f, 0.f, 0.f, 0.f};
    bf16x8 At[4][2], B0[2][2], B1[2][2];
    const char* cA = (const char*)g.A + (size_t)cur.pm * tstep; const char* cB = (const char*)g.Bt + (size_t)cur.pn * tstep;
    S.a_ready(cur);
    if constexpr (SP2) {
        PG8_STAGE(PG8_SB(0, 0), cB, voffB); PG8_STAGE(PG8_SB(0, 1), cB + hstep, voffB); PG8_STAGE(PG8_SA(0, 0), cA, voffA); PG8_STAGE(PG8_SA(0, 1), cA + hstep, voffA);
        if (wr == 1) PG8_BAR;
        PG8_WAIT_V(2); PG8_BAR;
        PG8_STAGE(PG8_SB(1, 0), cB + kstep, voffB); PG8_STAGE(PG8_SA(1, 0), cA + kstep, voffA); PG8_STAGE(PG8_SB(1, 1), cB + hstep + kstep, voffB);
        PG8_WAIT_V(6); PG8_BAR;
    } else {
        PG8_STAGE(PG8_SB(0, 0), cB, voffB); PG8_STAGE(PG8_SA(0, 0), cA, voffA); PG8_STAGE(PG8_SB(0, 1), cB + hstep, voffB); PG8_STAGE(PG8_SA(0, 1), cA + hstep, voffA);
        if (wr == 1) PG8_BAR;
        PG8_WAIT_V(4); PG8_BAR;
        PG8_STAGE(PG8_SB(1, 0), cB + kstep, voffB); PG8_STAGE(PG8_SA(1, 0), cA + kstep, voffA); PG8_STAGE(PG8_SB(1, 1), cB + hstep + kstep, voffB);
        PG8_WAIT_V(6); PG8_BAR;
    }
    for (;;) {
        const bool has_next = S.next(ui + 1, nxt);
        const char* nA = has_next ? (const char*)g.A + (size_t)nxt.pm * tstep : cA; const char* nB = has_next ? (const char*)g.Bt + (size_t)nxt.pn * tstep : cB;
        for (int t = 0; t < nt; t += 2) {
            const bool last = (t == nt - 2);
            const char* a1 = cA + (size_t)(t + 1) * kstep;
            const char* a2 = last ? nA : cA + (size_t)(t + 2) * kstep; const char* b2 = last ? nB : cB + (size_t)(t + 2) * kstep;
            const char* a3 = a2 + kstep; const char* b3 = b2 + kstep;
            if (last && has_next) S.a_ready(nxt);
            if constexpr (SP2) {
            PG8_LDB(B0, 0, 0); PG8_LDB(B1, 0, 1); PG8_SCHED; PG8_LDA(At, 0, 0); PG8_STAGE(PG8_SA(1, 1), a1 + hstep, voffA);
            PG8_WAIT_V(8); PG8_WAIT_L(0); PG8_BAR; PG8_MMA(0, 0, At, B0); PG8_MMA(0, 1, At, B1); PG8_BAR; PG8_SCHED;
            PG8_LDA(At, 0, 1); PG8_STAGE(PG8_SB(0, 0), b2, voffB); PG8_STAGE(PG8_SB(0, 1), b2 + hstep, voffB); PG8_STAGE(PG8_SA(0, 0), a2, voffA);
            PG8_WAIT_V(8); PG8_WAIT_L(0); PG8_BAR; PG8_MMA(1, 0, At, B0); PG8_MMA(1, 1, At, B1); PG8_BAR; PG8_SCHED;
            PG8_LDB(B0, 1, 0); PG8_LDB(B1, 1, 1); PG8_SCHED; PG8_LDA(At, 1, 0); PG8_STAGE(PG8_SA(0, 1), a2 + hstep, voffA);
            PG8_WAIT_V(8); PG8_WAIT_L(0); PG8_BAR; PG8_MMA(0, 0, At, B0); PG8_MMA(0, 1, At, B1); PG8_BAR; PG8_SCHED;
            PG8_LDA(At, 1, 1); PG8_STAGE(PG8_SB(1, 0), b3, voffB); PG8_STAGE(PG8_SB(1, 1), b3 + hstep, voffB); PG8_STAGE(PG8_SA(1, 0), a3, voffA);
            PG8_WAIT_V(8); PG8_WAIT_L(0); PG8_BAR; PG8_MMA(1, 0, At, B0); PG8_MMA(1, 1, At, B1); PG8_BAR; PG8_SCHED;
            } else {
            PG8_LDB(B0, 0, 0); PG8_SCHED; PG8_LDA(At, 0, 0); PG8_STAGE(PG8_SA(1, 1), a1 + hstep, voffA);
            PG8_WAIT_L(8); PG8_BAR; PG8_WAIT_L(0); PG8_MMA(0, 0, At, B0); PG8_BAR; PG8_SCHED;
            PG8_LDB(B1, 0, 1); PG8_STAGE(PG8_SB(0, 0), b2, voffB);
            PG8_BAR; PG8_WAIT_L(0); PG8_MMA(0, 1, At, B1); PG8_BAR;
            PG8_LDA(At, 0, 1); PG8_STAGE(PG8_SA(0, 0), a2, voffA);
            PG8_BAR; PG8_WAIT_L(0); PG8_MMA(1, 0, At, B0); PG8_BAR; PG8_SCHED;
            PG8_STAGE(PG8_SB(0, 1), b2 + hstep, voffB);
            PG8_WAIT_V(6); PG8_BAR; PG8_MMA(1, 1, At, B1); PG8_BAR;
            PG8_LDB(B0, 1, 0); PG8_SCHED; PG8_LDA(At, 1, 0); PG8_STAGE(PG8_SA(0, 1), a2 + hstep, voffA);
            PG8_WAIT_L(8); PG8_BAR; PG8_WAIT_L(0); PG8_MMA(0, 0, At, B0); PG8_BAR; PG8_SCHED;
            PG8_LDB(B1, 1, 1); PG8_STAGE(PG8_SB(1, 0), b3, voffB);
            PG8_BAR; PG8_WAIT_L(0); PG8_MMA(0, 1, At, B1); PG8_BAR;
            PG8_LDA(At, 1, 1); PG8_STAGE(PG8_SA(1, 0), a3, voffA);
            PG8_BAR; PG8_WAIT_L(0); PG8_MMA(1, 0, At, B0); PG8_BAR; PG8_SCHED;
            PG8_STAGE(PG8_SB(1, 1), b3 + hstep, voffB);
            PG8_WAIT_V(6); PG8_BAR; PG8_MMA(1, 1, At, B1); PG8_BAR;
            }
        }
        if constexpr (ALIGN_EPI) { if (wr == 0) PG8_BAR; }
        if constexpr (!Epi::AFTER_DRAIN) { E(acc, cur, wr, wc, fr, fq); S.done(cur); }
        if (!has_next) break;
#pragma unroll
        for (int a = 0; a < 2; ++a)
#pragma unroll
            for (int b = 0; b < 2; ++b)
#pragma unroll
                for (int m = 0; m < 4; ++m)
#pragma unroll
                    for (int n = 0; n < 2; ++n) acc[a][b][m][n] = (f32x4){0.f, 0.f, 0.f, 0.f};
        cur = nxt; cA = nA; cB = nB; ++ui;
        if constexpr (ALIGN_EPI) { if (wr == 1) PG8_BAR; }
    }
    PG8_WAIT_V(0);
    if constexpr (!ALIGN_EPI) { if (wr == 0) PG8_BAR; }
    PG8_BAR;
    if constexpr (Epi::AFTER_DRAIN) { E.fused(acc, cur, wr, wc, fr, fq, lds, wid, lane); S.done(cur); }
#undef PG8_SA
#undef PG8_SB
#undef PG8_STAGE
#undef PG8_LDA
#undef PG8_LDB
#undef PG8_MMA
#undef PG8_WAIT_V
#undef PG8_WAIT_L
#undef PG8_BAR
#undef PG8_SCHED
}
}
#define MK_ONE_LAUNCH 1

constexpr int NB = 4, SEQ = 8192, T = NB * SEQ, D = 1024;
constexpr int NIN = 3584, DH = 512, HD = 128, NHH = 4, CHK = 64;
constexpr int NSEG = 16, SEGC = 8;
constexpr int CW = 31, CPAD = 15, DC = 512;
constexpr int PHEADS = 8, NQK = 2048, NSEL = 128;
constexpr float EPS = 1e-6f;
constexpr int NWAVES = 8, NTHR = 512;

constexpr size_t MiB = 1u << 20;
constexpr size_t WS_CTL = 0, CTL_ZERO_BYTES = 65536;
constexpr size_t WS_MOD = 1 * MiB, WS_FMOD = WS_MOD + 131072, WS_LB = WS_MOD + 196608, WS_BIASQ = WS_MOD + 262144;
constexpr size_t WS_WIN = 2 * MiB, WS_WOUT = 10 * MiB, WS_WQK = 12 * MiB;
constexpr size_t WS_UT = 16 * MiB, WS_VT = 48 * MiB;
constexpr size_t WS_BUFA = 80 * MiB;
constexpr size_t WS_BUFB = 144 * MiB;
constexpr size_t WS_SEG = 208 * MiB;
constexpr size_t WS_E = 208 * MiB, WS_W = 224 * MiB;
constexpr size_t WS_BIG = 240 * MiB;
constexpr size_t WS_SSQ = 496 * MiB;
constexpr size_t WS_SEGA = 498 * MiB;
constexpr size_t WS_RSTD = 499 * MiB;
constexpr size_t WS_END = 500 * MiB;
constexpr size_t WS_PACT = 240 * MiB;
constexpr size_t WS_Y = 368 * MiB;
constexpr int NSL = 8, CSL = 128;
constexpr float VSCALE = 16.0f;
constexpr float UQSCALE = 677.0f, HQSCALE = 16.0f;
constexpr int CW_QU = 8192, CW_QV = 8192 + 64 * 16;
constexpr int CW_BAR = 1024;

#ifndef LDSFILL
#define LDSFILL 0u
#endif
constexpr int LDS_BYTES = 155648;
constexpr int MISC_OFF = LDS_BYTES - 256;

#define GAS __attribute__((address_space(1)))
#define LAS __attribute__((address_space(3)))
typedef unsigned short bf16;
typedef unsigned v4u __attribute__((ext_vector_type(4)));
typedef unsigned v2u __attribute__((ext_vector_type(2)));
typedef float f32x4 __attribute__((ext_vector_type(4)));
typedef float f32x16 __attribute__((ext_vector_type(16)));
typedef short bf16x8 __attribute__((ext_vector_type(8)));
typedef float f32x2_ __attribute__((ext_vector_type(2)));

__device__ __forceinline__ float bf2f(unsigned h) { return __builtin_bit_cast(float, h << 16); }
__device__ __forceinline__ float bflo(unsigned u) { return __builtin_bit_cast(float, u << 16); }
__device__ __forceinline__ float bfhi(unsigned u) { return __builtin_bit_cast(float, u & 0xffff0000u); }
__device__ __forceinline__ unsigned f2bf(float f) { unsigned u = __builtin_bit_cast(unsigned, f); return (u + 0x7fffu + ((u >> 16) & 1u)) >> 16; }
__device__ __forceinline__ unsigned pk2(float lo, float hi) { return f2bf(lo) | (f2bf(hi) << 16); }
__device__ __forceinline__ unsigned cvtpk(float lo, float hi) { unsigned r; asm("v_cvt_pk_bf16_f32 %0, %1, %2" : "=v"(r) : "v"(lo), "v"(hi)); return r; }
__device__ __forceinline__ float sigmoidf_(float x) { return __builtin_amdgcn_rcpf(1.0f + __expf(-x)); }
#define DPP_ADD(s, ctrl) ((s) + __builtin_bit_cast(float, __builtin_amdgcn_update_dpp(0, __builtin_bit_cast(int, (s)), (ctrl), 0xF, 0xF, false)))
__device__ __forceinline__ float wave_sum(float v) {
#pragma unroll
    for (int o = 1; o < 64; o <<= 1) v += __shfl_xor(v, o);
    return v;
}

#define XB_TMO      128
#define XB_XCNT(j)  (256  + 64 * (j))
#define XB_XSUB(j)  (1280 + 64 * (j))
#define XB_XGEN(j)  (2304 + 64 * (j))
#define XB_TOP      3328
#define XB_TOPGEN   3392
#define XCD_BAR_WORDS 3456
#define XB_SPIN_CAP (1u << 18)
__device__ __forceinline__ unsigned xb_ld(unsigned* p)              { return __hip_atomic_load(p, __ATOMIC_RELAXED, __HIP_MEMORY_SCOPE_AGENT); }
__device__ __forceinline__ unsigned xb_add(unsigned* p, unsigned v) { return __hip_atomic_fetch_add(p, v, __ATOMIC_RELAXED, __HIP_MEMORY_SCOPE_AGENT); }
__device__ __forceinline__ unsigned xb_xcc_id() { return (unsigned)__builtin_amdgcn_s_getreg((3 << 11) | 20) & 0xFu; }
#define XB_SPIN(cond, bar) do { unsigned _sp = 0; while (cond) { __builtin_amdgcn_s_sleep(1); \
    if ((++_sp & 255u) == 0u) { if (xb_ld(&(bar)[XB_TMO])) break; if (_sp > XB_SPIN_CAP) { atomicAdd(&(bar)[XB_TMO], 1u); break; } } } } while (0)
struct XcdBarrier { unsigned* bar; unsigned x; volatile LAS unsigned* st; };
__device__ __forceinline__ XcdBarrier xcd_barrier_post(unsigned* bar, volatile LAS unsigned* st) {
    XcdBarrier b; b.bar = bar; b.x = xb_xcc_id(); b.st = st;
    if (threadIdx.x == 0) (void)xb_add(&bar[XB_XCNT(b.x)], 1u);
    return b;
}
__device__ __forceinline__ void xcd_barrier_complete(unsigned* bar, unsigned x, unsigned& nloc, unsigned& nx) {
    const unsigned G = gridDim.x * gridDim.y * gridDim.z;
    unsigned sum, cnt, mine, sp = 0u;
    for (;;) {
        sum = 0u; cnt = 0u; mine = 0u;
#pragma unroll
        for (unsigned j = 0; j < 16; ++j) { const unsigned c = xb_ld(&bar[XB_XCNT(j)]); sum += c; cnt += (c > 0u) ? 1u : 0u; mine = (j == x) ? c : mine; }
        if (sum == G) break;
        __builtin_amdgcn_s_sleep(1);
        if ((++sp & 255u) == 0u) { if (xb_ld(&bar[XB_TMO])) break; if (sp > XB_SPIN_CAP) { atomicAdd(&bar[XB_TMO], 1u); break; } }
    }
    nloc = mine > 0u ? mine : 1u; nx = cnt > 0u ? cnt : 1u;
}
__device__ __forceinline__ void xcd_barrier(const XcdBarrier& b) {
    asm volatile("s_waitcnt vmcnt(0)" ::: "memory");
    __syncthreads();
    if (threadIdx.x == 0) {
        unsigned* bar = b.bar;
        __builtin_amdgcn_s_waitcnt(0);
        unsigned nloc = b.st[0], nx = b.st[1];
        if (nloc == 0u) { xcd_barrier_complete(bar, b.x, nloc, nx); b.st[0] = nloc; b.st[1] = nx; }
        const unsigned old = xb_add(&bar[XB_XSUB(b.x)], 1u);
        const unsigned gen = old / nloc;
        if (old + 1u == (gen + 1u) * nloc) {
            __builtin_amdgcn_fence(__ATOMIC_RELEASE, "agent");
            asm volatile("s_waitcnt vmcnt(0)" ::: "memory");
            const unsigned og = xb_add(&bar[XB_TOP], 1u);
            const unsigned tg = og / nx;
            if (og + 1u == (tg + 1u) * nx) xb_add(&bar[XB_TOPGEN], 1u);
            else XB_SPIN(xb_ld(&bar[XB_TOPGEN]) == tg, bar);
            __builtin_amdgcn_fence(__ATOMIC_ACQUIRE, "agent");
            xb_add(&bar[XB_XGEN(b.x)], 1u);
            asm volatile("s_waitcnt vmcnt(0)" ::: "memory");
        } else {
            XB_SPIN(xb_ld(&bar[XB_XGEN(b.x)]) == gen, bar);
            __builtin_amdgcn_fence(__ATOMIC_ACQUIRE, "agent");
            asm volatile("s_waitcnt vmcnt(0)" ::: "memory");
        }
    }
    __syncthreads();
}

struct Args { const float* in[23]; float* out; unsigned char* ws; int ph_lo, ph_hi; };
struct Frame {
    LAS unsigned char* lds;
    int tid, lane, wave, G, bid;
    const Args* a;
    __device__ __forceinline__ const float* x() const { return a->in[0]; }
    __device__ __forceinline__ const float* c() const { return a->in[1]; }
    __device__ __forceinline__ const float* ada_w() const { return a->in[2]; }
    __device__ __forceinline__ const float* ada_b() const { return a->in[3]; }
    __device__ __forceinline__ const float* g_mix() const { return a->in[4]; }
    __device__ __forceinline__ const float* w_in() const { return a->in[5]; }
    __device__ __forceinline__ const float* lbg_f() const { return a->in[6]; }
    __device__ __forceinline__ const float* lbg_b() const { return a->in[7]; }
    __device__ __forceinline__ const float* hnorm_g() const { return a->in[8]; }
    __device__ __forceinline__ const float* conv_w() const { return a->in[9]; }
    __device__ __forceinline__ const float* conv_b() const { return a->in[10]; }
    __device__ __forceinline__ const float* cln_g() const { return a->in[11]; }
    __device__ __forceinline__ const float* cln_b() const { return a->in[12]; }
    __device__ __forceinline__ const float* w_out() const { return a->in[13]; }
    __device__ __forceinline__ const float* g_ffn() const { return a->in[14]; }
    __device__ __forceinline__ const float* wq() const { return a->in[15]; }
    __device__ __forceinline__ const float* keys1() const { return a->in[16]; }
    __device__ __forceinline__ const float* keys2() const { return a->in[17]; }
    __device__ __forceinline__ const float* utab() const { return a->in[18]; }
    __device__ __forceinline__ const float* vtab() const { return a->in[19]; }
    __device__ __forceinline__ const float* fada_w() const { return a->in[20]; }
    __device__ __forceinline__ const float* fada_b() const { return a->in[21]; }
    __device__ __forceinline__ const float* fnorm_g() const { return a->in[22]; }
    __device__ __forceinline__ float* out() const { return a->out; }
    __device__ __forceinline__ float* mod() const { return (float*)(a->ws + WS_MOD); }
    __device__ __forceinline__ float* fmod() const { return (float*)(a->ws + WS_FMOD); }
    __device__ __forceinline__ float* lb() const { return (float*)(a->ws + WS_LB); }
    __device__ __forceinline__ float* biasq() const { return (float*)(a->ws + WS_BIASQ); }
    __device__ __forceinline__ float* ssqp() const { return (float*)(a->ws + WS_SSQ); }
    __device__ __forceinline__ float* sega() const { return (float*)(a->ws + WS_SEGA); }
    __device__ __forceinline__ float* segu() const { return (float*)(a->ws + WS_SEG); }
    __device__ __forceinline__ float* of() const { return (float*)(a->ws + WS_BUFB); }
    __device__ __forceinline__ float* scores() const { return (float*)(a->ws + WS_BIG); }
    __device__ __forceinline__ float* wsel() const { return (float*)(a->ws + WS_W); }
    __device__ __forceinline__ int* esel() const { return (int*)(a->ws + WS_E); }
    __device__ __forceinline__ bf16* Win_t() const { return (bf16*)(a->ws + WS_WIN); }
    __device__ __forceinline__ bf16* Wout_t() const { return (bf16*)(a->ws + WS_WOUT); }
    __device__ __forceinline__ bf16* Wqk_t() const { return (bf16*)(a->ws + WS_WQK); }
    __device__ __forceinline__ bf16* Ub() const { return (bf16*)(a->ws + WS_UT); }
    __device__ __forceinline__ bf16* Vb() const { return (bf16*)(a->ws + WS_VT); }
    __device__ __forceinline__ bf16* bufA() const { return (bf16*)(a->ws + WS_BUFA); }
    __device__ __forceinline__ bf16* hg() const { return (bf16*)(a->ws + WS_BUFB); }
    __device__ __forceinline__ bf16* proj() const { return (bf16*)(a->ws + WS_BIG); }
    __device__ __forceinline__ float* coef() const { return (float*)(a->ws + WS_BUFA); }
    __device__ __forceinline__ float* rstd() const { return (float*)(a->ws + WS_RSTD); }
    __device__ __forceinline__ bf16* pact() const { return (bf16*)(a->ws + WS_PACT); }
    __device__ __forceinline__ bf16* ybuf() const { return (bf16*)(a->ws + WS_Y); }
    __device__ __forceinline__ unsigned char* U8() const { return (unsigned char*)(a->ws + WS_UT); }
    __device__ __forceinline__ unsigned char* V8() const { return (unsigned char*)(a->ws + WS_VT); }
    __device__ __forceinline__ unsigned* ctl() const { return (unsigned*)(a->ws + WS_CTL); }
};

__device__ __forceinline__ void p0_gemv(Frame& F) {
    LAS float* cact = (LAS float*)(F.lds);
    LAS float* red = (LAS float*)(F.lds + 16384);
    for (int i = F.tid; i < 4096; i += NTHR) { const float c = F.c()[i]; cact[i] = c * sigmoidf_(c); }
    __syncthreads();
    for (int item = F.bid; item < 128; item += F.G) {
        const int col0 = item * 64; const float* W; int N, cc;
        if (col0 < 6144) { W = F.ada_w(); N = 6144; cc = col0; } else { W = F.fada_w(); N = 2048; cc = col0 - 6144; }
        const float* wp = W + (size_t)(F.wave * 128) * N + cc + F.lane;
        float a0 = 0.f, a1 = 0.f, a2 = 0.f, a3 = 0.f;
#pragma unroll 32
        for (int k = 0; k < 128; ++k) { const float w = wp[(size_t)k * N]; const int kk = F.wave * 128 + k;
            a0 += cact[kk] * w; a1 += cact[1024 + kk] * w; a2 += cact[2048 + kk] * w; a3 += cact[3072 + kk] * w; }
        red[(F.wave * 4 + 0) * 64 + F.lane] = a0; red[(F.wave * 4 + 1) * 64 + F.lane] = a1; red[(F.wave * 4 + 2) * 64 + F.lane] = a2; red[(F.wave * 4 + 3) * 64 + F.lane] = a3;
        __syncthreads();
        if (F.tid < 256) { const int b = F.tid >> 6, l = F.tid & 63; float s = 0.f;
#pragma unroll
            for (int w = 0; w < 8; ++w) s += red[(w * 4 + b) * 64 + l];
            if (col0 < 6144) F.mod()[b * 6144 + cc + l] = s + F.ada_b()[cc + l]; else F.fmod()[b * 2048 + cc + l] = s + F.fada_b()[cc + l]; }
        __syncthreads();
    }
}
__device__ __forceinline__ void p0_transpose_item(const float* W, int K, int N, bf16* WT, LAS float* scr, int item, int lane) {
    const int nblk = N / 32, kb = item / nblk, nb = item % nblk, k0 = 64 * kb, n0 = 32 * nb;
#pragma unroll 8
    for (int i = 0; i < 32; ++i) { const int kk = 2 * i + (lane >> 5); scr[kk * 33 + (lane & 31)] = W[(size_t)(k0 + kk) * N + n0 + (lane & 31)]; }
    asm volatile("s_waitcnt lgkmcnt(0)" ::: "memory");
    const int c = lane & 7;
#pragma unroll
    for (int j = 0; j < 4; ++j) { const int n = (lane >> 3) + 8 * j; const LAS float* s = scr + (8 * c) * 33 + n;
        v4u o; o.x = pk2(s[0 * 33], s[1 * 33]); o.y = pk2(s[2 * 33], s[3 * 33]); o.z = pk2(s[4 * 33], s[5 * 33]); o.w = pk2(s[6 * 33], s[7 * 33]);
        *(v4u*)(WT + (size_t)(n0 + n) * K + k0 + 8 * c) = o; }
    asm volatile("s_waitcnt lgkmcnt(0)" ::: "memory");
}
__device__ __forceinline__ void p0_wqk_item(Frame& F, int item) {
    const int jq = item & 7, kb = (item >> 3) & 15, hh = item >> 7, h = hh >> 1, half = hh & 1;
    const float* keys = (half ? F.keys2() : F.keys1()) + (size_t)(jq * 16) * 128;
    const int k = kb * 64 + F.lane;
    const float* wrow = F.wq() + (size_t)k * 2048 + h * 256 + half * 128;
    float acc[16];
#pragma unroll
    for (int j = 0; j < 16; ++j) acc[j] = 0.f;
#pragma unroll 4
    for (int d = 0; d < 128; d += 4) {
        const f32x4 a = *(const f32x4*)(wrow + d);
#pragma unroll
        for (int j = 0; j < 16; ++j) { const float* kp = keys + j * 128 + d; acc[j] += a[0] * kp[0] + a[1] * kp[1] + a[2] * kp[2] + a[3] * kp[3]; }
    }
    bf16* o = F.Wqk_t() + (size_t)(h * 256 + half * 128 + jq * 16) * 1024 + k;
#pragma unroll
    for (int j = 0; j < 16; ++j) o[(size_t)j * 1024] = (bf16)f2bf(acc[j]);
}
__device__ __forceinline__ void p0_prologue(Frame& F) {
    if (F.bid < 128) p0_gemv(F);
    if (F.bid == 128 % F.G) { const int i = F.tid;
        F.lb()[i] = __builtin_amdgcn_rcpf(1.0f + __expf(F.lbg_f()[512 + i] - F.lbg_f()[i]));
        F.lb()[512 + i] = __builtin_amdgcn_rcpf(1.0f + __expf(F.lbg_b()[512 + i] - F.lbg_b()[i])); }
    LAS float* scr = (LAS float*)(F.lds + 32768 + F.wave * 8704);
    const int gw = F.wave * F.G + F.bid, NGW = F.G * NWAVES;
    constexpr int I_QK = 2048, I_IN = (D / 64) * (NIN / 32), I_OUT = (D / 64) * (D / 32), I_TAB = 2 * 16384 / 4;
    constexpr int NITEMS = I_QK + I_IN + I_OUT + I_TAB;
    for (int it = gw; it < NITEMS; it += NGW) {
        int r = it;
        if (r < I_QK) { p0_wqk_item(F, r); continue; } r -= I_QK;
        if (r < I_IN) { p0_transpose_item(F.w_in(), D, NIN, F.Win_t(), scr, r, F.lane); continue; } r -= I_IN;
        if (r < I_OUT) { p0_transpose_item(F.w_out(), D, D, F.Wout_t(), scr, r, F.lane); continue; } r -= I_OUT;
        { const int tab = r >= 4096, rr = (tab ? r - 4096 : r) * 4; const float* src = (tab ? F.vtab() : F.utab()) + (size_t)rr * 1024; unsigned char* dst = tab ? F.V8() : F.U8();
          const float sc = tab ? VSCALE : UQSCALE;
#pragma unroll
          for (int q = 0; q < 16; ++q) { const int row = rr + (q >> 2), qq = q & 3; const f32x4 v = *(const f32x4*)(src + (q >> 2) * 1024 + qq * 256 + 4 * F.lane) * sc;
              int pk;
              if (tab) { pk = __builtin_amdgcn_cvt_pk_fp8_f32(v[0], v[1], 0, false); pk = __builtin_amdgcn_cvt_pk_fp8_f32(v[2], v[3], pk, true); }
              else { int q0 = (int)__builtin_rintf(v[0]), q1 = (int)__builtin_rintf(v[1]), q2 = (int)__builtin_rintf(v[2]), q3 = (int)__builtin_rintf(v[3]);
                  q0 = q0 < -127 ? -127 : (q0 > 127 ? 127 : q0); q1 = q1 < -127 ? -127 : (q1 > 127 ? 127 : q1); q2 = q2 < -127 ? -127 : (q2 > 127 ? 127 : q2); q3 = q3 < -127 ? -127 : (q3 > 127 ? 127 : q3);
                  pk = (q0 & 0xff) | ((q1 & 0xff) << 8) | ((q2 & 0xff) << 16) | (q3 << 24); }
              const int sl = 2 * qq + (F.lane >> 5);
              *(int*)(dst + ((size_t)sl * 16384 + row) * CSL + 4 * (F.lane & 31)) = pk; } }
    }
}

__device__ __forceinline__ void p1_norm(Frame& F) {
    const int gwc = F.bid * NWAVES + F.wave, NGW = F.G * NWAVES;
    for (int row0 = gwc * 16; row0 < T; row0 += NGW * 16) {
        const int b = row0 >> 13; const float* mb = F.mod() + b * 6144;
        f32x4 ca[4], cb[4];
#pragma unroll
        for (int j = 0; j < 4; ++j) { const int k = 256 * j + 4 * F.lane; const f32x4 g = *(const f32x4*)(F.g_mix() + k), s = *(const f32x4*)(mb + 1024 + k); ca[j] = g * (s + 1.0f); cb[j] = *(const f32x4*)(mb + k); }
#pragma unroll 4
        for (int r = 0; r < 16; ++r) { const float* xr = F.x() + (size_t)(row0 + r) * D;
            f32x4 v[4]; float ss = 0.f;
#pragma unroll
            for (int j = 0; j < 4; ++j) { v[j] = *(const f32x4*)(xr + 256 * j + 4 * F.lane); ss += v[j][0] * v[j][0] + v[j][1] * v[j][1] + v[j][2] * v[j][2] + v[j][3] * v[j][3]; }
            const float rstd = __builtin_amdgcn_rsqf(wave_sum(ss) * (1.0f / D) + EPS);
            bf16* o = F.bufA() + (size_t)(row0 + r) * D;
#pragma unroll
            for (int j = 0; j < 4; ++j) { const f32x4 y = v[j] * rstd * ca[j] + cb[j]; v2u w; w.x = pk2(y[0], y[1]); w.y = pk2(y[2], y[3]); *(v2u*)(o + 256 * j + 4 * F.lane) = w; } }
    }
    const int gw = F.wave * F.G + F.bid;
    for (int n0 = gw * 32; n0 < NQK; n0 += NGW * 32) {
        float sv[4][16];
#pragma unroll
        for (int b = 0; b < 4; ++b) { const float* sh2 = F.mod() + b * 6144 + 3072;
#pragma unroll
            for (int i = 0; i < 8; ++i) { sv[b][i] = sh2[8 * F.lane + i]; sv[b][8 + i] = sh2[512 + 8 * F.lane + i]; } }
        float res[4] = {0.f, 0.f, 0.f, 0.f};
        for (int q = 0; q < 32; ++q) { const int n = n0 + q;
            const v4u w0 = *(const v4u*)(F.Wqk_t() + (size_t)n * 1024 + 8 * F.lane), w1 = *(const v4u*)(F.Wqk_t() + (size_t)n * 1024 + 512 + 8 * F.lane);
            float wv[16];
#pragma unroll
            for (int i = 0; i < 4; ++i) { wv[2 * i] = bflo(w0[i]); wv[2 * i + 1] = bfhi(w0[i]); wv[8 + 2 * i] = bflo(w1[i]); wv[8 + 2 * i + 1] = bfhi(w1[i]); }
#pragma unroll
            for (int b = 0; b < 4; ++b) { float sm = 0.f;
#pragma unroll
                for (int i = 0; i < 16; ++i) sm += wv[i] * sv[b][i];
                sm = wave_sum(sm); if (F.lane == q) res[b] = sm; } }
        if (F.lane < 32) {
#pragma unroll
            for (int b = 0; b < 4; ++b) F.biasq()[b * 2048 + n0 + F.lane] = res[b]; }
    }
}

__device__ __forceinline__ void conv_item(Frame& F, int item, const float (&cw)[CW], float cbias) {
    LAS bf16* hbuf = (LAS bf16*)(F.lds);
    LAS float* ybuf = (LAS float*)(F.lds + 65536);
    const int tok0 = item * 32, b = tok0 >> 13, t0 = tok0 & (SEQ - 1), c = F.tid;
#pragma unroll
    for (int k = 0; k < 8; ++k) { const int pi = F.tid + NTHR * k; if (pi < 62 * 64) { const int r = pi >> 6, ch = pi & 63, t = t0 - CPAD + r; v4u o = {0u, 0u, 0u, 0u};
            if (t >= 0 && t < SEQ) { const bf16* pr = F.proj() + (size_t)(b * SEQ + t) * NIN + 8 * ch; const v4u a = *(const v4u*)(pr + 2560), g = *(const v4u*)(pr + 3072);
#pragma unroll
                for (int i = 0; i < 4; ++i) o[i] = cvtpk(bflo(a[i]) * bflo(g[i]), bfhi(a[i]) * bfhi(g[i])); }
            *(LAS v4u*)(hbuf + r * 512 + 8 * ch) = o; } }
    __syncthreads();
    float hv[62];
#pragma unroll
    for (int r = 0; r < 62; ++r) hv[r] = bf2f(hbuf[r * 512 + c]);
#pragma unroll
    for (int tt = 0; tt < 32; ++tt) { float acc = cbias;
#pragma unroll
        for (int j = 0; j < CW; ++j) acc += cw[j] * hv[tt + j];
        ybuf[tt * 512 + c] = acc; }
    __syncthreads();
#pragma unroll
    for (int q = 0; q < 4; ++q) { const int tt = F.wave * 4 + q;
        const f32x4 y0 = *(LAS const f32x4*)(ybuf + tt * 512 + 8 * F.lane), y1 = *(LAS const f32x4*)(ybuf + tt * 512 + 8 * F.lane + 4);
        const float mean = wave_sum((y0[0] + y0[1] + y0[2] + y0[3]) + (y1[0] + y1[1] + y1[2] + y1[3])) * (1.0f / DC);
        const f32x4 d0 = y0 - mean, d1 = y1 - mean;
        const float var = wave_sum((d0[0] * d0[0] + d0[1] * d0[1] + d0[2] * d0[2] + d0[3] * d0[3]) + (d1[0] * d1[0] + d1[1] * d1[1] + d1[2] * d1[2] + d1[3] * d1[3])) * (1.0f / DC);
        const float rstd = __builtin_amdgcn_rsqf(var + EPS);
        const f32x4 g0 = *(const f32x4*)(F.cln_g() + 8 * F.lane), g1 = *(const f32x4*)(F.cln_g() + 8 * F.lane + 4), b0 = *(const f32x4*)(F.cln_b() + 8 * F.lane), b1 = *(const f32x4*)(F.cln_b() + 8 * F.lane + 4);
        f32x4 z0 = d0 * rstd * g0 + b0, z1 = d1 * rstd * g1 + b1;
#pragma unroll
        for (int i = 0; i < 4; ++i) { z0[i] = z0[i] * sigmoidf_(z0[i]); z1[i] = z1[i] * sigmoidf_(z1[i]); }
        v4u w; w.x = cvtpk(z0[0], z0[1]); w.y = cvtpk(z0[2], z0[3]); w.z = cvtpk(z1[0], z1[1]); w.w = cvtpk(z1[2], z1[3]);
        *(v4u*)(F.bufA() + (size_t)(tok0 + tt) * D + 512 + 8 * F.lane) = w; }
    __syncthreads();
}

constexpr int PQ = 272, PT = 144;
constexpr int HL_QR = 0, HL_KR = 17408, HL_QE = 34816, HL_KET = 52224, HL_VT = 70656, HL_SCM = 89088, HL_ST = 98304, HL_PBLK = 133120  , HL_AV = 137216, HL_RS = 137728;
static_assert(HL_PBLK + 8 * 128 * 4 <= HL_AV && HL_AV + 512 <= HL_RS && HL_RS + 1024 <= 155648 - 256, "HGRN LDS map");
__device__ __forceinline__ bf16x8 ldf(LAS const unsigned char* base, int row, int pitch, int kbyte) { return *(LAS const bf16x8*)(base + row * pitch + kbyte); }
#define MFMA32(a, b, c) __builtin_amdgcn_mfma_f32_32x32x16_bf16((a), (b), (c), 0, 0, 0)

template <bool FULL>
__device__ __forceinline__ void hgrn_load(Frame& F, int b, int h, int dir, int chunk, unsigned (&rz)[8], unsigned (&rv)[8], unsigned (&rq)[8]) {
    const size_t tokbase = (size_t)b * SEQ + (size_t)chunk * CHK; const int zoff = dir ? 1024 : 512, c0 = 2 * F.lane;
#pragma unroll
    for (int i = 0; i < 8; ++i) { const int p = 8 * F.wave + i, tr = dir ? (63 - p) : p; const bf16* q = F.proj() + (tokbase + tr) * NIN + h * HD;
        rz[i] = *(const unsigned*)(q + zoff + c0); rv[i] = *(const unsigned*)(q + 1536 + c0); if (FULL) rq[i] = *(const unsigned*)(q + c0); }
}
template <bool FULL, int MODE>
__device__ __forceinline__ void hgrn_chunk(Frame& F, int b, int h, int dir, int chunk, int nchunk, f32x16 (&accS)[2], float lb0, float lb1, unsigned (&rz)[8], unsigned (&rv)[8], unsigned (&rq)[8]) {
    LAS unsigned char* lds = F.lds;
    int r = F.lane & 31, hh = F.lane >> 5, c0 = 2 * F.lane;
    asm volatile("" : "+v"(r), "+v"(hh), "+v"(c0));
    const int w = F.wave, rb = w;
    const size_t tokbase = (size_t)b * SEQ + (size_t)chunk * CHK;
    {
        const f32x2_ oml = {1.0f - lb0, 1.0f - lb1};
        f32x2_ f2[8], cf2[8], cr2[8];
        f32x2_ run = {1.f, 1.f};
#pragma unroll
        for (int i = 0; i < 8; ++i) { const f32x2_ kk = {bflo(rz[i]), bfhi(rz[i])}; f2[i] = 1.0f - oml * kk; run *= f2[i]; cf2[i] = run; }
        { f32x2_ q = {1.f, 1.f};
#pragma unroll
          for (int i = 7; i >= 0; --i) { cr2[i] = q; q *= f2[i]; } }
        LAS float* pblk = (LAS float*)(lds + HL_PBLK);
        *(LAS f32x2_*)(pblk + rb * 128 + c0) = run;
        __syncthreads();
        f32x2_ pre = {1.f, 1.f}, post = {1.f, 1.f}, mid = {1.f, 1.f};
        for (int q = 0; q < rb; ++q) pre *= *(LAS const f32x2_*)(pblk + q * 128 + c0);
        for (int q = rb + 1; q < 8; ++q) post *= *(LAS const f32x2_*)(pblk + q * 128 + c0);
        if (rb < 4) { for (int q = rb + 1; q < 4; ++q) mid *= *(LAS const f32x2_*)(pblk + q * 128 + c0); }
        else { for (int q = 4; q < rb; ++q) mid *= *(LAS const f32x2_*)(pblk + q * 128 + c0); }
        if (rb == 0) *(LAS f32x2_*)((LAS float*)(lds + HL_AV) + c0) = run * post;
        f32x2_ ke2[8];
#pragma unroll
        for (int i = 0; i < 8; ++i) ke2[i] = (1.0f - f2[i]) * cr2[i] * post;
        if (FULL) {
            if (rb < 4) {
#pragma unroll
                for (int i = 0; i < 8; ++i) { const int p = 8 * rb + i; const f32x2_ qs = {bflo(rq[i]), bfhi(rq[i])}, k2 = 1.0f - f2[i], G = cr2[i] * mid;
                    f32x2_ iG; iG[0] = __builtin_amdgcn_rcpf(G[0]); iG[1] = __builtin_amdgcn_rcpf(G[1]);
                    const f32x2_ qe = qs * pre * cf2[i], qr = qs * iG, kr = k2 * G;
                    *(LAS unsigned*)(lds + HL_QE + p * PQ + c0 * 2) = cvtpk(qe[0], qe[1]);
                    *(LAS unsigned*)(lds + HL_QR + p * PQ + c0 * 2) = cvtpk(qr[0], qr[1]);
                    *(LAS unsigned*)(lds + HL_KR + p * PQ + c0 * 2) = cvtpk(kr[0], kr[1]); }
            } else {
#pragma unroll
                for (int i = 0; i < 8; ++i) { const int p = 8 * rb + i; const f32x2_ qs = {bflo(rq[i]), bfhi(rq[i])}, k2 = 1.0f - f2[i], G = cf2[i] * mid;
                    f32x2_ iG; iG[0] = __builtin_amdgcn_rcpf(G[0]); iG[1] = __builtin_amdgcn_rcpf(G[1]);
                    const f32x2_ qe = qs * pre * cf2[i], qr = qs * G, kr = k2 * iG;
                    *(LAS unsigned*)(lds + HL_QE + p * PQ + c0 * 2) = cvtpk(qe[0], qe[1]);
                    *(LAS unsigned*)(lds + HL_QR + p * PQ + c0 * 2) = cvtpk(qr[0], qr[1]);
                    *(LAS unsigned*)(lds + HL_KR + p * PQ + c0 * 2) = cvtpk(kr[0], kr[1]); }
            }
        }
        v4u ka, kb, va, vb2;
        ka.x = cvtpk(ke2[0][0], ke2[1][0]); ka.y = cvtpk(ke2[2][0], ke2[3][0]); ka.z = cvtpk(ke2[4][0], ke2[5][0]); ka.w = cvtpk(ke2[6][0], ke2[7][0]);
        kb.x = cvtpk(ke2[0][1], ke2[1][1]); kb.y = cvtpk(ke2[2][1], ke2[3][1]); kb.z = cvtpk(ke2[4][1], ke2[5][1]); kb.w = cvtpk(ke2[6][1], ke2[7][1]);
        va.x = (rv[0] & 0xffffu) | (rv[1] << 16); va.y = (rv[2] & 0xffffu) | (rv[3] << 16); va.z = (rv[4] & 0xffffu) | (rv[5] << 16); va.w = (rv[6] & 0xffffu) | (rv[7] << 16);
        vb2.x = (rv[0] >> 16) | (rv[1] & 0xffff0000u); vb2.y = (rv[2] >> 16) | (rv[3] & 0xffff0000u); vb2.z = (rv[4] >> 16) | (rv[5] & 0xffff0000u); vb2.w = (rv[6] >> 16) | (rv[7] & 0xffff0000u);
        *(LAS v4u*)(lds + HL_KET + c0 * PT + 16 * rb) = ka; *(LAS v4u*)(lds + HL_KET + (c0 + 1) * PT + 16 * rb) = kb;
        *(LAS v4u*)(lds + HL_VT + c0 * PT + 16 * rb) = va; *(LAS v4u*)(lds + HL_VT + (c0 + 1) * PT + 16 * rb) = vb2;
    }
    if (nchunk >= 0) hgrn_load<FULL>(F, b, h, dir, nchunk, rz, rv, rq);
    __syncthreads();
    const int pbO = w & 1, vb = w >> 1;
    f32x16 accO, accU[2];
#pragma unroll
    for (int i = 0; i < 16; ++i) { accO[i] = 0.f; accU[0][i] = 0.f; accU[1][i] = 0.f; }
    if (FULL) {
        if (w < 3) { const int pbS = (w + 1) >> 1, sbS = (w == 2) ? 1 : 0; f32x16 sc;
#pragma unroll
            for (int i = 0; i < 16; ++i) sc[i] = 0.f;
#pragma unroll
            for (int s = 0; s < 8; ++s) sc = MFMA32(ldf(lds + HL_QR, pbS * 32 + r, PQ, 32 * s + 16 * hh), ldf(lds + HL_KR, sbS * 32 + r, PQ, 32 * s + 16 * hh), sc);
#pragma unroll
            for (int i = 0; i < 16; i += 2) { const int p = pbS * 32 + (i & 3) + 8 * (i >> 2) + 4 * hh, s = sbS * 32 + r;
                const unsigned pkd = cvtpk(s <= p ? sc[i] : 0.f, s <= p + 1 ? sc[i + 1] : 0.f);
                *(LAS bf16*)(lds + HL_SCM + p * PT + s * 2) = (bf16)pkd; *(LAS bf16*)(lds + HL_SCM + (p + 1) * PT + s * 2) = (bf16)(pkd >> 16); } }
        __builtin_amdgcn_sched_barrier(0);
#pragma unroll
        for (int s = 0; s < 8; ++s) accO = MFMA32(ldf(lds + HL_QE, pbO * 32 + r, PQ, 32 * s + 16 * hh), ldf(lds + HL_ST, vb * 32 + r, PQ, 32 * s + 16 * hh), accO);
        __builtin_amdgcn_sched_barrier(0);
    }
#pragma unroll
    for (int i = 0; i < 2; ++i) { const int db = 2 * (w & 1) + i;
#pragma unroll
        for (int s = 0; s < 4; ++s) accU[i] = MFMA32(ldf(lds + HL_VT, vb * 32 + r, PT, 32 * s + 16 * hh), ldf(lds + HL_KET, db * 32 + r, PT, 32 * s + 16 * hh), accU[i]); }
    __builtin_amdgcn_sched_barrier(0);
    if (FULL) __syncthreads();
    if (FULL) {
        const unsigned v = vb * 32 + r;
        const unsigned lrow = (MODE == 0 ? (unsigned)hh : (unsigned)(1 - hh)) * 4u;
        const size_t rbase = (MODE == 0) ? (tokbase + pbO * 32) : (tokbase + 63 - pbO * 32 - 4);
        const unsigned lo_of = lrow * DH + v, lo_pr = lrow * NIN + v, lo_a2 = lrow * D + v;
        float ofv[16]; unsigned gv[16];
        if (MODE == 1) {
#pragma unroll
            for (int i = 0; i < 16; ++i) { const int ci = (i & 3) + 8 * (i >> 2); ofv[i] = (F.of() + (rbase - ci) * DH + h * HD)[lo_of]; } }
        for (int sb = 0; sb <= pbO; ++sb)
#pragma unroll
            for (int s2 = 0; s2 < 2; ++s2) accO = MFMA32(ldf(lds + HL_SCM, pbO * 32 + r, PT, 64 * sb + 32 * s2 + 16 * hh), ldf(lds + HL_VT, vb * 32 + r, PT, 64 * sb + 32 * s2 + 16 * hh), accO);
        if (MODE == 0) {
#pragma unroll
            for (int i = 0; i < 16; ++i) { const int ci = (i & 3) + 8 * (i >> 2); (F.of() + (rbase + ci) * DH + h * HD)[lo_of] = accO[i]; }
        } else {
            LAS float* rs = (LAS float*)(lds + HL_RS);
#pragma unroll
            for (int i = 0; i < 16; ++i) { const int ci = (i & 3) + 8 * (i >> 2); gv[i] = (F.proj() + (rbase - ci) * NIN + 2048 + h * HD)[lo_pr]; }
            float ov[16];
#pragma unroll
            for (int i = 0; i < 16; ++i) { const int ci = (i & 3) + 8 * (i >> 2), p = pbO * 32 + ci + 4 * hh;
                ov[i] = accO[i] + ofv[i]; float ss = ov[i] * ov[i];
                ss = DPP_ADD(ss, 0x128); ss = DPP_ADD(ss, 0x124); ss = DPP_ADD(ss, 0x122); ss = DPP_ADD(ss, 0x121); ss += __shfl_xor(ss, 16);
                if (r == 0) rs[p * 4 + vb] = ss; }
            __syncthreads();
            const float ng = F.hnorm_g()[h * HD + v];
#pragma unroll
            for (int i = 0; i < 16; ++i) { const int ci = (i & 3) + 8 * (i >> 2), p = pbO * 32 + ci + 4 * hh;
                const f32x4 q = *(LAS const f32x4*)(rs + p * 4);
                const float rstd = __builtin_amdgcn_rsqf((q[0] + q[1] + q[2] + q[3]) * (1.0f / HD) + EPS);
                const float g = bf2f(gv[i]);
                (F.bufA() + (rbase - ci) * D + h * HD)[lo_a2] = (bf16)cvtpk(ov[i] * rstd * ng * g, 0.f); }
        }
    }
    {
        const LAS float* av = (const LAS float*)(lds + HL_AV);
#pragma unroll
        for (int i = 0; i < 2; ++i) { const int db = 2 * (w & 1) + i; const float a = av[db * 32 + r];
#pragma unroll
            for (int j = 0; j < 16; j += 2) { const float s0 = accS[i][j] * a + accU[i][j], s1 = accS[i][j + 1] * a + accU[i][j + 1]; accS[i][j] = s0; accS[i][j + 1] = s1;
                if (FULL) { const int vv = vb * 32 + (j & 3) + 8 * (j >> 2) + 4 * hh; const unsigned pkd = cvtpk(s0, s1);
                    *(LAS bf16*)(lds + HL_ST + vv * PQ + (db * 32 + r) * 2) = (bf16)pkd; *(LAS bf16*)(lds + HL_ST + (vv + 1) * PQ + (db * 32 + r) * 2) = (bf16)(pkd >> 16); } } }
    }
    __syncthreads();
}
__device__ __forceinline__ void h1_item(Frame& F, int item) {
    const int seg = item & 15, dir = (item >> 4) & 1, h = (item >> 5) & 3, b = item >> 7;
    const float lb0 = F.lb()[dir * 512 + h * HD + 2 * F.lane], lb1 = F.lb()[dir * 512 + h * HD + 2 * F.lane + 1];
    f32x16 accS[2];
#pragma unroll
    for (int i = 0; i < 16; ++i) { accS[0][i] = 0.f; accS[1][i] = 0.f; }
    float atot = 1.f; const int col = F.tid & 127;
    unsigned rzA[8], rvA[8], rzB[8], rvB[8], rq[8];
#define H1CH(c) (seg * SEGC + (dir ? (SEGC - 1 - (c)) : (c)))
    hgrn_load<false>(F, b, h, dir, H1CH(0), rzA, rvA, rq); hgrn_load<false>(F, b, h, dir, H1CH(1), rzB, rvB, rq);
    for (int c = 0; c < SEGC; c += 2) {
        hgrn_chunk<false, 0>(F, b, h, dir, H1CH(c), (c + 2 < SEGC) ? H1CH(c + 2) : -1, accS, lb0, lb1, rzA, rvA, rq);
        atot *= ((const LAS float*)(F.lds + HL_AV))[col];
        hgrn_chunk<false, 0>(F, b, h, dir, H1CH(c + 1), (c + 3 < SEGC) ? H1CH(c + 3) : -1, accS, lb0, lb1, rzB, rvB, rq);
        atot *= ((const LAS float*)(F.lds + HL_AV))[col]; }
#undef H1CH
    if (F.tid < 128) F.sega()[(size_t)item * 128 + col] = atot;
    float* U = F.segu() + (size_t)item * 16384;
#pragma unroll
    for (int i = 0; i < 2; ++i)
#pragma unroll
        for (int j = 0; j < 16; j += 4) { f32x4 o; o[0] = accS[i][j]; o[1] = accS[i][j + 1]; o[2] = accS[i][j + 2]; o[3] = accS[i][j + 3]; ((f32x4*)(U + (i * 4 + (j >> 2)) * NTHR * 4))[F.tid] = o; }
}
__device__ __forceinline__ void h2_init_state(Frame& F, int b, int h, int dir, int seg, f32x16 (&accS)[2]) {
    const int w = F.wave, r = F.lane & 31, hh = F.lane >> 5, vb = w >> 1;
#pragma unroll
    for (int i = 0; i < 16; ++i) { accS[0][i] = 0.f; accS[1][i] = 0.f; }
    const int base = ((b * 4 + h) * 2 + dir) * 16;
    const int n = dir ? (NSEG - 1 - seg) : seg;
    for (int q = 0; q < n; ++q) { const int s = dir ? (NSEG - 1 - q) : q;
        const float* U = F.segu() + (size_t)(base + s) * 16384; const float* A = F.sega() + (size_t)(base + s) * 128;
#pragma unroll
        for (int i = 0; i < 2; ++i) { const int db = 2 * (w & 1) + i; const float a = (A + db * 32)[r];
#pragma unroll
            for (int j = 0; j < 16; j += 4) { const f32x4 u4 = ((const f32x4*)(U + (i * 4 + (j >> 2)) * NTHR * 4))[F.tid];
                accS[i][j] = accS[i][j] * a + u4[0]; accS[i][j + 1] = accS[i][j + 1] * a + u4[1]; accS[i][j + 2] = accS[i][j + 2] * a + u4[2]; accS[i][j + 3] = accS[i][j + 3] * a + u4[3]; } } }
#pragma unroll
    for (int i = 0; i < 2; ++i) { const int db = 2 * (w & 1) + i;
#pragma unroll
        for (int j = 0; j < 16; ++j) { const int vv = vb * 32 + (j & 3) + 8 * (j >> 2) + 4 * hh; *(LAS bf16*)(F.lds + HL_ST + vv * PQ + (db * 32 + r) * 2) = (bf16)f2bf(accS[i][j]); } }
    __syncthreads();
}
__device__ __forceinline__ void h2_item(Frame& F, int item) {
    const int seg = item & 15, h = (item >> 4) & 3, b = item >> 6;
    f32x16 accS[2];
    unsigned rzA[8], rvA[8], rqA[8], rzB[8], rvB[8], rqB[8];
    { const float lb0 = F.lb()[h * HD + 2 * F.lane], lb1 = F.lb()[h * HD + 2 * F.lane + 1];
      const int c0 = seg * SEGC;
      hgrn_load<true>(F, b, h, 0, c0, rzA, rvA, rqA); hgrn_load<true>(F, b, h, 0, c0 + 1, rzB, rvB, rqB);
      h2_init_state(F, b, h, 0, seg, accS);
      for (int c = 0; c < SEGC; c += 2) {
          hgrn_chunk<true, 0>(F, b, h, 0, c0 + c, (c + 2 < SEGC) ? (c0 + c + 2) : -1, accS, lb0, lb1, rzA, rvA, rqA);
          hgrn_chunk<true, 0>(F, b, h, 0, c0 + c + 1, (c + 3 < SEGC) ? (c0 + c + 3) : -1, accS, lb0, lb1, rzB, rvB, rqB); } }
    asm volatile("s_waitcnt vmcnt(0)" ::: "memory");
    __syncthreads();
    { const float lb0 = F.lb()[512 + h * HD + 2 * F.lane], lb1 = F.lb()[512 + h * HD + 2 * F.lane + 1];
      const int cl = seg * SEGC + SEGC - 1;
      hgrn_load<true>(F, b, h, 1, cl, rzA, rvA, rqA); hgrn_load<true>(F, b, h, 1, cl - 1, rzB, rvB, rqB);
      h2_init_state(F, b, h, 1, seg, accS);
      for (int c = 0; c < SEGC; c += 2) {
          hgrn_chunk<true, 1>(F, b, h, 1, cl - c, (c + 2 < SEGC) ? (cl - c - 2) : -1, accS, lb0, lb1, rzA, rvA, rqA);
          hgrn_chunk<true, 1>(F, b, h, 1, cl - c - 1, (c + 3 < SEGC) ? (cl - c - 3) : -1, accS, lb0, lb1, rzB, rvB, rqB); } }
}

__device__ __forceinline__ unsigned f2key(float f) { const unsigned u = __builtin_bit_cast(unsigned, f); return (u & 0x80000000u) ? ~u : (u | 0x80000000u); }
__device__ __forceinline__ float key2f(unsigned k) { const unsigned u = (k & 0x80000000u) ? (k & 0x7fffffffu) : ~k; return __builtin_bit_cast(float, u); }
__device__ __forceinline__ unsigned umax_(unsigned a, unsigned b) { return a > b ? a : b; }
__device__ __forceinline__ unsigned umin_(unsigned a, unsigned b) { return a < b ? a : b; }
__device__ __forceinline__ void sort16(unsigned (&a)[16]) {
#pragma unroll
    for (int k = 2; k <= 16; k <<= 1)
#pragma unroll
        for (int j = k >> 1; j > 0; j >>= 1)
#pragma unroll
            for (int i = 0; i < 16; ++i) { const int l = i ^ j; if (l > i) { const bool desc = ((i & k) == 0); const unsigned x = a[i], y = a[l], mx = umax_(x, y), mn = umin_(x, y); a[i] = desc ? mx : mn; a[l] = desc ? mn : mx; } }
}
__device__ __forceinline__ void merge16(unsigned (&a)[16], const unsigned (&b)[16]) {
#pragma unroll
    for (int i = 0; i < 16; ++i) a[i] = umax_(a[i], b[15 - i]);
#pragma unroll
    for (int j = 8; j > 0; j >>= 1)
#pragma unroll
        for (int i = 0; i < 16; ++i) { const int l = i ^ j; if (l > i) { const unsigned x = a[i], y = a[l]; a[i] = umax_(x, y); a[l] = umin_(x, y); } }
}
__device__ __forceinline__ unsigned dpp_swap1(unsigned v) { return (unsigned)__builtin_amdgcn_update_dpp(0, (int)v, 0xB1, 0xF, 0xF, false); }
__device__ __forceinline__ unsigned pick_byte(const unsigned (&pk)[4], unsigned a) {
    const unsigned wsel = a >> 2; unsigned v = wsel == 0 ? pk[0] : (wsel == 1 ? pk[1] : (wsel == 2 ? pk[2] : pk[3]));
    return (v >> ((a & 3u) * 8u)) & 0xffu;
}
__device__ __forceinline__ void topk_stage2(const unsigned (&top)[16], bool tab0, size_t item, int* esel, float* wsel) {
        float vO[16], vP[16]; unsigned iOpk[4] = {0u, 0u, 0u, 0u}, iPpk[4] = {0u, 0u, 0u, 0u};
#pragma unroll
        for (int i = 0; i < 16; ++i) { const unsigned t = top[i], tp = dpp_swap1(t);
            vO[i] = key2f(t & ~0x7fu); vP[i] = key2f(tp & ~0x7fu);
            iOpk[i >> 2] |= (127u - (t & 0x7fu)) << ((i & 3) * 8); iPpk[i >> 2] |= (127u - (tp & 0x7fu)) << ((i & 3) * 8); }
        unsigned R[16], G1[16], G2[16], G3[16];
#define CAND(a, b) ((f2key(vO[a] + vP[b]) & ~0xffu) | (unsigned)(((a) << 4) | (b)))
#pragma unroll
        for (int i = 0; i < 16; ++i) R[i] = CAND(0, i);
        G1[0] = CAND(1, 0); G1[1] = CAND(1, 1); G1[2] = CAND(1, 2); G1[3] = CAND(1, 3); G1[4] = CAND(1, 4); G1[5] = CAND(1, 5); G1[6] = CAND(1, 6); G1[7] = CAND(1, 7);
        G1[8] = CAND(2, 0); G1[9] = CAND(2, 1); G1[10] = CAND(2, 2); G1[11] = CAND(2, 3); G1[12] = CAND(2, 4); G1[13] = CAND(3, 0); G1[14] = CAND(3, 1); G1[15] = CAND(3, 2);
        G2[0] = CAND(3, 3); G2[1] = CAND(4, 0); G2[2] = CAND(4, 1); G2[3] = CAND(4, 2); G2[4] = CAND(5, 0); G2[5] = CAND(5, 1); G2[6] = CAND(6, 0); G2[7] = CAND(6, 1);
        G2[8] = CAND(7, 0); G2[9] = CAND(7, 1); G2[10] = CAND(8, 0); G2[11] = CAND(9, 0); G2[12] = CAND(10, 0); G2[13] = CAND(11, 0); G2[14] = CAND(12, 0); G2[15] = CAND(13, 0);
        G3[0] = CAND(14, 0); G3[1] = CAND(15, 0);
#pragma unroll
        for (int i = 2; i < 16; ++i) G3[i] = 0u;
#undef CAND
        sort16(G1); sort16(G2); sort16(G3);
        merge16(R, G1); merge16(R, G2); merge16(R, G3);
        float sc[16], ex[16]; float sum = 0.f; unsigned eid[16];
        #pragma unroll
        for (int i = 0; i < 16; ++i) { sc[i] = key2f(R[i] & ~0xffu); const unsigned a = (R[i] >> 4) & 15u, bb = R[i] & 15u;
            const unsigned io = pick_byte(iOpk, a), ip = pick_byte(iPpk, bb);
            eid[i] = tab0 ? (io * 128u + ip) : (ip * 128u + io); }
#pragma unroll
        for (int i = 0; i < 16; ++i) { ex[i] = __expf(sc[i] - sc[0]); sum += ex[i]; }
        const float inv = 1.0f / sum;
        if (tab0) { const size_t o = item * 16;
#pragma unroll
            for (int q = 0; q < 4; ++q) { v4u ev; ev.x = eid[4 * q]; ev.y = eid[4 * q + 1]; ev.z = eid[4 * q + 2]; ev.w = eid[4 * q + 3]; *(v4u*)(esel + o + 4 * q) = ev;
                f32x4 wv; wv[0] = ex[4 * q] * inv; wv[1] = ex[4 * q + 1] * inv; wv[2] = ex[4 * q + 2] * inv; wv[3] = ex[4 * q + 3] * inv; *(f32x4*)(wsel + o + 4 * q) = wv; } }
}
__device__ __forceinline__ void p7_topk(Frame& F) {
    const int NT = T * PHEADS * 2;
    for (int g0 = (F.bid * NWAVES + F.wave) * 64; g0 < NT; g0 += F.G * NTHR) {
        const int g = g0 + F.lane; const float* wb = F.scores() + (size_t)g0 * 128;
        LAS float* stg = (LAS float*)(F.lds) + F.wave * (64 * 36);
        unsigned top[16];
#pragma unroll
        for (int sg = 0; sg < 4; ++sg) {
            f32x4 tl[8];
#pragma unroll
            for (int i = 0; i < 8; ++i) tl[i] = __builtin_nontemporal_load((const f32x4*)(wb + (size_t)(8 * i + (F.lane >> 3)) * 128 + sg * 32 + 4 * (F.lane & 7)));
#pragma unroll
            for (int i = 0; i < 8; ++i) *(LAS f32x4*)(stg + (8 * i + (F.lane >> 3)) * 36 + 4 * (F.lane & 7)) = tl[i];
            asm volatile("s_waitcnt lgkmcnt(0)" ::: "memory");
#pragma unroll
            for (int hg2 = 0; hg2 < 2; ++hg2) { const int grp = sg * 2 + hg2; unsigned k[16];
#pragma unroll
                for (int q = 0; q < 4; ++q) { const f32x4 v = *(LAS const f32x4*)(stg + F.lane * 36 + hg2 * 16 + q * 4);
#pragma unroll
                    for (int e = 0; e < 4; ++e) { const int j = grp * 16 + q * 4 + e; k[q * 4 + e] = (f2key(v[e]) & ~0x7fu) | (unsigned)(127 - j); } }
                sort16(k);
                if (grp == 0) {
#pragma unroll
                    for (int i = 0; i < 16; ++i) top[i] = k[i];
                } else merge16(top, k); }
            asm volatile("s_waitcnt lgkmcnt(0)" ::: "memory");
        }
        topk_stage2(top, (g & 1) == 0, (size_t)((g >> 1) & 7) * T + (size_t)(g >> 4), F.esel(), F.wsel());
    }
}


struct EpiScoreTopk {
    static constexpr bool PERM = false, AFTER_DRAIN = false;
    float* scr; const float* ssqp; const float* biasq; float* rstd_out; int* esel; float* wsel;
    __device__ __forceinline__ void operator()(const f32x4 (&acc)[2][2][4][2], const pg8::Unit& u, int wr, int wc, int fr, int fq) const {
        asm volatile("" : "+v"(fr), "+v"(fq));
        const int rl0 = wr * 64 + fr, col0 = wc * 32 + 4 * fq, b = (u.pm * 256) >> 13;
        f32x4 bv[2][2];
#pragma unroll
        for (int bj = 0; bj < 2; ++bj)
#pragma unroll
            for (int n = 0; n < 2; ++n) bv[bj][n] = *(const f32x4*)(biasq + b * 2048 + u.pn * 256 + col0 + bj * 128 + n * 16);
#pragma unroll
        for (int ai = 0; ai < 2; ++ai)
#pragma unroll
            for (int m = 0; m < 4; ++m) { const int rl = rl0 + ai * 128 + m * 16, row = u.pm * 256 + rl;
                const f32x4 p0 = *(const f32x4*)(ssqp + (size_t)row * 4), p1 = *(const f32x4*)(ssqp + ((size_t)32768 + row) * 4), p2 = *(const f32x4*)(ssqp + ((size_t)65536 + row) * 4), p3 = *(const f32x4*)(ssqp + ((size_t)98304 + row) * 4);
                const float tot = (p0[0] + p0[1] + p0[2] + p0[3]) + (p1[0] + p1[1] + p1[2] + p1[3]) + (p2[0] + p2[1] + p2[2] + p2[3]) + (p3[0] + p3[1] + p3[2] + p3[3]);
                const float rstd = __builtin_amdgcn_rsqf(tot * (1.0f / 1024.0f) + 1e-6f);
                if (u.pn == 0 && wc == 0 && fq == 0) rstd_out[row] = rstd;
                float* blk = scr + (2 * wr + 4 * ai + (m >> 1)) * 8192 + 8 * wc * 256 + 32 * (m & 1) * 4;
                const unsigned loff4 = (unsigned)(2 * fr + 64 * fq);
#pragma unroll
                for (int bj = 0; bj < 2; ++bj)
#pragma unroll
                    for (int n = 0; n < 2; ++n) ((f32x4*)(blk + (4 * n * 64 + bj) * 4))[loff4] = acc[ai][bj][m][n] * rstd + bv[bj][n]; }
        asm volatile("s_waitcnt vmcnt(0)" ::: "memory");
        __builtin_amdgcn_s_barrier();
        asm volatile("" ::: "memory");
        int tid = threadIdx.x; asm volatile("" : "+v"(tid));
        const int rl = tid >> 1, tab = tid & 1;
        const float* bp = scr + __builtin_amdgcn_readfirstlane(tid >> 6) * 8192;
        const unsigned lo4 = (unsigned)(tid & 63) * 4u;
        unsigned top[16];
        f32x4 cur[4], nxt[4];
#pragma unroll
        for (int q = 0; q < 4; ++q) cur[q] = *(const f32x4*)(bp + q * 256 + lo4);
#pragma unroll
        for (int grp = 0; grp < 8; ++grp) { unsigned k[16];
            if (grp < 7) {
#pragma unroll
                for (int q = 0; q < 4; ++q) nxt[q] = *(const f32x4*)(bp + ((grp + 1) * 4 + q) * 256 + lo4); }
#pragma unroll
            for (int q = 0; q < 4; ++q) { const f32x4 v = cur[q];
#pragma unroll
                for (int e = 0; e < 4; ++e) { const int j = grp * 16 + q * 4 + e; k[q * 4 + e] = (f2key(v[e]) & ~0x7fu) | (unsigned)(127 - j); } }
            sort16(k);
            if (grp == 0) {
#pragma unroll
                for (int i = 0; i < 16; ++i) top[i] = k[i];
            } else merge16(top, k);
#pragma unroll
            for (int q = 0; q < 4; ++q) cur[q] = nxt[q];
            __builtin_amdgcn_sched_barrier(0); }
        topk_stage2(top, tab == 0, (size_t)u.pn * T + (size_t)(u.pm * 256 + rl), esel, wsel);
    }
};

__device__ __forceinline__ void cvt16(const v4u& u, f32x2_ (&f)[8]) {
#pragma unroll
    for (int i = 0; i < 4; ++i) { f[2 * i] = __builtin_amdgcn_cvt_pk_f32_fp8((int)u[i], false); f[2 * i + 1] = __builtin_amdgcn_cvt_pk_f32_fp8((int)u[i], true); }
}
constexpr int PITEM = 8, NPITEM = T / PITEM;
__device__ __forceinline__ int peer_next(unsigned* q, int lane) {
    int idx = 0; if (lane == 0) idx = (int)__hip_atomic_fetch_add(q, 1u, __ATOMIC_RELAXED, __HIP_MEMORY_SCOPE_AGENT);
    return __builtin_amdgcn_readfirstlane(idx);
}
#define PEER_SB() __builtin_amdgcn_sched_barrier(0)
#define DPP_IADD(s, ctrl) ((s) + __builtin_amdgcn_update_dpp(0, (s), (ctrl), 0xF, 0xF, false))
__device__ __forceinline__ void p8_dots(const v4u (&ud)[16], const int (&hq)[4], int c8, int& r0, int& r1) {
#pragma unroll
    for (int i = 0; i < 16; ++i) { int sm = __builtin_amdgcn_sdot4((int)ud[i][0], hq[0], 0, false);
        sm = __builtin_amdgcn_sdot4((int)ud[i][1], hq[1], sm, false); sm = __builtin_amdgcn_sdot4((int)ud[i][2], hq[2], sm, false); sm = __builtin_amdgcn_sdot4((int)ud[i][3], hq[3], sm, false);
        sm = DPP_IADD(sm, 0xB1); sm = DPP_IADD(sm, 0x4E); sm = DPP_IADD(sm, 0x141);
        if ((i & 1) == 0) r0 = (c8 == (i >> 1)) ? sm : r0; else r1 = (c8 == (i >> 1)) ? sm : r1; }
}
constexpr int PSLAB = 12288;
__device__ __forceinline__ void p8_item(Frame& F, int sl, int item, int nitem, bool filled, LAS unsigned char* slab) {
    const int c8 = F.lane & 7, q8 = F.lane >> 3, t0 = item * PITEM;
    const unsigned char* ub = F.U8() + (size_t)sl * 16384 * CSL + 16 * c8;
    LAS int* eL = (LAS int*)slab; LAS unsigned char* hL = (LAS unsigned char*)(slab + 4096);
    v4u t4[4], h2[2]; float rs2[2]; f32x4 sA, sB;
#define P8_BLK_LOAD(tb) do { \
        { const float* sp_ = F.mod() + ((tb) >> 13) * 6144 + 3072 + sl * CSL + 8 * (F.lane & 15); sA = *(const f32x4*)sp_; sB = *(const f32x4*)(sp_ + 4); } \
        _Pragma("unroll") for (int i = 0; i < 2; ++i) rs2[i] = F.rstd()[(tb) + 4 * i + (F.lane >> 4)]; \
        _Pragma("unroll") for (int i = 0; i < 4; ++i) t4[i] = __builtin_nontemporal_load((const v4u*)(F.esel() + ((size_t)(2 * i + (F.lane >> 5)) * T + (tb)) * 16) + (F.lane & 31)); \
        _Pragma("unroll") for (int i = 0; i < 2; ++i) h2[i] = __builtin_nontemporal_load((const v4u*)(F.hg() + (size_t)((tb) + 4 * i + (F.lane >> 4)) * D + sl * CSL + 8 * (F.lane & 15))); } while (0)
#define P8_Q8(x) ((int)__builtin_rintf(__builtin_fminf(__builtin_fmaxf((x) * HQSCALE, -127.f), 127.f)) & 0xff)
#define P8_BLK_STORE() do { _Pragma("unroll") for (int i = 0; i < 4; ++i) *(LAS v4u*)(eL + ((F.lane & 31) >> 2) * NSEL + (2 * i + (F.lane >> 5)) * 16 + 4 * (F.lane & 3)) = t4[i]; \
        _Pragma("unroll") for (int i = 0; i < 2; ++i) { const float r_ = rs2[i]; const v4u h_ = h2[i]; v2u o_; \
            o_[0] = (unsigned)(P8_Q8(bflo(h_[0]) * r_ + sA[0]) | (P8_Q8(bfhi(h_[0]) * r_ + sA[1]) << 8) | (P8_Q8(bflo(h_[1]) * r_ + sA[2]) << 16) | (P8_Q8(bfhi(h_[1]) * r_ + sA[3]) << 24)); \
            o_[1] = (unsigned)(P8_Q8(bflo(h_[2]) * r_ + sB[0]) | (P8_Q8(bfhi(h_[2]) * r_ + sB[1]) << 8) | (P8_Q8(bflo(h_[3]) * r_ + sB[2]) << 16) | (P8_Q8(bfhi(h_[3]) * r_ + sB[3]) << 24)); \
            *(LAS v2u*)(hL + (4 * i + (F.lane >> 4)) * 128 + 8 * (F.lane & 15)) = o_; } \
        asm volatile("s_waitcnt lgkmcnt(0)" ::: "memory"); } while (0)
    if (!filled) { P8_BLK_LOAD(t0); P8_BLK_STORE(); }
    bf16* po = F.pact() + ((size_t)t0 * NSL + sl) * NSEL + 16 * q8 + 2 * c8;
    v4u udA[16], udB[16];
#define P8_GATHER(dst, tt) do { v4u e_[4]; _Pragma("unroll") for (int k = 0; k < 4; ++k) e_[k] = *(LAS const v4u*)(eL + (tt) * NSEL + 16 * q8 + 4 * k); \
        _Pragma("unroll") for (int i = 0; i < 16; ++i) dst[i] = *(const v4u*)(ub + (size_t)e_[i >> 2][i & 3] * CSL); } while (0)
#define P8_HN(tt) int hq[4]; { const v4u hv_ = *(LAS const v4u*)(hL + (tt) * 128 + 16 * c8); hq[0] = (int)hv_[0]; hq[1] = (int)hv_[1]; hq[2] = (int)hv_[2]; hq[3] = (int)hv_[3]; }
#define P8_OUT(tt, r0, r1) do { __builtin_nontemporal_store(cvtpk((float)(r0) * (1.0f / (UQSCALE * HQSCALE)), (float)(r1) * (1.0f / (UQSCALE * HQSCALE))), (unsigned*)(po + (size_t)(tt) * NSL * NSEL)); } while (0)
    P8_GATHER(udA, 0);
    for (int tt = 0; tt < PITEM - 2; tt += 2) {
        P8_GATHER(udB, tt + 1);
        { P8_HN(tt); int r0 = 0, r1 = 0; p8_dots(udA, hq, c8, r0, r1); P8_OUT(tt, r0, r1); }
        P8_GATHER(udA, tt + 2);
        { P8_HN(tt + 1); int r0 = 0, r1 = 0; p8_dots(udB, hq, c8, r0, r1); P8_OUT(tt + 1, r0, r1); }
    }
    {
        P8_GATHER(udB, PITEM - 1);
        { P8_HN(PITEM - 2); int r0 = 0, r1 = 0; p8_dots(udA, hq, c8, r0, r1); P8_OUT(PITEM - 2, r0, r1); }
        if (nitem >= 0) P8_BLK_LOAD(nitem * PITEM);
        { P8_HN(PITEM - 1); int r0 = 0, r1 = 0; p8_dots(udB, hq, c8, r0, r1); P8_OUT(PITEM - 1, r0, r1); }
        if (nitem >= 0) P8_BLK_STORE();
    }
#undef P8_GATHER
#undef P8_HN
#undef P8_OUT
#undef P8_BLK_LOAD
#undef P8_BLK_STORE
#undef P8_Q8
}
__device__ __forceinline__ void p8b_coef(Frame& F) {
    const size_t N = (size_t)T * NSEL;
    for (size_t i = (size_t)F.bid * NTHR + F.tid; i < N; i += (size_t)F.G * NTHR) { const size_t t = i >> 7; const int j = (int)(i & 127);
        const bf16* pp = F.pact() + t * NSL * NSEL + j; float a = 0.f;
#pragma unroll
        for (int s = 0; s < NSL; ++s) a += bf2f(__builtin_nontemporal_load(pp + s * NSEL));
        F.coef()[i] = F.wsel()[((size_t)(j >> 4) * T + t) * 16 + (j & 15)] * 0.5f * a * (1.0f + erff(a * 0.70710678f)); }
}
__device__ __forceinline__ void p9_token(const v4u (&vd)[16], LAS const float* cL, bf16* yo, LAS float* red, int lane, int c8, int q8) {
    f32x4 cc[4];
#pragma unroll
    for (int k = 0; k < 4; ++k) cc[k] = *(LAS const f32x4*)(cL + 16 * q8 + 4 * k);
    f32x2_ y[8];
#pragma unroll
    for (int k = 0; k < 8; ++k) y[k] = (f32x2_){0.f, 0.f};
#pragma unroll
    for (int i = 0; i < 16; ++i) { f32x2_ vf[8]; cvt16(vd[i], vf); const float c = cc[i >> 2][i & 3]; const f32x2_ c2 = {c, c};
#pragma unroll
        for (int k = 0; k < 8; ++k) y[k] += c2 * vf[k];
        PEER_SB(); }
#pragma unroll
    for (int k = 0; k < 4; ++k) { f32x4 o; o[0] = y[2 * k][0]; o[1] = y[2 * k][1]; o[2] = y[2 * k + 1][0]; o[3] = y[2 * k + 1][1]; *(LAS f32x4*)(red + q8 * 128 + 16 * c8 + 4 * k) = o; }
    asm volatile("s_waitcnt lgkmcnt(0)" ::: "memory");
    f32x2_ sm = {0.f, 0.f};
#pragma unroll
    for (int g = 0; g < 8; ++g) sm += *(LAS const f32x2_*)(red + g * 128 + 2 * lane);
    sm = sm * (1.0f / VSCALE);
    __builtin_nontemporal_store(cvtpk(sm[0], sm[1]), (unsigned*)(yo + 2 * lane));
    asm volatile("s_waitcnt lgkmcnt(0)" ::: "memory");
    PEER_SB();
}
__device__ __forceinline__ void p9_item(Frame& F, int sl, int item, int nitem, bool filled, LAS unsigned char* slab) {
    const int c8 = F.lane & 7, q8 = F.lane >> 3, t0 = item * PITEM;
    const unsigned char* vb = F.V8() + (size_t)sl * 16384 * CSL + 16 * c8;
    LAS int* eL = (LAS int*)slab; LAS float* cL = (LAS float*)(slab + 4096); LAS float* red = (LAS float*)(slab + 8192);
    v4u t4[4], c4[4];
#define P9_BLK_LOAD(tb) do { const v4u* cp_ = (const v4u*)(F.coef() + (size_t)(tb) * NSEL); \
        _Pragma("unroll") for (int i = 0; i < 4; ++i) { t4[i] = __builtin_nontemporal_load((const v4u*)(F.esel() + ((size_t)(2 * i + (F.lane >> 5)) * T + (tb)) * 16) + (F.lane & 31)); c4[i] = __builtin_nontemporal_load(cp_ + i * 64 + F.lane); } } while (0)
#define P9_BLK_STORE() do { _Pragma("unroll") for (int i = 0; i < 4; ++i) { *(LAS v4u*)(eL + ((F.lane & 31) >> 2) * NSEL + (2 * i + (F.lane >> 5)) * 16 + 4 * (F.lane & 3)) = t4[i]; *(LAS v4u*)(cL + (i * 64 + F.lane) * 4) = c4[i]; } \
        asm volatile("s_waitcnt lgkmcnt(0)" ::: "memory"); } while (0)
    if (!filled) { P9_BLK_LOAD(t0); P9_BLK_STORE(); }
    bf16* yo = F.ybuf() + (size_t)t0 * D + sl * CSL;
    v4u vdA[16], vdB[16];
#define P9_GATHER(dst, tt) do { v4u e_[4]; _Pragma("unroll") for (int k = 0; k < 4; ++k) e_[k] = *(LAS const v4u*)(eL + (tt) * NSEL + 16 * q8 + 4 * k); \
        _Pragma("unroll") for (int i = 0; i < 16; ++i) dst[i] = *(const v4u*)(vb + (size_t)e_[i >> 2][i & 3] * CSL); } while (0)
    P9_GATHER(vdA, 0);
    for (int tt = 0; tt < PITEM - 2; tt += 2) {
        P9_GATHER(vdB, tt + 1);
        p9_token(vdA, cL + tt * NSEL, yo + (size_t)tt * D, red, F.lane, c8, q8);
        P9_GATHER(vdA, tt + 2);
        p9_token(vdB, cL + (tt + 1) * NSEL, yo + (size_t)(tt + 1) * D, red, F.lane, c8, q8);
    }
    {
        P9_GATHER(vdB, PITEM - 1);
        p9_token(vdA, cL + (PITEM - 2) * NSEL, yo + (size_t)(PITEM - 2) * D, red, F.lane, c8, q8);
        if (nitem >= 0) P9_BLK_LOAD(nitem * PITEM);
        p9_token(vdB, cL + (PITEM - 1) * NSEL, yo + (size_t)(PITEM - 1) * D, red, F.lane, c8, q8);
        if (nitem >= 0) P9_BLK_STORE();
    }
#undef P9_GATHER
#undef P9_BLK_LOAD
#undef P9_BLK_STORE
}
template <int SIDE>
__device__ __forceinline__ void peer_phase(Frame& F0, int rep) {
    Frame F = F0; asm volatile("" : "+v"(F.lane));
    const int s0 = (int)(xb_xcc_id() & 7u);
    unsigned* qbase = F.ctl() + (SIDE == 0 ? CW_QU : CW_QV) + rep * 64 * 32;
    LAS unsigned char* cf = F.lds + F.wave * PSLAB;
    for (int k = 0; k < NSL; ++k) { const int sl = (s0 + k) & (NSL - 1);
        int item = peer_next(qbase + 64 * sl, F.lane); bool filled = false;
        while (item < NPITEM) { int nitem = peer_next(qbase + 64 * sl, F.lane); if (nitem >= NPITEM) nitem = -1;
            if (SIDE == 0) p8_item(F, sl, item, nitem, filled, cf); else p9_item(F, sl, item, nitem, filled, cf);
            filled = nitem >= 0; item = nitem >= 0 ? nitem : NPITEM; } }
}
__device__ __forceinline__ void p10_final(Frame& F) {
    const int gwc = F.bid * NWAVES + F.wave, NGW = F.G * NWAVES;
    for (int row0 = gwc * 16; row0 < T; row0 += NGW * 16) {
        const int b = row0 >> 13; const float* mb = F.mod() + b * 6144 + 5120; const float* fm = F.fmod() + b * 2048;
        f32x4 g2[4], ca[4], cb[4];
#pragma unroll
        for (int j = 0; j < 4; ++j) { const int k = 256 * j + 4 * F.lane; g2[j] = *(const f32x4*)(mb + k); ca[j] = *(const f32x4*)(F.fnorm_g() + k) * (*(const f32x4*)(fm + 1024 + k) + 1.0f); cb[j] = *(const f32x4*)(fm + k); }
#pragma unroll 4
        for (int r = 0; r < 16; ++r) { float* hr = F.out() + (size_t)(row0 + r) * D; const bf16* yr = F.ybuf() + (size_t)(row0 + r) * D; const bf16* hb = (const bf16*)hr;
            f32x4 z[4]; float ss = 0.f;
#pragma unroll
            for (int j = 0; j < 4; ++j) { const v2u hq = *(const v2u*)(hb + 256 * j + 4 * F.lane); f32x4 hv; hv[0] = bflo(hq[0]); hv[1] = bfhi(hq[0]); hv[2] = bflo(hq[1]); hv[3] = bfhi(hq[1]);
                const v2u yq = __builtin_nontemporal_load((const v2u*)(yr + 256 * j + 4 * F.lane)); f32x4 yv; yv[0] = bflo(yq[0]); yv[1] = bfhi(yq[0]); yv[2] = bflo(yq[1]); yv[3] = bfhi(yq[1]);
                z[j] = hv + g2[j] * yv; ss += z[j][0] * z[j][0] + z[j][1] * z[j][1] + z[j][2] * z[j][2] + z[j][3] * z[j][3]; }
            const float rstd = __builtin_amdgcn_rsqf(wave_sum(ss) * (1.0f / D) + EPS);
#pragma unroll
            for (int j = 0; j < 4; ++j) *(f32x4*)(hr + 256 * j + 4 * F.lane) = z[j] * rstd * ca[j] + cb[j]; }
    }
}

constexpr int NPHASE = 12;
__global__ void __launch_bounds__(NTHR, 2) fwd_kernel(Args args) {
    extern __shared__ __attribute__((aligned(16))) unsigned char lds_raw[];
    Frame F;
    F.lds = (LAS unsigned char*)lds_raw;
    F.tid = threadIdx.x; F.lane = F.tid & 63; F.wave = __builtin_amdgcn_readfirstlane(F.tid >> 6); F.G = gridDim.x; F.bid = blockIdx.x;
    unsigned char* ws = args.ws; F.a = &args;
    volatile LAS unsigned* misc = (volatile LAS unsigned*)(F.lds + MISC_OFF);
    if (F.tid < 64) misc[F.tid] = 0u;
    __syncthreads();
    const int lo = args.ph_lo, hi = args.ph_hi;
    const bool multi = (hi - lo) > 1;
    XcdBarrier bar; bar.bar = (unsigned*)(ws + WS_CTL) + CW_BAR; bar.x = 0; bar.st = nullptr;
    if (multi) bar = xcd_barrier_post((unsigned*)(ws + WS_CTL) + CW_BAR, misc + 8);
#ifndef PHMASK
#define PHMASK 0xfff
#endif
#define IN(k) (((PHMASK >> (k)) & 1) && lo <= (k) && (k) < hi)
#define SEAM(k) do { if (IN(k) && IN((k) + 1)) xcd_barrier(bar); } while (0)

#ifndef REPMASK
#define REPMASK 0
#endif
#define REP(k) (((REPMASK) >> (k)) & 1)
#define REPBAR(k) if (REP(k) && rep == 0) xcd_barrier(bar)
    if (IN(0)) { for (int rep = 0; rep <= REP(0); ++rep) { p0_prologue(F); REPBAR(0); } } SEAM(0);
    if (IN(1)) { for (int rep = 0; rep <= REP(1); ++rep) { p1_norm(F); REPBAR(1); } } SEAM(1);
    if (IN(2)) { { pg8::Gemm g{F.bufA(), F.Win_t(), T, NIN, D}; pg8::StaticOrder S; S.init(T, NIN, F.G, F.bid);
        pg8::EpiProj E{F.proj(), NIN};
        pg8::gemm_phase<pg8::EpiProj, pg8::StaticOrder, true, true>(F.lds, g, S, E); }
#if ((REPMASK) >> 2) & 1
        xcd_barrier(bar); { pg8::Gemm g{F.bufA(), F.Win_t(), T, NIN, D}; pg8::StaticOrder S; S.init(T, NIN, F.G, F.bid);
        pg8::EpiProj E{F.proj(), NIN};
        pg8::gemm_phase<pg8::EpiProj, pg8::StaticOrder, true, true>(F.lds, g, S, E); }
#endif
    } SEAM(2);
    if (IN(3)) { for (int rep = 0; rep <= REP(3); ++rep) {
        for (int it = F.bid; it < NB * NHH * 2 * NSEG; it += F.G) h1_item(F, it);
        float cw[CW];
#pragma unroll
        for (int j = 0; j < CW; ++j) cw[j] = F.conv_w()[j * DC + F.tid];
        const float cbias = F.conv_b()[F.tid];
        for (int it = F.bid; it < T / 32; it += F.G) conv_item(F, it, cw, cbias); REPBAR(3); }
    } SEAM(3);
    if (IN(4)) { for (int rep = 0; rep <= REP(4); ++rep) { for (int it = F.bid; it < NB * NHH * NSEG; it += F.G) h2_item(F, it); REPBAR(4); } } SEAM(4);
    if (IN(5)) { { pg8::Gemm g{F.bufA(), F.Wout_t(), T, D, D}; pg8::StaticOrder S; S.init(T, D, F.G, F.bid);
        pg8::EpiOut E{F.x(), F.out(), F.hg(), F.mod(), F.g_ffn(), F.ssqp()};
        pg8::gemm_phase<pg8::EpiOut, pg8::StaticOrder, true, true>(F.lds, g, S, E); }
#if ((REPMASK) >> 5) & 1
        xcd_barrier(bar); { pg8::Gemm g{F.bufA(), F.Wout_t(), T, D, D}; pg8::StaticOrder S; S.init(T, D, F.G, F.bid);
        pg8::EpiOut E{F.x(), F.out(), F.hg(), F.mod(), F.g_ffn(), F.ssqp()};
        pg8::gemm_phase<pg8::EpiOut, pg8::StaticOrder, true, true>(F.lds, g, S, E); }
#endif
    } SEAM(5);
    if (IN(6)) { { pg8::Gemm g{F.hg(), F.Wqk_t(), T, NQK, D}; pg8::StaticOrder S; S.init(T, NQK, F.G, F.bid);
        EpiScoreTopk E{F.scores() + (size_t)F.bid * 65536, F.ssqp(), F.biasq(), F.rstd(), F.esel(), F.wsel()};
        pg8::gemm_phase<EpiScoreTopk, pg8::StaticOrder, true, true>(F.lds, g, S, E); }
    } SEAM(6);
    if (IN(8)) { for (int rep = 0; rep <= REP(8); ++rep) { peer_phase<0>(F, rep); REPBAR(8); } } SEAM(8);
    if (IN(9)) { for (int rep = 0; rep <= REP(9); ++rep) { p8b_coef(F); REPBAR(9); } } SEAM(9);
    if (IN(10)) { for (int rep = 0; rep <= REP(10); ++rep) { peer_phase<1>(F, rep); REPBAR(10); } } SEAM(10);
    if (IN(11)) { p10_final(F); }
#undef IN
#undef SEAM
}

#ifndef MK_ONE_LAUNCH
#define MK_ONE_LAUNCH 0
#endif
extern "C" void kernel_launch(void* const* d_in, const int* in_sizes, int n_in, void* d_out, int out_size, void* d_ws, size_t ws_size, hipStream_t stream) {
    static int grid = 0;
    if (grid == 0) {
        if (n_in != 23 || out_size != T * D || ws_size < WS_END) { fprintf(stderr, "kernel_launch: unexpected shapes (n_in %d, out %d, ws %zu)\n", n_in, out_size, ws_size); grid = -1; return; }
        int dev = 0, cus = 0, per_cu = 0;
        if (hipGetDevice(&dev) != hipSuccess || hipDeviceGetAttribute(&cus, hipDeviceAttributeMultiprocessorCount, dev) != hipSuccess) { grid = -1; return; }
        if (hipFuncSetAttribute((const void*)fwd_kernel, hipFuncAttributeMaxDynamicSharedMemorySize, LDS_BYTES) != hipSuccess) { fprintf(stderr, "kernel_launch: hipFuncSetAttribute failed\n"); grid = -1; return; }
        if (hipOccupancyMaxActiveBlocksPerMultiprocessor(&per_cu, (const void*)fwd_kernel, NTHR, LDS_BYTES) != hipSuccess || per_cu < 1) { fprintf(stderr, "kernel_launch: occupancy query reports %d\n", per_cu); }
        (void)hipGetLastError();
        grid = cus;
    }
    if (grid < 0) return;
    (void)hipMemsetAsync((char*)d_ws + WS_CTL, 0, CTL_ZERO_BYTES, stream);
    Args a{};
    for (int i = 0; i < 23; ++i) a.in[i] = (const float*)d_in[i];
    a.out = (float*)d_out; a.ws = (unsigned char*)d_ws;
#if MK_ONE_LAUNCH
    a.ph_lo = 0; a.ph_hi = NPHASE;
    hipLaunchKernelGGL(fwd_kernel, dim3(grid), dim3(NTHR), LDS_BYTES, stream, a);
#else
    for (int p = 0; p < NPHASE; ++p) { a.ph_lo = p; a.ph_hi = p + 1; hipLaunchKernelGGL(fwd_kernel, dim3(grid), dim3(NTHR), LDS_BYTES, stream, a); }
#endif
}
```

```cpp
#include <hip/hip_runtime.h>
#include <cstdio>
#include <cstdint>
namespace pg8 {
#define PG8_LAS __attribute__((address_space(3)))
typedef unsigned short bf16_t;
typedef short bf16x8 __attribute__((ext_vector_type(8)));
typedef float f32x4 __attribute__((ext_vector_type(4)));
typedef unsigned u32x4 __attribute__((ext_vector_type(4)));
constexpr int BM = 256, BK = 64, HALF = 128, HTB = HALF * BK * 2  , STAGE_BYTES = 8 * HTB, NXCD = 8, WGM = 8;

__host__ __device__ __forceinline__ int lds_byte(int r, int c) { const int st = (r >> 4) * 2 + (c >> 5), rr = r & 15, cc = c & 31, ob = rr * 64 + cc * 2; return st * 1024 + (ob ^ (((ob >> 9) & 1) << 5)); }
__host__ __device__ __forceinline__ void stage_rc(int b, int& R, int& C) { const int st = b / 1024, sb = b % 1024, swz = sb ^ (((sb >> 9) & 1) << 5); R = (st >> 1) * 16 + swz / 64; C = (st & 1) * 32 + (swz % 64) / 2; }
__host__ __device__ __forceinline__ int perm32(int rho) { const int n = rho >> 4, i = rho & 15; return 8 * (i >> 2) + 4 * n + (i & 3); }

struct Unit { int pm, pn; };
struct Gemm { const bf16_t* A; const bf16_t* Bt; int M, N, K; };

struct StaticOrder {
    int nM, nN, nwg, G, c;
    __host__ __device__ void init(int M, int N, int G_, int c_) { nM = M / BM; nN = N / BM; nwg = nM * nN; G = G_; c = c_; }
    __host__ __device__ bool next(int i, Unit& u) const {
        const long L = (long)i * G + c; if (L >= nwg) return false;
        int wgid = (int)L; { const int q = nwg / NXCD, r = nwg % NXCD, xcd = wgid % NXCD, off = wgid / NXCD; wgid = (xcd < r ? xcd * (q + 1) : r * (q + 1) + (xcd - r) * q) + off; }
        const int nig = WGM * nN, gid = wgid / nig, fm = gid * WGM, gsz = (nM - fm) < WGM ? (nM - fm) : WGM;
        u.pm = fm + ((wgid % nig) % gsz); u.pn = (wgid % nig) / gsz; return true;
    }
    __device__ __forceinline__ void a_ready(const Unit&) const {}
    __device__ __forceinline__ void done(const Unit&) const {}
};
__device__ __forceinline__ unsigned cvt_pk_bf16(float lo, float hi) { unsigned r; asm volatile("v_cvt_pk_bf16_f32 %0, %1, %2" : "=v"(r) : "v"(lo), "v"(hi)); return r; }
typedef float f32x2 __attribute__((ext_vector_type(2)));
__device__ __forceinline__ f32x2 gelu_pk(f32x2 v) {
    const f32x2 av = __builtin_elementwise_abs(v), d = av * 0.2316418882f + 1.0f;
    f32x2 t; t.x = __builtin_amdgcn_rcpf(d.x); t.y = __builtin_amdgcn_rcpf(d.y);
    f32x2 q = t * 0.5307027145f + (-0.7265760135f); q = q * t + 0.7107068705f; q = q * t + (-0.142248368f); q = q * t + 0.127414796f; q = q * t;
    const f32x2 s = (v * v) * (-0.72134752044f);
    f32x2 e; e.x = __builtin_amdgcn_exp2f(s.x); e.y = __builtin_amdgcn_exp2f(s.y);
    const f32x2 m = v * (q * e), r = v - m;
    f32x2 o; o.x = v.x < 0.f ? m.x : r.x; o.y = v.y < 0.f ? m.y : r.y; return o;
}

template <int ACT  > struct EpiBf16 {
    static constexpr bool PERM = true, AFTER_DRAIN = false; static_assert(ACT == 0 || ACT == 1, "EpiBf16: ACT is 0 (none) or 1 (gelu_pk)");
    bf16_t* O; int ldc; const float* bias; int split_cols; size_t split_stride; float scale0;
    __device__ __forceinline__ void operator()(const f32x4 (&acc)[2][2][4][2], const Unit& u, int wr, int wc, int fr, int fq) const {
        const int row0 = u.pm * BM + wr * 64 + fr; int colt = u.pn * BM; bf16_t* base = O;
        float sc = 1.f; if (split_cols) { const int t = colt / split_cols; base += (size_t)t * split_stride; colt -= t * split_cols; if (t == 0) sc = scale0; }
        const int col0 = colt + wc * 32 + 8 * fq, bcol0 = u.pn * BM + wc * 32 + 8 * fq;
        f32x4 bv[2][2];
#pragma unroll
        for (int bj = 0; bj < 2; ++bj)
#pragma unroll
            for (int n = 0; n < 2; ++n) bv[bj][n] = bias ? *(const f32x4*)(bias + bcol0 + bj * HALF + 4 * n) : (f32x4){0.f, 0.f, 0.f, 0.f};
#pragma unroll
        for (int ai = 0; ai < 2; ++ai)
#pragma unroll
            for (int m = 0; m < 4; ++m) { bf16_t* rowp = base + (size_t)(row0 + ai * HALF + m * 16) * ldc + col0;
#pragma unroll
                for (int bj = 0; bj < 2; ++bj) { f32x4 v0 = acc[ai][bj][m][0] + bv[bj][0], v1 = acc[ai][bj][m][1] + bv[bj][1];
                    if (ACT == 1) { f32x2 a = gelu_pk((f32x2){v0[0], v0[1]}), b = gelu_pk((f32x2){v0[2], v0[3]}), c = gelu_pk((f32x2){v1[0], v1[1]}), d = gelu_pk((f32x2){v1[2], v1[3]});
                        v0 = (f32x4){a.x, a.y, b.x, b.y}; v1 = (f32x4){c.x, c.y, d.x, d.y}; }
                    v0 = v0 * sc; v1 = v1 * sc; u32x4 w; w.x = cvt_pk_bf16(v0[0], v0[1]); w.y = cvt_pk_bf16(v0[2], v0[3]); w.z = cvt_pk_bf16(v1[0], v1[1]); w.w = cvt_pk_bf16(v1[2], v1[3]);
                    *(u32x4*)(rowp + bj * HALF) = w; } }
    }
};

struct EpiOut {
    static constexpr bool PERM = true, AFTER_DRAIN = false;
    const float* X; float* Hout; bf16_t* HG; const float* mod; const float* gffn; float* ssqp;
    __device__ __forceinline__ void operator()(const f32x4 (&acc)[2][2][4][2], const Unit& u, int wr, int wc, int fr, int fq) const {
        const int row0 = u.pm * BM + wr * 64 + fr, col0 = u.pn * BM + wc * 32 + 8 * fq;
        const int b = (u.pm * BM) >> 13;
        const float* mb = mod + b * 6144;
        f32x4 g1v[2][2], gv2[2][2];
#pragma unroll
        for (int bj = 0; bj < 2; ++bj)
#pragma unroll
            for (int n = 0; n < 2; ++n) { const int c = col0 + bj * HALF + 4 * n;
                g1v[bj][n] = *(const f32x4*)(mb + 2048 + c);
                const f32x4 s2 = *(const f32x4*)(mb + 4096 + c), gf = *(const f32x4*)(gffn + c);
                gv2[bj][n] = gf * (s2 + 1.0f); }
#pragma unroll
        for (int ai = 0; ai < 2; ++ai)
#pragma unroll
            for (int m = 0; m < 4; ++m) { const int row = row0 + ai * HALF + m * 16; const size_t ro = (size_t)row * 1024 + col0; float ss = 0.f;
#pragma unroll
                for (int bj = 0; bj < 2; ++bj) {
                    const f32x4 x0 = *(const f32x4*)(X + ro + bj * HALF), x1 = *(const f32x4*)(X + ro + bj * HALF + 4);
                    const f32x4 h0 = x0 + g1v[bj][0] * acc[ai][bj][m][0], h1 = x1 + g1v[bj][1] * acc[ai][bj][m][1];
                    { u32x4 hw; hw.x = cvt_pk_bf16(h0[0], h0[1]); hw.y = cvt_pk_bf16(h0[2], h0[3]); hw.z = cvt_pk_bf16(h1[0], h1[1]); hw.w = cvt_pk_bf16(h1[2], h1[3]);
                      *(u32x4*)((bf16_t*)Hout + (size_t)row * 2048 + col0 + bj * HALF) = hw; }
                    ss += h0[0] * h0[0] + h0[1] * h0[1] + h0[2] * h0[2] + h0[3] * h0[3] + h1[0] * h1[0] + h1[1] * h1[1] + h1[2] * h1[2] + h1[3] * h1[3];
                    const f32x4 q0 = h0 * gv2[bj][0], q1 = h1 * gv2[bj][1];
                    u32x4 w; w.x = cvt_pk_bf16(q0[0], q0[1]); w.y = cvt_pk_bf16(q0[2], q0[3]); w.z = cvt_pk_bf16(q1[0], q1[1]); w.w = cvt_pk_bf16(q1[2], q1[3]);
                    *(u32x4*)(HG + ro + bj * HALF) = w; }
                ss += __shfl_xor(ss, 16); ss += __shfl_xor(ss, 32);
                if (fq == 0) ssqp[((size_t)u.pn * 32768 + row) * 4 + wc] = ss; }
    }
};
struct EpiScore {
    static constexpr bool PERM = false, AFTER_DRAIN = false;
    float* S; const float* ssqp; const float* biasq; float* rstd_out;
    __device__ __forceinline__ void operator()(const f32x4 (&acc)[2][2][4][2], const Unit& u, int wr, int wc, int fr, int fq) const {
        const int row0 = u.pm * BM + wr * 64 + fr, col0 = u.pn * BM + wc * 32 + 4 * fq;
        const int b = (u.pm * BM) >> 13;
        f32x4 bv[2][2];
#pragma unroll
        for (int bj = 0; bj < 2; ++bj)
#pragma unroll
            for (int n = 0; n < 2; ++n) bv[bj][n] = *(const f32x4*)(biasq + b * 2048 + col0 + bj * HALF + n * 16);
#pragma unroll
        for (int ai = 0; ai < 2; ++ai)
#pragma unroll
            for (int m = 0; m < 4; ++m) { const int row = row0 + ai * HALF + m * 16;
                const f32x4 p0 = *(const f32x4*)(ssqp + (size_t)row * 4), p1 = *(const f32x4*)(ssqp + ((size_t)32768 + row) * 4), p2 = *(const f32x4*)(ssqp + ((size_t)65536 + row) * 4), p3 = *(const f32x4*)(ssqp + ((size_t)98304 + row) * 4);
                const float tot = (p0[0] + p0[1] + p0[2] + p0[3]) + (p1[0] + p1[1] + p1[2] + p1[3]) + (p2[0] + p2[1] + p2[2] + p2[3]) + (p3[0] + p3[1] + p3[2] + p3[3]);
                const float rstd = __builtin_amdgcn_rsqf(tot * (1.0f / 1024.0f) + 1e-6f);
                if (u.pn == 0 && wc == 0 && fq == 0) rstd_out[row] = rstd;
                float* rowp = S + (size_t)row * 2048 + col0;
#pragma unroll
                for (int bj = 0; bj < 2; ++bj)
#pragma unroll
                    for (int n = 0; n < 2; ++n) *(f32x4*)(rowp + bj * HALF + n * 16) = acc[ai][bj][m][n] * rstd + bv[bj][n]; }
    }
};

struct EpiProj {
    static constexpr bool PERM = true, AFTER_DRAIN = false;
    bf16_t* O; int ldc;
    __device__ __forceinline__ void operator()(const f32x4 (&acc)[2][2][4][2], const Unit& u, int wr, int wc, int fr, int fq) const {
        asm volatile("" : "+v"(fr), "+v"(fq));
        const int row0 = u.pm * BM + wr * 64 + fr, col0 = u.pn * BM + wc * 32 + 8 * fq;
        const int cls = u.pn >> 1;
        const bool ident = (cls == 3) || (cls == 5), mulx = (cls == 0) || (cls == 4);
        const float sgn = (cls == 1 || cls == 2) ? 1.4426950408889634f : -1.4426950408889634f;
#pragma unroll
        for (int ai = 0; ai < 2; ++ai)
#pragma unroll
            for (int m = 0; m < 4; ++m) { bf16_t* rowp = O + (size_t)(row0 + ai * HALF + m * 16) * ldc + col0;
#pragma unroll
                for (int bj = 0; bj < 2; ++bj) { f32x4 v0 = acc[ai][bj][m][0], v1 = acc[ai][bj][m][1];
                    if (!ident) {
#pragma unroll
                        for (int j = 0; j < 4; ++j) { const float r0 = __builtin_amdgcn_rcpf(1.0f + __builtin_amdgcn_exp2f(sgn * v0[j])), r1 = __builtin_amdgcn_rcpf(1.0f + __builtin_amdgcn_exp2f(sgn * v1[j]));
                            v0[j] = mulx ? v0[j] * r0 : r0; v1[j] = mulx ? v1[j] * r1 : r1; } }
                    u32x4 w; w.x = cvt_pk_bf16(v0[0], v0[1]); w.y = cvt_pk_bf16(v0[2], v0[3]); w.z = cvt_pk_bf16(v1[0], v1[1]); w.w = cvt_pk_bf16(v1[2], v1[3]);
                    *(u32x4*)(rowp + bj * HALF) = w; } }
    }
};
template <class Epi, class Sched, bool ALIGN_EPI = false, bool SP2 = false>
__device__ __forceinline__ void gemm_phase(PG8_LAS unsigned char* lds, const Gemm g, const Sched& S, const Epi& E) {
    const int tid = threadIdx.x, wid = __builtin_amdgcn_readfirstlane(tid >> 6), lane = tid & 63, wr = wid >> 2, wc = wid & 3, fr = lane & 15, fq = lane >> 4;
    const int K = g.K, nt = K / BK;
    unsigned voffA[2], voffB[2];
#pragma unroll
    for (int i = 0; i < 2; ++i) { int R, C; stage_rc(tid * 16 + i * 8192, R, C); const int Rb = Epi::PERM ? ((R & ~31) + perm32(R & 31)) : R;
        voffA[i] = (unsigned)(R * K + C) * 2u; voffB[i] = (unsigned)(Rb * K + C) * 2u; }
    const size_t kstep = (size_t)(BK * 2);
    const size_t hstep = (size_t)HALF * K * 2;
    const size_t tstep = 2 * hstep;
    const unsigned ldsw = (unsigned)wid * 1024u;
    const int aoff = lds_byte(wr * 64 + fr, fq * 8), boff = lds_byte(wc * 32 + fr, fq * 8);
#define PG8_SA(b, h) (((b) * 2 + (h)) * HTB)
#define PG8_SB(b, h) ((4 + (b) * 2 + (h)) * HTB)
#define PG8_STAGE(bufoff, gbase, voff) do { _Pragma("unroll") for (int _i = 0; _i < 2; ++_i) \
        __builtin_amdgcn_global_load_lds((const unsigned*)((const char*)(gbase) + (voff)[_i]), (PG8_LAS unsigned*)(lds + (bufoff) + ldsw + _i * 8192), 16, 0, 0); } while (0)
#define PG8_LDA(dst, b, h) do { _Pragma("unroll") for (int m = 0; m < 4; ++m) _Pragma("unroll") for (int k = 0; k < 2; ++k) dst[m][k] = *(const PG8_LAS bf16x8*)(lds + PG8_SA(b, h) + aoff + m * 2048 + k * 1024); } while (0)
#define PG8_LDB(dst, b, h) do { _Pragma("unroll") for (int n = 0; n < 2; ++n) _Pragma("unroll") for (int k = 0; k < 2; ++k) dst[n][k] = *(const PG8_LAS bf16x8*)(lds + PG8_SB(b, h) + boff + n * 2048 + k * 1024); } while (0)
#define PG8_MMA(ai, bj, At, Bt) do { __builtin_amdgcn_s_setprio(1); _Pragma("unroll") for (int m = 0; m < 4; ++m) _Pragma("unroll") for (int n = 0; n < 2; ++n) _Pragma("unroll") for (int k = 0; k < 2; ++k) \
        acc[ai][bj][m][n] = __builtin_amdgcn_mfma_f32_16x16x32_bf16(Bt[n][k], At[m][k], acc[ai][bj][m][n], 0, 0, 0); __builtin_amdgcn_s_setprio(0); } while (0)
#define PG8_WAIT_V(n) asm volatile("s_waitcnt vmcnt(" #n ")" ::: "memory")
#define PG8_WAIT_L(n) asm volatile("s_waitcnt lgkmcnt(" #n ")" ::: "memory")
#define PG8_BAR __builtin_amdgcn_s_barrier()
#define PG8_SCHED __builtin_amdgcn_sched_barrier(0)
    Unit cur, nxt; int ui = 0;
    if (!S.next(0, cur)) return;
    f32x4 acc[2][2][4][2];
#pragma unroll
    for (int a = 0; a < 2; ++a)
#pragma unroll
        for (int b = 0; b < 2; ++b)
#pragma unroll
            for (int m = 0; m < 4; ++m)
#pragma unroll
                for (int n = 0; n < 2; ++n) acc[a][b][m][n] = (f32x4){0.f, 0.f, 0.f, 0.f};
    bf16x8 At[4][2], B0[2][2], B1[2][2];
    const char* cA = (const char*)g.A + (size_t)cur.pm * tstep; const char* cB = (const char*)g.Bt + (size_t)cur.pn * tstep;
    S.a_ready(cur);
    if constexpr (SP2) {
        PG8_STAGE(PG8_SB(0, 0), cB, voffB); PG8_STAGE(PG8_SB(0, 1), cB + hstep, voffB); PG8_STAGE(PG8_SA(0, 0), cA, voffA); PG8_STAGE(PG8_SA(0, 1), cA + hstep, voffA);
        if (wr == 1) PG8_BAR;
        PG8_WAIT_V(2); PG8_BAR;
        PG8_STAGE(PG8_SB(1, 0), cB + kstep, voffB); PG8_STAGE(PG8_SA(1, 0), cA + kstep, voffA); PG8_STAGE(PG8_SB(1, 1), cB + hstep + kstep, voffB);
        PG8_WAIT_V(6); PG8_BAR;
    } else {
        PG8_STAGE(PG8_SB(0, 0), cB, voffB); PG8_STAGE(PG8_SA(0, 0), cA, voffA); PG8_STAGE(PG8_SB(0, 1), cB + hstep, voffB); PG8_STAGE(PG8_SA(0, 1), cA + hstep, voffA);
        if (wr == 1) PG8_BAR;
        PG8_WAIT_V(4); PG8_BAR;
        PG8_STAGE(PG8_SB(1, 0), cB + kstep, voffB); PG8_STAGE(PG8_SA(1, 0), cA + kstep, voffA); PG8_STAGE(PG8_SB(1, 1), cB + hstep + kstep, voffB);
        PG8_WAIT_V(6); PG8_BAR;
    }
    for (;;) {
        const bool has_next = S.next(ui + 1, nxt);
        const char* nA = has_next ? (const char*)g.A + (size_t)nxt.pm * tstep : cA; const char* nB = has_next ? (const char*)g.Bt + (size_t)nxt.pn * tstep : cB;
        for (int t = 0; t < nt; t += 2) {
            const bool last = (t == nt - 2);
            const char* a1 = cA + (size_t)(t + 1) * kstep;
            const char* a2 = last ? nA : cA + (size_t)(t + 2) * kstep; const char* b2 = last ? nB : cB + (size_t)(t + 2) * kstep;
            const char* a3 = a2 + kstep; const char* b3 = b2 + kstep;
            if (last && has_next) S.a_ready(nxt);
            if constexpr (SP2) {
            PG8_LDB(B0, 0, 0); PG8_LDB(B1, 0, 1); PG8_SCHED; PG8_LDA(At, 0, 0); PG8_STAGE(PG8_SA(1, 1), a1 + hstep, voffA);
            PG8_WAIT_V(8); PG8_WAIT_L(0); PG8_BAR; PG8_MMA(0, 0, At, B0); PG8_MMA(0, 1, At, B1); PG8_BAR; PG8_SCHED;
            PG8_LDA(At, 0, 1); PG8_STAGE(PG8_SB(0, 0), b2, voffB); PG8_STAGE(PG8_SB(0, 1), b2 + hstep, voffB); PG8_STAGE(PG8_SA(0, 0), a2, voffA);
            PG8_WAIT_V(8); PG8_WAIT_L(0); PG8_BAR; PG8_MMA(1, 0, At, B0); PG8_MMA(1, 1, At, B1); PG8_BAR; PG8_SCHED;
            PG8_LDB(B0, 1, 0); PG8_LDB(B1, 1, 1); PG8_SCHED; PG8_LDA(At, 1, 0); PG8_STAGE(PG8_SA(0, 1), a2 + hstep, voffA);
            PG8_WAIT_V(8); PG8_WAIT_L(0); PG8_BAR; PG8_MMA(0, 0, At, B0); PG8_MMA(0, 1, At, B1); PG8_BAR; PG8_SCHED;
            PG8_LDA(At, 1, 1); PG8_STAGE(PG8_SB(1, 0), b3, voffB); PG8_STAGE(PG8_SB(1, 1), b3 + hstep, voffB); PG8_STAGE(PG8_SA(1, 0), a3, voffA);
            PG8_WAIT_V(8); PG8_WAIT_L(0); PG8_BAR; PG8_MMA(1, 0, At, B0); PG8_MMA(1, 1, At, B1); PG8_BAR; PG8_SCHED;
            } else {
            PG8_LDB(B0, 0, 0); PG8_SCHED; PG8_LDA(At, 0, 0); PG8_STAGE(PG8_SA(1, 1), a1 + hstep, voffA);
            PG8_WAIT_L(8); PG8_BAR; PG8_WAIT_L(0); PG8_MMA(0, 0, At, B0); PG8_BAR; PG8_SCHED;
            PG8_LDB(B1, 0, 1); PG8_STAGE(PG8_SB(0, 0), b2, voffB);
            PG8_BAR; PG8_WAIT_L(0); PG8_MMA(0, 1, At, B1); PG8_BAR;
            PG8_LDA(At, 0, 1); PG8_STAGE(PG8_SA(0, 0), a2, voffA);
            PG8_BAR; PG8_WAIT_L(0); PG8_MMA(1, 0, At, B0); PG8_BAR; PG8_SCHED;
            PG8_STAGE(PG8_SB(0, 1), b2 + hstep, voffB);
            PG8_WAIT_V(6); PG8_BAR; PG8_MMA(1, 1, At, B1); PG8_BAR;
            PG8_LDB(B0, 1, 0); PG8_SCHED; PG8_LDA(At, 1, 0); PG8_STAGE(PG8_SA(0, 1), a2 + hstep, voffA);
            PG8_WAIT_L(8); PG8_BAR; PG8_WAIT_L(0); PG8_MMA(0, 0, At, B0); PG8_BAR; PG8_SCHED;
            PG8_LDB(B1, 1, 1); PG8_STAGE(PG8_SB(1, 0), b3, voffB);
            PG8_BAR; PG8_WAIT_L(0); PG8_MMA(0, 1, At, B1); PG8_BAR;
            PG8_LDA(At, 1, 1); PG8_STAGE(PG8_SA(1, 0), a3, voffA);
            PG8_BAR; PG8_WAIT_L(0); PG8_MMA(1, 0, At, B0); PG8_BAR; PG8_SCHED;
            PG8_STAGE(PG8_SB(1, 1), b3 + hstep, voffB);
            PG8_WAIT_V(6); PG8_BAR; PG8_MMA(1, 1, At, B1); PG8_BAR;
            }
        }
        if constexpr (ALIGN_EPI) { if (wr == 0) PG8_BAR; }
        if constexpr (!Epi::AFTER_DRAIN) { E(acc, cur, wr, wc, fr, fq); S.done(cur); }
        if (!has_next) break;
#pragma unroll
        for (int a = 0; a < 2; ++a)
#pragma unroll
            for (int b = 0; b < 2; ++b)
#pragma unroll
                for (int m = 0; m < 4; ++m)
#pragma unroll
                    for (int n = 0; n < 2; ++n) acc[a][b][m][n] = (f32x4){0.f, 0.f, 0.f, 0.f};
        cur = nxt; cA = nA; cB = nB; ++ui;
        if constexpr (ALIGN_EPI) { if (wr == 1) PG8_BAR; }
    }
    PG8_WAIT_V(0);
    if constexpr (!ALIGN_EPI) { if (wr == 0) PG8_BAR; }
    PG8_BAR;
    if constexpr (Epi::AFTER_DRAIN) { E.fused(acc, cur, wr, wc, fr, fq, lds, wid, lane); S.done(cur); }
#undef PG8_SA
#undef PG8_SB
#undef PG8_STAGE
#undef PG8_LDA
#undef PG8_LDB
#undef PG8_MMA
#undef PG8_WAIT_V
#undef PG8_WAIT_L
#undef PG8_BAR
#undef PG8_SCHED
}
}
#define MK_ONE_LAUNCH 1

constexpr int NB = 4, SEQ = 8192, T = NB * SEQ, D = 1024;
constexpr int NIN = 3584, DH = 512, HD = 128, NHH = 4, CHK = 64;
constexpr int NSEG = 16, SEGC = 8;
constexpr int CW = 31, CPAD = 15, DC = 512;
constexpr int PHEADS = 8, NQK = 2048, NSEL = 128;
constexpr float EPS = 1e-6f;
constexpr int NWAVES = 8, NTHR = 512;

constexpr size_t MiB = 1u << 20;
constexpr size_t WS_CTL = 0, CTL_ZERO_BYTES = 65536;
constexpr size_t WS_MOD = 1 * MiB, WS_FMOD = WS_MOD + 131072, WS_LB = WS_MOD + 196608, WS_BIASQ = WS_MOD + 262144;
constexpr size_t WS_WIN = 2 * MiB, WS_WOUT = 10 * MiB, WS_WQK = 12 * MiB;
constexpr size_t WS_UT = 16 * MiB, WS_VT = 48 * MiB;
constexpr size_t WS_BUFA = 80 * MiB;
constexpr size_t WS_BUFB = 144 * MiB;
constexpr size_t WS_SEG = 208 * MiB;
constexpr size_t WS_E = 208 * MiB, WS_W = 224 * MiB;
constexpr size_t WS_BIG = 240 * MiB;
constexpr size_t WS_SSQ = 496 * MiB;
constexpr size_t WS_SEGA = 498 * MiB;
constexpr size_t WS_RSTD = 499 * MiB;
constexpr size_t WS_END = 500 * MiB;
constexpr size_t WS_PACT = 240 * MiB;
constexpr size_t WS_Y = 368 * MiB;
constexpr int NSL = 8, CSL = 128;
constexpr float VSCALE = 16.0f;
constexpr float UQSCALE = 677.0f;
constexpr int CW_QU = 8192, CW_QV = 8192 + 64 * 16;
constexpr int CW_BAR = 1024;

#ifndef LDSFILL
#define LDSFILL 0u
#endif
constexpr int LDS_BYTES = 155648;
constexpr int MISC_OFF = LDS_BYTES - 256;

#define GAS __attribute__((address_space(1)))
#define LAS __attribute__((address_space(3)))
typedef unsigned short bf16;
typedef unsigned v4u __attribute__((ext_vector_type(4)));
typedef unsigned v2u __attribute__((ext_vector_type(2)));
typedef float f32x4 __attribute__((ext_vector_type(4)));
typedef float f32x16 __attribute__((ext_vector_type(16)));
typedef short bf16x8 __attribute__((ext_vector_type(8)));
typedef float f32x2_ __attribute__((ext_vector_type(2)));

__device__ __forceinline__ float bf2f(unsigned h) { return __builtin_bit_cast(float, h << 16); }
__device__ __forceinline__ float bflo(unsigned u) { return __builtin_bit_cast(float, u << 16); }
__device__ __forceinline__ float bfhi(unsigned u) { return __builtin_bit_cast(float, u & 0xffff0000u); }
__device__ __forceinline__ unsigned f2bf(float f) { unsigned u = __builtin_bit_cast(unsigned, f); return (u + 0x7fffu + ((u >> 16) & 1u)) >> 16; }
__device__ __forceinline__ unsigned pk2(float lo, float hi) { return f2bf(lo) | (f2bf(hi) << 16); }
__device__ __forceinline__ unsigned cvtpk(float lo, float hi) { unsigned r; asm("v_cvt_pk_bf16_f32 %0, %1, %2" : "=v"(r) : "v"(lo), "v"(hi)); return r; }
__device__ __forceinline__ float sigmoidf_(float x) { return __builtin_amdgcn_rcpf(1.0f + __expf(-x)); }
#define DPP_ADD(s, ctrl) ((s) + __builtin_bit_cast(float, __builtin_amdgcn_update_dpp(0, __builtin_bit_cast(int, (s)), (ctrl), 0xF, 0xF, false)))
__device__ __forceinline__ float wave_sum(float v) {
#pragma unroll
    for (int o = 1; o < 64; o <<= 1) v += __shfl_xor(v, o);
    return v;
}

#define XB_TMO      128
#define XB_XCNT(j)  (256  + 64 * (j))
#define XB_XSUB(j)  (1280 + 64 * (j))
#define XB_XGEN(j)  (2304 + 64 * (j))
#define XB_TOP      3328
#define XB_TOPGEN   3392
#define XCD_BAR_WORDS 3456
#define XB_SPIN_CAP (1u << 18)
__device__ __forceinline__ unsigned xb_ld(unsigned* p)              { return __hip_atomic_load(p, __ATOMIC_RELAXED, __HIP_MEMORY_SCOPE_AGENT); }
__device__ __forceinline__ unsigned xb_add(unsigned* p, unsigned v) { return __hip_atomic_fetch_add(p, v, __ATOMIC_RELAXED, __HIP_MEMORY_SCOPE_AGENT); }
__device__ __forceinline__ unsigned xb_xcc_id() { return (unsigned)__builtin_amdgcn_s_getreg((3 << 11) | 20) & 0xFu; }
#define XB_SPIN(cond, bar) do { unsigned _sp = 0; while (cond) { __builtin_amdgcn_s_sleep(1); \
    if ((++_sp & 255u) == 0u) { if (xb_ld(&(bar)[XB_TMO])) break; if (_sp > XB_SPIN_CAP) { atomicAdd(&(bar)[XB_TMO], 1u); break; } } } } while (0)
struct XcdBarrier { unsigned* bar; unsigned x; volatile LAS unsigned* st; };
__device__ __forceinline__ XcdBarrier xcd_barrier_post(unsigned* bar, volatile LAS unsigned* st) {
    XcdBarrier b; b.bar = bar; b.x = xb_xcc_id(); b.st = st;
    if (threadIdx.x == 0) (void)xb_add(&bar[XB_XCNT(b.x)], 1u);
    return b;
}
__device__ __forceinline__ void xcd_barrier_complete(unsigned* bar, unsigned x, unsigned& nloc, unsigned& nx) {
    const unsigned G = gridDim.x * gridDim.y * gridDim.z;
    unsigned sum, cnt, mine, sp = 0u;
    for (;;) {
        sum = 0u; cnt = 0u; mine = 0u;
#pragma unroll
        for (unsigned j = 0; j < 16; ++j) { const unsigned c = xb_ld(&bar[XB_XCNT(j)]); sum += c; cnt += (c > 0u) ? 1u : 0u; mine = (j == x) ? c : mine; }
        if (sum == G) break;
        __builtin_amdgcn_s_sleep(1);
        if ((++sp & 255u) == 0u) { if (xb_ld(&bar[XB_TMO])) break; if (sp > XB_SPIN_CAP) { atomicAdd(&bar[XB_TMO], 1u); break; } }
    }
    nloc = mine > 0u ? mine : 1u; nx = cnt > 0u ? cnt : 1u;
}
__device__ __forceinline__ void xcd_barrier(const XcdBarrier& b) {
    asm volatile("s_waitcnt vmcnt(0)" ::: "memory");
    __syncthreads();
    if (threadIdx.x == 0) {
        unsigned* bar = b.bar;
        __builtin_amdgcn_s_waitcnt(0);
        unsigned nloc = b.st[0], nx = b.st[1];
        if (nloc == 0u) { xcd_barrier_complete(bar, b.x, nloc, nx); b.st[0] = nloc; b.st[1] = nx; }
        const unsigned old = xb_add(&bar[XB_XSUB(b.x)], 1u);
        const unsigned gen = old / nloc;
        if (old + 1u == (gen + 1u) * nloc) {
            __builtin_amdgcn_fence(__ATOMIC_RELEASE, "agent");
            asm volatile("s_waitcnt vmcnt(0)" ::: "memory");
            const unsigned og = xb_add(&bar[XB_TOP], 1u);
            const unsigned tg = og / nx;
            if (og + 1u == (tg + 1u) * nx) xb_add(&bar[XB_TOPGEN], 1u);
            else XB_SPIN(xb_ld(&bar[XB_TOPGEN]) == tg, bar);
            __builtin_amdgcn_fence(__ATOMIC_ACQUIRE, "agent");
            xb_add(&bar[XB_XGEN(b.x)], 1u);
            asm volatile("s_waitcnt vmcnt(0)" ::: "memory");
        } else {
            XB_SPIN(xb_ld(&bar[XB_XGEN(b.x)]) == gen, bar);
            __builtin_amdgcn_fence(__ATOMIC_ACQUIRE, "agent");
            asm volatile("s_waitcnt vmcnt(0)" ::: "memory");
        }
    }
    __syncthreads();
}

struct Args { const float* in[23]; float* out; unsigned char* ws; int ph_lo, ph_hi; };
struct Frame {
    LAS unsigned char* lds;
    int tid, lane, wave, G, bid;
    const Args* a;
    __device__ __forceinline__ const float* x() const { return a->in[0]; }
    __device__ __forceinline__ const float* c() const { return a->in[1]; }
    __device__ __forceinline__ const float* ada_w() const { return a->in[2]; }
    __device__ __forceinline__ const float* ada_b() const { return a->in[3]; }
    __device__ __forceinline__ const float* g_mix() const { return a->in[4]; }
    __device__ __forceinline__ const float* w_in() const { return a->in[5]; }
    __device__ __forceinline__ const float* lbg_f() const { return a->in[6]; }
    __device__ __forceinline__ const float* lbg_b() const { return a->in[7]; }
    __device__ __forceinline__ const float* hnorm_g() const { return a->in[8]; }
    __device__ __forceinline__ const float* conv_w() const { return a->in[9]; }
    __device__ __forceinline__ const float* conv_b() const { return a->in[10]; }
    __device__ __forceinline__ const float* cln_g() const { return a->in[11]; }
    __device__ __forceinline__ const float* cln_b() const { return a->in[12]; }
    __device__ __forceinline__ const float* w_out() const { return a->in[13]; }
    __device__ __forceinline__ const float* g_ffn() const { return a->in[14]; }
    __device__ __forceinline__ const float* wq() const { return a->in[15]; }
    __device__ __forceinline__ const float* keys1() const { return a->in[16]; }
    __device__ __forceinline__ const float* keys2() const { return a->in[17]; }
    __device__ __forceinline__ const float* utab() const { return a->in[18]; }
    __device__ __forceinline__ const float* vtab() const { return a->in[19]; }
    __device__ __forceinline__ const float* fada_w() const { return a->in[20]; }
    __device__ __forceinline__ const float* fada_b() const { return a->in[21]; }
    __device__ __forceinline__ const float* fnorm_g() const { return a->in[22]; }
    __device__ __forceinline__ float* out() const { return a->out; }
    __device__ __forceinline__ float* mod() const { return (float*)(a->ws + WS_MOD); }
    __device__ __forceinline__ float* fmod() const { return (float*)(a->ws + WS_FMOD); }
    __device__ __forceinline__ float* lb() const { return (float*)(a->ws + WS_LB); }
    __device__ __forceinline__ float* biasq() const { return (float*)(a->ws + WS_BIASQ); }
    __device__ __forceinline__ float* ssqp() const { return (float*)(a->ws + WS_SSQ); }
    __device__ __forceinline__ float* sega() const { return (float*)(a->ws + WS_SEGA); }
    __device__ __forceinline__ float* segu() const { return (float*)(a->ws + WS_SEG); }
    __device__ __forceinline__ float* of() const { return (float*)(a->ws + WS_BUFB); }
    __device__ __forceinline__ float* scores() const { return (float*)(a->ws + WS_BIG); }
    __device__ __forceinline__ float* wsel() const { return (float*)(a->ws + WS_W); }
    __device__ __forceinline__ int* esel() const { return (int*)(a->ws + WS_E); }
    __device__ __forceinline__ bf16* Win_t() const { return (bf16*)(a->ws + WS_WIN); }
    __device__ __forceinline__ bf16* Wout_t() const { return (bf16*)(a->ws + WS_WOUT); }
    __device__ __forceinline__ bf16* Wqk_t() const { return (bf16*)(a->ws + WS_WQK); }
    __device__ __forceinline__ bf16* Ub() const { return (bf16*)(a->ws + WS_UT); }
    __device__ __forceinline__ bf16* Vb() const { return (bf16*)(a->ws + WS_VT); }
    __device__ __forceinline__ bf16* bufA() const { return (bf16*)(a->ws + WS_BUFA); }
    __device__ __forceinline__ bf16* hg() const { return (bf16*)(a->ws + WS_BUFB); }
    __device__ __forceinline__ bf16* proj() const { return (bf16*)(a->ws + WS_BIG); }
    __device__ __forceinline__ float* coef() const { return (float*)(a->ws + WS_BUFA); }
    __device__ __forceinline__ float* rstd() const { return (float*)(a->ws + WS_RSTD); }
    __device__ __forceinline__ bf16* pact() const { return (bf16*)(a->ws + WS_PACT); }
    __device__ __forceinline__ bf16* ybuf() const { return (bf16*)(a->ws + WS_Y); }
    __device__ __forceinline__ unsigned char* U8() const { return (unsigned char*)(a->ws + WS_UT); }
    __device__ __forceinline__ unsigned char* V8() const { return (unsigned char*)(a->ws + WS_VT); }
    __device__ __forceinline__ unsigned* ctl() const { return (unsigned*)(a->ws + WS_CTL); }
};

__device__ __forceinline__ void p0_gemv(Frame& F) {
    LAS float* cact = (LAS float*)(F.lds);
    LAS float* red = (LAS float*)(F.lds + 16384);
    for (int i = F.tid; i < 4096; i += NTHR) { const float c = F.c()[i]; cact[i] = c * sigmoidf_(c); }
    __syncthreads();
    for (int item = F.bid; item < 128; item += F.G) {
        const int col0 = item * 64; const float* W; int N, cc;
        if (col0 < 6144) { W = F.ada_w(); N = 6144; cc = col0; } else { W = F.fada_w(); N = 2048; cc = col0 - 6144; }
        const float* wp = W + (size_t)(F.wave * 128) * N + cc + F.lane;
        float a0 = 0.f, a1 = 0.f, a2 = 0.f, a3 = 0.f;
#pragma unroll 32
        for (int k = 0; k < 128; ++k) { const float w = wp[(size_t)k * N]; const int kk = F.wave * 128 + k;
            a0 += cact[kk] * w; a1 += cact[1024 + kk] * w; a2 += cact[2048 + kk] * w; a3 += cact[3072 + kk] * w; }
        red[(F.wave * 4 + 0) * 64 + F.lane] = a0; red[(F.wave * 4 + 1) * 64 + F.lane] = a1; red[(F.wave * 4 + 2) * 64 + F.lane] = a2; red[(F.wave * 4 + 3) * 64 + F.lane] = a3;
        __syncthreads();
        if (F.tid < 256) { const int b = F.tid >> 6, l = F.tid & 63; float s = 0.f;
#pragma unroll
            for (int w = 0; w < 8; ++w) s += red[(w * 4 + b) * 64 + l];
            if (col0 < 6144) F.mod()[b * 6144 + cc + l] = s + F.ada_b()[cc + l]; else F.fmod()[b * 2048 + cc + l] = s + F.fada_b()[cc + l]; }
        __syncthreads();
    }
}
__device__ __forceinline__ void p0_transpose_item(const float* W, int K, int N, bf16* WT, LAS float* scr, int item, int lane) {
    const int nblk = N / 32, kb = item / nblk, nb = item % nblk, k0 = 64 * kb, n0 = 32 * nb;
#pragma unroll
    for (int i = 0; i < 32; ++i) { const int kk = 2 * i + (lane >> 5); scr[kk * 33 + (lane & 31)] = W[(size_t)(k0 + kk) * N + n0 + (lane & 31)]; }
    asm volatile("s_waitcnt lgkmcnt(0)" ::: "memory");
    const int c = lane & 7;
#pragma unroll
    for (int j = 0; j < 4; ++j) { const int n = (lane >> 3) + 8 * j; const LAS float* s = scr + (8 * c) * 33 + n;
        v4u o; o.x = pk2(s[0 * 33], s[1 * 33]); o.y = pk2(s[2 * 33], s[3 * 33]); o.z = pk2(s[4 * 33], s[5 * 33]); o.w = pk2(s[6 * 33], s[7 * 33]);
        *(v4u*)(WT + (size_t)(n0 + n) * K + k0 + 8 * c) = o; }
    asm volatile("s_waitcnt lgkmcnt(0)" ::: "memory");
}
__device__ __forceinline__ void p0_wqk_item(Frame& F, int item, LAS float* scr) {
    const int jq = item & 7, kb = (item >> 3) & 15, hh = item >> 7, h = hh >> 1, half = hh & 1;
    const float* keys = (half ? F.keys2() : F.keys1()) + (size_t)(jq * 16) * 128;
    const float* wtile = F.wq() + (size_t)(kb * 64) * 2048 + h * 256 + half * 128;
    float acc[16];
#pragma unroll
    for (int j = 0; j < 16; ++j) acc[j] = 0.f;
    f32x4 t4[4], n4[4];
#pragma unroll
    for (int i = 0; i < 4; ++i) t4[i] = *(const f32x4*)(wtile + (size_t)(16 * i + (F.lane >> 2)) * 2048 + 4 * (F.lane & 3));
    for (int d0 = 0; d0 < 128; d0 += 16) {
        if (d0 + 16 < 128) {
#pragma unroll
            for (int i = 0; i < 4; ++i) n4[i] = *(const f32x4*)(wtile + (size_t)(16 * i + (F.lane >> 2)) * 2048 + d0 + 16 + 4 * (F.lane & 3)); }
#pragma unroll
        for (int i = 0; i < 4; ++i) *(LAS f32x4*)(scr + (16 * i + (F.lane >> 2)) * 20 + 4 * (F.lane & 3)) = t4[i];
        asm volatile("s_waitcnt lgkmcnt(0)" ::: "memory");
#pragma unroll
        for (int dd = 0; dd < 16; dd += 4) { const f32x4 a = *(LAS const f32x4*)(scr + F.lane * 20 + dd);
#pragma unroll
            for (int j = 0; j < 16; ++j) { const float* kp = keys + j * 128 + d0 + dd; acc[j] += a[0] * kp[0] + a[1] * kp[1] + a[2] * kp[2] + a[3] * kp[3]; } }
        asm volatile("s_waitcnt lgkmcnt(0)" ::: "memory");
#pragma unroll
        for (int i = 0; i < 4; ++i) t4[i] = n4[i];
    }
    bf16* o = F.Wqk_t() + (size_t)(h * 256 + half * 128 + jq * 16) * 1024 + kb * 64 + F.lane;
#pragma unroll
    for (int j = 0; j < 16; ++j) o[(size_t)j * 1024] = (bf16)f2bf(acc[j]);
}
__device__ __forceinline__ void p0_prologue(Frame& F) {
    if (F.bid < 128) p0_gemv(F);
    if (F.bid == 128 % F.G) { const int i = F.tid;
        F.lb()[i] = __builtin_amdgcn_rcpf(1.0f + __expf(F.lbg_f()[512 + i] - F.lbg_f()[i]));
        F.lb()[512 + i] = __builtin_amdgcn_rcpf(1.0f + __expf(F.lbg_b()[512 + i] - F.lbg_b()[i])); }
    LAS float* scr = (LAS float*)(F.lds + 32768 + F.wave * 8704);
    const int gw = F.wave * F.G + F.bid, NGW = F.G * NWAVES;
    constexpr int I_QK = 2048, I_IN = (D / 64) * (NIN / 32), I_OUT = (D / 64) * (D / 32), I_TAB = 2 * 16384 / 4;
    constexpr int NITEMS = I_QK + I_IN + I_OUT + I_TAB;
    for (int it = gw; it < NITEMS; it += NGW) {
        int r = it;
        if (r < I_QK) { p0_wqk_item(F, r, scr); continue; } r -= I_QK;
        if (r < I_IN) { p0_transpose_item(F.w_in(), D, NIN, F.Win_t(), scr, r, F.lane); continue; } r -= I_IN;
        if (r < I_OUT) { p0_transpose_item(F.w_out(), D, D, F.Wout_t(), scr, r, F.lane); continue; } r -= I_OUT;
        { const int tab = r >= 4096, rr = (tab ? r - 4096 : r) * 4; const float* src = (tab ? F.vtab() : F.utab()) + (size_t)rr * 1024; unsigned char* dst = tab ? F.V8() : F.U8();
          const float sc = tab ? VSCALE : UQSCALE;
#pragma unroll
          for (int q = 0; q < 16; ++q) { const int row = rr + (q >> 2), qq = q & 3; const f32x4 v = *(const f32x4*)(src + (q >> 2) * 1024 + qq * 256 + 4 * F.lane) * sc;
              int pk;
              if (tab) { pk = __builtin_amdgcn_cvt_pk_fp8_f32(v[0], v[1], 0, false); pk = __builtin_amdgcn_cvt_pk_fp8_f32(v[2], v[3], pk, true); }
              else { int q0 = (int)__builtin_rintf(v[0]), q1 = (int)__builtin_rintf(v[1]), q2 = (int)__builtin_rintf(v[2]), q3 = (int)__builtin_rintf(v[3]);
                  q0 = q0 < -127 ? -127 : (q0 > 127 ? 127 : q0); q1 = q1 < -127 ? -127 : (q1 > 127 ? 127 : q1); q2 = q2 < -127 ? -127 : (q2 > 127 ? 127 : q2); q3 = q3 < -127 ? -127 : (q3 > 127 ? 127 : q3);
                  pk = (q0 & 0xff) | ((q1 & 0xff) << 8) | ((q2 & 0xff) << 16) | (q3 << 24); }
              const int sl = 2 * qq + (F.lane >> 5);
              *(int*)(dst + ((size_t)sl * 16384 + row) * CSL + 4 * (F.lane & 31)) = pk; } }
    }
}

__device__ __forceinline__ void p1_norm(Frame& F) {
    const int gwc = F.bid * NWAVES + F.wave, NGW = F.G * NWAVES;
    for (int row0 = gwc * 16; row0 < T; row0 += NGW * 16) {
        const int b = row0 >> 13; const float* mb = F.mod() + b * 6144;
        f32x4 ca[4], cb[4];
#pragma unroll
        for (int j = 0; j < 4; ++j) { const int k = 256 * j + 4 * F.lane; const f32x4 g = *(const f32x4*)(F.g_mix() + k), s = *(const f32x4*)(mb + 1024 + k); ca[j] = g * (s + 1.0f); cb[j] = *(const f32x4*)(mb + k); }
#pragma unroll 4
        for (int r = 0; r < 16; ++r) { const float* xr = F.x() + (size_t)(row0 + r) * D;
            f32x4 v[4]; float ss = 0.f;
#pragma unroll
            for (int j = 0; j < 4; ++j) { v[j] = *(const f32x4*)(xr + 256 * j + 4 * F.lane); ss += v[j][0] * v[j][0] + v[j][1] * v[j][1] + v[j][2] * v[j][2] + v[j][3] * v[j][3]; }
            const float rstd = __builtin_amdgcn_rsqf(wave_sum(ss) * (1.0f / D) + EPS);
            bf16* o = F.bufA() + (size_t)(row0 + r) * D;
#pragma unroll
            for (int j = 0; j < 4; ++j) { const f32x4 y = v[j] * rstd * ca[j] + cb[j]; v2u w; w.x = pk2(y[0], y[1]); w.y = pk2(y[2], y[3]); *(v2u*)(o + 256 * j + 4 * F.lane) = w; } }
    }
    const int gw = F.wave * F.G + F.bid;
    for (int n0 = gw * 32; n0 < NQK; n0 += NGW * 32) {
        float sv[4][16];
#pragma unroll
        for (int b = 0; b < 4; ++b) { const float* sh2 = F.mod() + b * 6144 + 3072;
#pragma unroll
            for (int i = 0; i < 8; ++i) { sv[b][i] = sh2[8 * F.lane + i]; sv[b][8 + i] = sh2[512 + 8 * F.lane + i]; } }
        float res[4] = {0.f, 0.f, 0.f, 0.f};
        for (int q = 0; q < 32; ++q) { const int n = n0 + q;
            const v4u w0 = *(const v4u*)(F.Wqk_t() + (size_t)n * 1024 + 8 * F.lane), w1 = *(const v4u*)(F.Wqk_t() + (size_t)n * 1024 + 512 + 8 * F.lane);
            float wv[16];
#pragma unroll
            for (int i = 0; i < 4; ++i) { wv[2 * i] = bflo(w0[i]); wv[2 * i + 1] = bfhi(w0[i]); wv[8 + 2 * i] = bflo(w1[i]); wv[8 + 2 * i + 1] = bfhi(w1[i]); }
#pragma unroll
            for (int b = 0; b < 4; ++b) { float sm = 0.f;
#pragma unroll
                for (int i = 0; i < 16; ++i) sm += wv[i] * sv[b][i];
                sm = wave_sum(sm); if (F.lane == q) res[b] = sm; } }
        if (F.lane < 32) {
#pragma unroll
            for (int b = 0; b < 4; ++b) F.biasq()[b * 2048 + n0 + F.lane] = res[b]; }
    }
}

__device__ __forceinline__ void conv_item(Frame& F, int item, const float (&cw)[CW], float cbias) {
    LAS bf16* hbuf = (LAS bf16*)(F.lds);
    LAS float* ybuf = (LAS float*)(F.lds + 65536);
    const int tok0 = item * 32, b = tok0 >> 13, t0 = tok0 & (SEQ - 1), c = F.tid;
#pragma unroll
    for (int k = 0; k < 8; ++k) { const int pi = F.tid + NTHR * k; if (pi < 62 * 64) { const int r = pi >> 6, ch = pi & 63, t = t0 - CPAD + r; v4u o = {0u, 0u, 0u, 0u};
            if (t >= 0 && t < SEQ) { const bf16* pr = F.proj() + (size_t)(b * SEQ + t) * NIN + 8 * ch; const v4u a = *(const v4u*)(pr + 2560), g = *(const v4u*)(pr + 3072);
#pragma unroll
                for (int i = 0; i < 4; ++i) o[i] = cvtpk(bflo(a[i]) * bflo(g[i]), bfhi(a[i]) * bfhi(g[i])); }
            *(LAS v4u*)(hbuf + r * 512 + 8 * ch) = o; } }
    __syncthreads();
    float hv[62];
#pragma unroll
    for (int r = 0; r < 62; ++r) hv[r] = bf2f(hbuf[r * 512 + c]);
#pragma unroll
    for (int tt = 0; tt < 32; ++tt) { float acc = cbias;
#pragma unroll
        for (int j = 0; j < CW; ++j) acc += cw[j] * hv[tt + j];
        ybuf[tt * 512 + c] = acc; }
    __syncthreads();
#pragma unroll
    for (int q = 0; q < 4; ++q) { const int tt = F.wave * 4 + q;
        const f32x4 y0 = *(LAS const f32x4*)(ybuf + tt * 512 + 8 * F.lane), y1 = *(LAS const f32x4*)(ybuf + tt * 512 + 8 * F.lane + 4);
        const float mean = wave_sum((y0[0] + y0[1] + y0[2] + y0[3]) + (y1[0] + y1[1] + y1[2] + y1[3])) * (1.0f / DC);
        const f32x4 d0 = y0 - mean, d1 = y1 - mean;
        const float var = wave_sum((d0[0] * d0[0] + d0[1] * d0[1] + d0[2] * d0[2] + d0[3] * d0[3]) + (d1[0] * d1[0] + d1[1] * d1[1] + d1[2] * d1[2] + d1[3] * d1[3])) * (1.0f / DC);
        const float rstd = __builtin_amdgcn_rsqf(var + EPS);
        const f32x4 g0 = *(const f32x4*)(F.cln_g() + 8 * F.lane), g1 = *(const f32x4*)(F.cln_g() + 8 * F.lane + 4), b0 = *(const f32x4*)(F.cln_b() + 8 * F.lane), b1 = *(const f32x4*)(F.cln_b() + 8 * F.lane + 4);
        f32x4 z0 = d0 * rstd * g0 + b0, z1 = d1 * rstd * g1 + b1;
#pragma unroll
        for (int i = 0; i < 4; ++i) { z0[i] = z0[i] * sigmoidf_(z0[i]); z1[i] = z1[i] * sigmoidf_(z1[i]); }
        v4u w; w.x = cvtpk(z0[0], z0[1]); w.y = cvtpk(z0[2], z0[3]); w.z = cvtpk(z1[0], z1[1]); w.w = cvtpk(z1[2], z1[3]);
        *(v4u*)(F.bufA() + (size_t)(tok0 + tt) * D + 512 + 8 * F.lane) = w; }
    __syncthreads();
}

constexpr int PQ = 272, PT = 144;
constexpr int HL_QR = 0, HL_KR = 17408, HL_QE = 34816, HL_KET = 52224, HL_VT = 70656, HL_SCM = 89088, HL_ST = 98304, HL_PBLK = 133120  , HL_AV = 137216, HL_RS = 137728;
static_assert(HL_PBLK + 8 * 128 * 4 <= HL_AV && HL_AV + 512 <= HL_RS && HL_RS + 1024 <= 155648 - 256, "HGRN LDS map");
__device__ __forceinline__ bf16x8 ldf(LAS const unsigned char* base, int row, int pitch, int kbyte) { return *(LAS const bf16x8*)(base + row * pitch + kbyte); }
#define MFMA32(a, b, c) __builtin_amdgcn_mfma_f32_32x32x16_bf16((a), (b), (c), 0, 0, 0)

template <bool FULL>
__device__ __forceinline__ void hgrn_load(Frame& F, int b, int h, int dir, int chunk, unsigned (&rz)[8], unsigned (&rv)[8], unsigned (&rq)[8]) {
    const size_t tokbase = (size_t)b * SEQ + (size_t)chunk * CHK; const int zoff = dir ? 1024 : 512, c0 = 2 * F.lane;
#pragma unroll
    for (int i = 0; i < 8; ++i) { const int p = 8 * F.wave + i, tr = dir ? (63 - p) : p; const bf16* q = F.proj() + (tokbase + tr) * NIN + h * HD;
        rz[i] = *(const unsigned*)(q + zoff + c0); rv[i] = *(const unsigned*)(q + 1536 + c0); if (FULL) rq[i] = *(const unsigned*)(q + c0); }
}
template <bool FULL, int MODE>
__device__ __forceinline__ void hgrn_chunk(Frame& F, int b, int h, int dir, int chunk, int nchunk, f32x16 (&accS)[2], float lb0, float lb1, unsigned (&rz)[8], unsigned (&rv)[8], unsigned (&rq)[8]) {
    LAS unsigned char* lds = F.lds;
    int r = F.lane & 31, hh = F.lane >> 5, c0 = 2 * F.lane;
    asm volatile("" : "+v"(r), "+v"(hh), "+v"(c0));
    const int w = F.wave, rb = w;
    const size_t tokbase = (size_t)b * SEQ + (size_t)chunk * CHK;
    {
        const f32x2_ oml = {1.0f - lb0, 1.0f - lb1};
        f32x2_ f2[8], cf2[8], cr2[8];
        f32x2_ run = {1.f, 1.f};
#pragma unroll
        for (int i = 0; i < 8; ++i) { const f32x2_ kk = {bflo(rz[i]), bfhi(rz[i])}; f2[i] = 1.0f - oml * kk; run *= f2[i]; cf2[i] = run; }
        { f32x2_ q = {1.f, 1.f};
#pragma unroll
          for (int i = 7; i >= 0; --i) { cr2[i] = q; q *= f2[i]; } }
        LAS float* pblk = (LAS float*)(lds + HL_PBLK);
        *(LAS f32x2_*)(pblk + rb * 128 + c0) = run;
        __syncthreads();
        f32x2_ pre = {1.f, 1.f}, post = {1.f, 1.f}, mid = {1.f, 1.f};
        for (int q = 0; q < rb; ++q) pre *= *(LAS const f32x2_*)(pblk + q * 128 + c0);
        for (int q = rb + 1; q < 8; ++q) post *= *(LAS const f32x2_*)(pblk + q * 128 + c0);
        if (rb < 4) { for (int q = rb + 1; q < 4; ++q) mid *= *(LAS const f32x2_*)(pblk + q * 128 + c0); }
        else { for (int q = 4; q < rb; ++q) mid *= *(LAS const f32x2_*)(pblk + q * 128 + c0); }
        if (rb == 0) *(LAS f32x2_*)((LAS float*)(lds + HL_AV) + c0) = run * post;
        f32x2_ ke2[8];
#pragma unroll
        for (int i = 0; i < 8; ++i) ke2[i] = (1.0f - f2[i]) * cr2[i] * post;
        if (FULL) {
            if (rb < 4) {
#pragma unroll
                for (int i = 0; i < 8; ++i) { const int p = 8 * rb + i; const f32x2_ qs = {bflo(rq[i]), bfhi(rq[i])}, k2 = 1.0f - f2[i], G = cr2[i] * mid;
                    f32x2_ iG; iG[0] = __builtin_amdgcn_rcpf(G[0]); iG[1] = __builtin_amdgcn_rcpf(G[1]);
                    const f32x2_ qe = qs * pre * cf2[i], qr = qs * iG, kr = k2 * G;
                    *(LAS unsigned*)(lds + HL_QE + p * PQ + c0 * 2) = cvtpk(qe[0], qe[1]);
                    *(LAS unsigned*)(lds + HL_QR + p * PQ + c0 * 2) = cvtpk(qr[0], qr[1]);
                    *(LAS unsigned*)(lds + HL_KR + p * PQ + c0 * 2) = cvtpk(kr[0], kr[1]); }
            } else {
#pragma unroll
                for (int i = 0; i < 8; ++i) { const int p = 8 * rb + i; const f32x2_ qs = {bflo(rq[i]), bfhi(rq[i])}, k2 = 1.0f - f2[i], G = cf2[i] * mid;
                    f32x2_ iG; iG[0] = __builtin_amdgcn_rcpf(G[0]); iG[1] = __builtin_amdgcn_rcpf(G[1]);
                    const f32x2_ qe = qs * pre * cf2[i], qr = qs * G, kr = k2 * iG;
                    *(LAS unsigned*)(lds + HL_QE + p * PQ + c0 * 2) = cvtpk(qe[0], qe[1]);
                    *(LAS unsigned*)(lds + HL_QR + p * PQ + c0 * 2) = cvtpk(qr[0], qr[1]);
                    *(LAS unsigned*)(lds + HL_KR + p * PQ + c0 * 2) = cvtpk(kr[0], kr[1]); }
            }
        }
        v4u ka, kb, va, vb2;
        ka.x = cvtpk(ke2[0][0], ke2[1][0]); ka.y = cvtpk(ke2[2][0], ke2[3][0]); ka.z = cvtpk(ke2[4][0], ke2[5][0]); ka.w = cvtpk(ke2[6][0], ke2[7][0]);
        kb.x = cvtpk(ke2[0][1], ke2[1][1]); kb.y = cvtpk(ke2[2][1], ke2[3][1]); kb.z = cvtpk(ke2[4][1], ke2[5][1]); kb.w = cvtpk(ke2[6][1], ke2[7][1]);
        va.x = (rv[0] & 0xffffu) | (rv[1] << 16); va.y = (rv[2] & 0xffffu) | (rv[3] << 16); va.z = (rv[4] & 0xffffu) | (rv[5] << 16); va.w = (rv[6] & 0xffffu) | (rv[7] << 16);
        vb2.x = (rv[0] >> 16) | (rv[1] & 0xffff0000u); vb2.y = (rv[2] >> 16) | (rv[3] & 0xffff0000u); vb2.z = (rv[4] >> 16) | (rv[5] & 0xffff0000u); vb2.w = (rv[6] >> 16) | (rv[7] & 0xffff0000u);
        *(LAS v4u*)(lds + HL_KET + c0 * PT + 16 * rb) = ka; *(LAS v4u*)(lds + HL_KET + (c0 + 1) * PT + 16 * rb) = kb;
        *(LAS v4u*)(lds + HL_VT + c0 * PT + 16 * rb) = va; *(LAS v4u*)(lds + HL_VT + (c0 + 1) * PT + 16 * rb) = vb2;
    }
    if (nchunk >= 0) hgrn_load<FULL>(F, b, h, dir, nchunk, rz, rv, rq);
    __syncthreads();
    const int pbO = w & 1, vb = w >> 1;
    f32x16 accO, accU[2];
#pragma unroll
    for (int i = 0; i < 16; ++i) { accO[i] = 0.f; accU[0][i] = 0.f; accU[1][i] = 0.f; }
    if (FULL) {
        if (w < 3) { const int pbS = (w + 1) >> 1, sbS = (w == 2) ? 1 : 0; f32x16 sc;
#pragma unroll
            for (int i = 0; i < 16; ++i) sc[i] = 0.f;
#pragma unroll
            for (int s = 0; s < 8; ++s) sc = MFMA32(ldf(lds + HL_QR, pbS * 32 + r, PQ, 32 * s + 16 * hh), ldf(lds + HL_KR, sbS * 32 + r, PQ, 32 * s + 16 * hh), sc);
#pragma unroll
            for (int i = 0; i < 16; i += 2) { const int p = pbS * 32 + (i & 3) + 8 * (i >> 2) + 4 * hh, s = sbS * 32 + r;
                const unsigned pkd = cvtpk(s <= p ? sc[i] : 0.f, s <= p + 1 ? sc[i + 1] : 0.f);
                *(LAS bf16*)(lds + HL_SCM + p * PT + s * 2) = (bf16)pkd; *(LAS bf16*)(lds + HL_SCM + (p + 1) * PT + s * 2) = (bf16)(pkd >> 16); } }
        __builtin_amdgcn_sched_barrier(0);
#pragma unroll
        for (int s = 0; s < 8; ++s) accO = MFMA32(ldf(lds + HL_QE, pbO * 32 + r, PQ, 32 * s + 16 * hh), ldf(lds + HL_ST, vb * 32 + r, PQ, 32 * s + 16 * hh), accO);
        __builtin_amdgcn_sched_barrier(0);
    }
#pragma unroll
    for (int i = 0; i < 2; ++i) { const int db = 2 * (w & 1) + i;
#pragma unroll
        for (int s = 0; s < 4; ++s) accU[i] = MFMA32(ldf(lds + HL_VT, vb * 32 + r, PT, 32 * s + 16 * hh), ldf(lds + HL_KET, db * 32 + r, PT, 32 * s + 16 * hh), accU[i]); }
    __builtin_amdgcn_sched_barrier(0);
    if (FULL) __syncthreads();
    if (FULL) {
        const unsigned v = vb * 32 + r;
        const unsigned lrow = (MODE == 0 ? (unsigned)hh : (unsigned)(1 - hh)) * 4u;
        const size_t rbase = (MODE == 0) ? (tokbase + pbO * 32) : (tokbase + 63 - pbO * 32 - 4);
        const unsigned lo_of = lrow * DH + v, lo_pr = lrow * NIN + v, lo_a2 = lrow * D + v;
        float ofv[16]; unsigned gv[16];
        if (MODE == 1) {
#pragma unroll
            for (int i = 0; i < 16; ++i) { const int ci = (i & 3) + 8 * (i >> 2); ofv[i] = (F.of() + (rbase - ci) * DH + h * HD)[lo_of]; } }
        for (int sb = 0; sb <= pbO; ++sb)
#pragma unroll
            for (int s2 = 0; s2 < 2; ++s2) accO = MFMA32(ldf(lds + HL_SCM, pbO * 32 + r, PT, 64 * sb + 32 * s2 + 16 * hh), ldf(lds + HL_VT, vb * 32 + r, PT, 64 * sb + 32 * s2 + 16 * hh), accO);
        if (MODE == 0) {
#pragma unroll
            for (int i = 0; i < 16; ++i) { const int ci = (i & 3) + 8 * (i >> 2); (F.of() + (rbase + ci) * DH + h * HD)[lo_of] = accO[i]; }
        } else {
            LAS float* rs = (LAS float*)(lds + HL_RS);
#pragma unroll
            for (int i = 0; i < 16; ++i) { const int ci = (i & 3) + 8 * (i >> 2); gv[i] = (F.proj() + (rbase - ci) * NIN + 2048 + h * HD)[lo_pr]; }
            float ov[16];
#pragma unroll
            for (int i = 0; i < 16; ++i) { const int ci = (i & 3) + 8 * (i >> 2), p = pbO * 32 + ci + 4 * hh;
                ov[i] = accO[i] + ofv[i]; float ss = ov[i] * ov[i];
                ss = DPP_ADD(ss, 0x128); ss = DPP_ADD(ss, 0x124); ss = DPP_ADD(ss, 0x122); ss = DPP_ADD(ss, 0x121); ss += __shfl_xor(ss, 16);
                if (r == 0) rs[p * 4 + vb] = ss; }
            __syncthreads();
            const float ng = F.hnorm_g()[h * HD + v];
#pragma unroll
            for (int i = 0; i < 16; ++i) { const int ci = (i & 3) + 8 * (i >> 2), p = pbO * 32 + ci + 4 * hh;
                const f32x4 q = *(LAS const f32x4*)(rs + p * 4);
                const float rstd = __builtin_amdgcn_rsqf((q[0] + q[1] + q[2] + q[3]) * (1.0f / HD) + EPS);
                const float g = bf2f(gv[i]);
                (F.bufA() + (rbase - ci) * D + h * HD)[lo_a2] = (bf16)cvtpk(ov[i] * rstd * ng * g, 0.f); }
        }
    }
    {
        const LAS float* av = (const LAS float*)(lds + HL_AV);
#pragma unroll
        for (int i = 0; i < 2; ++i) { const int db = 2 * (w & 1) + i; const float a = av[db * 32 + r];
#pragma unroll
            for (int j = 0; j < 16; j += 2) { const float s0 = accS[i][j] * a + accU[i][j], s1 = accS[i][j + 1] * a + accU[i][j + 1]; accS[i][j] = s0; accS[i][j + 1] = s1;
                if (FULL) { const int vv = vb * 32 + (j & 3) + 8 * (j >> 2) + 4 * hh; const unsigned pkd = cvtpk(s0, s1);
                    *(LAS bf16*)(lds + HL_ST + vv * PQ + (db * 32 + r) * 2) = (bf16)pkd; *(LAS bf16*)(lds + HL_ST + (vv + 1) * PQ + (db * 32 + r) * 2) = (bf16)(pkd >> 16); } } }
    }
    __syncthreads();
}
__device__ __forceinline__ void h1_item(Frame& F, int item) {
    const int seg = item & 15, dir = (item >> 4) & 1, h = (item >> 5) & 3, b = item >> 7;
    const float lb0 = F.lb()[dir * 512 + h * HD + 2 * F.lane], lb1 = F.lb()[dir * 512 + h * HD + 2 * F.lane + 1];
    f32x16 accS[2];
#pragma unroll
    for (int i = 0; i < 16; ++i) { accS[0][i] = 0.f; accS[1][i] = 0.f; }
    float atot = 1.f; const int col = F.tid & 127;
    unsigned rzA[8], rvA[8], rzB[8], rvB[8], rq[8];
#define H1CH(c) (seg * SEGC + (dir ? (SEGC - 1 - (c)) : (c)))
    hgrn_load<false>(F, b, h, dir, H1CH(0), rzA, rvA, rq); hgrn_load<false>(F, b, h, dir, H1CH(1), rzB, rvB, rq);
    for (int c = 0; c < SEGC; c += 2) {
        hgrn_chunk<false, 0>(F, b, h, dir, H1CH(c), (c + 2 < SEGC) ? H1CH(c + 2) : -1, accS, lb0, lb1, rzA, rvA, rq);
        atot *= ((const LAS float*)(F.lds + HL_AV))[col];
        hgrn_chunk<false, 0>(F, b, h, dir, H1CH(c + 1), (c + 3 < SEGC) ? H1CH(c + 3) : -1, accS, lb0, lb1, rzB, rvB, rq);
        atot *= ((const LAS float*)(F.lds + HL_AV))[col]; }
#undef H1CH
    if (F.tid < 128) F.sega()[(size_t)item * 128 + col] = atot;
    float* U = F.segu() + (size_t)item * 16384;
#pragma unroll
    for (int i = 0; i < 2; ++i)
#pragma unroll
        for (int j = 0; j < 16; j += 4) { f32x4 o; o[0] = accS[i][j]; o[1] = accS[i][j + 1]; o[2] = accS[i][j + 2]; o[3] = accS[i][j + 3]; ((f32x4*)(U + (i * 4 + (j >> 2)) * NTHR * 4))[F.tid] = o; }
}
__device__ __forceinline__ void h2_init_state(Frame& F, int b, int h, int dir, int seg, f32x16 (&accS)[2]) {
    const int w = F.wave, r = F.lane & 31, hh = F.lane >> 5, vb = w >> 1;
#pragma unroll
    for (int i = 0; i < 16; ++i) { accS[0][i] = 0.f; accS[1][i] = 0.f; }
    const int base = ((b * 4 + h) * 2 + dir) * 16;
    const int n = dir ? (NSEG - 1 - seg) : seg;
    for (int q0 = 0; q0 < n; q0 += 3) {
        f32x4 u4[3][8]; float av[3][2];
#pragma unroll
        for (int t = 0; t < 3; ++t) { const int q = (q0 + t < n) ? (q0 + t) : (n - 1); const int s = dir ? (NSEG - 1 - q) : q;
            const float* U = F.segu() + (size_t)(base + s) * 16384; const float* A = F.sega() + (size_t)(base + s) * 128;
#pragma unroll
            for (int i = 0; i < 2; ++i) av[t][i] = (A + (2 * (w & 1) + i) * 32)[r];
#pragma unroll
            for (int k = 0; k < 8; ++k) u4[t][k] = ((const f32x4*)(U + k * NTHR * 4))[F.tid]; }
#pragma unroll
        for (int t = 0; t < 3; ++t) { if (q0 + t < n) {
#pragma unroll
            for (int i = 0; i < 2; ++i) { const float a = av[t][i];
#pragma unroll
                for (int j = 0; j < 16; j += 4) { const f32x4 v = u4[t][i * 4 + (j >> 2)];
                    accS[i][j] = accS[i][j] * a + v[0]; accS[i][j + 1] = accS[i][j + 1] * a + v[1]; accS[i][j + 2] = accS[i][j + 2] * a + v[2]; accS[i][j + 3] = accS[i][j + 3] * a + v[3]; } } } }
    }
#pragma unroll
    for (int i = 0; i < 2; ++i) { const int db = 2 * (w & 1) + i;
#pragma unroll
        for (int j = 0; j < 16; ++j) { const int vv = vb * 32 + (j & 3) + 8 * (j >> 2) + 4 * hh; *(LAS bf16*)(F.lds + HL_ST + vv * PQ + (db * 32 + r) * 2) = (bf16)f2bf(accS[i][j]); } }
    __syncthreads();
}
__device__ __forceinline__ void h2_item(Frame& F, int item) {
    const int seg = item & 15, h = (item >> 4) & 3, b = item >> 6;
    f32x16 accS[2];
    unsigned rzA[8], rvA[8], rqA[8], rzB[8], rvB[8], rqB[8];
    { const float lb0 = F.lb()[h * HD + 2 * F.lane], lb1 = F.lb()[h * HD + 2 * F.lane + 1];
      const int c0 = seg * SEGC;
      hgrn_load<true>(F, b, h, 0, c0, rzA, rvA, rqA); hgrn_load<true>(F, b, h, 0, c0 + 1, rzB, rvB, rqB);
      h2_init_state(F, b, h, 0, seg, accS);
      for (int c = 0; c < SEGC; c += 2) {
          hgrn_chunk<true, 0>(F, b, h, 0, c0 + c, (c + 2 < SEGC) ? (c0 + c + 2) : -1, accS, lb0, lb1, rzA, rvA, rqA);
          hgrn_chunk<true, 0>(F, b, h, 0, c0 + c + 1, (c + 3 < SEGC) ? (c0 + c + 3) : -1, accS, lb0, lb1, rzB, rvB, rqB); } }
    asm volatile("s_waitcnt vmcnt(0)" ::: "memory");
    __syncthreads();
    { const float lb0 = F.lb()[512 + h * HD + 2 * F.lane], lb1 = F.lb()[512 + h * HD + 2 * F.lane + 1];
      const int cl = seg * SEGC + SEGC - 1;
      hgrn_load<true>(F, b, h, 1, cl, rzA, rvA, rqA); hgrn_load<true>(F, b, h, 1, cl - 1, rzB, rvB, rqB);
      h2_init_state(F, b, h, 1, seg, accS);
      for (int c = 0; c < SEGC; c += 2) {
          hgrn_chunk<true, 1>(F, b, h, 1, cl - c, (c + 2 < SEGC) ? (cl - c - 2) : -1, accS, lb0, lb1, rzA, rvA, rqA);
          hgrn_chunk<true, 1>(F, b, h, 1, cl - c - 1, (c + 3 < SEGC) ? (cl - c - 3) : -1, accS, lb0, lb1, rzB, rvB, rqB); } }
}

__device__ __forceinline__ unsigned f2key(float f) { const unsigned u = __builtin_bit_cast(unsigned, f); return (u & 0x80000000u) ? ~u : (u | 0x80000000u); }
__device__ __forceinline__ float key2f(unsigned k) { const unsigned u = (k & 0x80000000u) ? (k & 0x7fffffffu) : ~k; return __builtin_bit_cast(float, u); }
__device__ __forceinline__ unsigned umax_(unsigned a, unsigned b) { return a > b ? a : b; }
__device__ __forceinline__ unsigned umin_(unsigned a, unsigned b) { return a < b ? a : b; }
__device__ __forceinline__ void sort16(unsigned (&a)[16]) {
#pragma unroll
    for (int k = 2; k <= 16; k <<= 1)
#pragma unroll
        for (int j = k >> 1; j > 0; j >>= 1)
#pragma unroll
            for (int i = 0; i < 16; ++i) { const int l = i ^ j; if (l > i) { const bool desc = ((i & k) == 0); const unsigned x = a[i], y = a[l], mx = umax_(x, y), mn = umin_(x, y); a[i] = desc ? mx : mn; a[l] = desc ? mn : mx; } }
}
__device__ __forceinline__ void merge16(unsigned (&a)[16], const unsigned (&b)[16]) {
#pragma unroll
    for (int i = 0; i < 16; ++i) a[i] = umax_(a[i], b[15 - i]);
#pragma unroll
    for (int j = 8; j > 0; j >>= 1)
#pragma unroll
        for (int i = 0; i < 16; ++i) { const int l = i ^ j; if (l > i) { const unsigned x = a[i], y = a[l]; a[i] = umax_(x, y); a[l] = umin_(x, y); } }
}
__device__ __forceinline__ unsigned dpp_swap1(unsigned v) { return (unsigned)__builtin_amdgcn_update_dpp(0, (int)v, 0xB1, 0xF, 0xF, false); }
__device__ __forceinline__ unsigned pick_byte(const unsigned (&pk)[4], unsigned a) {
    const unsigned wsel = a >> 2; unsigned v = wsel == 0 ? pk[0] : (wsel == 1 ? pk[1] : (wsel == 2 ? pk[2] : pk[3]));
    return (v >> ((a & 3u) * 8u)) & 0xffu;
}
__device__ __forceinline__ void topk_stage2(const unsigned (&top)[16], bool tab0, size_t item, int* esel, float* wsel) {
        float vO[16], vP[16]; unsigned iOpk[4] = {0u, 0u, 0u, 0u}, iPpk[4] = {0u, 0u, 0u, 0u};
#pragma unroll
        for (int i = 0; i < 16; ++i) { const unsigned t = top[i], tp = dpp_swap1(t);
            vO[i] = key2f(t & ~0x7fu); vP[i] = key2f(tp & ~0x7fu);
            iOpk[i >> 2] |= (127u - (t & 0x7fu)) << ((i & 3) * 8); iPpk[i >> 2] |= (127u - (tp & 0x7fu)) << ((i & 3) * 8); }
        unsigned R[16], G1[16], G2[16], G3[16];
#define CAND(a, b) ((f2key(vO[a] + vP[b]) & ~0xffu) | (unsigned)(((a) << 4) | (b)))
#pragma unroll
        for (int i = 0; i < 16; ++i) R[i] = CAND(0, i);
        G1[0] = CAND(1, 0); G1[1] = CAND(1, 1); G1[2] = CAND(1, 2); G1[3] = CAND(1, 3); G1[4] = CAND(1, 4); G1[5] = CAND(1, 5); G1[6] = CAND(1, 6); G1[7] = CAND(1, 7);
        G1[8] = CAND(2, 0); G1[9] = CAND(2, 1); G1[10] = CAND(2, 2); G1[11] = CAND(2, 3); G1[12] = CAND(2, 4); G1[13] = CAND(3, 0); G1[14] = CAND(3, 1); G1[15] = CAND(3, 2);
        G2[0] = CAND(3, 3); G2[1] = CAND(4, 0); G2[2] = CAND(4, 1); G2[3] = CAND(4, 2); G2[4] = CAND(5, 0); G2[5] = CAND(5, 1); G2[6] = CAND(6, 0); G2[7] = CAND(6, 1);
        G2[8] = CAND(7, 0); G2[9] = CAND(7, 1); G2[10] = CAND(8, 0); G2[11] = CAND(9, 0); G2[12] = CAND(10, 0); G2[13] = CAND(11, 0); G2[14] = CAND(12, 0); G2[15] = CAND(13, 0);
        G3[0] = CAND(14, 0); G3[1] = CAND(15, 0);
#pragma unroll
        for (int i = 2; i < 16; ++i) G3[i] = 0u;
#undef CAND
        sort16(G1); sort16(G2); sort16(G3);
        merge16(R, G1); merge16(R, G2); merge16(R, G3);
        float sc[16], ex[16]; float sum = 0.f; unsigned eid[16];
        #pragma unroll
        for (int i = 0; i < 16; ++i) { sc[i] = key2f(R[i] & ~0xffu); const unsigned a = (R[i] >> 4) & 15u, bb = R[i] & 15u;
            const unsigned io = pick_byte(iOpk, a), ip = pick_byte(iPpk, bb);
            eid[i] = tab0 ? (io * 128u + ip) : (ip * 128u + io); }
#pragma unroll
        for (int i = 0; i < 16; ++i) { ex[i] = __expf(sc[i] - sc[0]); sum += ex[i]; }
        const float inv = 1.0f / sum;
        if (tab0) { const size_t o = item * 16;
#pragma unroll
            for (int q = 0; q < 4; ++q) { v4u ev; ev.x = eid[4 * q]; ev.y = eid[4 * q + 1]; ev.z = eid[4 * q + 2]; ev.w = eid[4 * q + 3]; *(v4u*)(esel + o + 4 * q) = ev;
                f32x4 wv; wv[0] = ex[4 * q] * inv; wv[1] = ex[4 * q + 1] * inv; wv[2] = ex[4 * q + 2] * inv; wv[3] = ex[4 * q + 3] * inv; *(f32x4*)(wsel + o + 4 * q) = wv; } }
}
__device__ __forceinline__ void p7_topk(Frame& F) {
    const int NT = T * PHEADS * 2;
    for (int g0 = (F.bid * NWAVES + F.wave) * 64; g0 < NT; g0 += F.G * NTHR) {
        const int g = g0 + F.lane; const float* wb = F.scores() + (size_t)g0 * 128;
        LAS float* stg = (LAS float*)(F.lds) + F.wave * (64 * 36);
        unsigned top[16];
#pragma unroll
        for (int sg = 0; sg < 4; ++sg) {
            f32x4 tl[8];
#pragma unroll
            for (int i = 0; i < 8; ++i) tl[i] = __builtin_nontemporal_load((const f32x4*)(wb + (size_t)(8 * i + (F.lane >> 3)) * 128 + sg * 32 + 4 * (F.lane & 7)));
#pragma unroll
            for (int i = 0; i < 8; ++i) *(LAS f32x4*)(stg + (8 * i + (F.lane >> 3)) * 36 + 4 * (F.lane & 7)) = tl[i];
            asm volatile("s_waitcnt lgkmcnt(0)" ::: "memory");
#pragma unroll
            for (int hg2 = 0; hg2 < 2; ++hg2) { const int grp = sg * 2 + hg2; unsigned k[16];
#pragma unroll
                for (int q = 0; q < 4; ++q) { const f32x4 v = *(LAS const f32x4*)(stg + F.lane * 36 + hg2 * 16 + q * 4);
#pragma unroll
                    for (int e = 0; e < 4; ++e) { const int j = grp * 16 + q * 4 + e; k[q * 4 + e] = (f2key(v[e]) & ~0x7fu) | (unsigned)(127 - j); } }
                sort16(k);
                if (grp == 0) {
#pragma unroll
                    for (int i = 0; i < 16; ++i) top[i] = k[i];
                } else merge16(top, k); }
            asm volatile("s_waitcnt lgkmcnt(0)" ::: "memory");
        }
        topk_stage2(top, (g & 1) == 0, (size_t)((g >> 1) & 7) * T + (size_t)(g >> 4), F.esel(), F.wsel());
    }
}


struct EpiScoreTopk {
    static constexpr bool PERM = false, AFTER_DRAIN = false;
    float* scr; const float* ssqp; const float* biasq; float* rstd_out; int* esel; float* wsel;
    __device__ __forceinline__ void operator()(const f32x4 (&acc)[2][2][4][2], const pg8::Unit& u, int wr, int wc, int fr, int fq) const {
        asm volatile("" : "+v"(fr), "+v"(fq));
        const int rl0 = wr * 64 + fr, col0 = wc * 32 + 4 * fq, b = (u.pm * 256) >> 13;
        f32x4 bv[2][2];
#pragma unroll
        for (int bj = 0; bj < 2; ++bj)
#pragma unroll
            for (int n = 0; n < 2; ++n) bv[bj][n] = *(const f32x4*)(biasq + b * 2048 + u.pn * 256 + col0 + bj * 128 + n * 16);
#pragma unroll
        for (int ai = 0; ai < 2; ++ai)
#pragma unroll
            for (int m = 0; m < 4; ++m) { const int rl = rl0 + ai * 128 + m * 16, row = u.pm * 256 + rl;
                const f32x4 p0 = *(const f32x4*)(ssqp + (size_t)row * 4), p1 = *(const f32x4*)(ssqp + ((size_t)32768 + row) * 4), p2 = *(const f32x4*)(ssqp + ((size_t)65536 + row) * 4), p3 = *(const f32x4*)(ssqp + ((size_t)98304 + row) * 4);
                const float tot = (p0[0] + p0[1] + p0[2] + p0[3]) + (p1[0] + p1[1] + p1[2] + p1[3]) + (p2[0] + p2[1] + p2[2] + p2[3]) + (p3[0] + p3[1] + p3[2] + p3[3]);
                const float rstd = __builtin_amdgcn_rsqf(tot * (1.0f / 1024.0f) + 1e-6f);
                if (u.pn == 0 && wc == 0 && fq == 0) rstd_out[row] = rstd;
                float* blk = scr + (2 * wr + 4 * ai + (m >> 1)) * 8192 + 8 * wc * 256 + 32 * (m & 1) * 4;
                const unsigned loff4 = (unsigned)(2 * fr + 64 * fq);
#pragma unroll
                for (int bj = 0; bj < 2; ++bj)
#pragma unroll
                    for (int n = 0; n < 2; ++n) ((f32x4*)(blk + (4 * n * 64 + bj) * 4))[loff4] = acc[ai][bj][m][n] * rstd + bv[bj][n]; }
        asm volatile("s_waitcnt vmcnt(0)" ::: "memory");
        __builtin_amdgcn_s_barrier();
        asm volatile("" ::: "memory");
        int tid = threadIdx.x; asm volatile("" : "+v"(tid));
        const int rl = tid >> 1, tab = tid & 1;
        const float* bp = scr + __builtin_amdgcn_readfirstlane(tid >> 6) * 8192;
        const unsigned lo4 = (unsigned)(tid & 63) * 4u;
        unsigned top[16];
        f32x4 cur[4], nxt[4];
#pragma unroll
        for (int q = 0; q < 4; ++q) cur[q] = *(const f32x4*)(bp + q * 256 + lo4);
#pragma unroll
        for (int grp = 0; grp < 8; ++grp) { unsigned k[16];
            if (grp < 7) {
#pragma unroll
                for (int q = 0; q < 4; ++q) nxt[q] = *(const f32x4*)(bp + ((grp + 1) * 4 + q) * 256 + lo4); }
#pragma unroll
            for (int q = 0; q < 4; ++q) { const f32x4 v = cur[q];
#pragma unroll
                for (int e = 0; e < 4; ++e) { const int j = grp * 16 + q * 4 + e; k[q * 4 + e] = (f2key(v[e]) & ~0x7fu) | (unsigned)(127 - j); } }
            sort16(k);
            if (grp == 0) {
#pragma unroll
                for (int i = 0; i < 16; ++i) top[i] = k[i];
            } else merge16(top, k);
#pragma unroll
            for (int q = 0; q < 4; ++q) cur[q] = nxt[q];
            __builtin_amdgcn_sched_barrier(0); }
        topk_stage2(top, tab == 0, (size_t)u.pn * T + (size_t)(u.pm * 256 + rl), esel, wsel);
    }
};

__device__ __forceinline__ void cvt16(const v4u& u, f32x2_ (&f)[8]) {
#pragma unroll
    for (int i = 0; i < 4; ++i) { f[2 * i] = __builtin_amdgcn_cvt_pk_f32_fp8((int)u[i], false); f[2 * i + 1] = __builtin_amdgcn_cvt_pk_f32_fp8((int)u[i], true); }
}
constexpr int PITEM = 8, NPITEM = T / PITEM;
__device__ __forceinline__ int peer_next(unsigned* q, int lane) {
    int idx = 0; if (lane == 0) idx = (int)__hip_atomic_fetch_add(q, 1u, __ATOMIC_RELAXED, __HIP_MEMORY_SCOPE_AGENT);
    return __builtin_amdgcn_readfirstlane(idx);
}
#define PEER_SB() __builtin_amdgcn_sched_barrier(0)
#define DPP_IADD(s, ctrl) ((s) + __builtin_amdgcn_update_dpp(0, (s), (ctrl), 0xF, 0xF, false))
__device__ __forceinline__ void p8_dots(const v4u (&ud)[16], const int (&hq)[4], int c8, int& r0, int& r1) {
#pragma unroll
    for (int i = 0; i < 16; ++i) { int sm = __builtin_amdgcn_sdot4((int)ud[i][0], hq[0], 0, false);
        sm = __builtin_amdgcn_sdot4((int)ud[i][1], hq[1], sm, false); sm = __builtin_amdgcn_sdot4((int)ud[i][2], hq[2], sm, false); sm = __builtin_amdgcn_sdot4((int)ud[i][3], hq[3], sm, false);
        sm = DPP_IADD(sm, 0xB1); sm = DPP_IADD(sm, 0x4E); sm = DPP_IADD(sm, 0x141);
        if ((i & 1) == 0) r0 = (c8 == (i >> 1)) ? sm : r0; else r1 = (c8 == (i >> 1)) ? sm : r1; }
}
constexpr int PSLAB = 12288;
__device__ __forceinline__ void p8_item(Frame& F, int sl, int item, int nitem, bool filled, LAS unsigned char* slab) {
    const int c8 = F.lane & 7, q8 = F.lane >> 3, t0 = item * PITEM;
    const unsigned char* ub = F.U8() + (size_t)sl * 16384 * CSL + 16 * c8;
    LAS int* eL = (LAS int*)slab; LAS unsigned char* hL = (LAS unsigned char*)(slab + 4096);
    LAS float* qL = (LAS float*)(slab + 6144);
    v4u t4[4], h2[2]; float rs2[2]; f32x4 sA, sB;
#define P8_BLK_LOAD(tb) do { \
        { const float* sp_ = F.mod() + ((tb) >> 13) * 6144 + 3072 + sl * CSL + 8 * (F.lane & 15); sA = *(const f32x4*)sp_; sB = *(const f32x4*)(sp_ + 4); } \
        _Pragma("unroll") for (int i = 0; i < 2; ++i) rs2[i] = F.rstd()[(tb) + 4 * i + (F.lane >> 4)]; \
        _Pragma("unroll") for (int i = 0; i < 4; ++i) t4[i] = __builtin_nontemporal_load((const v4u*)(F.esel() + ((size_t)(2 * i + (F.lane >> 5)) * T + (tb)) * 16) + (F.lane & 31)); \
        _Pragma("unroll") for (int i = 0; i < 2; ++i) h2[i] = __builtin_nontemporal_load((const v4u*)(F.hg() + (size_t)((tb) + 4 * i + (F.lane >> 4)) * D + sl * CSL + 8 * (F.lane & 15))); } while (0)
#define P8_Q8(x) ((int)__builtin_rintf((x) * qs_) & 0xff)
#define DPP_FMAX(v, ctrl) __builtin_fmaxf((v), __builtin_bit_cast(float, __builtin_amdgcn_update_dpp(0, __builtin_bit_cast(int, (v)), (ctrl), 0xF, 0xF, false)))
#define P8_BLK_STORE() do { _Pragma("unroll") for (int i = 0; i < 4; ++i) *(LAS v4u*)(eL + ((F.lane & 31) >> 2) * NSEL + (2 * i + (F.lane >> 5)) * 16 + 4 * (F.lane & 3)) = t4[i]; \
        _Pragma("unroll") for (int i = 0; i < 2; ++i) { const float r_ = rs2[i]; const v4u h_ = h2[i]; v2u o_; \
            const float x0 = bflo(h_[0]) * r_ + sA[0], x1 = bfhi(h_[0]) * r_ + sA[1], x2 = bflo(h_[1]) * r_ + sA[2], x3 = bfhi(h_[1]) * r_ + sA[3]; \
            const float x4 = bflo(h_[2]) * r_ + sB[0], x5 = bfhi(h_[2]) * r_ + sB[1], x6 = bflo(h_[3]) * r_ + sB[2], x7 = bfhi(h_[3]) * r_ + sB[3]; \
            float m_ = __builtin_fmaxf(__builtin_fmaxf(__builtin_fmaxf(__builtin_fabsf(x0), __builtin_fabsf(x1)), __builtin_fmaxf(__builtin_fabsf(x2), __builtin_fabsf(x3))), \
                                       __builtin_fmaxf(__builtin_fmaxf(__builtin_fabsf(x4), __builtin_fabsf(x5)), __builtin_fmaxf(__builtin_fabsf(x6), __builtin_fabsf(x7)))); \
            m_ = DPP_FMAX(m_, 0x128); m_ = DPP_FMAX(m_, 0x124); m_ = DPP_FMAX(m_, 0x122); m_ = DPP_FMAX(m_, 0x121); m_ = __builtin_fmaxf(m_, 1e-20f); \
            const float qs_ = 127.0f * __builtin_amdgcn_rcpf(m_); \
            if ((F.lane & 15) == 0) qL[4 * i + (F.lane >> 4)] = m_ * (1.0f / (127.0f * UQSCALE)); \
            o_[0] = (unsigned)(P8_Q8(x0) | (P8_Q8(x1) << 8) | (P8_Q8(x2) << 16) | (P8_Q8(x3) << 24)); \
            o_[1] = (unsigned)(P8_Q8(x4) | (P8_Q8(x5) << 8) | (P8_Q8(x6) << 16) | (P8_Q8(x7) << 24)); \
            *(LAS v2u*)(hL + (4 * i + (F.lane >> 4)) * 128 + 8 * (F.lane & 15)) = o_; } \
        asm volatile("s_waitcnt lgkmcnt(0)" ::: "memory"); } while (0)
    if (!filled) { P8_BLK_LOAD(t0); P8_BLK_STORE(); }
    bf16* po = F.pact() + ((size_t)t0 * NSL + sl) * NSEL + 16 * q8 + 2 * c8;
    v4u udA[16], udB[16];
#define P8_GATHER(dst, tt) do { v4u e_[4]; _Pragma("unroll") for (int k = 0; k < 4; ++k) e_[k] = *(LAS const v4u*)(eL + (tt) * NSEL + 16 * q8 + 4 * k); \
        _Pragma("unroll") for (int i = 0; i < 16; ++i) dst[i] = *(const v4u*)(ub + (size_t)e_[i >> 2][i & 3] * CSL); } while (0)
#define P8_HN(tt) int hq[4]; { const v4u hv_ = *(LAS const v4u*)(hL + (tt) * 128 + 16 * c8); hq[0] = (int)hv_[0]; hq[1] = (int)hv_[1]; hq[2] = (int)hv_[2]; hq[3] = (int)hv_[3]; }
#define P8_OUT(tt, r0, r1) do { const float dq_ = qL[tt]; __builtin_nontemporal_store(cvtpk((float)(r0) * dq_, (float)(r1) * dq_), (unsigned*)(po + (size_t)(tt) * NSL * NSEL)); } while (0)
    P8_GATHER(udA, 0);
    for (int tt = 0; tt < PITEM - 2; tt += 2) {
        P8_GATHER(udB, tt + 1);
        { P8_HN(tt); int r0 = 0, r1 = 0; p8_dots(udA, hq, c8, r0, r1); P8_OUT(tt, r0, r1); }
        P8_GATHER(udA, tt + 2);
        { P8_HN(tt + 1); int r0 = 0, r1 = 0; p8_dots(udB, hq, c8, r0, r1); P8_OUT(tt + 1, r0, r1); }
    }
    {
        P8_GATHER(udB, PITEM - 1);
        { P8_HN(PITEM - 2); int r0 = 0, r1 = 0; p8_dots(udA, hq, c8, r0, r1); P8_OUT(PITEM - 2, r0, r1); }
        if (nitem >= 0) P8_BLK_LOAD(nitem * PITEM);
        { P8_HN(PITEM - 1); int r0 = 0, r1 = 0; p8_dots(udB, hq, c8, r0, r1); P8_OUT(PITEM - 1, r0, r1); }
        if (nitem >= 0) P8_BLK_STORE();
    }
#undef P8_GATHER
#undef P8_HN
#undef P8_OUT
#undef P8_BLK_LOAD
#undef P8_BLK_STORE
#undef P8_Q8
#undef DPP_FMAX
}
__device__ __forceinline__ void p8b_coef(Frame& F) {
    const size_t N = (size_t)T * NSEL;
#pragma unroll 4
    for (size_t i = (size_t)F.bid * NTHR + F.tid; i < N; i += (size_t)F.G * NTHR) { const size_t t = i >> 7; const int j = (int)(i & 127);
        const bf16* pp = F.pact() + t * NSL * NSEL + j; float a = 0.f;
#pragma unroll
        for (int s = 0; s < NSL; ++s) a += bf2f(__builtin_nontemporal_load(pp + s * NSEL));
        F.coef()[i] = F.wsel()[((size_t)(j >> 4) * T + t) * 16 + (j & 15)] * 0.5f * a * (1.0f + erff(a * 0.70710678f)); }
}
__device__ __forceinline__ void p9_token(const v4u (&vd)[16], LAS const float* cL, bf16* yo, LAS float* red, int lane, int c8, int q8) {
    f32x4 cc[4];
#pragma unroll
    for (int k = 0; k < 4; ++k) cc[k] = *(LAS const f32x4*)(cL + 16 * q8 + 4 * k);
    f32x2_ y[8];
#pragma unroll
    for (int k = 0; k < 8; ++k) y[k] = (f32x2_){0.f, 0.f};
#pragma unroll
    for (int i = 0; i < 16; ++i) { f32x2_ vf[8]; cvt16(vd[i], vf); const float c = cc[i >> 2][i & 3]; const f32x2_ c2 = {c, c};
#pragma unroll
        for (int k = 0; k < 8; ++k) y[k] += c2 * vf[k];
        PEER_SB(); }
#pragma unroll
    for (int k = 0; k < 4; ++k) { f32x4 o; o[0] = y[2 * k][0]; o[1] = y[2 * k][1]; o[2] = y[2 * k + 1][0]; o[3] = y[2 * k + 1][1]; *(LAS f32x4*)(red + q8 * 128 + 16 * c8 + 4 * k) = o; }
    asm volatile("s_waitcnt lgkmcnt(0)" ::: "memory");
    f32x2_ sm = {0.f, 0.f};
#pragma unroll
    for (int g = 0; g < 8; ++g) sm += *(LAS const f32x2_*)(red + g * 128 + 2 * lane);
    sm = sm * (1.0f / VSCALE);
    __builtin_nontemporal_store(cvtpk(sm[0], sm[1]), (unsigned*)(yo + 2 * lane));
    asm volatile("s_waitcnt lgkmcnt(0)" ::: "memory");
    PEER_SB();
}
__device__ __forceinline__ void p9_item(Frame& F, int sl, int item, int nitem, bool filled, LAS unsigned char* slab) {
    const int c8 = F.lane & 7, q8 = F.lane >> 3, t0 = item * PITEM;
    const unsigned char* vb = F.V8() + (size_t)sl * 16384 * CSL + 16 * c8;
    LAS int* eL = (LAS int*)slab; LAS float* cL = (LAS float*)(slab + 4096); LAS float* red = (LAS float*)(slab + 8192);
    v4u t4[4], c4[4];
#define P9_BLK_LOAD(tb) do { const v4u* cp_ = (const v4u*)(F.coef() + (size_t)(tb) * NSEL); \
        _Pragma("unroll") for (int i = 0; i < 4; ++i) { t4[i] = __builtin_nontemporal_load((const v4u*)(F.esel() + ((size_t)(2 * i + (F.lane >> 5)) * T + (tb)) * 16) + (F.lane & 31)); c4[i] = __builtin_nontemporal_load(cp_ + i * 64 + F.lane); } } while (0)
#define P9_BLK_STORE() do { _Pragma("unroll") for (int i = 0; i < 4; ++i) { *(LAS v4u*)(eL + ((F.lane & 31) >> 2) * NSEL + (2 * i + (F.lane >> 5)) * 16 + 4 * (F.lane & 3)) = t4[i]; *(LAS v4u*)(cL + (i * 64 + F.lane) * 4) = c4[i]; } \
        asm volatile("s_waitcnt lgkmcnt(0)" ::: "memory"); } while (0)
    if (!filled) { P9_BLK_LOAD(t0); P9_BLK_STORE(); }
    bf16* yo = F.ybuf() + (size_t)t0 * D + sl * CSL;
    v4u vdA[16], vdB[16];
#define P9_GATHER(dst, tt) do { v4u e_[4]; _Pragma("unroll") for (int k = 0; k < 4; ++k) e_[k] = *(LAS const v4u*)(eL + (tt) * NSEL + 16 * q8 + 4 * k); \
        _Pragma("unroll") for (int i = 0; i < 16; ++i) dst[i] = *(const v4u*)(vb + (size_t)e_[i >> 2][i & 3] * CSL); } while (0)
    P9_GATHER(vdA, 0);
    for (int tt = 0; tt < PITEM - 2; tt += 2) {
        P9_GATHER(vdB, tt + 1);
        p9_token(vdA, cL + tt * NSEL, yo + (size_t)tt * D, red, F.lane, c8, q8);
        P9_GATHER(vdA, tt + 2);
        p9_token(vdB, cL + (tt + 1) * NSEL, yo + (size_t)(tt + 1) * D, red, F.lane, c8, q8);
    }
    {
        P9_GATHER(vdB, PITEM - 1);
        p9_token(vdA, cL + (PITEM - 2) * NSEL, yo + (size_t)(PITEM - 2) * D, red, F.lane, c8, q8);
        if (nitem >= 0) P9_BLK_LOAD(nitem * PITEM);
        p9_token(vdB, cL + (PITEM - 1) * NSEL, yo + (size_t)(PITEM - 1) * D, red, F.lane, c8, q8);
        if (nitem >= 0) P9_BLK_STORE();
    }
#undef P9_GATHER
#undef P9_BLK_LOAD
#undef P9_BLK_STORE
}
template <int SIDE>
__device__ __forceinline__ void peer_phase(Frame& F0, int rep) {
    Frame F = F0; asm volatile("" : "+v"(F.lane));
    const int s0 = (int)(xb_xcc_id() & 7u);
    unsigned* qbase = F.ctl() + (SIDE == 0 ? CW_QU : CW_QV) + rep * 64 * 32;
    LAS unsigned char* cf = F.lds + F.wave * PSLAB;
    for (int k = 0; k < NSL; ++k) { const int sl = (s0 + k) & (NSL - 1);
        int item = peer_next(qbase + 64 * sl, F.lane); bool filled = false;
        while (item < NPITEM) { int nitem = peer_next(qbase + 64 * sl, F.lane); if (nitem >= NPITEM) nitem = -1;
            if (SIDE == 0) p8_item(F, sl, item, nitem, filled, cf); else p9_item(F, sl, item, nitem, filled, cf);
            filled = nitem >= 0; item = nitem >= 0 ? nitem : NPITEM; } }
}
__device__ __forceinline__ void p10_final(Frame& F) {
    const int gwc = F.bid * NWAVES + F.wave, NGW = F.G * NWAVES;
    for (int row0 = gwc * 16; row0 < T; row0 += NGW * 16) {
        const int b = row0 >> 13; const float* mb = F.mod() + b * 6144 + 5120; const float* fm = F.fmod() + b * 2048;
        f32x4 g2[4], ca[4], cb[4];
#pragma unroll
        for (int j = 0; j < 4; ++j) { const int k = 256 * j + 4 * F.lane; g2[j] = *(const f32x4*)(mb + k); ca[j] = *(const f32x4*)(F.fnorm_g() + k) * (*(const f32x4*)(fm + 1024 + k) + 1.0f); cb[j] = *(const f32x4*)(fm + k); }
#pragma unroll 4
        for (int r = 0; r < 16; ++r) { float* hr = F.out() + (size_t)(row0 + r) * D; const bf16* yr = F.ybuf() + (size_t)(row0 + r) * D; const bf16* hb = (const bf16*)hr;
            f32x4 z[4]; float ss = 0.f;
#pragma unroll
            for (int j = 0; j < 4; ++j) { const v2u hq = *(const v2u*)(hb + 256 * j + 4 * F.lane); f32x4 hv; hv[0] = bflo(hq[0]); hv[1] = bfhi(hq[0]); hv[2] = bflo(hq[1]); hv[3] = bfhi(hq[1]);
                const v2u yq = __builtin_nontemporal_load((const v2u*)(yr + 256 * j + 4 * F.lane)); f32x4 yv; yv[0] = bflo(yq[0]); yv[1] = bfhi(yq[0]); yv[2] = bflo(yq[1]); yv[3] = bfhi(yq[1]);
                z[j] = hv + g2[j] * yv; ss += z[j][0] * z[j][0] + z[j][1] * z[j][1] + z[j][2] * z[j][2] + z[j][3] * z[j][3]; }
            const float rstd = __builtin_amdgcn_rsqf(wave_sum(ss) * (1.0f / D) + EPS);
#pragma unroll
            for (int j = 0; j < 4; ++j) *(f32x4*)(hr + 256 * j + 4 * F.lane) = z[j] * rstd * ca[j] + cb[j]; }
    }
}

constexpr int NPHASE = 12;
__global__ void __launch_bounds__(NTHR, 2) fwd_kernel(Args args) {
    extern __shared__ __attribute__((aligned(16))) unsigned char lds_raw[];
    Frame F;
    F.lds = (LAS unsigned char*)lds_raw;
    F.tid = threadIdx.x; F.lane = F.tid & 63; F.wave = __builtin_amdgcn_readfirstlane(F.tid >> 6); F.G = gridDim.x; F.bid = blockIdx.x;
    unsigned char* ws = args.ws; F.a = &args;
    volatile LAS unsigned* misc = (volatile LAS unsigned*)(F.lds + MISC_OFF);
    if (F.tid < 64) misc[F.tid] = 0u;
    __syncthreads();
    const int lo = args.ph_lo, hi = args.ph_hi;
    const bool multi = (hi - lo) > 1;
    XcdBarrier bar; bar.bar = (unsigned*)(ws + WS_CTL) + CW_BAR; bar.x = 0; bar.st = nullptr;
    if (multi) bar = xcd_barrier_post((unsigned*)(ws + WS_CTL) + CW_BAR, misc + 8);
#ifndef PHMASK
#define PHMASK 0xfff
#endif
#define IN(k) (((PHMASK >> (k)) & 1) && lo <= (k) && (k) < hi)
#define SEAM(k) do { if (IN(k) && IN((k) + 1)) xcd_barrier(bar); } while (0)

#ifndef REPMASK
#define REPMASK 0
#endif
#define REP(k) (((REPMASK) >> (k)) & 1)
#define REPBAR(k) if (REP(k) && rep == 0) xcd_barrier(bar)
    if (IN(0)) { for (int rep = 0; rep <= REP(0); ++rep) { p0_prologue(F); REPBAR(0); } } SEAM(0);
    if (IN(1)) { for (int rep = 0; rep <= REP(1); ++rep) { p1_norm(F); REPBAR(1); } } SEAM(1);
    if (IN(2)) { { pg8::Gemm g{F.bufA(), F.Win_t(), T, NIN, D}; pg8::StaticOrder S; S.init(T, NIN, F.G, F.bid);
        pg8::EpiProj E{F.proj(), NIN};
        pg8::gemm_phase<pg8::EpiProj, pg8::StaticOrder, true, true>(F.lds, g, S, E); }
#if ((REPMASK) >> 2) & 1
        xcd_barrier(bar); { pg8::Gemm g{F.bufA(), F.Win_t(), T, NIN, D}; pg8::StaticOrder S; S.init(T, NIN, F.G, F.bid);
        pg8::EpiProj E{F.proj(), NIN};
        pg8::gemm_phase<pg8::EpiProj, pg8::StaticOrder, true, true>(F.lds, g, S, E); }
#endif
    } SEAM(2);
    if (IN(3)) { for (int rep = 0; rep <= REP(3); ++rep) {
        for (int it = F.bid; it < NB * NHH * 2 * NSEG; it += F.G) h1_item(F, it);
        float cw[CW];
#pragma unroll
        for (int j = 0; j < CW; ++j) cw[j] = F.conv_w()[j * DC + F.tid];
        const float cbias = F.conv_b()[F.tid];
        for (int it = F.bid; it < T / 32; it += F.G) conv_item(F, it, cw, cbias); REPBAR(3); }
    } SEAM(3);
    if (IN(4)) { for (int rep = 0; rep <= REP(4); ++rep) { for (int it = F.bid; it < NB * NHH * NSEG; it += F.G) h2_item(F, it); REPBAR(4); } } SEAM(4);
    if (IN(5)) { { pg8::Gemm g{F.bufA(), F.Wout_t(), T, D, D}; pg8::StaticOrder S; S.init(T, D, F.G, F.bid);
        pg8::EpiOut E{F.x(), F.out(), F.hg(), F.mod(), F.g_ffn(), F.ssqp()};
        pg8::gemm_phase<pg8::EpiOut, pg8::StaticOrder, true, true>(F.lds, g, S, E); }
#if ((REPMASK) >> 5) & 1
        xcd_barrier(bar); { pg8::Gemm g{F.bufA(), F.Wout_t(), T, D, D}; pg8::StaticOrder S; S.init(T, D, F.G, F.bid);
        pg8::EpiOut E{F.x(), F.out(), F.hg(), F.mod(), F.g_ffn(), F.ssqp()};
        pg8::gemm_phase<pg8::EpiOut, pg8::StaticOrder, true, true>(F.lds, g, S, E); }
#endif
    } SEAM(5);
    if (IN(6)) { { pg8::Gemm g{F.hg(), F.Wqk_t(), T, NQK, D}; pg8::StaticOrder S; S.init(T, NQK, F.G, F.bid);
        EpiScoreTopk E{F.scores() + (size_t)F.bid * 65536, F.ssqp(), F.biasq(), F.rstd(), F.esel(), F.wsel()};
        pg8::gemm_phase<EpiScoreTopk, pg8::StaticOrder, true, true>(F.lds, g, S, E); }
    } SEAM(6);
    if (IN(8)) { for (int rep = 0; rep <= REP(8); ++rep) { peer_phase<0>(F, rep); REPBAR(8); } } SEAM(8);
    if (IN(9)) { for (int rep = 0; rep <= REP(9); ++rep) { p8b_coef(F); REPBAR(9); } } SEAM(9);
    if (IN(10)) { for (int rep = 0; rep <= REP(10); ++rep) { peer_phase<1>(F, rep); REPBAR(10); } } SEAM(10);
    if (IN(11)) { p10_final(F); }
#undef IN
#undef SEAM
}

#ifndef MK_ONE_LAUNCH
#define MK_ONE_LAUNCH 0
#endif
extern "C" void kernel_launch(void* const* d_in, const int* in_sizes, int n_in, void* d_out, int out_size, void* d_ws, size_t ws_size, hipStream_t stream) {
    static int grid = 0;
    if (grid == 0) {
        if (n_in != 23 || out_size != T * D || ws_size < WS_END) { fprintf(stderr, "kernel_launch: unexpected shapes (n_in %d, out %d, ws %zu)\n", n_in, out_size, ws_size); grid = -1; return; }
        int dev = 0, cus = 0, per_cu = 0;
        if (hipGetDevice(&dev) != hipSuccess || hipDeviceGetAttribute(&cus, hipDeviceAttributeMultiprocessorCount, dev) != hipSuccess) { grid = -1; return; }
        if (hipFuncSetAttribute((const void*)fwd_kernel, hipFuncAttributeMaxDynamicSharedMemorySize, LDS_BYTES) != hipSuccess) { fprintf(stderr, "kernel_launch: hipFuncSetAttribute failed\n"); grid = -1; return; }
        if (hipOccupancyMaxActiveBlocksPerMultiprocessor(&per_cu, (const void*)fwd_kernel, NTHR, LDS_BYTES) != hipSuccess || per_cu < 1) { fprintf(stderr, "kernel_launch: occupancy query reports %d\n", per_cu); }
        (void)hipGetLastError();
        grid = cus;
    }
    if (grid < 0) return;
    (void)hipMemsetAsync((char*)d_ws + WS_CTL, 0, CTL_ZERO_BYTES, stream);
    Args a{};
    for (int i = 0; i < 23; ++i) a.in[i] = (const float*)d_in[i];
    a.out = (float*)d_out; a.ws = (unsigned char*)d_ws;
#if MK_ONE_LAUNCH
    a.ph_lo = 0; a.ph_hi = NPHASE;
    hipLaunchKernelGGL(fwd_kernel, dim3(grid), dim3(NTHR), LDS_BYTES, stream, a);
#else
    for (int p = 0; p < NPHASE; ++p) { a.ph_lo = p; a.ph_hi = p + 1; hipLaunchKernelGGL(fwd_kernel, dim3(grid), dim3(NTHR), LDS_BYTES, stream, a); }
#endif
}
```

```cpp
#include <hip/hip_runtime.h>
#include <cstdio>
#include <cstdint>
namespace pg8 {
#define PG8_LAS __attribute__((address_space(3)))
typedef unsigned short bf16_t;
typedef short bf16x8 __attribute__((ext_vector_type(8)));
typedef float f32x4 __attribute__((ext_vector_type(4)));
typedef unsigned u32x4 __attribute__((ext_vector_type(4)));
constexpr int BM = 256, BK = 64, HALF = 128, HTB = HALF * BK * 2  , STAGE_BYTES = 8 * HTB, NXCD = 8, WGM = 8;

__host__ __device__ __forceinline__ int lds_byte(int r, int c) { const int st = (r >> 4) * 2 + (c >> 5), rr = r & 15, cc = c & 31, ob = rr * 64 + cc * 2; return st * 1024 + (ob ^ (((ob >> 9) & 1) << 5)); }
__host__ __device__ __forceinline__ void stage_rc(int b, int& R, int& C) { const int st = b / 1024, sb = b % 1024, swz = sb ^ (((sb >> 9) & 1) << 5); R = (st >> 1) * 16 + swz / 64; C = (st & 1) * 32 + (swz % 64) / 2; }
__host__ __device__ __forceinline__ int perm32(int rho) { const int n = rho >> 4, i = rho & 15; return 8 * (i >> 2) + 4 * n + (i & 3); }

struct Unit { int pm, pn; };
struct Gemm { const bf16_t* A; const bf16_t* Bt; int M, N, K; };

struct StaticOrder {
    int nM, nN, nwg, G, c;
    __host__ __device__ void init(int M, int N, int G_, int c_) { nM = M / BM; nN = N / BM; nwg = nM * nN; G = G_; c = c_; }
    __host__ __device__ bool next(int i, Unit& u) const {
        const long L = (long)i * G + c; if (L >= nwg) return false;
        int wgid = (int)L; { const int q = nwg / NXCD, r = nwg % NXCD, xcd = wgid % NXCD, off = wgid / NXCD; wgid = (xcd < r ? xcd * (q + 1) : r * (q + 1) + (xcd - r) * q) + off; }
        const int nig = WGM * nN, gid = wgid / nig, fm = gid * WGM, gsz = (nM - fm) < WGM ? (nM - fm) : WGM;
        u.pm = fm + ((wgid % nig) % gsz); u.pn = (wgid % nig) / gsz; return true;
    }
    __device__ __forceinline__ void a_ready(const Unit&) const {}
    __device__ __forceinline__ void done(const Unit&) const {}
};
__device__ __forceinline__ unsigned cvt_pk_bf16(float lo, float hi) { unsigned r; asm volatile("v_cvt_pk_bf16_f32 %0, %1, %2" : "=v"(r) : "v"(lo), "v"(hi)); return r; }
typedef float f32x2 __attribute__((ext_vector_type(2)));
__device__ __forceinline__ f32x2 gelu_pk(f32x2 v) {
    const f32x2 av = __builtin_elementwise_abs(v), d = av * 0.2316418882f + 1.0f;
    f32x2 t; t.x = __builtin_amdgcn_rcpf(d.x); t.y = __builtin_amdgcn_rcpf(d.y);
    f32x2 q = t * 0.5307027145f + (-0.7265760135f); q = q * t + 0.7107068705f; q = q * t + (-0.142248368f); q = q * t + 0.127414796f; q = q * t;
    const f32x2 s = (v * v) * (-0.72134752044f);
    f32x2 e; e.x = __builtin_amdgcn_exp2f(s.x); e.y = __builtin_amdgcn_exp2f(s.y);
    const f32x2 m = v * (q * e), r = v - m;
    f32x2 o; o.x = v.x < 0.f ? m.x : r.x; o.y = v.y < 0.f ? m.y : r.y; return o;
}

template <int ACT  > struct EpiBf16 {
    static constexpr bool PERM = true, AFTER_DRAIN = false; static_assert(ACT == 0 || ACT == 1, "EpiBf16: ACT is 0 (none) or 1 (gelu_pk)");
    bf16_t* O; int ldc; const float* bias; int split_cols; size_t split_stride; float scale0;
    __device__ __forceinline__ void operator()(const f32x4 (&acc)[2][2][4][2], const Unit& u, int wr, int wc, int fr, int fq) const {
        const int row0 = u.pm * BM + wr * 64 + fr; int colt = u.pn * BM; bf16_t* base = O;
        float sc = 1.f; if (split_cols) { const int t = colt / split_cols; base += (size_t)t * split_stride; colt -= t * split_cols; if (t == 0) sc = scale0; }
        const int col0 = colt + wc * 32 + 8 * fq, bcol0 = u.pn * BM + wc * 32 + 8 * fq;
        f32x4 bv[2][2];
#pragma unroll
        for (int bj = 0; bj < 2; ++bj)
#pragma unroll
            for (int n = 0; n < 2; ++n) bv[bj][n] = bias ? *(const f32x4*)(bias + bcol0 + bj * HALF + 4 * n) : (f32x4){0.f, 0.f, 0.f, 0.f};
#pragma unroll
        for (int ai = 0; ai < 2; ++ai)
#pragma unroll
            for (int m = 0; m < 4; ++m) { bf16_t* rowp = base + (size_t)(row0 + ai * HALF + m * 16) * ldc + col0;
#pragma unroll
                for (int bj = 0; bj < 2; ++bj) { f32x4 v0 = acc[ai][bj][m][0] + bv[bj][0], v1 = acc[ai][bj][m][1] + bv[bj][1];
                    if (ACT == 1) { f32x2 a = gelu_pk((f32x2){v0[0], v0[1]}), b = gelu_pk((f32x2){v0[2], v0[3]}), c = gelu_pk((f32x2){v1[0], v1[1]}), d = gelu_pk((f32x2){v1[2], v1[3]});
                        v0 = (f32x4){a.x, a.y, b.x, b.y}; v1 = (f32x4){c.x, c.y, d.x, d.y}; }
                    v0 = v0 * sc; v1 = v1 * sc; u32x4 w; w.x = cvt_pk_bf16(v0[0], v0[1]); w.y = cvt_pk_bf16(v0[2], v0[3]); w.z = cvt_pk_bf16(v1[0], v1[1]); w.w = cvt_pk_bf16(v1[2], v1[3]);
                    *(u32x4*)(rowp + bj * HALF) = w; } }
    }
};

struct EpiOut {
    static constexpr bool PERM = true, AFTER_DRAIN = false;
    const float* X; float* Hout; bf16_t* HG; const float* mod; const float* gffn; float* ssqp;
    __device__ __forceinline__ void operator()(const f32x4 (&acc)[2][2][4][2], const Unit& u, int wr, int wc, int fr, int fq) const {
        const int row0 = u.pm * BM + wr * 64 + fr, col0 = u.pn * BM + wc * 32 + 8 * fq;
        const int b = (u.pm * BM) >> 13;
        const float* mb = mod + b * 6144;
        f32x4 g1v[2][2], gv2[2][2];
#pragma unroll
        for (int bj = 0; bj < 2; ++bj)
#pragma unroll
            for (int n = 0; n < 2; ++n) { const int c = col0 + bj * HALF + 4 * n;
                g1v[bj][n] = *(const f32x4*)(mb + 2048 + c);
                const f32x4 s2 = *(const f32x4*)(mb + 4096 + c), gf = *(const f32x4*)(gffn + c);
                gv2[bj][n] = gf * (s2 + 1.0f); }
#pragma unroll
        for (int ai = 0; ai < 2; ++ai)
#pragma unroll
            for (int m = 0; m < 4; ++m) { const int row = row0 + ai * HALF + m * 16; const size_t ro = (size_t)row * 1024 + col0; float ss = 0.f;
#pragma unroll
                for (int bj = 0; bj < 2; ++bj) {
                    const f32x4 x0 = *(const f32x4*)(X + ro + bj * HALF), x1 = *(const f32x4*)(X + ro + bj * HALF + 4);
                    const f32x4 h0 = x0 + g1v[bj][0] * acc[ai][bj][m][0], h1 = x1 + g1v[bj][1] * acc[ai][bj][m][1];
                    { u32x4 hw; hw.x = cvt_pk_bf16(h0[0], h0[1]); hw.y = cvt_pk_bf16(h0[2], h0[3]); hw.z = cvt_pk_bf16(h1[0], h1[1]); hw.w = cvt_pk_bf16(h1[2], h1[3]);
                      *(u32x4*)((bf16_t*)Hout + (size_t)row * 2048 + col0 + bj * HALF) = hw; }
                    ss += h0[0] * h0[0] + h0[1] * h0[1] + h0[2] * h0[2] + h0[3] * h0[3] + h1[0] * h1[0] + h1[1] * h1[1] + h1[2] * h1[2] + h1[3] * h1[3];
                    const f32x4 q0 = h0 * gv2[bj][0], q1 = h1 * gv2[bj][1];
                    u32x4 w; w.x = cvt_pk_bf16(q0[0], q0[1]); w.y = cvt_pk_bf16(q0[2], q0[3]); w.z = cvt_pk_bf16(q1[0], q1[1]); w.w = cvt_pk_bf16(q1[2], q1[3]);
                    *(u32x4*)(HG + ro + bj * HALF) = w; }
                ss += __shfl_xor(ss, 16); ss += __shfl_xor(ss, 32);
                if (fq == 0) ssqp[((size_t)u.pn * 32768 + row) * 4 + wc] = ss; }
    }
};
struct EpiScore {
    static constexpr bool PERM = false, AFTER_DRAIN = false;
    float* S; const float* ssqp; const float* biasq; float* rstd_out;
    __device__ __forceinline__ void operator()(const f32x4 (&acc)[2][2][4][2], const Unit& u, int wr, int wc, int fr, int fq) const {
        const int row0 = u.pm * BM + wr * 64 + fr, col0 = u.pn * BM + wc * 32 + 4 * fq;
        const int b = (u.pm * BM) >> 13;
        f32x4 bv[2][2];
#pragma unroll
        for (int bj = 0; bj < 2; ++bj)
#pragma unroll
            for (int n = 0; n < 2; ++n) bv[bj][n] = *(const f32x4*)(biasq + b * 2048 + col0 + bj * HALF + n * 16);
#pragma unroll
        for (int ai = 0; ai < 2; ++ai)
#pragma unroll
            for (int m = 0; m < 4; ++m) { const int row = row0 + ai * HALF + m * 16;
                const f32x4 p0 = *(const f32x4*)(ssqp + (size_t)row * 4), p1 = *(const f32x4*)(ssqp + ((size_t)32768 + row) * 4), p2 = *(const f32x4*)(ssqp + ((size_t)65536 + row) * 4), p3 = *(const f32x4*)(ssqp + ((size_t)98304 + row) * 4);
                const float tot = (p0[0] + p0[1] + p0[2] + p0[3]) + (p1[0] + p1[1] + p1[2] + p1[3]) + (p2[0] + p2[1] + p2[2] + p2[3]) + (p3[0] + p3[1] + p3[2] + p3[3]);
                const float rstd = __builtin_amdgcn_rsqf(tot * (1.0f / 1024.0f) + 1e-6f);
                if (u.pn == 0 && wc == 0 && fq == 0) rstd_out[row] = rstd;
                float* rowp = S + (size_t)row * 2048 + col0;
#pragma unroll
                for (int bj = 0; bj < 2; ++bj)
#pragma unroll
                    for (int n = 0; n < 2; ++n) *(f32x4*)(rowp + bj * HALF + n * 16) = acc[ai][bj][m][n] * rstd + bv[bj][n]; }
    }
};

struct EpiProj {
    static constexpr bool PERM = true, AFTER_DRAIN = false;
    bf16_t* O; int ldc;
    __device__ __forceinline__ void operator()(const f32x4 (&acc)[2][2][4][2], const Unit& u, int wr, int wc, int fr, int fq) const {
        asm volatile("" : "+v"(fr), "+v"(fq));
        const int row0 = u.pm * BM + wr * 64 + fr, col0 = u.pn * BM + wc * 32 + 8 * fq;
        const int cls = u.pn >> 1;
        const bool ident = (cls == 3) || (cls == 5), mulx = (cls == 0) || (cls == 4);
        const float sgn = (cls == 1 || cls == 2) ? 1.4426950408889634f : -1.4426950408889634f;
#pragma unroll
        for (int ai = 0; ai < 2; ++ai)
#pragma unroll
            for (int m = 0; m < 4; ++m) { bf16_t* rowp = O + (size_t)(row0 + ai * HALF + m * 16) * ldc + col0;
#pragma unroll
                for (int bj = 0; bj < 2; ++bj) { f32x4 v0 = acc[ai][bj][m][0], v1 = acc[ai][bj][m][1];
                    if (!ident) {
#pragma unroll
                        for (int j = 0; j < 4; ++j) { const float r0 = __builtin_amdgcn_rcpf(1.0f + __builtin_amdgcn_exp2f(sgn * v0[j])), r1 = __builtin_amdgcn_rcpf(1.0f + __builtin_amdgcn_exp2f(sgn * v1[j]));
                            v0[j] = mulx ? v0[j] * r0 : r0; v1[j] = mulx ? v1[j] * r1 : r1; } }
                    u32x4 w; w.x = cvt_pk_bf16(v0[0], v0[1]); w.y = cvt_pk_bf16(v0[2], v0[3]); w.z = cvt_pk_bf16(v1[0], v1[1]); w.w = cvt_pk_bf16(v1[2], v1[3]);
                    *(u32x4*)(rowp + bj * HALF) = w; } }
    }
};
template <class Epi, class Sched, bool ALIGN_EPI = false, bool SP2 = false>
__device__ __forceinline__ void gemm_phase(PG8_LAS unsigned char* lds, const Gemm g, const Sched& S, const Epi& E) {
    const int tid = threadIdx.x, wid = __builtin_amdgcn_readfirstlane(tid >> 6), lane = tid & 63, wr = wid >> 2, wc = wid & 3, fr = lane & 15, fq = lane >> 4;
    const int K = g.K, nt = K / BK;
    unsigned voffA[2], voffB[2];
#pragma unroll
    for (int i = 0; i < 2; ++i) { int R, C; stage_rc(tid * 16 + i * 8192, R, C); const int Rb = Epi::PERM ? ((R & ~31) + perm32(R & 31)) : R;
        voffA[i] = (unsigned)(R * K + C) * 2u; voffB[i] = (unsigned)(Rb * K + C) * 2u; }
    const size_t kstep = (size_t)(BK * 2);
    const size_t hstep = (size_t)HALF * K * 2;
    const size_t tstep = 2 * hstep;
    const unsigned ldsw = (unsigned)wid * 1024u;
    const int aoff = lds_byte(wr * 64 + fr, fq * 8), boff = lds_byte(wc * 32 + fr, fq * 8);
#define PG8_SA(b, h) (((b) * 2 + (h)) * HTB)
#define PG8_SB(b, h) ((4 + (b) * 2 + (h)) * HTB)
#define PG8_STAGE(bufoff, gbase, voff) do { _Pragma("unroll") for (int _i = 0; _i < 2; ++_i) \
        __builtin_amdgcn_global_load_lds((const unsigned*)((const char*)(gbase) + (voff)[_i]), (PG8_LAS unsigned*)(lds + (bufoff) + ldsw + _i * 8192), 16, 0, 0); } while (0)
#define PG8_LDA(dst, b, h) do { _Pragma("unroll") for (int m = 0; m < 4; ++m) _Pragma("unroll") for (int k = 0; k < 2; ++k) dst[m][k] = *(const PG8_LAS bf16x8*)(lds + PG8_SA(b, h) + aoff + m * 2048 + k * 1024); } while (0)
#define PG8_LDB(dst, b, h) do { _Pragma("unroll") for (int n = 0; n < 2; ++n) _Pragma("unroll") for (int k = 0; k < 2; ++k) dst[n][k] = *(const PG8_LAS bf16x8*)(lds + PG8_SB(b, h) + boff + n * 2048 + k * 1024); } while (0)
#define PG8_MMA(ai, bj, At, Bt) do { __builtin_amdgcn_s_setprio(1); _Pragma("unroll") for (int m = 0; m < 4; ++m) _Pragma("unroll") for (int n = 0; n < 2; ++n) _Pragma("unroll") for (int k = 0; k < 2; ++k) \
        acc[ai][bj][m][n] = __builtin_amdgcn_mfma_f32_16x16x32_bf16(Bt[n][k], At[m][k], acc[ai][bj][m][n], 0, 0, 0); __builtin_amdgcn_s_setprio(0); } while (0)
#define PG8_WAIT_V(n) asm volatile("s_waitcnt vmcnt(" #n ")" ::: "memory")
#define PG8_WAIT_L(n) asm volatile("s_waitcnt lgkmcnt(" #n ")" ::: "memory")
#define PG8_BAR __builtin_amdgcn_s_barrier()
#define PG8_SCHED __builtin_amdgcn_sched_barrier(0)
    Unit cur, nxt; int ui = 0;
    if (!S.next(0, cur)) return;
    f32x4 acc[2][2][4][2];
#pragma unroll
    for (int a = 0; a < 2; ++a)
#pragma unroll
        for (int b = 0; b < 2; ++b)
#pragma unroll
            for (int m = 0; m < 4; ++m)
#pragma unroll
                for (int n = 0; n < 2; ++n) acc[a][b][m][n] = (f32x4){0.f, 0.f, 0.f, 0.f};
    bf16x8 At[4][2], B0[2][2], B1[2][2];
    const char* cA = (const char*)g.A + (size_t)cur.pm * tstep; const char* cB = (const char*)g.Bt + (size_t)cur.pn * tstep;
    S.a_ready(cur);
    if constexpr (SP2) {
        PG8_STAGE(PG8_SB(0, 0), cB, voffB); PG8_STAGE(PG8_SB(0, 1), cB + hstep, voffB); PG8_STAGE(PG8_SA(0, 0), cA, voffA); PG8_STAGE(PG8_SA(0, 1), cA + hstep, voffA);
        if (wr == 1) PG8_BAR;
        PG8_WAIT_V(2); PG8_BAR;
        PG8_STAGE(PG8_SB(1, 0), cB + kstep, voffB); PG8_STAGE(PG8_SA(1, 0), cA + kstep, voffA); PG8_STAGE(PG8_SB(1, 1), cB + hstep + kstep, voffB);
        PG8_WAIT_V(6); PG8_BAR;
    } else {
        PG8_STAGE(PG8_SB(0, 0), cB, voffB); PG8_STAGE(PG8_SA(0, 0), cA, voffA); PG8_STAGE(PG8_SB(0, 1), cB + hstep, voffB); PG8_STAGE(PG8_SA(0, 1), cA + hstep, voffA);
        if (wr == 1) PG8_BAR;
        PG8_WAIT_V(4); PG8_BAR;
        PG8_STAGE(PG8_SB(1, 0), cB + kstep, voffB); PG8_STAGE(PG8_SA(1, 0), cA + kstep, voffA); PG8_STAGE(PG8_SB(1, 1), cB + hstep + kstep, voffB);
        PG8_WAIT_V(6); PG8_BAR;
    }
    for (;;) {
        const bool has_next = S.next(ui + 1, nxt);
        const char* nA = has_next ? (const char*)g.A + (size_t)nxt.pm * tstep : cA; const char* nB = has_next ? (const char*)g.Bt + (size_t)nxt.pn * tstep : cB;
        for (int t = 0; t < nt; t += 2) {
            const bool last = (t == nt - 2);
            const char* a1 = cA + (size_t)(t + 1) * kstep;
            const char* a2 = last ? nA : cA + (size_t)(t + 2) * kstep; const char* b2 = last ? nB : cB + (size_t)(t + 2) * kstep;
            const char* a3 = a2 + kstep; const char* b3 = b2 + kstep;
            if (last && has_next) S.a_ready(nxt);
            if constexpr (SP2) {
            PG8_LDB(B0, 0, 0); PG8_LDB(B1, 0, 1); PG8_SCHED; PG8_LDA(At, 0, 0); PG8_STAGE(PG8_SA(1, 1), a1 + hstep, voffA);
            PG8_WAIT_V(8); PG8_WAIT_L(0); PG8_BAR; PG8_MMA(0, 0, At, B0); PG8_MMA(0, 1, At, B1); PG8_BAR; PG8_SCHED;
            PG8_LDA(At, 0, 1); PG8_STAGE(PG8_SB(0, 0), b2, voffB); PG8_STAGE(PG8_SB(0, 1), b2 + hstep, voffB); PG8_STAGE(PG8_SA(0, 0), a2, voffA);
            PG8_WAIT_V(8); PG8_WAIT_L(0); PG8_BAR; PG8_MMA(1, 0, At, B0); PG8_MMA(1, 1, At, B1); PG8_BAR; PG8_SCHED;
            PG8_LDB(B0, 1, 0); PG8_LDB(B1, 1, 1); PG8_SCHED; PG8_LDA(At, 1, 0); PG8_STAGE(PG8_SA(0, 1), a2 + hstep, voffA);
            PG8_WAIT_V(8); PG8_WAIT_L(0); PG8_BAR; PG8_MMA(0, 0, At, B0); PG8_MMA(0, 1, At, B1); PG8_BAR; PG8_SCHED;
            PG8_LDA(At, 1, 1); PG8_STAGE(PG8_SB(1, 0), b3, voffB); PG8_STAGE(PG8_SB(1, 1), b3 + hstep, voffB); PG8_STAGE(PG8_SA(1, 0), a3, voffA);
            PG8_WAIT_V(8); PG8_WAIT_L(0); PG8_BAR; PG8_MMA(1, 0, At, B0); PG8_MMA(1, 1, At, B1); PG8_BAR; PG8_SCHED;
            } else {
            PG8_LDB(B0, 0, 0); PG8_SCHED; PG8_LDA(At, 0, 0); PG8_STAGE(PG8_SA(1, 1), a1 + hstep, voffA);
            PG8_WAIT_L(8); PG8_BAR; PG8_WAIT_L(0); PG8_MMA(0, 0, At, B0); PG8_BAR; PG8_SCHED;
            PG8_LDB(B1, 0, 1); PG8_STAGE(PG8_SB(0, 0), b2, voffB);
            PG8_BAR; PG8_WAIT_L(0); PG8_MMA(0, 1, At, B1); PG8_BAR;
            PG8_LDA(At, 0, 1); PG8_STAGE(PG8_SA(0, 0), a2, voffA);
            PG8_BAR; PG8_WAIT_L(0); PG8_MMA(1, 0, At, B0); PG8_BAR; PG8_SCHED;
            PG8_STAGE(PG8_SB(0, 1), b2 + hstep, voffB);
            PG8_WAIT_V(6); PG8_BAR; PG8_MMA(1, 1, At, B1); PG8_BAR;
            PG8_LDB(B0, 1, 0); PG8_SCHED; PG8_LDA(At, 1, 0); PG8_STAGE(PG8_SA(0, 1), a2 + hstep, voffA);
            PG8_WAIT_L(8); PG8_BAR; PG8_WAIT_L(0); PG8_MMA(0, 0, At, B0); PG8_BAR; PG8_SCHED;
            PG8_LDB(B1, 1, 1); PG8_STAGE(PG8_SB(1, 0), b3, voffB);
            PG8_BAR; PG8_WAIT_L(0); PG8_MMA(0, 1, At, B1); PG8_BAR;
            PG8_LDA(At, 1, 1); PG8_STAGE(PG8_SA(1, 0), a3, voffA);
            PG8_BAR; PG8_WAIT_L(0); PG8_MMA(1, 0, At, B0); PG8_BAR; PG8_SCHED;
            PG8_STAGE(PG8_SB(1, 1), b3 + hstep, voffB);
            PG8_WAIT_V(6); PG8_BAR; PG8_MMA(1, 1, At, B1); PG8_BAR;
            }
        }
        if constexpr (ALIGN_EPI) { if (wr == 0) PG8_BAR; }
        if constexpr (!Epi::AFTER_DRAIN) { E(acc, cur, wr, wc, fr, fq); S.done(cur); }
        if (!has_next) break;
#pragma unroll
        for (int a = 0; a < 2; ++a)
#pragma unroll
            for (int b = 0; b < 2; ++b)
#pragma unroll
                for (int m = 0; m < 4; ++m)
#pragma unroll
                    for (int n = 0; n < 2; ++n) acc[a][b][m][n] = (f32x4){0.f, 0.f, 0.f, 0.f};
        cur = nxt; cA = nA; cB = nB; ++ui;
        if constexpr (ALIGN_EPI) { if (wr == 1) PG8_BAR; }
    }
    PG8_WAIT_V(0);
    if constexpr (!ALIGN_EPI) { if (wr == 0) PG8_BAR; }
    PG8_BAR;
    if constexpr (Epi::AFTER_DRAIN) { E.fused(acc, cur, wr, wc, fr, fq, lds, wid, lane); S.done(cur); }
#undef PG8_SA
#undef PG8_SB
#undef PG8_STAGE
#undef PG8_LDA
#undef PG8_LDB
#undef PG8_MMA
#undef PG8_WAIT_V
#undef PG8_WAIT_L
#undef PG8_BAR
#undef PG8_SCHED
}
}
#define MK_ONE_LAUNCH 1

constexpr int NB = 4, SEQ = 8192, T = NB * SEQ, D = 1024;
constexpr int NIN = 3584, DH = 512, HD = 128, NHH = 4, CHK = 64;
constexpr int NSEG = 16, SEGC = 8;
constexpr int CW = 31, CPAD = 15, DC = 512;
constexpr int PHEADS = 8, NQK = 2048, NSEL = 128;
constexpr float EPS = 1e-6f;
constexpr int NWAVES = 8, NTHR = 512;

constexpr size_t MiB = 1u << 20;
constexpr size_t WS_CTL = 0, CTL_ZERO_BYTES = 65536;
constexpr size_t WS_MOD = 1 * MiB, WS_FMOD = WS_MOD + 131072, WS_LB = WS_MOD + 196608, WS_BIASQ = WS_MOD + 262144;
constexpr size_t WS_WIN = 2 * MiB, WS_WOUT = 10 * MiB, WS_WQK = 12 * MiB;
constexpr size_t WS_UT = 16 * MiB, WS_VT = 48 * MiB;
constexpr size_t WS_BUFA = 80 * MiB;
constexpr size_t WS_BUFB = 144 * MiB;
constexpr size_t WS_SEG = 208 * MiB;
constexpr size_t WS_E = 208 * MiB, WS_W = 224 * MiB;
constexpr size_t WS_BIG = 240 * MiB;
constexpr size_t WS_SSQ = 496 * MiB;
constexpr size_t WS_SEGA = 498 * MiB;
constexpr size_t WS_RSTD = 499 * MiB;
constexpr size_t WS_END = 500 * MiB;
constexpr size_t WS_PACT = 240 * MiB;
constexpr size_t WS_Y = 368 * MiB;
constexpr int NSL = 8, CSL = 128;
constexpr float VSCALE = 16.0f;
constexpr float UQSCALE = 677.0f;
constexpr int CW_QU = 8192, CW_QV = 8192 + 64 * 16;
constexpr int CW_BAR = 1024;

#ifndef LDSFILL
#define LDSFILL 0u
#endif
constexpr int LDS_BYTES = 155648;
constexpr int MISC_OFF = LDS_BYTES - 256;

#define GAS __attribute__((address_space(1)))
#define LAS __attribute__((address_space(3)))
typedef unsigned short bf16;
typedef unsigned v4u __attribute__((ext_vector_type(4)));
typedef unsigned v2u __attribute__((ext_vector_type(2)));
typedef float f32x4 __attribute__((ext_vector_type(4)));
typedef float f32x16 __attribute__((ext_vector_type(16)));
typedef short bf16x8 __attribute__((ext_vector_type(8)));
typedef float f32x2_ __attribute__((ext_vector_type(2)));

__device__ __forceinline__ float bf2f(unsigned h) { return __builtin_bit_cast(float, h << 16); }
__device__ __forceinline__ float bflo(unsigned u) { return __builtin_bit_cast(float, u << 16); }
__device__ __forceinline__ float bfhi(unsigned u) { return __builtin_bit_cast(float, u & 0xffff0000u); }
__device__ __forceinline__ unsigned f2bf(float f) { unsigned u = __builtin_bit_cast(unsigned, f); return (u + 0x7fffu + ((u >> 16) & 1u)) >> 16; }
__device__ __forceinline__ unsigned pk2(float lo, float hi) { return f2bf(lo) | (f2bf(hi) << 16); }
__device__ __forceinline__ unsigned cvtpk(float lo, float hi) { unsigned r; asm("v_cvt_pk_bf16_f32 %0, %1, %2" : "=v"(r) : "v"(lo), "v"(hi)); return r; }
__device__ __forceinline__ float sigmoidf_(float x) { return __builtin_amdgcn_rcpf(1.0f + __expf(-x)); }
#define DPP_ADD(s, ctrl) ((s) + __builtin_bit_cast(float, __builtin_amdgcn_update_dpp(0, __builtin_bit_cast(int, (s)), (ctrl), 0xF, 0xF, false)))
__device__ __forceinline__ float wave_sum(float v) {
#pragma unroll
    for (int o = 1; o < 64; o <<= 1) v += __shfl_xor(v, o);
    return v;
}

#define XB_TMO      128
#define XB_XCNT(j)  (256  + 64 * (j))
#define XB_XSUB(j)  (1280 + 64 * (j))
#define XB_XGEN(j)  (2304 + 64 * (j))
#define XB_TOP      3328
#define XB_TOPGEN   3392
#define XCD_BAR_WORDS 3456
#define XB_SPIN_CAP (1u << 18)
__device__ __forceinline__ unsigned xb_ld(unsigned* p)              { return __hip_atomic_load(p, __ATOMIC_RELAXED, __HIP_MEMORY_SCOPE_AGENT); }
__device__ __forceinline__ unsigned xb_add(unsigned* p, unsigned v) { return __hip_atomic_fetch_add(p, v, __ATOMIC_RELAXED, __HIP_MEMORY_SCOPE_AGENT); }
__device__ __forceinline__ unsigned xb_xcc_id() { return (unsigned)__builtin_amdgcn_s_getreg((3 << 11) | 20) & 0xFu; }
#define XB_SPIN(cond, bar) do { unsigned _sp = 0; while (cond) { __builtin_amdgcn_s_sleep(1); \
    if ((++_sp & 255u) == 0u) { if (xb_ld(&(bar)[XB_TMO])) break; if (_sp > XB_SPIN_CAP) { atomicAdd(&(bar)[XB_TMO], 1u); break; } } } } while (0)
struct XcdBarrier { unsigned* bar; unsigned x; volatile LAS unsigned* st; };
__device__ __forceinline__ XcdBarrier xcd_barrier_post(unsigned* bar, volatile LAS unsigned* st) {
    XcdBarrier b; b.bar = bar; b.x = xb_xcc_id(); b.st = st;
    if (threadIdx.x == 0) (void)xb_add(&bar[XB_XCNT(b.x)], 1u);
    return b;
}
__device__ __forceinline__ void xcd_barrier_complete(unsigned* bar, unsigned x, unsigned& nloc, unsigned& nx) {
    const unsigned G = gridDim.x * gridDim.y * gridDim.z;
    unsigned sum, cnt, mine, sp = 0u;
    for (;;) {
        sum = 0u; cnt = 0u; mine = 0u;
#pragma unroll
        for (unsigned j = 0; j < 16; ++j) { const unsigned c = xb_ld(&bar[XB_XCNT(j)]); sum += c; cnt += (c > 0u) ? 1u : 0u; mine = (j == x) ? c : mine; }
        if (sum == G) break;
        __builtin_amdgcn_s_sleep(1);
        if ((++sp & 255u) == 0u) { if (xb_ld(&bar[XB_TMO])) break; if (sp > XB_SPIN_CAP) { atomicAdd(&bar[XB_TMO], 1u); break; } }
    }
    nloc = mine > 0u ? mine : 1u; nx = cnt > 0u ? cnt : 1u;
}
__device__ __forceinline__ void xcd_barrier(const XcdBarrier& b) {
    asm volatile("s_waitcnt vmcnt(0)" ::: "memory");
    __syncthreads();
    if (threadIdx.x == 0) {
        unsigned* bar = b.bar;
        __builtin_amdgcn_s_waitcnt(0);
        unsigned nloc = b.st[0], nx = b.st[1];
        if (nloc == 0u) { xcd_barrier_complete(bar, b.x, nloc, nx); b.st[0] = nloc; b.st[1] = nx; }
        const unsigned old = xb_add(&bar[XB_XSUB(b.x)], 1u);
        const unsigned gen = old / nloc;
        if (old + 1u == (gen + 1u) * nloc) {
            __builtin_amdgcn_fence(__ATOMIC_RELEASE, "agent");
            asm volatile("s_waitcnt vmcnt(0)" ::: "memory");
            const unsigned og = xb_add(&bar[XB_TOP], 1u);
            const unsigned tg = og / nx;
            if (og + 1u == (tg + 1u) * nx) xb_add(&bar[XB_TOPGEN], 1u);
            else XB_SPIN(xb_ld(&bar[XB_TOPGEN]) == tg, bar);
            __builtin_amdgcn_fence(__ATOMIC_ACQUIRE, "agent");
            xb_add(&bar[XB_XGEN(b.x)], 1u);
            asm volatile("s_waitcnt vmcnt(0)" ::: "memory");
        } else {
            XB_SPIN(xb_ld(&bar[XB_XGEN(b.x)]) == gen, bar);
            __builtin_amdgcn_fence(__ATOMIC_ACQUIRE, "agent");
            asm volatile("s_waitcnt vmcnt(0)" ::: "memory");
        }
    }
    __syncthreads();
}

struct Args { const float* in[23]; float* out; unsigned char* ws; int ph_lo, ph_hi; };
struct Frame {
    LAS unsigned char* lds;
    int tid, lane, wave, G, bid;
    const Args* a;
    __device__ __forceinline__ const float* x() const { return a->in[0]; }
    __device__ __forceinline__ const float* c() const { return a->in[1]; }
    __device__ __forceinline__ const float* ada_w() const { return a->in[2]; }
    __device__ __forceinline__ const float* ada_b() const { return a->in[3]; }
    __device__ __forceinline__ const float* g_mix() const { return a->in[4]; }
    __device__ __forceinline__ const float* w_in() const { return a->in[5]; }
    __device__ __forceinline__ const float* lbg_f() const { return a->in[6]; }
    __device__ __forceinline__ const float* lbg_b() const { return a->in[7]; }
    __device__ __forceinline__ const float* hnorm_g() const { return a->in[8]; }
    __device__ __forceinline__ const float* conv_w() const { return a->in[9]; }
    __device__ __forceinline__ const float* conv_b() const { return a->in[10]; }
    __device__ __forceinline__ const float* cln_g() const { return a->in[11]; }
    __device__ __forceinline__ const float* cln_b() const { return a->in[12]; }
    __device__ __forceinline__ const float* w_out() const { return a->in[13]; }
    __device__ __forceinline__ const float* g_ffn() const { return a->in[14]; }
    __device__ __forceinline__ const float* wq() const { return a->in[15]; }
    __device__ __forceinline__ const float* keys1() const { return a->in[16]; }
    __device__ __forceinline__ const float* keys2() const { return a->in[17]; }
    __device__ __forceinline__ const float* utab() const { return a->in[18]; }
    __device__ __forceinline__ const float* vtab() const { return a->in[19]; }
    __device__ __forceinline__ const float* fada_w() const { return a->in[20]; }
    __device__ __forceinline__ const float* fada_b() const { return a->in[21]; }
    __device__ __forceinline__ const float* fnorm_g() const { return a->in[22]; }
    __device__ __forceinline__ float* out() const { return a->out; }
    __device__ __forceinline__ float* mod() const { return (float*)(a->ws + WS_MOD); }
    __device__ __forceinline__ float* fmod() const { return (float*)(a->ws + WS_FMOD); }
    __device__ __forceinline__ float* lb() const { return (float*)(a->ws + WS_LB); }
    __device__ __forceinline__ float* biasq() const { return (float*)(a->ws + WS_BIASQ); }
    __device__ __forceinline__ float* ssqp() const { return (float*)(a->ws + WS_SSQ); }
    __device__ __forceinline__ float* sega() const { return (float*)(a->ws + WS_SEGA); }
    __device__ __forceinline__ float* segu() const { return (float*)(a->ws + WS_SEG); }
    __device__ __forceinline__ float* of() const { return (float*)(a->ws + WS_BUFB); }
    __device__ __forceinline__ float* scores() const { return (float*)(a->ws + WS_BIG); }
    __device__ __forceinline__ float* wsel() const { return (float*)(a->ws + WS_W); }
    __device__ __forceinline__ int* esel() const { return (int*)(a->ws + WS_E); }
    __device__ __forceinline__ bf16* Win_t() const { return (bf16*)(a->ws + WS_WIN); }
    __device__ __forceinline__ bf16* Wout_t() const { return (bf16*)(a->ws + WS_WOUT); }
    __device__ __forceinline__ bf16* Wqk_t() const { return (bf16*)(a->ws + WS_WQK); }
    __device__ __forceinline__ bf16* Ub() const { return (bf16*)(a->ws + WS_UT); }
    __device__ __forceinline__ bf16* Vb() const { return (bf16*)(a->ws + WS_VT); }
    __device__ __forceinline__ bf16* bufA() const { return (bf16*)(a->ws + WS_BUFA); }
    __device__ __forceinline__ bf16* hg() const { return (bf16*)(a->ws + WS_BUFB); }
    __device__ __forceinline__ bf16* proj() const { return (bf16*)(a->ws + WS_BIG); }
    __device__ __forceinline__ float* coef() const { return (float*)(a->ws + WS_BUFA); }
    __device__ __forceinline__ float* rstd() const { return (float*)(a->ws + WS_RSTD); }
    __device__ __forceinline__ bf16* pact() const { return (bf16*)(a->ws + WS_PACT); }
    __device__ __forceinline__ bf16* ybuf() const { return (bf16*)(a->ws + WS_Y); }
    __device__ __forceinline__ unsigned char* U8() const { return (unsigned char*)(a->ws + WS_UT); }
    __device__ __forceinline__ unsigned char* V8() const { return (unsigned char*)(a->ws + WS_VT); }
    __device__ __forceinline__ unsigned* ctl() const { return (unsigned*)(a->ws + WS_CTL); }
};

__device__ __forceinline__ void p0_gemv(Frame& F) {
    LAS float* cact = (LAS float*)(F.lds);
    LAS float* red = (LAS float*)(F.lds + 16384);
    for (int i = F.tid; i < 4096; i += NTHR) { const float c = F.c()[i]; cact[i] = c * sigmoidf_(c); }
    __syncthreads();
    for (int item = F.bid; item < 128; item += F.G) {
        const int col0 = item * 64; const float* W; int N, cc;
        if (col0 < 6144) { W = F.ada_w(); N = 6144; cc = col0; } else { W = F.fada_w(); N = 2048; cc = col0 - 6144; }
        const float* wp = W + (size_t)(F.wave * 128) * N + cc + F.lane;
        float a0 = 0.f, a1 = 0.f, a2 = 0.f, a3 = 0.f;
#pragma unroll 32
        for (int k = 0; k < 128; ++k) { const float w = wp[(size_t)k * N]; const int kk = F.wave * 128 + k;
            a0 += cact[kk] * w; a1 += cact[1024 + kk] * w; a2 += cact[2048 + kk] * w; a3 += cact[3072 + kk] * w; }
        red[(F.wave * 4 + 0) * 64 + F.lane] = a0; red[(F.wave * 4 + 1) * 64 + F.lane] = a1; red[(F.wave * 4 + 2) * 64 + F.lane] = a2; red[(F.wave * 4 + 3) * 64 + F.lane] = a3;
        __syncthreads();
        if (F.tid < 256) { const int b = F.tid >> 6, l = F.tid & 63; float s = 0.f;
#pragma unroll
            for (int w = 0; w < 8; ++w) s += red[(w * 4 + b) * 64 + l];
            if (col0 < 6144) F.mod()[b * 6144 + cc + l] = s + F.ada_b()[cc + l]; else F.fmod()[b * 2048 + cc + l] = s + F.fada_b()[cc + l]; }
        __syncthreads();
    }
}
__device__ __forceinline__ void p0_transpose_item(const float* W, int K, int N, bf16* WT, LAS float* scr, int item, int lane) {
    const int nblk = N / 32, kb = item / nblk, nb = item % nblk, k0 = 64 * kb, n0 = 32 * nb;
#pragma unroll
    for (int i = 0; i < 32; ++i) { const int kk = 2 * i + (lane >> 5); scr[kk * 33 + (lane & 31)] = W[(size_t)(k0 + kk) * N + n0 + (lane & 31)]; }
    asm volatile("s_waitcnt lgkmcnt(0)" ::: "memory");
    const int c = lane & 7;
#pragma unroll
    for (int j = 0; j < 4; ++j) { const int n = (lane >> 3) + 8 * j; const LAS float* s = scr + (8 * c) * 33 + n;
        v4u o; o.x = pk2(s[0 * 33], s[1 * 33]); o.y = pk2(s[2 * 33], s[3 * 33]); o.z = pk2(s[4 * 33], s[5 * 33]); o.w = pk2(s[6 * 33], s[7 * 33]);
        *(v4u*)(WT + (size_t)(n0 + n) * K + k0 + 8 * c) = o; }
    asm volatile("s_waitcnt lgkmcnt(0)" ::: "memory");
}
__device__ __forceinline__ void p0_wqk_item(Frame& F, int item, LAS float* scr) {
    const int jq = item & 7, kb = (item >> 3) & 15, hh = item >> 7, h = hh >> 1, half = hh & 1;
    const float* keys = (half ? F.keys2() : F.keys1()) + (size_t)(jq * 16) * 128;
    const float* wtile = F.wq() + (size_t)(kb * 64) * 2048 + h * 256 + half * 128;
    LAS float* kL = scr + 1280;
    { f32x4 k4[8];
#pragma unroll
      for (int i = 0; i < 8; ++i) k4[i] = *(const f32x4*)(keys + (i * 64 + F.lane) * 4);
#pragma unroll
      for (int i = 0; i < 8; ++i) *(LAS f32x4*)(kL + (i * 64 + F.lane) * 4) = k4[i]; }
    float acc[16];
#pragma unroll
    for (int j = 0; j < 16; ++j) acc[j] = 0.f;
    f32x4 t4[4], n4[4];
#pragma unroll
    for (int i = 0; i < 4; ++i) t4[i] = *(const f32x4*)(wtile + (size_t)(16 * i + (F.lane >> 2)) * 2048 + 4 * (F.lane & 3));
    for (int d0 = 0; d0 < 128; d0 += 16) {
        if (d0 + 16 < 128) {
#pragma unroll
            for (int i = 0; i < 4; ++i) n4[i] = *(const f32x4*)(wtile + (size_t)(16 * i + (F.lane >> 2)) * 2048 + d0 + 16 + 4 * (F.lane & 3)); }
#pragma unroll
        for (int i = 0; i < 4; ++i) *(LAS f32x4*)(scr + (16 * i + (F.lane >> 2)) * 20 + 4 * (F.lane & 3)) = t4[i];
        asm volatile("s_waitcnt lgkmcnt(0)" ::: "memory");
#pragma unroll
        for (int dd = 0; dd < 16; dd += 4) { const f32x4 a = *(LAS const f32x4*)(scr + F.lane * 20 + dd);
#pragma unroll
            for (int j = 0; j < 16; ++j) { const f32x4 kp = *(LAS const f32x4*)(kL + j * 128 + d0 + dd); acc[j] += a[0] * kp[0] + a[1] * kp[1] + a[2] * kp[2] + a[3] * kp[3]; } }
        asm volatile("s_waitcnt lgkmcnt(0)" ::: "memory");
#pragma unroll
        for (int i = 0; i < 4; ++i) t4[i] = n4[i];
    }
    bf16* o = F.Wqk_t() + (size_t)(h * 256 + half * 128 + jq * 16) * 1024 + kb * 64 + F.lane;
#pragma unroll
    for (int j = 0; j < 16; ++j) o[(size_t)j * 1024] = (bf16)f2bf(acc[j]);
}
__device__ __forceinline__ void p0_prologue(Frame& F) {
    if (F.bid < 128) p0_gemv(F);
    if (F.bid == 128 % F.G) { const int i = F.tid;
        F.lb()[i] = __builtin_amdgcn_rcpf(1.0f + __expf(F.lbg_f()[512 + i] - F.lbg_f()[i]));
        F.lb()[512 + i] = __builtin_amdgcn_rcpf(1.0f + __expf(F.lbg_b()[512 + i] - F.lbg_b()[i])); }
    LAS float* scr = (LAS float*)(F.lds + 32768 + F.wave * 14336);
    const int gw = F.wave * F.G + F.bid, NGW = F.G * NWAVES;
    constexpr int I_QK = 2048, I_IN = (D / 64) * (NIN / 32), I_OUT = (D / 64) * (D / 32), I_TAB = 2 * 16384 / 4;
    constexpr int NITEMS = I_QK + I_IN + I_OUT + I_TAB;
    for (int it = gw; it < NITEMS; it += NGW) {
        int r = it;
        if (r < I_QK) { p0_wqk_item(F, r, scr); continue; } r -= I_QK;
        if (r < I_IN) { p0_transpose_item(F.w_in(), D, NIN, F.Win_t(), scr, r, F.lane); continue; } r -= I_IN;
        if (r < I_OUT) { p0_transpose_item(F.w_out(), D, D, F.Wout_t(), scr, r, F.lane); continue; } r -= I_OUT;
        { const int tab = r >= 4096, rr = (tab ? r - 4096 : r) * 4; const float* src = (tab ? F.vtab() : F.utab()) + (size_t)rr * 1024; unsigned char* dst = tab ? F.V8() : F.U8();
          const float sc = tab ? VSCALE : UQSCALE;
#pragma unroll
          for (int q = 0; q < 16; ++q) { const int row = rr + (q >> 2), qq = q & 3; const f32x4 v = *(const f32x4*)(src + (q >> 2) * 1024 + qq * 256 + 4 * F.lane) * sc;
              int pk;
              if (tab) { pk = __builtin_amdgcn_cvt_pk_fp8_f32(v[0], v[1], 0, false); pk = __builtin_amdgcn_cvt_pk_fp8_f32(v[2], v[3], pk, true); }
              else { int q0 = (int)__builtin_rintf(v[0]), q1 = (int)__builtin_rintf(v[1]), q2 = (int)__builtin_rintf(v[2]), q3 = (int)__builtin_rintf(v[3]);
                  q0 = q0 < -127 ? -127 : (q0 > 127 ? 127 : q0); q1 = q1 < -127 ? -127 : (q1 > 127 ? 127 : q1); q2 = q2 < -127 ? -127 : (q2 > 127 ? 127 : q2); q3 = q3 < -127 ? -127 : (q3 > 127 ? 127 : q3);
                  pk = (q0 & 0xff) | ((q1 & 0xff) << 8) | ((q2 & 0xff) << 16) | (q3 << 24); }
              const int sl = 2 * qq + (F.lane >> 5);
              *(int*)(dst + ((size_t)sl * 16384 + row) * CSL + 4 * (F.lane & 31)) = pk; } }
    }
}

__device__ __forceinline__ void p1_norm(Frame& F) {
    const int gwc = F.bid * NWAVES + F.wave, NGW = F.G * NWAVES;
    for (int row0 = gwc * 16; row0 < T; row0 += NGW * 16) {
        const int b = row0 >> 13; const float* mb = F.mod() + b * 6144;
        f32x4 ca[4], cb[4];
#pragma unroll
        for (int j = 0; j < 4; ++j) { const int k = 256 * j + 4 * F.lane; const f32x4 g = *(const f32x4*)(F.g_mix() + k), s = *(const f32x4*)(mb + 1024 + k); ca[j] = g * (s + 1.0f); cb[j] = *(const f32x4*)(mb + k); }
#pragma unroll 4
        for (int r = 0; r < 16; ++r) { const float* xr = F.x() + (size_t)(row0 + r) * D;
            f32x4 v[4]; float ss = 0.f;
#pragma unroll
            for (int j = 0; j < 4; ++j) { v[j] = *(const f32x4*)(xr + 256 * j + 4 * F.lane); ss += v[j][0] * v[j][0] + v[j][1] * v[j][1] + v[j][2] * v[j][2] + v[j][3] * v[j][3]; }
            const float rstd = __builtin_amdgcn_rsqf(wave_sum(ss) * (1.0f / D) + EPS);
            bf16* o = F.bufA() + (size_t)(row0 + r) * D;
#pragma unroll
            for (int j = 0; j < 4; ++j) { const f32x4 y = v[j] * rstd * ca[j] + cb[j]; v2u w; w.x = pk2(y[0], y[1]); w.y = pk2(y[2], y[3]); *(v2u*)(o + 256 * j + 4 * F.lane) = w; } }
    }
    const int gw = F.wave * F.G + F.bid;
    for (int n0 = gw * 32; n0 < NQK; n0 += NGW * 32) {
        float sv[4][16];
#pragma unroll
        for (int b = 0; b < 4; ++b) { const float* sh2 = F.mod() + b * 6144 + 3072;
#pragma unroll
            for (int i = 0; i < 8; ++i) { sv[b][i] = sh2[8 * F.lane + i]; sv[b][8 + i] = sh2[512 + 8 * F.lane + i]; } }
        float res[4] = {0.f, 0.f, 0.f, 0.f};
        for (int q = 0; q < 32; ++q) { const int n = n0 + q;
            const v4u w0 = *(const v4u*)(F.Wqk_t() + (size_t)n * 1024 + 8 * F.lane), w1 = *(const v4u*)(F.Wqk_t() + (size_t)n * 1024 + 512 + 8 * F.lane);
            float wv[16];
#pragma unroll
            for (int i = 0; i < 4; ++i) { wv[2 * i] = bflo(w0[i]); wv[2 * i + 1] = bfhi(w0[i]); wv[8 + 2 * i] = bflo(w1[i]); wv[8 + 2 * i + 1] = bfhi(w1[i]); }
#pragma unroll
            for (int b = 0; b < 4; ++b) { float sm = 0.f;
#pragma unroll
                for (int i = 0; i < 16; ++i) sm += wv[i] * sv[b][i];
                sm = wave_sum(sm); if (F.lane == q) res[b] = sm; } }
        if (F.lane < 32) {
#pragma unroll
            for (int b = 0; b < 4; ++b) F.biasq()[b * 2048 + n0 + F.lane] = res[b]; }
    }
}

__device__ __forceinline__ void conv_item(Frame& F, int item, const float (&cw)[CW], float cbias) {
    LAS bf16* hbuf = (LAS bf16*)(F.lds);
    LAS float* ybuf = (LAS float*)(F.lds + 65536);
    const int tok0 = item * 32, b = tok0 >> 13, t0 = tok0 & (SEQ - 1), c = F.tid;
#pragma unroll
    for (int k = 0; k < 8; ++k) { const int pi = F.tid + NTHR * k; if (pi < 62 * 64) { const int r = pi >> 6, ch = pi & 63, t = t0 - CPAD + r; v4u o = {0u, 0u, 0u, 0u};
            if (t >= 0 && t < SEQ) { const bf16* pr = F.proj() + (size_t)(b * SEQ + t) * NIN + 8 * ch; const v4u a = *(const v4u*)(pr + 2560), g = *(const v4u*)(pr + 3072);
#pragma unroll
                for (int i = 0; i < 4; ++i) o[i] = cvtpk(bflo(a[i]) * bflo(g[i]), bfhi(a[i]) * bfhi(g[i])); }
            *(LAS v4u*)(hbuf + r * 512 + 8 * ch) = o; } }
    __syncthreads();
    float hv[62];
#pragma unroll
    for (int r = 0; r < 62; ++r) hv[r] = bf2f(hbuf[r * 512 + c]);
#pragma unroll
    for (int tt = 0; tt < 32; ++tt) { float acc = cbias;
#pragma unroll
        for (int j = 0; j < CW; ++j) acc += cw[j] * hv[tt + j];
        ybuf[tt * 512 + c] = acc; }
    __syncthreads();
#pragma unroll
    for (int q = 0; q < 4; ++q) { const int tt = F.wave * 4 + q;
        const f32x4 y0 = *(LAS const f32x4*)(ybuf + tt * 512 + 8 * F.lane), y1 = *(LAS const f32x4*)(ybuf + tt * 512 + 8 * F.lane + 4);
        const float mean = wave_sum((y0[0] + y0[1] + y0[2] + y0[3]) + (y1[0] + y1[1] + y1[2] + y1[3])) * (1.0f / DC);
        const f32x4 d0 = y0 - mean, d1 = y1 - mean;
        const float var = wave_sum((d0[0] * d0[0] + d0[1] * d0[1] + d0[2] * d0[2] + d0[3] * d0[3]) + (d1[0] * d1[0] + d1[1] * d1[1] + d1[2] * d1[2] + d1[3] * d1[3])) * (1.0f / DC);
        const float rstd = __builtin_amdgcn_rsqf(var + EPS);
        const f32x4 g0 = *(const f32x4*)(F.cln_g() + 8 * F.lane), g1 = *(const f32x4*)(F.cln_g() + 8 * F.lane + 4), b0 = *(const f32x4*)(F.cln_b() + 8 * F.lane), b1 = *(const f32x4*)(F.cln_b() + 8 * F.lane + 4);
        f32x4 z0 = d0 * rstd * g0 + b0, z1 = d1 * rstd * g1 + b1;
#pragma unroll
        for (int i = 0; i < 4; ++i) { z0[i] = z0[i] * sigmoidf_(z0[i]); z1[i] = z1[i] * sigmoidf_(z1[i]); }
        v4u w; w.x = cvtpk(z0[0], z0[1]); w.y = cvtpk(z0[2], z0[3]); w.z = cvtpk(z1[0], z1[1]); w.w = cvtpk(z1[2], z1[3]);
        *(v4u*)(F.bufA() + (size_t)(tok0 + tt) * D + 512 + 8 * F.lane) = w; }
    __syncthreads();
}

constexpr int PQ = 272, PT = 144;
constexpr int HL_QR = 0, HL_KR = 17408, HL_QE = 34816, HL_KET = 52224, HL_VT = 70656, HL_SCM = 89088, HL_ST = 98304, HL_PBLK = 133120  , HL_AV = 137216, HL_RS = 137728;
static_assert(HL_PBLK + 8 * 128 * 4 <= HL_AV && HL_AV + 512 <= HL_RS && HL_RS + 1024 <= 155648 - 256, "HGRN LDS map");
__device__ __forceinline__ bf16x8 ldf(LAS const unsigned char* base, int row, int pitch, int kbyte) { return *(LAS const bf16x8*)(base + row * pitch + kbyte); }
#define MFMA32(a, b, c) __builtin_amdgcn_mfma_f32_32x32x16_bf16((a), (b), (c), 0, 0, 0)

template <bool FULL>
__device__ __forceinline__ void hgrn_load(Frame& F, int b, int h, int dir, int chunk, unsigned (&rz)[8], unsigned (&rv)[8], unsigned (&rq)[8]) {
    const size_t tokbase = (size_t)b * SEQ + (size_t)chunk * CHK; const int zoff = dir ? 1024 : 512, c0 = 2 * F.lane;
#pragma unroll
    for (int i = 0; i < 8; ++i) { const int p = 8 * F.wave + i, tr = dir ? (63 - p) : p; const bf16* q = F.proj() + (tokbase + tr) * NIN + h * HD;
        rz[i] = *(const unsigned*)(q + zoff + c0); rv[i] = *(const unsigned*)(q + 1536 + c0); if (FULL) rq[i] = *(const unsigned*)(q + c0); }
}
template <bool FULL, int MODE>
__device__ __forceinline__ void hgrn_chunk(Frame& F, int b, int h, int dir, int chunk, int nchunk, f32x16 (&accS)[2], float lb0, float lb1, unsigned (&rz)[8], unsigned (&rv)[8], unsigned (&rq)[8]) {
    LAS unsigned char* lds = F.lds;
    int r = F.lane & 31, hh = F.lane >> 5, c0 = 2 * F.lane;
    asm volatile("" : "+v"(r), "+v"(hh), "+v"(c0));
    const int w = F.wave, rb = w;
    const size_t tokbase = (size_t)b * SEQ + (size_t)chunk * CHK;
    {
        const f32x2_ oml = {1.0f - lb0, 1.0f - lb1};
        f32x2_ f2[8], cf2[8], cr2[8];
        f32x2_ run = {1.f, 1.f};
#pragma unroll
        for (int i = 0; i < 8; ++i) { const f32x2_ kk = {bflo(rz[i]), bfhi(rz[i])}; f2[i] = 1.0f - oml * kk; run *= f2[i]; cf2[i] = run; }
        { f32x2_ q = {1.f, 1.f};
#pragma unroll
          for (int i = 7; i >= 0; --i) { cr2[i] = q; q *= f2[i]; } }
        LAS float* pblk = (LAS float*)(lds + HL_PBLK);
        *(LAS f32x2_*)(pblk + rb * 128 + c0) = run;
        __syncthreads();
        f32x2_ pre = {1.f, 1.f}, post = {1.f, 1.f}, mid = {1.f, 1.f};
        for (int q = 0; q < rb; ++q) pre *= *(LAS const f32x2_*)(pblk + q * 128 + c0);
        for (int q = rb + 1; q < 8; ++q) post *= *(LAS const f32x2_*)(pblk + q * 128 + c0);
        if (rb < 4) { for (int q = rb + 1; q < 4; ++q) mid *= *(LAS const f32x2_*)(pblk + q * 128 + c0); }
        else { for (int q = 4; q < rb; ++q) mid *= *(LAS const f32x2_*)(pblk + q * 128 + c0); }
        if (rb == 0) *(LAS f32x2_*)((LAS float*)(lds + HL_AV) + c0) = run * post;
        f32x2_ ke2[8];
#pragma unroll
        for (int i = 0; i < 8; ++i) ke2[i] = (1.0f - f2[i]) * cr2[i] * post;
        if (FULL) {
            if (rb < 4) {
#pragma unroll
                for (int i = 0; i < 8; ++i) { const int p = 8 * rb + i; const f32x2_ qs = {bflo(rq[i]), bfhi(rq[i])}, k2 = 1.0f - f2[i], G = cr2[i] * mid;
                    f32x2_ iG; iG[0] = __builtin_amdgcn_rcpf(G[0]); iG[1] = __builtin_amdgcn_rcpf(G[1]);
                    const f32x2_ qe = qs * pre * cf2[i], qr = qs * iG, kr = k2 * G;
                    *(LAS unsigned*)(lds + HL_QE + p * PQ + c0 * 2) = cvtpk(qe[0], qe[1]);
                    *(LAS unsigned*)(lds + HL_QR + p * PQ + c0 * 2) = cvtpk(qr[0], qr[1]);
                    *(LAS unsigned*)(lds + HL_KR + p * PQ + c0 * 2) = cvtpk(kr[0], kr[1]); }
            } else {
#pragma unroll
                for (int i = 0; i < 8; ++i) { const int p = 8 * rb + i; const f32x2_ qs = {bflo(rq[i]), bfhi(rq[i])}, k2 = 1.0f - f2[i], G = cf2[i] * mid;
                    f32x2_ iG; iG[0] = __builtin_amdgcn_rcpf(G[0]); iG[1] = __builtin_amdgcn_rcpf(G[1]);
                    const f32x2_ qe = qs * pre * cf2[i], qr = qs * G, kr = k2 * iG;
                    *(LAS unsigned*)(lds + HL_QE + p * PQ + c0 * 2) = cvtpk(qe[0], qe[1]);
                    *(LAS unsigned*)(lds + HL_QR + p * PQ + c0 * 2) = cvtpk(qr[0], qr[1]);
                    *(LAS unsigned*)(lds + HL_KR + p * PQ + c0 * 2) = cvtpk(kr[0], kr[1]); }
            }
        }
        v4u ka, kb, va, vb2;
        ka.x = cvtpk(ke2[0][0], ke2[1][0]); ka.y = cvtpk(ke2[2][0], ke2[3][0]); ka.z = cvtpk(ke2[4][0], ke2[5][0]); ka.w = cvtpk(ke2[6][0], ke2[7][0]);
        kb.x = cvtpk(ke2[0][1], ke2[1][1]); kb.y = cvtpk(ke2[2][1], ke2[3][1]); kb.z = cvtpk(ke2[4][1], ke2[5][1]); kb.w = cvtpk(ke2[6][1], ke2[7][1]);
        va.x = (rv[0] & 0xffffu) | (rv[1] << 16); va.y = (rv[2] & 0xffffu) | (rv[3] << 16); va.z = (rv[4] & 0xffffu) | (rv[5] << 16); va.w = (rv[6] & 0xffffu) | (rv[7] << 16);
        vb2.x = (rv[0] >> 16) | (rv[1] & 0xffff0000u); vb2.y = (rv[2] >> 16) | (rv[3] & 0xffff0000u); vb2.z = (rv[4] >> 16) | (rv[5] & 0xffff0000u); vb2.w = (rv[6] >> 16) | (rv[7] & 0xffff0000u);
        *(LAS v4u*)(lds + HL_KET + c0 * PT + 16 * rb) = ka; *(LAS v4u*)(lds + HL_KET + (c0 + 1) * PT + 16 * rb) = kb;
        *(LAS v4u*)(lds + HL_VT + c0 * PT + 16 * rb) = va; *(LAS v4u*)(lds + HL_VT + (c0 + 1) * PT + 16 * rb) = vb2;
    }
    if (nchunk >= 0) hgrn_load<FULL>(F, b, h, dir, nchunk, rz, rv, rq);
    __syncthreads();
    const int pbO = w & 1, vb = w >> 1;
    f32x16 accO, accU[2];
#pragma unroll
    for (int i = 0; i < 16; ++i) { accO[i] = 0.f; accU[0][i] = 0.f; accU[1][i] = 0.f; }
    if (FULL) {
        if (w < 3) { const int pbS = (w + 1) >> 1, sbS = (w == 2) ? 1 : 0; f32x16 sc;
#pragma unroll
            for (int i = 0; i < 16; ++i) sc[i] = 0.f;
#pragma unroll
            for (int s = 0; s < 8; ++s) sc = MFMA32(ldf(lds + HL_QR, pbS * 32 + r, PQ, 32 * s + 16 * hh), ldf(lds + HL_KR, sbS * 32 + r, PQ, 32 * s + 16 * hh), sc);
#pragma unroll
            for (int i = 0; i < 16; i += 2) { const int p = pbS * 32 + (i & 3) + 8 * (i >> 2) + 4 * hh, s = sbS * 32 + r;
                const unsigned pkd = cvtpk(s <= p ? sc[i] : 0.f, s <= p + 1 ? sc[i + 1] : 0.f);
                *(LAS bf16*)(lds + HL_SCM + p * PT + s * 2) = (bf16)pkd; *(LAS bf16*)(lds + HL_SCM + (p + 1) * PT + s * 2) = (bf16)(pkd >> 16); } }
        __builtin_amdgcn_sched_barrier(0);
#pragma unroll
        for (int s = 0; s < 8; ++s) accO = MFMA32(ldf(lds + HL_QE, pbO * 32 + r, PQ, 32 * s + 16 * hh), ldf(lds + HL_ST, vb * 32 + r, PQ, 32 * s + 16 * hh), accO);
        __builtin_amdgcn_sched_barrier(0);
    }
#pragma unroll
    for (int i = 0; i < 2; ++i) { const int db = 2 * (w & 1) + i;
#pragma unroll
        for (int s = 0; s < 4; ++s) accU[i] = MFMA32(ldf(lds + HL_VT, vb * 32 + r, PT, 32 * s + 16 * hh), ldf(lds + HL_KET, db * 32 + r, PT, 32 * s + 16 * hh), accU[i]); }
    __builtin_amdgcn_sched_barrier(0);
    if (FULL) __syncthreads();
    if (FULL) {
        const unsigned v = vb * 32 + r;
        const unsigned lrow = (MODE == 0 ? (unsigned)hh : (unsigned)(1 - hh)) * 4u;
        const size_t rbase = (MODE == 0) ? (tokbase + pbO * 32) : (tokbase + 63 - pbO * 32 - 4);
        const unsigned lo_of = lrow * DH + v, lo_pr = lrow * NIN + v, lo_a2 = lrow * D + v;
        float ofv[16]; unsigned gv[16];
        if (MODE == 1) {
#pragma unroll
            for (int i = 0; i < 16; ++i) { const int ci = (i & 3) + 8 * (i >> 2); ofv[i] = (F.of() + (rbase - ci) * DH + h * HD)[lo_of]; } }
        for (int sb = 0; sb <= pbO; ++sb)
#pragma unroll
            for (int s2 = 0; s2 < 2; ++s2) accO = MFMA32(ldf(lds + HL_SCM, pbO * 32 + r, PT, 64 * sb + 32 * s2 + 16 * hh), ldf(lds + HL_VT, vb * 32 + r, PT, 64 * sb + 32 * s2 + 16 * hh), accO);
        if (MODE == 0) {
#pragma unroll
            for (int i = 0; i < 16; ++i) { const int ci = (i & 3) + 8 * (i >> 2); (F.of() + (rbase + ci) * DH + h * HD)[lo_of] = accO[i]; }
        } else {
            LAS float* rs = (LAS float*)(lds + HL_RS);
#pragma unroll
            for (int i = 0; i < 16; ++i) { const int ci = (i & 3) + 8 * (i >> 2); gv[i] = (F.proj() + (rbase - ci) * NIN + 2048 + h * HD)[lo_pr]; }
            float ov[16];
#pragma unroll
            for (int i = 0; i < 16; ++i) { const int ci = (i & 3) + 8 * (i >> 2), p = pbO * 32 + ci + 4 * hh;
                ov[i] = accO[i] + ofv[i]; float ss = ov[i] * ov[i];
                ss = DPP_ADD(ss, 0x128); ss = DPP_ADD(ss, 0x124); ss = DPP_ADD(ss, 0x122); ss = DPP_ADD(ss, 0x121); ss += __shfl_xor(ss, 16);
                if (r == 0) rs[p * 4 + vb] = ss; }
            __syncthreads();
            const float ng = F.hnorm_g()[h * HD + v];
#pragma unroll
            for (int i = 0; i < 16; ++i) { const int ci = (i & 3) + 8 * (i >> 2), p = pbO * 32 + ci + 4 * hh;
                const f32x4 q = *(LAS const f32x4*)(rs + p * 4);
                const float rstd = __builtin_amdgcn_rsqf((q[0] + q[1] + q[2] + q[3]) * (1.0f / HD) + EPS);
                const float g = bf2f(gv[i]);
                (F.bufA() + (rbase - ci) * D + h * HD)[lo_a2] = (bf16)cvtpk(ov[i] * rstd * ng * g, 0.f); }
        }
    }
    {
        const LAS float* av = (const LAS float*)(lds + HL_AV);
#pragma unroll
        for (int i = 0; i < 2; ++i) { const int db = 2 * (w & 1) + i; const float a = av[db * 32 + r];
#pragma unroll
            for (int j = 0; j < 16; j += 2) { const float s0 = accS[i][j] * a + accU[i][j], s1 = accS[i][j + 1] * a + accU[i][j + 1]; accS[i][j] = s0; accS[i][j + 1] = s1;
                if (FULL) { const int vv = vb * 32 + (j & 3) + 8 * (j >> 2) + 4 * hh; const unsigned pkd = cvtpk(s0, s1);
                    *(LAS bf16*)(lds + HL_ST + vv * PQ + (db * 32 + r) * 2) = (bf16)pkd; *(LAS bf16*)(lds + HL_ST + (vv + 1) * PQ + (db * 32 + r) * 2) = (bf16)(pkd >> 16); } } }
    }
    __syncthreads();
}
__device__ __forceinline__ void h1_item(Frame& F, int item) {
    const int seg = item & 15, dir = (item >> 4) & 1, h = (item >> 5) & 3, b = item >> 7;
    const float lb0 = F.lb()[dir * 512 + h * HD + 2 * F.lane], lb1 = F.lb()[dir * 512 + h * HD + 2 * F.lane + 1];
    f32x16 accS[2];
#pragma unroll
    for (int i = 0; i < 16; ++i) { accS[0][i] = 0.f; accS[1][i] = 0.f; }
    float atot = 1.f; const int col = F.tid & 127;
    unsigned rzA[8], rvA[8], rzB[8], rvB[8], rq[8];
#define H1CH(c) (seg * SEGC + (dir ? (SEGC - 1 - (c)) : (c)))
    hgrn_load<false>(F, b, h, dir, H1CH(0), rzA, rvA, rq); hgrn_load<false>(F, b, h, dir, H1CH(1), rzB, rvB, rq);
    for (int c = 0; c < SEGC; c += 2) {
        hgrn_chunk<false, 0>(F, b, h, dir, H1CH(c), (c + 2 < SEGC) ? H1CH(c + 2) : -1, accS, lb0, lb1, rzA, rvA, rq);
        atot *= ((const LAS float*)(F.lds + HL_AV))[col];
        hgrn_chunk<false, 0>(F, b, h, dir, H1CH(c + 1), (c + 3 < SEGC) ? H1CH(c + 3) : -1, accS, lb0, lb1, rzB, rvB, rq);
        atot *= ((const LAS float*)(F.lds + HL_AV))[col]; }
#undef H1CH
    if (F.tid < 128) F.sega()[(size_t)item * 128 + col] = atot;
    float* U = F.segu() + (size_t)item * 16384;
#pragma unroll
    for (int i = 0; i < 2; ++i)
#pragma unroll
        for (int j = 0; j < 16; j += 4) { f32x4 o; o[0] = accS[i][j]; o[1] = accS[i][j + 1]; o[2] = accS[i][j + 2]; o[3] = accS[i][j + 3]; ((f32x4*)(U + (i * 4 + (j >> 2)) * NTHR * 4))[F.tid] = o; }
}
__device__ __forceinline__ void h2_init_state(Frame& F, int b, int h, int dir, int seg, f32x16 (&accS)[2]) {
    const int w = F.wave, r = F.lane & 31, hh = F.lane >> 5, vb = w >> 1;
#pragma unroll
    for (int i = 0; i < 16; ++i) { accS[0][i] = 0.f; accS[1][i] = 0.f; }
    const int base = ((b * 4 + h) * 2 + dir) * 16;
    const int n = dir ? (NSEG - 1 - seg) : seg;
    for (int q0 = 0; q0 < n; q0 += 3) {
        f32x4 u4[3][8]; float av[3][2];
#pragma unroll
        for (int t = 0; t < 3; ++t) { const int q = (q0 + t < n) ? (q0 + t) : (n - 1); const int s = dir ? (NSEG - 1 - q) : q;
            const float* U = F.segu() + (size_t)(base + s) * 16384; const float* A = F.sega() + (size_t)(base + s) * 128;
#pragma unroll
            for (int i = 0; i < 2; ++i) av[t][i] = (A + (2 * (w & 1) + i) * 32)[r];
#pragma unroll
            for (int k = 0; k < 8; ++k) u4[t][k] = ((const f32x4*)(U + k * NTHR * 4))[F.tid]; }
#pragma unroll
        for (int t = 0; t < 3; ++t) { if (q0 + t < n) {
#pragma unroll
            for (int i = 0; i < 2; ++i) { const float a = av[t][i];
#pragma unroll
                for (int j = 0; j < 16; j += 4) { const f32x4 v = u4[t][i * 4 + (j >> 2)];
                    accS[i][j] = accS[i][j] * a + v[0]; accS[i][j + 1] = accS[i][j + 1] * a + v[1]; accS[i][j + 2] = accS[i][j + 2] * a + v[2]; accS[i][j + 3] = accS[i][j + 3] * a + v[3]; } } } }
    }
#pragma unroll
    for (int i = 0; i < 2; ++i) { const int db = 2 * (w & 1) + i;
#pragma unroll
        for (int j = 0; j < 16; ++j) { const int vv = vb * 32 + (j & 3) + 8 * (j >> 2) + 4 * hh; *(LAS bf16*)(F.lds + HL_ST + vv * PQ + (db * 32 + r) * 2) = (bf16)f2bf(accS[i][j]); } }
    __syncthreads();
}
__device__ __forceinline__ void h2_item(Frame& F, int item) {
    const int seg = item & 15, h = (item >> 4) & 3, b = item >> 6;
    f32x16 accS[2];
    unsigned rzA[8], rvA[8], rqA[8], rzB[8], rvB[8], rqB[8];
    { const float lb0 = F.lb()[h * HD + 2 * F.lane], lb1 = F.lb()[h * HD + 2 * F.lane + 1];
      const int c0 = seg * SEGC;
      hgrn_load<true>(F, b, h, 0, c0, rzA, rvA, rqA); hgrn_load<true>(F, b, h, 0, c0 + 1, rzB, rvB, rqB);
      h2_init_state(F, b, h, 0, seg, accS);
      for (int c = 0; c < SEGC; c += 2) {
          hgrn_chunk<true, 0>(F, b, h, 0, c0 + c, (c + 2 < SEGC) ? (c0 + c + 2) : -1, accS, lb0, lb1, rzA, rvA, rqA);
          hgrn_chunk<true, 0>(F, b, h, 0, c0 + c + 1, (c + 3 < SEGC) ? (c0 + c + 3) : -1, accS, lb0, lb1, rzB, rvB, rqB); } }
    asm volatile("s_waitcnt vmcnt(0)" ::: "memory");
    __syncthreads();
    { const float lb0 = F.lb()[512 + h * HD + 2 * F.lane], lb1 = F.lb()[512 + h * HD + 2 * F.lane + 1];
      const int cl = seg * SEGC + SEGC - 1;
      hgrn_load<true>(F, b, h, 1, cl, rzA, rvA, rqA); hgrn_load<true>(F, b, h, 1, cl - 1, rzB, rvB, rqB);
      h2_init_state(F, b, h, 1, seg, accS);
      for (int c = 0; c < SEGC; c += 2) {
          hgrn_chunk<true, 1>(F, b, h, 1, cl - c, (c + 2 < SEGC) ? (cl - c - 2) : -1, accS, lb0, lb1, rzA, rvA, rqA);
          hgrn_chunk<true, 1>(F, b, h, 1, cl - c - 1, (c + 3 < SEGC) ? (cl - c - 3) : -1, accS, lb0, lb1, rzB, rvB, rqB); } }
}

__device__ __forceinline__ unsigned f2key(float f) { const unsigned u = __builtin_bit_cast(unsigned, f); return (u & 0x80000000u) ? ~u : (u | 0x80000000u); }
__device__ __forceinline__ float key2f(unsigned k) { const unsigned u = (k & 0x80000000u) ? (k & 0x7fffffffu) : ~k; return __builtin_bit_cast(float, u); }
__device__ __forceinline__ unsigned umax_(unsigned a, unsigned b) { return a > b ? a : b; }
__device__ __forceinline__ unsigned umin_(unsigned a, unsigned b) { return a < b ? a : b; }
__device__ __forceinline__ void sort16(unsigned (&a)[16]) {
#pragma unroll
    for (int k = 2; k <= 16; k <<= 1)
#pragma unroll
        for (int j = k >> 1; j > 0; j >>= 1)
#pragma unroll
            for (int i = 0; i < 16; ++i) { const int l = i ^ j; if (l > i) { const bool desc = ((i & k) == 0); const unsigned x = a[i], y = a[l], mx = umax_(x, y), mn = umin_(x, y); a[i] = desc ? mx : mn; a[l] = desc ? mn : mx; } }
}
__device__ __forceinline__ void merge16(unsigned (&a)[16], const unsigned (&b)[16]) {
#pragma unroll
    for (int i = 0; i < 16; ++i) a[i] = umax_(a[i], b[15 - i]);
#pragma unroll
    for (int j = 8; j > 0; j >>= 1)
#pragma unroll
        for (int i = 0; i < 16; ++i) { const int l = i ^ j; if (l > i) { const unsigned x = a[i], y = a[l]; a[i] = umax_(x, y); a[l] = umin_(x, y); } }
}
__device__ __forceinline__ unsigned dpp_swap1(unsigned v) { return (unsigned)__builtin_amdgcn_update_dpp(0, (int)v, 0xB1, 0xF, 0xF, false); }
__device__ __forceinline__ unsigned pick_byte(const unsigned (&pk)[4], unsigned a) {
    const unsigned wsel = a >> 2; unsigned v = wsel == 0 ? pk[0] : (wsel == 1 ? pk[1] : (wsel == 2 ? pk[2] : pk[3]));
    return (v >> ((a & 3u) * 8u)) & 0xffu;
}
__device__ __forceinline__ void topk_stage2(const unsigned (&top)[16], bool tab0, size_t item, int* esel, float* wsel) {
        float vO[16], vP[16]; unsigned iOpk[4] = {0u, 0u, 0u, 0u}, iPpk[4] = {0u, 0u, 0u, 0u};
#pragma unroll
        for (int i = 0; i < 16; ++i) { const unsigned t = top[i], tp = dpp_swap1(t);
            vO[i] = key2f(t & ~0x7fu); vP[i] = key2f(tp & ~0x7fu);
            iOpk[i >> 2] |= (127u - (t & 0x7fu)) << ((i & 3) * 8); iPpk[i >> 2] |= (127u - (tp & 0x7fu)) << ((i & 3) * 8); }
        unsigned R[16], G1[16], G2[16], G3[16];
#define CAND(a, b) ((f2key(vO[a] + vP[b]) & ~0xffu) | (unsigned)(((a) << 4) | (b)))
#pragma unroll
        for (int i = 0; i < 16; ++i) R[i] = CAND(0, i);
        G1[0] = CAND(1, 0); G1[1] = CAND(1, 1); G1[2] = CAND(1, 2); G1[3] = CAND(1, 3); G1[4] = CAND(1, 4); G1[5] = CAND(1, 5); G1[6] = CAND(1, 6); G1[7] = CAND(1, 7);
        G1[8] = CAND(2, 0); G1[9] = CAND(2, 1); G1[10] = CAND(2, 2); G1[11] = CAND(2, 3); G1[12] = CAND(2, 4); G1[13] = CAND(3, 0); G1[14] = CAND(3, 1); G1[15] = CAND(3, 2);
        G2[0] = CAND(3, 3); G2[1] = CAND(4, 0); G2[2] = CAND(4, 1); G2[3] = CAND(4, 2); G2[4] = CAND(5, 0); G2[5] = CAND(5, 1); G2[6] = CAND(6, 0); G2[7] = CAND(6, 1);
        G2[8] = CAND(7, 0); G2[9] = CAND(7, 1); G2[10] = CAND(8, 0); G2[11] = CAND(9, 0); G2[12] = CAND(10, 0); G2[13] = CAND(11, 0); G2[14] = CAND(12, 0); G2[15] = CAND(13, 0);
        G3[0] = CAND(14, 0); G3[1] = CAND(15, 0);
#pragma unroll
        for (int i = 2; i < 16; ++i) G3[i] = 0u;
#undef CAND
        sort16(G1); sort16(G2); sort16(G3);
        merge16(R, G1); merge16(R, G2); merge16(R, G3);
        float sc[16], ex[16]; float sum = 0.f; unsigned eid[16];
        #pragma unroll
        for (int i = 0; i < 16; ++i) { sc[i] = key2f(R[i] & ~0xffu); const unsigned a = (R[i] >> 4) & 15u, bb = R[i] & 15u;
            const unsigned io = pick_byte(iOpk, a), ip = pick_byte(iPpk, bb);
            eid[i] = tab0 ? (io * 128u + ip) : (ip * 128u + io); }
#pragma unroll
        for (int i = 0; i < 16; ++i) { ex[i] = __expf(sc[i] - sc[0]); sum += ex[i]; }
        const float inv = 1.0f / sum;
        if (tab0) { const size_t o = item * 16;
#pragma unroll
            for (int q = 0; q < 4; ++q) { v4u ev; ev.x = eid[4 * q]; ev.y = eid[4 * q + 1]; ev.z = eid[4 * q + 2]; ev.w = eid[4 * q + 3]; *(v4u*)(esel + o + 4 * q) = ev;
                f32x4 wv; wv[0] = ex[4 * q] * inv; wv[1] = ex[4 * q + 1] * inv; wv[2] = ex[4 * q + 2] * inv; wv[3] = ex[4 * q + 3] * inv; *(f32x4*)(wsel + o + 4 * q) = wv; } }
}
__device__ __forceinline__ void p7_topk(Frame& F) {
    const int NT = T * PHEADS * 2;
    for (int g0 = (F.bid * NWAVES + F.wave) * 64; g0 < NT; g0 += F.G * NTHR) {
        const int g = g0 + F.lane; const float* wb = F.scores() + (size_t)g0 * 128;
        LAS float* stg = (LAS float*)(F.lds) + F.wave * (64 * 36);
        unsigned top[16];
#pragma unroll
        for (int sg = 0; sg < 4; ++sg) {
            f32x4 tl[8];
#pragma unroll
            for (int i = 0; i < 8; ++i) tl[i] = __builtin_nontemporal_load((const f32x4*)(wb + (size_t)(8 * i + (F.lane >> 3)) * 128 + sg * 32 + 4 * (F.lane & 7)));
#pragma unroll
            for (int i = 0; i < 8; ++i) *(LAS f32x4*)(stg + (8 * i + (F.lane >> 3)) * 36 + 4 * (F.lane & 7)) = tl[i];
            asm volatile("s_waitcnt lgkmcnt(0)" ::: "memory");
#pragma unroll
            for (int hg2 = 0; hg2 < 2; ++hg2) { const int grp = sg * 2 + hg2; unsigned k[16];
#pragma unroll
                for (int q = 0; q < 4; ++q) { const f32x4 v = *(LAS const f32x4*)(stg + F.lane * 36 + hg2 * 16 + q * 4);
#pragma unroll
                    for (int e = 0; e < 4; ++e) { const int j = grp * 16 + q * 4 + e; k[q * 4 + e] = (f2key(v[e]) & ~0x7fu) | (unsigned)(127 - j); } }
                sort16(k);
                if (grp == 0) {
#pragma unroll
                    for (int i = 0; i < 16; ++i) top[i] = k[i];
                } else merge16(top, k); }
            asm volatile("s_waitcnt lgkmcnt(0)" ::: "memory");
        }
        topk_stage2(top, (g & 1) == 0, (size_t)((g >> 1) & 7) * T + (size_t)(g >> 4), F.esel(), F.wsel());
    }
}


struct EpiScoreTopk {
    static constexpr bool PERM = false, AFTER_DRAIN = false;
    float* scr; const float* ssqp; const float* biasq; float* rstd_out; int* esel; float* wsel;
    __device__ __forceinline__ void operator()(const f32x4 (&acc)[2][2][4][2], const pg8::Unit& u, int wr, int wc, int fr, int fq) const {
        asm volatile("" : "+v"(fr), "+v"(fq));
        const int rl0 = wr * 64 + fr, col0 = wc * 32 + 4 * fq, b = (u.pm * 256) >> 13;
        f32x4 bv[2][2];
#pragma unroll
        for (int bj = 0; bj < 2; ++bj)
#pragma unroll
            for (int n = 0; n < 2; ++n) bv[bj][n] = *(const f32x4*)(biasq + b * 2048 + u.pn * 256 + col0 + bj * 128 + n * 16);
#pragma unroll
        for (int ai = 0; ai < 2; ++ai)
#pragma unroll
            for (int m = 0; m < 4; ++m) { const int rl = rl0 + ai * 128 + m * 16, row = u.pm * 256 + rl;
                const f32x4 p0 = *(const f32x4*)(ssqp + (size_t)row * 4), p1 = *(const f32x4*)(ssqp + ((size_t)32768 + row) * 4), p2 = *(const f32x4*)(ssqp + ((size_t)65536 + row) * 4), p3 = *(const f32x4*)(ssqp + ((size_t)98304 + row) * 4);
                const float tot = (p0[0] + p0[1] + p0[2] + p0[3]) + (p1[0] + p1[1] + p1[2] + p1[3]) + (p2[0] + p2[1] + p2[2] + p2[3]) + (p3[0] + p3[1] + p3[2] + p3[3]);
                const float rstd = __builtin_amdgcn_rsqf(tot * (1.0f / 1024.0f) + 1e-6f);
                if (u.pn == 0 && wc == 0 && fq == 0) rstd_out[row] = rstd;
                float* blk = scr + (2 * wr + 4 * ai + (m >> 1)) * 8192 + 8 * wc * 256 + 32 * (m & 1) * 4;
                const unsigned loff4 = (unsigned)(2 * fr + 64 * fq);
#pragma unroll
                for (int bj = 0; bj < 2; ++bj)
#pragma unroll
                    for (int n = 0; n < 2; ++n) ((f32x4*)(blk + (4 * n * 64 + bj) * 4))[loff4] = acc[ai][bj][m][n] * rstd + bv[bj][n]; }
        asm volatile("s_waitcnt vmcnt(0)" ::: "memory");
        __builtin_amdgcn_s_barrier();
        asm volatile("" ::: "memory");
        int tid = threadIdx.x; asm volatile("" : "+v"(tid));
        const int rl = tid >> 1, tab = tid & 1;
        const float* bp = scr + __builtin_amdgcn_readfirstlane(tid >> 6) * 8192;
        const unsigned lo4 = (unsigned)(tid & 63) * 4u;
        unsigned top[16];
        f32x4 cur[4], nxt[4];
#pragma unroll
        for (int q = 0; q < 4; ++q) cur[q] = *(const f32x4*)(bp + q * 256 + lo4);
#pragma unroll
        for (int grp = 0; grp < 8; ++grp) { unsigned k[16];
            if (grp < 7) {
#pragma unroll
                for (int q = 0; q < 4; ++q) nxt[q] = *(const f32x4*)(bp + ((grp + 1) * 4 + q) * 256 + lo4); }
#pragma unroll
            for (int q = 0; q < 4; ++q) { const f32x4 v = cur[q];
#pragma unroll
                for (int e = 0; e < 4; ++e) { const int j = grp * 16 + q * 4 + e; k[q * 4 + e] = (f2key(v[e]) & ~0x7fu) | (unsigned)(127 - j); } }
            sort16(k);
            if (grp == 0) {
#pragma unroll
                for (int i = 0; i < 16; ++i) top[i] = k[i];
            } else merge16(top, k);
#pragma unroll
            for (int q = 0; q < 4; ++q) cur[q] = nxt[q];
            __builtin_amdgcn_sched_barrier(0); }
        topk_stage2(top, tab == 0, (size_t)u.pn * T + (size_t)(u.pm * 256 + rl), esel, wsel);
    }
};

__device__ __forceinline__ void cvt16(const v4u& u, f32x2_ (&f)[8]) {
#pragma unroll
    for (int i = 0; i < 4; ++i) { f[2 * i] = __builtin_amdgcn_cvt_pk_f32_fp8((int)u[i], false); f[2 * i + 1] = __builtin_amdgcn_cvt_pk_f32_fp8((int)u[i], true); }
}
constexpr int PITEM = 8, NPITEM = T / PITEM;
__device__ __forceinline__ int peer_next(unsigned* q, int lane) {
    int idx = 0; if (lane == 0) idx = (int)__hip_atomic_fetch_add(q, 1u, __ATOMIC_RELAXED, __HIP_MEMORY_SCOPE_AGENT);
    return __builtin_amdgcn_readfirstlane(idx);
}
#define PEER_SB() __builtin_amdgcn_sched_barrier(0)
#define DPP_IADD(s, ctrl) ((s) + __builtin_amdgcn_update_dpp(0, (s), (ctrl), 0xF, 0xF, false))
__device__ __forceinline__ void p8_dots(const v4u (&ud)[16], const int (&hq)[4], int c8, int& r0, int& r1) {
#pragma unroll
    for (int i = 0; i < 16; ++i) { int sm = __builtin_amdgcn_sdot4((int)ud[i][0], hq[0], 0, false);
        sm = __builtin_amdgcn_sdot4((int)ud[i][1], hq[1], sm, false); sm = __builtin_amdgcn_sdot4((int)ud[i][2], hq[2], sm, false); sm = __builtin_amdgcn_sdot4((int)ud[i][3], hq[3], sm, false);
        sm = DPP_IADD(sm, 0xB1); sm = DPP_IADD(sm, 0x4E); sm = DPP_IADD(sm, 0x141);
        if ((i & 1) == 0) r0 = (c8 == (i >> 1)) ? sm : r0; else r1 = (c8 == (i >> 1)) ? sm : r1; }
}
constexpr int PSLAB = 12288;
__device__ __forceinline__ void p8_item(Frame& F, int sl, int item, int nitem, bool filled, LAS unsigned char* slab) {
    const int c8 = F.lane & 7, q8 = F.lane >> 3, t0 = item * PITEM;
    const unsigned char* ub = F.U8() + (size_t)sl * 16384 * CSL + 16 * c8;
    LAS int* eL = (LAS int*)slab; LAS unsigned char* hL = (LAS unsigned char*)(slab + 4096);
    LAS float* qL = (LAS float*)(slab + 6144);
    v4u t4[4], h2[2]; float rs2[2]; f32x4 sA, sB;
#define P8_BLK_LOAD(tb) do { \
        { const float* sp_ = F.mod() + ((tb) >> 13) * 6144 + 3072 + sl * CSL + 8 * (F.lane & 15); sA = *(const f32x4*)sp_; sB = *(const f32x4*)(sp_ + 4); } \
        _Pragma("unroll") for (int i = 0; i < 2; ++i) rs2[i] = F.rstd()[(tb) + 4 * i + (F.lane >> 4)]; \
        _Pragma("unroll") for (int i = 0; i < 4; ++i) t4[i] = __builtin_nontemporal_load((const v4u*)(F.esel() + ((size_t)(2 * i + (F.lane >> 5)) * T + (tb)) * 16) + (F.lane & 31)); \
        _Pragma("unroll") for (int i = 0; i < 2; ++i) h2[i] = __builtin_nontemporal_load((const v4u*)(F.hg() + (size_t)((tb) + 4 * i + (F.lane >> 4)) * D + sl * CSL + 8 * (F.lane & 15))); } while (0)
#define P8_Q8(x) ((int)__builtin_rintf((x) * qs_) & 0xff)
#define DPP_FMAX(v, ctrl) __builtin_fmaxf((v), __builtin_bit_cast(float, __builtin_amdgcn_update_dpp(0, __builtin_bit_cast(int, (v)), (ctrl), 0xF, 0xF, false)))
#define P8_BLK_STORE() do { _Pragma("unroll") for (int i = 0; i < 4; ++i) *(LAS v4u*)(eL + ((F.lane & 31) >> 2) * NSEL + (2 * i + (F.lane >> 5)) * 16 + 4 * (F.lane & 3)) = t4[i]; \
        _Pragma("unroll") for (int i = 0; i < 2; ++i) { const float r_ = rs2[i]; const v4u h_ = h2[i]; v2u o_; \
            const float x0 = bflo(h_[0]) * r_ + sA[0], x1 = bfhi(h_[0]) * r_ + sA[1], x2 = bflo(h_[1]) * r_ + sA[2], x3 = bfhi(h_[1]) * r_ + sA[3]; \
            const float x4 = bflo(h_[2]) * r_ + sB[0], x5 = bfhi(h_[2]) * r_ + sB[1], x6 = bflo(h_[3]) * r_ + sB[2], x7 = bfhi(h_[3]) * r_ + sB[3]; \
            float m_ = __builtin_fmaxf(__builtin_fmaxf(__builtin_fmaxf(__builtin_fabsf(x0), __builtin_fabsf(x1)), __builtin_fmaxf(__builtin_fabsf(x2), __builtin_fabsf(x3))), \
                                       __builtin_fmaxf(__builtin_fmaxf(__builtin_fabsf(x4), __builtin_fabsf(x5)), __builtin_fmaxf(__builtin_fabsf(x6), __builtin_fabsf(x7)))); \
            m_ = DPP_FMAX(m_, 0x128); m_ = DPP_FMAX(m_, 0x124); m_ = DPP_FMAX(m_, 0x122); m_ = DPP_FMAX(m_, 0x121); m_ = __builtin_fmaxf(m_, 1e-20f); \
            const float qs_ = 127.0f * __builtin_amdgcn_rcpf(m_); \
            if ((F.lane & 15) == 0) qL[4 * i + (F.lane >> 4)] = m_ * (1.0f / (127.0f * UQSCALE)); \
            o_[0] = (unsigned)(P8_Q8(x0) | (P8_Q8(x1) << 8) | (P8_Q8(x2) << 16) | (P8_Q8(x3) << 24)); \
            o_[1] = (unsigned)(P8_Q8(x4) | (P8_Q8(x5) << 8) | (P8_Q8(x6) << 16) | (P8_Q8(x7) << 24)); \
            *(LAS v2u*)(hL + (4 * i + (F.lane >> 4)) * 128 + 8 * (F.lane & 15)) = o_; } \
        asm volatile("s_waitcnt lgkmcnt(0)" ::: "memory"); } while (0)
    if (!filled) { P8_BLK_LOAD(t0); P8_BLK_STORE(); }
    bf16* po = F.pact() + ((size_t)t0 * NSL + sl) * NSEL + 16 * q8 + 2 * c8;
    v4u udA[16], udB[16];
#define P8_GATHER(dst, tt) do { v4u e_[4]; _Pragma("unroll") for (int k = 0; k < 4; ++k) e_[k] = *(LAS const v4u*)(eL + (tt) * NSEL + 16 * q8 + 4 * k); \
        _Pragma("unroll") for (int i = 0; i < 16; ++i) dst[i] = *(const v4u*)(ub + (size_t)e_[i >> 2][i & 3] * CSL); } while (0)
#define P8_HN(tt) int hq[4]; { const v4u hv_ = *(LAS const v4u*)(hL + (tt) * 128 + 16 * c8); hq[0] = (int)hv_[0]; hq[1] = (int)hv_[1]; hq[2] = (int)hv_[2]; hq[3] = (int)hv_[3]; }
#define P8_OUT(tt, r0, r1) do { const float dq_ = qL[tt]; __builtin_nontemporal_store(cvtpk((float)(r0) * dq_, (float)(r1) * dq_), (unsigned*)(po + (size_t)(tt) * NSL * NSEL)); } while (0)
    P8_GATHER(udA, 0);
    for (int tt = 0; tt < PITEM - 2; tt += 2) {
        P8_GATHER(udB, tt + 1);
        { P8_HN(tt); int r0 = 0, r1 = 0; p8_dots(udA, hq, c8, r0, r1); P8_OUT(tt, r0, r1); }
        P8_GATHER(udA, tt + 2);
        { P8_HN(tt + 1); int r0 = 0, r1 = 0; p8_dots(udB, hq, c8, r0, r1); P8_OUT(tt + 1, r0, r1); }
    }
    {
        P8_GATHER(udB, PITEM - 1);
        { P8_HN(PITEM - 2); int r0 = 0, r1 = 0; p8_dots(udA, hq, c8, r0, r1); P8_OUT(PITEM - 2, r0, r1); }
        if (nitem >= 0) P8_BLK_LOAD(nitem * PITEM);
        { P8_HN(PITEM - 1); int r0 = 0, r1 = 0; p8_dots(udB, hq, c8, r0, r1); P8_OUT(PITEM - 1, r0, r1); }
        if (nitem >= 0) P8_BLK_STORE();
    }
#undef P8_GATHER
#undef P8_HN
#undef P8_OUT
#undef P8_BLK_LOAD
#undef P8_BLK_STORE
#undef P8_Q8
#undef DPP_FMAX
}
__device__ __forceinline__ void p8b_coef(Frame& F) {
    const size_t N = (size_t)T * NSEL;
#pragma unroll 4
    for (size_t i = (size_t)F.bid * NTHR + F.tid; i < N; i += (size_t)F.G * NTHR) { const size_t t = i >> 7; const int j = (int)(i & 127);
        const bf16* pp = F.pact() + t * NSL * NSEL + j; float a = 0.f;
#pragma unroll
        for (int s = 0; s < NSL; ++s) a += bf2f(__builtin_nontemporal_load(pp + s * NSEL));
        F.coef()[i] = F.wsel()[((size_t)(j >> 4) * T + t) * 16 + (j & 15)] * 0.5f * a * (1.0f + erff(a * 0.70710678f)); }
}
__device__ __forceinline__ void p9_token(const v4u (&vd)[16], LAS const float* cL, bf16* yo, LAS float* red, int lane, int c8, int q8) {
    f32x4 cc[4];
#pragma unroll
    for (int k = 0; k < 4; ++k) cc[k] = *(LAS const f32x4*)(cL + 16 * q8 + 4 * k);
    f32x2_ y[8];
#pragma unroll
    for (int k = 0; k < 8; ++k) y[k] = (f32x2_){0.f, 0.f};
#pragma unroll
    for (int i = 0; i < 16; ++i) { f32x2_ vf[8]; cvt16(vd[i], vf); const float c = cc[i >> 2][i & 3]; const f32x2_ c2 = {c, c};
#pragma unroll
        for (int k = 0; k < 8; ++k) y[k] += c2 * vf[k];
        PEER_SB(); }
#pragma unroll
    for (int k = 0; k < 4; ++k) { f32x4 o; o[0] = y[2 * k][0]; o[1] = y[2 * k][1]; o[2] = y[2 * k + 1][0]; o[3] = y[2 * k + 1][1]; *(LAS f32x4*)(red + q8 * 128 + 16 * c8 + 4 * k) = o; }
    asm volatile("s_waitcnt lgkmcnt(0)" ::: "memory");
    f32x2_ sm = {0.f, 0.f};
#pragma unroll
    for (int g = 0; g < 8; ++g) sm += *(LAS const f32x2_*)(red + g * 128 + 2 * lane);
    sm = sm * (1.0f / VSCALE);
    __builtin_nontemporal_store(cvtpk(sm[0], sm[1]), (unsigned*)(yo + 2 * lane));
    asm volatile("s_waitcnt lgkmcnt(0)" ::: "memory");
    PEER_SB();
}
__device__ __forceinline__ void p9_item(Frame& F, int sl, int item, int nitem, bool filled, LAS unsigned char* slab) {
    const int c8 = F.lane & 7, q8 = F.lane >> 3, t0 = item * PITEM;
    const unsigned char* vb = F.V8() + (size_t)sl * 16384 * CSL + 16 * c8;
    LAS int* eL = (LAS int*)slab; LAS float* cL = (LAS float*)(slab + 4096); LAS float* red = (LAS float*)(slab + 8192);
    v4u t4[4], c4[4];
#define P9_BLK_LOAD(tb) do { const v4u* cp_ = (const v4u*)(F.coef() + (size_t)(tb) * NSEL); \
        _Pragma("unroll") for (int i = 0; i < 4; ++i) { t4[i] = __builtin_nontemporal_load((const v4u*)(F.esel() + ((size_t)(2 * i + (F.lane >> 5)) * T + (tb)) * 16) + (F.lane & 31)); c4[i] = __builtin_nontemporal_load(cp_ + i * 64 + F.lane); } } while (0)
#define P9_BLK_STORE() do { _Pragma("unroll") for (int i = 0; i < 4; ++i) { *(LAS v4u*)(eL + ((F.lane & 31) >> 2) * NSEL + (2 * i + (F.lane >> 5)) * 16 + 4 * (F.lane & 3)) = t4[i]; *(LAS v4u*)(cL + (i * 64 + F.lane) * 4) = c4[i]; } \
        asm volatile("s_waitcnt lgkmcnt(0)" ::: "memory"); } while (0)
    if (!filled) { P9_BLK_LOAD(t0); P9_BLK_STORE(); }
    bf16* yo = F.ybuf() + (size_t)t0 * D + sl * CSL;
    v4u vdA[16], vdB[16];
#define P9_GATHER(dst, tt) do { v4u e_[4]; _Pragma("unroll") for (int k = 0; k < 4; ++k) e_[k] = *(LAS const v4u*)(eL + (tt) * NSEL + 16 * q8 + 4 * k); \
        _Pragma("unroll") for (int i = 0; i < 16; ++i) dst[i] = *(const v4u*)(vb + (size_t)e_[i >> 2][i & 3] * CSL); } while (0)
    P9_GATHER(vdA, 0);
    for (int tt = 0; tt < PITEM - 2; tt += 2) {
        P9_GATHER(vdB, tt + 1);
        p9_token(vdA, cL + tt * NSEL, yo + (size_t)tt * D, red, F.lane, c8, q8);
        P9_GATHER(vdA, tt + 2);
        p9_token(vdB, cL + (tt + 1) * NSEL, yo + (size_t)(tt + 1) * D, red, F.lane, c8, q8);
    }
    {
        P9_GATHER(vdB, PITEM - 1);
        p9_token(vdA, cL + (PITEM - 2) * NSEL, yo + (size_t)(PITEM - 2) * D, red, F.lane, c8, q8);
        if (nitem >= 0) P9_BLK_LOAD(nitem * PITEM);
        p9_token(vdB, cL + (PITEM - 1) * NSEL, yo + (size_t)(PITEM - 1) * D, red, F.lane, c8, q8);
        if (nitem >= 0) P9_BLK_STORE();
    }
#undef P9_GATHER
#undef P9_BLK_LOAD
#undef P9_BLK_STORE
}
template <int SIDE>
__device__ __forceinline__ void peer_phase(Frame& F0, int rep) {
    Frame F = F0; asm volatile("" : "+v"(F.lane));
    const int s0 = (int)(xb_xcc_id() & 7u);
    unsigned* qbase = F.ctl() + (SIDE == 0 ? CW_QU : CW_QV) + rep * 64 * 32;
    LAS unsigned char* cf = F.lds + F.wave * PSLAB;
    for (int k = 0; k < NSL; ++k) { const int sl = (s0 + k) & (NSL - 1);
        int item = peer_next(qbase + 64 * sl, F.lane); bool filled = false;
        while (item < NPITEM) { int nitem = peer_next(qbase + 64 * sl, F.lane); if (nitem >= NPITEM) nitem = -1;
            if (SIDE == 0) p8_item(F, sl, item, nitem, filled, cf); else p9_item(F, sl, item, nitem, filled, cf);
            filled = nitem >= 0; item = nitem >= 0 ? nitem : NPITEM; } }
}
__device__ __forceinline__ void p10_final(Frame& F) {
    const int gwc = F.bid * NWAVES + F.wave, NGW = F.G * NWAVES;
    for (int row0 = gwc * 16; row0 < T; row0 += NGW * 16) {
        const int b = row0 >> 13; const float* mb = F.mod() + b * 6144 + 5120; const float* fm = F.fmod() + b * 2048;
        f32x4 g2[4], ca[4], cb[4];
#pragma unroll
        for (int j = 0; j < 4; ++j) { const int k = 256 * j + 4 * F.lane; g2[j] = *(const f32x4*)(mb + k); ca[j] = *(const f32x4*)(F.fnorm_g() + k) * (*(const f32x4*)(fm + 1024 + k) + 1.0f); cb[j] = *(const f32x4*)(fm + k); }
#pragma unroll 4
        for (int r = 0; r < 16; ++r) { float* hr = F.out() + (size_t)(row0 + r) * D; const bf16* yr = F.ybuf() + (size_t)(row0 + r) * D; const bf16* hb = (const bf16*)hr;
            f32x4 z[4]; float ss = 0.f;
#pragma unroll
            for (int j = 0; j < 4; ++j) { const v2u hq = *(const v2u*)(hb + 256 * j + 4 * F.lane); f32x4 hv; hv[0] = bflo(hq[0]); hv[1] = bfhi(hq[0]); hv[2] = bflo(hq[1]); hv[3] = bfhi(hq[1]);
                const v2u yq = __builtin_nontemporal_load((const v2u*)(yr + 256 * j + 4 * F.lane)); f32x4 yv; yv[0] = bflo(yq[0]); yv[1] = bfhi(yq[0]); yv[2] = bflo(yq[1]); yv[3] = bfhi(yq[1]);
                z[j] = hv + g2[j] * yv; ss += z[j][0] * z[j][0] + z[j][1] * z[j][1] + z[j][2] * z[j][2] + z[j][3] * z[j][3]; }
            const float rstd = __builtin_amdgcn_rsqf(wave_sum(ss) * (1.0f / D) + EPS);
#pragma unroll
            for (int j = 0; j < 4; ++j) *(f32x4*)(hr + 256 * j + 4 * F.lane) = z[j] * rstd * ca[j] + cb[j]; }
    }
}

constexpr int NPHASE = 12;
__global__ void __launch_bounds__(NTHR, 2) fwd_kernel(Args args) {
    extern __shared__ __attribute__((aligned(16))) unsigned char lds_raw[];
    Frame F;
    F.lds = (LAS unsigned char*)lds_raw;
    F.tid = threadIdx.x; F.lane = F.tid & 63; F.wave = __builtin_amdgcn_readfirstlane(F.tid >> 6); F.G = gridDim.x; F.bid = blockIdx.x;
    unsigned char* ws = args.ws; F.a = &args;
    volatile LAS unsigned* misc = (volatile LAS unsigned*)(F.lds + MISC_OFF);
    if (F.tid < 64) misc[F.tid] = 0u;
    __syncthreads();
    const int lo = args.ph_lo, hi = args.ph_hi;
    const bool multi = (hi - lo) > 1;
    XcdBarrier bar; bar.bar = (unsigned*)(ws + WS_CTL) + CW_BAR; bar.x = 0; bar.st = nullptr;
    if (multi) bar = xcd_barrier_post((unsigned*)(ws + WS_CTL) + CW_BAR, misc + 8);
#ifndef PHMASK
#define PHMASK 0xfff
#endif
#define IN(k) (((PHMASK >> (k)) & 1) && lo <= (k) && (k) < hi)
#define SEAM(k) do { if (IN(k) && IN((k) + 1)) xcd_barrier(bar); } while (0)

#ifndef REPMASK
#define REPMASK 0
#endif
#define REP(k) (((REPMASK) >> (k)) & 1)
#define REPBAR(k) if (REP(k) && rep == 0) xcd_barrier(bar)
    if (IN(0)) { for (int rep = 0; rep <= REP(0); ++rep) { p0_prologue(F); REPBAR(0); } } SEAM(0);
    if (IN(1)) { for (int rep = 0; rep <= REP(1); ++rep) { p1_norm(F); REPBAR(1); } } SEAM(1);
    if (IN(2)) { { pg8::Gemm g{F.bufA(), F.Win_t(), T, NIN, D}; pg8::StaticOrder S; S.init(T, NIN, F.G, F.bid);
        pg8::EpiProj E{F.proj(), NIN};
        pg8::gemm_phase<pg8::EpiProj, pg8::StaticOrder, true, true>(F.lds, g, S, E); }
#if ((REPMASK) >> 2) & 1
        xcd_barrier(bar); { pg8::Gemm g{F.bufA(), F.Win_t(), T, NIN, D}; pg8::StaticOrder S; S.init(T, NIN, F.G, F.bid);
        pg8::EpiProj E{F.proj(), NIN};
        pg8::gemm_phase<pg8::EpiProj, pg8::StaticOrder, true, true>(F.lds, g, S, E); }
#endif
    } SEAM(2);
    if (IN(3)) { for (int rep = 0; rep <= REP(3); ++rep) {
        for (int it = F.bid; it < NB * NHH * 2 * NSEG; it += F.G) h1_item(F, it);
        float cw[CW];
#pragma unroll
        for (int j = 0; j < CW; ++j) cw[j] = F.conv_w()[j * DC + F.tid];
        const float cbias = F.conv_b()[F.tid];
        for (int it = F.bid; it < T / 32; it += F.G) conv_item(F, it, cw, cbias); REPBAR(3); }
    } SEAM(3);
    if (IN(4)) { for (int rep = 0; rep <= REP(4); ++rep) { for (int it = F.bid; it < NB * NHH * NSEG; it += F.G) h2_item(F, it); REPBAR(4); } } SEAM(4);
    if (IN(5)) { { pg8::Gemm g{F.bufA(), F.Wout_t(), T, D, D}; pg8::StaticOrder S; S.init(T, D, F.G, F.bid);
        pg8::EpiOut E{F.x(), F.out(), F.hg(), F.mod(), F.g_ffn(), F.ssqp()};
        pg8::gemm_phase<pg8::EpiOut, pg8::StaticOrder, true, true>(F.lds, g, S, E); }
#if ((REPMASK) >> 5) & 1
        xcd_barrier(bar); { pg8::Gemm g{F.bufA(), F.Wout_t(), T, D, D}; pg8::StaticOrder S; S.init(T, D, F.G, F.bid);
        pg8::EpiOut E{F.x(), F.out(), F.hg(), F.mod(), F.g_ffn(), F.ssqp()};
        pg8::gemm_phase<pg8::EpiOut, pg8::StaticOrder, true, true>(F.lds, g, S, E); }
#endif
    } SEAM(5);
    if (IN(6)) { { pg8::Gemm g{F.hg(), F.Wqk_t(), T, NQK, D}; pg8::StaticOrder S; S.init(T, NQK, F.G, F.bid);
        EpiScoreTopk E{F.scores() + (size_t)F.bid * 65536, F.ssqp(), F.biasq(), F.rstd(), F.esel(), F.wsel()};
        pg8::gemm_phase<EpiScoreTopk, pg8::StaticOrder, true, true>(F.lds, g, S, E); }
    } SEAM(6);
    if (IN(8)) { for (int rep = 0; rep <= REP(8); ++rep) { peer_phase<0>(F, rep); REPBAR(8); } } SEAM(8);
    if (IN(9)) { for (int rep = 0; rep <= REP(9); ++rep) { p8b_coef(F); REPBAR(9); } } SEAM(9);
    if (IN(10)) { for (int rep = 0; rep <= REP(10); ++rep) { peer_phase<1>(F, rep); REPBAR(10); } } SEAM(10);
    if (IN(11)) { p10_final(F); }
#undef IN
#undef SEAM
}

#ifndef MK_ONE_LAUNCH
#define MK_ONE_LAUNCH 0
#endif
extern "C" void kernel_launch(void* const* d_in, const int* in_sizes, int n_in, void* d_out, int out_size, void* d_ws, size_t ws_size, hipStream_t stream) {
    static int grid = 0;
    if (grid == 0) {
        if (n_in != 23 || out_size != T * D || ws_size < WS_END) { fprintf(stderr, "kernel_launch: unexpected shapes (n_in %d, out %d, ws %zu)\n", n_in, out_size, ws_size); grid = -1; return; }
        int dev = 0, cus = 0, per_cu = 0;
        if (hipGetDevice(&dev) != hipSuccess || hipDeviceGetAttribute(&cus, hipDeviceAttributeMultiprocessorCount, dev) != hipSuccess) { grid = -1; return; }
        if (hipFuncSetAttribute((const void*)fwd_kernel, hipFuncAttributeMaxDynamicSharedMemorySize, LDS_BYTES) != hipSuccess) { fprintf(stderr, "kernel_launch: hipFuncSetAttribute failed\n"); grid = -1; return; }
        if (hipOccupancyMaxActiveBlocksPerMultiprocessor(&per_cu, (const void*)fwd_kernel, NTHR, LDS_BYTES) != hipSuccess || per_cu < 1) { fprintf(stderr, "kernel_launch: occupancy query reports %d\n", per_cu); }
        (void)hipGetLastError();
        grid = cus;
    }
    if (grid < 0) return;
    (void)hipMemsetAsync((char*)d_ws + WS_CTL, 0, CTL_ZERO_BYTES, stream);
    Args a{};
    for (int i = 0; i < 23; ++i) a.in[i] = (const float*)d_in[i];
    a.out = (float*)d_out; a.ws = (unsigned char*)d_ws;
#if MK_ONE_LAUNCH
    a.ph_lo = 0; a.ph_hi = NPHASE;
    hipLaunchKernelGGL(fwd_kernel, dim3(grid), dim3(NTHR), LDS_BYTES, stream, a);
#else
    for (int p = 0; p < NPHASE; ++p) { a.ph_lo = p; a.ph_hi = p + 1; hipLaunchKernelGGL(fwd_kernel, dim3(grid), dim3(NTHR), LDS_BYTES, stream, a); }
#endif
}
```

```cpp
#include <hip/hip_runtime.h>
#include <cstdio>
#include <cstdint>
namespace pg8 {
#define PG8_LAS __attribute__((address_space(3)))
typedef unsigned short bf16_t;
typedef short bf16x8 __attribute__((ext_vector_type(8)));
typedef float f32x4 __attribute__((ext_vector_type(4)));
typedef unsigned u32x4 __attribute__((ext_vector_type(4)));
constexpr int BM = 256, BK = 64, HALF = 128, HTB = HALF * BK * 2  , STAGE_BYTES = 8 * HTB, NXCD = 8, WGM = 8;

__host__ __device__ __forceinline__ int lds_byte(int r, int c) { const int st = (r >> 4) * 2 + (c >> 5), rr = r & 15, cc = c & 31, ob = rr * 64 + cc * 2; return st * 1024 + (ob ^ (((ob >> 9) & 1) << 5)); }
__host__ __device__ __forceinline__ void stage_rc(int b, int& R, int& C) { const int st = b / 1024, sb = b % 1024, swz = sb ^ (((sb >> 9) & 1) << 5); R = (st >> 1) * 16 + swz / 64; C = (st & 1) * 32 + (swz % 64) / 2; }
__host__ __device__ __forceinline__ int perm32(int rho) { const int n = rho >> 4, i = rho & 15; return 8 * (i >> 2) + 4 * n + (i & 3); }

struct Unit { int pm, pn; };
struct Gemm { const bf16_t* A; const bf16_t* Bt; int M, N, K; };

struct StaticOrder {
    int nM, nN, nwg, G, c;
    __host__ __device__ void init(int M, int N, int G_, int c_) { nM = M / BM; nN = N / BM; nwg = nM * nN; G = G_; c = c_; }
    __host__ __device__ bool next(int i, Unit& u) const {
        const long L = (long)i * G + c; if (L >= nwg) return false;
        int wgid = (int)L; { const int q = nwg / NXCD, r = nwg % NXCD, xcd = wgid % NXCD, off = wgid / NXCD; wgid = (xcd < r ? xcd * (q + 1) : r * (q + 1) + (xcd - r) * q) + off; }
        const int nig = WGM * nN, gid = wgid / nig, fm = gid * WGM, gsz = (nM - fm) < WGM ? (nM - fm) : WGM;
        u.pm = fm + ((wgid % nig) % gsz); u.pn = (wgid % nig) / gsz; return true;
    }
    __device__ __forceinline__ void a_ready(const Unit&) const {}
    __device__ __forceinline__ void done(const Unit&) const {}
};
__device__ __forceinline__ unsigned cvt_pk_bf16(float lo, float hi) { unsigned r; asm volatile("v_cvt_pk_bf16_f32 %0, %1, %2" : "=v"(r) : "v"(lo), "v"(hi)); return r; }
typedef float f32x2 __attribute__((ext_vector_type(2)));
__device__ __forceinline__ f32x2 gelu_pk(f32x2 v) {
    const f32x2 av = __builtin_elementwise_abs(v), d = av * 0.2316418882f + 1.0f;
    f32x2 t; t.x = __builtin_amdgcn_rcpf(d.x); t.y = __builtin_amdgcn_rcpf(d.y);
    f32x2 q = t * 0.5307027145f + (-0.7265760135f); q = q * t + 0.7107068705f; q = q * t + (-0.142248368f); q = q * t + 0.127414796f; q = q * t;
    const f32x2 s = (v * v) * (-0.72134752044f);
    f32x2 e; e.x = __builtin_amdgcn_exp2f(s.x); e.y = __builtin_amdgcn_exp2f(s.y);
    const f32x2 m = v * (q * e), r = v - m;
    f32x2 o; o.x = v.x < 0.f ? m.x : r.x; o.y = v.y < 0.f ? m.y : r.y; return o;
}

template <int ACT  > struct EpiBf16 {
    static constexpr bool PERM = true, AFTER_DRAIN = false; static_assert(ACT == 0 || ACT == 1, "EpiBf16: ACT is 0 (none) or 1 (gelu_pk)");
    bf16_t* O; int ldc; const float* bias; int split_cols; size_t split_stride; float scale0;
    __device__ __forceinline__ void operator()(const f32x4 (&acc)[2][2][4][2], const Unit& u, int wr, int wc, int fr, int fq) const {
        const int row0 = u.pm * BM + wr * 64 + fr; int colt = u.pn * BM; bf16_t* base = O;
        float sc = 1.f; if (split_cols) { const int t = colt / split_cols; base += (size_t)t * split_stride; colt -= t * split_cols; if (t == 0) sc = scale0; }
        const int col0 = colt + wc * 32 + 8 * fq, bcol0 = u.pn * BM + wc * 32 + 8 * fq;
        f32x4 bv[2][2];
#pragma unroll
        for (int bj = 0; bj < 2; ++bj)
#pragma unroll
            for (int n = 0; n < 2; ++n) bv[bj][n] = bias ? *(const f32x4*)(bias + bcol0 + bj * HALF + 4 * n) : (f32x4){0.f, 0.f, 0.f, 0.f};
#pragma unroll
        for (int ai = 0; ai < 2; ++ai)
#pragma unroll
            for (int m = 0; m < 4; ++m) { bf16_t* rowp = base + (size_t)(row0 + ai * HALF + m * 16) * ldc + col0;
#pragma unroll
                for (int bj = 0; bj < 2; ++bj) { f32x4 v0 = acc[ai][bj][m][0] + bv[bj][0], v1 = acc[ai][bj][m][1] + bv[bj][1];
                    if (ACT == 1) { f32x2 a = gelu_pk((f32x2){v0[0], v0[1]}), b = gelu_pk((f32x2){v0[2], v0[3]}), c = gelu_pk((f32x2){v1[0], v1[1]}), d = gelu_pk((f32x2){v1[2], v1[3]});
                        v0 = (f32x4){a.x, a.y, b.x, b.y}; v1 = (f32x4){c.x, c.y, d.x, d.y}; }
                    v0 = v0 * sc; v1 = v1 * sc; u32x4 w; w.x = cvt_pk_bf16(v0[0], v0[1]); w.y = cvt_pk_bf16(v0[2], v0[3]); w.z = cvt_pk_bf16(v1[0], v1[1]); w.w = cvt_pk_bf16(v1[2], v1[3]);
                    *(u32x4*)(rowp + bj * HALF) = w; } }
    }
};

struct EpiOut {
    static constexpr bool PERM = true, AFTER_DRAIN = false;
    const float* X; float* Hout; bf16_t* HG; const float* mod; const float* gffn; float* ssqp;
    __device__ __forceinline__ void operator()(const f32x4 (&acc)[2][2][4][2], const Unit& u, int wr, int wc, int fr, int fq) const {
        const int row0 = u.pm * BM + wr * 64 + fr, col0 = u.pn * BM + wc * 32 + 8 * fq;
        const int b = (u.pm * BM) >> 13;
        const float* mb = mod + b * 6144;
        f32x4 g1v[2][2], gv2[2][2];
#pragma unroll
        for (int bj = 0; bj < 2; ++bj)
#pragma unroll
            for (int n = 0; n < 2; ++n) { const int c = col0 + bj * HALF + 4 * n;
                g1v[bj][n] = *(const f32x4*)(mb + 2048 + c);
                const f32x4 s2 = *(const f32x4*)(mb + 4096 + c), gf = *(const f32x4*)(gffn + c);
                gv2[bj][n] = gf * (s2 + 1.0f); }
#pragma unroll
        for (int ai = 0; ai < 2; ++ai)
#pragma unroll
            for (int m = 0; m < 4; ++m) { const int row = row0 + ai * HALF + m * 16; const size_t ro = (size_t)row * 1024 + col0; float ss = 0.f;
#pragma unroll
                for (int bj = 0; bj < 2; ++bj) {
                    const f32x4 x0 = *(const f32x4*)(X + ro + bj * HALF), x1 = *(const f32x4*)(X + ro + bj * HALF + 4);
                    const f32x4 h0 = x0 + g1v[bj][0] * acc[ai][bj][m][0], h1 = x1 + g1v[bj][1] * acc[ai][bj][m][1];
                    { u32x4 hw; hw.x = cvt_pk_bf16(h0[0], h0[1]); hw.y = cvt_pk_bf16(h0[2], h0[3]); hw.z = cvt_pk_bf16(h1[0], h1[1]); hw.w = cvt_pk_bf16(h1[2], h1[3]);
                      *(u32x4*)((bf16_t*)Hout + (size_t)row * 2048 + col0 + bj * HALF) = hw; }
                    ss += h0[0] * h0[0] + h0[1] * h0[1] + h0[2] * h0[2] + h0[3] * h0[3] + h1[0] * h1[0] + h1[1] * h1[1] + h1[2] * h1[2] + h1[3] * h1[3];
                    const f32x4 q0 = h0 * gv2[bj][0], q1 = h1 * gv2[bj][1];
                    u32x4 w; w.x = cvt_pk_bf16(q0[0], q0[1]); w.y = cvt_pk_bf16(q0[2], q0[3]); w.z = cvt_pk_bf16(q1[0], q1[1]); w.w = cvt_pk_bf16(q1[2], q1[3]);
                    *(u32x4*)(HG + ro + bj * HALF) = w; }
                ss += __shfl_xor(ss, 16); ss += __shfl_xor(ss, 32);
                if (fq == 0) ssqp[((size_t)u.pn * 32768 + row) * 4 + wc] = ss; }
    }
};
struct EpiScore {
    static constexpr bool PERM = false, AFTER_DRAIN = false;
    float* S; const float* ssqp; const float* biasq; float* rstd_out;
    __device__ __forceinline__ void operator()(const f32x4 (&acc)[2][2][4][2], const Unit& u, int wr, int wc, int fr, int fq) const {
        const int row0 = u.pm * BM + wr * 64 + fr, col0 = u.pn * BM + wc * 32 + 4 * fq;
        const int b = (u.pm * BM) >> 13;
        f32x4 bv[2][2];
#pragma unroll
        for (int bj = 0; bj < 2; ++bj)
#pragma unroll
            for (int n = 0; n < 2; ++n) bv[bj][n] = *(const f32x4*)(biasq + b * 2048 + col0 + bj * HALF + n * 16);
#pragma unroll
        for (int ai = 0; ai < 2; ++ai)
#pragma unroll
            for (int m = 0; m < 4; ++m) { const int row = row0 + ai * HALF + m * 16;
                const f32x4 p0 = *(const f32x4*)(ssqp + (size_t)row * 4), p1 = *(const f32x4*)(ssqp + ((size_t)32768 + row) * 4), p2 = *(const f32x4*)(ssqp + ((size_t)65536 + row) * 4), p3 = *(const f32x4*)(ssqp + ((size_t)98304 + row) * 4);
                const float tot = (p0[0] + p0[1] + p0[2] + p0[3]) + (p1[0] + p1[1] + p1[2] + p1[3]) + (p2[0] + p2[1] + p2[2] + p2[3]) + (p3[0] + p3[1] + p3[2] + p3[3]);
                const float rstd = __builtin_amdgcn_rsqf(tot * (1.0f / 1024.0f) + 1e-6f);
                if (u.pn == 0 && wc == 0 && fq == 0) rstd_out[row] = rstd;
                float* rowp = S + (size_t)row * 2048 + col0;
#pragma unroll
                for (int bj = 0; bj < 2; ++bj)
#pragma unroll
                    for (int n = 0; n < 2; ++n) *(f32x4*)(rowp + bj * HALF + n * 16) = acc[ai][bj][m][n] * rstd + bv[bj][n]; }
    }
};

struct EpiProj {
    static constexpr bool PERM = true, AFTER_DRAIN = false;
    bf16_t* O; int ldc;
    __device__ __forceinline__ void operator()(const f32x4 (&acc)[2][2][4][2], const Unit& u, int wr, int wc, int fr, int fq) const {
        asm volatile("" : "+v"(fr), "+v"(fq));
        const int row0 = u.pm * BM + wr * 64 + fr, col0 = u.pn * BM + wc * 32 + 8 * fq;
        const int cls = u.pn >> 1;
        const bool ident = (cls == 3) || (cls == 5), mulx = (cls == 0) || (cls == 4);
        const float sgn = (cls == 1 || cls == 2) ? 1.4426950408889634f : -1.4426950408889634f;
#pragma unroll
        for (int ai = 0; ai < 2; ++ai)
#pragma unroll
            for (int m = 0; m < 4; ++m) { bf16_t* rowp = O + (size_t)(row0 + ai * HALF + m * 16) * ldc + col0;
#pragma unroll
                for (int bj = 0; bj < 2; ++bj) { f32x4 v0 = acc[ai][bj][m][0], v1 = acc[ai][bj][m][1];
                    if (!ident) {
#pragma unroll
                        for (int j = 0; j < 4; ++j) { const float r0 = __builtin_amdgcn_rcpf(1.0f + __builtin_amdgcn_exp2f(sgn * v0[j])), r1 = __builtin_amdgcn_rcpf(1.0f + __builtin_amdgcn_exp2f(sgn * v1[j]));
                            v0[j] = mulx ? v0[j] * r0 : r0; v1[j] = mulx ? v1[j] * r1 : r1; } }
                    u32x4 w; w.x = cvt_pk_bf16(v0[0], v0[1]); w.y = cvt_pk_bf16(v0[2], v0[3]); w.z = cvt_pk_bf16(v1[0], v1[1]); w.w = cvt_pk_bf16(v1[2], v1[3]);
                    *(u32x4*)(rowp + bj * HALF) = w; } }
    }
};
template <class Epi, class Sched, bool ALIGN_EPI = false, bool SP2 = false>
__device__ __forceinline__ void gemm_phase(PG8_LAS unsigned char* lds, const Gemm g, const Sched& S, const Epi& E) {
    const int tid = threadIdx.x, wid = __builtin_amdgcn_readfirstlane(tid >> 6), lane = tid & 63, wr = wid >> 2, wc = wid & 3, fr = lane & 15, fq = lane >> 4;
    const int K = g.K, nt = K / BK;
    unsigned voffA[2], voffB[2];
#pragma unroll
    for (int i = 0; i < 2; ++i) { int R, C; stage_rc(tid * 16 + i * 8192, R, C); const int Rb = Epi::PERM ? ((R & ~31) + perm32(R & 31)) : R;
        voffA[i] = (unsigned)(R * K + C) * 2u; voffB[i] = (unsigned)(Rb * K + C) * 2u; }
    const size_t kstep = (size_t)(BK * 2);
    const size_t hstep = (size_t)HALF * K * 2;
    const size_t tstep = 2 * hstep;
    const unsigned ldsw = (unsigned)wid * 1024u;
    const int aoff = lds_byte(wr * 64 + fr, fq * 8), boff = lds_byte(wc * 32 + fr, fq * 8);
#define PG8_SA(b, h) (((b) * 2 + (h)) * HTB)
#define PG8_SB(b, h) ((4 + (b) * 2 + (h)) * HTB)
#define PG8_STAGE(bufoff, gbase, voff) do { _Pragma("unroll") for (int _i = 0; _i < 2; ++_i) \
        __builtin_amdgcn_global_load_lds((const unsigned*)((const char*)(gbase) + (voff)[_i]), (PG8_LAS unsigned*)(lds + (bufoff) + ldsw + _i * 8192), 16, 0, 0); } while (0)
#define PG8_LDA(dst, b, h) do { _Pragma("unroll") for (int m = 0; m < 4; ++m) _Pragma("unroll") for (int k = 0; k < 2; ++k) dst[m][k] = *(const PG8_LAS bf16x8*)(lds + PG8_SA(b, h) + aoff + m * 2048 + k * 1024); } while (0)
#define PG8_LDB(dst, b, h) do { _Pragma("unroll") for (int n = 0; n < 2; ++n) _Pragma("unroll") for (int k = 0; k < 2; ++k) dst[n][k] = *(const PG8_LAS bf16x8*)(lds + PG8_SB(b, h) + boff + n * 2048 + k * 1024); } while (0)
#define PG8_MMA(ai, bj, At, Bt) do { __builtin_amdgcn_s_setprio(1); _Pragma("unroll") for (int m = 0; m < 4; ++m) _Pragma("unroll") for (int n = 0; n < 2; ++n) _Pragma("unroll") for (int k = 0; k < 2; ++k) \
        acc[ai][bj][m][n] = __builtin_amdgcn_mfma_f32_16x16x32_bf16(Bt[n][k], At[m][k], acc[ai][bj][m][n], 0, 0, 0); __builtin_amdgcn_s_setprio(0); } while (0)
#define PG8_WAIT_V(n) asm volatile("s_waitcnt vmcnt(" #n ")" ::: "memory")
#define PG8_WAIT_L(n) asm volatile("s_waitcnt lgkmcnt(" #n ")" ::: "memory")
#define PG8_BAR __builtin_amdgcn_s_barrier()
#define PG8_SCHED __builtin_amdgcn_sched_barrier(0)
    Unit cur, nxt; int ui = 0;
    if (!S.next(0, cur)) return;
    f32x4 acc[2][2][4][2];
#pragma unroll
    for (int a = 0; a < 2; ++a)
#pragma unroll
        for (int b = 0; b < 2; ++b)
#pragma unroll
            for (int m = 0; m < 4; ++m)
#pragma unroll
                for (int n = 0; n < 2; ++n) acc[a][b][m][n] = (f32x4){0.f, 0.f, 0.f, 0.f};
    bf16x8 At[4][2], B0[2][2], B1[2][2];
    const char* cA = (const char*)g.A + (size_t)cur.pm * tstep; const char* cB = (const char*)g.Bt + (size_t)cur.pn * tstep;
    S.a_ready(cur);
    if constexpr (SP2) {
        PG8_STAGE(PG8_SB(0, 0), cB, voffB); PG8_STAGE(PG8_SB(0, 1), cB + hstep, voffB); PG8_STAGE(PG8_SA(0, 0), cA, voffA); PG8_STAGE(PG8_SA(0, 1), cA + hstep, voffA);
        if (wr == 1) PG8_BAR;
        PG8_WAIT_V(2); PG8_BAR;
        PG8_STAGE(PG8_SB(1, 0), cB + kstep, voffB); PG8_STAGE(PG8_SA(1, 0), cA + kstep, voffA); PG8_STAGE(PG8_SB(1, 1), cB + hstep + kstep, voffB);
        PG8_WAIT_V(6); PG8_BAR;
    } else {
        PG8_STAGE(PG8_SB(0, 0), cB, voffB); PG8_STAGE(PG8_SA(0, 0), cA, voffA); PG8_STAGE(PG8_SB(0, 1), cB + hstep, voffB); PG8_STAGE(PG8_SA(0, 1), cA + hstep, voffA);
        if (wr == 1) PG8_BAR;
        PG8_WAIT_V(4); PG8_BAR;
        PG8_STAGE(PG8_SB(1, 0), cB + kstep, voffB); PG8_STAGE(PG8_SA(1, 0), cA + kstep, voffA); PG8_STAGE(PG8_SB(1, 1), cB + hstep + kstep, voffB);
        PG8_WAIT_V(6); PG8_BAR;
    }
    for (;;) {
        const bool has_next = S.next(ui + 1, nxt);
        const char* nA = has_next ? (const char*)g.A + (size_t)nxt.pm * tstep : cA; const char* nB = has_next ? (const char*)g.Bt + (size_t)nxt.pn * tstep : cB;
        for (int t = 0; t < nt; t += 2) {
            const bool last = (t == nt - 2);
            const char* a1 = cA + (size_t)(t + 1) * kstep;
            const char* a2 = last ? nA : cA + (size_t)(t + 2) * kstep; const char* b2 = last ? nB : cB + (size_t)(t + 2) * kstep;
            const char* a3 = a2 + kstep; const char* b3 = b2 + kstep;
            if (last && has_next) S.a_ready(nxt);
            if constexpr (SP2) {
            PG8_LDB(B0, 0, 0); PG8_LDB(B1, 0, 1); PG8_SCHED; PG8_LDA(At, 0, 0); PG8_STAGE(PG8_SA(1, 1), a1 + hstep, voffA);
            PG8_WAIT_V(8); PG8_WAIT_L(0); PG8_BAR; PG8_MMA(0, 0, At, B0); PG8_MMA(0, 1, At, B1); PG8_BAR; PG8_SCHED;
            PG8_LDA(At, 0, 1); PG8_STAGE(PG8_SB(0, 0), b2, voffB); PG8_STAGE(PG8_SB(0, 1), b2 + hstep, voffB); PG8_STAGE(PG8_SA(0, 0), a2, voffA);
            PG8_WAIT_V(8); PG8_WAIT_L(0); PG8_BAR; PG8_MMA(1, 0, At, B0); PG8_MMA(1, 1, At, B1); PG8_BAR; PG8_SCHED;
            PG8_LDB(B0, 1, 0); PG8_LDB(B1, 1, 1); PG8_SCHED; PG8_LDA(At, 1, 0); PG8_STAGE(PG8_SA(0, 1), a2 + hstep, voffA);
            PG8_WAIT_V(8); PG8_WAIT_L(0); PG8_BAR; PG8_MMA(0, 0, At, B0); PG8_MMA(0, 1, At, B1); PG8_BAR; PG8_SCHED;
            PG8_LDA(At, 1, 1); PG8_STAGE(PG8_SB(1, 0), b3, voffB); PG8_STAGE(PG8_SB(1, 1), b3 + hstep, voffB); PG8_STAGE(PG8_SA(1, 0), a3, voffA);
            PG8_WAIT_V(8); PG8_WAIT_L(0); PG8_BAR; PG8_MMA(1, 0, At, B0); PG8_MMA(1, 1, At, B1); PG8_BAR; PG8_SCHED;
            } else {
            PG8_LDB(B0, 0, 0); PG8_SCHED; PG8_LDA(At, 0, 0); PG8_STAGE(PG8_SA(1, 1), a1 + hstep, voffA);
            PG8_WAIT_L(8); PG8_BAR; PG8_WAIT_L(0); PG8_MMA(0, 0, At, B0); PG8_BAR; PG8_SCHED;
            PG8_LDB(B1, 0, 1); PG8_STAGE(PG8_SB(0, 0), b2, voffB);
            PG8_BAR; PG8_WAIT_L(0); PG8_MMA(0, 1, At, B1); PG8_BAR;
            PG8_LDA(At, 0, 1); PG8_STAGE(PG8_SA(0, 0), a2, voffA);
            PG8_BAR; PG8_WAIT_L(0); PG8_MMA(1, 0, At, B0); PG8_BAR; PG8_SCHED;
            PG8_STAGE(PG8_SB(0, 1), b2 + hstep, voffB);
            PG8_WAIT_V(6); PG8_BAR; PG8_MMA(1, 1, At, B1); PG8_BAR;
            PG8_LDB(B0, 1, 0); PG8_SCHED; PG8_LDA(At, 1, 0); PG8_STAGE(PG8_SA(0, 1), a2 + hstep, voffA);
            PG8_WAIT_L(8); PG8_BAR; PG8_WAIT_L(0); PG8_MMA(0, 0, At, B0); PG8_BAR; PG8_SCHED;
            PG8_LDB(B1, 1, 1); PG8_STAGE(PG8_SB(1, 0), b3, voffB);
            PG8_BAR; PG8_WAIT_L(0); PG8_MMA(0, 1, At, B1); PG8_BAR;
            PG8_LDA(At, 1, 1); PG8_STAGE(PG8_SA(1, 0), a3, voffA);
            PG8_BAR; PG8_WAIT_L(0); PG8_MMA(1, 0, At, B0); PG8_BAR; PG8_SCHED;
            PG8_STAGE(PG8_SB(1, 1), b3 + hstep, voffB);
            PG8_WAIT_V(6); PG8_BAR; PG8_MMA(1, 1, At, B1); PG8_BAR;
            }
        }
        if constexpr (ALIGN_EPI) { if (wr == 0) PG8_BAR; }
        if constexpr (!Epi::AFTER_DRAIN) { E(acc, cur, wr, wc, fr, fq); S.done(cur); }
        if (!has_next) break;
#pragma unroll
        for (int a = 0; a < 2; ++a)
#pragma unroll
            for (int b = 0; b < 2; ++b)
#pragma unroll
                for (int m = 0; m < 4; ++m)
#pragma unroll
                    for (int n = 0; n < 2; ++n) acc[a][b][m][n] = (f32x4){0.f, 0.f, 0.f, 0.f};
        cur = nxt; cA = nA; cB = nB; ++ui;
        if constexpr (ALIGN_EPI) { if (wr == 1) PG8_BAR; }
    }
    PG8_WAIT_V(0);
    if constexpr (!ALIGN_EPI) { if (wr == 0) PG8_BAR; }
    PG8_BAR;
    if constexpr (Epi::AFTER_DRAIN) { E.fused(acc, cur, wr, wc, fr, fq, lds, wid, lane); S.done(cur); }
#undef PG8_SA
#undef PG8_SB
#undef PG8_STAGE
#undef PG8_LDA
#undef PG8_LDB
#undef PG8_MMA
#undef PG8_WAIT_V
#undef PG8_WAIT_L
#undef PG8_BAR
#undef PG8_SCHED
}
}
#define MK_ONE_LAUNCH 1

constexpr int NB = 4, SEQ = 8192, T = NB * SEQ, D = 1024;
constexpr int NIN = 3584, DH = 512, HD = 128, NHH = 4, CHK = 64;
constexpr int NSEG = 16, SEGC = 8;
constexpr int CW = 31, CPAD = 15, DC = 512;
constexpr int PHEADS = 8, NQK = 2048, NSEL = 128;
constexpr float EPS = 1e-6f;
constexpr int NWAVES = 8, NTHR = 512;

constexpr size_t MiB = 1u << 20;
constexpr size_t WS_CTL = 0, CTL_ZERO_BYTES = 65536;
constexpr size_t WS_MOD = 1 * MiB, WS_FMOD = WS_MOD + 131072, WS_LB = WS_MOD + 196608, WS_BIASQ = WS_MOD + 262144;
constexpr size_t WS_WIN = 2 * MiB, WS_WOUT = 10 * MiB, WS_WQK = 12 * MiB;
constexpr size_t WS_UT = 16 * MiB, WS_VT = 48 * MiB;
constexpr size_t WS_BUFA = 80 * MiB;
constexpr size_t WS_BUFB = 144 * MiB;
constexpr size_t WS_SEG = 208 * MiB;
constexpr size_t WS_E = 208 * MiB, WS_W = 224 * MiB;
constexpr size_t WS_BIG = 240 * MiB;
constexpr size_t WS_SSQ = 496 * MiB;
constexpr size_t WS_SEGA = 498 * MiB;
constexpr size_t WS_RSTD = 499 * MiB;
constexpr size_t WS_END = 500 * MiB;
constexpr size_t WS_PACT = 240 * MiB;
constexpr size_t WS_Y = 368 * MiB;
constexpr int NSL = 8, CSL = 128;
constexpr float VSCALE = 16.0f;
constexpr float UQSCALE = 95.5f;
constexpr int NSLU = 4, CSLU = 256;
constexpr int CW_QU = 8192, CW_QV = 8192 + 64 * 16;
constexpr int CW_BAR = 1024;

#ifndef LDSFILL
#define LDSFILL 0u
#endif
constexpr int LDS_BYTES = 155648;
constexpr int MISC_OFF = LDS_BYTES - 256;

#define GAS __attribute__((address_space(1)))
#define LAS __attribute__((address_space(3)))
typedef unsigned short bf16;
typedef unsigned v4u __attribute__((ext_vector_type(4)));
typedef unsigned v2u __attribute__((ext_vector_type(2)));
typedef float f32x4 __attribute__((ext_vector_type(4)));
typedef float f32x16 __attribute__((ext_vector_type(16)));
typedef short bf16x8 __attribute__((ext_vector_type(8)));
typedef float f32x2_ __attribute__((ext_vector_type(2)));

__device__ __forceinline__ float bf2f(unsigned h) { return __builtin_bit_cast(float, h << 16); }
__device__ __forceinline__ float bflo(unsigned u) { return __builtin_bit_cast(float, u << 16); }
__device__ __forceinline__ float bfhi(unsigned u) { return __builtin_bit_cast(float, u & 0xffff0000u); }
__device__ __forceinline__ unsigned f2bf(float f) { unsigned u = __builtin_bit_cast(unsigned, f); return (u + 0x7fffu + ((u >> 16) & 1u)) >> 16; }
__device__ __forceinline__ unsigned pk2(float lo, float hi) { return f2bf(lo) | (f2bf(hi) << 16); }
__device__ __forceinline__ unsigned cvtpk(float lo, float hi) { unsigned r; asm("v_cvt_pk_bf16_f32 %0, %1, %2" : "=v"(r) : "v"(lo), "v"(hi)); return r; }
__device__ __forceinline__ float sigmoidf_(float x) { return __builtin_amdgcn_rcpf(1.0f + __expf(-x)); }
#define DPP_ADD(s, ctrl) ((s) + __builtin_bit_cast(float, __builtin_amdgcn_update_dpp(0, __builtin_bit_cast(int, (s)), (ctrl), 0xF, 0xF, false)))
__device__ __forceinline__ float wave_sum(float v) {
#pragma unroll
    for (int o = 1; o < 64; o <<= 1) v += __shfl_xor(v, o);
    return v;
}

#define XB_TMO      128
#define XB_XCNT(j)  (256  + 64 * (j))
#define XB_XSUB(j)  (1280 + 64 * (j))
#define XB_XGEN(j)  (2304 + 64 * (j))
#define XB_TOP      3328
#define XB_TOPGEN   3392
#define XCD_BAR_WORDS 3456
#define XB_SPIN_CAP (1u << 18)
__device__ __forceinline__ unsigned xb_ld(unsigned* p)              { return __hip_atomic_load(p, __ATOMIC_RELAXED, __HIP_MEMORY_SCOPE_AGENT); }
__device__ __forceinline__ unsigned xb_add(unsigned* p, unsigned v) { return __hip_atomic_fetch_add(p, v, __ATOMIC_RELAXED, __HIP_MEMORY_SCOPE_AGENT); }
__device__ __forceinline__ unsigned xb_xcc_id() { return (unsigned)__builtin_amdgcn_s_getreg((3 << 11) | 20) & 0xFu; }
#define XB_SPIN(cond, bar) do { unsigned _sp = 0; while (cond) { __builtin_amdgcn_s_sleep(1); \
    if ((++_sp & 255u) == 0u) { if (xb_ld(&(bar)[XB_TMO])) break; if (_sp > XB_SPIN_CAP) { atomicAdd(&(bar)[XB_TMO], 1u); break; } } } } while (0)
struct XcdBarrier { unsigned* bar; unsigned x; volatile LAS unsigned* st; };
__device__ __forceinline__ XcdBarrier xcd_barrier_post(unsigned* bar, volatile LAS unsigned* st) {
    XcdBarrier b; b.bar = bar; b.x = xb_xcc_id(); b.st = st;
    if (threadIdx.x == 0) (void)xb_add(&bar[XB_XCNT(b.x)], 1u);
    return b;
}
__device__ __forceinline__ void xcd_barrier_complete(unsigned* bar, unsigned x, unsigned& nloc, unsigned& nx) {
    const unsigned G = gridDim.x * gridDim.y * gridDim.z;
    unsigned sum, cnt, mine, sp = 0u;
    for (;;) {
        sum = 0u; cnt = 0u; mine = 0u;
#pragma unroll
        for (unsigned j = 0; j < 16; ++j) { const unsigned c = xb_ld(&bar[XB_XCNT(j)]); sum += c; cnt += (c > 0u) ? 1u : 0u; mine = (j == x) ? c : mine; }
        if (sum == G) break;
        __builtin_amdgcn_s_sleep(1);
        if ((++sp & 255u) == 0u) { if (xb_ld(&bar[XB_TMO])) break; if (sp > XB_SPIN_CAP) { atomicAdd(&bar[XB_TMO], 1u); break; } }
    }
    nloc = mine > 0u ? mine : 1u; nx = cnt > 0u ? cnt : 1u;
}
__device__ __forceinline__ void xcd_barrier(const XcdBarrier& b) {
    asm volatile("s_waitcnt vmcnt(0)" ::: "memory");
    __syncthreads();
    if (threadIdx.x == 0) {
        unsigned* bar = b.bar;
        __builtin_amdgcn_s_waitcnt(0);
        unsigned nloc = b.st[0], nx = b.st[1];
        if (nloc == 0u) { xcd_barrier_complete(bar, b.x, nloc, nx); b.st[0] = nloc; b.st[1] = nx; }
        const unsigned old = xb_add(&bar[XB_XSUB(b.x)], 1u);
        const unsigned gen = old / nloc;
        if (old + 1u == (gen + 1u) * nloc) {
            __builtin_amdgcn_fence(__ATOMIC_RELEASE, "agent");
            asm volatile("s_waitcnt vmcnt(0)" ::: "memory");
            const unsigned og = xb_add(&bar[XB_TOP], 1u);
            const unsigned tg = og / nx;
            if (og + 1u == (tg + 1u) * nx) xb_add(&bar[XB_TOPGEN], 1u);
            else XB_SPIN(xb_ld(&bar[XB_TOPGEN]) == tg, bar);
            __builtin_amdgcn_fence(__ATOMIC_ACQUIRE, "agent");
            xb_add(&bar[XB_XGEN(b.x)], 1u);
            asm volatile("s_waitcnt vmcnt(0)" ::: "memory");
        } else {
            XB_SPIN(xb_ld(&bar[XB_XGEN(b.x)]) == gen, bar);
            __builtin_amdgcn_fence(__ATOMIC_ACQUIRE, "agent");
            asm volatile("s_waitcnt vmcnt(0)" ::: "memory");
        }
    }
    __syncthreads();
}

struct Args { const float* in[23]; float* out; unsigned char* ws; int ph_lo, ph_hi; };
struct Frame {
    LAS unsigned char* lds;
    int tid, lane, wave, G, bid;
    const Args* a;
    __device__ __forceinline__ const float* x() const { return a->in[0]; }
    __device__ __forceinline__ const float* c() const { return a->in[1]; }
    __device__ __forceinline__ const float* ada_w() const { return a->in[2]; }
    __device__ __forceinline__ const float* ada_b() const { return a->in[3]; }
    __device__ __forceinline__ const float* g_mix() const { return a->in[4]; }
    __device__ __forceinline__ const float* w_in() const { return a->in[5]; }
    __device__ __forceinline__ const float* lbg_f() const { return a->in[6]; }
    __device__ __forceinline__ const float* lbg_b() const { return a->in[7]; }
    __device__ __forceinline__ const float* hnorm_g() const { return a->in[8]; }
    __device__ __forceinline__ const float* conv_w() const { return a->in[9]; }
    __device__ __forceinline__ const float* conv_b() const { return a->in[10]; }
    __device__ __forceinline__ const float* cln_g() const { return a->in[11]; }
    __device__ __forceinline__ const float* cln_b() const { return a->in[12]; }
    __device__ __forceinline__ const float* w_out() const { return a->in[13]; }
    __device__ __forceinline__ const float* g_ffn() const { return a->in[14]; }
    __device__ __forceinline__ const float* wq() const { return a->in[15]; }
    __device__ __forceinline__ const float* keys1() const { return a->in[16]; }
    __device__ __forceinline__ const float* keys2() const { return a->in[17]; }
    __device__ __forceinline__ const float* utab() const { return a->in[18]; }
    __device__ __forceinline__ const float* vtab() const { return a->in[19]; }
    __device__ __forceinline__ const float* fada_w() const { return a->in[20]; }
    __device__ __forceinline__ const float* fada_b() const { return a->in[21]; }
    __device__ __forceinline__ const float* fnorm_g() const { return a->in[22]; }
    __device__ __forceinline__ float* out() const { return a->out; }
    __device__ __forceinline__ float* mod() const { return (float*)(a->ws + WS_MOD); }
    __device__ __forceinline__ float* fmod() const { return (float*)(a->ws + WS_FMOD); }
    __device__ __forceinline__ float* lb() const { return (float*)(a->ws + WS_LB); }
    __device__ __forceinline__ float* biasq() const { return (float*)(a->ws + WS_BIASQ); }
    __device__ __forceinline__ float* ssqp() const { return (float*)(a->ws + WS_SSQ); }
    __device__ __forceinline__ float* sega() const { return (float*)(a->ws + WS_SEGA); }
    __device__ __forceinline__ float* segu() const { return (float*)(a->ws + WS_SEG); }
    __device__ __forceinline__ float* of() const { return (float*)(a->ws + WS_BUFB); }
    __device__ __forceinline__ float* scores() const { return (float*)(a->ws + WS_BIG); }
    __device__ __forceinline__ float* wsel() const { return (float*)(a->ws + WS_W); }
    __device__ __forceinline__ int* esel() const { return (int*)(a->ws + WS_E); }
    __device__ __forceinline__ bf16* Win_t() const { return (bf16*)(a->ws + WS_WIN); }
    __device__ __forceinline__ bf16* Wout_t() const { return (bf16*)(a->ws + WS_WOUT); }
    __device__ __forceinline__ bf16* Wqk_t() const { return (bf16*)(a->ws + WS_WQK); }
    __device__ __forceinline__ bf16* Ub() const { return (bf16*)(a->ws + WS_UT); }
    __device__ __forceinline__ bf16* Vb() const { return (bf16*)(a->ws + WS_VT); }
    __device__ __forceinline__ bf16* bufA() const { return (bf16*)(a->ws + WS_BUFA); }
    __device__ __forceinline__ bf16* hg() const { return (bf16*)(a->ws + WS_BUFB); }
    __device__ __forceinline__ bf16* proj() const { return (bf16*)(a->ws + WS_BIG); }
    __device__ __forceinline__ float* coef() const { return (float*)(a->ws + WS_BUFA); }
    __device__ __forceinline__ float* rstd() const { return (float*)(a->ws + WS_RSTD); }
    __device__ __forceinline__ bf16* pact() const { return (bf16*)(a->ws + WS_PACT); }
    __device__ __forceinline__ bf16* ybuf() const { return (bf16*)(a->ws + WS_Y); }
    __device__ __forceinline__ unsigned char* U8() const { return (unsigned char*)(a->ws + WS_UT); }
    __device__ __forceinline__ unsigned char* V8() const { return (unsigned char*)(a->ws + WS_VT); }
    __device__ __forceinline__ unsigned* ctl() const { return (unsigned*)(a->ws + WS_CTL); }
};

__device__ __forceinline__ void p0_gemv(Frame& F) {
    LAS float* cact = (LAS float*)(F.lds);
    LAS float* red = (LAS float*)(F.lds + 16384);
    for (int i = F.tid; i < 4096; i += NTHR) { const float c = F.c()[i]; cact[i] = c * sigmoidf_(c); }
    __syncthreads();
    for (int item = F.bid; item < 128; item += F.G) {
        const int col0 = item * 64; const float* W; int N, cc;
        if (col0 < 6144) { W = F.ada_w(); N = 6144; cc = col0; } else { W = F.fada_w(); N = 2048; cc = col0 - 6144; }
        const float* wp = W + (size_t)(F.wave * 128) * N + cc + F.lane;
        float a0 = 0.f, a1 = 0.f, a2 = 0.f, a3 = 0.f;
#pragma unroll 32
        for (int k = 0; k < 128; ++k) { const float w = wp[(size_t)k * N]; const int kk = F.wave * 128 + k;
            a0 += cact[kk] * w; a1 += cact[1024 + kk] * w; a2 += cact[2048 + kk] * w; a3 += cact[3072 + kk] * w; }
        red[(F.wave * 4 + 0) * 64 + F.lane] = a0; red[(F.wave * 4 + 1) * 64 + F.lane] = a1; red[(F.wave * 4 + 2) * 64 + F.lane] = a2; red[(F.wave * 4 + 3) * 64 + F.lane] = a3;
        __syncthreads();
        if (F.tid < 256) { const int b = F.tid >> 6, l = F.tid & 63; float s = 0.f;
#pragma unroll
            for (int w = 0; w < 8; ++w) s += red[(w * 4 + b) * 64 + l];
            if (col0 < 6144) F.mod()[b * 6144 + cc + l] = s + F.ada_b()[cc + l]; else F.fmod()[b * 2048 + cc + l] = s + F.fada_b()[cc + l]; }
        __syncthreads();
    }
}
__device__ __forceinline__ void p0_transpose_item(const float* W, int K, int N, bf16* WT, LAS float* scr, int item, int lane) {
    const int nblk = N / 32, kb = item / nblk, nb = item % nblk, k0 = 64 * kb, n0 = 32 * nb;
#pragma unroll
    for (int i = 0; i < 32; ++i) { const int kk = 2 * i + (lane >> 5); scr[kk * 33 + (lane & 31)] = W[(size_t)(k0 + kk) * N + n0 + (lane & 31)]; }
    asm volatile("s_waitcnt lgkmcnt(0)" ::: "memory");
    const int c = lane & 7;
#pragma unroll
    for (int j = 0; j < 4; ++j) { const int n = (lane >> 3) + 8 * j; const LAS float* s = scr + (8 * c) * 33 + n;
        v4u o; o.x = pk2(s[0 * 33], s[1 * 33]); o.y = pk2(s[2 * 33], s[3 * 33]); o.z = pk2(s[4 * 33], s[5 * 33]); o.w = pk2(s[6 * 33], s[7 * 33]);
        *(v4u*)(WT + (size_t)(n0 + n) * K + k0 + 8 * c) = o; }
    asm volatile("s_waitcnt lgkmcnt(0)" ::: "memory");
}
__device__ __forceinline__ void p0_wqk_item(Frame& F, int item, LAS float* scr) {
    const int jq = item & 7, kb = (item >> 3) & 15, hh = item >> 7, h = hh >> 1, half = hh & 1;
    const float* keys = (half ? F.keys2() : F.keys1()) + (size_t)(jq * 16) * 128;
    const float* wtile = F.wq() + (size_t)(kb * 64) * 2048 + h * 256 + half * 128;
    LAS float* kL = scr + 1280;
    { f32x4 k4[8];
#pragma unroll
      for (int i = 0; i < 8; ++i) k4[i] = *(const f32x4*)(keys + (i * 64 + F.lane) * 4);
#pragma unroll
      for (int i = 0; i < 8; ++i) *(LAS f32x4*)(kL + (i * 64 + F.lane) * 4) = k4[i]; }
    float acc[16];
#pragma unroll
    for (int j = 0; j < 16; ++j) acc[j] = 0.f;
    f32x4 t4[4], n4[4];
#pragma unroll
    for (int i = 0; i < 4; ++i) t4[i] = *(const f32x4*)(wtile + (size_t)(16 * i + (F.lane >> 2)) * 2048 + 4 * (F.lane & 3));
    for (int d0 = 0; d0 < 128; d0 += 16) {
        if (d0 + 16 < 128) {
#pragma unroll
            for (int i = 0; i < 4; ++i) n4[i] = *(const f32x4*)(wtile + (size_t)(16 * i + (F.lane >> 2)) * 2048 + d0 + 16 + 4 * (F.lane & 3)); }
#pragma unroll
        for (int i = 0; i < 4; ++i) *(LAS f32x4*)(scr + (16 * i + (F.lane >> 2)) * 20 + 4 * (F.lane & 3)) = t4[i];
        asm volatile("s_waitcnt lgkmcnt(0)" ::: "memory");
#pragma unroll
        for (int dd = 0; dd < 16; dd += 4) { const f32x4 a = *(LAS const f32x4*)(scr + F.lane * 20 + dd);
#pragma unroll
            for (int j = 0; j < 16; ++j) { const f32x4 kp = *(LAS const f32x4*)(kL + j * 128 + d0 + dd); acc[j] += a[0] * kp[0] + a[1] * kp[1] + a[2] * kp[2] + a[3] * kp[3]; } }
        asm volatile("s_waitcnt lgkmcnt(0)" ::: "memory");
#pragma unroll
        for (int i = 0; i < 4; ++i) t4[i] = n4[i];
    }
    bf16* o = F.Wqk_t() + (size_t)(h * 256 + half * 128 + jq * 16) * 1024 + kb * 64 + F.lane;
#pragma unroll
    for (int j = 0; j < 16; ++j) o[(size_t)j * 1024] = (bf16)f2bf(acc[j]);
}
__device__ __forceinline__ void p0_prologue(Frame& F) {
    if (F.bid < 128) p0_gemv(F);
    if (F.bid == 128 % F.G) { const int i = F.tid;
        F.lb()[i] = __builtin_amdgcn_rcpf(1.0f + __expf(F.lbg_f()[512 + i] - F.lbg_f()[i]));
        F.lb()[512 + i] = __builtin_amdgcn_rcpf(1.0f + __expf(F.lbg_b()[512 + i] - F.lbg_b()[i])); }
    LAS float* scr = (LAS float*)(F.lds + 32768 + F.wave * 14336);
    const int gw = F.wave * F.G + F.bid, NGW = F.G * NWAVES;
    constexpr int I_QK = 2048, I_IN = (D / 64) * (NIN / 32), I_OUT = (D / 64) * (D / 32), I_TAB = 2 * 16384 / 4;
    constexpr int NITEMS = I_QK + I_IN + I_OUT + I_TAB;
    for (int it = gw; it < NITEMS; it += NGW) {
        int r = it;
        if (r < I_QK) { p0_wqk_item(F, r, scr); continue; } r -= I_QK;
        if (r < I_IN) { p0_transpose_item(F.w_in(), D, NIN, F.Win_t(), scr, r, F.lane); continue; } r -= I_IN;
        if (r < I_OUT) { p0_transpose_item(F.w_out(), D, D, F.Wout_t(), scr, r, F.lane); continue; } r -= I_OUT;
        { const int tab = r >= 4096, rr = (tab ? r - 4096 : r) * 4; const float* src = (tab ? F.vtab() : F.utab()) + (size_t)rr * 1024; unsigned char* dst = tab ? F.V8() : F.U8();
          const float sc = tab ? VSCALE : UQSCALE;
#pragma unroll
          for (int q = 0; q < 16; ++q) { const int row = rr + (q >> 2), qq = q & 3; const f32x4 v = *(const f32x4*)(src + (q >> 2) * 1024 + qq * 256 + 4 * F.lane) * sc;
              int pk;
              if (tab) { pk = __builtin_amdgcn_cvt_pk_fp8_f32(v[0], v[1], 0, false); pk = __builtin_amdgcn_cvt_pk_fp8_f32(v[2], v[3], pk, true); }
              else { int q0 = (int)__builtin_rintf(v[0]), q1 = (int)__builtin_rintf(v[1]), q2 = (int)__builtin_rintf(v[2]), q3 = (int)__builtin_rintf(v[3]);
                  q0 = q0 < -7 ? -7 : (q0 > 7 ? 7 : q0); q1 = q1 < -7 ? -7 : (q1 > 7 ? 7 : q1); q2 = q2 < -7 ? -7 : (q2 > 7 ? 7 : q2); q3 = q3 < -7 ? -7 : (q3 > 7 ? 7 : q3);
                  *(unsigned short*)(dst + ((size_t)qq * 16384 + row) * 128 + 2 * F.lane) = (unsigned short)((q0 & 0xf) | ((q1 & 0xf) << 4) | ((q2 & 0xf) << 8) | ((q3 & 0xf) << 12)); continue; }
              const int sl = 2 * qq + (F.lane >> 5);
              *(int*)(dst + ((size_t)sl * 16384 + row) * CSL + 4 * (F.lane & 31)) = pk; } }
    }
}

__device__ __forceinline__ void p1_norm(Frame& F) {
    const int gwc = F.bid * NWAVES + F.wave, NGW = F.G * NWAVES;
    for (int row0 = gwc * 16; row0 < T; row0 += NGW * 16) {
        const int b = row0 >> 13; const float* mb = F.mod() + b * 6144;
        f32x4 ca[4], cb[4];
#pragma unroll
        for (int j = 0; j < 4; ++j) { const int k = 256 * j + 4 * F.lane; const f32x4 g = *(const f32x4*)(F.g_mix() + k), s = *(const f32x4*)(mb + 1024 + k); ca[j] = g * (s + 1.0f); cb[j] = *(const f32x4*)(mb + k); }
#pragma unroll 4
        for (int r = 0; r < 16; ++r) { const float* xr = F.x() + (size_t)(row0 + r) * D;
            f32x4 v[4]; float ss = 0.f;
#pragma unroll
            for (int j = 0; j < 4; ++j) { v[j] = *(const f32x4*)(xr + 256 * j + 4 * F.lane); ss += v[j][0] * v[j][0] + v[j][1] * v[j][1] + v[j][2] * v[j][2] + v[j][3] * v[j][3]; }
            const float rstd = __builtin_amdgcn_rsqf(wave_sum(ss) * (1.0f / D) + EPS);
            bf16* o = F.bufA() + (size_t)(row0 + r) * D;
#pragma unroll
            for (int j = 0; j < 4; ++j) { const f32x4 y = v[j] * rstd * ca[j] + cb[j]; v2u w; w.x = pk2(y[0], y[1]); w.y = pk2(y[2], y[3]); *(v2u*)(o + 256 * j + 4 * F.lane) = w; } }
    }
    const int gw = F.wave * F.G + F.bid;
    for (int n0 = gw * 32; n0 < NQK; n0 += NGW * 32) {
        float sv[4][16];
#pragma unroll
        for (int b = 0; b < 4; ++b) { const float* sh2 = F.mod() + b * 6144 + 3072;
#pragma unroll
            for (int i = 0; i < 8; ++i) { sv[b][i] = sh2[8 * F.lane + i]; sv[b][8 + i] = sh2[512 + 8 * F.lane + i]; } }
        float res[4] = {0.f, 0.f, 0.f, 0.f};
        for (int q = 0; q < 32; ++q) { const int n = n0 + q;
            const v4u w0 = *(const v4u*)(F.Wqk_t() + (size_t)n * 1024 + 8 * F.lane), w1 = *(const v4u*)(F.Wqk_t() + (size_t)n * 1024 + 512 + 8 * F.lane);
            float wv[16];
#pragma unroll
            for (int i = 0; i < 4; ++i) { wv[2 * i] = bflo(w0[i]); wv[2 * i + 1] = bfhi(w0[i]); wv[8 + 2 * i] = bflo(w1[i]); wv[8 + 2 * i + 1] = bfhi(w1[i]); }
#pragma unroll
            for (int b = 0; b < 4; ++b) { float sm = 0.f;
#pragma unroll
                for (int i = 0; i < 16; ++i) sm += wv[i] * sv[b][i];
                sm = wave_sum(sm); if (F.lane == q) res[b] = sm; } }
        if (F.lane < 32) {
#pragma unroll
            for (int b = 0; b < 4; ++b) F.biasq()[b * 2048 + n0 + F.lane] = res[b]; }
    }
}

__device__ __forceinline__ void conv_item(Frame& F, int item, const float (&cw)[CW], float cbias) {
    LAS bf16* hbuf = (LAS bf16*)(F.lds);
    LAS float* ybuf = (LAS float*)(F.lds + 65536);
    const int tok0 = item * 32, b = tok0 >> 13, t0 = tok0 & (SEQ - 1), c = F.tid;
#pragma unroll
    for (int k = 0; k < 8; ++k) { const int pi = F.tid + NTHR * k; if (pi < 62 * 64) { const int r = pi >> 6, ch = pi & 63, t = t0 - CPAD + r; v4u o = {0u, 0u, 0u, 0u};
            if (t >= 0 && t < SEQ) { const bf16* pr = F.proj() + (size_t)(b * SEQ + t) * NIN + 8 * ch; const v4u a = *(const v4u*)(pr + 2560), g = *(const v4u*)(pr + 3072);
#pragma unroll
                for (int i = 0; i < 4; ++i) o[i] = cvtpk(bflo(a[i]) * bflo(g[i]), bfhi(a[i]) * bfhi(g[i])); }
            *(LAS v4u*)(hbuf + r * 512 + 8 * ch) = o; } }
    __syncthreads();
    float hv[62];
#pragma unroll
    for (int r = 0; r < 62; ++r) hv[r] = bf2f(hbuf[r * 512 + c]);
#pragma unroll
    for (int tt = 0; tt < 32; ++tt) { float acc = cbias;
#pragma unroll
        for (int j = 0; j < CW; ++j) acc += cw[j] * hv[tt + j];
        ybuf[tt * 512 + c] = acc; }
    __syncthreads();
#pragma unroll
    for (int q = 0; q < 4; ++q) { const int tt = F.wave * 4 + q;
        const f32x4 y0 = *(LAS const f32x4*)(ybuf + tt * 512 + 8 * F.lane), y1 = *(LAS const f32x4*)(ybuf + tt * 512 + 8 * F.lane + 4);
        const float mean = wave_sum((y0[0] + y0[1] + y0[2] + y0[3]) + (y1[0] + y1[1] + y1[2] + y1[3])) * (1.0f / DC);
        const f32x4 d0 = y0 - mean, d1 = y1 - mean;
        const float var = wave_sum((d0[0] * d0[0] + d0[1] * d0[1] + d0[2] * d0[2] + d0[3] * d0[3]) + (d1[0] * d1[0] + d1[1] * d1[1] + d1[2] * d1[2] + d1[3] * d1[3])) * (1.0f / DC);
        const float rstd = __builtin_amdgcn_rsqf(var + EPS);
        const f32x4 g0 = *(const f32x4*)(F.cln_g() + 8 * F.lane), g1 = *(const f32x4*)(F.cln_g() + 8 * F.lane + 4), b0 = *(const f32x4*)(F.cln_b() + 8 * F.lane), b1 = *(const f32x4*)(F.cln_b() + 8 * F.lane + 4);
        f32x4 z0 = d0 * rstd * g0 + b0, z1 = d1 * rstd * g1 + b1;
#pragma unroll
        for (int i = 0; i < 4; ++i) { z0[i] = z0[i] * sigmoidf_(z0[i]); z1[i] = z1[i] * sigmoidf_(z1[i]); }
        v4u w; w.x = cvtpk(z0[0], z0[1]); w.y = cvtpk(z0[2], z0[3]); w.z = cvtpk(z1[0], z1[1]); w.w = cvtpk(z1[2], z1[3]);
        *(v4u*)(F.bufA() + (size_t)(tok0 + tt) * D + 512 + 8 * F.lane) = w; }
    __syncthreads();
}

constexpr int PQ = 272, PT = 144;
constexpr int HL_QR = 0, HL_KR = 17408, HL_QE = 34816, HL_KET = 52224, HL_VT = 70656, HL_SCM = 89088, HL_ST = 98304, HL_PBLK = 133120  , HL_AV = 137216, HL_RS = 137728;
static_assert(HL_PBLK + 8 * 128 * 4 <= HL_AV && HL_AV + 512 <= HL_RS && HL_RS + 1024 <= 155648 - 256, "HGRN LDS map");
__device__ __forceinline__ bf16x8 ldf(LAS const unsigned char* base, int row, int pitch, int kbyte) { return *(LAS const bf16x8*)(base + row * pitch + kbyte); }
#define MFMA32(a, b, c) __builtin_amdgcn_mfma_f32_32x32x16_bf16((a), (b), (c), 0, 0, 0)

template <bool FULL>
__device__ __forceinline__ void hgrn_load(Frame& F, int b, int h, int dir, int chunk, unsigned (&rz)[8], unsigned (&rv)[8], unsigned (&rq)[8]) {
    const size_t tokbase = (size_t)b * SEQ + (size_t)chunk * CHK; const int zoff = dir ? 1024 : 512, c0 = 2 * F.lane;
#pragma unroll
    for (int i = 0; i < 8; ++i) { const int p = 8 * F.wave + i, tr = dir ? (63 - p) : p; const bf16* q = F.proj() + (tokbase + tr) * NIN + h * HD;
        rz[i] = *(const unsigned*)(q + zoff + c0); rv[i] = *(const unsigned*)(q + 1536 + c0); if (FULL) rq[i] = *(const unsigned*)(q + c0); }
}
template <bool FULL, int MODE>
__device__ __forceinline__ void hgrn_chunk(Frame& F, int b, int h, int dir, int chunk, int nchunk, f32x16 (&accS)[2], float lb0, float lb1, unsigned (&rz)[8], unsigned (&rv)[8], unsigned (&rq)[8]) {
    LAS unsigned char* lds = F.lds;
    int r = F.lane & 31, hh = F.lane >> 5, c0 = 2 * F.lane;
    asm volatile("" : "+v"(r), "+v"(hh), "+v"(c0));
    const int w = F.wave, rb = w;
    const size_t tokbase = (size_t)b * SEQ + (size_t)chunk * CHK;
    {
        const f32x2_ oml = {1.0f - lb0, 1.0f - lb1};
        f32x2_ f2[8], cf2[8], cr2[8];
        f32x2_ run = {1.f, 1.f};
#pragma unroll
        for (int i = 0; i < 8; ++i) { const f32x2_ kk = {bflo(rz[i]), bfhi(rz[i])}; f2[i] = 1.0f - oml * kk; run *= f2[i]; cf2[i] = run; }
        { f32x2_ q = {1.f, 1.f};
#pragma unroll
          for (int i = 7; i >= 0; --i) { cr2[i] = q; q *= f2[i]; } }
        LAS float* pblk = (LAS float*)(lds + HL_PBLK);
        *(LAS f32x2_*)(pblk + rb * 128 + c0) = run;
        __syncthreads();
        f32x2_ pre = {1.f, 1.f}, post = {1.f, 1.f}, mid = {1.f, 1.f};
        for (int q = 0; q < rb; ++q) pre *= *(LAS const f32x2_*)(pblk + q * 128 + c0);
        for (int q = rb + 1; q < 8; ++q) post *= *(LAS const f32x2_*)(pblk + q * 128 + c0);
        if (rb < 4) { for (int q = rb + 1; q < 4; ++q) mid *= *(LAS const f32x2_*)(pblk + q * 128 + c0); }
        else { for (int q = 4; q < rb; ++q) mid *= *(LAS const f32x2_*)(pblk + q * 128 + c0); }
        if (rb == 0) *(LAS f32x2_*)((LAS float*)(lds + HL_AV) + c0) = run * post;
        f32x2_ ke2[8];
#pragma unroll
        for (int i = 0; i < 8; ++i) ke2[i] = (1.0f - f2[i]) * cr2[i] * post;
        if (FULL) {
            if (rb < 4) {
#pragma unroll
                for (int i = 0; i < 8; ++i) { const int p = 8 * rb + i; const f32x2_ qs = {bflo(rq[i]), bfhi(rq[i])}, k2 = 1.0f - f2[i], G = cr2[i] * mid;
                    f32x2_ iG; iG[0] = __builtin_amdgcn_rcpf(G[0]); iG[1] = __builtin_amdgcn_rcpf(G[1]);
                    const f32x2_ qe = qs * pre * cf2[i], qr = qs * iG, kr = k2 * G;
                    *(LAS unsigned*)(lds + HL_QE + p * PQ + c0 * 2) = cvtpk(qe[0], qe[1]);
                    *(LAS unsigned*)(lds + HL_QR + p * PQ + c0 * 2) = cvtpk(qr[0], qr[1]);
                    *(LAS unsigned*)(lds + HL_KR + p * PQ + c0 * 2) = cvtpk(kr[0], kr[1]); }
            } else {
#pragma unroll
                for (int i = 0; i < 8; ++i) { const int p = 8 * rb + i; const f32x2_ qs = {bflo(rq[i]), bfhi(rq[i])}, k2 = 1.0f - f2[i], G = cf2[i] * mid;
                    f32x2_ iG; iG[0] = __builtin_amdgcn_rcpf(G[0]); iG[1] = __builtin_amdgcn_rcpf(G[1]);
                    const f32x2_ qe = qs * pre * cf2[i], qr = qs * G, kr = k2 * iG;
                    *(LAS unsigned*)(lds + HL_QE + p * PQ + c0 * 2) = cvtpk(qe[0], qe[1]);
                    *(LAS unsigned*)(lds + HL_QR + p * PQ + c0 * 2) = cvtpk(qr[0], qr[1]);
                    *(LAS unsigned*)(lds + HL_KR + p * PQ + c0 * 2) = cvtpk(kr[0], kr[1]); }
            }
        }
        v4u ka, kb, va, vb2;
        ka.x = cvtpk(ke2[0][0], ke2[1][0]); ka.y = cvtpk(ke2[2][0], ke2[3][0]); ka.z = cvtpk(ke2[4][0], ke2[5][0]); ka.w = cvtpk(ke2[6][0], ke2[7][0]);
        kb.x = cvtpk(ke2[0][1], ke2[1][1]); kb.y = cvtpk(ke2[2][1], ke2[3][1]); kb.z = cvtpk(ke2[4][1], ke2[5][1]); kb.w = cvtpk(ke2[6][1], ke2[7][1]);
        va.x = (rv[0] & 0xffffu) | (rv[1] << 16); va.y = (rv[2] & 0xffffu) | (rv[3] << 16); va.z = (rv[4] & 0xffffu) | (rv[5] << 16); va.w = (rv[6] & 0xffffu) | (rv[7] << 16);
        vb2.x = (rv[0] >> 16) | (rv[1] & 0xffff0000u); vb2.y = (rv[2] >> 16) | (rv[3] & 0xffff0000u); vb2.z = (rv[4] >> 16) | (rv[5] & 0xffff0000u); vb2.w = (rv[6] >> 16) | (rv[7] & 0xffff0000u);
        *(LAS v4u*)(lds + HL_KET + c0 * PT + 16 * rb) = ka; *(LAS v4u*)(lds + HL_KET + (c0 + 1) * PT + 16 * rb) = kb;
        *(LAS v4u*)(lds + HL_VT + c0 * PT + 16 * rb) = va; *(LAS v4u*)(lds + HL_VT + (c0 + 1) * PT + 16 * rb) = vb2;
    }
    if (nchunk >= 0) hgrn_load<FULL>(F, b, h, dir, nchunk, rz, rv, rq);
    __syncthreads();
    const int pbO = w & 1, vb = w >> 1;
    f32x16 accO, accU[2];
#pragma unroll
    for (int i = 0; i < 16; ++i) { accO[i] = 0.f; accU[0][i] = 0.f; accU[1][i] = 0.f; }
    if (FULL) {
        if (w < 3) { const int pbS = (w + 1) >> 1, sbS = (w == 2) ? 1 : 0; f32x16 sc;
#pragma unroll
            for (int i = 0; i < 16; ++i) sc[i] = 0.f;
#pragma unroll
            for (int s = 0; s < 8; ++s) sc = MFMA32(ldf(lds + HL_QR, pbS * 32 + r, PQ, 32 * s + 16 * hh), ldf(lds + HL_KR, sbS * 32 + r, PQ, 32 * s + 16 * hh), sc);
#pragma unroll
            for (int i = 0; i < 16; i += 2) { const int p = pbS * 32 + (i & 3) + 8 * (i >> 2) + 4 * hh, s = sbS * 32 + r;
                const unsigned pkd = cvtpk(s <= p ? sc[i] : 0.f, s <= p + 1 ? sc[i + 1] : 0.f);
                *(LAS bf16*)(lds + HL_SCM + p * PT + s * 2) = (bf16)pkd; *(LAS bf16*)(lds + HL_SCM + (p + 1) * PT + s * 2) = (bf16)(pkd >> 16); } }
        __builtin_amdgcn_sched_barrier(0);
#pragma unroll
        for (int s = 0; s < 8; ++s) accO = MFMA32(ldf(lds + HL_QE, pbO * 32 + r, PQ, 32 * s + 16 * hh), ldf(lds + HL_ST, vb * 32 + r, PQ, 32 * s + 16 * hh), accO);
        __builtin_amdgcn_sched_barrier(0);
    }
#pragma unroll
    for (int i = 0; i < 2; ++i) { const int db = 2 * (w & 1) + i;
#pragma unroll
        for (int s = 0; s < 4; ++s) accU[i] = MFMA32(ldf(lds + HL_VT, vb * 32 + r, PT, 32 * s + 16 * hh), ldf(lds + HL_KET, db * 32 + r, PT, 32 * s + 16 * hh), accU[i]); }
    __builtin_amdgcn_sched_barrier(0);
    if (FULL) __syncthreads();
    if (FULL) {
        const unsigned v = vb * 32 + r;
        const unsigned lrow = (MODE == 0 ? (unsigned)hh : (unsigned)(1 - hh)) * 4u;
        const size_t rbase = (MODE == 0) ? (tokbase + pbO * 32) : (tokbase + 63 - pbO * 32 - 4);
        const unsigned lo_of = lrow * DH + v, lo_pr = lrow * NIN + v, lo_a2 = lrow * D + v;
        float ofv[16]; unsigned gv[16];
        if (MODE == 1) {
#pragma unroll
            for (int i = 0; i < 16; ++i) { const int ci = (i & 3) + 8 * (i >> 2); ofv[i] = (F.of() + (rbase - ci) * DH + h * HD)[lo_of]; } }
        for (int sb = 0; sb <= pbO; ++sb)
#pragma unroll
            for (int s2 = 0; s2 < 2; ++s2) accO = MFMA32(ldf(lds + HL_SCM, pbO * 32 + r, PT, 64 * sb + 32 * s2 + 16 * hh), ldf(lds + HL_VT, vb * 32 + r, PT, 64 * sb + 32 * s2 + 16 * hh), accO);
        if (MODE == 0) {
#pragma unroll
            for (int i = 0; i < 16; ++i) { const int ci = (i & 3) + 8 * (i >> 2); (F.of() + (rbase + ci) * DH + h * HD)[lo_of] = accO[i]; }
        } else {
            LAS float* rs = (LAS float*)(lds + HL_RS);
#pragma unroll
            for (int i = 0; i < 16; ++i) { const int ci = (i & 3) + 8 * (i >> 2); gv[i] = (F.proj() + (rbase - ci) * NIN + 2048 + h * HD)[lo_pr]; }
            float ov[16];
#pragma unroll
            for (int i = 0; i < 16; ++i) { const int ci = (i & 3) + 8 * (i >> 2), p = pbO * 32 + ci + 4 * hh;
                ov[i] = accO[i] + ofv[i]; float ss = ov[i] * ov[i];
                ss = DPP_ADD(ss, 0x128); ss = DPP_ADD(ss, 0x124); ss = DPP_ADD(ss, 0x122); ss = DPP_ADD(ss, 0x121); ss += __shfl_xor(ss, 16);
                if (r == 0) rs[p * 4 + vb] = ss; }
            __syncthreads();
            const float ng = F.hnorm_g()[h * HD + v];
#pragma unroll
            for (int i = 0; i < 16; ++i) { const int ci = (i & 3) + 8 * (i >> 2), p = pbO * 32 + ci + 4 * hh;
                const f32x4 q = *(LAS const f32x4*)(rs + p * 4);
                const float rstd = __builtin_amdgcn_rsqf((q[0] + q[1] + q[2] + q[3]) * (1.0f / HD) + EPS);
                const float g = bf2f(gv[i]);
                (F.bufA() + (rbase - ci) * D + h * HD)[lo_a2] = (bf16)cvtpk(ov[i] * rstd * ng * g, 0.f); }
        }
    }
    {
        const LAS float* av = (const LAS float*)(lds + HL_AV);
#pragma unroll
        for (int i = 0; i < 2; ++i) { const int db = 2 * (w & 1) + i; const float a = av[db * 32 + r];
#pragma unroll
            for (int j = 0; j < 16; j += 2) { const float s0 = accS[i][j] * a + accU[i][j], s1 = accS[i][j + 1] * a + accU[i][j + 1]; accS[i][j] = s0; accS[i][j + 1] = s1;
                if (FULL) { const int vv = vb * 32 + (j & 3) + 8 * (j >> 2) + 4 * hh; const unsigned pkd = cvtpk(s0, s1);
                    *(LAS bf16*)(lds + HL_ST + vv * PQ + (db * 32 + r) * 2) = (bf16)pkd; *(LAS bf16*)(lds + HL_ST + (vv + 1) * PQ + (db * 32 + r) * 2) = (bf16)(pkd >> 16); } } }
    }
    __syncthreads();
}
__device__ __forceinline__ void h1_item(Frame& F, int item) {
    const int seg = item & 15, dir = (item >> 4) & 1, h = (item >> 5) & 3, b = item >> 7;
    const float lb0 = F.lb()[dir * 512 + h * HD + 2 * F.lane], lb1 = F.lb()[dir * 512 + h * HD + 2 * F.lane + 1];
    f32x16 accS[2];
#pragma unroll
    for (int i = 0; i < 16; ++i) { accS[0][i] = 0.f; accS[1][i] = 0.f; }
    float atot = 1.f; const int col = F.tid & 127;
    unsigned rzA[8], rvA[8], rzB[8], rvB[8], rq[8];
#define H1CH(c) (seg * SEGC + (dir ? (SEGC - 1 - (c)) : (c)))
    hgrn_load<false>(F, b, h, dir, H1CH(0), rzA, rvA, rq); hgrn_load<false>(F, b, h, dir, H1CH(1), rzB, rvB, rq);
    for (int c = 0; c < SEGC; c += 2) {
        hgrn_chunk<false, 0>(F, b, h, dir, H1CH(c), (c + 2 < SEGC) ? H1CH(c + 2) : -1, accS, lb0, lb1, rzA, rvA, rq);
        atot *= ((const LAS float*)(F.lds + HL_AV))[col];
        hgrn_chunk<false, 0>(F, b, h, dir, H1CH(c + 1), (c + 3 < SEGC) ? H1CH(c + 3) : -1, accS, lb0, lb1, rzB, rvB, rq);
        atot *= ((const LAS float*)(F.lds + HL_AV))[col]; }
#undef H1CH
    if (F.tid < 128) F.sega()[(size_t)item * 128 + col] = atot;
    float* U = F.segu() + (size_t)item * 16384;
#pragma unroll
    for (int i = 0; i < 2; ++i)
#pragma unroll
        for (int j = 0; j < 16; j += 4) { f32x4 o; o[0] = accS[i][j]; o[1] = accS[i][j + 1]; o[2] = accS[i][j + 2]; o[3] = accS[i][j + 3]; ((f32x4*)(U + (i * 4 + (j >> 2)) * NTHR * 4))[F.tid] = o; }
}
__device__ __forceinline__ void h2_init_state(Frame& F, int b, int h, int dir, int seg, f32x16 (&accS)[2]) {
    const int w = F.wave, r = F.lane & 31, hh = F.lane >> 5, vb = w >> 1;
#pragma unroll
    for (int i = 0; i < 16; ++i) { accS[0][i] = 0.f; accS[1][i] = 0.f; }
    const int base = ((b * 4 + h) * 2 + dir) * 16;
    const int n = dir ? (NSEG - 1 - seg) : seg;
    for (int q0 = 0; q0 < n; q0 += 3) {
        f32x4 u4[3][8]; float av[3][2];
#pragma unroll
        for (int t = 0; t < 3; ++t) { const int q = (q0 + t < n) ? (q0 + t) : (n - 1); const int s = dir ? (NSEG - 1 - q) : q;
            const float* U = F.segu() + (size_t)(base + s) * 16384; const float* A = F.sega() + (size_t)(base + s) * 128;
#pragma unroll
            for (int i = 0; i < 2; ++i) av[t][i] = (A + (2 * (w & 1) + i) * 32)[r];
#pragma unroll
            for (int k = 0; k < 8; ++k) u4[t][k] = ((const f32x4*)(U + k * NTHR * 4))[F.tid]; }
#pragma unroll
        for (int t = 0; t < 3; ++t) { if (q0 + t < n) {
#pragma unroll
            for (int i = 0; i < 2; ++i) { const float a = av[t][i];
#pragma unroll
                for (int j = 0; j < 16; j += 4) { const f32x4 v = u4[t][i * 4 + (j >> 2)];
                    accS[i][j] = accS[i][j] * a + v[0]; accS[i][j + 1] = accS[i][j + 1] * a + v[1]; accS[i][j + 2] = accS[i][j + 2] * a + v[2]; accS[i][j + 3] = accS[i][j + 3] * a + v[3]; } } } }
    }
#pragma unroll
    for (int i = 0; i < 2; ++i) { const int db = 2 * (w & 1) + i;
#pragma unroll
        for (int j = 0; j < 16; ++j) { const int vv = vb * 32 + (j & 3) + 8 * (j >> 2) + 4 * hh; *(LAS bf16*)(F.lds + HL_ST + vv * PQ + (db * 32 + r) * 2) = (bf16)f2bf(accS[i][j]); } }
    __syncthreads();
}
__device__ __forceinline__ void h2_item(Frame& F, int item) {
    const int seg = item & 15, h = (item >> 4) & 3, b = item >> 6;
    f32x16 accS[2];
    unsigned rzA[8], rvA[8], rqA[8], rzB[8], rvB[8], rqB[8];
    { const float lb0 = F.lb()[h * HD + 2 * F.lane], lb1 = F.lb()[h * HD + 2 * F.lane + 1];
      const int c0 = seg * SEGC;
      hgrn_load<true>(F, b, h, 0, c0, rzA, rvA, rqA); hgrn_load<true>(F, b, h, 0, c0 + 1, rzB, rvB, rqB);
      h2_init_state(F, b, h, 0, seg, accS);
      for (int c = 0; c < SEGC; c += 2) {
          hgrn_chunk<true, 0>(F, b, h, 0, c0 + c, (c + 2 < SEGC) ? (c0 + c + 2) : -1, accS, lb0, lb1, rzA, rvA, rqA);
          hgrn_chunk<true, 0>(F, b, h, 0, c0 + c + 1, (c + 3 < SEGC) ? (c0 + c + 3) : -1, accS, lb0, lb1, rzB, rvB, rqB); } }
    asm volatile("s_waitcnt vmcnt(0)" ::: "memory");
    __syncthreads();
    { const float lb0 = F.lb()[512 + h * HD + 2 * F.lane], lb1 = F.lb()[512 + h * HD + 2 * F.lane + 1];
      const int cl = seg * SEGC + SEGC - 1;
      hgrn_load<true>(F, b, h, 1, cl, rzA, rvA, rqA); hgrn_load<true>(F, b, h, 1, cl - 1, rzB, rvB, rqB);
      h2_init_state(F, b, h, 1, seg, accS);
      for (int c = 0; c < SEGC; c += 2) {
          hgrn_chunk<true, 1>(F, b, h, 1, cl - c, (c + 2 < SEGC) ? (cl - c - 2) : -1, accS, lb0, lb1, rzA, rvA, rqA);
          hgrn_chunk<true, 1>(F, b, h, 1, cl - c - 1, (c + 3 < SEGC) ? (cl - c - 3) : -1, accS, lb0, lb1, rzB, rvB, rqB); } }
}

__device__ __forceinline__ unsigned f2key(float f) { const unsigned u = __builtin_bit_cast(unsigned, f); return (u & 0x80000000u) ? ~u : (u | 0x80000000u); }
__device__ __forceinline__ float key2f(unsigned k) { const unsigned u = (k & 0x80000000u) ? (k & 0x7fffffffu) : ~k; return __builtin_bit_cast(float, u); }
__device__ __forceinline__ unsigned umax_(unsigned a, unsigned b) { return a > b ? a : b; }
__device__ __forceinline__ unsigned umin_(unsigned a, unsigned b) { return a < b ? a : b; }
__device__ __forceinline__ void sort16(unsigned (&a)[16]) {
#pragma unroll
    for (int k = 2; k <= 16; k <<= 1)
#pragma unroll
        for (int j = k >> 1; j > 0; j >>= 1)
#pragma unroll
            for (int i = 0; i < 16; ++i) { const int l = i ^ j; if (l > i) { const bool desc = ((i & k) == 0); const unsigned x = a[i], y = a[l], mx = umax_(x, y), mn = umin_(x, y); a[i] = desc ? mx : mn; a[l] = desc ? mn : mx; } }
}
__device__ __forceinline__ void merge16(unsigned (&a)[16], const unsigned (&b)[16]) {
#pragma unroll
    for (int i = 0; i < 16; ++i) a[i] = umax_(a[i], b[15 - i]);
#pragma unroll
    for (int j = 8; j > 0; j >>= 1)
#pragma unroll
        for (int i = 0; i < 16; ++i) { const int l = i ^ j; if (l > i) { const unsigned x = a[i], y = a[l]; a[i] = umax_(x, y); a[l] = umin_(x, y); } }
}
__device__ __forceinline__ unsigned dpp_swap1(unsigned v) { return (unsigned)__builtin_amdgcn_update_dpp(0, (int)v, 0xB1, 0xF, 0xF, false); }
__device__ __forceinline__ unsigned pick_byte(const unsigned (&pk)[4], unsigned a) {
    const unsigned wsel = a >> 2; unsigned v = wsel == 0 ? pk[0] : (wsel == 1 ? pk[1] : (wsel == 2 ? pk[2] : pk[3]));
    return (v >> ((a & 3u) * 8u)) & 0xffu;
}
__device__ __forceinline__ void topk_stage2(const unsigned (&top)[16], bool tab0, size_t item, int* esel, float* wsel) {
        float vO[16], vP[16]; unsigned iOpk[4] = {0u, 0u, 0u, 0u}, iPpk[4] = {0u, 0u, 0u, 0u};
#pragma unroll
        for (int i = 0; i < 16; ++i) { const unsigned t = top[i], tp = dpp_swap1(t);
            vO[i] = key2f(t & ~0x7fu); vP[i] = key2f(tp & ~0x7fu);
            iOpk[i >> 2] |= (127u - (t & 0x7fu)) << ((i & 3) * 8); iPpk[i >> 2] |= (127u - (tp & 0x7fu)) << ((i & 3) * 8); }
        unsigned R[16], G1[16], G2[16], G3[16];
#define CAND(a, b) ((f2key(vO[a] + vP[b]) & ~0xffu) | (unsigned)(((a) << 4) | (b)))
#pragma unroll
        for (int i = 0; i < 16; ++i) R[i] = CAND(0, i);
        G1[0] = CAND(1, 0); G1[1] = CAND(1, 1); G1[2] = CAND(1, 2); G1[3] = CAND(1, 3); G1[4] = CAND(1, 4); G1[5] = CAND(1, 5); G1[6] = CAND(1, 6); G1[7] = CAND(1, 7);
        G1[8] = CAND(2, 0); G1[9] = CAND(2, 1); G1[10] = CAND(2, 2); G1[11] = CAND(2, 3); G1[12] = CAND(2, 4); G1[13] = CAND(3, 0); G1[14] = CAND(3, 1); G1[15] = CAND(3, 2);
        G2[0] = CAND(3, 3); G2[1] = CAND(4, 0); G2[2] = CAND(4, 1); G2[3] = CAND(4, 2); G2[4] = CAND(5, 0); G2[5] = CAND(5, 1); G2[6] = CAND(6, 0); G2[7] = CAND(6, 1);
        G2[8] = CAND(7, 0); G2[9] = CAND(7, 1); G2[10] = CAND(8, 0); G2[11] = CAND(9, 0); G2[12] = CAND(10, 0); G2[13] = CAND(11, 0); G2[14] = CAND(12, 0); G2[15] = CAND(13, 0);
        G3[0] = CAND(14, 0); G3[1] = CAND(15, 0);
#pragma unroll
        for (int i = 2; i < 16; ++i) G3[i] = 0u;
#undef CAND
        sort16(G1); sort16(G2); sort16(G3);
        merge16(R, G1); merge16(R, G2); merge16(R, G3);
        float sc[16], ex[16]; float sum = 0.f; unsigned eid[16];
        #pragma unroll
        for (int i = 0; i < 16; ++i) { sc[i] = key2f(R[i] & ~0xffu); const unsigned a = (R[i] >> 4) & 15u, bb = R[i] & 15u;
            const unsigned io = pick_byte(iOpk, a), ip = pick_byte(iPpk, bb);
            eid[i] = tab0 ? (io * 128u + ip) : (ip * 128u + io); }
#pragma unroll
        for (int i = 0; i < 16; ++i) { ex[i] = __expf(sc[i] - sc[0]); sum += ex[i]; }
        const float inv = 1.0f / sum;
        if (tab0) { const size_t o = item * 16;
#pragma unroll
            for (int q = 0; q < 4; ++q) { v4u ev; ev.x = eid[4 * q]; ev.y = eid[4 * q + 1]; ev.z = eid[4 * q + 2]; ev.w = eid[4 * q + 3]; *(v4u*)(esel + o + 4 * q) = ev;
                f32x4 wv; wv[0] = ex[4 * q] * inv; wv[1] = ex[4 * q + 1] * inv; wv[2] = ex[4 * q + 2] * inv; wv[3] = ex[4 * q + 3] * inv; *(f32x4*)(wsel + o + 4 * q) = wv; } }
}
__device__ __forceinline__ void p7_topk(Frame& F) {
    const int NT = T * PHEADS * 2;
    for (int g0 = (F.bid * NWAVES + F.wave) * 64; g0 < NT; g0 += F.G * NTHR) {
        const int g = g0 + F.lane; const float* wb = F.scores() + (size_t)g0 * 128;
        LAS float* stg = (LAS float*)(F.lds) + F.wave * (64 * 36);
        unsigned top[16];
#pragma unroll
        for (int sg = 0; sg < 4; ++sg) {
            f32x4 tl[8];
#pragma unroll
            for (int i = 0; i < 8; ++i) tl[i] = __builtin_nontemporal_load((const f32x4*)(wb + (size_t)(8 * i + (F.lane >> 3)) * 128 + sg * 32 + 4 * (F.lane & 7)));
#pragma unroll
            for (int i = 0; i < 8; ++i) *(LAS f32x4*)(stg + (8 * i + (F.lane >> 3)) * 36 + 4 * (F.lane & 7)) = tl[i];
            asm volatile("s_waitcnt lgkmcnt(0)" ::: "memory");
#pragma unroll
            for (int hg2 = 0; hg2 < 2; ++hg2) { const int grp = sg * 2 + hg2; unsigned k[16];
#pragma unroll
                for (int q = 0; q < 4; ++q) { const f32x4 v = *(LAS const f32x4*)(stg + F.lane * 36 + hg2 * 16 + q * 4);
#pragma unroll
                    for (int e = 0; e < 4; ++e) { const int j = grp * 16 + q * 4 + e; k[q * 4 + e] = (f2key(v[e]) & ~0x7fu) | (unsigned)(127 - j); } }
                sort16(k);
                if (grp == 0) {
#pragma unroll
                    for (int i = 0; i < 16; ++i) top[i] = k[i];
                } else merge16(top, k); }
            asm volatile("s_waitcnt lgkmcnt(0)" ::: "memory");
        }
        topk_stage2(top, (g & 1) == 0, (size_t)((g >> 1) & 7) * T + (size_t)(g >> 4), F.esel(), F.wsel());
    }
}


struct EpiScoreTopk {
    static constexpr bool PERM = false, AFTER_DRAIN = false;
    float* scr; const float* ssqp; const float* biasq; float* rstd_out; int* esel; float* wsel;
    __device__ __forceinline__ void operator()(const f32x4 (&acc)[2][2][4][2], const pg8::Unit& u, int wr, int wc, int fr, int fq) const {
        asm volatile("" : "+v"(fr), "+v"(fq));
        const int rl0 = wr * 64 + fr, col0 = wc * 32 + 4 * fq, b = (u.pm * 256) >> 13;
        f32x4 bv[2][2];
#pragma unroll
        for (int bj = 0; bj < 2; ++bj)
#pragma unroll
            for (int n = 0; n < 2; ++n) bv[bj][n] = *(const f32x4*)(biasq + b * 2048 + u.pn * 256 + col0 + bj * 128 + n * 16);
#pragma unroll
        for (int ai = 0; ai < 2; ++ai)
#pragma unroll
            for (int m = 0; m < 4; ++m) { const int rl = rl0 + ai * 128 + m * 16, row = u.pm * 256 + rl;
                const f32x4 p0 = *(const f32x4*)(ssqp + (size_t)row * 4), p1 = *(const f32x4*)(ssqp + ((size_t)32768 + row) * 4), p2 = *(const f32x4*)(ssqp + ((size_t)65536 + row) * 4), p3 = *(const f32x4*)(ssqp + ((size_t)98304 + row) * 4);
                const float tot = (p0[0] + p0[1] + p0[2] + p0[3]) + (p1[0] + p1[1] + p1[2] + p1[3]) + (p2[0] + p2[1] + p2[2] + p2[3]) + (p3[0] + p3[1] + p3[2] + p3[3]);
                const float rstd = __builtin_amdgcn_rsqf(tot * (1.0f / 1024.0f) + 1e-6f);
                if (u.pn == 0 && wc == 0 && fq == 0) rstd_out[row] = rstd;
                float* blk = scr + (2 * wr + 4 * ai + (m >> 1)) * 8192 + 8 * wc * 256 + 32 * (m & 1) * 4;
                const unsigned loff4 = (unsigned)(2 * fr + 64 * fq);
#pragma unroll
                for (int bj = 0; bj < 2; ++bj)
#pragma unroll
                    for (int n = 0; n < 2; ++n) ((f32x4*)(blk + (4 * n * 64 + bj) * 4))[loff4] = acc[ai][bj][m][n] * rstd + bv[bj][n]; }
        asm volatile("s_waitcnt vmcnt(0)" ::: "memory");
        __builtin_amdgcn_s_barrier();
        asm volatile("" ::: "memory");
        int tid = threadIdx.x; asm volatile("" : "+v"(tid));
        const int rl = tid >> 1, tab = tid & 1;
        const float* bp = scr + __builtin_amdgcn_readfirstlane(tid >> 6) * 8192;
        const unsigned lo4 = (unsigned)(tid & 63) * 4u;
        unsigned top[16];
        f32x4 cur[4], nxt[4];
#pragma unroll
        for (int q = 0; q < 4; ++q) cur[q] = *(const f32x4*)(bp + q * 256 + lo4);
#pragma unroll
        for (int grp = 0; grp < 8; ++grp) { unsigned k[16];
            if (grp < 7) {
#pragma unroll
                for (int q = 0; q < 4; ++q) nxt[q] = *(const f32x4*)(bp + ((grp + 1) * 4 + q) * 256 + lo4); }
#pragma unroll
            for (int q = 0; q < 4; ++q) { const f32x4 v = cur[q];
#pragma unroll
                for (int e = 0; e < 4; ++e) { const int j = grp * 16 + q * 4 + e; k[q * 4 + e] = (f2key(v[e]) & ~0x7fu) | (unsigned)(127 - j); } }
            sort16(k);
            if (grp == 0) {
#pragma unroll
                for (int i = 0; i < 16; ++i) top[i] = k[i];
            } else merge16(top, k);
#pragma unroll
            for (int q = 0; q < 4; ++q) cur[q] = nxt[q];
            __builtin_amdgcn_sched_barrier(0); }
        topk_stage2(top, tab == 0, (size_t)u.pn * T + (size_t)(u.pm * 256 + rl), esel, wsel);
    }
};

__device__ __forceinline__ void cvt16(const v4u& u, f32x2_ (&f)[8]) {
#pragma unroll
    for (int i = 0; i < 4; ++i) { f[2 * i] = __builtin_amdgcn_cvt_pk_f32_fp8((int)u[i], false); f[2 * i + 1] = __builtin_amdgcn_cvt_pk_f32_fp8((int)u[i], true); }
}
constexpr int PITEM = 8, NPITEM = T / PITEM;
__device__ __forceinline__ int peer_next(unsigned* q, int lane) {
    int idx = 0; if (lane == 0) idx = (int)__hip_atomic_fetch_add(q, 1u, __ATOMIC_RELAXED, __HIP_MEMORY_SCOPE_AGENT);
    return __builtin_amdgcn_readfirstlane(idx);
}
#define PEER_SB() __builtin_amdgcn_sched_barrier(0)
#define DPP_IADD(s, ctrl) ((s) + __builtin_amdgcn_update_dpp(0, (s), (ctrl), 0xF, 0xF, false))
__device__ __forceinline__ void p8_dots(const v4u (&ud)[16], const int (&hh)[4], const int (&hl)[4], int c8, int& r0, int& r1) {
#pragma unroll
    for (int i = 0; i < 16; ++i) { int sh = 0, sl = 0;
#pragma unroll
        for (int d = 0; d < 4; ++d) { sh = __builtin_amdgcn_sdot8((int)ud[i][d], hh[d], sh, false); sl = __builtin_amdgcn_sdot8((int)ud[i][d], hl[d], sl, false); }
        int sm = (sh << 4) + sl;
        sm = DPP_IADD(sm, 0xB1); sm = DPP_IADD(sm, 0x4E); sm = DPP_IADD(sm, 0x141);
        if ((i & 1) == 0) r0 = (c8 == (i >> 1)) ? sm : r0; else r1 = (c8 == (i >> 1)) ? sm : r1; }
}
constexpr int PSLAB = 12288;
__device__ __forceinline__ void p8_item(Frame& F, int sl, int item, int nitem, bool filled, LAS unsigned char* slab) {
    const int c8 = F.lane & 7, q8 = F.lane >> 3, t0 = item * PITEM;
    const unsigned char* ub = F.U8() + (size_t)sl * 16384 * 128 + 16 * c8;
    LAS int* eL = (LAS int*)slab; LAS unsigned char* hL = (LAS unsigned char*)(slab + 4096);
    LAS float* qL = (LAS float*)(slab + 6144);
    v4u t4[4], h2[4]; float rs2[4]; f32x4 sA, sB;
#define P8_BLK_LOAD(tb) do { \
        { const float* sp_ = F.mod() + ((tb) >> 13) * 6144 + 3072 + sl * CSLU + 8 * (F.lane & 31); sA = *(const f32x4*)sp_; sB = *(const f32x4*)(sp_ + 4); } \
        _Pragma("unroll") for (int i = 0; i < 4; ++i) rs2[i] = F.rstd()[(tb) + 2 * i + (F.lane >> 5)]; \
        _Pragma("unroll") for (int i = 0; i < 4; ++i) t4[i] = __builtin_nontemporal_load((const v4u*)(F.esel() + ((size_t)(2 * i + (F.lane >> 5)) * T + (tb)) * 16) + (F.lane & 31)); \
        _Pragma("unroll") for (int i = 0; i < 4; ++i) h2[i] = __builtin_nontemporal_load((const v4u*)(F.hg() + (size_t)((tb) + 2 * i + (F.lane >> 5)) * D + sl * CSLU + 8 * (F.lane & 31))); } while (0)
#define DPP_FMAX(v, ctrl) __builtin_fmaxf((v), __builtin_bit_cast(float, __builtin_amdgcn_update_dpp(0, __builtin_bit_cast(int, (v)), (ctrl), 0xF, 0xF, false)))
#define P8_QN(x, k) { const int q_ = (int)__builtin_rintf((x) * qs_), lo_ = ((q_ + 8) & 15) - 8, hi_ = (q_ - lo_) >> 4; wl_ |= (unsigned)(lo_ & 15) << (4 * (k)); wh_ |= (unsigned)(hi_ & 15) << (4 * (k)); }
#define P8_BLK_STORE() do { _Pragma("unroll") for (int i = 0; i < 4; ++i) *(LAS v4u*)(eL + ((F.lane & 31) >> 2) * NSEL + (2 * i + (F.lane >> 5)) * 16 + 4 * (F.lane & 3)) = t4[i]; \
        _Pragma("unroll") for (int i = 0; i < 4; ++i) { const float r_ = rs2[i]; const v4u h_ = h2[i]; \
            const float x0 = bflo(h_[0]) * r_ + sA[0], x1 = bfhi(h_[0]) * r_ + sA[1], x2 = bflo(h_[1]) * r_ + sA[2], x3 = bfhi(h_[1]) * r_ + sA[3]; \
            const float x4 = bflo(h_[2]) * r_ + sB[0], x5 = bfhi(h_[2]) * r_ + sB[1], x6 = bflo(h_[3]) * r_ + sB[2], x7 = bfhi(h_[3]) * r_ + sB[3]; \
            float m_ = __builtin_fmaxf(__builtin_fmaxf(__builtin_fmaxf(__builtin_fabsf(x0), __builtin_fabsf(x1)), __builtin_fmaxf(__builtin_fabsf(x2), __builtin_fabsf(x3))), \
                                       __builtin_fmaxf(__builtin_fmaxf(__builtin_fabsf(x4), __builtin_fabsf(x5)), __builtin_fmaxf(__builtin_fabsf(x6), __builtin_fabsf(x7)))); \
            m_ = DPP_FMAX(m_, 0x128); m_ = DPP_FMAX(m_, 0x124); m_ = DPP_FMAX(m_, 0x122); m_ = DPP_FMAX(m_, 0x121); m_ = __builtin_fmaxf(m_, __shfl_xor(m_, 16)); m_ = __builtin_fmaxf(m_, 1e-20f); \
            const float qs_ = 119.0f * __builtin_amdgcn_rcpf(m_); \
            const int tk_ = 2 * i + (F.lane >> 5); \
            if ((F.lane & 31) == 0) qL[tk_] = m_ * (1.0f / (119.0f * UQSCALE)); \
            unsigned wl_ = 0u, wh_ = 0u; P8_QN(x0, 0) P8_QN(x1, 1) P8_QN(x2, 2) P8_QN(x3, 3) P8_QN(x4, 4) P8_QN(x5, 5) P8_QN(x6, 6) P8_QN(x7, 7) \
            *(LAS unsigned*)(hL + tk_ * 256 + 4 * (F.lane & 31)) = wh_; *(LAS unsigned*)(hL + tk_ * 256 + 128 + 4 * (F.lane & 31)) = wl_; } \
        asm volatile("s_waitcnt lgkmcnt(0)" ::: "memory"); } while (0)
    if (!filled) { P8_BLK_LOAD(t0); P8_BLK_STORE(); }
    bf16* po = F.pact() + ((size_t)t0 * NSLU + sl) * NSEL + 16 * q8 + 2 * c8;
    v4u udA[16], udB[16];
#define P8_GATHER(dst, tt) do { v4u e_[4]; _Pragma("unroll") for (int k = 0; k < 4; ++k) e_[k] = *(LAS const v4u*)(eL + (tt) * NSEL + 16 * q8 + 4 * k); \
        _Pragma("unroll") for (int i = 0; i < 16; ++i) dst[i] = *(const v4u*)(ub + (size_t)e_[i >> 2][i & 3] * 128); } while (0)
#define P8_HN(tt) int hh[4], hl[4]; { const v4u a_ = *(LAS const v4u*)(hL + (tt) * 256 + 16 * c8), b_ = *(LAS const v4u*)(hL + (tt) * 256 + 128 + 16 * c8); \
        hh[0] = (int)a_[0]; hh[1] = (int)a_[1]; hh[2] = (int)a_[2]; hh[3] = (int)a_[3]; hl[0] = (int)b_[0]; hl[1] = (int)b_[1]; hl[2] = (int)b_[2]; hl[3] = (int)b_[3]; }
#define P8_OUT(tt, r0, r1) do { const float dq_ = qL[tt]; __builtin_nontemporal_store(cvtpk((float)(r0) * dq_, (float)(r1) * dq_), (unsigned*)(po + (size_t)(tt) * NSLU * NSEL)); } while (0)
    P8_GATHER(udA, 0);
    for (int tt = 0; tt < PITEM - 2; tt += 2) {
        P8_GATHER(udB, tt + 1);
        { P8_HN(tt); int r0 = 0, r1 = 0; p8_dots(udA, hh, hl, c8, r0, r1); P8_OUT(tt, r0, r1); }
        P8_GATHER(udA, tt + 2);
        { P8_HN(tt + 1); int r0 = 0, r1 = 0; p8_dots(udB, hh, hl, c8, r0, r1); P8_OUT(tt + 1, r0, r1); }
    }
    {
        P8_GATHER(udB, PITEM - 1);
        { P8_HN(PITEM - 2); int r0 = 0, r1 = 0; p8_dots(udA, hh, hl, c8, r0, r1); P8_OUT(PITEM - 2, r0, r1); }
        if (nitem >= 0) P8_BLK_LOAD(nitem * PITEM);
        { P8_HN(PITEM - 1); int r0 = 0, r1 = 0; p8_dots(udB, hh, hl, c8, r0, r1); P8_OUT(PITEM - 1, r0, r1); }
        if (nitem >= 0) P8_BLK_STORE();
    }
#undef P8_GATHER
#undef P8_HN
#undef P8_OUT
#undef P8_BLK_LOAD
#undef P8_BLK_STORE
#undef P8_QN
#undef DPP_FMAX
}
__device__ __forceinline__ void p8b_coef(Frame& F) {
    const size_t N = (size_t)T * NSEL;
#pragma unroll 4
    for (size_t i = (size_t)F.bid * NTHR + F.tid; i < N; i += (size_t)F.G * NTHR) { const size_t t = i >> 7; const int j = (int)(i & 127);
        const bf16* pp = F.pact() + t * NSLU * NSEL + j; float a = 0.f;
#pragma unroll
        for (int s = 0; s < NSLU; ++s) a += bf2f(__builtin_nontemporal_load(pp + s * NSEL));
        F.coef()[i] = F.wsel()[((size_t)(j >> 4) * T + t) * 16 + (j & 15)] * 0.5f * a * (1.0f + erff(a * 0.70710678f)); }
}
__device__ __forceinline__ void p9_token(const v4u (&vd)[16], LAS const float* cL, bf16* yo, LAS float* red, int lane, int c8, int q8) {
    f32x4 cc[4];
#pragma unroll
    for (int k = 0; k < 4; ++k) cc[k] = *(LAS const f32x4*)(cL + 16 * q8 + 4 * k);
    f32x2_ y[8];
#pragma unroll
    for (int k = 0; k < 8; ++k) y[k] = (f32x2_){0.f, 0.f};
#pragma unroll
    for (int i = 0; i < 16; ++i) { f32x2_ vf[8]; cvt16(vd[i], vf); const float c = cc[i >> 2][i & 3]; const f32x2_ c2 = {c, c};
#pragma unroll
        for (int k = 0; k < 8; ++k) y[k] += c2 * vf[k];
        PEER_SB(); }
#pragma unroll
    for (int k = 0; k < 4; ++k) { f32x4 o; o[0] = y[2 * k][0]; o[1] = y[2 * k][1]; o[2] = y[2 * k + 1][0]; o[3] = y[2 * k + 1][1]; *(LAS f32x4*)(red + q8 * 128 + 16 * c8 + 4 * k) = o; }
    asm volatile("s_waitcnt lgkmcnt(0)" ::: "memory");
    f32x2_ sm = {0.f, 0.f};
#pragma unroll
    for (int g = 0; g < 8; ++g) sm += *(LAS const f32x2_*)(red + g * 128 + 2 * lane);
    sm = sm * (1.0f / VSCALE);
    __builtin_nontemporal_store(cvtpk(sm[0], sm[1]), (unsigned*)(yo + 2 * lane));
    asm volatile("s_waitcnt lgkmcnt(0)" ::: "memory");
    PEER_SB();
}
__device__ __forceinline__ void p9_item(Frame& F, int sl, int item, int nitem, bool filled, LAS unsigned char* slab) {
    const int c8 = F.lane & 7, q8 = F.lane >> 3, t0 = item * PITEM;
    const unsigned char* vb = F.V8() + (size_t)sl * 16384 * CSL + 16 * c8;
    LAS int* eL = (LAS int*)slab; LAS float* cL = (LAS float*)(slab + 4096); LAS float* red = (LAS float*)(slab + 8192);
    v4u t4[4], c4[4];
#define P9_BLK_LOAD(tb) do { const v4u* cp_ = (const v4u*)(F.coef() + (size_t)(tb) * NSEL); \
        _Pragma("unroll") for (int i = 0; i < 4; ++i) { t4[i] = __builtin_nontemporal_load((const v4u*)(F.esel() + ((size_t)(2 * i + (F.lane >> 5)) * T + (tb)) * 16) + (F.lane & 31)); c4[i] = __builtin_nontemporal_load(cp_ + i * 64 + F.lane); } } while (0)
#define P9_BLK_STORE() do { _Pragma("unroll") for (int i = 0; i < 4; ++i) { *(LAS v4u*)(eL + ((F.lane & 31) >> 2) * NSEL + (2 * i + (F.lane >> 5)) * 16 + 4 * (F.lane & 3)) = t4[i]; *(LAS v4u*)(cL + (i * 64 + F.lane) * 4) = c4[i]; } \
        asm volatile("s_waitcnt lgkmcnt(0)" ::: "memory"); } while (0)
    if (!filled) { P9_BLK_LOAD(t0); P9_BLK_STORE(); }
    bf16* yo = F.ybuf() + (size_t)t0 * D + sl * CSL;
    v4u vdA[16], vdB[16];
#define P9_GATHER(dst, tt) do { v4u e_[4]; _Pragma("unroll") for (int k = 0; k < 4; ++k) e_[k] = *(LAS const v4u*)(eL + (tt) * NSEL + 16 * q8 + 4 * k); \
        _Pragma("unroll") for (int i = 0; i < 16; ++i) dst[i] = *(const v4u*)(vb + (size_t)e_[i >> 2][i & 3] * CSL); } while (0)
    P9_GATHER(vdA, 0);
    for (int tt = 0; tt < PITEM - 2; tt += 2) {
        P9_GATHER(vdB, tt + 1);
        p9_token(vdA, cL + tt * NSEL, yo + (size_t)tt * D, red, F.lane, c8, q8);
        P9_GATHER(vdA, tt + 2);
        p9_token(vdB, cL + (tt + 1) * NSEL, yo + (size_t)(tt + 1) * D, red, F.lane, c8, q8);
    }
    {
        P9_GATHER(vdB, PITEM - 1);
        p9_token(vdA, cL + (PITEM - 2) * NSEL, yo + (size_t)(PITEM - 2) * D, red, F.lane, c8, q8);
        if (nitem >= 0) P9_BLK_LOAD(nitem * PITEM);
        p9_token(vdB, cL + (PITEM - 1) * NSEL, yo + (size_t)(PITEM - 1) * D, red, F.lane, c8, q8);
        if (nitem >= 0) P9_BLK_STORE();
    }
#undef P9_GATHER
#undef P9_BLK_LOAD
#undef P9_BLK_STORE
}
template <int SIDE>
__device__ __forceinline__ void peer_phase(Frame& F0, int rep) {
    Frame F = F0; asm volatile("" : "+v"(F.lane));
    constexpr int NS = (SIDE == 0) ? NSLU : NSL;
    const int s0 = (int)(xb_xcc_id() & (unsigned)(NS - 1));
    unsigned* qbase = F.ctl() + (SIDE == 0 ? CW_QU : CW_QV) + rep * 64 * 32;
    LAS unsigned char* cf = F.lds + F.wave * PSLAB;
    for (int k = 0; k < NS; ++k) { const int sl = (s0 + k) & (NS - 1);
        int item = peer_next(qbase + 64 * sl, F.lane); bool filled = false;
        while (item < NPITEM) { int nitem = peer_next(qbase + 64 * sl, F.lane); if (nitem >= NPITEM) nitem = -1;
            if (SIDE == 0) p8_item(F, sl, item, nitem, filled, cf); else p9_item(F, sl, item, nitem, filled, cf);
            filled = nitem >= 0; item = nitem >= 0 ? nitem : NPITEM; } }
}
__device__ __forceinline__ void p10_final(Frame& F) {
    const int gwc = F.bid * NWAVES + F.wave, NGW = F.G * NWAVES;
    for (int row0 = gwc * 16; row0 < T; row0 += NGW * 16) {
        const int b = row0 >> 13; const float* mb = F.mod() + b * 6144 + 5120; const float* fm = F.fmod() + b * 2048;
        f32x4 g2[4], ca[4], cb[4];
#pragma unroll
        for (int j = 0; j < 4; ++j) { const int k = 256 * j + 4 * F.lane; g2[j] = *(const f32x4*)(mb + k); ca[j] = *(const f32x4*)(F.fnorm_g() + k) * (*(const f32x4*)(fm + 1024 + k) + 1.0f); cb[j] = *(const f32x4*)(fm + k); }
#pragma unroll 4
        for (int r = 0; r < 16; ++r) { float* hr = F.out() + (size_t)(row0 + r) * D; const bf16* yr = F.ybuf() + (size_t)(row0 + r) * D; const bf16* hb = (const bf16*)hr;
            f32x4 z[4]; float ss = 0.f;
#pragma unroll
            for (int j = 0; j < 4; ++j) { const v2u hq = *(const v2u*)(hb + 256 * j + 4 * F.lane); f32x4 hv; hv[0] = bflo(hq[0]); hv[1] = bfhi(hq[0]); hv[2] = bflo(hq[1]); hv[3] = bfhi(hq[1]);
                const v2u yq = __builtin_nontemporal_load((const v2u*)(yr + 256 * j + 4 * F.lane)); f32x4 yv; yv[0] = bflo(yq[0]); yv[1] = bfhi(yq[0]); yv[2] = bflo(yq[1]); yv[3] = bfhi(yq[1]);
                z[j] = hv + g2[j] * yv; ss += z[j][0] * z[j][0] + z[j][1] * z[j][1] + z[j][2] * z[j][2] + z[j][3] * z[j][3]; }
            const float rstd = __builtin_amdgcn_rsqf(wave_sum(ss) * (1.0f / D) + EPS);
#pragma unroll
            for (int j = 0; j < 4; ++j) *(f32x4*)(hr + 256 * j + 4 * F.lane) = z[j] * rstd * ca[j] + cb[j]; }
    }
}

constexpr int NPHASE = 12;
__global__ void __launch_bounds__(NTHR, 2) fwd_kernel(Args args) {
    extern __shared__ __attribute__((aligned(16))) unsigned char lds_raw[];
    Frame F;
    F.lds = (LAS unsigned char*)lds_raw;
    F.tid = threadIdx.x; F.lane = F.tid & 63; F.wave = __builtin_amdgcn_readfirstlane(F.tid >> 6); F.G = gridDim.x; F.bid = blockIdx.x;
    unsigned char* ws = args.ws; F.a = &args;
    volatile LAS unsigned* misc = (volatile LAS unsigned*)(F.lds + MISC_OFF);
    if (F.tid < 64) misc[F.tid] = 0u;
    __syncthreads();
    const int lo = args.ph_lo, hi = args.ph_hi;
    const bool multi = (hi - lo) > 1;
    XcdBarrier bar; bar.bar = (unsigned*)(ws + WS_CTL) + CW_BAR; bar.x = 0; bar.st = nullptr;
    if (multi) bar = xcd_barrier_post((unsigned*)(ws + WS_CTL) + CW_BAR, misc + 8);
#ifndef PHMASK
#define PHMASK 0xfff
#endif
#define IN(k) (((PHMASK >> (k)) & 1) && lo <= (k) && (k) < hi)
#define SEAM(k) do { if (IN(k) && IN((k) + 1)) xcd_barrier(bar); } while (0)

#ifndef REPMASK
#define REPMASK 0
#endif
#define REP(k) (((REPMASK) >> (k)) & 1)
#define REPBAR(k) if (REP(k) && rep == 0) xcd_barrier(bar)
    if (IN(0)) { for (int rep = 0; rep <= REP(0); ++rep) { p0_prologue(F); REPBAR(0); } } SEAM(0);
    if (IN(1)) { for (int rep = 0; rep <= REP(1); ++rep) { p1_norm(F); REPBAR(1); } } SEAM(1);
    if (IN(2)) { { pg8::Gemm g{F.bufA(), F.Win_t(), T, NIN, D}; pg8::StaticOrder S; S.init(T, NIN, F.G, F.bid);
        pg8::EpiProj E{F.proj(), NIN};
        pg8::gemm_phase<pg8::EpiProj, pg8::StaticOrder, true, true>(F.lds, g, S, E); }
#if ((REPMASK) >> 2) & 1
        xcd_barrier(bar); { pg8::Gemm g{F.bufA(), F.Win_t(), T, NIN, D}; pg8::StaticOrder S; S.init(T, NIN, F.G, F.bid);
        pg8::EpiProj E{F.proj(), NIN};
        pg8::gemm_phase<pg8::EpiProj, pg8::StaticOrder, true, true>(F.lds, g, S, E); }
#endif
    } SEAM(2);
    if (IN(3)) { for (int rep = 0; rep <= REP(3); ++rep) {
        for (int it = F.bid; it < NB * NHH * 2 * NSEG; it += F.G) h1_item(F, it);
        float cw[CW];
#pragma unroll
        for (int j = 0; j < CW; ++j) cw[j] = F.conv_w()[j * DC + F.tid];
        const float cbias = F.conv_b()[F.tid];
        for (int it = F.bid; it < T / 32; it += F.G) conv_item(F, it, cw, cbias); REPBAR(3); }
    } SEAM(3);
    if (IN(4)) { for (int rep = 0; rep <= REP(4); ++rep) { for (int it = F.bid; it < NB * NHH * NSEG; it += F.G) h2_item(F, it); REPBAR(4); } } SEAM(4);
    if (IN(5)) { { pg8::Gemm g{F.bufA(), F.Wout_t(), T, D, D}; pg8::StaticOrder S; S.init(T, D, F.G, F.bid);
        pg8::EpiOut E{F.x(), F.out(), F.hg(), F.mod(), F.g_ffn(), F.ssqp()};
        pg8::gemm_phase<pg8::EpiOut, pg8::StaticOrder, true, true>(F.lds, g, S, E); }
#if ((REPMASK) >> 5) & 1
        xcd_barrier(bar); { pg8::Gemm g{F.bufA(), F.Wout_t(), T, D, D}; pg8::StaticOrder S; S.init(T, D, F.G, F.bid);
        pg8::EpiOut E{F.x(), F.out(), F.hg(), F.mod(), F.g_ffn(), F.ssqp()};
        pg8::gemm_phase<pg8::EpiOut, pg8::StaticOrder, true, true>(F.lds, g, S, E); }
#endif
    } SEAM(5);
    if (IN(6)) { { pg8::Gemm g{F.hg(), F.Wqk_t(), T, NQK, D}; pg8::StaticOrder S; S.init(T, NQK, F.G, F.bid);
        EpiScoreTopk E{F.scores() + (size_t)F.bid * 65536, F.ssqp(), F.biasq(), F.rstd(), F.esel(), F.wsel()};
        pg8::gemm_phase<EpiScoreTopk, pg8::StaticOrder, true, true>(F.lds, g, S, E); }
    } SEAM(6);
    if (IN(8)) { for (int rep = 0; rep <= REP(8); ++rep) { peer_phase<0>(F, rep); REPBAR(8); } } SEAM(8);
    if (IN(9)) { for (int rep = 0; rep <= REP(9); ++rep) { p8b_coef(F); REPBAR(9); } } SEAM(9);
    if (IN(10)) { for (int rep = 0; rep <= REP(10); ++rep) { peer_phase<1>(F, rep); REPBAR(10); } } SEAM(10);
    if (IN(11)) { p10_final(F); }
#undef IN
#undef SEAM
}

#ifndef MK_ONE_LAUNCH
#define MK_ONE_LAUNCH 0
#endif
extern "C" void kernel_launch(void* const* d_in, const int* in_sizes, int n_in, void* d_out, int out_size, void* d_ws, size_t ws_size, hipStream_t stream) {
    static int grid = 0;
    if (grid == 0) {
        if (n_in != 23 || out_size != T * D || ws_size < WS_END) { fprintf(stderr, "kernel_launch: unexpected shapes (n_in %d, out %d, ws %zu)\n", n_in, out_size, ws_size); grid = -1; return; }
        int dev = 0, cus = 0, per_cu = 0;
        if (hipGetDevice(&dev) != hipSuccess || hipDeviceGetAttribute(&cus, hipDeviceAttributeMultiprocessorCount, dev) != hipSuccess) { grid = -1; return; }
        if (hipFuncSetAttribute((const void*)fwd_kernel, hipFuncAttributeMaxDynamicSharedMemorySize, LDS_BYTES) != hipSuccess) { fprintf(stderr, "kernel_launch: hipFuncSetAttribute failed\n"); grid = -1; return; }
        if (hipOccupancyMaxActiveBlocksPerMultiprocessor(&per_cu, (const void*)fwd_kernel, NTHR, LDS_BYTES) != hipSuccess || per_cu < 1) { fprintf(stderr, "kernel_launch: occupancy query reports %d\n", per_cu); }
        (void)hipGetLastError();
        grid = cus;
    }
    if (grid < 0) return;
    (void)hipMemsetAsync((char*)d_ws + WS_CTL, 0, CTL_ZERO_BYTES, stream);
    Args a{};
    for (int i = 0; i < 23; ++i) a.in[i] = (const float*)d_in[i];
    a.out = (float*)d_out; a.ws = (unsigned char*)d_ws;
#if MK_ONE_LAUNCH
    a.ph_lo = 0; a.ph_hi = NPHASE;
    hipLaunchKernelGGL(fwd_kernel, dim3(grid), dim3(NTHR), LDS_BYTES, stream, a);
#else
    for (int p = 0; p < NPHASE; ++p) { a.ph_lo = p; a.ph_hi = p + 1; hipLaunchKernelGGL(fwd_kernel, dim3(grid), dim3(NTHR), LDS_BYTES, stream, a); }
#endif
}
```

```cpp
#include <hip/hip_runtime.h>
#include <cstdio>
#include <cstdint>
namespace pg8 {
#define PG8_LAS __attribute__((address_space(3)))
typedef unsigned short bf16_t;
typedef short bf16x8 __attribute__((ext_vector_type(8)));
typedef float f32x4 __attribute__((ext_vector_type(4)));
typedef unsigned u32x4 __attribute__((ext_vector_type(4)));
constexpr int BM = 256, BK = 64, HALF = 128, HTB = HALF * BK * 2  , STAGE_BYTES = 8 * HTB, NXCD = 8, WGM = 8;

__host__ __device__ __forceinline__ int lds_byte(int r, int c) { const int st = (r >> 4) * 2 + (c >> 5), rr = r & 15, cc = c & 31, ob = rr * 64 + cc * 2; return st * 1024 + (ob ^ (((ob >> 9) & 1) << 5)); }
__host__ __device__ __forceinline__ void stage_rc(int b, int& R, int& C) { const int st = b / 1024, sb = b % 1024, swz = sb ^ (((sb >> 9) & 1) << 5); R = (st >> 1) * 16 + swz / 64; C = (st & 1) * 32 + (swz % 64) / 2; }
__host__ __device__ __forceinline__ int perm32(int rho) { const int n = rho >> 4, i = rho & 15; return 8 * (i >> 2) + 4 * n + (i & 3); }

struct Unit { int pm, pn; };
struct Gemm { const bf16_t* A; const bf16_t* Bt; int M, N, K; };

struct StaticOrder {
    int nM, nN, nwg, G, c;
    __host__ __device__ void init(int M, int N, int G_, int c_) { nM = M / BM; nN = N / BM; nwg = nM * nN; G = G_; c = c_; }
    __host__ __device__ bool next(int i, Unit& u) const {
        const long L = (long)i * G + c; if (L >= nwg) return false;
        int wgid = (int)L; { const int q = nwg / NXCD, r = nwg % NXCD, xcd = wgid % NXCD, off = wgid / NXCD; wgid = (xcd < r ? xcd * (q + 1) : r * (q + 1) + (xcd - r) * q) + off; }
        const int nig = WGM * nN, gid = wgid / nig, fm = gid * WGM, gsz = (nM - fm) < WGM ? (nM - fm) : WGM;
        u.pm = fm + ((wgid % nig) % gsz); u.pn = (wgid % nig) / gsz; return true;
    }
    __device__ __forceinline__ void a_ready(const Unit&) const {}
    __device__ __forceinline__ void done(const Unit&) const {}
};
__device__ __forceinline__ unsigned cvt_pk_bf16(float lo, float hi) { unsigned r; asm volatile("v_cvt_pk_bf16_f32 %0, %1, %2" : "=v"(r) : "v"(lo), "v"(hi)); return r; }
typedef float f32x2 __attribute__((ext_vector_type(2)));
__device__ __forceinline__ f32x2 gelu_pk(f32x2 v) {
    const f32x2 av = __builtin_elementwise_abs(v), d = av * 0.2316418882f + 1.0f;
    f32x2 t; t.x = __builtin_amdgcn_rcpf(d.x); t.y = __builtin_amdgcn_rcpf(d.y);
    f32x2 q = t * 0.5307027145f + (-0.7265760135f); q = q * t + 0.7107068705f; q = q * t + (-0.142248368f); q = q * t + 0.127414796f; q = q * t;
    const f32x2 s = (v * v) * (-0.72134752044f);
    f32x2 e; e.x = __builtin_amdgcn_exp2f(s.x); e.y = __builtin_amdgcn_exp2f(s.y);
    const f32x2 m = v * (q * e), r = v - m;
    f32x2 o; o.x = v.x < 0.f ? m.x : r.x; o.y = v.y < 0.f ? m.y : r.y; return o;
}

template <int ACT  > struct EpiBf16 {
    static constexpr bool PERM = true, AFTER_DRAIN = false; static_assert(ACT == 0 || ACT == 1, "EpiBf16: ACT is 0 (none) or 1 (gelu_pk)");
    bf16_t* O; int ldc; const float* bias; int split_cols; size_t split_stride; float scale0;
    __device__ __forceinline__ void operator()(const f32x4 (&acc)[2][2][4][2], const Unit& u, int wr, int wc, int fr, int fq) const {
        const int row0 = u.pm * BM + wr * 64 + fr; int colt = u.pn * BM; bf16_t* base = O;
        float sc = 1.f; if (split_cols) { const int t = colt / split_cols; base += (size_t)t * split_stride; colt -= t * split_cols; if (t == 0) sc = scale0; }
        const int col0 = colt + wc * 32 + 8 * fq, bcol0 = u.pn * BM + wc * 32 + 8 * fq;
        f32x4 bv[2][2];
#pragma unroll
        for (int bj = 0; bj < 2; ++bj)
#pragma unroll
            for (int n = 0; n < 2; ++n) bv[bj][n] = bias ? *(const f32x4*)(bias + bcol0 + bj * HALF + 4 * n) : (f32x4){0.f, 0.f, 0.f, 0.f};
#pragma unroll
        for (int ai = 0; ai < 2; ++ai)
#pragma unroll
            for (int m = 0; m < 4; ++m) { bf16_t* rowp = base + (size_t)(row0 + ai * HALF + m * 16) * ldc + col0;
#pragma unroll
                for (int bj = 0; bj < 2; ++bj) { f32x4 v0 = acc[ai][bj][m][0] + bv[bj][0], v1 = acc[ai][bj][m][1] + bv[bj][1];
                    if (ACT == 1) { f32x2 a = gelu_pk((f32x2){v0[0], v0[1]}), b = gelu_pk((f32x2){v0[2], v0[3]}), c = gelu_pk((f32x2){v1[0], v1[1]}), d = gelu_pk((f32x2){v1[2], v1[3]});
                        v0 = (f32x4){a.x, a.y, b.x, b.y}; v1 = (f32x4){c.x, c.y, d.x, d.y}; }
                    v0 = v0 * sc; v1 = v1 * sc; u32x4 w; w.x = cvt_pk_bf16(v0[0], v0[1]); w.y = cvt_pk_bf16(v0[2], v0[3]); w.z = cvt_pk_bf16(v1[0], v1[1]); w.w = cvt_pk_bf16(v1[2], v1[3]);
                    *(u32x4*)(rowp + bj * HALF) = w; } }
    }
};

struct EpiOut {
    static constexpr bool PERM = true, AFTER_DRAIN = false;
    const float* X; float* Hout; bf16_t* HG; const float* mod; const float* gffn; float* ssqp;
    __device__ __forceinline__ void operator()(const f32x4 (&acc)[2][2][4][2], const Unit& u, int wr, int wc, int fr, int fq) const {
        const int row0 = u.pm * BM + wr * 64 + fr, col0 = u.pn * BM + wc * 32 + 8 * fq;
        const int b = (u.pm * BM) >> 13;
        const float* mb = mod + b * 6144;
        f32x4 g1v[2][2], gv2[2][2];
#pragma unroll
        for (int bj = 0; bj < 2; ++bj)
#pragma unroll
            for (int n = 0; n < 2; ++n) { const int c = col0 + bj * HALF + 4 * n;
                g1v[bj][n] = *(const f32x4*)(mb + 2048 + c);
                const f32x4 s2 = *(const f32x4*)(mb + 4096 + c), gf = *(const f32x4*)(gffn + c);
                gv2[bj][n] = gf * (s2 + 1.0f); }
#pragma unroll
        for (int ai = 0; ai < 2; ++ai)
#pragma unroll
            for (int m = 0; m < 4; ++m) { const int row = row0 + ai * HALF + m * 16; const size_t ro = (size_t)row * 1024 + col0; float ss = 0.f;
#pragma unroll
                for (int bj = 0; bj < 2; ++bj) {
                    const f32x4 x0 = *(const f32x4*)(X + ro + bj * HALF), x1 = *(const f32x4*)(X + ro + bj * HALF + 4);
                    const f32x4 h0 = x0 + g1v[bj][0] * acc[ai][bj][m][0], h1 = x1 + g1v[bj][1] * acc[ai][bj][m][1];
                    { u32x4 hw; hw.x = cvt_pk_bf16(h0[0], h0[1]); hw.y = cvt_pk_bf16(h0[2], h0[3]); hw.z = cvt_pk_bf16(h1[0], h1[1]); hw.w = cvt_pk_bf16(h1[2], h1[3]);
                      *(u32x4*)((bf16_t*)Hout + (size_t)row * 2048 + col0 + bj * HALF) = hw; }
                    ss += h0[0] * h0[0] + h0[1] * h0[1] + h0[2] * h0[2] + h0[3] * h0[3] + h1[0] * h1[0] + h1[1] * h1[1] + h1[2] * h1[2] + h1[3] * h1[3];
                    const f32x4 q0 = h0 * gv2[bj][0], q1 = h1 * gv2[bj][1];
                    u32x4 w; w.x = cvt_pk_bf16(q0[0], q0[1]); w.y = cvt_pk_bf16(q0[2], q0[3]); w.z = cvt_pk_bf16(q1[0], q1[1]); w.w = cvt_pk_bf16(q1[2], q1[3]);
                    *(u32x4*)(HG + ro + bj * HALF) = w; }
                ss += __shfl_xor(ss, 16); ss += __shfl_xor(ss, 32);
                if (fq == 0) ssqp[((size_t)u.pn * 32768 + row) * 4 + wc] = ss; }
    }
};
struct EpiScore {
    static constexpr bool PERM = false, AFTER_DRAIN = false;
    float* S; const float* ssqp; const float* biasq; float* rstd_out;
    __device__ __forceinline__ void operator()(const f32x4 (&acc)[2][2][4][2], const Unit& u, int wr, int wc, int fr, int fq) const {
        const int row0 = u.pm * BM + wr * 64 + fr, col0 = u.pn * BM + wc * 32 + 4 * fq;
        const int b = (u.pm * BM) >> 13;
        f32x4 bv[2][2];
#pragma unroll
        for (int bj = 0; bj < 2; ++bj)
#pragma unroll
            for (int n = 0; n < 2; ++n) bv[bj][n] = *(const f32x4*)(biasq + b * 2048 + col0 + bj * HALF + n * 16);
#pragma unroll
        for (int ai = 0; ai < 2; ++ai)
#pragma unroll
            for (int m = 0; m < 4; ++m) { const int row = row0 + ai * HALF + m * 16;
                const f32x4 p0 = *(const f32x4*)(ssqp + (size_t)row * 4), p1 = *(const f32x4*)(ssqp + ((size_t)32768 + row) * 4), p2 = *(const f32x4*)(ssqp + ((size_t)65536 + row) * 4), p3 = *(const f32x4*)(ssqp + ((size_t)98304 + row) * 4);
                const float tot = (p0[0] + p0[1] + p0[2] + p0[3]) + (p1[0] + p1[1] + p1[2] + p1[3]) + (p2[0] + p2[1] + p2[2] + p2[3]) + (p3[0] + p3[1] + p3[2] + p3[3]);
                const float rstd = __builtin_amdgcn_rsqf(tot * (1.0f / 1024.0f) + 1e-6f);
                if (u.pn == 0 && wc == 0 && fq == 0) rstd_out[row] = rstd;
                float* rowp = S + (size_t)row * 2048 + col0;
#pragma unroll
                for (int bj = 0; bj < 2; ++bj)
#pragma unroll
                    for (int n = 0; n < 2; ++n) *(f32x4*)(rowp + bj * HALF + n * 16) = acc[ai][bj][m][n] * rstd + bv[bj][n]; }
    }
};

struct EpiProj {
    static constexpr bool PERM = true, AFTER_DRAIN = false;
    bf16_t* O; int ldc;
    __device__ __forceinline__ void operator()(const f32x4 (&acc)[2][2][4][2], const Unit& u, int wr, int wc, int fr, int fq) const {
        asm volatile("" : "+v"(fr), "+v"(fq));
        const int row0 = u.pm * BM + wr * 64 + fr, col0 = u.pn * BM + wc * 32 + 8 * fq;
        const int cls = u.pn >> 1;
        const bool ident = (cls == 3) || (cls == 5), mulx = (cls == 0) || (cls == 4);
        const float sgn = (cls == 1 || cls == 2) ? 1.4426950408889634f : -1.4426950408889634f;
#pragma unroll
        for (int ai = 0; ai < 2; ++ai)
#pragma unroll
            for (int m = 0; m < 4; ++m) { bf16_t* rowp = O + (size_t)(row0 + ai * HALF + m * 16) * ldc + col0;
#pragma unroll
                for (int bj = 0; bj < 2; ++bj) { f32x4 v0 = acc[ai][bj][m][0], v1 = acc[ai][bj][m][1];
                    if (!ident) {
#pragma unroll
                        for (int j = 0; j < 4; ++j) { const float r0 = __builtin_amdgcn_rcpf(1.0f + __builtin_amdgcn_exp2f(sgn * v0[j])), r1 = __builtin_amdgcn_rcpf(1.0f + __builtin_amdgcn_exp2f(sgn * v1[j]));
                            v0[j] = mulx ? v0[j] * r0 : r0; v1[j] = mulx ? v1[j] * r1 : r1; } }
                    u32x4 w; w.x = cvt_pk_bf16(v0[0], v0[1]); w.y = cvt_pk_bf16(v0[2], v0[3]); w.z = cvt_pk_bf16(v1[0], v1[1]); w.w = cvt_pk_bf16(v1[2], v1[3]);
                    *(u32x4*)(rowp + bj * HALF) = w; } }
    }
};
template <class Epi, class Sched, bool ALIGN_EPI = false, bool SP2 = false>
__device__ __forceinline__ void gemm_phase(PG8_LAS unsigned char* lds, const Gemm g, const Sched& S, const Epi& E) {
    const int tid = threadIdx.x, wid = __builtin_amdgcn_readfirstlane(tid >> 6), lane = tid & 63, wr = wid >> 2, wc = wid & 3, fr = lane & 15, fq = lane >> 4;
    const int K = g.K, nt = K / BK;
    unsigned voffA[2], voffB[2];
#pragma unroll
    for (int i = 0; i < 2; ++i) { int R, C; stage_rc(tid * 16 + i * 8192, R, C); const int Rb = Epi::PERM ? ((R & ~31) + perm32(R & 31)) : R;
        voffA[i] = (unsigned)(R * K + C) * 2u; voffB[i] = (unsigned)(Rb * K + C) * 2u; }
    const size_t kstep = (size_t)(BK * 2);
    const size_t hstep = (size_t)HALF * K * 2;
    const size_t tstep = 2 * hstep;
    const unsigned ldsw = (unsigned)wid * 1024u;
    const int aoff = lds_byte(wr * 64 + fr, fq * 8), boff = lds_byte(wc * 32 + fr, fq * 8);
#define PG8_SA(b, h) (((b) * 2 + (h)) * HTB)
#define PG8_SB(b, h) ((4 + (b) * 2 + (h)) * HTB)
#define PG8_STAGE(bufoff, gbase, voff) do { _Pragma("unroll") for (int _i = 0; _i < 2; ++_i) \
        __builtin_amdgcn_global_load_lds((const unsigned*)((const char*)(gbase) + (voff)[_i]), (PG8_LAS unsigned*)(lds + (bufoff) + ldsw + _i * 8192), 16, 0, 0); } while (0)
#define PG8_LDA(dst, b, h) do { _Pragma("unroll") for (int m = 0; m < 4; ++m) _Pragma("unroll") for (int k = 0; k < 2; ++k) dst[m][k] = *(const PG8_LAS bf16x8*)(lds + PG8_SA(b, h) + aoff + m * 2048 + k * 1024); } while (0)
#define PG8_LDB(dst, b, h) do { _Pragma("unroll") for (int n = 0; n < 2; ++n) _Pragma("unroll") for (int k = 0; k < 2; ++k) dst[n][k] = *(const PG8_LAS bf16x8*)(lds + PG8_SB(b, h) + boff + n * 2048 + k * 1024); } while (0)
#define PG8_MMA(ai, bj, At, Bt) do { __builtin_amdgcn_s_setprio(1); _Pragma("unroll") for (int m = 0; m < 4; ++m) _Pragma("unroll") for (int n = 0; n < 2; ++n) _Pragma("unroll") for (int k = 0; k < 2; ++k) \
        acc[ai][bj][m][n] = __builtin_amdgcn_mfma_f32_16x16x32_bf16(Bt[n][k], At[m][k], acc[ai][bj][m][n], 0, 0, 0); __builtin_amdgcn_s_setprio(0); } while (0)
#define PG8_WAIT_V(n) asm volatile("s_waitcnt vmcnt(" #n ")" ::: "memory")
#define PG8_WAIT_L(n) asm volatile("s_waitcnt lgkmcnt(" #n ")" ::: "memory")
#define PG8_BAR __builtin_amdgcn_s_barrier()
#define PG8_SCHED __builtin_amdgcn_sched_barrier(0)
    Unit cur, nxt; int ui = 0;
    if (!S.next(0, cur)) return;
    f32x4 acc[2][2][4][2];
#pragma unroll
    for (int a = 0; a < 2; ++a)
#pragma unroll
        for (int b = 0; b < 2; ++b)
#pragma unroll
            for (int m = 0; m < 4; ++m)
#pragma unroll
                for (int n = 0; n < 2; ++n) acc[a][b][m][n] = (f32x4){0.f, 0.f, 0.f, 0.f};
    bf16x8 At[4][2], B0[2][2], B1[2][2];
    const char* cA = (const char*)g.A + (size_t)cur.pm * tstep; const char* cB = (const char*)g.Bt + (size_t)cur.pn * tstep;
    S.a_ready(cur);
    if constexpr (SP2) {
        PG8_STAGE(PG8_SB(0, 0), cB, voffB); PG8_STAGE(PG8_SB(0, 1), cB + hstep, voffB); PG8_STAGE(PG8_SA(0, 0), cA, voffA); PG8_STAGE(PG8_SA(0, 1), cA + hstep, voffA);
        if (wr == 1) PG8_BAR;
        PG8_WAIT_V(2); PG8_BAR;
        PG8_STAGE(PG8_SB(1, 0), cB + kstep, voffB); PG8_STAGE(PG8_SA(1, 0), cA + kstep, voffA); PG8_STAGE(PG8_SB(1, 1), cB + hstep + kstep, voffB);
        PG8_WAIT_V(6); PG8_BAR;
    } else {
        PG8_STAGE(PG8_SB(0, 0), cB, voffB); PG8_STAGE(PG8_SA(0, 0), cA, voffA); PG8_STAGE(PG8_SB(0, 1), cB + hstep, voffB); PG8_STAGE(PG8_SA(0, 1), cA + hstep, voffA);
        if (wr == 1) PG8_BAR;
        PG8_WAIT_V(4); PG8_BAR;
        PG8_STAGE(PG8_SB(1, 0), cB + kstep, voffB); PG8_STAGE(PG8_SA(1, 0), cA + kstep, voffA); PG8_STAGE(PG8_SB(1, 1), cB + hstep + kstep, voffB);
        PG8_WAIT_V(6); PG8_BAR;
    }
    for (;;) {
        const bool has_next = S.next(ui + 1, nxt);
        const char* nA = has_next ? (const char*)g.A + (size_t)nxt.pm * tstep : cA; const char* nB = has_next ? (const char*)g.Bt + (size_t)nxt.pn * tstep : cB;
        for (int t = 0; t < nt; t += 2) {
            const bool last = (t == nt - 2);
            const char* a1 = cA + (size_t)(t + 1) * kstep;
            const char* a2 = last ? nA : cA + (size_t)(t + 2) * kstep; const char* b2 = last ? nB : cB + (size_t)(t + 2) * kstep;
            const char* a3 = a2 + kstep; const char* b3 = b2 + kstep;
            if (last && has_next) S.a_ready(nxt);
            if constexpr (SP2) {
            PG8_LDB(B0, 0, 0); PG8_LDB(B1, 0, 1); PG8_SCHED; PG8_LDA(At, 0, 0); PG8_STAGE(PG8_SA(1, 1), a1 + hstep, voffA);
            PG8_WAIT_V(8); PG8_WAIT_L(0); PG8_BAR; PG8_MMA(0, 0, At, B0); PG8_MMA(0, 1, At, B1); PG8_BAR; PG8_SCHED;
            PG8_LDA(At, 0, 1); PG8_STAGE(PG8_SB(0, 0), b2, voffB); PG8_STAGE(PG8_SB(0, 1), b2 + hstep, voffB); PG8_STAGE(PG8_SA(0, 0), a2, voffA);
            PG8_WAIT_V(8); PG8_WAIT_L(0); PG8_BAR; PG8_MMA(1, 0, At, B0); PG8_MMA(1, 1, At, B1); PG8_BAR; PG8_SCHED;
            PG8_LDB(B0, 1, 0); PG8_LDB(B1, 1, 1); PG8_SCHED; PG8_LDA(At, 1, 0); PG8_STAGE(PG8_SA(0, 1), a2 + hstep, voffA);
            PG8_WAIT_V(8); PG8_WAIT_L(0); PG8_BAR; PG8_MMA(0, 0, At, B0); PG8_MMA(0, 1, At, B1); PG8_BAR; PG8_SCHED;
            PG8_LDA(At, 1, 1); PG8_STAGE(PG8_SB(1, 0), b3, voffB); PG8_STAGE(PG8_SB(1, 1), b3 + hstep, voffB); PG8_STAGE(PG8_SA(1, 0), a3, voffA);
            PG8_WAIT_V(8); PG8_WAIT_L(0); PG8_BAR; PG8_MMA(1, 0, At, B0); PG8_MMA(1, 1, At, B1); PG8_BAR; PG8_SCHED;
            } else {
            PG8_LDB(B0, 0, 0); PG8_SCHED; PG8_LDA(At, 0, 0); PG8_STAGE(PG8_SA(1, 1), a1 + hstep, voffA);
            PG8_WAIT_L(8); PG8_BAR; PG8_WAIT_L(0); PG8_MMA(0, 0, At, B0); PG8_BAR; PG8_SCHED;
            PG8_LDB(B1, 0, 1); PG8_STAGE(PG8_SB(0, 0), b2, voffB);
            PG8_BAR; PG8_WAIT_L(0); PG8_MMA(0, 1, At, B1); PG8_BAR;
            PG8_LDA(At, 0, 1); PG8_STAGE(PG8_SA(0, 0), a2, voffA);
            PG8_BAR; PG8_WAIT_L(0); PG8_MMA(1, 0, At, B0); PG8_BAR; PG8_SCHED;
            PG8_STAGE(PG8_SB(0, 1), b2 + hstep, voffB);
            PG8_WAIT_V(6); PG8_BAR; PG8_MMA(1, 1, At, B1); PG8_BAR;
            PG8_LDB(B0, 1, 0); PG8_SCHED; PG8_LDA(At, 1, 0); PG8_STAGE(PG8_SA(0, 1), a2 + hstep, voffA);
            PG8_WAIT_L(8); PG8_BAR; PG8_WAIT_L(0); PG8_MMA(0, 0, At, B0); PG8_BAR; PG8_SCHED;
            PG8_LDB(B1, 1, 1); PG8_STAGE(PG8_SB(1, 0), b3, voffB);
            PG8_BAR; PG8_WAIT_L(0); PG8_MMA(0, 1, At, B1); PG8_BAR;
            PG8_LDA(At, 1, 1); PG8_STAGE(PG8_SA(1, 0), a3, voffA);
            PG8_BAR; PG8_WAIT_L(0); PG8_MMA(1, 0, At, B0); PG8_BAR; PG8_SCHED;
            PG8_STAGE(PG8_SB(1, 1), b3 + hstep, voffB);
            PG8_WAIT_V(6); PG8_BAR; PG8_MMA(1, 1, At, B1); PG8_BAR;
            }
        }
        if constexpr (ALIGN_EPI) { if (wr == 0) PG8_BAR; }
        if constexpr (!Epi::AFTER_DRAIN) { E(acc, cur, wr, wc, fr, fq); S.done(cur); }
        if (!has_next) break;
#pragma unroll
        for (int a = 0; a < 2; ++a)
#pragma unroll
            for (int b = 0; b < 2; ++b)
#pragma unroll
                for (int m = 0; m < 4; ++m)
#pragma unroll
                    for (int n = 0; n < 2; ++n) acc[a][b][m][n] = (f32x4){0.f, 0.f, 0.f, 0.f};
        cur = nxt; cA = nA; cB = nB; ++ui;
        if constexpr (ALIGN_EPI) { if (wr == 1) PG8_BAR; }
    }
    PG8_WAIT_V(0);
    if constexpr (!ALIGN_EPI) { if (wr == 0) PG8_BAR; }
    PG8_BAR;
    if constexpr (Epi::AFTER_DRAIN) { E.fused(acc, cur, wr, wc, fr, fq, lds, wid, lane); S.done(cur); }
#undef PG8_SA
#undef PG8_SB
#undef PG8_STAGE
#undef PG8_LDA
#undef PG8_LDB
#undef PG8_MMA
#undef PG8_WAIT_V
#undef PG8_WAIT_L
#undef PG8_BAR
#undef PG8_SCHED
}
}
#define MK_ONE_LAUNCH 1

constexpr int NB = 4, SEQ = 8192, T = NB * SEQ, D = 1024;
constexpr int NIN = 3584, DH = 512, HD = 128, NHH = 4, CHK = 64;
constexpr int NSEG = 16, SEGC = 8;
constexpr int CW = 31, CPAD = 15, DC = 512;
constexpr int PHEADS = 8, NQK = 2048, NSEL = 128;
constexpr float EPS = 1e-6f;
constexpr int NWAVES = 8, NTHR = 512;

constexpr size_t MiB = 1u << 20;
constexpr size_t WS_CTL = 0, CTL_ZERO_BYTES = 65536;
constexpr size_t WS_MOD = 1 * MiB, WS_FMOD = WS_MOD + 131072, WS_LB = WS_MOD + 196608, WS_BIASQ = WS_MOD + 262144;
constexpr size_t WS_WIN = 2 * MiB, WS_WOUT = 10 * MiB, WS_WQK = 12 * MiB;
constexpr size_t WS_UT = 16 * MiB, WS_VT = 48 * MiB;
constexpr size_t WS_BUFA = 80 * MiB;
constexpr size_t WS_BUFB = 144 * MiB;
constexpr size_t WS_SEG = 208 * MiB;
constexpr size_t WS_E = 208 * MiB, WS_W = 224 * MiB;
constexpr size_t WS_BIG = 240 * MiB;
constexpr size_t WS_SSQ = 496 * MiB;
constexpr size_t WS_SEGA = 498 * MiB;
constexpr size_t WS_RSTD = 499 * MiB;
constexpr size_t WS_END = 500 * MiB;
constexpr size_t WS_PACT = 240 * MiB;
constexpr size_t WS_Y = 368 * MiB;
constexpr int NSL = 8, CSL = 128;
constexpr float VSCALE = 16.0f;
constexpr float UQSCALE = 95.5f;
constexpr int NSLU = 4, CSLU = 256;
constexpr int CW_QU = 8192, CW_QV = 8192 + 64 * 16;
constexpr int CW_BAR = 1024;

#ifndef LDSFILL
#define LDSFILL 0u
#endif
constexpr int LDS_BYTES = 155648;
constexpr int MISC_OFF = LDS_BYTES - 256;

#define GAS __attribute__((address_space(1)))
#define LAS __attribute__((address_space(3)))
typedef unsigned short bf16;
typedef unsigned v4u __attribute__((ext_vector_type(4)));
typedef unsigned v2u __attribute__((ext_vector_type(2)));
typedef float f32x4 __attribute__((ext_vector_type(4)));
typedef float f32x16 __attribute__((ext_vector_type(16)));
typedef short bf16x8 __attribute__((ext_vector_type(8)));
typedef float f32x2_ __attribute__((ext_vector_type(2)));

__device__ __forceinline__ float bf2f(unsigned h) { return __builtin_bit_cast(float, h << 16); }
__device__ __forceinline__ float bflo(unsigned u) { return __builtin_bit_cast(float, u << 16); }
__device__ __forceinline__ float bfhi(unsigned u) { return __builtin_bit_cast(float, u & 0xffff0000u); }
__device__ __forceinline__ unsigned f2bf(float f) { unsigned u = __builtin_bit_cast(unsigned, f); return (u + 0x7fffu + ((u >> 16) & 1u)) >> 16; }
__device__ __forceinline__ unsigned pk2(float lo, float hi) { return f2bf(lo) | (f2bf(hi) << 16); }
__device__ __forceinline__ unsigned cvtpk(float lo, float hi) { unsigned r; asm("v_cvt_pk_bf16_f32 %0, %1, %2" : "=v"(r) : "v"(lo), "v"(hi)); return r; }
__device__ __forceinline__ float sigmoidf_(float x) { return __builtin_amdgcn_rcpf(1.0f + __expf(-x)); }
#define DPP_ADD(s, ctrl) ((s) + __builtin_bit_cast(float, __builtin_amdgcn_update_dpp(0, __builtin_bit_cast(int, (s)), (ctrl), 0xF, 0xF, false)))
__device__ __forceinline__ float wave_sum(float v) {
#pragma unroll
    for (int o = 1; o < 64; o <<= 1) v += __shfl_xor(v, o);
    return v;
}

#define XB_TMO      128
#define XB_XCNT(j)  (256  + 64 * (j))
#define XB_XSUB(j)  (1280 + 64 * (j))
#define XB_XGEN(j)  (2304 + 64 * (j))
#define XB_TOP      3328
#define XB_TOPGEN   3392
#define XCD_BAR_WORDS 3456
#define XB_SPIN_CAP (1u << 18)
__device__ __forceinline__ unsigned xb_ld(unsigned* p)              { return __hip_atomic_load(p, __ATOMIC_RELAXED, __HIP_MEMORY_SCOPE_AGENT); }
__device__ __forceinline__ unsigned xb_add(unsigned* p, unsigned v) { return __hip_atomic_fetch_add(p, v, __ATOMIC_RELAXED, __HIP_MEMORY_SCOPE_AGENT); }
__device__ __forceinline__ unsigned xb_xcc_id() { return (unsigned)__builtin_amdgcn_s_getreg((3 << 11) | 20) & 0xFu; }
#define XB_SPIN(cond, bar) do { unsigned _sp = 0; while (cond) { __builtin_amdgcn_s_sleep(1); \
    if ((++_sp & 255u) == 0u) { if (xb_ld(&(bar)[XB_TMO])) break; if (_sp > XB_SPIN_CAP) { atomicAdd(&(bar)[XB_TMO], 1u); break; } } } } while (0)
struct XcdBarrier { unsigned* bar; unsigned x; volatile LAS unsigned* st; };
__device__ __forceinline__ XcdBarrier xcd_barrier_post(unsigned* bar, volatile LAS unsigned* st) {
    XcdBarrier b; b.bar = bar; b.x = xb_xcc_id(); b.st = st;
    if (threadIdx.x == 0) (void)xb_add(&bar[XB_XCNT(b.x)], 1u);
    return b;
}
__device__ __forceinline__ void xcd_barrier_complete(unsigned* bar, unsigned x, unsigned& nloc, unsigned& nx) {
    const unsigned G = gridDim.x * gridDim.y * gridDim.z;
    unsigned sum, cnt, mine, sp = 0u;
    for (;;) {
        sum = 0u; cnt = 0u; mine = 0u;
#pragma unroll
        for (unsigned j = 0; j < 16; ++j) { const unsigned c = xb_ld(&bar[XB_XCNT(j)]); sum += c; cnt += (c > 0u) ? 1u : 0u; mine = (j == x) ? c : mine; }
        if (sum == G) break;
        __builtin_amdgcn_s_sleep(1);
        if ((++sp & 255u) == 0u) { if (xb_ld(&bar[XB_TMO])) break; if (sp > XB_SPIN_CAP) { atomicAdd(&bar[XB_TMO], 1u); break; } }
    }
    nloc = mine > 0u ? mine : 1u; nx = cnt > 0u ? cnt : 1u;
}
__device__ __forceinline__ void xcd_barrier(const XcdBarrier& b) {
    asm volatile("s_waitcnt vmcnt(0)" ::: "memory");
    __syncthreads();
    if (threadIdx.x == 0) {
        unsigned* bar = b.bar;
        __builtin_amdgcn_s_waitcnt(0);
        unsigned nloc = b.st[0], nx = b.st[1];
        if (nloc == 0u) { xcd_barrier_complete(bar, b.x, nloc, nx); b.st[0] = nloc; b.st[1] = nx; }
        const unsigned old = xb_add(&bar[XB_XSUB(b.x)], 1u);
        const unsigned gen = old / nloc;
        if (old + 1u == (gen + 1u) * nloc) {
            __builtin_amdgcn_fence(__ATOMIC_RELEASE, "agent");
            asm volatile("s_waitcnt vmcnt(0)" ::: "memory");
            const unsigned og = xb_add(&bar[XB_TOP], 1u);
            const unsigned tg = og / nx;
            if (og + 1u == (tg + 1u) * nx) xb_add(&bar[XB_TOPGEN], 1u);
            else XB_SPIN(xb_ld(&bar[XB_TOPGEN]) == tg, bar);
            __builtin_amdgcn_fence(__ATOMIC_ACQUIRE, "agent");
            xb_add(&bar[XB_XGEN(b.x)], 1u);
            asm volatile("s_waitcnt vmcnt(0)" ::: "memory");
        } else {
            XB_SPIN(xb_ld(&bar[XB_XGEN(b.x)]) == gen, bar);
            __builtin_amdgcn_fence(__ATOMIC_ACQUIRE, "agent");
            asm volatile("s_waitcnt vmcnt(0)" ::: "memory");
        }
    }
    __syncthreads();
}

struct Args { const float* in[23]; float* out; unsigned char* ws; int ph_lo, ph_hi; };
struct Frame {
    LAS unsigned char* lds;
    int tid, lane, wave, G, bid;
    const Args* a;
    __device__ __forceinline__ const float* x() const { return a->in[0]; }
    __device__ __forceinline__ const float* c() const { return a->in[1]; }
    __device__ __forceinline__ const float* ada_w() const { return a->in[2]; }
    __device__ __forceinline__ const float* ada_b() const { return a->in[3]; }
    __device__ __forceinline__ const float* g_mix() const { return a->in[4]; }
    __device__ __forceinline__ const float* w_in() const { return a->in[5]; }
    __device__ __forceinline__ const float* lbg_f() const { return a->in[6]; }
    __device__ __forceinline__ const float* lbg_b() const { return a->in[7]; }
    __device__ __forceinline__ const float* hnorm_g() const { return a->in[8]; }
    __device__ __forceinline__ const float* conv_w() const { return a->in[9]; }
    __device__ __forceinline__ const float* conv_b() const { return a->in[10]; }
    __device__ __forceinline__ const float* cln_g() const { return a->in[11]; }
    __device__ __forceinline__ const float* cln_b() const { return a->in[12]; }
    __device__ __forceinline__ const float* w_out() const { return a->in[13]; }
    __device__ __forceinline__ const float* g_ffn() const { return a->in[14]; }
    __device__ __forceinline__ const float* wq() const { return a->in[15]; }
    __device__ __forceinline__ const float* keys1() const { return a->in[16]; }
    __device__ __forceinline__ const float* keys2() const { return a->in[17]; }
    __device__ __forceinline__ const float* utab() const { return a->in[18]; }
    __device__ __forceinline__ const float* vtab() const { return a->in[19]; }
    __device__ __forceinline__ const float* fada_w() const { return a->in[20]; }
    __device__ __forceinline__ const float* fada_b() const { return a->in[21]; }
    __device__ __forceinline__ const float* fnorm_g() const { return a->in[22]; }
    __device__ __forceinline__ float* out() const { return a->out; }
    __device__ __forceinline__ float* mod() const { return (float*)(a->ws + WS_MOD); }
    __device__ __forceinline__ float* fmod() const { return (float*)(a->ws + WS_FMOD); }
    __device__ __forceinline__ float* lb() const { return (float*)(a->ws + WS_LB); }
    __device__ __forceinline__ float* biasq() const { return (float*)(a->ws + WS_BIASQ); }
    __device__ __forceinline__ float* ssqp() const { return (float*)(a->ws + WS_SSQ); }
    __device__ __forceinline__ float* sega() const { return (float*)(a->ws + WS_SEGA); }
    __device__ __forceinline__ float* segu() const { return (float*)(a->ws + WS_SEG); }
    __device__ __forceinline__ float* of() const { return (float*)(a->ws + WS_BUFB); }
    __device__ __forceinline__ float* scores() const { return (float*)(a->ws + WS_BIG); }
    __device__ __forceinline__ float* wsel() const { return (float*)(a->ws + WS_W); }
    __device__ __forceinline__ int* esel() const { return (int*)(a->ws + WS_E); }
    __device__ __forceinline__ bf16* Win_t() const { return (bf16*)(a->ws + WS_WIN); }
    __device__ __forceinline__ bf16* Wout_t() const { return (bf16*)(a->ws + WS_WOUT); }
    __device__ __forceinline__ bf16* Wqk_t() const { return (bf16*)(a->ws + WS_WQK); }
    __device__ __forceinline__ bf16* Ub() const { return (bf16*)(a->ws + WS_UT); }
    __device__ __forceinline__ bf16* Vb() const { return (bf16*)(a->ws + WS_VT); }
    __device__ __forceinline__ bf16* bufA() const { return (bf16*)(a->ws + WS_BUFA); }
    __device__ __forceinline__ bf16* hg() const { return (bf16*)(a->ws + WS_BUFB); }
    __device__ __forceinline__ bf16* proj() const { return (bf16*)(a->ws + WS_BIG); }
    __device__ __forceinline__ float* coef() const { return (float*)(a->ws + WS_BUFA); }
    __device__ __forceinline__ float* rstd() const { return (float*)(a->ws + WS_RSTD); }
    __device__ __forceinline__ bf16* pact() const { return (bf16*)(a->ws + WS_PACT); }
    __device__ __forceinline__ bf16* ybuf() const { return (bf16*)(a->ws + WS_Y); }
    __device__ __forceinline__ unsigned char* U8() const { return (unsigned char*)(a->ws + WS_UT); }
    __device__ __forceinline__ unsigned char* V8() const { return (unsigned char*)(a->ws + WS_VT); }
    __device__ __forceinline__ unsigned* ctl() const { return (unsigned*)(a->ws + WS_CTL); }
};

__device__ __forceinline__ void p0_gemv(Frame& F) {
    LAS float* cact = (LAS float*)(F.lds);
    LAS float* red = (LAS float*)(F.lds + 16384);
    for (int i = F.tid; i < 4096; i += NTHR) { const float c = F.c()[i]; cact[i] = c * sigmoidf_(c); }
    __syncthreads();
    for (int item = F.bid; item < 128; item += F.G) {
        const int col0 = item * 64; const float* W; int N, cc;
        if (col0 < 6144) { W = F.ada_w(); N = 6144; cc = col0; } else { W = F.fada_w(); N = 2048; cc = col0 - 6144; }
        const float* wp = W + (size_t)(F.wave * 128) * N + cc + F.lane;
        float a0 = 0.f, a1 = 0.f, a2 = 0.f, a3 = 0.f;
#pragma unroll 32
        for (int k = 0; k < 128; ++k) { const float w = wp[(size_t)k * N]; const int kk = F.wave * 128 + k;
            a0 += cact[kk] * w; a1 += cact[1024 + kk] * w; a2 += cact[2048 + kk] * w; a3 += cact[3072 + kk] * w; }
        red[(F.wave * 4 + 0) * 64 + F.lane] = a0; red[(F.wave * 4 + 1) * 64 + F.lane] = a1; red[(F.wave * 4 + 2) * 64 + F.lane] = a2; red[(F.wave * 4 + 3) * 64 + F.lane] = a3;
        __syncthreads();
        if (F.tid < 256) { const int b = F.tid >> 6, l = F.tid & 63; float s = 0.f;
#pragma unroll
            for (int w = 0; w < 8; ++w) s += red[(w * 4 + b) * 64 + l];
            if (col0 < 6144) F.mod()[b * 6144 + cc + l] = s + F.ada_b()[cc + l]; else F.fmod()[b * 2048 + cc + l] = s + F.fada_b()[cc + l]; }
        __syncthreads();
    }
}
__device__ __forceinline__ void p0_transpose_item(const float* W, int K, int N, bf16* WT, LAS float* scr, int item, int lane) {
    const int nblk = N / 32, kb = item / nblk, nb = item % nblk, k0 = 64 * kb, n0 = 32 * nb;
#pragma unroll
    for (int i = 0; i < 32; ++i) { const int kk = 2 * i + (lane >> 5); scr[kk * 33 + (lane & 31)] = W[(size_t)(k0 + kk) * N + n0 + (lane & 31)]; }
    asm volatile("s_waitcnt lgkmcnt(0)" ::: "memory");
    const int c = lane & 7;
#pragma unroll
    for (int j = 0; j < 4; ++j) { const int n = (lane >> 3) + 8 * j; const LAS float* s = scr + (8 * c) * 33 + n;
        v4u o; o.x = pk2(s[0 * 33], s[1 * 33]); o.y = pk2(s[2 * 33], s[3 * 33]); o.z = pk2(s[4 * 33], s[5 * 33]); o.w = pk2(s[6 * 33], s[7 * 33]);
        *(v4u*)(WT + (size_t)(n0 + n) * K + k0 + 8 * c) = o; }
    asm volatile("s_waitcnt lgkmcnt(0)" ::: "memory");
}
__device__ __forceinline__ void p0_wqk_item(Frame& F, int item, LAS float* scr) {
    const int jq = item & 7, kb = (item >> 3) & 15, hh = item >> 7, h = hh >> 1, half = hh & 1;
    const float* keys = (half ? F.keys2() : F.keys1()) + (size_t)(jq * 16) * 128;
    const float* wtile = F.wq() + (size_t)(kb * 64) * 2048 + h * 256 + half * 128;
    LAS float* kL = scr + 1280;
    { f32x4 k4[8];
#pragma unroll
      for (int i = 0; i < 8; ++i) k4[i] = *(const f32x4*)(keys + (i * 64 + F.lane) * 4);
#pragma unroll
      for (int i = 0; i < 8; ++i) *(LAS f32x4*)(kL + (i * 64 + F.lane) * 4) = k4[i]; }
    float acc[16];
#pragma unroll
    for (int j = 0; j < 16; ++j) acc[j] = 0.f;
    f32x4 t4[4], n4[4];
#pragma unroll
    for (int i = 0; i < 4; ++i) t4[i] = *(const f32x4*)(wtile + (size_t)(16 * i + (F.lane >> 2)) * 2048 + 4 * (F.lane & 3));
    for (int d0 = 0; d0 < 128; d0 += 16) {
        if (d0 + 16 < 128) {
#pragma unroll
            for (int i = 0; i < 4; ++i) n4[i] = *(const f32x4*)(wtile + (size_t)(16 * i + (F.lane >> 2)) * 2048 + d0 + 16 + 4 * (F.lane & 3)); }
#pragma unroll
        for (int i = 0; i < 4; ++i) *(LAS f32x4*)(scr + (16 * i + (F.lane >> 2)) * 20 + 4 * (F.lane & 3)) = t4[i];
        asm volatile("s_waitcnt lgkmcnt(0)" ::: "memory");
#pragma unroll
        for (int dd = 0; dd < 16; dd += 4) { const f32x4 a = *(LAS const f32x4*)(scr + F.lane * 20 + dd);
#pragma unroll
            for (int j = 0; j < 16; ++j) { const f32x4 kp = *(LAS const f32x4*)(kL + j * 128 + d0 + dd); acc[j] += a[0] * kp[0] + a[1] * kp[1] + a[2] * kp[2] + a[3] * kp[3]; } }
        asm volatile("s_waitcnt lgkmcnt(0)" ::: "memory");
#pragma unroll
        for (int i = 0; i < 4; ++i) t4[i] = n4[i];
    }
    bf16* o = F.Wqk_t() + (size_t)(h * 256 + half * 128 + jq * 16) * 1024 + kb * 64 + F.lane;
#pragma unroll
    for (int j = 0; j < 16; ++j) o[(size_t)j * 1024] = (bf16)f2bf(acc[j]);
}
__device__ __forceinline__ void p0_prologue(Frame& F) {
    if (F.bid < 128) p0_gemv(F);
    if (F.bid == 128 % F.G) { const int i = F.tid;
        F.lb()[i] = __builtin_amdgcn_rcpf(1.0f + __expf(F.lbg_f()[512 + i] - F.lbg_f()[i]));
        F.lb()[512 + i] = __builtin_amdgcn_rcpf(1.0f + __expf(F.lbg_b()[512 + i] - F.lbg_b()[i])); }
    LAS float* scr = (LAS float*)(F.lds + 32768 + F.wave * 14336);
    const int gw = F.wave * F.G + F.bid, NGW = F.G * NWAVES;
    constexpr int I_QK = 2048, I_IN = (D / 64) * (NIN / 32), I_OUT = (D / 64) * (D / 32), I_TAB = 2 * 16384 / 4;
    constexpr int NITEMS = I_QK + I_IN + I_OUT + I_TAB;
    for (int it = gw; it < NITEMS; it += NGW) {
        int r = it;
        if (r < I_QK) { p0_wqk_item(F, r, scr); continue; } r -= I_QK;
        if (r < I_IN) { p0_transpose_item(F.w_in(), D, NIN, F.Win_t(), scr, r, F.lane); continue; } r -= I_IN;
        if (r < I_OUT) { p0_transpose_item(F.w_out(), D, D, F.Wout_t(), scr, r, F.lane); continue; } r -= I_OUT;
        { const int tab = r >= 4096, rr = (tab ? r - 4096 : r) * 4; const float* src = (tab ? F.vtab() : F.utab()) + (size_t)rr * 1024; unsigned char* dst = tab ? F.V8() : F.U8();
          const float sc = tab ? VSCALE : UQSCALE;
#pragma unroll
          for (int q = 0; q < 16; ++q) { const int row = rr + (q >> 2), qq = q & 3; const f32x4 v = *(const f32x4*)(src + (q >> 2) * 1024 + qq * 256 + 4 * F.lane) * sc;
              int pk;
              if (tab) { pk = __builtin_amdgcn_cvt_pk_fp8_f32(v[0], v[1], 0, false); pk = __builtin_amdgcn_cvt_pk_fp8_f32(v[2], v[3], pk, true); }
              else { int q0 = (int)__builtin_rintf(v[0]), q1 = (int)__builtin_rintf(v[1]), q2 = (int)__builtin_rintf(v[2]), q3 = (int)__builtin_rintf(v[3]);
                  q0 = q0 < -7 ? -7 : (q0 > 7 ? 7 : q0); q1 = q1 < -7 ? -7 : (q1 > 7 ? 7 : q1); q2 = q2 < -7 ? -7 : (q2 > 7 ? 7 : q2); q3 = q3 < -7 ? -7 : (q3 > 7 ? 7 : q3);
                  *(unsigned short*)(dst + ((size_t)qq * 16384 + row) * 128 + 2 * F.lane) = (unsigned short)((q0 & 0xf) | ((q1 & 0xf) << 4) | ((q2 & 0xf) << 8) | ((q3 & 0xf) << 12)); continue; }
              const int sl = 2 * qq + (F.lane >> 5);
              *(int*)(dst + ((size_t)sl * 16384 + row) * CSL + 4 * (F.lane & 31)) = pk; } }
    }
}

__device__ __forceinline__ void p1_norm(Frame& F) {
    const int gwc = F.bid * NWAVES + F.wave, NGW = F.G * NWAVES;
    for (int row0 = gwc * 16; row0 < T; row0 += NGW * 16) {
        const int b = row0 >> 13; const float* mb = F.mod() + b * 6144;
        f32x4 ca[4], cb[4];
#pragma unroll
        for (int j = 0; j < 4; ++j) { const int k = 256 * j + 4 * F.lane; const f32x4 g = *(const f32x4*)(F.g_mix() + k), s = *(const f32x4*)(mb + 1024 + k); ca[j] = g * (s + 1.0f); cb[j] = *(const f32x4*)(mb + k); }
#pragma unroll 4
        for (int r = 0; r < 16; ++r) { const float* xr = F.x() + (size_t)(row0 + r) * D;
            f32x4 v[4]; float ss = 0.f;
#pragma unroll
            for (int j = 0; j < 4; ++j) { v[j] = *(const f32x4*)(xr + 256 * j + 4 * F.lane); ss += v[j][0] * v[j][0] + v[j][1] * v[j][1] + v[j][2] * v[j][2] + v[j][3] * v[j][3]; }
            const float rstd = __builtin_amdgcn_rsqf(wave_sum(ss) * (1.0f / D) + EPS);
            bf16* o = F.bufA() + (size_t)(row0 + r) * D;
#pragma unroll
            for (int j = 0; j < 4; ++j) { const f32x4 y = v[j] * rstd * ca[j] + cb[j]; v2u w; w.x = pk2(y[0], y[1]); w.y = pk2(y[2], y[3]); *(v2u*)(o + 256 * j + 4 * F.lane) = w; } }
    }
    const int gw = F.wave * F.G + F.bid;
    for (int n0 = gw * 32; n0 < NQK; n0 += NGW * 32) {
        float sv[4][16];
#pragma unroll
        for (int b = 0; b < 4; ++b) { const float* sh2 = F.mod() + b * 6144 + 3072;
#pragma unroll
            for (int i = 0; i < 8; ++i) { sv[b][i] = sh2[8 * F.lane + i]; sv[b][8 + i] = sh2[512 + 8 * F.lane + i]; } }
        float res[4] = {0.f, 0.f, 0.f, 0.f};
        for (int q = 0; q < 32; ++q) { const int n = n0 + q;
            const v4u w0 = *(const v4u*)(F.Wqk_t() + (size_t)n * 1024 + 8 * F.lane), w1 = *(const v4u*)(F.Wqk_t() + (size_t)n * 1024 + 512 + 8 * F.lane);
            float wv[16];
#pragma unroll
            for (int i = 0; i < 4; ++i) { wv[2 * i] = bflo(w0[i]); wv[2 * i + 1] = bfhi(w0[i]); wv[8 + 2 * i] = bflo(w1[i]); wv[8 + 2 * i + 1] = bfhi(w1[i]); }
#pragma unroll
            for (int b = 0; b < 4; ++b) { float sm = 0.f;
#pragma unroll
                for (int i = 0; i < 16; ++i) sm += wv[i] * sv[b][i];
                sm = wave_sum(sm); if (F.lane == q) res[b] = sm; } }
        if (F.lane < 32) {
#pragma unroll
            for (int b = 0; b < 4; ++b) F.biasq()[b * 2048 + n0 + F.lane] = res[b]; }
    }
}

__device__ __forceinline__ void conv_item(Frame& F, int item, const float (&cw)[CW], float cbias) {
    LAS bf16* hbuf = (LAS bf16*)(F.lds);
    LAS float* ybuf = (LAS float*)(F.lds + 65536);
    const int tok0 = item * 32, b = tok0 >> 13, t0 = tok0 & (SEQ - 1), c = F.tid;
#pragma unroll
    for (int k = 0; k < 8; ++k) { const int pi = F.tid + NTHR * k; if (pi < 62 * 64) { const int r = pi >> 6, ch = pi & 63, t = t0 - CPAD + r; v4u o = {0u, 0u, 0u, 0u};
            if (t >= 0 && t < SEQ) { const bf16* pr = F.proj() + (size_t)(b * SEQ + t) * NIN + 8 * ch; const v4u a = *(const v4u*)(pr + 2560), g = *(const v4u*)(pr + 3072);
#pragma unroll
                for (int i = 0; i < 4; ++i) o[i] = cvtpk(bflo(a[i]) * bflo(g[i]), bfhi(a[i]) * bfhi(g[i])); }
            *(LAS v4u*)(hbuf + r * 512 + 8 * ch) = o; } }
    __syncthreads();
    float hv[62];
#pragma unroll
    for (int r = 0; r < 62; ++r) hv[r] = bf2f(hbuf[r * 512 + c]);
#pragma unroll
    for (int tt = 0; tt < 32; ++tt) { float acc = cbias;
#pragma unroll
        for (int j = 0; j < CW; ++j) acc += cw[j] * hv[tt + j];
        ybuf[tt * 512 + c] = acc; }
    __syncthreads();
#pragma unroll
    for (int q = 0; q < 4; ++q) { const int tt = F.wave * 4 + q;
        const f32x4 y0 = *(LAS const f32x4*)(ybuf + tt * 512 + 8 * F.lane), y1 = *(LAS const f32x4*)(ybuf + tt * 512 + 8 * F.lane + 4);
        const float mean = wave_sum((y0[0] + y0[1] + y0[2] + y0[3]) + (y1[0] + y1[1] + y1[2] + y1[3])) * (1.0f / DC);
        const f32x4 d0 = y0 - mean, d1 = y1 - mean;
        const float var = wave_sum((d0[0] * d0[0] + d0[1] * d0[1] + d0[2] * d0[2] + d0[3] * d0[3]) + (d1[0] * d1[0] + d1[1] * d1[1] + d1[2] * d1[2] + d1[3] * d1[3])) * (1.0f / DC);
        const float rstd = __builtin_amdgcn_rsqf(var + EPS);
        const f32x4 g0 = *(const f32x4*)(F.cln_g() + 8 * F.lane), g1 = *(const f32x4*)(F.cln_g() + 8 * F.lane + 4), b0 = *(const f32x4*)(F.cln_b() + 8 * F.lane), b1 = *(const f32x4*)(F.cln_b() + 8 * F.lane + 4);
        f32x4 z0 = d0 * rstd * g0 + b0, z1 = d1 * rstd * g1 + b1;
#pragma unroll
        for (int i = 0; i < 4; ++i) { z0[i] = z0[i] * sigmoidf_(z0[i]); z1[i] = z1[i] * sigmoidf_(z1[i]); }
        v4u w; w.x = cvtpk(z0[0], z0[1]); w.y = cvtpk(z0[2], z0[3]); w.z = cvtpk(z1[0], z1[1]); w.w = cvtpk(z1[2], z1[3]);
        *(v4u*)(F.bufA() + (size_t)(tok0 + tt) * D + 512 + 8 * F.lane) = w; }
    __syncthreads();
}

constexpr int PQ = 272, PT = 144;
constexpr int HL_QR = 0, HL_KR = 17408, HL_QE = 34816, HL_KET = 52224, HL_VT = 70656, HL_SCM = 89088, HL_ST = 98304, HL_PBLK = 133120  , HL_AV = 137216, HL_RS = 137728;
static_assert(HL_PBLK + 8 * 128 * 4 <= HL_AV && HL_AV + 512 <= HL_RS && HL_RS + 1024 <= 155648 - 256, "HGRN LDS map");
__device__ __forceinline__ bf16x8 ldf(LAS const unsigned char* base, int row, int pitch, int kbyte) { return *(LAS const bf16x8*)(base + row * pitch + kbyte); }
#define MFMA32(a, b, c) __builtin_amdgcn_mfma_f32_32x32x16_bf16((a), (b), (c), 0, 0, 0)

template <bool FULL>
__device__ __forceinline__ void hgrn_load(Frame& F, int b, int h, int dir, int chunk, unsigned (&rz)[8], unsigned (&rv)[8], unsigned (&rq)[8]) {
    const size_t tokbase = (size_t)b * SEQ + (size_t)chunk * CHK; const int zoff = dir ? 1024 : 512, c0 = 2 * F.lane;
#pragma unroll
    for (int i = 0; i < 8; ++i) { const int p = 8 * F.wave + i, tr = dir ? (63 - p) : p; const bf16* q = F.proj() + (tokbase + tr) * NIN + h * HD;
        rz[i] = *(const unsigned*)(q + zoff + c0); rv[i] = *(const unsigned*)(q + 1536 + c0); if (FULL) rq[i] = *(const unsigned*)(q + c0); }
}
template <bool FULL, int MODE>
__device__ __forceinline__ void hgrn_chunk(Frame& F, int b, int h, int dir, int chunk, int nchunk, f32x16 (&accS)[2], float lb0, float lb1, unsigned (&rz)[8], unsigned (&rv)[8], unsigned (&rq)[8]) {
    LAS unsigned char* lds = F.lds;
    int r = F.lane & 31, hh = F.lane >> 5, c0 = 2 * F.lane;
    asm volatile("" : "+v"(r), "+v"(hh), "+v"(c0));
    const int w = F.wave, rb = w;
    const size_t tokbase = (size_t)b * SEQ + (size_t)chunk * CHK;
    {
        const f32x2_ oml = {1.0f - lb0, 1.0f - lb1};
        f32x2_ f2[8], cf2[8], cr2[8];
        f32x2_ run = {1.f, 1.f};
#pragma unroll
        for (int i = 0; i < 8; ++i) { const f32x2_ kk = {bflo(rz[i]), bfhi(rz[i])}; f2[i] = 1.0f - oml * kk; run *= f2[i]; cf2[i] = run; }
        { f32x2_ q = {1.f, 1.f};
#pragma unroll
          for (int i = 7; i >= 0; --i) { cr2[i] = q; q *= f2[i]; } }
        LAS float* pblk = (LAS float*)(lds + HL_PBLK);
        *(LAS f32x2_*)(pblk + rb * 128 + c0) = run;
        __syncthreads();
        f32x2_ pre = {1.f, 1.f}, post = {1.f, 1.f}, mid = {1.f, 1.f};
        for (int q = 0; q < rb; ++q) pre *= *(LAS const f32x2_*)(pblk + q * 128 + c0);
        for (int q = rb + 1; q < 8; ++q) post *= *(LAS const f32x2_*)(pblk + q * 128 + c0);
        if (rb < 4) { for (int q = rb + 1; q < 4; ++q) mid *= *(LAS const f32x2_*)(pblk + q * 128 + c0); }
        else { for (int q = 4; q < rb; ++q) mid *= *(LAS const f32x2_*)(pblk + q * 128 + c0); }
        if (rb == 0) *(LAS f32x2_*)((LAS float*)(lds + HL_AV) + c0) = run * post;
        f32x2_ ke2[8];
#pragma unroll
        for (int i = 0; i < 8; ++i) ke2[i] = (1.0f - f2[i]) * cr2[i] * post;
        if (FULL) {
            if (rb < 4) {
#pragma unroll
                for (int i = 0; i < 8; ++i) { const int p = 8 * rb + i; const f32x2_ qs = {bflo(rq[i]), bfhi(rq[i])}, k2 = 1.0f - f2[i], G = cr2[i] * mid;
                    f32x2_ iG; iG[0] = __builtin_amdgcn_rcpf(G[0]); iG[1] = __builtin_amdgcn_rcpf(G[1]);
                    const f32x2_ qe = qs * pre * cf2[i], qr = qs * iG, kr = k2 * G;
                    *(LAS unsigned*)(lds + HL_QE + p * PQ + c0 * 2) = cvtpk(qe[0], qe[1]);
                    *(LAS unsigned*)(lds + HL_QR + p * PQ + c0 * 2) = cvtpk(qr[0], qr[1]);
                    *(LAS unsigned*)(lds + HL_KR + p * PQ + c0 * 2) = cvtpk(kr[0], kr[1]); }
            } else {
#pragma unroll
                for (int i = 0; i < 8; ++i) { const int p = 8 * rb + i; const f32x2_ qs = {bflo(rq[i]), bfhi(rq[i])}, k2 = 1.0f - f2[i], G = cf2[i] * mid;
                    f32x2_ iG; iG[0] = __builtin_amdgcn_rcpf(G[0]); iG[1] = __builtin_amdgcn_rcpf(G[1]);
                    const f32x2_ qe = qs * pre * cf2[i], qr = qs * G, kr = k2 * iG;
                    *(LAS unsigned*)(lds + HL_QE + p * PQ + c0 * 2) = cvtpk(qe[0], qe[1]);
                    *(LAS unsigned*)(lds + HL_QR + p * PQ + c0 * 2) = cvtpk(qr[0], qr[1]);
                    *(LAS unsigned*)(lds + HL_KR + p * PQ + c0 * 2) = cvtpk(kr[0], kr[1]); }
            }
        }
        v4u ka, kb, va, vb2;
        ka.x = cvtpk(ke2[0][0], ke2[1][0]); ka.y = cvtpk(ke2[2][0], ke2[3][0]); ka.z = cvtpk(ke2[4][0], ke2[5][0]); ka.w = cvtpk(ke2[6][0], ke2[7][0]);
        kb.x = cvtpk(ke2[0][1], ke2[1][1]); kb.y = cvtpk(ke2[2][1], ke2[3][1]); kb.z = cvtpk(ke2[4][1], ke2[5][1]); kb.w = cvtpk(ke2[6][1], ke2[7][1]);
        va.x = (rv[0] & 0xffffu) | (rv[1] << 16); va.y = (rv[2] & 0xffffu) | (rv[3] << 16); va.z = (rv[4] & 0xffffu) | (rv[5] << 16); va.w = (rv[6] & 0xffffu) | (rv[7] << 16);
        vb2.x = (rv[0] >> 16) | (rv[1] & 0xffff0000u); vb2.y = (rv[2] >> 16) | (rv[3] & 0xffff0000u); vb2.z = (rv[4] >> 16) | (rv[5] & 0xffff0000u); vb2.w = (rv[6] >> 16) | (rv[7] & 0xffff0000u);
        *(LAS v4u*)(lds + HL_KET + c0 * PT + 16 * rb) = ka; *(LAS v4u*)(lds + HL_KET + (c0 + 1) * PT + 16 * rb) = kb;
        *(LAS v4u*)(lds + HL_VT + c0 * PT + 16 * rb) = va; *(LAS v4u*)(lds + HL_VT + (c0 + 1) * PT + 16 * rb) = vb2;
    }
    if (nchunk >= 0) hgrn_load<FULL>(F, b, h, dir, nchunk, rz, rv, rq);
    __syncthreads();
    const int pbO = w & 1, vb = w >> 1;
    f32x16 accO, accU[2];
#pragma unroll
    for (int i = 0; i < 16; ++i) { accO[i] = 0.f; accU[0][i] = 0.f; accU[1][i] = 0.f; }
    if (FULL) {
        if (w < 3) { const int pbS = (w + 1) >> 1, sbS = (w == 2) ? 1 : 0; f32x16 sc;
#pragma unroll
            for (int i = 0; i < 16; ++i) sc[i] = 0.f;
#pragma unroll
            for (int s = 0; s < 8; ++s) sc = MFMA32(ldf(lds + HL_QR, pbS * 32 + r, PQ, 32 * s + 16 * hh), ldf(lds + HL_KR, sbS * 32 + r, PQ, 32 * s + 16 * hh), sc);
#pragma unroll
            for (int i = 0; i < 16; i += 2) { const int p = pbS * 32 + (i & 3) + 8 * (i >> 2) + 4 * hh, s = sbS * 32 + r;
                const unsigned pkd = cvtpk(s <= p ? sc[i] : 0.f, s <= p + 1 ? sc[i + 1] : 0.f);
                *(LAS bf16*)(lds + HL_SCM + p * PT + s * 2) = (bf16)pkd; *(LAS bf16*)(lds + HL_SCM + (p + 1) * PT + s * 2) = (bf16)(pkd >> 16); } }
        __builtin_amdgcn_sched_barrier(0);
#pragma unroll
        for (int s = 0; s < 8; ++s) accO = MFMA32(ldf(lds + HL_QE, pbO * 32 + r, PQ, 32 * s + 16 * hh), ldf(lds + HL_ST, vb * 32 + r, PQ, 32 * s + 16 * hh), accO);
        __builtin_amdgcn_sched_barrier(0);
    }
#pragma unroll
    for (int i = 0; i < 2; ++i) { const int db = 2 * (w & 1) + i;
#pragma unroll
        for (int s = 0; s < 4; ++s) accU[i] = MFMA32(ldf(lds + HL_VT, vb * 32 + r, PT, 32 * s + 16 * hh), ldf(lds + HL_KET, db * 32 + r, PT, 32 * s + 16 * hh), accU[i]); }
    __builtin_amdgcn_sched_barrier(0);
    if (FULL) __syncthreads();
    if (FULL) {
        const unsigned v = vb * 32 + r;
        const unsigned lrow = (MODE == 0 ? (unsigned)hh : (unsigned)(1 - hh)) * 4u;
        const size_t rbase = (MODE == 0) ? (tokbase + pbO * 32) : (tokbase + 63 - pbO * 32 - 4);
        const unsigned lo_of = lrow * DH + v, lo_pr = lrow * NIN + v, lo_a2 = lrow * D + v;
        float ofv[16]; unsigned gv[16];
        if (MODE == 1) {
#pragma unroll
            for (int i = 0; i < 16; ++i) { const int ci = (i & 3) + 8 * (i >> 2); ofv[i] = (F.of() + (rbase - ci) * DH + h * HD)[lo_of]; } }
        for (int sb = 0; sb <= pbO; ++sb)
#pragma unroll
            for (int s2 = 0; s2 < 2; ++s2) accO = MFMA32(ldf(lds + HL_SCM, pbO * 32 + r, PT, 64 * sb + 32 * s2 + 16 * hh), ldf(lds + HL_VT, vb * 32 + r, PT, 64 * sb + 32 * s2 + 16 * hh), accO);
        if (MODE == 0) {
#pragma unroll
            for (int i = 0; i < 16; ++i) { const int ci = (i & 3) + 8 * (i >> 2); (F.of() + (rbase + ci) * DH + h * HD)[lo_of] = accO[i]; }
        } else {
            LAS float* rs = (LAS float*)(lds + HL_RS);
#pragma unroll
            for (int i = 0; i < 16; ++i) { const int ci = (i & 3) + 8 * (i >> 2); gv[i] = (F.proj() + (rbase - ci) * NIN + 2048 + h * HD)[lo_pr]; }
            float ov[16];
#pragma unroll
            for (int i = 0; i < 16; ++i) { const int ci = (i & 3) + 8 * (i >> 2), p = pbO * 32 + ci + 4 * hh;
                ov[i] = accO[i] + ofv[i]; float ss = ov[i] * ov[i];
                ss = DPP_ADD(ss, 0x128); ss = DPP_ADD(ss, 0x124); ss = DPP_ADD(ss, 0x122); ss = DPP_ADD(ss, 0x121); ss += __shfl_xor(ss, 16);
                if (r == 0) rs[p * 4 + vb] = ss; }
            __syncthreads();
            const float ng = F.hnorm_g()[h * HD + v];
#pragma unroll
            for (int i = 0; i < 16; ++i) { const int ci = (i & 3) + 8 * (i >> 2), p = pbO * 32 + ci + 4 * hh;
                const f32x4 q = *(LAS const f32x4*)(rs + p * 4);
                const float rstd = __builtin_amdgcn_rsqf((q[0] + q[1] + q[2] + q[3]) * (1.0f / HD) + EPS);
                const float g = bf2f(gv[i]);
                (F.bufA() + (rbase - ci) * D + h * HD)[lo_a2] = (bf16)cvtpk(ov[i] * rstd * ng * g, 0.f); }
        }
    }
    {
        const LAS float* av = (const LAS float*)(lds + HL_AV);
#pragma unroll
        for (int i = 0; i < 2; ++i) { const int db = 2 * (w & 1) + i; const float a = av[db * 32 + r];
#pragma unroll
            for (int j = 0; j < 16; j += 2) { const float s0 = accS[i][j] * a + accU[i][j], s1 = accS[i][j + 1] * a + accU[i][j + 1]; accS[i][j] = s0; accS[i][j + 1] = s1;
                if (FULL) { const int vv = vb * 32 + (j & 3) + 8 * (j >> 2) + 4 * hh; const unsigned pkd = cvtpk(s0, s1);
                    *(LAS bf16*)(lds + HL_ST + vv * PQ + (db * 32 + r) * 2) = (bf16)pkd; *(LAS bf16*)(lds + HL_ST + (vv + 1) * PQ + (db * 32 + r) * 2) = (bf16)(pkd >> 16); } } }
    }
    __syncthreads();
}
__device__ __forceinline__ void h1_item(Frame& F, int item) {
    const int seg = item & 15, dir = (item >> 4) & 1, h = (item >> 5) & 3, b = item >> 7;
    const float lb0 = F.lb()[dir * 512 + h * HD + 2 * F.lane], lb1 = F.lb()[dir * 512 + h * HD + 2 * F.lane + 1];
    f32x16 accS[2];
#pragma unroll
    for (int i = 0; i < 16; ++i) { accS[0][i] = 0.f; accS[1][i] = 0.f; }
    float atot = 1.f; const int col = F.tid & 127;
    unsigned rzA[8], rvA[8], rzB[8], rvB[8], rq[8];
#define H1CH(c) (seg * SEGC + (dir ? (SEGC - 1 - (c)) : (c)))
    hgrn_load<false>(F, b, h, dir, H1CH(0), rzA, rvA, rq); hgrn_load<false>(F, b, h, dir, H1CH(1), rzB, rvB, rq);
    for (int c = 0; c < SEGC; c += 2) {
        hgrn_chunk<false, 0>(F, b, h, dir, H1CH(c), (c + 2 < SEGC) ? H1CH(c + 2) : -1, accS, lb0, lb1, rzA, rvA, rq);
        atot *= ((const LAS float*)(F.lds + HL_AV))[col];
        hgrn_chunk<false, 0>(F, b, h, dir, H1CH(c + 1), (c + 3 < SEGC) ? H1CH(c + 3) : -1, accS, lb0, lb1, rzB, rvB, rq);
        atot *= ((const LAS float*)(F.lds + HL_AV))[col]; }
#undef H1CH
    if (F.tid < 128) F.sega()[(size_t)item * 128 + col] = atot;
    float* U = F.segu() + (size_t)item * 16384;
#pragma unroll
    for (int i = 0; i < 2; ++i)
#pragma unroll
        for (int j = 0; j < 16; j += 4) { f32x4 o; o[0] = accS[i][j]; o[1] = accS[i][j + 1]; o[2] = accS[i][j + 2]; o[3] = accS[i][j + 3]; ((f32x4*)(U + (i * 4 + (j >> 2)) * NTHR * 4))[F.tid] = o; }
}
__device__ __forceinline__ void h2_init_state(Frame& F, int b, int h, int dir, int seg, f32x16 (&accS)[2]) {
    const int w = F.wave, r = F.lane & 31, hh = F.lane >> 5, vb = w >> 1;
#pragma unroll
    for (int i = 0; i < 16; ++i) { accS[0][i] = 0.f; accS[1][i] = 0.f; }
    const int base = ((b * 4 + h) * 2 + dir) * 16;
    const int n = dir ? (NSEG - 1 - seg) : seg;
    for (int q0 = 0; q0 < n; q0 += 3) {
        f32x4 u4[3][8]; float av[3][2];
#pragma unroll
        for (int t = 0; t < 3; ++t) { const int q = (q0 + t < n) ? (q0 + t) : (n - 1); const int s = dir ? (NSEG - 1 - q) : q;
            const float* U = F.segu() + (size_t)(base + s) * 16384; const float* A = F.sega() + (size_t)(base + s) * 128;
#pragma unroll
            for (int i = 0; i < 2; ++i) av[t][i] = (A + (2 * (w & 1) + i) * 32)[r];
#pragma unroll
            for (int k = 0; k < 8; ++k) u4[t][k] = ((const f32x4*)(U + k * NTHR * 4))[F.tid]; }
#pragma unroll
        for (int t = 0; t < 3; ++t) { if (q0 + t < n) {
#pragma unroll
            for (int i = 0; i < 2; ++i) { const float a = av[t][i];
#pragma unroll
                for (int j = 0; j < 16; j += 4) { const f32x4 v = u4[t][i * 4 + (j >> 2)];
                    accS[i][j] = accS[i][j] * a + v[0]; accS[i][j + 1] = accS[i][j + 1] * a + v[1]; accS[i][j + 2] = accS[i][j + 2] * a + v[2]; accS[i][j + 3] = accS[i][j + 3] * a + v[3]; } } } }
    }
#pragma unroll
    for (int i = 0; i < 2; ++i) { const int db = 2 * (w & 1) + i;
#pragma unroll
        for (int j = 0; j < 16; ++j) { const int vv = vb * 32 + (j & 3) + 8 * (j >> 2) + 4 * hh; *(LAS bf16*)(F.lds + HL_ST + vv * PQ + (db * 32 + r) * 2) = (bf16)f2bf(accS[i][j]); } }
    __syncthreads();
}
__device__ __forceinline__ void h2_item(Frame& F, int item) {
    const int seg = item & 15, h = (item >> 4) & 3, b = item >> 6;
    f32x16 accS[2];
    unsigned rzA[8], rvA[8], rqA[8], rzB[8], rvB[8], rqB[8];
    { const float lb0 = F.lb()[h * HD + 2 * F.lane], lb1 = F.lb()[h * HD + 2 * F.lane + 1];
      const int c0 = seg * SEGC;
      hgrn_load<true>(F, b, h, 0, c0, rzA, rvA, rqA); hgrn_load<true>(F, b, h, 0, c0 + 1, rzB, rvB, rqB);
      h2_init_state(F, b, h, 0, seg, accS);
      for (int c = 0; c < SEGC; c += 2) {
          hgrn_chunk<true, 0>(F, b, h, 0, c0 + c, (c + 2 < SEGC) ? (c0 + c + 2) : -1, accS, lb0, lb1, rzA, rvA, rqA);
          hgrn_chunk<true, 0>(F, b, h, 0, c0 + c + 1, (c + 3 < SEGC) ? (c0 + c + 3) : -1, accS, lb0, lb1, rzB, rvB, rqB); } }
    asm volatile("s_waitcnt vmcnt(0)" ::: "memory");
    __syncthreads();
    { const float lb0 = F.lb()[512 + h * HD + 2 * F.lane], lb1 = F.lb()[512 + h * HD + 2 * F.lane + 1];
      const int cl = seg * SEGC + SEGC - 1;
      hgrn_load<true>(F, b, h, 1, cl, rzA, rvA, rqA); hgrn_load<true>(F, b, h, 1, cl - 1, rzB, rvB, rqB);
      h2_init_state(F, b, h, 1, seg, accS);
      for (int c = 0; c < SEGC; c += 2) {
          hgrn_chunk<true, 1>(F, b, h, 1, cl - c, (c + 2 < SEGC) ? (cl - c - 2) : -1, accS, lb0, lb1, rzA, rvA, rqA);
          hgrn_chunk<true, 1>(F, b, h, 1, cl - c - 1, (c + 3 < SEGC) ? (cl - c - 3) : -1, accS, lb0, lb1, rzB, rvB, rqB); } }
}

__device__ __forceinline__ unsigned f2key(float f) { const unsigned u = __builtin_bit_cast(unsigned, f); return (u & 0x80000000u) ? ~u : (u | 0x80000000u); }
__device__ __forceinline__ float key2f(unsigned k) { const unsigned u = (k & 0x80000000u) ? (k & 0x7fffffffu) : ~k; return __builtin_bit_cast(float, u); }
__device__ __forceinline__ unsigned umax_(unsigned a, unsigned b) { return a > b ? a : b; }
__device__ __forceinline__ unsigned umin_(unsigned a, unsigned b) { return a < b ? a : b; }
__device__ __forceinline__ void sort16(unsigned (&a)[16]) {
#define CE_(i, j) { const unsigned x_ = a[i], y_ = a[j]; a[i] = umax_(x_, y_); a[j] = umin_(x_, y_); }
    CE_(0, 13) CE_(1, 12) CE_(2, 15) CE_(3, 14) CE_(4, 8) CE_(5, 6) CE_(7, 11) CE_(9, 10)
    CE_(0, 5) CE_(1, 7) CE_(2, 9) CE_(3, 4) CE_(6, 13) CE_(8, 14) CE_(10, 15) CE_(11, 12)
    CE_(0, 1) CE_(2, 3) CE_(4, 5) CE_(6, 8) CE_(7, 9) CE_(10, 11) CE_(12, 13) CE_(14, 15)
    CE_(0, 2) CE_(1, 3) CE_(4, 10) CE_(5, 11) CE_(6, 7) CE_(8, 9) CE_(12, 14) CE_(13, 15)
    CE_(1, 2) CE_(3, 12) CE_(4, 6) CE_(5, 7) CE_(8, 10) CE_(9, 11) CE_(13, 14)
    CE_(1, 4) CE_(2, 6) CE_(5, 8) CE_(7, 10) CE_(9, 13) CE_(11, 14)
    CE_(2, 4) CE_(3, 6) CE_(9, 12) CE_(11, 13)
    CE_(3, 5) CE_(6, 8) CE_(7, 9) CE_(10, 12)
    CE_(3, 4) CE_(5, 6) CE_(7, 8) CE_(9, 10) CE_(11, 12)
    CE_(6, 7) CE_(8, 9)
#undef CE_
}
__device__ __forceinline__ void merge16(unsigned (&a)[16], const unsigned (&b)[16]) {
#pragma unroll
    for (int i = 0; i < 16; ++i) a[i] = umax_(a[i], b[15 - i]);
#pragma unroll
    for (int j = 8; j > 0; j >>= 1)
#pragma unroll
        for (int i = 0; i < 16; ++i) { const int l = i ^ j; if (l > i) { const unsigned x = a[i], y = a[l]; a[i] = umax_(x, y); a[l] = umin_(x, y); } }
}
__device__ __forceinline__ unsigned dpp_swap1(unsigned v) { return (unsigned)__builtin_amdgcn_update_dpp(0, (int)v, 0xB1, 0xF, 0xF, false); }
__device__ __forceinline__ unsigned pick_byte(const unsigned (&pk)[4], unsigned a) {
    const unsigned wsel = a >> 2; unsigned v = wsel == 0 ? pk[0] : (wsel == 1 ? pk[1] : (wsel == 2 ? pk[2] : pk[3]));
    return (v >> ((a & 3u) * 8u)) & 0xffu;
}
__device__ __forceinline__ void topk_stage2(const unsigned (&top)[16], bool tab0, size_t item, int* esel, float* wsel) {
        float vO[16], vP[16]; unsigned iOpk[4] = {0u, 0u, 0u, 0u}, iPpk[4] = {0u, 0u, 0u, 0u};
#pragma unroll
        for (int i = 0; i < 16; ++i) { const unsigned t = top[i], tp = dpp_swap1(t);
            vO[i] = key2f(t & ~0x7fu); vP[i] = key2f(tp & ~0x7fu);
            iOpk[i >> 2] |= (127u - (t & 0x7fu)) << ((i & 3) * 8); iPpk[i >> 2] |= (127u - (tp & 0x7fu)) << ((i & 3) * 8); }
        unsigned R[16], G1[16], G2[16], G3[16];
#define CAND(a, b) ((f2key(vO[a] + vP[b]) & ~0xffu) | (unsigned)(((a) << 4) | (b)))
#pragma unroll
        for (int i = 0; i < 16; ++i) R[i] = CAND(0, i);
        G1[0] = CAND(1, 0); G1[1] = CAND(1, 1); G1[2] = CAND(1, 2); G1[3] = CAND(1, 3); G1[4] = CAND(1, 4); G1[5] = CAND(1, 5); G1[6] = CAND(1, 6); G1[7] = CAND(1, 7);
        G1[8] = CAND(2, 0); G1[9] = CAND(2, 1); G1[10] = CAND(2, 2); G1[11] = CAND(2, 3); G1[12] = CAND(2, 4); G1[13] = CAND(3, 0); G1[14] = CAND(3, 1); G1[15] = CAND(3, 2);
        G2[0] = CAND(3, 3); G2[1] = CAND(4, 0); G2[2] = CAND(4, 1); G2[3] = CAND(4, 2); G2[4] = CAND(5, 0); G2[5] = CAND(5, 1); G2[6] = CAND(6, 0); G2[7] = CAND(6, 1);
        G2[8] = CAND(7, 0); G2[9] = CAND(7, 1); G2[10] = CAND(8, 0); G2[11] = CAND(9, 0); G2[12] = CAND(10, 0); G2[13] = CAND(11, 0); G2[14] = CAND(12, 0); G2[15] = CAND(13, 0);
        G3[0] = CAND(14, 0); G3[1] = CAND(15, 0);
#pragma unroll
        for (int i = 2; i < 16; ++i) G3[i] = 0u;
#undef CAND
        sort16(G1); sort16(G2); sort16(G3);
        merge16(R, G1); merge16(R, G2); merge16(R, G3);
        float sc[16], ex[16]; float sum = 0.f; unsigned eid[16];
        #pragma unroll
        for (int i = 0; i < 16; ++i) { sc[i] = key2f(R[i] & ~0xffu); const unsigned a = (R[i] >> 4) & 15u, bb = R[i] & 15u;
            const unsigned io = pick_byte(iOpk, a), ip = pick_byte(iPpk, bb);
            eid[i] = tab0 ? (io * 128u + ip) : (ip * 128u + io); }
#pragma unroll
        for (int i = 0; i < 16; ++i) { ex[i] = __expf(sc[i] - sc[0]); sum += ex[i]; }
        const float inv = 1.0f / sum;
        if (tab0) { const size_t o = item * 16;
#pragma unroll
            for (int q = 0; q < 4; ++q) { v4u ev; ev.x = eid[4 * q]; ev.y = eid[4 * q + 1]; ev.z = eid[4 * q + 2]; ev.w = eid[4 * q + 3]; *(v4u*)(esel + o + 4 * q) = ev;
                f32x4 wv; wv[0] = ex[4 * q] * inv; wv[1] = ex[4 * q + 1] * inv; wv[2] = ex[4 * q + 2] * inv; wv[3] = ex[4 * q + 3] * inv; *(f32x4*)(wsel + o + 4 * q) = wv; } }
}
__device__ __forceinline__ void p7_topk(Frame& F) {
    const int NT = T * PHEADS * 2;
    for (int g0 = (F.bid * NWAVES + F.wave) * 64; g0 < NT; g0 += F.G * NTHR) {
        const int g = g0 + F.lane; const float* wb = F.scores() + (size_t)g0 * 128;
        LAS float* stg = (LAS float*)(F.lds) + F.wave * (64 * 36);
        unsigned top[16];
#pragma unroll
        for (int sg = 0; sg < 4; ++sg) {
            f32x4 tl[8];
#pragma unroll
            for (int i = 0; i < 8; ++i) tl[i] = __builtin_nontemporal_load((const f32x4*)(wb + (size_t)(8 * i + (F.lane >> 3)) * 128 + sg * 32 + 4 * (F.lane & 7)));
#pragma unroll
            for (int i = 0; i < 8; ++i) *(LAS f32x4*)(stg + (8 * i + (F.lane >> 3)) * 36 + 4 * (F.lane & 7)) = tl[i];
            asm volatile("s_waitcnt lgkmcnt(0)" ::: "memory");
#pragma unroll
            for (int hg2 = 0; hg2 < 2; ++hg2) { const int grp = sg * 2 + hg2; unsigned k[16];
#pragma unroll
                for (int q = 0; q < 4; ++q) { const f32x4 v = *(LAS const f32x4*)(stg + F.lane * 36 + hg2 * 16 + q * 4);
#pragma unroll
                    for (int e = 0; e < 4; ++e) { const int j = grp * 16 + q * 4 + e; k[q * 4 + e] = (f2key(v[e]) & ~0x7fu) | (unsigned)(127 - j); } }
                sort16(k);
                if (grp == 0) {
#pragma unroll
                    for (int i = 0; i < 16; ++i) top[i] = k[i];
                } else merge16(top, k); }
            asm volatile("s_waitcnt lgkmcnt(0)" ::: "memory");
        }
        topk_stage2(top, (g & 1) == 0, (size_t)((g >> 1) & 7) * T + (size_t)(g >> 4), F.esel(), F.wsel());
    }
}


struct EpiScoreTopk {
    static constexpr bool PERM = false, AFTER_DRAIN = false;
    float* scr; const float* ssqp; const float* biasq; float* rstd_out; int* esel; float* wsel;
    __device__ __forceinline__ void operator()(const f32x4 (&acc)[2][2][4][2], const pg8::Unit& u, int wr, int wc, int fr, int fq) const {
        asm volatile("" : "+v"(fr), "+v"(fq));
        const int rl0 = wr * 64 + fr, col0 = wc * 32 + 4 * fq, b = (u.pm * 256) >> 13;
        f32x4 bv[2][2];
#pragma unroll
        for (int bj = 0; bj < 2; ++bj)
#pragma unroll
            for (int n = 0; n < 2; ++n) bv[bj][n] = *(const f32x4*)(biasq + b * 2048 + u.pn * 256 + col0 + bj * 128 + n * 16);
#pragma unroll
        for (int ai = 0; ai < 2; ++ai)
#pragma unroll
            for (int m = 0; m < 4; ++m) { const int rl = rl0 + ai * 128 + m * 16, row = u.pm * 256 + rl;
                const f32x4 p0 = *(const f32x4*)(ssqp + (size_t)row * 4), p1 = *(const f32x4*)(ssqp + ((size_t)32768 + row) * 4), p2 = *(const f32x4*)(ssqp + ((size_t)65536 + row) * 4), p3 = *(const f32x4*)(ssqp + ((size_t)98304 + row) * 4);
                const float tot = (p0[0] + p0[1] + p0[2] + p0[3]) + (p1[0] + p1[1] + p1[2] + p1[3]) + (p2[0] + p2[1] + p2[2] + p2[3]) + (p3[0] + p3[1] + p3[2] + p3[3]);
                const float rstd = __builtin_amdgcn_rsqf(tot * (1.0f / 1024.0f) + 1e-6f);
                if (u.pn == 0 && wc == 0 && fq == 0) rstd_out[row] = rstd;
                float* blk = scr + (2 * wr + 4 * ai + (m >> 1)) * 8192 + 8 * wc * 256 + 32 * (m & 1) * 4;
                const unsigned loff4 = (unsigned)(2 * fr + 64 * fq);
#pragma unroll
                for (int bj = 0; bj < 2; ++bj)
#pragma unroll
                    for (int n = 0; n < 2; ++n) ((f32x4*)(blk + (4 * n * 64 + bj) * 4))[loff4] = acc[ai][bj][m][n] * rstd + bv[bj][n]; }
        asm volatile("s_waitcnt vmcnt(0)" ::: "memory");
        __builtin_amdgcn_s_barrier();
        asm volatile("" ::: "memory");
        int tid = threadIdx.x; asm volatile("" : "+v"(tid));
        const int rl = tid >> 1, tab = tid & 1;
        const float* bp = scr + __builtin_amdgcn_readfirstlane(tid >> 6) * 8192;
        const unsigned lo4 = (unsigned)(tid & 63) * 4u;
        unsigned top[16];
        f32x4 cur[4], nxt[4];
#pragma unroll
        for (int q = 0; q < 4; ++q) cur[q] = *(const f32x4*)(bp + q * 256 + lo4);
#pragma unroll
        for (int grp = 0; grp < 8; ++grp) { unsigned k[16];
            if (grp < 7) {
#pragma unroll
                for (int q = 0; q < 4; ++q) nxt[q] = *(const f32x4*)(bp + ((grp + 1) * 4 + q) * 256 + lo4); }
#pragma unroll
            for (int q = 0; q < 4; ++q) { const f32x4 v = cur[q];
#pragma unroll
                for (int e = 0; e < 4; ++e) { const int j = grp * 16 + q * 4 + e; k[q * 4 + e] = (f2key(v[e]) & ~0x7fu) | (unsigned)(127 - j); } }
            sort16(k);
            if (grp == 0) {
#pragma unroll
                for (int i = 0; i < 16; ++i) top[i] = k[i];
            } else merge16(top, k);
#pragma unroll
            for (int q = 0; q < 4; ++q) cur[q] = nxt[q];
            __builtin_amdgcn_sched_barrier(0); }
        topk_stage2(top, tab == 0, (size_t)u.pn * T + (size_t)(u.pm * 256 + rl), esel, wsel);
    }
};

__device__ __forceinline__ void cvt16(const v4u& u, f32x2_ (&f)[8]) {
#pragma unroll
    for (int i = 0; i < 4; ++i) { f[2 * i] = __builtin_amdgcn_cvt_pk_f32_fp8((int)u[i], false); f[2 * i + 1] = __builtin_amdgcn_cvt_pk_f32_fp8((int)u[i], true); }
}
constexpr int PITEM = 8, NPITEM = T / PITEM;
__device__ __forceinline__ int peer_next(unsigned* q, int lane) {
    int idx = 0; if (lane == 0) idx = (int)__hip_atomic_fetch_add(q, 1u, __ATOMIC_RELAXED, __HIP_MEMORY_SCOPE_AGENT);
    return __builtin_amdgcn_readfirstlane(idx);
}
#define PEER_SB() __builtin_amdgcn_sched_barrier(0)
#define DPP_IADD(s, ctrl) ((s) + __builtin_amdgcn_update_dpp(0, (s), (ctrl), 0xF, 0xF, false))
__device__ __forceinline__ void p8_dots(const v4u (&ud)[16], const int (&hh)[4], const int (&hl)[4], int c8, int& r0, int& r1) {
#pragma unroll
    for (int i = 0; i < 16; ++i) { int sh = 0, sl = 0;
#pragma unroll
        for (int d = 0; d < 4; ++d) { sh = __builtin_amdgcn_sdot8((int)ud[i][d], hh[d], sh, false); sl = __builtin_amdgcn_sdot8((int)ud[i][d], hl[d], sl, false); }
        int sm = (sh << 4) + sl;
        sm = DPP_IADD(sm, 0xB1); sm = DPP_IADD(sm, 0x4E); sm = DPP_IADD(sm, 0x141);
        if ((i & 1) == 0) r0 = (c8 == (i >> 1)) ? sm : r0; else r1 = (c8 == (i >> 1)) ? sm : r1; }
}
constexpr int PSLAB = 12288;
__device__ __forceinline__ void p8_item(Frame& F, int sl, int item, int nitem, bool filled, LAS unsigned char* slab) {
    const int c8 = F.lane & 7, q8 = F.lane >> 3, t0 = item * PITEM;
    const unsigned char* ub = F.U8() + (size_t)sl * 16384 * 128 + 16 * c8;
    LAS int* eL = (LAS int*)slab; LAS unsigned char* hL = (LAS unsigned char*)(slab + 4096);
    LAS float* qL = (LAS float*)(slab + 6144);
    v4u t4[4], h2[4]; float rs2[4]; f32x4 sA, sB;
#define P8_BLK_LOAD(tb) do { \
        { const float* sp_ = F.mod() + ((tb) >> 13) * 6144 + 3072 + sl * CSLU + 8 * (F.lane & 31); sA = *(const f32x4*)sp_; sB = *(const f32x4*)(sp_ + 4); } \
        _Pragma("unroll") for (int i = 0; i < 4; ++i) rs2[i] = F.rstd()[(tb) + 2 * i + (F.lane >> 5)]; \
        _Pragma("unroll") for (int i = 0; i < 4; ++i) t4[i] = __builtin_nontemporal_load((const v4u*)(F.esel() + ((size_t)(2 * i + (F.lane >> 5)) * T + (tb)) * 16) + (F.lane & 31)); \
        _Pragma("unroll") for (int i = 0; i < 4; ++i) h2[i] = __builtin_nontemporal_load((const v4u*)(F.hg() + (size_t)((tb) + 2 * i + (F.lane >> 5)) * D + sl * CSLU + 8 * (F.lane & 31))); } while (0)
#define DPP_FMAX(v, ctrl) __builtin_fmaxf((v), __builtin_bit_cast(float, __builtin_amdgcn_update_dpp(0, __builtin_bit_cast(int, (v)), (ctrl), 0xF, 0xF, false)))
#define P8_QN(x, k) { const int q_ = (int)__builtin_rintf((x) * qs_), lo_ = ((q_ + 8) & 15) - 8, hi_ = (q_ - lo_) >> 4; wl_ |= (unsigned)(lo_ & 15) << (4 * (k)); wh_ |= (unsigned)(hi_ & 15) << (4 * (k)); }
#define P8_BLK_STORE() do { _Pragma("unroll") for (int i = 0; i < 4; ++i) *(LAS v4u*)(eL + ((F.lane & 31) >> 2) * NSEL + (2 * i + (F.lane >> 5)) * 16 + 4 * (F.lane & 3)) = t4[i]; \
        _Pragma("unroll") for (int i = 0; i < 4; ++i) { const float r_ = rs2[i]; const v4u h_ = h2[i]; \
            const float x0 = bflo(h_[0]) * r_ + sA[0], x1 = bfhi(h_[0]) * r_ + sA[1], x2 = bflo(h_[1]) * r_ + sA[2], x3 = bfhi(h_[1]) * r_ + sA[3]; \
            const float x4 = bflo(h_[2]) * r_ + sB[0], x5 = bfhi(h_[2]) * r_ + sB[1], x6 = bflo(h_[3]) * r_ + sB[2], x7 = bfhi(h_[3]) * r_ + sB[3]; \
            float m_ = __builtin_fmaxf(__builtin_fmaxf(__builtin_fmaxf(__builtin_fabsf(x0), __builtin_fabsf(x1)), __builtin_fmaxf(__builtin_fabsf(x2), __builtin_fabsf(x3))), \
                                       __builtin_fmaxf(__builtin_fmaxf(__builtin_fabsf(x4), __builtin_fabsf(x5)), __builtin_fmaxf(__builtin_fabsf(x6), __builtin_fabsf(x7)))); \
            m_ = DPP_FMAX(m_, 0x128); m_ = DPP_FMAX(m_, 0x124); m_ = DPP_FMAX(m_, 0x122); m_ = DPP_FMAX(m_, 0x121); m_ = __builtin_fmaxf(m_, __shfl_xor(m_, 16)); m_ = __builtin_fmaxf(m_, 1e-20f); \
            const float qs_ = 119.0f * __builtin_amdgcn_rcpf(m_); \
            const int tk_ = 2 * i + (F.lane >> 5); \
            if ((F.lane & 31) == 0) qL[tk_] = m_ * (1.0f / (119.0f * UQSCALE)); \
            unsigned wl_ = 0u, wh_ = 0u; P8_QN(x0, 0) P8_QN(x1, 1) P8_QN(x2, 2) P8_QN(x3, 3) P8_QN(x4, 4) P8_QN(x5, 5) P8_QN(x6, 6) P8_QN(x7, 7) \
            *(LAS unsigned*)(hL + tk_ * 256 + 4 * (F.lane & 31)) = wh_; *(LAS unsigned*)(hL + tk_ * 256 + 128 + 4 * (F.lane & 31)) = wl_; } \
        asm volatile("s_waitcnt lgkmcnt(0)" ::: "memory"); } while (0)
    if (!filled) { P8_BLK_LOAD(t0); P8_BLK_STORE(); }
    bf16* po = F.pact() + ((size_t)t0 * NSLU + sl) * NSEL + 16 * q8 + 2 * c8;
    v4u udA[16], udB[16];
#define P8_GATHER(dst, tt) do { v4u e_[4]; _Pragma("unroll") for (int k = 0; k < 4; ++k) e_[k] = *(LAS const v4u*)(eL + (tt) * NSEL + 16 * q8 + 4 * k); \
        _Pragma("unroll") for (int i = 0; i < 16; ++i) dst[i] = *(const v4u*)(ub + (size_t)e_[i >> 2][i & 3] * 128); } while (0)
#define P8_HN(tt) int hh[4], hl[4]; { const v4u a_ = *(LAS const v4u*)(hL + (tt) * 256 + 16 * c8), b_ = *(LAS const v4u*)(hL + (tt) * 256 + 128 + 16 * c8); \
        hh[0] = (int)a_[0]; hh[1] = (int)a_[1]; hh[2] = (int)a_[2]; hh[3] = (int)a_[3]; hl[0] = (int)b_[0]; hl[1] = (int)b_[1]; hl[2] = (int)b_[2]; hl[3] = (int)b_[3]; }
#define P8_OUT(tt, r0, r1) do { const float dq_ = qL[tt]; __builtin_nontemporal_store(cvtpk((float)(r0) * dq_, (float)(r1) * dq_), (unsigned*)(po + (size_t)(tt) * NSLU * NSEL)); } while (0)
    P8_GATHER(udA, 0);
    for (int tt = 0; tt < PITEM - 2; tt += 2) {
        P8_GATHER(udB, tt + 1);
        { P8_HN(tt); int r0 = 0, r1 = 0; p8_dots(udA, hh, hl, c8, r0, r1); P8_OUT(tt, r0, r1); }
        P8_GATHER(udA, tt + 2);
        { P8_HN(tt + 1); int r0 = 0, r1 = 0; p8_dots(udB, hh, hl, c8, r0, r1); P8_OUT(tt + 1, r0, r1); }
    }
    {
        P8_GATHER(udB, PITEM - 1);
        { P8_HN(PITEM - 2); int r0 = 0, r1 = 0; p8_dots(udA, hh, hl, c8, r0, r1); P8_OUT(PITEM - 2, r0, r1); }
        if (nitem >= 0) P8_BLK_LOAD(nitem * PITEM);
        { P8_HN(PITEM - 1); int r0 = 0, r1 = 0; p8_dots(udB, hh, hl, c8, r0, r1); P8_OUT(PITEM - 1, r0, r1); }
        if (nitem >= 0) P8_BLK_STORE();
    }
#undef P8_GATHER
#undef P8_HN
#undef P8_OUT
#undef P8_BLK_LOAD
#undef P8_BLK_STORE
#undef P8_QN
#undef DPP_FMAX
}
__device__ __forceinline__ void p8b_coef(Frame& F) {
    const size_t N = (size_t)T * NSEL;
#pragma unroll 4
    for (size_t i = (size_t)F.bid * NTHR + F.tid; i < N; i += (size_t)F.G * NTHR) { const size_t t = i >> 7; const int j = (int)(i & 127);
        const bf16* pp = F.pact() + t * NSLU * NSEL + j; float a = 0.f;
#pragma unroll
        for (int s = 0; s < NSLU; ++s) a += bf2f(__builtin_nontemporal_load(pp + s * NSEL));
        F.coef()[i] = F.wsel()[((size_t)(j >> 4) * T + t) * 16 + (j & 15)] * 0.5f * a * (1.0f + erff(a * 0.70710678f)); }
}
__device__ __forceinline__ void p9_token(const v4u (&vd)[16], LAS const float* cL, bf16* yo, LAS float* red, int lane, int c8, int q8) {
    f32x4 cc[4];
#pragma unroll
    for (int k = 0; k < 4; ++k) cc[k] = *(LAS const f32x4*)(cL + 16 * q8 + 4 * k);
    f32x2_ y[8];
#pragma unroll
    for (int k = 0; k < 8; ++k) y[k] = (f32x2_){0.f, 0.f};
#pragma unroll
    for (int i = 0; i < 16; ++i) { f32x2_ vf[8]; cvt16(vd[i], vf); const float c = cc[i >> 2][i & 3]; const f32x2_ c2 = {c, c};
#pragma unroll
        for (int k = 0; k < 8; ++k) y[k] += c2 * vf[k];
        PEER_SB(); }
#pragma unroll
    for (int k = 0; k < 4; ++k) { f32x4 o; o[0] = y[2 * k][0]; o[1] = y[2 * k][1]; o[2] = y[2 * k + 1][0]; o[3] = y[2 * k + 1][1]; *(LAS f32x4*)(red + q8 * 128 + 16 * c8 + 4 * k) = o; }
    asm volatile("s_waitcnt lgkmcnt(0)" ::: "memory");
    f32x2_ sm = {0.f, 0.f};
#pragma unroll
    for (int g = 0; g < 8; ++g) sm += *(LAS const f32x2_*)(red + g * 128 + 2 * lane);
    sm = sm * (1.0f / VSCALE);
    __builtin_nontemporal_store(cvtpk(sm[0], sm[1]), (unsigned*)(yo + 2 * lane));
    asm volatile("s_waitcnt lgkmcnt(0)" ::: "memory");
    PEER_SB();
}
__device__ __forceinline__ void p9_item(Frame& F, int sl, int item, int nitem, bool filled, LAS unsigned char* slab) {
    const int c8 = F.lane & 7, q8 = F.lane >> 3, t0 = item * PITEM;
    const unsigned char* vb = F.V8() + (size_t)sl * 16384 * CSL + 16 * c8;
    LAS int* eL = (LAS int*)slab; LAS float* cL = (LAS float*)(slab + 4096); LAS float* red = (LAS float*)(slab + 8192);
    v4u t4[4], c4[4];
#define P9_BLK_LOAD(tb) do { const v4u* cp_ = (const v4u*)(F.coef() + (size_t)(tb) * NSEL); \
        _Pragma("unroll") for (int i = 0; i < 4; ++i) { t4[i] = __builtin_nontemporal_load((const v4u*)(F.esel() + ((size_t)(2 * i + (F.lane >> 5)) * T + (tb)) * 16) + (F.lane & 31)); c4[i] = __builtin_nontemporal_load(cp_ + i * 64 + F.lane); } } while (0)
#define P9_BLK_STORE() do { _Pragma("unroll") for (int i = 0; i < 4; ++i) { *(LAS v4u*)(eL + ((F.lane & 31) >> 2) * NSEL + (2 * i + (F.lane >> 5)) * 16 + 4 * (F.lane & 3)) = t4[i]; *(LAS v4u*)(cL + (i * 64 + F.lane) * 4) = c4[i]; } \
        asm volatile("s_waitcnt lgkmcnt(0)" ::: "memory"); } while (0)
    if (!filled) { P9_BLK_LOAD(t0); P9_BLK_STORE(); }
    bf16* yo = F.ybuf() + (size_t)t0 * D + sl * CSL;
    v4u vdA[16], vdB[16];
#define P9_GATHER(dst, tt) do { v4u e_[4]; _Pragma("unroll") for (int k = 0; k < 4; ++k) e_[k] = *(LAS const v4u*)(eL + (tt) * NSEL + 16 * q8 + 4 * k); \
        _Pragma("unroll") for (int i = 0; i < 16; ++i) dst[i] = *(const v4u*)(vb + (size_t)e_[i >> 2][i & 3] * CSL); } while (0)
    P9_GATHER(vdA, 0);
    for (int tt = 0; tt < PITEM - 2; tt += 2) {
        P9_GATHER(vdB, tt + 1);
        p9_token(vdA, cL + tt * NSEL, yo + (size_t)tt * D, red, F.lane, c8, q8);
        P9_GATHER(vdA, tt + 2);
        p9_token(vdB, cL + (tt + 1) * NSEL, yo + (size_t)(tt + 1) * D, red, F.lane, c8, q8);
    }
    {
        P9_GATHER(vdB, PITEM - 1);
        p9_token(vdA, cL + (PITEM - 2) * NSEL, yo + (size_t)(PITEM - 2) * D, red, F.lane, c8, q8);
        if (nitem >= 0) P9_BLK_LOAD(nitem * PITEM);
        p9_token(vdB, cL + (PITEM - 1) * NSEL, yo + (size_t)(PITEM - 1) * D, red, F.lane, c8, q8);
        if (nitem >= 0) P9_BLK_STORE();
    }
#undef P9_GATHER
#undef P9_BLK_LOAD
#undef P9_BLK_STORE
}
template <int SIDE>
__device__ __forceinline__ void peer_phase(Frame& F0, int rep) {
    Frame F = F0; asm volatile("" : "+v"(F.lane));
    constexpr int NS = (SIDE == 0) ? NSLU : NSL;
    const int s0 = (int)(xb_xcc_id() & (unsigned)(NS - 1));
    unsigned* qbase = F.ctl() + (SIDE == 0 ? CW_QU : CW_QV) + rep * 64 * 32;
    LAS unsigned char* cf = F.lds + F.wave * PSLAB;
    for (int k = 0; k < NS; ++k) { const int sl = (s0 + k) & (NS - 1);
        int item = peer_next(qbase + 64 * sl, F.lane); bool filled = false;
        while (item < NPITEM) { int nitem = peer_next(qbase + 64 * sl, F.lane); if (nitem >= NPITEM) nitem = -1;
            if (SIDE == 0) p8_item(F, sl, item, nitem, filled, cf); else p9_item(F, sl, item, nitem, filled, cf);
            filled = nitem >= 0; item = nitem >= 0 ? nitem : NPITEM; } }
}
__device__ __forceinline__ void p10_final(Frame& F) {
    const int gwc = F.bid * NWAVES + F.wave, NGW = F.G * NWAVES;
    for (int row0 = gwc * 16; row0 < T; row0 += NGW * 16) {
        const int b = row0 >> 13; const float* mb = F.mod() + b * 6144 + 5120; const float* fm = F.fmod() + b * 2048;
        f32x4 g2[4], ca[4], cb[4];
#pragma unroll
        for (int j = 0; j < 4; ++j) { const int k = 256 * j + 4 * F.lane; g2[j] = *(const f32x4*)(mb + k); ca[j] = *(const f32x4*)(F.fnorm_g() + k) * (*(const f32x4*)(fm + 1024 + k) + 1.0f); cb[j] = *(const f32x4*)(fm + k); }
#pragma unroll 4
        for (int r = 0; r < 16; ++r) { float* hr = F.out() + (size_t)(row0 + r) * D; const bf16* yr = F.ybuf() + (size_t)(row0 + r) * D; const bf16* hb = (const bf16*)hr;
            f32x4 z[4]; float ss = 0.f;
#pragma unroll
            for (int j = 0; j < 4; ++j) { const v2u hq = *(const v2u*)(hb + 256 * j + 4 * F.lane); f32x4 hv; hv[0] = bflo(hq[0]); hv[1] = bfhi(hq[0]); hv[2] = bflo(hq[1]); hv[3] = bfhi(hq[1]);
                const v2u yq = __builtin_nontemporal_load((const v2u*)(yr + 256 * j + 4 * F.lane)); f32x4 yv; yv[0] = bflo(yq[0]); yv[1] = bfhi(yq[0]); yv[2] = bflo(yq[1]); yv[3] = bfhi(yq[1]);
                z[j] = hv + g2[j] * yv; ss += z[j][0] * z[j][0] + z[j][1] * z[j][1] + z[j][2] * z[j][2] + z[j][3] * z[j][3]; }
            const float rstd = __builtin_amdgcn_rsqf(wave_sum(ss) * (1.0f / D) + EPS);
#pragma unroll
            for (int j = 0; j < 4; ++j) *(f32x4*)(hr + 256 * j + 4 * F.lane) = z[j] * rstd * ca[j] + cb[j]; }
    }
}

constexpr int NPHASE = 12;
__global__ void __launch_bounds__(NTHR, 2) fwd_kernel(Args args) {
    extern __shared__ __attribute__((aligned(16))) unsigned char lds_raw[];
    Frame F;
    F.lds = (LAS unsigned char*)lds_raw;
    F.tid = threadIdx.x; F.lane = F.tid & 63; F.wave = __builtin_amdgcn_readfirstlane(F.tid >> 6); F.G = gridDim.x; F.bid = blockIdx.x;
    unsigned char* ws = args.ws; F.a = &args;
    volatile LAS unsigned* misc = (volatile LAS unsigned*)(F.lds + MISC_OFF);
    if (F.tid < 64) misc[F.tid] = 0u;
    __syncthreads();
    const int lo = args.ph_lo, hi = args.ph_hi;
    const bool multi = (hi - lo) > 1;
    XcdBarrier bar; bar.bar = (unsigned*)(ws + WS_CTL) + CW_BAR; bar.x = 0; bar.st = nullptr;
    if (multi) bar = xcd_barrier_post((unsigned*)(ws + WS_CTL) + CW_BAR, misc + 8);
#ifndef PHMASK
#define PHMASK 0xfff
#endif
#define IN(k) (((PHMASK >> (k)) & 1) && lo <= (k) && (k) < hi)
#define SEAM(k) do { if (IN(k) && IN((k) + 1)) xcd_barrier(bar); } while (0)

#ifndef REPMASK
#define REPMASK 0
#endif
#define REP(k) (((REPMASK) >> (k)) & 1)
#define REPBAR(k) if (REP(k) && rep == 0) xcd_barrier(bar)
    if (IN(0)) { for (int rep = 0; rep <= REP(0); ++rep) { p0_prologue(F); REPBAR(0); } } SEAM(0);
    if (IN(1)) { for (int rep = 0; rep <= REP(1); ++rep) { p1_norm(F); REPBAR(1); } } SEAM(1);
    if (IN(2)) { { pg8::Gemm g{F.bufA(), F.Win_t(), T, NIN, D}; pg8::StaticOrder S; S.init(T, NIN, F.G, F.bid);
        pg8::EpiProj E{F.proj(), NIN};
        pg8::gemm_phase<pg8::EpiProj, pg8::StaticOrder, true, true>(F.lds, g, S, E); }
#if ((REPMASK) >> 2) & 1
        xcd_barrier(bar); { pg8::Gemm g{F.bufA(), F.Win_t(), T, NIN, D}; pg8::StaticOrder S; S.init(T, NIN, F.G, F.bid);
        pg8::EpiProj E{F.proj(), NIN};
        pg8::gemm_phase<pg8::EpiProj, pg8::StaticOrder, true, true>(F.lds, g, S, E); }
#endif
    } SEAM(2);
    if (IN(3)) { for (int rep = 0; rep <= REP(3); ++rep) {
        for (int it = F.bid; it < NB * NHH * 2 * NSEG; it += F.G) h1_item(F, it);
        float cw[CW];
#pragma unroll
        for (int j = 0; j < CW; ++j) cw[j] = F.conv_w()[j * DC + F.tid];
        const float cbias = F.conv_b()[F.tid];
        for (int it = F.bid; it < T / 32; it += F.G) conv_item(F, it, cw, cbias); REPBAR(3); }
    } SEAM(3);
    if (IN(4)) { for (int rep = 0; rep <= REP(4); ++rep) { for (int it = F.bid; it < NB * NHH * NSEG; it += F.G) h2_item(F, it); REPBAR(4); } } SEAM(4);
    if (IN(5)) { { pg8::Gemm g{F.bufA(), F.Wout_t(), T, D, D}; pg8::StaticOrder S; S.init(T, D, F.G, F.bid);
        pg8::EpiOut E{F.x(), F.out(), F.hg(), F.mod(), F.g_ffn(), F.ssqp()};
        pg8::gemm_phase<pg8::EpiOut, pg8::StaticOrder, true, true>(F.lds, g, S, E); }
#if ((REPMASK) >> 5) & 1
        xcd_barrier(bar); { pg8::Gemm g{F.bufA(), F.Wout_t(), T, D, D}; pg8::StaticOrder S; S.init(T, D, F.G, F.bid);
        pg8::EpiOut E{F.x(), F.out(), F.hg(), F.mod(), F.g_ffn(), F.ssqp()};
        pg8::gemm_phase<pg8::EpiOut, pg8::StaticOrder, true, true>(F.lds, g, S, E); }
#endif
    } SEAM(5);
    if (IN(6)) { { pg8::Gemm g{F.hg(), F.Wqk_t(), T, NQK, D}; pg8::StaticOrder S; S.init(T, NQK, F.G, F.bid);
        EpiScoreTopk E{F.scores() + (size_t)F.bid * 65536, F.ssqp(), F.biasq(), F.rstd(), F.esel(), F.wsel()};
        pg8::gemm_phase<EpiScoreTopk, pg8::StaticOrder, true, true>(F.lds, g, S, E); }
    } SEAM(6);
    if (IN(8)) { for (int rep = 0; rep <= REP(8); ++rep) { peer_phase<0>(F, rep); REPBAR(8); } } SEAM(8);
    if (IN(9)) { for (int rep = 0; rep <= REP(9); ++rep) { p8b_coef(F); REPBAR(9); } } SEAM(9);
    if (IN(10)) { for (int rep = 0; rep <= REP(10); ++rep) { peer_phase<1>(F, rep); REPBAR(10); } } SEAM(10);
    if (IN(11)) { p10_final(F); }
#undef IN
#undef SEAM
}

#ifndef MK_ONE_LAUNCH
#define MK_ONE_LAUNCH 0
#endif
extern "C" void kernel_launch(void* const* d_in, const int* in_sizes, int n_in, void* d_out, int out_size, void* d_ws, size_t ws_size, hipStream_t stream) {
    static int grid = 0;
    if (grid == 0) {
        if (n_in != 23 || out_size != T * D || ws_size < WS_END) { fprintf(stderr, "kernel_launch: unexpected shapes (n_in %d, out %d, ws %zu)\n", n_in, out_size, ws_size); grid = -1; return; }
        int dev = 0, cus = 0, per_cu = 0;
        if (hipGetDevice(&dev) != hipSuccess || hipDeviceGetAttribute(&cus, hipDeviceAttributeMultiprocessorCount, dev) != hipSuccess) { grid = -1; return; }
        if (hipFuncSetAttribute((const void*)fwd_kernel, hipFuncAttributeMaxDynamicSharedMemorySize, LDS_BYTES) != hipSuccess) { fprintf(stderr, "kernel_launch: hipFuncSetAttribute failed\n"); grid = -1; return; }
        if (hipOccupancyMaxActiveBlocksPerMultiprocessor(&per_cu, (const void*)fwd_kernel, NTHR, LDS_BYTES) != hipSuccess || per_cu < 1) { fprintf(stderr, "kernel_launch: occupancy query reports %d\n", per_cu); }
        (void)hipGetLastError();
        grid = cus;
    }
    if (grid < 0) return;
    (void)hipMemsetAsync((char*)d_ws + WS_CTL, 0, CTL_ZERO_BYTES, stream);
    Args a{};
    for (int i = 0; i < 23; ++i) a.in[i] = (const float*)d_in[i];
    a.out = (float*)d_out; a.ws = (unsigned char*)d_ws;
#if MK_ONE_LAUNCH
    a.ph_lo = 0; a.ph_hi = NPHASE;
    hipLaunchKernelGGL(fwd_kernel, dim3(grid), dim3(NTHR), LDS_BYTES, stream, a);
#else
    for (int p = 0; p < NPHASE; ++p) { a.ph_lo = p; a.ph_hi = p + 1; hipLaunchKernelGGL(fwd_kernel, dim3(grid), dim3(NTHR), LDS_BYTES, stream, a); }
#endif
}
```

```cpp
#include <hip/hip_runtime.h>
#include <cstdio>
#include <cstdint>
namespace pg8 {
#define PG8_LAS __attribute__((address_space(3)))
typedef unsigned short bf16_t;
typedef short bf16x8 __attribute__((ext_vector_type(8)));
typedef float f32x4 __attribute__((ext_vector_type(4)));
typedef unsigned u32x4 __attribute__((ext_vector_type(4)));
constexpr int BM = 256, BK = 64, HALF = 128, HTB = HALF * BK * 2  , STAGE_BYTES = 8 * HTB, NXCD = 8, WGM = 8;

__host__ __device__ __forceinline__ int lds_byte(int r, int c) { const int st = (r >> 4) * 2 + (c >> 5), rr = r & 15, cc = c & 31, ob = rr * 64 + cc * 2; return st * 1024 + (ob ^ (((ob >> 9) & 1) << 5)); }
__host__ __device__ __forceinline__ void stage_rc(int b, int& R, int& C) { const int st = b / 1024, sb = b % 1024, swz = sb ^ (((sb >> 9) & 1) << 5); R = (st >> 1) * 16 + swz / 64; C = (st & 1) * 32 + (swz % 64) / 2; }
__host__ __device__ __forceinline__ int perm32(int rho) { const int n = rho >> 4, i = rho & 15; return 8 * (i >> 2) + 4 * n + (i & 3); }

struct Unit { int pm, pn; };
struct Gemm { const bf16_t* A; const bf16_t* Bt; int M, N, K; };

struct StaticOrder {
    int nM, nN, nwg, G, c;
    __host__ __device__ void init(int M, int N, int G_, int c_) { nM = M / BM; nN = N / BM; nwg = nM * nN; G = G_; c = c_; }
    __host__ __device__ bool next(int i, Unit& u) const {
        const long L = (long)i * G + c; if (L >= nwg) return false;
        int wgid = (int)L; { const int q = nwg / NXCD, r = nwg % NXCD, xcd = wgid % NXCD, off = wgid / NXCD; wgid = (xcd < r ? xcd * (q + 1) : r * (q + 1) + (xcd - r) * q) + off; }
        const int nig = WGM * nN, gid = wgid / nig, fm = gid * WGM, gsz = (nM - fm) < WGM ? (nM - fm) : WGM;
        u.pm = fm + ((wgid % nig) % gsz); u.pn = (wgid % nig) / gsz; return true;
    }
    __device__ __forceinline__ void a_ready(const Unit&) const {}
    __device__ __forceinline__ void done(const Unit&) const {}
};
__device__ __forceinline__ unsigned cvt_pk_bf16(float lo, float hi) { unsigned r; asm volatile("v_cvt_pk_bf16_f32 %0, %1, %2" : "=v"(r) : "v"(lo), "v"(hi)); return r; }
typedef float f32x2 __attribute__((ext_vector_type(2)));
__device__ __forceinline__ f32x2 gelu_pk(f32x2 v) {
    const f32x2 av = __builtin_elementwise_abs(v), d = av * 0.2316418882f + 1.0f;
    f32x2 t; t.x = __builtin_amdgcn_rcpf(d.x); t.y = __builtin_amdgcn_rcpf(d.y);
    f32x2 q = t * 0.5307027145f + (-0.7265760135f); q = q * t + 0.7107068705f; q = q * t + (-0.142248368f); q = q * t + 0.127414796f; q = q * t;
    const f32x2 s = (v * v) * (-0.72134752044f);
    f32x2 e; e.x = __builtin_amdgcn_exp2f(s.x); e.y = __builtin_amdgcn_exp2f(s.y);
    const f32x2 m = v * (q * e), r = v - m;
    f32x2 o; o.x = v.x < 0.f ? m.x : r.x; o.y = v.y < 0.f ? m.y : r.y; return o;
}

template <int ACT  > struct EpiBf16 {
    static constexpr bool PERM = true, AFTER_DRAIN = false; static_assert(ACT == 0 || ACT == 1, "EpiBf16: ACT is 0 (none) or 1 (gelu_pk)");
    bf16_t* O; int ldc; const float* bias; int split_cols; size_t split_stride; float scale0;
    __device__ __forceinline__ void operator()(const f32x4 (&acc)[2][2][4][2], const Unit& u, int wr, int wc, int fr, int fq) const {
        const int row0 = u.pm * BM + wr * 64 + fr; int colt = u.pn * BM; bf16_t* base = O;
        float sc = 1.f; if (split_cols) { const int t = colt / split_cols; base += (size_t)t * split_stride; colt -= t * split_cols; if (t == 0) sc = scale0; }
        const int col0 = colt + wc * 32 + 8 * fq, bcol0 = u.pn * BM + wc * 32 + 8 * fq;
        f32x4 bv[2][2];
#pragma unroll
        for (int bj = 0; bj < 2; ++bj)
#pragma unroll
            for (int n = 0; n < 2; ++n) bv[bj][n] = bias ? *(const f32x4*)(bias + bcol0 + bj * HALF + 4 * n) : (f32x4){0.f, 0.f, 0.f, 0.f};
#pragma unroll
        for (int ai = 0; ai < 2; ++ai)
#pragma unroll
            for (int m = 0; m < 4; ++m) { bf16_t* rowp = base + (size_t)(row0 + ai * HALF + m * 16) * ldc + col0;
#pragma unroll
                for (int bj = 0; bj < 2; ++bj) { f32x4 v0 = acc[ai][bj][m][0] + bv[bj][0], v1 = acc[ai][bj][m][1] + bv[bj][1];
                    if (ACT == 1) { f32x2 a = gelu_pk((f32x2){v0[0], v0[1]}), b = gelu_pk((f32x2){v0[2], v0[3]}), c = gelu_pk((f32x2){v1[0], v1[1]}), d = gelu_pk((f32x2){v1[2], v1[3]});
                        v0 = (f32x4){a.x, a.y, b.x, b.y}; v1 = (f32x4){c.x, c.y, d.x, d.y}; }
                    v0 = v0 * sc; v1 = v1 * sc; u32x4 w; w.x = cvt_pk_bf16(v0[0], v0[1]); w.y = cvt_pk_bf16(v0[2], v0[3]); w.z = cvt_pk_bf16(v1[0], v1[1]); w.w = cvt_pk_bf16(v1[2], v1[3]);
                    *(u32x4*)(rowp + bj * HALF) = w; } }
    }
};

struct EpiOut {
    static constexpr bool PERM = true, AFTER_DRAIN = false;
    const float* X; float* Hout; bf16_t* HG; const float* mod; const float* gffn; float* ssqp;
    __device__ __forceinline__ void operator()(const f32x4 (&acc)[2][2][4][2], const Unit& u, int wr, int wc, int fr, int fq) const {
        const int row0 = u.pm * BM + wr * 64 + fr, col0 = u.pn * BM + wc * 32 + 8 * fq;
        const int b = (u.pm * BM) >> 13;
        const float* mb = mod + b * 6144;
        f32x4 g1v[2][2], gv2[2][2];
#pragma unroll
        for (int bj = 0; bj < 2; ++bj)
#pragma unroll
            for (int n = 0; n < 2; ++n) { const int c = col0 + bj * HALF + 4 * n;
                g1v[bj][n] = *(const f32x4*)(mb + 2048 + c);
                const f32x4 s2 = *(const f32x4*)(mb + 4096 + c), gf = *(const f32x4*)(gffn + c);
                gv2[bj][n] = gf * (s2 + 1.0f); }
#pragma unroll
        for (int ai = 0; ai < 2; ++ai)
#pragma unroll
            for (int m = 0; m < 4; ++m) { const int row = row0 + ai * HALF + m * 16; const size_t ro = (size_t)row * 1024 + col0; float ss = 0.f;
#pragma unroll
                for (int bj = 0; bj < 2; ++bj) {
                    const f32x4 x0 = *(const f32x4*)(X + ro + bj * HALF), x1 = *(const f32x4*)(X + ro + bj * HALF + 4);
                    const f32x4 h0 = x0 + g1v[bj][0] * acc[ai][bj][m][0], h1 = x1 + g1v[bj][1] * acc[ai][bj][m][1];
                    { u32x4 hw; hw.x = cvt_pk_bf16(h0[0], h0[1]); hw.y = cvt_pk_bf16(h0[2], h0[3]); hw.z = cvt_pk_bf16(h1[0], h1[1]); hw.w = cvt_pk_bf16(h1[2], h1[3]);
                      *(u32x4*)((bf16_t*)Hout + (size_t)row * 2048 + col0 + bj * HALF) = hw; }
                    ss += h0[0] * h0[0] + h0[1] * h0[1] + h0[2] * h0[2] + h0[3] * h0[3] + h1[0] * h1[0] + h1[1] * h1[1] + h1[2] * h1[2] + h1[3] * h1[3];
                    const f32x4 q0 = h0 * gv2[bj][0], q1 = h1 * gv2[bj][1];
                    u32x4 w; w.x = cvt_pk_bf16(q0[0], q0[1]); w.y = cvt_pk_bf16(q0[2], q0[3]); w.z = cvt_pk_bf16(q1[0], q1[1]); w.w = cvt_pk_bf16(q1[2], q1[3]);
                    *(u32x4*)(HG + ro + bj * HALF) = w; }
                ss += __shfl_xor(ss, 16); ss += __shfl_xor(ss, 32);
                if (fq == 0) ssqp[((size_t)u.pn * 32768 + row) * 4 + wc] = ss; }
    }
};
struct EpiScore {
    static constexpr bool PERM = false, AFTER_DRAIN = false;
    float* S; const float* ssqp; const float* biasq; float* rstd_out;
    __device__ __forceinline__ void operator()(const f32x4 (&acc)[2][2][4][2], const Unit& u, int wr, int wc, int fr, int fq) const {
        const int row0 = u.pm * BM + wr * 64 + fr, col0 = u.pn * BM + wc * 32 + 4 * fq;
        const int b = (u.pm * BM) >> 13;
        f32x4 bv[2][2];
#pragma unroll
        for (int bj = 0; bj < 2; ++bj)
#pragma unroll
            for (int n = 0; n < 2; ++n) bv[bj][n] = *(const f32x4*)(biasq + b * 2048 + col0 + bj * HALF + n * 16);
#pragma unroll
        for (int ai = 0; ai < 2; ++ai)
#pragma unroll
            for (int m = 0; m < 4; ++m) { const int row = row0 + ai * HALF + m * 16;
                const f32x4 p0 = *(const f32x4*)(ssqp + (size_t)row * 4), p1 = *(const f32x4*)(ssqp + ((size_t)32768 + row) * 4), p2 = *(const f32x4*)(ssqp + ((size_t)65536 + row) * 4), p3 = *(const f32x4*)(ssqp + ((size_t)98304 + row) * 4);
                const float tot = (p0[0] + p0[1] + p0[2] + p0[3]) + (p1[0] + p1[1] + p1[2] + p1[3]) + (p2[0] + p2[1] + p2[2] + p2[3]) + (p3[0] + p3[1] + p3[2] + p3[3]);
                const float rstd = __builtin_amdgcn_rsqf(tot * (1.0f / 1024.0f) + 1e-6f);
                if (u.pn == 0 && wc == 0 && fq == 0) rstd_out[row] = rstd;
                float* rowp = S + (size_t)row * 2048 + col0;
#pragma unroll
                for (int bj = 0; bj < 2; ++bj)
#pragma unroll
                    for (int n = 0; n < 2; ++n) *(f32x4*)(rowp + bj * HALF + n * 16) = acc[ai][bj][m][n] * rstd + bv[bj][n]; }
    }
};

struct EpiProj {
    static constexpr bool PERM = true, AFTER_DRAIN = false;
    bf16_t* O; int ldc;
    __device__ __forceinline__ void operator()(const f32x4 (&acc)[2][2][4][2], const Unit& u, int wr, int wc, int fr, int fq) const {
        asm volatile("" : "+v"(fr), "+v"(fq));
        const int row0 = u.pm * BM + wr * 64 + fr, col0 = u.pn * BM + wc * 32 + 8 * fq;
        const int cls = u.pn >> 1;
        const bool ident = (cls == 3) || (cls == 5), mulx = (cls == 0) || (cls == 4);
        const float sgn = (cls == 1 || cls == 2) ? 1.4426950408889634f : -1.4426950408889634f;
#pragma unroll
        for (int ai = 0; ai < 2; ++ai)
#pragma unroll
            for (int m = 0; m < 4; ++m) { bf16_t* rowp = O + (size_t)(row0 + ai * HALF + m * 16) * ldc + col0;
#pragma unroll
                for (int bj = 0; bj < 2; ++bj) { f32x4 v0 = acc[ai][bj][m][0], v1 = acc[ai][bj][m][1];
                    if (!ident) {
#pragma unroll
                        for (int j = 0; j < 4; ++j) { const float r0 = __builtin_amdgcn_rcpf(1.0f + __builtin_amdgcn_exp2f(sgn * v0[j])), r1 = __builtin_amdgcn_rcpf(1.0f + __builtin_amdgcn_exp2f(sgn * v1[j]));
                            v0[j] = mulx ? v0[j] * r0 : r0; v1[j] = mulx ? v1[j] * r1 : r1; } }
                    u32x4 w; w.x = cvt_pk_bf16(v0[0], v0[1]); w.y = cvt_pk_bf16(v0[2], v0[3]); w.z = cvt_pk_bf16(v1[0], v1[1]); w.w = cvt_pk_bf16(v1[2], v1[3]);
                    *(u32x4*)(rowp + bj * HALF) = w; } }
    }
};
template <class Epi, class Sched, bool ALIGN_EPI = false, bool SP2 = false>
__device__ __forceinline__ void gemm_phase(PG8_LAS unsigned char* lds, const Gemm g, const Sched& S, const Epi& E) {
    const int tid = threadIdx.x, wid = __builtin_amdgcn_readfirstlane(tid >> 6), lane = tid & 63, wr = wid >> 2, wc = wid & 3, fr = lane & 15, fq = lane >> 4;
    const int K = g.K, nt = K / BK;
    unsigned voffA[2], voffB[2];
#pragma unroll
    for (int i = 0; i < 2; ++i) { int R, C; stage_rc(tid * 16 + i * 8192, R, C); const int Rb = Epi::PERM ? ((R & ~31) + perm32(R & 31)) : R;
        voffA[i] = (unsigned)(R * K + C) * 2u; voffB[i] = (unsigned)(Rb * K + C) * 2u; }
    const size_t kstep = (size_t)(BK * 2);
    const size_t hstep = (size_t)HALF * K * 2;
    const size_t tstep = 2 * hstep;
    const unsigned ldsw = (unsigned)wid * 1024u;
    const int aoff = lds_byte(wr * 64 + fr, fq * 8), boff = lds_byte(wc * 32 + fr, fq * 8);
#define PG8_SA(b, h) (((b) * 2 + (h)) * HTB)
#define PG8_SB(b, h) ((4 + (b) * 2 + (h)) * HTB)
#define PG8_STAGE(bufoff, gbase, voff) do { _Pragma("unroll") for (int _i = 0; _i < 2; ++_i) \
        __builtin_amdgcn_global_load_lds((const unsigned*)((const char*)(gbase) + (voff)[_i]), (PG8_LAS unsigned*)(lds + (bufoff) + ldsw + _i * 8192), 16, 0, 0); } while (0)
#define PG8_LDA(dst, b, h) do { _Pragma("unroll") for (int m = 0; m < 4; ++m) _Pragma("unroll") for (int k = 0; k < 2; ++k) dst[m][k] = *(const PG8_LAS bf16x8*)(lds + PG8_SA(b, h) + aoff + m * 2048 + k * 1024); } while (0)
#define PG8_LDB(dst, b, h) do { _Pragma("unroll") for (int n = 0; n < 2; ++n) _Pragma("unroll") for (int k = 0; k < 2; ++k) dst[n][k] = *(const PG8_LAS bf16x8*)(lds + PG8_SB(b, h) + boff + n * 2048 + k * 1024); } while (0)
#define PG8_MMA(ai, bj, At, Bt) do { __builtin_amdgcn_s_setprio(1); _Pragma("unroll") for (int m = 0; m < 4; ++m) _Pragma("unroll") for (int n = 0; n < 2; ++n) _Pragma("unroll") for (int k = 0; k < 2; ++k) \
        acc[ai][bj][m][n] = __builtin_amdgcn_mfma_f32_16x16x32_bf16(Bt[n][k], At[m][k], acc[ai][bj][m][n], 0, 0, 0); __builtin_amdgcn_s_setprio(0); } while (0)
#define PG8_WAIT_V(n) asm volatile("s_waitcnt vmcnt(" #n ")" ::: "memory")
#define PG8_WAIT_L(n) asm volatile("s_waitcnt lgkmcnt(" #n ")" ::: "memory")
#define PG8_BAR __builtin_amdgcn_s_barrier()
#define PG8_SCHED __builtin_amdgcn_sched_barrier(0)
    Unit cur, nxt; int ui = 0;
    if (!S.next(0, cur)) return;
    f32x4 acc[2][2][4][2];
#pragma unroll
    for (int a = 0; a < 2; ++a)
#pragma unroll
        for (int b = 0; b < 2; ++b)
#pragma unroll
            for (int m = 0; m < 4; ++m)
#pragma unroll
                for (int n = 0; n < 2; ++n) acc[a][b][m][n] = (f32x4){0.f, 0.f, 0.f, 0.f};
    bf16x8 At[4][2], B0[2][2], B1[2][2];
    const char* cA = (const char*)g.A + (size_t)cur.pm * tstep; const char* cB = (const char*)g.Bt + (size_t)cur.pn * tstep;
    S.a_ready(cur);
    if constexpr (SP2) {
        PG8_STAGE(PG8_SB(0, 0), cB, voffB); PG8_STAGE(PG8_SB(0, 1), cB + hstep, voffB); PG8_STAGE(PG8_SA(0, 0), cA, voffA); PG8_STAGE(PG8_SA(0, 1), cA + hstep, voffA);
        if (wr == 1) PG8_BAR;
        PG8_WAIT_V(2); PG8_BAR;
        PG8_STAGE(PG8_SB(1, 0), cB + kstep, voffB); PG8_STAGE(PG8_SA(1, 0), cA + kstep, voffA); PG8_STAGE(PG8_SB(1, 1), cB + hstep + kstep, voffB);
        PG8_WAIT_V(6); PG8_BAR;
    } else {
        PG8_STAGE(PG8_SB(0, 0), cB, voffB); PG8_STAGE(PG8_SA(0, 0), cA, voffA); PG8_STAGE(PG8_SB(0, 1), cB + hstep, voffB); PG8_STAGE(PG8_SA(0, 1), cA + hstep, voffA);
        if (wr == 1) PG8_BAR;
        PG8_WAIT_V(4); PG8_BAR;
        PG8_STAGE(PG8_SB(1, 0), cB + kstep, voffB); PG8_STAGE(PG8_SA(1, 0), cA + kstep, voffA); PG8_STAGE(PG8_SB(1, 1), cB + hstep + kstep, voffB);
        PG8_WAIT_V(6); PG8_BAR;
    }
    for (;;) {
        const bool has_next = S.next(ui + 1, nxt);
        const char* nA = has_next ? (const char*)g.A + (size_t)nxt.pm * tstep : cA; const char* nB = has_next ? (const char*)g.Bt + (size_t)nxt.pn * tstep : cB;
        for (int t = 0; t < nt; t += 2) {
            const bool last = (t == nt - 2);
            const char* a1 = cA + (size_t)(t + 1) * kstep;
            const char* a2 = last ? nA : cA + (size_t)(t + 2) * kstep; const char* b2 = last ? nB : cB + (size_t)(t + 2) * kstep;
            const char* a3 = a2 + kstep; const char* b3 = b2 + kstep;
            if (last && has_next) S.a_ready(nxt);
            if constexpr (SP2) {
            PG8_LDB(B0, 0, 0); PG8_LDB(B1, 0, 1); PG8_SCHED; PG8_LDA(At, 0, 0); PG8_STAGE(PG8_SA(1, 1), a1 + hstep, voffA);
            PG8_WAIT_V(8); PG8_WAIT_L(0); PG8_BAR; PG8_MMA(0, 0, At, B0); PG8_MMA(0, 1, At, B1); PG8_BAR; PG8_SCHED;
            PG8_LDA(At, 0, 1); PG8_STAGE(PG8_SB(0, 0), b2, voffB); PG8_STAGE(PG8_SB(0, 1), b2 + hstep, voffB); PG8_STAGE(PG8_SA(0, 0), a2, voffA);
            PG8_WAIT_V(8); PG8_WAIT_L(0); PG8_BAR; PG8_MMA(1, 0, At, B0); PG8_MMA(1, 1, At, B1); PG8_BAR; PG8_SCHED;
            PG8_LDB(B0, 1, 0); PG8_LDB(B1, 1, 1); PG8_SCHED; PG8_LDA(At, 1, 0); PG8_STAGE(PG8_SA(0, 1), a2 + hstep, voffA);
            PG8_WAIT_V(8); PG8_WAIT_L(0); PG8_BAR; PG8_MMA(0, 0, At, B0); PG8_MMA(0, 1, At, B1); PG8_BAR; PG8_SCHED;
            PG8_LDA(At, 1, 1); PG8_STAGE(PG8_SB(1, 0), b3, voffB); PG8_STAGE(PG8_SB(1, 1), b3 + hstep, voffB); PG8_STAGE(PG8_SA(1, 0), a3, voffA);
            PG8_WAIT_V(8); PG8_WAIT_L(0); PG8_BAR; PG8_MMA(1, 0, At, B0); PG8_MMA(1, 1, At, B1); PG8_BAR; PG8_SCHED;
            } else {
            PG8_LDB(B0, 0, 0); PG8_SCHED; PG8_LDA(At, 0, 0); PG8_STAGE(PG8_SA(1, 1), a1 + hstep, voffA);
            PG8_WAIT_L(8); PG8_BAR; PG8_WAIT_L(0); PG8_MMA(0, 0, At, B0); PG8_BAR; PG8_SCHED;
            PG8_LDB(B1, 0, 1); PG8_STAGE(PG8_SB(0, 0), b2, voffB);
            PG8_BAR; PG8_WAIT_L(0); PG8_MMA(0, 1, At, B1); PG8_BAR;
            PG8_LDA(At, 0, 1); PG8_STAGE(PG8_SA(0, 0), a2, voffA);
            PG8_BAR; PG8_WAIT_L(0); PG8_MMA(1, 0, At, B0); PG8_BAR; PG8_SCHED;
            PG8_STAGE(PG8_SB(0, 1), b2 + hstep, voffB);
            PG8_WAIT_V(6); PG8_BAR; PG8_MMA(1, 1, At, B1); PG8_BAR;
            PG8_LDB(B0, 1, 0); PG8_SCHED; PG8_LDA(At, 1, 0); PG8_STAGE(PG8_SA(0, 1), a2 + hstep, voffA);
            PG8_WAIT_L(8); PG8_BAR; PG8_WAIT_L(0); PG8_MMA(0, 0, At, B0); PG8_BAR; PG8_SCHED;
            PG8_LDB(B1, 1, 1); PG8_STAGE(PG8_SB(1, 0), b3, voffB);
            PG8_BAR; PG8_WAIT_L(0); PG8_MMA(0, 1, At, B1); PG8_BAR;
            PG8_LDA(At, 1, 1); PG8_STAGE(PG8_SA(1, 0), a3, voffA);
            PG8_BAR; PG8_WAIT_L(0); PG8_MMA(1, 0, At, B0); PG8_BAR; PG8_SCHED;
            PG8_STAGE(PG8_SB(1, 1), b3 + hstep, voffB);
            PG8_WAIT_V(6); PG8_BAR; PG8_MMA(1, 1, At, B1); PG8_BAR;
            }
        }
        if constexpr (ALIGN_EPI) { if (wr == 0) PG8_BAR; }
        if constexpr (!Epi::AFTER_DRAIN) { E(acc, cur, wr, wc, fr, fq); S.done(cur); }
        if (!has_next) break;
#pragma unroll
        for (int a = 0; a < 2; ++a)
#pragma unroll
            for (int b = 0; b < 2; ++b)
#pragma unroll
                for (int m = 0; m < 4; ++m)
#pragma unroll
                    for (int n = 0; n < 2; ++n) acc[a][b][m][n] = (f32x4){0.f, 0.f, 0.f, 0.f};
        cur = nxt; cA = nA; cB = nB; ++ui;
        if constexpr (ALIGN_EPI) { if (wr == 1) PG8_BAR; }
    }
    PG8_WAIT_V(0);
    if constexpr (!ALIGN_EPI) { if (wr == 0) PG8_BAR; }
    PG8_BAR;
    if constexpr (Epi::AFTER_DRAIN) { E.fused(acc, cur, wr, wc, fr, fq, lds, wid, lane); S.done(cur); }
#undef PG8_SA
#undef PG8_SB
#undef PG8_STAGE
#undef PG8_LDA
#undef PG8_LDB
#undef PG8_MMA
#undef PG8_WAIT_V
#undef PG8_WAIT_L
#undef PG8_BAR
#undef PG8_SCHED
}
}
#define MK_ONE_LAUNCH 1

constexpr int NB = 4, SEQ = 8192, T = NB * SEQ, D = 1024;
constexpr int NIN = 3584, DH = 512, HD = 128, NHH = 4, CHK = 64;
constexpr int NSEG = 16, SEGC = 8;
constexpr int CW = 31, CPAD = 15, DC = 512;
constexpr int PHEADS = 8, NQK = 2048, NSEL = 128;
constexpr float EPS = 1e-6f;
constexpr int NWAVES = 8, NTHR = 512;

constexpr size_t MiB = 1u << 20;
constexpr size_t WS_CTL = 0, CTL_ZERO_BYTES = 65536;
constexpr size_t WS_MOD = 1 * MiB, WS_FMOD = WS_MOD + 131072, WS_LB = WS_MOD + 196608, WS_BIASQ = WS_MOD + 262144;
constexpr size_t WS_WIN = 2 * MiB, WS_WOUT = 10 * MiB, WS_WQK = 12 * MiB;
constexpr size_t WS_UT = 16 * MiB, WS_VT = 48 * MiB;
constexpr size_t WS_BUFA = 80 * MiB;
constexpr size_t WS_BUFB = 144 * MiB;
constexpr size_t WS_SEG = 208 * MiB;
constexpr size_t WS_E = 208 * MiB, WS_W = 224 * MiB;
constexpr size_t WS_BIG = 240 * MiB;
constexpr size_t WS_SSQ = 496 * MiB;
constexpr size_t WS_SEGA = 498 * MiB;
constexpr size_t WS_RSTD = 499 * MiB;
constexpr size_t WS_END = 500 * MiB;
constexpr size_t WS_PACT = 240 * MiB;
constexpr size_t WS_Y = 368 * MiB;
constexpr int NSL = 8, CSL = 128;
constexpr float VSCALE = 16.0f;
constexpr float UQSCALE = 95.5f;
constexpr int NSLU = 4, CSLU = 256;
constexpr int CW_QU = 8192, CW_QV = 8192 + 64 * 16;
constexpr int CW_BAR = 1024;

#ifndef LDSFILL
#define LDSFILL 0u
#endif
constexpr int LDS_BYTES = 155648;
constexpr int MISC_OFF = LDS_BYTES - 256;

#define GAS __attribute__((address_space(1)))
#define LAS __attribute__((address_space(3)))
typedef unsigned short bf16;
typedef unsigned v4u __attribute__((ext_vector_type(4)));
typedef unsigned v2u __attribute__((ext_vector_type(2)));
typedef float f32x4 __attribute__((ext_vector_type(4)));
typedef float f32x16 __attribute__((ext_vector_type(16)));
typedef short bf16x8 __attribute__((ext_vector_type(8)));
typedef float f32x2_ __attribute__((ext_vector_type(2)));

__device__ __forceinline__ float bf2f(unsigned h) { return __builtin_bit_cast(float, h << 16); }
__device__ __forceinline__ float bflo(unsigned u) { return __builtin_bit_cast(float, u << 16); }
__device__ __forceinline__ float bfhi(unsigned u) { return __builtin_bit_cast(float, u & 0xffff0000u); }
__device__ __forceinline__ unsigned f2bf(float f) { unsigned u = __builtin_bit_cast(unsigned, f); return (u + 0x7fffu + ((u >> 16) & 1u)) >> 16; }
__device__ __forceinline__ unsigned pk2(float lo, float hi) { return f2bf(lo) | (f2bf(hi) << 16); }
__device__ __forceinline__ unsigned cvtpk(float lo, float hi) { unsigned r; asm("v_cvt_pk_bf16_f32 %0, %1, %2" : "=v"(r) : "v"(lo), "v"(hi)); return r; }
__device__ __forceinline__ float sigmoidf_(float x) { return __builtin_amdgcn_rcpf(1.0f + __expf(-x)); }
#define DPP_ADD(s, ctrl) ((s) + __builtin_bit_cast(float, __builtin_amdgcn_update_dpp(0, __builtin_bit_cast(int, (s)), (ctrl), 0xF, 0xF, false)))
__device__ __forceinline__ float wave_sum(float v) {
#pragma unroll
    for (int o = 1; o < 64; o <<= 1) v += __shfl_xor(v, o);
    return v;
}

#define XB_TMO      128
#define XB_XCNT(j)  (256  + 64 * (j))
#define XB_XSUB(j)  (1280 + 64 * (j))
#define XB_XGEN(j)  (2304 + 64 * (j))
#define XB_TOP      3328
#define XB_TOPGEN   3392
#define XCD_BAR_WORDS 3456
#define XB_SPIN_CAP (1u << 18)
__device__ __forceinline__ unsigned xb_ld(unsigned* p)              { return __hip_atomic_load(p, __ATOMIC_RELAXED, __HIP_MEMORY_SCOPE_AGENT); }
__device__ __forceinline__ unsigned xb_add(unsigned* p, unsigned v) { return __hip_atomic_fetch_add(p, v, __ATOMIC_RELAXED, __HIP_MEMORY_SCOPE_AGENT); }
__device__ __forceinline__ unsigned xb_xcc_id() { return (unsigned)__builtin_amdgcn_s_getreg((3 << 11) | 20) & 0xFu; }
#define XB_SPIN(cond, bar) do { unsigned _sp = 0; while (cond) { __builtin_amdgcn_s_sleep(1); \
    if ((++_sp & 255u) == 0u) { if (xb_ld(&(bar)[XB_TMO])) break; if (_sp > XB_SPIN_CAP) { atomicAdd(&(bar)[XB_TMO], 1u); break; } } } } while (0)
struct XcdBarrier { unsigned* bar; unsigned x; volatile LAS unsigned* st; };
__device__ __forceinline__ XcdBarrier xcd_barrier_post(unsigned* bar, volatile LAS unsigned* st) {
    XcdBarrier b; b.bar = bar; b.x = xb_xcc_id(); b.st = st;
    if (threadIdx.x == 0) (void)xb_add(&bar[XB_XCNT(b.x)], 1u);
    return b;
}
__device__ __forceinline__ void xcd_barrier_complete(unsigned* bar, unsigned x, unsigned& nloc, unsigned& nx) {
    const unsigned G = gridDim.x * gridDim.y * gridDim.z;
    unsigned sum, cnt, mine, sp = 0u;
    for (;;) {
        sum = 0u; cnt = 0u; mine = 0u;
#pragma unroll
        for (unsigned j = 0; j < 16; ++j) { const unsigned c = xb_ld(&bar[XB_XCNT(j)]); sum += c; cnt += (c > 0u) ? 1u : 0u; mine = (j == x) ? c : mine; }
        if (sum == G) break;
        __builtin_amdgcn_s_sleep(1);
        if ((++sp & 255u) == 0u) { if (xb_ld(&bar[XB_TMO])) break; if (sp > XB_SPIN_CAP) { atomicAdd(&bar[XB_TMO], 1u); break; } }
    }
    nloc = mine > 0u ? mine : 1u; nx = cnt > 0u ? cnt : 1u;
}
__device__ __forceinline__ void xcd_barrier(const XcdBarrier& b) {
    asm volatile("s_waitcnt vmcnt(0)" ::: "memory");
    __syncthreads();
    if (threadIdx.x == 0) {
        unsigned* bar = b.bar;
        __builtin_amdgcn_s_waitcnt(0);
        unsigned nloc = b.st[0], nx = b.st[1];
        if (nloc == 0u) { xcd_barrier_complete(bar, b.x, nloc, nx); b.st[0] = nloc; b.st[1] = nx; }
        const unsigned old = xb_add(&bar[XB_XSUB(b.x)], 1u);
        const unsigned gen = old / nloc;
        if (old + 1u == (gen + 1u) * nloc) {
            __builtin_amdgcn_fence(__ATOMIC_RELEASE, "agent");
            asm volatile("s_waitcnt vmcnt(0)" ::: "memory");
            const unsigned og = xb_add(&bar[XB_TOP], 1u);
            const unsigned tg = og / nx;
            if (og + 1u == (tg + 1u) * nx) xb_add(&bar[XB_TOPGEN], 1u);
            else XB_SPIN(xb_ld(&bar[XB_TOPGEN]) == tg, bar);
            __builtin_amdgcn_fence(__ATOMIC_ACQUIRE, "agent");
            xb_add(&bar[XB_XGEN(b.x)], 1u);
            asm volatile("s_waitcnt vmcnt(0)" ::: "memory");
        } else {
            XB_SPIN(xb_ld(&bar[XB_XGEN(b.x)]) == gen, bar);
            __builtin_amdgcn_fence(__ATOMIC_ACQUIRE, "agent");
            asm volatile("s_waitcnt vmcnt(0)" ::: "memory");
        }
    }
    __syncthreads();
}

struct Args { const float* in[23]; float* out; unsigned char* ws; int ph_lo, ph_hi; };
struct Frame {
    LAS unsigned char* lds;
    int tid, lane, wave, G, bid;
    const Args* a;
    __device__ __forceinline__ const float* x() const { return a->in[0]; }
    __device__ __forceinline__ const float* c() const { return a->in[1]; }
    __device__ __forceinline__ const float* ada_w() const { return a->in[2]; }
    __device__ __forceinline__ const float* ada_b() const { return a->in[3]; }
    __device__ __forceinline__ const float* g_mix() const { return a->in[4]; }
    __device__ __forceinline__ const float* w_in() const { return a->in[5]; }
    __device__ __forceinline__ const float* lbg_f() const { return a->in[6]; }
    __device__ __forceinline__ const float* lbg_b() const { return a->in[7]; }
    __device__ __forceinline__ const float* hnorm_g() const { return a->in[8]; }
    __device__ __forceinline__ const float* conv_w() const { return a->in[9]; }
    __device__ __forceinline__ const float* conv_b() const { return a->in[10]; }
    __device__ __forceinline__ const float* cln_g() const { return a->in[11]; }
    __device__ __forceinline__ const float* cln_b() const { return a->in[12]; }
    __device__ __forceinline__ const float* w_out() const { return a->in[13]; }
    __device__ __forceinline__ const float* g_ffn() const { return a->in[14]; }
    __device__ __forceinline__ const float* wq() const { return a->in[15]; }
    __device__ __forceinline__ const float* keys1() const { return a->in[16]; }
    __device__ __forceinline__ const float* keys2() const { return a->in[17]; }
    __device__ __forceinline__ const float* utab() const { return a->in[18]; }
    __device__ __forceinline__ const float* vtab() const { return a->in[19]; }
    __device__ __forceinline__ const float* fada_w() const { return a->in[20]; }
    __device__ __forceinline__ const float* fada_b() const { return a->in[21]; }
    __device__ __forceinline__ const float* fnorm_g() const { return a->in[22]; }
    __device__ __forceinline__ float* out() const { return a->out; }
    __device__ __forceinline__ float* mod() const { return (float*)(a->ws + WS_MOD); }
    __device__ __forceinline__ float* fmod() const { return (float*)(a->ws + WS_FMOD); }
    __device__ __forceinline__ float* lb() const { return (float*)(a->ws + WS_LB); }
    __device__ __forceinline__ float* biasq() const { return (float*)(a->ws + WS_BIASQ); }
    __device__ __forceinline__ float* ssqp() const { return (float*)(a->ws + WS_SSQ); }
    __device__ __forceinline__ float* sega() const { return (float*)(a->ws + WS_SEGA); }
    __device__ __forceinline__ float* segu() const { return (float*)(a->ws + WS_SEG); }
    __device__ __forceinline__ float* of() const { return (float*)(a->ws + WS_BUFB); }
    __device__ __forceinline__ float* scores() const { return (float*)(a->ws + WS_BIG); }
    __device__ __forceinline__ float* wsel() const { return (float*)(a->ws + WS_W); }
    __device__ __forceinline__ int* esel() const { return (int*)(a->ws + WS_E); }
    __device__ __forceinline__ bf16* Win_t() const { return (bf16*)(a->ws + WS_WIN); }
    __device__ __forceinline__ bf16* Wout_t() const { return (bf16*)(a->ws + WS_WOUT); }
    __device__ __forceinline__ bf16* Wqk_t() const { return (bf16*)(a->ws + WS_WQK); }
    __device__ __forceinline__ bf16* Ub() const { return (bf16*)(a->ws + WS_UT); }
    __device__ __forceinline__ bf16* Vb() const { return (bf16*)(a->ws + WS_VT); }
    __device__ __forceinline__ bf16* bufA() const { return (bf16*)(a->ws + WS_BUFA); }
    __device__ __forceinline__ bf16* hg() const { return (bf16*)(a->ws + WS_BUFB); }
    __device__ __forceinline__ bf16* proj() const { return (bf16*)(a->ws + WS_BIG); }
    __device__ __forceinline__ float* coef() const { return (float*)(a->ws + WS_BUFA); }
    __device__ __forceinline__ float* rstd() const { return (float*)(a->ws + WS_RSTD); }
    __device__ __forceinline__ bf16* pact() const { return (bf16*)(a->ws + WS_PACT); }
    __device__ __forceinline__ bf16* ybuf() const { return (bf16*)(a->ws + WS_Y); }
    __device__ __forceinline__ unsigned char* U8() const { return (unsigned char*)(a->ws + WS_UT); }
    __device__ __forceinline__ unsigned char* V8() const { return (unsigned char*)(a->ws + WS_VT); }
    __device__ __forceinline__ unsigned* ctl() const { return (unsigned*)(a->ws + WS_CTL); }
};

__device__ __forceinline__ void p0_gemv(Frame& F) {
    LAS float* cact = (LAS float*)(F.lds);
    LAS float* red = (LAS float*)(F.lds + 16384);
    for (int i = F.tid; i < 4096; i += NTHR) { const float c = F.c()[i]; cact[i] = c * sigmoidf_(c); }
    __syncthreads();
    for (int item = F.bid; item < 128; item += F.G) {
        const int col0 = item * 64; const float* W; int N, cc;
        if (col0 < 6144) { W = F.ada_w(); N = 6144; cc = col0; } else { W = F.fada_w(); N = 2048; cc = col0 - 6144; }
        const float* wp = W + (size_t)(F.wave * 128) * N + cc + F.lane;
        float a0 = 0.f, a1 = 0.f, a2 = 0.f, a3 = 0.f;
#pragma unroll 32
        for (int k = 0; k < 128; ++k) { const float w = wp[(size_t)k * N]; const int kk = F.wave * 128 + k;
            a0 += cact[kk] * w; a1 += cact[1024 + kk] * w; a2 += cact[2048 + kk] * w; a3 += cact[3072 + kk] * w; }
        red[(F.wave * 4 + 0) * 64 + F.lane] = a0; red[(F.wave * 4 + 1) * 64 + F.lane] = a1; red[(F.wave * 4 + 2) * 64 + F.lane] = a2; red[(F.wave * 4 + 3) * 64 + F.lane] = a3;
        __syncthreads();
        if (F.tid < 256) { const int b = F.tid >> 6, l = F.tid & 63; float s = 0.f;
#pragma unroll
            for (int w = 0; w < 8; ++w) s += red[(w * 4 + b) * 64 + l];
            if (col0 < 6144) F.mod()[b * 6144 + cc + l] = s + F.ada_b()[cc + l]; else F.fmod()[b * 2048 + cc + l] = s + F.fada_b()[cc + l]; }
        __syncthreads();
    }
}
__device__ __forceinline__ void p0_transpose_item(const float* W, int K, int N, bf16* WT, LAS float* scr, int item, int lane) {
    const int nblk = N / 32, kb = item / nblk, nb = item % nblk, k0 = 64 * kb, n0 = 32 * nb;
#pragma unroll
    for (int i = 0; i < 32; ++i) { const int kk = 2 * i + (lane >> 5); scr[kk * 33 + (lane & 31)] = W[(size_t)(k0 + kk) * N + n0 + (lane & 31)]; }
    asm volatile("s_waitcnt lgkmcnt(0)" ::: "memory");
    const int c = lane & 7;
#pragma unroll
    for (int j = 0; j < 4; ++j) { const int n = (lane >> 3) + 8 * j; const LAS float* s = scr + (8 * c) * 33 + n;
        v4u o; o.x = pk2(s[0 * 33], s[1 * 33]); o.y = pk2(s[2 * 33], s[3 * 33]); o.z = pk2(s[4 * 33], s[5 * 33]); o.w = pk2(s[6 * 33], s[7 * 33]);
        *(v4u*)(WT + (size_t)(n0 + n) * K + k0 + 8 * c) = o; }
    asm volatile("s_waitcnt lgkmcnt(0)" ::: "memory");
}
__device__ __forceinline__ void p0_wqk_item(Frame& F, int item, LAS float* scr) {
    const int jq = item & 7, kb = (item >> 3) & 15, hh = item >> 7, h = hh >> 1, half = hh & 1;
    const float* keys = (half ? F.keys2() : F.keys1()) + (size_t)(jq * 16) * 128;
    const float* wtile = F.wq() + (size_t)(kb * 64) * 2048 + h * 256 + half * 128;
    LAS float* kL = scr + 1280;
    { f32x4 k4[8];
#pragma unroll
      for (int i = 0; i < 8; ++i) k4[i] = *(const f32x4*)(keys + (i * 64 + F.lane) * 4);
#pragma unroll
      for (int i = 0; i < 8; ++i) *(LAS f32x4*)(kL + (i * 64 + F.lane) * 4) = k4[i]; }
    float acc[16];
#pragma unroll
    for (int j = 0; j < 16; ++j) acc[j] = 0.f;
    f32x4 t4[4], n4[4];
#pragma unroll
    for (int i = 0; i < 4; ++i) t4[i] = *(const f32x4*)(wtile + (size_t)(16 * i + (F.lane >> 2)) * 2048 + 4 * (F.lane & 3));
    for (int d0 = 0; d0 < 128; d0 += 16) {
        if (d0 + 16 < 128) {
#pragma unroll
            for (int i = 0; i < 4; ++i) n4[i] = *(const f32x4*)(wtile + (size_t)(16 * i + (F.lane >> 2)) * 2048 + d0 + 16 + 4 * (F.lane & 3)); }
#pragma unroll
        for (int i = 0; i < 4; ++i) *(LAS f32x4*)(scr + (16 * i + (F.lane >> 2)) * 20 + 4 * (F.lane & 3)) = t4[i];
        asm volatile("s_waitcnt lgkmcnt(0)" ::: "memory");
#pragma unroll
        for (int dd = 0; dd < 16; dd += 4) { const f32x4 a = *(LAS const f32x4*)(scr + F.lane * 20 + dd);
#pragma unroll
            for (int j = 0; j < 16; ++j) { const f32x4 kp = *(LAS const f32x4*)(kL + j * 128 + d0 + dd); acc[j] += a[0] * kp[0] + a[1] * kp[1] + a[2] * kp[2] + a[3] * kp[3]; } }
        asm volatile("s_waitcnt lgkmcnt(0)" ::: "memory");
#pragma unroll
        for (int i = 0; i < 4; ++i) t4[i] = n4[i];
    }
    bf16* o = F.Wqk_t() + (size_t)(h * 256 + half * 128 + jq * 16) * 1024 + kb * 64 + F.lane;
#pragma unroll
    for (int j = 0; j < 16; ++j) o[(size_t)j * 1024] = (bf16)f2bf(acc[j]);
}
__device__ __forceinline__ void p0_prologue(Frame& F) {
    if (F.bid < 128) p0_gemv(F);
    if (F.bid == 128 % F.G) { const int i = F.tid;
        F.lb()[i] = __builtin_amdgcn_rcpf(1.0f + __expf(F.lbg_f()[512 + i] - F.lbg_f()[i]));
        F.lb()[512 + i] = __builtin_amdgcn_rcpf(1.0f + __expf(F.lbg_b()[512 + i] - F.lbg_b()[i])); }
    LAS float* scr = (LAS float*)(F.lds + 32768 + F.wave * 14336);
    const int gw = F.wave * F.G + F.bid, NGW = F.G * NWAVES;
    constexpr int I_QK = 2048, I_IN = (D / 64) * (NIN / 32), I_OUT = (D / 64) * (D / 32), I_TAB = 2 * 16384 / 4;
    constexpr int NITEMS = I_QK + I_IN + I_OUT + I_TAB;
    for (int it = gw; it < NITEMS; it += NGW) {
        int r = it;
        if (r < I_QK) { p0_wqk_item(F, r, scr); continue; } r -= I_QK;
        if (r < I_IN) { p0_transpose_item(F.w_in(), D, NIN, F.Win_t(), scr, r, F.lane); continue; } r -= I_IN;
        if (r < I_OUT) { p0_transpose_item(F.w_out(), D, D, F.Wout_t(), scr, r, F.lane); continue; } r -= I_OUT;
        { const int tab = r >= 4096, rr = (tab ? r - 4096 : r) * 4; const float* src = (tab ? F.vtab() : F.utab()) + (size_t)rr * 1024; unsigned char* dst = tab ? F.V8() : F.U8();
          const float sc = tab ? VSCALE : UQSCALE;
#pragma unroll
          for (int q = 0; q < 16; ++q) { const int row = rr + (q >> 2), qq = q & 3; const f32x4 v = *(const f32x4*)(src + (q >> 2) * 1024 + qq * 256 + 4 * F.lane) * sc;
              int pk;
              if (tab) { pk = __builtin_amdgcn_cvt_pk_fp8_f32(v[0], v[1], 0, false); pk = __builtin_amdgcn_cvt_pk_fp8_f32(v[2], v[3], pk, true); }
              else { int q0 = (int)__builtin_rintf(v[0]), q1 = (int)__builtin_rintf(v[1]), q2 = (int)__builtin_rintf(v[2]), q3 = (int)__builtin_rintf(v[3]);
                  q0 = q0 < -7 ? -7 : (q0 > 7 ? 7 : q0); q1 = q1 < -7 ? -7 : (q1 > 7 ? 7 : q1); q2 = q2 < -7 ? -7 : (q2 > 7 ? 7 : q2); q3 = q3 < -7 ? -7 : (q3 > 7 ? 7 : q3);
                  *(unsigned short*)(dst + ((size_t)qq * 16384 + row) * 128 + 2 * F.lane) = (unsigned short)((q0 & 0xf) | ((q1 & 0xf) << 4) | ((q2 & 0xf) << 8) | ((q3 & 0xf) << 12)); continue; }
              const int sl = 2 * qq + (F.lane >> 5);
              *(int*)(dst + ((size_t)sl * 16384 + row) * CSL + 4 * (F.lane & 31)) = pk; } }
    }
}

__device__ __forceinline__ void p1_norm(Frame& F) {
    const int gwc = F.bid * NWAVES + F.wave, NGW = F.G * NWAVES;
    for (int row0 = gwc * 16; row0 < T; row0 += NGW * 16) {
        const int b = row0 >> 13; const float* mb = F.mod() + b * 6144;
        f32x4 ca[4], cb[4];
#pragma unroll
        for (int j = 0; j < 4; ++j) { const int k = 256 * j + 4 * F.lane; const f32x4 g = *(const f32x4*)(F.g_mix() + k), s = *(const f32x4*)(mb + 1024 + k); ca[j] = g * (s + 1.0f); cb[j] = *(const f32x4*)(mb + k); }
#pragma unroll 4
        for (int r = 0; r < 16; ++r) { const float* xr = F.x() + (size_t)(row0 + r) * D;
            f32x4 v[4]; float ss = 0.f;
#pragma unroll
            for (int j = 0; j < 4; ++j) { v[j] = *(const f32x4*)(xr + 256 * j + 4 * F.lane); ss += v[j][0] * v[j][0] + v[j][1] * v[j][1] + v[j][2] * v[j][2] + v[j][3] * v[j][3]; }
            const float rstd = __builtin_amdgcn_rsqf(wave_sum(ss) * (1.0f / D) + EPS);
            bf16* o = F.bufA() + (size_t)(row0 + r) * D;
#pragma unroll
            for (int j = 0; j < 4; ++j) { const f32x4 y = v[j] * rstd * ca[j] + cb[j]; v2u w; w.x = pk2(y[0], y[1]); w.y = pk2(y[2], y[3]); *(v2u*)(o + 256 * j + 4 * F.lane) = w; } }
    }
    const int gw = F.wave * F.G + F.bid;
    for (int n0 = gw * 32; n0 < NQK; n0 += NGW * 32) {
        float sv[4][16];
#pragma unroll
        for (int b = 0; b < 4; ++b) { const float* sh2 = F.mod() + b * 6144 + 3072;
#pragma unroll
            for (int i = 0; i < 8; ++i) { sv[b][i] = sh2[8 * F.lane + i]; sv[b][8 + i] = sh2[512 + 8 * F.lane + i]; } }
        float res[4] = {0.f, 0.f, 0.f, 0.f};
        for (int q = 0; q < 32; ++q) { const int n = n0 + q;
            const v4u w0 = *(const v4u*)(F.Wqk_t() + (size_t)n * 1024 + 8 * F.lane), w1 = *(const v4u*)(F.Wqk_t() + (size_t)n * 1024 + 512 + 8 * F.lane);
            float wv[16];
#pragma unroll
            for (int i = 0; i < 4; ++i) { wv[2 * i] = bflo(w0[i]); wv[2 * i + 1] = bfhi(w0[i]); wv[8 + 2 * i] = bflo(w1[i]); wv[8 + 2 * i + 1] = bfhi(w1[i]); }
#pragma unroll
            for (int b = 0; b < 4; ++b) { float sm = 0.f;
#pragma unroll
                for (int i = 0; i < 16; ++i) sm += wv[i] * sv[b][i];
                sm = wave_sum(sm); if (F.lane == q) res[b] = sm; } }
        if (F.lane < 32) {
#pragma unroll
            for (int b = 0; b < 4; ++b) F.biasq()[b * 2048 + n0 + F.lane] = res[b]; }
    }
}

__device__ __forceinline__ void conv_item(Frame& F, int item, const float (&cw)[CW], float cbias) {
    LAS bf16* hbuf = (LAS bf16*)(F.lds);
    LAS float* ybuf = (LAS float*)(F.lds + 65536);
    const int tok0 = item * 32, b = tok0 >> 13, t0 = tok0 & (SEQ - 1), c = F.tid;
#pragma unroll
    for (int k = 0; k < 8; ++k) { const int pi = F.tid + NTHR * k; if (pi < 62 * 64) { const int r = pi >> 6, ch = pi & 63, t = t0 - CPAD + r; v4u o = {0u, 0u, 0u, 0u};
            if (t >= 0 && t < SEQ) { const bf16* pr = F.proj() + (size_t)(b * SEQ + t) * NIN + 8 * ch; const v4u a = *(const v4u*)(pr + 2560), g = *(const v4u*)(pr + 3072);
#pragma unroll
                for (int i = 0; i < 4; ++i) o[i] = cvtpk(bflo(a[i]) * bflo(g[i]), bfhi(a[i]) * bfhi(g[i])); }
            *(LAS v4u*)(hbuf + r * 512 + 8 * ch) = o; } }
    __syncthreads();
    float hv[62];
#pragma unroll
    for (int r = 0; r < 62; ++r) hv[r] = bf2f(hbuf[r * 512 + c]);
#pragma unroll
    for (int tt = 0; tt < 32; ++tt) { float acc = cbias;
#pragma unroll
        for (int j = 0; j < CW; ++j) acc += cw[j] * hv[tt + j];
        ybuf[tt * 512 + c] = acc; }
    __syncthreads();
#pragma unroll
    for (int q = 0; q < 4; ++q) { const int tt = F.wave * 4 + q;
        const f32x4 y0 = *(LAS const f32x4*)(ybuf + tt * 512 + 8 * F.lane), y1 = *(LAS const f32x4*)(ybuf + tt * 512 + 8 * F.lane + 4);
        const float mean = wave_sum((y0[0] + y0[1] + y0[2] + y0[3]) + (y1[0] + y1[1] + y1[2] + y1[3])) * (1.0f / DC);
        const f32x4 d0 = y0 - mean, d1 = y1 - mean;
        const float var = wave_sum((d0[0] * d0[0] + d0[1] * d0[1] + d0[2] * d0[2] + d0[3] * d0[3]) + (d1[0] * d1[0] + d1[1] * d1[1] + d1[2] * d1[2] + d1[3] * d1[3])) * (1.0f / DC);
        const float rstd = __builtin_amdgcn_rsqf(var + EPS);
        const f32x4 g0 = *(const f32x4*)(F.cln_g() + 8 * F.lane), g1 = *(const f32x4*)(F.cln_g() + 8 * F.lane + 4), b0 = *(const f32x4*)(F.cln_b() + 8 * F.lane), b1 = *(const f32x4*)(F.cln_b() + 8 * F.lane + 4);
        f32x4 z0 = d0 * rstd * g0 + b0, z1 = d1 * rstd * g1 + b1;
#pragma unroll
        for (int i = 0; i < 4; ++i) { z0[i] = z0[i] * sigmoidf_(z0[i]); z1[i] = z1[i] * sigmoidf_(z1[i]); }
        v4u w; w.x = cvtpk(z0[0], z0[1]); w.y = cvtpk(z0[2], z0[3]); w.z = cvtpk(z1[0], z1[1]); w.w = cvtpk(z1[2], z1[3]);
        *(v4u*)(F.bufA() + (size_t)(tok0 + tt) * D + 512 + 8 * F.lane) = w; }
    __syncthreads();
}

constexpr int PQ = 272, PT = 144;
constexpr int HL_QR = 0, HL_KR = 17408, HL_QE = 34816, HL_KET = 52224, HL_VT = 70656, HL_SCM = 89088, HL_ST = 98304, HL_PBLK = 133120  , HL_AV = 137216, HL_RS = 137728;
static_assert(HL_PBLK + 8 * 128 * 4 <= HL_AV && HL_AV + 512 <= HL_RS && HL_RS + 1024 <= 155648 - 256, "HGRN LDS map");
__device__ __forceinline__ bf16x8 ldf(LAS const unsigned char* base, int row, int pitch, int kbyte) { return *(LAS const bf16x8*)(base + row * pitch + kbyte); }
#define MFMA32(a, b, c) __builtin_amdgcn_mfma_f32_32x32x16_bf16((a), (b), (c), 0, 0, 0)

template <bool FULL>
__device__ __forceinline__ void hgrn_load(Frame& F, int b, int h, int dir, int chunk, unsigned (&rz)[8], unsigned (&rv)[8], unsigned (&rq)[8]) {
    const size_t tokbase = (size_t)b * SEQ + (size_t)chunk * CHK; const int zoff = dir ? 1024 : 512, c0 = 2 * F.lane;
#pragma unroll
    for (int i = 0; i < 8; ++i) { const int p = 8 * F.wave + i, tr = dir ? (63 - p) : p; const bf16* q = F.proj() + (tokbase + tr) * NIN + h * HD;
        rz[i] = *(const unsigned*)(q + zoff + c0); rv[i] = *(const unsigned*)(q + 1536 + c0); if (FULL) rq[i] = *(const unsigned*)(q + c0); }
}
template <bool FULL, int MODE>
__device__ __forceinline__ void hgrn_chunk(Frame& F, int b, int h, int dir, int chunk, int nchunk, f32x16 (&accS)[2], float lb0, float lb1, unsigned (&rz)[8], unsigned (&rv)[8], unsigned (&rq)[8]) {
    LAS unsigned char* lds = F.lds;
    int r = F.lane & 31, hh = F.lane >> 5, c0 = 2 * F.lane;
    asm volatile("" : "+v"(r), "+v"(hh), "+v"(c0));
    const int w = F.wave, rb = w;
    const size_t tokbase = (size_t)b * SEQ + (size_t)chunk * CHK;
    {
        const f32x2_ oml = {1.0f - lb0, 1.0f - lb1};
        f32x2_ f2[8], cf2[8], cr2[8];
        f32x2_ run = {1.f, 1.f};
#pragma unroll
        for (int i = 0; i < 8; ++i) { const f32x2_ kk = {bflo(rz[i]), bfhi(rz[i])}; f2[i] = 1.0f - oml * kk; run *= f2[i]; cf2[i] = run; }
        { f32x2_ q = {1.f, 1.f};
#pragma unroll
          for (int i = 7; i >= 0; --i) { cr2[i] = q; q *= f2[i]; } }
        LAS float* pblk = (LAS float*)(lds + HL_PBLK);
        *(LAS f32x2_*)(pblk + rb * 128 + c0) = run;
        __syncthreads();
        f32x2_ pre = {1.f, 1.f}, post = {1.f, 1.f}, mid = {1.f, 1.f};
        for (int q = 0; q < rb; ++q) pre *= *(LAS const f32x2_*)(pblk + q * 128 + c0);
        for (int q = rb + 1; q < 8; ++q) post *= *(LAS const f32x2_*)(pblk + q * 128 + c0);
        if (rb < 4) { for (int q = rb + 1; q < 4; ++q) mid *= *(LAS const f32x2_*)(pblk + q * 128 + c0); }
        else { for (int q = 4; q < rb; ++q) mid *= *(LAS const f32x2_*)(pblk + q * 128 + c0); }
        if (rb == 0) *(LAS f32x2_*)((LAS float*)(lds + HL_AV) + c0) = run * post;
        f32x2_ ke2[8];
#pragma unroll
        for (int i = 0; i < 8; ++i) ke2[i] = (1.0f - f2[i]) * cr2[i] * post;
        if (FULL) {
            if (rb < 4) {
#pragma unroll
                for (int i = 0; i < 8; ++i) { const int p = 8 * rb + i; const f32x2_ qs = {bflo(rq[i]), bfhi(rq[i])}, k2 = 1.0f - f2[i], G = cr2[i] * mid;
                    f32x2_ iG; iG[0] = __builtin_amdgcn_rcpf(G[0]); iG[1] = __builtin_amdgcn_rcpf(G[1]);
                    const f32x2_ qe = qs * pre * cf2[i], qr = qs * iG, kr = k2 * G;
                    *(LAS unsigned*)(lds + HL_QE + p * PQ + c0 * 2) = cvtpk(qe[0], qe[1]);
                    *(LAS unsigned*)(lds + HL_QR + p * PQ + c0 * 2) = cvtpk(qr[0], qr[1]);
                    *(LAS unsigned*)(lds + HL_KR + p * PQ + c0 * 2) = cvtpk(kr[0], kr[1]); }
            } else {
#pragma unroll
                for (int i = 0; i < 8; ++i) { const int p = 8 * rb + i; const f32x2_ qs = {bflo(rq[i]), bfhi(rq[i])}, k2 = 1.0f - f2[i], G = cf2[i] * mid;
                    f32x2_ iG; iG[0] = __builtin_amdgcn_rcpf(G[0]); iG[1] = __builtin_amdgcn_rcpf(G[1]);
                    const f32x2_ qe = qs * pre * cf2[i], qr = qs * G, kr = k2 * iG;
                    *(LAS unsigned*)(lds + HL_QE + p * PQ + c0 * 2) = cvtpk(qe[0], qe[1]);
                    *(LAS unsigned*)(lds + HL_QR + p * PQ + c0 * 2) = cvtpk(qr[0], qr[1]);
                    *(LAS unsigned*)(lds + HL_KR + p * PQ + c0 * 2) = cvtpk(kr[0], kr[1]); }
            }
        }
        v4u ka, kb, va, vb2;
        ka.x = cvtpk(ke2[0][0], ke2[1][0]); ka.y = cvtpk(ke2[2][0], ke2[3][0]); ka.z = cvtpk(ke2[4][0], ke2[5][0]); ka.w = cvtpk(ke2[6][0], ke2[7][0]);
        kb.x = cvtpk(ke2[0][1], ke2[1][1]); kb.y = cvtpk(ke2[2][1], ke2[3][1]); kb.z = cvtpk(ke2[4][1], ke2[5][1]); kb.w = cvtpk(ke2[6][1], ke2[7][1]);
        va.x = (rv[0] & 0xffffu) | (rv[1] << 16); va.y = (rv[2] & 0xffffu) | (rv[3] << 16); va.z = (rv[4] & 0xffffu) | (rv[5] << 16); va.w = (rv[6] & 0xffffu) | (rv[7] << 16);
        vb2.x = (rv[0] >> 16) | (rv[1] & 0xffff0000u); vb2.y = (rv[2] >> 16) | (rv[3] & 0xffff0000u); vb2.z = (rv[4] >> 16) | (rv[5] & 0xffff0000u); vb2.w = (rv[6] >> 16) | (rv[7] & 0xffff0000u);
        *(LAS v4u*)(lds + HL_KET + c0 * PT + 16 * rb) = ka; *(LAS v4u*)(lds + HL_KET + (c0 + 1) * PT + 16 * rb) = kb;
        *(LAS v4u*)(lds + HL_VT + c0 * PT + 16 * rb) = va; *(LAS v4u*)(lds + HL_VT + (c0 + 1) * PT + 16 * rb) = vb2;
    }
    if (nchunk >= 0) hgrn_load<FULL>(F, b, h, dir, nchunk, rz, rv, rq);
    __syncthreads();
    const int pbO = w & 1, vb = w >> 1;
    f32x16 accO, accU[2];
#pragma unroll
    for (int i = 0; i < 16; ++i) { accO[i] = 0.f; accU[0][i] = 0.f; accU[1][i] = 0.f; }
    if (FULL) {
        if (w < 3) { const int pbS = (w + 1) >> 1, sbS = (w == 2) ? 1 : 0; f32x16 sc;
#pragma unroll
            for (int i = 0; i < 16; ++i) sc[i] = 0.f;
#pragma unroll
            for (int s = 0; s < 8; ++s) sc = MFMA32(ldf(lds + HL_QR, pbS * 32 + r, PQ, 32 * s + 16 * hh), ldf(lds + HL_KR, sbS * 32 + r, PQ, 32 * s + 16 * hh), sc);
#pragma unroll
            for (int i = 0; i < 16; i += 2) { const int p = pbS * 32 + (i & 3) + 8 * (i >> 2) + 4 * hh, s = sbS * 32 + r;
                const unsigned pkd = cvtpk(s <= p ? sc[i] : 0.f, s <= p + 1 ? sc[i + 1] : 0.f);
                *(LAS bf16*)(lds + HL_SCM + p * PT + s * 2) = (bf16)pkd; *(LAS bf16*)(lds + HL_SCM + (p + 1) * PT + s * 2) = (bf16)(pkd >> 16); } }
        __builtin_amdgcn_sched_barrier(0);
#pragma unroll
        for (int s = 0; s < 8; ++s) accO = MFMA32(ldf(lds + HL_QE, pbO * 32 + r, PQ, 32 * s + 16 * hh), ldf(lds + HL_ST, vb * 32 + r, PQ, 32 * s + 16 * hh), accO);
        __builtin_amdgcn_sched_barrier(0);
    }
#pragma unroll
    for (int i = 0; i < 2; ++i) { const int db = 2 * (w & 1) + i;
#pragma unroll
        for (int s = 0; s < 4; ++s) accU[i] = MFMA32(ldf(lds + HL_VT, vb * 32 + r, PT, 32 * s + 16 * hh), ldf(lds + HL_KET, db * 32 + r, PT, 32 * s + 16 * hh), accU[i]); }
    __builtin_amdgcn_sched_barrier(0);
    if (FULL) __syncthreads();
    if (FULL) {
        const unsigned v = vb * 32 + r;
        const unsigned lrow = (MODE == 0 ? (unsigned)hh : (unsigned)(1 - hh)) * 4u;
        const size_t rbase = (MODE == 0) ? (tokbase + pbO * 32) : (tokbase + 63 - pbO * 32 - 4);
        const unsigned lo_of = lrow * DH + v, lo_pr = lrow * NIN + v, lo_a2 = lrow * D + v;
        float ofv[16]; unsigned gv[16];
        if (MODE == 1) {
#pragma unroll
            for (int i = 0; i < 16; ++i) { const int ci = (i & 3) + 8 * (i >> 2); ofv[i] = (F.of() + (rbase - ci) * DH + h * HD)[lo_of]; } }
        for (int sb = 0; sb <= pbO; ++sb)
#pragma unroll
            for (int s2 = 0; s2 < 2; ++s2) accO = MFMA32(ldf(lds + HL_SCM, pbO * 32 + r, PT, 64 * sb + 32 * s2 + 16 * hh), ldf(lds + HL_VT, vb * 32 + r, PT, 64 * sb + 32 * s2 + 16 * hh), accO);
        if (MODE == 0) {
#pragma unroll
            for (int i = 0; i < 16; ++i) { const int ci = (i & 3) + 8 * (i >> 2); (F.of() + (rbase + ci) * DH + h * HD)[lo_of] = accO[i]; }
        } else {
            LAS float* rs = (LAS float*)(lds + HL_RS);
#pragma unroll
            for (int i = 0; i < 16; ++i) { const int ci = (i & 3) + 8 * (i >> 2); gv[i] = (F.proj() + (rbase - ci) * NIN + 2048 + h * HD)[lo_pr]; }
            float ov[16];
#pragma unroll
            for (int i = 0; i < 16; ++i) { const int ci = (i & 3) + 8 * (i >> 2), p = pbO * 32 + ci + 4 * hh;
                ov[i] = accO[i] + ofv[i]; float ss = ov[i] * ov[i];
                ss = DPP_ADD(ss, 0x128); ss = DPP_ADD(ss, 0x124); ss = DPP_ADD(ss, 0x122); ss = DPP_ADD(ss, 0x121); ss += __shfl_xor(ss, 16);
                if (r == 0) rs[p * 4 + vb] = ss; }
            __syncthreads();
            const float ng = F.hnorm_g()[h * HD + v];
#pragma unroll
            for (int i = 0; i < 16; ++i) { const int ci = (i & 3) + 8 * (i >> 2), p = pbO * 32 + ci + 4 * hh;
                const f32x4 q = *(LAS const f32x4*)(rs + p * 4);
                const float rstd = __builtin_amdgcn_rsqf((q[0] + q[1] + q[2] + q[3]) * (1.0f / HD) + EPS);
                const float g = bf2f(gv[i]);
                (F.bufA() + (rbase - ci) * D + h * HD)[lo_a2] = (bf16)cvtpk(ov[i] * rstd * ng * g, 0.f); }
        }
    }
    {
        const LAS float* av = (const LAS float*)(lds + HL_AV);
#pragma unroll
        for (int i = 0; i < 2; ++i) { const int db = 2 * (w & 1) + i; const float a = av[db * 32 + r];
#pragma unroll
            for (int j = 0; j < 16; j += 2) { const float s0 = accS[i][j] * a + accU[i][j], s1 = accS[i][j + 1] * a + accU[i][j + 1]; accS[i][j] = s0; accS[i][j + 1] = s1;
                if (FULL) { const int vv = vb * 32 + (j & 3) + 8 * (j >> 2) + 4 * hh; const unsigned pkd = cvtpk(s0, s1);
                    *(LAS bf16*)(lds + HL_ST + vv * PQ + (db * 32 + r) * 2) = (bf16)pkd; *(LAS bf16*)(lds + HL_ST + (vv + 1) * PQ + (db * 32 + r) * 2) = (bf16)(pkd >> 16); } } }
    }
    __syncthreads();
}
__device__ __forceinline__ void h1_item(Frame& F, int item) {
    const int seg = item & 15, dir = (item >> 4) & 1, h = (item >> 5) & 3, b = item >> 7;
    const float lb0 = F.lb()[dir * 512 + h * HD + 2 * F.lane], lb1 = F.lb()[dir * 512 + h * HD + 2 * F.lane + 1];
    f32x16 accS[2];
#pragma unroll
    for (int i = 0; i < 16; ++i) { accS[0][i] = 0.f; accS[1][i] = 0.f; }
    float atot = 1.f; const int col = F.tid & 127;
    unsigned rzA[8], rvA[8], rzB[8], rvB[8], rq[8];
#define H1CH(c) (seg * SEGC + (dir ? (SEGC - 1 - (c)) : (c)))
    hgrn_load<false>(F, b, h, dir, H1CH(0), rzA, rvA, rq); hgrn_load<false>(F, b, h, dir, H1CH(1), rzB, rvB, rq);
    for (int c = 0; c < SEGC; c += 2) {
        hgrn_chunk<false, 0>(F, b, h, dir, H1CH(c), (c + 2 < SEGC) ? H1CH(c + 2) : -1, accS, lb0, lb1, rzA, rvA, rq);
        atot *= ((const LAS float*)(F.lds + HL_AV))[col];
        hgrn_chunk<false, 0>(F, b, h, dir, H1CH(c + 1), (c + 3 < SEGC) ? H1CH(c + 3) : -1, accS, lb0, lb1, rzB, rvB, rq);
        atot *= ((const LAS float*)(F.lds + HL_AV))[col]; }
#undef H1CH
    if (F.tid < 128) F.sega()[(size_t)item * 128 + col] = atot;
    float* U = F.segu() + (size_t)item * 16384;
#pragma unroll
    for (int i = 0; i < 2; ++i)
#pragma unroll
        for (int j = 0; j < 16; j += 4) { f32x4 o; o[0] = accS[i][j]; o[1] = accS[i][j + 1]; o[2] = accS[i][j + 2]; o[3] = accS[i][j + 3]; ((f32x4*)(U + (i * 4 + (j >> 2)) * NTHR * 4))[F.tid] = o; }
}
__device__ __forceinline__ void h2_init_state(Frame& F, int b, int h, int dir, int seg, f32x16 (&accS)[2]) {
    const int w = F.wave, r = F.lane & 31, hh = F.lane >> 5, vb = w >> 1;
#pragma unroll
    for (int i = 0; i < 16; ++i) { accS[0][i] = 0.f; accS[1][i] = 0.f; }
    const int base = ((b * 4 + h) * 2 + dir) * 16;
    const int n = dir ? (NSEG - 1 - seg) : seg;
    for (int q0 = 0; q0 < n; q0 += 3) {
        f32x4 u4[3][8]; float av[3][2];
#pragma unroll
        for (int t = 0; t < 3; ++t) { const int q = (q0 + t < n) ? (q0 + t) : (n - 1); const int s = dir ? (NSEG - 1 - q) : q;
            const float* U = F.segu() + (size_t)(base + s) * 16384; const float* A = F.sega() + (size_t)(base + s) * 128;
#pragma unroll
            for (int i = 0; i < 2; ++i) av[t][i] = (A + (2 * (w & 1) + i) * 32)[r];
#pragma unroll
            for (int k = 0; k < 8; ++k) u4[t][k] = ((const f32x4*)(U + k * NTHR * 4))[F.tid]; }
#pragma unroll
        for (int t = 0; t < 3; ++t) { if (q0 + t < n) {
#pragma unroll
            for (int i = 0; i < 2; ++i) { const float a = av[t][i];
#pragma unroll
                for (int j = 0; j < 16; j += 4) { const f32x4 v = u4[t][i * 4 + (j >> 2)];
                    accS[i][j] = accS[i][j] * a + v[0]; accS[i][j + 1] = accS[i][j + 1] * a + v[1]; accS[i][j + 2] = accS[i][j + 2] * a + v[2]; accS[i][j + 3] = accS[i][j + 3] * a + v[3]; } } } }
    }
#pragma unroll
    for (int i = 0; i < 2; ++i) { const int db = 2 * (w & 1) + i;
#pragma unroll
        for (int j = 0; j < 16; ++j) { const int vv = vb * 32 + (j & 3) + 8 * (j >> 2) + 4 * hh; *(LAS bf16*)(F.lds + HL_ST + vv * PQ + (db * 32 + r) * 2) = (bf16)f2bf(accS[i][j]); } }
    __syncthreads();
}
__device__ __forceinline__ void h2_item(Frame& F, int item) {
    const int seg = item & 15, h = (item >> 4) & 3, b = item >> 6;
    f32x16 accS[2];
    unsigned rzA[8], rvA[8], rqA[8], rzB[8], rvB[8], rqB[8];
    { const float lb0 = F.lb()[h * HD + 2 * F.lane], lb1 = F.lb()[h * HD + 2 * F.lane + 1];
      const int c0 = seg * SEGC;
      hgrn_load<true>(F, b, h, 0, c0, rzA, rvA, rqA); hgrn_load<true>(F, b, h, 0, c0 + 1, rzB, rvB, rqB);
      h2_init_state(F, b, h, 0, seg, accS);
      for (int c = 0; c < SEGC; c += 2) {
          hgrn_chunk<true, 0>(F, b, h, 0, c0 + c, (c + 2 < SEGC) ? (c0 + c + 2) : -1, accS, lb0, lb1, rzA, rvA, rqA);
          hgrn_chunk<true, 0>(F, b, h, 0, c0 + c + 1, (c + 3 < SEGC) ? (c0 + c + 3) : -1, accS, lb0, lb1, rzB, rvB, rqB); } }
    asm volatile("s_waitcnt vmcnt(0)" ::: "memory");
    __syncthreads();
    { const float lb0 = F.lb()[512 + h * HD + 2 * F.lane], lb1 = F.lb()[512 + h * HD + 2 * F.lane + 1];
      const int cl = seg * SEGC + SEGC - 1;
      hgrn_load<true>(F, b, h, 1, cl, rzA, rvA, rqA); hgrn_load<true>(F, b, h, 1, cl - 1, rzB, rvB, rqB);
      h2_init_state(F, b, h, 1, seg, accS);
      for (int c = 0; c < SEGC; c += 2) {
          hgrn_chunk<true, 1>(F, b, h, 1, cl - c, (c + 2 < SEGC) ? (cl - c - 2) : -1, accS, lb0, lb1, rzA, rvA, rqA);
          hgrn_chunk<true, 1>(F, b, h, 1, cl - c - 1, (c + 3 < SEGC) ? (cl - c - 3) : -1, accS, lb0, lb1, rzB, rvB, rqB); } }
}

__device__ __forceinline__ unsigned f2key(float f) { return __builtin_bit_cast(unsigned, f); }
__device__ __forceinline__ float key2f(unsigned k) { return __builtin_bit_cast(float, k); }
__device__ __forceinline__ unsigned umax_(unsigned a, unsigned b) { unsigned r; asm("v_max_f32 %0, %1, %2" : "=v"(r) : "v"(a), "v"(b)); return r; }
__device__ __forceinline__ unsigned umin_(unsigned a, unsigned b) { unsigned r; asm("v_min_f32 %0, %1, %2" : "=v"(r) : "v"(a), "v"(b)); return r; }
__device__ __forceinline__ void sort16(unsigned (&a)[16]) {
#define CE_(i, j) { const unsigned x_ = a[i], y_ = a[j]; a[i] = umax_(x_, y_); a[j] = umin_(x_, y_); }
    CE_(0, 13) CE_(1, 12) CE_(2, 15) CE_(3, 14) CE_(4, 8) CE_(5, 6) CE_(7, 11) CE_(9, 10)
    CE_(0, 5) CE_(1, 7) CE_(2, 9) CE_(3, 4) CE_(6, 13) CE_(8, 14) CE_(10, 15) CE_(11, 12)
    CE_(0, 1) CE_(2, 3) CE_(4, 5) CE_(6, 8) CE_(7, 9) CE_(10, 11) CE_(12, 13) CE_(14, 15)
    CE_(0, 2) CE_(1, 3) CE_(4, 10) CE_(5, 11) CE_(6, 7) CE_(8, 9) CE_(12, 14) CE_(13, 15)
    CE_(1, 2) CE_(3, 12) CE_(4, 6) CE_(5, 7) CE_(8, 10) CE_(9, 11) CE_(13, 14)
    CE_(1, 4) CE_(2, 6) CE_(5, 8) CE_(7, 10) CE_(9, 13) CE_(11, 14)
    CE_(2, 4) CE_(3, 6) CE_(9, 12) CE_(11, 13)
    CE_(3, 5) CE_(6, 8) CE_(7, 9) CE_(10, 12)
    CE_(3, 4) CE_(5, 6) CE_(7, 8) CE_(9, 10) CE_(11, 12)
    CE_(6, 7) CE_(8, 9)
#undef CE_
}
__device__ __forceinline__ void merge16(unsigned (&a)[16], const unsigned (&b)[16]) {
#pragma unroll
    for (int i = 0; i < 16; ++i) a[i] = umax_(a[i], b[15 - i]);
#pragma unroll
    for (int j = 8; j > 0; j >>= 1)
#pragma unroll
        for (int i = 0; i < 16; ++i) { const int l = i ^ j; if (l > i) { const unsigned x = a[i], y = a[l]; a[i] = umax_(x, y); a[l] = umin_(x, y); } }
}
__device__ __forceinline__ unsigned dpp_swap1(unsigned v) { return (unsigned)__builtin_amdgcn_update_dpp(0, (int)v, 0xB1, 0xF, 0xF, false); }
__device__ __forceinline__ unsigned pick_byte(const unsigned (&pk)[4], unsigned a) {
    const unsigned wsel = a >> 2; unsigned v = wsel == 0 ? pk[0] : (wsel == 1 ? pk[1] : (wsel == 2 ? pk[2] : pk[3]));
    return (v >> ((a & 3u) * 8u)) & 0xffu;
}
__device__ __forceinline__ void topk_stage2(const unsigned (&top)[16], bool tab0, size_t item, int* esel, float* wsel) {
        float vO[16], vP[16]; unsigned iOpk[4] = {0u, 0u, 0u, 0u}, iPpk[4] = {0u, 0u, 0u, 0u};
#pragma unroll
        for (int i = 0; i < 16; ++i) { const unsigned t = top[i], tp = dpp_swap1(t);
            vO[i] = key2f(t & ~0x7fu); vP[i] = key2f(tp & ~0x7fu);
            iOpk[i >> 2] |= (127u - (t & 0x7fu)) << ((i & 3) * 8); iPpk[i >> 2] |= (127u - (tp & 0x7fu)) << ((i & 3) * 8); }
        unsigned R[16], G1[16], G2[16];
#define CAND(a, b) ((f2key(vO[a] + vP[b]) & ~0xffu) | (unsigned)(((a) << 4) | (b)))
#pragma unroll
        for (int i = 0; i < 16; ++i) R[i] = CAND(0, i);
        G1[0] = CAND(1, 0); G1[1] = CAND(1, 1); G1[2] = CAND(1, 2); G1[3] = CAND(1, 3); G1[4] = CAND(1, 4); G1[5] = CAND(1, 5); G1[6] = CAND(1, 6); G1[7] = CAND(1, 7);
        G1[8] = CAND(2, 0); G1[9] = CAND(2, 1); G1[10] = CAND(2, 2); G1[11] = CAND(2, 3); G1[12] = CAND(2, 4); G1[13] = CAND(3, 0); G1[14] = CAND(3, 1); G1[15] = CAND(3, 2);
        G2[0] = CAND(3, 3); G2[1] = CAND(4, 0); G2[2] = CAND(4, 1); G2[3] = CAND(4, 2); G2[4] = CAND(5, 0); G2[5] = CAND(5, 1); G2[6] = CAND(6, 0); G2[7] = CAND(6, 1);
        G2[8] = CAND(7, 0); G2[9] = CAND(7, 1); G2[10] = CAND(8, 0); G2[11] = CAND(9, 0); G2[12] = CAND(10, 0); G2[13] = CAND(11, 0); G2[14] = CAND(12, 0); G2[15] = CAND(13, 0);
        const unsigned g30 = CAND(14, 0), g31 = CAND(15, 0);
#undef CAND
        sort16(G1); sort16(G2);
        merge16(R, G1); merge16(R, G2);
        { const unsigned hi = umax_(g30, g31), lo = umin_(g30, g31); R[15] = umax_(R[15], hi); R[14] = umax_(R[14], lo);
#pragma unroll
          for (int j = 8; j > 0; j >>= 1)
#pragma unroll
              for (int i = 0; i < 16; ++i) { const int l = i ^ j; if (l > i) { const unsigned x = R[i], y = R[l]; R[i] = umax_(x, y); R[l] = umin_(x, y); } } }
        float sc[16], ex[16]; float sum = 0.f; unsigned eid[16];
        #pragma unroll
        for (int i = 0; i < 16; ++i) { sc[i] = key2f(R[i] & ~0xffu); const unsigned a = (R[i] >> 4) & 15u, bb = R[i] & 15u;
            const unsigned io = pick_byte(iOpk, a), ip = pick_byte(iPpk, bb);
            eid[i] = tab0 ? (io * 128u + ip) : (ip * 128u + io); }
#pragma unroll
        for (int i = 0; i < 16; ++i) { ex[i] = __expf(sc[i] - sc[0]); sum += ex[i]; }
        const float inv = 1.0f / sum;
        if (tab0) { const size_t o = item * 16;
#pragma unroll
            for (int q = 0; q < 4; ++q) { v4u ev; ev.x = eid[4 * q]; ev.y = eid[4 * q + 1]; ev.z = eid[4 * q + 2]; ev.w = eid[4 * q + 3]; *(v4u*)(esel + o + 4 * q) = ev;
                f32x4 wv; wv[0] = ex[4 * q] * inv; wv[1] = ex[4 * q + 1] * inv; wv[2] = ex[4 * q + 2] * inv; wv[3] = ex[4 * q + 3] * inv; *(f32x4*)(wsel + o + 4 * q) = wv; } }
}

struct EpiScoreTopk {
    static constexpr bool PERM = false, AFTER_DRAIN = false;
    float* scr; const float* ssqp; const float* biasq; float* rstd_out; int* esel; float* wsel;
    __device__ __forceinline__ void operator()(const f32x4 (&acc)[2][2][4][2], const pg8::Unit& u, int wr, int wc, int fr, int fq) const {
        asm volatile("" : "+v"(fr), "+v"(fq));
        const int rl0 = wr * 64 + fr, col0 = wc * 32 + 4 * fq, b = (u.pm * 256) >> 13;
        f32x4 bv[2][2];
#pragma unroll
        for (int bj = 0; bj < 2; ++bj)
#pragma unroll
            for (int n = 0; n < 2; ++n) bv[bj][n] = *(const f32x4*)(biasq + b * 2048 + u.pn * 256 + col0 + bj * 128 + n * 16);
#pragma unroll
        for (int ai = 0; ai < 2; ++ai)
#pragma unroll
            for (int m = 0; m < 4; ++m) { const int rl = rl0 + ai * 128 + m * 16, row = u.pm * 256 + rl;
                const f32x4 p0 = *(const f32x4*)(ssqp + (size_t)row * 4), p1 = *(const f32x4*)(ssqp + ((size_t)32768 + row) * 4), p2 = *(const f32x4*)(ssqp + ((size_t)65536 + row) * 4), p3 = *(const f32x4*)(ssqp + ((size_t)98304 + row) * 4);
                const float tot = (p0[0] + p0[1] + p0[2] + p0[3]) + (p1[0] + p1[1] + p1[2] + p1[3]) + (p2[0] + p2[1] + p2[2] + p2[3]) + (p3[0] + p3[1] + p3[2] + p3[3]);
                const float rstd = __builtin_amdgcn_rsqf(tot * (1.0f / 1024.0f) + 1e-6f);
                if (u.pn == 0 && wc == 0 && fq == 0) rstd_out[row] = rstd;
                float* blk = scr + (2 * wr + 4 * ai + (m >> 1)) * 8192 + 8 * wc * 256 + 32 * (m & 1) * 4;
                const unsigned loff4 = (unsigned)(2 * fr + 64 * fq);
#pragma unroll
                for (int bj = 0; bj < 2; ++bj)
#pragma unroll
                    for (int n = 0; n < 2; ++n) ((f32x4*)(blk + (4 * n * 64 + bj) * 4))[loff4] = acc[ai][bj][m][n] * rstd + bv[bj][n]; }
        asm volatile("s_waitcnt vmcnt(0)" ::: "memory");
        __builtin_amdgcn_s_barrier();
        asm volatile("" ::: "memory");
        int tid = threadIdx.x; asm volatile("" : "+v"(tid));
        const int rl = tid >> 1, tab = tid & 1;
        const float* bp = scr + __builtin_amdgcn_readfirstlane(tid >> 6) * 8192;
        const unsigned lo4 = (unsigned)(tid & 63) * 4u;
        unsigned top[16];
        f32x4 cur[4], nxt[4];
#pragma unroll
        for (int q = 0; q < 4; ++q) cur[q] = *(const f32x4*)(bp + q * 256 + lo4);
#pragma unroll
        for (int grp = 0; grp < 8; ++grp) { unsigned k[16];
            if (grp < 7) {
#pragma unroll
                for (int q = 0; q < 4; ++q) nxt[q] = *(const f32x4*)(bp + ((grp + 1) * 4 + q) * 256 + lo4); }
#pragma unroll
            for (int q = 0; q < 4; ++q) { const f32x4 v = cur[q];
#pragma unroll
                for (int e = 0; e < 4; ++e) { const int j = grp * 16 + q * 4 + e; k[q * 4 + e] = (f2key(v[e]) & ~0x7fu) | (unsigned)(127 - j); } }
            sort16(k);
            if (grp == 0) {
#pragma unroll
                for (int i = 0; i < 16; ++i) top[i] = k[i];
            } else merge16(top, k);
#pragma unroll
            for (int q = 0; q < 4; ++q) cur[q] = nxt[q];
            __builtin_amdgcn_sched_barrier(0); }
        topk_stage2(top, tab == 0, (size_t)u.pn * T + (size_t)(u.pm * 256 + rl), esel, wsel);
    }
};

__device__ __forceinline__ void cvt16(const v4u& u, f32x2_ (&f)[8]) {
#pragma unroll
    for (int i = 0; i < 4; ++i) { f[2 * i] = __builtin_amdgcn_cvt_pk_f32_fp8((int)u[i], false); f[2 * i + 1] = __builtin_amdgcn_cvt_pk_f32_fp8((int)u[i], true); }
}
constexpr int PITEM = 8, NPITEM = T / PITEM;
__device__ __forceinline__ int peer_next(unsigned* q, int lane) {
    int idx = 0; if (lane == 0) idx = (int)__hip_atomic_fetch_add(q, 1u, __ATOMIC_RELAXED, __HIP_MEMORY_SCOPE_AGENT);
    return __builtin_amdgcn_readfirstlane(idx);
}
#define PEER_SB() __builtin_amdgcn_sched_barrier(0)
#define DPP_IADD(s, ctrl) ((s) + __builtin_amdgcn_update_dpp(0, (s), (ctrl), 0xF, 0xF, false))
__device__ __forceinline__ void p8_dots(const v4u (&ud)[16], const int (&hh)[4], const int (&hl)[4], int c8, int& r0, int& r1) {
#pragma unroll
    for (int i = 0; i < 16; ++i) { int sh = 0, sl = 0;
#pragma unroll
        for (int d = 0; d < 4; ++d) { sh = __builtin_amdgcn_sdot8((int)ud[i][d], hh[d], sh, false); sl = __builtin_amdgcn_sdot8((int)ud[i][d], hl[d], sl, false); }
        int sm = (sh << 4) + sl;
        sm = DPP_IADD(sm, 0xB1); sm = DPP_IADD(sm, 0x4E); sm = DPP_IADD(sm, 0x141);
        if ((i & 1) == 0) r0 = (c8 == (i >> 1)) ? sm : r0; else r1 = (c8 == (i >> 1)) ? sm : r1; }
}
constexpr int PSLAB = 12288;
__device__ __forceinline__ void p8_item(Frame& F, int sl, int item, int nitem, bool filled, LAS unsigned char* slab) {
    const int c8 = F.lane & 7, q8 = F.lane >> 3, t0 = item * PITEM;
    const unsigned char* ub = F.U8() + (size_t)sl * 16384 * 128 + 16 * c8;
    LAS int* eL = (LAS int*)slab; LAS unsigned char* hL = (LAS unsigned char*)(slab + 4096);
    LAS float* qL = (LAS float*)(slab + 6144);
    v4u t4[4], h2[4]; float rs2[4]; f32x4 sA, sB;
#define P8_BLK_LOAD(tb) do { \
        { const float* sp_ = F.mod() + ((tb) >> 13) * 6144 + 3072 + sl * CSLU + 8 * (F.lane & 31); sA = *(const f32x4*)sp_; sB = *(const f32x4*)(sp_ + 4); } \
        _Pragma("unroll") for (int i = 0; i < 4; ++i) rs2[i] = F.rstd()[(tb) + 2 * i + (F.lane >> 5)]; \
        _Pragma("unroll") for (int i = 0; i < 4; ++i) t4[i] = __builtin_nontemporal_load((const v4u*)(F.esel() + ((size_t)(2 * i + (F.lane >> 5)) * T + (tb)) * 16) + (F.lane & 31)); \
        _Pragma("unroll") for (int i = 0; i < 4; ++i) h2[i] = __builtin_nontemporal_load((const v4u*)(F.hg() + (size_t)((tb) + 2 * i + (F.lane >> 5)) * D + sl * CSLU + 8 * (F.lane & 31))); } while (0)
#define DPP_FMAX(v, ctrl) __builtin_fmaxf((v), __builtin_bit_cast(float, __builtin_amdgcn_update_dpp(0, __builtin_bit_cast(int, (v)), (ctrl), 0xF, 0xF, false)))
#define P8_QN(x, k) { const int q_ = (int)__builtin_rintf((x) * qs_), lo_ = ((q_ + 8) & 15) - 8, hi_ = (q_ - lo_) >> 4; wl_ |= (unsigned)(lo_ & 15) << (4 * (k)); wh_ |= (unsigned)(hi_ & 15) << (4 * (k)); }
#define P8_BLK_STORE() do { _Pragma("unroll") for (int i = 0; i < 4; ++i) *(LAS v4u*)(eL + ((F.lane & 31) >> 2) * NSEL + (2 * i + (F.lane >> 5)) * 16 + 4 * (F.lane & 3)) = t4[i]; \
        _Pragma("unroll") for (int i = 0; i < 4; ++i) { const float r_ = rs2[i]; const v4u h_ = h2[i]; \
            const float x0 = bflo(h_[0]) * r_ + sA[0], x1 = bfhi(h_[0]) * r_ + sA[1], x2 = bflo(h_[1]) * r_ + sA[2], x3 = bfhi(h_[1]) * r_ + sA[3]; \
            const float x4 = bflo(h_[2]) * r_ + sB[0], x5 = bfhi(h_[2]) * r_ + sB[1], x6 = bflo(h_[3]) * r_ + sB[2], x7 = bfhi(h_[3]) * r_ + sB[3]; \
            float m_ = __builtin_fmaxf(__builtin_fmaxf(__builtin_fmaxf(__builtin_fabsf(x0), __builtin_fabsf(x1)), __builtin_fmaxf(__builtin_fabsf(x2), __builtin_fabsf(x3))), \
                                       __builtin_fmaxf(__builtin_fmaxf(__builtin_fabsf(x4), __builtin_fabsf(x5)), __builtin_fmaxf(__builtin_fabsf(x6), __builtin_fabsf(x7)))); \
            m_ = DPP_FMAX(m_, 0x128); m_ = DPP_FMAX(m_, 0x124); m_ = DPP_FMAX(m_, 0x122); m_ = DPP_FMAX(m_, 0x121); m_ = __builtin_fmaxf(m_, __shfl_xor(m_, 16)); m_ = __builtin_fmaxf(m_, 1e-20f); \
            const float qs_ = 119.0f * __builtin_amdgcn_rcpf(m_); \
            const int tk_ = 2 * i + (F.lane >> 5); \
            if ((F.lane & 31) == 0) qL[tk_] = m_ * (1.0f / (119.0f * UQSCALE)); \
            unsigned wl_ = 0u, wh_ = 0u; P8_QN(x0, 0) P8_QN(x1, 1) P8_QN(x2, 2) P8_QN(x3, 3) P8_QN(x4, 4) P8_QN(x5, 5) P8_QN(x6, 6) P8_QN(x7, 7) \
            *(LAS unsigned*)(hL + tk_ * 256 + 4 * (F.lane & 31)) = wh_; *(LAS unsigned*)(hL + tk_ * 256 + 128 + 4 * (F.lane & 31)) = wl_; } \
        asm volatile("s_waitcnt lgkmcnt(0)" ::: "memory"); } while (0)
    if (!filled) { P8_BLK_LOAD(t0); P8_BLK_STORE(); }
    bf16* po = F.pact() + ((size_t)t0 * NSLU + sl) * NSEL + 16 * q8 + 2 * c8;
    v4u udA[16], udB[16];
#define P8_GATHER(dst, tt) do { v4u e_[4]; _Pragma("unroll") for (int k = 0; k < 4; ++k) e_[k] = *(LAS const v4u*)(eL + (tt) * NSEL + 16 * q8 + 4 * k); \
        _Pragma("unroll") for (int i = 0; i < 16; ++i) dst[i] = *(const v4u*)(ub + (size_t)e_[i >> 2][i & 3] * 128); } while (0)
#define P8_HN(tt) int hh[4], hl[4]; { const v4u a_ = *(LAS const v4u*)(hL + (tt) * 256 + 16 * c8), b_ = *(LAS const v4u*)(hL + (tt) * 256 + 128 + 16 * c8); \
        hh[0] = (int)a_[0]; hh[1] = (int)a_[1]; hh[2] = (int)a_[2]; hh[3] = (int)a_[3]; hl[0] = (int)b_[0]; hl[1] = (int)b_[1]; hl[2] = (int)b_[2]; hl[3] = (int)b_[3]; }
#define P8_OUT(tt, r0, r1) do { const float dq_ = qL[tt]; __builtin_nontemporal_store(cvtpk((float)(r0) * dq_, (float)(r1) * dq_), (unsigned*)(po + (size_t)(tt) * NSLU * NSEL)); } while (0)
    P8_GATHER(udA, 0);
    for (int tt = 0; tt < PITEM - 2; tt += 2) {
        P8_GATHER(udB, tt + 1);
        { P8_HN(tt); int r0 = 0, r1 = 0; p8_dots(udA, hh, hl, c8, r0, r1); P8_OUT(tt, r0, r1); }
        P8_GATHER(udA, tt + 2);
        { P8_HN(tt + 1); int r0 = 0, r1 = 0; p8_dots(udB, hh, hl, c8, r0, r1); P8_OUT(tt + 1, r0, r1); }
    }
    {
        P8_GATHER(udB, PITEM - 1);
        { P8_HN(PITEM - 2); int r0 = 0, r1 = 0; p8_dots(udA, hh, hl, c8, r0, r1); P8_OUT(PITEM - 2, r0, r1); }
        if (nitem >= 0) P8_BLK_LOAD(nitem * PITEM);
        { P8_HN(PITEM - 1); int r0 = 0, r1 = 0; p8_dots(udB, hh, hl, c8, r0, r1); P8_OUT(PITEM - 1, r0, r1); }
        if (nitem >= 0) P8_BLK_STORE();
    }
#undef P8_GATHER
#undef P8_HN
#undef P8_OUT
#undef P8_BLK_LOAD
#undef P8_BLK_STORE
#undef P8_QN
#undef DPP_FMAX
}
__device__ __forceinline__ void p8b_coef(Frame& F) {
    const size_t N = (size_t)T * NSEL;
#pragma unroll 4
    for (size_t i = (size_t)F.bid * NTHR + F.tid; i < N; i += (size_t)F.G * NTHR) { const size_t t = i >> 7; const int j = (int)(i & 127);
        const bf16* pp = F.pact() + t * NSLU * NSEL + j; float a = 0.f;
#pragma unroll
        for (int s = 0; s < NSLU; ++s) a += bf2f(__builtin_nontemporal_load(pp + s * NSEL));
        F.coef()[i] = F.wsel()[((size_t)(j >> 4) * T + t) * 16 + (j & 15)] * 0.5f * a * (1.0f + erff(a * 0.70710678f)); }
}
__device__ __forceinline__ void p9_token(const v4u (&vd)[16], LAS const float* cL, bf16* yo, LAS float* red, int lane, int c8, int q8) {
    f32x4 cc[4];
#pragma unroll
    for (int k = 0; k < 4; ++k) cc[k] = *(LAS const f32x4*)(cL + 16 * q8 + 4 * k);
    f32x2_ y[8];
#pragma unroll
    for (int k = 0; k < 8; ++k) y[k] = (f32x2_){0.f, 0.f};
#pragma unroll
    for (int i = 0; i < 16; ++i) { f32x2_ vf[8]; cvt16(vd[i], vf); const float c = cc[i >> 2][i & 3]; const f32x2_ c2 = {c, c};
#pragma unroll
        for (int k = 0; k < 8; ++k) y[k] += c2 * vf[k];
        PEER_SB(); }
#pragma unroll
    for (int k = 0; k < 4; ++k) { f32x4 o; o[0] = y[2 * k][0]; o[1] = y[2 * k][1]; o[2] = y[2 * k + 1][0]; o[3] = y[2 * k + 1][1]; *(LAS f32x4*)(red + q8 * 128 + 16 * c8 + 4 * k) = o; }
    asm volatile("s_waitcnt lgkmcnt(0)" ::: "memory");
    f32x2_ sm = {0.f, 0.f};
#pragma unroll
    for (int g = 0; g < 8; ++g) sm += *(LAS const f32x2_*)(red + g * 128 + 2 * lane);
    sm = sm * (1.0f / VSCALE);
    __builtin_nontemporal_store(cvtpk(sm[0], sm[1]), (unsigned*)(yo + 2 * lane));
    asm volatile("s_waitcnt lgkmcnt(0)" ::: "memory");
    PEER_SB();
}
__device__ __forceinline__ void p9_item(Frame& F, int sl, int item, int nitem, bool filled, LAS unsigned char* slab) {
    const int c8 = F.lane & 7, q8 = F.lane >> 3, t0 = item * PITEM;
    const unsigned char* vb = F.V8() + (size_t)sl * 16384 * CSL + 16 * c8;
    LAS int* eL = (LAS int*)slab; LAS float* cL = (LAS float*)(slab + 4096); LAS float* red = (LAS float*)(slab + 8192);
    v4u t4[4], c4[4];
#define P9_BLK_LOAD(tb) do { const v4u* cp_ = (const v4u*)(F.coef() + (size_t)(tb) * NSEL); \
        _Pragma("unroll") for (int i = 0; i < 4; ++i) { t4[i] = __builtin_nontemporal_load((const v4u*)(F.esel() + ((size_t)(2 * i + (F.lane >> 5)) * T + (tb)) * 16) + (F.lane & 31)); c4[i] = __builtin_nontemporal_load(cp_ + i * 64 + F.lane); } } while (0)
#define P9_BLK_STORE() do { _Pragma("unroll") for (int i = 0; i < 4; ++i) { *(LAS v4u*)(eL + ((F.lane & 31) >> 2) * NSEL + (2 * i + (F.lane >> 5)) * 16 + 4 * (F.lane & 3)) = t4[i]; *(LAS v4u*)(cL + (i * 64 + F.lane) * 4) = c4[i]; } \
        asm volatile("s_waitcnt lgkmcnt(0)" ::: "memory"); } while (0)
    if (!filled) { P9_BLK_LOAD(t0); P9_BLK_STORE(); }
    bf16* yo = F.ybuf() + (size_t)t0 * D + sl * CSL;
    v4u vdA[16], vdB[16];
#define P9_GATHER(dst, tt) do { v4u e_[4]; _Pragma("unroll") for (int k = 0; k < 4; ++k) e_[k] = *(LAS const v4u*)(eL + (tt) * NSEL + 16 * q8 + 4 * k); \
        _Pragma("unroll") for (int i = 0; i < 16; ++i) dst[i] = *(const v4u*)(vb + (size_t)e_[i >> 2][i & 3] * CSL); } while (0)
    P9_GATHER(vdA, 0);
    for (int tt = 0; tt < PITEM - 2; tt += 2) {
        P9_GATHER(vdB, tt + 1);
        p9_token(vdA, cL + tt * NSEL, yo + (size_t)tt * D, red, F.lane, c8, q8);
        P9_GATHER(vdA, tt + 2);
        p9_token(vdB, cL + (tt + 1) * NSEL, yo + (size_t)(tt + 1) * D, red, F.lane, c8, q8);
    }
    {
        P9_GATHER(vdB, PITEM - 1);
        p9_token(vdA, cL + (PITEM - 2) * NSEL, yo + (size_t)(PITEM - 2) * D, red, F.lane, c8, q8);
        if (nitem >= 0) P9_BLK_LOAD(nitem * PITEM);
        p9_token(vdB, cL + (PITEM - 1) * NSEL, yo + (size_t)(PITEM - 1) * D, red, F.lane, c8, q8);
        if (nitem >= 0) P9_BLK_STORE();
    }
#undef P9_GATHER
#undef P9_BLK_LOAD
#undef P9_BLK_STORE
}
template <int SIDE>
__device__ __forceinline__ void peer_phase(Frame& F0, int rep) {
    Frame F = F0; asm volatile("" : "+v"(F.lane));
    constexpr int NS = (SIDE == 0) ? NSLU : NSL;
    const int s0 = (int)(xb_xcc_id() & (unsigned)(NS - 1));
    unsigned* qbase = F.ctl() + (SIDE == 0 ? CW_QU : CW_QV) + rep * 64 * 32;
    LAS unsigned char* cf = F.lds + F.wave * PSLAB;
    for (int k = 0; k < NS; ++k) { const int sl = (s0 + k) & (NS - 1);
        int item = peer_next(qbase + 64 * sl, F.lane); bool filled = false;
        while (item < NPITEM) { int nitem = peer_next(qbase + 64 * sl, F.lane); if (nitem >= NPITEM) nitem = -1;
            if (SIDE == 0) p8_item(F, sl, item, nitem, filled, cf); else p9_item(F, sl, item, nitem, filled, cf);
            filled = nitem >= 0; item = nitem >= 0 ? nitem : NPITEM; } }
}
__device__ __forceinline__ void p10_final(Frame& F) {
    const int gwc = F.bid * NWAVES + F.wave, NGW = F.G * NWAVES;
    for (int row0 = gwc * 16; row0 < T; row0 += NGW * 16) {
        const int b = row0 >> 13; const float* mb = F.mod() + b * 6144 + 5120; const float* fm = F.fmod() + b * 2048;
        f32x4 g2[4], ca[4], cb[4];
#pragma unroll
        for (int j = 0; j < 4; ++j) { const int k = 256 * j + 4 * F.lane; g2[j] = *(const f32x4*)(mb + k); ca[j] = *(const f32x4*)(F.fnorm_g() + k) * (*(const f32x4*)(fm + 1024 + k) + 1.0f); cb[j] = *(const f32x4*)(fm + k); }
#pragma unroll 4
        for (int r = 0; r < 16; ++r) { float* hr = F.out() + (size_t)(row0 + r) * D; const bf16* yr = F.ybuf() + (size_t)(row0 + r) * D; const bf16* hb = (const bf16*)hr;
            f32x4 z[4]; float ss = 0.f;
#pragma unroll
            for (int j = 0; j < 4; ++j) { const v2u hq = *(const v2u*)(hb + 256 * j + 4 * F.lane); f32x4 hv; hv[0] = bflo(hq[0]); hv[1] = bfhi(hq[0]); hv[2] = bflo(hq[1]); hv[3] = bfhi(hq[1]);
                const v2u yq = __builtin_nontemporal_load((const v2u*)(yr + 256 * j + 4 * F.lane)); f32x4 yv; yv[0] = bflo(yq[0]); yv[1] = bfhi(yq[0]); yv[2] = bflo(yq[1]); yv[3] = bfhi(yq[1]);
                z[j] = hv + g2[j] * yv; ss += z[j][0] * z[j][0] + z[j][1] * z[j][1] + z[j][2] * z[j][2] + z[j][3] * z[j][3]; }
            const float rstd = __builtin_amdgcn_rsqf(wave_sum(ss) * (1.0f / D) + EPS);
#pragma unroll
            for (int j = 0; j < 4; ++j) *(f32x4*)(hr + 256 * j + 4 * F.lane) = z[j] * rstd * ca[j] + cb[j]; }
    }
}

constexpr int NPHASE = 12;
__global__ void __launch_bounds__(NTHR, 2) fwd_kernel(Args args) {
    extern __shared__ __attribute__((aligned(16))) unsigned char lds_raw[];
    Frame F;
    F.lds = (LAS unsigned char*)lds_raw;
    F.tid = threadIdx.x; F.lane = F.tid & 63; F.wave = __builtin_amdgcn_readfirstlane(F.tid >> 6); F.G = gridDim.x; F.bid = blockIdx.x;
    unsigned char* ws = args.ws; F.a = &args;
    volatile LAS unsigned* misc = (volatile LAS unsigned*)(F.lds + MISC_OFF);
    if (F.tid < 64) misc[F.tid] = 0u;
    __syncthreads();
    const int lo = args.ph_lo, hi = args.ph_hi;
    const bool multi = (hi - lo) > 1;
    XcdBarrier bar; bar.bar = (unsigned*)(ws + WS_CTL) + CW_BAR; bar.x = 0; bar.st = nullptr;
    if (multi) bar = xcd_barrier_post((unsigned*)(ws + WS_CTL) + CW_BAR, misc + 8);
#ifndef PHMASK
#define PHMASK 0xfff
#endif
#define IN(k) (((PHMASK >> (k)) & 1) && lo <= (k) && (k) < hi)
#define SEAM(k) do { if (IN(k) && IN((k) + 1)) xcd_barrier(bar); } while (0)

#ifndef REPMASK
#define REPMASK 0
#endif
#define REP(k) (((REPMASK) >> (k)) & 1)
#define REPBAR(k) if (REP(k) && rep == 0) xcd_barrier(bar)
    if (IN(0)) { for (int rep = 0; rep <= REP(0); ++rep) { p0_prologue(F); REPBAR(0); } } SEAM(0);
    if (IN(1)) { for (int rep = 0; rep <= REP(1); ++rep) { p1_norm(F); REPBAR(1); } } SEAM(1);
    if (IN(2)) { { pg8::Gemm g{F.bufA(), F.Win_t(), T, NIN, D}; pg8::StaticOrder S; S.init(T, NIN, F.G, F.bid);
        pg8::EpiProj E{F.proj(), NIN};
        pg8::gemm_phase<pg8::EpiProj, pg8::StaticOrder, true, true>(F.lds, g, S, E); }
#if ((REPMASK) >> 2) & 1
        xcd_barrier(bar); { pg8::Gemm g{F.bufA(), F.Win_t(), T, NIN, D}; pg8::StaticOrder S; S.init(T, NIN, F.G, F.bid);
        pg8::EpiProj E{F.proj(), NIN};
        pg8::gemm_phase<pg8::EpiProj, pg8::StaticOrder, true, true>(F.lds, g, S, E); }
#endif
    } SEAM(2);
    if (IN(3)) { for (int rep = 0; rep <= REP(3); ++rep) {
        for (int it = F.bid; it < NB * NHH * 2 * NSEG; it += F.G) h1_item(F, it);
        float cw[CW];
#pragma unroll
        for (int j = 0; j < CW; ++j) cw[j] = F.conv_w()[j * DC + F.tid];
        const float cbias = F.conv_b()[F.tid];
        for (int it = F.bid; it < T / 32; it += F.G) conv_item(F, it, cw, cbias); REPBAR(3); }
    } SEAM(3);
    if (IN(4)) { for (int rep = 0; rep <= REP(4); ++rep) { for (int it = F.bid; it < NB * NHH * NSEG; it += F.G) h2_item(F, it); REPBAR(4); } } SEAM(4);
    if (IN(5)) { { pg8::Gemm g{F.bufA(), F.Wout_t(), T, D, D}; pg8::StaticOrder S; S.init(T, D, F.G, F.bid);
        pg8::EpiOut E{F.x(), F.out(), F.hg(), F.mod(), F.g_ffn(), F.ssqp()};
        pg8::gemm_phase<pg8::EpiOut, pg8::StaticOrder, true, true>(F.lds, g, S, E); }
#if ((REPMASK) >> 5) & 1
        xcd_barrier(bar); { pg8::Gemm g{F.bufA(), F.Wout_t(), T, D, D}; pg8::StaticOrder S; S.init(T, D, F.G, F.bid);
        pg8::EpiOut E{F.x(), F.out(), F.hg(), F.mod(), F.g_ffn(), F.ssqp()};
        pg8::gemm_phase<pg8::EpiOut, pg8::StaticOrder, true, true>(F.lds, g, S, E); }
#endif
    } SEAM(5);
    if (IN(6)) { { pg8::Gemm g{F.hg(), F.Wqk_t(), T, NQK, D}; pg8::StaticOrder S; S.init(T, NQK, F.G, F.bid);
        EpiScoreTopk E{F.scores() + (size_t)F.bid * 65536, F.ssqp(), F.biasq(), F.rstd(), F.esel(), F.wsel()};
        pg8::gemm_phase<EpiScoreTopk, pg8::StaticOrder, true, true>(F.lds, g, S, E); }
    } SEAM(6);
    if (IN(8)) { for (int rep = 0; rep <= REP(8); ++rep) { peer_phase<0>(F, rep); REPBAR(8); } } SEAM(8);
    if (IN(9)) { for (int rep = 0; rep <= REP(9); ++rep) { p8b_coef(F); REPBAR(9); } } SEAM(9);
    if (IN(10)) { for (int rep = 0; rep <= REP(10); ++rep) { peer_phase<1>(F, rep); REPBAR(10); } } SEAM(10);
    if (IN(11)) { p10_final(F); }
#undef IN
#undef SEAM
}

#ifndef MK_ONE_LAUNCH
#define MK_ONE_LAUNCH 0
#endif
extern "C" void kernel_launch(void* const* d_in, const int* in_sizes, int n_in, void* d_out, int out_size, void* d_ws, size_t ws_size, hipStream_t stream) {
    static int grid = 0;
    if (grid == 0) {
        if (n_in != 23 || out_size != T * D || ws_size < WS_END) { fprintf(stderr, "kernel_launch: unexpected shapes (n_in %d, out %d, ws %zu)\n", n_in, out_size, ws_size); grid = -1; return; }
        int dev = 0, cus = 0, per_cu = 0;
        if (hipGetDevice(&dev) != hipSuccess || hipDeviceGetAttribute(&cus, hipDeviceAttributeMultiprocessorCount, dev) != hipSuccess) { grid = -1; return; }
        if (hipFuncSetAttribute((const void*)fwd_kernel, hipFuncAttributeMaxDynamicSharedMemorySize, LDS_BYTES) != hipSuccess) { fprintf(stderr, "kernel_launch: hipFuncSetAttribute failed\n"); grid = -1; return; }
        if (hipOccupancyMaxActiveBlocksPerMultiprocessor(&per_cu, (const void*)fwd_kernel, NTHR, LDS_BYTES) != hipSuccess || per_cu < 1) { fprintf(stderr, "kernel_launch: occupancy query reports %d\n", per_cu); }
        (void)hipGetLastError();
        grid = cus;
    }
    if (grid < 0) return;
    (void)hipMemsetAsync((char*)d_ws + WS_CTL, 0, CTL_ZERO_BYTES, stream);
    Args a{};
    for (int i = 0; i < 23; ++i) a.in[i] = (const float*)d_in[i];
    a.out = (float*)d_out; a.ws = (unsigned char*)d_ws;
#if MK_ONE_LAUNCH
    a.ph_lo = 0; a.ph_hi = NPHASE;
    hipLaunchKernelGGL(fwd_kernel, dim3(grid), dim3(NTHR), LDS_BYTES, stream, a);
#else
    for (int p = 0; p < NPHASE; ++p) { a.ph_lo = p; a.ph_hi = p + 1; hipLaunchKernelGGL(fwd_kernel, dim3(grid), dim3(NTHR), LDS_BYTES, stream, a); }
#endif
}
```

```cpp
#include <hip/hip_runtime.h>
#include <cstdio>
#include <cstdint>
namespace pg8 {
#define PG8_LAS __attribute__((address_space(3)))
typedef unsigned short bf16_t;
typedef short bf16x8 __attribute__((ext_vector_type(8)));
typedef float f32x4 __attribute__((ext_vector_type(4)));
typedef unsigned u32x4 __attribute__((ext_vector_type(4)));
constexpr int BM = 256, BK = 64, HALF = 128, HTB = HALF * BK * 2  , STAGE_BYTES = 8 * HTB, NXCD = 8, WGM = 8;

__host__ __device__ __forceinline__ int lds_byte(int r, int c) { const int st = (r >> 4) * 2 + (c >> 5), rr = r & 15, cc = c & 31, ob = rr * 64 + cc * 2; return st * 1024 + (ob ^ (((ob >> 9) & 1) << 5)); }
__host__ __device__ __forceinline__ void stage_rc(int b, int& R, int& C) { const int st = b / 1024, sb = b % 1024, swz = sb ^ (((sb >> 9) & 1) << 5); R = (st >> 1) * 16 + swz / 64; C = (st & 1) * 32 + (swz % 64) / 2; }
__host__ __device__ __forceinline__ int perm32(int rho) { const int n = rho >> 4, i = rho & 15; return 8 * (i >> 2) + 4 * n + (i & 3); }

struct Unit { int pm, pn; };
struct Gemm { const bf16_t* A; const bf16_t* Bt; int M, N, K; };

struct StaticOrder {
    int nM, nN, nwg, G, c;
    __host__ __device__ void init(int M, int N, int G_, int c_) { nM = M / BM; nN = N / BM; nwg = nM * nN; G = G_; c = c_; }
    __host__ __device__ bool next(int i, Unit& u) const {
        const long L = (long)i * G + c; if (L >= nwg) return false;
        int wgid = (int)L; { const int q = nwg / NXCD, r = nwg % NXCD, xcd = wgid % NXCD, off = wgid / NXCD; wgid = (xcd < r ? xcd * (q + 1) : r * (q + 1) + (xcd - r) * q) + off; }
        const int nig = WGM * nN, gid = wgid / nig, fm = gid * WGM, gsz = (nM - fm) < WGM ? (nM - fm) : WGM;
        u.pm = fm + ((wgid % nig) % gsz); u.pn = (wgid % nig) / gsz; return true;
    }
    __device__ __forceinline__ void a_ready(const Unit&) const {}
    __device__ __forceinline__ void done(const Unit&) const {}
};
__device__ __forceinline__ unsigned cvt_pk_bf16(float lo, float hi) { unsigned r; asm volatile("v_cvt_pk_bf16_f32 %0, %1, %2" : "=v"(r) : "v"(lo), "v"(hi)); return r; }
typedef float f32x2 __attribute__((ext_vector_type(2)));
__device__ __forceinline__ f32x2 gelu_pk(f32x2 v) {
    const f32x2 av = __builtin_elementwise_abs(v), d = av * 0.2316418882f + 1.0f;
    f32x2 t; t.x = __builtin_amdgcn_rcpf(d.x); t.y = __builtin_amdgcn_rcpf(d.y);
    f32x2 q = t * 0.5307027145f + (-0.7265760135f); q = q * t + 0.7107068705f; q = q * t + (-0.142248368f); q = q * t + 0.127414796f; q = q * t;
    const f32x2 s = (v * v) * (-0.72134752044f);
    f32x2 e; e.x = __builtin_amdgcn_exp2f(s.x); e.y = __builtin_amdgcn_exp2f(s.y);
    const f32x2 m = v * (q * e), r = v - m;
    f32x2 o; o.x = v.x < 0.f ? m.x : r.x; o.y = v.y < 0.f ? m.y : r.y; return o;
}

template <int ACT  > struct EpiBf16 {
    static constexpr bool PERM = true, AFTER_DRAIN = false; static_assert(ACT == 0 || ACT == 1, "EpiBf16: ACT is 0 (none) or 1 (gelu_pk)");
    bf16_t* O; int ldc; const float* bias; int split_cols; size_t split_stride; float scale0;
    __device__ __forceinline__ void operator()(const f32x4 (&acc)[2][2][4][2], const Unit& u, int wr, int wc, int fr, int fq) const {
        const int row0 = u.pm * BM + wr * 64 + fr; int colt = u.pn * BM; bf16_t* base = O;
        float sc = 1.f; if (split_cols) { const int t = colt / split_cols; base += (size_t)t * split_stride; colt -= t * split_cols; if (t == 0) sc = scale0; }
        const int col0 = colt + wc * 32 + 8 * fq, bcol0 = u.pn * BM + wc * 32 + 8 * fq;
        f32x4 bv[2][2];
#pragma unroll
        for (int bj = 0; bj < 2; ++bj)
#pragma unroll
            for (int n = 0; n < 2; ++n) bv[bj][n] = bias ? *(const f32x4*)(bias + bcol0 + bj * HALF + 4 * n) : (f32x4){0.f, 0.f, 0.f, 0.f};
#pragma unroll
        for (int ai = 0; ai < 2; ++ai)
#pragma unroll
            for (int m = 0; m < 4; ++m) { bf16_t* rowp = base + (size_t)(row0 + ai * HALF + m * 16) * ldc + col0;
#pragma unroll
                for (int bj = 0; bj < 2; ++bj) { f32x4 v0 = acc[ai][bj][m][0] + bv[bj][0], v1 = acc[ai][bj][m][1] + bv[bj][1];
                    if (ACT == 1) { f32x2 a = gelu_pk((f32x2){v0[0], v0[1]}), b = gelu_pk((f32x2){v0[2], v0[3]}), c = gelu_pk((f32x2){v1[0], v1[1]}), d = gelu_pk((f32x2){v1[2], v1[3]});
                        v0 = (f32x4){a.x, a.y, b.x, b.y}; v1 = (f32x4){c.x, c.y, d.x, d.y}; }
                    v0 = v0 * sc; v1 = v1 * sc; u32x4 w; w.x = cvt_pk_bf16(v0[0], v0[1]); w.y = cvt_pk_bf16(v0[2], v0[3]); w.z = cvt_pk_bf16(v1[0], v1[1]); w.w = cvt_pk_bf16(v1[2], v1[3]);
                    *(u32x4*)(rowp + bj * HALF) = w; } }
    }
};

struct EpiOut {
    static constexpr bool PERM = true, AFTER_DRAIN = false;
    const float* X; float* Hout; bf16_t* HG; const float* mod; const float* gffn; float* ssqp;
    __device__ __forceinline__ void operator()(const f32x4 (&acc)[2][2][4][2], const Unit& u, int wr, int wc, int fr, int fq) const {
        const int row0 = u.pm * BM + wr * 64 + fr, col0 = u.pn * BM + wc * 32 + 8 * fq;
        const int b = (u.pm * BM) >> 13;
        const float* mb = mod + b * 6144;
        f32x4 g1v[2][2], gv2[2][2];
#pragma unroll
        for (int bj = 0; bj < 2; ++bj)
#pragma unroll
            for (int n = 0; n < 2; ++n) { const int c = col0 + bj * HALF + 4 * n;
                g1v[bj][n] = *(const f32x4*)(mb + 2048 + c);
                const f32x4 s2 = *(const f32x4*)(mb + 4096 + c), gf = *(const f32x4*)(gffn + c);
                gv2[bj][n] = gf * (s2 + 1.0f); }
#pragma unroll
        for (int ai = 0; ai < 2; ++ai)
#pragma unroll
            for (int m = 0; m < 4; ++m) { const int row = row0 + ai * HALF + m * 16; const size_t ro = (size_t)row * 1024 + col0; float ss = 0.f;
#pragma unroll
                for (int bj = 0; bj < 2; ++bj) {
                    const f32x4 x0 = *(const f32x4*)(X + ro + bj * HALF), x1 = *(const f32x4*)(X + ro + bj * HALF + 4);
                    const f32x4 h0 = x0 + g1v[bj][0] * acc[ai][bj][m][0], h1 = x1 + g1v[bj][1] * acc[ai][bj][m][1];
                    { u32x4 hw; hw.x = cvt_pk_bf16(h0[0], h0[1]); hw.y = cvt_pk_bf16(h0[2], h0[3]); hw.z = cvt_pk_bf16(h1[0], h1[1]); hw.w = cvt_pk_bf16(h1[2], h1[3]);
                      *(u32x4*)((bf16_t*)Hout + (size_t)row * 2048 + col0 + bj * HALF) = hw; }
                    ss += h0[0] * h0[0] + h0[1] * h0[1] + h0[2] * h0[2] + h0[3] * h0[3] + h1[0] * h1[0] + h1[1] * h1[1] + h1[2] * h1[2] + h1[3] * h1[3];
                    const f32x4 q0 = h0 * gv2[bj][0], q1 = h1 * gv2[bj][1];
                    u32x4 w; w.x = cvt_pk_bf16(q0[0], q0[1]); w.y = cvt_pk_bf16(q0[2], q0[3]); w.z = cvt_pk_bf16(q1[0], q1[1]); w.w = cvt_pk_bf16(q1[2], q1[3]);
                    *(u32x4*)(HG + ro + bj * HALF) = w; }
                ss += __shfl_xor(ss, 16); ss += __shfl_xor(ss, 32);
                if (fq == 0) ssqp[((size_t)u.pn * 32768 + row) * 4 + wc] = ss; }
    }
};
struct EpiScore {
    static constexpr bool PERM = false, AFTER_DRAIN = false;
    float* S; const float* ssqp; const float* biasq; float* rstd_out;
    __device__ __forceinline__ void operator()(const f32x4 (&acc)[2][2][4][2], const Unit& u, int wr, int wc, int fr, int fq) const {
        const int row0 = u.pm * BM + wr * 64 + fr, col0 = u.pn * BM + wc * 32 + 4 * fq;
        const int b = (u.pm * BM) >> 13;
        f32x4 bv[2][2];
#pragma unroll
        for (int bj = 0; bj < 2; ++bj)
#pragma unroll
            for (int n = 0; n < 2; ++n) bv[bj][n] = *(const f32x4*)(biasq + b * 2048 + col0 + bj * HALF + n * 16);
#pragma unroll
        for (int ai = 0; ai < 2; ++ai)
#pragma unroll
            for (int m = 0; m < 4; ++m) { const int row = row0 + ai * HALF + m * 16;
                const f32x4 p0 = *(const f32x4*)(ssqp + (size_t)row * 4), p1 = *(const f32x4*)(ssqp + ((size_t)32768 + row) * 4), p2 = *(const f32x4*)(ssqp + ((size_t)65536 + row) * 4), p3 = *(const f32x4*)(ssqp + ((size_t)98304 + row) * 4);
                const float tot = (p0[0] + p0[1] + p0[2] + p0[3]) + (p1[0] + p1[1] + p1[2] + p1[3]) + (p2[0] + p2[1] + p2[2] + p2[3]) + (p3[0] + p3[1] + p3[2] + p3[3]);
                const float rstd = __builtin_amdgcn_rsqf(tot * (1.0f / 1024.0f) + 1e-6f);
                if (u.pn == 0 && wc == 0 && fq == 0) rstd_out[row] = rstd;
                float* rowp = S + (size_t)row * 2048 + col0;
#pragma unroll
                for (int bj = 0; bj < 2; ++bj)
#pragma unroll
                    for (int n = 0; n < 2; ++n) *(f32x4*)(rowp + bj * HALF + n * 16) = acc[ai][bj][m][n] * rstd + bv[bj][n]; }
    }
};

struct EpiProj {
    static constexpr bool PERM = true, AFTER_DRAIN = false;
    bf16_t* O; int ldc;
    __device__ __forceinline__ void operator()(const f32x4 (&acc)[2][2][4][2], const Unit& u, int wr, int wc, int fr, int fq) const {
        asm volatile("" : "+v"(fr), "+v"(fq));
        const int row0 = u.pm * BM + wr * 64 + fr, col0 = u.pn * BM + wc * 32 + 8 * fq;
        const int cls = u.pn >> 1;
        const bool ident = (cls == 3) || (cls == 5), mulx = (cls == 0) || (cls == 4);
        const float sgn = (cls == 1 || cls == 2) ? 1.4426950408889634f : -1.4426950408889634f;
#pragma unroll
        for (int ai = 0; ai < 2; ++ai)
#pragma unroll
            for (int m = 0; m < 4; ++m) { bf16_t* rowp = O + (size_t)(row0 + ai * HALF + m * 16) * ldc + col0;
#pragma unroll
                for (int bj = 0; bj < 2; ++bj) { f32x4 v0 = acc[ai][bj][m][0], v1 = acc[ai][bj][m][1];
                    if (!ident) {
#pragma unroll
                        for (int j = 0; j < 4; ++j) { const float r0 = __builtin_amdgcn_rcpf(1.0f + __builtin_amdgcn_exp2f(sgn * v0[j])), r1 = __builtin_amdgcn_rcpf(1.0f + __builtin_amdgcn_exp2f(sgn * v1[j]));
                            v0[j] = mulx ? v0[j] * r0 : r0; v1[j] = mulx ? v1[j] * r1 : r1; } }
                    u32x4 w; w.x = cvt_pk_bf16(v0[0], v0[1]); w.y = cvt_pk_bf16(v0[2], v0[3]); w.z = cvt_pk_bf16(v1[0], v1[1]); w.w = cvt_pk_bf16(v1[2], v1[3]);
                    *(u32x4*)(rowp + bj * HALF) = w; } }
    }
};
template <class Epi, class Sched, bool ALIGN_EPI = false, bool SP2 = false>
__device__ __forceinline__ void gemm_phase(PG8_LAS unsigned char* lds, const Gemm g, const Sched& S, const Epi& E) {
    const int tid = threadIdx.x, wid = __builtin_amdgcn_readfirstlane(tid >> 6), lane = tid & 63, wr = wid >> 2, wc = wid & 3, fr = lane & 15, fq = lane >> 4;
    const int K = g.K, nt = K / BK;
    unsigned voffA[2], voffB[2];
#pragma unroll
    for (int i = 0; i < 2; ++i) { int R, C; stage_rc(tid * 16 + i * 8192, R, C); const int Rb = Epi::PERM ? ((R & ~31) + perm32(R & 31)) : R;
        voffA[i] = (unsigned)(R * K + C) * 2u; voffB[i] = (unsigned)(Rb * K + C) * 2u; }
    const size_t kstep = (size_t)(BK * 2);
    const size_t hstep = (size_t)HALF * K * 2;
    const size_t tstep = 2 * hstep;
    const unsigned ldsw = (unsigned)wid * 1024u;
    const int aoff = lds_byte(wr * 64 + fr, fq * 8), boff = lds_byte(wc * 32 + fr, fq * 8);
#define PG8_SA(b, h) (((b) * 2 + (h)) * HTB)
#define PG8_SB(b, h) ((4 + (b) * 2 + (h)) * HTB)
#define PG8_STAGE(bufoff, gbase, voff) do { _Pragma("unroll") for (int _i = 0; _i < 2; ++_i) \
        __builtin_amdgcn_global_load_lds((const unsigned*)((const char*)(gbase) + (voff)[_i]), (PG8_LAS unsigned*)(lds + (bufoff) + ldsw + _i * 8192), 16, 0, 0); } while (0)
#define PG8_LDA(dst, b, h) do { _Pragma("unroll") for (int m = 0; m < 4; ++m) _Pragma("unroll") for (int k = 0; k < 2; ++k) dst[m][k] = *(const PG8_LAS bf16x8*)(lds + PG8_SA(b, h) + aoff + m * 2048 + k * 1024); } while (0)
#define PG8_LDB(dst, b, h) do { _Pragma("unroll") for (int n = 0; n < 2; ++n) _Pragma("unroll") for (int k = 0; k < 2; ++k) dst[n][k] = *(const PG8_LAS bf16x8*)(lds + PG8_SB(b, h) + boff + n * 2048 + k * 1024); } while (0)
#define PG8_MMA(ai, bj, At, Bt) do { __builtin_amdgcn_s_setprio(1); _Pragma("unroll") for (int m = 0; m < 4; ++m) _Pragma("unroll") for (int n = 0; n < 2; ++n) _Pragma("unroll") for (int k = 0; k < 2; ++k) \
        acc[ai][bj][m][n] = __builtin_amdgcn_mfma_f32_16x16x32_bf16(Bt[n][k], At[m][k], acc[ai][bj][m][n], 0, 0, 0); __builtin_amdgcn_s_setprio(0); } while (0)
#define PG8_WAIT_V(n) asm volatile("s_waitcnt vmcnt(" #n ")" ::: "memory")
#define PG8_WAIT_L(n) asm volatile("s_waitcnt lgkmcnt(" #n ")" ::: "memory")
#define PG8_BAR __builtin_amdgcn_s_barrier()
#define PG8_SCHED __builtin_amdgcn_sched_barrier(0)
    Unit cur, nxt; int ui = 0;
    if (!S.next(0, cur)) return;
    f32x4 acc[2][2][4][2];
#pragma unroll
    for (int a = 0; a < 2; ++a)
#pragma unroll
        for (int b = 0; b < 2; ++b)
#pragma unroll
            for (int m = 0; m < 4; ++m)
#pragma unroll
                for (int n = 0; n < 2; ++n) acc[a][b][m][n] = (f32x4){0.f, 0.f, 0.f, 0.f};
    bf16x8 At[4][2], B0[2][2], B1[2][2];
    const char* cA = (const char*)g.A + (size_t)cur.pm * tstep; const char* cB = (const char*)g.Bt + (size_t)cur.pn * tstep;
    S.a_ready(cur);
    if constexpr (SP2) {
        PG8_STAGE(PG8_SB(0, 0), cB, voffB); PG8_STAGE(PG8_SB(0, 1), cB + hstep, voffB); PG8_STAGE(PG8_SA(0, 0), cA, voffA); PG8_STAGE(PG8_SA(0, 1), cA + hstep, voffA);
        if (wr == 1) PG8_BAR;
        PG8_WAIT_V(2); PG8_BAR;
        PG8_STAGE(PG8_SB(1, 0), cB + kstep, voffB); PG8_STAGE(PG8_SA(1, 0), cA + kstep, voffA); PG8_STAGE(PG8_SB(1, 1), cB + hstep + kstep, voffB);
        PG8_WAIT_V(6); PG8_BAR;
    } else {
        PG8_STAGE(PG8_SB(0, 0), cB, voffB); PG8_STAGE(PG8_SA(0, 0), cA, voffA); PG8_STAGE(PG8_SB(0, 1), cB + hstep, voffB); PG8_STAGE(PG8_SA(0, 1), cA + hstep, voffA);
        if (wr == 1) PG8_BAR;
        PG8_WAIT_V(4); PG8_BAR;
        PG8_STAGE(PG8_SB(1, 0), cB + kstep, voffB); PG8_STAGE(PG8_SA(1, 0), cA + kstep, voffA); PG8_STAGE(PG8_SB(1, 1), cB + hstep + kstep, voffB);
        PG8_WAIT_V(6); PG8_BAR;
    }
    for (;;) {
        const bool has_next = S.next(ui + 1, nxt);
        const char* nA = has_next ? (const char*)g.A + (size_t)nxt.pm * tstep : cA; const char* nB = has_next ? (const char*)g.Bt + (size_t)nxt.pn * tstep : cB;
        for (int t = 0; t < nt; t += 2) {
            const bool last = (t == nt - 2);
            const char* a1 = cA + (size_t)(t + 1) * kstep;
            const char* a2 = last ? nA : cA + (size_t)(t + 2) * kstep; const char* b2 = last ? nB : cB + (size_t)(t + 2) * kstep;
            const char* a3 = a2 + kstep; const char* b3 = b2 + kstep;
            if (last && has_next) S.a_ready(nxt);
            if constexpr (SP2) {
            PG8_LDB(B0, 0, 0); PG8_LDB(B1, 0, 1); PG8_SCHED; PG8_LDA(At, 0, 0); PG8_STAGE(PG8_SA(1, 1), a1 + hstep, voffA);
            PG8_WAIT_V(8); PG8_WAIT_L(0); PG8_BAR; PG8_MMA(0, 0, At, B0); PG8_MMA(0, 1, At, B1); PG8_BAR; PG8_SCHED;
            PG8_LDA(At, 0, 1); PG8_STAGE(PG8_SB(0, 0), b2, voffB); PG8_STAGE(PG8_SB(0, 1), b2 + hstep, voffB); PG8_STAGE(PG8_SA(0, 0), a2, voffA);
            PG8_WAIT_V(8); PG8_WAIT_L(0); PG8_BAR; PG8_MMA(1, 0, At, B0); PG8_MMA(1, 1, At, B1); PG8_BAR; PG8_SCHED;
            PG8_LDB(B0, 1, 0); PG8_LDB(B1, 1, 1); PG8_SCHED; PG8_LDA(At, 1, 0); PG8_STAGE(PG8_SA(0, 1), a2 + hstep, voffA);
            PG8_WAIT_V(8); PG8_WAIT_L(0); PG8_BAR; PG8_MMA(0, 0, At, B0); PG8_MMA(0, 1, At, B1); PG8_BAR; PG8_SCHED;
            PG8_LDA(At, 1, 1); PG8_STAGE(PG8_SB(1, 0), b3, voffB); PG8_STAGE(PG8_SB(1, 1), b3 + hstep, voffB); PG8_STAGE(PG8_SA(1, 0), a3, voffA);
            PG8_WAIT_V(8); PG8_WAIT_L(0); PG8_BAR; PG8_MMA(1, 0, At, B0); PG8_MMA(1, 1, At, B1); PG8_BAR; PG8_SCHED;
            } else {
            PG8_LDB(B0, 0, 0); PG8_SCHED; PG8_LDA(At, 0, 0); PG8_STAGE(PG8_SA(1, 1), a1 + hstep, voffA);
            PG8_WAIT_L(8); PG8_BAR; PG8_WAIT_L(0); PG8_MMA(0, 0, At, B0); PG8_BAR; PG8_SCHED;
            PG8_LDB(B1, 0, 1); PG8_STAGE(PG8_SB(0, 0), b2, voffB);
            PG8_BAR; PG8_WAIT_L(0); PG8_MMA(0, 1, At, B1); PG8_BAR;
            PG8_LDA(At, 0, 1); PG8_STAGE(PG8_SA(0, 0), a2, voffA);
            PG8_BAR; PG8_WAIT_L(0); PG8_MMA(1, 0, At, B0); PG8_BAR; PG8_SCHED;
            PG8_STAGE(PG8_SB(0, 1), b2 + hstep, voffB);
            PG8_WAIT_V(6); PG8_BAR; PG8_MMA(1, 1, At, B1); PG8_BAR;
            PG8_LDB(B0, 1, 0); PG8_SCHED; PG8_LDA(At, 1, 0); PG8_STAGE(PG8_SA(0, 1), a2 + hstep, voffA);
            PG8_WAIT_L(8); PG8_BAR; PG8_WAIT_L(0); PG8_MMA(0, 0, At, B0); PG8_BAR; PG8_SCHED;
            PG8_LDB(B1, 1, 1); PG8_STAGE(PG8_SB(1, 0), b3, voffB);
            PG8_BAR; PG8_WAIT_L(0); PG8_MMA(0, 1, At, B1); PG8_BAR;
            PG8_LDA(At, 1, 1); PG8_STAGE(PG8_SA(1, 0), a3, voffA);
            PG8_BAR; PG8_WAIT_L(0); PG8_MMA(1, 0, At, B0); PG8_BAR; PG8_SCHED;
            PG8_STAGE(PG8_SB(1, 1), b3 + hstep, voffB);
            PG8_WAIT_V(6); PG8_BAR; PG8_MMA(1, 1, At, B1); PG8_BAR;
            }
        }
        if constexpr (ALIGN_EPI) { if (wr == 0) PG8_BAR; }
        if constexpr (!Epi::AFTER_DRAIN) { E(acc, cur, wr, wc, fr, fq); S.done(cur); }
        if (!has_next) break;
#pragma unroll
        for (int a = 0; a < 2; ++a)
#pragma unroll
            for (int b = 0; b < 2; ++b)
#pragma unroll
                for (int m = 0; m < 4; ++m)
#pragma unroll
                    for (int n = 0; n < 2; ++n) acc[a][b][m][n] = (f32x4){0.f, 0.f, 0.f, 0.f};
        cur = nxt; cA = nA; cB = nB; ++ui;
        if constexpr (ALIGN_EPI) { if (wr == 1) PG8_BAR; }
    }
    PG8_WAIT_V(0);
    if constexpr (!ALIGN_EPI) { if (wr == 0) PG8_BAR; }
    PG8_BAR;
    if constexpr (Epi::AFTER_DRAIN) { E.fused(acc, cur, wr, wc, fr, fq, lds, wid, lane); S.done(cur); }
#undef PG8_SA
#undef PG8_SB
#undef PG8_STAGE
#undef PG8_LDA
#undef PG8_LDB
#undef PG8_MMA
#undef PG8_WAIT_V
#undef PG8_WAIT_L
#undef PG8_BAR
#undef PG8_SCHED
}
}
#define MK_ONE_LAUNCH 1

constexpr int NB = 4, SEQ = 8192, T = NB * SEQ, D = 1024;
constexpr int NIN = 3584, DH = 512, HD = 128, NHH = 4, CHK = 64;
constexpr int NSEG = 16, SEGC = 8;
constexpr int CW = 31, CPAD = 15, DC = 512;
constexpr int PHEADS = 8, NQK = 2048, NSEL = 128;
constexpr float EPS = 1e-6f;
constexpr int NWAVES = 8, NTHR = 512;

constexpr size_t MiB = 1u << 20;
constexpr size_t WS_CTL = 0, CTL_ZERO_BYTES = 65536;
constexpr size_t WS_MOD = 1 * MiB, WS_FMOD = WS_MOD + 131072, WS_LB = WS_MOD + 196608, WS_BIASQ = WS_MOD + 262144;
constexpr size_t WS_WIN = 2 * MiB, WS_WOUT = 10 * MiB, WS_WQK = 12 * MiB;
constexpr size_t WS_UT = 16 * MiB, WS_VT = 48 * MiB;
constexpr size_t WS_BUFA = 80 * MiB;
constexpr size_t WS_BUFB = 144 * MiB;
constexpr size_t WS_SEG = 208 * MiB;
constexpr size_t WS_E = 208 * MiB, WS_W = 224 * MiB;
constexpr size_t WS_BIG = 240 * MiB;
constexpr size_t WS_SSQ = 496 * MiB;
constexpr size_t WS_SEGA = 498 * MiB;
constexpr size_t WS_RSTD = 499 * MiB;
constexpr size_t WS_END = 500 * MiB;
constexpr size_t WS_PACT = 240 * MiB;
constexpr size_t WS_Y = 368 * MiB;
constexpr int NSL = 8, CSL = 128;
constexpr float VSCALE = 16.0f;
constexpr float UQSCALE = 95.5f;
constexpr int NSLU = 4, CSLU = 256;
constexpr int CW_QU = 8192, CW_QV = 8192 + 64 * 16;
constexpr int CW_H1 = 6144;
constexpr int CW_BAR = 1024;

#ifndef LDSFILL
#define LDSFILL 0u
#endif
constexpr int LDS_BYTES = 155648;
constexpr int MISC_OFF = LDS_BYTES - 256;

#define GAS __attribute__((address_space(1)))
#define LAS __attribute__((address_space(3)))
typedef unsigned short bf16;
typedef unsigned v4u __attribute__((ext_vector_type(4)));
typedef unsigned v2u __attribute__((ext_vector_type(2)));
typedef float f32x4 __attribute__((ext_vector_type(4)));
typedef float f32x16 __attribute__((ext_vector_type(16)));
typedef short bf16x8 __attribute__((ext_vector_type(8)));
typedef float f32x2_ __attribute__((ext_vector_type(2)));

__device__ __forceinline__ float bf2f(unsigned h) { return __builtin_bit_cast(float, h << 16); }
__device__ __forceinline__ float bflo(unsigned u) { return __builtin_bit_cast(float, u << 16); }
__device__ __forceinline__ float bfhi(unsigned u) { return __builtin_bit_cast(float, u & 0xffff0000u); }
__device__ __forceinline__ unsigned f2bf(float f) { unsigned u = __builtin_bit_cast(unsigned, f); return (u + 0x7fffu + ((u >> 16) & 1u)) >> 16; }
__device__ __forceinline__ unsigned pk2(float lo, float hi) { return f2bf(lo) | (f2bf(hi) << 16); }
__device__ __forceinline__ unsigned cvtpk(float lo, float hi) { unsigned r; asm("v_cvt_pk_bf16_f32 %0, %1, %2" : "=v"(r) : "v"(lo), "v"(hi)); return r; }
__device__ __forceinline__ float sigmoidf_(float x) { return __builtin_amdgcn_rcpf(1.0f + __expf(-x)); }
#define DPP_ADD(s, ctrl) ((s) + __builtin_bit_cast(float, __builtin_amdgcn_update_dpp(0, __builtin_bit_cast(int, (s)), (ctrl), 0xF, 0xF, false)))
__device__ __forceinline__ float wave_sum(float v) {
#pragma unroll
    for (int o = 1; o < 64; o <<= 1) v += __shfl_xor(v, o);
    return v;
}

#define XB_TMO      128
#define XB_XCNT(j)  (256  + 64 * (j))
#define XB_XSUB(j)  (1280 + 64 * (j))
#define XB_XGEN(j)  (2304 + 64 * (j))
#define XB_TOP      3328
#define XB_TOPGEN   3392
#define XCD_BAR_WORDS 3456
#define XB_SPIN_CAP (1u << 18)
__device__ __forceinline__ unsigned xb_ld(unsigned* p)              { return __hip_atomic_load(p, __ATOMIC_RELAXED, __HIP_MEMORY_SCOPE_AGENT); }
__device__ __forceinline__ unsigned xb_add(unsigned* p, unsigned v) { return __hip_atomic_fetch_add(p, v, __ATOMIC_RELAXED, __HIP_MEMORY_SCOPE_AGENT); }
__device__ __forceinline__ unsigned xb_xcc_id() { return (unsigned)__builtin_amdgcn_s_getreg((3 << 11) | 20) & 0xFu; }
#define XB_SPIN(cond, bar) do { unsigned _sp = 0; while (cond) { __builtin_amdgcn_s_sleep(1); \
    if ((++_sp & 255u) == 0u) { if (xb_ld(&(bar)[XB_TMO])) break; if (_sp > XB_SPIN_CAP) { atomicAdd(&(bar)[XB_TMO], 1u); break; } } } } while (0)
struct XcdBarrier { unsigned* bar; unsigned x; volatile LAS unsigned* st; };
__device__ __forceinline__ XcdBarrier xcd_barrier_post(unsigned* bar, volatile LAS unsigned* st) {
    XcdBarrier b; b.bar = bar; b.x = xb_xcc_id(); b.st = st;
    if (threadIdx.x == 0) (void)xb_add(&bar[XB_XCNT(b.x)], 1u);
    return b;
}
__device__ __forceinline__ void xcd_barrier_complete(unsigned* bar, unsigned x, unsigned& nloc, unsigned& nx) {
    const unsigned G = gridDim.x * gridDim.y * gridDim.z;
    unsigned sum, cnt, mine, sp = 0u;
    for (;;) {
        sum = 0u; cnt = 0u; mine = 0u;
#pragma unroll
        for (unsigned j = 0; j < 16; ++j) { const unsigned c = xb_ld(&bar[XB_XCNT(j)]); sum += c; cnt += (c > 0u) ? 1u : 0u; mine = (j == x) ? c : mine; }
        if (sum == G) break;
        __builtin_amdgcn_s_sleep(1);
        if ((++sp & 255u) == 0u) { if (xb_ld(&bar[XB_TMO])) break; if (sp > XB_SPIN_CAP) { atomicAdd(&bar[XB_TMO], 1u); break; } }
    }
    nloc = mine > 0u ? mine : 1u; nx = cnt > 0u ? cnt : 1u;
}
__device__ __forceinline__ void xcd_barrier(const XcdBarrier& b) {
    asm volatile("s_waitcnt vmcnt(0)" ::: "memory");
    __syncthreads();
    if (threadIdx.x == 0) {
        unsigned* bar = b.bar;
        __builtin_amdgcn_s_waitcnt(0);
        unsigned nloc = b.st[0], nx = b.st[1];
        if (nloc == 0u) { xcd_barrier_complete(bar, b.x, nloc, nx); b.st[0] = nloc; b.st[1] = nx; }
        const unsigned old = xb_add(&bar[XB_XSUB(b.x)], 1u);
        const unsigned gen = old / nloc;
        if (old + 1u == (gen + 1u) * nloc) {
            __builtin_amdgcn_fence(__ATOMIC_RELEASE, "agent");
            asm volatile("s_waitcnt vmcnt(0)" ::: "memory");
            const unsigned og = xb_add(&bar[XB_TOP], 1u);
            const unsigned tg = og / nx;
            if (og + 1u == (tg + 1u) * nx) xb_add(&bar[XB_TOPGEN], 1u);
            else XB_SPIN(xb_ld(&bar[XB_TOPGEN]) == tg, bar);
            __builtin_amdgcn_fence(__ATOMIC_ACQUIRE, "agent");
            xb_add(&bar[XB_XGEN(b.x)], 1u);
            asm volatile("s_waitcnt vmcnt(0)" ::: "memory");
        } else {
            XB_SPIN(xb_ld(&bar[XB_XGEN(b.x)]) == gen, bar);
            __builtin_amdgcn_fence(__ATOMIC_ACQUIRE, "agent");
            asm volatile("s_waitcnt vmcnt(0)" ::: "memory");
        }
    }
    __syncthreads();
}

struct Args { const float* in[23]; float* out; unsigned char* ws; int ph_lo, ph_hi; };
struct Frame {
    LAS unsigned char* lds;
    int tid, lane, wave, G, bid;
    const Args* a;
    __device__ __forceinline__ const float* x() const { return a->in[0]; }
    __device__ __forceinline__ const float* c() const { return a->in[1]; }
    __device__ __forceinline__ const float* ada_w() const { return a->in[2]; }
    __device__ __forceinline__ const float* ada_b() const { return a->in[3]; }
    __device__ __forceinline__ const float* g_mix() const { return a->in[4]; }
    __device__ __forceinline__ const float* w_in() const { return a->in[5]; }
    __device__ __forceinline__ const float* lbg_f() const { return a->in[6]; }
    __device__ __forceinline__ const float* lbg_b() const { return a->in[7]; }
    __device__ __forceinline__ const float* hnorm_g() const { return a->in[8]; }
    __device__ __forceinline__ const float* conv_w() const { return a->in[9]; }
    __device__ __forceinline__ const float* conv_b() const { return a->in[10]; }
    __device__ __forceinline__ const float* cln_g() const { return a->in[11]; }
    __device__ __forceinline__ const float* cln_b() const { return a->in[12]; }
    __device__ __forceinline__ const float* w_out() const { return a->in[13]; }
    __device__ __forceinline__ const float* g_ffn() const { return a->in[14]; }
    __device__ __forceinline__ const float* wq() const { return a->in[15]; }
    __device__ __forceinline__ const float* keys1() const { return a->in[16]; }
    __device__ __forceinline__ const float* keys2() const { return a->in[17]; }
    __device__ __forceinline__ const float* utab() const { return a->in[18]; }
    __device__ __forceinline__ const float* vtab() const { return a->in[19]; }
    __device__ __forceinline__ const float* fada_w() const { return a->in[20]; }
    __device__ __forceinline__ const float* fada_b() const { return a->in[21]; }
    __device__ __forceinline__ const float* fnorm_g() const { return a->in[22]; }
    __device__ __forceinline__ float* out() const { return a->out; }
    __device__ __forceinline__ float* mod() const { return (float*)(a->ws + WS_MOD); }
    __device__ __forceinline__ float* fmod() const { return (float*)(a->ws + WS_FMOD); }
    __device__ __forceinline__ float* lb() const { return (float*)(a->ws + WS_LB); }
    __device__ __forceinline__ float* biasq() const { return (float*)(a->ws + WS_BIASQ); }
    __device__ __forceinline__ float* ssqp() const { return (float*)(a->ws + WS_SSQ); }
    __device__ __forceinline__ float* sega() const { return (float*)(a->ws + WS_SEGA); }
    __device__ __forceinline__ float* segu() const { return (float*)(a->ws + WS_SEG); }
    __device__ __forceinline__ float* of() const { return (float*)(a->ws + WS_BUFB); }
    __device__ __forceinline__ float* scores() const { return (float*)(a->ws + WS_BIG); }
    __device__ __forceinline__ float* wsel() const { return (float*)(a->ws + WS_W); }
    __device__ __forceinline__ int* esel() const { return (int*)(a->ws + WS_E); }
    __device__ __forceinline__ bf16* Win_t() const { return (bf16*)(a->ws + WS_WIN); }
    __device__ __forceinline__ bf16* Wout_t() const { return (bf16*)(a->ws + WS_WOUT); }
    __device__ __forceinline__ bf16* Wqk_t() const { return (bf16*)(a->ws + WS_WQK); }
    __device__ __forceinline__ bf16* Ub() const { return (bf16*)(a->ws + WS_UT); }
    __device__ __forceinline__ bf16* Vb() const { return (bf16*)(a->ws + WS_VT); }
    __device__ __forceinline__ bf16* bufA() const { return (bf16*)(a->ws + WS_BUFA); }
    __device__ __forceinline__ bf16* hg() const { return (bf16*)(a->ws + WS_BUFB); }
    __device__ __forceinline__ bf16* proj() const { return (bf16*)(a->ws + WS_BIG); }
    __device__ __forceinline__ float* coef() const { return (float*)(a->ws + WS_BUFA); }
    __device__ __forceinline__ float* rstd() const { return (float*)(a->ws + WS_RSTD); }
    __device__ __forceinline__ bf16* pact() const { return (bf16*)(a->ws + WS_PACT); }
    __device__ __forceinline__ bf16* ybuf() const { return (bf16*)(a->ws + WS_Y); }
    __device__ __forceinline__ unsigned char* U8() const { return (unsigned char*)(a->ws + WS_UT); }
    __device__ __forceinline__ unsigned char* V8() const { return (unsigned char*)(a->ws + WS_VT); }
    __device__ __forceinline__ unsigned* ctl() const { return (unsigned*)(a->ws + WS_CTL); }
};

__device__ __forceinline__ void p0_gemv(Frame& F) {
    LAS float* cact = (LAS float*)(F.lds);
    LAS float* red = (LAS float*)(F.lds + 16384);
    for (int i = F.tid; i < 4096; i += NTHR) { const float c = F.c()[i]; cact[i] = c * sigmoidf_(c); }
    __syncthreads();
    for (int item = F.bid; item < 128; item += F.G) {
        const int col0 = item * 64; const float* W; int N, cc;
        if (col0 < 6144) { W = F.ada_w(); N = 6144; cc = col0; } else { W = F.fada_w(); N = 2048; cc = col0 - 6144; }
        const float* wp = W + (size_t)(F.wave * 128) * N + cc + F.lane;
        float a0 = 0.f, a1 = 0.f, a2 = 0.f, a3 = 0.f;
#pragma unroll 32
        for (int k = 0; k < 128; ++k) { const float w = wp[(size_t)k * N]; const int kk = F.wave * 128 + k;
            a0 += cact[kk] * w; a1 += cact[1024 + kk] * w; a2 += cact[2048 + kk] * w; a3 += cact[3072 + kk] * w; }
        red[(F.wave * 4 + 0) * 64 + F.lane] = a0; red[(F.wave * 4 + 1) * 64 + F.lane] = a1; red[(F.wave * 4 + 2) * 64 + F.lane] = a2; red[(F.wave * 4 + 3) * 64 + F.lane] = a3;
        __syncthreads();
        if (F.tid < 256) { const int b = F.tid >> 6, l = F.tid & 63; float s = 0.f;
#pragma unroll
            for (int w = 0; w < 8; ++w) s += red[(w * 4 + b) * 64 + l];
            if (col0 < 6144) F.mod()[b * 6144 + cc + l] = s + F.ada_b()[cc + l]; else F.fmod()[b * 2048 + cc + l] = s + F.fada_b()[cc + l]; }
        __syncthreads();
    }
}
__device__ __forceinline__ void p0_transpose_item(const float* W, int K, int N, bf16* WT, LAS float* scr, int item, int lane) {
    const int nblk = N / 32, kb = item / nblk, nb = item % nblk, k0 = 64 * kb, n0 = 32 * nb;
#pragma unroll
    for (int i = 0; i < 32; ++i) { const int kk = 2 * i + (lane >> 5); scr[kk * 33 + (lane & 31)] = W[(size_t)(k0 + kk) * N + n0 + (lane & 31)]; }
    asm volatile("s_waitcnt lgkmcnt(0)" ::: "memory");
    const int c = lane & 7;
#pragma unroll
    for (int j = 0; j < 4; ++j) { const int n = (lane >> 3) + 8 * j; const LAS float* s = scr + (8 * c) * 33 + n;
        v4u o; o.x = pk2(s[0 * 33], s[1 * 33]); o.y = pk2(s[2 * 33], s[3 * 33]); o.z = pk2(s[4 * 33], s[5 * 33]); o.w = pk2(s[6 * 33], s[7 * 33]);
        *(v4u*)(WT + (size_t)(n0 + n) * K + k0 + 8 * c) = o; }
    asm volatile("s_waitcnt lgkmcnt(0)" ::: "memory");
}
__device__ __forceinline__ void p0_wqk_item(Frame& F, int item, LAS float* scr) {
    const int jq = item & 7, kb = (item >> 3) & 15, hh = item >> 7, h = hh >> 1, half = hh & 1;
    const float* keys = (half ? F.keys2() : F.keys1()) + (size_t)(jq * 16) * 128;
    const float* wtile = F.wq() + (size_t)(kb * 64) * 2048 + h * 256 + half * 128;
    LAS float* kL = scr + 1280;
    { f32x4 k4[8];
#pragma unroll
      for (int i = 0; i < 8; ++i) k4[i] = *(const f32x4*)(keys + (i * 64 + F.lane) * 4);
#pragma unroll
      for (int i = 0; i < 8; ++i) *(LAS f32x4*)(kL + (i * 64 + F.lane) * 4) = k4[i]; }
    float acc[16];
#pragma unroll
    for (int j = 0; j < 16; ++j) acc[j] = 0.f;
    f32x4 t4[4], n4[4];
#pragma unroll
    for (int i = 0; i < 4; ++i) t4[i] = *(const f32x4*)(wtile + (size_t)(16 * i + (F.lane >> 2)) * 2048 + 4 * (F.lane & 3));
    for (int d0 = 0; d0 < 128; d0 += 16) {
        if (d0 + 16 < 128) {
#pragma unroll
            for (int i = 0; i < 4; ++i) n4[i] = *(const f32x4*)(wtile + (size_t)(16 * i + (F.lane >> 2)) * 2048 + d0 + 16 + 4 * (F.lane & 3)); }
#pragma unroll
        for (int i = 0; i < 4; ++i) *(LAS f32x4*)(scr + (16 * i + (F.lane >> 2)) * 20 + 4 * (F.lane & 3)) = t4[i];
        asm volatile("s_waitcnt lgkmcnt(0)" ::: "memory");
#pragma unroll
        for (int dd = 0; dd < 16; dd += 4) { const f32x4 a = *(LAS const f32x4*)(scr + F.lane * 20 + dd);
#pragma unroll
            for (int j = 0; j < 16; ++j) { const f32x4 kp = *(LAS const f32x4*)(kL + j * 128 + d0 + dd); acc[j] += a[0] * kp[0] + a[1] * kp[1] + a[2] * kp[2] + a[3] * kp[3]; } }
        asm volatile("s_waitcnt lgkmcnt(0)" ::: "memory");
#pragma unroll
        for (int i = 0; i < 4; ++i) t4[i] = n4[i];
    }
    bf16* o = F.Wqk_t() + (size_t)(h * 256 + half * 128 + jq * 16) * 1024 + kb * 64 + F.lane;
#pragma unroll
    for (int j = 0; j < 16; ++j) o[(size_t)j * 1024] = (bf16)f2bf(acc[j]);
}
__device__ __forceinline__ void p0_prologue(Frame& F) {
    if (F.bid < 128) p0_gemv(F);
    if (F.bid == 128 % F.G) { const int i = F.tid;
        F.lb()[i] = __builtin_amdgcn_rcpf(1.0f + __expf(F.lbg_f()[512 + i] - F.lbg_f()[i]));
        F.lb()[512 + i] = __builtin_amdgcn_rcpf(1.0f + __expf(F.lbg_b()[512 + i] - F.lbg_b()[i])); }
    LAS float* scr = (LAS float*)(F.lds + 32768 + F.wave * 14336);
    const int gw = F.wave * F.G + F.bid, NGW = F.G * NWAVES;
    constexpr int I_QK = 2048, I_IN = (D / 64) * (NIN / 32), I_OUT = (D / 64) * (D / 32), I_TAB = 2 * 16384 / 4;
    constexpr int NITEMS = I_QK + I_IN + I_OUT + I_TAB;
    for (int it = gw; it < NITEMS; it += NGW) {
        int r = it;
        if (r < I_QK) { p0_wqk_item(F, r, scr); continue; } r -= I_QK;
        if (r < I_IN) { p0_transpose_item(F.w_in(), D, NIN, F.Win_t(), scr, r, F.lane); continue; } r -= I_IN;
        if (r < I_OUT) { p0_transpose_item(F.w_out(), D, D, F.Wout_t(), scr, r, F.lane); continue; } r -= I_OUT;
        { const int tab = r >= 4096, rr = (tab ? r - 4096 : r) * 4; const float* src = (tab ? F.vtab() : F.utab()) + (size_t)rr * 1024; unsigned char* dst = tab ? F.V8() : F.U8();
          const float sc = tab ? VSCALE : UQSCALE;
#pragma unroll
          for (int q = 0; q < 16; ++q) { const int row = rr + (q >> 2), qq = q & 3; const f32x4 v = *(const f32x4*)(src + (q >> 2) * 1024 + qq * 256 + 4 * F.lane) * sc;
              int pk;
              if (tab) { pk = __builtin_amdgcn_cvt_pk_fp8_f32(v[0], v[1], 0, false); pk = __builtin_amdgcn_cvt_pk_fp8_f32(v[2], v[3], pk, true); }
              else { int q0 = (int)__builtin_rintf(v[0]), q1 = (int)__builtin_rintf(v[1]), q2 = (int)__builtin_rintf(v[2]), q3 = (int)__builtin_rintf(v[3]);
                  q0 = q0 < -7 ? -7 : (q0 > 7 ? 7 : q0); q1 = q1 < -7 ? -7 : (q1 > 7 ? 7 : q1); q2 = q2 < -7 ? -7 : (q2 > 7 ? 7 : q2); q3 = q3 < -7 ? -7 : (q3 > 7 ? 7 : q3);
                  *(unsigned short*)(dst + ((size_t)qq * 16384 + row) * 128 + 2 * F.lane) = (unsigned short)((q0 & 0xf) | ((q1 & 0xf) << 4) | ((q2 & 0xf) << 8) | ((q3 & 0xf) << 12)); continue; }
              const int sl = 2 * qq + (F.lane >> 5);
              *(int*)(dst + ((size_t)sl * 16384 + row) * CSL + 4 * (F.lane & 31)) = pk; } }
    }
}

__device__ __forceinline__ void p1_norm(Frame& F) {
    const int gwc = F.bid * NWAVES + F.wave, NGW = F.G * NWAVES;
    for (int row0 = gwc * 16; row0 < T; row0 += NGW * 16) {
        const int b = row0 >> 13; const float* mb = F.mod() + b * 6144;
        f32x4 ca[4], cb[4];
#pragma unroll
        for (int j = 0; j < 4; ++j) { const int k = 256 * j + 4 * F.lane; const f32x4 g = *(const f32x4*)(F.g_mix() + k), s = *(const f32x4*)(mb + 1024 + k); ca[j] = g * (s + 1.0f); cb[j] = *(const f32x4*)(mb + k); }
#pragma unroll 4
        for (int r = 0; r < 16; ++r) { const float* xr = F.x() + (size_t)(row0 + r) * D;
            f32x4 v[4]; float ss = 0.f;
#pragma unroll
            for (int j = 0; j < 4; ++j) { v[j] = *(const f32x4*)(xr + 256 * j + 4 * F.lane); ss += v[j][0] * v[j][0] + v[j][1] * v[j][1] + v[j][2] * v[j][2] + v[j][3] * v[j][3]; }
            const float rstd = __builtin_amdgcn_rsqf(wave_sum(ss) * (1.0f / D) + EPS);
            bf16* o = F.bufA() + (size_t)(row0 + r) * D;
#pragma unroll
            for (int j = 0; j < 4; ++j) { const f32x4 y = v[j] * rstd * ca[j] + cb[j]; v2u w; w.x = pk2(y[0], y[1]); w.y = pk2(y[2], y[3]); *(v2u*)(o + 256 * j + 4 * F.lane) = w; } }
    }
    const int gw = F.wave * F.G + F.bid;
    for (int n0 = gw * 32; n0 < NQK; n0 += NGW * 32) {
        float sv[4][16];
#pragma unroll
        for (int b = 0; b < 4; ++b) { const float* sh2 = F.mod() + b * 6144 + 3072;
#pragma unroll
            for (int i = 0; i < 8; ++i) { sv[b][i] = sh2[8 * F.lane + i]; sv[b][8 + i] = sh2[512 + 8 * F.lane + i]; } }
        float res[4] = {0.f, 0.f, 0.f, 0.f};
        for (int q = 0; q < 32; ++q) { const int n = n0 + q;
            const v4u w0 = *(const v4u*)(F.Wqk_t() + (size_t)n * 1024 + 8 * F.lane), w1 = *(const v4u*)(F.Wqk_t() + (size_t)n * 1024 + 512 + 8 * F.lane);
            float wv[16];
#pragma unroll
            for (int i = 0; i < 4; ++i) { wv[2 * i] = bflo(w0[i]); wv[2 * i + 1] = bfhi(w0[i]); wv[8 + 2 * i] = bflo(w1[i]); wv[8 + 2 * i + 1] = bfhi(w1[i]); }
#pragma unroll
            for (int b = 0; b < 4; ++b) { float sm = 0.f;
#pragma unroll
                for (int i = 0; i < 16; ++i) sm += wv[i] * sv[b][i];
                sm = wave_sum(sm); if (F.lane == q) res[b] = sm; } }
        if (F.lane < 32) {
#pragma unroll
            for (int b = 0; b < 4; ++b) F.biasq()[b * 2048 + n0 + F.lane] = res[b]; }
    }
}

__device__ __forceinline__ void conv_item(Frame& F, int item, const float (&cw)[CW], float cbias) {
    LAS bf16* hbuf = (LAS bf16*)(F.lds);
    LAS float* ybuf = (LAS float*)(F.lds + 65536);
    const int tok0 = item * 32, b = tok0 >> 13, t0 = tok0 & (SEQ - 1), c = F.tid;
#pragma unroll
    for (int k = 0; k < 8; ++k) { const int pi = F.tid + NTHR * k; if (pi < 62 * 64) { const int r = pi >> 6, ch = pi & 63, t = t0 - CPAD + r; v4u o = {0u, 0u, 0u, 0u};
            if (t >= 0 && t < SEQ) { const bf16* pr = F.proj() + (size_t)(b * SEQ + t) * NIN + 8 * ch; const v4u a = *(const v4u*)(pr + 2560), g = *(const v4u*)(pr + 3072);
#pragma unroll
                for (int i = 0; i < 4; ++i) o[i] = cvtpk(bflo(a[i]) * bflo(g[i]), bfhi(a[i]) * bfhi(g[i])); }
            *(LAS v4u*)(hbuf + r * 512 + 8 * ch) = o; } }
    __syncthreads();
    float hv[62];
#pragma unroll
    for (int r = 0; r < 62; ++r) hv[r] = bf2f(hbuf[r * 512 + c]);
#pragma unroll
    for (int tt = 0; tt < 32; ++tt) { float acc = cbias;
#pragma unroll
        for (int j = 0; j < CW; ++j) acc += cw[j] * hv[tt + j];
        ybuf[tt * 512 + c] = acc; }
    __syncthreads();
#pragma unroll
    for (int q = 0; q < 4; ++q) { const int tt = F.wave * 4 + q;
        const f32x4 y0 = *(LAS const f32x4*)(ybuf + tt * 512 + 8 * F.lane), y1 = *(LAS const f32x4*)(ybuf + tt * 512 + 8 * F.lane + 4);
        const float mean = wave_sum((y0[0] + y0[1] + y0[2] + y0[3]) + (y1[0] + y1[1] + y1[2] + y1[3])) * (1.0f / DC);
        const f32x4 d0 = y0 - mean, d1 = y1 - mean;
        const float var = wave_sum((d0[0] * d0[0] + d0[1] * d0[1] + d0[2] * d0[2] + d0[3] * d0[3]) + (d1[0] * d1[0] + d1[1] * d1[1] + d1[2] * d1[2] + d1[3] * d1[3])) * (1.0f / DC);
        const float rstd = __builtin_amdgcn_rsqf(var + EPS);
        const f32x4 g0 = *(const f32x4*)(F.cln_g() + 8 * F.lane), g1 = *(const f32x4*)(F.cln_g() + 8 * F.lane + 4), b0 = *(const f32x4*)(F.cln_b() + 8 * F.lane), b1 = *(const f32x4*)(F.cln_b() + 8 * F.lane + 4);
        f32x4 z0 = d0 * rstd * g0 + b0, z1 = d1 * rstd * g1 + b1;
#pragma unroll
        for (int i = 0; i < 4; ++i) { z0[i] = z0[i] * sigmoidf_(z0[i]); z1[i] = z1[i] * sigmoidf_(z1[i]); }
        v4u w; w.x = cvtpk(z0[0], z0[1]); w.y = cvtpk(z0[2], z0[3]); w.z = cvtpk(z1[0], z1[1]); w.w = cvtpk(z1[2], z1[3]);
        *(v4u*)(F.bufA() + (size_t)(tok0 + tt) * D + 512 + 8 * F.lane) = w; }
    __syncthreads();
}

constexpr int PQ = 272, PT = 144;
constexpr int HL_QR = 0, HL_KR = 17408, HL_QE = 34816, HL_KET = 52224, HL_VT = 70656, HL_SCM = 89088, HL_ST = 98304, HL_PBLK = 133120  , HL_AV = 137216, HL_RS = 137728;
static_assert(HL_PBLK + 8 * 128 * 4 <= HL_AV && HL_AV + 512 <= HL_RS && HL_RS + 1024 <= 155648 - 256, "HGRN LDS map");
__device__ __forceinline__ bf16x8 ldf(LAS const unsigned char* base, int row, int pitch, int kbyte) { return *(LAS const bf16x8*)(base + row * pitch + kbyte); }
#define MFMA32(a, b, c) __builtin_amdgcn_mfma_f32_32x32x16_bf16((a), (b), (c), 0, 0, 0)

template <bool FULL>
__device__ __forceinline__ void hgrn_load(Frame& F, int b, int h, int dir, int chunk, unsigned (&rz)[8], unsigned (&rv)[8], unsigned (&rq)[8]) {
    const size_t tokbase = (size_t)b * SEQ + (size_t)chunk * CHK; const int zoff = dir ? 1024 : 512, c0 = 2 * F.lane;
#pragma unroll
    for (int i = 0; i < 8; ++i) { const int p = 8 * F.wave + i, tr = dir ? (63 - p) : p; const bf16* q = F.proj() + (tokbase + tr) * NIN + h * HD;
        rz[i] = *(const unsigned*)(q + zoff + c0); rv[i] = *(const unsigned*)(q + 1536 + c0); if (FULL) rq[i] = *(const unsigned*)(q + c0); }
}
template <bool FULL, int MODE>
__device__ __forceinline__ void hgrn_chunk(Frame& F, int b, int h, int dir, int chunk, int nchunk, f32x16 (&accS)[2], float lb0, float lb1, unsigned (&rz)[8], unsigned (&rv)[8], unsigned (&rq)[8]) {
    LAS unsigned char* lds = F.lds;
    int r = F.lane & 31, hh = F.lane >> 5, c0 = 2 * F.lane;
    asm volatile("" : "+v"(r), "+v"(hh), "+v"(c0));
    const int w = F.wave, rb = w;
    const size_t tokbase = (size_t)b * SEQ + (size_t)chunk * CHK;
    {
        const f32x2_ oml = {1.0f - lb0, 1.0f - lb1};
        f32x2_ f2[8], cf2[8], cr2[8];
        f32x2_ run = {1.f, 1.f};
#pragma unroll
        for (int i = 0; i < 8; ++i) { const f32x2_ kk = {bflo(rz[i]), bfhi(rz[i])}; f2[i] = 1.0f - oml * kk; run *= f2[i]; cf2[i] = run; }
        { f32x2_ q = {1.f, 1.f};
#pragma unroll
          for (int i = 7; i >= 0; --i) { cr2[i] = q; q *= f2[i]; } }
        LAS float* pblk = (LAS float*)(lds + HL_PBLK);
        *(LAS f32x2_*)(pblk + rb * 128 + c0) = run;
        __syncthreads();
        f32x2_ pre = {1.f, 1.f}, post = {1.f, 1.f}, mid = {1.f, 1.f};
        for (int q = 0; q < rb; ++q) pre *= *(LAS const f32x2_*)(pblk + q * 128 + c0);
        for (int q = rb + 1; q < 8; ++q) post *= *(LAS const f32x2_*)(pblk + q * 128 + c0);
        if (rb < 4) { for (int q = rb + 1; q < 4; ++q) mid *= *(LAS const f32x2_*)(pblk + q * 128 + c0); }
        else { for (int q = 4; q < rb; ++q) mid *= *(LAS const f32x2_*)(pblk + q * 128 + c0); }
        if (rb == 0) *(LAS f32x2_*)((LAS float*)(lds + HL_AV) + c0) = run * post;
        f32x2_ ke2[8];
#pragma unroll
        for (int i = 0; i < 8; ++i) ke2[i] = (1.0f - f2[i]) * cr2[i] * post;
        if (FULL) {
            if (rb < 4) {
#pragma unroll
                for (int i = 0; i < 8; ++i) { const int p = 8 * rb + i; const f32x2_ qs = {bflo(rq[i]), bfhi(rq[i])}, k2 = 1.0f - f2[i], G = cr2[i] * mid;
                    f32x2_ iG; iG[0] = __builtin_amdgcn_rcpf(G[0]); iG[1] = __builtin_amdgcn_rcpf(G[1]);
                    const f32x2_ qe = qs * pre * cf2[i], qr = qs * iG, kr = k2 * G;
                    *(LAS unsigned*)(lds + HL_QE + p * PQ + c0 * 2) = cvtpk(qe[0], qe[1]);
                    *(LAS unsigned*)(lds + HL_QR + p * PQ + c0 * 2) = cvtpk(qr[0], qr[1]);
                    *(LAS unsigned*)(lds + HL_KR + p * PQ + c0 * 2) = cvtpk(kr[0], kr[1]); }
            } else {
#pragma unroll
                for (int i = 0; i < 8; ++i) { const int p = 8 * rb + i; const f32x2_ qs = {bflo(rq[i]), bfhi(rq[i])}, k2 = 1.0f - f2[i], G = cf2[i] * mid;
                    f32x2_ iG; iG[0] = __builtin_amdgcn_rcpf(G[0]); iG[1] = __builtin_amdgcn_rcpf(G[1]);
                    const f32x2_ qe = qs * pre * cf2[i], qr = qs * G, kr = k2 * iG;
                    *(LAS unsigned*)(lds + HL_QE + p * PQ + c0 * 2) = cvtpk(qe[0], qe[1]);
                    *(LAS unsigned*)(lds + HL_QR + p * PQ + c0 * 2) = cvtpk(qr[0], qr[1]);
                    *(LAS unsigned*)(lds + HL_KR + p * PQ + c0 * 2) = cvtpk(kr[0], kr[1]); }
            }
        }
        v4u ka, kb, va, vb2;
        ka.x = cvtpk(ke2[0][0], ke2[1][0]); ka.y = cvtpk(ke2[2][0], ke2[3][0]); ka.z = cvtpk(ke2[4][0], ke2[5][0]); ka.w = cvtpk(ke2[6][0], ke2[7][0]);
        kb.x = cvtpk(ke2[0][1], ke2[1][1]); kb.y = cvtpk(ke2[2][1], ke2[3][1]); kb.z = cvtpk(ke2[4][1], ke2[5][1]); kb.w = cvtpk(ke2[6][1], ke2[7][1]);
        va.x = (rv[0] & 0xffffu) | (rv[1] << 16); va.y = (rv[2] & 0xffffu) | (rv[3] << 16); va.z = (rv[4] & 0xffffu) | (rv[5] << 16); va.w = (rv[6] & 0xffffu) | (rv[7] << 16);
        vb2.x = (rv[0] >> 16) | (rv[1] & 0xffff0000u); vb2.y = (rv[2] >> 16) | (rv[3] & 0xffff0000u); vb2.z = (rv[4] >> 16) | (rv[5] & 0xffff0000u); vb2.w = (rv[6] >> 16) | (rv[7] & 0xffff0000u);
        *(LAS v4u*)(lds + HL_KET + c0 * PT + 16 * rb) = ka; *(LAS v4u*)(lds + HL_KET + (c0 + 1) * PT + 16 * rb) = kb;
        *(LAS v4u*)(lds + HL_VT + c0 * PT + 16 * rb) = va; *(LAS v4u*)(lds + HL_VT + (c0 + 1) * PT + 16 * rb) = vb2;
    }
    if (nchunk >= 0) hgrn_load<FULL>(F, b, h, dir, nchunk, rz, rv, rq);
    __syncthreads();
    const int pbO = w & 1, vb = w >> 1;
    f32x16 accO, accU[2];
#pragma unroll
    for (int i = 0; i < 16; ++i) { accO[i] = 0.f; accU[0][i] = 0.f; accU[1][i] = 0.f; }
    if (FULL) {
        if (w < 3) { const int pbS = (w + 1) >> 1, sbS = (w == 2) ? 1 : 0; f32x16 sc;
#pragma unroll
            for (int i = 0; i < 16; ++i) sc[i] = 0.f;
#pragma unroll
            for (int s = 0; s < 8; ++s) sc = MFMA32(ldf(lds + HL_QR, pbS * 32 + r, PQ, 32 * s + 16 * hh), ldf(lds + HL_KR, sbS * 32 + r, PQ, 32 * s + 16 * hh), sc);
#pragma unroll
            for (int i = 0; i < 16; i += 2) { const int p = pbS * 32 + (i & 3) + 8 * (i >> 2) + 4 * hh, s = sbS * 32 + r;
                const unsigned pkd = cvtpk(s <= p ? sc[i] : 0.f, s <= p + 1 ? sc[i + 1] : 0.f);
                *(LAS bf16*)(lds + HL_SCM + p * PT + s * 2) = (bf16)pkd; *(LAS bf16*)(lds + HL_SCM + (p + 1) * PT + s * 2) = (bf16)(pkd >> 16); } }
        __builtin_amdgcn_sched_barrier(0);
#pragma unroll
        for (int s = 0; s < 8; ++s) accO = MFMA32(ldf(lds + HL_QE, pbO * 32 + r, PQ, 32 * s + 16 * hh), ldf(lds + HL_ST, vb * 32 + r, PQ, 32 * s + 16 * hh), accO);
        __builtin_amdgcn_sched_barrier(0);
    }
#pragma unroll
    for (int i = 0; i < 2; ++i) { const int db = 2 * (w & 1) + i;
#pragma unroll
        for (int s = 0; s < 4; ++s) accU[i] = MFMA32(ldf(lds + HL_VT, vb * 32 + r, PT, 32 * s + 16 * hh), ldf(lds + HL_KET, db * 32 + r, PT, 32 * s + 16 * hh), accU[i]); }
    __builtin_amdgcn_sched_barrier(0);
    if (FULL) __syncthreads();
    if (FULL) {
        const unsigned v = vb * 32 + r;
        const unsigned lrow = (MODE == 0 ? (unsigned)hh : (unsigned)(1 - hh)) * 4u;
        const size_t rbase = (MODE == 0) ? (tokbase + pbO * 32) : (tokbase + 63 - pbO * 32 - 4);
        const unsigned lo_of = lrow * DH + v, lo_pr = lrow * NIN + v, lo_a2 = lrow * D + v;
        float ofv[16]; unsigned gv[16];
        if (MODE == 1) {
#pragma unroll
            for (int i = 0; i < 16; ++i) { const int ci = (i & 3) + 8 * (i >> 2); ofv[i] = (F.of() + (rbase - ci) * DH + h * HD)[lo_of]; } }
        for (int sb = 0; sb <= pbO; ++sb)
#pragma unroll
            for (int s2 = 0; s2 < 2; ++s2) accO = MFMA32(ldf(lds + HL_SCM, pbO * 32 + r, PT, 64 * sb + 32 * s2 + 16 * hh), ldf(lds + HL_VT, vb * 32 + r, PT, 64 * sb + 32 * s2 + 16 * hh), accO);
        if (MODE == 0) {
#pragma unroll
            for (int i = 0; i < 16; ++i) { const int ci = (i & 3) + 8 * (i >> 2); (F.of() + (rbase + ci) * DH + h * HD)[lo_of] = accO[i]; }
        } else {
            LAS float* rs = (LAS float*)(lds + HL_RS);
#pragma unroll
            for (int i = 0; i < 16; ++i) { const int ci = (i & 3) + 8 * (i >> 2); gv[i] = (F.proj() + (rbase - ci) * NIN + 2048 + h * HD)[lo_pr]; }
            float ov[16];
            float ssr[16];
#pragma unroll
            for (int i = 0; i < 16; ++i) { ov[i] = accO[i] + ofv[i]; float ss = ov[i] * ov[i];
                ss = DPP_ADD(ss, 0x128); ss = DPP_ADD(ss, 0x124); ss = DPP_ADD(ss, 0x122); ss = DPP_ADD(ss, 0x121);
                ssr[i] = ss + __builtin_bit_cast(float, __builtin_amdgcn_update_dpp(0, __builtin_bit_cast(int, ss), 0x142, 0xA, 0xF, false)); }
            if (r == 16) {
#pragma unroll
                for (int i = 0; i < 16; ++i) { const int ci = (i & 3) + 8 * (i >> 2), p = pbO * 32 + ci + 4 * hh; rs[p * 4 + vb] = ssr[i]; } }
            __syncthreads();
            const float ng = F.hnorm_g()[h * HD + v];
#pragma unroll
            for (int i = 0; i < 16; ++i) { const int ci = (i & 3) + 8 * (i >> 2), p = pbO * 32 + ci + 4 * hh;
                const f32x4 q = *(LAS const f32x4*)(rs + p * 4);
                const float rstd = __builtin_amdgcn_rsqf((q[0] + q[1] + q[2] + q[3]) * (1.0f / HD) + EPS);
                const float g = bf2f(gv[i]);
                (F.bufA() + (rbase - ci) * D + h * HD)[lo_a2] = (bf16)cvtpk(ov[i] * rstd * ng * g, 0.f); }
        }
    }
    {
        const LAS float* av = (const LAS float*)(lds + HL_AV);
#pragma unroll
        for (int i = 0; i < 2; ++i) { const int db = 2 * (w & 1) + i; const float a = av[db * 32 + r];
#pragma unroll
            for (int j = 0; j < 16; j += 2) { const float s0 = accS[i][j] * a + accU[i][j], s1 = accS[i][j + 1] * a + accU[i][j + 1]; accS[i][j] = s0; accS[i][j + 1] = s1;
                if (FULL) { const int vv = vb * 32 + (j & 3) + 8 * (j >> 2) + 4 * hh; const unsigned pkd = cvtpk(s0, s1);
                    *(LAS bf16*)(lds + HL_ST + vv * PQ + (db * 32 + r) * 2) = (bf16)pkd; *(LAS bf16*)(lds + HL_ST + (vv + 1) * PQ + (db * 32 + r) * 2) = (bf16)(pkd >> 16); } } }
    }
    __syncthreads();
}
__device__ __forceinline__ void h1_item(Frame& F, int item) {
    const int seg = item & 15, dir = (item >> 4) & 1, h = (item >> 5) & 3, b = item >> 7;
    const float lb0 = F.lb()[dir * 512 + h * HD + 2 * F.lane], lb1 = F.lb()[dir * 512 + h * HD + 2 * F.lane + 1];
    f32x16 accS[2];
#pragma unroll
    for (int i = 0; i < 16; ++i) { accS[0][i] = 0.f; accS[1][i] = 0.f; }
    float atot = 1.f; const int col = F.tid & 127;
    unsigned rzA[8], rvA[8], rzB[8], rvB[8], rq[8];
#define H1CH(c) (seg * SEGC + (dir ? (SEGC - 1 - (c)) : (c)))
    hgrn_load<false>(F, b, h, dir, H1CH(0), rzA, rvA, rq); hgrn_load<false>(F, b, h, dir, H1CH(1), rzB, rvB, rq);
    for (int c = 0; c < SEGC; c += 2) {
        hgrn_chunk<false, 0>(F, b, h, dir, H1CH(c), (c + 2 < SEGC) ? H1CH(c + 2) : -1, accS, lb0, lb1, rzA, rvA, rq);
        atot *= ((const LAS float*)(F.lds + HL_AV))[col];
        hgrn_chunk<false, 0>(F, b, h, dir, H1CH(c + 1), (c + 3 < SEGC) ? H1CH(c + 3) : -1, accS, lb0, lb1, rzB, rvB, rq);
        atot *= ((const LAS float*)(F.lds + HL_AV))[col]; }
#undef H1CH
    if (F.tid < 128) F.sega()[(size_t)item * 128 + col] = atot;
    float* U = F.segu() + (size_t)item * 16384;
#pragma unroll
    for (int i = 0; i < 2; ++i)
#pragma unroll
        for (int j = 0; j < 16; j += 4) { f32x4 o; o[0] = accS[i][j]; o[1] = accS[i][j + 1]; o[2] = accS[i][j + 2]; o[3] = accS[i][j + 3]; ((f32x4*)(U + (i * 4 + (j >> 2)) * NTHR * 4))[F.tid] = o; }
}
__device__ __forceinline__ void h_scan(Frame& F) {
    for (int g = F.bid; g < NB * NHH * 2 * 8; g += F.G) {
        const int chain = g >> 3, k = g & 7, dir = chain & 1;
        const int aidx = (2 * (F.wave & 1) + (k >> 2)) * 32 + (F.lane & 31);
        float* U = F.segu() + (size_t)chain * NSEG * 16384 + (size_t)k * NTHR * 4 + F.tid * 4;
        const float* A = F.sega() + (size_t)chain * NSEG * 128 + aidx;
        f32x4 u[NSEG]; float av[NSEG];
#pragma unroll
        for (int q = 0; q < NSEG; ++q) { const int sg = dir ? (NSEG - 1 - q) : q; u[q] = *(const f32x4*)(U + (size_t)sg * 16384); av[q] = A[sg * 128]; }
        f32x4 S = {0.f, 0.f, 0.f, 0.f};
#pragma unroll
        for (int q = 0; q < NSEG; ++q) { const int sg = dir ? (NSEG - 1 - q) : q; *(f32x4*)(U + (size_t)sg * 16384) = S; S = S * av[q] + u[q]; }
    }
}
__device__ __forceinline__ void h2_init_state(Frame& F, int b, int h, int dir, int seg, f32x16 (&accS)[2]) {
    const int w = F.wave, r = F.lane & 31, hh = F.lane >> 5, vb = w >> 1;
    const float* U = F.segu() + (size_t)(((b * 4 + h) * 2 + dir) * NSEG + seg) * 16384;
#pragma unroll
    for (int k = 0; k < 8; ++k) { const f32x4 v = ((const f32x4*)(U + k * NTHR * 4))[F.tid]; const int i = k >> 2, j = (k & 3) * 4;
        accS[i][j] = v[0]; accS[i][j + 1] = v[1]; accS[i][j + 2] = v[2]; accS[i][j + 3] = v[3]; }
#pragma unroll
    for (int i = 0; i < 2; ++i) { const int db = 2 * (w & 1) + i;
#pragma unroll
        for (int j = 0; j < 16; ++j) { const int vv = vb * 32 + (j & 3) + 8 * (j >> 2) + 4 * hh; *(LAS bf16*)(F.lds + HL_ST + vv * PQ + (db * 32 + r) * 2) = (bf16)f2bf(accS[i][j]); } }
    __syncthreads();
}
__device__ __forceinline__ void h2_item(Frame& F, int item) {
    const int seg = item & 15, h = (item >> 4) & 3, b = item >> 6;
    f32x16 accS[2];
    unsigned rzA[8], rvA[8], rqA[8], rzB[8], rvB[8], rqB[8];
    { const float lb0 = F.lb()[h * HD + 2 * F.lane], lb1 = F.lb()[h * HD + 2 * F.lane + 1];
      const int c0 = seg * SEGC;
      hgrn_load<true>(F, b, h, 0, c0, rzA, rvA, rqA); hgrn_load<true>(F, b, h, 0, c0 + 1, rzB, rvB, rqB);
      h2_init_state(F, b, h, 0, seg, accS);
      for (int c = 0; c < SEGC; c += 2) {
          hgrn_chunk<true, 0>(F, b, h, 0, c0 + c, (c + 2 < SEGC) ? (c0 + c + 2) : -1, accS, lb0, lb1, rzA, rvA, rqA);
          hgrn_chunk<true, 0>(F, b, h, 0, c0 + c + 1, (c + 3 < SEGC) ? (c0 + c + 3) : -1, accS, lb0, lb1, rzB, rvB, rqB); } }
    asm volatile("s_waitcnt vmcnt(0)" ::: "memory");
    __syncthreads();
    { const float lb0 = F.lb()[512 + h * HD + 2 * F.lane], lb1 = F.lb()[512 + h * HD + 2 * F.lane + 1];
      const int cl = seg * SEGC + SEGC - 1;
      hgrn_load<true>(F, b, h, 1, cl, rzA, rvA, rqA); hgrn_load<true>(F, b, h, 1, cl - 1, rzB, rvB, rqB);
      h2_init_state(F, b, h, 1, seg, accS);
      for (int c = 0; c < SEGC; c += 2) {
          hgrn_chunk<true, 1>(F, b, h, 1, cl - c, (c + 2 < SEGC) ? (cl - c - 2) : -1, accS, lb0, lb1, rzA, rvA, rqA);
          hgrn_chunk<true, 1>(F, b, h, 1, cl - c - 1, (c + 3 < SEGC) ? (cl - c - 3) : -1, accS, lb0, lb1, rzB, rvB, rqB); } }
}

__device__ __forceinline__ unsigned f2key(float f) { return __builtin_bit_cast(unsigned, f); }
__device__ __forceinline__ float key2f(unsigned k) { return __builtin_bit_cast(float, k); }
__device__ __forceinline__ unsigned umax_(unsigned a, unsigned b) { unsigned r; asm("v_max_f32 %0, %1, %2" : "=v"(r) : "v"(a), "v"(b)); return r; }
__device__ __forceinline__ unsigned umin_(unsigned a, unsigned b) { unsigned r; asm("v_min_f32 %0, %1, %2" : "=v"(r) : "v"(a), "v"(b)); return r; }
__device__ __forceinline__ void sort16(unsigned (&a)[16]) {
#define CE_(i, j) { const unsigned x_ = a[i], y_ = a[j]; a[i] = umax_(x_, y_); a[j] = umin_(x_, y_); }
    CE_(0, 13) CE_(1, 12) CE_(2, 15) CE_(3, 14) CE_(4, 8) CE_(5, 6) CE_(7, 11) CE_(9, 10)
    CE_(0, 5) CE_(1, 7) CE_(2, 9) CE_(3, 4) CE_(6, 13) CE_(8, 14) CE_(10, 15) CE_(11, 12)
    CE_(0, 1) CE_(2, 3) CE_(4, 5) CE_(6, 8) CE_(7, 9) CE_(10, 11) CE_(12, 13) CE_(14, 15)
    CE_(0, 2) CE_(1, 3) CE_(4, 10) CE_(5, 11) CE_(6, 7) CE_(8, 9) CE_(12, 14) CE_(13, 15)
    CE_(1, 2) CE_(3, 12) CE_(4, 6) CE_(5, 7) CE_(8, 10) CE_(9, 11) CE_(13, 14)
    CE_(1, 4) CE_(2, 6) CE_(5, 8) CE_(7, 10) CE_(9, 13) CE_(11, 14)
    CE_(2, 4) CE_(3, 6) CE_(9, 12) CE_(11, 13)
    CE_(3, 5) CE_(6, 8) CE_(7, 9) CE_(10, 12)
    CE_(3, 4) CE_(5, 6) CE_(7, 8) CE_(9, 10) CE_(11, 12)
    CE_(6, 7) CE_(8, 9)
#undef CE_
}
__device__ __forceinline__ void merge16(unsigned (&a)[16], const unsigned (&b)[16]) {
#pragma unroll
    for (int i = 0; i < 16; ++i) a[i] = umax_(a[i], b[15 - i]);
#pragma unroll
    for (int j = 8; j > 0; j >>= 1)
#pragma unroll
        for (int i = 0; i < 16; ++i) { const int l = i ^ j; if (l > i) { const unsigned x = a[i], y = a[l]; a[i] = umax_(x, y); a[l] = umin_(x, y); } }
}
__device__ __forceinline__ unsigned dpp_swap1(unsigned v) { return (unsigned)__builtin_amdgcn_update_dpp(0, (int)v, 0xB1, 0xF, 0xF, false); }
__device__ __forceinline__ unsigned pick_byte(const unsigned (&pk)[4], unsigned a) {
    const unsigned wsel = a >> 2; unsigned v = wsel == 0 ? pk[0] : (wsel == 1 ? pk[1] : (wsel == 2 ? pk[2] : pk[3]));
    return (v >> ((a & 3u) * 8u)) & 0xffu;
}
__device__ __forceinline__ void topk_stage2(const unsigned (&top)[16], bool tab0, size_t item, int* esel, float* wsel) {
        float vO[16], vP[16]; unsigned iOpk[4] = {0u, 0u, 0u, 0u}, iPpk[4] = {0u, 0u, 0u, 0u};
#pragma unroll
        for (int i = 0; i < 16; ++i) { const unsigned t = top[i], tp = dpp_swap1(t);
            vO[i] = key2f(t & ~0x7fu); vP[i] = key2f(tp & ~0x7fu);
            iOpk[i >> 2] |= (127u - (t & 0x7fu)) << ((i & 3) * 8); iPpk[i >> 2] |= (127u - (tp & 0x7fu)) << ((i & 3) * 8); }
        unsigned R[16], G1[16], G2[16];
#define CAND(a, b) ((f2key(vO[a] + vP[b]) & ~0xffu) | (unsigned)(((a) << 4) | (b)))
#pragma unroll
        for (int i = 0; i < 16; ++i) R[i] = CAND(0, i);
        G1[0] = CAND(1, 0); G1[1] = CAND(1, 1); G1[2] = CAND(1, 2); G1[3] = CAND(1, 3); G1[4] = CAND(1, 4); G1[5] = CAND(1, 5); G1[6] = CAND(1, 6); G1[7] = CAND(1, 7);
        G1[8] = CAND(2, 0); G1[9] = CAND(2, 1); G1[10] = CAND(2, 2); G1[11] = CAND(2, 3); G1[12] = CAND(2, 4); G1[13] = CAND(3, 0); G1[14] = CAND(3, 1); G1[15] = CAND(3, 2);
        G2[0] = CAND(3, 3); G2[1] = CAND(4, 0); G2[2] = CAND(4, 1); G2[3] = CAND(4, 2); G2[4] = CAND(5, 0); G2[5] = CAND(5, 1); G2[6] = CAND(6, 0); G2[7] = CAND(6, 1);
        G2[8] = CAND(7, 0); G2[9] = CAND(7, 1); G2[10] = CAND(8, 0); G2[11] = CAND(9, 0); G2[12] = CAND(10, 0); G2[13] = CAND(11, 0); G2[14] = CAND(12, 0); G2[15] = CAND(13, 0);
        const unsigned g30 = CAND(14, 0), g31 = CAND(15, 0);
#undef CAND
        sort16(G1); sort16(G2);
        merge16(R, G1); merge16(R, G2);
        { const unsigned hi = umax_(g30, g31), lo = umin_(g30, g31); R[15] = umax_(R[15], hi); R[14] = umax_(R[14], lo);
#pragma unroll
          for (int j = 8; j > 0; j >>= 1)
#pragma unroll
              for (int i = 0; i < 16; ++i) { const int l = i ^ j; if (l > i) { const unsigned x = R[i], y = R[l]; R[i] = umax_(x, y); R[l] = umin_(x, y); } } }
        float sc[16], ex[16]; float sum = 0.f; unsigned eid[16];
        #pragma unroll
        for (int i = 0; i < 16; ++i) { sc[i] = key2f(R[i] & ~0xffu); const unsigned a = (R[i] >> 4) & 15u, bb = R[i] & 15u;
            const unsigned io = pick_byte(iOpk, a), ip = pick_byte(iPpk, bb);
            eid[i] = tab0 ? (io * 128u + ip) : (ip * 128u + io); }
#pragma unroll
        for (int i = 0; i < 16; ++i) { ex[i] = __expf(sc[i] - sc[0]); sum += ex[i]; }
        const float inv = 1.0f / sum;
        if (tab0) { const size_t o = item * 16;
#pragma unroll
            for (int q = 0; q < 4; ++q) { v4u ev; ev.x = eid[4 * q]; ev.y = eid[4 * q + 1]; ev.z = eid[4 * q + 2]; ev.w = eid[4 * q + 3]; *(v4u*)(esel + o + 4 * q) = ev;
                f32x4 wv; wv[0] = ex[4 * q] * inv; wv[1] = ex[4 * q + 1] * inv; wv[2] = ex[4 * q + 2] * inv; wv[3] = ex[4 * q + 3] * inv; *(f32x4*)(wsel + o + 4 * q) = wv; } }
}

struct EpiScoreTopk {
    static constexpr bool PERM = false, AFTER_DRAIN = false;
    float* scr; const float* ssqp; const float* biasq; float* rstd_out; int* esel; float* wsel;
    __device__ __forceinline__ void operator()(const f32x4 (&acc)[2][2][4][2], const pg8::Unit& u, int wr, int wc, int fr, int fq) const {
        asm volatile("" : "+v"(fr), "+v"(fq));
        const int rl0 = wr * 64 + fr, col0 = wc * 32 + 4 * fq, b = (u.pm * 256) >> 13;
        f32x4 bv[2][2];
#pragma unroll
        for (int bj = 0; bj < 2; ++bj)
#pragma unroll
            for (int n = 0; n < 2; ++n) bv[bj][n] = *(const f32x4*)(biasq + b * 2048 + u.pn * 256 + col0 + bj * 128 + n * 16);
#pragma unroll
        for (int ai = 0; ai < 2; ++ai)
#pragma unroll
            for (int m = 0; m < 4; ++m) { const int rl = rl0 + ai * 128 + m * 16, row = u.pm * 256 + rl;
                const f32x4 p0 = *(const f32x4*)(ssqp + (size_t)row * 4), p1 = *(const f32x4*)(ssqp + ((size_t)32768 + row) * 4), p2 = *(const f32x4*)(ssqp + ((size_t)65536 + row) * 4), p3 = *(const f32x4*)(ssqp + ((size_t)98304 + row) * 4);
                const float tot = (p0[0] + p0[1] + p0[2] + p0[3]) + (p1[0] + p1[1] + p1[2] + p1[3]) + (p2[0] + p2[1] + p2[2] + p2[3]) + (p3[0] + p3[1] + p3[2] + p3[3]);
                const float rstd = __builtin_amdgcn_rsqf(tot * (1.0f / 1024.0f) + 1e-6f);
                if (u.pn == 0 && wc == 0 && fq == 0) rstd_out[row] = rstd;
                float* blk = scr + (2 * wr + 4 * ai + (m >> 1)) * 8192 + 8 * wc * 256 + 32 * (m & 1) * 4;
                const unsigned loff4 = (unsigned)(2 * fr + 64 * fq);
#pragma unroll
                for (int bj = 0; bj < 2; ++bj)
#pragma unroll
                    for (int n = 0; n < 2; ++n) ((f32x4*)(blk + (4 * n * 64 + bj) * 4))[loff4] = acc[ai][bj][m][n] * rstd + bv[bj][n]; }
        asm volatile("s_waitcnt vmcnt(0)" ::: "memory");
        __builtin_amdgcn_s_barrier();
        asm volatile("" ::: "memory");
        int tid = threadIdx.x; asm volatile("" : "+v"(tid));
        const int rl = tid >> 1, tab = tid & 1;
        const float* bp = scr + __builtin_amdgcn_readfirstlane(tid >> 6) * 8192;
        const unsigned lo4 = (unsigned)(tid & 63) * 4u;
        unsigned top[16];
        f32x4 cur[4], nxt[4];
#pragma unroll
        for (int q = 0; q < 4; ++q) cur[q] = *(const f32x4*)(bp + q * 256 + lo4);
#pragma unroll
        for (int grp = 0; grp < 8; ++grp) { unsigned k[16];
            if (grp < 7) {
#pragma unroll
                for (int q = 0; q < 4; ++q) nxt[q] = *(const f32x4*)(bp + ((grp + 1) * 4 + q) * 256 + lo4); }
#pragma unroll
            for (int q = 0; q < 4; ++q) { const f32x4 v = cur[q];
#pragma unroll
                for (int e = 0; e < 4; ++e) { const int j = grp * 16 + q * 4 + e; k[q * 4 + e] = (f2key(v[e]) & ~0x7fu) | (unsigned)(127 - j); } }
            sort16(k);
            if (grp == 0) {
#pragma unroll
                for (int i = 0; i < 16; ++i) top[i] = k[i];
            } else merge16(top, k);
#pragma unroll
            for (int q = 0; q < 4; ++q) cur[q] = nxt[q];
            __builtin_amdgcn_sched_barrier(0); }
        topk_stage2(top, tab == 0, (size_t)u.pn * T + (size_t)(u.pm * 256 + rl), esel, wsel);
    }
};

__device__ __forceinline__ void cvt16(const v4u& u, f32x2_ (&f)[8]) {
#pragma unroll
    for (int i = 0; i < 4; ++i) { f[2 * i] = __builtin_amdgcn_cvt_pk_f32_fp8((int)u[i], false); f[2 * i + 1] = __builtin_amdgcn_cvt_pk_f32_fp8((int)u[i], true); }
}
constexpr int PITEM = 8, NPITEM = T / PITEM;
__device__ __forceinline__ int peer_next(unsigned* q, int lane) {
    int idx = 0; if (lane == 0) idx = (int)__hip_atomic_fetch_add(q, 1u, __ATOMIC_RELAXED, __HIP_MEMORY_SCOPE_AGENT);
    return __builtin_amdgcn_readfirstlane(idx);
}
#define PEER_SB() __builtin_amdgcn_sched_barrier(0)
#define DPP_IADD(s, ctrl) ((s) + __builtin_amdgcn_update_dpp(0, (s), (ctrl), 0xF, 0xF, false))
__device__ __forceinline__ void p8_dots(const v4u (&ud)[16], const int (&hh)[4], const int (&hl)[4], int c8, int& r0, int& r1) {
#pragma unroll
    for (int i = 0; i < 16; ++i) { int sh = 0, sl = 0;
#pragma unroll
        for (int d = 0; d < 4; ++d) { sh = __builtin_amdgcn_sdot8((int)ud[i][d], hh[d], sh, false); sl = __builtin_amdgcn_sdot8((int)ud[i][d], hl[d], sl, false); }
        int sm = (sh << 4) + sl;
        sm = DPP_IADD(sm, 0xB1); sm = DPP_IADD(sm, 0x4E); sm = DPP_IADD(sm, 0x141);
        if ((i & 1) == 0) r0 = (c8 == (i >> 1)) ? sm : r0; else r1 = (c8 == (i >> 1)) ? sm : r1; }
}
constexpr int PSLAB = 12288;
__device__ __forceinline__ void p8_item(Frame& F, int sl, int item, int nitem, bool filled, LAS unsigned char* slab) {
    const int c8 = F.lane & 7, q8 = F.lane >> 3, t0 = item * PITEM;
    const unsigned char* ub = F.U8() + (size_t)sl * 16384 * 128 + 16 * c8;
    LAS int* eL = (LAS int*)slab; LAS unsigned char* hL = (LAS unsigned char*)(slab + 4096);
    LAS float* qL = (LAS float*)(slab + 6144);
    v4u t4[4], h2[4]; float rs2[4]; f32x4 sA, sB;
#define P8_BLK_LOAD(tb) do { \
        { const float* sp_ = F.mod() + ((tb) >> 13) * 6144 + 3072 + sl * CSLU + 8 * (F.lane & 31); sA = *(const f32x4*)sp_; sB = *(const f32x4*)(sp_ + 4); } \
        _Pragma("unroll") for (int i = 0; i < 4; ++i) rs2[i] = F.rstd()[(tb) + 2 * i + (F.lane >> 5)]; \
        _Pragma("unroll") for (int i = 0; i < 4; ++i) t4[i] = __builtin_nontemporal_load((const v4u*)(F.esel() + ((size_t)(2 * i + (F.lane >> 5)) * T + (tb)) * 16) + (F.lane & 31)); \
        _Pragma("unroll") for (int i = 0; i < 4; ++i) h2[i] = __builtin_nontemporal_load((const v4u*)(F.hg() + (size_t)((tb) + 2 * i + (F.lane >> 5)) * D + sl * CSLU + 8 * (F.lane & 31))); } while (0)
#define DPP_FMAX(v, ctrl) __builtin_fmaxf((v), __builtin_bit_cast(float, __builtin_amdgcn_update_dpp(0, __builtin_bit_cast(int, (v)), (ctrl), 0xF, 0xF, false)))
#define P8_QN(x, k) { const int q_ = (int)__builtin_rintf((x) * qs_), lo_ = ((q_ + 8) & 15) - 8, hi_ = (q_ - lo_) >> 4; wl_ |= (unsigned)(lo_ & 15) << (4 * (k)); wh_ |= (unsigned)(hi_ & 15) << (4 * (k)); }
#define P8_BLK_STORE() do { _Pragma("unroll") for (int i = 0; i < 4; ++i) *(LAS v4u*)(eL + ((F.lane & 31) >> 2) * NSEL + (2 * i + (F.lane >> 5)) * 16 + 4 * (F.lane & 3)) = t4[i]; \
        _Pragma("unroll") for (int i = 0; i < 4; ++i) { const float r_ = rs2[i]; const v4u h_ = h2[i]; \
            const float x0 = bflo(h_[0]) * r_ + sA[0], x1 = bfhi(h_[0]) * r_ + sA[1], x2 = bflo(h_[1]) * r_ + sA[2], x3 = bfhi(h_[1]) * r_ + sA[3]; \
            const float x4 = bflo(h_[2]) * r_ + sB[0], x5 = bfhi(h_[2]) * r_ + sB[1], x6 = bflo(h_[3]) * r_ + sB[2], x7 = bfhi(h_[3]) * r_ + sB[3]; \
            float m_ = __builtin_fmaxf(__builtin_fmaxf(__builtin_fmaxf(__builtin_fabsf(x0), __builtin_fabsf(x1)), __builtin_fmaxf(__builtin_fabsf(x2), __builtin_fabsf(x3))), \
                                       __builtin_fmaxf(__builtin_fmaxf(__builtin_fabsf(x4), __builtin_fabsf(x5)), __builtin_fmaxf(__builtin_fabsf(x6), __builtin_fabsf(x7)))); \
            m_ = DPP_FMAX(m_, 0x128); m_ = DPP_FMAX(m_, 0x124); m_ = DPP_FMAX(m_, 0x122); m_ = DPP_FMAX(m_, 0x121); m_ = __builtin_fmaxf(m_, __shfl_xor(m_, 16)); m_ = __builtin_fmaxf(m_, 1e-20f); \
            const float qs_ = 119.0f * __builtin_amdgcn_rcpf(m_); \
            const int tk_ = 2 * i + (F.lane >> 5); \
            if ((F.lane & 31) == 0) qL[tk_] = m_ * (1.0f / (119.0f * UQSCALE)); \
            unsigned wl_ = 0u, wh_ = 0u; P8_QN(x0, 0) P8_QN(x1, 1) P8_QN(x2, 2) P8_QN(x3, 3) P8_QN(x4, 4) P8_QN(x5, 5) P8_QN(x6, 6) P8_QN(x7, 7) \
            *(LAS unsigned*)(hL + tk_ * 256 + 4 * (F.lane & 31)) = wh_; *(LAS unsigned*)(hL + tk_ * 256 + 128 + 4 * (F.lane & 31)) = wl_; } \
        asm volatile("s_waitcnt lgkmcnt(0)" ::: "memory"); } while (0)
    if (!filled) { P8_BLK_LOAD(t0); P8_BLK_STORE(); }
    bf16* po = F.pact() + ((size_t)t0 * NSLU + sl) * NSEL + 16 * q8 + 2 * c8;
    v4u udA[16], udB[16];
#define P8_GATHER(dst, tt) do { v4u e_[4]; _Pragma("unroll") for (int k = 0; k < 4; ++k) e_[k] = *(LAS const v4u*)(eL + (tt) * NSEL + 16 * q8 + 4 * k); \
        _Pragma("unroll") for (int i = 0; i < 16; ++i) dst[i] = *(const v4u*)(ub + (size_t)e_[i >> 2][i & 3] * 128); } while (0)
#define P8_HN(tt) int hh[4], hl[4]; { const v4u a_ = *(LAS const v4u*)(hL + (tt) * 256 + 16 * c8), b_ = *(LAS const v4u*)(hL + (tt) * 256 + 128 + 16 * c8); \
        hh[0] = (int)a_[0]; hh[1] = (int)a_[1]; hh[2] = (int)a_[2]; hh[3] = (int)a_[3]; hl[0] = (int)b_[0]; hl[1] = (int)b_[1]; hl[2] = (int)b_[2]; hl[3] = (int)b_[3]; }
#define P8_OUT(tt, r0, r1) do { const float dq_ = qL[tt]; __builtin_nontemporal_store(cvtpk((float)(r0) * dq_, (float)(r1) * dq_), (unsigned*)(po + (size_t)(tt) * NSLU * NSEL)); } while (0)
    P8_GATHER(udA, 0);
    for (int tt = 0; tt < PITEM - 2; tt += 2) {
        P8_GATHER(udB, tt + 1);
        { P8_HN(tt); int r0 = 0, r1 = 0; p8_dots(udA, hh, hl, c8, r0, r1); P8_OUT(tt, r0, r1); }
        P8_GATHER(udA, tt + 2);
        { P8_HN(tt + 1); int r0 = 0, r1 = 0; p8_dots(udB, hh, hl, c8, r0, r1); P8_OUT(tt + 1, r0, r1); }
    }
    {
        P8_GATHER(udB, PITEM - 1);
        { P8_HN(PITEM - 2); int r0 = 0, r1 = 0; p8_dots(udA, hh, hl, c8, r0, r1); P8_OUT(PITEM - 2, r0, r1); }
        if (nitem >= 0) P8_BLK_LOAD(nitem * PITEM);
        { P8_HN(PITEM - 1); int r0 = 0, r1 = 0; p8_dots(udB, hh, hl, c8, r0, r1); P8_OUT(PITEM - 1, r0, r1); }
        if (nitem >= 0) P8_BLK_STORE();
    }
#undef P8_GATHER
#undef P8_HN
#undef P8_OUT
#undef P8_BLK_LOAD
#undef P8_BLK_STORE
#undef P8_QN
#undef DPP_FMAX
}
__device__ __forceinline__ void p8b_coef(Frame& F) {
    const size_t N = (size_t)T * NSEL;
#pragma unroll 4
    for (size_t i = (size_t)F.bid * NTHR + F.tid; i < N; i += (size_t)F.G * NTHR) { const size_t t = i >> 7; const int j = (int)(i & 127);
        const bf16* pp = F.pact() + t * NSLU * NSEL + j; float a = 0.f;
#pragma unroll
        for (int s = 0; s < NSLU; ++s) a += bf2f(__builtin_nontemporal_load(pp + s * NSEL));
        F.coef()[i] = F.wsel()[((size_t)(j >> 4) * T + t) * 16 + (j & 15)] * 0.5f * a * (1.0f + erff(a * 0.70710678f)); }
}
__device__ __forceinline__ void p9_token(const v4u (&vd)[16], LAS const float* cL, bf16* yo, LAS float* red, int lane, int c8, int q8) {
    f32x4 cc[4];
#pragma unroll
    for (int k = 0; k < 4; ++k) cc[k] = *(LAS const f32x4*)(cL + 16 * q8 + 4 * k);
    f32x2_ y[8];
#pragma unroll
    for (int k = 0; k < 8; ++k) y[k] = (f32x2_){0.f, 0.f};
#pragma unroll
    for (int i = 0; i < 16; ++i) { f32x2_ vf[8]; cvt16(vd[i], vf); const float c = cc[i >> 2][i & 3]; const f32x2_ c2 = {c, c};
#pragma unroll
        for (int k = 0; k < 8; ++k) y[k] += c2 * vf[k];
        PEER_SB(); }
#pragma unroll
    for (int k = 0; k < 4; ++k) { f32x4 o; o[0] = y[2 * k][0]; o[1] = y[2 * k][1]; o[2] = y[2 * k + 1][0]; o[3] = y[2 * k + 1][1]; *(LAS f32x4*)(red + q8 * 128 + 16 * c8 + 4 * k) = o; }
    asm volatile("s_waitcnt lgkmcnt(0)" ::: "memory");
    f32x2_ sm = {0.f, 0.f};
#pragma unroll
    for (int g = 0; g < 8; ++g) sm += *(LAS const f32x2_*)(red + g * 128 + 2 * lane);
    sm = sm * (1.0f / VSCALE);
    __builtin_nontemporal_store(cvtpk(sm[0], sm[1]), (unsigned*)(yo + 2 * lane));
    asm volatile("s_waitcnt lgkmcnt(0)" ::: "memory");
    PEER_SB();
}
__device__ __forceinline__ void p9_item(Frame& F, int sl, int item, int nitem, bool filled, LAS unsigned char* slab) {
    const int c8 = F.lane & 7, q8 = F.lane >> 3, t0 = item * PITEM;
    const unsigned char* vb = F.V8() + (size_t)sl * 16384 * CSL + 16 * c8;
    LAS int* eL = (LAS int*)slab; LAS float* cL = (LAS float*)(slab + 4096); LAS float* red = (LAS float*)(slab + 8192);
    v4u t4[4], c4[4];
#define P9_BLK_LOAD(tb) do { const v4u* cp_ = (const v4u*)(F.coef() + (size_t)(tb) * NSEL); \
        _Pragma("unroll") for (int i = 0; i < 4; ++i) { t4[i] = __builtin_nontemporal_load((const v4u*)(F.esel() + ((size_t)(2 * i + (F.lane >> 5)) * T + (tb)) * 16) + (F.lane & 31)); c4[i] = __builtin_nontemporal_load(cp_ + i * 64 + F.lane); } } while (0)
#define P9_BLK_STORE() do { _Pragma("unroll") for (int i = 0; i < 4; ++i) { *(LAS v4u*)(eL + ((F.lane & 31) >> 2) * NSEL + (2 * i + (F.lane >> 5)) * 16 + 4 * (F.lane & 3)) = t4[i]; *(LAS v4u*)(cL + (i * 64 + F.lane) * 4) = c4[i]; } \
        asm volatile("s_waitcnt lgkmcnt(0)" ::: "memory"); } while (0)
    if (!filled) { P9_BLK_LOAD(t0); P9_BLK_STORE(); }
    bf16* yo = F.ybuf() + (size_t)t0 * D + sl * CSL;
    v4u vdA[16], vdB[16];
#define P9_GATHER(dst, tt) do { v4u e_[4]; _Pragma("unroll") for (int k = 0; k < 4; ++k) e_[k] = *(LAS const v4u*)(eL + (tt) * NSEL + 16 * q8 + 4 * k); \
        _Pragma("unroll") for (int i = 0; i < 16; ++i) dst[i] = *(const v4u*)(vb + (size_t)e_[i >> 2][i & 3] * CSL); } while (0)
    P9_GATHER(vdA, 0);
    for (int tt = 0; tt < PITEM - 2; tt += 2) {
        P9_GATHER(vdB, tt + 1);
        p9_token(vdA, cL + tt * NSEL, yo + (size_t)tt * D, red, F.lane, c8, q8);
        P9_GATHER(vdA, tt + 2);
        p9_token(vdB, cL + (tt + 1) * NSEL, yo + (size_t)(tt + 1) * D, red, F.lane, c8, q8);
    }
    {
        P9_GATHER(vdB, PITEM - 1);
        p9_token(vdA, cL + (PITEM - 2) * NSEL, yo + (size_t)(PITEM - 2) * D, red, F.lane, c8, q8);
        if (nitem >= 0) P9_BLK_LOAD(nitem * PITEM);
        p9_token(vdB, cL + (PITEM - 1) * NSEL, yo + (size_t)(PITEM - 1) * D, red, F.lane, c8, q8);
        if (nitem >= 0) P9_BLK_STORE();
    }
#undef P9_GATHER
#undef P9_BLK_LOAD
#undef P9_BLK_STORE
}
template <int SIDE>
__device__ __forceinline__ void peer_phase(Frame& F0, int rep) {
    Frame F = F0; asm volatile("" : "+v"(F.lane));
    constexpr int NS = (SIDE == 0) ? NSLU : NSL;
    const int s0 = (int)(xb_xcc_id() & (unsigned)(NS - 1));
    unsigned* qbase = F.ctl() + (SIDE == 0 ? CW_QU : CW_QV) + rep * 64 * 32;
    LAS unsigned char* cf = F.lds + F.wave * PSLAB;
    for (int k = 0; k < NS; ++k) { const int sl = (s0 + k) & (NS - 1);
        int item = peer_next(qbase + 64 * sl, F.lane); bool filled = false;
        while (item < NPITEM) { int nitem = peer_next(qbase + 64 * sl, F.lane); if (nitem >= NPITEM) nitem = -1;
            if (SIDE == 0) p8_item(F, sl, item, nitem, filled, cf); else p9_item(F, sl, item, nitem, filled, cf);
            filled = nitem >= 0; item = nitem >= 0 ? nitem : NPITEM; } }
}
__device__ __forceinline__ void p10_final(Frame& F) {
    const int gwc = F.bid * NWAVES + F.wave, NGW = F.G * NWAVES;
    for (int row0 = gwc * 16; row0 < T; row0 += NGW * 16) {
        const int b = row0 >> 13; const float* mb = F.mod() + b * 6144 + 5120; const float* fm = F.fmod() + b * 2048;
        f32x4 g2[4], ca[4], cb[4];
#pragma unroll
        for (int j = 0; j < 4; ++j) { const int k = 256 * j + 4 * F.lane; g2[j] = *(const f32x4*)(mb + k); ca[j] = *(const f32x4*)(F.fnorm_g() + k) * (*(const f32x4*)(fm + 1024 + k) + 1.0f); cb[j] = *(const f32x4*)(fm + k); }
#pragma unroll 4
        for (int r = 0; r < 16; ++r) { float* hr = F.out() + (size_t)(row0 + r) * D; const bf16* yr = F.ybuf() + (size_t)(row0 + r) * D; const bf16* hb = (const bf16*)hr;
            f32x4 z[4]; float ss = 0.f;
#pragma unroll
            for (int j = 0; j < 4; ++j) { const v2u hq = *(const v2u*)(hb + 256 * j + 4 * F.lane); f32x4 hv; hv[0] = bflo(hq[0]); hv[1] = bfhi(hq[0]); hv[2] = bflo(hq[1]); hv[3] = bfhi(hq[1]);
                const v2u yq = __builtin_nontemporal_load((const v2u*)(yr + 256 * j + 4 * F.lane)); f32x4 yv; yv[0] = bflo(yq[0]); yv[1] = bfhi(yq[0]); yv[2] = bflo(yq[1]); yv[3] = bfhi(yq[1]);
                z[j] = hv + g2[j] * yv; ss += z[j][0] * z[j][0] + z[j][1] * z[j][1] + z[j][2] * z[j][2] + z[j][3] * z[j][3]; }
            const float rstd = __builtin_amdgcn_rsqf(wave_sum(ss) * (1.0f / D) + EPS);
#pragma unroll
            for (int j = 0; j < 4; ++j) *(f32x4*)(hr + 256 * j + 4 * F.lane) = z[j] * rstd * ca[j] + cb[j]; }
    }
}

constexpr int NPHASE = 12;
__global__ void __launch_bounds__(NTHR, 2) fwd_kernel(Args args) {
    extern __shared__ __attribute__((aligned(16))) unsigned char lds_raw[];
    Frame F;
    F.lds = (LAS unsigned char*)lds_raw;
    F.tid = threadIdx.x; F.lane = F.tid & 63; F.wave = __builtin_amdgcn_readfirstlane(F.tid >> 6); F.G = gridDim.x; F.bid = blockIdx.x;
    unsigned char* ws = args.ws; F.a = &args;
    volatile LAS unsigned* misc = (volatile LAS unsigned*)(F.lds + MISC_OFF);
    if (F.tid < 64) misc[F.tid] = 0u;
    __syncthreads();
    const int lo = args.ph_lo, hi = args.ph_hi;
    const bool multi = (hi - lo) > 1;
    XcdBarrier bar; bar.bar = (unsigned*)(ws + WS_CTL) + CW_BAR; bar.x = 0; bar.st = nullptr;
    if (multi) bar = xcd_barrier_post((unsigned*)(ws + WS_CTL) + CW_BAR, misc + 8);
#ifndef PHMASK
#define PHMASK 0xfff
#endif
#define IN(k) (((PHMASK >> (k)) & 1) && lo <= (k) && (k) < hi)
#define SEAM(k) do { if (IN(k) && IN((k) + 1)) xcd_barrier(bar); } while (0)

#ifndef REPMASK
#define REPMASK 0
#endif
#define REP(k) (((REPMASK) >> (k)) & 1)
#define REPBAR(k) if (REP(k) && rep == 0) xcd_barrier(bar)
    if (IN(0)) { for (int rep = 0; rep <= REP(0); ++rep) { p0_prologue(F); REPBAR(0); } } SEAM(0);
    if (IN(1)) { for (int rep = 0; rep <= REP(1); ++rep) { p1_norm(F); REPBAR(1); } } SEAM(1);
    if (IN(2)) { { pg8::Gemm g{F.bufA(), F.Win_t(), T, NIN, D}; pg8::StaticOrder S; S.init(T, NIN, F.G, F.bid);
        pg8::EpiProj E{F.proj(), NIN};
        pg8::gemm_phase<pg8::EpiProj, pg8::StaticOrder, true, true>(F.lds, g, S, E); }
#if ((REPMASK) >> 2) & 1
        xcd_barrier(bar); { pg8::Gemm g{F.bufA(), F.Win_t(), T, NIN, D}; pg8::StaticOrder S; S.init(T, NIN, F.G, F.bid);
        pg8::EpiProj E{F.proj(), NIN};
        pg8::gemm_phase<pg8::EpiProj, pg8::StaticOrder, true, true>(F.lds, g, S, E); }
#endif
    } SEAM(2);
    if (IN(3)) { for (int rep = 0; rep <= REP(3); ++rep) {
        for (int it = F.bid; it < NB * NHH * 2 * NSEG; it += F.G) h1_item(F, it);
        asm volatile("s_waitcnt vmcnt(0)" ::: "memory");
        __syncthreads();
        if (F.tid == 0) { __builtin_amdgcn_fence(__ATOMIC_RELEASE, "agent"); asm volatile("s_waitcnt vmcnt(0)" ::: "memory"); (void)xb_add(F.ctl() + CW_H1, 1u); }
        float cw[CW];
#pragma unroll
        for (int j = 0; j < CW; ++j) cw[j] = F.conv_w()[j * DC + F.tid];
        const float cbias = F.conv_b()[F.tid];
        for (int it = F.bid; it < T / 32; it += F.G) conv_item(F, it, cw, cbias);
        if (F.tid == 0) { const unsigned tgt = (unsigned)F.G * (unsigned)(rep + 1); XB_SPIN(xb_ld(F.ctl() + CW_H1) < tgt, bar.bar); __builtin_amdgcn_fence(__ATOMIC_ACQUIRE, "agent"); asm volatile("s_waitcnt vmcnt(0)" ::: "memory"); }
        __syncthreads();
        h_scan(F);
        REPBAR(3); }
    } SEAM(3);
    if (IN(4)) { for (int rep = 0; rep <= REP(4); ++rep) { for (int it = F.bid; it < NB * NHH * NSEG; it += F.G) h2_item(F, it); REPBAR(4); } } SEAM(4);
    if (IN(5)) { { pg8::Gemm g{F.bufA(), F.Wout_t(), T, D, D}; pg8::StaticOrder S; S.init(T, D, F.G, F.bid);
        pg8::EpiOut E{F.x(), F.out(), F.hg(), F.mod(), F.g_ffn(), F.ssqp()};
        pg8::gemm_phase<pg8::EpiOut, pg8::StaticOrder, true, true>(F.lds, g, S, E); }
#if ((REPMASK) >> 5) & 1
        xcd_barrier(bar); { pg8::Gemm g{F.bufA(), F.Wout_t(), T, D, D}; pg8::StaticOrder S; S.init(T, D, F.G, F.bid);
        pg8::EpiOut E{F.x(), F.out(), F.hg(), F.mod(), F.g_ffn(), F.ssqp()};
        pg8::gemm_phase<pg8::EpiOut, pg8::StaticOrder, true, true>(F.lds, g, S, E); }
#endif
    } SEAM(5);
    if (IN(6)) { { pg8::Gemm g{F.hg(), F.Wqk_t(), T, NQK, D}; pg8::StaticOrder S; S.init(T, NQK, F.G, F.bid);
        EpiScoreTopk E{F.scores() + (size_t)F.bid * 65536, F.ssqp(), F.biasq(), F.rstd(), F.esel(), F.wsel()};
        pg8::gemm_phase<EpiScoreTopk, pg8::StaticOrder, true, true>(F.lds, g, S, E); }
    } SEAM(6);
    if (IN(8)) { for (int rep = 0; rep <= REP(8); ++rep) { peer_phase<0>(F, rep); REPBAR(8); } } SEAM(8);
    if (IN(9)) { for (int rep = 0; rep <= REP(9); ++rep) { p8b_coef(F); REPBAR(9); } } SEAM(9);
    if (IN(10)) { for (int rep = 0; rep <= REP(10); ++rep) { peer_phase<1>(F, rep); REPBAR(10); } } SEAM(10);
    if (IN(11)) { p10_final(F); }
#undef IN
#undef SEAM
}

#ifndef MK_ONE_LAUNCH
#define MK_ONE_LAUNCH 0
#endif
extern "C" void kernel_launch(void* const* d_in, const int* in_sizes, int n_in, void* d_out, int out_size, void* d_ws, size_t ws_size, hipStream_t stream) {
    static int grid = 0;
    if (grid == 0) {
        if (n_in != 23 || out_size != T * D || ws_size < WS_END) { fprintf(stderr, "kernel_launch: unexpected shapes (n_in %d, out %d, ws %zu)\n", n_in, out_size, ws_size); grid = -1; return; }
        int dev = 0, cus = 0, per_cu = 0;
        if (hipGetDevice(&dev) != hipSuccess || hipDeviceGetAttribute(&cus, hipDeviceAttributeMultiprocessorCount, dev) != hipSuccess) { grid = -1; return; }
        if (hipFuncSetAttribute((const void*)fwd_kernel, hipFuncAttributeMaxDynamicSharedMemorySize, LDS_BYTES) != hipSuccess) { fprintf(stderr, "kernel_launch: hipFuncSetAttribute failed\n"); grid = -1; return; }
        if (hipOccupancyMaxActiveBlocksPerMultiprocessor(&per_cu, (const void*)fwd_kernel, NTHR, LDS_BYTES) != hipSuccess || per_cu < 1) { fprintf(stderr, "kernel_launch: occupancy query reports %d\n", per_cu); }
        (void)hipGetLastError();
        grid = cus;
    }
    if (grid < 0) return;
    (void)hipMemsetAsync((char*)d_ws + WS_CTL, 0, CTL_ZERO_BYTES, stream);
    Args a{};
    for (int i = 0; i < 23; ++i) a.in[i] = (const float*)d_in[i];
    a.out = (float*)d_out; a.ws = (unsigned char*)d_ws;
#if MK_ONE_LAUNCH
    a.ph_lo = 0; a.ph_hi = NPHASE;
    hipLaunchKernelGGL(fwd_kernel, dim3(grid), dim3(NTHR), LDS_BYTES, stream, a);
#else
    for (int p = 0; p < NPHASE; ++p) { a.ph_lo = p; a.ph_hi = p + 1; hipLaunchKernelGGL(fwd_kernel, dim3(grid), dim3(NTHR), LDS_BYTES, stream, a); }
#endif
}
```

```cpp
#include <hip/hip_runtime.h>
#include <cstdio>
#include <cstdint>
namespace pg8 {
#define PG8_LAS __attribute__((address_space(3)))
typedef unsigned short bf16_t;
typedef short bf16x8 __attribute__((ext_vector_type(8)));
typedef float f32x4 __attribute__((ext_vector_type(4)));
typedef unsigned u32x4 __attribute__((ext_vector_type(4)));
constexpr int BM = 256, BK = 64, HALF = 128, HTB = HALF * BK * 2  , STAGE_BYTES = 8 * HTB, NXCD = 8, WGM = 8;

__host__ __device__ __forceinline__ int lds_byte(int r, int c) { const int st = (r >> 4) * 2 + (c >> 5), rr = r & 15, cc = c & 31, ob = rr * 64 + cc * 2; return st * 1024 + (ob ^ (((ob >> 9) & 1) << 5)); }
__host__ __device__ __forceinline__ void stage_rc(int b, int& R, int& C) { const int st = b / 1024, sb = b % 1024, swz = sb ^ (((sb >> 9) & 1) << 5); R = (st >> 1) * 16 + swz / 64; C = (st & 1) * 32 + (swz % 64) / 2; }
__host__ __device__ __forceinline__ int perm32(int rho) { const int n = rho >> 4, i = rho & 15; return 8 * (i >> 2) + 4 * n + (i & 3); }

struct Unit { int pm, pn; };
struct Gemm { const bf16_t* A; const bf16_t* Bt; int M, N, K; };

struct StaticOrder {
    int nM, nN, nwg, G, c;
    __host__ __device__ void init(int M, int N, int G_, int c_) { nM = M / BM; nN = N / BM; nwg = nM * nN; G = G_; c = c_; }
    __host__ __device__ bool next(int i, Unit& u) const {
        const long L = (long)i * G + c; if (L >= nwg) return false;
        int wgid = (int)L; { const int q = nwg / NXCD, r = nwg % NXCD, xcd = wgid % NXCD, off = wgid / NXCD; wgid = (xcd < r ? xcd * (q + 1) : r * (q + 1) + (xcd - r) * q) + off; }
        const int nig = WGM * nN, gid = wgid / nig, fm = gid * WGM, gsz = (nM - fm) < WGM ? (nM - fm) : WGM;
        u.pm = fm + ((wgid % nig) % gsz); u.pn = (wgid % nig) / gsz; return true;
    }
    __device__ __forceinline__ void a_ready(const Unit&) const {}
    __device__ __forceinline__ void done(const Unit&) const {}
};
__device__ __forceinline__ unsigned cvt_pk_bf16(float lo, float hi) { unsigned r; asm volatile("v_cvt_pk_bf16_f32 %0, %1, %2" : "=v"(r) : "v"(lo), "v"(hi)); return r; }
typedef float f32x2 __attribute__((ext_vector_type(2)));
__device__ __forceinline__ f32x2 gelu_pk(f32x2 v) {
    const f32x2 av = __builtin_elementwise_abs(v), d = av * 0.2316418882f + 1.0f;
    f32x2 t; t.x = __builtin_amdgcn_rcpf(d.x); t.y = __builtin_amdgcn_rcpf(d.y);
    f32x2 q = t * 0.5307027145f + (-0.7265760135f); q = q * t + 0.7107068705f; q = q * t + (-0.142248368f); q = q * t + 0.127414796f; q = q * t;
    const f32x2 s = (v * v) * (-0.72134752044f);
    f32x2 e; e.x = __builtin_amdgcn_exp2f(s.x); e.y = __builtin_amdgcn_exp2f(s.y);
    const f32x2 m = v * (q * e), r = v - m;
    f32x2 o; o.x = v.x < 0.f ? m.x : r.x; o.y = v.y < 0.f ? m.y : r.y; return o;
}

template <int ACT  > struct EpiBf16 {
    static constexpr bool PERM = true, AFTER_DRAIN = false; static_assert(ACT == 0 || ACT == 1, "EpiBf16: ACT is 0 (none) or 1 (gelu_pk)");
    bf16_t* O; int ldc; const float* bias; int split_cols; size_t split_stride; float scale0;
    __device__ __forceinline__ void operator()(const f32x4 (&acc)[2][2][4][2], const Unit& u, int wr, int wc, int fr, int fq) const {
        const int row0 = u.pm * BM + wr * 64 + fr; int colt = u.pn * BM; bf16_t* base = O;
        float sc = 1.f; if (split_cols) { const int t = colt / split_cols; base += (size_t)t * split_stride; colt -= t * split_cols; if (t == 0) sc = scale0; }
        const int col0 = colt + wc * 32 + 8 * fq, bcol0 = u.pn * BM + wc * 32 + 8 * fq;
        f32x4 bv[2][2];
#pragma unroll
        for (int bj = 0; bj < 2; ++bj)
#pragma unroll
            for (int n = 0; n < 2; ++n) bv[bj][n] = bias ? *(const f32x4*)(bias + bcol0 + bj * HALF + 4 * n) : (f32x4){0.f, 0.f, 0.f, 0.f};
#pragma unroll
        for (int ai = 0; ai < 2; ++ai)
#pragma unroll
            for (int m = 0; m < 4; ++m) { bf16_t* rowp = base + (size_t)(row0 + ai * HALF + m * 16) * ldc + col0;
#pragma unroll
                for (int bj = 0; bj < 2; ++bj) { f32x4 v0 = acc[ai][bj][m][0] + bv[bj][0], v1 = acc[ai][bj][m][1] + bv[bj][1];
                    if (ACT == 1) { f32x2 a = gelu_pk((f32x2){v0[0], v0[1]}), b = gelu_pk((f32x2){v0[2], v0[3]}), c = gelu_pk((f32x2){v1[0], v1[1]}), d = gelu_pk((f32x2){v1[2], v1[3]});
                        v0 = (f32x4){a.x, a.y, b.x, b.y}; v1 = (f32x4){c.x, c.y, d.x, d.y}; }
                    v0 = v0 * sc; v1 = v1 * sc; u32x4 w; w.x = cvt_pk_bf16(v0[0], v0[1]); w.y = cvt_pk_bf16(v0[2], v0[3]); w.z = cvt_pk_bf16(v1[0], v1[1]); w.w = cvt_pk_bf16(v1[2], v1[3]);
                    *(u32x4*)(rowp + bj * HALF) = w; } }
    }
};

struct EpiOut {
    static constexpr bool PERM = true, AFTER_DRAIN = false;
    const float* X; float* Hout; bf16_t* HG; const float* mod; const float* gffn; float* ssqp;
    __device__ __forceinline__ void operator()(const f32x4 (&acc)[2][2][4][2], const Unit& u, int wr, int wc, int fr, int fq) const {
        const int row0 = u.pm * BM + wr * 64 + fr, col0 = u.pn * BM + wc * 32 + 8 * fq;
        const int b = (u.pm * BM) >> 13;
        const float* mb = mod + b * 6144;
        f32x4 g1v[2][2], gv2[2][2];
#pragma unroll
        for (int bj = 0; bj < 2; ++bj)
#pragma unroll
            for (int n = 0; n < 2; ++n) { const int c = col0 + bj * HALF + 4 * n;
                g1v[bj][n] = *(const f32x4*)(mb + 2048 + c);
                const f32x4 s2 = *(const f32x4*)(mb + 4096 + c), gf = *(const f32x4*)(gffn + c);
                gv2[bj][n] = gf * (s2 + 1.0f); }
#pragma unroll
        for (int ai = 0; ai < 2; ++ai)
#pragma unroll
            for (int m = 0; m < 4; ++m) { const int row = row0 + ai * HALF + m * 16; const size_t ro = (size_t)row * 1024 + col0; float ss = 0.f;
#pragma unroll
                for (int bj = 0; bj < 2; ++bj) {
                    const f32x4 x0 = *(const f32x4*)(X + ro + bj * HALF), x1 = *(const f32x4*)(X + ro + bj * HALF + 4);
                    const f32x4 h0 = x0 + g1v[bj][0] * acc[ai][bj][m][0], h1 = x1 + g1v[bj][1] * acc[ai][bj][m][1];
                    { u32x4 hw; hw.x = cvt_pk_bf16(h0[0], h0[1]); hw.y = cvt_pk_bf16(h0[2], h0[3]); hw.z = cvt_pk_bf16(h1[0], h1[1]); hw.w = cvt_pk_bf16(h1[2], h1[3]);
                      *(u32x4*)((bf16_t*)Hout + (size_t)row * 2048 + col0 + bj * HALF) = hw; }
                    ss += h0[0] * h0[0] + h0[1] * h0[1] + h0[2] * h0[2] + h0[3] * h0[3] + h1[0] * h1[0] + h1[1] * h1[1] + h1[2] * h1[2] + h1[3] * h1[3];
                    const f32x4 q0 = h0 * gv2[bj][0], q1 = h1 * gv2[bj][1];
                    u32x4 w; w.x = cvt_pk_bf16(q0[0], q0[1]); w.y = cvt_pk_bf16(q0[2], q0[3]); w.z = cvt_pk_bf16(q1[0], q1[1]); w.w = cvt_pk_bf16(q1[2], q1[3]);
                    *(u32x4*)(HG + ro + bj * HALF) = w; }
                ss += __shfl_xor(ss, 16); ss += __shfl_xor(ss, 32);
                if (fq == 0) ssqp[((size_t)u.pn * 32768 + row) * 4 + wc] = ss; }
    }
};
struct EpiScore {
    static constexpr bool PERM = false, AFTER_DRAIN = false;
    float* S; const float* ssqp; const float* biasq; float* rstd_out;
    __device__ __forceinline__ void operator()(const f32x4 (&acc)[2][2][4][2], const Unit& u, int wr, int wc, int fr, int fq) const {
        const int row0 = u.pm * BM + wr * 64 + fr, col0 = u.pn * BM + wc * 32 + 4 * fq;
        const int b = (u.pm * BM) >> 13;
        f32x4 bv[2][2];
#pragma unroll
        for (int bj = 0; bj < 2; ++bj)
#pragma unroll
            for (int n = 0; n < 2; ++n) bv[bj][n] = *(const f32x4*)(biasq + b * 2048 + col0 + bj * HALF + n * 16);
#pragma unroll
        for (int ai = 0; ai < 2; ++ai)
#pragma unroll
            for (int m = 0; m < 4; ++m) { const int row = row0 + ai * HALF + m * 16;
                const f32x4 p0 = *(const f32x4*)(ssqp + (size_t)row * 4), p1 = *(const f32x4*)(ssqp + ((size_t)32768 + row) * 4), p2 = *(const f32x4*)(ssqp + ((size_t)65536 + row) * 4), p3 = *(const f32x4*)(ssqp + ((size_t)98304 + row) * 4);
                const float tot = (p0[0] + p0[1] + p0[2] + p0[3]) + (p1[0] + p1[1] + p1[2] + p1[3]) + (p2[0] + p2[1] + p2[2] + p2[3]) + (p3[0] + p3[1] + p3[2] + p3[3]);
                const float rstd = __builtin_amdgcn_rsqf(tot * (1.0f / 1024.0f) + 1e-6f);
                if (u.pn == 0 && wc == 0 && fq == 0) rstd_out[row] = rstd;
                float* rowp = S + (size_t)row * 2048 + col0;
#pragma unroll
                for (int bj = 0; bj < 2; ++bj)
#pragma unroll
                    for (int n = 0; n < 2; ++n) *(f32x4*)(rowp + bj * HALF + n * 16) = acc[ai][bj][m][n] * rstd + bv[bj][n]; }
    }
};

struct EpiProj {
    static constexpr bool PERM = true, AFTER_DRAIN = false;
    bf16_t* O; int ldc;
    __device__ __forceinline__ void operator()(const f32x4 (&acc)[2][2][4][2], const Unit& u, int wr, int wc, int fr, int fq) const {
        asm volatile("" : "+v"(fr), "+v"(fq));
        const int row0 = u.pm * BM + wr * 64 + fr, col0 = u.pn * BM + wc * 32 + 8 * fq;
        const int cls = u.pn >> 1;
        const bool ident = (cls == 3) || (cls == 5), mulx = (cls == 0) || (cls == 4);
        const float sgn = (cls == 1 || cls == 2) ? 1.4426950408889634f : -1.4426950408889634f;
#pragma unroll
        for (int ai = 0; ai < 2; ++ai)
#pragma unroll
            for (int m = 0; m < 4; ++m) { bf16_t* rowp = O + (size_t)(row0 + ai * HALF + m * 16) * ldc + col0;
#pragma unroll
                for (int bj = 0; bj < 2; ++bj) { f32x4 v0 = acc[ai][bj][m][0], v1 = acc[ai][bj][m][1];
                    if (!ident) {
#pragma unroll
                        for (int j = 0; j < 4; ++j) { const float r0 = __builtin_amdgcn_rcpf(1.0f + __builtin_amdgcn_exp2f(sgn * v0[j])), r1 = __builtin_amdgcn_rcpf(1.0f + __builtin_amdgcn_exp2f(sgn * v1[j]));
                            v0[j] = mulx ? v0[j] * r0 : r0; v1[j] = mulx ? v1[j] * r1 : r1; } }
                    u32x4 w; w.x = cvt_pk_bf16(v0[0], v0[1]); w.y = cvt_pk_bf16(v0[2], v0[3]); w.z = cvt_pk_bf16(v1[0], v1[1]); w.w = cvt_pk_bf16(v1[2], v1[3]);
                    *(u32x4*)(rowp + bj * HALF) = w; } }
    }
};
template <class Epi, class Sched, bool ALIGN_EPI = false, bool SP2 = false>
__device__ __forceinline__ void gemm_phase(PG8_LAS unsigned char* lds, const Gemm g, const Sched& S, const Epi& E) {
    const int tid = threadIdx.x, wid = __builtin_amdgcn_readfirstlane(tid >> 6), lane = tid & 63, wr = wid >> 2, wc = wid & 3, fr = lane & 15, fq = lane >> 4;
    const int K = g.K, nt = K / BK;
    unsigned voffA[2], voffB[2];
#pragma unroll
    for (int i = 0; i < 2; ++i) { int R, C; stage_rc(tid * 16 + i * 8192, R, C); const int Rb = Epi::PERM ? ((R & ~31) + perm32(R & 31)) : R;
        voffA[i] = (unsigned)(R * K + C) * 2u; voffB[i] = (unsigned)(Rb * K + C) * 2u; }
    const size_t kstep = (size_t)(BK * 2);
    const size_t hstep = (size_t)HALF * K * 2;
    const size_t tstep = 2 * hstep;
    const unsigned ldsw = (unsigned)wid * 1024u;
    const int aoff = lds_byte(wr * 64 + fr, fq * 8), boff = lds_byte(wc * 32 + fr, fq * 8);
#define PG8_SA(b, h) (((b) * 2 + (h)) * HTB)
#define PG8_SB(b, h) ((4 + (b) * 2 + (h)) * HTB)
#define PG8_STAGE(bufoff, gbase, voff) do { _Pragma("unroll") for (int _i = 0; _i < 2; ++_i) \
        __builtin_amdgcn_global_load_lds((const unsigned*)((const char*)(gbase) + (voff)[_i]), (PG8_LAS unsigned*)(lds + (bufoff) + ldsw + _i * 8192), 16, 0, 0); } while (0)
#define PG8_LDA(dst, b, h) do { _Pragma("unroll") for (int m = 0; m < 4; ++m) _Pragma("unroll") for (int k = 0; k < 2; ++k) dst[m][k] = *(const PG8_LAS bf16x8*)(lds + PG8_SA(b, h) + aoff + m * 2048 + k * 1024); } while (0)
#define PG8_LDB(dst, b, h) do { _Pragma("unroll") for (int n = 0; n < 2; ++n) _Pragma("unroll") for (int k = 0; k < 2; ++k) dst[n][k] = *(const PG8_LAS bf16x8*)(lds + PG8_SB(b, h) + boff + n * 2048 + k * 1024); } while (0)
#define PG8_MMA(ai, bj, At, Bt) do { __builtin_amdgcn_s_setprio(1); _Pragma("unroll") for (int m = 0; m < 4; ++m) _Pragma("unroll") for (int n = 0; n < 2; ++n) _Pragma("unroll") for (int k = 0; k < 2; ++k) \
        acc[ai][bj][m][n] = __builtin_amdgcn_mfma_f32_16x16x32_bf16(Bt[n][k], At[m][k], acc[ai][bj][m][n], 0, 0, 0); __builtin_amdgcn_s_setprio(0); } while (0)
#define PG8_WAIT_V(n) asm volatile("s_waitcnt vmcnt(" #n ")" ::: "memory")
#define PG8_WAIT_L(n) asm volatile("s_waitcnt lgkmcnt(" #n ")" ::: "memory")
#define PG8_BAR __builtin_amdgcn_s_barrier()
#define PG8_SCHED __builtin_amdgcn_sched_barrier(0)
    Unit cur, nxt; int ui = 0;
    if (!S.next(0, cur)) return;
    f32x4 acc[2][2][4][2];
#pragma unroll
    for (int a = 0; a < 2; ++a)
#pragma unroll
        for (int b = 0; b < 2; ++b)
#pragma unroll
            for (int m = 0; m < 4; ++m)
#pragma unroll
                for (int n = 0; n < 2; ++n) acc[a][b][m][n] = (f32x4){0.f, 0.f, 0.f, 0.f};
    bf16x8 At[4][2], B0[2][2], B1[2][2];
    const char* cA = (const char*)g.A + (size_t)cur.pm * tstep; const char* cB = (const char*)g.Bt + (size_t)cur.pn * tstep;
    S.a_ready(cur);
    if constexpr (SP2) {
        PG8_STAGE(PG8_SB(0, 0), cB, voffB); PG8_STAGE(PG8_SB(0, 1), cB + hstep, voffB); PG8_STAGE(PG8_SA(0, 0), cA, voffA); PG8_STAGE(PG8_SA(0, 1), cA + hstep, voffA);
        if (wr == 1) PG8_BAR;
        PG8_WAIT_V(2); PG8_BAR;
        PG8_STAGE(PG8_SB(1, 0), cB + kstep, voffB); PG8_STAGE(PG8_SA(1, 0), cA + kstep, voffA); PG8_STAGE(PG8_SB(1, 1), cB + hstep + kstep, voffB);
        PG8_WAIT_V(6); PG8_BAR;
    } else {
        PG8_STAGE(PG8_SB(0, 0), cB, voffB); PG8_STAGE(PG8_SA(0, 0), cA, voffA); PG8_STAGE(PG8_SB(0, 1), cB + hstep, voffB); PG8_STAGE(PG8_SA(0, 1), cA + hstep, voffA);
        if (wr == 1) PG8_BAR;
        PG8_WAIT_V(4); PG8_BAR;
        PG8_STAGE(PG8_SB(1, 0), cB + kstep, voffB); PG8_STAGE(PG8_SA(1, 0), cA + kstep, voffA); PG8_STAGE(PG8_SB(1, 1), cB + hstep + kstep, voffB);
        PG8_WAIT_V(6); PG8_BAR;
    }
    for (;;) {
        const bool has_next = S.next(ui + 1, nxt);
        const char* nA = has_next ? (const char*)g.A + (size_t)nxt.pm * tstep : cA; const char* nB = has_next ? (const char*)g.Bt + (size_t)nxt.pn * tstep : cB;
        for (int t = 0; t < nt; t += 2) {
            const bool last = (t == nt - 2);
            const char* a1 = cA + (size_t)(t + 1) * kstep;
            const char* a2 = last ? nA : cA + (size_t)(t + 2) * kstep; const char* b2 = last ? nB : cB + (size_t)(t + 2) * kstep;
            const char* a3 = a2 + kstep; const char* b3 = b2 + kstep;
            if (last && has_next) S.a_ready(nxt);
            if constexpr (SP2) {
            PG8_LDB(B0, 0, 0); PG8_LDB(B1, 0, 1); PG8_SCHED; PG8_LDA(At, 0, 0); PG8_STAGE(PG8_SA(1, 1), a1 + hstep, voffA);
            PG8_WAIT_V(8); PG8_WAIT_L(0); PG8_BAR; PG8_MMA(0, 0, At, B0); PG8_MMA(0, 1, At, B1); PG8_BAR; PG8_SCHED;
            PG8_LDA(At, 0, 1); PG8_STAGE(PG8_SB(0, 0), b2, voffB); PG8_STAGE(PG8_SB(0, 1), b2 + hstep, voffB); PG8_STAGE(PG8_SA(0, 0), a2, voffA);
            PG8_WAIT_V(8); PG8_WAIT_L(0); PG8_BAR; PG8_MMA(1, 0, At, B0); PG8_MMA(1, 1, At, B1); PG8_BAR; PG8_SCHED;
            PG8_LDB(B0, 1, 0); PG8_LDB(B1, 1, 1); PG8_SCHED; PG8_LDA(At, 1, 0); PG8_STAGE(PG8_SA(0, 1), a2 + hstep, voffA);
            PG8_WAIT_V(8); PG8_WAIT_L(0); PG8_BAR; PG8_MMA(0, 0, At, B0); PG8_MMA(0, 1, At, B1); PG8_BAR; PG8_SCHED;
            PG8_LDA(At, 1, 1); PG8_STAGE(PG8_SB(1, 0), b3, voffB); PG8_STAGE(PG8_SB(1, 1), b3 + hstep, voffB); PG8_STAGE(PG8_SA(1, 0), a3, voffA);
            PG8_WAIT_V(8); PG8_WAIT_L(0); PG8_BAR; PG8_MMA(1, 0, At, B0); PG8_MMA(1, 1, At, B1); PG8_BAR; PG8_SCHED;
            } else {
            PG8_LDB(B0, 0, 0); PG8_SCHED; PG8_LDA(At, 0, 0); PG8_STAGE(PG8_SA(1, 1), a1 + hstep, voffA);
            PG8_WAIT_L(8); PG8_BAR; PG8_WAIT_L(0); PG8_MMA(0, 0, At, B0); PG8_BAR; PG8_SCHED;
            PG8_LDB(B1, 0, 1); PG8_STAGE(PG8_SB(0, 0), b2, voffB);
            PG8_BAR; PG8_WAIT_L(0); PG8_MMA(0, 1, At, B1); PG8_BAR;
            PG8_LDA(At, 0, 1); PG8_STAGE(PG8_SA(0, 0), a2, voffA);
            PG8_BAR; PG8_WAIT_L(0); PG8_MMA(1, 0, At, B0); PG8_BAR; PG8_SCHED;
            PG8_STAGE(PG8_SB(0, 1), b2 + hstep, voffB);
            PG8_WAIT_V(6); PG8_BAR; PG8_MMA(1, 1, At, B1); PG8_BAR;
            PG8_LDB(B0, 1, 0); PG8_SCHED; PG8_LDA(At, 1, 0); PG8_STAGE(PG8_SA(0, 1), a2 + hstep, voffA);
            PG8_WAIT_L(8); PG8_BAR; PG8_WAIT_L(0); PG8_MMA(0, 0, At, B0); PG8_BAR; PG8_SCHED;
            PG8_LDB(B1, 1, 1); PG8_STAGE(PG8_SB(1, 0), b3, voffB);
            PG8_BAR; PG8_WAIT_L(0); PG8_MMA(0, 1, At, B1); PG8_BAR;
            PG8_LDA(At, 1, 1); PG8_STAGE(PG8_SA(1, 0), a3, voffA);
            PG8_BAR; PG8_WAIT_L(0); PG8_MMA(1, 0, At, B0); PG8_BAR; PG8_SCHED;
            PG8_STAGE(PG8_SB(1, 1), b3 + hstep, voffB);
            PG8_WAIT_V(6); PG8_BAR; PG8_MMA(1, 1, At, B1); PG8_BAR;
            }
        }
        if constexpr (ALIGN_EPI) { if (wr == 0) PG8_BAR; }
        if constexpr (!Epi::AFTER_DRAIN) { E(acc, cur, wr, wc, fr, fq); S.done(cur); }
        if (!has_next) break;
#pragma unroll
        for (int a = 0; a < 2; ++a)
#pragma unroll
            for (int b = 0; b < 2; ++b)
#pragma unroll
                for (int m = 0; m < 4; ++m)
#pragma unroll
                    for (int n = 0; n < 2; ++n) acc[a][b][m][n] = (f32x4){0.f, 0.f, 0.f, 0.f};
        cur = nxt; cA = nA; cB = nB; ++ui;
        if constexpr (ALIGN_EPI) { if (wr == 1) PG8_BAR; }
    }
    PG8_WAIT_V(0);
    if constexpr (!ALIGN_EPI) { if (wr == 0) PG8_BAR; }
    PG8_BAR;
    if constexpr (Epi::AFTER_DRAIN) { E.fused(acc, cur, wr, wc, fr, fq, lds, wid, lane); S.done(cur); }
#undef PG8_SA
#undef PG8_SB
#undef PG8_STAGE
#undef PG8_LDA
#undef PG8_LDB
#undef PG8_MMA
#undef PG8_WAIT_V
#undef PG8_WAIT_L
#undef PG8_BAR
#undef PG8_SCHED
}
}
#define MK_ONE_LAUNCH 1

constexpr int NB = 4, SEQ = 8192, T = NB * SEQ, D = 1024;
constexpr int NIN = 3584, DH = 512, HD = 128, NHH = 4, CHK = 64;
constexpr int NSEG = 16, SEGC = 8;
constexpr int CW = 31, CPAD = 15, DC = 512;
constexpr int PHEADS = 8, NQK = 2048, NSEL = 128;
constexpr float EPS = 1e-6f;
constexpr int NWAVES = 8, NTHR = 512;

constexpr size_t MiB = 1u << 20;
constexpr size_t WS_CTL = 0, CTL_ZERO_BYTES = 65536;
constexpr size_t WS_MOD = 1 * MiB, WS_FMOD = WS_MOD + 131072, WS_LB = WS_MOD + 196608, WS_BIASQ = WS_MOD + 262144;
constexpr size_t WS_WIN = 2 * MiB, WS_WOUT = 10 * MiB, WS_WQK = 12 * MiB;
constexpr size_t WS_UT = 16 * MiB, WS_VT = 48 * MiB;
constexpr size_t WS_BUFA = 80 * MiB;
constexpr size_t WS_BUFB = 144 * MiB;
constexpr size_t WS_SEG = 208 * MiB;
constexpr size_t WS_E = 208 * MiB, WS_W = 224 * MiB;
constexpr size_t WS_BIG = 240 * MiB;
constexpr size_t WS_SSQ = 496 * MiB;
constexpr size_t WS_SEGA = 498 * MiB;
constexpr size_t WS_RSTD = 499 * MiB;
constexpr size_t WS_END = 500 * MiB;
constexpr size_t WS_PACT = 240 * MiB;
constexpr size_t WS_Y = 368 * MiB;
constexpr int NSL = 8, CSL = 128;
constexpr float VSCALE = 16.0f;
constexpr float UQSCALE = 95.5f;
constexpr int NSLU = 4, CSLU = 256;
constexpr int CW_QU = 8192, CW_QV = 8192 + 64 * 16;
constexpr int CW_H1 = 6144;
constexpr int CW_BAR = 1024;

#ifndef LDSFILL
#define LDSFILL 0u
#endif
constexpr int LDS_BYTES = 155648;
constexpr int MISC_OFF = LDS_BYTES - 256;

#define GAS __attribute__((address_space(1)))
#define LAS __attribute__((address_space(3)))
typedef unsigned short bf16;
typedef unsigned v4u __attribute__((ext_vector_type(4)));
typedef unsigned v2u __attribute__((ext_vector_type(2)));
typedef float f32x4 __attribute__((ext_vector_type(4)));
typedef float f32x16 __attribute__((ext_vector_type(16)));
typedef short bf16x8 __attribute__((ext_vector_type(8)));
typedef float f32x2_ __attribute__((ext_vector_type(2)));

__device__ __forceinline__ float bf2f(unsigned h) { return __builtin_bit_cast(float, h << 16); }
__device__ __forceinline__ float bflo(unsigned u) { return __builtin_bit_cast(float, u << 16); }
__device__ __forceinline__ float bfhi(unsigned u) { return __builtin_bit_cast(float, u & 0xffff0000u); }
__device__ __forceinline__ unsigned f2bf(float f) { unsigned u = __builtin_bit_cast(unsigned, f); return (u + 0x7fffu + ((u >> 16) & 1u)) >> 16; }
__device__ __forceinline__ unsigned pk2(float lo, float hi) { return f2bf(lo) | (f2bf(hi) << 16); }
__device__ __forceinline__ unsigned cvtpk(float lo, float hi) { unsigned r; asm("v_cvt_pk_bf16_f32 %0, %1, %2" : "=v"(r) : "v"(lo), "v"(hi)); return r; }
__device__ __forceinline__ float sigmoidf_(float x) { return __builtin_amdgcn_rcpf(1.0f + __expf(-x)); }
#define DPP_ADD(s, ctrl) ((s) + __builtin_bit_cast(float, __builtin_amdgcn_update_dpp(0, __builtin_bit_cast(int, (s)), (ctrl), 0xF, 0xF, false)))
__device__ __forceinline__ float wave_sum(float v) {
#pragma unroll
    for (int o = 1; o < 64; o <<= 1) v += __shfl_xor(v, o);
    return v;
}

#define XB_TMO      128
#define XB_XCNT(j)  (256  + 64 * (j))
#define XB_XSUB(j)  (1280 + 64 * (j))
#define XB_XGEN(j)  (2304 + 64 * (j))
#define XB_TOP      3328
#define XB_TOPGEN   3392
#define XCD_BAR_WORDS 3456
#define XB_SPIN_CAP (1u << 18)
__device__ __forceinline__ unsigned xb_ld(unsigned* p)              { return __hip_atomic_load(p, __ATOMIC_RELAXED, __HIP_MEMORY_SCOPE_AGENT); }
__device__ __forceinline__ unsigned xb_add(unsigned* p, unsigned v) { return __hip_atomic_fetch_add(p, v, __ATOMIC_RELAXED, __HIP_MEMORY_SCOPE_AGENT); }
__device__ __forceinline__ unsigned xb_xcc_id() { return (unsigned)__builtin_amdgcn_s_getreg((3 << 11) | 20) & 0xFu; }
#define XB_SPIN(cond, bar) do { unsigned _sp = 0; while (cond) { __builtin_amdgcn_s_sleep(1); \
    if ((++_sp & 255u) == 0u) { if (xb_ld(&(bar)[XB_TMO])) break; if (_sp > XB_SPIN_CAP) { atomicAdd(&(bar)[XB_TMO], 1u); break; } } } } while (0)
struct XcdBarrier { unsigned* bar; unsigned x; volatile LAS unsigned* st; };
__device__ __forceinline__ XcdBarrier xcd_barrier_post(unsigned* bar, volatile LAS unsigned* st) {
    XcdBarrier b; b.bar = bar; b.x = xb_xcc_id(); b.st = st;
    if (threadIdx.x == 0) (void)xb_add(&bar[XB_XCNT(b.x)], 1u);
    return b;
}
__device__ __forceinline__ void xcd_barrier_complete(unsigned* bar, unsigned x, unsigned& nloc, unsigned& nx) {
    const unsigned G = gridDim.x * gridDim.y * gridDim.z;
    unsigned sum, cnt, mine, sp = 0u;
    for (;;) {
        sum = 0u; cnt = 0u; mine = 0u;
#pragma unroll
        for (unsigned j = 0; j < 16; ++j) { const unsigned c = xb_ld(&bar[XB_XCNT(j)]); sum += c; cnt += (c > 0u) ? 1u : 0u; mine = (j == x) ? c : mine; }
        if (sum == G) break;
        __builtin_amdgcn_s_sleep(1);
        if ((++sp & 255u) == 0u) { if (xb_ld(&bar[XB_TMO])) break; if (sp > XB_SPIN_CAP) { atomicAdd(&bar[XB_TMO], 1u); break; } }
    }
    nloc = mine > 0u ? mine : 1u; nx = cnt > 0u ? cnt : 1u;
}
__device__ __forceinline__ void xcd_barrier(const XcdBarrier& b) {
    asm volatile("s_waitcnt vmcnt(0)" ::: "memory");
    __syncthreads();
    if (threadIdx.x == 0) {
        unsigned* bar = b.bar;
        __builtin_amdgcn_s_waitcnt(0);
        unsigned nloc = b.st[0], nx = b.st[1];
        if (nloc == 0u) { xcd_barrier_complete(bar, b.x, nloc, nx); b.st[0] = nloc; b.st[1] = nx; }
        const unsigned old = xb_add(&bar[XB_XSUB(b.x)], 1u);
        const unsigned gen = old / nloc;
        if (old + 1u == (gen + 1u) * nloc) {
            __builtin_amdgcn_fence(__ATOMIC_RELEASE, "agent");
            asm volatile("s_waitcnt vmcnt(0)" ::: "memory");
            const unsigned og = xb_add(&bar[XB_TOP], 1u);
            const unsigned tg = og / nx;
            if (og + 1u == (tg + 1u) * nx) xb_add(&bar[XB_TOPGEN], 1u);
            else XB_SPIN(xb_ld(&bar[XB_TOPGEN]) == tg, bar);
            __builtin_amdgcn_fence(__ATOMIC_ACQUIRE, "agent");
            xb_add(&bar[XB_XGEN(b.x)], 1u);
            asm volatile("s_waitcnt vmcnt(0)" ::: "memory");
        } else {
            XB_SPIN(xb_ld(&bar[XB_XGEN(b.x)]) == gen, bar);
            __builtin_amdgcn_fence(__ATOMIC_ACQUIRE, "agent");
            asm volatile("s_waitcnt vmcnt(0)" ::: "memory");
        }
    }
    __syncthreads();
}

struct Args { const float* in[23]; float* out; unsigned char* ws; int ph_lo, ph_hi; };
struct Frame {
    LAS unsigned char* lds;
    int tid, lane, wave, G, bid;
    const Args* a;
    __device__ __forceinline__ const float* x() const { return a->in[0]; }
    __device__ __forceinline__ const float* c() const { return a->in[1]; }
    __device__ __forceinline__ const float* ada_w() const { return a->in[2]; }
    __device__ __forceinline__ const float* ada_b() const { return a->in[3]; }
    __device__ __forceinline__ const float* g_mix() const { return a->in[4]; }
    __device__ __forceinline__ const float* w_in() const { return a->in[5]; }
    __device__ __forceinline__ const float* lbg_f() const { return a->in[6]; }
    __device__ __forceinline__ const float* lbg_b() const { return a->in[7]; }
    __device__ __forceinline__ const float* hnorm_g() const { return a->in[8]; }
    __device__ __forceinline__ const float* conv_w() const { return a->in[9]; }
    __device__ __forceinline__ const float* conv_b() const { return a->in[10]; }
    __device__ __forceinline__ const float* cln_g() const { return a->in[11]; }
    __device__ __forceinline__ const float* cln_b() const { return a->in[12]; }
    __device__ __forceinline__ const float* w_out() const { return a->in[13]; }
    __device__ __forceinline__ const float* g_ffn() const { return a->in[14]; }
    __device__ __forceinline__ const float* wq() const { return a->in[15]; }
    __device__ __forceinline__ const float* keys1() const { return a->in[16]; }
    __device__ __forceinline__ const float* keys2() const { return a->in[17]; }
    __device__ __forceinline__ const float* utab() const { return a->in[18]; }
    __device__ __forceinline__ const float* vtab() const { return a->in[19]; }
    __device__ __forceinline__ const float* fada_w() const { return a->in[20]; }
    __device__ __forceinline__ const float* fada_b() const { return a->in[21]; }
    __device__ __forceinline__ const float* fnorm_g() const { return a->in[22]; }
    __device__ __forceinline__ float* out() const { return a->out; }
    __device__ __forceinline__ float* mod() const { return (float*)(a->ws + WS_MOD); }
    __device__ __forceinline__ float* fmod() const { return (float*)(a->ws + WS_FMOD); }
    __device__ __forceinline__ float* lb() const { return (float*)(a->ws + WS_LB); }
    __device__ __forceinline__ float* biasq() const { return (float*)(a->ws + WS_BIASQ); }
    __device__ __forceinline__ float* ssqp() const { return (float*)(a->ws + WS_SSQ); }
    __device__ __forceinline__ float* sega() const { return (float*)(a->ws + WS_SEGA); }
    __device__ __forceinline__ float* segu() const { return (float*)(a->ws + WS_SEG); }
    __device__ __forceinline__ float* of() const { return (float*)(a->ws + WS_BUFB); }
    __device__ __forceinline__ float* scores() const { return (float*)(a->ws + WS_BIG); }
    __device__ __forceinline__ float* wsel() const { return (float*)(a->ws + WS_W); }
    __device__ __forceinline__ int* esel() const { return (int*)(a->ws + WS_E); }
    __device__ __forceinline__ bf16* Win_t() const { return (bf16*)(a->ws + WS_WIN); }
    __device__ __forceinline__ bf16* Wout_t() const { return (bf16*)(a->ws + WS_WOUT); }
    __device__ __forceinline__ bf16* Wqk_t() const { return (bf16*)(a->ws + WS_WQK); }
    __device__ __forceinline__ bf16* Ub() const { return (bf16*)(a->ws + WS_UT); }
    __device__ __forceinline__ bf16* Vb() const { return (bf16*)(a->ws + WS_VT); }
    __device__ __forceinline__ bf16* bufA() const { return (bf16*)(a->ws + WS_BUFA); }
    __device__ __forceinline__ bf16* hg() const { return (bf16*)(a->ws + WS_BUFB); }
    __device__ __forceinline__ bf16* proj() const { return (bf16*)(a->ws + WS_BIG); }
    __device__ __forceinline__ float* coef() const { return (float*)(a->ws + WS_BUFA); }
    __device__ __forceinline__ float* rstd() const { return (float*)(a->ws + WS_RSTD); }
    __device__ __forceinline__ bf16* pact() const { return (bf16*)(a->ws + WS_PACT); }
    __device__ __forceinline__ bf16* ybuf() const { return (bf16*)(a->ws + WS_Y); }
    __device__ __forceinline__ unsigned char* U8() const { return (unsigned char*)(a->ws + WS_UT); }
    __device__ __forceinline__ unsigned char* V8() const { return (unsigned char*)(a->ws + WS_VT); }
    __device__ __forceinline__ unsigned* ctl() const { return (unsigned*)(a->ws + WS_CTL); }
};

__device__ __forceinline__ void p0_gemv(Frame& F) {
    LAS float* cact = (LAS float*)(F.lds);
    LAS float* red = (LAS float*)(F.lds + 16384);
    for (int i = F.tid; i < 4096; i += NTHR) { const float c = F.c()[i]; cact[i] = c * sigmoidf_(c); }
    __syncthreads();
    for (int item = F.bid; item < 128; item += F.G) {
        const int col0 = item * 64; const float* W; int N, cc;
        if (col0 < 6144) { W = F.ada_w(); N = 6144; cc = col0; } else { W = F.fada_w(); N = 2048; cc = col0 - 6144; }
        const float* wp = W + (size_t)(F.wave * 128) * N + cc + F.lane;
        float a0 = 0.f, a1 = 0.f, a2 = 0.f, a3 = 0.f;
#pragma unroll 32
        for (int k = 0; k < 128; ++k) { const float w = wp[(size_t)k * N]; const int kk = F.wave * 128 + k;
            a0 += cact[kk] * w; a1 += cact[1024 + kk] * w; a2 += cact[2048 + kk] * w; a3 += cact[3072 + kk] * w; }
        red[(F.wave * 4 + 0) * 64 + F.lane] = a0; red[(F.wave * 4 + 1) * 64 + F.lane] = a1; red[(F.wave * 4 + 2) * 64 + F.lane] = a2; red[(F.wave * 4 + 3) * 64 + F.lane] = a3;
        __syncthreads();
        if (F.tid < 256) { const int b = F.tid >> 6, l = F.tid & 63; float s = 0.f;
#pragma unroll
            for (int w = 0; w < 8; ++w) s += red[(w * 4 + b) * 64 + l];
            if (col0 < 6144) F.mod()[b * 6144 + cc + l] = s + F.ada_b()[cc + l]; else F.fmod()[b * 2048 + cc + l] = s + F.fada_b()[cc + l]; }
        __syncthreads();
    }
}
__device__ __forceinline__ void p0_transpose_item(const float* W, int K, int N, bf16* WT, LAS float* scr, int item, int lane) {
    const int nblk = N / 32, kb = item / nblk, nb = item % nblk, k0 = 64 * kb, n0 = 32 * nb;
#pragma unroll
    for (int i = 0; i < 32; ++i) { const int kk = 2 * i + (lane >> 5); scr[kk * 33 + (lane & 31)] = W[(size_t)(k0 + kk) * N + n0 + (lane & 31)]; }
    asm volatile("s_waitcnt lgkmcnt(0)" ::: "memory");
    const int c = lane & 7;
#pragma unroll
    for (int j = 0; j < 4; ++j) { const int n = (lane >> 3) + 8 * j; const LAS float* s = scr + (8 * c) * 33 + n;
        v4u o; o.x = pk2(s[0 * 33], s[1 * 33]); o.y = pk2(s[2 * 33], s[3 * 33]); o.z = pk2(s[4 * 33], s[5 * 33]); o.w = pk2(s[6 * 33], s[7 * 33]);
        *(v4u*)(WT + (size_t)(n0 + n) * K + k0 + 8 * c) = o; }
    asm volatile("s_waitcnt lgkmcnt(0)" ::: "memory");
}
__device__ __forceinline__ void p0_wqk_item(Frame& F, int item, LAS float* scr) {
    const int jq = item & 7, kb = (item >> 3) & 15, hh = item >> 7, h = hh >> 1, half = hh & 1;
    const float* keys = (half ? F.keys2() : F.keys1()) + (size_t)(jq * 16) * 128;
    const float* wtile = F.wq() + (size_t)(kb * 64) * 2048 + h * 256 + half * 128;
    LAS float* kL = scr + 1280;
    { f32x4 k4[8];
#pragma unroll
      for (int i = 0; i < 8; ++i) k4[i] = *(const f32x4*)(keys + (i * 64 + F.lane) * 4);
#pragma unroll
      for (int i = 0; i < 8; ++i) *(LAS f32x4*)(kL + (i * 64 + F.lane) * 4) = k4[i]; }
    float acc[16];
#pragma unroll
    for (int j = 0; j < 16; ++j) acc[j] = 0.f;
    f32x4 t4[4], n4[4];
#pragma unroll
    for (int i = 0; i < 4; ++i) t4[i] = *(const f32x4*)(wtile + (size_t)(16 * i + (F.lane >> 2)) * 2048 + 4 * (F.lane & 3));
    for (int d0 = 0; d0 < 128; d0 += 16) {
        if (d0 + 16 < 128) {
#pragma unroll
            for (int i = 0; i < 4; ++i) n4[i] = *(const f32x4*)(wtile + (size_t)(16 * i + (F.lane >> 2)) * 2048 + d0 + 16 + 4 * (F.lane & 3)); }
#pragma unroll
        for (int i = 0; i < 4; ++i) *(LAS f32x4*)(scr + (16 * i + (F.lane >> 2)) * 20 + 4 * (F.lane & 3)) = t4[i];
        asm volatile("s_waitcnt lgkmcnt(0)" ::: "memory");
#pragma unroll
        for (int dd = 0; dd < 16; dd += 4) { const f32x4 a = *(LAS const f32x4*)(scr + F.lane * 20 + dd);
#pragma unroll
            for (int j = 0; j < 16; ++j) { const f32x4 kp = *(LAS const f32x4*)(kL + j * 128 + d0 + dd); acc[j] += a[0] * kp[0] + a[1] * kp[1] + a[2] * kp[2] + a[3] * kp[3]; } }
        asm volatile("s_waitcnt lgkmcnt(0)" ::: "memory");
#pragma unroll
        for (int i = 0; i < 4; ++i) t4[i] = n4[i];
    }
    bf16* o = F.Wqk_t() + (size_t)(h * 256 + half * 128 + jq * 16) * 1024 + kb * 64 + F.lane;
#pragma unroll
    for (int j = 0; j < 16; ++j) o[(size_t)j * 1024] = (bf16)f2bf(acc[j]);
}
__device__ __forceinline__ void p0_prologue(Frame& F) {
    if (F.bid < 128) p0_gemv(F);
    if (F.bid == 128 % F.G) { const int i = F.tid;
        F.lb()[i] = __builtin_amdgcn_rcpf(1.0f + __expf(F.lbg_f()[512 + i] - F.lbg_f()[i]));
        F.lb()[512 + i] = __builtin_amdgcn_rcpf(1.0f + __expf(F.lbg_b()[512 + i] - F.lbg_b()[i])); }
    LAS float* scr = (LAS float*)(F.lds + 32768 + F.wave * 14336);
    const int gw = F.wave * F.G + F.bid, NGW = F.G * NWAVES;
    constexpr int I_QK = 2048, I_IN = (D / 64) * (NIN / 32), I_OUT = (D / 64) * (D / 32), I_TAB = 2 * 16384 / 4;
    constexpr int NITEMS = I_QK + I_IN + I_OUT + I_TAB;
    for (int it = gw; it < NITEMS; it += NGW) {
        int r = it;
        if (r < I_QK) { p0_wqk_item(F, r, scr); continue; } r -= I_QK;
        if (r < I_IN) { p0_transpose_item(F.w_in(), D, NIN, F.Win_t(), scr, r, F.lane); continue; } r -= I_IN;
        if (r < I_OUT) { p0_transpose_item(F.w_out(), D, D, F.Wout_t(), scr, r, F.lane); continue; } r -= I_OUT;
        { const int tab = r >= 4096, rr = (tab ? r - 4096 : r) * 4; const float* src = (tab ? F.vtab() : F.utab()) + (size_t)rr * 1024; unsigned char* dst = tab ? F.V8() : F.U8();
          const float sc = tab ? VSCALE : UQSCALE;
#pragma unroll
          for (int q = 0; q < 16; ++q) { const int row = rr + (q >> 2), qq = q & 3; const f32x4 v = *(const f32x4*)(src + (q >> 2) * 1024 + qq * 256 + 4 * F.lane) * sc;
              int pk;
              if (tab) { pk = __builtin_amdgcn_cvt_pk_fp8_f32(v[0], v[1], 0, false); pk = __builtin_amdgcn_cvt_pk_fp8_f32(v[2], v[3], pk, true); }
              else { int q0 = (int)__builtin_rintf(v[0]), q1 = (int)__builtin_rintf(v[1]), q2 = (int)__builtin_rintf(v[2]), q3 = (int)__builtin_rintf(v[3]);
                  q0 = q0 < -7 ? -7 : (q0 > 7 ? 7 : q0); q1 = q1 < -7 ? -7 : (q1 > 7 ? 7 : q1); q2 = q2 < -7 ? -7 : (q2 > 7 ? 7 : q2); q3 = q3 < -7 ? -7 : (q3 > 7 ? 7 : q3);
                  *(unsigned short*)(dst + ((size_t)qq * 16384 + row) * 128 + 2 * F.lane) = (unsigned short)((q0 & 0xf) | ((q1 & 0xf) << 4) | ((q2 & 0xf) << 8) | ((q3 & 0xf) << 12)); continue; }
              const int sl = 2 * qq + (F.lane >> 5);
              *(int*)(dst + ((size_t)sl * 16384 + row) * CSL + 4 * (F.lane & 31)) = pk; } }
    }
}

__device__ __forceinline__ void p1_norm(Frame& F) {
    const int gwc = F.bid * NWAVES + F.wave, NGW = F.G * NWAVES;
    for (int row0 = gwc * 16; row0 < T; row0 += NGW * 16) {
        const int b = row0 >> 13; const float* mb = F.mod() + b * 6144;
        f32x4 ca[4], cb[4];
#pragma unroll
        for (int j = 0; j < 4; ++j) { const int k = 256 * j + 4 * F.lane; const f32x4 g = *(const f32x4*)(F.g_mix() + k), s = *(const f32x4*)(mb + 1024 + k); ca[j] = g * (s + 1.0f); cb[j] = *(const f32x4*)(mb + k); }
#pragma unroll 4
        for (int r = 0; r < 16; ++r) { const float* xr = F.x() + (size_t)(row0 + r) * D;
            f32x4 v[4]; float ss = 0.f;
#pragma unroll
            for (int j = 0; j < 4; ++j) { v[j] = *(const f32x4*)(xr + 256 * j + 4 * F.lane); ss += v[j][0] * v[j][0] + v[j][1] * v[j][1] + v[j][2] * v[j][2] + v[j][3] * v[j][3]; }
            const float rstd = __builtin_amdgcn_rsqf(wave_sum(ss) * (1.0f / D) + EPS);
            bf16* o = F.bufA() + (size_t)(row0 + r) * D;
#pragma unroll
            for (int j = 0; j < 4; ++j) { const f32x4 y = v[j] * rstd * ca[j] + cb[j]; v2u w; w.x = pk2(y[0], y[1]); w.y = pk2(y[2], y[3]); *(v2u*)(o + 256 * j + 4 * F.lane) = w; } }
    }
    const int gw = F.wave * F.G + F.bid;
    for (int n0 = gw * 32; n0 < NQK; n0 += NGW * 32) {
        float sv[4][16];
#pragma unroll
        for (int b = 0; b < 4; ++b) { const float* sh2 = F.mod() + b * 6144 + 3072;
#pragma unroll
            for (int i = 0; i < 8; ++i) { sv[b][i] = sh2[8 * F.lane + i]; sv[b][8 + i] = sh2[512 + 8 * F.lane + i]; } }
        float res[4] = {0.f, 0.f, 0.f, 0.f};
        for (int q = 0; q < 32; ++q) { const int n = n0 + q;
            const v4u w0 = *(const v4u*)(F.Wqk_t() + (size_t)n * 1024 + 8 * F.lane), w1 = *(const v4u*)(F.Wqk_t() + (size_t)n * 1024 + 512 + 8 * F.lane);
            float wv[16];
#pragma unroll
            for (int i = 0; i < 4; ++i) { wv[2 * i] = bflo(w0[i]); wv[2 * i + 1] = bfhi(w0[i]); wv[8 + 2 * i] = bflo(w1[i]); wv[8 + 2 * i + 1] = bfhi(w1[i]); }
#pragma unroll
            for (int b = 0; b < 4; ++b) { float sm = 0.f;
#pragma unroll
                for (int i = 0; i < 16; ++i) sm += wv[i] * sv[b][i];
                sm = wave_sum(sm); if (F.lane == q) res[b] = sm; } }
        if (F.lane < 32) {
#pragma unroll
            for (int b = 0; b < 4; ++b) F.biasq()[b * 2048 + n0 + F.lane] = res[b]; }
    }
}

__device__ __forceinline__ void conv_item(Frame& F, int item, const float (&cw)[CW], float cbias) {
    LAS bf16* hbuf = (LAS bf16*)(F.lds);
    LAS float* ybuf = (LAS float*)(F.lds + 65536);
    const int tok0 = item * 32, b = tok0 >> 13, t0 = tok0 & (SEQ - 1), c = F.tid;
#pragma unroll
    for (int k = 0; k < 8; ++k) { const int pi = F.tid + NTHR * k; if (pi < 62 * 64) { const int r = pi >> 6, ch = pi & 63, t = t0 - CPAD + r; v4u o = {0u, 0u, 0u, 0u};
            if (t >= 0 && t < SEQ) { const bf16* pr = F.proj() + (size_t)(b * SEQ + t) * NIN + 8 * ch; const v4u a = *(const v4u*)(pr + 2560), g = *(const v4u*)(pr + 3072);
#pragma unroll
                for (int i = 0; i < 4; ++i) o[i] = cvtpk(bflo(a[i]) * bflo(g[i]), bfhi(a[i]) * bfhi(g[i])); }
            *(LAS v4u*)(hbuf + r * 512 + 8 * ch) = o; } }
    __syncthreads();
    f32x2_ hp[31];
#pragma unroll
    for (int m = 0; m < 31; ++m) hp[m] = (f32x2_){bf2f(hbuf[(2 * m) * 512 + c]), bf2f(hbuf[(2 * m + 1) * 512 + c])};
    f32x2_ ce[15], co[15];
#pragma unroll
    for (int m = 0; m < 15; ++m) { ce[m] = (f32x2_){cw[2 * m], cw[2 * m + 1]}; co[m] = (f32x2_){cw[2 * m + 1], cw[2 * m + 2]}; }
#pragma unroll
    for (int e = 0; e < 16; ++e) {
        { f32x2_ a = {cbias, 0.f};
#pragma unroll
          for (int m = 0; m < 15; ++m) a += ce[m] * hp[e + m];
          ybuf[(2 * e) * 512 + c] = (a[0] + a[1]) + cw[30] * hp[e + 15][0]; }
        { f32x2_ a = {cbias, 0.f};
#pragma unroll
          for (int m = 0; m < 15; ++m) a += co[m] * hp[e + m + 1];
          ybuf[(2 * e + 1) * 512 + c] = (a[0] + a[1]) + cw[0] * hp[e][1]; } }
    __syncthreads();
#pragma unroll
    for (int q = 0; q < 4; ++q) { const int tt = F.wave * 4 + q;
        const f32x4 y0 = *(LAS const f32x4*)(ybuf + tt * 512 + 8 * F.lane), y1 = *(LAS const f32x4*)(ybuf + tt * 512 + 8 * F.lane + 4);
        const float mean = wave_sum((y0[0] + y0[1] + y0[2] + y0[3]) + (y1[0] + y1[1] + y1[2] + y1[3])) * (1.0f / DC);
        const f32x4 d0 = y0 - mean, d1 = y1 - mean;
        const float var = wave_sum((d0[0] * d0[0] + d0[1] * d0[1] + d0[2] * d0[2] + d0[3] * d0[3]) + (d1[0] * d1[0] + d1[1] * d1[1] + d1[2] * d1[2] + d1[3] * d1[3])) * (1.0f / DC);
        const float rstd = __builtin_amdgcn_rsqf(var + EPS);
        const f32x4 g0 = *(const f32x4*)(F.cln_g() + 8 * F.lane), g1 = *(const f32x4*)(F.cln_g() + 8 * F.lane + 4), b0 = *(const f32x4*)(F.cln_b() + 8 * F.lane), b1 = *(const f32x4*)(F.cln_b() + 8 * F.lane + 4);
        f32x4 z0 = d0 * rstd * g0 + b0, z1 = d1 * rstd * g1 + b1;
#pragma unroll
        for (int i = 0; i < 4; ++i) { z0[i] = z0[i] * sigmoidf_(z0[i]); z1[i] = z1[i] * sigmoidf_(z1[i]); }
        v4u w; w.x = cvtpk(z0[0], z0[1]); w.y = cvtpk(z0[2], z0[3]); w.z = cvtpk(z1[0], z1[1]); w.w = cvtpk(z1[2], z1[3]);
        *(v4u*)(F.bufA() + (size_t)(tok0 + tt) * D + 512 + 8 * F.lane) = w; }
    __syncthreads();
}

constexpr int PQ = 272, PT = 144;
constexpr int HL_QR = 0, HL_KR = 17408, HL_QE = 34816, HL_KET = 52224, HL_VT = 70656, HL_SCM = 89088, HL_ST = 98304, HL_PBLK = 133120  , HL_AV = 137216, HL_RS = 137728;
static_assert(HL_PBLK + 8 * 128 * 4 <= HL_AV && HL_AV + 512 <= HL_RS && HL_RS + 1024 <= 155648 - 256, "HGRN LDS map");
__device__ __forceinline__ bf16x8 ldf(LAS const unsigned char* base, int row, int pitch, int kbyte) { return *(LAS const bf16x8*)(base + row * pitch + kbyte); }
#define MFMA32(a, b, c) __builtin_amdgcn_mfma_f32_32x32x16_bf16((a), (b), (c), 0, 0, 0)

template <bool FULL>
__device__ __forceinline__ void hgrn_load(Frame& F, int b, int h, int dir, int chunk, unsigned (&rz)[8], unsigned (&rv)[8], unsigned (&rq)[8]) {
    const size_t tokbase = (size_t)b * SEQ + (size_t)chunk * CHK; const int zoff = dir ? 1024 : 512, c0 = 2 * F.lane;
#pragma unroll
    for (int i = 0; i < 8; ++i) { const int p = 8 * F.wave + i, tr = dir ? (63 - p) : p; const bf16* q = F.proj() + (tokbase + tr) * NIN + h * HD;
        rz[i] = *(const unsigned*)(q + zoff + c0); rv[i] = *(const unsigned*)(q + 1536 + c0); if (FULL) rq[i] = *(const unsigned*)(q + c0); }
}
template <bool FULL, int MODE>
__device__ __forceinline__ void hgrn_chunk(Frame& F, int b, int h, int dir, int chunk, int nchunk, f32x16 (&accS)[2], float lb0, float lb1, unsigned (&rz)[8], unsigned (&rv)[8], unsigned (&rq)[8]) {
    LAS unsigned char* lds = F.lds;
    int r = F.lane & 31, hh = F.lane >> 5, c0 = 2 * F.lane;
    asm volatile("" : "+v"(r), "+v"(hh), "+v"(c0));
    const int w = F.wave, rb = w;
    const size_t tokbase = (size_t)b * SEQ + (size_t)chunk * CHK;
    {
        const f32x2_ oml = {1.0f - lb0, 1.0f - lb1};
        f32x2_ f2[8], cf2[8], cr2[8];
        f32x2_ run = {1.f, 1.f};
#pragma unroll
        for (int i = 0; i < 8; ++i) { const f32x2_ kk = {bflo(rz[i]), bfhi(rz[i])}; f2[i] = 1.0f - oml * kk; run *= f2[i]; cf2[i] = run; }
        { f32x2_ q = {1.f, 1.f};
#pragma unroll
          for (int i = 7; i >= 0; --i) { cr2[i] = q; q *= f2[i]; } }
        LAS float* pblk = (LAS float*)(lds + HL_PBLK);
        *(LAS f32x2_*)(pblk + rb * 128 + c0) = run;
        __syncthreads();
        f32x2_ pre = {1.f, 1.f}, post = {1.f, 1.f}, mid = {1.f, 1.f};
        for (int q = 0; q < rb; ++q) pre *= *(LAS const f32x2_*)(pblk + q * 128 + c0);
        for (int q = rb + 1; q < 8; ++q) post *= *(LAS const f32x2_*)(pblk + q * 128 + c0);
        if (rb < 4) { for (int q = rb + 1; q < 4; ++q) mid *= *(LAS const f32x2_*)(pblk + q * 128 + c0); }
        else { for (int q = 4; q < rb; ++q) mid *= *(LAS const f32x2_*)(pblk + q * 128 + c0); }
        if (rb == 0) *(LAS f32x2_*)((LAS float*)(lds + HL_AV) + c0) = run * post;
        f32x2_ ke2[8];
#pragma unroll
        for (int i = 0; i < 8; ++i) ke2[i] = (1.0f - f2[i]) * cr2[i] * post;
        if (FULL) {
            if (rb < 4) {
#pragma unroll
                for (int i = 0; i < 8; ++i) { const int p = 8 * rb + i; const f32x2_ qs = {bflo(rq[i]), bfhi(rq[i])}, k2 = 1.0f - f2[i], G = cr2[i] * mid;
                    f32x2_ iG; iG[0] = __builtin_amdgcn_rcpf(G[0]); iG[1] = __builtin_amdgcn_rcpf(G[1]);
                    const f32x2_ qe = qs * pre * cf2[i], qr = qs * iG, kr = k2 * G;
                    *(LAS unsigned*)(lds + HL_QE + p * PQ + c0 * 2) = cvtpk(qe[0], qe[1]);
                    *(LAS unsigned*)(lds + HL_QR + p * PQ + c0 * 2) = cvtpk(qr[0], qr[1]);
                    *(LAS unsigned*)(lds + HL_KR + p * PQ + c0 * 2) = cvtpk(kr[0], kr[1]); }
            } else {
#pragma unroll
                for (int i = 0; i < 8; ++i) { const int p = 8 * rb + i; const f32x2_ qs = {bflo(rq[i]), bfhi(rq[i])}, k2 = 1.0f - f2[i], G = cf2[i] * mid;
                    f32x2_ iG; iG[0] = __builtin_amdgcn_rcpf(G[0]); iG[1] = __builtin_amdgcn_rcpf(G[1]);
                    const f32x2_ qe = qs * pre * cf2[i], qr = qs * G, kr = k2 * iG;
                    *(LAS unsigned*)(lds + HL_QE + p * PQ + c0 * 2) = cvtpk(qe[0], qe[1]);
                    *(LAS unsigned*)(lds + HL_QR + p * PQ + c0 * 2) = cvtpk(qr[0], qr[1]);
                    *(LAS unsigned*)(lds + HL_KR + p * PQ + c0 * 2) = cvtpk(kr[0], kr[1]); }
            }
        }
        v4u ka, kb, va, vb2;
        ka.x = cvtpk(ke2[0][0], ke2[1][0]); ka.y = cvtpk(ke2[2][0], ke2[3][0]); ka.z = cvtpk(ke2[4][0], ke2[5][0]); ka.w = cvtpk(ke2[6][0], ke2[7][0]);
        kb.x = cvtpk(ke2[0][1], ke2[1][1]); kb.y = cvtpk(ke2[2][1], ke2[3][1]); kb.z = cvtpk(ke2[4][1], ke2[5][1]); kb.w = cvtpk(ke2[6][1], ke2[7][1]);
        va.x = (rv[0] & 0xffffu) | (rv[1] << 16); va.y = (rv[2] & 0xffffu) | (rv[3] << 16); va.z = (rv[4] & 0xffffu) | (rv[5] << 16); va.w = (rv[6] & 0xffffu) | (rv[7] << 16);
        vb2.x = (rv[0] >> 16) | (rv[1] & 0xffff0000u); vb2.y = (rv[2] >> 16) | (rv[3] & 0xffff0000u); vb2.z = (rv[4] >> 16) | (rv[5] & 0xffff0000u); vb2.w = (rv[6] >> 16) | (rv[7] & 0xffff0000u);
        *(LAS v4u*)(lds + HL_KET + c0 * PT + 16 * rb) = ka; *(LAS v4u*)(lds + HL_KET + (c0 + 1) * PT + 16 * rb) = kb;
        *(LAS v4u*)(lds + HL_VT + c0 * PT + 16 * rb) = va; *(LAS v4u*)(lds + HL_VT + (c0 + 1) * PT + 16 * rb) = vb2;
    }
    if (nchunk >= 0) hgrn_load<FULL>(F, b, h, dir, nchunk, rz, rv, rq);
    __syncthreads();
    const int pbO = w & 1, vb = w >> 1;
    f32x16 accO, accU[2];
#pragma unroll
    for (int i = 0; i < 16; ++i) { accO[i] = 0.f; accU[0][i] = 0.f; accU[1][i] = 0.f; }
    if (FULL) {
        if (w < 3) { const int pbS = (w + 1) >> 1, sbS = (w == 2) ? 1 : 0; f32x16 sc;
#pragma unroll
            for (int i = 0; i < 16; ++i) sc[i] = 0.f;
#pragma unroll
            for (int s = 0; s < 8; ++s) sc = MFMA32(ldf(lds + HL_QR, pbS * 32 + r, PQ, 32 * s + 16 * hh), ldf(lds + HL_KR, sbS * 32 + r, PQ, 32 * s + 16 * hh), sc);
#pragma unroll
            for (int i = 0; i < 16; i += 2) { const int p = pbS * 32 + (i & 3) + 8 * (i >> 2) + 4 * hh, s = sbS * 32 + r;
                const unsigned pkd = cvtpk(s <= p ? sc[i] : 0.f, s <= p + 1 ? sc[i + 1] : 0.f);
                *(LAS bf16*)(lds + HL_SCM + p * PT + s * 2) = (bf16)pkd; *(LAS bf16*)(lds + HL_SCM + (p + 1) * PT + s * 2) = (bf16)(pkd >> 16); } }
        __builtin_amdgcn_sched_barrier(0);
#pragma unroll
        for (int s = 0; s < 8; ++s) accO = MFMA32(ldf(lds + HL_QE, pbO * 32 + r, PQ, 32 * s + 16 * hh), ldf(lds + HL_ST, vb * 32 + r, PQ, 32 * s + 16 * hh), accO);
        __builtin_amdgcn_sched_barrier(0);
    }
#pragma unroll
    for (int i = 0; i < 2; ++i) { const int db = 2 * (w & 1) + i;
#pragma unroll
        for (int s = 0; s < 4; ++s) accU[i] = MFMA32(ldf(lds + HL_VT, vb * 32 + r, PT, 32 * s + 16 * hh), ldf(lds + HL_KET, db * 32 + r, PT, 32 * s + 16 * hh), accU[i]); }
    __builtin_amdgcn_sched_barrier(0);
    if (FULL) __syncthreads();
    if (FULL) {
        const unsigned v = vb * 32 + r;
        const unsigned lrow = (MODE == 0 ? (unsigned)hh : (unsigned)(1 - hh)) * 4u;
        const size_t rbase = (MODE == 0) ? (tokbase + pbO * 32) : (tokbase + 63 - pbO * 32 - 4);
        const unsigned lo_of = lrow * DH + v, lo_pr = lrow * NIN + v, lo_a2 = lrow * D + v;
        float ofv[16]; unsigned gv[16];
        if (MODE == 1) {
#pragma unroll
            for (int i = 0; i < 16; ++i) { const int ci = (i & 3) + 8 * (i >> 2); ofv[i] = (F.of() + (rbase - ci) * DH + h * HD)[lo_of]; } }
        for (int sb = 0; sb <= pbO; ++sb)
#pragma unroll
            for (int s2 = 0; s2 < 2; ++s2) accO = MFMA32(ldf(lds + HL_SCM, pbO * 32 + r, PT, 64 * sb + 32 * s2 + 16 * hh), ldf(lds + HL_VT, vb * 32 + r, PT, 64 * sb + 32 * s2 + 16 * hh), accO);
        if (MODE == 0) {
#pragma unroll
            for (int i = 0; i < 16; ++i) { const int ci = (i & 3) + 8 * (i >> 2); (F.of() + (rbase + ci) * DH + h * HD)[lo_of] = accO[i]; }
        } else {
            LAS float* rs = (LAS float*)(lds + HL_RS);
#pragma unroll
            for (int i = 0; i < 16; ++i) { const int ci = (i & 3) + 8 * (i >> 2); gv[i] = (F.proj() + (rbase - ci) * NIN + 2048 + h * HD)[lo_pr]; }
            float ov[16];
            float ssr[16];
#pragma unroll
            for (int i = 0; i < 16; ++i) { ov[i] = accO[i] + ofv[i]; float ss = ov[i] * ov[i];
                ss = DPP_ADD(ss, 0x128); ss = DPP_ADD(ss, 0x124); ss = DPP_ADD(ss, 0x122); ss = DPP_ADD(ss, 0x121);
                ssr[i] = ss + __builtin_bit_cast(float, __builtin_amdgcn_update_dpp(0, __builtin_bit_cast(int, ss), 0x142, 0xA, 0xF, false)); }
            if (r == 16) {
#pragma unroll
                for (int i = 0; i < 16; ++i) { const int ci = (i & 3) + 8 * (i >> 2), p = pbO * 32 + ci + 4 * hh; rs[p * 4 + vb] = ssr[i]; } }
            __syncthreads();
            const float ng = F.hnorm_g()[h * HD + v];
#pragma unroll
            for (int i = 0; i < 16; ++i) { const int ci = (i & 3) + 8 * (i >> 2), p = pbO * 32 + ci + 4 * hh;
                const f32x4 q = *(LAS const f32x4*)(rs + p * 4);
                const float rstd = __builtin_amdgcn_rsqf((q[0] + q[1] + q[2] + q[3]) * (1.0f / HD) + EPS);
                const float g = bf2f(gv[i]);
                (F.bufA() + (rbase - ci) * D + h * HD)[lo_a2] = (bf16)cvtpk(ov[i] * rstd * ng * g, 0.f); }
        }
    }
    {
        const LAS float* av = (const LAS float*)(lds + HL_AV);
#pragma unroll
        for (int i = 0; i < 2; ++i) { const int db = 2 * (w & 1) + i; const float a = av[db * 32 + r];
#pragma unroll
            for (int j = 0; j < 16; j += 2) { const float s0 = accS[i][j] * a + accU[i][j], s1 = accS[i][j + 1] * a + accU[i][j + 1]; accS[i][j] = s0; accS[i][j + 1] = s1;
                if (FULL) { const int vv = vb * 32 + (j & 3) + 8 * (j >> 2) + 4 * hh; const unsigned pkd = cvtpk(s0, s1);
                    *(LAS bf16*)(lds + HL_ST + vv * PQ + (db * 32 + r) * 2) = (bf16)pkd; *(LAS bf16*)(lds + HL_ST + (vv + 1) * PQ + (db * 32 + r) * 2) = (bf16)(pkd >> 16); } } }
    }
    __syncthreads();
}
__device__ __forceinline__ void h1_item(Frame& F, int item) {
    const int seg = item & 15, dir = (item >> 4) & 1, h = (item >> 5) & 3, b = item >> 7;
    const float lb0 = F.lb()[dir * 512 + h * HD + 2 * F.lane], lb1 = F.lb()[dir * 512 + h * HD + 2 * F.lane + 1];
    f32x16 accS[2];
#pragma unroll
    for (int i = 0; i < 16; ++i) { accS[0][i] = 0.f; accS[1][i] = 0.f; }
    float atot = 1.f; const int col = F.tid & 127;
    unsigned rzA[8], rvA[8], rzB[8], rvB[8], rq[8];
#define H1CH(c) (seg * SEGC + (dir ? (SEGC - 1 - (c)) : (c)))
    hgrn_load<false>(F, b, h, dir, H1CH(0), rzA, rvA, rq); hgrn_load<false>(F, b, h, dir, H1CH(1), rzB, rvB, rq);
    for (int c = 0; c < SEGC; c += 2) {
        hgrn_chunk<false, 0>(F, b, h, dir, H1CH(c), (c + 2 < SEGC) ? H1CH(c + 2) : -1, accS, lb0, lb1, rzA, rvA, rq);
        atot *= ((const LAS float*)(F.lds + HL_AV))[col];
        hgrn_chunk<false, 0>(F, b, h, dir, H1CH(c + 1), (c + 3 < SEGC) ? H1CH(c + 3) : -1, accS, lb0, lb1, rzB, rvB, rq);
        atot *= ((const LAS float*)(F.lds + HL_AV))[col]; }
#undef H1CH
    if (F.tid < 128) F.sega()[(size_t)item * 128 + col] = atot;
    float* U = F.segu() + (size_t)item * 16384;
#pragma unroll
    for (int i = 0; i < 2; ++i)
#pragma unroll
        for (int j = 0; j < 16; j += 4) { f32x4 o; o[0] = accS[i][j]; o[1] = accS[i][j + 1]; o[2] = accS[i][j + 2]; o[3] = accS[i][j + 3]; ((f32x4*)(U + (i * 4 + (j >> 2)) * NTHR * 4))[F.tid] = o; }
}
__device__ __forceinline__ void h_scan(Frame& F) {
    for (int g = F.bid; g < NB * NHH * 2 * 8; g += F.G) {
        const int chain = g >> 3, k = g & 7, dir = chain & 1;
        const int aidx = (2 * (F.wave & 1) + (k >> 2)) * 32 + (F.lane & 31);
        float* U = F.segu() + (size_t)chain * NSEG * 16384 + (size_t)k * NTHR * 4 + F.tid * 4;
        const float* A = F.sega() + (size_t)chain * NSEG * 128 + aidx;
        f32x4 u[NSEG]; float av[NSEG];
#pragma unroll
        for (int q = 0; q < NSEG; ++q) { const int sg = dir ? (NSEG - 1 - q) : q; u[q] = *(const f32x4*)(U + (size_t)sg * 16384); av[q] = A[sg * 128]; }
        f32x4 S = {0.f, 0.f, 0.f, 0.f};
#pragma unroll
        for (int q = 0; q < NSEG; ++q) { const int sg = dir ? (NSEG - 1 - q) : q; *(f32x4*)(U + (size_t)sg * 16384) = S; S = S * av[q] + u[q]; }
    }
}
__device__ __forceinline__ void h2_init_state(Frame& F, int b, int h, int dir, int seg, f32x16 (&accS)[2]) {
    const int w = F.wave, r = F.lane & 31, hh = F.lane >> 5, vb = w >> 1;
    const float* U = F.segu() + (size_t)(((b * 4 + h) * 2 + dir) * NSEG + seg) * 16384;
#pragma unroll
    for (int k = 0; k < 8; ++k) { const f32x4 v = ((const f32x4*)(U + k * NTHR * 4))[F.tid]; const int i = k >> 2, j = (k & 3) * 4;
        accS[i][j] = v[0]; accS[i][j + 1] = v[1]; accS[i][j + 2] = v[2]; accS[i][j + 3] = v[3]; }
#pragma unroll
    for (int i = 0; i < 2; ++i) { const int db = 2 * (w & 1) + i;
#pragma unroll
        for (int j = 0; j < 16; ++j) { const int vv = vb * 32 + (j & 3) + 8 * (j >> 2) + 4 * hh; *(LAS bf16*)(F.lds + HL_ST + vv * PQ + (db * 32 + r) * 2) = (bf16)f2bf(accS[i][j]); } }
    __syncthreads();
}
__device__ __forceinline__ void h2_item(Frame& F, int item) {
    const int seg = item & 15, h = (item >> 4) & 3, b = item >> 6;
    f32x16 accS[2];
    unsigned rzA[8], rvA[8], rqA[8], rzB[8], rvB[8], rqB[8];
    { const float lb0 = F.lb()[h * HD + 2 * F.lane], lb1 = F.lb()[h * HD + 2 * F.lane + 1];
      const int c0 = seg * SEGC;
      hgrn_load<true>(F, b, h, 0, c0, rzA, rvA, rqA); hgrn_load<true>(F, b, h, 0, c0 + 1, rzB, rvB, rqB);
      h2_init_state(F, b, h, 0, seg, accS);
      for (int c = 0; c < SEGC; c += 2) {
          hgrn_chunk<true, 0>(F, b, h, 0, c0 + c, (c + 2 < SEGC) ? (c0 + c + 2) : -1, accS, lb0, lb1, rzA, rvA, rqA);
          hgrn_chunk<true, 0>(F, b, h, 0, c0 + c + 1, (c + 3 < SEGC) ? (c0 + c + 3) : -1, accS, lb0, lb1, rzB, rvB, rqB); } }
    asm volatile("s_waitcnt vmcnt(0)" ::: "memory");
    __syncthreads();
    { const float lb0 = F.lb()[512 + h * HD + 2 * F.lane], lb1 = F.lb()[512 + h * HD + 2 * F.lane + 1];
      const int cl = seg * SEGC + SEGC - 1;
      hgrn_load<true>(F, b, h, 1, cl, rzA, rvA, rqA); hgrn_load<true>(F, b, h, 1, cl - 1, rzB, rvB, rqB);
      h2_init_state(F, b, h, 1, seg, accS);
      for (int c = 0; c < SEGC; c += 2) {
          hgrn_chunk<true, 1>(F, b, h, 1, cl - c, (c + 2 < SEGC) ? (cl - c - 2) : -1, accS, lb0, lb1, rzA, rvA, rqA);
          hgrn_chunk<true, 1>(F, b, h, 1, cl - c - 1, (c + 3 < SEGC) ? (cl - c - 3) : -1, accS, lb0, lb1, rzB, rvB, rqB); } }
}

__device__ __forceinline__ unsigned f2key(float f) { return __builtin_bit_cast(unsigned, f); }
__device__ __forceinline__ float key2f(unsigned k) { return __builtin_bit_cast(float, k); }
__device__ __forceinline__ unsigned umax_(unsigned a, unsigned b) { unsigned r; asm("v_max_f32 %0, %1, %2" : "=v"(r) : "v"(a), "v"(b)); return r; }
__device__ __forceinline__ unsigned umin_(unsigned a, unsigned b) { unsigned r; asm("v_min_f32 %0, %1, %2" : "=v"(r) : "v"(a), "v"(b)); return r; }
__device__ __forceinline__ void sort16(unsigned (&a)[16]) {
#define CE_(i, j) { const unsigned x_ = a[i], y_ = a[j]; a[i] = umax_(x_, y_); a[j] = umin_(x_, y_); }
    CE_(0, 13) CE_(1, 12) CE_(2, 15) CE_(3, 14) CE_(4, 8) CE_(5, 6) CE_(7, 11) CE_(9, 10)
    CE_(0, 5) CE_(1, 7) CE_(2, 9) CE_(3, 4) CE_(6, 13) CE_(8, 14) CE_(10, 15) CE_(11, 12)
    CE_(0, 1) CE_(2, 3) CE_(4, 5) CE_(6, 8) CE_(7, 9) CE_(10, 11) CE_(12, 13) CE_(14, 15)
    CE_(0, 2) CE_(1, 3) CE_(4, 10) CE_(5, 11) CE_(6, 7) CE_(8, 9) CE_(12, 14) CE_(13, 15)
    CE_(1, 2) CE_(3, 12) CE_(4, 6) CE_(5, 7) CE_(8, 10) CE_(9, 11) CE_(13, 14)
    CE_(1, 4) CE_(2, 6) CE_(5, 8) CE_(7, 10) CE_(9, 13) CE_(11, 14)
    CE_(2, 4) CE_(3, 6) CE_(9, 12) CE_(11, 13)
    CE_(3, 5) CE_(6, 8) CE_(7, 9) CE_(10, 12)
    CE_(3, 4) CE_(5, 6) CE_(7, 8) CE_(9, 10) CE_(11, 12)
    CE_(6, 7) CE_(8, 9)
#undef CE_
}
__device__ __forceinline__ void merge16(unsigned (&a)[16], const unsigned (&b)[16]) {
#pragma unroll
    for (int i = 0; i < 16; ++i) a[i] = umax_(a[i], b[15 - i]);
#pragma unroll
    for (int j = 8; j > 0; j >>= 1)
#pragma unroll
        for (int i = 0; i < 16; ++i) { const int l = i ^ j; if (l > i) { const unsigned x = a[i], y = a[l]; a[i] = umax_(x, y); a[l] = umin_(x, y); } }
}
__device__ __forceinline__ unsigned dpp_swap1(unsigned v) { return (unsigned)__builtin_amdgcn_update_dpp(0, (int)v, 0xB1, 0xF, 0xF, false); }
__device__ __forceinline__ unsigned pick_byte(const unsigned (&pk)[4], unsigned a) {
    const unsigned wsel = a >> 2; unsigned v = wsel == 0 ? pk[0] : (wsel == 1 ? pk[1] : (wsel == 2 ? pk[2] : pk[3]));
    return (v >> ((a & 3u) * 8u)) & 0xffu;
}
__device__ __forceinline__ void topk_stage2(const unsigned (&top)[16], bool tab0, size_t item, int* esel, float* wsel) {
        float vO[16], vP[16]; unsigned iOpk[4] = {0u, 0u, 0u, 0u}, iPpk[4] = {0u, 0u, 0u, 0u};
#pragma unroll
        for (int i = 0; i < 16; ++i) { const unsigned t = top[i], tp = dpp_swap1(t);
            vO[i] = key2f(t & ~0x7fu); vP[i] = key2f(tp & ~0x7fu);
            iOpk[i >> 2] |= (127u - (t & 0x7fu)) << ((i & 3) * 8); iPpk[i >> 2] |= (127u - (tp & 0x7fu)) << ((i & 3) * 8); }
        unsigned R[16], G1[16], G2[16];
#define CAND(a, b) ((f2key(vO[a] + vP[b]) & ~0xffu) | (unsigned)(((a) << 4) | (b)))
#pragma unroll
        for (int i = 0; i < 16; ++i) R[i] = CAND(0, i);
        G1[0] = CAND(1, 0); G1[1] = CAND(1, 1); G1[2] = CAND(1, 2); G1[3] = CAND(1, 3); G1[4] = CAND(1, 4); G1[5] = CAND(1, 5); G1[6] = CAND(1, 6); G1[7] = CAND(1, 7);
        G1[8] = CAND(2, 0); G1[9] = CAND(2, 1); G1[10] = CAND(2, 2); G1[11] = CAND(2, 3); G1[12] = CAND(2, 4); G1[13] = CAND(3, 0); G1[14] = CAND(3, 1); G1[15] = CAND(3, 2);
        G2[0] = CAND(3, 3); G2[1] = CAND(4, 0); G2[2] = CAND(4, 1); G2[3] = CAND(4, 2); G2[4] = CAND(5, 0); G2[5] = CAND(5, 1); G2[6] = CAND(6, 0); G2[7] = CAND(6, 1);
        G2[8] = CAND(7, 0); G2[9] = CAND(7, 1); G2[10] = CAND(8, 0); G2[11] = CAND(9, 0); G2[12] = CAND(10, 0); G2[13] = CAND(11, 0); G2[14] = CAND(12, 0); G2[15] = CAND(13, 0);
        const unsigned g30 = CAND(14, 0), g31 = CAND(15, 0);
#undef CAND
        sort16(G1); sort16(G2);
        merge16(R, G1); merge16(R, G2);
        { const unsigned hi = umax_(g30, g31), lo = umin_(g30, g31); R[15] = umax_(R[15], hi); R[14] = umax_(R[14], lo);
#pragma unroll
          for (int j = 8; j > 0; j >>= 1)
#pragma unroll
              for (int i = 0; i < 16; ++i) { const int l = i ^ j; if (l > i) { const unsigned x = R[i], y = R[l]; R[i] = umax_(x, y); R[l] = umin_(x, y); } } }
        float sc[16], ex[16]; float sum = 0.f; unsigned eid[16];
        #pragma unroll
        for (int i = 0; i < 16; ++i) { sc[i] = key2f(R[i] & ~0xffu); const unsigned a = (R[i] >> 4) & 15u, bb = R[i] & 15u;
            const unsigned io = pick_byte(iOpk, a), ip = pick_byte(iPpk, bb);
            eid[i] = tab0 ? (io * 128u + ip) : (ip * 128u + io); }
#pragma unroll
        for (int i = 0; i < 16; ++i) { ex[i] = __expf(sc[i] - sc[0]); sum += ex[i]; }
        const float inv = 1.0f / sum;
        if (tab0) { const size_t o = item * 16;
#pragma unroll
            for (int q = 0; q < 4; ++q) { v4u ev; ev.x = eid[4 * q]; ev.y = eid[4 * q + 1]; ev.z = eid[4 * q + 2]; ev.w = eid[4 * q + 3]; *(v4u*)(esel + o + 4 * q) = ev;
                f32x4 wv; wv[0] = ex[4 * q] * inv; wv[1] = ex[4 * q + 1] * inv; wv[2] = ex[4 * q + 2] * inv; wv[3] = ex[4 * q + 3] * inv; *(f32x4*)(wsel + o + 4 * q) = wv; } }
}

struct EpiScoreTopk {
    static constexpr bool PERM = false, AFTER_DRAIN = false;
    float* scr; const float* ssqp; const float* biasq; float* rstd_out; int* esel; float* wsel;
    __device__ __forceinline__ void operator()(const f32x4 (&acc)[2][2][4][2], const pg8::Unit& u, int wr, int wc, int fr, int fq) const {
        asm volatile("" : "+v"(fr), "+v"(fq));
        const int rl0 = wr * 64 + fr, col0 = wc * 32 + 4 * fq, b = (u.pm * 256) >> 13;
        f32x4 bv[2][2];
#pragma unroll
        for (int bj = 0; bj < 2; ++bj)
#pragma unroll
            for (int n = 0; n < 2; ++n) bv[bj][n] = *(const f32x4*)(biasq + b * 2048 + u.pn * 256 + col0 + bj * 128 + n * 16);
#pragma unroll
        for (int ai = 0; ai < 2; ++ai)
#pragma unroll
            for (int m = 0; m < 4; ++m) { const int rl = rl0 + ai * 128 + m * 16, row = u.pm * 256 + rl;
                const f32x4 p0 = *(const f32x4*)(ssqp + (size_t)row * 4), p1 = *(const f32x4*)(ssqp + ((size_t)32768 + row) * 4), p2 = *(const f32x4*)(ssqp + ((size_t)65536 + row) * 4), p3 = *(const f32x4*)(ssqp + ((size_t)98304 + row) * 4);
                const float tot = (p0[0] + p0[1] + p0[2] + p0[3]) + (p1[0] + p1[1] + p1[2] + p1[3]) + (p2[0] + p2[1] + p2[2] + p2[3]) + (p3[0] + p3[1] + p3[2] + p3[3]);
                const float rstd = __builtin_amdgcn_rsqf(tot * (1.0f / 1024.0f) + 1e-6f);
                if (u.pn == 0 && wc == 0 && fq == 0) rstd_out[row] = rstd;
                float* blk = scr + (2 * wr + 4 * ai + (m >> 1)) * 8192 + 8 * wc * 256 + 32 * (m & 1) * 4;
                const unsigned loff4 = (unsigned)(2 * fr + 64 * fq);
#pragma unroll
                for (int bj = 0; bj < 2; ++bj)
#pragma unroll
                    for (int n = 0; n < 2; ++n) ((f32x4*)(blk + (4 * n * 64 + bj) * 4))[loff4] = acc[ai][bj][m][n] * rstd + bv[bj][n]; }
        asm volatile("s_waitcnt vmcnt(0)" ::: "memory");
        __builtin_amdgcn_s_barrier();
        asm volatile("" ::: "memory");
        int tid = threadIdx.x; asm volatile("" : "+v"(tid));
        const int rl = tid >> 1, tab = tid & 1;
        const float* bp = scr + __builtin_amdgcn_readfirstlane(tid >> 6) * 8192;
        const unsigned lo4 = (unsigned)(tid & 63) * 4u;
        unsigned top[16];
        f32x4 cur[4], nxt[4];
#pragma unroll
        for (int q = 0; q < 4; ++q) cur[q] = *(const f32x4*)(bp + q * 256 + lo4);
#pragma unroll
        for (int grp = 0; grp < 8; ++grp) { unsigned k[16];
            if (grp < 7) {
#pragma unroll
                for (int q = 0; q < 4; ++q) nxt[q] = *(const f32x4*)(bp + ((grp + 1) * 4 + q) * 256 + lo4); }
#pragma unroll
            for (int q = 0; q < 4; ++q) { const f32x4 v = cur[q];
#pragma unroll
                for (int e = 0; e < 4; ++e) { const int j = grp * 16 + q * 4 + e; k[q * 4 + e] = (f2key(v[e]) & ~0x7fu) | (unsigned)(127 - j); } }
            sort16(k);
            if (grp == 0) {
#pragma unroll
                for (int i = 0; i < 16; ++i) top[i] = k[i];
            } else merge16(top, k);
#pragma unroll
            for (int q = 0; q < 4; ++q) cur[q] = nxt[q];
            __builtin_amdgcn_sched_barrier(0); }
        topk_stage2(top, tab == 0, (size_t)u.pn * T + (size_t)(u.pm * 256 + rl), esel, wsel);
    }
};

__device__ __forceinline__ void cvt16(const v4u& u, f32x2_ (&f)[8]) {
#pragma unroll
    for (int i = 0; i < 4; ++i) { f[2 * i] = __builtin_amdgcn_cvt_pk_f32_fp8((int)u[i], false); f[2 * i + 1] = __builtin_amdgcn_cvt_pk_f32_fp8((int)u[i], true); }
}
constexpr int PITEM = 8, NPITEM = T / PITEM;
__device__ __forceinline__ int peer_next(unsigned* q, int lane) {
    int idx = 0; if (lane == 0) idx = (int)__hip_atomic_fetch_add(q, 1u, __ATOMIC_RELAXED, __HIP_MEMORY_SCOPE_AGENT);
    return __builtin_amdgcn_readfirstlane(idx);
}
#define PEER_SB() __builtin_amdgcn_sched_barrier(0)
#define DPP_IADD(s, ctrl) ((s) + __builtin_amdgcn_update_dpp(0, (s), (ctrl), 0xF, 0xF, false))
__device__ __forceinline__ void p8_dots(const v4u (&ud)[16], const int (&hh)[4], const int (&hl)[4], int c8, int& r0, int& r1) {
#pragma unroll
    for (int i = 0; i < 16; ++i) { int sh = 0, sl = 0;
#pragma unroll
        for (int d = 0; d < 4; ++d) { sh = __builtin_amdgcn_sdot8((int)ud[i][d], hh[d], sh, false); sl = __builtin_amdgcn_sdot8((int)ud[i][d], hl[d], sl, false); }
        int sm = (sh << 4) + sl;
        sm = DPP_IADD(sm, 0xB1); sm = DPP_IADD(sm, 0x4E); sm = DPP_IADD(sm, 0x141);
        if ((i & 1) == 0) r0 = (c8 == (i >> 1)) ? sm : r0; else r1 = (c8 == (i >> 1)) ? sm : r1; }
}
constexpr int PSLAB = 12288;
__device__ __forceinline__ void p8_item(Frame& F, int sl, int item, int nitem, bool filled, LAS unsigned char* slab) {
    const int c8 = F.lane & 7, q8 = F.lane >> 3, t0 = item * PITEM;
    const unsigned char* ub = F.U8() + (size_t)sl * 16384 * 128 + 16 * c8;
    LAS int* eL = (LAS int*)slab; LAS unsigned char* hL = (LAS unsigned char*)(slab + 4096);
    LAS float* qL = (LAS float*)(slab + 6144);
    v4u t4[4], h2[4]; float rs2[4]; f32x4 sA, sB;
#define P8_BLK_LOAD(tb) do { \
        { const float* sp_ = F.mod() + ((tb) >> 13) * 6144 + 3072 + sl * CSLU + 8 * (F.lane & 31); sA = *(const f32x4*)sp_; sB = *(const f32x4*)(sp_ + 4); } \
        _Pragma("unroll") for (int i = 0; i < 4; ++i) rs2[i] = F.rstd()[(tb) + 2 * i + (F.lane >> 5)]; \
        _Pragma("unroll") for (int i = 0; i < 4; ++i) t4[i] = __builtin_nontemporal_load((const v4u*)(F.esel() + ((size_t)(2 * i + (F.lane >> 5)) * T + (tb)) * 16) + (F.lane & 31)); \
        _Pragma("unroll") for (int i = 0; i < 4; ++i) h2[i] = __builtin_nontemporal_load((const v4u*)(F.hg() + (size_t)((tb) + 2 * i + (F.lane >> 5)) * D + sl * CSLU + 8 * (F.lane & 31))); } while (0)
#define DPP_FMAX(v, ctrl) __builtin_fmaxf((v), __builtin_bit_cast(float, __builtin_amdgcn_update_dpp(0, __builtin_bit_cast(int, (v)), (ctrl), 0xF, 0xF, false)))
#define P8_QN(x, k) { const int q_ = (int)__builtin_rintf((x) * qs_), lo_ = ((q_ + 8) & 15) - 8, hi_ = (q_ - lo_) >> 4; wl_ |= (unsigned)(lo_ & 15) << (4 * (k)); wh_ |= (unsigned)(hi_ & 15) << (4 * (k)); }
#define P8_BLK_STORE() do { _Pragma("unroll") for (int i = 0; i < 4; ++i) *(LAS v4u*)(eL + ((F.lane & 31) >> 2) * NSEL + (2 * i + (F.lane >> 5)) * 16 + 4 * (F.lane & 3)) = t4[i]; \
        _Pragma("unroll") for (int i = 0; i < 4; ++i) { const float r_ = rs2[i]; const v4u h_ = h2[i]; \
            const float x0 = bflo(h_[0]) * r_ + sA[0], x1 = bfhi(h_[0]) * r_ + sA[1], x2 = bflo(h_[1]) * r_ + sA[2], x3 = bfhi(h_[1]) * r_ + sA[3]; \
            const float x4 = bflo(h_[2]) * r_ + sB[0], x5 = bfhi(h_[2]) * r_ + sB[1], x6 = bflo(h_[3]) * r_ + sB[2], x7 = bfhi(h_[3]) * r_ + sB[3]; \
            float m_ = __builtin_fmaxf(__builtin_fmaxf(__builtin_fmaxf(__builtin_fabsf(x0), __builtin_fabsf(x1)), __builtin_fmaxf(__builtin_fabsf(x2), __builtin_fabsf(x3))), \
                                       __builtin_fmaxf(__builtin_fmaxf(__builtin_fabsf(x4), __builtin_fabsf(x5)), __builtin_fmaxf(__builtin_fabsf(x6), __builtin_fabsf(x7)))); \
            m_ = DPP_FMAX(m_, 0x128); m_ = DPP_FMAX(m_, 0x124); m_ = DPP_FMAX(m_, 0x122); m_ = DPP_FMAX(m_, 0x121); m_ = __builtin_fmaxf(m_, __shfl_xor(m_, 16)); m_ = __builtin_fmaxf(m_, 1e-20f); \
            const float qs_ = 119.0f * __builtin_amdgcn_rcpf(m_); \
            const int tk_ = 2 * i + (F.lane >> 5); \
            if ((F.lane & 31) == 0) qL[tk_] = m_ * (1.0f / (119.0f * UQSCALE)); \
            unsigned wl_ = 0u, wh_ = 0u; P8_QN(x0, 0) P8_QN(x1, 1) P8_QN(x2, 2) P8_QN(x3, 3) P8_QN(x4, 4) P8_QN(x5, 5) P8_QN(x6, 6) P8_QN(x7, 7) \
            *(LAS unsigned*)(hL + tk_ * 256 + 4 * (F.lane & 31)) = wh_; *(LAS unsigned*)(hL + tk_ * 256 + 128 + 4 * (F.lane & 31)) = wl_; } \
        asm volatile("s_waitcnt lgkmcnt(0)" ::: "memory"); } while (0)
    if (!filled) { P8_BLK_LOAD(t0); P8_BLK_STORE(); }
    bf16* po = F.pact() + ((size_t)t0 * NSLU + sl) * NSEL + 16 * q8 + 2 * c8;
    v4u udA[16], udB[16];
#define P8_GATHER(dst, tt) do { v4u e_[4]; _Pragma("unroll") for (int k = 0; k < 4; ++k) e_[k] = *(LAS const v4u*)(eL + (tt) * NSEL + 16 * q8 + 4 * k); \
        _Pragma("unroll") for (int i = 0; i < 16; ++i) dst[i] = *(const v4u*)(ub + (size_t)e_[i >> 2][i & 3] * 128); } while (0)
#define P8_HN(tt) int hh[4], hl[4]; { const v4u a_ = *(LAS const v4u*)(hL + (tt) * 256 + 16 * c8), b_ = *(LAS const v4u*)(hL + (tt) * 256 + 128 + 16 * c8); \
        hh[0] = (int)a_[0]; hh[1] = (int)a_[1]; hh[2] = (int)a_[2]; hh[3] = (int)a_[3]; hl[0] = (int)b_[0]; hl[1] = (int)b_[1]; hl[2] = (int)b_[2]; hl[3] = (int)b_[3]; }
#define P8_OUT(tt, r0, r1) do { const float dq_ = qL[tt]; __builtin_nontemporal_store(cvtpk((float)(r0) * dq_, (float)(r1) * dq_), (unsigned*)(po + (size_t)(tt) * NSLU * NSEL)); } while (0)
    P8_GATHER(udA, 0);
    for (int tt = 0; tt < PITEM - 2; tt += 2) {
        P8_GATHER(udB, tt + 1);
        { P8_HN(tt); int r0 = 0, r1 = 0; p8_dots(udA, hh, hl, c8, r0, r1); P8_OUT(tt, r0, r1); }
        P8_GATHER(udA, tt + 2);
        { P8_HN(tt + 1); int r0 = 0, r1 = 0; p8_dots(udB, hh, hl, c8, r0, r1); P8_OUT(tt + 1, r0, r1); }
    }
    {
        P8_GATHER(udB, PITEM - 1);
        { P8_HN(PITEM - 2); int r0 = 0, r1 = 0; p8_dots(udA, hh, hl, c8, r0, r1); P8_OUT(PITEM - 2, r0, r1); }
        if (nitem >= 0) P8_BLK_LOAD(nitem * PITEM);
        { P8_HN(PITEM - 1); int r0 = 0, r1 = 0; p8_dots(udB, hh, hl, c8, r0, r1); P8_OUT(PITEM - 1, r0, r1); }
        if (nitem >= 0) P8_BLK_STORE();
    }
#undef P8_GATHER
#undef P8_HN
#undef P8_OUT
#undef P8_BLK_LOAD
#undef P8_BLK_STORE
#undef P8_QN
#undef DPP_FMAX
}
__device__ __forceinline__ void p8b_coef(Frame& F) {
    const size_t N = (size_t)T * NSEL;
#pragma unroll 4
    for (size_t i = (size_t)F.bid * NTHR + F.tid; i < N; i += (size_t)F.G * NTHR) { const size_t t = i >> 7; const int j = (int)(i & 127);
        const bf16* pp = F.pact() + t * NSLU * NSEL + j; float a = 0.f;
#pragma unroll
        for (int s = 0; s < NSLU; ++s) a += bf2f(__builtin_nontemporal_load(pp + s * NSEL));
        F.coef()[i] = F.wsel()[((size_t)(j >> 4) * T + t) * 16 + (j & 15)] * 0.5f * a * (1.0f + erff(a * 0.70710678f)); }
}
__device__ __forceinline__ void p9_token(const v4u (&vd)[16], LAS const float* cL, bf16* yo, LAS float* red, int lane, int c8, int q8) {
    f32x4 cc[4];
#pragma unroll
    for (int k = 0; k < 4; ++k) cc[k] = *(LAS const f32x4*)(cL + 16 * q8 + 4 * k);
    f32x2_ y[8];
#pragma unroll
    for (int k = 0; k < 8; ++k) y[k] = (f32x2_){0.f, 0.f};
#pragma unroll
    for (int i = 0; i < 16; ++i) { f32x2_ vf[8]; cvt16(vd[i], vf); const float c = cc[i >> 2][i & 3]; const f32x2_ c2 = {c, c};
#pragma unroll
        for (int k = 0; k < 8; ++k) y[k] += c2 * vf[k];
        PEER_SB(); }
#pragma unroll
    for (int k = 0; k < 4; ++k) { f32x4 o; o[0] = y[2 * k][0]; o[1] = y[2 * k][1]; o[2] = y[2 * k + 1][0]; o[3] = y[2 * k + 1][1]; *(LAS f32x4*)(red + q8 * 128 + 16 * c8 + 4 * k) = o; }
    asm volatile("s_waitcnt lgkmcnt(0)" ::: "memory");
    f32x2_ sm = {0.f, 0.f};
#pragma unroll
    for (int g = 0; g < 8; ++g) sm += *(LAS const f32x2_*)(red + g * 128 + 2 * lane);
    sm = sm * (1.0f / VSCALE);
    __builtin_nontemporal_store(cvtpk(sm[0], sm[1]), (unsigned*)(yo + 2 * lane));
    asm volatile("s_waitcnt lgkmcnt(0)" ::: "memory");
    PEER_SB();
}
__device__ __forceinline__ void p9_item(Frame& F, int sl, int item, int nitem, bool filled, LAS unsigned char* slab) {
    const int c8 = F.lane & 7, q8 = F.lane >> 3, t0 = item * PITEM;
    const unsigned char* vb = F.V8() + (size_t)sl * 16384 * CSL + 16 * c8;
    LAS int* eL = (LAS int*)slab; LAS float* cL = (LAS float*)(slab + 4096); LAS float* red = (LAS float*)(slab + 8192);
    v4u t4[4], c4[4];
#define P9_BLK_LOAD(tb) do { const v4u* cp_ = (const v4u*)(F.coef() + (size_t)(tb) * NSEL); \
        _Pragma("unroll") for (int i = 0; i < 4; ++i) { t4[i] = __builtin_nontemporal_load((const v4u*)(F.esel() + ((size_t)(2 * i + (F.lane >> 5)) * T + (tb)) * 16) + (F.lane & 31)); c4[i] = __builtin_nontemporal_load(cp_ + i * 64 + F.lane); } } while (0)
#define P9_BLK_STORE() do { _Pragma("unroll") for (int i = 0; i < 4; ++i) { *(LAS v4u*)(eL + ((F.lane & 31) >> 2) * NSEL + (2 * i + (F.lane >> 5)) * 16 + 4 * (F.lane & 3)) = t4[i]; *(LAS v4u*)(cL + (i * 64 + F.lane) * 4) = c4[i]; } \
        asm volatile("s_waitcnt lgkmcnt(0)" ::: "memory"); } while (0)
    if (!filled) { P9_BLK_LOAD(t0); P9_BLK_STORE(); }
    bf16* yo = F.ybuf() + (size_t)t0 * D + sl * CSL;
    v4u vdA[16], vdB[16];
#define P9_GATHER(dst, tt) do { v4u e_[4]; _Pragma("unroll") for (int k = 0; k < 4; ++k) e_[k] = *(LAS const v4u*)(eL + (tt) * NSEL + 16 * q8 + 4 * k); \
        _Pragma("unroll") for (int i = 0; i < 16; ++i) dst[i] = *(const v4u*)(vb + (size_t)e_[i >> 2][i & 3] * CSL); } while (0)
    P9_GATHER(vdA, 0);
    for (int tt = 0; tt < PITEM - 2; tt += 2) {
        P9_GATHER(vdB, tt + 1);
        p9_token(vdA, cL + tt * NSEL, yo + (size_t)tt * D, red, F.lane, c8, q8);
        P9_GATHER(vdA, tt + 2);
        p9_token(vdB, cL + (tt + 1) * NSEL, yo + (size_t)(tt + 1) * D, red, F.lane, c8, q8);
    }
    {
        P9_GATHER(vdB, PITEM - 1);
        p9_token(vdA, cL + (PITEM - 2) * NSEL, yo + (size_t)(PITEM - 2) * D, red, F.lane, c8, q8);
        if (nitem >= 0) P9_BLK_LOAD(nitem * PITEM);
        p9_token(vdB, cL + (PITEM - 1) * NSEL, yo + (size_t)(PITEM - 1) * D, red, F.lane, c8, q8);
        if (nitem >= 0) P9_BLK_STORE();
    }
#undef P9_GATHER
#undef P9_BLK_LOAD
#undef P9_BLK_STORE
}
template <int SIDE>
__device__ __forceinline__ void peer_phase(Frame& F0, int rep) {
    Frame F = F0; asm volatile("" : "+v"(F.lane));
    constexpr int NS = (SIDE == 0) ? NSLU : NSL;
    const int s0 = (int)(xb_xcc_id() & (unsigned)(NS - 1));
    unsigned* qbase = F.ctl() + (SIDE == 0 ? CW_QU : CW_QV) + rep * 64 * 32;
    LAS unsigned char* cf = F.lds + F.wave * PSLAB;
    for (int k = 0; k < NS; ++k) { const int sl = (s0 + k) & (NS - 1);
        int item = peer_next(qbase + 64 * sl, F.lane); bool filled = false;
        while (item < NPITEM) { int nitem = peer_next(qbase + 64 * sl, F.lane); if (nitem >= NPITEM) nitem = -1;
            if (SIDE == 0) p8_item(F, sl, item, nitem, filled, cf); else p9_item(F, sl, item, nitem, filled, cf);
            filled = nitem >= 0; item = nitem >= 0 ? nitem : NPITEM; } }
}
__device__ __forceinline__ void p10_final(Frame& F) {
    const int gwc = F.bid * NWAVES + F.wave, NGW = F.G * NWAVES;
    for (int row0 = gwc * 16; row0 < T; row0 += NGW * 16) {
        const int b = row0 >> 13; const float* mb = F.mod() + b * 6144 + 5120; const float* fm = F.fmod() + b * 2048;
        f32x4 g2[4], ca[4], cb[4];
#pragma unroll
        for (int j = 0; j < 4; ++j) { const int k = 256 * j + 4 * F.lane; g2[j] = *(const f32x4*)(mb + k); ca[j] = *(const f32x4*)(F.fnorm_g() + k) * (*(const f32x4*)(fm + 1024 + k) + 1.0f); cb[j] = *(const f32x4*)(fm + k); }
#pragma unroll 4
        for (int r = 0; r < 16; ++r) { float* hr = F.out() + (size_t)(row0 + r) * D; const bf16* yr = F.ybuf() + (size_t)(row0 + r) * D; const bf16* hb = (const bf16*)hr;
            f32x4 z[4]; float ss = 0.f;
#pragma unroll
            for (int j = 0; j < 4; ++j) { const v2u hq = *(const v2u*)(hb + 256 * j + 4 * F.lane); f32x4 hv; hv[0] = bflo(hq[0]); hv[1] = bfhi(hq[0]); hv[2] = bflo(hq[1]); hv[3] = bfhi(hq[1]);
                const v2u yq = __builtin_nontemporal_load((const v2u*)(yr + 256 * j + 4 * F.lane)); f32x4 yv; yv[0] = bflo(yq[0]); yv[1] = bfhi(yq[0]); yv[2] = bflo(yq[1]); yv[3] = bfhi(yq[1]);
                z[j] = hv + g2[j] * yv; ss += z[j][0] * z[j][0] + z[j][1] * z[j][1] + z[j][2] * z[j][2] + z[j][3] * z[j][3]; }
            const float rstd = __builtin_amdgcn_rsqf(wave_sum(ss) * (1.0f / D) + EPS);
#pragma unroll
            for (int j = 0; j < 4; ++j) *(f32x4*)(hr + 256 * j + 4 * F.lane) = z[j] * rstd * ca[j] + cb[j]; }
    }
}

constexpr int NPHASE = 12;
__global__ void __launch_bounds__(NTHR, 2) fwd_kernel(Args args) {
    extern __shared__ __attribute__((aligned(16))) unsigned char lds_raw[];
    Frame F;
    F.lds = (LAS unsigned char*)lds_raw;
    F.tid = threadIdx.x; F.lane = F.tid & 63; F.wave = __builtin_amdgcn_readfirstlane(F.tid >> 6); F.G = gridDim.x; F.bid = blockIdx.x;
    unsigned char* ws = args.ws; F.a = &args;
    volatile LAS unsigned* misc = (volatile LAS unsigned*)(F.lds + MISC_OFF);
    if (F.tid < 64) misc[F.tid] = 0u;
    __syncthreads();
    const int lo = args.ph_lo, hi = args.ph_hi;
    const bool multi = (hi - lo) > 1;
    XcdBarrier bar; bar.bar = (unsigned*)(ws + WS_CTL) + CW_BAR; bar.x = 0; bar.st = nullptr;
    if (multi) bar = xcd_barrier_post((unsigned*)(ws + WS_CTL) + CW_BAR, misc + 8);
#ifndef PHMASK
#define PHMASK 0xfff
#endif
#define IN(k) (((PHMASK >> (k)) & 1) && lo <= (k) && (k) < hi)
#define SEAM(k) do { if (IN(k) && IN((k) + 1)) xcd_barrier(bar); } while (0)

#ifndef REPMASK
#define REPMASK 0
#endif
#define REP(k) (((REPMASK) >> (k)) & 1)
#define REPBAR(k) if (REP(k) && rep == 0) xcd_barrier(bar)
    if (IN(0)) { for (int rep = 0; rep <= REP(0); ++rep) { p0_prologue(F); REPBAR(0); } } SEAM(0);
    if (IN(1)) { for (int rep = 0; rep <= REP(1); ++rep) { p1_norm(F); REPBAR(1); } } SEAM(1);
    if (IN(2)) { { pg8::Gemm g{F.bufA(), F.Win_t(), T, NIN, D}; pg8::StaticOrder S; S.init(T, NIN, F.G, F.bid);
        pg8::EpiProj E{F.proj(), NIN};
        pg8::gemm_phase<pg8::EpiProj, pg8::StaticOrder, true, true>(F.lds, g, S, E); }
#if ((REPMASK) >> 2) & 1
        xcd_barrier(bar); { pg8::Gemm g{F.bufA(), F.Win_t(), T, NIN, D}; pg8::StaticOrder S; S.init(T, NIN, F.G, F.bid);
        pg8::EpiProj E{F.proj(), NIN};
        pg8::gemm_phase<pg8::EpiProj, pg8::StaticOrder, true, true>(F.lds, g, S, E); }
#endif
    } SEAM(2);
    if (IN(3)) { for (int rep = 0; rep <= REP(3); ++rep) {
        for (int it = F.bid; it < NB * NHH * 2 * NSEG; it += F.G) h1_item(F, it);
        asm volatile("s_waitcnt vmcnt(0)" ::: "memory");
        __syncthreads();
        if (F.tid == 0) { __builtin_amdgcn_fence(__ATOMIC_RELEASE, "agent"); asm volatile("s_waitcnt vmcnt(0)" ::: "memory"); (void)xb_add(F.ctl() + CW_H1, 1u); }
        float cw[CW];
#pragma unroll
        for (int j = 0; j < CW; ++j) cw[j] = F.conv_w()[j * DC + F.tid];
        const float cbias = F.conv_b()[F.tid];
        for (int it = F.bid; it < T / 32; it += F.G) conv_item(F, it, cw, cbias);
        if (F.tid == 0) { const unsigned tgt = (unsigned)F.G * (unsigned)(rep + 1); XB_SPIN(xb_ld(F.ctl() + CW_H1) < tgt, bar.bar); __builtin_amdgcn_fence(__ATOMIC_ACQUIRE, "agent"); asm volatile("s_waitcnt vmcnt(0)" ::: "memory"); }
        __syncthreads();
        h_scan(F);
        REPBAR(3); }
    } SEAM(3);
    if (IN(4)) { for (int rep = 0; rep <= REP(4); ++rep) { for (int it = F.bid; it < NB * NHH * NSEG; it += F.G) h2_item(F, it); REPBAR(4); } } SEAM(4);
    if (IN(5)) { { pg8::Gemm g{F.bufA(), F.Wout_t(), T, D, D}; pg8::StaticOrder S; S.init(T, D, F.G, F.bid);
        pg8::EpiOut E{F.x(), F.out(), F.hg(), F.mod(), F.g_ffn(), F.ssqp()};
        pg8::gemm_phase<pg8::EpiOut, pg8::StaticOrder, true, true>(F.lds, g, S, E); }
#if ((REPMASK) >> 5) & 1
        xcd_barrier(bar); { pg8::Gemm g{F.bufA(), F.Wout_t(), T, D, D}; pg8::StaticOrder S; S.init(T, D, F.G, F.bid);
        pg8::EpiOut E{F.x(), F.out(), F.hg(), F.mod(), F.g_ffn(), F.ssqp()};
        pg8::gemm_phase<pg8::EpiOut, pg8::StaticOrder, true, true>(F.lds, g, S, E); }
#endif
    } SEAM(5);
    if (IN(6)) { { pg8::Gemm g{F.hg(), F.Wqk_t(), T, NQK, D}; pg8::StaticOrder S; S.init(T, NQK, F.G, F.bid);
        EpiScoreTopk E{F.scores() + (size_t)F.bid * 65536, F.ssqp(), F.biasq(), F.rstd(), F.esel(), F.wsel()};
        pg8::gemm_phase<EpiScoreTopk, pg8::StaticOrder, true, true>(F.lds, g, S, E); }
    } SEAM(6);
    if (IN(8)) { for (int rep = 0; rep <= REP(8); ++rep) { peer_phase<0>(F, rep); REPBAR(8); } } SEAM(8);
    if (IN(9)) { for (int rep = 0; rep <= REP(9); ++rep) { p8b_coef(F); REPBAR(9); } } SEAM(9);
    if (IN(10)) { for (int rep = 0; rep <= REP(10); ++rep) { peer_phase<1>(F, rep); REPBAR(10); } } SEAM(10);
    if (IN(11)) { p10_final(F); }
#undef IN
#undef SEAM
}

#ifndef MK_ONE_LAUNCH
#define MK_ONE_LAUNCH 0
#endif
extern "C" void kernel_launch(void* const* d_in, const int* in_sizes, int n_in, void* d_out, int out_size, void* d_ws, size_t ws_size, hipStream_t stream) {
    static int grid = 0;
    if (grid == 0) {
        if (n_in != 23 || out_size != T * D || ws_size < WS_END) { fprintf(stderr, "kernel_launch: unexpected shapes (n_in %d, out %d, ws %zu)\n", n_in, out_size, ws_size); grid = -1; return; }
        int dev = 0, cus = 0, per_cu = 0;
        if (hipGetDevice(&dev) != hipSuccess || hipDeviceGetAttribute(&cus, hipDeviceAttributeMultiprocessorCount, dev) != hipSuccess) { grid = -1; return; }
        if (hipFuncSetAttribute((const void*)fwd_kernel, hipFuncAttributeMaxDynamicSharedMemorySize, LDS_BYTES) != hipSuccess) { fprintf(stderr, "kernel_launch: hipFuncSetAttribute failed\n"); grid = -1; return; }
        if (hipOccupancyMaxActiveBlocksPerMultiprocessor(&per_cu, (const void*)fwd_kernel, NTHR, LDS_BYTES) != hipSuccess || per_cu < 1) { fprintf(stderr, "kernel_launch: occupancy query reports %d\n", per_cu); }
        (void)hipGetLastError();
        grid = cus;
    }
    if (grid < 0) return;
    (void)hipMemsetAsync((char*)d_ws + WS_CTL, 0, CTL_ZERO_BYTES, stream);
    Args a{};
    for (int i = 0; i < 23; ++i) a.in[i] = (const float*)d_in[i];
    a.out = (float*)d_out; a.ws = (unsigned char*)d_ws;
#if MK_ONE_LAUNCH
    a.ph_lo = 0; a.ph_hi = NPHASE;
    hipLaunchKernelGGL(fwd_kernel, dim3(grid), dim3(NTHR), LDS_BYTES, stream, a);
#else
    for (int p = 0; p < NPHASE; ++p) { a.ph_lo = p; a.ph_hi = p + 1; hipLaunchKernelGGL(fwd_kernel, dim3(grid), dim3(NTHR), LDS_BYTES, stream, a); }
#endif
}
```

```cpp
#include <hip/hip_runtime.h>
#include <cstdio>
#include <cstdint>
namespace pg8 {
#define PG8_LAS __attribute__((address_space(3)))
typedef unsigned short bf16_t;
typedef short bf16x8 __attribute__((ext_vector_type(8)));
typedef float f32x4 __attribute__((ext_vector_type(4)));
typedef unsigned u32x4 __attribute__((ext_vector_type(4)));
constexpr int BM = 256, BK = 64, HALF = 128, HTB = HALF * BK * 2  , STAGE_BYTES = 8 * HTB, NXCD = 8, WGM = 8;

__host__ __device__ __forceinline__ int lds_byte(int r, int c) { const int st = (r >> 4) * 2 + (c >> 5), rr = r & 15, cc = c & 31, ob = rr * 64 + cc * 2; return st * 1024 + (ob ^ (((ob >> 9) & 1) << 5)); }
__host__ __device__ __forceinline__ void stage_rc(int b, int& R, int& C) { const int st = b / 1024, sb = b % 1024, swz = sb ^ (((sb >> 9) & 1) << 5); R = (st >> 1) * 16 + swz / 64; C = (st & 1) * 32 + (swz % 64) / 2; }
__host__ __device__ __forceinline__ int perm32(int rho) { const int n = rho >> 4, i = rho & 15; return 8 * (i >> 2) + 4 * n + (i & 3); }

struct Unit { int pm, pn; };
struct Gemm { const bf16_t* A; const bf16_t* Bt; int M, N, K; size_t bbatch = 0; };

struct StaticOrder {
    int nM, nN, nwg, G, c;
    __host__ __device__ void init(int M, int N, int G_, int c_) { nM = M / BM; nN = N / BM; nwg = nM * nN; G = G_; c = c_; }
    __host__ __device__ bool next(int i, Unit& u) const {
        const long L = (long)i * G + c; if (L >= nwg) return false;
        int wgid = (int)L; { const int q = nwg / NXCD, r = nwg % NXCD, xcd = wgid % NXCD, off = wgid / NXCD; wgid = (xcd < r ? xcd * (q + 1) : r * (q + 1) + (xcd - r) * q) + off; }
        const int nig = WGM * nN, gid = wgid / nig, fm = gid * WGM, gsz = (nM - fm) < WGM ? (nM - fm) : WGM;
        u.pm = fm + ((wgid % nig) % gsz); u.pn = (wgid % nig) / gsz; return true;
    }
    __device__ __forceinline__ void a_ready(const Unit&) const {}
    __device__ __forceinline__ void done(const Unit&) const {}
};
__device__ __forceinline__ unsigned cvt_pk_bf16(float lo, float hi) { unsigned r; asm volatile("v_cvt_pk_bf16_f32 %0, %1, %2" : "=v"(r) : "v"(lo), "v"(hi)); return r; }
typedef float f32x2 __attribute__((ext_vector_type(2)));
__device__ __forceinline__ f32x2 gelu_pk(f32x2 v) {
    const f32x2 av = __builtin_elementwise_abs(v), d = av * 0.2316418882f + 1.0f;
    f32x2 t; t.x = __builtin_amdgcn_rcpf(d.x); t.y = __builtin_amdgcn_rcpf(d.y);
    f32x2 q = t * 0.5307027145f + (-0.7265760135f); q = q * t + 0.7107068705f; q = q * t + (-0.142248368f); q = q * t + 0.127414796f; q = q * t;
    const f32x2 s = (v * v) * (-0.72134752044f);
    f32x2 e; e.x = __builtin_amdgcn_exp2f(s.x); e.y = __builtin_amdgcn_exp2f(s.y);
    const f32x2 m = v * (q * e), r = v - m;
    f32x2 o; o.x = v.x < 0.f ? m.x : r.x; o.y = v.y < 0.f ? m.y : r.y; return o;
}

template <int ACT  > struct EpiBf16 {
    static constexpr bool PERM = true, AFTER_DRAIN = false; static_assert(ACT == 0 || ACT == 1, "EpiBf16: ACT is 0 (none) or 1 (gelu_pk)");
    bf16_t* O; int ldc; const float* bias; int split_cols; size_t split_stride; float scale0;
    __device__ __forceinline__ void operator()(const f32x4 (&acc)[2][2][4][2], const Unit& u, int wr, int wc, int fr, int fq) const {
        const int row0 = u.pm * BM + wr * 64 + fr; int colt = u.pn * BM; bf16_t* base = O;
        float sc = 1.f; if (split_cols) { const int t = colt / split_cols; base += (size_t)t * split_stride; colt -= t * split_cols; if (t == 0) sc = scale0; }
        const int col0 = colt + wc * 32 + 8 * fq, bcol0 = u.pn * BM + wc * 32 + 8 * fq;
        f32x4 bv[2][2];
#pragma unroll
        for (int bj = 0; bj < 2; ++bj)
#pragma unroll
            for (int n = 0; n < 2; ++n) bv[bj][n] = bias ? *(const f32x4*)(bias + bcol0 + bj * HALF + 4 * n) : (f32x4){0.f, 0.f, 0.f, 0.f};
#pragma unroll
        for (int ai = 0; ai < 2; ++ai)
#pragma unroll
            for (int m = 0; m < 4; ++m) { bf16_t* rowp = base + (size_t)(row0 + ai * HALF + m * 16) * ldc + col0;
#pragma unroll
                for (int bj = 0; bj < 2; ++bj) { f32x4 v0 = acc[ai][bj][m][0] + bv[bj][0], v1 = acc[ai][bj][m][1] + bv[bj][1];
                    if (ACT == 1) { f32x2 a = gelu_pk((f32x2){v0[0], v0[1]}), b = gelu_pk((f32x2){v0[2], v0[3]}), c = gelu_pk((f32x2){v1[0], v1[1]}), d = gelu_pk((f32x2){v1[2], v1[3]});
                        v0 = (f32x4){a.x, a.y, b.x, b.y}; v1 = (f32x4){c.x, c.y, d.x, d.y}; }
                    v0 = v0 * sc; v1 = v1 * sc; u32x4 w; w.x = cvt_pk_bf16(v0[0], v0[1]); w.y = cvt_pk_bf16(v0[2], v0[3]); w.z = cvt_pk_bf16(v1[0], v1[1]); w.w = cvt_pk_bf16(v1[2], v1[3]);
                    *(u32x4*)(rowp + bj * HALF) = w; } }
    }
};

struct EpiOut {
    static constexpr bool PERM = true, AFTER_DRAIN = false;
    const float* X; bf16_t* HB; const float* mod; float* ssqp;
    __device__ __forceinline__ void operator()(const f32x4 (&acc)[2][2][4][2], const Unit& u, int wr, int wc, int fr, int fq) const {
        const int row0 = u.pm * BM + wr * 64 + fr, col0 = u.pn * BM + wc * 32 + 8 * fq;
        const int b = (u.pm * BM) >> 13;
        const float* mb = mod + b * 6144;
        f32x4 g1v[2][2];
#pragma unroll
        for (int bj = 0; bj < 2; ++bj)
#pragma unroll
            for (int n = 0; n < 2; ++n) g1v[bj][n] = *(const f32x4*)(mb + 2048 + col0 + bj * HALF + 4 * n);
#pragma unroll
        for (int ai = 0; ai < 2; ++ai)
#pragma unroll
            for (int m = 0; m < 4; ++m) { const int row = row0 + ai * HALF + m * 16; const size_t ro = (size_t)row * 1024 + col0; float ss = 0.f;
#pragma unroll
                for (int bj = 0; bj < 2; ++bj) {
                    const f32x4 x0 = *(const f32x4*)(X + ro + bj * HALF), x1 = *(const f32x4*)(X + ro + bj * HALF + 4);
                    const f32x4 h0 = x0 + g1v[bj][0] * acc[ai][bj][m][0], h1 = x1 + g1v[bj][1] * acc[ai][bj][m][1];
                    u32x4 hw; hw.x = cvt_pk_bf16(h0[0], h0[1]); hw.y = cvt_pk_bf16(h0[2], h0[3]); hw.z = cvt_pk_bf16(h1[0], h1[1]); hw.w = cvt_pk_bf16(h1[2], h1[3]);
                    *(u32x4*)(HB + ro + bj * HALF) = hw;
                    ss += h0[0] * h0[0] + h0[1] * h0[1] + h0[2] * h0[2] + h0[3] * h0[3] + h1[0] * h1[0] + h1[1] * h1[1] + h1[2] * h1[2] + h1[3] * h1[3]; }
                ss += __shfl_xor(ss, 16); ss += __shfl_xor(ss, 32);
                if (fq == 0) ssqp[((size_t)u.pn * 32768 + row) * 4 + wc] = ss; }
    }
};
struct EpiScore {
    static constexpr bool PERM = false, AFTER_DRAIN = false;
    float* S; const float* ssqp; const float* biasq; float* rstd_out;
    __device__ __forceinline__ void operator()(const f32x4 (&acc)[2][2][4][2], const Unit& u, int wr, int wc, int fr, int fq) const {
        const int row0 = u.pm * BM + wr * 64 + fr, col0 = u.pn * BM + wc * 32 + 4 * fq;
        const int b = (u.pm * BM) >> 13;
        f32x4 bv[2][2];
#pragma unroll
        for (int bj = 0; bj < 2; ++bj)
#pragma unroll
            for (int n = 0; n < 2; ++n) bv[bj][n] = *(const f32x4*)(biasq + b * 2048 + col0 + bj * HALF + n * 16);
#pragma unroll
        for (int ai = 0; ai < 2; ++ai)
#pragma unroll
            for (int m = 0; m < 4; ++m) { const int row = row0 + ai * HALF + m * 16;
                const f32x4 p0 = *(const f32x4*)(ssqp + (size_t)row * 4), p1 = *(const f32x4*)(ssqp + ((size_t)32768 + row) * 4), p2 = *(const f32x4*)(ssqp + ((size_t)65536 + row) * 4), p3 = *(const f32x4*)(ssqp + ((size_t)98304 + row) * 4);
                const float tot = (p0[0] + p0[1] + p0[2] + p0[3]) + (p1[0] + p1[1] + p1[2] + p1[3]) + (p2[0] + p2[1] + p2[2] + p2[3]) + (p3[0] + p3[1] + p3[2] + p3[3]);
                const float rstd = __builtin_amdgcn_rsqf(tot * (1.0f / 1024.0f) + 1e-6f);
                if (u.pn == 0 && wc == 0 && fq == 0) rstd_out[row] = rstd;
                float* rowp = S + (size_t)row * 2048 + col0;
#pragma unroll
                for (int bj = 0; bj < 2; ++bj)
#pragma unroll
                    for (int n = 0; n < 2; ++n) *(f32x4*)(rowp + bj * HALF + n * 16) = acc[ai][bj][m][n] * rstd + bv[bj][n]; }
    }
};

struct EpiProj {
    static constexpr bool PERM = true, AFTER_DRAIN = false;
    bf16_t* O; int ldc;
    __device__ __forceinline__ void operator()(const f32x4 (&acc)[2][2][4][2], const Unit& u, int wr, int wc, int fr, int fq) const {
        asm volatile("" : "+v"(fr), "+v"(fq));
        const int row0 = u.pm * BM + wr * 64 + fr, col0 = u.pn * BM + wc * 32 + 8 * fq;
        const int cls = u.pn >> 1;
        const bool ident = (cls == 3) || (cls == 5), mulx = (cls == 0) || (cls == 4);
        const float sgn = (cls == 1 || cls == 2) ? 1.4426950408889634f : -1.4426950408889634f;
#pragma unroll
        for (int ai = 0; ai < 2; ++ai)
#pragma unroll
            for (int m = 0; m < 4; ++m) { bf16_t* rowp = O + (size_t)(row0 + ai * HALF + m * 16) * ldc + col0;
#pragma unroll
                for (int bj = 0; bj < 2; ++bj) { f32x4 v0 = acc[ai][bj][m][0], v1 = acc[ai][bj][m][1];
                    if (!ident) {
#pragma unroll
                        for (int j = 0; j < 4; ++j) { const float r0 = __builtin_amdgcn_rcpf(1.0f + __builtin_amdgcn_exp2f(sgn * v0[j])), r1 = __builtin_amdgcn_rcpf(1.0f + __builtin_amdgcn_exp2f(sgn * v1[j]));
                            v0[j] = mulx ? v0[j] * r0 : r0; v1[j] = mulx ? v1[j] * r1 : r1; } }
                    u32x4 w; w.x = cvt_pk_bf16(v0[0], v0[1]); w.y = cvt_pk_bf16(v0[2], v0[3]); w.z = cvt_pk_bf16(v1[0], v1[1]); w.w = cvt_pk_bf16(v1[2], v1[3]);
                    *(u32x4*)(rowp + bj * HALF) = w; } }
    }
};
template <class Epi, class Sched, bool ALIGN_EPI = false, bool SP2 = false>
__device__ __forceinline__ void gemm_phase(PG8_LAS unsigned char* lds, const Gemm g, const Sched& S, const Epi& E) {
    const int tid = threadIdx.x, wid = __builtin_amdgcn_readfirstlane(tid >> 6), lane = tid & 63, wr = wid >> 2, wc = wid & 3, fr = lane & 15, fq = lane >> 4;
    const int K = g.K, nt = K / BK;
    unsigned voffA[2], voffB[2];
#pragma unroll
    for (int i = 0; i < 2; ++i) { int R, C; stage_rc(tid * 16 + i * 8192, R, C); const int Rb = Epi::PERM ? ((R & ~31) + perm32(R & 31)) : R;
        voffA[i] = (unsigned)(R * K + C) * 2u; voffB[i] = (unsigned)(Rb * K + C) * 2u; }
    const size_t kstep = (size_t)(BK * 2);
    const size_t hstep = (size_t)HALF * K * 2;
    const size_t tstep = 2 * hstep;
    const unsigned ldsw = (unsigned)wid * 1024u;
    const int aoff = lds_byte(wr * 64 + fr, fq * 8), boff = lds_byte(wc * 32 + fr, fq * 8);
#define PG8_SA(b, h) (((b) * 2 + (h)) * HTB)
#define PG8_SB(b, h) ((4 + (b) * 2 + (h)) * HTB)
#define PG8_STAGE(bufoff, gbase, voff) do { _Pragma("unroll") for (int _i = 0; _i < 2; ++_i) \
        __builtin_amdgcn_global_load_lds((const unsigned*)((const char*)(gbase) + (voff)[_i]), (PG8_LAS unsigned*)(lds + (bufoff) + ldsw + _i * 8192), 16, 0, 0); } while (0)
#define PG8_LDA(dst, b, h) do { _Pragma("unroll") for (int m = 0; m < 4; ++m) _Pragma("unroll") for (int k = 0; k < 2; ++k) dst[m][k] = *(const PG8_LAS bf16x8*)(lds + PG8_SA(b, h) + aoff + m * 2048 + k * 1024); } while (0)
#define PG8_LDB(dst, b, h) do { _Pragma("unroll") for (int n = 0; n < 2; ++n) _Pragma("unroll") for (int k = 0; k < 2; ++k) dst[n][k] = *(const PG8_LAS bf16x8*)(lds + PG8_SB(b, h) + boff + n * 2048 + k * 1024); } while (0)
#define PG8_MMA(ai, bj, At, Bt) do { __builtin_amdgcn_s_setprio(1); _Pragma("unroll") for (int m = 0; m < 4; ++m) _Pragma("unroll") for (int n = 0; n < 2; ++n) _Pragma("unroll") for (int k = 0; k < 2; ++k) \
        acc[ai][bj][m][n] = __builtin_amdgcn_mfma_f32_16x16x32_bf16(Bt[n][k], At[m][k], acc[ai][bj][m][n], 0, 0, 0); __builtin_amdgcn_s_setprio(0); } while (0)
#define PG8_WAIT_V(n) asm volatile("s_waitcnt vmcnt(" #n ")" ::: "memory")
#define PG8_WAIT_L(n) asm volatile("s_waitcnt lgkmcnt(" #n ")" ::: "memory")
#define PG8_BAR __builtin_amdgcn_s_barrier()
#define PG8_SCHED __builtin_amdgcn_sched_barrier(0)
    Unit cur, nxt; int ui = 0;
    if (!S.next(0, cur)) return;
    f32x4 acc[2][2][4][2];
#pragma unroll
    for (int a = 0; a < 2; ++a)
#pragma unroll
        for (int b = 0; b < 2; ++b)
#pragma unroll
            for (int m = 0; m < 4; ++m)
#pragma unroll
                for (int n = 0; n < 2; ++n) acc[a][b][m][n] = (f32x4){0.f, 0.f, 0.f, 0.f};
    bf16x8 At[4][2], B0[2][2], B1[2][2];
    const char* cA = (const char*)g.A + (size_t)cur.pm * tstep; const char* cB = (const char*)g.Bt + (size_t)cur.pn * tstep + (size_t)(cur.pm >> 5) * g.bbatch;
    S.a_ready(cur);
    if constexpr (SP2) {
        PG8_STAGE(PG8_SB(0, 0), cB, voffB); PG8_STAGE(PG8_SB(0, 1), cB + hstep, voffB); PG8_STAGE(PG8_SA(0, 0), cA, voffA); PG8_STAGE(PG8_SA(0, 1), cA + hstep, voffA);
        if (wr == 1) PG8_BAR;
        PG8_WAIT_V(2); PG8_BAR;
        PG8_STAGE(PG8_SB(1, 0), cB + kstep, voffB); PG8_STAGE(PG8_SA(1, 0), cA + kstep, voffA); PG8_STAGE(PG8_SB(1, 1), cB + hstep + kstep, voffB);
        PG8_WAIT_V(6); PG8_BAR;
    } else {
        PG8_STAGE(PG8_SB(0, 0), cB, voffB); PG8_STAGE(PG8_SA(0, 0), cA, voffA); PG8_STAGE(PG8_SB(0, 1), cB + hstep, voffB); PG8_STAGE(PG8_SA(0, 1), cA + hstep, voffA);
        if (wr == 1) PG8_BAR;
        PG8_WAIT_V(4); PG8_BAR;
        PG8_STAGE(PG8_SB(1, 0), cB + kstep, voffB); PG8_STAGE(PG8_SA(1, 0), cA + kstep, voffA); PG8_STAGE(PG8_SB(1, 1), cB + hstep + kstep, voffB);
        PG8_WAIT_V(6); PG8_BAR;
    }
    for (;;) {
        const bool has_next = S.next(ui + 1, nxt);
        const char* nA = has_next ? (const char*)g.A + (size_t)nxt.pm * tstep : cA; const char* nB = has_next ? (const char*)g.Bt + (size_t)nxt.pn * tstep + (size_t)(nxt.pm >> 5) * g.bbatch : cB;
        for (int t = 0; t < nt; t += 2) {
            const bool last = (t == nt - 2);
            const char* a1 = cA + (size_t)(t + 1) * kstep;
            const char* a2 = last ? nA : cA + (size_t)(t + 2) * kstep; const char* b2 = last ? nB : cB + (size_t)(t + 2) * kstep;
            const char* a3 = a2 + kstep; const char* b3 = b2 + kstep;
            if (last && has_next) S.a_ready(nxt);
            if constexpr (SP2) {
            PG8_LDB(B0, 0, 0); PG8_LDB(B1, 0, 1); PG8_SCHED; PG8_LDA(At, 0, 0); PG8_STAGE(PG8_SA(1, 1), a1 + hstep, voffA);
            PG8_WAIT_V(8); PG8_WAIT_L(0); PG8_BAR; PG8_MMA(0, 0, At, B0); PG8_MMA(0, 1, At, B1); PG8_BAR; PG8_SCHED;
            PG8_LDA(At, 0, 1); PG8_STAGE(PG8_SB(0, 0), b2, voffB); PG8_STAGE(PG8_SB(0, 1), b2 + hstep, voffB); PG8_STAGE(PG8_SA(0, 0), a2, voffA);
            PG8_WAIT_V(8); PG8_WAIT_L(0); PG8_BAR; PG8_MMA(1, 0, At, B0); PG8_MMA(1, 1, At, B1); PG8_BAR; PG8_SCHED;
            PG8_LDB(B0, 1, 0); PG8_LDB(B1, 1, 1); PG8_SCHED; PG8_LDA(At, 1, 0); PG8_STAGE(PG8_SA(0, 1), a2 + hstep, voffA);
            PG8_WAIT_V(8); PG8_WAIT_L(0); PG8_BAR; PG8_MMA(0, 0, At, B0); PG8_MMA(0, 1, At, B1); PG8_BAR; PG8_SCHED;
            PG8_LDA(At, 1, 1); PG8_STAGE(PG8_SB(1, 0), b3, voffB); PG8_STAGE(PG8_SB(1, 1), b3 + hstep, voffB); PG8_STAGE(PG8_SA(1, 0), a3, voffA);
            PG8_WAIT_V(8); PG8_WAIT_L(0); PG8_BAR; PG8_MMA(1, 0, At, B0); PG8_MMA(1, 1, At, B1); PG8_BAR; PG8_SCHED;
            } else {
            PG8_LDB(B0, 0, 0); PG8_SCHED; PG8_LDA(At, 0, 0); PG8_STAGE(PG8_SA(1, 1), a1 + hstep, voffA);
            PG8_WAIT_L(8); PG8_BAR; PG8_WAIT_L(0); PG8_MMA(0, 0, At, B0); PG8_BAR; PG8_SCHED;
            PG8_LDB(B1, 0, 1); PG8_STAGE(PG8_SB(0, 0), b2, voffB);
            PG8_BAR; PG8_WAIT_L(0); PG8_MMA(0, 1, At, B1); PG8_BAR;
            PG8_LDA(At, 0, 1); PG8_STAGE(PG8_SA(0, 0), a2, voffA);
            PG8_BAR; PG8_WAIT_L(0); PG8_MMA(1, 0, At, B0); PG8_BAR; PG8_SCHED;
            PG8_STAGE(PG8_SB(0, 1), b2 + hstep, voffB);
            PG8_WAIT_V(6); PG8_BAR; PG8_MMA(1, 1, At, B1); PG8_BAR;
            PG8_LDB(B0, 1, 0); PG8_SCHED; PG8_LDA(At, 1, 0); PG8_STAGE(PG8_SA(0, 1), a2 + hstep, voffA);
            PG8_WAIT_L(8); PG8_BAR; PG8_WAIT_L(0); PG8_MMA(0, 0, At, B0); PG8_BAR; PG8_SCHED;
            PG8_LDB(B1, 1, 1); PG8_STAGE(PG8_SB(1, 0), b3, voffB);
            PG8_BAR; PG8_WAIT_L(0); PG8_MMA(0, 1, At, B1); PG8_BAR;
            PG8_LDA(At, 1, 1); PG8_STAGE(PG8_SA(1, 0), a3, voffA);
            PG8_BAR; PG8_WAIT_L(0); PG8_MMA(1, 0, At, B0); PG8_BAR; PG8_SCHED;
            PG8_STAGE(PG8_SB(1, 1), b3 + hstep, voffB);
            PG8_WAIT_V(6); PG8_BAR; PG8_MMA(1, 1, At, B1); PG8_BAR;
            }
        }
        if constexpr (ALIGN_EPI) { if (wr == 0) PG8_BAR; }
        if constexpr (!Epi::AFTER_DRAIN) { E(acc, cur, wr, wc, fr, fq); S.done(cur); }
        if (!has_next) break;
#pragma unroll
        for (int a = 0; a < 2; ++a)
#pragma unroll
            for (int b = 0; b < 2; ++b)
#pragma unroll
                for (int m = 0; m < 4; ++m)
#pragma unroll
                    for (int n = 0; n < 2; ++n) acc[a][b][m][n] = (f32x4){0.f, 0.f, 0.f, 0.f};
        cur = nxt; cA = nA; cB = nB; ++ui;
        if constexpr (ALIGN_EPI) { if (wr == 1) PG8_BAR; }
    }
    PG8_WAIT_V(0);
    if constexpr (!ALIGN_EPI) { if (wr == 0) PG8_BAR; }
    PG8_BAR;
    if constexpr (Epi::AFTER_DRAIN) { E.fused(acc, cur, wr, wc, fr, fq, lds, wid, lane); S.done(cur); }
#undef PG8_SA
#undef PG8_SB
#undef PG8_STAGE
#undef PG8_LDA
#undef PG8_LDB
#undef PG8_MMA
#undef PG8_WAIT_V
#undef PG8_WAIT_L
#undef PG8_BAR
#undef PG8_SCHED
}
}
#define MK_ONE_LAUNCH 1

constexpr int NB = 4, SEQ = 8192, T = NB * SEQ, D = 1024;
constexpr int NIN = 3584, DH = 512, HD = 128, NHH = 4, CHK = 64;
constexpr int NSEG = 16, SEGC = 8;
constexpr int CW = 31, CPAD = 15, DC = 512;
constexpr int PHEADS = 8, NQK = 2048, NSEL = 128;
constexpr float EPS = 1e-6f;
constexpr int NWAVES = 8, NTHR = 512;

constexpr size_t MiB = 1u << 20;
constexpr size_t WS_CTL = 0, CTL_ZERO_BYTES = 65536;
constexpr size_t WS_MOD = 1 * MiB, WS_FMOD = WS_MOD + 131072, WS_LB = WS_MOD + 196608, WS_BIASQ = WS_MOD + 262144;
constexpr size_t WS_WIN = 2 * MiB, WS_WOUT = 10 * MiB, WS_WQK = 12 * MiB;
constexpr size_t WS_UT = 16 * MiB, WS_WQKB = 24 * MiB, WS_VT = 48 * MiB;
constexpr size_t WS_BUFA = 80 * MiB;
constexpr size_t WS_BUFB = 144 * MiB;
constexpr size_t WS_SEG = 208 * MiB;
constexpr size_t WS_E = 208 * MiB, WS_W = 224 * MiB;
constexpr size_t WS_BIG = 240 * MiB;
constexpr size_t WS_SSQ = 496 * MiB;
constexpr size_t WS_SEGA = 498 * MiB;
constexpr size_t WS_RSTD = 499 * MiB;
constexpr size_t WS_END = 500 * MiB;
constexpr size_t WS_PACT = 240 * MiB;
constexpr size_t WS_Y = 368 * MiB;
constexpr int NSL = 8, CSL = 128;
constexpr float VSCALE = 16.0f;
constexpr float UQSCALE = 95.5f;
constexpr int NSLU = 4, CSLU = 256;
constexpr int CW_QU = 8192, CW_QV = 8192 + 64 * 16;
constexpr int CW_H1 = 6144;
constexpr int CW_BAR = 1024;

#ifndef LDSFILL
#define LDSFILL 0u
#endif
constexpr int LDS_BYTES = 155648;
constexpr int MISC_OFF = LDS_BYTES - 256;

#define GAS __attribute__((address_space(1)))
#define LAS __attribute__((address_space(3)))
typedef unsigned short bf16;
typedef unsigned v4u __attribute__((ext_vector_type(4)));
typedef unsigned v2u __attribute__((ext_vector_type(2)));
typedef float f32x4 __attribute__((ext_vector_type(4)));
typedef float f32x16 __attribute__((ext_vector_type(16)));
typedef short bf16x8 __attribute__((ext_vector_type(8)));
typedef float f32x2_ __attribute__((ext_vector_type(2)));

__device__ __forceinline__ float bf2f(unsigned h) { return __builtin_bit_cast(float, h << 16); }
__device__ __forceinline__ float bflo(unsigned u) { return __builtin_bit_cast(float, u << 16); }
__device__ __forceinline__ float bfhi(unsigned u) { return __builtin_bit_cast(float, u & 0xffff0000u); }
__device__ __forceinline__ unsigned f2bf(float f) { unsigned u = __builtin_bit_cast(unsigned, f); return (u + 0x7fffu + ((u >> 16) & 1u)) >> 16; }
__device__ __forceinline__ unsigned pk2(float lo, float hi) { return f2bf(lo) | (f2bf(hi) << 16); }
__device__ __forceinline__ unsigned cvtpk(float lo, float hi) { unsigned r; asm("v_cvt_pk_bf16_f32 %0, %1, %2" : "=v"(r) : "v"(lo), "v"(hi)); return r; }
__device__ __forceinline__ float sigmoidf_(float x) { return __builtin_amdgcn_rcpf(1.0f + __expf(-x)); }
#define DPP_ADD(s, ctrl) ((s) + __builtin_bit_cast(float, __builtin_amdgcn_update_dpp(0, __builtin_bit_cast(int, (s)), (ctrl), 0xF, 0xF, false)))
__device__ __forceinline__ float wave_sum(float v) {
#pragma unroll
    for (int o = 1; o < 64; o <<= 1) v += __shfl_xor(v, o);
    return v;
}

#define XB_TMO      128
#define XB_XCNT(j)  (256  + 64 * (j))
#define XB_XSUB(j)  (1280 + 64 * (j))
#define XB_XGEN(j)  (2304 + 64 * (j))
#define XB_TOP      3328
#define XB_TOPGEN   3392
#define XCD_BAR_WORDS 3456
#define XB_SPIN_CAP (1u << 18)
__device__ __forceinline__ unsigned xb_ld(unsigned* p)              { return __hip_atomic_load(p, __ATOMIC_RELAXED, __HIP_MEMORY_SCOPE_AGENT); }
__device__ __forceinline__ unsigned xb_add(unsigned* p, unsigned v) { return __hip_atomic_fetch_add(p, v, __ATOMIC_RELAXED, __HIP_MEMORY_SCOPE_AGENT); }
__device__ __forceinline__ unsigned xb_xcc_id() { return (unsigned)__builtin_amdgcn_s_getreg((3 << 11) | 20) & 0xFu; }
#define XB_SPIN(cond, bar) do { unsigned _sp = 0; while (cond) { __builtin_amdgcn_s_sleep(1); \
    if ((++_sp & 255u) == 0u) { if (xb_ld(&(bar)[XB_TMO])) break; if (_sp > XB_SPIN_CAP) { atomicAdd(&(bar)[XB_TMO], 1u); break; } } } } while (0)
struct XcdBarrier { unsigned* bar; unsigned x; volatile LAS unsigned* st; };
__device__ __forceinline__ XcdBarrier xcd_barrier_post(unsigned* bar, volatile LAS unsigned* st) {
    XcdBarrier b; b.bar = bar; b.x = xb_xcc_id(); b.st = st;
    if (threadIdx.x == 0) (void)xb_add(&bar[XB_XCNT(b.x)], 1u);
    return b;
}
__device__ __forceinline__ void xcd_barrier_complete(unsigned* bar, unsigned x, unsigned& nloc, unsigned& nx) {
    const unsigned G = gridDim.x * gridDim.y * gridDim.z;
    unsigned sum, cnt, mine, sp = 0u;
    for (;;) {
        sum = 0u; cnt = 0u; mine = 0u;
#pragma unroll
        for (unsigned j = 0; j < 16; ++j) { const unsigned c = xb_ld(&bar[XB_XCNT(j)]); sum += c; cnt += (c > 0u) ? 1u : 0u; mine = (j == x) ? c : mine; }
        if (sum == G) break;
        __builtin_amdgcn_s_sleep(1);
        if ((++sp & 255u) == 0u) { if (xb_ld(&bar[XB_TMO])) break; if (sp > XB_SPIN_CAP) { atomicAdd(&bar[XB_TMO], 1u); break; } }
    }
    nloc = mine > 0u ? mine : 1u; nx = cnt > 0u ? cnt : 1u;
}
__device__ __forceinline__ void xcd_barrier(const XcdBarrier& b) {
    asm volatile("s_waitcnt vmcnt(0)" ::: "memory");
    __syncthreads();
    if (threadIdx.x == 0) {
        unsigned* bar = b.bar;
        __builtin_amdgcn_s_waitcnt(0);
        unsigned nloc = b.st[0], nx = b.st[1];
        if (nloc == 0u) { xcd_barrier_complete(bar, b.x, nloc, nx); b.st[0] = nloc; b.st[1] = nx; }
        const unsigned old = xb_add(&bar[XB_XSUB(b.x)], 1u);
        const unsigned gen = old / nloc;
        if (old + 1u == (gen + 1u) * nloc) {
            __builtin_amdgcn_fence(__ATOMIC_RELEASE, "agent");
            asm volatile("s_waitcnt vmcnt(0)" ::: "memory");
            const unsigned og = xb_add(&bar[XB_TOP], 1u);
            const unsigned tg = og / nx;
            if (og + 1u == (tg + 1u) * nx) xb_add(&bar[XB_TOPGEN], 1u);
            else XB_SPIN(xb_ld(&bar[XB_TOPGEN]) == tg, bar);
            __builtin_amdgcn_fence(__ATOMIC_ACQUIRE, "agent");
            xb_add(&bar[XB_XGEN(b.x)], 1u);
            asm volatile("s_waitcnt vmcnt(0)" ::: "memory");
        } else {
            XB_SPIN(xb_ld(&bar[XB_XGEN(b.x)]) == gen, bar);
            __builtin_amdgcn_fence(__ATOMIC_ACQUIRE, "agent");
            asm volatile("s_waitcnt vmcnt(0)" ::: "memory");
        }
    }
    __syncthreads();
}

struct Args { const float* in[23]; float* out; unsigned char* ws; int ph_lo, ph_hi; };
struct Frame {
    LAS unsigned char* lds;
    int tid, lane, wave, G, bid;
    const Args* a;
    __device__ __forceinline__ const float* x() const { return a->in[0]; }
    __device__ __forceinline__ const float* c() const { return a->in[1]; }
    __device__ __forceinline__ const float* ada_w() const { return a->in[2]; }
    __device__ __forceinline__ const float* ada_b() const { return a->in[3]; }
    __device__ __forceinline__ const float* g_mix() const { return a->in[4]; }
    __device__ __forceinline__ const float* w_in() const { return a->in[5]; }
    __device__ __forceinline__ const float* lbg_f() const { return a->in[6]; }
    __device__ __forceinline__ const float* lbg_b() const { return a->in[7]; }
    __device__ __forceinline__ const float* hnorm_g() const { return a->in[8]; }
    __device__ __forceinline__ const float* conv_w() const { return a->in[9]; }
    __device__ __forceinline__ const float* conv_b() const { return a->in[10]; }
    __device__ __forceinline__ const float* cln_g() const { return a->in[11]; }
    __device__ __forceinline__ const float* cln_b() const { return a->in[12]; }
    __device__ __forceinline__ const float* w_out() const { return a->in[13]; }
    __device__ __forceinline__ const float* g_ffn() const { return a->in[14]; }
    __device__ __forceinline__ const float* wq() const { return a->in[15]; }
    __device__ __forceinline__ const float* keys1() const { return a->in[16]; }
    __device__ __forceinline__ const float* keys2() const { return a->in[17]; }
    __device__ __forceinline__ const float* utab() const { return a->in[18]; }
    __device__ __forceinline__ const float* vtab() const { return a->in[19]; }
    __device__ __forceinline__ const float* fada_w() const { return a->in[20]; }
    __device__ __forceinline__ const float* fada_b() const { return a->in[21]; }
    __device__ __forceinline__ const float* fnorm_g() const { return a->in[22]; }
    __device__ __forceinline__ float* out() const { return a->out; }
    __device__ __forceinline__ float* mod() const { return (float*)(a->ws + WS_MOD); }
    __device__ __forceinline__ float* fmod() const { return (float*)(a->ws + WS_FMOD); }
    __device__ __forceinline__ float* lb() const { return (float*)(a->ws + WS_LB); }
    __device__ __forceinline__ float* biasq() const { return (float*)(a->ws + WS_BIASQ); }
    __device__ __forceinline__ float* ssqp() const { return (float*)(a->ws + WS_SSQ); }
    __device__ __forceinline__ float* sega() const { return (float*)(a->ws + WS_SEGA); }
    __device__ __forceinline__ float* segu() const { return (float*)(a->ws + WS_SEG); }
    __device__ __forceinline__ float* of() const { return (float*)(a->ws + WS_BUFB); }
    __device__ __forceinline__ float* scores() const { return (float*)(a->ws + WS_BIG); }
    __device__ __forceinline__ float* wsel() const { return (float*)(a->ws + WS_W); }
    __device__ __forceinline__ int* esel() const { return (int*)(a->ws + WS_E); }
    __device__ __forceinline__ bf16* Win_t() const { return (bf16*)(a->ws + WS_WIN); }
    __device__ __forceinline__ bf16* Wout_t() const { return (bf16*)(a->ws + WS_WOUT); }
    __device__ __forceinline__ bf16* Wqk_t() const { return (bf16*)(a->ws + WS_WQK); }
    __device__ __forceinline__ bf16* Wqk_b() const { return (bf16*)(a->ws + WS_WQKB); }
    __device__ __forceinline__ bf16* Ub() const { return (bf16*)(a->ws + WS_UT); }
    __device__ __forceinline__ bf16* Vb() const { return (bf16*)(a->ws + WS_VT); }
    __device__ __forceinline__ bf16* bufA() const { return (bf16*)(a->ws + WS_BUFA); }
    __device__ __forceinline__ bf16* hg() const { return (bf16*)(a->ws + WS_BUFB); }
    __device__ __forceinline__ bf16* proj() const { return (bf16*)(a->ws + WS_BIG); }
    __device__ __forceinline__ float* coef() const { return (float*)(a->ws + WS_BUFA); }
    __device__ __forceinline__ float* rstd() const { return (float*)(a->ws + WS_RSTD); }
    __device__ __forceinline__ bf16* pact() const { return (bf16*)(a->ws + WS_PACT); }
    __device__ __forceinline__ bf16* ybuf() const { return (bf16*)(a->ws + WS_Y); }
    __device__ __forceinline__ unsigned char* U8() const { return (unsigned char*)(a->ws + WS_UT); }
    __device__ __forceinline__ unsigned char* V8() const { return (unsigned char*)(a->ws + WS_VT); }
    __device__ __forceinline__ unsigned* ctl() const { return (unsigned*)(a->ws + WS_CTL); }
};

__device__ __forceinline__ void p0_gemv(Frame& F) {
    LAS float* cact = (LAS float*)(F.lds);
    LAS float* red = (LAS float*)(F.lds + 16384);
    for (int i = F.tid; i < 4096; i += NTHR) { const float c = F.c()[i]; cact[i] = c * sigmoidf_(c); }
    __syncthreads();
    for (int item = F.bid; item < 128; item += F.G) {
        const int col0 = item * 64; const float* W; int N, cc;
        if (col0 < 6144) { W = F.ada_w(); N = 6144; cc = col0; } else { W = F.fada_w(); N = 2048; cc = col0 - 6144; }
        const float* wp = W + (size_t)(F.wave * 128) * N + cc + F.lane;
        float a0 = 0.f, a1 = 0.f, a2 = 0.f, a3 = 0.f;
#pragma unroll 32
        for (int k = 0; k < 128; ++k) { const float w = wp[(size_t)k * N]; const int kk = F.wave * 128 + k;
            a0 += cact[kk] * w; a1 += cact[1024 + kk] * w; a2 += cact[2048 + kk] * w; a3 += cact[3072 + kk] * w; }
        red[(F.wave * 4 + 0) * 64 + F.lane] = a0; red[(F.wave * 4 + 1) * 64 + F.lane] = a1; red[(F.wave * 4 + 2) * 64 + F.lane] = a2; red[(F.wave * 4 + 3) * 64 + F.lane] = a3;
        __syncthreads();
        if (F.tid < 256) { const int b = F.tid >> 6, l = F.tid & 63; float s = 0.f;
#pragma unroll
            for (int w = 0; w < 8; ++w) s += red[(w * 4 + b) * 64 + l];
            if (col0 < 6144) F.mod()[b * 6144 + cc + l] = s + F.ada_b()[cc + l]; else F.fmod()[b * 2048 + cc + l] = s + F.fada_b()[cc + l]; }
        __syncthreads();
    }
}
__device__ __forceinline__ void p0_transpose_item(const float* W, int K, int N, bf16* WT, LAS float* scr, int item, int lane) {
    const int nblk = N / 32, kb = item / nblk, nb = item % nblk, k0 = 64 * kb, n0 = 32 * nb;
#pragma unroll
    for (int i = 0; i < 32; ++i) { const int kk = 2 * i + (lane >> 5); scr[kk * 33 + (lane & 31)] = W[(size_t)(k0 + kk) * N + n0 + (lane & 31)]; }
    asm volatile("s_waitcnt lgkmcnt(0)" ::: "memory");
    const int c = lane & 7;
#pragma unroll
    for (int j = 0; j < 4; ++j) { const int n = (lane >> 3) + 8 * j; const LAS float* s = scr + (8 * c) * 33 + n;
        v4u o; o.x = pk2(s[0 * 33], s[1 * 33]); o.y = pk2(s[2 * 33], s[3 * 33]); o.z = pk2(s[4 * 33], s[5 * 33]); o.w = pk2(s[6 * 33], s[7 * 33]);
        *(v4u*)(WT + (size_t)(n0 + n) * K + k0 + 8 * c) = o; }
    asm volatile("s_waitcnt lgkmcnt(0)" ::: "memory");
}
__device__ __forceinline__ void p0_wqk_item(Frame& F, int item, LAS float* scr) {
    const int jq = item & 7, kb = (item >> 3) & 15, hh = item >> 7, h = hh >> 1, half = hh & 1;
    const float* keys = (half ? F.keys2() : F.keys1()) + (size_t)(jq * 16) * 128;
    const float* wtile = F.wq() + (size_t)(kb * 64) * 2048 + h * 256 + half * 128;
    LAS float* kL = scr + 1280;
    { f32x4 k4[8];
#pragma unroll
      for (int i = 0; i < 8; ++i) k4[i] = *(const f32x4*)(keys + (i * 64 + F.lane) * 4);
#pragma unroll
      for (int i = 0; i < 8; ++i) *(LAS f32x4*)(kL + (i * 64 + F.lane) * 4) = k4[i]; }
    float acc[16];
#pragma unroll
    for (int j = 0; j < 16; ++j) acc[j] = 0.f;
    f32x4 t4[4], n4[4];
#pragma unroll
    for (int i = 0; i < 4; ++i) t4[i] = *(const f32x4*)(wtile + (size_t)(16 * i + (F.lane >> 2)) * 2048 + 4 * (F.lane & 3));
    for (int d0 = 0; d0 < 128; d0 += 16) {
        if (d0 + 16 < 128) {
#pragma unroll
            for (int i = 0; i < 4; ++i) n4[i] = *(const f32x4*)(wtile + (size_t)(16 * i + (F.lane >> 2)) * 2048 + d0 + 16 + 4 * (F.lane & 3)); }
#pragma unroll
        for (int i = 0; i < 4; ++i) *(LAS f32x4*)(scr + (16 * i + (F.lane >> 2)) * 20 + 4 * (F.lane & 3)) = t4[i];
        asm volatile("s_waitcnt lgkmcnt(0)" ::: "memory");
#pragma unroll
        for (int dd = 0; dd < 16; dd += 4) { const f32x4 a = *(LAS const f32x4*)(scr + F.lane * 20 + dd);
#pragma unroll
            for (int j = 0; j < 16; ++j) { const f32x4 kp = *(LAS const f32x4*)(kL + j * 128 + d0 + dd); acc[j] += a[0] * kp[0] + a[1] * kp[1] + a[2] * kp[2] + a[3] * kp[3]; } }
        asm volatile("s_waitcnt lgkmcnt(0)" ::: "memory");
#pragma unroll
        for (int i = 0; i < 4; ++i) t4[i] = n4[i];
    }
    bf16* o = F.Wqk_t() + (size_t)(h * 256 + half * 128 + jq * 16) * 1024 + kb * 64 + F.lane;
#pragma unroll
    for (int j = 0; j < 16; ++j) o[(size_t)j * 1024] = (bf16)f2bf(acc[j]);
}
__device__ __forceinline__ void p0_prologue(Frame& F) {
    if (F.bid < 128) p0_gemv(F);
    if (F.bid == 128 % F.G) { const int i = F.tid;
        F.lb()[i] = __builtin_amdgcn_rcpf(1.0f + __expf(F.lbg_f()[512 + i] - F.lbg_f()[i]));
        F.lb()[512 + i] = __builtin_amdgcn_rcpf(1.0f + __expf(F.lbg_b()[512 + i] - F.lbg_b()[i])); }
    LAS float* scr = (LAS float*)(F.lds + 32768 + F.wave * 14336);
    const int gw = F.wave * F.G + F.bid, NGW = F.G * NWAVES;
    constexpr int I_QK = 2048, I_IN = (D / 64) * (NIN / 32), I_OUT = (D / 64) * (D / 32), I_TAB = 2 * 16384 / 4;
    constexpr int NITEMS = I_QK + I_IN + I_OUT + I_TAB;
    for (int it = gw; it < NITEMS; it += NGW) {
        int r = it;
        if (r < I_QK) { p0_wqk_item(F, r, scr); continue; } r -= I_QK;
        if (r < I_IN) { p0_transpose_item(F.w_in(), D, NIN, F.Win_t(), scr, r, F.lane); continue; } r -= I_IN;
        if (r < I_OUT) { p0_transpose_item(F.w_out(), D, D, F.Wout_t(), scr, r, F.lane); continue; } r -= I_OUT;
        { const int tab = r >= 4096, rr = (tab ? r - 4096 : r) * 4; const float* src = (tab ? F.vtab() : F.utab()) + (size_t)rr * 1024; unsigned char* dst = tab ? F.V8() : F.U8();
          const float sc = tab ? VSCALE : UQSCALE;
#pragma unroll
          for (int q = 0; q < 16; ++q) { const int row = rr + (q >> 2), qq = q & 3; const f32x4 v = *(const f32x4*)(src + (q >> 2) * 1024 + qq * 256 + 4 * F.lane) * sc;
              int pk;
              if (tab) { pk = __builtin_amdgcn_cvt_pk_fp8_f32(v[0], v[1], 0, false); pk = __builtin_amdgcn_cvt_pk_fp8_f32(v[2], v[3], pk, true); }
              else { int q0 = (int)__builtin_rintf(v[0]), q1 = (int)__builtin_rintf(v[1]), q2 = (int)__builtin_rintf(v[2]), q3 = (int)__builtin_rintf(v[3]);
                  q0 = q0 < -7 ? -7 : (q0 > 7 ? 7 : q0); q1 = q1 < -7 ? -7 : (q1 > 7 ? 7 : q1); q2 = q2 < -7 ? -7 : (q2 > 7 ? 7 : q2); q3 = q3 < -7 ? -7 : (q3 > 7 ? 7 : q3);
                  *(unsigned short*)(dst + ((size_t)qq * 16384 + row) * 128 + 2 * F.lane) = (unsigned short)((q0 & 0xf) | ((q1 & 0xf) << 4) | ((q2 & 0xf) << 8) | ((q3 & 0xf) << 12)); continue; }
              const int sl = 2 * qq + (F.lane >> 5);
              *(int*)(dst + ((size_t)sl * 16384 + row) * CSL + 4 * (F.lane & 31)) = pk; } }
    }
}

__device__ __forceinline__ void p1_norm(Frame& F) {
    const int gwc = F.bid * NWAVES + F.wave, NGW = F.G * NWAVES;
    for (int row0 = gwc * 16; row0 < T; row0 += NGW * 16) {
        const int b = row0 >> 13; const float* mb = F.mod() + b * 6144;
        f32x4 ca[4], cb[4];
#pragma unroll
        for (int j = 0; j < 4; ++j) { const int k = 256 * j + 4 * F.lane; const f32x4 g = *(const f32x4*)(F.g_mix() + k), s = *(const f32x4*)(mb + 1024 + k); ca[j] = g * (s + 1.0f); cb[j] = *(const f32x4*)(mb + k); }
#pragma unroll 4
        for (int r = 0; r < 16; ++r) { const float* xr = F.x() + (size_t)(row0 + r) * D;
            f32x4 v[4]; float ss = 0.f;
#pragma unroll
            for (int j = 0; j < 4; ++j) { v[j] = *(const f32x4*)(xr + 256 * j + 4 * F.lane); ss += v[j][0] * v[j][0] + v[j][1] * v[j][1] + v[j][2] * v[j][2] + v[j][3] * v[j][3]; }
            const float rstd = __builtin_amdgcn_rsqf(wave_sum(ss) * (1.0f / D) + EPS);
            bf16* o = F.bufA() + (size_t)(row0 + r) * D;
#pragma unroll
            for (int j = 0; j < 4; ++j) { const f32x4 y = v[j] * rstd * ca[j] + cb[j]; v2u w; w.x = pk2(y[0], y[1]); w.y = pk2(y[2], y[3]); *(v2u*)(o + 256 * j + 4 * F.lane) = w; } }
    }
    for (int i = F.bid * NTHR + F.tid; i < NQK * (D / 8); i += F.G * NTHR) { const int n = i >> 7, k0 = (i & 127) * 8;
        const v4u w = *(const v4u*)(F.Wqk_t() + (size_t)n * D + k0);
        const f32x4 g0 = *(const f32x4*)(F.g_ffn() + k0), g1 = *(const f32x4*)(F.g_ffn() + k0 + 4);
        f32x4 wa, wb; wa[0] = bflo(w[0]) * g0[0]; wa[1] = bfhi(w[0]) * g0[1]; wa[2] = bflo(w[1]) * g0[2]; wa[3] = bfhi(w[1]) * g0[3]; wb[0] = bflo(w[2]) * g1[0]; wb[1] = bfhi(w[2]) * g1[1]; wb[2] = bflo(w[3]) * g1[2]; wb[3] = bfhi(w[3]) * g1[3];
#pragma unroll
        for (int b = 0; b < NB; ++b) { const float* sc = F.mod() + b * 6144 + 4096 + k0; const f32x4 s0 = *(const f32x4*)sc + 1.0f, s1 = *(const f32x4*)(sc + 4) + 1.0f;
            const f32x4 pa = wa * s0, pb = wb * s1;
            v4u o; o.x = cvtpk(pa[0], pa[1]); o.y = cvtpk(pa[2], pa[3]); o.z = cvtpk(pb[0], pb[1]); o.w = cvtpk(pb[2], pb[3]);
            *(v4u*)(F.Wqk_b() + ((size_t)b * NQK + n) * D + k0) = o; } }
    const int gw = F.wave * F.G + F.bid;
    for (int n0 = gw * 32; n0 < NQK; n0 += NGW * 32) {
        float sv[4][16];
#pragma unroll
        for (int b = 0; b < 4; ++b) { const float* sh2 = F.mod() + b * 6144 + 3072;
#pragma unroll
            for (int i = 0; i < 8; ++i) { sv[b][i] = sh2[8 * F.lane + i]; sv[b][8 + i] = sh2[512 + 8 * F.lane + i]; } }
        float res[4] = {0.f, 0.f, 0.f, 0.f};
        for (int q = 0; q < 32; ++q) { const int n = n0 + q;
            const v4u w0 = *(const v4u*)(F.Wqk_t() + (size_t)n * 1024 + 8 * F.lane), w1 = *(const v4u*)(F.Wqk_t() + (size_t)n * 1024 + 512 + 8 * F.lane);
            float wv[16];
#pragma unroll
            for (int i = 0; i < 4; ++i) { wv[2 * i] = bflo(w0[i]); wv[2 * i + 1] = bfhi(w0[i]); wv[8 + 2 * i] = bflo(w1[i]); wv[8 + 2 * i + 1] = bfhi(w1[i]); }
#pragma unroll
            for (int b = 0; b < 4; ++b) { float sm = 0.f;
#pragma unroll
                for (int i = 0; i < 16; ++i) sm += wv[i] * sv[b][i];
                sm = wave_sum(sm); if (F.lane == q) res[b] = sm; } }
        if (F.lane < 32) {
#pragma unroll
            for (int b = 0; b < 4; ++b) F.biasq()[b * 2048 + n0 + F.lane] = res[b]; }
    }
}

__device__ __forceinline__ void conv_item(Frame& F, int item, const float (&cw)[CW], float cbias) {
    LAS bf16* hbuf = (LAS bf16*)(F.lds);
    LAS float* ybuf = (LAS float*)(F.lds + 65536);
    const int tok0 = item * 32, b = tok0 >> 13, t0 = tok0 & (SEQ - 1), c = F.tid;
#pragma unroll
    for (int k = 0; k < 8; ++k) { const int pi = F.tid + NTHR * k; if (pi < 62 * 64) { const int r = pi >> 6, ch = pi & 63, t = t0 - CPAD + r; v4u o = {0u, 0u, 0u, 0u};
            if (t >= 0 && t < SEQ) { const bf16* pr = F.proj() + (size_t)(b * SEQ + t) * NIN + 8 * ch; const v4u a = *(const v4u*)(pr + 2560), g = *(const v4u*)(pr + 3072);
#pragma unroll
                for (int i = 0; i < 4; ++i) o[i] = cvtpk(bflo(a[i]) * bflo(g[i]), bfhi(a[i]) * bfhi(g[i])); }
            *(LAS v4u*)(hbuf + r * 512 + 8 * ch) = o; } }
    __syncthreads();
    f32x2_ hp[31];
#pragma unroll
    for (int m = 0; m < 31; ++m) hp[m] = (f32x2_){bf2f(hbuf[(2 * m) * 512 + c]), bf2f(hbuf[(2 * m + 1) * 512 + c])};
    f32x2_ ce[15], co[15];
#pragma unroll
    for (int m = 0; m < 15; ++m) { ce[m] = (f32x2_){cw[2 * m], cw[2 * m + 1]}; co[m] = (f32x2_){cw[2 * m + 1], cw[2 * m + 2]}; }
#pragma unroll
    for (int e = 0; e < 16; ++e) {
        { f32x2_ a = {cbias, 0.f};
#pragma unroll
          for (int m = 0; m < 15; ++m) a += ce[m] * hp[e + m];
          ybuf[(2 * e) * 512 + c] = (a[0] + a[1]) + cw[30] * hp[e + 15][0]; }
        { f32x2_ a = {cbias, 0.f};
#pragma unroll
          for (int m = 0; m < 15; ++m) a += co[m] * hp[e + m + 1];
          ybuf[(2 * e + 1) * 512 + c] = (a[0] + a[1]) + cw[0] * hp[e][1]; } }
    __syncthreads();
#pragma unroll
    for (int q = 0; q < 4; ++q) { const int tt = F.wave * 4 + q;
        const f32x4 y0 = *(LAS const f32x4*)(ybuf + tt * 512 + 8 * F.lane), y1 = *(LAS const f32x4*)(ybuf + tt * 512 + 8 * F.lane + 4);
        const float mean = wave_sum((y0[0] + y0[1] + y0[2] + y0[3]) + (y1[0] + y1[1] + y1[2] + y1[3])) * (1.0f / DC);
        const f32x4 d0 = y0 - mean, d1 = y1 - mean;
        const float var = wave_sum((d0[0] * d0[0] + d0[1] * d0[1] + d0[2] * d0[2] + d0[3] * d0[3]) + (d1[0] * d1[0] + d1[1] * d1[1] + d1[2] * d1[2] + d1[3] * d1[3])) * (1.0f / DC);
        const float rstd = __builtin_amdgcn_rsqf(var + EPS);
        const f32x4 g0 = *(const f32x4*)(F.cln_g() + 8 * F.lane), g1 = *(const f32x4*)(F.cln_g() + 8 * F.lane + 4), b0 = *(const f32x4*)(F.cln_b() + 8 * F.lane), b1 = *(const f32x4*)(F.cln_b() + 8 * F.lane + 4);
        f32x4 z0 = d0 * rstd * g0 + b0, z1 = d1 * rstd * g1 + b1;
#pragma unroll
        for (int i = 0; i < 4; ++i) { z0[i] = z0[i] * sigmoidf_(z0[i]); z1[i] = z1[i] * sigmoidf_(z1[i]); }
        v4u w; w.x = cvtpk(z0[0], z0[1]); w.y = cvtpk(z0[2], z0[3]); w.z = cvtpk(z1[0], z1[1]); w.w = cvtpk(z1[2], z1[3]);
        *(v4u*)(F.bufA() + (size_t)(tok0 + tt) * D + 512 + 8 * F.lane) = w; }
    __syncthreads();
}

constexpr int PQ = 272, PT = 144;
constexpr int HL_QR = 0, HL_KR = 17408, HL_QE = 34816, HL_KET = 52224, HL_VT = 70656, HL_SCM = 89088, HL_ST = 98304, HL_PBLK = 133120  , HL_AV = 137216, HL_RS = 137728;
static_assert(HL_PBLK + 8 * 128 * 4 <= HL_AV && HL_AV + 512 <= HL_RS && HL_RS + 1024 <= 155648 - 256, "HGRN LDS map");
__device__ __forceinline__ bf16x8 ldf(LAS const unsigned char* base, int row, int pitch, int kbyte) { return *(LAS const bf16x8*)(base + row * pitch + kbyte); }
#define MFMA32(a, b, c) __builtin_amdgcn_mfma_f32_32x32x16_bf16((a), (b), (c), 0, 0, 0)

template <bool FULL>
__device__ __forceinline__ void hgrn_load(Frame& F, int b, int h, int dir, int chunk, unsigned (&rz)[8], unsigned (&rv)[8], unsigned (&rq)[8]) {
    const size_t tokbase = (size_t)b * SEQ + (size_t)chunk * CHK; const int zoff = dir ? 1024 : 512, c0 = 2 * F.lane;
#pragma unroll
    for (int i = 0; i < 8; ++i) { const int p = 8 * F.wave + i, tr = dir ? (63 - p) : p; const bf16* q = F.proj() + (tokbase + tr) * NIN + h * HD;
        rz[i] = *(const unsigned*)(q + zoff + c0); rv[i] = *(const unsigned*)(q + 1536 + c0); if (FULL) rq[i] = *(const unsigned*)(q + c0); }
}
template <bool FULL, int MODE>
__device__ __forceinline__ void hgrn_chunk(Frame& F, int b, int h, int dir, int chunk, int nchunk, f32x16 (&accS)[2], float lb0, float lb1, unsigned (&rz)[8], unsigned (&rv)[8], unsigned (&rq)[8]) {
    LAS unsigned char* lds = F.lds;
    int r = F.lane & 31, hh = F.lane >> 5, c0 = 2 * F.lane;
    asm volatile("" : "+v"(r), "+v"(hh), "+v"(c0));
    const int w = F.wave, rb = w;
    const size_t tokbase = (size_t)b * SEQ + (size_t)chunk * CHK;
    {
        const f32x2_ oml = {1.0f - lb0, 1.0f - lb1};
        f32x2_ f2[8], cf2[8], cr2[8];
        f32x2_ run = {1.f, 1.f};
#pragma unroll
        for (int i = 0; i < 8; ++i) { const f32x2_ kk = {bflo(rz[i]), bfhi(rz[i])}; f2[i] = 1.0f - oml * kk; run *= f2[i]; cf2[i] = run; }
        { f32x2_ q = {1.f, 1.f};
#pragma unroll
          for (int i = 7; i >= 0; --i) { cr2[i] = q; q *= f2[i]; } }
        LAS float* pblk = (LAS float*)(lds + HL_PBLK);
        *(LAS f32x2_*)(pblk + rb * 128 + c0) = run;
        __syncthreads();
        f32x2_ pre = {1.f, 1.f}, post = {1.f, 1.f}, mid = {1.f, 1.f};
        for (int q = 0; q < rb; ++q) pre *= *(LAS const f32x2_*)(pblk + q * 128 + c0);
        for (int q = rb + 1; q < 8; ++q) post *= *(LAS const f32x2_*)(pblk + q * 128 + c0);
        if (rb < 4) { for (int q = rb + 1; q < 4; ++q) mid *= *(LAS const f32x2_*)(pblk + q * 128 + c0); }
        else { for (int q = 4; q < rb; ++q) mid *= *(LAS const f32x2_*)(pblk + q * 128 + c0); }
        if (rb == 0) *(LAS f32x2_*)((LAS float*)(lds + HL_AV) + c0) = run * post;
        f32x2_ ke2[8];
#pragma unroll
        for (int i = 0; i < 8; ++i) ke2[i] = (1.0f - f2[i]) * cr2[i] * post;
        if (FULL) {
            if (rb < 4) {
#pragma unroll
                for (int i = 0; i < 8; ++i) { const int p = 8 * rb + i; const f32x2_ qs = {bflo(rq[i]), bfhi(rq[i])}, k2 = 1.0f - f2[i], G = cr2[i] * mid;
                    f32x2_ iG; iG[0] = __builtin_amdgcn_rcpf(G[0]); iG[1] = __builtin_amdgcn_rcpf(G[1]);
                    const f32x2_ qe = qs * pre * cf2[i], qr = qs * iG, kr = k2 * G;
                    *(LAS unsigned*)(lds + HL_QE + p * PQ + c0 * 2) = cvtpk(qe[0], qe[1]);
                    *(LAS unsigned*)(lds + HL_QR + p * PQ + c0 * 2) = cvtpk(qr[0], qr[1]);
                    *(LAS unsigned*)(lds + HL_KR + p * PQ + c0 * 2) = cvtpk(kr[0], kr[1]); }
            } else {
#pragma unroll
                for (int i = 0; i < 8; ++i) { const int p = 8 * rb + i; const f32x2_ qs = {bflo(rq[i]), bfhi(rq[i])}, k2 = 1.0f - f2[i], G = cf2[i] * mid;
                    f32x2_ iG; iG[0] = __builtin_amdgcn_rcpf(G[0]); iG[1] = __builtin_amdgcn_rcpf(G[1]);
                    const f32x2_ qe = qs * pre * cf2[i], qr = qs * G, kr = k2 * iG;
                    *(LAS unsigned*)(lds + HL_QE + p * PQ + c0 * 2) = cvtpk(qe[0], qe[1]);
                    *(LAS unsigned*)(lds + HL_QR + p * PQ + c0 * 2) = cvtpk(qr[0], qr[1]);
                    *(LAS unsigned*)(lds + HL_KR + p * PQ + c0 * 2) = cvtpk(kr[0], kr[1]); }
            }
        }
        v4u ka, kb, va, vb2;
        ka.x = cvtpk(ke2[0][0], ke2[1][0]); ka.y = cvtpk(ke2[2][0], ke2[3][0]); ka.z = cvtpk(ke2[4][0], ke2[5][0]); ka.w = cvtpk(ke2[6][0], ke2[7][0]);
        kb.x = cvtpk(ke2[0][1], ke2[1][1]); kb.y = cvtpk(ke2[2][1], ke2[3][1]); kb.z = cvtpk(ke2[4][1], ke2[5][1]); kb.w = cvtpk(ke2[6][1], ke2[7][1]);
        va.x = (rv[0] & 0xffffu) | (rv[1] << 16); va.y = (rv[2] & 0xffffu) | (rv[3] << 16); va.z = (rv[4] & 0xffffu) | (rv[5] << 16); va.w = (rv[6] & 0xffffu) | (rv[7] << 16);
        vb2.x = (rv[0] >> 16) | (rv[1] & 0xffff0000u); vb2.y = (rv[2] >> 16) | (rv[3] & 0xffff0000u); vb2.z = (rv[4] >> 16) | (rv[5] & 0xffff0000u); vb2.w = (rv[6] >> 16) | (rv[7] & 0xffff0000u);
        *(LAS v4u*)(lds + HL_KET + c0 * PT + 16 * rb) = ka; *(LAS v4u*)(lds + HL_KET + (c0 + 1) * PT + 16 * rb) = kb;
        *(LAS v4u*)(lds + HL_VT + c0 * PT + 16 * rb) = va; *(LAS v4u*)(lds + HL_VT + (c0 + 1) * PT + 16 * rb) = vb2;
    }
    if (nchunk >= 0) hgrn_load<FULL>(F, b, h, dir, nchunk, rz, rv, rq);
    __syncthreads();
    const int pbO = w & 1, vb = w >> 1;
    f32x16 accO, accU[2];
#pragma unroll
    for (int i = 0; i < 16; ++i) { accO[i] = 0.f; accU[0][i] = 0.f; accU[1][i] = 0.f; }
    if (FULL) {
        if (w < 3) { const int pbS = (w + 1) >> 1, sbS = (w == 2) ? 1 : 0; f32x16 sc;
#pragma unroll
            for (int i = 0; i < 16; ++i) sc[i] = 0.f;
#pragma unroll
            for (int s = 0; s < 8; ++s) sc = MFMA32(ldf(lds + HL_QR, pbS * 32 + r, PQ, 32 * s + 16 * hh), ldf(lds + HL_KR, sbS * 32 + r, PQ, 32 * s + 16 * hh), sc);
#pragma unroll
            for (int i = 0; i < 16; i += 2) { const int p = pbS * 32 + (i & 3) + 8 * (i >> 2) + 4 * hh, s = sbS * 32 + r;
                const unsigned pkd = cvtpk(s <= p ? sc[i] : 0.f, s <= p + 1 ? sc[i + 1] : 0.f);
                *(LAS bf16*)(lds + HL_SCM + p * PT + s * 2) = (bf16)pkd; *(LAS bf16*)(lds + HL_SCM + (p + 1) * PT + s * 2) = (bf16)(pkd >> 16); } }
        __builtin_amdgcn_sched_barrier(0);
#pragma unroll
        for (int s = 0; s < 8; ++s) accO = MFMA32(ldf(lds + HL_QE, pbO * 32 + r, PQ, 32 * s + 16 * hh), ldf(lds + HL_ST, vb * 32 + r, PQ, 32 * s + 16 * hh), accO);
        __builtin_amdgcn_sched_barrier(0);
    }
#pragma unroll
    for (int i = 0; i < 2; ++i) { const int db = 2 * (w & 1) + i;
#pragma unroll
        for (int s = 0; s < 4; ++s) accU[i] = MFMA32(ldf(lds + HL_VT, vb * 32 + r, PT, 32 * s + 16 * hh), ldf(lds + HL_KET, db * 32 + r, PT, 32 * s + 16 * hh), accU[i]); }
    __builtin_amdgcn_sched_barrier(0);
    if (FULL) __syncthreads();
    if (FULL) {
        const unsigned v = vb * 32 + r;
        const unsigned lrow = (MODE == 0 ? (unsigned)hh : (unsigned)(1 - hh)) * 4u;
        const size_t rbase = (MODE == 0) ? (tokbase + pbO * 32) : (tokbase + 63 - pbO * 32 - 4);
        const unsigned lo_of = lrow * DH + v, lo_pr = lrow * NIN + v, lo_a2 = lrow * D + v;
        float ofv[16]; unsigned gv[16];
        if (MODE == 1) {
#pragma unroll
            for (int i = 0; i < 16; ++i) { const int ci = (i & 3) + 8 * (i >> 2); ofv[i] = (F.of() + (rbase - ci) * DH + h * HD)[lo_of]; } }
        for (int sb = 0; sb <= pbO; ++sb)
#pragma unroll
            for (int s2 = 0; s2 < 2; ++s2) accO = MFMA32(ldf(lds + HL_SCM, pbO * 32 + r, PT, 64 * sb + 32 * s2 + 16 * hh), ldf(lds + HL_VT, vb * 32 + r, PT, 64 * sb + 32 * s2 + 16 * hh), accO);
        if (MODE == 0) {
#pragma unroll
            for (int i = 0; i < 16; ++i) { const int ci = (i & 3) + 8 * (i >> 2); (F.of() + (rbase + ci) * DH + h * HD)[lo_of] = accO[i]; }
        } else {
            LAS float* rs = (LAS float*)(lds + HL_RS);
#pragma unroll
            for (int i = 0; i < 16; ++i) { const int ci = (i & 3) + 8 * (i >> 2); gv[i] = (F.proj() + (rbase - ci) * NIN + 2048 + h * HD)[lo_pr]; }
            float ov[16];
            float ssr[16];
#pragma unroll
            for (int i = 0; i < 16; ++i) { ov[i] = accO[i] + ofv[i]; float ss = ov[i] * ov[i];
                ss = DPP_ADD(ss, 0x128); ss = DPP_ADD(ss, 0x124); ss = DPP_ADD(ss, 0x122); ss = DPP_ADD(ss, 0x121);
                ssr[i] = ss + __builtin_bit_cast(float, __builtin_amdgcn_update_dpp(0, __builtin_bit_cast(int, ss), 0x142, 0xA, 0xF, false)); }
            if (r == 16) {
#pragma unroll
                for (int i = 0; i < 16; ++i) { const int ci = (i & 3) + 8 * (i >> 2), p = pbO * 32 + ci + 4 * hh; rs[p * 4 + vb] = ssr[i]; } }
            __syncthreads();
            const float ng = F.hnorm_g()[h * HD + v];
#pragma unroll
            for (int i = 0; i < 16; ++i) { const int ci = (i & 3) + 8 * (i >> 2), p = pbO * 32 + ci + 4 * hh;
                const f32x4 q = *(LAS const f32x4*)(rs + p * 4);
                const float rstd = __builtin_amdgcn_rsqf((q[0] + q[1] + q[2] + q[3]) * (1.0f / HD) + EPS);
                const float g = bf2f(gv[i]);
                (F.bufA() + (rbase - ci) * D + h * HD)[lo_a2] = (bf16)cvtpk(ov[i] * rstd * ng * g, 0.f); }
        }
    }
    {
        const LAS float* av = (const LAS float*)(lds + HL_AV);
#pragma unroll
        for (int i = 0; i < 2; ++i) { const int db = 2 * (w & 1) + i; const float a = av[db * 32 + r];
#pragma unroll
            for (int j = 0; j < 16; j += 2) { const float s0 = accS[i][j] * a + accU[i][j], s1 = accS[i][j + 1] * a + accU[i][j + 1]; accS[i][j] = s0; accS[i][j + 1] = s1;
                if (FULL) { const int vv = vb * 32 + (j & 3) + 8 * (j >> 2) + 4 * hh; const unsigned pkd = cvtpk(s0, s1);
                    *(LAS bf16*)(lds + HL_ST + vv * PQ + (db * 32 + r) * 2) = (bf16)pkd; *(LAS bf16*)(lds + HL_ST + (vv + 1) * PQ + (db * 32 + r) * 2) = (bf16)(pkd >> 16); } } }
    }
    __syncthreads();
}
__device__ __forceinline__ void h1_item(Frame& F, int item) {
    const int seg = item & 15, dir = (item >> 4) & 1, h = (item >> 5) & 3, b = item >> 7;
    const float lb0 = F.lb()[dir * 512 + h * HD + 2 * F.lane], lb1 = F.lb()[dir * 512 + h * HD + 2 * F.lane + 1];
    f32x16 accS[2];
#pragma unroll
    for (int i = 0; i < 16; ++i) { accS[0][i] = 0.f; accS[1][i] = 0.f; }
    float atot = 1.f; const int col = F.tid & 127;
    unsigned rzA[8], rvA[8], rzB[8], rvB[8], rq[8];
#define H1CH(c) (seg * SEGC + (dir ? (SEGC - 1 - (c)) : (c)))
    hgrn_load<false>(F, b, h, dir, H1CH(0), rzA, rvA, rq); hgrn_load<false>(F, b, h, dir, H1CH(1), rzB, rvB, rq);
    for (int c = 0; c < SEGC; c += 2) {
        hgrn_chunk<false, 0>(F, b, h, dir, H1CH(c), (c + 2 < SEGC) ? H1CH(c + 2) : -1, accS, lb0, lb1, rzA, rvA, rq);
        atot *= ((const LAS float*)(F.lds + HL_AV))[col];
        hgrn_chunk<false, 0>(F, b, h, dir, H1CH(c + 1), (c + 3 < SEGC) ? H1CH(c + 3) : -1, accS, lb0, lb1, rzB, rvB, rq);
        atot *= ((const LAS float*)(F.lds + HL_AV))[col]; }
#undef H1CH
    if (F.tid < 128) F.sega()[(size_t)item * 128 + col] = atot;
    float* U = F.segu() + (size_t)item * 16384;
#pragma unroll
    for (int i = 0; i < 2; ++i)
#pragma unroll
        for (int j = 0; j < 16; j += 4) { f32x4 o; o[0] = accS[i][j]; o[1] = accS[i][j + 1]; o[2] = accS[i][j + 2]; o[3] = accS[i][j + 3]; ((f32x4*)(U + (i * 4 + (j >> 2)) * NTHR * 4))[F.tid] = o; }
}
__device__ __forceinline__ void h_scan(Frame& F) {
    for (int g = F.bid; g < NB * NHH * 2 * 8; g += F.G) {
        const int chain = g >> 3, k = g & 7, dir = chain & 1;
        const int aidx = (2 * (F.wave & 1) + (k >> 2)) * 32 + (F.lane & 31);
        float* U = F.segu() + (size_t)chain * NSEG * 16384 + (size_t)k * NTHR * 4 + F.tid * 4;
        const float* A = F.sega() + (size_t)chain * NSEG * 128 + aidx;
        f32x4 u[NSEG]; float av[NSEG];
#pragma unroll
        for (int q = 0; q < NSEG; ++q) { const int sg = dir ? (NSEG - 1 - q) : q; u[q] = *(const f32x4*)(U + (size_t)sg * 16384); av[q] = A[sg * 128]; }
        f32x4 S = {0.f, 0.f, 0.f, 0.f};
#pragma unroll
        for (int q = 0; q < NSEG; ++q) { const int sg = dir ? (NSEG - 1 - q) : q; *(f32x4*)(U + (size_t)sg * 16384) = S; S = S * av[q] + u[q]; }
    }
}
__device__ __forceinline__ void h2_init_state(Frame& F, int b, int h, int dir, int seg, f32x16 (&accS)[2]) {
    const int w = F.wave, r = F.lane & 31, hh = F.lane >> 5, vb = w >> 1;
    const float* U = F.segu() + (size_t)(((b * 4 + h) * 2 + dir) * NSEG + seg) * 16384;
#pragma unroll
    for (int k = 0; k < 8; ++k) { const f32x4 v = ((const f32x4*)(U + k * NTHR * 4))[F.tid]; const int i = k >> 2, j = (k & 3) * 4;
        accS[i][j] = v[0]; accS[i][j + 1] = v[1]; accS[i][j + 2] = v[2]; accS[i][j + 3] = v[3]; }
#pragma unroll
    for (int i = 0; i < 2; ++i) { const int db = 2 * (w & 1) + i;
#pragma unroll
        for (int j = 0; j < 16; ++j) { const int vv = vb * 32 + (j & 3) + 8 * (j >> 2) + 4 * hh; *(LAS bf16*)(F.lds + HL_ST + vv * PQ + (db * 32 + r) * 2) = (bf16)f2bf(accS[i][j]); } }
    __syncthreads();
}
__device__ __forceinline__ void h2_item(Frame& F, int item) {
    const int seg = item & 15, h = (item >> 4) & 3, b = item >> 6;
    f32x16 accS[2];
    unsigned rzA[8], rvA[8], rqA[8], rzB[8], rvB[8], rqB[8];
    { const float lb0 = F.lb()[h * HD + 2 * F.lane], lb1 = F.lb()[h * HD + 2 * F.lane + 1];
      const int c0 = seg * SEGC;
      hgrn_load<true>(F, b, h, 0, c0, rzA, rvA, rqA); hgrn_load<true>(F, b, h, 0, c0 + 1, rzB, rvB, rqB);
      h2_init_state(F, b, h, 0, seg, accS);
      for (int c = 0; c < SEGC; c += 2) {
          hgrn_chunk<true, 0>(F, b, h, 0, c0 + c, (c + 2 < SEGC) ? (c0 + c + 2) : -1, accS, lb0, lb1, rzA, rvA, rqA);
          hgrn_chunk<true, 0>(F, b, h, 0, c0 + c + 1, (c + 3 < SEGC) ? (c0 + c + 3) : -1, accS, lb0, lb1, rzB, rvB, rqB); } }
    asm volatile("s_waitcnt vmcnt(0)" ::: "memory");
    __syncthreads();
    { const float lb0 = F.lb()[512 + h * HD + 2 * F.lane], lb1 = F.lb()[512 + h * HD + 2 * F.lane + 1];
      const int cl = seg * SEGC + SEGC - 1;
      hgrn_load<true>(F, b, h, 1, cl, rzA, rvA, rqA); hgrn_load<true>(F, b, h, 1, cl - 1, rzB, rvB, rqB);
      h2_init_state(F, b, h, 1, seg, accS);
      for (int c = 0; c < SEGC; c += 2) {
          hgrn_chunk<true, 1>(F, b, h, 1, cl - c, (c + 2 < SEGC) ? (cl - c - 2) : -1, accS, lb0, lb1, rzA, rvA, rqA);
          hgrn_chunk<true, 1>(F, b, h, 1, cl - c - 1, (c + 3 < SEGC) ? (cl - c - 3) : -1, accS, lb0, lb1, rzB, rvB, rqB); } }
}

__device__ __forceinline__ unsigned f2key(float f) { return __builtin_bit_cast(unsigned, f); }
__device__ __forceinline__ float key2f(unsigned k) { return __builtin_bit_cast(float, k); }
__device__ __forceinline__ unsigned umax_(unsigned a, unsigned b) { unsigned r; asm("v_max_f32 %0, %1, %2" : "=v"(r) : "v"(a), "v"(b)); return r; }
__device__ __forceinline__ unsigned umin_(unsigned a, unsigned b) { unsigned r; asm("v_min_f32 %0, %1, %2" : "=v"(r) : "v"(a), "v"(b)); return r; }
__device__ __forceinline__ void sort16(unsigned (&a)[16]) {
#define CE_(i, j) { const unsigned x_ = a[i], y_ = a[j]; a[i] = umax_(x_, y_); a[j] = umin_(x_, y_); }
    CE_(0, 13) CE_(1, 12) CE_(2, 15) CE_(3, 14) CE_(4, 8) CE_(5, 6) CE_(7, 11) CE_(9, 10)
    CE_(0, 5) CE_(1, 7) CE_(2, 9) CE_(3, 4) CE_(6, 13) CE_(8, 14) CE_(10, 15) CE_(11, 12)
    CE_(0, 1) CE_(2, 3) CE_(4, 5) CE_(6, 8) CE_(7, 9) CE_(10, 11) CE_(12, 13) CE_(14, 15)
    CE_(0, 2) CE_(1, 3) CE_(4, 10) CE_(5, 11) CE_(6, 7) CE_(8, 9) CE_(12, 14) CE_(13, 15)
    CE_(1, 2) CE_(3, 12) CE_(4, 6) CE_(5, 7) CE_(8, 10) CE_(9, 11) CE_(13, 14)
    CE_(1, 4) CE_(2, 6) CE_(5, 8) CE_(7, 10) CE_(9, 13) CE_(11, 14)
    CE_(2, 4) CE_(3, 6) CE_(9, 12) CE_(11, 13)
    CE_(3, 5) CE_(6, 8) CE_(7, 9) CE_(10, 12)
    CE_(3, 4) CE_(5, 6) CE_(7, 8) CE_(9, 10) CE_(11, 12)
    CE_(6, 7) CE_(8, 9)
#undef CE_
}
__device__ __forceinline__ void merge16(unsigned (&a)[16], const unsigned (&b)[16]) {
#pragma unroll
    for (int i = 0; i < 16; ++i) a[i] = umax_(a[i], b[15 - i]);
#pragma unroll
    for (int j = 8; j > 0; j >>= 1)
#pragma unroll
        for (int i = 0; i < 16; ++i) { const int l = i ^ j; if (l > i) { const unsigned x = a[i], y = a[l]; a[i] = umax_(x, y); a[l] = umin_(x, y); } }
}
__device__ __forceinline__ unsigned dpp_swap1(unsigned v) { return (unsigned)__builtin_amdgcn_update_dpp(0, (int)v, 0xB1, 0xF, 0xF, false); }
__device__ __forceinline__ unsigned pick_byte(const unsigned (&pk)[4], unsigned a) {
    const unsigned wsel = a >> 2; unsigned v = wsel == 0 ? pk[0] : (wsel == 1 ? pk[1] : (wsel == 2 ? pk[2] : pk[3]));
    return (v >> ((a & 3u) * 8u)) & 0xffu;
}
__device__ __forceinline__ void topk_stage2(const unsigned (&top)[16], bool tab0, size_t item, int* esel, float* wsel) {
        float vO[16], vP[16]; unsigned iOpk[4] = {0u, 0u, 0u, 0u}, iPpk[4] = {0u, 0u, 0u, 0u};
#pragma unroll
        for (int i = 0; i < 16; ++i) { const unsigned t = top[i], tp = dpp_swap1(t);
            vO[i] = key2f(t & ~0x7fu); vP[i] = key2f(tp & ~0x7fu);
            iOpk[i >> 2] |= (127u - (t & 0x7fu)) << ((i & 3) * 8); iPpk[i >> 2] |= (127u - (tp & 0x7fu)) << ((i & 3) * 8); }
        unsigned R[16], G1[16], G2[16];
#define CAND(a, b) ((f2key(vO[a] + vP[b]) & ~0xffu) | (unsigned)(((a) << 4) | (b)))
#pragma unroll
        for (int i = 0; i < 16; ++i) R[i] = CAND(0, i);
        G1[0] = CAND(1, 0); G1[1] = CAND(1, 1); G1[2] = CAND(1, 2); G1[3] = CAND(1, 3); G1[4] = CAND(1, 4); G1[5] = CAND(1, 5); G1[6] = CAND(1, 6); G1[7] = CAND(1, 7);
        G1[8] = CAND(2, 0); G1[9] = CAND(2, 1); G1[10] = CAND(2, 2); G1[11] = CAND(2, 3); G1[12] = CAND(2, 4); G1[13] = CAND(3, 0); G1[14] = CAND(3, 1); G1[15] = CAND(3, 2);
        G2[0] = CAND(3, 3); G2[1] = CAND(4, 0); G2[2] = CAND(4, 1); G2[3] = CAND(4, 2); G2[4] = CAND(5, 0); G2[5] = CAND(5, 1); G2[6] = CAND(6, 0); G2[7] = CAND(6, 1);
        G2[8] = CAND(7, 0); G2[9] = CAND(7, 1); G2[10] = CAND(8, 0); G2[11] = CAND(9, 0); G2[12] = CAND(10, 0); G2[13] = CAND(11, 0); G2[14] = CAND(12, 0); G2[15] = CAND(13, 0);
        const unsigned g30 = CAND(14, 0), g31 = CAND(15, 0);
#undef CAND
        sort16(G1); sort16(G2);
        merge16(R, G1); merge16(R, G2);
        { const unsigned hi = umax_(g30, g31), lo = umin_(g30, g31); R[15] = umax_(R[15], hi); R[14] = umax_(R[14], lo);
#pragma unroll
          for (int j = 8; j > 0; j >>= 1)
#pragma unroll
              for (int i = 0; i < 16; ++i) { const int l = i ^ j; if (l > i) { const unsigned x = R[i], y = R[l]; R[i] = umax_(x, y); R[l] = umin_(x, y); } } }
        float sc[16], ex[16]; float sum = 0.f; unsigned eid[16];
        #pragma unroll
        for (int i = 0; i < 16; ++i) { sc[i] = key2f(R[i] & ~0xffu); const unsigned a = (R[i] >> 4) & 15u, bb = R[i] & 15u;
            const unsigned io = pick_byte(iOpk, a), ip = pick_byte(iPpk, bb);
            eid[i] = tab0 ? (io * 128u + ip) : (ip * 128u + io); }
#pragma unroll
        for (int i = 0; i < 16; ++i) { ex[i] = __expf(sc[i] - sc[0]); sum += ex[i]; }
        const float inv = 1.0f / sum;
        if (tab0) { const size_t o = item * 16;
#pragma unroll
            for (int q = 0; q < 4; ++q) { v4u ev; ev.x = eid[4 * q]; ev.y = eid[4 * q + 1]; ev.z = eid[4 * q + 2]; ev.w = eid[4 * q + 3]; *(v4u*)(esel + o + 4 * q) = ev;
                f32x4 wv; wv[0] = ex[4 * q] * inv; wv[1] = ex[4 * q + 1] * inv; wv[2] = ex[4 * q + 2] * inv; wv[3] = ex[4 * q + 3] * inv; *(f32x4*)(wsel + o + 4 * q) = wv; } }
}

struct EpiScoreTopk {
    static constexpr bool PERM = false, AFTER_DRAIN = false;
    float* scr; const float* ssqp; const float* biasq; float* rstd_out; int* esel; float* wsel;
    __device__ __forceinline__ void operator()(const f32x4 (&acc)[2][2][4][2], const pg8::Unit& u, int wr, int wc, int fr, int fq) const {
        asm volatile("" : "+v"(fr), "+v"(fq));
        const int rl0 = wr * 64 + fr, col0 = wc * 32 + 4 * fq, b = (u.pm * 256) >> 13;
        f32x4 bv[2][2];
#pragma unroll
        for (int bj = 0; bj < 2; ++bj)
#pragma unroll
            for (int n = 0; n < 2; ++n) bv[bj][n] = *(const f32x4*)(biasq + b * 2048 + u.pn * 256 + col0 + bj * 128 + n * 16);
#pragma unroll
        for (int ai = 0; ai < 2; ++ai)
#pragma unroll
            for (int m = 0; m < 4; ++m) { const int rl = rl0 + ai * 128 + m * 16, row = u.pm * 256 + rl;
                const f32x4 p0 = *(const f32x4*)(ssqp + (size_t)row * 4), p1 = *(const f32x4*)(ssqp + ((size_t)32768 + row) * 4), p2 = *(const f32x4*)(ssqp + ((size_t)65536 + row) * 4), p3 = *(const f32x4*)(ssqp + ((size_t)98304 + row) * 4);
                const float tot = (p0[0] + p0[1] + p0[2] + p0[3]) + (p1[0] + p1[1] + p1[2] + p1[3]) + (p2[0] + p2[1] + p2[2] + p2[3]) + (p3[0] + p3[1] + p3[2] + p3[3]);
                const float rstd = __builtin_amdgcn_rsqf(tot * (1.0f / 1024.0f) + 1e-6f);
                if (u.pn == 0 && wc == 0 && fq == 0) rstd_out[row] = rstd;
                float* blk = scr + (2 * wr + 4 * ai + (m >> 1)) * 8192 + 8 * wc * 256 + 32 * (m & 1) * 4;
                const unsigned loff4 = (unsigned)(2 * fr + 64 * fq);
#pragma unroll
                for (int bj = 0; bj < 2; ++bj)
#pragma unroll
                    for (int n = 0; n < 2; ++n) ((f32x4*)(blk + (4 * n * 64 + bj) * 4))[loff4] = acc[ai][bj][m][n] * rstd + bv[bj][n]; }
        asm volatile("s_waitcnt vmcnt(0)" ::: "memory");
        __builtin_amdgcn_s_barrier();
        asm volatile("" ::: "memory");
        int tid = threadIdx.x; asm volatile("" : "+v"(tid));
        const int rl = tid >> 1, tab = tid & 1;
        const float* bp = scr + __builtin_amdgcn_readfirstlane(tid >> 6) * 8192;
        const unsigned lo4 = (unsigned)(tid & 63) * 4u;
        unsigned top[16];
        f32x4 cur[4], nxt[4];
#pragma unroll
        for (int q = 0; q < 4; ++q) cur[q] = *(const f32x4*)(bp + q * 256 + lo4);
#pragma unroll
        for (int grp = 0; grp < 8; ++grp) { unsigned k[16];
            if (grp < 7) {
#pragma unroll
                for (int q = 0; q < 4; ++q) nxt[q] = *(const f32x4*)(bp + ((grp + 1) * 4 + q) * 256 + lo4); }
#pragma unroll
            for (int q = 0; q < 4; ++q) { const f32x4 v = cur[q];
#pragma unroll
                for (int e = 0; e < 4; ++e) { const int j = grp * 16 + q * 4 + e; k[q * 4 + e] = (f2key(v[e]) & ~0x7fu) | (unsigned)(127 - j); } }
            sort16(k);
            if (grp == 0) {
#pragma unroll
                for (int i = 0; i < 16; ++i) top[i] = k[i];
            } else merge16(top, k);
#pragma unroll
            for (int q = 0; q < 4; ++q) cur[q] = nxt[q];
            __builtin_amdgcn_sched_barrier(0); }
        topk_stage2(top, tab == 0, (size_t)u.pn * T + (size_t)(u.pm * 256 + rl), esel, wsel);
    }
};

__device__ __forceinline__ void cvt16(const v4u& u, f32x2_ (&f)[8]) {
#pragma unroll
    for (int i = 0; i < 4; ++i) { f[2 * i] = __builtin_amdgcn_cvt_pk_f32_fp8((int)u[i], false); f[2 * i + 1] = __builtin_amdgcn_cvt_pk_f32_fp8((int)u[i], true); }
}
constexpr int PITEM = 8, NPITEM = T / PITEM;
__device__ __forceinline__ int peer_next(unsigned* q, int lane) {
    int idx = 0; if (lane == 0) idx = (int)__hip_atomic_fetch_add(q, 1u, __ATOMIC_RELAXED, __HIP_MEMORY_SCOPE_AGENT);
    return __builtin_amdgcn_readfirstlane(idx);
}
#define PEER_SB() __builtin_amdgcn_sched_barrier(0)
#define DPP_IADD(s, ctrl) ((s) + __builtin_amdgcn_update_dpp(0, (s), (ctrl), 0xF, 0xF, false))
__device__ __forceinline__ void p8_dots(const v4u (&ud)[16], const int (&hh)[4], const int (&hl)[4], int c8, int& r0, int& r1) {
#pragma unroll
    for (int i = 0; i < 16; ++i) { int sh = 0, sl = 0;
#pragma unroll
        for (int d = 0; d < 4; ++d) { sh = __builtin_amdgcn_sdot8((int)ud[i][d], hh[d], sh, false); sl = __builtin_amdgcn_sdot8((int)ud[i][d], hl[d], sl, false); }
        int sm = (sh << 4) + sl;
        sm = DPP_IADD(sm, 0xB1); sm = DPP_IADD(sm, 0x4E); sm = DPP_IADD(sm, 0x141);
        if ((i & 1) == 0) r0 = (c8 == (i >> 1)) ? sm : r0; else r1 = (c8 == (i >> 1)) ? sm : r1; }
}
constexpr int PSLAB = 12288;
__device__ __forceinline__ void p8_item(Frame& F, int sl, int item, int nitem, bool filled, LAS unsigned char* slab) {
    const int c8 = F.lane & 7, q8 = F.lane >> 3, t0 = item * PITEM;
    const unsigned char* ub = F.U8() + (size_t)sl * 16384 * 128 + 16 * c8;
    LAS int* eL = (LAS int*)slab; LAS unsigned char* hL = (LAS unsigned char*)(slab + 4096);
    LAS float* qL = (LAS float*)(slab + 6144);
    v4u t4[4], h2[4]; float rs2[4]; f32x4 sA, sB, gA, gB;
#define P8_BLK_LOAD(tb) do { \
        { const float* sp_ = F.mod() + ((tb) >> 13) * 6144 + 3072 + sl * CSLU + 8 * (F.lane & 31); sA = *(const f32x4*)sp_; sB = *(const f32x4*)(sp_ + 4); \
          const float* gp_ = F.g_ffn() + sl * CSLU + 8 * (F.lane & 31); gA = *(const f32x4*)gp_ * (*(const f32x4*)(sp_ + 1024) + 1.0f); gB = *(const f32x4*)(gp_ + 4) * (*(const f32x4*)(sp_ + 1028) + 1.0f); } \
        _Pragma("unroll") for (int i = 0; i < 4; ++i) rs2[i] = F.rstd()[(tb) + 2 * i + (F.lane >> 5)]; \
        _Pragma("unroll") for (int i = 0; i < 4; ++i) t4[i] = __builtin_nontemporal_load((const v4u*)(F.esel() + ((size_t)(2 * i + (F.lane >> 5)) * T + (tb)) * 16) + (F.lane & 31)); \
        _Pragma("unroll") for (int i = 0; i < 4; ++i) h2[i] = __builtin_nontemporal_load((const v4u*)(F.hg() + (size_t)((tb) + 2 * i + (F.lane >> 5)) * D + sl * CSLU + 8 * (F.lane & 31))); } while (0)
#define DPP_FMAX(v, ctrl) __builtin_fmaxf((v), __builtin_bit_cast(float, __builtin_amdgcn_update_dpp(0, __builtin_bit_cast(int, (v)), (ctrl), 0xF, 0xF, false)))
#define P8_QN(x, k) { const int q_ = (int)__builtin_rintf((x) * qs_), lo_ = ((q_ + 8) & 15) - 8, hi_ = (q_ - lo_) >> 4; wl_ |= (unsigned)(lo_ & 15) << (4 * (k)); wh_ |= (unsigned)(hi_ & 15) << (4 * (k)); }
#define P8_BLK_STORE() do { _Pragma("unroll") for (int i = 0; i < 4; ++i) *(LAS v4u*)(eL + ((F.lane & 31) >> 2) * NSEL + (2 * i + (F.lane >> 5)) * 16 + 4 * (F.lane & 3)) = t4[i]; \
        _Pragma("unroll") for (int i = 0; i < 4; ++i) { const float r_ = rs2[i]; const v4u h_ = h2[i]; \
            const f32x4 ra_ = gA * r_, rb_ = gB * r_; \
            const float x0 = bflo(h_[0]) * ra_[0] + sA[0], x1 = bfhi(h_[0]) * ra_[1] + sA[1], x2 = bflo(h_[1]) * ra_[2] + sA[2], x3 = bfhi(h_[1]) * ra_[3] + sA[3]; \
            const float x4 = bflo(h_[2]) * rb_[0] + sB[0], x5 = bfhi(h_[2]) * rb_[1] + sB[1], x6 = bflo(h_[3]) * rb_[2] + sB[2], x7 = bfhi(h_[3]) * rb_[3] + sB[3]; \
            float m_ = __builtin_fmaxf(__builtin_fmaxf(__builtin_fmaxf(__builtin_fabsf(x0), __builtin_fabsf(x1)), __builtin_fmaxf(__builtin_fabsf(x2), __builtin_fabsf(x3))), \
                                       __builtin_fmaxf(__builtin_fmaxf(__builtin_fabsf(x4), __builtin_fabsf(x5)), __builtin_fmaxf(__builtin_fabsf(x6), __builtin_fabsf(x7)))); \
            m_ = DPP_FMAX(m_, 0x128); m_ = DPP_FMAX(m_, 0x124); m_ = DPP_FMAX(m_, 0x122); m_ = DPP_FMAX(m_, 0x121); m_ = __builtin_fmaxf(m_, __shfl_xor(m_, 16)); m_ = __builtin_fmaxf(m_, 1e-20f); \
            const float qs_ = 119.0f * __builtin_amdgcn_rcpf(m_); \
            const int tk_ = 2 * i + (F.lane >> 5); \
            if ((F.lane & 31) == 0) qL[tk_] = m_ * (1.0f / (119.0f * UQSCALE)); \
            unsigned wl_ = 0u, wh_ = 0u; P8_QN(x0, 0) P8_QN(x1, 1) P8_QN(x2, 2) P8_QN(x3, 3) P8_QN(x4, 4) P8_QN(x5, 5) P8_QN(x6, 6) P8_QN(x7, 7) \
            *(LAS unsigned*)(hL + tk_ * 256 + 4 * (F.lane & 31)) = wh_; *(LAS unsigned*)(hL + tk_ * 256 + 128 + 4 * (F.lane & 31)) = wl_; } \
        asm volatile("s_waitcnt lgkmcnt(0)" ::: "memory"); } while (0)
    if (!filled) { P8_BLK_LOAD(t0); P8_BLK_STORE(); }
    bf16* po = F.pact() + ((size_t)t0 * NSLU + sl) * NSEL + 16 * q8 + 2 * c8;
    v4u udA[16], udB[16];
#define P8_GATHER(dst, tt) do { v4u e_[4]; _Pragma("unroll") for (int k = 0; k < 4; ++k) e_[k] = *(LAS const v4u*)(eL + (tt) * NSEL + 16 * q8 + 4 * k); \
        _Pragma("unroll") for (int i = 0; i < 16; ++i) dst[i] = *(const v4u*)(ub + (size_t)e_[i >> 2][i & 3] * 128); } while (0)
#define P8_HN(tt) int hh[4], hl[4]; { const v4u a_ = *(LAS const v4u*)(hL + (tt) * 256 + 16 * c8), b_ = *(LAS const v4u*)(hL + (tt) * 256 + 128 + 16 * c8); \
        hh[0] = (int)a_[0]; hh[1] = (int)a_[1]; hh[2] = (int)a_[2]; hh[3] = (int)a_[3]; hl[0] = (int)b_[0]; hl[1] = (int)b_[1]; hl[2] = (int)b_[2]; hl[3] = (int)b_[3]; }
#define P8_OUT(tt, r0, r1) do { const float dq_ = qL[tt]; __builtin_nontemporal_store(cvtpk((float)(r0) * dq_, (float)(r1) * dq_), (unsigned*)(po + (size_t)(tt) * NSLU * NSEL)); } while (0)
    P8_GATHER(udA, 0);
    for (int tt = 0; tt < PITEM - 2; tt += 2) {
        P8_GATHER(udB, tt + 1);
        { P8_HN(tt); int r0 = 0, r1 = 0; p8_dots(udA, hh, hl, c8, r0, r1); P8_OUT(tt, r0, r1); }
        P8_GATHER(udA, tt + 2);
        { P8_HN(tt + 1); int r0 = 0, r1 = 0; p8_dots(udB, hh, hl, c8, r0, r1); P8_OUT(tt + 1, r0, r1); }
    }
    {
        P8_GATHER(udB, PITEM - 1);
        { P8_HN(PITEM - 2); int r0 = 0, r1 = 0; p8_dots(udA, hh, hl, c8, r0, r1); P8_OUT(PITEM - 2, r0, r1); }
        if (nitem >= 0) P8_BLK_LOAD(nitem * PITEM);
        { P8_HN(PITEM - 1); int r0 = 0, r1 = 0; p8_dots(udB, hh, hl, c8, r0, r1); P8_OUT(PITEM - 1, r0, r1); }
        if (nitem >= 0) P8_BLK_STORE();
    }
#undef P8_GATHER
#undef P8_HN
#undef P8_OUT
#undef P8_BLK_LOAD
#undef P8_BLK_STORE
#undef P8_QN
#undef DPP_FMAX
}
__device__ __forceinline__ void p8b_coef(Frame& F) {
    const int N8 = T * (NSEL / 8);
#pragma unroll 2
    for (int i = F.bid * NTHR + F.tid; i < N8; i += F.G * NTHR) { const size_t t = (size_t)(i >> 4); const int m = i & 15;
        const bf16* pp = F.pact() + t * NSLU * NSEL + 8 * m;
        v4u p4[NSLU];
#pragma unroll
        for (int q = 0; q < NSLU; ++q) p4[q] = __builtin_nontemporal_load((const v4u*)(pp + q * NSEL));
        const float* wp = F.wsel() + ((size_t)(m >> 1) * T + t) * 16 + 8 * (m & 1);
        const f32x4 w0 = *(const f32x4*)wp, w1 = *(const f32x4*)(wp + 4);
        float a[8];
#pragma unroll
        for (int e = 0; e < 4; ++e) { float lo = 0.f, hi = 0.f;
#pragma unroll
            for (int q = 0; q < NSLU; ++q) { lo += bflo(p4[q][e]); hi += bfhi(p4[q][e]); }
            a[2 * e] = lo; a[2 * e + 1] = hi; }
        f32x4 o0, o1;
#pragma unroll
        for (int e = 0; e < 4; ++e) { o0[e] = w0[e] * 0.5f * a[e] * (1.0f + erff(a[e] * 0.70710678f)); o1[e] = w1[e] * 0.5f * a[4 + e] * (1.0f + erff(a[4 + e] * 0.70710678f)); }
        float* cp = F.coef() + t * NSEL + 8 * m;
        *(f32x4*)cp = o0; *(f32x4*)(cp + 4) = o1; }
}
__device__ __forceinline__ void p9_token(const v4u (&vd)[16], LAS const float* cL, bf16* yo, LAS float* red, int lane, int c8, int q8) {
    f32x4 cc[4];
#pragma unroll
    for (int k = 0; k < 4; ++k) cc[k] = *(LAS const f32x4*)(cL + 16 * q8 + 4 * k);
    f32x2_ y[8];
#pragma unroll
    for (int k = 0; k < 8; ++k) y[k] = (f32x2_){0.f, 0.f};
#pragma unroll
    for (int i = 0; i < 16; ++i) { f32x2_ vf[8]; cvt16(vd[i], vf); const float c = cc[i >> 2][i & 3]; const f32x2_ c2 = {c, c};
#pragma unroll
        for (int k = 0; k < 8; ++k) y[k] += c2 * vf[k];
        PEER_SB(); }
#pragma unroll
    for (int k = 0; k < 4; ++k) { f32x4 o; o[0] = y[2 * k][0]; o[1] = y[2 * k][1]; o[2] = y[2 * k + 1][0]; o[3] = y[2 * k + 1][1]; *(LAS f32x4*)(red + q8 * 128 + 16 * c8 + 4 * k) = o; }
    asm volatile("s_waitcnt lgkmcnt(0)" ::: "memory");
    f32x2_ sm = {0.f, 0.f};
#pragma unroll
    for (int g = 0; g < 8; ++g) sm += *(LAS const f32x2_*)(red + g * 128 + 2 * lane);
    sm = sm * (1.0f / VSCALE);
    __builtin_nontemporal_store(cvtpk(sm[0], sm[1]), (unsigned*)(yo + 2 * lane));
    asm volatile("s_waitcnt lgkmcnt(0)" ::: "memory");
    PEER_SB();
}
__device__ __forceinline__ void p9_item(Frame& F, int sl, int item, int nitem, bool filled, LAS unsigned char* slab) {
    const int c8 = F.lane & 7, q8 = F.lane >> 3, t0 = item * PITEM;
    const unsigned char* vb = F.V8() + (size_t)sl * 16384 * CSL + 16 * c8;
    LAS int* eL = (LAS int*)slab; LAS float* cL = (LAS float*)(slab + 4096); LAS float* red = (LAS float*)(slab + 8192);
    v4u t4[4], c4[4];
#define P9_BLK_LOAD(tb) do { const v4u* cp_ = (const v4u*)(F.coef() + (size_t)(tb) * NSEL); \
        _Pragma("unroll") for (int i = 0; i < 4; ++i) { t4[i] = __builtin_nontemporal_load((const v4u*)(F.esel() + ((size_t)(2 * i + (F.lane >> 5)) * T + (tb)) * 16) + (F.lane & 31)); c4[i] = __builtin_nontemporal_load(cp_ + i * 64 + F.lane); } } while (0)
#define P9_BLK_STORE() do { _Pragma("unroll") for (int i = 0; i < 4; ++i) { *(LAS v4u*)(eL + ((F.lane & 31) >> 2) * NSEL + (2 * i + (F.lane >> 5)) * 16 + 4 * (F.lane & 3)) = t4[i]; *(LAS v4u*)(cL + (i * 64 + F.lane) * 4) = c4[i]; } \
        asm volatile("s_waitcnt lgkmcnt(0)" ::: "memory"); } while (0)
    if (!filled) { P9_BLK_LOAD(t0); P9_BLK_STORE(); }
    bf16* yo = F.ybuf() + (size_t)t0 * D + sl * CSL;
    v4u vdA[16], vdB[16];
#define P9_GATHER(dst, tt) do { v4u e_[4]; _Pragma("unroll") for (int k = 0; k < 4; ++k) e_[k] = *(LAS const v4u*)(eL + (tt) * NSEL + 16 * q8 + 4 * k); \
        _Pragma("unroll") for (int i = 0; i < 16; ++i) dst[i] = *(const v4u*)(vb + (size_t)e_[i >> 2][i & 3] * CSL); } while (0)
    P9_GATHER(vdA, 0);
    for (int tt = 0; tt < PITEM - 2; tt += 2) {
        P9_GATHER(vdB, tt + 1);
        p9_token(vdA, cL + tt * NSEL, yo + (size_t)tt * D, red, F.lane, c8, q8);
        P9_GATHER(vdA, tt + 2);
        p9_token(vdB, cL + (tt + 1) * NSEL, yo + (size_t)(tt + 1) * D, red, F.lane, c8, q8);
    }
    {
        P9_GATHER(vdB, PITEM - 1);
        p9_token(vdA, cL + (PITEM - 2) * NSEL, yo + (size_t)(PITEM - 2) * D, red, F.lane, c8, q8);
        if (nitem >= 0) P9_BLK_LOAD(nitem * PITEM);
        p9_token(vdB, cL + (PITEM - 1) * NSEL, yo + (size_t)(PITEM - 1) * D, red, F.lane, c8, q8);
        if (nitem >= 0) P9_BLK_STORE();
    }
#undef P9_GATHER
#undef P9_BLK_LOAD
#undef P9_BLK_STORE
}
template <int SIDE>
__device__ __forceinline__ void peer_phase(Frame& F0, int rep) {
    Frame F = F0; asm volatile("" : "+v"(F.lane));
    constexpr int NS = (SIDE == 0) ? NSLU : NSL;
    const int s0 = (int)(xb_xcc_id() & (unsigned)(NS - 1));
    unsigned* qbase = F.ctl() + (SIDE == 0 ? CW_QU : CW_QV) + rep * 64 * 32;
    LAS unsigned char* cf = F.lds + F.wave * PSLAB;
    for (int k = 0; k < NS; ++k) { const int sl = (s0 + k) & (NS - 1);
        int item = peer_next(qbase + 64 * sl, F.lane); bool filled = false;
        while (item < NPITEM) { int nitem = peer_next(qbase + 64 * sl, F.lane); if (nitem >= NPITEM) nitem = -1;
            if (SIDE == 0) p8_item(F, sl, item, nitem, filled, cf); else p9_item(F, sl, item, nitem, filled, cf);
            filled = nitem >= 0; item = nitem >= 0 ? nitem : NPITEM; } }
}
__device__ __forceinline__ void p10_final(Frame& F) {
    const int gwc = F.bid * NWAVES + F.wave, NGW = F.G * NWAVES;
    for (int row0 = gwc * 16; row0 < T; row0 += NGW * 16) {
        const int b = row0 >> 13; const float* mb = F.mod() + b * 6144 + 5120; const float* fm = F.fmod() + b * 2048;
        f32x4 g2[4], ca[4], cb[4];
#pragma unroll
        for (int j = 0; j < 4; ++j) { const int k = 256 * j + 4 * F.lane; g2[j] = *(const f32x4*)(mb + k); ca[j] = *(const f32x4*)(F.fnorm_g() + k) * (*(const f32x4*)(fm + 1024 + k) + 1.0f); cb[j] = *(const f32x4*)(fm + k); }
#pragma unroll 4
        for (int r = 0; r < 16; ++r) { float* hr = F.out() + (size_t)(row0 + r) * D; const bf16* yr = F.ybuf() + (size_t)(row0 + r) * D; const bf16* hb = F.hg() + (size_t)(row0 + r) * D;
            f32x4 z[4]; float ss = 0.f;
#pragma unroll
            for (int j = 0; j < 4; ++j) { const v2u hq = *(const v2u*)(hb + 256 * j + 4 * F.lane); f32x4 hv; hv[0] = bflo(hq[0]); hv[1] = bfhi(hq[0]); hv[2] = bflo(hq[1]); hv[3] = bfhi(hq[1]);
                const v2u yq = __builtin_nontemporal_load((const v2u*)(yr + 256 * j + 4 * F.lane)); f32x4 yv; yv[0] = bflo(yq[0]); yv[1] = bfhi(yq[0]); yv[2] = bflo(yq[1]); yv[3] = bfhi(yq[1]);
                z[j] = hv + g2[j] * yv; ss += z[j][0] * z[j][0] + z[j][1] * z[j][1] + z[j][2] * z[j][2] + z[j][3] * z[j][3]; }
            const float rstd = __builtin_amdgcn_rsqf(wave_sum(ss) * (1.0f / D) + EPS);
#pragma unroll
            for (int j = 0; j < 4; ++j) *(f32x4*)(hr + 256 * j + 4 * F.lane) = z[j] * rstd * ca[j] + cb[j]; }
    }
}

constexpr int NPHASE = 12;
__global__ void __launch_bounds__(NTHR, 2) fwd_kernel(Args args) {
    extern __shared__ __attribute__((aligned(16))) unsigned char lds_raw[];
    Frame F;
    F.lds = (LAS unsigned char*)lds_raw;
    F.tid = threadIdx.x; F.lane = F.tid & 63; F.wave = __builtin_amdgcn_readfirstlane(F.tid >> 6); F.G = gridDim.x; F.bid = blockIdx.x;
    unsigned char* ws = args.ws; F.a = &args;
    volatile LAS unsigned* misc = (volatile LAS unsigned*)(F.lds + MISC_OFF);
    if (F.tid < 64) misc[F.tid] = 0u;
    __syncthreads();
    const int lo = args.ph_lo, hi = args.ph_hi;
    const bool multi = (hi - lo) > 1;
    XcdBarrier bar; bar.bar = (unsigned*)(ws + WS_CTL) + CW_BAR; bar.x = 0; bar.st = nullptr;
    if (multi) bar = xcd_barrier_post((unsigned*)(ws + WS_CTL) + CW_BAR, misc + 8);
#ifndef PHMASK
#define PHMASK 0xfff
#endif
#define IN(k) (((PHMASK >> (k)) & 1) && lo <= (k) && (k) < hi)
#define SEAM(k) do { if (IN(k) && IN((k) + 1)) xcd_barrier(bar); } while (0)

#ifndef REPMASK
#define REPMASK 0
#endif
#define REP(k) (((REPMASK) >> (k)) & 1)
#define REPBAR(k) if (REP(k) && rep == 0) xcd_barrier(bar)
    if (IN(0)) { for (int rep = 0; rep <= REP(0); ++rep) { p0_prologue(F); REPBAR(0); } } SEAM(0);
    if (IN(1)) { for (int rep = 0; rep <= REP(1); ++rep) { p1_norm(F); REPBAR(1); } } SEAM(1);
    if (IN(2)) { { pg8::Gemm g{F.bufA(), F.Win_t(), T, NIN, D}; pg8::StaticOrder S; S.init(T, NIN, F.G, F.bid);
        pg8::EpiProj E{F.proj(), NIN};
        pg8::gemm_phase<pg8::EpiProj, pg8::StaticOrder, true, true>(F.lds, g, S, E); }
#if ((REPMASK) >> 2) & 1
        xcd_barrier(bar); { pg8::Gemm g{F.bufA(), F.Win_t(), T, NIN, D}; pg8::StaticOrder S; S.init(T, NIN, F.G, F.bid);
        pg8::EpiProj E{F.proj(), NIN};
        pg8::gemm_phase<pg8::EpiProj, pg8::StaticOrder, true, true>(F.lds, g, S, E); }
#endif
    } SEAM(2);
    if (IN(3)) { for (int rep = 0; rep <= REP(3); ++rep) {
        for (int it = F.bid; it < NB * NHH * 2 * NSEG; it += F.G) h1_item(F, it);
        asm volatile("s_waitcnt vmcnt(0)" ::: "memory");
        __syncthreads();
        if (F.tid == 0) { __builtin_amdgcn_fence(__ATOMIC_RELEASE, "agent"); asm volatile("s_waitcnt vmcnt(0)" ::: "memory"); (void)xb_add(F.ctl() + CW_H1, 1u); }
        float cw[CW];
#pragma unroll
        for (int j = 0; j < CW; ++j) cw[j] = F.conv_w()[j * DC + F.tid];
        const float cbias = F.conv_b()[F.tid];
        for (int it = F.bid; it < T / 32; it += F.G) conv_item(F, it, cw, cbias);
        if (F.tid == 0) { const unsigned tgt = (unsigned)F.G * (unsigned)(rep + 1); XB_SPIN(xb_ld(F.ctl() + CW_H1) < tgt, bar.bar); __builtin_amdgcn_fence(__ATOMIC_ACQUIRE, "agent"); asm volatile("s_waitcnt vmcnt(0)" ::: "memory"); }
        __syncthreads();
        h_scan(F);
        REPBAR(3); }
    } SEAM(3);
    if (IN(4)) { for (int rep = 0; rep <= REP(4); ++rep) { for (int it = F.bid; it < NB * NHH * NSEG; it += F.G) h2_item(F, it); REPBAR(4); } } SEAM(4);
    if (IN(5)) { { pg8::Gemm g{F.bufA(), F.Wout_t(), T, D, D}; pg8::StaticOrder S; S.init(T, D, F.G, F.bid);
        pg8::EpiOut E{F.x(), F.hg(), F.mod(), F.ssqp()};
        pg8::gemm_phase<pg8::EpiOut, pg8::StaticOrder, true, true>(F.lds, g, S, E); }
#if ((REPMASK) >> 5) & 1
        xcd_barrier(bar); { pg8::Gemm g{F.bufA(), F.Wout_t(), T, D, D}; pg8::StaticOrder S; S.init(T, D, F.G, F.bid);
        pg8::EpiOut E{F.x(), F.hg(), F.mod(), F.ssqp()};
        pg8::gemm_phase<pg8::EpiOut, pg8::StaticOrder, true, true>(F.lds, g, S, E); }
#endif
    } SEAM(5);
    if (IN(6)) { { pg8::Gemm g{F.hg(), F.Wqk_b(), T, NQK, D, (size_t)NQK * D * 2}; pg8::StaticOrder S; S.init(T, NQK, F.G, F.bid);
        EpiScoreTopk E{F.scores() + (size_t)F.bid * 65536, F.ssqp(), F.biasq(), F.rstd(), F.esel(), F.wsel()};
        pg8::gemm_phase<EpiScoreTopk, pg8::StaticOrder, true, true>(F.lds, g, S, E); }
    } SEAM(6);
    if (IN(8)) { for (int rep = 0; rep <= REP(8); ++rep) { peer_phase<0>(F, rep); REPBAR(8); } } SEAM(8);
    if (IN(9)) { for (int rep = 0; rep <= REP(9); ++rep) { p8b_coef(F); REPBAR(9); } } SEAM(9);
    if (IN(10)) { for (int rep = 0; rep <= REP(10); ++rep) { peer_phase<1>(F, rep); REPBAR(10); } } SEAM(10);
    if (IN(11)) { p10_final(F); }
#undef IN
#undef SEAM
}

#ifndef MK_ONE_LAUNCH
#define MK_ONE_LAUNCH 0
#endif
extern "C" void kernel_launch(void* const* d_in, const int* in_sizes, int n_in, void* d_out, int out_size, void* d_ws, size_t ws_size, hipStream_t stream) {
    static int grid = 0;
    if (grid == 0) {
        if (n_in != 23 || out_size != T * D || ws_size < WS_END) { fprintf(stderr, "kernel_launch: unexpected shapes (n_in %d, out %d, ws %zu)\n", n_in, out_size, ws_size); grid = -1; return; }
        int dev = 0, cus = 0, per_cu = 0;
        if (hipGetDevice(&dev) != hipSuccess || hipDeviceGetAttribute(&cus, hipDeviceAttributeMultiprocessorCount, dev) != hipSuccess) { grid = -1; return; }
        if (hipFuncSetAttribute((const void*)fwd_kernel, hipFuncAttributeMaxDynamicSharedMemorySize, LDS_BYTES) != hipSuccess) { fprintf(stderr, "kernel_launch: hipFuncSetAttribute failed\n"); grid = -1; return; }
        if (hipOccupancyMaxActiveBlocksPerMultiprocessor(&per_cu, (const void*)fwd_kernel, NTHR, LDS_BYTES) != hipSuccess || per_cu < 1) { fprintf(stderr, "kernel_launch: occupancy query reports %d\n", per_cu); }
        (void)hipGetLastError();
        grid = cus;
    }
    if (grid < 0) return;
    (void)hipMemsetAsync((char*)d_ws + WS_CTL, 0, CTL_ZERO_BYTES, stream);
    Args a{};
    for (int i = 0; i < 23; ++i) a.in[i] = (const float*)d_in[i];
    a.out = (float*)d_out; a.ws = (unsigned char*)d_ws;
#if MK_ONE_LAUNCH
    a.ph_lo = 0; a.ph_hi = NPHASE;
    hipLaunchKernelGGL(fwd_kernel, dim3(grid), dim3(NTHR), LDS_BYTES, stream, a);
#else
    for (int p = 0; p < NPHASE; ++p) { a.ph_lo = p; a.ph_hi = p + 1; hipLaunchKernelGGL(fwd_kernel, dim3(grid), dim3(NTHR), LDS_BYTES, stream, a); }
#endif
}
```

```cpp
#include <hip/hip_runtime.h>
#include <cstdio>
#include <cstdint>
namespace pg8 {
#define PG8_LAS __attribute__((address_space(3)))
typedef unsigned short bf16_t;
typedef short bf16x8 __attribute__((ext_vector_type(8)));
typedef float f32x4 __attribute__((ext_vector_type(4)));
typedef unsigned u32x4 __attribute__((ext_vector_type(4)));
constexpr int BM = 256, BK = 64, HALF = 128, HTB = HALF * BK * 2  , STAGE_BYTES = 8 * HTB, NXCD = 8, WGM = 8;

__host__ __device__ __forceinline__ int lds_byte(int r, int c) { const int st = (r >> 4) * 2 + (c >> 5), rr = r & 15, cc = c & 31, ob = rr * 64 + cc * 2; return st * 1024 + (ob ^ (((ob >> 9) & 1) << 5)); }
__host__ __device__ __forceinline__ void stage_rc(int b, int& R, int& C) { const int st = b / 1024, sb = b % 1024, swz = sb ^ (((sb >> 9) & 1) << 5); R = (st >> 1) * 16 + swz / 64; C = (st & 1) * 32 + (swz % 64) / 2; }
__host__ __device__ __forceinline__ int perm32(int rho) { const int n = rho >> 4, i = rho & 15; return 8 * (i >> 2) + 4 * n + (i & 3); }

struct Unit { int pm, pn; };
struct Gemm { const bf16_t* A; const bf16_t* Bt; int M, N, K; size_t bbatch = 0; };

struct StaticOrder {
    int nM, nN, nwg, G, c;
    __host__ __device__ void init(int M, int N, int G_, int c_) { nM = M / BM; nN = N / BM; nwg = nM * nN; G = G_; c = c_; }
    __host__ __device__ bool next(int i, Unit& u) const {
        const long L = (long)i * G + c; if (L >= nwg) return false;
        int wgid = (int)L; { const int q = nwg / NXCD, r = nwg % NXCD, xcd = wgid % NXCD, off = wgid / NXCD; wgid = (xcd < r ? xcd * (q + 1) : r * (q + 1) + (xcd - r) * q) + off; }
        const int nig = WGM * nN, gid = wgid / nig, fm = gid * WGM, gsz = (nM - fm) < WGM ? (nM - fm) : WGM;
        u.pm = fm + ((wgid % nig) % gsz); u.pn = (wgid % nig) / gsz; return true;
    }
    __device__ __forceinline__ void a_ready(const Unit&) const {}
    __device__ __forceinline__ void done(const Unit&) const {}
};
__device__ __forceinline__ unsigned cvt_pk_bf16(float lo, float hi) { unsigned r; asm volatile("v_cvt_pk_bf16_f32 %0, %1, %2" : "=v"(r) : "v"(lo), "v"(hi)); return r; }
typedef float f32x2 __attribute__((ext_vector_type(2)));
__device__ __forceinline__ f32x2 gelu_pk(f32x2 v) {
    const f32x2 av = __builtin_elementwise_abs(v), d = av * 0.2316418882f + 1.0f;
    f32x2 t; t.x = __builtin_amdgcn_rcpf(d.x); t.y = __builtin_amdgcn_rcpf(d.y);
    f32x2 q = t * 0.5307027145f + (-0.7265760135f); q = q * t + 0.7107068705f; q = q * t + (-0.142248368f); q = q * t + 0.127414796f; q = q * t;
    const f32x2 s = (v * v) * (-0.72134752044f);
    f32x2 e; e.x = __builtin_amdgcn_exp2f(s.x); e.y = __builtin_amdgcn_exp2f(s.y);
    const f32x2 m = v * (q * e), r = v - m;
    f32x2 o; o.x = v.x < 0.f ? m.x : r.x; o.y = v.y < 0.f ? m.y : r.y; return o;
}

template <int ACT  > struct EpiBf16 {
    static constexpr bool PERM = true, AFTER_DRAIN = false; static_assert(ACT == 0 || ACT == 1, "EpiBf16: ACT is 0 (none) or 1 (gelu_pk)");
    bf16_t* O; int ldc; const float* bias; int split_cols; size_t split_stride; float scale0;
    __device__ __forceinline__ void operator()(const f32x4 (&acc)[2][2][4][2], const Unit& u, int wr, int wc, int fr, int fq) const {
        const int row0 = u.pm * BM + wr * 64 + fr; int colt = u.pn * BM; bf16_t* base = O;
        float sc = 1.f; if (split_cols) { const int t = colt / split_cols; base += (size_t)t * split_stride; colt -= t * split_cols; if (t == 0) sc = scale0; }
        const int col0 = colt + wc * 32 + 8 * fq, bcol0 = u.pn * BM + wc * 32 + 8 * fq;
        f32x4 bv[2][2];
#pragma unroll
        for (int bj = 0; bj < 2; ++bj)
#pragma unroll
            for (int n = 0; n < 2; ++n) bv[bj][n] = bias ? *(const f32x4*)(bias + bcol0 + bj * HALF + 4 * n) : (f32x4){0.f, 0.f, 0.f, 0.f};
#pragma unroll
        for (int ai = 0; ai < 2; ++ai)
#pragma unroll
            for (int m = 0; m < 4; ++m) { bf16_t* rowp = base + (size_t)(row0 + ai * HALF + m * 16) * ldc + col0;
#pragma unroll
                for (int bj = 0; bj < 2; ++bj) { f32x4 v0 = acc[ai][bj][m][0] + bv[bj][0], v1 = acc[ai][bj][m][1] + bv[bj][1];
                    if (ACT == 1) { f32x2 a = gelu_pk((f32x2){v0[0], v0[1]}), b = gelu_pk((f32x2){v0[2], v0[3]}), c = gelu_pk((f32x2){v1[0], v1[1]}), d = gelu_pk((f32x2){v1[2], v1[3]});
                        v0 = (f32x4){a.x, a.y, b.x, b.y}; v1 = (f32x4){c.x, c.y, d.x, d.y}; }
                    v0 = v0 * sc; v1 = v1 * sc; u32x4 w; w.x = cvt_pk_bf16(v0[0], v0[1]); w.y = cvt_pk_bf16(v0[2], v0[3]); w.z = cvt_pk_bf16(v1[0], v1[1]); w.w = cvt_pk_bf16(v1[2], v1[3]);
                    *(u32x4*)(rowp + bj * HALF) = w; } }
    }
};

struct EpiOut {
    static constexpr bool PERM = true, AFTER_DRAIN = false;
    const float* X; bf16_t* HB; const float* mod; float* ssqp;
    __device__ __forceinline__ void operator()(const f32x4 (&acc)[2][2][4][2], const Unit& u, int wr, int wc, int fr, int fq) const {
        const int row0 = u.pm * BM + wr * 64 + fr, col0 = u.pn * BM + wc * 32 + 8 * fq;
        const int b = (u.pm * BM) >> 13;
        const float* mb = mod + b * 6144;
        f32x4 g1v[2][2];
#pragma unroll
        for (int bj = 0; bj < 2; ++bj)
#pragma unroll
            for (int n = 0; n < 2; ++n) g1v[bj][n] = *(const f32x4*)(mb + 2048 + col0 + bj * HALF + 4 * n);
#pragma unroll
        for (int ai = 0; ai < 2; ++ai)
#pragma unroll
            for (int m = 0; m < 4; ++m) { const int row = row0 + ai * HALF + m * 16; const size_t ro = (size_t)row * 1024 + col0; float ss = 0.f;
#pragma unroll
                for (int bj = 0; bj < 2; ++bj) {
                    const f32x4 x0 = *(const f32x4*)(X + ro + bj * HALF), x1 = *(const f32x4*)(X + ro + bj * HALF + 4);
                    const f32x4 h0 = x0 + g1v[bj][0] * acc[ai][bj][m][0], h1 = x1 + g1v[bj][1] * acc[ai][bj][m][1];
                    u32x4 hw; hw.x = cvt_pk_bf16(h0[0], h0[1]); hw.y = cvt_pk_bf16(h0[2], h0[3]); hw.z = cvt_pk_bf16(h1[0], h1[1]); hw.w = cvt_pk_bf16(h1[2], h1[3]);
                    *(u32x4*)(HB + ro + bj * HALF) = hw;
                    ss += h0[0] * h0[0] + h0[1] * h0[1] + h0[2] * h0[2] + h0[3] * h0[3] + h1[0] * h1[0] + h1[1] * h1[1] + h1[2] * h1[2] + h1[3] * h1[3]; }
                ss += __shfl_xor(ss, 16); ss += __shfl_xor(ss, 32);
                if (fq == 0) ssqp[((size_t)u.pn * 32768 + row) * 4 + wc] = ss; }
    }
};
struct EpiScore {
    static constexpr bool PERM = false, AFTER_DRAIN = false;
    float* S; const float* ssqp; const float* biasq; float* rstd_out;
    __device__ __forceinline__ void operator()(const f32x4 (&acc)[2][2][4][2], const Unit& u, int wr, int wc, int fr, int fq) const {
        const int row0 = u.pm * BM + wr * 64 + fr, col0 = u.pn * BM + wc * 32 + 4 * fq;
        const int b = (u.pm * BM) >> 13;
        f32x4 bv[2][2];
#pragma unroll
        for (int bj = 0; bj < 2; ++bj)
#pragma unroll
            for (int n = 0; n < 2; ++n) bv[bj][n] = *(const f32x4*)(biasq + b * 2048 + col0 + bj * HALF + n * 16);
#pragma unroll
        for (int ai = 0; ai < 2; ++ai)
#pragma unroll
            for (int m = 0; m < 4; ++m) { const int row = row0 + ai * HALF + m * 16;
                const f32x4 p0 = *(const f32x4*)(ssqp + (size_t)row * 4), p1 = *(const f32x4*)(ssqp + ((size_t)32768 + row) * 4), p2 = *(const f32x4*)(ssqp + ((size_t)65536 + row) * 4), p3 = *(const f32x4*)(ssqp + ((size_t)98304 + row) * 4);
                const float tot = (p0[0] + p0[1] + p0[2] + p0[3]) + (p1[0] + p1[1] + p1[2] + p1[3]) + (p2[0] + p2[1] + p2[2] + p2[3]) + (p3[0] + p3[1] + p3[2] + p3[3]);
                const float rstd = __builtin_amdgcn_rsqf(tot * (1.0f / 1024.0f) + 1e-6f);
                if (u.pn == 0 && wc == 0 && fq == 0) rstd_out[row] = rstd;
                float* rowp = S + (size_t)row * 2048 + col0;
#pragma unroll
                for (int bj = 0; bj < 2; ++bj)
#pragma unroll
                    for (int n = 0; n < 2; ++n) *(f32x4*)(rowp + bj * HALF + n * 16) = acc[ai][bj][m][n] * rstd + bv[bj][n]; }
    }
};

struct EpiProj {
    static constexpr bool PERM = true, AFTER_DRAIN = false;
    bf16_t* O; int ldc;
    __device__ __forceinline__ void operator()(const f32x4 (&acc)[2][2][4][2], const Unit& u, int wr, int wc, int fr, int fq) const {
        asm volatile("" : "+v"(fr), "+v"(fq));
        const int row0 = u.pm * BM + wr * 64 + fr, col0 = u.pn * BM + wc * 32 + 8 * fq;
        const int cls = u.pn >> 1;
        const bool ident = (cls == 3) || (cls == 5), mulx = (cls == 0) || (cls == 4);
        const float sgn = (cls == 1 || cls == 2) ? 1.4426950408889634f : -1.4426950408889634f;
#pragma unroll
        for (int ai = 0; ai < 2; ++ai)
#pragma unroll
            for (int m = 0; m < 4; ++m) { bf16_t* rowp = O + (size_t)(row0 + ai * HALF + m * 16) * ldc + col0;
#pragma unroll
                for (int bj = 0; bj < 2; ++bj) { f32x4 v0 = acc[ai][bj][m][0], v1 = acc[ai][bj][m][1];
                    if (!ident) {
#pragma unroll
                        for (int j = 0; j < 4; ++j) { const float r0 = __builtin_amdgcn_rcpf(1.0f + __builtin_amdgcn_exp2f(sgn * v0[j])), r1 = __builtin_amdgcn_rcpf(1.0f + __builtin_amdgcn_exp2f(sgn * v1[j]));
                            v0[j] = mulx ? v0[j] * r0 : r0; v1[j] = mulx ? v1[j] * r1 : r1; } }
                    u32x4 w; w.x = cvt_pk_bf16(v0[0], v0[1]); w.y = cvt_pk_bf16(v0[2], v0[3]); w.z = cvt_pk_bf16(v1[0], v1[1]); w.w = cvt_pk_bf16(v1[2], v1[3]);
                    *(u32x4*)(rowp + bj * HALF) = w; } }
    }
};
template <class Epi, class Sched, bool ALIGN_EPI = false, bool SP2 = false>
__device__ __forceinline__ void gemm_phase(PG8_LAS unsigned char* lds, const Gemm g, const Sched& S, const Epi& E) {
    const int tid = threadIdx.x, wid = __builtin_amdgcn_readfirstlane(tid >> 6), lane = tid & 63, wr = wid >> 2, wc = wid & 3, fr = lane & 15, fq = lane >> 4;
    const int K = g.K, nt = K / BK;
    unsigned voffA[2], voffB[2];
#pragma unroll
    for (int i = 0; i < 2; ++i) { int R, C; stage_rc(tid * 16 + i * 8192, R, C); const int Rb = Epi::PERM ? ((R & ~31) + perm32(R & 31)) : R;
        voffA[i] = (unsigned)(R * K + C) * 2u; voffB[i] = (unsigned)(Rb * K + C) * 2u; }
    const size_t kstep = (size_t)(BK * 2);
    const size_t hstep = (size_t)HALF * K * 2;
    const size_t tstep = 2 * hstep;
    const unsigned ldsw = (unsigned)wid * 1024u;
    const int aoff = lds_byte(wr * 64 + fr, fq * 8), boff = lds_byte(wc * 32 + fr, fq * 8);
#define PG8_SA(b, h) (((b) * 2 + (h)) * HTB)
#define PG8_SB(b, h) ((4 + (b) * 2 + (h)) * HTB)
#define PG8_STAGE(bufoff, gbase, voff) do { _Pragma("unroll") for (int _i = 0; _i < 2; ++_i) \
        __builtin_amdgcn_global_load_lds((const unsigned*)((const char*)(gbase) + (voff)[_i]), (PG8_LAS unsigned*)(lds + (bufoff) + ldsw + _i * 8192), 16, 0, 0); } while (0)
#define PG8_LDA(dst, b, h) do { _Pragma("unroll") for (int m = 0; m < 4; ++m) _Pragma("unroll") for (int k = 0; k < 2; ++k) dst[m][k] = *(const PG8_LAS bf16x8*)(lds + PG8_SA(b, h) + aoff + m * 2048 + k * 1024); } while (0)
#define PG8_LDB(dst, b, h) do { _Pragma("unroll") for (int n = 0; n < 2; ++n) _Pragma("unroll") for (int k = 0; k < 2; ++k) dst[n][k] = *(const PG8_LAS bf16x8*)(lds + PG8_SB(b, h) + boff + n * 2048 + k * 1024); } while (0)
#define PG8_MMA(ai, bj, At, Bt) do { __builtin_amdgcn_s_setprio(1); _Pragma("unroll") for (int m = 0; m < 4; ++m) _Pragma("unroll") for (int n = 0; n < 2; ++n) _Pragma("unroll") for (int k = 0; k < 2; ++k) \
        acc[ai][bj][m][n] = __builtin_amdgcn_mfma_f32_16x16x32_bf16(Bt[n][k], At[m][k], acc[ai][bj][m][n], 0, 0, 0); __builtin_amdgcn_s_setprio(0); } while (0)
#define PG8_WAIT_V(n) asm volatile("s_waitcnt vmcnt(" #n ")" ::: "memory")
#define PG8_WAIT_L(n) asm volatile("s_waitcnt lgkmcnt(" #n ")" ::: "memory")
#define PG8_BAR __builtin_amdgcn_s_barrier()
#define PG8_SCHED __builtin_amdgcn_sched_barrier(0)
    Unit cur, nxt; int ui = 0;
    if (!S.next(0, cur)) return;
    f32x4 acc[2][2][4][2];
#pragma unroll
    for (int a = 0; a < 2; ++a)
#pragma unroll
        for (int b = 0; b < 2; ++b)
#pragma unroll
            for (int m = 0; m < 4; ++m)
#pragma unroll
                for (int n = 0; n < 2; ++n) acc[a][b][m][n] = (f32x4){0.f, 0.f, 0.f, 0.f};
    bf16x8 At[4][2], B0[2][2], B1[2][2];
    const char* cA = (const char*)g.A + (size_t)cur.pm * tstep; const char* cB = (const char*)g.Bt + (size_t)cur.pn * tstep + (size_t)(cur.pm >> 5) * g.bbatch;
    S.a_ready(cur);
    if constexpr (SP2) {
        PG8_STAGE(PG8_SB(0, 0), cB, voffB); PG8_STAGE(PG8_SB(0, 1), cB + hstep, voffB); PG8_STAGE(PG8_SA(0, 0), cA, voffA); PG8_STAGE(PG8_SA(0, 1), cA + hstep, voffA);
        if (wr == 1) PG8_BAR;
        PG8_WAIT_V(2); PG8_BAR;
        PG8_STAGE(PG8_SB(1, 0), cB + kstep, voffB); PG8_STAGE(PG8_SA(1, 0), cA + kstep, voffA); PG8_STAGE(PG8_SB(1, 1), cB + hstep + kstep, voffB);
        PG8_WAIT_V(6); PG8_BAR;
    } else {
        PG8_STAGE(PG8_SB(0, 0), cB, voffB); PG8_STAGE(PG8_SA(0, 0), cA, voffA); PG8_STAGE(PG8_SB(0, 1), cB + hstep, voffB); PG8_STAGE(PG8_SA(0, 1), cA + hstep, voffA);
        if (wr == 1) PG8_BAR;
        PG8_WAIT_V(4); PG8_BAR;
        PG8_STAGE(PG8_SB(1, 0), cB + kstep, voffB); PG8_STAGE(PG8_SA(1, 0), cA + kstep, voffA); PG8_STAGE(PG8_SB(1, 1), cB + hstep + kstep, voffB);
        PG8_WAIT_V(6); PG8_BAR;
    }
    for (;;) {
        const bool has_next = S.next(ui + 1, nxt);
        const char* nA = has_next ? (const char*)g.A + (size_t)nxt.pm * tstep : cA; const char* nB = has_next ? (const char*)g.Bt + (size_t)nxt.pn * tstep + (size_t)(nxt.pm >> 5) * g.bbatch : cB;
        for (int t = 0; t < nt; t += 2) {
            const bool last = (t == nt - 2);
            const char* a1 = cA + (size_t)(t + 1) * kstep;
            const char* a2 = last ? nA : cA + (size_t)(t + 2) * kstep; const char* b2 = last ? nB : cB + (size_t)(t + 2) * kstep;
            const char* a3 = a2 + kstep; const char* b3 = b2 + kstep;
            if (last && has_next) S.a_ready(nxt);
            if constexpr (SP2) {
            PG8_LDB(B0, 0, 0); PG8_LDB(B1, 0, 1); PG8_SCHED; PG8_LDA(At, 0, 0); PG8_STAGE(PG8_SA(1, 1), a1 + hstep, voffA);
            PG8_WAIT_V(8); PG8_WAIT_L(0); PG8_BAR; PG8_MMA(0, 0, At, B0); PG8_MMA(0, 1, At, B1); PG8_BAR; PG8_SCHED;
            PG8_LDA(At, 0, 1); PG8_STAGE(PG8_SB(0, 0), b2, voffB); PG8_STAGE(PG8_SB(0, 1), b2 + hstep, voffB); PG8_STAGE(PG8_SA(0, 0), a2, voffA);
            PG8_WAIT_V(8); PG8_WAIT_L(0); PG8_BAR; PG8_MMA(1, 0, At, B0); PG8_MMA(1, 1, At, B1); PG8_BAR; PG8_SCHED;
            PG8_LDB(B0, 1, 0); PG8_LDB(B1, 1, 1); PG8_SCHED; PG8_LDA(At, 1, 0); PG8_STAGE(PG8_SA(0, 1), a2 + hstep, voffA);
            PG8_WAIT_V(8); PG8_WAIT_L(0); PG8_BAR; PG8_MMA(0, 0, At, B0); PG8_MMA(0, 1, At, B1); PG8_BAR; PG8_SCHED;
            PG8_LDA(At, 1, 1); PG8_STAGE(PG8_SB(1, 0), b3, voffB); PG8_STAGE(PG8_SB(1, 1), b3 + hstep, voffB); PG8_STAGE(PG8_SA(1, 0), a3, voffA);
            PG8_WAIT_V(8); PG8_WAIT_L(0); PG8_BAR; PG8_MMA(1, 0, At, B0); PG8_MMA(1, 1, At, B1); PG8_BAR; PG8_SCHED;
            } else {
            PG8_LDB(B0, 0, 0); PG8_SCHED; PG8_LDA(At, 0, 0); PG8_STAGE(PG8_SA(1, 1), a1 + hstep, voffA);
            PG8_WAIT_L(8); PG8_BAR; PG8_WAIT_L(0); PG8_MMA(0, 0, At, B0); PG8_BAR; PG8_SCHED;
            PG8_LDB(B1, 0, 1); PG8_STAGE(PG8_SB(0, 0), b2, voffB);
            PG8_BAR; PG8_WAIT_L(0); PG8_MMA(0, 1, At, B1); PG8_BAR;
            PG8_LDA(At, 0, 1); PG8_STAGE(PG8_SA(0, 0), a2, voffA);
            PG8_BAR; PG8_WAIT_L(0); PG8_MMA(1, 0, At, B0); PG8_BAR; PG8_SCHED;
            PG8_STAGE(PG8_SB(0, 1), b2 + hstep, voffB);
            PG8_WAIT_V(6); PG8_BAR; PG8_MMA(1, 1, At, B1); PG8_BAR;
            PG8_LDB(B0, 1, 0); PG8_SCHED; PG8_LDA(At, 1, 0); PG8_STAGE(PG8_SA(0, 1), a2 + hstep, voffA);
            PG8_WAIT_L(8); PG8_BAR; PG8_WAIT_L(0); PG8_MMA(0, 0, At, B0); PG8_BAR; PG8_SCHED;
            PG8_LDB(B1, 1, 1); PG8_STAGE(PG8_SB(1, 0), b3, voffB);
            PG8_BAR; PG8_WAIT_L(0); PG8_MMA(0, 1, At, B1); PG8_BAR;
            PG8_LDA(At, 1, 1); PG8_STAGE(PG8_SA(1, 0), a3, voffA);
            PG8_BAR; PG8_WAIT_L(0); PG8_MMA(1, 0, At, B0); PG8_BAR; PG8_SCHED;
            PG8_STAGE(PG8_SB(1, 1), b3 + hstep, voffB);
            PG8_WAIT_V(6); PG8_BAR; PG8_MMA(1, 1, At, B1); PG8_BAR;
            }
        }
        if constexpr (ALIGN_EPI) { if (wr == 0) PG8_BAR; }
        if constexpr (!Epi::AFTER_DRAIN) { E(acc, cur, wr, wc, fr, fq); S.done(cur); }
        if (!has_next) break;
#pragma unroll
        for (int a = 0; a < 2; ++a)
#pragma unroll
            for (int b = 0; b < 2; ++b)
#pragma unroll
                for (int m = 0; m < 4; ++m)
#pragma unroll
                    for (int n = 0; n < 2; ++n) acc[a][b][m][n] = (f32x4){0.f, 0.f, 0.f, 0.f};
        cur = nxt; cA = nA; cB = nB; ++ui;
        if constexpr (ALIGN_EPI) { if (wr == 1) PG8_BAR; }
    }
    PG8_WAIT_V(0);
    if constexpr (!ALIGN_EPI) { if (wr == 0) PG8_BAR; }
    PG8_BAR;
    if constexpr (Epi::AFTER_DRAIN) { E.fused(acc, cur, wr, wc, fr, fq, lds, wid, lane); S.done(cur); }
#undef PG8_SA
#undef PG8_SB
#undef PG8_STAGE
#undef PG8_LDA
#undef PG8_LDB
#undef PG8_MMA
#undef PG8_WAIT_V
#undef PG8_WAIT_L
#undef PG8_BAR
#undef PG8_SCHED
}
}
#define MK_ONE_LAUNCH 1

constexpr int NB = 4, SEQ = 8192, T = NB * SEQ, D = 1024;
constexpr int NIN = 3584, DH = 512, HD = 128, NHH = 4, CHK = 64;
constexpr int NSEG = 16, SEGC = 8;
constexpr int CW = 31, CPAD = 15, DC = 512;
constexpr int PHEADS = 8, NQK = 2048, NSEL = 128;
constexpr float EPS = 1e-6f;
constexpr int NWAVES = 8, NTHR = 512;

constexpr size_t MiB = 1u << 20;
constexpr size_t WS_CTL = 0, CTL_ZERO_BYTES = 65536;
constexpr size_t WS_MOD = 1 * MiB, WS_FMOD = WS_MOD + 131072, WS_LB = WS_MOD + 196608, WS_BIASQ = WS_MOD + 262144;
constexpr size_t WS_WIN = 2 * MiB, WS_WOUT = 10 * MiB, WS_WQK = 12 * MiB;
constexpr size_t WS_UT = 16 * MiB, WS_WQKB = 24 * MiB, WS_VT = 48 * MiB;
constexpr size_t WS_BUFA = 80 * MiB;
constexpr size_t WS_BUFB = 144 * MiB;
constexpr size_t WS_SEG = 208 * MiB;
constexpr size_t WS_E = 208 * MiB, WS_W = 224 * MiB;
constexpr size_t WS_BIG = 240 * MiB;
constexpr size_t WS_SSQ = 496 * MiB;
constexpr size_t WS_SEGA = 498 * MiB;
constexpr size_t WS_RSTD = 499 * MiB;
constexpr size_t WS_END = 500 * MiB;
constexpr size_t WS_PACT = 240 * MiB;
constexpr size_t WS_Y = 368 * MiB;
constexpr int NSL = 8, CSL = 128;
constexpr float VSCALE = 16.0f;
constexpr float UQSCALE = 95.5f;
constexpr int NSLU = 4, CSLU = 256;
constexpr int CW_QU = 8192, CW_QV = 8192 + 64 * 16;
constexpr int CW_GV = 6400;
constexpr int CW_H1 = 6144;
constexpr int CW_BAR = 1024;

#ifndef LDSFILL
#define LDSFILL 0u
#endif
constexpr int LDS_BYTES = 155648;
constexpr int MISC_OFF = LDS_BYTES - 256;

#define GAS __attribute__((address_space(1)))
#define LAS __attribute__((address_space(3)))
typedef unsigned short bf16;
typedef unsigned v4u __attribute__((ext_vector_type(4)));
typedef unsigned v2u __attribute__((ext_vector_type(2)));
typedef float f32x4 __attribute__((ext_vector_type(4)));
typedef float f32x16 __attribute__((ext_vector_type(16)));
typedef short bf16x8 __attribute__((ext_vector_type(8)));
typedef float f32x2_ __attribute__((ext_vector_type(2)));

__device__ __forceinline__ float bf2f(unsigned h) { return __builtin_bit_cast(float, h << 16); }
__device__ __forceinline__ float bflo(unsigned u) { return __builtin_bit_cast(float, u << 16); }
__device__ __forceinline__ float bfhi(unsigned u) { return __builtin_bit_cast(float, u & 0xffff0000u); }
__device__ __forceinline__ unsigned f2bf(float f) { unsigned u = __builtin_bit_cast(unsigned, f); return (u + 0x7fffu + ((u >> 16) & 1u)) >> 16; }
__device__ __forceinline__ unsigned pk2(float lo, float hi) { return f2bf(lo) | (f2bf(hi) << 16); }
__device__ __forceinline__ unsigned cvtpk(float lo, float hi) { unsigned r; asm("v_cvt_pk_bf16_f32 %0, %1, %2" : "=v"(r) : "v"(lo), "v"(hi)); return r; }
__device__ __forceinline__ float sigmoidf_(float x) { return __builtin_amdgcn_rcpf(1.0f + __expf(-x)); }
#define DPP_ADD(s, ctrl) ((s) + __builtin_bit_cast(float, __builtin_amdgcn_update_dpp(0, __builtin_bit_cast(int, (s)), (ctrl), 0xF, 0xF, false)))
__device__ __forceinline__ float wave_sum(float v) {
#pragma unroll
    for (int o = 1; o < 64; o <<= 1) v += __shfl_xor(v, o);
    return v;
}

#define XB_TMO      128
#define XB_XCNT(j)  (256  + 64 * (j))
#define XB_XSUB(j)  (1280 + 64 * (j))
#define XB_XGEN(j)  (2304 + 64 * (j))
#define XB_TOP      3328
#define XB_TOPGEN   3392
#define XCD_BAR_WORDS 3456
#define XB_SPIN_CAP (1u << 18)
__device__ __forceinline__ unsigned xb_ld(unsigned* p)              { return __hip_atomic_load(p, __ATOMIC_RELAXED, __HIP_MEMORY_SCOPE_AGENT); }
__device__ __forceinline__ unsigned xb_add(unsigned* p, unsigned v) { return __hip_atomic_fetch_add(p, v, __ATOMIC_RELAXED, __HIP_MEMORY_SCOPE_AGENT); }
__device__ __forceinline__ unsigned xb_xcc_id() { return (unsigned)__builtin_amdgcn_s_getreg((3 << 11) | 20) & 0xFu; }
#define XB_SPIN(cond, bar) do { unsigned _sp = 0; while (cond) { __builtin_amdgcn_s_sleep(1); \
    if ((++_sp & 255u) == 0u) { if (xb_ld(&(bar)[XB_TMO])) break; if (_sp > XB_SPIN_CAP) { atomicAdd(&(bar)[XB_TMO], 1u); break; } } } } while (0)
struct XcdBarrier { unsigned* bar; unsigned x; volatile LAS unsigned* st; };
__device__ __forceinline__ XcdBarrier xcd_barrier_post(unsigned* bar, volatile LAS unsigned* st) {
    XcdBarrier b; b.bar = bar; b.x = xb_xcc_id(); b.st = st;
    if (threadIdx.x == 0) (void)xb_add(&bar[XB_XCNT(b.x)], 1u);
    return b;
}
__device__ __forceinline__ void xcd_barrier_complete(unsigned* bar, unsigned x, unsigned& nloc, unsigned& nx) {
    const unsigned G = gridDim.x * gridDim.y * gridDim.z;
    unsigned sum, cnt, mine, sp = 0u;
    for (;;) {
        sum = 0u; cnt = 0u; mine = 0u;
#pragma unroll
        for (unsigned j = 0; j < 16; ++j) { const unsigned c = xb_ld(&bar[XB_XCNT(j)]); sum += c; cnt += (c > 0u) ? 1u : 0u; mine = (j == x) ? c : mine; }
        if (sum == G) break;
        __builtin_amdgcn_s_sleep(1);
        if ((++sp & 255u) == 0u) { if (xb_ld(&bar[XB_TMO])) break; if (sp > XB_SPIN_CAP) { atomicAdd(&bar[XB_TMO], 1u); break; } }
    }
    nloc = mine > 0u ? mine : 1u; nx = cnt > 0u ? cnt : 1u;
}
__device__ __forceinline__ void xcd_barrier(const XcdBarrier& b) {
    asm volatile("s_waitcnt vmcnt(0)" ::: "memory");
    __syncthreads();
    if (threadIdx.x == 0) {
        unsigned* bar = b.bar;
        __builtin_amdgcn_s_waitcnt(0);
        unsigned nloc = b.st[0], nx = b.st[1];
        if (nloc == 0u) { xcd_barrier_complete(bar, b.x, nloc, nx); b.st[0] = nloc; b.st[1] = nx; }
        const unsigned old = xb_add(&bar[XB_XSUB(b.x)], 1u);
        const unsigned gen = old / nloc;
        if (old + 1u == (gen + 1u) * nloc) {
            __builtin_amdgcn_fence(__ATOMIC_RELEASE, "agent");
            asm volatile("s_waitcnt vmcnt(0)" ::: "memory");
            const unsigned og = xb_add(&bar[XB_TOP], 1u);
            const unsigned tg = og / nx;
            if (og + 1u == (tg + 1u) * nx) xb_add(&bar[XB_TOPGEN], 1u);
            else XB_SPIN(xb_ld(&bar[XB_TOPGEN]) == tg, bar);
            __builtin_amdgcn_fence(__ATOMIC_ACQUIRE, "agent");
            xb_add(&bar[XB_XGEN(b.x)], 1u);
            asm volatile("s_waitcnt vmcnt(0)" ::: "memory");
        } else {
            XB_SPIN(xb_ld(&bar[XB_XGEN(b.x)]) == gen, bar);
            __builtin_amdgcn_fence(__ATOMIC_ACQUIRE, "agent");
            asm volatile("s_waitcnt vmcnt(0)" ::: "memory");
        }
    }
    __syncthreads();
}

struct Args { const float* in[23]; float* out; unsigned char* ws; int ph_lo, ph_hi; };
struct Frame {
    LAS unsigned char* lds;
    int tid, lane, wave, G, bid;
    const Args* a;
    __device__ __forceinline__ const float* x() const { return a->in[0]; }
    __device__ __forceinline__ const float* c() const { return a->in[1]; }
    __device__ __forceinline__ const float* ada_w() const { return a->in[2]; }
    __device__ __forceinline__ const float* ada_b() const { return a->in[3]; }
    __device__ __forceinline__ const float* g_mix() const { return a->in[4]; }
    __device__ __forceinline__ const float* w_in() const { return a->in[5]; }
    __device__ __forceinline__ const float* lbg_f() const { return a->in[6]; }
    __device__ __forceinline__ const float* lbg_b() const { return a->in[7]; }
    __device__ __forceinline__ const float* hnorm_g() const { return a->in[8]; }
    __device__ __forceinline__ const float* conv_w() const { return a->in[9]; }
    __device__ __forceinline__ const float* conv_b() const { return a->in[10]; }
    __device__ __forceinline__ const float* cln_g() const { return a->in[11]; }
    __device__ __forceinline__ const float* cln_b() const { return a->in[12]; }
    __device__ __forceinline__ const float* w_out() const { return a->in[13]; }
    __device__ __forceinline__ const float* g_ffn() const { return a->in[14]; }
    __device__ __forceinline__ const float* wq() const { return a->in[15]; }
    __device__ __forceinline__ const float* keys1() const { return a->in[16]; }
    __device__ __forceinline__ const float* keys2() const { return a->in[17]; }
    __device__ __forceinline__ const float* utab() const { return a->in[18]; }
    __device__ __forceinline__ const float* vtab() const { return a->in[19]; }
    __device__ __forceinline__ const float* fada_w() const { return a->in[20]; }
    __device__ __forceinline__ const float* fada_b() const { return a->in[21]; }
    __device__ __forceinline__ const float* fnorm_g() const { return a->in[22]; }
    __device__ __forceinline__ float* out() const { return a->out; }
    __device__ __forceinline__ float* mod() const { return (float*)(a->ws + WS_MOD); }
    __device__ __forceinline__ float* fmod() const { return (float*)(a->ws + WS_FMOD); }
    __device__ __forceinline__ float* lb() const { return (float*)(a->ws + WS_LB); }
    __device__ __forceinline__ float* biasq() const { return (float*)(a->ws + WS_BIASQ); }
    __device__ __forceinline__ float* ssqp() const { return (float*)(a->ws + WS_SSQ); }
    __device__ __forceinline__ float* sega() const { return (float*)(a->ws + WS_SEGA); }
    __device__ __forceinline__ float* segu() const { return (float*)(a->ws + WS_SEG); }
    __device__ __forceinline__ float* of() const { return (float*)(a->ws + WS_BUFB); }
    __device__ __forceinline__ float* scores() const { return (float*)(a->ws + WS_BIG); }
    __device__ __forceinline__ float* wsel() const { return (float*)(a->ws + WS_W); }
    __device__ __forceinline__ int* esel() const { return (int*)(a->ws + WS_E); }
    __device__ __forceinline__ bf16* Win_t() const { return (bf16*)(a->ws + WS_WIN); }
    __device__ __forceinline__ bf16* Wout_t() const { return (bf16*)(a->ws + WS_WOUT); }
    __device__ __forceinline__ bf16* Wqk_t() const { return (bf16*)(a->ws + WS_WQK); }
    __device__ __forceinline__ bf16* Wqk_b() const { return (bf16*)(a->ws + WS_WQKB); }
    __device__ __forceinline__ bf16* Ub() const { return (bf16*)(a->ws + WS_UT); }
    __device__ __forceinline__ bf16* Vb() const { return (bf16*)(a->ws + WS_VT); }
    __device__ __forceinline__ bf16* bufA() const { return (bf16*)(a->ws + WS_BUFA); }
    __device__ __forceinline__ bf16* hg() const { return (bf16*)(a->ws + WS_BUFB); }
    __device__ __forceinline__ bf16* proj() const { return (bf16*)(a->ws + WS_BIG); }
    __device__ __forceinline__ float* coef() const { return (float*)(a->ws + WS_BUFA); }
    __device__ __forceinline__ float* rstd() const { return (float*)(a->ws + WS_RSTD); }
    __device__ __forceinline__ bf16* pact() const { return (bf16*)(a->ws + WS_PACT); }
    __device__ __forceinline__ bf16* ybuf() const { return (bf16*)(a->ws + WS_Y); }
    __device__ __forceinline__ unsigned char* U8() const { return (unsigned char*)(a->ws + WS_UT); }
    __device__ __forceinline__ unsigned char* V8() const { return (unsigned char*)(a->ws + WS_VT); }
    __device__ __forceinline__ unsigned* ctl() const { return (unsigned*)(a->ws + WS_CTL); }
};

__device__ __forceinline__ void p0_gemv(Frame& F) {
    LAS float* cact = (LAS float*)(F.lds);
    LAS float* red = (LAS float*)(F.lds + 16384);
    for (int i = F.tid; i < 4096; i += NTHR) { const float c = F.c()[i]; cact[i] = c * sigmoidf_(c); }
    __syncthreads();
    for (int item = F.bid; item < 128; item += F.G) {
        const int col0 = item * 64; const float* W; int N, cc;
        if (col0 < 6144) { W = F.ada_w(); N = 6144; cc = col0; } else { W = F.fada_w(); N = 2048; cc = col0 - 6144; }
        const float* wp = W + (size_t)(F.wave * 128) * N + cc + F.lane;
        float a0 = 0.f, a1 = 0.f, a2 = 0.f, a3 = 0.f;
#pragma unroll 32
        for (int k = 0; k < 128; ++k) { const float w = wp[(size_t)k * N]; const int kk = F.wave * 128 + k;
            a0 += cact[kk] * w; a1 += cact[1024 + kk] * w; a2 += cact[2048 + kk] * w; a3 += cact[3072 + kk] * w; }
        red[(F.wave * 4 + 0) * 64 + F.lane] = a0; red[(F.wave * 4 + 1) * 64 + F.lane] = a1; red[(F.wave * 4 + 2) * 64 + F.lane] = a2; red[(F.wave * 4 + 3) * 64 + F.lane] = a3;
        __syncthreads();
        if (F.tid < 256) { const int b = F.tid >> 6, l = F.tid & 63; float s = 0.f;
#pragma unroll
            for (int w = 0; w < 8; ++w) s += red[(w * 4 + b) * 64 + l];
            if (col0 < 6144) F.mod()[b * 6144 + cc + l] = s + F.ada_b()[cc + l]; else F.fmod()[b * 2048 + cc + l] = s + F.fada_b()[cc + l]; }
        __syncthreads();
    }
}
__device__ __forceinline__ void p0_transpose_item(const float* W, int K, int N, bf16* WT, LAS float* scr, int item, int lane) {
    const int nblk = N / 32, kb = item / nblk, nb = item % nblk, k0 = 64 * kb, n0 = 32 * nb;
#pragma unroll
    for (int i = 0; i < 32; ++i) { const int kk = 2 * i + (lane >> 5); scr[kk * 33 + (lane & 31)] = W[(size_t)(k0 + kk) * N + n0 + (lane & 31)]; }
    asm volatile("s_waitcnt lgkmcnt(0)" ::: "memory");
    const int c = lane & 7;
#pragma unroll
    for (int j = 0; j < 4; ++j) { const int n = (lane >> 3) + 8 * j; const LAS float* s = scr + (8 * c) * 33 + n;
        v4u o; o.x = pk2(s[0 * 33], s[1 * 33]); o.y = pk2(s[2 * 33], s[3 * 33]); o.z = pk2(s[4 * 33], s[5 * 33]); o.w = pk2(s[6 * 33], s[7 * 33]);
        *(v4u*)(WT + (size_t)(n0 + n) * K + k0 + 8 * c) = o; }
    asm volatile("s_waitcnt lgkmcnt(0)" ::: "memory");
}
__device__ __forceinline__ void p0_wqk_item(Frame& F, int item, LAS float* scr) {
    const int jq = item & 7, kb = (item >> 3) & 15, hh = item >> 7, h = hh >> 1, half = hh & 1;
    const float* keys = (half ? F.keys2() : F.keys1()) + (size_t)(jq * 16) * 128;
    const float* wtile = F.wq() + (size_t)(kb * 64) * 2048 + h * 256 + half * 128;
    LAS float* kL = scr + 1280;
    { f32x4 k4[8];
#pragma unroll
      for (int i = 0; i < 8; ++i) k4[i] = *(const f32x4*)(keys + (i * 64 + F.lane) * 4);
#pragma unroll
      for (int i = 0; i < 8; ++i) *(LAS f32x4*)(kL + (i * 64 + F.lane) * 4) = k4[i]; }
    float acc[16];
#pragma unroll
    for (int j = 0; j < 16; ++j) acc[j] = 0.f;
    f32x4 t4[4], n4[4];
#pragma unroll
    for (int i = 0; i < 4; ++i) t4[i] = *(const f32x4*)(wtile + (size_t)(16 * i + (F.lane >> 2)) * 2048 + 4 * (F.lane & 3));
    for (int d0 = 0; d0 < 128; d0 += 16) {
        if (d0 + 16 < 128) {
#pragma unroll
            for (int i = 0; i < 4; ++i) n4[i] = *(const f32x4*)(wtile + (size_t)(16 * i + (F.lane >> 2)) * 2048 + d0 + 16 + 4 * (F.lane & 3)); }
#pragma unroll
        for (int i = 0; i < 4; ++i) *(LAS f32x4*)(scr + (16 * i + (F.lane >> 2)) * 20 + 4 * (F.lane & 3)) = t4[i];
        asm volatile("s_waitcnt lgkmcnt(0)" ::: "memory");
#pragma unroll
        for (int dd = 0; dd < 16; dd += 4) { const f32x4 a = *(LAS const f32x4*)(scr + F.lane * 20 + dd);
#pragma unroll
            for (int j = 0; j < 16; ++j) { const f32x4 kp = *(LAS const f32x4*)(kL + j * 128 + d0 + dd); acc[j] += a[0] * kp[0] + a[1] * kp[1] + a[2] * kp[2] + a[3] * kp[3]; } }
        asm volatile("s_waitcnt lgkmcnt(0)" ::: "memory");
#pragma unroll
        for (int i = 0; i < 4; ++i) t4[i] = n4[i];
    }
    bf16* o = F.Wqk_t() + (size_t)(h * 256 + half * 128 + jq * 16) * 1024 + kb * 64 + F.lane;
#pragma unroll
    for (int j = 0; j < 16; ++j) o[(size_t)j * 1024] = (bf16)f2bf(acc[j]);
}
__device__ __forceinline__ void p0_prologue(Frame& F) {
    if (F.bid < 128) p0_gemv(F);
    asm volatile("s_waitcnt vmcnt(0)" ::: "memory");
    __syncthreads();
    if (F.tid == 0) { __builtin_amdgcn_fence(__ATOMIC_RELEASE, "agent"); asm volatile("s_waitcnt vmcnt(0)" ::: "memory"); (void)xb_add(F.ctl() + CW_GV, 1u); }
    if (F.bid == 128 % F.G) { const int i = F.tid;
        F.lb()[i] = __builtin_amdgcn_rcpf(1.0f + __expf(F.lbg_f()[512 + i] - F.lbg_f()[i]));
        F.lb()[512 + i] = __builtin_amdgcn_rcpf(1.0f + __expf(F.lbg_b()[512 + i] - F.lbg_b()[i])); }
    LAS float* scr = (LAS float*)(F.lds + 32768 + F.wave * 14336);
    const int gw = F.wave * F.G + F.bid, NGW = F.G * NWAVES;
    constexpr int I_QK = 2048, I_IN = (D / 64) * (NIN / 32), I_OUT = (D / 64) * (D / 32), I_TAB = 2 * 16384 / 4;
    constexpr int NITEMS = I_QK + I_IN + I_OUT + I_TAB;
    for (int it = gw; it < NITEMS; it += NGW) {
        int r = it;
        if (r < I_QK) { p0_wqk_item(F, r, scr); continue; } r -= I_QK;
        if (r < I_IN) { p0_transpose_item(F.w_in(), D, NIN, F.Win_t(), scr, r, F.lane); continue; } r -= I_IN;
        if (r < I_OUT) { p0_transpose_item(F.w_out(), D, D, F.Wout_t(), scr, r, F.lane); continue; } r -= I_OUT;
        { const int tab = r >= 4096, rr = (tab ? r - 4096 : r) * 4; const float* src = (tab ? F.vtab() : F.utab()) + (size_t)rr * 1024; unsigned char* dst = tab ? F.V8() : F.U8();
          const float sc = tab ? VSCALE : UQSCALE;
#pragma unroll
          for (int q = 0; q < 16; ++q) { const int row = rr + (q >> 2), qq = q & 3; const f32x4 v = *(const f32x4*)(src + (q >> 2) * 1024 + qq * 256 + 4 * F.lane) * sc;
              int pk;
              if (tab) { pk = __builtin_amdgcn_cvt_pk_fp8_f32(v[0], v[1], 0, false); pk = __builtin_amdgcn_cvt_pk_fp8_f32(v[2], v[3], pk, true); }
              else { int q0 = (int)__builtin_rintf(v[0]), q1 = (int)__builtin_rintf(v[1]), q2 = (int)__builtin_rintf(v[2]), q3 = (int)__builtin_rintf(v[3]);
                  q0 = q0 < -7 ? -7 : (q0 > 7 ? 7 : q0); q1 = q1 < -7 ? -7 : (q1 > 7 ? 7 : q1); q2 = q2 < -7 ? -7 : (q2 > 7 ? 7 : q2); q3 = q3 < -7 ? -7 : (q3 > 7 ? 7 : q3);
                  *(unsigned short*)(dst + ((size_t)qq * 16384 + row) * 128 + 2 * F.lane) = (unsigned short)((q0 & 0xf) | ((q1 & 0xf) << 4) | ((q2 & 0xf) << 8) | ((q3 & 0xf) << 12)); continue; }
              const int sl = 2 * qq + (F.lane >> 5);
              *(int*)(dst + ((size_t)sl * 16384 + row) * CSL + 4 * (F.lane & 31)) = pk; } }
    }
}

__device__ __forceinline__ void p1_norm(Frame& F) {
    const int gwc = F.bid * NWAVES + F.wave, NGW = F.G * NWAVES;
    for (int row0 = gwc * 16; row0 < T; row0 += NGW * 16) {
        const int b = row0 >> 13; const float* mb = F.mod() + b * 6144;
        f32x4 ca[4], cb[4];
#pragma unroll
        for (int j = 0; j < 4; ++j) { const int k = 256 * j + 4 * F.lane; const f32x4 g = *(const f32x4*)(F.g_mix() + k), s = *(const f32x4*)(mb + 1024 + k); ca[j] = g * (s + 1.0f); cb[j] = *(const f32x4*)(mb + k); }
#pragma unroll 4
        for (int r = 0; r < 16; ++r) { const float* xr = F.x() + (size_t)(row0 + r) * D;
            f32x4 v[4]; float ss = 0.f;
#pragma unroll
            for (int j = 0; j < 4; ++j) { v[j] = *(const f32x4*)(xr + 256 * j + 4 * F.lane); ss += v[j][0] * v[j][0] + v[j][1] * v[j][1] + v[j][2] * v[j][2] + v[j][3] * v[j][3]; }
            const float rstd = __builtin_amdgcn_rsqf(wave_sum(ss) * (1.0f / D) + EPS);
            bf16* o = F.bufA() + (size_t)(row0 + r) * D;
#pragma unroll
            for (int j = 0; j < 4; ++j) { const f32x4 y = v[j] * rstd * ca[j] + cb[j]; v2u w; w.x = pk2(y[0], y[1]); w.y = pk2(y[2], y[3]); *(v2u*)(o + 256 * j + 4 * F.lane) = w; } }
    }
}
__device__ __forceinline__ void p3_pre(Frame& F) {
    const int NGW = F.G * NWAVES;
    for (int i = F.bid * NTHR + F.tid; i < NQK * (D / 8); i += F.G * NTHR) { const int n = i >> 7, k0 = (i & 127) * 8;
        const v4u w = *(const v4u*)(F.Wqk_t() + (size_t)n * D + k0);
        const f32x4 g0 = *(const f32x4*)(F.g_ffn() + k0), g1 = *(const f32x4*)(F.g_ffn() + k0 + 4);
        f32x4 wa, wb; wa[0] = bflo(w[0]) * g0[0]; wa[1] = bfhi(w[0]) * g0[1]; wa[2] = bflo(w[1]) * g0[2]; wa[3] = bfhi(w[1]) * g0[3]; wb[0] = bflo(w[2]) * g1[0]; wb[1] = bfhi(w[2]) * g1[1]; wb[2] = bflo(w[3]) * g1[2]; wb[3] = bfhi(w[3]) * g1[3];
#pragma unroll
        for (int b = 0; b < NB; ++b) { const float* sc = F.mod() + b * 6144 + 4096 + k0; const f32x4 s0 = *(const f32x4*)sc + 1.0f, s1 = *(const f32x4*)(sc + 4) + 1.0f;
            const f32x4 pa = wa * s0, pb = wb * s1;
            v4u o; o.x = cvtpk(pa[0], pa[1]); o.y = cvtpk(pa[2], pa[3]); o.z = cvtpk(pb[0], pb[1]); o.w = cvtpk(pb[2], pb[3]);
            *(v4u*)(F.Wqk_b() + ((size_t)b * NQK + n) * D + k0) = o; } }
    const int gw = F.wave * F.G + F.bid;
    for (int n0 = gw * 32; n0 < NQK; n0 += NGW * 32) {
        float sv[4][16];
#pragma unroll
        for (int b = 0; b < 4; ++b) { const float* sh2 = F.mod() + b * 6144 + 3072;
#pragma unroll
            for (int i = 0; i < 8; ++i) { sv[b][i] = sh2[8 * F.lane + i]; sv[b][8 + i] = sh2[512 + 8 * F.lane + i]; } }
        float res[4] = {0.f, 0.f, 0.f, 0.f};
        for (int q = 0; q < 32; ++q) { const int n = n0 + q;
            const v4u w0 = *(const v4u*)(F.Wqk_t() + (size_t)n * 1024 + 8 * F.lane), w1 = *(const v4u*)(F.Wqk_t() + (size_t)n * 1024 + 512 + 8 * F.lane);
            float wv[16];
#pragma unroll
            for (int i = 0; i < 4; ++i) { wv[2 * i] = bflo(w0[i]); wv[2 * i + 1] = bfhi(w0[i]); wv[8 + 2 * i] = bflo(w1[i]); wv[8 + 2 * i + 1] = bfhi(w1[i]); }
#pragma unroll
            for (int b = 0; b < 4; ++b) { float sm = 0.f;
#pragma unroll
                for (int i = 0; i < 16; ++i) sm += wv[i] * sv[b][i];
                sm = wave_sum(sm); if (F.lane == q) res[b] = sm; } }
        if (F.lane < 32) {
#pragma unroll
            for (int b = 0; b < 4; ++b) F.biasq()[b * 2048 + n0 + F.lane] = res[b]; }
    }
}

__device__ __forceinline__ void conv_item(Frame& F, int item, const float (&cw)[CW], float cbias) {
    LAS bf16* hbuf = (LAS bf16*)(F.lds);
    LAS float* ybuf = (LAS float*)(F.lds + 65536);
    const int tok0 = item * 32, b = tok0 >> 13, t0 = tok0 & (SEQ - 1), c = F.tid;
#pragma unroll
    for (int k = 0; k < 8; ++k) { const int pi = F.tid + NTHR * k; if (pi < 62 * 64) { const int r = pi >> 6, ch = pi & 63, t = t0 - CPAD + r; v4u o = {0u, 0u, 0u, 0u};
            if (t >= 0 && t < SEQ) { const bf16* pr = F.proj() + (size_t)(b * SEQ + t) * NIN + 8 * ch; const v4u a = *(const v4u*)(pr + 2560), g = *(const v4u*)(pr + 3072);
#pragma unroll
                for (int i = 0; i < 4; ++i) o[i] = cvtpk(bflo(a[i]) * bflo(g[i]), bfhi(a[i]) * bfhi(g[i])); }
            *(LAS v4u*)(hbuf + r * 512 + 8 * ch) = o; } }
    __syncthreads();
    f32x2_ hp[31];
#pragma unroll
    for (int m = 0; m < 31; ++m) hp[m] = (f32x2_){bf2f(hbuf[(2 * m) * 512 + c]), bf2f(hbuf[(2 * m + 1) * 512 + c])};
    f32x2_ ce[15], co[15];
#pragma unroll
    for (int m = 0; m < 15; ++m) { ce[m] = (f32x2_){cw[2 * m], cw[2 * m + 1]}; co[m] = (f32x2_){cw[2 * m + 1], cw[2 * m + 2]}; }
#pragma unroll
    for (int e = 0; e < 16; ++e) {
        { f32x2_ a = {cbias, 0.f};
#pragma unroll
          for (int m = 0; m < 15; ++m) a += ce[m] * hp[e + m];
          ybuf[(2 * e) * 512 + c] = (a[0] + a[1]) + cw[30] * hp[e + 15][0]; }
        { f32x2_ a = {cbias, 0.f};
#pragma unroll
          for (int m = 0; m < 15; ++m) a += co[m] * hp[e + m + 1];
          ybuf[(2 * e + 1) * 512 + c] = (a[0] + a[1]) + cw[0] * hp[e][1]; } }
    __syncthreads();
#pragma unroll
    for (int q = 0; q < 4; ++q) { const int tt = F.wave * 4 + q;
        const f32x4 y0 = *(LAS const f32x4*)(ybuf + tt * 512 + 8 * F.lane), y1 = *(LAS const f32x4*)(ybuf + tt * 512 + 8 * F.lane + 4);
        const float mean = wave_sum((y0[0] + y0[1] + y0[2] + y0[3]) + (y1[0] + y1[1] + y1[2] + y1[3])) * (1.0f / DC);
        const f32x4 d0 = y0 - mean, d1 = y1 - mean;
        const float var = wave_sum((d0[0] * d0[0] + d0[1] * d0[1] + d0[2] * d0[2] + d0[3] * d0[3]) + (d1[0] * d1[0] + d1[1] * d1[1] + d1[2] * d1[2] + d1[3] * d1[3])) * (1.0f / DC);
        const float rstd = __builtin_amdgcn_rsqf(var + EPS);
        const f32x4 g0 = *(const f32x4*)(F.cln_g() + 8 * F.lane), g1 = *(const f32x4*)(F.cln_g() + 8 * F.lane + 4), b0 = *(const f32x4*)(F.cln_b() + 8 * F.lane), b1 = *(const f32x4*)(F.cln_b() + 8 * F.lane + 4);
        f32x4 z0 = d0 * rstd * g0 + b0, z1 = d1 * rstd * g1 + b1;
#pragma unroll
        for (int i = 0; i < 4; ++i) { z0[i] = z0[i] * sigmoidf_(z0[i]); z1[i] = z1[i] * sigmoidf_(z1[i]); }
        v4u w; w.x = cvtpk(z0[0], z0[1]); w.y = cvtpk(z0[2], z0[3]); w.z = cvtpk(z1[0], z1[1]); w.w = cvtpk(z1[2], z1[3]);
        *(v4u*)(F.bufA() + (size_t)(tok0 + tt) * D + 512 + 8 * F.lane) = w; }
    __syncthreads();
}

constexpr int PQ = 272, PT = 144;
constexpr int HL_QR = 0, HL_KR = 17408, HL_QE = 34816, HL_KET = 52224, HL_VT = 70656, HL_SCM = 89088, HL_ST = 98304, HL_PBLK = 133120  , HL_AV = 137216, HL_RS = 137728;
static_assert(HL_PBLK + 8 * 128 * 4 <= HL_AV && HL_AV + 512 <= HL_RS && HL_RS + 1024 <= 155648 - 256, "HGRN LDS map");
__device__ __forceinline__ bf16x8 ldf(LAS const unsigned char* base, int row, int pitch, int kbyte) { return *(LAS const bf16x8*)(base + row * pitch + kbyte); }
#define MFMA32(a, b, c) __builtin_amdgcn_mfma_f32_32x32x16_bf16((a), (b), (c), 0, 0, 0)

template <bool FULL>
__device__ __forceinline__ void hgrn_load(Frame& F, int b, int h, int dir, int chunk, unsigned (&rz)[8], unsigned (&rv)[8], unsigned (&rq)[8]) {
    const size_t tokbase = (size_t)b * SEQ + (size_t)chunk * CHK; const int zoff = dir ? 1024 : 512, c0 = 2 * F.lane;
#pragma unroll
    for (int i = 0; i < 8; ++i) { const int p = 8 * F.wave + i, tr = dir ? (63 - p) : p; const bf16* q = F.proj() + (tokbase + tr) * NIN + h * HD;
        rz[i] = *(const unsigned*)(q + zoff + c0); rv[i] = *(const unsigned*)(q + 1536 + c0); if (FULL) rq[i] = *(const unsigned*)(q + c0); }
}
template <bool FULL, int MODE>
__device__ __forceinline__ void hgrn_chunk(Frame& F, int b, int h, int dir, int chunk, int nchunk, f32x16 (&accS)[2], float lb0, float lb1, unsigned (&rz)[8], unsigned (&rv)[8], unsigned (&rq)[8]) {
    LAS unsigned char* lds = F.lds;
    int r = F.lane & 31, hh = F.lane >> 5, c0 = 2 * F.lane;
    asm volatile("" : "+v"(r), "+v"(hh), "+v"(c0));
    const int w = F.wave, rb = w;
    const size_t tokbase = (size_t)b * SEQ + (size_t)chunk * CHK;
    {
        const f32x2_ oml = {1.0f - lb0, 1.0f - lb1};
        f32x2_ f2[8], cf2[8], cr2[8];
        f32x2_ run = {1.f, 1.f};
#pragma unroll
        for (int i = 0; i < 8; ++i) { const f32x2_ kk = {bflo(rz[i]), bfhi(rz[i])}; f2[i] = 1.0f - oml * kk; run *= f2[i]; cf2[i] = run; }
        { f32x2_ q = {1.f, 1.f};
#pragma unroll
          for (int i = 7; i >= 0; --i) { cr2[i] = q; q *= f2[i]; } }
        LAS float* pblk = (LAS float*)(lds + HL_PBLK);
        *(LAS f32x2_*)(pblk + rb * 128 + c0) = run;
        __syncthreads();
        f32x2_ pre = {1.f, 1.f}, post = {1.f, 1.f}, mid = {1.f, 1.f};
        for (int q = 0; q < rb; ++q) pre *= *(LAS const f32x2_*)(pblk + q * 128 + c0);
        for (int q = rb + 1; q < 8; ++q) post *= *(LAS const f32x2_*)(pblk + q * 128 + c0);
        if (rb < 4) { for (int q = rb + 1; q < 4; ++q) mid *= *(LAS const f32x2_*)(pblk + q * 128 + c0); }
        else { for (int q = 4; q < rb; ++q) mid *= *(LAS const f32x2_*)(pblk + q * 128 + c0); }
        if (rb == 0) *(LAS f32x2_*)((LAS float*)(lds + HL_AV) + c0) = run * post;
        f32x2_ ke2[8];
#pragma unroll
        for (int i = 0; i < 8; ++i) ke2[i] = (1.0f - f2[i]) * cr2[i] * post;
        if (FULL) {
            if (rb < 4) {
#pragma unroll
                for (int i = 0; i < 8; ++i) { const int p = 8 * rb + i; const f32x2_ qs = {bflo(rq[i]), bfhi(rq[i])}, k2 = 1.0f - f2[i], G = cr2[i] * mid;
                    f32x2_ iG; iG[0] = __builtin_amdgcn_rcpf(G[0]); iG[1] = __builtin_amdgcn_rcpf(G[1]);
                    const f32x2_ qe = qs * pre * cf2[i], qr = qs * iG, kr = k2 * G;
                    *(LAS unsigned*)(lds + HL_QE + p * PQ + c0 * 2) = cvtpk(qe[0], qe[1]);
                    *(LAS unsigned*)(lds + HL_QR + p * PQ + c0 * 2) = cvtpk(qr[0], qr[1]);
                    *(LAS unsigned*)(lds + HL_KR + p * PQ + c0 * 2) = cvtpk(kr[0], kr[1]); }
            } else {
#pragma unroll
                for (int i = 0; i < 8; ++i) { const int p = 8 * rb + i; const f32x2_ qs = {bflo(rq[i]), bfhi(rq[i])}, k2 = 1.0f - f2[i], G = cf2[i] * mid;
                    f32x2_ iG; iG[0] = __builtin_amdgcn_rcpf(G[0]); iG[1] = __builtin_amdgcn_rcpf(G[1]);
                    const f32x2_ qe = qs * pre * cf2[i], qr = qs * G, kr = k2 * iG;
                    *(LAS unsigned*)(lds + HL_QE + p * PQ + c0 * 2) = cvtpk(qe[0], qe[1]);
                    *(LAS unsigned*)(lds + HL_QR + p * PQ + c0 * 2) = cvtpk(qr[0], qr[1]);
                    *(LAS unsigned*)(lds + HL_KR + p * PQ + c0 * 2) = cvtpk(kr[0], kr[1]); }
            }
        }
        v4u ka, kb, va, vb2;
        ka.x = cvtpk(ke2[0][0], ke2[1][0]); ka.y = cvtpk(ke2[2][0], ke2[3][0]); ka.z = cvtpk(ke2[4][0], ke2[5][0]); ka.w = cvtpk(ke2[6][0], ke2[7][0]);
        kb.x = cvtpk(ke2[0][1], ke2[1][1]); kb.y = cvtpk(ke2[2][1], ke2[3][1]); kb.z = cvtpk(ke2[4][1], ke2[5][1]); kb.w = cvtpk(ke2[6][1], ke2[7][1]);
        va.x = (rv[0] & 0xffffu) | (rv[1] << 16); va.y = (rv[2] & 0xffffu) | (rv[3] << 16); va.z = (rv[4] & 0xffffu) | (rv[5] << 16); va.w = (rv[6] & 0xffffu) | (rv[7] << 16);
        vb2.x = (rv[0] >> 16) | (rv[1] & 0xffff0000u); vb2.y = (rv[2] >> 16) | (rv[3] & 0xffff0000u); vb2.z = (rv[4] >> 16) | (rv[5] & 0xffff0000u); vb2.w = (rv[6] >> 16) | (rv[7] & 0xffff0000u);
        *(LAS v4u*)(lds + HL_KET + c0 * PT + 16 * rb) = ka; *(LAS v4u*)(lds + HL_KET + (c0 + 1) * PT + 16 * rb) = kb;
        *(LAS v4u*)(lds + HL_VT + c0 * PT + 16 * rb) = va; *(LAS v4u*)(lds + HL_VT + (c0 + 1) * PT + 16 * rb) = vb2;
    }
    if (nchunk >= 0) hgrn_load<FULL>(F, b, h, dir, nchunk, rz, rv, rq);
    __syncthreads();
    const int pbO = w & 1, vb = w >> 1;
    f32x16 accO, accU[2];
#pragma unroll
    for (int i = 0; i < 16; ++i) { accO[i] = 0.f; accU[0][i] = 0.f; accU[1][i] = 0.f; }
    if (FULL) {
        if (w < 3) { const int pbS = (w + 1) >> 1, sbS = (w == 2) ? 1 : 0; f32x16 sc;
#pragma unroll
            for (int i = 0; i < 16; ++i) sc[i] = 0.f;
#pragma unroll
            for (int s = 0; s < 8; ++s) sc = MFMA32(ldf(lds + HL_QR, pbS * 32 + r, PQ, 32 * s + 16 * hh), ldf(lds + HL_KR, sbS * 32 + r, PQ, 32 * s + 16 * hh), sc);
#pragma unroll
            for (int i = 0; i < 16; i += 2) { const int p = pbS * 32 + (i & 3) + 8 * (i >> 2) + 4 * hh, s = sbS * 32 + r;
                const unsigned pkd = cvtpk(s <= p ? sc[i] : 0.f, s <= p + 1 ? sc[i + 1] : 0.f);
                *(LAS bf16*)(lds + HL_SCM + p * PT + s * 2) = (bf16)pkd; *(LAS bf16*)(lds + HL_SCM + (p + 1) * PT + s * 2) = (bf16)(pkd >> 16); } }
        __builtin_amdgcn_sched_barrier(0);
#pragma unroll
        for (int s = 0; s < 8; ++s) accO = MFMA32(ldf(lds + HL_QE, pbO * 32 + r, PQ, 32 * s + 16 * hh), ldf(lds + HL_ST, vb * 32 + r, PQ, 32 * s + 16 * hh), accO);
        __builtin_amdgcn_sched_barrier(0);
    }
#pragma unroll
    for (int i = 0; i < 2; ++i) { const int db = 2 * (w & 1) + i;
#pragma unroll
        for (int s = 0; s < 4; ++s) accU[i] = MFMA32(ldf(lds + HL_VT, vb * 32 + r, PT, 32 * s + 16 * hh), ldf(lds + HL_KET, db * 32 + r, PT, 32 * s + 16 * hh), accU[i]); }
    __builtin_amdgcn_sched_barrier(0);
    if (FULL) __syncthreads();
    if (FULL) {
        const unsigned v = vb * 32 + r;
        const unsigned lrow = (MODE == 0 ? (unsigned)hh : (unsigned)(1 - hh)) * 4u;
        const size_t rbase = (MODE == 0) ? (tokbase + pbO * 32) : (tokbase + 63 - pbO * 32 - 4);
        const unsigned lo_of = lrow * DH + v, lo_pr = lrow * NIN + v, lo_a2 = lrow * D + v;
        float ofv[16]; unsigned gv[16];
        if (MODE == 1) {
#pragma unroll
            for (int i = 0; i < 16; ++i) { const int ci = (i & 3) + 8 * (i >> 2); ofv[i] = (F.of() + (rbase - ci) * DH + h * HD)[lo_of]; } }
        for (int sb = 0; sb <= pbO; ++sb)
#pragma unroll
            for (int s2 = 0; s2 < 2; ++s2) accO = MFMA32(ldf(lds + HL_SCM, pbO * 32 + r, PT, 64 * sb + 32 * s2 + 16 * hh), ldf(lds + HL_VT, vb * 32 + r, PT, 64 * sb + 32 * s2 + 16 * hh), accO);
        if (MODE == 0) {
#pragma unroll
            for (int i = 0; i < 16; ++i) { const int ci = (i & 3) + 8 * (i >> 2); (F.of() + (rbase + ci) * DH + h * HD)[lo_of] = accO[i]; }
        } else {
            LAS float* rs = (LAS float*)(lds + HL_RS);
#pragma unroll
            for (int i = 0; i < 16; ++i) { const int ci = (i & 3) + 8 * (i >> 2); gv[i] = (F.proj() + (rbase - ci) * NIN + 2048 + h * HD)[lo_pr]; }
            float ov[16];
            float ssr[16];
#pragma unroll
            for (int i = 0; i < 16; ++i) { ov[i] = accO[i] + ofv[i]; float ss = ov[i] * ov[i];
                ss = DPP_ADD(ss, 0x128); ss = DPP_ADD(ss, 0x124); ss = DPP_ADD(ss, 0x122); ss = DPP_ADD(ss, 0x121);
                ssr[i] = ss + __builtin_bit_cast(float, __builtin_amdgcn_update_dpp(0, __builtin_bit_cast(int, ss), 0x142, 0xA, 0xF, false)); }
            if (r == 16) {
#pragma unroll
                for (int i = 0; i < 16; ++i) { const int ci = (i & 3) + 8 * (i >> 2), p = pbO * 32 + ci + 4 * hh; rs[p * 4 + vb] = ssr[i]; } }
            __syncthreads();
            const float ng = F.hnorm_g()[h * HD + v];
#pragma unroll
            for (int i = 0; i < 16; ++i) { const int ci = (i & 3) + 8 * (i >> 2), p = pbO * 32 + ci + 4 * hh;
                const f32x4 q = *(LAS const f32x4*)(rs + p * 4);
                const float rstd = __builtin_amdgcn_rsqf((q[0] + q[1] + q[2] + q[3]) * (1.0f / HD) + EPS);
                const float g = bf2f(gv[i]);
                (F.bufA() + (rbase - ci) * D + h * HD)[lo_a2] = (bf16)cvtpk(ov[i] * rstd * ng * g, 0.f); }
        }
    }
    {
        const LAS float* av = (const LAS float*)(lds + HL_AV);
#pragma unroll
        for (int i = 0; i < 2; ++i) { const int db = 2 * (w & 1) + i; const float a = av[db * 32 + r];
#pragma unroll
            for (int j = 0; j < 16; j += 2) { const float s0 = accS[i][j] * a + accU[i][j], s1 = accS[i][j + 1] * a + accU[i][j + 1]; accS[i][j] = s0; accS[i][j + 1] = s1;
                if (FULL) { const int vv = vb * 32 + (j & 3) + 8 * (j >> 2) + 4 * hh; const unsigned pkd = cvtpk(s0, s1);
                    *(LAS bf16*)(lds + HL_ST + vv * PQ + (db * 32 + r) * 2) = (bf16)pkd; *(LAS bf16*)(lds + HL_ST + (vv + 1) * PQ + (db * 32 + r) * 2) = (bf16)(pkd >> 16); } } }
    }
    __syncthreads();
}
__device__ __forceinline__ void h1_item(Frame& F, int item) {
    const int seg = item & 15, dir = (item >> 4) & 1, h = (item >> 5) & 3, b = item >> 7;
    const float lb0 = F.lb()[dir * 512 + h * HD + 2 * F.lane], lb1 = F.lb()[dir * 512 + h * HD + 2 * F.lane + 1];
    f32x16 accS[2];
#pragma unroll
    for (int i = 0; i < 16; ++i) { accS[0][i] = 0.f; accS[1][i] = 0.f; }
    float atot = 1.f; const int col = F.tid & 127;
    unsigned rzA[8], rvA[8], rzB[8], rvB[8], rq[8];
#define H1CH(c) (seg * SEGC + (dir ? (SEGC - 1 - (c)) : (c)))
    hgrn_load<false>(F, b, h, dir, H1CH(0), rzA, rvA, rq); hgrn_load<false>(F, b, h, dir, H1CH(1), rzB, rvB, rq);
    for (int c = 0; c < SEGC; c += 2) {
        hgrn_chunk<false, 0>(F, b, h, dir, H1CH(c), (c + 2 < SEGC) ? H1CH(c + 2) : -1, accS, lb0, lb1, rzA, rvA, rq);
        atot *= ((const LAS float*)(F.lds + HL_AV))[col];
        hgrn_chunk<false, 0>(F, b, h, dir, H1CH(c + 1), (c + 3 < SEGC) ? H1CH(c + 3) : -1, accS, lb0, lb1, rzB, rvB, rq);
        atot *= ((const LAS float*)(F.lds + HL_AV))[col]; }
#undef H1CH
    if (F.tid < 128) F.sega()[(size_t)item * 128 + col] = atot;
    float* U = F.segu() + (size_t)item * 16384;
#pragma unroll
    for (int i = 0; i < 2; ++i)
#pragma unroll
        for (int j = 0; j < 16; j += 4) { f32x4 o; o[0] = accS[i][j]; o[1] = accS[i][j + 1]; o[2] = accS[i][j + 2]; o[3] = accS[i][j + 3]; ((f32x4*)(U + (i * 4 + (j >> 2)) * NTHR * 4))[F.tid] = o; }
}
__device__ __forceinline__ void h_scan(Frame& F) {
    for (int g = F.bid; g < NB * NHH * 2 * 8; g += F.G) {
        const int chain = g >> 3, k = g & 7, dir = chain & 1;
        const int aidx = (2 * (F.wave & 1) + (k >> 2)) * 32 + (F.lane & 31);
        float* U = F.segu() + (size_t)chain * NSEG * 16384 + (size_t)k * NTHR * 4 + F.tid * 4;
        const float* A = F.sega() + (size_t)chain * NSEG * 128 + aidx;
        f32x4 u[NSEG]; float av[NSEG];
#pragma unroll
        for (int q = 0; q < NSEG; ++q) { const int sg = dir ? (NSEG - 1 - q) : q; u[q] = *(const f32x4*)(U + (size_t)sg * 16384); av[q] = A[sg * 128]; }
        f32x4 S = {0.f, 0.f, 0.f, 0.f};
#pragma unroll
        for (int q = 0; q < NSEG; ++q) { const int sg = dir ? (NSEG - 1 - q) : q; *(f32x4*)(U + (size_t)sg * 16384) = S; S = S * av[q] + u[q]; }
    }
}
__device__ __forceinline__ void h2_init_state(Frame& F, int b, int h, int dir, int seg, f32x16 (&accS)[2]) {
    const int w = F.wave, r = F.lane & 31, hh = F.lane >> 5, vb = w >> 1;
    const float* U = F.segu() + (size_t)(((b * 4 + h) * 2 + dir) * NSEG + seg) * 16384;
#pragma unroll
    for (int k = 0; k < 8; ++k) { const f32x4 v = ((const f32x4*)(U + k * NTHR * 4))[F.tid]; const int i = k >> 2, j = (k & 3) * 4;
        accS[i][j] = v[0]; accS[i][j + 1] = v[1]; accS[i][j + 2] = v[2]; accS[i][j + 3] = v[3]; }
#pragma unroll
    for (int i = 0; i < 2; ++i) { const int db = 2 * (w & 1) + i;
#pragma unroll
        for (int j = 0; j < 16; ++j) { const int vv = vb * 32 + (j & 3) + 8 * (j >> 2) + 4 * hh; *(LAS bf16*)(F.lds + HL_ST + vv * PQ + (db * 32 + r) * 2) = (bf16)f2bf(accS[i][j]); } }
    __syncthreads();
}
__device__ __forceinline__ void h2_item(Frame& F, int item) {
    const int seg = item & 15, h = (item >> 4) & 3, b = item >> 6;
    f32x16 accS[2];
    unsigned rzA[8], rvA[8], rqA[8], rzB[8], rvB[8], rqB[8];
    { const float lb0 = F.lb()[h * HD + 2 * F.lane], lb1 = F.lb()[h * HD + 2 * F.lane + 1];
      const int c0 = seg * SEGC;
      hgrn_load<true>(F, b, h, 0, c0, rzA, rvA, rqA); hgrn_load<true>(F, b, h, 0, c0 + 1, rzB, rvB, rqB);
      h2_init_state(F, b, h, 0, seg, accS);
      for (int c = 0; c < SEGC; c += 2) {
          hgrn_chunk<true, 0>(F, b, h, 0, c0 + c, (c + 2 < SEGC) ? (c0 + c + 2) : -1, accS, lb0, lb1, rzA, rvA, rqA);
          hgrn_chunk<true, 0>(F, b, h, 0, c0 + c + 1, (c + 3 < SEGC) ? (c0 + c + 3) : -1, accS, lb0, lb1, rzB, rvB, rqB); } }
    asm volatile("s_waitcnt vmcnt(0)" ::: "memory");
    __syncthreads();
    { const float lb0 = F.lb()[512 + h * HD + 2 * F.lane], lb1 = F.lb()[512 + h * HD + 2 * F.lane + 1];
      const int cl = seg * SEGC + SEGC - 1;
      hgrn_load<true>(F, b, h, 1, cl, rzA, rvA, rqA); hgrn_load<true>(F, b, h, 1, cl - 1, rzB, rvB, rqB);
      h2_init_state(F, b, h, 1, seg, accS);
      for (int c = 0; c < SEGC; c += 2) {
          hgrn_chunk<true, 1>(F, b, h, 1, cl - c, (c + 2 < SEGC) ? (cl - c - 2) : -1, accS, lb0, lb1, rzA, rvA, rqA);
          hgrn_chunk<true, 1>(F, b, h, 1, cl - c - 1, (c + 3 < SEGC) ? (cl - c - 3) : -1, accS, lb0, lb1, rzB, rvB, rqB); } }
}

__device__ __forceinline__ unsigned f2key(float f) { return __builtin_bit_cast(unsigned, f); }
__device__ __forceinline__ float key2f(unsigned k) { return __builtin_bit_cast(float, k); }
__device__ __forceinline__ unsigned umax_(unsigned a, unsigned b) { unsigned r; asm("v_max_f32 %0, %1, %2" : "=v"(r) : "v"(a), "v"(b)); return r; }
__device__ __forceinline__ unsigned umin_(unsigned a, unsigned b) { unsigned r; asm("v_min_f32 %0, %1, %2" : "=v"(r) : "v"(a), "v"(b)); return r; }
__device__ __forceinline__ void sort16(unsigned (&a)[16]) {
#define CE_(i, j) { const unsigned x_ = a[i], y_ = a[j]; a[i] = umax_(x_, y_); a[j] = umin_(x_, y_); }
    CE_(0, 13) CE_(1, 12) CE_(2, 15) CE_(3, 14) CE_(4, 8) CE_(5, 6) CE_(7, 11) CE_(9, 10)
    CE_(0, 5) CE_(1, 7) CE_(2, 9) CE_(3, 4) CE_(6, 13) CE_(8, 14) CE_(10, 15) CE_(11, 12)
    CE_(0, 1) CE_(2, 3) CE_(4, 5) CE_(6, 8) CE_(7, 9) CE_(10, 11) CE_(12, 13) CE_(14, 15)
    CE_(0, 2) CE_(1, 3) CE_(4, 10) CE_(5, 11) CE_(6, 7) CE_(8, 9) CE_(12, 14) CE_(13, 15)
    CE_(1, 2) CE_(3, 12) CE_(4, 6) CE_(5, 7) CE_(8, 10) CE_(9, 11) CE_(13, 14)
    CE_(1, 4) CE_(2, 6) CE_(5, 8) CE_(7, 10) CE_(9, 13) CE_(11, 14)
    CE_(2, 4) CE_(3, 6) CE_(9, 12) CE_(11, 13)
    CE_(3, 5) CE_(6, 8) CE_(7, 9) CE_(10, 12)
    CE_(3, 4) CE_(5, 6) CE_(7, 8) CE_(9, 10) CE_(11, 12)
    CE_(6, 7) CE_(8, 9)
#undef CE_
}
__device__ __forceinline__ void merge16(unsigned (&a)[16], const unsigned (&b)[16]) {
#pragma unroll
    for (int i = 0; i < 16; ++i) a[i] = umax_(a[i], b[15 - i]);
#pragma unroll
    for (int j = 8; j > 0; j >>= 1)
#pragma unroll
        for (int i = 0; i < 16; ++i) { const int l = i ^ j; if (l > i) { const unsigned x = a[i], y = a[l]; a[i] = umax_(x, y); a[l] = umin_(x, y); } }
}
__device__ __forceinline__ unsigned dpp_swap1(unsigned v) { return (unsigned)__builtin_amdgcn_update_dpp(0, (int)v, 0xB1, 0xF, 0xF, false); }
__device__ __forceinline__ unsigned pick_byte(const unsigned (&pk)[4], unsigned a) {
    const unsigned wsel = a >> 2; unsigned v = wsel == 0 ? pk[0] : (wsel == 1 ? pk[1] : (wsel == 2 ? pk[2] : pk[3]));
    return (v >> ((a & 3u) * 8u)) & 0xffu;
}
__device__ __forceinline__ void topk_stage2(const unsigned (&top)[16], bool tab0, size_t item, int* esel, float* wsel) {
        float vO[16], vP[16]; unsigned iOpk[4] = {0u, 0u, 0u, 0u}, iPpk[4] = {0u, 0u, 0u, 0u};
#pragma unroll
        for (int i = 0; i < 16; ++i) { const unsigned t = top[i], tp = dpp_swap1(t);
            vO[i] = key2f(t & ~0x7fu); vP[i] = key2f(tp & ~0x7fu);
            iOpk[i >> 2] |= (127u - (t & 0x7fu)) << ((i & 3) * 8); iPpk[i >> 2] |= (127u - (tp & 0x7fu)) << ((i & 3) * 8); }
        unsigned R[16], G1[16], G2[16];
#define CAND(a, b) ((f2key(vO[a] + vP[b]) & ~0xffu) | (unsigned)(((a) << 4) | (b)))
#pragma unroll
        for (int i = 0; i < 16; ++i) R[i] = CAND(0, i);
        G1[0] = CAND(1, 0); G1[1] = CAND(1, 1); G1[2] = CAND(1, 2); G1[3] = CAND(1, 3); G1[4] = CAND(1, 4); G1[5] = CAND(1, 5); G1[6] = CAND(1, 6); G1[7] = CAND(1, 7);
        G1[8] = CAND(2, 0); G1[9] = CAND(2, 1); G1[10] = CAND(2, 2); G1[11] = CAND(2, 3); G1[12] = CAND(2, 4); G1[13] = CAND(3, 0); G1[14] = CAND(3, 1); G1[15] = CAND(3, 2);
        G2[0] = CAND(3, 3); G2[1] = CAND(4, 0); G2[2] = CAND(4, 1); G2[3] = CAND(4, 2); G2[4] = CAND(5, 0); G2[5] = CAND(5, 1); G2[6] = CAND(6, 0); G2[7] = CAND(6, 1);
        G2[8] = CAND(7, 0); G2[9] = CAND(7, 1); G2[10] = CAND(8, 0); G2[11] = CAND(9, 0); G2[12] = CAND(10, 0); G2[13] = CAND(11, 0); G2[14] = CAND(12, 0); G2[15] = CAND(13, 0);
        const unsigned g30 = CAND(14, 0), g31 = CAND(15, 0);
#undef CAND
        sort16(G1); sort16(G2);
        merge16(R, G1); merge16(R, G2);
        { const unsigned hi = umax_(g30, g31), lo = umin_(g30, g31); R[15] = umax_(R[15], hi); R[14] = umax_(R[14], lo);
#pragma unroll
          for (int j = 8; j > 0; j >>= 1)
#pragma unroll
              for (int i = 0; i < 16; ++i) { const int l = i ^ j; if (l > i) { const unsigned x = R[i], y = R[l]; R[i] = umax_(x, y); R[l] = umin_(x, y); } } }
        float sc[16], ex[16]; float sum = 0.f; unsigned eid[16];
        #pragma unroll
        for (int i = 0; i < 16; ++i) { sc[i] = key2f(R[i] & ~0xffu); const unsigned a = (R[i] >> 4) & 15u, bb = R[i] & 15u;
            const unsigned io = pick_byte(iOpk, a), ip = pick_byte(iPpk, bb);
            eid[i] = tab0 ? (io * 128u + ip) : (ip * 128u + io); }
#pragma unroll
        for (int i = 0; i < 16; ++i) { ex[i] = __expf(sc[i] - sc[0]); sum += ex[i]; }
        const float inv = 1.0f / sum;
        if (tab0) { const size_t o = item * 16;
#pragma unroll
            for (int q = 0; q < 4; ++q) { v4u ev; ev.x = eid[4 * q]; ev.y = eid[4 * q + 1]; ev.z = eid[4 * q + 2]; ev.w = eid[4 * q + 3]; *(v4u*)(esel + o + 4 * q) = ev;
                f32x4 wv; wv[0] = ex[4 * q] * inv; wv[1] = ex[4 * q + 1] * inv; wv[2] = ex[4 * q + 2] * inv; wv[3] = ex[4 * q + 3] * inv; *(f32x4*)(wsel + o + 4 * q) = wv; } }
}

struct EpiScoreTopk {
    static constexpr bool PERM = false, AFTER_DRAIN = false;
    float* scr; const float* ssqp; const float* biasq; float* rstd_out; int* esel; float* wsel;
    __device__ __forceinline__ void operator()(const f32x4 (&acc)[2][2][4][2], const pg8::Unit& u, int wr, int wc, int fr, int fq) const {
        asm volatile("" : "+v"(fr), "+v"(fq));
        const int rl0 = wr * 64 + fr, col0 = wc * 32 + 4 * fq, b = (u.pm * 256) >> 13;
        f32x4 bv[2][2];
#pragma unroll
        for (int bj = 0; bj < 2; ++bj)
#pragma unroll
            for (int n = 0; n < 2; ++n) bv[bj][n] = *(const f32x4*)(biasq + b * 2048 + u.pn * 256 + col0 + bj * 128 + n * 16);
#pragma unroll
        for (int ai = 0; ai < 2; ++ai)
#pragma unroll
            for (int m = 0; m < 4; ++m) { const int rl = rl0 + ai * 128 + m * 16, row = u.pm * 256 + rl;
                const f32x4 p0 = *(const f32x4*)(ssqp + (size_t)row * 4), p1 = *(const f32x4*)(ssqp + ((size_t)32768 + row) * 4), p2 = *(const f32x4*)(ssqp + ((size_t)65536 + row) * 4), p3 = *(const f32x4*)(ssqp + ((size_t)98304 + row) * 4);
                const float tot = (p0[0] + p0[1] + p0[2] + p0[3]) + (p1[0] + p1[1] + p1[2] + p1[3]) + (p2[0] + p2[1] + p2[2] + p2[3]) + (p3[0] + p3[1] + p3[2] + p3[3]);
                const float rstd = __builtin_amdgcn_rsqf(tot * (1.0f / 1024.0f) + 1e-6f);
                if (u.pn == 0 && wc == 0 && fq == 0) rstd_out[row] = rstd;
                float* blk = scr + (2 * wr + 4 * ai + (m >> 1)) * 8192 + 8 * wc * 256 + 32 * (m & 1) * 4;
                const unsigned loff4 = (unsigned)(2 * fr + 64 * fq);
#pragma unroll
                for (int bj = 0; bj < 2; ++bj)
#pragma unroll
                    for (int n = 0; n < 2; ++n) ((f32x4*)(blk + (4 * n * 64 + bj) * 4))[loff4] = acc[ai][bj][m][n] * rstd + bv[bj][n]; }
        asm volatile("s_waitcnt vmcnt(0)" ::: "memory");
        __builtin_amdgcn_s_barrier();
        asm volatile("" ::: "memory");
        int tid = threadIdx.x; asm volatile("" : "+v"(tid));
        const int rl = tid >> 1, tab = tid & 1;
        const float* bp = scr + __builtin_amdgcn_readfirstlane(tid >> 6) * 8192;
        const unsigned lo4 = (unsigned)(tid & 63) * 4u;
        unsigned top[16];
        f32x4 cur[4], nxt[4];
#pragma unroll
        for (int q = 0; q < 4; ++q) cur[q] = *(const f32x4*)(bp + q * 256 + lo4);
#pragma unroll
        for (int grp = 0; grp < 8; ++grp) { unsigned k[16];
            if (grp < 7) {
#pragma unroll
                for (int q = 0; q < 4; ++q) nxt[q] = *(const f32x4*)(bp + ((grp + 1) * 4 + q) * 256 + lo4); }
#pragma unroll
            for (int q = 0; q < 4; ++q) { const f32x4 v = cur[q];
#pragma unroll
                for (int e = 0; e < 4; ++e) { const int j = grp * 16 + q * 4 + e; k[q * 4 + e] = (f2key(v[e]) & ~0x7fu) | (unsigned)(127 - j); } }
            sort16(k);
            if (grp == 0) {
#pragma unroll
                for (int i = 0; i < 16; ++i) top[i] = k[i];
            } else merge16(top, k);
#pragma unroll
            for (int q = 0; q < 4; ++q) cur[q] = nxt[q];
            __builtin_amdgcn_sched_barrier(0); }
        topk_stage2(top, tab == 0, (size_t)u.pn * T + (size_t)(u.pm * 256 + rl), esel, wsel);
    }
};

__device__ __forceinline__ void cvt16(const v4u& u, f32x2_ (&f)[8]) {
#pragma unroll
    for (int i = 0; i < 4; ++i) { f[2 * i] = __builtin_amdgcn_cvt_pk_f32_fp8((int)u[i], false); f[2 * i + 1] = __builtin_amdgcn_cvt_pk_f32_fp8((int)u[i], true); }
}
constexpr int PITEM = 8, NPITEM = T / PITEM;
__device__ __forceinline__ int peer_next(unsigned* q, int lane) {
    int idx = 0; if (lane == 0) idx = (int)__hip_atomic_fetch_add(q, 1u, __ATOMIC_RELAXED, __HIP_MEMORY_SCOPE_AGENT);
    return __builtin_amdgcn_readfirstlane(idx);
}
#define PEER_SB() __builtin_amdgcn_sched_barrier(0)
#define DPP_IADD(s, ctrl) ((s) + __builtin_amdgcn_update_dpp(0, (s), (ctrl), 0xF, 0xF, false))
__device__ __forceinline__ void p8_dots(const v4u (&ud)[16], const int (&hh)[4], const int (&hl)[4], int c8, int& r0, int& r1) {
#pragma unroll
    for (int i = 0; i < 16; ++i) { int sh = 0, sl = 0;
#pragma unroll
        for (int d = 0; d < 4; ++d) { sh = __builtin_amdgcn_sdot8((int)ud[i][d], hh[d], sh, false); sl = __builtin_amdgcn_sdot8((int)ud[i][d], hl[d], sl, false); }
        int sm = (sh << 4) + sl;
        sm = DPP_IADD(sm, 0xB1); sm = DPP_IADD(sm, 0x4E); sm = DPP_IADD(sm, 0x141);
        if ((i & 1) == 0) r0 = (c8 == (i >> 1)) ? sm : r0; else r1 = (c8 == (i >> 1)) ? sm : r1; }
}
constexpr int PSLAB = 12288;
__device__ __forceinline__ void p8_item(Frame& F, int sl, int item, int nitem, bool filled, LAS unsigned char* slab) {
    const int c8 = F.lane & 7, q8 = F.lane >> 3, t0 = item * PITEM;
    const unsigned char* ub = F.U8() + (size_t)sl * 16384 * 128 + 16 * c8;
    LAS int* eL = (LAS int*)slab; LAS unsigned char* hL = (LAS unsigned char*)(slab + 4096);
    LAS float* qL = (LAS float*)(slab + 6144);
    v4u t4[4], h2[4]; float rs2[4]; f32x4 sA, sB, gA, gB;
#define P8_BLK_LOAD(tb) do { \
        { const float* sp_ = F.mod() + ((tb) >> 13) * 6144 + 3072 + sl * CSLU + 8 * (F.lane & 31); sA = *(const f32x4*)sp_; sB = *(const f32x4*)(sp_ + 4); \
          const float* gp_ = F.g_ffn() + sl * CSLU + 8 * (F.lane & 31); gA = *(const f32x4*)gp_ * (*(const f32x4*)(sp_ + 1024) + 1.0f); gB = *(const f32x4*)(gp_ + 4) * (*(const f32x4*)(sp_ + 1028) + 1.0f); } \
        _Pragma("unroll") for (int i = 0; i < 4; ++i) rs2[i] = F.rstd()[(tb) + 2 * i + (F.lane >> 5)]; \
        _Pragma("unroll") for (int i = 0; i < 4; ++i) t4[i] = __builtin_nontemporal_load((const v4u*)(F.esel() + ((size_t)(2 * i + (F.lane >> 5)) * T + (tb)) * 16) + (F.lane & 31)); \
        _Pragma("unroll") for (int i = 0; i < 4; ++i) h2[i] = __builtin_nontemporal_load((const v4u*)(F.hg() + (size_t)((tb) + 2 * i + (F.lane >> 5)) * D + sl * CSLU + 8 * (F.lane & 31))); } while (0)
#define DPP_FMAX(v, ctrl) __builtin_fmaxf((v), __builtin_bit_cast(float, __builtin_amdgcn_update_dpp(0, __builtin_bit_cast(int, (v)), (ctrl), 0xF, 0xF, false)))
#define P8_QN(x, k) { const int q_ = (int)__builtin_rintf((x) * qs_), lo_ = ((q_ + 8) & 15) - 8, hi_ = (q_ - lo_) >> 4; wl_ |= (unsigned)(lo_ & 15) << (4 * (k)); wh_ |= (unsigned)(hi_ & 15) << (4 * (k)); }
#define P8_BLK_STORE() do { _Pragma("unroll") for (int i = 0; i < 4; ++i) *(LAS v4u*)(eL + ((F.lane & 31) >> 2) * NSEL + (2 * i + (F.lane >> 5)) * 16 + 4 * (F.lane & 3)) = t4[i]; \
        _Pragma("unroll") for (int i = 0; i < 4; ++i) { const float r_ = rs2[i]; const v4u h_ = h2[i]; \
            const f32x4 ra_ = gA * r_, rb_ = gB * r_; \
            const float x0 = bflo(h_[0]) * ra_[0] + sA[0], x1 = bfhi(h_[0]) * ra_[1] + sA[1], x2 = bflo(h_[1]) * ra_[2] + sA[2], x3 = bfhi(h_[1]) * ra_[3] + sA[3]; \
            const float x4 = bflo(h_[2]) * rb_[0] + sB[0], x5 = bfhi(h_[2]) * rb_[1] + sB[1], x6 = bflo(h_[3]) * rb_[2] + sB[2], x7 = bfhi(h_[3]) * rb_[3] + sB[3]; \
            float m_ = __builtin_fmaxf(__builtin_fmaxf(__builtin_fmaxf(__builtin_fabsf(x0), __builtin_fabsf(x1)), __builtin_fmaxf(__builtin_fabsf(x2), __builtin_fabsf(x3))), \
                                       __builtin_fmaxf(__builtin_fmaxf(__builtin_fabsf(x4), __builtin_fabsf(x5)), __builtin_fmaxf(__builtin_fabsf(x6), __builtin_fabsf(x7)))); \
            m_ = DPP_FMAX(m_, 0x128); m_ = DPP_FMAX(m_, 0x124); m_ = DPP_FMAX(m_, 0x122); m_ = DPP_FMAX(m_, 0x121); m_ = __builtin_fmaxf(m_, __shfl_xor(m_, 16)); m_ = __builtin_fmaxf(m_, 1e-20f); \
            const float qs_ = 119.0f * __builtin_amdgcn_rcpf(m_); \
            const int tk_ = 2 * i + (F.lane >> 5); \
            if ((F.lane & 31) == 0) qL[tk_] = m_ * (1.0f / (119.0f * UQSCALE)); \
            unsigned wl_ = 0u, wh_ = 0u; P8_QN(x0, 0) P8_QN(x1, 1) P8_QN(x2, 2) P8_QN(x3, 3) P8_QN(x4, 4) P8_QN(x5, 5) P8_QN(x6, 6) P8_QN(x7, 7) \
            *(LAS unsigned*)(hL + tk_ * 256 + 4 * (F.lane & 31)) = wh_; *(LAS unsigned*)(hL + tk_ * 256 + 128 + 4 * (F.lane & 31)) = wl_; } \
        asm volatile("s_waitcnt lgkmcnt(0)" ::: "memory"); } while (0)
    if (!filled) { P8_BLK_LOAD(t0); P8_BLK_STORE(); }
    bf16* po = F.pact() + ((size_t)t0 * NSLU + sl) * NSEL + 16 * q8 + 2 * c8;
    v4u udA[16], udB[16];
#define P8_GATHER(dst, tt) do { v4u e_[4]; _Pragma("unroll") for (int k = 0; k < 4; ++k) e_[k] = *(LAS const v4u*)(eL + (tt) * NSEL + 16 * q8 + 4 * k); \
        _Pragma("unroll") for (int i = 0; i < 16; ++i) dst[i] = *(const v4u*)(ub + (size_t)e_[i >> 2][i & 3] * 128); } while (0)
#define P8_HN(tt) int hh[4], hl[4]; { const v4u a_ = *(LAS const v4u*)(hL + (tt) * 256 + 16 * c8), b_ = *(LAS const v4u*)(hL + (tt) * 256 + 128 + 16 * c8); \
        hh[0] = (int)a_[0]; hh[1] = (int)a_[1]; hh[2] = (int)a_[2]; hh[3] = (int)a_[3]; hl[0] = (int)b_[0]; hl[1] = (int)b_[1]; hl[2] = (int)b_[2]; hl[3] = (int)b_[3]; }
#define P8_OUT(tt, r0, r1) do { const float dq_ = qL[tt]; __builtin_nontemporal_store(cvtpk((float)(r0) * dq_, (float)(r1) * dq_), (unsigned*)(po + (size_t)(tt) * NSLU * NSEL)); } while (0)
    P8_GATHER(udA, 0);
    for (int tt = 0; tt < PITEM - 2; tt += 2) {
        P8_GATHER(udB, tt + 1);
        { P8_HN(tt); int r0 = 0, r1 = 0; p8_dots(udA, hh, hl, c8, r0, r1); P8_OUT(tt, r0, r1); }
        P8_GATHER(udA, tt + 2);
        { P8_HN(tt + 1); int r0 = 0, r1 = 0; p8_dots(udB, hh, hl, c8, r0, r1); P8_OUT(tt + 1, r0, r1); }
    }
    {
        P8_GATHER(udB, PITEM - 1);
        { P8_HN(PITEM - 2); int r0 = 0, r1 = 0; p8_dots(udA, hh, hl, c8, r0, r1); P8_OUT(PITEM - 2, r0, r1); }
        if (nitem >= 0) P8_BLK_LOAD(nitem * PITEM);
        { P8_HN(PITEM - 1); int r0 = 0, r1 = 0; p8_dots(udB, hh, hl, c8, r0, r1); P8_OUT(PITEM - 1, r0, r1); }
        if (nitem >= 0) P8_BLK_STORE();
    }
#undef P8_GATHER
#undef P8_HN
#undef P8_OUT
#undef P8_BLK_LOAD
#undef P8_BLK_STORE
#undef P8_QN
#undef DPP_FMAX
}
__device__ __forceinline__ void p8b_coef(Frame& F) {
    const int N8 = T * (NSEL / 8);
#pragma unroll 2
    for (int i = F.bid * NTHR + F.tid; i < N8; i += F.G * NTHR) { const size_t t = (size_t)(i >> 4); const int m = i & 15;
        const bf16* pp = F.pact() + t * NSLU * NSEL + 8 * m;
        v4u p4[NSLU];
#pragma unroll
        for (int q = 0; q < NSLU; ++q) p4[q] = __builtin_nontemporal_load((const v4u*)(pp + q * NSEL));
        const float* wp = F.wsel() + ((size_t)(m >> 1) * T + t) * 16 + 8 * (m & 1);
        const f32x4 w0 = *(const f32x4*)wp, w1 = *(const f32x4*)(wp + 4);
        float a[8];
#pragma unroll
        for (int e = 0; e < 4; ++e) { float lo = 0.f, hi = 0.f;
#pragma unroll
            for (int q = 0; q < NSLU; ++q) { lo += bflo(p4[q][e]); hi += bfhi(p4[q][e]); }
            a[2 * e] = lo; a[2 * e + 1] = hi; }
        f32x4 o0, o1;
#pragma unroll
        for (int e = 0; e < 4; ++e) { o0[e] = w0[e] * 0.5f * a[e] * (1.0f + erff(a[e] * 0.70710678f)); o1[e] = w1[e] * 0.5f * a[4 + e] * (1.0f + erff(a[4 + e] * 0.70710678f)); }
        float* cp = F.coef() + t * NSEL + 8 * m;
        *(f32x4*)cp = o0; *(f32x4*)(cp + 4) = o1; }
}
__device__ __forceinline__ void p9_token(const v4u (&vd)[16], LAS const float* cL, bf16* yo, LAS float* red, int lane, int c8, int q8) {
    f32x4 cc[4];
#pragma unroll
    for (int k = 0; k < 4; ++k) cc[k] = *(LAS const f32x4*)(cL + 16 * q8 + 4 * k);
    f32x2_ y[8];
#pragma unroll
    for (int k = 0; k < 8; ++k) y[k] = (f32x2_){0.f, 0.f};
#pragma unroll
    for (int i = 0; i < 16; ++i) { f32x2_ vf[8]; cvt16(vd[i], vf); const float c = cc[i >> 2][i & 3]; const f32x2_ c2 = {c, c};
#pragma unroll
        for (int k = 0; k < 8; ++k) y[k] += c2 * vf[k];
        PEER_SB(); }
#pragma unroll
    for (int k = 0; k < 4; ++k) { f32x4 o; o[0] = y[2 * k][0]; o[1] = y[2 * k][1]; o[2] = y[2 * k + 1][0]; o[3] = y[2 * k + 1][1]; *(LAS f32x4*)(red + q8 * 128 + 16 * c8 + 4 * k) = o; }
    asm volatile("s_waitcnt lgkmcnt(0)" ::: "memory");
    f32x2_ sm = {0.f, 0.f};
#pragma unroll
    for (int g = 0; g < 8; ++g) sm += *(LAS const f32x2_*)(red + g * 128 + 2 * lane);
    sm = sm * (1.0f / VSCALE);
    __builtin_nontemporal_store(cvtpk(sm[0], sm[1]), (unsigned*)(yo + 2 * lane));
    asm volatile("s_waitcnt lgkmcnt(0)" ::: "memory");
    PEER_SB();
}
__device__ __forceinline__ void p9_item(Frame& F, int sl, int item, int nitem, bool filled, LAS unsigned char* slab) {
    const int c8 = F.lane & 7, q8 = F.lane >> 3, t0 = item * PITEM;
    const unsigned char* vb = F.V8() + (size_t)sl * 16384 * CSL + 16 * c8;
    LAS int* eL = (LAS int*)slab; LAS float* cL = (LAS float*)(slab + 4096); LAS float* red = (LAS float*)(slab + 8192);
    v4u t4[4], c4[4];
#define P9_BLK_LOAD(tb) do { const v4u* cp_ = (const v4u*)(F.coef() + (size_t)(tb) * NSEL); \
        _Pragma("unroll") for (int i = 0; i < 4; ++i) { t4[i] = __builtin_nontemporal_load((const v4u*)(F.esel() + ((size_t)(2 * i + (F.lane >> 5)) * T + (tb)) * 16) + (F.lane & 31)); c4[i] = __builtin_nontemporal_load(cp_ + i * 64 + F.lane); } } while (0)
#define P9_BLK_STORE() do { _Pragma("unroll") for (int i = 0; i < 4; ++i) { *(LAS v4u*)(eL + ((F.lane & 31) >> 2) * NSEL + (2 * i + (F.lane >> 5)) * 16 + 4 * (F.lane & 3)) = t4[i]; *(LAS v4u*)(cL + (i * 64 + F.lane) * 4) = c4[i]; } \
        asm volatile("s_waitcnt lgkmcnt(0)" ::: "memory"); } while (0)
    if (!filled) { P9_BLK_LOAD(t0); P9_BLK_STORE(); }
    bf16* yo = F.ybuf() + (size_t)t0 * D + sl * CSL;
    v4u vdA[16], vdB[16];
#define P9_GATHER(dst, tt) do { v4u e_[4]; _Pragma("unroll") for (int k = 0; k < 4; ++k) e_[k] = *(LAS const v4u*)(eL + (tt) * NSEL + 16 * q8 + 4 * k); \
        _Pragma("unroll") for (int i = 0; i < 16; ++i) dst[i] = *(const v4u*)(vb + (size_t)e_[i >> 2][i & 3] * CSL); } while (0)
    P9_GATHER(vdA, 0);
    for (int tt = 0; tt < PITEM - 2; tt += 2) {
        P9_GATHER(vdB, tt + 1);
        p9_token(vdA, cL + tt * NSEL, yo + (size_t)tt * D, red, F.lane, c8, q8);
        P9_GATHER(vdA, tt + 2);
        p9_token(vdB, cL + (tt + 1) * NSEL, yo + (size_t)(tt + 1) * D, red, F.lane, c8, q8);
    }
    {
        P9_GATHER(vdB, PITEM - 1);
        p9_token(vdA, cL + (PITEM - 2) * NSEL, yo + (size_t)(PITEM - 2) * D, red, F.lane, c8, q8);
        if (nitem >= 0) P9_BLK_LOAD(nitem * PITEM);
        p9_token(vdB, cL + (PITEM - 1) * NSEL, yo + (size_t)(PITEM - 1) * D, red, F.lane, c8, q8);
        if (nitem >= 0) P9_BLK_STORE();
    }
#undef P9_GATHER
#undef P9_BLK_LOAD
#undef P9_BLK_STORE
}
template <int SIDE>
__device__ __forceinline__ void peer_phase(Frame& F0, int rep) {
    Frame F = F0; asm volatile("" : "+v"(F.lane));
    constexpr int NS = (SIDE == 0) ? NSLU : NSL;
    const int s0 = (int)(xb_xcc_id() & (unsigned)(NS - 1));
    unsigned* qbase = F.ctl() + (SIDE == 0 ? CW_QU : CW_QV) + rep * 64 * 32;
    LAS unsigned char* cf = F.lds + F.wave * PSLAB;
    for (int k = 0; k < NS; ++k) { const int sl = (s0 + k) & (NS - 1);
        int item = peer_next(qbase + 64 * sl, F.lane); bool filled = false;
        while (item < NPITEM) { int nitem = peer_next(qbase + 64 * sl, F.lane); if (nitem >= NPITEM) nitem = -1;
            if (SIDE == 0) p8_item(F, sl, item, nitem, filled, cf); else p9_item(F, sl, item, nitem, filled, cf);
            filled = nitem >= 0; item = nitem >= 0 ? nitem : NPITEM; } }
}
__device__ __forceinline__ void p10_final(Frame& F) {
    const int gwc = F.bid * NWAVES + F.wave, NGW = F.G * NWAVES;
    for (int row0 = gwc * 16; row0 < T; row0 += NGW * 16) {
        const int b = row0 >> 13; const float* mb = F.mod() + b * 6144 + 5120; const float* fm = F.fmod() + b * 2048;
        f32x4 g2[4], ca[4], cb[4];
#pragma unroll
        for (int j = 0; j < 4; ++j) { const int k = 256 * j + 4 * F.lane; g2[j] = *(const f32x4*)(mb + k); ca[j] = *(const f32x4*)(F.fnorm_g() + k) * (*(const f32x4*)(fm + 1024 + k) + 1.0f); cb[j] = *(const f32x4*)(fm + k); }
#pragma unroll 4
        for (int r = 0; r < 16; ++r) { float* hr = F.out() + (size_t)(row0 + r) * D; const bf16* yr = F.ybuf() + (size_t)(row0 + r) * D; const bf16* hb = F.hg() + (size_t)(row0 + r) * D;
            f32x4 z[4]; float ss = 0.f;
#pragma unroll
            for (int j = 0; j < 4; ++j) { const v2u hq = *(const v2u*)(hb + 256 * j + 4 * F.lane); f32x4 hv; hv[0] = bflo(hq[0]); hv[1] = bfhi(hq[0]); hv[2] = bflo(hq[1]); hv[3] = bfhi(hq[1]);
                const v2u yq = __builtin_nontemporal_load((const v2u*)(yr + 256 * j + 4 * F.lane)); f32x4 yv; yv[0] = bflo(yq[0]); yv[1] = bfhi(yq[0]); yv[2] = bflo(yq[1]); yv[3] = bfhi(yq[1]);
                z[j] = hv + g2[j] * yv; ss += z[j][0] * z[j][0] + z[j][1] * z[j][1] + z[j][2] * z[j][2] + z[j][3] * z[j][3]; }
            const float rstd = __builtin_amdgcn_rsqf(wave_sum(ss) * (1.0f / D) + EPS);
#pragma unroll
            for (int j = 0; j < 4; ++j) *(f32x4*)(hr + 256 * j + 4 * F.lane) = z[j] * rstd * ca[j] + cb[j]; }
    }
}

constexpr int NPHASE = 12;
__global__ void __launch_bounds__(NTHR, 2) fwd_kernel(Args args) {
    extern __shared__ __attribute__((aligned(16))) unsigned char lds_raw[];
    Frame F;
    F.lds = (LAS unsigned char*)lds_raw;
    F.tid = threadIdx.x; F.lane = F.tid & 63; F.wave = __builtin_amdgcn_readfirstlane(F.tid >> 6); F.G = gridDim.x; F.bid = blockIdx.x;
    unsigned char* ws = args.ws; F.a = &args;
    volatile LAS unsigned* misc = (volatile LAS unsigned*)(F.lds + MISC_OFF);
    if (F.tid < 64) misc[F.tid] = 0u;
    __syncthreads();
    const int lo = args.ph_lo, hi = args.ph_hi;
    const bool multi = (hi - lo) > 1;
    XcdBarrier bar; bar.bar = (unsigned*)(ws + WS_CTL) + CW_BAR; bar.x = 0; bar.st = nullptr;
    if (multi) bar = xcd_barrier_post((unsigned*)(ws + WS_CTL) + CW_BAR, misc + 8);
#ifndef PHMASK
#define PHMASK 0xfff
#endif
#define IN(k) (((PHMASK >> (k)) & 1) && lo <= (k) && (k) < hi)
#define SEAM(k) do { if (IN(k) && IN((k) + 1)) xcd_barrier(bar); } while (0)

#ifndef REPMASK
#define REPMASK 0
#endif
#define REP(k) (((REPMASK) >> (k)) & 1)
#define REPBAR(k) if (REP(k) && rep == 0) xcd_barrier(bar)
    if (IN(0)) p0_prologue(F);
    if (IN(0) && IN(1)) {
        if (F.tid == 0) { XB_SPIN(xb_ld(F.ctl() + CW_GV) < (unsigned)F.G, bar.bar); __builtin_amdgcn_fence(__ATOMIC_ACQUIRE, "agent"); asm volatile("s_waitcnt vmcnt(0)" ::: "memory"); }
        __syncthreads(); }
    if (IN(1)) p1_norm(F);
    SEAM(1);
    if (IN(2)) { { pg8::Gemm g{F.bufA(), F.Win_t(), T, NIN, D}; pg8::StaticOrder S; S.init(T, NIN, F.G, F.bid);
        pg8::EpiProj E{F.proj(), NIN};
        pg8::gemm_phase<pg8::EpiProj, pg8::StaticOrder, true, true>(F.lds, g, S, E); }
#if ((REPMASK) >> 2) & 1
        xcd_barrier(bar); { pg8::Gemm g{F.bufA(), F.Win_t(), T, NIN, D}; pg8::StaticOrder S; S.init(T, NIN, F.G, F.bid);
        pg8::EpiProj E{F.proj(), NIN};
        pg8::gemm_phase<pg8::EpiProj, pg8::StaticOrder, true, true>(F.lds, g, S, E); }
#endif
    } SEAM(2);
    if (IN(3)) { p3_pre(F);
      for (int rep = 0; rep <= REP(3); ++rep) {
        for (int it = F.bid; it < NB * NHH * 2 * NSEG; it += F.G) h1_item(F, it);
        asm volatile("s_waitcnt vmcnt(0)" ::: "memory");
        __syncthreads();
        if (F.tid == 0) { __builtin_amdgcn_fence(__ATOMIC_RELEASE, "agent"); asm volatile("s_waitcnt vmcnt(0)" ::: "memory"); (void)xb_add(F.ctl() + CW_H1, 1u); }
        float cw[CW];
#pragma unroll
        for (int j = 0; j < CW; ++j) cw[j] = F.conv_w()[j * DC + F.tid];
        const float cbias = F.conv_b()[F.tid];
        for (int it = F.bid; it < T / 32; it += F.G) conv_item(F, it, cw, cbias);
        if (F.tid == 0) { const unsigned tgt = (unsigned)F.G * (unsigned)(rep + 1); XB_SPIN(xb_ld(F.ctl() + CW_H1) < tgt, bar.bar); __builtin_amdgcn_fence(__ATOMIC_ACQUIRE, "agent"); asm volatile("s_waitcnt vmcnt(0)" ::: "memory"); }
        __syncthreads();
        h_scan(F);
        REPBAR(3); }
    } SEAM(3);
    if (IN(4)) { for (int rep = 0; rep <= REP(4); ++rep) { for (int it = F.bid; it < NB * NHH * NSEG; it += F.G) h2_item(F, it); REPBAR(4); } } SEAM(4);
    if (IN(5)) { { pg8::Gemm g{F.bufA(), F.Wout_t(), T, D, D}; pg8::StaticOrder S; S.init(T, D, F.G, F.bid);
        pg8::EpiOut E{F.x(), F.hg(), F.mod(), F.ssqp()};
        pg8::gemm_phase<pg8::EpiOut, pg8::StaticOrder, true, true>(F.lds, g, S, E); }
#if ((REPMASK) >> 5) & 1
        xcd_barrier(bar); { pg8::Gemm g{F.bufA(), F.Wout_t(), T, D, D}; pg8::StaticOrder S; S.init(T, D, F.G, F.bid);
        pg8::EpiOut E{F.x(), F.hg(), F.mod(), F.ssqp()};
        pg8::gemm_phase<pg8::EpiOut, pg8::StaticOrder, true, true>(F.lds, g, S, E); }
#endif
    } SEAM(5);
    if (IN(6)) { { pg8::Gemm g{F.hg(), F.Wqk_b(), T, NQK, D, (size_t)NQK * D * 2}; pg8::StaticOrder S; S.init(T, NQK, F.G, F.bid);
        EpiScoreTopk E{F.scores() + (size_t)F.bid * 65536, F.ssqp(), F.biasq(), F.rstd(), F.esel(), F.wsel()};
        pg8::gemm_phase<EpiScoreTopk, pg8::StaticOrder, true, true>(F.lds, g, S, E); }
    } SEAM(6);
    if (IN(8)) { for (int rep = 0; rep <= REP(8); ++rep) { peer_phase<0>(F, rep); REPBAR(8); } } SEAM(8);
    if (IN(9)) { for (int rep = 0; rep <= REP(9); ++rep) { p8b_coef(F); REPBAR(9); } } SEAM(9);
    if (IN(10)) { for (int rep = 0; rep <= REP(10); ++rep) { peer_phase<1>(F, rep); REPBAR(10); } } SEAM(10);
    if (IN(11)) { p10_final(F); }
#undef IN
#undef SEAM
}

#ifndef MK_ONE_LAUNCH
#define MK_ONE_LAUNCH 0
#endif
extern "C" void kernel_launch(void* const* d_in, const int* in_sizes, int n_in, void* d_out, int out_size, void* d_ws, size_t ws_size, hipStream_t stream) {
    static int grid = 0;
    if (grid == 0) {
        if (n_in != 23 || out_size != T * D || ws_size < WS_END) { fprintf(stderr, "kernel_launch: unexpected shapes (n_in %d, out %d, ws %zu)\n", n_in, out_size, ws_size); grid = -1; return; }
        int dev = 0, cus = 0, per_cu = 0;
        if (hipGetDevice(&dev) != hipSuccess || hipDeviceGetAttribute(&cus, hipDeviceAttributeMultiprocessorCount, dev) != hipSuccess) { grid = -1; return; }
        if (hipFuncSetAttribute((const void*)fwd_kernel, hipFuncAttributeMaxDynamicSharedMemorySize, LDS_BYTES) != hipSuccess) { fprintf(stderr, "kernel_launch: hipFuncSetAttribute failed\n"); grid = -1; return; }
        if (hipOccupancyMaxActiveBlocksPerMultiprocessor(&per_cu, (const void*)fwd_kernel, NTHR, LDS_BYTES) != hipSuccess || per_cu < 1) { fprintf(stderr, "kernel_launch: occupancy query reports %d\n", per_cu); }
        (void)hipGetLastError();
        grid = cus;
    }
    if (grid < 0) return;
    (void)hipMemsetAsync((char*)d_ws + WS_CTL, 0, CTL_ZERO_BYTES, stream);
    Args a{};
    for (int i = 0; i < 23; ++i) a.in[i] = (const float*)d_in[i];
    a.out = (float*)d_out; a.ws = (unsigned char*)d_ws;
#if MK_ONE_LAUNCH
    a.ph_lo = 0; a.ph_hi = NPHASE;
    hipLaunchKernelGGL(fwd_kernel, dim3(grid), dim3(NTHR), LDS_BYTES, stream, a);
#else
    for (int p = 0; p < NPHASE; ++p) { a.ph_lo = p; a.ph_hi = p + 1; hipLaunchKernelGGL(fwd_kernel, dim3(grid), dim3(NTHR), LDS_BYTES, stream, a); }
#endif
}
```

```cpp
#include <hip/hip_runtime.h>
#include <cstdio>
#include <cstdint>
namespace pg8 {
#define PG8_LAS __attribute__((address_space(3)))
typedef unsigned short bf16_t;
typedef short bf16x8 __attribute__((ext_vector_type(8)));
typedef float f32x4 __attribute__((ext_vector_type(4)));
typedef unsigned u32x4 __attribute__((ext_vector_type(4)));
constexpr int BM = 256, BK = 64, HALF = 128, HTB = HALF * BK * 2  , STAGE_BYTES = 8 * HTB, NXCD = 8, WGM = 8;

__host__ __device__ __forceinline__ int lds_byte(int r, int c) { const int st = (r >> 4) * 2 + (c >> 5), rr = r & 15, cc = c & 31, ob = rr * 64 + cc * 2; return st * 1024 + (ob ^ (((ob >> 9) & 1) << 5)); }
__host__ __device__ __forceinline__ void stage_rc(int b, int& R, int& C) { const int st = b / 1024, sb = b % 1024, swz = sb ^ (((sb >> 9) & 1) << 5); R = (st >> 1) * 16 + swz / 64; C = (st & 1) * 32 + (swz % 64) / 2; }
__host__ __device__ __forceinline__ int perm32(int rho) { const int n = rho >> 4, i = rho & 15; return 8 * (i >> 2) + 4 * n + (i & 3); }

struct Unit { int pm, pn; };
struct Gemm { const bf16_t* A; const bf16_t* Bt; int M, N, K; size_t bbatch = 0; };

struct StaticOrder {
    int nM, nN, nwg, G, c;
    __host__ __device__ void init(int M, int N, int G_, int c_) { nM = M / BM; nN = N / BM; nwg = nM * nN; G = G_; c = c_; }
    __host__ __device__ bool next(int i, Unit& u) const {
        const long L = (long)i * G + c; if (L >= nwg) return false;
        int wgid = (int)L; { const int q = nwg / NXCD, r = nwg % NXCD, xcd = wgid % NXCD, off = wgid / NXCD; wgid = (xcd < r ? xcd * (q + 1) : r * (q + 1) + (xcd - r) * q) + off; }
        const int nig = WGM * nN, gid = wgid / nig, fm = gid * WGM, gsz = (nM - fm) < WGM ? (nM - fm) : WGM;
        u.pm = fm + ((wgid % nig) % gsz); u.pn = (wgid % nig) / gsz; return true;
    }
    __device__ __forceinline__ void a_ready(const Unit&) const {}
    __device__ __forceinline__ void done(const Unit&) const {}
};
__device__ __forceinline__ unsigned cvt_pk_bf16(float lo, float hi) { unsigned r; asm volatile("v_cvt_pk_bf16_f32 %0, %1, %2" : "=v"(r) : "v"(lo), "v"(hi)); return r; }
typedef float f32x2 __attribute__((ext_vector_type(2)));
__device__ __forceinline__ f32x2 gelu_pk(f32x2 v) {
    const f32x2 av = __builtin_elementwise_abs(v), d = av * 0.2316418882f + 1.0f;
    f32x2 t; t.x = __builtin_amdgcn_rcpf(d.x); t.y = __builtin_amdgcn_rcpf(d.y);
    f32x2 q = t * 0.5307027145f + (-0.7265760135f); q = q * t + 0.7107068705f; q = q * t + (-0.142248368f); q = q * t + 0.127414796f; q = q * t;
    const f32x2 s = (v * v) * (-0.72134752044f);
    f32x2 e; e.x = __builtin_amdgcn_exp2f(s.x); e.y = __builtin_amdgcn_exp2f(s.y);
    const f32x2 m = v * (q * e), r = v - m;
    f32x2 o; o.x = v.x < 0.f ? m.x : r.x; o.y = v.y < 0.f ? m.y : r.y; return o;
}

template <int ACT  > struct EpiBf16 {
    static constexpr bool PERM = true, AFTER_DRAIN = false; static_assert(ACT == 0 || ACT == 1, "EpiBf16: ACT is 0 (none) or 1 (gelu_pk)");
    bf16_t* O; int ldc; const float* bias; int split_cols; size_t split_stride; float scale0;
    __device__ __forceinline__ void operator()(const f32x4 (&acc)[2][2][4][2], const Unit& u, int wr, int wc, int fr, int fq) const {
        const int row0 = u.pm * BM + wr * 64 + fr; int colt = u.pn * BM; bf16_t* base = O;
        float sc = 1.f; if (split_cols) { const int t = colt / split_cols; base += (size_t)t * split_stride; colt -= t * split_cols; if (t == 0) sc = scale0; }
        const int col0 = colt + wc * 32 + 8 * fq, bcol0 = u.pn * BM + wc * 32 + 8 * fq;
        f32x4 bv[2][2];
#pragma unroll
        for (int bj = 0; bj < 2; ++bj)
#pragma unroll
            for (int n = 0; n < 2; ++n) bv[bj][n] = bias ? *(const f32x4*)(bias + bcol0 + bj * HALF + 4 * n) : (f32x4){0.f, 0.f, 0.f, 0.f};
#pragma unroll
        for (int ai = 0; ai < 2; ++ai)
#pragma unroll
            for (int m = 0; m < 4; ++m) { bf16_t* rowp = base + (size_t)(row0 + ai * HALF + m * 16) * ldc + col0;
#pragma unroll
                for (int bj = 0; bj < 2; ++bj) { f32x4 v0 = acc[ai][bj][m][0] + bv[bj][0], v1 = acc[ai][bj][m][1] + bv[bj][1];
                    if (ACT == 1) { f32x2 a = gelu_pk((f32x2){v0[0], v0[1]}), b = gelu_pk((f32x2){v0[2], v0[3]}), c = gelu_pk((f32x2){v1[0], v1[1]}), d = gelu_pk((f32x2){v1[2], v1[3]});
                        v0 = (f32x4){a.x, a.y, b.x, b.y}; v1 = (f32x4){c.x, c.y, d.x, d.y}; }
                    v0 = v0 * sc; v1 = v1 * sc; u32x4 w; w.x = cvt_pk_bf16(v0[0], v0[1]); w.y = cvt_pk_bf16(v0[2], v0[3]); w.z = cvt_pk_bf16(v1[0], v1[1]); w.w = cvt_pk_bf16(v1[2], v1[3]);
                    *(u32x4*)(rowp + bj * HALF) = w; } }
    }
};

struct EpiOut {
    static constexpr bool PERM = true, AFTER_DRAIN = false;
    const float* X; bf16_t* HB; const float* mod; float* ssqp;
    __device__ __forceinline__ void operator()(const f32x4 (&acc)[2][2][4][2], const Unit& u, int wr, int wc, int fr, int fq) const {
        const int row0 = u.pm * BM + wr * 64 + fr, col0 = u.pn * BM + wc * 32 + 8 * fq;
        const int b = (u.pm * BM) >> 13;
        const float* mb = mod + b * 6144;
        f32x4 g1v[2][2];
#pragma unroll
        for (int bj = 0; bj < 2; ++bj)
#pragma unroll
            for (int n = 0; n < 2; ++n) g1v[bj][n] = *(const f32x4*)(mb + 2048 + col0 + bj * HALF + 4 * n);
#pragma unroll
        for (int ai = 0; ai < 2; ++ai)
#pragma unroll
            for (int m = 0; m < 4; ++m) { const int row = row0 + ai * HALF + m * 16; const size_t ro = (size_t)row * 1024 + col0; float ss = 0.f;
#pragma unroll
                for (int bj = 0; bj < 2; ++bj) {
                    const f32x4 x0 = *(const f32x4*)(X + ro + bj * HALF), x1 = *(const f32x4*)(X + ro + bj * HALF + 4);
                    const f32x4 h0 = x0 + g1v[bj][0] * acc[ai][bj][m][0], h1 = x1 + g1v[bj][1] * acc[ai][bj][m][1];
                    u32x4 hw; hw.x = cvt_pk_bf16(h0[0], h0[1]); hw.y = cvt_pk_bf16(h0[2], h0[3]); hw.z = cvt_pk_bf16(h1[0], h1[1]); hw.w = cvt_pk_bf16(h1[2], h1[3]);
                    *(u32x4*)(HB + ro + bj * HALF) = hw;
                    ss += h0[0] * h0[0] + h0[1] * h0[1] + h0[2] * h0[2] + h0[3] * h0[3] + h1[0] * h1[0] + h1[1] * h1[1] + h1[2] * h1[2] + h1[3] * h1[3]; }
                ss += __shfl_xor(ss, 16); ss += __shfl_xor(ss, 32);
                if (fq == 0) ssqp[((size_t)u.pn * 32768 + row) * 4 + wc] = ss; }
    }
};
struct EpiScore {
    static constexpr bool PERM = false, AFTER_DRAIN = false;
    float* S; const float* ssqp; const float* biasq; float* rstd_out;
    __device__ __forceinline__ void operator()(const f32x4 (&acc)[2][2][4][2], const Unit& u, int wr, int wc, int fr, int fq) const {
        const int row0 = u.pm * BM + wr * 64 + fr, col0 = u.pn * BM + wc * 32 + 4 * fq;
        const int b = (u.pm * BM) >> 13;
        f32x4 bv[2][2];
#pragma unroll
        for (int bj = 0; bj < 2; ++bj)
#pragma unroll
            for (int n = 0; n < 2; ++n) bv[bj][n] = *(const f32x4*)(biasq + b * 2048 + col0 + bj * HALF + n * 16);
#pragma unroll
        for (int ai = 0; ai < 2; ++ai)
#pragma unroll
            for (int m = 0; m < 4; ++m) { const int row = row0 + ai * HALF + m * 16;
                const f32x4 p0 = *(const f32x4*)(ssqp + (size_t)row * 4), p1 = *(const f32x4*)(ssqp + ((size_t)32768 + row) * 4), p2 = *(const f32x4*)(ssqp + ((size_t)65536 + row) * 4), p3 = *(const f32x4*)(ssqp + ((size_t)98304 + row) * 4);
                const float tot = (p0[0] + p0[1] + p0[2] + p0[3]) + (p1[0] + p1[1] + p1[2] + p1[3]) + (p2[0] + p2[1] + p2[2] + p2[3]) + (p3[0] + p3[1] + p3[2] + p3[3]);
                const float rstd = __builtin_amdgcn_rsqf(tot * (1.0f / 1024.0f) + 1e-6f);
                if (u.pn == 0 && wc == 0 && fq == 0) rstd_out[row] = rstd;
                float* rowp = S + (size_t)row * 2048 + col0;
#pragma unroll
                for (int bj = 0; bj < 2; ++bj)
#pragma unroll
                    for (int n = 0; n < 2; ++n) *(f32x4*)(rowp + bj * HALF + n * 16) = acc[ai][bj][m][n] * rstd + bv[bj][n]; }
    }
};

struct EpiProj {
    static constexpr bool PERM = true, AFTER_DRAIN = false;
    bf16_t* O; int ldc;
    __device__ __forceinline__ void operator()(const f32x4 (&acc)[2][2][4][2], const Unit& u, int wr, int wc, int fr, int fq) const {
        asm volatile("" : "+v"(fr), "+v"(fq));
        const int row0 = u.pm * BM + wr * 64 + fr, col0 = u.pn * BM + wc * 32 + 8 * fq;
        const int cls = u.pn >> 1;
        const bool ident = (cls == 3) || (cls == 5), mulx = (cls == 0) || (cls == 4);
        const float sgn = (cls == 1 || cls == 2) ? 1.4426950408889634f : -1.4426950408889634f;
#pragma unroll
        for (int ai = 0; ai < 2; ++ai)
#pragma unroll
            for (int m = 0; m < 4; ++m) { bf16_t* rowp = O + (size_t)(row0 + ai * HALF + m * 16) * ldc + col0;
#pragma unroll
                for (int bj = 0; bj < 2; ++bj) { f32x4 v0 = acc[ai][bj][m][0], v1 = acc[ai][bj][m][1];
                    if (!ident) {
#pragma unroll
                        for (int j = 0; j < 4; ++j) { const float r0 = __builtin_amdgcn_rcpf(1.0f + __builtin_amdgcn_exp2f(sgn * v0[j])), r1 = __builtin_amdgcn_rcpf(1.0f + __builtin_amdgcn_exp2f(sgn * v1[j]));
                            v0[j] = mulx ? v0[j] * r0 : r0; v1[j] = mulx ? v1[j] * r1 : r1; } }
                    u32x4 w; w.x = cvt_pk_bf16(v0[0], v0[1]); w.y = cvt_pk_bf16(v0[2], v0[3]); w.z = cvt_pk_bf16(v1[0], v1[1]); w.w = cvt_pk_bf16(v1[2], v1[3]);
                    *(u32x4*)(rowp + bj * HALF) = w; } }
    }
};
template <class Epi, class Sched, bool ALIGN_EPI = false, bool SP2 = false>
__device__ __forceinline__ void gemm_phase(PG8_LAS unsigned char* lds, const Gemm g, const Sched& S, const Epi& E) {
    const int tid = threadIdx.x, wid = __builtin_amdgcn_readfirstlane(tid >> 6), lane = tid & 63, wr = wid >> 2, wc = wid & 3, fr = lane & 15, fq = lane >> 4;
    const int K = g.K, nt = K / BK;
    unsigned voffA[2], voffB[2];
#pragma unroll
    for (int i = 0; i < 2; ++i) { int R, C; stage_rc(tid * 16 + i * 8192, R, C); const int Rb = Epi::PERM ? ((R & ~31) + perm32(R & 31)) : R;
        voffA[i] = (unsigned)(R * K + C) * 2u; voffB[i] = (unsigned)(Rb * K + C) * 2u; }
    const size_t kstep = (size_t)(BK * 2);
    const size_t hstep = (size_t)HALF * K * 2;
    const size_t tstep = 2 * hstep;
    const unsigned ldsw = (unsigned)wid * 1024u;
    const int aoff = lds_byte(wr * 64 + fr, fq * 8), boff = lds_byte(wc * 32 + fr, fq * 8);
#define PG8_SA(b, h) (((b) * 2 + (h)) * HTB)
#define PG8_SB(b, h) ((4 + (b) * 2 + (h)) * HTB)
#define PG8_STAGE(bufoff, gbase, voff) do { _Pragma("unroll") for (int _i = 0; _i < 2; ++_i) \
        __builtin_amdgcn_global_load_lds((const unsigned*)((const char*)(gbase) + (voff)[_i]), (PG8_LAS unsigned*)(lds + (bufoff) + ldsw + _i * 8192), 16, 0, 0); } while (0)
#define PG8_LDA(dst, b, h) do { _Pragma("unroll") for (int m = 0; m < 4; ++m) _Pragma("unroll") for (int k = 0; k < 2; ++k) dst[m][k] = *(const PG8_LAS bf16x8*)(lds + PG8_SA(b, h) + aoff + m * 2048 + k * 1024); } while (0)
#define PG8_LDB(dst, b, h) do { _Pragma("unroll") for (int n = 0; n < 2; ++n) _Pragma("unroll") for (int k = 0; k < 2; ++k) dst[n][k] = *(const PG8_LAS bf16x8*)(lds + PG8_SB(b, h) + boff + n * 2048 + k * 1024); } while (0)
#define PG8_MMA(ai, bj, At, Bt) do { __builtin_amdgcn_s_setprio(1); _Pragma("unroll") for (int m = 0; m < 4; ++m) _Pragma("unroll") for (int n = 0; n < 2; ++n) _Pragma("unroll") for (int k = 0; k < 2; ++k) \
        acc[ai][bj][m][n] = __builtin_amdgcn_mfma_f32_16x16x32_bf16(Bt[n][k], At[m][k], acc[ai][bj][m][n], 0, 0, 0); __builtin_amdgcn_s_setprio(0); } while (0)
#define PG8_WAIT_V(n) asm volatile("s_waitcnt vmcnt(" #n ")" ::: "memory")
#define PG8_WAIT_L(n) asm volatile("s_waitcnt lgkmcnt(" #n ")" ::: "memory")
#define PG8_BAR __builtin_amdgcn_s_barrier()
#define PG8_SCHED __builtin_amdgcn_sched_barrier(0)
    Unit cur, nxt; int ui = 0;
    if (!S.next(0, cur)) return;
    f32x4 acc[2][2][4][2];
#pragma unroll
    for (int a = 0; a < 2; ++a)
#pragma unroll
        for (int b = 0; b < 2; ++b)
#pragma unroll
            for (int m = 0; m < 4; ++m)
#pragma unroll
                for (int n = 0; n < 2; ++n) acc[a][b][m][n] = (f32x4){0.f, 0.f, 0.f, 0.f};
    bf16x8 At[4][2], B0[2][2], B1[2][2];
    const char* cA = (const char*)g.A + (size_t)cur.pm * tstep; const char* cB = (const char*)g.Bt + (size_t)cur.pn * tstep + (size_t)(cur.pm >> 5) * g.bbatch;
    S.a_ready(cur);
    if constexpr (SP2) {
        PG8_STAGE(PG8_SB(0, 0), cB, voffB); PG8_STAGE(PG8_SB(0, 1), cB + hstep, voffB); PG8_STAGE(PG8_SA(0, 0), cA, voffA); PG8_STAGE(PG8_SA(0, 1), cA + hstep, voffA);
        if (wr == 1) PG8_BAR;
        PG8_WAIT_V(2); PG8_BAR;
        PG8_STAGE(PG8_SB(1, 0), cB + kstep, voffB); PG8_STAGE(PG8_SA(1, 0), cA + kstep, voffA); PG8_STAGE(PG8_SB(1, 1), cB + hstep + kstep, voffB);
        PG8_WAIT_V(6); PG8_BAR;
    } else {
        PG8_STAGE(PG8_SB(0, 0), cB, voffB); PG8_STAGE(PG8_SA(0, 0), cA, voffA); PG8_STAGE(PG8_SB(0, 1), cB + hstep, voffB); PG8_STAGE(PG8_SA(0, 1), cA + hstep, voffA);
        if (wr == 1) PG8_BAR;
        PG8_WAIT_V(4); PG8_BAR;
        PG8_STAGE(PG8_SB(1, 0), cB + kstep, voffB); PG8_STAGE(PG8_SA(1, 0), cA + kstep, voffA); PG8_STAGE(PG8_SB(1, 1), cB + hstep + kstep, voffB);
        PG8_WAIT_V(6); PG8_BAR;
    }
    for (;;) {
        const bool has_next = S.next(ui + 1, nxt);
        const char* nA = has_next ? (const char*)g.A + (size_t)nxt.pm * tstep : cA; const char* nB = has_next ? (const char*)g.Bt + (size_t)nxt.pn * tstep + (size_t)(nxt.pm >> 5) * g.bbatch : cB;
        for (int t = 0; t < nt; t += 2) {
            const bool last = (t == nt - 2);
            const char* a1 = cA + (size_t)(t + 1) * kstep;
            const char* a2 = last ? nA : cA + (size_t)(t + 2) * kstep; const char* b2 = last ? nB : cB + (size_t)(t + 2) * kstep;
            const char* a3 = a2 + kstep; const char* b3 = b2 + kstep;
            if (last && has_next) S.a_ready(nxt);
            if constexpr (SP2) {
            PG8_LDB(B0, 0, 0); PG8_LDB(B1, 0, 1); PG8_SCHED; PG8_LDA(At, 0, 0); PG8_STAGE(PG8_SA(1, 1), a1 + hstep, voffA);
            PG8_WAIT_V(8); PG8_WAIT_L(0); PG8_BAR; PG8_MMA(0, 0, At, B0); PG8_MMA(0, 1, At, B1); PG8_BAR; PG8_SCHED;
            PG8_LDA(At, 0, 1); PG8_STAGE(PG8_SB(0, 0), b2, voffB); PG8_STAGE(PG8_SB(0, 1), b2 + hstep, voffB); PG8_STAGE(PG8_SA(0, 0), a2, voffA);
            PG8_WAIT_V(8); PG8_WAIT_L(0); PG8_BAR; PG8_MMA(1, 0, At, B0); PG8_MMA(1, 1, At, B1); PG8_BAR; PG8_SCHED;
            PG8_LDB(B0, 1, 0); PG8_LDB(B1, 1, 1); PG8_SCHED; PG8_LDA(At, 1, 0); PG8_STAGE(PG8_SA(0, 1), a2 + hstep, voffA);
            PG8_WAIT_V(8); PG8_WAIT_L(0); PG8_BAR; PG8_MMA(0, 0, At, B0); PG8_MMA(0, 1, At, B1); PG8_BAR; PG8_SCHED;
            PG8_LDA(At, 1, 1); PG8_STAGE(PG8_SB(1, 0), b3, voffB); PG8_STAGE(PG8_SB(1, 1), b3 + hstep, voffB); PG8_STAGE(PG8_SA(1, 0), a3, voffA);
            PG8_WAIT_V(8); PG8_WAIT_L(0); PG8_BAR; PG8_MMA(1, 0, At, B0); PG8_MMA(1, 1, At, B1); PG8_BAR; PG8_SCHED;
            } else {
            PG8_LDB(B0, 0, 0); PG8_SCHED; PG8_LDA(At, 0, 0); PG8_STAGE(PG8_SA(1, 1), a1 + hstep, voffA);
            PG8_WAIT_L(8); PG8_BAR; PG8_WAIT_L(0); PG8_MMA(0, 0, At, B0); PG8_BAR; PG8_SCHED;
            PG8_LDB(B1, 0, 1); PG8_STAGE(PG8_SB(0, 0), b2, voffB);
            PG8_BAR; PG8_WAIT_L(0); PG8_MMA(0, 1, At, B1); PG8_BAR;
            PG8_LDA(At, 0, 1); PG8_STAGE(PG8_SA(0, 0), a2, voffA);
            PG8_BAR; PG8_WAIT_L(0); PG8_MMA(1, 0, At, B0); PG8_BAR; PG8_SCHED;
            PG8_STAGE(PG8_SB(0, 1), b2 + hstep, voffB);
            PG8_WAIT_V(6); PG8_BAR; PG8_MMA(1, 1, At, B1); PG8_BAR;
            PG8_LDB(B0, 1, 0); PG8_SCHED; PG8_LDA(At, 1, 0); PG8_STAGE(PG8_SA(0, 1), a2 + hstep, voffA);
            PG8_WAIT_L(8); PG8_BAR; PG8_WAIT_L(0); PG8_MMA(0, 0, At, B0); PG8_BAR; PG8_SCHED;
            PG8_LDB(B1, 1, 1); PG8_STAGE(PG8_SB(1, 0), b3, voffB);
            PG8_BAR; PG8_WAIT_L(0); PG8_MMA(0, 1, At, B1); PG8_BAR;
            PG8_LDA(At, 1, 1); PG8_STAGE(PG8_SA(1, 0), a3, voffA);
            PG8_BAR; PG8_WAIT_L(0); PG8_MMA(1, 0, At, B0); PG8_BAR; PG8_SCHED;
            PG8_STAGE(PG8_SB(1, 1), b3 + hstep, voffB);
            PG8_WAIT_V(6); PG8_BAR; PG8_MMA(1, 1, At, B1); PG8_BAR;
            }
        }
        if constexpr (ALIGN_EPI) { if (wr == 0) PG8_BAR; }
        if constexpr (!Epi::AFTER_DRAIN) { E(acc, cur, wr, wc, fr, fq); S.done(cur); }
        if (!has_next) break;
#pragma unroll
        for (int a = 0; a < 2; ++a)
#pragma unroll
            for (int b = 0; b < 2; ++b)
#pragma unroll
                for (int m = 0; m < 4; ++m)
#pragma unroll
                    for (int n = 0; n < 2; ++n) acc[a][b][m][n] = (f32x4){0.f, 0.f, 0.f, 0.f};
        cur = nxt; cA = nA; cB = nB; ++ui;
        if constexpr (ALIGN_EPI) { if (wr == 1) PG8_BAR; }
    }
    PG8_WAIT_V(0);
    if constexpr (!ALIGN_EPI) { if (wr == 0) PG8_BAR; }
    PG8_BAR;
    if constexpr (Epi::AFTER_DRAIN) { E.fused(acc, cur, wr, wc, fr, fq, lds, wid, lane); S.done(cur); }
#undef PG8_SA
#undef PG8_SB
#undef PG8_STAGE
#undef PG8_LDA
#undef PG8_LDB
#undef PG8_MMA
#undef PG8_WAIT_V
#undef PG8_WAIT_L
#undef PG8_BAR
#undef PG8_SCHED
}
}
#define MK_ONE_LAUNCH 1

constexpr int NB = 4, SEQ = 8192, T = NB * SEQ, D = 1024;
constexpr int NIN = 3584, DH = 512, HD = 128, NHH = 4, CHK = 64;
constexpr int NSEG = 16, SEGC = 8;
constexpr int CW = 31, CPAD = 15, DC = 512;
constexpr int PHEADS = 8, NQK = 2048, NSEL = 128;
constexpr float EPS = 1e-6f;
constexpr int NWAVES = 8, NTHR = 512;

constexpr size_t MiB = 1u << 20;
constexpr size_t WS_CTL = 0, CTL_ZERO_BYTES = 65536;
constexpr size_t WS_MOD = 1 * MiB, WS_FMOD = WS_MOD + 131072, WS_LB = WS_MOD + 196608, WS_BIASQ = WS_MOD + 262144;
constexpr size_t WS_WIN = 2 * MiB, WS_WOUT = 10 * MiB, WS_WQK = 12 * MiB;
constexpr size_t WS_UT = 16 * MiB, WS_WQKB = 24 * MiB, WS_VT = 48 * MiB;
constexpr size_t WS_BUFA = 80 * MiB;
constexpr size_t WS_BUFB = 144 * MiB;
constexpr size_t WS_SEG = 208 * MiB;
constexpr size_t WS_E = 208 * MiB, WS_W = 224 * MiB;
constexpr size_t WS_BIG = 240 * MiB;
constexpr size_t WS_SSQ = 496 * MiB;
constexpr size_t WS_SEGA = 498 * MiB;
constexpr size_t WS_RSTD = 499 * MiB;
constexpr size_t WS_END = 500 * MiB;
constexpr size_t WS_PACT = 240 * MiB;
constexpr size_t WS_Y = 368 * MiB;
constexpr int NSL = 8, CSL = 128;
constexpr float VSCALE = 16.0f;
constexpr float UQSCALE = 95.5f;
constexpr int NSLU = 4, CSLU = 256;
constexpr int CW_QU = 8192, CW_QV = 8192 + 64 * 16;
constexpr int CW_GV = 6400;
constexpr int CW_H1 = 6144;
constexpr int CW_BAR = 1024;

#ifndef LDSFILL
#define LDSFILL 0u
#endif
constexpr int LDS_BYTES = 155648;
constexpr int MISC_OFF = LDS_BYTES - 256;

#define GAS __attribute__((address_space(1)))
#define LAS __attribute__((address_space(3)))
typedef unsigned short bf16;
typedef unsigned v4u __attribute__((ext_vector_type(4)));
typedef unsigned v2u __attribute__((ext_vector_type(2)));
typedef float f32x4 __attribute__((ext_vector_type(4)));
typedef float f32x16 __attribute__((ext_vector_type(16)));
typedef short bf16x8 __attribute__((ext_vector_type(8)));
typedef float f32x2_ __attribute__((ext_vector_type(2)));

__device__ __forceinline__ float bf2f(unsigned h) { return __builtin_bit_cast(float, h << 16); }
__device__ __forceinline__ float bflo(unsigned u) { return __builtin_bit_cast(float, u << 16); }
__device__ __forceinline__ float bfhi(unsigned u) { return __builtin_bit_cast(float, u & 0xffff0000u); }
__device__ __forceinline__ unsigned f2bf(float f) { unsigned u = __builtin_bit_cast(unsigned, f); return (u + 0x7fffu + ((u >> 16) & 1u)) >> 16; }
__device__ __forceinline__ unsigned pk2(float lo, float hi) { return f2bf(lo) | (f2bf(hi) << 16); }
__device__ __forceinline__ unsigned cvtpk(float lo, float hi) { unsigned r; asm("v_cvt_pk_bf16_f32 %0, %1, %2" : "=v"(r) : "v"(lo), "v"(hi)); return r; }
__device__ __forceinline__ float sigmoidf_(float x) { return __builtin_amdgcn_rcpf(1.0f + __expf(-x)); }
#define DPP_ADD(s, ctrl) ((s) + __builtin_bit_cast(float, __builtin_amdgcn_update_dpp(0, __builtin_bit_cast(int, (s)), (ctrl), 0xF, 0xF, false)))
__device__ __forceinline__ float wave_sum(float v) {
    v = DPP_ADD(v, 0x128); v = DPP_ADD(v, 0x124); v = DPP_ADD(v, 0x122); v = DPP_ADD(v, 0x121);
    v += __builtin_bit_cast(float, __builtin_amdgcn_update_dpp(0, __builtin_bit_cast(int, v), 0x142, 0xA, 0xF, false));
    v += __builtin_bit_cast(float, __builtin_amdgcn_update_dpp(0, __builtin_bit_cast(int, v), 0x143, 0xC, 0xF, false));
    return __builtin_bit_cast(float, __builtin_amdgcn_readlane(__builtin_bit_cast(int, v), 63));
}

#define XB_TMO      128
#define XB_XCNT(j)  (256  + 64 * (j))
#define XB_XSUB(j)  (1280 + 64 * (j))
#define XB_XGEN(j)  (2304 + 64 * (j))
#define XB_TOP      3328
#define XB_TOPGEN   3392
#define XCD_BAR_WORDS 3456
#define XB_SPIN_CAP (1u << 18)
__device__ __forceinline__ unsigned xb_ld(unsigned* p)              { return __hip_atomic_load(p, __ATOMIC_RELAXED, __HIP_MEMORY_SCOPE_AGENT); }
__device__ __forceinline__ unsigned xb_add(unsigned* p, unsigned v) { return __hip_atomic_fetch_add(p, v, __ATOMIC_RELAXED, __HIP_MEMORY_SCOPE_AGENT); }
__device__ __forceinline__ unsigned xb_xcc_id() { return (unsigned)__builtin_amdgcn_s_getreg((3 << 11) | 20) & 0xFu; }
#define XB_SPIN(cond, bar) do { unsigned _sp = 0; while (cond) { __builtin_amdgcn_s_sleep(1); \
    if ((++_sp & 255u) == 0u) { if (xb_ld(&(bar)[XB_TMO])) break; if (_sp > XB_SPIN_CAP) { atomicAdd(&(bar)[XB_TMO], 1u); break; } } } } while (0)
struct XcdBarrier { unsigned* bar; unsigned x; volatile LAS unsigned* st; };
__device__ __forceinline__ XcdBarrier xcd_barrier_post(unsigned* bar, volatile LAS unsigned* st) {
    XcdBarrier b; b.bar = bar; b.x = xb_xcc_id(); b.st = st;
    if (threadIdx.x == 0) (void)xb_add(&bar[XB_XCNT(b.x)], 1u);
    return b;
}
__device__ __forceinline__ void xcd_barrier_complete(unsigned* bar, unsigned x, unsigned& nloc, unsigned& nx) {
    const unsigned G = gridDim.x * gridDim.y * gridDim.z;
    unsigned sum, cnt, mine, sp = 0u;
    for (;;) {
        sum = 0u; cnt = 0u; mine = 0u;
#pragma unroll
        for (unsigned j = 0; j < 16; ++j) { const unsigned c = xb_ld(&bar[XB_XCNT(j)]); sum += c; cnt += (c > 0u) ? 1u : 0u; mine = (j == x) ? c : mine; }
        if (sum == G) break;
        __builtin_amdgcn_s_sleep(1);
        if ((++sp & 255u) == 0u) { if (xb_ld(&bar[XB_TMO])) break; if (sp > XB_SPIN_CAP) { atomicAdd(&bar[XB_TMO], 1u); break; } }
    }
    nloc = mine > 0u ? mine : 1u; nx = cnt > 0u ? cnt : 1u;
}
__device__ __forceinline__ void xcd_barrier(const XcdBarrier& b) {
    asm volatile("s_waitcnt vmcnt(0)" ::: "memory");
    __syncthreads();
    if (threadIdx.x == 0) {
        unsigned* bar = b.bar;
        __builtin_amdgcn_s_waitcnt(0);
        unsigned nloc = b.st[0], nx = b.st[1];
        if (nloc == 0u) { xcd_barrier_complete(bar, b.x, nloc, nx); b.st[0] = nloc; b.st[1] = nx; }
        const unsigned old = xb_add(&bar[XB_XSUB(b.x)], 1u);
        const unsigned gen = old / nloc;
        if (old + 1u == (gen + 1u) * nloc) {
            __builtin_amdgcn_fence(__ATOMIC_RELEASE, "agent");
            asm volatile("s_waitcnt vmcnt(0)" ::: "memory");
            const unsigned og = xb_add(&bar[XB_TOP], 1u);
            const unsigned tg = og / nx;
            if (og + 1u == (tg + 1u) * nx) xb_add(&bar[XB_TOPGEN], 1u);
            else XB_SPIN(xb_ld(&bar[XB_TOPGEN]) == tg, bar);
            __builtin_amdgcn_fence(__ATOMIC_ACQUIRE, "agent");
            xb_add(&bar[XB_XGEN(b.x)], 1u);
            asm volatile("s_waitcnt vmcnt(0)" ::: "memory");
        } else {
            XB_SPIN(xb_ld(&bar[XB_XGEN(b.x)]) == gen, bar);
            __builtin_amdgcn_fence(__ATOMIC_ACQUIRE, "agent");
            asm volatile("s_waitcnt vmcnt(0)" ::: "memory");
        }
    }
    __syncthreads();
}

struct Args { const float* in[23]; float* out; unsigned char* ws; int ph_lo, ph_hi; };
struct Frame {
    LAS unsigned char* lds;
    int tid, lane, wave, G, bid;
    const Args* a;
    __device__ __forceinline__ const float* x() const { return a->in[0]; }
    __device__ __forceinline__ const float* c() const { return a->in[1]; }
    __device__ __forceinline__ const float* ada_w() const { return a->in[2]; }
    __device__ __forceinline__ const float* ada_b() const { return a->in[3]; }
    __device__ __forceinline__ const float* g_mix() const { return a->in[4]; }
    __device__ __forceinline__ const float* w_in() const { return a->in[5]; }
    __device__ __forceinline__ const float* lbg_f() const { return a->in[6]; }
    __device__ __forceinline__ const float* lbg_b() const { return a->in[7]; }
    __device__ __forceinline__ const float* hnorm_g() const { return a->in[8]; }
    __device__ __forceinline__ const float* conv_w() const { return a->in[9]; }
    __device__ __forceinline__ const float* conv_b() const { return a->in[10]; }
    __device__ __forceinline__ const float* cln_g() const { return a->in[11]; }
    __device__ __forceinline__ const float* cln_b() const { return a->in[12]; }
    __device__ __forceinline__ const float* w_out() const { return a->in[13]; }
    __device__ __forceinline__ const float* g_ffn() const { return a->in[14]; }
    __device__ __forceinline__ const float* wq() const { return a->in[15]; }
    __device__ __forceinline__ const float* keys1() const { return a->in[16]; }
    __device__ __forceinline__ const float* keys2() const { return a->in[17]; }
    __device__ __forceinline__ const float* utab() const { return a->in[18]; }
    __device__ __forceinline__ const float* vtab() const { return a->in[19]; }
    __device__ __forceinline__ const float* fada_w() const { return a->in[20]; }
    __device__ __forceinline__ const float* fada_b() const { return a->in[21]; }
    __device__ __forceinline__ const float* fnorm_g() const { return a->in[22]; }
    __device__ __forceinline__ float* out() const { return a->out; }
    __device__ __forceinline__ float* mod() const { return (float*)(a->ws + WS_MOD); }
    __device__ __forceinline__ float* fmod() const { return (float*)(a->ws + WS_FMOD); }
    __device__ __forceinline__ float* lb() const { return (float*)(a->ws + WS_LB); }
    __device__ __forceinline__ float* biasq() const { return (float*)(a->ws + WS_BIASQ); }
    __device__ __forceinline__ float* ssqp() const { return (float*)(a->ws + WS_SSQ); }
    __device__ __forceinline__ float* sega() const { return (float*)(a->ws + WS_SEGA); }
    __device__ __forceinline__ float* segu() const { return (float*)(a->ws + WS_SEG); }
    __device__ __forceinline__ float* of() const { return (float*)(a->ws + WS_BUFB); }
    __device__ __forceinline__ float* scores() const { return (float*)(a->ws + WS_BIG); }
    __device__ __forceinline__ float* wsel() const { return (float*)(a->ws + WS_W); }
    __device__ __forceinline__ int* esel() const { return (int*)(a->ws + WS_E); }
    __device__ __forceinline__ bf16* Win_t() const { return (bf16*)(a->ws + WS_WIN); }
    __device__ __forceinline__ bf16* Wout_t() const { return (bf16*)(a->ws + WS_WOUT); }
    __device__ __forceinline__ bf16* Wqk_t() const { return (bf16*)(a->ws + WS_WQK); }
    __device__ __forceinline__ bf16* Wqk_b() const { return (bf16*)(a->ws + WS_WQKB); }
    __device__ __forceinline__ bf16* Ub() const { return (bf16*)(a->ws + WS_UT); }
    __device__ __forceinline__ bf16* Vb() const { return (bf16*)(a->ws + WS_VT); }
    __device__ __forceinline__ bf16* bufA() const { return (bf16*)(a->ws + WS_BUFA); }
    __device__ __forceinline__ bf16* hg() const { return (bf16*)(a->ws + WS_BUFB); }
    __device__ __forceinline__ bf16* proj() const { return (bf16*)(a->ws + WS_BIG); }
    __device__ __forceinline__ float* coef() const { return (float*)(a->ws + WS_BUFA); }
    __device__ __forceinline__ float* rstd() const { return (float*)(a->ws + WS_RSTD); }
    __device__ __forceinline__ bf16* pact() const { return (bf16*)(a->ws + WS_PACT); }
    __device__ __forceinline__ bf16* ybuf() const { return (bf16*)(a->ws + WS_Y); }
    __device__ __forceinline__ unsigned char* U8() const { return (unsigned char*)(a->ws + WS_UT); }
    __device__ __forceinline__ unsigned char* V8() const { return (unsigned char*)(a->ws + WS_VT); }
    __device__ __forceinline__ unsigned* ctl() const { return (unsigned*)(a->ws + WS_CTL); }
};

__device__ __forceinline__ void p0_gemv(Frame& F) {
    LAS float* cact = (LAS float*)(F.lds);
    LAS float* red = (LAS float*)(F.lds + 16384);
    for (int i = F.tid; i < 4096; i += NTHR) { const float c = F.c()[i]; cact[i] = c * sigmoidf_(c); }
    __syncthreads();
    for (int item = F.bid; item < 128; item += F.G) {
        const int col0 = item * 64; const float* W; int N, cc;
        if (col0 < 6144) { W = F.ada_w(); N = 6144; cc = col0; } else { W = F.fada_w(); N = 2048; cc = col0 - 6144; }
        const float* wp = W + (size_t)(F.wave * 128) * N + cc + F.lane;
        float a0 = 0.f, a1 = 0.f, a2 = 0.f, a3 = 0.f;
#pragma unroll 32
        for (int k = 0; k < 128; ++k) { const float w = wp[(size_t)k * N]; const int kk = F.wave * 128 + k;
            a0 += cact[kk] * w; a1 += cact[1024 + kk] * w; a2 += cact[2048 + kk] * w; a3 += cact[3072 + kk] * w; }
        red[(F.wave * 4 + 0) * 64 + F.lane] = a0; red[(F.wave * 4 + 1) * 64 + F.lane] = a1; red[(F.wave * 4 + 2) * 64 + F.lane] = a2; red[(F.wave * 4 + 3) * 64 + F.lane] = a3;
        __syncthreads();
        if (F.tid < 256) { const int b = F.tid >> 6, l = F.tid & 63; float s = 0.f;
#pragma unroll
            for (int w = 0; w < 8; ++w) s += red[(w * 4 + b) * 64 + l];
            if (col0 < 6144) F.mod()[b * 6144 + cc + l] = s + F.ada_b()[cc + l]; else F.fmod()[b * 2048 + cc + l] = s + F.fada_b()[cc + l]; }
        __syncthreads();
    }
}
__device__ __forceinline__ void p0_transpose_item(const float* W, int K, int N, bf16* WT, LAS float* scr, int item, int lane) {
    const int nblk = N / 32, kb = item / nblk, nb = item % nblk, k0 = 64 * kb, n0 = 32 * nb;
#pragma unroll
    for (int i = 0; i < 32; ++i) { const int kk = 2 * i + (lane >> 5); scr[kk * 33 + (lane & 31)] = W[(size_t)(k0 + kk) * N + n0 + (lane & 31)]; }
    asm volatile("s_waitcnt lgkmcnt(0)" ::: "memory");
    const int c = lane & 7;
#pragma unroll
    for (int j = 0; j < 4; ++j) { const int n = (lane >> 3) + 8 * j; const LAS float* s = scr + (8 * c) * 33 + n;
        v4u o; o.x = pk2(s[0 * 33], s[1 * 33]); o.y = pk2(s[2 * 33], s[3 * 33]); o.z = pk2(s[4 * 33], s[5 * 33]); o.w = pk2(s[6 * 33], s[7 * 33]);
        *(v4u*)(WT + (size_t)(n0 + n) * K + k0 + 8 * c) = o; }
    asm volatile("s_waitcnt lgkmcnt(0)" ::: "memory");
}
__device__ __forceinline__ void p0_wqk_item(Frame& F, int item, LAS float* scr) {
    const int jq = item & 7, kb = (item >> 3) & 15, hh = item >> 7, h = hh >> 1, half = hh & 1;
    const float* keys = (half ? F.keys2() : F.keys1()) + (size_t)(jq * 16) * 128;
    const float* wtile = F.wq() + (size_t)(kb * 64) * 2048 + h * 256 + half * 128;
    LAS float* kL = scr + 1280;
    { f32x4 k4[8];
#pragma unroll
      for (int i = 0; i < 8; ++i) k4[i] = *(const f32x4*)(keys + (i * 64 + F.lane) * 4);
#pragma unroll
      for (int i = 0; i < 8; ++i) *(LAS f32x4*)(kL + (i * 64 + F.lane) * 4) = k4[i]; }
    float acc[16];
#pragma unroll
    for (int j = 0; j < 16; ++j) acc[j] = 0.f;
    f32x4 t4[4], n4[4];
#pragma unroll
    for (int i = 0; i < 4; ++i) t4[i] = *(const f32x4*)(wtile + (size_t)(16 * i + (F.lane >> 2)) * 2048 + 4 * (F.lane & 3));
    for (int d0 = 0; d0 < 128; d0 += 16) {
        if (d0 + 16 < 128) {
#pragma unroll
            for (int i = 0; i < 4; ++i) n4[i] = *(const f32x4*)(wtile + (size_t)(16 * i + (F.lane >> 2)) * 2048 + d0 + 16 + 4 * (F.lane & 3)); }
#pragma unroll
        for (int i = 0; i < 4; ++i) *(LAS f32x4*)(scr + (16 * i + (F.lane >> 2)) * 20 + 4 * (F.lane & 3)) = t4[i];
        asm volatile("s_waitcnt lgkmcnt(0)" ::: "memory");
#pragma unroll
        for (int dd = 0; dd < 16; dd += 4) { const f32x4 a = *(LAS const f32x4*)(scr + F.lane * 20 + dd);
#pragma unroll
            for (int j = 0; j < 16; ++j) { const f32x4 kp = *(LAS const f32x4*)(kL + j * 128 + d0 + dd); acc[j] += a[0] * kp[0] + a[1] * kp[1] + a[2] * kp[2] + a[3] * kp[3]; } }
        asm volatile("s_waitcnt lgkmcnt(0)" ::: "memory");
#pragma unroll
        for (int i = 0; i < 4; ++i) t4[i] = n4[i];
    }
    bf16* o = F.Wqk_t() + (size_t)(h * 256 + half * 128 + jq * 16) * 1024 + kb * 64 + F.lane;
#pragma unroll
    for (int j = 0; j < 16; ++j) o[(size_t)j * 1024] = (bf16)f2bf(acc[j]);
}
__device__ __forceinline__ void p0_prologue(Frame& F) {
    if (F.bid < 128) p0_gemv(F);
    asm volatile("s_waitcnt vmcnt(0)" ::: "memory");
    __syncthreads();
    if (F.tid == 0) { __builtin_amdgcn_fence(__ATOMIC_RELEASE, "agent"); asm volatile("s_waitcnt vmcnt(0)" ::: "memory"); (void)xb_add(F.ctl() + CW_GV, 1u); }
    if (F.bid == 128 % F.G) { const int i = F.tid;
        F.lb()[i] = __builtin_amdgcn_rcpf(1.0f + __expf(F.lbg_f()[512 + i] - F.lbg_f()[i]));
        F.lb()[512 + i] = __builtin_amdgcn_rcpf(1.0f + __expf(F.lbg_b()[512 + i] - F.lbg_b()[i])); }
    LAS float* scr = (LAS float*)(F.lds + 32768 + F.wave * 14336);
    const int gw = F.wave * F.G + F.bid, NGW = F.G * NWAVES;
    constexpr int I_QK = 2048, I_IN = (D / 64) * (NIN / 32), I_OUT = (D / 64) * (D / 32), I_TAB = 2 * 16384 / 4;
    constexpr int NITEMS = I_QK + I_IN + I_OUT + I_TAB;
    for (int it = gw; it < NITEMS; it += NGW) {
        int r = it;
        if (r < I_QK) { p0_wqk_item(F, r, scr); continue; } r -= I_QK;
        if (r < I_IN) { p0_transpose_item(F.w_in(), D, NIN, F.Win_t(), scr, r, F.lane); continue; } r -= I_IN;
        if (r < I_OUT) { p0_transpose_item(F.w_out(), D, D, F.Wout_t(), scr, r, F.lane); continue; } r -= I_OUT;
        { const int tab = r >= 4096, rr = (tab ? r - 4096 : r) * 4; const float* src = (tab ? F.vtab() : F.utab()) + (size_t)rr * 1024; unsigned char* dst = tab ? F.V8() : F.U8();
          const float sc = tab ? VSCALE : UQSCALE;
#pragma unroll
          for (int q = 0; q < 16; ++q) { const int row = rr + (q >> 2), qq = q & 3; const f32x4 v = *(const f32x4*)(src + (q >> 2) * 1024 + qq * 256 + 4 * F.lane) * sc;
              int pk;
              if (tab) { pk = __builtin_amdgcn_cvt_pk_fp8_f32(v[0], v[1], 0, false); pk = __builtin_amdgcn_cvt_pk_fp8_f32(v[2], v[3], pk, true); }
              else { int q0 = (int)__builtin_rintf(v[0]), q1 = (int)__builtin_rintf(v[1]), q2 = (int)__builtin_rintf(v[2]), q3 = (int)__builtin_rintf(v[3]);
                  q0 = q0 < -7 ? -7 : (q0 > 7 ? 7 : q0); q1 = q1 < -7 ? -7 : (q1 > 7 ? 7 : q1); q2 = q2 < -7 ? -7 : (q2 > 7 ? 7 : q2); q3 = q3 < -7 ? -7 : (q3 > 7 ? 7 : q3);
                  *(unsigned short*)(dst + ((size_t)qq * 16384 + row) * 128 + 2 * F.lane) = (unsigned short)((q0 & 0xf) | ((q1 & 0xf) << 4) | ((q2 & 0xf) << 8) | ((q3 & 0xf) << 12)); continue; }
              const int sl = 2 * qq + (F.lane >> 5);
              *(int*)(dst + ((size_t)sl * 16384 + row) * CSL + 4 * (F.lane & 31)) = pk; } }
    }
}

__device__ __forceinline__ void p1_norm(Frame& F) {
    const int gwc = F.bid * NWAVES + F.wave, NGW = F.G * NWAVES;
    for (int row0 = gwc * 16; row0 < T; row0 += NGW * 16) {
        const int b = row0 >> 13; const float* mb = F.mod() + b * 6144;
        f32x4 ca[4], cb[4];
#pragma unroll
        for (int j = 0; j < 4; ++j) { const int k = 256 * j + 4 * F.lane; const f32x4 g = *(const f32x4*)(F.g_mix() + k), s = *(const f32x4*)(mb + 1024 + k); ca[j] = g * (s + 1.0f); cb[j] = *(const f32x4*)(mb + k); }
#pragma unroll 4
        for (int r = 0; r < 16; ++r) { const float* xr = F.x() + (size_t)(row0 + r) * D;
            f32x4 v[4]; float ss = 0.f;
#pragma unroll
            for (int j = 0; j < 4; ++j) { v[j] = *(const f32x4*)(xr + 256 * j + 4 * F.lane); ss += v[j][0] * v[j][0] + v[j][1] * v[j][1] + v[j][2] * v[j][2] + v[j][3] * v[j][3]; }
            const float rstd = __builtin_amdgcn_rsqf(wave_sum(ss) * (1.0f / D) + EPS);
            bf16* o = F.bufA() + (size_t)(row0 + r) * D;
#pragma unroll
            for (int j = 0; j < 4; ++j) { const f32x4 y = v[j] * rstd * ca[j] + cb[j]; v2u w; w.x = pk2(y[0], y[1]); w.y = pk2(y[2], y[3]); *(v2u*)(o + 256 * j + 4 * F.lane) = w; } }
    }
}
__device__ __forceinline__ void p3_pre(Frame& F) {
    const int NGW = F.G * NWAVES;
    for (int i = F.bid * NTHR + F.tid; i < NQK * (D / 8); i += F.G * NTHR) { const int n = i >> 7, k0 = (i & 127) * 8;
        const v4u w = *(const v4u*)(F.Wqk_t() + (size_t)n * D + k0);
        const f32x4 g0 = *(const f32x4*)(F.g_ffn() + k0), g1 = *(const f32x4*)(F.g_ffn() + k0 + 4);
        f32x4 wa, wb; wa[0] = bflo(w[0]) * g0[0]; wa[1] = bfhi(w[0]) * g0[1]; wa[2] = bflo(w[1]) * g0[2]; wa[3] = bfhi(w[1]) * g0[3]; wb[0] = bflo(w[2]) * g1[0]; wb[1] = bfhi(w[2]) * g1[1]; wb[2] = bflo(w[3]) * g1[2]; wb[3] = bfhi(w[3]) * g1[3];
#pragma unroll
        for (int b = 0; b < NB; ++b) { const float* sc = F.mod() + b * 6144 + 4096 + k0; const f32x4 s0 = *(const f32x4*)sc + 1.0f, s1 = *(const f32x4*)(sc + 4) + 1.0f;
            const f32x4 pa = wa * s0, pb = wb * s1;
            v4u o; o.x = cvtpk(pa[0], pa[1]); o.y = cvtpk(pa[2], pa[3]); o.z = cvtpk(pb[0], pb[1]); o.w = cvtpk(pb[2], pb[3]);
            *(v4u*)(F.Wqk_b() + ((size_t)b * NQK + n) * D + k0) = o; } }
    const int gw = F.wave * F.G + F.bid;
    for (int n0 = gw * 32; n0 < NQK; n0 += NGW * 32) {
        float sv[4][16];
#pragma unroll
        for (int b = 0; b < 4; ++b) { const float* sh2 = F.mod() + b * 6144 + 3072;
#pragma unroll
            for (int i = 0; i < 8; ++i) { sv[b][i] = sh2[8 * F.lane + i]; sv[b][8 + i] = sh2[512 + 8 * F.lane + i]; } }
        float res[4] = {0.f, 0.f, 0.f, 0.f};
        for (int q = 0; q < 32; ++q) { const int n = n0 + q;
            const v4u w0 = *(const v4u*)(F.Wqk_t() + (size_t)n * 1024 + 8 * F.lane), w1 = *(const v4u*)(F.Wqk_t() + (size_t)n * 1024 + 512 + 8 * F.lane);
            float wv[16];
#pragma unroll
            for (int i = 0; i < 4; ++i) { wv[2 * i] = bflo(w0[i]); wv[2 * i + 1] = bfhi(w0[i]); wv[8 + 2 * i] = bflo(w1[i]); wv[8 + 2 * i + 1] = bfhi(w1[i]); }
#pragma unroll
            for (int b = 0; b < 4; ++b) { float sm = 0.f;
#pragma unroll
                for (int i = 0; i < 16; ++i) sm += wv[i] * sv[b][i];
                sm = wave_sum(sm); if (F.lane == q) res[b] = sm; } }
        if (F.lane < 32) {
#pragma unroll
            for (int b = 0; b < 4; ++b) F.biasq()[b * 2048 + n0 + F.lane] = res[b]; }
    }
}

__device__ __forceinline__ void conv_item(Frame& F, int item, const float (&cw)[CW], float cbias) {
    LAS bf16* hbuf = (LAS bf16*)(F.lds);
    LAS float* ybuf = (LAS float*)(F.lds + 65536);
    const int tok0 = item * 32, b = tok0 >> 13, t0 = tok0 & (SEQ - 1), c = F.tid;
#pragma unroll
    for (int k = 0; k < 8; ++k) { const int pi = F.tid + NTHR * k; if (pi < 62 * 64) { const int r = pi >> 6, ch = pi & 63, t = t0 - CPAD + r; v4u o = {0u, 0u, 0u, 0u};
            if (t >= 0 && t < SEQ) { const bf16* pr = F.proj() + (size_t)(b * SEQ + t) * NIN + 8 * ch; const v4u a = *(const v4u*)(pr + 2560), g = *(const v4u*)(pr + 3072);
#pragma unroll
                for (int i = 0; i < 4; ++i) o[i] = cvtpk(bflo(a[i]) * bflo(g[i]), bfhi(a[i]) * bfhi(g[i])); }
            *(LAS v4u*)(hbuf + r * 512 + 8 * ch) = o; } }
    __syncthreads();
    f32x2_ hp[31];
#pragma unroll
    for (int m = 0; m < 31; ++m) hp[m] = (f32x2_){bf2f(hbuf[(2 * m) * 512 + c]), bf2f(hbuf[(2 * m + 1) * 512 + c])};
    f32x2_ ce[15], co[15];
#pragma unroll
    for (int m = 0; m < 15; ++m) { ce[m] = (f32x2_){cw[2 * m], cw[2 * m + 1]}; co[m] = (f32x2_){cw[2 * m + 1], cw[2 * m + 2]}; }
#pragma unroll
    for (int e = 0; e < 16; ++e) {
        { f32x2_ a = {cbias, 0.f};
#pragma unroll
          for (int m = 0; m < 15; ++m) a += ce[m] * hp[e + m];
          ybuf[(2 * e) * 512 + c] = (a[0] + a[1]) + cw[30] * hp[e + 15][0]; }
        { f32x2_ a = {cbias, 0.f};
#pragma unroll
          for (int m = 0; m < 15; ++m) a += co[m] * hp[e + m + 1];
          ybuf[(2 * e + 1) * 512 + c] = (a[0] + a[1]) + cw[0] * hp[e][1]; } }
    __syncthreads();
#pragma unroll
    for (int q = 0; q < 4; ++q) { const int tt = F.wave * 4 + q;
        const f32x4 y0 = *(LAS const f32x4*)(ybuf + tt * 512 + 8 * F.lane), y1 = *(LAS const f32x4*)(ybuf + tt * 512 + 8 * F.lane + 4);
        const float mean = wave_sum((y0[0] + y0[1] + y0[2] + y0[3]) + (y1[0] + y1[1] + y1[2] + y1[3])) * (1.0f / DC);
        const f32x4 d0 = y0 - mean, d1 = y1 - mean;
        const float var = wave_sum((d0[0] * d0[0] + d0[1] * d0[1] + d0[2] * d0[2] + d0[3] * d0[3]) + (d1[0] * d1[0] + d1[1] * d1[1] + d1[2] * d1[2] + d1[3] * d1[3])) * (1.0f / DC);
        const float rstd = __builtin_amdgcn_rsqf(var + EPS);
        const f32x4 g0 = *(const f32x4*)(F.cln_g() + 8 * F.lane), g1 = *(const f32x4*)(F.cln_g() + 8 * F.lane + 4), b0 = *(const f32x4*)(F.cln_b() + 8 * F.lane), b1 = *(const f32x4*)(F.cln_b() + 8 * F.lane + 4);
        f32x4 z0 = d0 * rstd * g0 + b0, z1 = d1 * rstd * g1 + b1;
#pragma unroll
        for (int i = 0; i < 4; ++i) { z0[i] = z0[i] * sigmoidf_(z0[i]); z1[i] = z1[i] * sigmoidf_(z1[i]); }
        v4u w; w.x = cvtpk(z0[0], z0[1]); w.y = cvtpk(z0[2], z0[3]); w.z = cvtpk(z1[0], z1[1]); w.w = cvtpk(z1[2], z1[3]);
        *(v4u*)(F.bufA() + (size_t)(tok0 + tt) * D + 512 + 8 * F.lane) = w; }
    __syncthreads();
}

constexpr int PQ = 272, PT = 144;
constexpr int HL_QR = 0, HL_KR = 17408, HL_QE = 34816, HL_KET = 52224, HL_VT = 70656, HL_SCM = 89088, HL_ST = 98304, HL_PBLK = 133120  , HL_AV = 137216, HL_RS = 137728;
static_assert(HL_PBLK + 8 * 128 * 4 <= HL_AV && HL_AV + 512 <= HL_RS && HL_RS + 1024 <= 155648 - 256, "HGRN LDS map");
__device__ __forceinline__ bf16x8 ldf(LAS const unsigned char* base, int row, int pitch, int kbyte) { return *(LAS const bf16x8*)(base + row * pitch + kbyte); }
#define MFMA32(a, b, c) __builtin_amdgcn_mfma_f32_32x32x16_bf16((a), (b), (c), 0, 0, 0)

template <bool FULL>
__device__ __forceinline__ void hgrn_load(Frame& F, int b, int h, int dir, int chunk, unsigned (&rz)[8], unsigned (&rv)[8], unsigned (&rq)[8]) {
    const size_t tokbase = (size_t)b * SEQ + (size_t)chunk * CHK; const int zoff = dir ? 1024 : 512, c0 = 2 * F.lane;
#pragma unroll
    for (int i = 0; i < 8; ++i) { const int p = 8 * F.wave + i, tr = dir ? (63 - p) : p; const bf16* q = F.proj() + (tokbase + tr) * NIN + h * HD;
        rz[i] = *(const unsigned*)(q + zoff + c0); rv[i] = *(const unsigned*)(q + 1536 + c0); if (FULL) rq[i] = *(const unsigned*)(q + c0); }
}
template <bool FULL, int MODE>
__device__ __forceinline__ void hgrn_chunk(Frame& F, int b, int h, int dir, int chunk, int nchunk, f32x16 (&accS)[2], float lb0, float lb1, unsigned (&rz)[8], unsigned (&rv)[8], unsigned (&rq)[8]) {
    LAS unsigned char* lds = F.lds;
    int r = F.lane & 31, hh = F.lane >> 5, c0 = 2 * F.lane;
    asm volatile("" : "+v"(r), "+v"(hh), "+v"(c0));
    const int w = F.wave, rb = w;
    const size_t tokbase = (size_t)b * SEQ + (size_t)chunk * CHK;
    {
        const f32x2_ oml = {1.0f - lb0, 1.0f - lb1};
        f32x2_ f2[8], cf2[8], cr2[8];
        f32x2_ run = {1.f, 1.f};
#pragma unroll
        for (int i = 0; i < 8; ++i) { const f32x2_ kk = {bflo(rz[i]), bfhi(rz[i])}; f2[i] = 1.0f - oml * kk; run *= f2[i]; cf2[i] = run; }
        { f32x2_ q = {1.f, 1.f};
#pragma unroll
          for (int i = 7; i >= 0; --i) { cr2[i] = q; q *= f2[i]; } }
        LAS float* pblk = (LAS float*)(lds + HL_PBLK);
        *(LAS f32x2_*)(pblk + rb * 128 + c0) = run;
        __syncthreads();
        f32x2_ pre = {1.f, 1.f}, post = {1.f, 1.f}, mid = {1.f, 1.f};
        for (int q = 0; q < rb; ++q) pre *= *(LAS const f32x2_*)(pblk + q * 128 + c0);
        for (int q = rb + 1; q < 8; ++q) post *= *(LAS const f32x2_*)(pblk + q * 128 + c0);
        if (rb < 4) { for (int q = rb + 1; q < 4; ++q) mid *= *(LAS const f32x2_*)(pblk + q * 128 + c0); }
        else { for (int q = 4; q < rb; ++q) mid *= *(LAS const f32x2_*)(pblk + q * 128 + c0); }
        if (rb == 0) *(LAS f32x2_*)((LAS float*)(lds + HL_AV) + c0) = run * post;
        f32x2_ ke2[8];
#pragma unroll
        for (int i = 0; i < 8; ++i) ke2[i] = (1.0f - f2[i]) * cr2[i] * post;
        if (FULL) {
            if (rb < 4) {
#pragma unroll
                for (int i = 0; i < 8; ++i) { const int p = 8 * rb + i; const f32x2_ qs = {bflo(rq[i]), bfhi(rq[i])}, k2 = 1.0f - f2[i], G = cr2[i] * mid;
                    f32x2_ iG; iG[0] = __builtin_amdgcn_rcpf(G[0]); iG[1] = __builtin_amdgcn_rcpf(G[1]);
                    const f32x2_ qe = qs * pre * cf2[i], qr = qs * iG, kr = k2 * G;
                    *(LAS unsigned*)(lds + HL_QE + p * PQ + c0 * 2) = cvtpk(qe[0], qe[1]);
                    *(LAS unsigned*)(lds + HL_QR + p * PQ + c0 * 2) = cvtpk(qr[0], qr[1]);
                    *(LAS unsigned*)(lds + HL_KR + p * PQ + c0 * 2) = cvtpk(kr[0], kr[1]); }
            } else {
#pragma unroll
                for (int i = 0; i < 8; ++i) { const int p = 8 * rb + i; const f32x2_ qs = {bflo(rq[i]), bfhi(rq[i])}, k2 = 1.0f - f2[i], G = cf2[i] * mid;
                    f32x2_ iG; iG[0] = __builtin_amdgcn_rcpf(G[0]); iG[1] = __builtin_amdgcn_rcpf(G[1]);
                    const f32x2_ qe = qs * pre * cf2[i], qr = qs * G, kr = k2 * iG;
                    *(LAS unsigned*)(lds + HL_QE + p * PQ + c0 * 2) = cvtpk(qe[0], qe[1]);
                    *(LAS unsigned*)(lds + HL_QR + p * PQ + c0 * 2) = cvtpk(qr[0], qr[1]);
                    *(LAS unsigned*)(lds + HL_KR + p * PQ + c0 * 2) = cvtpk(kr[0], kr[1]); }
            }
        }
        v4u ka, kb, va, vb2;
        ka.x = cvtpk(ke2[0][0], ke2[1][0]); ka.y = cvtpk(ke2[2][0], ke2[3][0]); ka.z = cvtpk(ke2[4][0], ke2[5][0]); ka.w = cvtpk(ke2[6][0], ke2[7][0]);
        kb.x = cvtpk(ke2[0][1], ke2[1][1]); kb.y = cvtpk(ke2[2][1], ke2[3][1]); kb.z = cvtpk(ke2[4][1], ke2[5][1]); kb.w = cvtpk(ke2[6][1], ke2[7][1]);
        va.x = (rv[0] & 0xffffu) | (rv[1] << 16); va.y = (rv[2] & 0xffffu) | (rv[3] << 16); va.z = (rv[4] & 0xffffu) | (rv[5] << 16); va.w = (rv[6] & 0xffffu) | (rv[7] << 16);
        vb2.x = (rv[0] >> 16) | (rv[1] & 0xffff0000u); vb2.y = (rv[2] >> 16) | (rv[3] & 0xffff0000u); vb2.z = (rv[4] >> 16) | (rv[5] & 0xffff0000u); vb2.w = (rv[6] >> 16) | (rv[7] & 0xffff0000u);
        *(LAS v4u*)(lds + HL_KET + c0 * PT + 16 * rb) = ka; *(LAS v4u*)(lds + HL_KET + (c0 + 1) * PT + 16 * rb) = kb;
        *(LAS v4u*)(lds + HL_VT + c0 * PT + 16 * rb) = va; *(LAS v4u*)(lds + HL_VT + (c0 + 1) * PT + 16 * rb) = vb2;
    }
    if (nchunk >= 0) hgrn_load<FULL>(F, b, h, dir, nchunk, rz, rv, rq);
    __syncthreads();
    const int pbO = w & 1, vb = w >> 1;
    f32x16 accO, accU[2];
#pragma unroll
    for (int i = 0; i < 16; ++i) { accO[i] = 0.f; accU[0][i] = 0.f; accU[1][i] = 0.f; }
    if (FULL) {
        if (w < 3) { const int pbS = (w + 1) >> 1, sbS = (w == 2) ? 1 : 0; f32x16 sc;
#pragma unroll
            for (int i = 0; i < 16; ++i) sc[i] = 0.f;
#pragma unroll
            for (int s = 0; s < 8; ++s) sc = MFMA32(ldf(lds + HL_QR, pbS * 32 + r, PQ, 32 * s + 16 * hh), ldf(lds + HL_KR, sbS * 32 + r, PQ, 32 * s + 16 * hh), sc);
#pragma unroll
            for (int i = 0; i < 16; i += 2) { const int p = pbS * 32 + (i & 3) + 8 * (i >> 2) + 4 * hh, s = sbS * 32 + r;
                const unsigned pkd = cvtpk(s <= p ? sc[i] : 0.f, s <= p + 1 ? sc[i + 1] : 0.f);
                *(LAS bf16*)(lds + HL_SCM + p * PT + s * 2) = (bf16)pkd; *(LAS bf16*)(lds + HL_SCM + (p + 1) * PT + s * 2) = (bf16)(pkd >> 16); } }
        __builtin_amdgcn_sched_barrier(0);
#pragma unroll
        for (int s = 0; s < 8; ++s) accO = MFMA32(ldf(lds + HL_QE, pbO * 32 + r, PQ, 32 * s + 16 * hh), ldf(lds + HL_ST, vb * 32 + r, PQ, 32 * s + 16 * hh), accO);
        __builtin_amdgcn_sched_barrier(0);
    }
#pragma unroll
    for (int i = 0; i < 2; ++i) { const int db = 2 * (w & 1) + i;
#pragma unroll
        for (int s = 0; s < 4; ++s) accU[i] = MFMA32(ldf(lds + HL_VT, vb * 32 + r, PT, 32 * s + 16 * hh), ldf(lds + HL_KET, db * 32 + r, PT, 32 * s + 16 * hh), accU[i]); }
    __builtin_amdgcn_sched_barrier(0);
    if (FULL) __syncthreads();
    if (FULL) {
        const unsigned v = vb * 32 + r;
        const unsigned lrow = (MODE == 0 ? (unsigned)hh : (unsigned)(1 - hh)) * 4u;
        const size_t rbase = (MODE == 0) ? (tokbase + pbO * 32) : (tokbase + 63 - pbO * 32 - 4);
        const unsigned lo_of = lrow * DH + v, lo_pr = lrow * NIN + v, lo_a2 = lrow * D + v;
        float ofv[16]; unsigned gv[16];
        if (MODE == 1) {
#pragma unroll
            for (int i = 0; i < 16; ++i) { const int ci = (i & 3) + 8 * (i >> 2); ofv[i] = (F.of() + (rbase - ci) * DH + h * HD)[lo_of]; } }
        for (int sb = 0; sb <= pbO; ++sb)
#pragma unroll
            for (int s2 = 0; s2 < 2; ++s2) accO = MFMA32(ldf(lds + HL_SCM, pbO * 32 + r, PT, 64 * sb + 32 * s2 + 16 * hh), ldf(lds + HL_VT, vb * 32 + r, PT, 64 * sb + 32 * s2 + 16 * hh), accO);
        if (MODE == 0) {
#pragma unroll
            for (int i = 0; i < 16; ++i) { const int ci = (i & 3) + 8 * (i >> 2); (F.of() + (rbase + ci) * DH + h * HD)[lo_of] = accO[i]; }
        } else {
            LAS float* rs = (LAS float*)(lds + HL_RS);
#pragma unroll
            for (int i = 0; i < 16; ++i) { const int ci = (i & 3) + 8 * (i >> 2); gv[i] = (F.proj() + (rbase - ci) * NIN + 2048 + h * HD)[lo_pr]; }
            float ov[16];
            float ssr[16];
#pragma unroll
            for (int i = 0; i < 16; ++i) { ov[i] = accO[i] + ofv[i]; float ss = ov[i] * ov[i];
                ss = DPP_ADD(ss, 0x128); ss = DPP_ADD(ss, 0x124); ss = DPP_ADD(ss, 0x122); ss = DPP_ADD(ss, 0x121);
                ssr[i] = ss + __builtin_bit_cast(float, __builtin_amdgcn_update_dpp(0, __builtin_bit_cast(int, ss), 0x142, 0xA, 0xF, false)); }
            if (r == 16) {
#pragma unroll
                for (int i = 0; i < 16; ++i) { const int ci = (i & 3) + 8 * (i >> 2), p = pbO * 32 + ci + 4 * hh; rs[p * 4 + vb] = ssr[i]; } }
            __syncthreads();
            const float ng = F.hnorm_g()[h * HD + v];
#pragma unroll
            for (int i = 0; i < 16; ++i) { const int ci = (i & 3) + 8 * (i >> 2), p = pbO * 32 + ci + 4 * hh;
                const f32x4 q = *(LAS const f32x4*)(rs + p * 4);
                const float rstd = __builtin_amdgcn_rsqf((q[0] + q[1] + q[2] + q[3]) * (1.0f / HD) + EPS);
                const float g = bf2f(gv[i]);
                (F.bufA() + (rbase - ci) * D + h * HD)[lo_a2] = (bf16)cvtpk(ov[i] * rstd * ng * g, 0.f); }
        }
    }
    {
        const LAS float* av = (const LAS float*)(lds + HL_AV);
#pragma unroll
        for (int i = 0; i < 2; ++i) { const int db = 2 * (w & 1) + i; const float a = av[db * 32 + r];
#pragma unroll
            for (int j = 0; j < 16; j += 2) { const float s0 = accS[i][j] * a + accU[i][j], s1 = accS[i][j + 1] * a + accU[i][j + 1]; accS[i][j] = s0; accS[i][j + 1] = s1;
                if (FULL) { const int vv = vb * 32 + (j & 3) + 8 * (j >> 2) + 4 * hh; const unsigned pkd = cvtpk(s0, s1);
                    *(LAS bf16*)(lds + HL_ST + vv * PQ + (db * 32 + r) * 2) = (bf16)pkd; *(LAS bf16*)(lds + HL_ST + (vv + 1) * PQ + (db * 32 + r) * 2) = (bf16)(pkd >> 16); } } }
    }
    __syncthreads();
}
__device__ __forceinline__ void h1_item(Frame& F, int item) {
    const int seg = item & 15, dir = (item >> 4) & 1, h = (item >> 5) & 3, b = item >> 7;
    const float lb0 = F.lb()[dir * 512 + h * HD + 2 * F.lane], lb1 = F.lb()[dir * 512 + h * HD + 2 * F.lane + 1];
    f32x16 accS[2];
#pragma unroll
    for (int i = 0; i < 16; ++i) { accS[0][i] = 0.f; accS[1][i] = 0.f; }
    float atot = 1.f; const int col = F.tid & 127;
    unsigned rzA[8], rvA[8], rzB[8], rvB[8], rq[8];
#define H1CH(c) (seg * SEGC + (dir ? (SEGC - 1 - (c)) : (c)))
    hgrn_load<false>(F, b, h, dir, H1CH(0), rzA, rvA, rq); hgrn_load<false>(F, b, h, dir, H1CH(1), rzB, rvB, rq);
    for (int c = 0; c < SEGC; c += 2) {
        hgrn_chunk<false, 0>(F, b, h, dir, H1CH(c), (c + 2 < SEGC) ? H1CH(c + 2) : -1, accS, lb0, lb1, rzA, rvA, rq);
        atot *= ((const LAS float*)(F.lds + HL_AV))[col];
        hgrn_chunk<false, 0>(F, b, h, dir, H1CH(c + 1), (c + 3 < SEGC) ? H1CH(c + 3) : -1, accS, lb0, lb1, rzB, rvB, rq);
        atot *= ((const LAS float*)(F.lds + HL_AV))[col]; }
#undef H1CH
    if (F.tid < 128) F.sega()[(size_t)item * 128 + col] = atot;
    float* U = F.segu() + (size_t)item * 16384;
#pragma unroll
    for (int i = 0; i < 2; ++i)
#pragma unroll
        for (int j = 0; j < 16; j += 4) { f32x4 o; o[0] = accS[i][j]; o[1] = accS[i][j + 1]; o[2] = accS[i][j + 2]; o[3] = accS[i][j + 3]; ((f32x4*)(U + (i * 4 + (j >> 2)) * NTHR * 4))[F.tid] = o; }
}
__device__ __forceinline__ void h_scan(Frame& F) {
    for (int g = F.bid; g < NB * NHH * 2 * 8; g += F.G) {
        const int chain = g >> 3, k = g & 7, dir = chain & 1;
        const int aidx = (2 * (F.wave & 1) + (k >> 2)) * 32 + (F.lane & 31);
        float* U = F.segu() + (size_t)chain * NSEG * 16384 + (size_t)k * NTHR * 4 + F.tid * 4;
        const float* A = F.sega() + (size_t)chain * NSEG * 128 + aidx;
        f32x4 u[NSEG]; float av[NSEG];
#pragma unroll
        for (int q = 0; q < NSEG; ++q) { const int sg = dir ? (NSEG - 1 - q) : q; u[q] = *(const f32x4*)(U + (size_t)sg * 16384); av[q] = A[sg * 128]; }
        f32x4 S = {0.f, 0.f, 0.f, 0.f};
#pragma unroll
        for (int q = 0; q < NSEG; ++q) { const int sg = dir ? (NSEG - 1 - q) : q; *(f32x4*)(U + (size_t)sg * 16384) = S; S = S * av[q] + u[q]; }
    }
}
__device__ __forceinline__ void h2_init_state(Frame& F, int b, int h, int dir, int seg, f32x16 (&accS)[2]) {
    const int w = F.wave, r = F.lane & 31, hh = F.lane >> 5, vb = w >> 1;
    const float* U = F.segu() + (size_t)(((b * 4 + h) * 2 + dir) * NSEG + seg) * 16384;
#pragma unroll
    for (int k = 0; k < 8; ++k) { const f32x4 v = ((const f32x4*)(U + k * NTHR * 4))[F.tid]; const int i = k >> 2, j = (k & 3) * 4;
        accS[i][j] = v[0]; accS[i][j + 1] = v[1]; accS[i][j + 2] = v[2]; accS[i][j + 3] = v[3]; }
#pragma unroll
    for (int i = 0; i < 2; ++i) { const int db = 2 * (w & 1) + i;
#pragma unroll
        for (int j = 0; j < 16; ++j) { const int vv = vb * 32 + (j & 3) + 8 * (j >> 2) + 4 * hh; *(LAS bf16*)(F.lds + HL_ST + vv * PQ + (db * 32 + r) * 2) = (bf16)f2bf(accS[i][j]); } }
    __syncthreads();
}
__device__ __forceinline__ void h2_item(Frame& F, int item) {
    const int seg = item & 15, h = (item >> 4) & 3, b = item >> 6;
    f32x16 accS[2];
    unsigned rzA[8], rvA[8], rqA[8], rzB[8], rvB[8], rqB[8];
    { const float lb0 = F.lb()[h * HD + 2 * F.lane], lb1 = F.lb()[h * HD + 2 * F.lane + 1];
      const int c0 = seg * SEGC;
      hgrn_load<true>(F, b, h, 0, c0, rzA, rvA, rqA); hgrn_load<true>(F, b, h, 0, c0 + 1, rzB, rvB, rqB);
      h2_init_state(F, b, h, 0, seg, accS);
      for (int c = 0; c < SEGC; c += 2) {
          hgrn_chunk<true, 0>(F, b, h, 0, c0 + c, (c + 2 < SEGC) ? (c0 + c + 2) : -1, accS, lb0, lb1, rzA, rvA, rqA);
          hgrn_chunk<true, 0>(F, b, h, 0, c0 + c + 1, (c + 3 < SEGC) ? (c0 + c + 3) : -1, accS, lb0, lb1, rzB, rvB, rqB); } }
    asm volatile("s_waitcnt vmcnt(0)" ::: "memory");
    __syncthreads();
    { const float lb0 = F.lb()[512 + h * HD + 2 * F.lane], lb1 = F.lb()[512 + h * HD + 2 * F.lane + 1];
      const int cl = seg * SEGC + SEGC - 1;
      hgrn_load<true>(F, b, h, 1, cl, rzA, rvA, rqA); hgrn_load<true>(F, b, h, 1, cl - 1, rzB, rvB, rqB);
      h2_init_state(F, b, h, 1, seg, accS);
      for (int c = 0; c < SEGC; c += 2) {
          hgrn_chunk<true, 1>(F, b, h, 1, cl - c, (c + 2 < SEGC) ? (cl - c - 2) : -1, accS, lb0, lb1, rzA, rvA, rqA);
          hgrn_chunk<true, 1>(F, b, h, 1, cl - c - 1, (c + 3 < SEGC) ? (cl - c - 3) : -1, accS, lb0, lb1, rzB, rvB, rqB); } }
}

__device__ __forceinline__ unsigned f2key(float f) { return __builtin_bit_cast(unsigned, f); }
__device__ __forceinline__ float key2f(unsigned k) { return __builtin_bit_cast(float, k); }
__device__ __forceinline__ unsigned umax_(unsigned a, unsigned b) { unsigned r; asm("v_max_f32 %0, %1, %2" : "=v"(r) : "v"(a), "v"(b)); return r; }
__device__ __forceinline__ unsigned umin_(unsigned a, unsigned b) { unsigned r; asm("v_min_f32 %0, %1, %2" : "=v"(r) : "v"(a), "v"(b)); return r; }
__device__ __forceinline__ void sort16(unsigned (&a)[16]) {
#define CE_(i, j) { const unsigned x_ = a[i], y_ = a[j]; a[i] = umax_(x_, y_); a[j] = umin_(x_, y_); }
    CE_(0, 13) CE_(1, 12) CE_(2, 15) CE_(3, 14) CE_(4, 8) CE_(5, 6) CE_(7, 11) CE_(9, 10)
    CE_(0, 5) CE_(1, 7) CE_(2, 9) CE_(3, 4) CE_(6, 13) CE_(8, 14) CE_(10, 15) CE_(11, 12)
    CE_(0, 1) CE_(2, 3) CE_(4, 5) CE_(6, 8) CE_(7, 9) CE_(10, 11) CE_(12, 13) CE_(14, 15)
    CE_(0, 2) CE_(1, 3) CE_(4, 10) CE_(5, 11) CE_(6, 7) CE_(8, 9) CE_(12, 14) CE_(13, 15)
    CE_(1, 2) CE_(3, 12) CE_(4, 6) CE_(5, 7) CE_(8, 10) CE_(9, 11) CE_(13, 14)
    CE_(1, 4) CE_(2, 6) CE_(5, 8) CE_(7, 10) CE_(9, 13) CE_(11, 14)
    CE_(2, 4) CE_(3, 6) CE_(9, 12) CE_(11, 13)
    CE_(3, 5) CE_(6, 8) CE_(7, 9) CE_(10, 12)
    CE_(3, 4) CE_(5, 6) CE_(7, 8) CE_(9, 10) CE_(11, 12)
    CE_(6, 7) CE_(8, 9)
#undef CE_
}
__device__ __forceinline__ void merge16(unsigned (&a)[16], const unsigned (&b)[16]) {
#pragma unroll
    for (int i = 0; i < 16; ++i) a[i] = umax_(a[i], b[15 - i]);
#pragma unroll
    for (int j = 8; j > 0; j >>= 1)
#pragma unroll
        for (int i = 0; i < 16; ++i) { const int l = i ^ j; if (l > i) { const unsigned x = a[i], y = a[l]; a[i] = umax_(x, y); a[l] = umin_(x, y); } }
}
__device__ __forceinline__ unsigned dpp_swap1(unsigned v) { return (unsigned)__builtin_amdgcn_update_dpp(0, (int)v, 0xB1, 0xF, 0xF, false); }
__device__ __forceinline__ unsigned pick_byte(const unsigned (&pk)[4], unsigned a) {
    const unsigned wsel = a >> 2; unsigned v = wsel == 0 ? pk[0] : (wsel == 1 ? pk[1] : (wsel == 2 ? pk[2] : pk[3]));
    return (v >> ((a & 3u) * 8u)) & 0xffu;
}
__device__ __forceinline__ void topk_stage2(const unsigned (&top)[16], bool tab0, size_t item, int* esel, float* wsel) {
        float vO[16], vP[16]; unsigned iOpk[4] = {0u, 0u, 0u, 0u}, iPpk[4] = {0u, 0u, 0u, 0u};
#pragma unroll
        for (int i = 0; i < 16; ++i) { const unsigned t = top[i], tp = dpp_swap1(t);
            vO[i] = key2f(t & ~0x7fu); vP[i] = key2f(tp & ~0x7fu);
            iOpk[i >> 2] |= (127u - (t & 0x7fu)) << ((i & 3) * 8); iPpk[i >> 2] |= (127u - (tp & 0x7fu)) << ((i & 3) * 8); }
        unsigned R[16], G1[16], G2[16];
#define CAND(a, b) ((f2key(vO[a] + vP[b]) & ~0xffu) | (unsigned)(((a) << 4) | (b)))
#pragma unroll
        for (int i = 0; i < 16; ++i) R[i] = CAND(0, i);
        G1[0] = CAND(1, 0); G1[1] = CAND(1, 1); G1[2] = CAND(1, 2); G1[3] = CAND(1, 3); G1[4] = CAND(1, 4); G1[5] = CAND(1, 5); G1[6] = CAND(1, 6); G1[7] = CAND(1, 7);
        G1[8] = CAND(2, 0); G1[9] = CAND(2, 1); G1[10] = CAND(2, 2); G1[11] = CAND(2, 3); G1[12] = CAND(2, 4); G1[13] = CAND(3, 0); G1[14] = CAND(3, 1); G1[15] = CAND(3, 2);
        G2[0] = CAND(3, 3); G2[1] = CAND(4, 0); G2[2] = CAND(4, 1); G2[3] = CAND(4, 2); G2[4] = CAND(5, 0); G2[5] = CAND(5, 1); G2[6] = CAND(6, 0); G2[7] = CAND(6, 1);
        G2[8] = CAND(7, 0); G2[9] = CAND(7, 1); G2[10] = CAND(8, 0); G2[11] = CAND(9, 0); G2[12] = CAND(10, 0); G2[13] = CAND(11, 0); G2[14] = CAND(12, 0); G2[15] = CAND(13, 0);
        const unsigned g30 = CAND(14, 0), g31 = CAND(15, 0);
#undef CAND
        sort16(G1); sort16(G2);
        merge16(R, G1); merge16(R, G2);
        { const unsigned hi = umax_(g30, g31), lo = umin_(g30, g31); R[15] = umax_(R[15], hi); R[14] = umax_(R[14], lo);
#pragma unroll
          for (int j = 8; j > 0; j >>= 1)
#pragma unroll
              for (int i = 0; i < 16; ++i) { const int l = i ^ j; if (l > i) { const unsigned x = R[i], y = R[l]; R[i] = umax_(x, y); R[l] = umin_(x, y); } } }
        float sc[16], ex[16]; float sum = 0.f; unsigned eid[16];
        #pragma unroll
        for (int i = 0; i < 16; ++i) { sc[i] = key2f(R[i] & ~0xffu); const unsigned a = (R[i] >> 4) & 15u, bb = R[i] & 15u;
            const unsigned io = pick_byte(iOpk, a), ip = pick_byte(iPpk, bb);
            eid[i] = tab0 ? (io * 128u + ip) : (ip * 128u + io); }
#pragma unroll
        for (int i = 0; i < 16; ++i) { ex[i] = __expf(sc[i] - sc[0]); sum += ex[i]; }
        const float inv = 1.0f / sum;
        if (tab0) { const size_t o = item * 16;
#pragma unroll
            for (int q = 0; q < 4; ++q) { v4u ev; ev.x = eid[4 * q]; ev.y = eid[4 * q + 1]; ev.z = eid[4 * q + 2]; ev.w = eid[4 * q + 3]; *(v4u*)(esel + o + 4 * q) = ev;
                f32x4 wv; wv[0] = ex[4 * q] * inv; wv[1] = ex[4 * q + 1] * inv; wv[2] = ex[4 * q + 2] * inv; wv[3] = ex[4 * q + 3] * inv; *(f32x4*)(wsel + o + 4 * q) = wv; } }
}

struct EpiScoreTopk {
    static constexpr bool PERM = false, AFTER_DRAIN = false;
    float* scr; const float* ssqp; const float* biasq; float* rstd_out; int* esel; float* wsel;
    __device__ __forceinline__ void operator()(const f32x4 (&acc)[2][2][4][2], const pg8::Unit& u, int wr, int wc, int fr, int fq) const {
        asm volatile("" : "+v"(fr), "+v"(fq));
        const int rl0 = wr * 64 + fr, col0 = wc * 32 + 4 * fq, b = (u.pm * 256) >> 13;
        f32x4 bv[2][2];
#pragma unroll
        for (int bj = 0; bj < 2; ++bj)
#pragma unroll
            for (int n = 0; n < 2; ++n) bv[bj][n] = *(const f32x4*)(biasq + b * 2048 + u.pn * 256 + col0 + bj * 128 + n * 16);
#pragma unroll
        for (int ai = 0; ai < 2; ++ai)
#pragma unroll
            for (int m = 0; m < 4; ++m) { const int rl = rl0 + ai * 128 + m * 16, row = u.pm * 256 + rl;
                const f32x4 p0 = *(const f32x4*)(ssqp + (size_t)row * 4), p1 = *(const f32x4*)(ssqp + ((size_t)32768 + row) * 4), p2 = *(const f32x4*)(ssqp + ((size_t)65536 + row) * 4), p3 = *(const f32x4*)(ssqp + ((size_t)98304 + row) * 4);
                const float tot = (p0[0] + p0[1] + p0[2] + p0[3]) + (p1[0] + p1[1] + p1[2] + p1[3]) + (p2[0] + p2[1] + p2[2] + p2[3]) + (p3[0] + p3[1] + p3[2] + p3[3]);
                const float rstd = __builtin_amdgcn_rsqf(tot * (1.0f / 1024.0f) + 1e-6f);
                if (u.pn == 0 && wc == 0 && fq == 0) rstd_out[row] = rstd;
                float* blk = scr + (2 * wr + 4 * ai + (m >> 1)) * 8192 + 8 * wc * 256 + 32 * (m & 1) * 4;
                const unsigned loff4 = (unsigned)(2 * fr + 64 * fq);
#pragma unroll
                for (int bj = 0; bj < 2; ++bj)
#pragma unroll
                    for (int n = 0; n < 2; ++n) ((f32x4*)(blk + (4 * n * 64 + bj) * 4))[loff4] = acc[ai][bj][m][n] * rstd + bv[bj][n]; }
        asm volatile("s_waitcnt vmcnt(0)" ::: "memory");
        __builtin_amdgcn_s_barrier();
        asm volatile("" ::: "memory");
        int tid = threadIdx.x; asm volatile("" : "+v"(tid));
        const int rl = tid >> 1, tab = tid & 1;
        const float* bp = scr + __builtin_amdgcn_readfirstlane(tid >> 6) * 8192;
        const unsigned lo4 = (unsigned)(tid & 63) * 4u;
        unsigned top[16];
        f32x4 cur[4], nxt[4];
#pragma unroll
        for (int q = 0; q < 4; ++q) cur[q] = *(const f32x4*)(bp + q * 256 + lo4);
#pragma unroll
        for (int grp = 0; grp < 8; ++grp) { unsigned k[16];
            if (grp < 7) {
#pragma unroll
                for (int q = 0; q < 4; ++q) nxt[q] = *(const f32x4*)(bp + ((grp + 1) * 4 + q) * 256 + lo4); }
#pragma unroll
            for (int q = 0; q < 4; ++q) { const f32x4 v = cur[q];
#pragma unroll
                for (int e = 0; e < 4; ++e) { const int j = grp * 16 + q * 4 + e; k[q * 4 + e] = (f2key(v[e]) & ~0x7fu) | (unsigned)(127 - j); } }
            sort16(k);
            if (grp == 0) {
#pragma unroll
                for (int i = 0; i < 16; ++i) top[i] = k[i];
            } else merge16(top, k);
#pragma unroll
            for (int q = 0; q < 4; ++q) cur[q] = nxt[q];
            __builtin_amdgcn_sched_barrier(0); }
        topk_stage2(top, tab == 0, (size_t)u.pn * T + (size_t)(u.pm * 256 + rl), esel, wsel);
    }
};

__device__ __forceinline__ void cvt16(const v4u& u, f32x2_ (&f)[8]) {
#pragma unroll
    for (int i = 0; i < 4; ++i) { f[2 * i] = __builtin_amdgcn_cvt_pk_f32_fp8((int)u[i], false); f[2 * i + 1] = __builtin_amdgcn_cvt_pk_f32_fp8((int)u[i], true); }
}
constexpr int PITEM = 8, NPITEM = T / PITEM;
__device__ __forceinline__ int peer_next(unsigned* q, int lane) {
    int idx = 0; if (lane == 0) idx = (int)__hip_atomic_fetch_add(q, 1u, __ATOMIC_RELAXED, __HIP_MEMORY_SCOPE_AGENT);
    return __builtin_amdgcn_readfirstlane(idx);
}
#define PEER_SB() __builtin_amdgcn_sched_barrier(0)
#define DPP_IADD(s, ctrl) ((s) + __builtin_amdgcn_update_dpp(0, (s), (ctrl), 0xF, 0xF, false))
__device__ __forceinline__ void p8_dots(const v4u (&ud)[16], const int (&hh)[4], const int (&hl)[4], int c8, int& r0, int& r1) {
#pragma unroll
    for (int i = 0; i < 16; ++i) { int sh = 0, sl = 0;
#pragma unroll
        for (int d = 0; d < 4; ++d) { sh = __builtin_amdgcn_sdot8((int)ud[i][d], hh[d], sh, false); sl = __builtin_amdgcn_sdot8((int)ud[i][d], hl[d], sl, false); }
        int sm = (sh << 4) + sl;
        sm = DPP_IADD(sm, 0xB1); sm = DPP_IADD(sm, 0x4E); sm = DPP_IADD(sm, 0x141);
        if ((i & 1) == 0) r0 = (c8 == (i >> 1)) ? sm : r0; else r1 = (c8 == (i >> 1)) ? sm : r1; }
}
constexpr int PSLAB = 12288;
__device__ __forceinline__ void p8_item(Frame& F, int sl, int item, int nitem, bool filled, LAS unsigned char* slab) {
    const int c8 = F.lane & 7, q8 = F.lane >> 3, t0 = item * PITEM;
    const unsigned char* ub = F.U8() + (size_t)sl * 16384 * 128 + 16 * c8;
    LAS int* eL = (LAS int*)slab; LAS unsigned char* hL = (LAS unsigned char*)(slab + 4096);
    LAS float* qL = (LAS float*)(slab + 6144);
    v4u t4[4], h2[4]; float rs2[4]; f32x4 sA, sB, gA, gB;
#define P8_BLK_LOAD(tb) do { \
        { const float* sp_ = F.mod() + ((tb) >> 13) * 6144 + 3072 + sl * CSLU + 8 * (F.lane & 31); sA = *(const f32x4*)sp_; sB = *(const f32x4*)(sp_ + 4); \
          const float* gp_ = F.g_ffn() + sl * CSLU + 8 * (F.lane & 31); gA = *(const f32x4*)gp_ * (*(const f32x4*)(sp_ + 1024) + 1.0f); gB = *(const f32x4*)(gp_ + 4) * (*(const f32x4*)(sp_ + 1028) + 1.0f); } \
        _Pragma("unroll") for (int i = 0; i < 4; ++i) rs2[i] = F.rstd()[(tb) + 2 * i + (F.lane >> 5)]; \
        _Pragma("unroll") for (int i = 0; i < 4; ++i) t4[i] = __builtin_nontemporal_load((const v4u*)(F.esel() + ((size_t)(2 * i + (F.lane >> 5)) * T + (tb)) * 16) + (F.lane & 31)); \
        _Pragma("unroll") for (int i = 0; i < 4; ++i) h2[i] = __builtin_nontemporal_load((const v4u*)(F.hg() + (size_t)((tb) + 2 * i + (F.lane >> 5)) * D + sl * CSLU + 8 * (F.lane & 31))); } while (0)
#define DPP_FMAX(v, ctrl) __builtin_fmaxf((v), __builtin_bit_cast(float, __builtin_amdgcn_update_dpp(0, __builtin_bit_cast(int, (v)), (ctrl), 0xF, 0xF, false)))
#define P8_QN(x, k) { const int q_ = (int)__builtin_rintf((x) * qs_), lo_ = ((q_ + 8) & 15) - 8, hi_ = (q_ - lo_) >> 4; wl_ |= (unsigned)(lo_ & 15) << (4 * (k)); wh_ |= (unsigned)(hi_ & 15) << (4 * (k)); }
#define P8_BLK_STORE() do { _Pragma("unroll") for (int i = 0; i < 4; ++i) *(LAS v4u*)(eL + ((F.lane & 31) >> 2) * NSEL + (2 * i + (F.lane >> 5)) * 16 + 4 * (F.lane & 3)) = t4[i]; \
        _Pragma("unroll") for (int i = 0; i < 4; ++i) { const float r_ = rs2[i]; const v4u h_ = h2[i]; \
            const f32x4 ra_ = gA * r_, rb_ = gB * r_; \
            const float x0 = bflo(h_[0]) * ra_[0] + sA[0], x1 = bfhi(h_[0]) * ra_[1] + sA[1], x2 = bflo(h_[1]) * ra_[2] + sA[2], x3 = bfhi(h_[1]) * ra_[3] + sA[3]; \
            const float x4 = bflo(h_[2]) * rb_[0] + sB[0], x5 = bfhi(h_[2]) * rb_[1] + sB[1], x6 = bflo(h_[3]) * rb_[2] + sB[2], x7 = bfhi(h_[3]) * rb_[3] + sB[3]; \
            float m_ = __builtin_fmaxf(__builtin_fmaxf(__builtin_fmaxf(__builtin_fabsf(x0), __builtin_fabsf(x1)), __builtin_fmaxf(__builtin_fabsf(x2), __builtin_fabsf(x3))), \
                                       __builtin_fmaxf(__builtin_fmaxf(__builtin_fabsf(x4), __builtin_fabsf(x5)), __builtin_fmaxf(__builtin_fabsf(x6), __builtin_fabsf(x7)))); \
            m_ = DPP_FMAX(m_, 0x128); m_ = DPP_FMAX(m_, 0x124); m_ = DPP_FMAX(m_, 0x122); m_ = DPP_FMAX(m_, 0x121); m_ = __builtin_fmaxf(m_, __shfl_xor(m_, 16)); m_ = __builtin_fmaxf(m_, 1e-20f); \
            const float qs_ = 119.0f * __builtin_amdgcn_rcpf(m_); \
            const int tk_ = 2 * i + (F.lane >> 5); \
            if ((F.lane & 31) == 0) qL[tk_] = m_ * (1.0f / (119.0f * UQSCALE)); \
            unsigned wl_ = 0u, wh_ = 0u; P8_QN(x0, 0) P8_QN(x1, 1) P8_QN(x2, 2) P8_QN(x3, 3) P8_QN(x4, 4) P8_QN(x5, 5) P8_QN(x6, 6) P8_QN(x7, 7) \
            *(LAS unsigned*)(hL + tk_ * 256 + 4 * (F.lane & 31)) = wh_; *(LAS unsigned*)(hL + tk_ * 256 + 128 + 4 * (F.lane & 31)) = wl_; } \
        asm volatile("s_waitcnt lgkmcnt(0)" ::: "memory"); } while (0)
    if (!filled) { P8_BLK_LOAD(t0); P8_BLK_STORE(); }
    bf16* po = F.pact() + ((size_t)t0 * NSLU + sl) * NSEL + 16 * q8 + 2 * c8;
    v4u udA[16], udB[16];
#define P8_GATHER(dst, tt) do { v4u e_[4]; _Pragma("unroll") for (int k = 0; k < 4; ++k) e_[k] = *(LAS const v4u*)(eL + (tt) * NSEL + 16 * q8 + 4 * k); \
        _Pragma("unroll") for (int i = 0; i < 16; ++i) dst[i] = *(const v4u*)(ub + (size_t)e_[i >> 2][i & 3] * 128); } while (0)
#define P8_HN(tt) int hh[4], hl[4]; { const v4u a_ = *(LAS const v4u*)(hL + (tt) * 256 + 16 * c8), b_ = *(LAS const v4u*)(hL + (tt) * 256 + 128 + 16 * c8); \
        hh[0] = (int)a_[0]; hh[1] = (int)a_[1]; hh[2] = (int)a_[2]; hh[3] = (int)a_[3]; hl[0] = (int)b_[0]; hl[1] = (int)b_[1]; hl[2] = (int)b_[2]; hl[3] = (int)b_[3]; }
#define P8_OUT(tt, r0, r1) do { const float dq_ = qL[tt]; __builtin_nontemporal_store(cvtpk((float)(r0) * dq_, (float)(r1) * dq_), (unsigned*)(po + (size_t)(tt) * NSLU * NSEL)); } while (0)
    P8_GATHER(udA, 0);
    for (int tt = 0; tt < PITEM - 2; tt += 2) {
        P8_GATHER(udB, tt + 1);
        { P8_HN(tt); int r0 = 0, r1 = 0; p8_dots(udA, hh, hl, c8, r0, r1); P8_OUT(tt, r0, r1); }
        P8_GATHER(udA, tt + 2);
        { P8_HN(tt + 1); int r0 = 0, r1 = 0; p8_dots(udB, hh, hl, c8, r0, r1); P8_OUT(tt + 1, r0, r1); }
    }
    {
        P8_GATHER(udB, PITEM - 1);
        { P8_HN(PITEM - 2); int r0 = 0, r1 = 0; p8_dots(udA, hh, hl, c8, r0, r1); P8_OUT(PITEM - 2, r0, r1); }
        if (nitem >= 0) P8_BLK_LOAD(nitem * PITEM);
        { P8_HN(PITEM - 1); int r0 = 0, r1 = 0; p8_dots(udB, hh, hl, c8, r0, r1); P8_OUT(PITEM - 1, r0, r1); }
        if (nitem >= 0) P8_BLK_STORE();
    }
#undef P8_GATHER
#undef P8_HN
#undef P8_OUT
#undef P8_BLK_LOAD
#undef P8_BLK_STORE
#undef P8_QN
#undef DPP_FMAX
}
__device__ __forceinline__ void p8b_coef(Frame& F) {
    const int N8 = T * (NSEL / 8);
#pragma unroll 2
    for (int i = F.bid * NTHR + F.tid; i < N8; i += F.G * NTHR) { const size_t t = (size_t)(i >> 4); const int m = i & 15;
        const bf16* pp = F.pact() + t * NSLU * NSEL + 8 * m;
        v4u p4[NSLU];
#pragma unroll
        for (int q = 0; q < NSLU; ++q) p4[q] = __builtin_nontemporal_load((const v4u*)(pp + q * NSEL));
        const float* wp = F.wsel() + ((size_t)(m >> 1) * T + t) * 16 + 8 * (m & 1);
        const f32x4 w0 = *(const f32x4*)wp, w1 = *(const f32x4*)(wp + 4);
        float a[8];
#pragma unroll
        for (int e = 0; e < 4; ++e) { float lo = 0.f, hi = 0.f;
#pragma unroll
            for (int q = 0; q < NSLU; ++q) { lo += bflo(p4[q][e]); hi += bfhi(p4[q][e]); }
            a[2 * e] = lo; a[2 * e + 1] = hi; }
        f32x4 o0, o1;
#pragma unroll
        for (int e = 0; e < 4; ++e) { o0[e] = w0[e] * 0.5f * a[e] * (1.0f + erff(a[e] * 0.70710678f)); o1[e] = w1[e] * 0.5f * a[4 + e] * (1.0f + erff(a[4 + e] * 0.70710678f)); }
        float* cp = F.coef() + t * NSEL + 8 * m;
        *(f32x4*)cp = o0; *(f32x4*)(cp + 4) = o1; }
}
__device__ __forceinline__ void p9_token(const v4u (&vd)[16], LAS const float* cL, bf16* yo, LAS float* red, int lane, int c8, int q8) {
    f32x4 cc[4];
#pragma unroll
    for (int k = 0; k < 4; ++k) cc[k] = *(LAS const f32x4*)(cL + 16 * q8 + 4 * k);
    f32x2_ y[8];
#pragma unroll
    for (int k = 0; k < 8; ++k) y[k] = (f32x2_){0.f, 0.f};
#pragma unroll
    for (int i = 0; i < 16; ++i) { f32x2_ vf[8]; cvt16(vd[i], vf); const float c = cc[i >> 2][i & 3]; const f32x2_ c2 = {c, c};
#pragma unroll
        for (int k = 0; k < 8; ++k) y[k] += c2 * vf[k];
        PEER_SB(); }
#pragma unroll
    for (int k = 0; k < 4; ++k) { f32x4 o; o[0] = y[2 * k][0]; o[1] = y[2 * k][1]; o[2] = y[2 * k + 1][0]; o[3] = y[2 * k + 1][1]; *(LAS f32x4*)(red + q8 * 128 + 16 * c8 + 4 * k) = o; }
    asm volatile("s_waitcnt lgkmcnt(0)" ::: "memory");
    f32x2_ sm = {0.f, 0.f};
#pragma unroll
    for (int g = 0; g < 8; ++g) sm += *(LAS const f32x2_*)(red + g * 128 + 2 * lane);
    sm = sm * (1.0f / VSCALE);
    __builtin_nontemporal_store(cvtpk(sm[0], sm[1]), (unsigned*)(yo + 2 * lane));
    asm volatile("s_waitcnt lgkmcnt(0)" ::: "memory");
    PEER_SB();
}
__device__ __forceinline__ void p9_item(Frame& F, int sl, int item, int nitem, bool filled, LAS unsigned char* slab) {
    const int c8 = F.lane & 7, q8 = F.lane >> 3, t0 = item * PITEM;
    const unsigned char* vb = F.V8() + (size_t)sl * 16384 * CSL + 16 * c8;
    LAS int* eL = (LAS int*)slab; LAS float* cL = (LAS float*)(slab + 4096); LAS float* red = (LAS float*)(slab + 8192);
    v4u t4[4], c4[4];
#define P9_BLK_LOAD(tb) do { const v4u* cp_ = (const v4u*)(F.coef() + (size_t)(tb) * NSEL); \
        _Pragma("unroll") for (int i = 0; i < 4; ++i) { t4[i] = __builtin_nontemporal_load((const v4u*)(F.esel() + ((size_t)(2 * i + (F.lane >> 5)) * T + (tb)) * 16) + (F.lane & 31)); c4[i] = __builtin_nontemporal_load(cp_ + i * 64 + F.lane); } } while (0)
#define P9_BLK_STORE() do { _Pragma("unroll") for (int i = 0; i < 4; ++i) { *(LAS v4u*)(eL + ((F.lane & 31) >> 2) * NSEL + (2 * i + (F.lane >> 5)) * 16 + 4 * (F.lane & 3)) = t4[i]; *(LAS v4u*)(cL + (i * 64 + F.lane) * 4) = c4[i]; } \
        asm volatile("s_waitcnt lgkmcnt(0)" ::: "memory"); } while (0)
    if (!filled) { P9_BLK_LOAD(t0); P9_BLK_STORE(); }
    bf16* yo = F.ybuf() + (size_t)t0 * D + sl * CSL;
    v4u vdA[16], vdB[16];
#define P9_GATHER(dst, tt) do { v4u e_[4]; _Pragma("unroll") for (int k = 0; k < 4; ++k) e_[k] = *(LAS const v4u*)(eL + (tt) * NSEL + 16 * q8 + 4 * k); \
        _Pragma("unroll") for (int i = 0; i < 16; ++i) dst[i] = *(const v4u*)(vb + (size_t)e_[i >> 2][i & 3] * CSL); } while (0)
    P9_GATHER(vdA, 0);
    for (int tt = 0; tt < PITEM - 2; tt += 2) {
        P9_GATHER(vdB, tt + 1);
        p9_token(vdA, cL + tt * NSEL, yo + (size_t)tt * D, red, F.lane, c8, q8);
        P9_GATHER(vdA, tt + 2);
        p9_token(vdB, cL + (tt + 1) * NSEL, yo + (size_t)(tt + 1) * D, red, F.lane, c8, q8);
    }
    {
        P9_GATHER(vdB, PITEM - 1);
        p9_token(vdA, cL + (PITEM - 2) * NSEL, yo + (size_t)(PITEM - 2) * D, red, F.lane, c8, q8);
        if (nitem >= 0) P9_BLK_LOAD(nitem * PITEM);
        p9_token(vdB, cL + (PITEM - 1) * NSEL, yo + (size_t)(PITEM - 1) * D, red, F.lane, c8, q8);
        if (nitem >= 0) P9_BLK_STORE();
    }
#undef P9_GATHER
#undef P9_BLK_LOAD
#undef P9_BLK_STORE
}
template <int SIDE>
__device__ __forceinline__ void peer_phase(Frame& F0, int rep) {
    Frame F = F0; asm volatile("" : "+v"(F.lane));
    constexpr int NS = (SIDE == 0) ? NSLU : NSL;
    const int s0 = (int)(xb_xcc_id() & (unsigned)(NS - 1));
    unsigned* qbase = F.ctl() + (SIDE == 0 ? CW_QU : CW_QV) + rep * 64 * 32;
    LAS unsigned char* cf = F.lds + F.wave * PSLAB;
    for (int k = 0; k < NS; ++k) { const int sl = (s0 + k) & (NS - 1);
        int item = peer_next(qbase + 64 * sl, F.lane); bool filled = false;
        while (item < NPITEM) { int nitem = peer_next(qbase + 64 * sl, F.lane); if (nitem >= NPITEM) nitem = -1;
            if (SIDE == 0) p8_item(F, sl, item, nitem, filled, cf); else p9_item(F, sl, item, nitem, filled, cf);
            filled = nitem >= 0; item = nitem >= 0 ? nitem : NPITEM; } }
}
__device__ __forceinline__ void p10_final(Frame& F) {
    const int gwc = F.bid * NWAVES + F.wave, NGW = F.G * NWAVES;
    for (int row0 = gwc * 16; row0 < T; row0 += NGW * 16) {
        const int b = row0 >> 13; const float* mb = F.mod() + b * 6144 + 5120; const float* fm = F.fmod() + b * 2048;
        f32x4 g2[4], ca[4], cb[4];
#pragma unroll
        for (int j = 0; j < 4; ++j) { const int k = 256 * j + 4 * F.lane; g2[j] = *(const f32x4*)(mb + k); ca[j] = *(const f32x4*)(F.fnorm_g() + k) * (*(const f32x4*)(fm + 1024 + k) + 1.0f); cb[j] = *(const f32x4*)(fm + k); }
#pragma unroll 4
        for (int r = 0; r < 16; ++r) { float* hr = F.out() + (size_t)(row0 + r) * D; const bf16* yr = F.ybuf() + (size_t)(row0 + r) * D; const bf16* hb = F.hg() + (size_t)(row0 + r) * D;
            f32x4 z[4]; float ss = 0.f;
#pragma unroll
            for (int j = 0; j < 4; ++j) { const v2u hq = *(const v2u*)(hb + 256 * j + 4 * F.lane); f32x4 hv; hv[0] = bflo(hq[0]); hv[1] = bfhi(hq[0]); hv[2] = bflo(hq[1]); hv[3] = bfhi(hq[1]);
                const v2u yq = __builtin_nontemporal_load((const v2u*)(yr + 256 * j + 4 * F.lane)); f32x4 yv; yv[0] = bflo(yq[0]); yv[1] = bfhi(yq[0]); yv[2] = bflo(yq[1]); yv[3] = bfhi(yq[1]);
                z[j] = hv + g2[j] * yv; ss += z[j][0] * z[j][0] + z[j][1] * z[j][1] + z[j][2] * z[j][2] + z[j][3] * z[j][3]; }
            const float rstd = __builtin_amdgcn_rsqf(wave_sum(ss) * (1.0f / D) + EPS);
#pragma unroll
            for (int j = 0; j < 4; ++j) *(f32x4*)(hr + 256 * j + 4 * F.lane) = z[j] * rstd * ca[j] + cb[j]; }
    }
}

constexpr int NPHASE = 12;
__global__ void __launch_bounds__(NTHR, 2) fwd_kernel(Args args) {
    extern __shared__ __attribute__((aligned(16))) unsigned char lds_raw[];
    Frame F;
    F.lds = (LAS unsigned char*)lds_raw;
    F.tid = threadIdx.x; F.lane = F.tid & 63; F.wave = __builtin_amdgcn_readfirstlane(F.tid >> 6); F.G = gridDim.x; F.bid = blockIdx.x;
    unsigned char* ws = args.ws; F.a = &args;
    volatile LAS unsigned* misc = (volatile LAS unsigned*)(F.lds + MISC_OFF);
    if (F.tid < 64) misc[F.tid] = 0u;
    __syncthreads();
    const int lo = args.ph_lo, hi = args.ph_hi;
    const bool multi = (hi - lo) > 1;
    XcdBarrier bar; bar.bar = (unsigned*)(ws + WS_CTL) + CW_BAR; bar.x = 0; bar.st = nullptr;
    if (multi) bar = xcd_barrier_post((unsigned*)(ws + WS_CTL) + CW_BAR, misc + 8);
#ifndef PHMASK
#define PHMASK 0xfff
#endif
#define IN(k) (((PHMASK >> (k)) & 1) && lo <= (k) && (k) < hi)
#define SEAM(k) do { if (IN(k) && IN((k) + 1)) xcd_barrier(bar); } while (0)

#ifndef REPMASK
#define REPMASK 0
#endif
#define REP(k) (((REPMASK) >> (k)) & 1)
#define REPBAR(k) if (REP(k) && rep == 0) xcd_barrier(bar)
    if (IN(0)) p0_prologue(F);
    if (IN(0) && IN(1)) {
        if (F.tid == 0) { XB_SPIN(xb_ld(F.ctl() + CW_GV) < (unsigned)F.G, bar.bar); __builtin_amdgcn_fence(__ATOMIC_ACQUIRE, "agent"); asm volatile("s_waitcnt vmcnt(0)" ::: "memory"); }
        __syncthreads(); }
    if (IN(1)) p1_norm(F);
    SEAM(1);
    if (IN(2)) { { pg8::Gemm g{F.bufA(), F.Win_t(), T, NIN, D}; pg8::StaticOrder S; S.init(T, NIN, F.G, F.bid);
        pg8::EpiProj E{F.proj(), NIN};
        pg8::gemm_phase<pg8::EpiProj, pg8::StaticOrder, true, true>(F.lds, g, S, E); }
#if ((REPMASK) >> 2) & 1
        xcd_barrier(bar); { pg8::Gemm g{F.bufA(), F.Win_t(), T, NIN, D}; pg8::StaticOrder S; S.init(T, NIN, F.G, F.bid);
        pg8::EpiProj E{F.proj(), NIN};
        pg8::gemm_phase<pg8::EpiProj, pg8::StaticOrder, true, true>(F.lds, g, S, E); }
#endif
    } SEAM(2);
    if (IN(3)) { p3_pre(F);
      for (int rep = 0; rep <= REP(3); ++rep) {
        for (int it = F.bid; it < NB * NHH * 2 * NSEG; it += F.G) h1_item(F, it);
        asm volatile("s_waitcnt vmcnt(0)" ::: "memory");
        __syncthreads();
        if (F.tid == 0) { __builtin_amdgcn_fence(__ATOMIC_RELEASE, "agent"); asm volatile("s_waitcnt vmcnt(0)" ::: "memory"); (void)xb_add(F.ctl() + CW_H1, 1u); }
        float cw[CW];
#pragma unroll
        for (int j = 0; j < CW; ++j) cw[j] = F.conv_w()[j * DC + F.tid];
        const float cbias = F.conv_b()[F.tid];
        for (int it = F.bid; it < T / 32; it += F.G) conv_item(F, it, cw, cbias);
        if (F.tid == 0) { const unsigned tgt = (unsigned)F.G * (unsigned)(rep + 1); XB_SPIN(xb_ld(F.ctl() + CW_H1) < tgt, bar.bar); __builtin_amdgcn_fence(__ATOMIC_ACQUIRE, "agent"); asm volatile("s_waitcnt vmcnt(0)" ::: "memory"); }
        __syncthreads();
        h_scan(F);
        REPBAR(3); }
    } SEAM(3);
    if (IN(4)) { for (int rep = 0; rep <= REP(4); ++rep) { for (int it = F.bid; it < NB * NHH * NSEG; it += F.G) h2_item(F, it); REPBAR(4); } } SEAM(4);
    if (IN(5)) { { pg8::Gemm g{F.bufA(), F.Wout_t(), T, D, D}; pg8::StaticOrder S; S.init(T, D, F.G, F.bid);
        pg8::EpiOut E{F.x(), F.hg(), F.mod(), F.ssqp()};
        pg8::gemm_phase<pg8::EpiOut, pg8::StaticOrder, true, true>(F.lds, g, S, E); }
#if ((REPMASK) >> 5) & 1
        xcd_barrier(bar); { pg8::Gemm g{F.bufA(), F.Wout_t(), T, D, D}; pg8::StaticOrder S; S.init(T, D, F.G, F.bid);
        pg8::EpiOut E{F.x(), F.hg(), F.mod(), F.ssqp()};
        pg8::gemm_phase<pg8::EpiOut, pg8::StaticOrder, true, true>(F.lds, g, S, E); }
#endif
    } SEAM(5);
    if (IN(6)) { { pg8::Gemm g{F.hg(), F.Wqk_b(), T, NQK, D, (size_t)NQK * D * 2}; pg8::StaticOrder S; S.init(T, NQK, F.G, F.bid);
        EpiScoreTopk E{F.scores() + (size_t)F.bid * 65536, F.ssqp(), F.biasq(), F.rstd(), F.esel(), F.wsel()};
        pg8::gemm_phase<EpiScoreTopk, pg8::StaticOrder, true, true>(F.lds, g, S, E); }
    } SEAM(6);
    if (IN(8)) { for (int rep = 0; rep <= REP(8); ++rep) { peer_phase<0>(F, rep); REPBAR(8); } } SEAM(8);
    if (IN(9)) { for (int rep = 0; rep <= REP(9); ++rep) { p8b_coef(F); REPBAR(9); } } SEAM(9);
    if (IN(10)) { for (int rep = 0; rep <= REP(10); ++rep) { peer_phase<1>(F, rep); REPBAR(10); } } SEAM(10);
    if (IN(11)) { p10_final(F); }
#undef IN
#undef SEAM
}

#ifndef MK_ONE_LAUNCH
#define MK_ONE_LAUNCH 0
#endif
extern "C" void kernel_launch(void* const* d_in, const int* in_sizes, int n_in, void* d_out, int out_size, void* d_ws, size_t ws_size, hipStream_t stream) {
    static int grid = 0;
    if (grid == 0) {
        if (n_in != 23 || out_size != T * D || ws_size < WS_END) { fprintf(stderr, "kernel_launch: unexpected shapes (n_in %d, out %d, ws %zu)\n", n_in, out_size, ws_size); grid = -1; return; }
        int dev = 0, cus = 0, per_cu = 0;
        if (hipGetDevice(&dev) != hipSuccess || hipDeviceGetAttribute(&cus, hipDeviceAttributeMultiprocessorCount, dev) != hipSuccess) { grid = -1; return; }
        if (hipFuncSetAttribute((const void*)fwd_kernel, hipFuncAttributeMaxDynamicSharedMemorySize, LDS_BYTES) != hipSuccess) { fprintf(stderr, "kernel_launch: hipFuncSetAttribute failed\n"); grid = -1; return; }
        if (hipOccupancyMaxActiveBlocksPerMultiprocessor(&per_cu, (const void*)fwd_kernel, NTHR, LDS_BYTES) != hipSuccess || per_cu < 1) { fprintf(stderr, "kernel_launch: occupancy query reports %d\n", per_cu); }
        (void)hipGetLastError();
        grid = cus;
    }
    if (grid < 0) return;
    (void)hipMemsetAsync((char*)d_ws + WS_CTL, 0, CTL_ZERO_BYTES, stream);
    Args a{};
    for (int i = 0; i < 23; ++i) a.in[i] = (const float*)d_in[i];
    a.out = (float*)d_out; a.ws = (unsigned char*)d_ws;
#if MK_ONE_LAUNCH
    a.ph_lo = 0; a.ph_hi = NPHASE;
    hipLaunchKernelGGL(fwd_kernel, dim3(grid), dim3(NTHR), LDS_BYTES, stream, a);
#else
    for (int p = 0; p < NPHASE; ++p) { a.ph_lo = p; a.ph_hi = p + 1; hipLaunchKernelGGL(fwd_kernel, dim3(grid), dim3(NTHR), LDS_BYTES, stream, a); }
#endif
}
```

```cpp
#include <hip/hip_runtime.h>
#include <cstdio>
#include <cstdint>
namespace pg8 {
#define PG8_LAS __attribute__((address_space(3)))
typedef unsigned short bf16_t;
typedef short bf16x8 __attribute__((ext_vector_type(8)));
typedef float f32x4 __attribute__((ext_vector_type(4)));
typedef unsigned u32x4 __attribute__((ext_vector_type(4)));
constexpr int BM = 256, BK = 64, HALF = 128, HTB = HALF * BK * 2  , STAGE_BYTES = 8 * HTB, NXCD = 8, WGM = 8;

__host__ __device__ __forceinline__ int lds_byte(int r, int c) { const int st = (r >> 4) * 2 + (c >> 5), rr = r & 15, cc = c & 31, ob = rr * 64 + cc * 2; return st * 1024 + (ob ^ (((ob >> 9) & 1) << 5)); }
__host__ __device__ __forceinline__ void stage_rc(int b, int& R, int& C) { const int st = b / 1024, sb = b % 1024, swz = sb ^ (((sb >> 9) & 1) << 5); R = (st >> 1) * 16 + swz / 64; C = (st & 1) * 32 + (swz % 64) / 2; }
__host__ __device__ __forceinline__ int perm32(int rho) { const int n = rho >> 4, i = rho & 15; return 8 * (i >> 2) + 4 * n + (i & 3); }

struct Unit { int pm, pn; };
struct Gemm { const bf16_t* A; const bf16_t* Bt; int M, N, K; size_t bbatch = 0; };

struct StaticOrder {
    int nM, nN, nwg, G, c;
    __host__ __device__ void init(int M, int N, int G_, int c_) { nM = M / BM; nN = N / BM; nwg = nM * nN; G = G_; c = c_; }
    __host__ __device__ bool next(int i, Unit& u) const {
        const long L = (long)i * G + c; if (L >= nwg) return false;
        int wgid = (int)L; { const int q = nwg / NXCD, r = nwg % NXCD, xcd = wgid % NXCD, off = wgid / NXCD; wgid = (xcd < r ? xcd * (q + 1) : r * (q + 1) + (xcd - r) * q) + off; }
        const int nig = WGM * nN, gid = wgid / nig, fm = gid * WGM, gsz = (nM - fm) < WGM ? (nM - fm) : WGM;
        u.pm = fm + ((wgid % nig) % gsz); u.pn = (wgid % nig) / gsz; return true;
    }
    __device__ __forceinline__ void a_ready(const Unit&) const {}
    __device__ __forceinline__ void done(const Unit&) const {}
};
__device__ __forceinline__ unsigned cvt_pk_bf16(float lo, float hi) { unsigned r; asm volatile("v_cvt_pk_bf16_f32 %0, %1, %2" : "=v"(r) : "v"(lo), "v"(hi)); return r; }
typedef float f32x2 __attribute__((ext_vector_type(2)));
__device__ __forceinline__ f32x2 gelu_pk(f32x2 v) {
    const f32x2 av = __builtin_elementwise_abs(v), d = av * 0.2316418882f + 1.0f;
    f32x2 t; t.x = __builtin_amdgcn_rcpf(d.x); t.y = __builtin_amdgcn_rcpf(d.y);
    f32x2 q = t * 0.5307027145f + (-0.7265760135f); q = q * t + 0.7107068705f; q = q * t + (-0.142248368f); q = q * t + 0.127414796f; q = q * t;
    const f32x2 s = (v * v) * (-0.72134752044f);
    f32x2 e; e.x = __builtin_amdgcn_exp2f(s.x); e.y = __builtin_amdgcn_exp2f(s.y);
    const f32x2 m = v * (q * e), r = v - m;
    f32x2 o; o.x = v.x < 0.f ? m.x : r.x; o.y = v.y < 0.f ? m.y : r.y; return o;
}

template <int ACT  > struct EpiBf16 {
    static constexpr bool PERM = true, AFTER_DRAIN = false; static_assert(ACT == 0 || ACT == 1, "EpiBf16: ACT is 0 (none) or 1 (gelu_pk)");
    bf16_t* O; int ldc; const float* bias; int split_cols; size_t split_stride; float scale0;
    __device__ __forceinline__ void operator()(const f32x4 (&acc)[2][2][4][2], const Unit& u, int wr, int wc, int fr, int fq) const {
        const int row0 = u.pm * BM + wr * 64 + fr; int colt = u.pn * BM; bf16_t* base = O;
        float sc = 1.f; if (split_cols) { const int t = colt / split_cols; base += (size_t)t * split_stride; colt -= t * split_cols; if (t == 0) sc = scale0; }
        const int col0 = colt + wc * 32 + 8 * fq, bcol0 = u.pn * BM + wc * 32 + 8 * fq;
        f32x4 bv[2][2];
#pragma unroll
        for (int bj = 0; bj < 2; ++bj)
#pragma unroll
            for (int n = 0; n < 2; ++n) bv[bj][n] = bias ? *(const f32x4*)(bias + bcol0 + bj * HALF + 4 * n) : (f32x4){0.f, 0.f, 0.f, 0.f};
#pragma unroll
        for (int ai = 0; ai < 2; ++ai)
#pragma unroll
            for (int m = 0; m < 4; ++m) { bf16_t* rowp = base + (size_t)(row0 + ai * HALF + m * 16) * ldc + col0;
#pragma unroll
                for (int bj = 0; bj < 2; ++bj) { f32x4 v0 = acc[ai][bj][m][0] + bv[bj][0], v1 = acc[ai][bj][m][1] + bv[bj][1];
                    if (ACT == 1) { f32x2 a = gelu_pk((f32x2){v0[0], v0[1]}), b = gelu_pk((f32x2){v0[2], v0[3]}), c = gelu_pk((f32x2){v1[0], v1[1]}), d = gelu_pk((f32x2){v1[2], v1[3]});
                        v0 = (f32x4){a.x, a.y, b.x, b.y}; v1 = (f32x4){c.x, c.y, d.x, d.y}; }
                    v0 = v0 * sc; v1 = v1 * sc; u32x4 w; w.x = cvt_pk_bf16(v0[0], v0[1]); w.y = cvt_pk_bf16(v0[2], v0[3]); w.z = cvt_pk_bf16(v1[0], v1[1]); w.w = cvt_pk_bf16(v1[2], v1[3]);
                    *(u32x4*)(rowp + bj * HALF) = w; } }
    }
};

struct EpiOut {
    static constexpr bool PERM = true, AFTER_DRAIN = false;
    const float* X; bf16_t* HB; const float* mod; float* ssqp;
    __device__ __forceinline__ void operator()(const f32x4 (&acc)[2][2][4][2], const Unit& u, int wr, int wc, int fr, int fq) const {
        const int row0 = u.pm * BM + wr * 64 + fr, col0 = u.pn * BM + wc * 32 + 8 * fq;
        const int b = (u.pm * BM) >> 13;
        const float* mb = mod + b * 6144;
        f32x4 g1v[2][2];
#pragma unroll
        for (int bj = 0; bj < 2; ++bj)
#pragma unroll
            for (int n = 0; n < 2; ++n) g1v[bj][n] = *(const f32x4*)(mb + 2048 + col0 + bj * HALF + 4 * n);
#pragma unroll
        for (int ai = 0; ai < 2; ++ai)
#pragma unroll
            for (int m = 0; m < 4; ++m) { const int row = row0 + ai * HALF + m * 16; const size_t ro = (size_t)row * 1024 + col0; float ss = 0.f;
#pragma unroll
                for (int bj = 0; bj < 2; ++bj) {
                    const f32x4 x0 = *(const f32x4*)(X + ro + bj * HALF), x1 = *(const f32x4*)(X + ro + bj * HALF + 4);
                    const f32x4 h0 = x0 + g1v[bj][0] * acc[ai][bj][m][0], h1 = x1 + g1v[bj][1] * acc[ai][bj][m][1];
                    u32x4 hw; hw.x = cvt_pk_bf16(h0[0], h0[1]); hw.y = cvt_pk_bf16(h0[2], h0[3]); hw.z = cvt_pk_bf16(h1[0], h1[1]); hw.w = cvt_pk_bf16(h1[2], h1[3]);
                    *(u32x4*)(HB + ro + bj * HALF) = hw;
                    ss += h0[0] * h0[0] + h0[1] * h0[1] + h0[2] * h0[2] + h0[3] * h0[3] + h1[0] * h1[0] + h1[1] * h1[1] + h1[2] * h1[2] + h1[3] * h1[3]; }
                ss += __shfl_xor(ss, 16); ss += __shfl_xor(ss, 32);
                if (fq == 0) ssqp[((size_t)u.pn * 32768 + row) * 4 + wc] = ss; }
    }
};
struct EpiScore {
    static constexpr bool PERM = false, AFTER_DRAIN = false;
    float* S; const float* ssqp; const float* biasq; float* rstd_out;
    __device__ __forceinline__ void operator()(const f32x4 (&acc)[2][2][4][2], const Unit& u, int wr, int wc, int fr, int fq) const {
        const int row0 = u.pm * BM + wr * 64 + fr, col0 = u.pn * BM + wc * 32 + 4 * fq;
        const int b = (u.pm * BM) >> 13;
        f32x4 bv[2][2];
#pragma unroll
        for (int bj = 0; bj < 2; ++bj)
#pragma unroll
            for (int n = 0; n < 2; ++n) bv[bj][n] = *(const f32x4*)(biasq + b * 2048 + col0 + bj * HALF + n * 16);
#pragma unroll
        for (int ai = 0; ai < 2; ++ai)
#pragma unroll
            for (int m = 0; m < 4; ++m) { const int row = row0 + ai * HALF + m * 16;
                const f32x4 p0 = *(const f32x4*)(ssqp + (size_t)row * 4), p1 = *(const f32x4*)(ssqp + ((size_t)32768 + row) * 4), p2 = *(const f32x4*)(ssqp + ((size_t)65536 + row) * 4), p3 = *(const f32x4*)(ssqp + ((size_t)98304 + row) * 4);
                const float tot = (p0[0] + p0[1] + p0[2] + p0[3]) + (p1[0] + p1[1] + p1[2] + p1[3]) + (p2[0] + p2[1] + p2[2] + p2[3]) + (p3[0] + p3[1] + p3[2] + p3[3]);
                const float rstd = __builtin_amdgcn_rsqf(tot * (1.0f / 1024.0f) + 1e-6f);
                if (u.pn == 0 && wc == 0 && fq == 0) rstd_out[row] = rstd;
                float* rowp = S + (size_t)row * 2048 + col0;
#pragma unroll
                for (int bj = 0; bj < 2; ++bj)
#pragma unroll
                    for (int n = 0; n < 2; ++n) *(f32x4*)(rowp + bj * HALF + n * 16) = acc[ai][bj][m][n] * rstd + bv[bj][n]; }
    }
};

struct EpiProj {
    static constexpr bool PERM = true, AFTER_DRAIN = false;
    bf16_t* O; int ldc;
    __device__ __forceinline__ void operator()(const f32x4 (&acc)[2][2][4][2], const Unit& u, int wr, int wc, int fr, int fq) const {
        asm volatile("" : "+v"(fr), "+v"(fq));
        const int row0 = u.pm * BM + wr * 64 + fr, col0 = u.pn * BM + wc * 32 + 8 * fq;
        const int cls = u.pn >> 1;
        const bool ident = (cls == 3) || (cls == 5), mulx = (cls == 0) || (cls == 4);
        const float sgn = (cls == 1 || cls == 2) ? 1.4426950408889634f : -1.4426950408889634f;
#pragma unroll
        for (int ai = 0; ai < 2; ++ai)
#pragma unroll
            for (int m = 0; m < 4; ++m) { bf16_t* rowp = O + (size_t)(row0 + ai * HALF + m * 16) * ldc + col0;
#pragma unroll
                for (int bj = 0; bj < 2; ++bj) { f32x4 v0 = acc[ai][bj][m][0], v1 = acc[ai][bj][m][1];
                    if (!ident) {
#pragma unroll
                        for (int j = 0; j < 4; ++j) { const float r0 = __builtin_amdgcn_rcpf(1.0f + __builtin_amdgcn_exp2f(sgn * v0[j])), r1 = __builtin_amdgcn_rcpf(1.0f + __builtin_amdgcn_exp2f(sgn * v1[j]));
                            v0[j] = mulx ? v0[j] * r0 : r0; v1[j] = mulx ? v1[j] * r1 : r1; } }
                    u32x4 w; w.x = cvt_pk_bf16(v0[0], v0[1]); w.y = cvt_pk_bf16(v0[2], v0[3]); w.z = cvt_pk_bf16(v1[0], v1[1]); w.w = cvt_pk_bf16(v1[2], v1[3]);
                    *(u32x4*)(rowp + bj * HALF) = w; } }
    }
};
template <class Epi, class Sched, bool ALIGN_EPI = false, bool SP2 = false>
__device__ __forceinline__ void gemm_phase(PG8_LAS unsigned char* lds, const Gemm g, const Sched& S, const Epi& E) {
    const int tid = threadIdx.x, wid = __builtin_amdgcn_readfirstlane(tid >> 6), lane = tid & 63, wr = wid >> 2, wc = wid & 3, fr = lane & 15, fq = lane >> 4;
    const int K = g.K, nt = K / BK;
    unsigned voffA[2], voffB[2];
#pragma unroll
    for (int i = 0; i < 2; ++i) { int R, C; stage_rc(tid * 16 + i * 8192, R, C); const int Rb = Epi::PERM ? ((R & ~31) + perm32(R & 31)) : R;
        voffA[i] = (unsigned)(R * K + C) * 2u; voffB[i] = (unsigned)(Rb * K + C) * 2u; }
    const size_t kstep = (size_t)(BK * 2);
    const size_t hstep = (size_t)HALF * K * 2;
    const size_t tstep = 2 * hstep;
    const unsigned ldsw = (unsigned)wid * 1024u;
    const int aoff = lds_byte(wr * 64 + fr, fq * 8), boff = lds_byte(wc * 32 + fr, fq * 8);
#define PG8_SA(b, h) (((b) * 2 + (h)) * HTB)
#define PG8_SB(b, h) ((4 + (b) * 2 + (h)) * HTB)
#define PG8_STAGE(bufoff, gbase, voff) do { _Pragma("unroll") for (int _i = 0; _i < 2; ++_i) \
        __builtin_amdgcn_global_load_lds((const unsigned*)((const char*)(gbase) + (voff)[_i]), (PG8_LAS unsigned*)(lds + (bufoff) + ldsw + _i * 8192), 16, 0, 0); } while (0)
#define PG8_LDA(dst, b, h) do { _Pragma("unroll") for (int m = 0; m < 4; ++m) _Pragma("unroll") for (int k = 0; k < 2; ++k) dst[m][k] = *(const PG8_LAS bf16x8*)(lds + PG8_SA(b, h) + aoff + m * 2048 + k * 1024); } while (0)
#define PG8_LDB(dst, b, h) do { _Pragma("unroll") for (int n = 0; n < 2; ++n) _Pragma("unroll") for (int k = 0; k < 2; ++k) dst[n][k] = *(const PG8_LAS bf16x8*)(lds + PG8_SB(b, h) + boff + n * 2048 + k * 1024); } while (0)
#define PG8_MMA(ai, bj, At, Bt) do { __builtin_amdgcn_s_setprio(1); _Pragma("unroll") for (int m = 0; m < 4; ++m) _Pragma("unroll") for (int n = 0; n < 2; ++n) _Pragma("unroll") for (int k = 0; k < 2; ++k) \
        acc[ai][bj][m][n] = __builtin_amdgcn_mfma_f32_16x16x32_bf16(Bt[n][k], At[m][k], acc[ai][bj][m][n], 0, 0, 0); __builtin_amdgcn_s_setprio(0); } while (0)
#define PG8_WAIT_V(n) asm volatile("s_waitcnt vmcnt(" #n ")" ::: "memory")
#define PG8_WAIT_L(n) asm volatile("s_waitcnt lgkmcnt(" #n ")" ::: "memory")
#define PG8_BAR __builtin_amdgcn_s_barrier()
#define PG8_SCHED __builtin_amdgcn_sched_barrier(0)
    Unit cur, nxt; int ui = 0;
    if (!S.next(0, cur)) return;
    f32x4 acc[2][2][4][2];
#pragma unroll
    for (int a = 0; a < 2; ++a)
#pragma unroll
        for (int b = 0; b < 2; ++b)
#pragma unroll
            for (int m = 0; m < 4; ++m)
#pragma unroll
                for (int n = 0; n < 2; ++n) acc[a][b][m][n] = (f32x4){0.f, 0.f, 0.f, 0.f};
    bf16x8 At[4][2], B0[2][2], B1[2][2];
    const char* cA = (const char*)g.A + (size_t)cur.pm * tstep; const char* cB = (const char*)g.Bt + (size_t)cur.pn * tstep + (size_t)(cur.pm >> 5) * g.bbatch;
    S.a_ready(cur);
    if constexpr (SP2) {
        PG8_STAGE(PG8_SB(0, 0), cB, voffB); PG8_STAGE(PG8_SB(0, 1), cB + hstep, voffB); PG8_STAGE(PG8_SA(0, 0), cA, voffA); PG8_STAGE(PG8_SA(0, 1), cA + hstep, voffA);
        if (wr == 1) PG8_BAR;
        PG8_WAIT_V(2); PG8_BAR;
        PG8_STAGE(PG8_SB(1, 0), cB + kstep, voffB); PG8_STAGE(PG8_SA(1, 0), cA + kstep, voffA); PG8_STAGE(PG8_SB(1, 1), cB + hstep + kstep, voffB);
        PG8_WAIT_V(6); PG8_BAR;
    } else {
        PG8_STAGE(PG8_SB(0, 0), cB, voffB); PG8_STAGE(PG8_SA(0, 0), cA, voffA); PG8_STAGE(PG8_SB(0, 1), cB + hstep, voffB); PG8_STAGE(PG8_SA(0, 1), cA + hstep, voffA);
        if (wr == 1) PG8_BAR;
        PG8_WAIT_V(4); PG8_BAR;
        PG8_STAGE(PG8_SB(1, 0), cB + kstep, voffB); PG8_STAGE(PG8_SA(1, 0), cA + kstep, voffA); PG8_STAGE(PG8_SB(1, 1), cB + hstep + kstep, voffB);
        PG8_WAIT_V(6); PG8_BAR;
    }
    for (;;) {
        const bool has_next = S.next(ui + 1, nxt);
        const char* nA = has_next ? (const char*)g.A + (size_t)nxt.pm * tstep : cA; const char* nB = has_next ? (const char*)g.Bt + (size_t)nxt.pn * tstep + (size_t)(nxt.pm >> 5) * g.bbatch : cB;
        for (int t = 0; t < nt; t += 2) {
            const bool last = (t == nt - 2);
            const char* a1 = cA + (size_t)(t + 1) * kstep;
            const char* a2 = last ? nA : cA + (size_t)(t + 2) * kstep; const char* b2 = last ? nB : cB + (size_t)(t + 2) * kstep;
            const char* a3 = a2 + kstep; const char* b3 = b2 + kstep;
            if (last && has_next) S.a_ready(nxt);
            if constexpr (SP2) {
            PG8_LDB(B0, 0, 0); PG8_LDB(B1, 0, 1); PG8_SCHED; PG8_LDA(At, 0, 0); PG8_STAGE(PG8_SA(1, 1), a1 + hstep, voffA);
            PG8_WAIT_V(8); PG8_WAIT_L(0); PG8_BAR; PG8_MMA(0, 0, At, B0); PG8_MMA(0, 1, At, B1); PG8_BAR; PG8_SCHED;
            PG8_LDA(At, 0, 1); PG8_STAGE(PG8_SB(0, 0), b2, voffB); PG8_STAGE(PG8_SB(0, 1), b2 + hstep, voffB); PG8_STAGE(PG8_SA(0, 0), a2, voffA);
            PG8_WAIT_V(8); PG8_WAIT_L(0); PG8_BAR; PG8_MMA(1, 0, At, B0); PG8_MMA(1, 1, At, B1); PG8_BAR; PG8_SCHED;
            PG8_LDB(B0, 1, 0); PG8_LDB(B1, 1, 1); PG8_SCHED; PG8_LDA(At, 1, 0); PG8_STAGE(PG8_SA(0, 1), a2 + hstep, voffA);
            PG8_WAIT_V(8); PG8_WAIT_L(0); PG8_BAR; PG8_MMA(0, 0, At, B0); PG8_MMA(0, 1, At, B1); PG8_BAR; PG8_SCHED;
            PG8_LDA(At, 1, 1); PG8_STAGE(PG8_SB(1, 0), b3, voffB); PG8_STAGE(PG8_SB(1, 1), b3 + hstep, voffB); PG8_STAGE(PG8_SA(1, 0), a3, voffA);
            PG8_WAIT_V(8); PG8_WAIT_L(0); PG8_BAR; PG8_MMA(1, 0, At, B0); PG8_MMA(1, 1, At, B1); PG8_BAR; PG8_SCHED;
            } else {
            PG8_LDB(B0, 0, 0); PG8_SCHED; PG8_LDA(At, 0, 0); PG8_STAGE(PG8_SA(1, 1), a1 + hstep, voffA);
            PG8_WAIT_L(8); PG8_BAR; PG8_WAIT_L(0); PG8_MMA(0, 0, At, B0); PG8_BAR; PG8_SCHED;
            PG8_LDB(B1, 0, 1); PG8_STAGE(PG8_SB(0, 0), b2, voffB);
            PG8_BAR; PG8_WAIT_L(0); PG8_MMA(0, 1, At, B1); PG8_BAR;
            PG8_LDA(At, 0, 1); PG8_STAGE(PG8_SA(0, 0), a2, voffA);
            PG8_BAR; PG8_WAIT_L(0); PG8_MMA(1, 0, At, B0); PG8_BAR; PG8_SCHED;
            PG8_STAGE(PG8_SB(0, 1), b2 + hstep, voffB);
            PG8_WAIT_V(6); PG8_BAR; PG8_MMA(1, 1, At, B1); PG8_BAR;
            PG8_LDB(B0, 1, 0); PG8_SCHED; PG8_LDA(At, 1, 0); PG8_STAGE(PG8_SA(0, 1), a2 + hstep, voffA);
            PG8_WAIT_L(8); PG8_BAR; PG8_WAIT_L(0); PG8_MMA(0, 0, At, B0); PG8_BAR; PG8_SCHED;
            PG8_LDB(B1, 1, 1); PG8_STAGE(PG8_SB(1, 0), b3, voffB);
            PG8_BAR; PG8_WAIT_L(0); PG8_MMA(0, 1, At, B1); PG8_BAR;
            PG8_LDA(At, 1, 1); PG8_STAGE(PG8_SA(1, 0), a3, voffA);
            PG8_BAR; PG8_WAIT_L(0); PG8_MMA(1, 0, At, B0); PG8_BAR; PG8_SCHED;
            PG8_STAGE(PG8_SB(1, 1), b3 + hstep, voffB);
            PG8_WAIT_V(6); PG8_BAR; PG8_MMA(1, 1, At, B1); PG8_BAR;
            }
        }
        if constexpr (ALIGN_EPI) { if (wr == 0) PG8_BAR; }
        if constexpr (!Epi::AFTER_DRAIN) { E(acc, cur, wr, wc, fr, fq); S.done(cur); }
        if (!has_next) break;
#pragma unroll
        for (int a = 0; a < 2; ++a)
#pragma unroll
            for (int b = 0; b < 2; ++b)
#pragma unroll
                for (int m = 0; m < 4; ++m)
#pragma unroll
                    for (int n = 0; n < 2; ++n) acc[a][b][m][n] = (f32x4){0.f, 0.f, 0.f, 0.f};
        cur = nxt; cA = nA; cB = nB; ++ui;
        if constexpr (ALIGN_EPI) { if (wr == 1) PG8_BAR; }
    }
    PG8_WAIT_V(0);
    if constexpr (!ALIGN_EPI) { if (wr == 0) PG8_BAR; }
    PG8_BAR;
    if constexpr (Epi::AFTER_DRAIN) { E.fused(acc, cur, wr, wc, fr, fq, lds, wid, lane); S.done(cur); }
#undef PG8_SA
#undef PG8_SB
#undef PG8_STAGE
#undef PG8_LDA
#undef PG8_LDB
#undef PG8_MMA
#undef PG8_WAIT_V
#undef PG8_WAIT_L
#undef PG8_BAR
#undef PG8_SCHED
}
}
#define MK_ONE_LAUNCH 1

constexpr int NB = 4, SEQ = 8192, T = NB * SEQ, D = 1024;
constexpr int NIN = 3584, DH = 512, HD = 128, NHH = 4, CHK = 64;
constexpr int NSEG = 16, SEGC = 8;
constexpr int CW = 31, CPAD = 15, DC = 512;
constexpr int PHEADS = 8, NQK = 2048, NSEL = 128;
constexpr float EPS = 1e-6f;
constexpr int NWAVES = 8, NTHR = 512;

constexpr size_t MiB = 1u << 20;
constexpr size_t WS_CTL = 0, CTL_ZERO_BYTES = 65536;
constexpr size_t WS_MOD = 1 * MiB, WS_FMOD = WS_MOD + 131072, WS_LB = WS_MOD + 196608, WS_BIASQ = WS_MOD + 262144;
constexpr size_t WS_WIN = 2 * MiB, WS_WOUT = 10 * MiB, WS_WQK = 12 * MiB;
constexpr size_t WS_UT = 16 * MiB, WS_WQKB = 24 * MiB, WS_VT = 48 * MiB;
constexpr size_t WS_BUFA = 80 * MiB;
constexpr size_t WS_BUFB = 144 * MiB;
constexpr size_t WS_SEG = 208 * MiB;
constexpr size_t WS_E = 208 * MiB, WS_W = 224 * MiB;
constexpr size_t WS_BIG = 240 * MiB;
constexpr size_t WS_SSQ = 496 * MiB;
constexpr size_t WS_SEGA = 498 * MiB;
constexpr size_t WS_RSTD = 499 * MiB;
constexpr size_t WS_END = 500 * MiB;
constexpr size_t WS_PACT = 240 * MiB;
constexpr size_t WS_Y = 368 * MiB;
constexpr int NSL = 8, CSL = 128;
constexpr float VSCALE = 16.0f;
constexpr float UQSCALE = 95.5f;
constexpr int NSLU = 4, CSLU = 256;
constexpr int CW_QU = 8192, CW_QV = 8192 + 64 * 16;
constexpr int CW_GV = 6400;
constexpr int CW_H1 = 6144;
constexpr int CW_BAR = 1024;

#ifndef LDSFILL
#define LDSFILL 0u
#endif
constexpr int LDS_BYTES = 155648;
constexpr int MISC_OFF = LDS_BYTES - 256;

#define GAS __attribute__((address_space(1)))
#define LAS __attribute__((address_space(3)))
typedef unsigned short bf16;
typedef unsigned v4u __attribute__((ext_vector_type(4)));
typedef unsigned v2u __attribute__((ext_vector_type(2)));
typedef float f32x4 __attribute__((ext_vector_type(4)));
typedef float f32x16 __attribute__((ext_vector_type(16)));
typedef short bf16x8 __attribute__((ext_vector_type(8)));
typedef float f32x2_ __attribute__((ext_vector_type(2)));

__device__ __forceinline__ float bf2f(unsigned h) { return __builtin_bit_cast(float, h << 16); }
__device__ __forceinline__ float bflo(unsigned u) { return __builtin_bit_cast(float, u << 16); }
__device__ __forceinline__ float bfhi(unsigned u) { return __builtin_bit_cast(float, u & 0xffff0000u); }
__device__ __forceinline__ unsigned f2bf(float f) { unsigned u = __builtin_bit_cast(unsigned, f); return (u + 0x7fffu + ((u >> 16) & 1u)) >> 16; }
__device__ __forceinline__ unsigned pk2(float lo, float hi) { return f2bf(lo) | (f2bf(hi) << 16); }
__device__ __forceinline__ unsigned cvtpk(float lo, float hi) { unsigned r; asm("v_cvt_pk_bf16_f32 %0, %1, %2" : "=v"(r) : "v"(lo), "v"(hi)); return r; }
__device__ __forceinline__ float sigmoidf_(float x) { return __builtin_amdgcn_rcpf(1.0f + __expf(-x)); }
#define DPP_ADD(s, ctrl) ((s) + __builtin_bit_cast(float, __builtin_amdgcn_update_dpp(0, __builtin_bit_cast(int, (s)), (ctrl), 0xF, 0xF, false)))
__device__ __forceinline__ float wave_sum(float v) {
    v = DPP_ADD(v, 0x128); v = DPP_ADD(v, 0x124); v = DPP_ADD(v, 0x122); v = DPP_ADD(v, 0x121);
    v += __builtin_bit_cast(float, __builtin_amdgcn_update_dpp(0, __builtin_bit_cast(int, v), 0x142, 0xA, 0xF, false));
    v += __builtin_bit_cast(float, __builtin_amdgcn_update_dpp(0, __builtin_bit_cast(int, v), 0x143, 0xC, 0xF, false));
    return __builtin_bit_cast(float, __builtin_amdgcn_readlane(__builtin_bit_cast(int, v), 63));
}

#define XB_TMO      128
#define XB_XCNT(j)  (256  + 64 * (j))
#define XB_XSUB(j)  (1280 + 64 * (j))
#define XB_XGEN(j)  (2304 + 64 * (j))
#define XB_TOP      3328
#define XB_TOPGEN   3392
#define XCD_BAR_WORDS 3456
#define XB_SPIN_CAP (1u << 18)
__device__ __forceinline__ unsigned xb_ld(unsigned* p)              { return __hip_atomic_load(p, __ATOMIC_RELAXED, __HIP_MEMORY_SCOPE_AGENT); }
__device__ __forceinline__ unsigned xb_add(unsigned* p, unsigned v) { return __hip_atomic_fetch_add(p, v, __ATOMIC_RELAXED, __HIP_MEMORY_SCOPE_AGENT); }
__device__ __forceinline__ unsigned xb_xcc_id() { return (unsigned)__builtin_amdgcn_s_getreg((3 << 11) | 20) & 0xFu; }
#define XB_SPIN(cond, bar) do { unsigned _sp = 0; while (cond) { __builtin_amdgcn_s_sleep(1); \
    if ((++_sp & 255u) == 0u) { if (xb_ld(&(bar)[XB_TMO])) break; if (_sp > XB_SPIN_CAP) { atomicAdd(&(bar)[XB_TMO], 1u); break; } } } } while (0)
struct XcdBarrier { unsigned* bar; unsigned x; volatile LAS unsigned* st; };
__device__ __forceinline__ XcdBarrier xcd_barrier_post(unsigned* bar, volatile LAS unsigned* st) {
    XcdBarrier b; b.bar = bar; b.x = xb_xcc_id(); b.st = st;
    if (threadIdx.x == 0) (void)xb_add(&bar[XB_XCNT(b.x)], 1u);
    return b;
}
__device__ __forceinline__ void xcd_barrier_complete(unsigned* bar, unsigned x, unsigned& nloc, unsigned& nx) {
    const unsigned G = gridDim.x * gridDim.y * gridDim.z;
    unsigned sum, cnt, mine, sp = 0u;
    for (;;) {
        sum = 0u; cnt = 0u; mine = 0u;
#pragma unroll
        for (unsigned j = 0; j < 16; ++j) { const unsigned c = xb_ld(&bar[XB_XCNT(j)]); sum += c; cnt += (c > 0u) ? 1u : 0u; mine = (j == x) ? c : mine; }
        if (sum == G) break;
        __builtin_amdgcn_s_sleep(1);
        if ((++sp & 255u) == 0u) { if (xb_ld(&bar[XB_TMO])) break; if (sp > XB_SPIN_CAP) { atomicAdd(&bar[XB_TMO], 1u); break; } }
    }
    nloc = mine > 0u ? mine : 1u; nx = cnt > 0u ? cnt : 1u;
}
__device__ __forceinline__ void xcd_barrier(const XcdBarrier& b) {
    asm volatile("s_waitcnt vmcnt(0)" ::: "memory");
    __syncthreads();
    if (threadIdx.x == 0) {
        unsigned* bar = b.bar;
        __builtin_amdgcn_s_waitcnt(0);
        unsigned nloc = b.st[0], nx = b.st[1];
        if (nloc == 0u) { xcd_barrier_complete(bar, b.x, nloc, nx); b.st[0] = nloc; b.st[1] = nx; }
        const unsigned old = xb_add(&bar[XB_XSUB(b.x)], 1u);
        const unsigned gen = old / nloc;
        if (old + 1u == (gen + 1u) * nloc) {
            __builtin_amdgcn_fence(__ATOMIC_RELEASE, "agent");
            asm volatile("s_waitcnt vmcnt(0)" ::: "memory");
            const unsigned og = xb_add(&bar[XB_TOP], 1u);
            const unsigned tg = og / nx;
            if (og + 1u == (tg + 1u) * nx) xb_add(&bar[XB_TOPGEN], 1u);
            else XB_SPIN(xb_ld(&bar[XB_TOPGEN]) == tg, bar);
            __builtin_amdgcn_fence(__ATOMIC_ACQUIRE, "agent");
            xb_add(&bar[XB_XGEN(b.x)], 1u);
            asm volatile("s_waitcnt vmcnt(0)" ::: "memory");
        } else {
            XB_SPIN(xb_ld(&bar[XB_XGEN(b.x)]) == gen, bar);
            __builtin_amdgcn_fence(__ATOMIC_ACQUIRE, "agent");
            asm volatile("s_waitcnt vmcnt(0)" ::: "memory");
        }
    }
    __syncthreads();
}

struct Args { const float* in[23]; float* out; unsigned char* ws; int ph_lo, ph_hi; };
struct Frame {
    LAS unsigned char* lds;
    int tid, lane, wave, G, bid;
    const Args* a;
    __device__ __forceinline__ const float* x() const { return a->in[0]; }
    __device__ __forceinline__ const float* c() const { return a->in[1]; }
    __device__ __forceinline__ const float* ada_w() const { return a->in[2]; }
    __device__ __forceinline__ const float* ada_b() const { return a->in[3]; }
    __device__ __forceinline__ const float* g_mix() const { return a->in[4]; }
    __device__ __forceinline__ const float* w_in() const { return a->in[5]; }
    __device__ __forceinline__ const float* lbg_f() const { return a->in[6]; }
    __device__ __forceinline__ const float* lbg_b() const { return a->in[7]; }
    __device__ __forceinline__ const float* hnorm_g() const { return a->in[8]; }
    __device__ __forceinline__ const float* conv_w() const { return a->in[9]; }
    __device__ __forceinline__ const float* conv_b() const { return a->in[10]; }
    __device__ __forceinline__ const float* cln_g() const { return a->in[11]; }
    __device__ __forceinline__ const float* cln_b() const { return a->in[12]; }
    __device__ __forceinline__ const float* w_out() const { return a->in[13]; }
    __device__ __forceinline__ const float* g_ffn() const { return a->in[14]; }
    __device__ __forceinline__ const float* wq() const { return a->in[15]; }
    __device__ __forceinline__ const float* keys1() const { return a->in[16]; }
    __device__ __forceinline__ const float* keys2() const { return a->in[17]; }
    __device__ __forceinline__ const float* utab() const { return a->in[18]; }
    __device__ __forceinline__ const float* vtab() const { return a->in[19]; }
    __device__ __forceinline__ const float* fada_w() const { return a->in[20]; }
    __device__ __forceinline__ const float* fada_b() const { return a->in[21]; }
    __device__ __forceinline__ const float* fnorm_g() const { return a->in[22]; }
    __device__ __forceinline__ float* out() const { return a->out; }
    __device__ __forceinline__ float* mod() const { return (float*)(a->ws + WS_MOD); }
    __device__ __forceinline__ float* fmod() const { return (float*)(a->ws + WS_FMOD); }
    __device__ __forceinline__ float* lb() const { return (float*)(a->ws + WS_LB); }
    __device__ __forceinline__ float* biasq() const { return (float*)(a->ws + WS_BIASQ); }
    __device__ __forceinline__ float* ssqp() const { return (float*)(a->ws + WS_SSQ); }
    __device__ __forceinline__ float* sega() const { return (float*)(a->ws + WS_SEGA); }
    __device__ __forceinline__ float* segu() const { return (float*)(a->ws + WS_SEG); }
    __device__ __forceinline__ float* of() const { return (float*)(a->ws + WS_BUFB); }
    __device__ __forceinline__ float* scores() const { return (float*)(a->ws + WS_BIG); }
    __device__ __forceinline__ float* wsel() const { return (float*)(a->ws + WS_W); }
    __device__ __forceinline__ int* esel() const { return (int*)(a->ws + WS_E); }
    __device__ __forceinline__ bf16* Win_t() const { return (bf16*)(a->ws + WS_WIN); }
    __device__ __forceinline__ bf16* Wout_t() const { return (bf16*)(a->ws + WS_WOUT); }
    __device__ __forceinline__ bf16* Wqk_t() const { return (bf16*)(a->ws + WS_WQK); }
    __device__ __forceinline__ bf16* Wqk_b() const { return (bf16*)(a->ws + WS_WQKB); }
    __device__ __forceinline__ bf16* Ub() const { return (bf16*)(a->ws + WS_UT); }
    __device__ __forceinline__ bf16* Vb() const { return (bf16*)(a->ws + WS_VT); }
    __device__ __forceinline__ bf16* bufA() const { return (bf16*)(a->ws + WS_BUFA); }
    __device__ __forceinline__ bf16* hg() const { return (bf16*)(a->ws + WS_BUFB); }
    __device__ __forceinline__ bf16* proj() const { return (bf16*)(a->ws + WS_BIG); }
    __device__ __forceinline__ float* coef() const { return (float*)(a->ws + WS_BUFA); }
    __device__ __forceinline__ float* rstd() const { return (float*)(a->ws + WS_RSTD); }
    __device__ __forceinline__ bf16* pact() const { return (bf16*)(a->ws + WS_PACT); }
    __device__ __forceinline__ bf16* ybuf() const { return (bf16*)(a->ws + WS_Y); }
    __device__ __forceinline__ unsigned char* U8() const { return (unsigned char*)(a->ws + WS_UT); }
    __device__ __forceinline__ unsigned char* V8() const { return (unsigned char*)(a->ws + WS_VT); }
    __device__ __forceinline__ unsigned* ctl() const { return (unsigned*)(a->ws + WS_CTL); }
};

__device__ __forceinline__ void p0_gemv(Frame& F) {
    LAS float* cact = (LAS float*)(F.lds);
    LAS float* red = (LAS float*)(F.lds + 16384);
    for (int i = F.tid; i < 4096; i += NTHR) { const float c = F.c()[i]; cact[i] = c * sigmoidf_(c); }
    __syncthreads();
    for (int item = F.bid; item < 128; item += F.G) {
        const int col0 = item * 64; const float* W; int N, cc;
        if (col0 < 6144) { W = F.ada_w(); N = 6144; cc = col0; } else { W = F.fada_w(); N = 2048; cc = col0 - 6144; }
        const float* wp = W + (size_t)(F.wave * 128) * N + cc + F.lane;
        float a0 = 0.f, a1 = 0.f, a2 = 0.f, a3 = 0.f;
#pragma unroll 32
        for (int k = 0; k < 128; ++k) { const float w = wp[(size_t)k * N]; const int kk = F.wave * 128 + k;
            a0 += cact[kk] * w; a1 += cact[1024 + kk] * w; a2 += cact[2048 + kk] * w; a3 += cact[3072 + kk] * w; }
        red[(F.wave * 4 + 0) * 64 + F.lane] = a0; red[(F.wave * 4 + 1) * 64 + F.lane] = a1; red[(F.wave * 4 + 2) * 64 + F.lane] = a2; red[(F.wave * 4 + 3) * 64 + F.lane] = a3;
        __syncthreads();
        if (F.tid < 256) { const int b = F.tid >> 6, l = F.tid & 63; float s = 0.f;
#pragma unroll
            for (int w = 0; w < 8; ++w) s += red[(w * 4 + b) * 64 + l];
            if (col0 < 6144) F.mod()[b * 6144 + cc + l] = s + F.ada_b()[cc + l]; else F.fmod()[b * 2048 + cc + l] = s + F.fada_b()[cc + l]; }
        __syncthreads();
    }
}
__device__ __forceinline__ void p0_transpose_item(const float* W, int K, int N, bf16* WT, LAS float* scr, int item, int lane) {
    const int nblk = N / 32, kb = item / nblk, nb = item % nblk, k0 = 64 * kb, n0 = 32 * nb;
#pragma unroll
    for (int i = 0; i < 32; ++i) { const int kk = 2 * i + (lane >> 5); scr[kk * 33 + (lane & 31)] = W[(size_t)(k0 + kk) * N + n0 + (lane & 31)]; }
    asm volatile("s_waitcnt lgkmcnt(0)" ::: "memory");
    const int c = lane & 7;
#pragma unroll
    for (int j = 0; j < 4; ++j) { const int n = (lane >> 3) + 8 * j; const LAS float* s = scr + (8 * c) * 33 + n;
        v4u o; o.x = pk2(s[0 * 33], s[1 * 33]); o.y = pk2(s[2 * 33], s[3 * 33]); o.z = pk2(s[4 * 33], s[5 * 33]); o.w = pk2(s[6 * 33], s[7 * 33]);
        *(v4u*)(WT + (size_t)(n0 + n) * K + k0 + 8 * c) = o; }
    asm volatile("s_waitcnt lgkmcnt(0)" ::: "memory");
}
__device__ __forceinline__ void p0_wqk_item(Frame& F, int item, LAS float* scr) {
    const int jq = item & 7, kb = (item >> 3) & 15, hh = item >> 7, h = hh >> 1, half = hh & 1;
    const float* keys = (half ? F.keys2() : F.keys1()) + (size_t)(jq * 16) * 128;
    const float* wtile = F.wq() + (size_t)(kb * 64) * 2048 + h * 256 + half * 128;
    LAS float* kL = scr + 1280;
    { f32x4 k4[8];
#pragma unroll
      for (int i = 0; i < 8; ++i) k4[i] = *(const f32x4*)(keys + (i * 64 + F.lane) * 4);
#pragma unroll
      for (int i = 0; i < 8; ++i) *(LAS f32x4*)(kL + (i * 64 + F.lane) * 4) = k4[i]; }
    float acc[16];
#pragma unroll
    for (int j = 0; j < 16; ++j) acc[j] = 0.f;
    f32x4 t4[4], n4[4];
#pragma unroll
    for (int i = 0; i < 4; ++i) t4[i] = *(const f32x4*)(wtile + (size_t)(16 * i + (F.lane >> 2)) * 2048 + 4 * (F.lane & 3));
    for (int d0 = 0; d0 < 128; d0 += 16) {
        if (d0 + 16 < 128) {
#pragma unroll
            for (int i = 0; i < 4; ++i) n4[i] = *(const f32x4*)(wtile + (size_t)(16 * i + (F.lane >> 2)) * 2048 + d0 + 16 + 4 * (F.lane & 3)); }
#pragma unroll
        for (int i = 0; i < 4; ++i) *(LAS f32x4*)(scr + (16 * i + (F.lane >> 2)) * 20 + 4 * (F.lane & 3)) = t4[i];
        asm volatile("s_waitcnt lgkmcnt(0)" ::: "memory");
#pragma unroll
        for (int dd = 0; dd < 16; dd += 4) { const f32x4 a = *(LAS const f32x4*)(scr + F.lane * 20 + dd);
#pragma unroll
            for (int j = 0; j < 16; ++j) { const f32x4 kp = *(LAS const f32x4*)(kL + j * 128 + d0 + dd); acc[j] += a[0] * kp[0] + a[1] * kp[1] + a[2] * kp[2] + a[3] * kp[3]; } }
        asm volatile("s_waitcnt lgkmcnt(0)" ::: "memory");
#pragma unroll
        for (int i = 0; i < 4; ++i) t4[i] = n4[i];
    }
    bf16* o = F.Wqk_t() + (size_t)(h * 256 + half * 128 + jq * 16) * 1024 + kb * 64 + F.lane;
#pragma unroll
    for (int j = 0; j < 16; ++j) o[(size_t)j * 1024] = (bf16)f2bf(acc[j]);
}
__device__ __forceinline__ void p0_prologue(Frame& F) {
    if (F.bid < 128) p0_gemv(F);
    asm volatile("s_waitcnt vmcnt(0)" ::: "memory");
    __syncthreads();
    if (F.tid == 0) { __builtin_amdgcn_fence(__ATOMIC_RELEASE, "agent"); asm volatile("s_waitcnt vmcnt(0)" ::: "memory"); (void)xb_add(F.ctl() + CW_GV, 1u); }
    if (F.bid == 128 % F.G) { const int i = F.tid;
        F.lb()[i] = __builtin_amdgcn_rcpf(1.0f + __expf(F.lbg_f()[512 + i] - F.lbg_f()[i]));
        F.lb()[512 + i] = __builtin_amdgcn_rcpf(1.0f + __expf(F.lbg_b()[512 + i] - F.lbg_b()[i])); }
    LAS float* scr = (LAS float*)(F.lds + 32768 + F.wave * 14336);
    const int gw = F.wave * F.G + F.bid, NGW = F.G * NWAVES;
    constexpr int I_QK = 2048, I_IN = (D / 64) * (NIN / 32), I_OUT = (D / 64) * (D / 32), I_TAB = 2 * 16384 / 4;
    constexpr int NITEMS = I_QK + I_IN + I_OUT + I_TAB;
    for (int it = gw; it < NITEMS; it += NGW) {
        int r = it;
        if (r < I_QK) { p0_wqk_item(F, r, scr); continue; } r -= I_QK;
        if (r < I_IN) { p0_transpose_item(F.w_in(), D, NIN, F.Win_t(), scr, r, F.lane); continue; } r -= I_IN;
        if (r < I_OUT) { p0_transpose_item(F.w_out(), D, D, F.Wout_t(), scr, r, F.lane); continue; } r -= I_OUT;
        { const int tab = r >= 4096, rr = (tab ? r - 4096 : r) * 4; const float* src = (tab ? F.vtab() : F.utab()) + (size_t)rr * 1024; unsigned char* dst = tab ? F.V8() : F.U8();
          const float sc = tab ? VSCALE : UQSCALE;
#pragma unroll
          for (int q = 0; q < 16; ++q) { const int row = rr + (q >> 2), qq = q & 3; const f32x4 v = *(const f32x4*)(src + (q >> 2) * 1024 + qq * 256 + 4 * F.lane) * sc;
              int pk;
              if (tab) { pk = __builtin_amdgcn_cvt_pk_fp8_f32(v[0], v[1], 0, false); pk = __builtin_amdgcn_cvt_pk_fp8_f32(v[2], v[3], pk, true); }
              else { int q0 = (int)__builtin_rintf(v[0]), q1 = (int)__builtin_rintf(v[1]), q2 = (int)__builtin_rintf(v[2]), q3 = (int)__builtin_rintf(v[3]);
                  q0 = q0 < -7 ? -7 : (q0 > 7 ? 7 : q0); q1 = q1 < -7 ? -7 : (q1 > 7 ? 7 : q1); q2 = q2 < -7 ? -7 : (q2 > 7 ? 7 : q2); q3 = q3 < -7 ? -7 : (q3 > 7 ? 7 : q3);
                  *(unsigned short*)(dst + ((size_t)qq * 16384 + row) * 128 + 2 * F.lane) = (unsigned short)((q0 & 0xf) | ((q1 & 0xf) << 4) | ((q2 & 0xf) << 8) | ((q3 & 0xf) << 12)); continue; }
              const int sl = 2 * qq + (F.lane >> 5);
              *(int*)(dst + ((size_t)sl * 16384 + row) * CSL + 4 * (F.lane & 31)) = pk; } }
    }
}

__device__ __forceinline__ void p1_norm(Frame& F) {
    const int gwc = F.bid * NWAVES + F.wave, NGW = F.G * NWAVES;
    for (int row0 = gwc * 16; row0 < T; row0 += NGW * 16) {
        const int b = row0 >> 13; const float* mb = F.mod() + b * 6144;
        f32x4 ca[4], cb[4];
#pragma unroll
        for (int j = 0; j < 4; ++j) { const int k = 256 * j + 4 * F.lane; const f32x4 g = *(const f32x4*)(F.g_mix() + k), s = *(const f32x4*)(mb + 1024 + k); ca[j] = g * (s + 1.0f); cb[j] = *(const f32x4*)(mb + k); }
#pragma unroll 4
        for (int r = 0; r < 16; ++r) { const float* xr = F.x() + (size_t)(row0 + r) * D;
            f32x4 v[4]; float ss = 0.f;
#pragma unroll
            for (int j = 0; j < 4; ++j) { v[j] = *(const f32x4*)(xr + 256 * j + 4 * F.lane); ss += v[j][0] * v[j][0] + v[j][1] * v[j][1] + v[j][2] * v[j][2] + v[j][3] * v[j][3]; }
            const float rstd = __builtin_amdgcn_rsqf(wave_sum(ss) * (1.0f / D) + EPS);
            bf16* o = F.bufA() + (size_t)(row0 + r) * D;
#pragma unroll
            for (int j = 0; j < 4; ++j) { const f32x4 y = v[j] * rstd * ca[j] + cb[j]; v2u w; w.x = pk2(y[0], y[1]); w.y = pk2(y[2], y[3]); *(v2u*)(o + 256 * j + 4 * F.lane) = w; } }
    }
}
__device__ __forceinline__ void p3_pre(Frame& F) {
    const int NGW = F.G * NWAVES;
    for (int i = F.bid * NTHR + F.tid; i < NQK * (D / 8); i += F.G * NTHR) { const int n = i >> 7, k0 = (i & 127) * 8;
        const v4u w = *(const v4u*)(F.Wqk_t() + (size_t)n * D + k0);
        const f32x4 g0 = *(const f32x4*)(F.g_ffn() + k0), g1 = *(const f32x4*)(F.g_ffn() + k0 + 4);
        f32x4 wa, wb; wa[0] = bflo(w[0]) * g0[0]; wa[1] = bfhi(w[0]) * g0[1]; wa[2] = bflo(w[1]) * g0[2]; wa[3] = bfhi(w[1]) * g0[3]; wb[0] = bflo(w[2]) * g1[0]; wb[1] = bfhi(w[2]) * g1[1]; wb[2] = bflo(w[3]) * g1[2]; wb[3] = bfhi(w[3]) * g1[3];
#pragma unroll
        for (int b = 0; b < NB; ++b) { const float* sc = F.mod() + b * 6144 + 4096 + k0; const f32x4 s0 = *(const f32x4*)sc + 1.0f, s1 = *(const f32x4*)(sc + 4) + 1.0f;
            const f32x4 pa = wa * s0, pb = wb * s1;
            v4u o; o.x = cvtpk(pa[0], pa[1]); o.y = cvtpk(pa[2], pa[3]); o.z = cvtpk(pb[0], pb[1]); o.w = cvtpk(pb[2], pb[3]);
            *(v4u*)(F.Wqk_b() + ((size_t)b * NQK + n) * D + k0) = o; } }
    const int gw = F.wave * F.G + F.bid;
    for (int n0 = gw * 8; n0 < NQK; n0 += NGW * 8) {
        float sv[4][16];
#pragma unroll
        for (int b = 0; b < 4; ++b) { const float* sh2 = F.mod() + b * 6144 + 3072;
#pragma unroll
            for (int i = 0; i < 8; ++i) { sv[b][i] = sh2[8 * F.lane + i]; sv[b][8 + i] = sh2[512 + 8 * F.lane + i]; } }
        v4u w0[8], w1[8];
#pragma unroll
        for (int q = 0; q < 8; ++q) { w0[q] = *(const v4u*)(F.Wqk_t() + (size_t)(n0 + q) * 1024 + 8 * F.lane); w1[q] = *(const v4u*)(F.Wqk_t() + (size_t)(n0 + q) * 1024 + 512 + 8 * F.lane); }
        float res[4] = {0.f, 0.f, 0.f, 0.f};
#pragma unroll
        for (int q = 0; q < 8; ++q) {
            float wv[16];
#pragma unroll
            for (int i = 0; i < 4; ++i) { wv[2 * i] = bflo(w0[q][i]); wv[2 * i + 1] = bfhi(w0[q][i]); wv[8 + 2 * i] = bflo(w1[q][i]); wv[8 + 2 * i + 1] = bfhi(w1[q][i]); }
#pragma unroll
            for (int b = 0; b < 4; ++b) { float sm = 0.f;
#pragma unroll
                for (int i = 0; i < 16; ++i) sm += wv[i] * sv[b][i];
                sm = wave_sum(sm); if (F.lane == q) res[b] = sm; } }
        if (F.lane < 8) {
#pragma unroll
            for (int b = 0; b < 4; ++b) F.biasq()[b * 2048 + n0 + F.lane] = res[b]; }
    }
}

__device__ __forceinline__ void conv_item(Frame& F, int item, const float (&cw)[CW], float cbias) {
    LAS bf16* hbuf = (LAS bf16*)(F.lds);
    LAS float* ybuf = (LAS float*)(F.lds + 65536);
    const int tok0 = item * 32, b = tok0 >> 13, t0 = tok0 & (SEQ - 1), c = F.tid;
#pragma unroll
    for (int k = 0; k < 8; ++k) { const int pi = F.tid + NTHR * k; if (pi < 62 * 64) { const int r = pi >> 6, ch = pi & 63, t = t0 - CPAD + r; v4u o = {0u, 0u, 0u, 0u};
            if (t >= 0 && t < SEQ) { const bf16* pr = F.proj() + (size_t)(b * SEQ + t) * NIN + 8 * ch; const v4u a = *(const v4u*)(pr + 2560), g = *(const v4u*)(pr + 3072);
#pragma unroll
                for (int i = 0; i < 4; ++i) o[i] = cvtpk(bflo(a[i]) * bflo(g[i]), bfhi(a[i]) * bfhi(g[i])); }
            *(LAS v4u*)(hbuf + r * 512 + 8 * ch) = o; } }
    __syncthreads();
    f32x2_ hp[31];
#pragma unroll
    for (int m = 0; m < 31; ++m) hp[m] = (f32x2_){bf2f(hbuf[(2 * m) * 512 + c]), bf2f(hbuf[(2 * m + 1) * 512 + c])};
    f32x2_ ce[15], co[15];
#pragma unroll
    for (int m = 0; m < 15; ++m) { ce[m] = (f32x2_){cw[2 * m], cw[2 * m + 1]}; co[m] = (f32x2_){cw[2 * m + 1], cw[2 * m + 2]}; }
#pragma unroll
    for (int e = 0; e < 16; ++e) {
        { f32x2_ a = {cbias, 0.f};
#pragma unroll
          for (int m = 0; m < 15; ++m) a += ce[m] * hp[e + m];
          ybuf[(2 * e) * 512 + c] = (a[0] + a[1]) + cw[30] * hp[e + 15][0]; }
        { f32x2_ a = {cbias, 0.f};
#pragma unroll
          for (int m = 0; m < 15; ++m) a += co[m] * hp[e + m + 1];
          ybuf[(2 * e + 1) * 512 + c] = (a[0] + a[1]) + cw[0] * hp[e][1]; } }
    __syncthreads();
#pragma unroll
    for (int q = 0; q < 4; ++q) { const int tt = F.wave * 4 + q;
        const f32x4 y0 = *(LAS const f32x4*)(ybuf + tt * 512 + 8 * F.lane), y1 = *(LAS const f32x4*)(ybuf + tt * 512 + 8 * F.lane + 4);
        const float mean = wave_sum((y0[0] + y0[1] + y0[2] + y0[3]) + (y1[0] + y1[1] + y1[2] + y1[3])) * (1.0f / DC);
        const f32x4 d0 = y0 - mean, d1 = y1 - mean;
        const float var = wave_sum((d0[0] * d0[0] + d0[1] * d0[1] + d0[2] * d0[2] + d0[3] * d0[3]) + (d1[0] * d1[0] + d1[1] * d1[1] + d1[2] * d1[2] + d1[3] * d1[3])) * (1.0f / DC);
        const float rstd = __builtin_amdgcn_rsqf(var + EPS);
        const f32x4 g0 = *(const f32x4*)(F.cln_g() + 8 * F.lane), g1 = *(const f32x4*)(F.cln_g() + 8 * F.lane + 4), b0 = *(const f32x4*)(F.cln_b() + 8 * F.lane), b1 = *(const f32x4*)(F.cln_b() + 8 * F.lane + 4);
        f32x4 z0 = d0 * rstd * g0 + b0, z1 = d1 * rstd * g1 + b1;
#pragma unroll
        for (int i = 0; i < 4; ++i) { z0[i] = z0[i] * sigmoidf_(z0[i]); z1[i] = z1[i] * sigmoidf_(z1[i]); }
        v4u w; w.x = cvtpk(z0[0], z0[1]); w.y = cvtpk(z0[2], z0[3]); w.z = cvtpk(z1[0], z1[1]); w.w = cvtpk(z1[2], z1[3]);
        *(v4u*)(F.bufA() + (size_t)(tok0 + tt) * D + 512 + 8 * F.lane) = w; }
    __syncthreads();
}

constexpr int PQ = 272, PT = 144;
constexpr int HL_QR = 0, HL_KR = 17408, HL_QE = 34816, HL_KET = 52224, HL_VT = 70656, HL_SCM = 89088, HL_ST = 98304, HL_PBLK = 133120  , HL_AV = 137216, HL_RS = 137728;
static_assert(HL_PBLK + 8 * 128 * 4 <= HL_AV && HL_AV + 512 <= HL_RS && HL_RS + 1024 <= 155648 - 256, "HGRN LDS map");
__device__ __forceinline__ bf16x8 ldf(LAS const unsigned char* base, int row, int pitch, int kbyte) { return *(LAS const bf16x8*)(base + row * pitch + kbyte); }
#define MFMA32(a, b, c) __builtin_amdgcn_mfma_f32_32x32x16_bf16((a), (b), (c), 0, 0, 0)

template <bool FULL>
__device__ __forceinline__ void hgrn_load(Frame& F, int b, int h, int dir, int chunk, unsigned (&rz)[8], unsigned (&rv)[8], unsigned (&rq)[8]) {
    const size_t tokbase = (size_t)b * SEQ + (size_t)chunk * CHK; const int zoff = dir ? 1024 : 512, c0 = 2 * F.lane;
#pragma unroll
    for (int i = 0; i < 8; ++i) { const int p = 8 * F.wave + i, tr = dir ? (63 - p) : p; const bf16* q = F.proj() + (tokbase + tr) * NIN + h * HD;
        rz[i] = *(const unsigned*)(q + zoff + c0); rv[i] = *(const unsigned*)(q + 1536 + c0); if (FULL) rq[i] = *(const unsigned*)(q + c0); }
}
template <bool FULL, int MODE>
__device__ __forceinline__ void hgrn_chunk(Frame& F, int b, int h, int dir, int chunk, int nchunk, f32x16 (&accS)[2], float lb0, float lb1, unsigned (&rz)[8], unsigned (&rv)[8], unsigned (&rq)[8]) {
    LAS unsigned char* lds = F.lds;
    int r = F.lane & 31, hh = F.lane >> 5, c0 = 2 * F.lane;
    asm volatile("" : "+v"(r), "+v"(hh), "+v"(c0));
    const int w = F.wave, rb = w;
    const size_t tokbase = (size_t)b * SEQ + (size_t)chunk * CHK;
    {
        const f32x2_ oml = {1.0f - lb0, 1.0f - lb1};
        f32x2_ f2[8], cf2[8], cr2[8];
        f32x2_ run = {1.f, 1.f};
#pragma unroll
        for (int i = 0; i < 8; ++i) { const f32x2_ kk = {bflo(rz[i]), bfhi(rz[i])}; f2[i] = 1.0f - oml * kk; run *= f2[i]; cf2[i] = run; }
        { f32x2_ q = {1.f, 1.f};
#pragma unroll
          for (int i = 7; i >= 0; --i) { cr2[i] = q; q *= f2[i]; } }
        LAS float* pblk = (LAS float*)(lds + HL_PBLK);
        *(LAS f32x2_*)(pblk + rb * 128 + c0) = run;
        __syncthreads();
        f32x2_ pre = {1.f, 1.f}, post = {1.f, 1.f}, mid = {1.f, 1.f};
        for (int q = 0; q < rb; ++q) pre *= *(LAS const f32x2_*)(pblk + q * 128 + c0);
        for (int q = rb + 1; q < 8; ++q) post *= *(LAS const f32x2_*)(pblk + q * 128 + c0);
        if (rb < 4) { for (int q = rb + 1; q < 4; ++q) mid *= *(LAS const f32x2_*)(pblk + q * 128 + c0); }
        else { for (int q = 4; q < rb; ++q) mid *= *(LAS const f32x2_*)(pblk + q * 128 + c0); }
        if (rb == 0) *(LAS f32x2_*)((LAS float*)(lds + HL_AV) + c0) = run * post;
        f32x2_ ke2[8];
#pragma unroll
        for (int i = 0; i < 8; ++i) ke2[i] = (1.0f - f2[i]) * cr2[i] * post;
        if (FULL) {
            if (rb < 4) {
#pragma unroll
                for (int i = 0; i < 8; ++i) { const int p = 8 * rb + i; const f32x2_ qs = {bflo(rq[i]), bfhi(rq[i])}, k2 = 1.0f - f2[i], G = cr2[i] * mid;
                    f32x2_ iG; iG[0] = __builtin_amdgcn_rcpf(G[0]); iG[1] = __builtin_amdgcn_rcpf(G[1]);
                    const f32x2_ qe = qs * pre * cf2[i], qr = qs * iG, kr = k2 * G;
                    *(LAS unsigned*)(lds + HL_QE + p * PQ + c0 * 2) = cvtpk(qe[0], qe[1]);
                    *(LAS unsigned*)(lds + HL_QR + p * PQ + c0 * 2) = cvtpk(qr[0], qr[1]);
                    *(LAS unsigned*)(lds + HL_KR + p * PQ + c0 * 2) = cvtpk(kr[0], kr[1]); }
            } else {
#pragma unroll
                for (int i = 0; i < 8; ++i) { const int p = 8 * rb + i; const f32x2_ qs = {bflo(rq[i]), bfhi(rq[i])}, k2 = 1.0f - f2[i], G = cf2[i] * mid;
                    f32x2_ iG; iG[0] = __builtin_amdgcn_rcpf(G[0]); iG[1] = __builtin_amdgcn_rcpf(G[1]);
                    const f32x2_ qe = qs * pre * cf2[i], qr = qs * G, kr = k2 * iG;
                    *(LAS unsigned*)(lds + HL_QE + p * PQ + c0 * 2) = cvtpk(qe[0], qe[1]);
                    *(LAS unsigned*)(lds + HL_QR + p * PQ + c0 * 2) = cvtpk(qr[0], qr[1]);
                    *(LAS unsigned*)(lds + HL_KR + p * PQ + c0 * 2) = cvtpk(kr[0], kr[1]); }
            }
        }
        v4u ka, kb, va, vb2;
        ka.x = cvtpk(ke2[0][0], ke2[1][0]); ka.y = cvtpk(ke2[2][0], ke2[3][0]); ka.z = cvtpk(ke2[4][0], ke2[5][0]); ka.w = cvtpk(ke2[6][0], ke2[7][0]);
        kb.x = cvtpk(ke2[0][1], ke2[1][1]); kb.y = cvtpk(ke2[2][1], ke2[3][1]); kb.z = cvtpk(ke2[4][1], ke2[5][1]); kb.w = cvtpk(ke2[6][1], ke2[7][1]);
        va.x = (rv[0] & 0xffffu) | (rv[1] << 16); va.y = (rv[2] & 0xffffu) | (rv[3] << 16); va.z = (rv[4] & 0xffffu) | (rv[5] << 16); va.w = (rv[6] & 0xffffu) | (rv[7] << 16);
        vb2.x = (rv[0] >> 16) | (rv[1] & 0xffff0000u); vb2.y = (rv[2] >> 16) | (rv[3] & 0xffff0000u); vb2.z = (rv[4] >> 16) | (rv[5] & 0xffff0000u); vb2.w = (rv[6] >> 16) | (rv[7] & 0xffff0000u);
        *(LAS v4u*)(lds + HL_KET + c0 * PT + 16 * rb) = ka; *(LAS v4u*)(lds + HL_KET + (c0 + 1) * PT + 16 * rb) = kb;
        *(LAS v4u*)(lds + HL_VT + c0 * PT + 16 * rb) = va; *(LAS v4u*)(lds + HL_VT + (c0 + 1) * PT + 16 * rb) = vb2;
    }
    if (nchunk >= 0) hgrn_load<FULL>(F, b, h, dir, nchunk, rz, rv, rq);
    __syncthreads();
    const int pbO = w & 1, vb = w >> 1;
    f32x16 accO, accU[2];
#pragma unroll
    for (int i = 0; i < 16; ++i) { accO[i] = 0.f; accU[0][i] = 0.f; accU[1][i] = 0.f; }
    if (FULL) {
        if (w < 3) { const int pbS = (w + 1) >> 1, sbS = (w == 2) ? 1 : 0; f32x16 sc;
#pragma unroll
            for (int i = 0; i < 16; ++i) sc[i] = 0.f;
#pragma unroll
            for (int s = 0; s < 8; ++s) sc = MFMA32(ldf(lds + HL_QR, pbS * 32 + r, PQ, 32 * s + 16 * hh), ldf(lds + HL_KR, sbS * 32 + r, PQ, 32 * s + 16 * hh), sc);
#pragma unroll
            for (int i = 0; i < 16; i += 2) { const int p = pbS * 32 + (i & 3) + 8 * (i >> 2) + 4 * hh, s = sbS * 32 + r;
                const unsigned pkd = cvtpk(s <= p ? sc[i] : 0.f, s <= p + 1 ? sc[i + 1] : 0.f);
                *(LAS bf16*)(lds + HL_SCM + p * PT + s * 2) = (bf16)pkd; *(LAS bf16*)(lds + HL_SCM + (p + 1) * PT + s * 2) = (bf16)(pkd >> 16); } }
        __builtin_amdgcn_sched_barrier(0);
#pragma unroll
        for (int s = 0; s < 8; ++s) accO = MFMA32(ldf(lds + HL_QE, pbO * 32 + r, PQ, 32 * s + 16 * hh), ldf(lds + HL_ST, vb * 32 + r, PQ, 32 * s + 16 * hh), accO);
        __builtin_amdgcn_sched_barrier(0);
    }
#pragma unroll
    for (int i = 0; i < 2; ++i) { const int db = 2 * (w & 1) + i;
#pragma unroll
        for (int s = 0; s < 4; ++s) accU[i] = MFMA32(ldf(lds + HL_VT, vb * 32 + r, PT, 32 * s + 16 * hh), ldf(lds + HL_KET, db * 32 + r, PT, 32 * s + 16 * hh), accU[i]); }
    __builtin_amdgcn_sched_barrier(0);
    if (FULL) __syncthreads();
    if (FULL) {
        const unsigned v = vb * 32 + r;
        const unsigned lrow = (MODE == 0 ? (unsigned)hh : (unsigned)(1 - hh)) * 4u;
        const size_t rbase = (MODE == 0) ? (tokbase + pbO * 32) : (tokbase + 63 - pbO * 32 - 4);
        const unsigned lo_of = lrow * DH + v, lo_pr = lrow * NIN + v, lo_a2 = lrow * D + v;
        float ofv[16]; unsigned gv[16];
        if (MODE == 1) {
#pragma unroll
            for (int i = 0; i < 16; ++i) { const int ci = (i & 3) + 8 * (i >> 2); ofv[i] = (F.of() + (rbase - ci) * DH + h * HD)[lo_of]; } }
        for (int sb = 0; sb <= pbO; ++sb)
#pragma unroll
            for (int s2 = 0; s2 < 2; ++s2) accO = MFMA32(ldf(lds + HL_SCM, pbO * 32 + r, PT, 64 * sb + 32 * s2 + 16 * hh), ldf(lds + HL_VT, vb * 32 + r, PT, 64 * sb + 32 * s2 + 16 * hh), accO);
        if (MODE == 0) {
#pragma unroll
            for (int i = 0; i < 16; ++i) { const int ci = (i & 3) + 8 * (i >> 2); (F.of() + (rbase + ci) * DH + h * HD)[lo_of] = accO[i]; }
        } else {
            LAS float* rs = (LAS float*)(lds + HL_RS);
#pragma unroll
            for (int i = 0; i < 16; ++i) { const int ci = (i & 3) + 8 * (i >> 2); gv[i] = (F.proj() + (rbase - ci) * NIN + 2048 + h * HD)[lo_pr]; }
            float ov[16];
            float ssr[16];
#pragma unroll
            for (int i = 0; i < 16; ++i) { ov[i] = accO[i] + ofv[i]; float ss = ov[i] * ov[i];
                ss = DPP_ADD(ss, 0x128); ss = DPP_ADD(ss, 0x124); ss = DPP_ADD(ss, 0x122); ss = DPP_ADD(ss, 0x121);
                ssr[i] = ss + __builtin_bit_cast(float, __builtin_amdgcn_update_dpp(0, __builtin_bit_cast(int, ss), 0x142, 0xA, 0xF, false)); }
            if (r == 16) {
#pragma unroll
                for (int i = 0; i < 16; ++i) { const int ci = (i & 3) + 8 * (i >> 2), p = pbO * 32 + ci + 4 * hh; rs[p * 4 + vb] = ssr[i]; } }
            __syncthreads();
            const float ng = F.hnorm_g()[h * HD + v];
#pragma unroll
            for (int i = 0; i < 16; ++i) { const int ci = (i & 3) + 8 * (i >> 2), p = pbO * 32 + ci + 4 * hh;
                const f32x4 q = *(LAS const f32x4*)(rs + p * 4);
                const float rstd = __builtin_amdgcn_rsqf((q[0] + q[1] + q[2] + q[3]) * (1.0f / HD) + EPS);
                const float g = bf2f(gv[i]);
                (F.bufA() + (rbase - ci) * D + h * HD)[lo_a2] = (bf16)cvtpk(ov[i] * rstd * ng * g, 0.f); }
        }
    }
    {
        const LAS float* av = (const LAS float*)(lds + HL_AV);
#pragma unroll
        for (int i = 0; i < 2; ++i) { const int db = 2 * (w & 1) + i; const float a = av[db * 32 + r];
#pragma unroll
            for (int j = 0; j < 16; j += 2) { const float s0 = accS[i][j] * a + accU[i][j], s1 = accS[i][j + 1] * a + accU[i][j + 1]; accS[i][j] = s0; accS[i][j + 1] = s1;
                if (FULL) { const int vv = vb * 32 + (j & 3) + 8 * (j >> 2) + 4 * hh; const unsigned pkd = cvtpk(s0, s1);
                    *(LAS bf16*)(lds + HL_ST + vv * PQ + (db * 32 + r) * 2) = (bf16)pkd; *(LAS bf16*)(lds + HL_ST + (vv + 1) * PQ + (db * 32 + r) * 2) = (bf16)(pkd >> 16); } } }
    }
    __syncthreads();
}
__device__ __forceinline__ void h1_item(Frame& F, int item) {
    const int seg = item & 15, dir = (item >> 4) & 1, h = (item >> 5) & 3, b = item >> 7;
    const float lb0 = F.lb()[dir * 512 + h * HD + 2 * F.lane], lb1 = F.lb()[dir * 512 + h * HD + 2 * F.lane + 1];
    f32x16 accS[2];
#pragma unroll
    for (int i = 0; i < 16; ++i) { accS[0][i] = 0.f; accS[1][i] = 0.f; }
    float atot = 1.f; const int col = F.tid & 127;
    unsigned rzA[8], rvA[8], rzB[8], rvB[8], rq[8];
#define H1CH(c) (seg * SEGC + (dir ? (SEGC - 1 - (c)) : (c)))
    hgrn_load<false>(F, b, h, dir, H1CH(0), rzA, rvA, rq); hgrn_load<false>(F, b, h, dir, H1CH(1), rzB, rvB, rq);
    for (int c = 0; c < SEGC; c += 2) {
        hgrn_chunk<false, 0>(F, b, h, dir, H1CH(c), (c + 2 < SEGC) ? H1CH(c + 2) : -1, accS, lb0, lb1, rzA, rvA, rq);
        atot *= ((const LAS float*)(F.lds + HL_AV))[col];
        hgrn_chunk<false, 0>(F, b, h, dir, H1CH(c + 1), (c + 3 < SEGC) ? H1CH(c + 3) : -1, accS, lb0, lb1, rzB, rvB, rq);
        atot *= ((const LAS float*)(F.lds + HL_AV))[col]; }
#undef H1CH
    if (F.tid < 128) F.sega()[(size_t)item * 128 + col] = atot;
    float* U = F.segu() + (size_t)item * 16384;
#pragma unroll
    for (int i = 0; i < 2; ++i)
#pragma unroll
        for (int j = 0; j < 16; j += 4) { f32x4 o; o[0] = accS[i][j]; o[1] = accS[i][j + 1]; o[2] = accS[i][j + 2]; o[3] = accS[i][j + 3]; ((f32x4*)(U + (i * 4 + (j >> 2)) * NTHR * 4))[F.tid] = o; }
}
__device__ __forceinline__ void h_scan(Frame& F) {
    for (int g = F.bid; g < NB * NHH * 2 * 8; g += F.G) {
        const int chain = g >> 3, k = g & 7, dir = chain & 1;
        const int aidx = (2 * (F.wave & 1) + (k >> 2)) * 32 + (F.lane & 31);
        float* U = F.segu() + (size_t)chain * NSEG * 16384 + (size_t)k * NTHR * 4 + F.tid * 4;
        const float* A = F.sega() + (size_t)chain * NSEG * 128 + aidx;
        f32x4 u[NSEG]; float av[NSEG];
#pragma unroll
        for (int q = 0; q < NSEG; ++q) { const int sg = dir ? (NSEG - 1 - q) : q; u[q] = *(const f32x4*)(U + (size_t)sg * 16384); av[q] = A[sg * 128]; }
        f32x4 S = {0.f, 0.f, 0.f, 0.f};
#pragma unroll
        for (int q = 0; q < NSEG; ++q) { const int sg = dir ? (NSEG - 1 - q) : q; *(f32x4*)(U + (size_t)sg * 16384) = S; S = S * av[q] + u[q]; }
    }
}
__device__ __forceinline__ void h2_init_state(Frame& F, int b, int h, int dir, int seg, f32x16 (&accS)[2]) {
    const int w = F.wave, r = F.lane & 31, hh = F.lane >> 5, vb = w >> 1;
    const float* U = F.segu() + (size_t)(((b * 4 + h) * 2 + dir) * NSEG + seg) * 16384;
#pragma unroll
    for (int k = 0; k < 8; ++k) { const f32x4 v = ((const f32x4*)(U + k * NTHR * 4))[F.tid]; const int i = k >> 2, j = (k & 3) * 4;
        accS[i][j] = v[0]; accS[i][j + 1] = v[1]; accS[i][j + 2] = v[2]; accS[i][j + 3] = v[3]; }
#pragma unroll
    for (int i = 0; i < 2; ++i) { const int db = 2 * (w & 1) + i;
#pragma unroll
        for (int j = 0; j < 16; ++j) { const int vv = vb * 32 + (j & 3) + 8 * (j >> 2) + 4 * hh; *(LAS bf16*)(F.lds + HL_ST + vv * PQ + (db * 32 + r) * 2) = (bf16)f2bf(accS[i][j]); } }
    __syncthreads();
}
__device__ __forceinline__ void h2_item(Frame& F, int item) {
    const int seg = item & 15, h = (item >> 4) & 3, b = item >> 6;
    f32x16 accS[2];
    unsigned rzA[8], rvA[8], rqA[8], rzB[8], rvB[8], rqB[8];
    { const float lb0 = F.lb()[h * HD + 2 * F.lane], lb1 = F.lb()[h * HD + 2 * F.lane + 1];
      const int c0 = seg * SEGC;
      hgrn_load<true>(F, b, h, 0, c0, rzA, rvA, rqA); hgrn_load<true>(F, b, h, 0, c0 + 1, rzB, rvB, rqB);
      h2_init_state(F, b, h, 0, seg, accS);
      for (int c = 0; c < SEGC; c += 2) {
          hgrn_chunk<true, 0>(F, b, h, 0, c0 + c, (c + 2 < SEGC) ? (c0 + c + 2) : -1, accS, lb0, lb1, rzA, rvA, rqA);
          hgrn_chunk<true, 0>(F, b, h, 0, c0 + c + 1, (c + 3 < SEGC) ? (c0 + c + 3) : -1, accS, lb0, lb1, rzB, rvB, rqB); } }
    asm volatile("s_waitcnt vmcnt(0)" ::: "memory");
    __syncthreads();
    { const float lb0 = F.lb()[512 + h * HD + 2 * F.lane], lb1 = F.lb()[512 + h * HD + 2 * F.lane + 1];
      const int cl = seg * SEGC + SEGC - 1;
      hgrn_load<true>(F, b, h, 1, cl, rzA, rvA, rqA); hgrn_load<true>(F, b, h, 1, cl - 1, rzB, rvB, rqB);
      h2_init_state(F, b, h, 1, seg, accS);
      for (int c = 0; c < SEGC; c += 2) {
          hgrn_chunk<true, 1>(F, b, h, 1, cl - c, (c + 2 < SEGC) ? (cl - c - 2) : -1, accS, lb0, lb1, rzA, rvA, rqA);
          hgrn_chunk<true, 1>(F, b, h, 1, cl - c - 1, (c + 3 < SEGC) ? (cl - c - 3) : -1, accS, lb0, lb1, rzB, rvB, rqB); } }
}

__device__ __forceinline__ unsigned f2key(float f) { return __builtin_bit_cast(unsigned, f); }
__device__ __forceinline__ float key2f(unsigned k) { return __builtin_bit_cast(float, k); }
__device__ __forceinline__ unsigned umax_(unsigned a, unsigned b) { unsigned r; asm("v_max_f32 %0, %1, %2" : "=v"(r) : "v"(a), "v"(b)); return r; }
__device__ __forceinline__ unsigned umin_(unsigned a, unsigned b) { unsigned r; asm("v_min_f32 %0, %1, %2" : "=v"(r) : "v"(a), "v"(b)); return r; }
__device__ __forceinline__ void sort16(unsigned (&a)[16]) {
#define CE_(i, j) { const unsigned x_ = a[i], y_ = a[j]; a[i] = umax_(x_, y_); a[j] = umin_(x_, y_); }
    CE_(0, 13) CE_(1, 12) CE_(2, 15) CE_(3, 14) CE_(4, 8) CE_(5, 6) CE_(7, 11) CE_(9, 10)
    CE_(0, 5) CE_(1, 7) CE_(2, 9) CE_(3, 4) CE_(6, 13) CE_(8, 14) CE_(10, 15) CE_(11, 12)
    CE_(0, 1) CE_(2, 3) CE_(4, 5) CE_(6, 8) CE_(7, 9) CE_(10, 11) CE_(12, 13) CE_(14, 15)
    CE_(0, 2) CE_(1, 3) CE_(4, 10) CE_(5, 11) CE_(6, 7) CE_(8, 9) CE_(12, 14) CE_(13, 15)
    CE_(1, 2) CE_(3, 12) CE_(4, 6) CE_(5, 7) CE_(8, 10) CE_(9, 11) CE_(13, 14)
    CE_(1, 4) CE_(2, 6) CE_(5, 8) CE_(7, 10) CE_(9, 13) CE_(11, 14)
    CE_(2, 4) CE_(3, 6) CE_(9, 12) CE_(11, 13)
    CE_(3, 5) CE_(6, 8) CE_(7, 9) CE_(10, 12)
    CE_(3, 4) CE_(5, 6) CE_(7, 8) CE_(9, 10) CE_(11, 12)
    CE_(6, 7) CE_(8, 9)
#undef CE_
}
__device__ __forceinline__ void merge16(unsigned (&a)[16], const unsigned (&b)[16]) {
#pragma unroll
    for (int i = 0; i < 16; ++i) a[i] = umax_(a[i], b[15 - i]);
#pragma unroll
    for (int j = 8; j > 0; j >>= 1)
#pragma unroll
        for (int i = 0; i < 16; ++i) { const int l = i ^ j; if (l > i) { const unsigned x = a[i], y = a[l]; a[i] = umax_(x, y); a[l] = umin_(x, y); } }
}
__device__ __forceinline__ unsigned dpp_swap1(unsigned v) { return (unsigned)__builtin_amdgcn_update_dpp(0, (int)v, 0xB1, 0xF, 0xF, false); }
__device__ __forceinline__ unsigned pick_byte(const unsigned (&pk)[4], unsigned a) {
    const unsigned wsel = a >> 2; unsigned v = wsel == 0 ? pk[0] : (wsel == 1 ? pk[1] : (wsel == 2 ? pk[2] : pk[3]));
    return (v >> ((a & 3u) * 8u)) & 0xffu;
}
__device__ __forceinline__ void topk_stage2(const unsigned (&top)[16], bool tab0, size_t item, int* esel, float* wsel) {
        float vO[16], vP[16]; unsigned iOpk[4] = {0u, 0u, 0u, 0u}, iPpk[4] = {0u, 0u, 0u, 0u};
#pragma unroll
        for (int i = 0; i < 16; ++i) { const unsigned t = top[i], tp = dpp_swap1(t);
            vO[i] = key2f(t & ~0x7fu); vP[i] = key2f(tp & ~0x7fu);
            iOpk[i >> 2] |= (127u - (t & 0x7fu)) << ((i & 3) * 8); iPpk[i >> 2] |= (127u - (tp & 0x7fu)) << ((i & 3) * 8); }
        unsigned R[16], G1[16], G2[16];
#define CAND(a, b) ((f2key(vO[a] + vP[b]) & ~0xffu) | (unsigned)(((a) << 4) | (b)))
#pragma unroll
        for (int i = 0; i < 16; ++i) R[i] = CAND(0, i);
        G1[0] = CAND(1, 0); G1[1] = CAND(1, 1); G1[2] = CAND(1, 2); G1[3] = CAND(1, 3); G1[4] = CAND(1, 4); G1[5] = CAND(1, 5); G1[6] = CAND(1, 6); G1[7] = CAND(1, 7);
        G1[8] = CAND(2, 0); G1[9] = CAND(2, 1); G1[10] = CAND(2, 2); G1[11] = CAND(2, 3); G1[12] = CAND(2, 4); G1[13] = CAND(3, 0); G1[14] = CAND(3, 1); G1[15] = CAND(3, 2);
        G2[0] = CAND(3, 3); G2[1] = CAND(4, 0); G2[2] = CAND(4, 1); G2[3] = CAND(4, 2); G2[4] = CAND(5, 0); G2[5] = CAND(5, 1); G2[6] = CAND(6, 0); G2[7] = CAND(6, 1);
        G2[8] = CAND(7, 0); G2[9] = CAND(7, 1); G2[10] = CAND(8, 0); G2[11] = CAND(9, 0); G2[12] = CAND(10, 0); G2[13] = CAND(11, 0); G2[14] = CAND(12, 0); G2[15] = CAND(13, 0);
        const unsigned g30 = CAND(14, 0), g31 = CAND(15, 0);
#undef CAND
        sort16(G1); sort16(G2);
        merge16(R, G1); merge16(R, G2);
        { const unsigned hi = umax_(g30, g31), lo = umin_(g30, g31); R[15] = umax_(R[15], hi); R[14] = umax_(R[14], lo);
#pragma unroll
          for (int j = 8; j > 0; j >>= 1)
#pragma unroll
              for (int i = 0; i < 16; ++i) { const int l = i ^ j; if (l > i) { const unsigned x = R[i], y = R[l]; R[i] = umax_(x, y); R[l] = umin_(x, y); } } }
        float sc[16], ex[16]; float sum = 0.f; unsigned eid[16];
        #pragma unroll
        for (int i = 0; i < 16; ++i) { sc[i] = key2f(R[i] & ~0xffu); const unsigned a = (R[i] >> 4) & 15u, bb = R[i] & 15u;
            const unsigned io = pick_byte(iOpk, a), ip = pick_byte(iPpk, bb);
            eid[i] = tab0 ? (io * 128u + ip) : (ip * 128u + io); }
#pragma unroll
        for (int i = 0; i < 16; ++i) { ex[i] = __expf(sc[i] - sc[0]); sum += ex[i]; }
        const float inv = 1.0f / sum;
        if (tab0) { const size_t o = item * 16;
#pragma unroll
            for (int q = 0; q < 4; ++q) { v4u ev; ev.x = eid[4 * q]; ev.y = eid[4 * q + 1]; ev.z = eid[4 * q + 2]; ev.w = eid[4 * q + 3]; *(v4u*)(esel + o + 4 * q) = ev;
                f32x4 wv; wv[0] = ex[4 * q] * inv; wv[1] = ex[4 * q + 1] * inv; wv[2] = ex[4 * q + 2] * inv; wv[3] = ex[4 * q + 3] * inv; *(f32x4*)(wsel + o + 4 * q) = wv; } }
}

struct EpiScoreTopk {
    static constexpr bool PERM = false, AFTER_DRAIN = false;
    float* scr; const float* ssqp; const float* biasq; float* rstd_out; int* esel; float* wsel;
    __device__ __forceinline__ void operator()(const f32x4 (&acc)[2][2][4][2], const pg8::Unit& u, int wr, int wc, int fr, int fq) const {
        asm volatile("" : "+v"(fr), "+v"(fq));
        const int rl0 = wr * 64 + fr, col0 = wc * 32 + 4 * fq, b = (u.pm * 256) >> 13;
        f32x4 bv[2][2];
#pragma unroll
        for (int bj = 0; bj < 2; ++bj)
#pragma unroll
            for (int n = 0; n < 2; ++n) bv[bj][n] = *(const f32x4*)(biasq + b * 2048 + u.pn * 256 + col0 + bj * 128 + n * 16);
#pragma unroll
        for (int ai = 0; ai < 2; ++ai)
#pragma unroll
            for (int m = 0; m < 4; ++m) { const int rl = rl0 + ai * 128 + m * 16, row = u.pm * 256 + rl;
                const f32x4 p0 = *(const f32x4*)(ssqp + (size_t)row * 4), p1 = *(const f32x4*)(ssqp + ((size_t)32768 + row) * 4), p2 = *(const f32x4*)(ssqp + ((size_t)65536 + row) * 4), p3 = *(const f32x4*)(ssqp + ((size_t)98304 + row) * 4);
                const float tot = (p0[0] + p0[1] + p0[2] + p0[3]) + (p1[0] + p1[1] + p1[2] + p1[3]) + (p2[0] + p2[1] + p2[2] + p2[3]) + (p3[0] + p3[1] + p3[2] + p3[3]);
                const float rstd = __builtin_amdgcn_rsqf(tot * (1.0f / 1024.0f) + 1e-6f);
                if (u.pn == 0 && wc == 0 && fq == 0) rstd_out[row] = rstd;
                float* blk = scr + (2 * wr + 4 * ai + (m >> 1)) * 8192 + 8 * wc * 256 + 32 * (m & 1) * 4;
                const unsigned loff4 = (unsigned)(2 * fr + 64 * fq);
#pragma unroll
                for (int bj = 0; bj < 2; ++bj)
#pragma unroll
                    for (int n = 0; n < 2; ++n) ((f32x4*)(blk + (4 * n * 64 + bj) * 4))[loff4] = acc[ai][bj][m][n] * rstd + bv[bj][n]; }
        asm volatile("s_waitcnt vmcnt(0)" ::: "memory");
        __builtin_amdgcn_s_barrier();
        asm volatile("" ::: "memory");
        int tid = threadIdx.x; asm volatile("" : "+v"(tid));
        const int rl = tid >> 1, tab = tid & 1;
        const float* bp = scr + __builtin_amdgcn_readfirstlane(tid >> 6) * 8192;
        const unsigned lo4 = (unsigned)(tid & 63) * 4u;
        unsigned top[16];
        f32x4 cur[4], nxt[4];
#pragma unroll
        for (int q = 0; q < 4; ++q) cur[q] = *(const f32x4*)(bp + q * 256 + lo4);
#pragma unroll
        for (int grp = 0; grp < 8; ++grp) { unsigned k[16];
            if (grp < 7) {
#pragma unroll
                for (int q = 0; q < 4; ++q) nxt[q] = *(const f32x4*)(bp + ((grp + 1) * 4 + q) * 256 + lo4); }
#pragma unroll
            for (int q = 0; q < 4; ++q) { const f32x4 v = cur[q];
#pragma unroll
                for (int e = 0; e < 4; ++e) { const int j = grp * 16 + q * 4 + e; k[q * 4 + e] = (f2key(v[e]) & ~0x7fu) | (unsigned)(127 - j); } }
            sort16(k);
            if (grp == 0) {
#pragma unroll
                for (int i = 0; i < 16; ++i) top[i] = k[i];
            } else merge16(top, k);
#pragma unroll
            for (int q = 0; q < 4; ++q) cur[q] = nxt[q];
            __builtin_amdgcn_sched_barrier(0); }
        topk_stage2(top, tab == 0, (size_t)u.pn * T + (size_t)(u.pm * 256 + rl), esel, wsel);
    }
};

__device__ __forceinline__ void cvt16(const v4u& u, f32x2_ (&f)[8]) {
#pragma unroll
    for (int i = 0; i < 4; ++i) { f[2 * i] = __builtin_amdgcn_cvt_pk_f32_fp8((int)u[i], false); f[2 * i + 1] = __builtin_amdgcn_cvt_pk_f32_fp8((int)u[i], true); }
}
constexpr int PITEM = 8, NPITEM = T / PITEM;
__device__ __forceinline__ int peer_next(unsigned* q, int lane) {
    int idx = 0; if (lane == 0) idx = (int)__hip_atomic_fetch_add(q, 1u, __ATOMIC_RELAXED, __HIP_MEMORY_SCOPE_AGENT);
    return __builtin_amdgcn_readfirstlane(idx);
}
#define PEER_SB() __builtin_amdgcn_sched_barrier(0)
#define DPP_IADD(s, ctrl) ((s) + __builtin_amdgcn_update_dpp(0, (s), (ctrl), 0xF, 0xF, false))
__device__ __forceinline__ void p8_dots(const v4u (&ud)[16], const int (&hh)[4], const int (&hl)[4], int c8, int& r0, int& r1) {
#pragma unroll
    for (int i = 0; i < 16; ++i) { int sh = 0, sl = 0;
#pragma unroll
        for (int d = 0; d < 4; ++d) { sh = __builtin_amdgcn_sdot8((int)ud[i][d], hh[d], sh, false); sl = __builtin_amdgcn_sdot8((int)ud[i][d], hl[d], sl, false); }
        int sm = (sh << 4) + sl;
        sm = DPP_IADD(sm, 0xB1); sm = DPP_IADD(sm, 0x4E); sm = DPP_IADD(sm, 0x141);
        if ((i & 1) == 0) r0 = (c8 == (i >> 1)) ? sm : r0; else r1 = (c8 == (i >> 1)) ? sm : r1; }
}
constexpr int PSLAB = 12288;
__device__ __forceinline__ void p8_item(Frame& F, int sl, int item, int nitem, bool filled, LAS unsigned char* slab) {
    const int c8 = F.lane & 7, q8 = F.lane >> 3, t0 = item * PITEM;
    const unsigned char* ub = F.U8() + (size_t)sl * 16384 * 128 + 16 * c8;
    LAS int* eL = (LAS int*)slab; LAS unsigned char* hL = (LAS unsigned char*)(slab + 4096);
    LAS float* qL = (LAS float*)(slab + 6144);
    v4u t4[4], h2[4]; float rs2[4]; f32x4 sA, sB, gA, gB;
#define P8_BLK_LOAD(tb) do { \
        { const float* sp_ = F.mod() + ((tb) >> 13) * 6144 + 3072 + sl * CSLU + 8 * (F.lane & 31); sA = *(const f32x4*)sp_; sB = *(const f32x4*)(sp_ + 4); \
          const float* gp_ = F.g_ffn() + sl * CSLU + 8 * (F.lane & 31); gA = *(const f32x4*)gp_ * (*(const f32x4*)(sp_ + 1024) + 1.0f); gB = *(const f32x4*)(gp_ + 4) * (*(const f32x4*)(sp_ + 1028) + 1.0f); } \
        _Pragma("unroll") for (int i = 0; i < 4; ++i) rs2[i] = F.rstd()[(tb) + 2 * i + (F.lane >> 5)]; \
        _Pragma("unroll") for (int i = 0; i < 4; ++i) t4[i] = __builtin_nontemporal_load((const v4u*)(F.esel() + ((size_t)(2 * i + (F.lane >> 5)) * T + (tb)) * 16) + (F.lane & 31)); \
        _Pragma("unroll") for (int i = 0; i < 4; ++i) h2[i] = __builtin_nontemporal_load((const v4u*)(F.hg() + (size_t)((tb) + 2 * i + (F.lane >> 5)) * D + sl * CSLU + 8 * (F.lane & 31))); } while (0)
#define DPP_FMAX(v, ctrl) __builtin_fmaxf((v), __builtin_bit_cast(float, __builtin_amdgcn_update_dpp(0, __builtin_bit_cast(int, (v)), (ctrl), 0xF, 0xF, false)))
#define P8_QN(x, k) { const int q_ = (int)__builtin_rintf((x) * qs_), lo_ = ((q_ + 8) & 15) - 8, hi_ = (q_ - lo_) >> 4; wl_ |= (unsigned)(lo_ & 15) << (4 * (k)); wh_ |= (unsigned)(hi_ & 15) << (4 * (k)); }
#define P8_BLK_STORE() do { _Pragma("unroll") for (int i = 0; i < 4; ++i) *(LAS v4u*)(eL + ((F.lane & 31) >> 2) * NSEL + (2 * i + (F.lane >> 5)) * 16 + 4 * (F.lane & 3)) = t4[i]; \
        _Pragma("unroll") for (int i = 0; i < 4; ++i) { const float r_ = rs2[i]; const v4u h_ = h2[i]; \
            const f32x4 ra_ = gA * r_, rb_ = gB * r_; \
            const float x0 = bflo(h_[0]) * ra_[0] + sA[0], x1 = bfhi(h_[0]) * ra_[1] + sA[1], x2 = bflo(h_[1]) * ra_[2] + sA[2], x3 = bfhi(h_[1]) * ra_[3] + sA[3]; \
            const float x4 = bflo(h_[2]) * rb_[0] + sB[0], x5 = bfhi(h_[2]) * rb_[1] + sB[1], x6 = bflo(h_[3]) * rb_[2] + sB[2], x7 = bfhi(h_[3]) * rb_[3] + sB[3]; \
            float m_ = __builtin_fmaxf(__builtin_fmaxf(__builtin_fmaxf(__builtin_fabsf(x0), __builtin_fabsf(x1)), __builtin_fmaxf(__builtin_fabsf(x2), __builtin_fabsf(x3))), \
                                       __builtin_fmaxf(__builtin_fmaxf(__builtin_fabsf(x4), __builtin_fabsf(x5)), __builtin_fmaxf(__builtin_fabsf(x6), __builtin_fabsf(x7)))); \
            m_ = DPP_FMAX(m_, 0x128); m_ = DPP_FMAX(m_, 0x124); m_ = DPP_FMAX(m_, 0x122); m_ = DPP_FMAX(m_, 0x121); m_ = __builtin_fmaxf(m_, __shfl_xor(m_, 16)); m_ = __builtin_fmaxf(m_, 1e-20f); \
            const float qs_ = 119.0f * __builtin_amdgcn_rcpf(m_); \
            const int tk_ = 2 * i + (F.lane >> 5); \
            if ((F.lane & 31) == 0) qL[tk_] = m_ * (1.0f / (119.0f * UQSCALE)); \
            unsigned wl_ = 0u, wh_ = 0u; P8_QN(x0, 0) P8_QN(x1, 1) P8_QN(x2, 2) P8_QN(x3, 3) P8_QN(x4, 4) P8_QN(x5, 5) P8_QN(x6, 6) P8_QN(x7, 7) \
            *(LAS unsigned*)(hL + tk_ * 256 + 4 * (F.lane & 31)) = wh_; *(LAS unsigned*)(hL + tk_ * 256 + 128 + 4 * (F.lane & 31)) = wl_; } \
        asm volatile("s_waitcnt lgkmcnt(0)" ::: "memory"); } while (0)
    if (!filled) { P8_BLK_LOAD(t0); P8_BLK_STORE(); }
    bf16* po = F.pact() + ((size_t)t0 * NSLU + sl) * NSEL + 16 * q8 + 2 * c8;
    v4u udA[16], udB[16];
#define P8_GATHER(dst, tt) do { v4u e_[4]; _Pragma("unroll") for (int k = 0; k < 4; ++k) e_[k] = *(LAS const v4u*)(eL + (tt) * NSEL + 16 * q8 + 4 * k); \
        _Pragma("unroll") for (int i = 0; i < 16; ++i) dst[i] = *(const v4u*)(ub + (size_t)e_[i >> 2][i & 3] * 128); } while (0)
#define P8_HN(tt) int hh[4], hl[4]; { const v4u a_ = *(LAS const v4u*)(hL + (tt) * 256 + 16 * c8), b_ = *(LAS const v4u*)(hL + (tt) * 256 + 128 + 16 * c8); \
        hh[0] = (int)a_[0]; hh[1] = (int)a_[1]; hh[2] = (int)a_[2]; hh[3] = (int)a_[3]; hl[0] = (int)b_[0]; hl[1] = (int)b_[1]; hl[2] = (int)b_[2]; hl[3] = (int)b_[3]; }
#define P8_OUT(tt, r0, r1) do { const float dq_ = qL[tt]; __builtin_nontemporal_store(cvtpk((float)(r0) * dq_, (float)(r1) * dq_), (unsigned*)(po + (size_t)(tt) * NSLU * NSEL)); } while (0)
    P8_GATHER(udA, 0);
    for (int tt = 0; tt < PITEM - 2; tt += 2) {
        P8_GATHER(udB, tt + 1);
        { P8_HN(tt); int r0 = 0, r1 = 0; p8_dots(udA, hh, hl, c8, r0, r1); P8_OUT(tt, r0, r1); }
        P8_GATHER(udA, tt + 2);
        { P8_HN(tt + 1); int r0 = 0, r1 = 0; p8_dots(udB, hh, hl, c8, r0, r1); P8_OUT(tt + 1, r0, r1); }
    }
    {
        P8_GATHER(udB, PITEM - 1);
        { P8_HN(PITEM - 2); int r0 = 0, r1 = 0; p8_dots(udA, hh, hl, c8, r0, r1); P8_OUT(PITEM - 2, r0, r1); }
        if (nitem >= 0) P8_BLK_LOAD(nitem * PITEM);
        { P8_HN(PITEM - 1); int r0 = 0, r1 = 0; p8_dots(udB, hh, hl, c8, r0, r1); P8_OUT(PITEM - 1, r0, r1); }
        if (nitem >= 0) P8_BLK_STORE();
    }
#undef P8_GATHER
#undef P8_HN
#undef P8_OUT
#undef P8_BLK_LOAD
#undef P8_BLK_STORE
#undef P8_QN
#undef DPP_FMAX
}
__device__ __forceinline__ void p8b_coef(Frame& F) {
    const int N8 = T * (NSEL / 8);
#pragma unroll 2
    for (int i = F.bid * NTHR + F.tid; i < N8; i += F.G * NTHR) { const size_t t = (size_t)(i >> 4); const int m = i & 15;
        const bf16* pp = F.pact() + t * NSLU * NSEL + 8 * m;
        v4u p4[NSLU];
#pragma unroll
        for (int q = 0; q < NSLU; ++q) p4[q] = __builtin_nontemporal_load((const v4u*)(pp + q * NSEL));
        const float* wp = F.wsel() + ((size_t)(m >> 1) * T + t) * 16 + 8 * (m & 1);
        const f32x4 w0 = *(const f32x4*)wp, w1 = *(const f32x4*)(wp + 4);
        float a[8];
#pragma unroll
        for (int e = 0; e < 4; ++e) { float lo = 0.f, hi = 0.f;
#pragma unroll
            for (int q = 0; q < NSLU; ++q) { lo += bflo(p4[q][e]); hi += bfhi(p4[q][e]); }
            a[2 * e] = lo; a[2 * e + 1] = hi; }
        f32x4 o0, o1;
#pragma unroll
        for (int e = 0; e < 4; ++e) { o0[e] = w0[e] * 0.5f * a[e] * (1.0f + erff(a[e] * 0.70710678f)); o1[e] = w1[e] * 0.5f * a[4 + e] * (1.0f + erff(a[4 + e] * 0.70710678f)); }
        float* cp = F.coef() + t * NSEL + 8 * m;
        *(f32x4*)cp = o0; *(f32x4*)(cp + 4) = o1; }
}
__device__ __forceinline__ void p9_token(const v4u (&vd)[16], LAS const float* cL, bf16* yo, LAS float* red, int lane, int c8, int q8) {
    f32x4 cc[4];
#pragma unroll
    for (int k = 0; k < 4; ++k) cc[k] = *(LAS const f32x4*)(cL + 16 * q8 + 4 * k);
    f32x2_ y[8];
#pragma unroll
    for (int k = 0; k < 8; ++k) y[k] = (f32x2_){0.f, 0.f};
#pragma unroll
    for (int i = 0; i < 16; ++i) { f32x2_ vf[8]; cvt16(vd[i], vf); const float c = cc[i >> 2][i & 3]; const f32x2_ c2 = {c, c};
#pragma unroll
        for (int k = 0; k < 8; ++k) y[k] += c2 * vf[k];
        PEER_SB(); }
#pragma unroll
    for (int k = 0; k < 4; ++k) { f32x4 o; o[0] = y[2 * k][0]; o[1] = y[2 * k][1]; o[2] = y[2 * k + 1][0]; o[3] = y[2 * k + 1][1]; *(LAS f32x4*)(red + q8 * 128 + 16 * c8 + 4 * k) = o; }
    asm volatile("s_waitcnt lgkmcnt(0)" ::: "memory");
    f32x2_ sm = {0.f, 0.f};
#pragma unroll
    for (int g = 0; g < 8; ++g) sm += *(LAS const f32x2_*)(red + g * 128 + 2 * lane);
    sm = sm * (1.0f / VSCALE);
    __builtin_nontemporal_store(cvtpk(sm[0], sm[1]), (unsigned*)(yo + 2 * lane));
    asm volatile("s_waitcnt lgkmcnt(0)" ::: "memory");
    PEER_SB();
}
__device__ __forceinline__ void p9_item(Frame& F, int sl, int item, int nitem, bool filled, LAS unsigned char* slab) {
    const int c8 = F.lane & 7, q8 = F.lane >> 3, t0 = item * PITEM;
    const unsigned char* vb = F.V8() + (size_t)sl * 16384 * CSL + 16 * c8;
    LAS int* eL = (LAS int*)slab; LAS float* cL = (LAS float*)(slab + 4096); LAS float* red = (LAS float*)(slab + 8192);
    v4u t4[4], c4[4];
#define P9_BLK_LOAD(tb) do { const v4u* cp_ = (const v4u*)(F.coef() + (size_t)(tb) * NSEL); \
        _Pragma("unroll") for (int i = 0; i < 4; ++i) { t4[i] = __builtin_nontemporal_load((const v4u*)(F.esel() + ((size_t)(2 * i + (F.lane >> 5)) * T + (tb)) * 16) + (F.lane & 31)); c4[i] = __builtin_nontemporal_load(cp_ + i * 64 + F.lane); } } while (0)
#define P9_BLK_STORE() do { _Pragma("unroll") for (int i = 0; i < 4; ++i) { *(LAS v4u*)(eL + ((F.lane & 31) >> 2) * NSEL + (2 * i + (F.lane >> 5)) * 16 + 4 * (F.lane & 3)) = t4[i]; *(LAS v4u*)(cL + (i * 64 + F.lane) * 4) = c4[i]; } \
        asm volatile("s_waitcnt lgkmcnt(0)" ::: "memory"); } while (0)
    if (!filled) { P9_BLK_LOAD(t0); P9_BLK_STORE(); }
    bf16* yo = F.ybuf() + (size_t)t0 * D + sl * CSL;
    v4u vdA[16], vdB[16];
#define P9_GATHER(dst, tt) do { v4u e_[4]; _Pragma("unroll") for (int k = 0; k < 4; ++k) e_[k] = *(LAS const v4u*)(eL + (tt) * NSEL + 16 * q8 + 4 * k); \
        _Pragma("unroll") for (int i = 0; i < 16; ++i) dst[i] = *(const v4u*)(vb + (size_t)e_[i >> 2][i & 3] * CSL); } while (0)
    P9_GATHER(vdA, 0);
    for (int tt = 0; tt < PITEM - 2; tt += 2) {
        P9_GATHER(vdB, tt + 1);
        p9_token(vdA, cL + tt * NSEL, yo + (size_t)tt * D, red, F.lane, c8, q8);
        P9_GATHER(vdA, tt + 2);
        p9_token(vdB, cL + (tt + 1) * NSEL, yo + (size_t)(tt + 1) * D, red, F.lane, c8, q8);
    }
    {
        P9_GATHER(vdB, PITEM - 1);
        p9_token(vdA, cL + (PITEM - 2) * NSEL, yo + (size_t)(PITEM - 2) * D, red, F.lane, c8, q8);
        if (nitem >= 0) P9_BLK_LOAD(nitem * PITEM);
        p9_token(vdB, cL + (PITEM - 1) * NSEL, yo + (size_t)(PITEM - 1) * D, red, F.lane, c8, q8);
        if (nitem >= 0) P9_BLK_STORE();
    }
#undef P9_GATHER
#undef P9_BLK_LOAD
#undef P9_BLK_STORE
}
template <int SIDE>
__device__ __forceinline__ void peer_phase(Frame& F0, int rep) {
    Frame F = F0; asm volatile("" : "+v"(F.lane));
    constexpr int NS = (SIDE == 0) ? NSLU : NSL;
    const int s0 = (int)(xb_xcc_id() & (unsigned)(NS - 1));
    unsigned* qbase = F.ctl() + (SIDE == 0 ? CW_QU : CW_QV) + rep * 64 * 32;
    LAS unsigned char* cf = F.lds + F.wave * PSLAB;
    for (int k = 0; k < NS; ++k) { const int sl = (s0 + k) & (NS - 1);
        int item = peer_next(qbase + 64 * sl, F.lane); bool filled = false;
        while (item < NPITEM) { int nitem = peer_next(qbase + 64 * sl, F.lane); if (nitem >= NPITEM) nitem = -1;
            if (SIDE == 0) p8_item(F, sl, item, nitem, filled, cf); else p9_item(F, sl, item, nitem, filled, cf);
            filled = nitem >= 0; item = nitem >= 0 ? nitem : NPITEM; } }
}
__device__ __forceinline__ void p10_final(Frame& F) {
    const int gwc = F.bid * NWAVES + F.wave, NGW = F.G * NWAVES;
    for (int row0 = gwc * 16; row0 < T; row0 += NGW * 16) {
        const int b = row0 >> 13; const float* mb = F.mod() + b * 6144 + 5120; const float* fm = F.fmod() + b * 2048;
        f32x4 g2[4], ca[4], cb[4];
#pragma unroll
        for (int j = 0; j < 4; ++j) { const int k = 256 * j + 4 * F.lane; g2[j] = *(const f32x4*)(mb + k); ca[j] = *(const f32x4*)(F.fnorm_g() + k) * (*(const f32x4*)(fm + 1024 + k) + 1.0f); cb[j] = *(const f32x4*)(fm + k); }
#pragma unroll 4
        for (int r = 0; r < 16; ++r) { float* hr = F.out() + (size_t)(row0 + r) * D; const bf16* yr = F.ybuf() + (size_t)(row0 + r) * D; const bf16* hb = F.hg() + (size_t)(row0 + r) * D;
            f32x4 z[4]; float ss = 0.f;
#pragma unroll
            for (int j = 0; j < 4; ++j) { const v2u hq = *(const v2u*)(hb + 256 * j + 4 * F.lane); f32x4 hv; hv[0] = bflo(hq[0]); hv[1] = bfhi(hq[0]); hv[2] = bflo(hq[1]); hv[3] = bfhi(hq[1]);
                const v2u yq = __builtin_nontemporal_load((const v2u*)(yr + 256 * j + 4 * F.lane)); f32x4 yv; yv[0] = bflo(yq[0]); yv[1] = bfhi(yq[0]); yv[2] = bflo(yq[1]); yv[3] = bfhi(yq[1]);
                z[j] = hv + g2[j] * yv; ss += z[j][0] * z[j][0] + z[j][1] * z[j][1] + z[j][2] * z[j][2] + z[j][3] * z[j][3]; }
            const float rstd = __builtin_amdgcn_rsqf(wave_sum(ss) * (1.0f / D) + EPS);
#pragma unroll
            for (int j = 0; j < 4; ++j) *(f32x4*)(hr + 256 * j + 4 * F.lane) = z[j] * rstd * ca[j] + cb[j]; }
    }
}

constexpr int NPHASE = 12;
__global__ void __launch_bounds__(NTHR, 2) fwd_kernel(Args args) {
    extern __shared__ __attribute__((aligned(16))) unsigned char lds_raw[];
    Frame F;
    F.lds = (LAS unsigned char*)lds_raw;
    F.tid = threadIdx.x; F.lane = F.tid & 63; F.wave = __builtin_amdgcn_readfirstlane(F.tid >> 6); F.G = gridDim.x; F.bid = blockIdx.x;
    unsigned char* ws = args.ws; F.a = &args;
    volatile LAS unsigned* misc = (volatile LAS unsigned*)(F.lds + MISC_OFF);
    if (F.tid < 64) misc[F.tid] = 0u;
    __syncthreads();
    const int lo = args.ph_lo, hi = args.ph_hi;
    const bool multi = (hi - lo) > 1;
    XcdBarrier bar; bar.bar = (unsigned*)(ws + WS_CTL) + CW_BAR; bar.x = 0; bar.st = nullptr;
    if (multi) bar = xcd_barrier_post((unsigned*)(ws + WS_CTL) + CW_BAR, misc + 8);
#ifndef PHMASK
#define PHMASK 0xfff
#endif
#define IN(k) (((PHMASK >> (k)) & 1) && lo <= (k) && (k) < hi)
#define SEAM(k) do { if (IN(k) && IN((k) + 1)) xcd_barrier(bar); } while (0)

#ifndef REPMASK
#define REPMASK 0
#endif
#define REP(k) (((REPMASK) >> (k)) & 1)
#define REPBAR(k) if (REP(k) && rep == 0) xcd_barrier(bar)
    if (IN(0)) p0_prologue(F);
    if (IN(0) && IN(1)) {
        if (F.tid == 0) { XB_SPIN(xb_ld(F.ctl() + CW_GV) < (unsigned)F.G, bar.bar); __builtin_amdgcn_fence(__ATOMIC_ACQUIRE, "agent"); asm volatile("s_waitcnt vmcnt(0)" ::: "memory"); }
        __syncthreads(); }
    if (IN(1)) p1_norm(F);
    SEAM(1);
    if (IN(2)) { { pg8::Gemm g{F.bufA(), F.Win_t(), T, NIN, D}; pg8::StaticOrder S; S.init(T, NIN, F.G, F.bid);
        pg8::EpiProj E{F.proj(), NIN};
        pg8::gemm_phase<pg8::EpiProj, pg8::StaticOrder, true, true>(F.lds, g, S, E); }
#if ((REPMASK) >> 2) & 1
        xcd_barrier(bar); { pg8::Gemm g{F.bufA(), F.Win_t(), T, NIN, D}; pg8::StaticOrder S; S.init(T, NIN, F.G, F.bid);
        pg8::EpiProj E{F.proj(), NIN};
        pg8::gemm_phase<pg8::EpiProj, pg8::StaticOrder, true, true>(F.lds, g, S, E); }
#endif
    } SEAM(2);
    if (IN(3)) { p3_pre(F);
      for (int rep = 0; rep <= REP(3); ++rep) {
        for (int it = F.bid; it < NB * NHH * 2 * NSEG; it += F.G) h1_item(F, it);
        asm volatile("s_waitcnt vmcnt(0)" ::: "memory");
        __syncthreads();
        if (F.tid == 0) { __builtin_amdgcn_fence(__ATOMIC_RELEASE, "agent"); asm volatile("s_waitcnt vmcnt(0)" ::: "memory"); (void)xb_add(F.ctl() + CW_H1, 1u); }
        float cw[CW];
#pragma unroll
        for (int j = 0; j < CW; ++j) cw[j] = F.conv_w()[j * DC + F.tid];
        const float cbias = F.conv_b()[F.tid];
        for (int it = F.bid; it < T / 32; it += F.G) conv_item(F, it, cw, cbias);
        if (F.tid == 0) { const unsigned tgt = (unsigned)F.G * (unsigned)(rep + 1); XB_SPIN(xb_ld(F.ctl() + CW_H1) < tgt, bar.bar); __builtin_amdgcn_fence(__ATOMIC_ACQUIRE, "agent"); asm volatile("s_waitcnt vmcnt(0)" ::: "memory"); }
        __syncthreads();
        h_scan(F);
        REPBAR(3); }
    } SEAM(3);
    if (IN(4)) { for (int rep = 0; rep <= REP(4); ++rep) { for (int it = F.bid; it < NB * NHH * NSEG; it += F.G) h2_item(F, it); REPBAR(4); } } SEAM(4);
    if (IN(5)) { { pg8::Gemm g{F.bufA(), F.Wout_t(), T, D, D}; pg8::StaticOrder S; S.init(T, D, F.G, F.bid);
        pg8::EpiOut E{F.x(), F.hg(), F.mod(), F.ssqp()};
        pg8::gemm_phase<pg8::EpiOut, pg8::StaticOrder, true, true>(F.lds, g, S, E); }
#if ((REPMASK) >> 5) & 1
        xcd_barrier(bar); { pg8::Gemm g{F.bufA(), F.Wout_t(), T, D, D}; pg8::StaticOrder S; S.init(T, D, F.G, F.bid);
        pg8::EpiOut E{F.x(), F.hg(), F.mod(), F.ssqp()};
        pg8::gemm_phase<pg8::EpiOut, pg8::StaticOrder, true, true>(F.lds, g, S, E); }
#endif
    } SEAM(5);
    if (IN(6)) { { pg8::Gemm g{F.hg(), F.Wqk_b(), T, NQK, D, (size_t)NQK * D * 2}; pg8::StaticOrder S; S.init(T, NQK, F.G, F.bid);
        EpiScoreTopk E{F.scores() + (size_t)F.bid * 65536, F.ssqp(), F.biasq(), F.rstd(), F.esel(), F.wsel()};
        pg8::gemm_phase<EpiScoreTopk, pg8::StaticOrder, true, true>(F.lds, g, S, E); }
    } SEAM(6);
    if (IN(8)) { for (int rep = 0; rep <= REP(8); ++rep) { peer_phase<0>(F, rep); REPBAR(8); } } SEAM(8);
    if (IN(9)) { for (int rep = 0; rep <= REP(9); ++rep) { p8b_coef(F); REPBAR(9); } } SEAM(9);
    if (IN(10)) { for (int rep = 0; rep <= REP(10); ++rep) { peer_phase<1>(F, rep); REPBAR(10); } } SEAM(10);
    if (IN(11)) { p10_final(F); }
#undef IN
#undef SEAM
}

#ifndef MK_ONE_LAUNCH
#define MK_ONE_LAUNCH 0
#endif
extern "C" void kernel_launch(void* const* d_in, const int* in_sizes, int n_in, void* d_out, int out_size, void* d_ws, size_t ws_size, hipStream_t stream) {
    static int grid = 0;
    if (grid == 0) {
        if (n_in != 23 || out_size != T * D || ws_size < WS_END) { fprintf(stderr, "kernel_launch: unexpected shapes (n_in %d, out %d, ws %zu)\n", n_in, out_size, ws_size); grid = -1; return; }
        int dev = 0, cus = 0, per_cu = 0;
        if (hipGetDevice(&dev) != hipSuccess || hipDeviceGetAttribute(&cus, hipDeviceAttributeMultiprocessorCount, dev) != hipSuccess) { grid = -1; return; }
        if (hipFuncSetAttribute((const void*)fwd_kernel, hipFuncAttributeMaxDynamicSharedMemorySize, LDS_BYTES) != hipSuccess) { fprintf(stderr, "kernel_launch: hipFuncSetAttribute failed\n"); grid = -1; return; }
        if (hipOccupancyMaxActiveBlocksPerMultiprocessor(&per_cu, (const void*)fwd_kernel, NTHR, LDS_BYTES) != hipSuccess || per_cu < 1) { fprintf(stderr, "kernel_launch: occupancy query reports %d\n", per_cu); }
        (void)hipGetLastError();
        grid = cus;
    }
    if (grid < 0) return;
    (void)hipMemsetAsync((char*)d_ws + WS_CTL, 0, CTL_ZERO_BYTES, stream);
    Args a{};
    for (int i = 0; i < 23; ++i) a.in[i] = (const float*)d_in[i];
    a.out = (float*)d_out; a.ws = (unsigned char*)d_ws;
#if MK_ONE_LAUNCH
    a.ph_lo = 0; a.ph_hi = NPHASE;
    hipLaunchKernelGGL(fwd_kernel, dim3(grid), dim3(NTHR), LDS_BYTES, stream, a);
#else
    for (int p = 0; p < NPHASE; ++p) { a.ph_lo = p; a.ph_hi = p + 1; hipLaunchKernelGGL(fwd_kernel, dim3(grid), dim3(NTHR), LDS_BYTES, stream, a); }
#endif
}
```

```cpp
#include <hip/hip_runtime.h>
#include <cstdio>
#include <cstdint>
namespace pg8 {
#define PG8_LAS __attribute__((address_space(3)))
typedef unsigned short bf16_t;
typedef short bf16x8 __attribute__((ext_vector_type(8)));
typedef float f32x4 __attribute__((ext_vector_type(4)));
typedef unsigned u32x4 __attribute__((ext_vector_type(4)));
constexpr int BM = 256, BK = 64, HALF = 128, HTB = HALF * BK * 2  , STAGE_BYTES = 8 * HTB, NXCD = 8, WGM = 8;

__host__ __device__ __forceinline__ int lds_byte(int r, int c) { const int st = (r >> 4) * 2 + (c >> 5), rr = r & 15, cc = c & 31, ob = rr * 64 + cc * 2; return st * 1024 + (ob ^ (((ob >> 9) & 1) << 5)); }
__host__ __device__ __forceinline__ void stage_rc(int b, int& R, int& C) { const int st = b / 1024, sb = b % 1024, swz = sb ^ (((sb >> 9) & 1) << 5); R = (st >> 1) * 16 + swz / 64; C = (st & 1) * 32 + (swz % 64) / 2; }
__host__ __device__ __forceinline__ int perm32(int rho) { const int n = rho >> 4, i = rho & 15; return 8 * (i >> 2) + 4 * n + (i & 3); }

struct Unit { int pm, pn; };
struct Gemm { const bf16_t* A; const bf16_t* Bt; int M, N, K; size_t bbatch = 0; };

struct StaticOrder {
    int nM, nN, nwg, G, c;
    __host__ __device__ void init(int M, int N, int G_, int c_) { nM = M / BM; nN = N / BM; nwg = nM * nN; G = G_; c = c_; }
    __host__ __device__ bool next(int i, Unit& u) const {
        const long L = (long)i * G + c; if (L >= nwg) return false;
        int wgid = (int)L; { const int q = nwg / NXCD, r = nwg % NXCD, xcd = wgid % NXCD, off = wgid / NXCD; wgid = (xcd < r ? xcd * (q + 1) : r * (q + 1) + (xcd - r) * q) + off; }
        const int nig = WGM * nN, gid = wgid / nig, fm = gid * WGM, gsz = (nM - fm) < WGM ? (nM - fm) : WGM;
        u.pm = fm + ((wgid % nig) % gsz); u.pn = (wgid % nig) / gsz; return true;
    }
    __device__ __forceinline__ void a_ready(const Unit&) const {}
    __device__ __forceinline__ void done(const Unit&) const {}
};
__device__ __forceinline__ unsigned cvt_pk_bf16(float lo, float hi) { unsigned r; asm volatile("v_cvt_pk_bf16_f32 %0, %1, %2" : "=v"(r) : "v"(lo), "v"(hi)); return r; }
typedef float f32x2 __attribute__((ext_vector_type(2)));
__device__ __forceinline__ f32x2 gelu_pk(f32x2 v) {
    const f32x2 av = __builtin_elementwise_abs(v), d = av * 0.2316418882f + 1.0f;
    f32x2 t; t.x = __builtin_amdgcn_rcpf(d.x); t.y = __builtin_amdgcn_rcpf(d.y);
    f32x2 q = t * 0.5307027145f + (-0.7265760135f); q = q * t + 0.7107068705f; q = q * t + (-0.142248368f); q = q * t + 0.127414796f; q = q * t;
    const f32x2 s = (v * v) * (-0.72134752044f);
    f32x2 e; e.x = __builtin_amdgcn_exp2f(s.x); e.y = __builtin_amdgcn_exp2f(s.y);
    const f32x2 m = v * (q * e), r = v - m;
    f32x2 o; o.x = v.x < 0.f ? m.x : r.x; o.y = v.y < 0.f ? m.y : r.y; return o;
}

template <int ACT  > struct EpiBf16 {
    static constexpr bool PERM = true, AFTER_DRAIN = false; static_assert(ACT == 0 || ACT == 1, "EpiBf16: ACT is 0 (none) or 1 (gelu_pk)");
    bf16_t* O; int ldc; const float* bias; int split_cols; size_t split_stride; float scale0;
    __device__ __forceinline__ void operator()(const f32x4 (&acc)[2][2][4][2], const Unit& u, int wr, int wc, int fr, int fq) const {
        const int row0 = u.pm * BM + wr * 64 + fr; int colt = u.pn * BM; bf16_t* base = O;
        float sc = 1.f; if (split_cols) { const int t = colt / split_cols; base += (size_t)t * split_stride; colt -= t * split_cols; if (t == 0) sc = scale0; }
        const int col0 = colt + wc * 32 + 8 * fq, bcol0 = u.pn * BM + wc * 32 + 8 * fq;
        f32x4 bv[2][2];
#pragma unroll
        for (int bj = 0; bj < 2; ++bj)
#pragma unroll
            for (int n = 0; n < 2; ++n) bv[bj][n] = bias ? *(const f32x4*)(bias + bcol0 + bj * HALF + 4 * n) : (f32x4){0.f, 0.f, 0.f, 0.f};
#pragma unroll
        for (int ai = 0; ai < 2; ++ai)
#pragma unroll
            for (int m = 0; m < 4; ++m) { bf16_t* rowp = base + (size_t)(row0 + ai * HALF + m * 16) * ldc + col0;
#pragma unroll
                for (int bj = 0; bj < 2; ++bj) { f32x4 v0 = acc[ai][bj][m][0] + bv[bj][0], v1 = acc[ai][bj][m][1] + bv[bj][1];
                    if (ACT == 1) { f32x2 a = gelu_pk((f32x2){v0[0], v0[1]}), b = gelu_pk((f32x2){v0[2], v0[3]}), c = gelu_pk((f32x2){v1[0], v1[1]}), d = gelu_pk((f32x2){v1[2], v1[3]});
                        v0 = (f32x4){a.x, a.y, b.x, b.y}; v1 = (f32x4){c.x, c.y, d.x, d.y}; }
                    v0 = v0 * sc; v1 = v1 * sc; u32x4 w; w.x = cvt_pk_bf16(v0[0], v0[1]); w.y = cvt_pk_bf16(v0[2], v0[3]); w.z = cvt_pk_bf16(v1[0], v1[1]); w.w = cvt_pk_bf16(v1[2], v1[3]);
                    *(u32x4*)(rowp + bj * HALF) = w; } }
    }
};

struct EpiOut {
    static constexpr bool PERM = true, AFTER_DRAIN = false;
    const float* X; bf16_t* HB; const float* mod; float* ssqp;
    __device__ __forceinline__ void operator()(const f32x4 (&acc)[2][2][4][2], const Unit& u, int wr, int wc, int fr, int fq) const {
        const int row0 = u.pm * BM + wr * 64 + fr, col0 = u.pn * BM + wc * 32 + 8 * fq;
        const int b = (u.pm * BM) >> 13;
        const float* mb = mod + b * 6144;
        f32x4 g1v[2][2];
#pragma unroll
        for (int bj = 0; bj < 2; ++bj)
#pragma unroll
            for (int n = 0; n < 2; ++n) g1v[bj][n] = *(const f32x4*)(mb + 2048 + col0 + bj * HALF + 4 * n);
#pragma unroll
        for (int ai = 0; ai < 2; ++ai)
#pragma unroll
            for (int m = 0; m < 4; ++m) { const int row = row0 + ai * HALF + m * 16; const size_t ro = (size_t)row * 1024 + col0; float ss = 0.f;
#pragma unroll
                for (int bj = 0; bj < 2; ++bj) {
                    const f32x4 x0 = *(const f32x4*)(X + ro + bj * HALF), x1 = *(const f32x4*)(X + ro + bj * HALF + 4);
                    const f32x4 h0 = x0 + g1v[bj][0] * acc[ai][bj][m][0], h1 = x1 + g1v[bj][1] * acc[ai][bj][m][1];
                    u32x4 hw; hw.x = cvt_pk_bf16(h0[0], h0[1]); hw.y = cvt_pk_bf16(h0[2], h0[3]); hw.z = cvt_pk_bf16(h1[0], h1[1]); hw.w = cvt_pk_bf16(h1[2], h1[3]);
                    *(u32x4*)(HB + ro + bj * HALF) = hw;
                    ss += h0[0] * h0[0] + h0[1] * h0[1] + h0[2] * h0[2] + h0[3] * h0[3] + h1[0] * h1[0] + h1[1] * h1[1] + h1[2] * h1[2] + h1[3] * h1[3]; }
                ss += __shfl_xor(ss, 16); ss += __shfl_xor(ss, 32);
                if (fq == 0) ssqp[((size_t)u.pn * 32768 + row) * 4 + wc] = ss; }
    }
};
struct EpiScore {
    static constexpr bool PERM = false, AFTER_DRAIN = false;
    float* S; const float* ssqp; const float* biasq; float* rstd_out;
    __device__ __forceinline__ void operator()(const f32x4 (&acc)[2][2][4][2], const Unit& u, int wr, int wc, int fr, int fq) const {
        const int row0 = u.pm * BM + wr * 64 + fr, col0 = u.pn * BM + wc * 32 + 4 * fq;
        const int b = (u.pm * BM) >> 13;
        f32x4 bv[2][2];
#pragma unroll
        for (int bj = 0; bj < 2; ++bj)
#pragma unroll
            for (int n = 0; n < 2; ++n) bv[bj][n] = *(const f32x4*)(biasq + b * 2048 + col0 + bj * HALF + n * 16);
#pragma unroll
        for (int ai = 0; ai < 2; ++ai)
#pragma unroll
            for (int m = 0; m < 4; ++m) { const int row = row0 + ai * HALF + m * 16;
                const f32x4 p0 = *(const f32x4*)(ssqp + (size_t)row * 4), p1 = *(const f32x4*)(ssqp + ((size_t)32768 + row) * 4), p2 = *(const f32x4*)(ssqp + ((size_t)65536 + row) * 4), p3 = *(const f32x4*)(ssqp + ((size_t)98304 + row) * 4);
                const float tot = (p0[0] + p0[1] + p0[2] + p0[3]) + (p1[0] + p1[1] + p1[2] + p1[3]) + (p2[0] + p2[1] + p2[2] + p2[3]) + (p3[0] + p3[1] + p3[2] + p3[3]);
                const float rstd = __builtin_amdgcn_rsqf(tot * (1.0f / 1024.0f) + 1e-6f);
                if (u.pn == 0 && wc == 0 && fq == 0) rstd_out[row] = rstd;
                float* rowp = S + (size_t)row * 2048 + col0;
#pragma unroll
                for (int bj = 0; bj < 2; ++bj)
#pragma unroll
                    for (int n = 0; n < 2; ++n) *(f32x4*)(rowp + bj * HALF + n * 16) = acc[ai][bj][m][n] * rstd + bv[bj][n]; }
    }
};

struct EpiProj {
    static constexpr bool PERM = true, AFTER_DRAIN = false;
    bf16_t* O; int ldc;
    __device__ __forceinline__ void operator()(const f32x4 (&acc)[2][2][4][2], const Unit& u, int wr, int wc, int fr, int fq) const {
        asm volatile("" : "+v"(fr), "+v"(fq));
        const int row0 = u.pm * BM + wr * 64 + fr, col0 = u.pn * BM + wc * 32 + 8 * fq;
        const int cls = u.pn >> 1;
        const bool ident = (cls == 3) || (cls == 5), mulx = (cls == 0) || (cls == 4);
        const float sgn = (cls == 1 || cls == 2) ? 1.4426950408889634f : -1.4426950408889634f;
#pragma unroll
        for (int ai = 0; ai < 2; ++ai)
#pragma unroll
            for (int m = 0; m < 4; ++m) { bf16_t* rowp = O + (size_t)(row0 + ai * HALF + m * 16) * ldc + col0;
#pragma unroll
                for (int bj = 0; bj < 2; ++bj) { f32x4 v0 = acc[ai][bj][m][0], v1 = acc[ai][bj][m][1];
                    if (!ident) {
#pragma unroll
                        for (int j = 0; j < 4; ++j) { const float r0 = __builtin_amdgcn_rcpf(1.0f + __builtin_amdgcn_exp2f(sgn * v0[j])), r1 = __builtin_amdgcn_rcpf(1.0f + __builtin_amdgcn_exp2f(sgn * v1[j]));
                            v0[j] = mulx ? v0[j] * r0 : r0; v1[j] = mulx ? v1[j] * r1 : r1; } }
                    u32x4 w; w.x = cvt_pk_bf16(v0[0], v0[1]); w.y = cvt_pk_bf16(v0[2], v0[3]); w.z = cvt_pk_bf16(v1[0], v1[1]); w.w = cvt_pk_bf16(v1[2], v1[3]);
                    *(u32x4*)(rowp + bj * HALF) = w; } }
    }
};
template <class Epi, class Sched, bool ALIGN_EPI = false, bool SP2 = false>
__device__ __forceinline__ void gemm_phase(PG8_LAS unsigned char* lds, const Gemm g, const Sched& S, const Epi& E) {
    const int tid = threadIdx.x, wid = __builtin_amdgcn_readfirstlane(tid >> 6), lane = tid & 63, wr = wid >> 2, wc = wid & 3, fr = lane & 15, fq = lane >> 4;
    const int K = g.K, nt = K / BK;
    unsigned voffA[2], voffB[2];
#pragma unroll
    for (int i = 0; i < 2; ++i) { int R, C; stage_rc(tid * 16 + i * 8192, R, C); const int Rb = Epi::PERM ? ((R & ~31) + perm32(R & 31)) : R;
        voffA[i] = (unsigned)(R * K + C) * 2u; voffB[i] = (unsigned)(Rb * K + C) * 2u; }
    const size_t kstep = (size_t)(BK * 2);
    const size_t hstep = (size_t)HALF * K * 2;
    const size_t tstep = 2 * hstep;
    const unsigned ldsw = (unsigned)wid * 1024u;
    const int aoff = lds_byte(wr * 64 + fr, fq * 8), boff = lds_byte(wc * 32 + fr, fq * 8);
#define PG8_SA(b, h) (((b) * 2 + (h)) * HTB)
#define PG8_SB(b, h) ((4 + (b) * 2 + (h)) * HTB)
#define PG8_STAGE(bufoff, gbase, voff) do { _Pragma("unroll") for (int _i = 0; _i < 2; ++_i) \
        __builtin_amdgcn_global_load_lds((const unsigned*)((const char*)(gbase) + (voff)[_i]), (PG8_LAS unsigned*)(lds + (bufoff) + ldsw + _i * 8192), 16, 0, 0); } while (0)
#define PG8_LDA(dst, b, h) do { _Pragma("unroll") for (int m = 0; m < 4; ++m) _Pragma("unroll") for (int k = 0; k < 2; ++k) dst[m][k] = *(const PG8_LAS bf16x8*)(lds + PG8_SA(b, h) + aoff + m * 2048 + k * 1024); } while (0)
#define PG8_LDB(dst, b, h) do { _Pragma("unroll") for (int n = 0; n < 2; ++n) _Pragma("unroll") for (int k = 0; k < 2; ++k) dst[n][k] = *(const PG8_LAS bf16x8*)(lds + PG8_SB(b, h) + boff + n * 2048 + k * 1024); } while (0)
#define PG8_MMA(ai, bj, At, Bt) do { __builtin_amdgcn_s_setprio(1); _Pragma("unroll") for (int m = 0; m < 4; ++m) _Pragma("unroll") for (int n = 0; n < 2; ++n) _Pragma("unroll") for (int k = 0; k < 2; ++k) \
        acc[ai][bj][m][n] = __builtin_amdgcn_mfma_f32_16x16x32_bf16(Bt[n][k], At[m][k], acc[ai][bj][m][n], 0, 0, 0); __builtin_amdgcn_s_setprio(0); } while (0)
#define PG8_WAIT_V(n) asm volatile("s_waitcnt vmcnt(" #n ")" ::: "memory")
#define PG8_WAIT_L(n) asm volatile("s_waitcnt lgkmcnt(" #n ")" ::: "memory")
#define PG8_BAR __builtin_amdgcn_s_barrier()
#define PG8_SCHED __builtin_amdgcn_sched_barrier(0)
    Unit cur, nxt; int ui = 0;
    if (!S.next(0, cur)) return;
    f32x4 acc[2][2][4][2];
#pragma unroll
    for (int a = 0; a < 2; ++a)
#pragma unroll
        for (int b = 0; b < 2; ++b)
#pragma unroll
            for (int m = 0; m < 4; ++m)
#pragma unroll
                for (int n = 0; n < 2; ++n) acc[a][b][m][n] = (f32x4){0.f, 0.f, 0.f, 0.f};
    bf16x8 At[4][2], B0[2][2], B1[2][2];
    const char* cA = (const char*)g.A + (size_t)cur.pm * tstep; const char* cB = (const char*)g.Bt + (size_t)cur.pn * tstep + (size_t)(cur.pm >> 5) * g.bbatch;
    S.a_ready(cur);
    if constexpr (SP2) {
        PG8_STAGE(PG8_SB(0, 0), cB, voffB); PG8_STAGE(PG8_SB(0, 1), cB + hstep, voffB); PG8_STAGE(PG8_SA(0, 0), cA, voffA); PG8_STAGE(PG8_SA(0, 1), cA + hstep, voffA);
        if (wr == 1) PG8_BAR;
        PG8_WAIT_V(2); PG8_BAR;
        PG8_STAGE(PG8_SB(1, 0), cB + kstep, voffB); PG8_STAGE(PG8_SA(1, 0), cA + kstep, voffA); PG8_STAGE(PG8_SB(1, 1), cB + hstep + kstep, voffB);
        PG8_WAIT_V(6); PG8_BAR;
    } else {
        PG8_STAGE(PG8_SB(0, 0), cB, voffB); PG8_STAGE(PG8_SA(0, 0), cA, voffA); PG8_STAGE(PG8_SB(0, 1), cB + hstep, voffB); PG8_STAGE(PG8_SA(0, 1), cA + hstep, voffA);
        if (wr == 1) PG8_BAR;
        PG8_WAIT_V(4); PG8_BAR;
        PG8_STAGE(PG8_SB(1, 0), cB + kstep, voffB); PG8_STAGE(PG8_SA(1, 0), cA + kstep, voffA); PG8_STAGE(PG8_SB(1, 1), cB + hstep + kstep, voffB);
        PG8_WAIT_V(6); PG8_BAR;
    }
    for (;;) {
        const bool has_next = S.next(ui + 1, nxt);
        const char* nA = has_next ? (const char*)g.A + (size_t)nxt.pm * tstep : cA; const char* nB = has_next ? (const char*)g.Bt + (size_t)nxt.pn * tstep + (size_t)(nxt.pm >> 5) * g.bbatch : cB;
        for (int t = 0; t < nt; t += 2) {
            const bool last = (t == nt - 2);
            const char* a1 = cA + (size_t)(t + 1) * kstep;
            const char* a2 = last ? nA : cA + (size_t)(t + 2) * kstep; const char* b2 = last ? nB : cB + (size_t)(t + 2) * kstep;
            const char* a3 = a2 + kstep; const char* b3 = b2 + kstep;
            if (last && has_next) S.a_ready(nxt);
            if constexpr (SP2) {
            PG8_LDB(B0, 0, 0); PG8_LDB(B1, 0, 1); PG8_SCHED; PG8_LDA(At, 0, 0); PG8_STAGE(PG8_SA(1, 1), a1 + hstep, voffA);
            PG8_WAIT_V(8); PG8_WAIT_L(0); PG8_BAR; PG8_MMA(0, 0, At, B0); PG8_MMA(0, 1, At, B1); PG8_BAR; PG8_SCHED;
            PG8_LDA(At, 0, 1); PG8_STAGE(PG8_SB(0, 0), b2, voffB); PG8_STAGE(PG8_SB(0, 1), b2 + hstep, voffB); PG8_STAGE(PG8_SA(0, 0), a2, voffA);
            PG8_WAIT_V(8); PG8_WAIT_L(0); PG8_BAR; PG8_MMA(1, 0, At, B0); PG8_MMA(1, 1, At, B1); PG8_BAR; PG8_SCHED;
            PG8_LDB(B0, 1, 0); PG8_LDB(B1, 1, 1); PG8_SCHED; PG8_LDA(At, 1, 0); PG8_STAGE(PG8_SA(0, 1), a2 + hstep, voffA);
            PG8_WAIT_V(8); PG8_WAIT_L(0); PG8_BAR; PG8_MMA(0, 0, At, B0); PG8_MMA(0, 1, At, B1); PG8_BAR; PG8_SCHED;
            PG8_LDA(At, 1, 1); PG8_STAGE(PG8_SB(1, 0), b3, voffB); PG8_STAGE(PG8_SB(1, 1), b3 + hstep, voffB); PG8_STAGE(PG8_SA(1, 0), a3, voffA);
            PG8_WAIT_V(8); PG8_WAIT_L(0); PG8_BAR; PG8_MMA(1, 0, At, B0); PG8_MMA(1, 1, At, B1); PG8_BAR; PG8_SCHED;
            } else {
            PG8_LDB(B0, 0, 0); PG8_SCHED; PG8_LDA(At, 0, 0); PG8_STAGE(PG8_SA(1, 1), a1 + hstep, voffA);
            PG8_WAIT_L(8); PG8_BAR; PG8_WAIT_L(0); PG8_MMA(0, 0, At, B0); PG8_BAR; PG8_SCHED;
            PG8_LDB(B1, 0, 1); PG8_STAGE(PG8_SB(0, 0), b2, voffB);
            PG8_BAR; PG8_WAIT_L(0); PG8_MMA(0, 1, At, B1); PG8_BAR;
            PG8_LDA(At, 0, 1); PG8_STAGE(PG8_SA(0, 0), a2, voffA);
            PG8_BAR; PG8_WAIT_L(0); PG8_MMA(1, 0, At, B0); PG8_BAR; PG8_SCHED;
            PG8_STAGE(PG8_SB(0, 1), b2 + hstep, voffB);
            PG8_WAIT_V(6); PG8_BAR; PG8_MMA(1, 1, At, B1); PG8_BAR;
            PG8_LDB(B0, 1, 0); PG8_SCHED; PG8_LDA(At, 1, 0); PG8_STAGE(PG8_SA(0, 1), a2 + hstep, voffA);
            PG8_WAIT_L(8); PG8_BAR; PG8_WAIT_L(0); PG8_MMA(0, 0, At, B0); PG8_BAR; PG8_SCHED;
            PG8_LDB(B1, 1, 1); PG8_STAGE(PG8_SB(1, 0), b3, voffB);
            PG8_BAR; PG8_WAIT_L(0); PG8_MMA(0, 1, At, B1); PG8_BAR;
            PG8_LDA(At, 1, 1); PG8_STAGE(PG8_SA(1, 0), a3, voffA);
            PG8_BAR; PG8_WAIT_L(0); PG8_MMA(1, 0, At, B0); PG8_BAR; PG8_SCHED;
            PG8_STAGE(PG8_SB(1, 1), b3 + hstep, voffB);
            PG8_WAIT_V(6); PG8_BAR; PG8_MMA(1, 1, At, B1); PG8_BAR;
            }
        }
        if constexpr (ALIGN_EPI) { if (wr == 0) PG8_BAR; }
        if constexpr (!Epi::AFTER_DRAIN) { E(acc, cur, wr, wc, fr, fq); S.done(cur); }
        if (!has_next) break;
#pragma unroll
        for (int a = 0; a < 2; ++a)
#pragma unroll
            for (int b = 0; b < 2; ++b)
#pragma unroll
                for (int m = 0; m < 4; ++m)
#pragma unroll
                    for (int n = 0; n < 2; ++n) acc[a][b][m][n] = (f32x4){0.f, 0.f, 0.f, 0.f};
        cur = nxt; cA = nA; cB = nB; ++ui;
        if constexpr (ALIGN_EPI) { if (wr == 1) PG8_BAR; }
    }
    PG8_WAIT_V(0);
    if constexpr (!ALIGN_EPI) { if (wr == 0) PG8_BAR; }
    PG8_BAR;
    if constexpr (Epi::AFTER_DRAIN) { E.fused(acc, cur, wr, wc, fr, fq, lds, wid, lane); S.done(cur); }
#undef PG8_SA
#undef PG8_SB
#undef PG8_STAGE
#undef PG8_LDA
#undef PG8_LDB
#undef PG8_MMA
#undef PG8_WAIT_V
#undef PG8_WAIT_L
#undef PG8_BAR
#undef PG8_SCHED
}
}
#define MK_ONE_LAUNCH 1

constexpr int NB = 4, SEQ = 8192, T = NB * SEQ, D = 1024;
constexpr int NIN = 3584, DH = 512, HD = 128, NHH = 4, CHK = 64;
constexpr int NSEG = 16, SEGC = 8;
constexpr int CW = 31, CPAD = 15, DC = 512;
constexpr int PHEADS = 8, NQK = 2048, NSEL = 128;
constexpr float EPS = 1e-6f;
constexpr int NWAVES = 8, NTHR = 512;

constexpr size_t MiB = 1u << 20;
constexpr size_t WS_CTL = 0, CTL_ZERO_BYTES = 65536;
constexpr size_t WS_MOD = 1 * MiB, WS_FMOD = WS_MOD + 131072, WS_LB = WS_MOD + 196608, WS_BIASQ = WS_MOD + 262144;
constexpr size_t WS_WIN = 2 * MiB, WS_WOUT = 10 * MiB, WS_WQK = 12 * MiB;
constexpr size_t WS_UT = 16 * MiB, WS_WQKB = 24 * MiB, WS_VT = 48 * MiB;
constexpr size_t WS_BUFA = 80 * MiB;
constexpr size_t WS_BUFB = 144 * MiB;
constexpr size_t WS_SEG = 208 * MiB;
constexpr size_t WS_E = 208 * MiB, WS_W = 224 * MiB;
constexpr size_t WS_BIG = 240 * MiB;
constexpr size_t WS_SSQ = 496 * MiB;
constexpr size_t WS_SEGA = 498 * MiB;
constexpr size_t WS_RSTD = 499 * MiB;
constexpr size_t WS_END = 500 * MiB;
constexpr size_t WS_PACT = 240 * MiB;
constexpr size_t WS_Y = 368 * MiB;
constexpr int NSL = 8, CSL = 128;
constexpr float VSCALE = 16.0f;
constexpr float UQSCALE = 95.5f;
constexpr int NSLU = 4, CSLU = 256;
constexpr int CW_QU = 8192, CW_QV = 8192 + 64 * 16;
constexpr int CW_GV = 6400;
constexpr int CW_H1 = 6144;
constexpr int CW_BAR = 1024;

#ifndef LDSFILL
#define LDSFILL 0u
#endif
constexpr int LDS_BYTES = 155648;
constexpr int MISC_OFF = LDS_BYTES - 256;

#define GAS __attribute__((address_space(1)))
#define LAS __attribute__((address_space(3)))
typedef unsigned short bf16;
typedef unsigned v4u __attribute__((ext_vector_type(4)));
typedef unsigned v2u __attribute__((ext_vector_type(2)));
typedef float f32x4 __attribute__((ext_vector_type(4)));
typedef float f32x16 __attribute__((ext_vector_type(16)));
typedef short bf16x8 __attribute__((ext_vector_type(8)));
typedef float f32x2_ __attribute__((ext_vector_type(2)));

__device__ __forceinline__ float bf2f(unsigned h) { return __builtin_bit_cast(float, h << 16); }
__device__ __forceinline__ float bflo(unsigned u) { return __builtin_bit_cast(float, u << 16); }
__device__ __forceinline__ float bfhi(unsigned u) { return __builtin_bit_cast(float, u & 0xffff0000u); }
__device__ __forceinline__ unsigned f2bf(float f) { unsigned u = __builtin_bit_cast(unsigned, f); return (u + 0x7fffu + ((u >> 16) & 1u)) >> 16; }
__device__ __forceinline__ unsigned pk2(float lo, float hi) { return f2bf(lo) | (f2bf(hi) << 16); }
__device__ __forceinline__ unsigned cvtpk(float lo, float hi) { unsigned r; asm("v_cvt_pk_bf16_f32 %0, %1, %2" : "=v"(r) : "v"(lo), "v"(hi)); return r; }
__device__ __forceinline__ float sigmoidf_(float x) { return __builtin_amdgcn_rcpf(1.0f + __expf(-x)); }
#define DPP_ADD(s, ctrl) ((s) + __builtin_bit_cast(float, __builtin_amdgcn_update_dpp(0, __builtin_bit_cast(int, (s)), (ctrl), 0xF, 0xF, false)))
__device__ __forceinline__ float wave_sum(float v) {
    v = DPP_ADD(v, 0x128); v = DPP_ADD(v, 0x124); v = DPP_ADD(v, 0x122); v = DPP_ADD(v, 0x121);
    v += __builtin_bit_cast(float, __builtin_amdgcn_update_dpp(0, __builtin_bit_cast(int, v), 0x142, 0xA, 0xF, false));
    v += __builtin_bit_cast(float, __builtin_amdgcn_update_dpp(0, __builtin_bit_cast(int, v), 0x143, 0xC, 0xF, false));
    return __builtin_bit_cast(float, __builtin_amdgcn_readlane(__builtin_bit_cast(int, v), 63));
}

#define XB_TMO      128
#define XB_XCNT(j)  (256  + 64 * (j))
#define XB_XSUB(j)  (1280 + 64 * (j))
#define XB_XGEN(j)  (2304 + 64 * (j))
#define XB_TOP      3328
#define XB_TOPGEN   3392
#define XCD_BAR_WORDS 3456
#define XB_SPIN_CAP (1u << 18)
__device__ __forceinline__ unsigned xb_ld(unsigned* p)              { return __hip_atomic_load(p, __ATOMIC_RELAXED, __HIP_MEMORY_SCOPE_AGENT); }
__device__ __forceinline__ unsigned xb_add(unsigned* p, unsigned v) { return __hip_atomic_fetch_add(p, v, __ATOMIC_RELAXED, __HIP_MEMORY_SCOPE_AGENT); }
__device__ __forceinline__ unsigned xb_xcc_id() { return (unsigned)__builtin_amdgcn_s_getreg((3 << 11) | 20) & 0xFu; }
#define XB_SPIN(cond, bar) do { unsigned _sp = 0; while (cond) { __builtin_amdgcn_s_sleep(1); \
    if ((++_sp & 255u) == 0u) { if (xb_ld(&(bar)[XB_TMO])) break; if (_sp > XB_SPIN_CAP) { atomicAdd(&(bar)[XB_TMO], 1u); break; } } } } while (0)
struct XcdBarrier { unsigned* bar; unsigned x; volatile LAS unsigned* st; };
__device__ __forceinline__ XcdBarrier xcd_barrier_post(unsigned* bar, volatile LAS unsigned* st) {
    XcdBarrier b; b.bar = bar; b.x = xb_xcc_id(); b.st = st;
    if (threadIdx.x == 0) (void)xb_add(&bar[XB_XCNT(b.x)], 1u);
    return b;
}
__device__ __forceinline__ void xcd_barrier_complete(unsigned* bar, unsigned x, unsigned& nloc, unsigned& nx) {
    const unsigned G = gridDim.x * gridDim.y * gridDim.z;
    unsigned sum, cnt, mine, sp = 0u;
    for (;;) {
        sum = 0u; cnt = 0u; mine = 0u;
#pragma unroll
        for (unsigned j = 0; j < 16; ++j) { const unsigned c = xb_ld(&bar[XB_XCNT(j)]); sum += c; cnt += (c > 0u) ? 1u : 0u; mine = (j == x) ? c : mine; }
        if (sum == G) break;
        __builtin_amdgcn_s_sleep(1);
        if ((++sp & 255u) == 0u) { if (xb_ld(&bar[XB_TMO])) break; if (sp > XB_SPIN_CAP) { atomicAdd(&bar[XB_TMO], 1u); break; } }
    }
    nloc = mine > 0u ? mine : 1u; nx = cnt > 0u ? cnt : 1u;
}
__device__ __forceinline__ void xcd_barrier(const XcdBarrier& b) {
    asm volatile("s_waitcnt vmcnt(0)" ::: "memory");
    __syncthreads();
    if (threadIdx.x == 0) {
        unsigned* bar = b.bar;
        __builtin_amdgcn_s_waitcnt(0);
        unsigned nloc = b.st[0], nx = b.st[1];
        if (nloc == 0u) { xcd_barrier_complete(bar, b.x, nloc, nx); b.st[0] = nloc; b.st[1] = nx; }
        const unsigned old = xb_add(&bar[XB_XSUB(b.x)], 1u);
        const unsigned gen = old / nloc;
        if (old + 1u == (gen + 1u) * nloc) {
            __builtin_amdgcn_fence(__ATOMIC_RELEASE, "agent");
            asm volatile("s_waitcnt vmcnt(0)" ::: "memory");
            const unsigned og = xb_add(&bar[XB_TOP], 1u);
            const unsigned tg = og / nx;
            if (og + 1u == (tg + 1u) * nx) xb_add(&bar[XB_TOPGEN], 1u);
            else XB_SPIN(xb_ld(&bar[XB_TOPGEN]) == tg, bar);
            __builtin_amdgcn_fence(__ATOMIC_ACQUIRE, "agent");
            xb_add(&bar[XB_XGEN(b.x)], 1u);
            asm volatile("s_waitcnt vmcnt(0)" ::: "memory");
        } else {
            XB_SPIN(xb_ld(&bar[XB_XGEN(b.x)]) == gen, bar);
            __builtin_amdgcn_fence(__ATOMIC_ACQUIRE, "agent");
            asm volatile("s_waitcnt vmcnt(0)" ::: "memory");
        }
    }
    __syncthreads();
}

struct Args { const float* in[23]; float* out; unsigned char* ws; int ph_lo, ph_hi; };
struct Frame {
    LAS unsigned char* lds;
    int tid, lane, wave, G, bid;
    const Args* a;
    __device__ __forceinline__ const float* x() const { return a->in[0]; }
    __device__ __forceinline__ const float* c() const { return a->in[1]; }
    __device__ __forceinline__ const float* ada_w() const { return a->in[2]; }
    __device__ __forceinline__ const float* ada_b() const { return a->in[3]; }
    __device__ __forceinline__ const float* g_mix() const { return a->in[4]; }
    __device__ __forceinline__ const float* w_in() const { return a->in[5]; }
    __device__ __forceinline__ const float* lbg_f() const { return a->in[6]; }
    __device__ __forceinline__ const float* lbg_b() const { return a->in[7]; }
    __device__ __forceinline__ const float* hnorm_g() const { return a->in[8]; }
    __device__ __forceinline__ const float* conv_w() const { return a->in[9]; }
    __device__ __forceinline__ const float* conv_b() const { return a->in[10]; }
    __device__ __forceinline__ const float* cln_g() const { return a->in[11]; }
    __device__ __forceinline__ const float* cln_b() const { return a->in[12]; }
    __device__ __forceinline__ const float* w_out() const { return a->in[13]; }
    __device__ __forceinline__ const float* g_ffn() const { return a->in[14]; }
    __device__ __forceinline__ const float* wq() const { return a->in[15]; }
    __device__ __forceinline__ const float* keys1() const { return a->in[16]; }
    __device__ __forceinline__ const float* keys2() const { return a->in[17]; }
    __device__ __forceinline__ const float* utab() const { return a->in[18]; }
    __device__ __forceinline__ const float* vtab() const { return a->in[19]; }
    __device__ __forceinline__ const float* fada_w() const { return a->in[20]; }
    __device__ __forceinline__ const float* fada_b() const { return a->in[21]; }
    __device__ __forceinline__ const float* fnorm_g() const { return a->in[22]; }
    __device__ __forceinline__ float* out() const { return a->out; }
    __device__ __forceinline__ float* mod() const { return (float*)(a->ws + WS_MOD); }
    __device__ __forceinline__ float* fmod() const { return (float*)(a->ws + WS_FMOD); }
    __device__ __forceinline__ float* lb() const { return (float*)(a->ws + WS_LB); }
    __device__ __forceinline__ float* biasq() const { return (float*)(a->ws + WS_BIASQ); }
    __device__ __forceinline__ float* ssqp() const { return (float*)(a->ws + WS_SSQ); }
    __device__ __forceinline__ float* sega() const { return (float*)(a->ws + WS_SEGA); }
    __device__ __forceinline__ float* segu() const { return (float*)(a->ws + WS_SEG); }
    __device__ __forceinline__ float* of() const { return (float*)(a->ws + WS_BUFB); }
    __device__ __forceinline__ float* scores() const { return (float*)(a->ws + WS_BIG); }
    __device__ __forceinline__ float* wsel() const { return (float*)(a->ws + WS_W); }
    __device__ __forceinline__ int* esel() const { return (int*)(a->ws + WS_E); }
    __device__ __forceinline__ bf16* Win_t() const { return (bf16*)(a->ws + WS_WIN); }
    __device__ __forceinline__ bf16* Wout_t() const { return (bf16*)(a->ws + WS_WOUT); }
    __device__ __forceinline__ bf16* Wqk_t() const { return (bf16*)(a->ws + WS_WQK); }
    __device__ __forceinline__ bf16* Wqk_b() const { return (bf16*)(a->ws + WS_WQKB); }
    __device__ __forceinline__ bf16* Ub() const { return (bf16*)(a->ws + WS_UT); }
    __device__ __forceinline__ bf16* Vb() const { return (bf16*)(a->ws + WS_VT); }
    __device__ __forceinline__ bf16* bufA() const { return (bf16*)(a->ws + WS_BUFA); }
    __device__ __forceinline__ bf16* hg() const { return (bf16*)(a->ws + WS_BUFB); }
    __device__ __forceinline__ bf16* proj() const { return (bf16*)(a->ws + WS_BIG); }
    __device__ __forceinline__ float* coef() const { return (float*)(a->ws + WS_BUFA); }
    __device__ __forceinline__ float* rstd() const { return (float*)(a->ws + WS_RSTD); }
    __device__ __forceinline__ bf16* pact() const { return (bf16*)(a->ws + WS_PACT); }
    __device__ __forceinline__ bf16* ybuf() const { return (bf16*)(a->ws + WS_Y); }
    __device__ __forceinline__ unsigned char* U8() const { return (unsigned char*)(a->ws + WS_UT); }
    __device__ __forceinline__ unsigned char* V8() const { return (unsigned char*)(a->ws + WS_VT); }
    __device__ __forceinline__ unsigned* ctl() const { return (unsigned*)(a->ws + WS_CTL); }
};

__device__ __forceinline__ void p0_gemv(Frame& F) {
    LAS float* cact = (LAS float*)(F.lds);
    LAS float* red = (LAS float*)(F.lds + 16384);
    for (int i = F.tid; i < 4096; i += NTHR) { const float c = F.c()[i]; cact[i] = c * sigmoidf_(c); }
    __syncthreads();
    for (int item = F.bid; item < 128; item += F.G) {
        const int col0 = item * 64; const float* W; int N, cc;
        if (col0 < 6144) { W = F.ada_w(); N = 6144; cc = col0; } else { W = F.fada_w(); N = 2048; cc = col0 - 6144; }
        const float* wp = W + (size_t)(F.wave * 128) * N + cc + F.lane;
        float a0 = 0.f, a1 = 0.f, a2 = 0.f, a3 = 0.f;
#pragma unroll 128
        for (int k = 0; k < 128; ++k) { const float w = wp[(size_t)k * N]; const int kk = F.wave * 128 + k;
            a0 += cact[kk] * w; a1 += cact[1024 + kk] * w; a2 += cact[2048 + kk] * w; a3 += cact[3072 + kk] * w; }
        red[(F.wave * 4 + 0) * 64 + F.lane] = a0; red[(F.wave * 4 + 1) * 64 + F.lane] = a1; red[(F.wave * 4 + 2) * 64 + F.lane] = a2; red[(F.wave * 4 + 3) * 64 + F.lane] = a3;
        __syncthreads();
        if (F.tid < 256) { const int b = F.tid >> 6, l = F.tid & 63; float s = 0.f;
#pragma unroll
            for (int w = 0; w < 8; ++w) s += red[(w * 4 + b) * 64 + l];
            if (col0 < 6144) F.mod()[b * 6144 + cc + l] = s + F.ada_b()[cc + l]; else F.fmod()[b * 2048 + cc + l] = s + F.fada_b()[cc + l]; }
        __syncthreads();
    }
}
__device__ __forceinline__ void p0_transpose_item(const float* W, int K, int N, bf16* WT, LAS float* scr, int item, int lane) {
    const int nblk = N / 32, kb = item / nblk, nb = item % nblk, k0 = 64 * kb, n0 = 32 * nb;
#pragma unroll
    for (int i = 0; i < 32; ++i) { const int kk = 2 * i + (lane >> 5); scr[kk * 33 + (lane & 31)] = W[(size_t)(k0 + kk) * N + n0 + (lane & 31)]; }
    asm volatile("s_waitcnt lgkmcnt(0)" ::: "memory");
    const int c = lane & 7;
#pragma unroll
    for (int j = 0; j < 4; ++j) { const int n = (lane >> 3) + 8 * j; const LAS float* s = scr + (8 * c) * 33 + n;
        v4u o; o.x = pk2(s[0 * 33], s[1 * 33]); o.y = pk2(s[2 * 33], s[3 * 33]); o.z = pk2(s[4 * 33], s[5 * 33]); o.w = pk2(s[6 * 33], s[7 * 33]);
        *(v4u*)(WT + (size_t)(n0 + n) * K + k0 + 8 * c) = o; }
    asm volatile("s_waitcnt lgkmcnt(0)" ::: "memory");
}
__device__ __forceinline__ void p0_wqk_item(Frame& F, int item, LAS float* scr) {
    const int jq = item & 7, kb = (item >> 3) & 15, hh = item >> 7, h = hh >> 1, half = hh & 1;
    const float* keys = (half ? F.keys2() : F.keys1()) + (size_t)(jq * 16) * 128;
    const float* wtile = F.wq() + (size_t)(kb * 64) * 2048 + h * 256 + half * 128;
    LAS float* kL = scr + 1280;
    { f32x4 k4[8];
#pragma unroll
      for (int i = 0; i < 8; ++i) k4[i] = *(const f32x4*)(keys + (i * 64 + F.lane) * 4);
#pragma unroll
      for (int i = 0; i < 8; ++i) *(LAS f32x4*)(kL + (i * 64 + F.lane) * 4) = k4[i]; }
    float acc[16];
#pragma unroll
    for (int j = 0; j < 16; ++j) acc[j] = 0.f;
    f32x4 t4[4], n4[4];
#pragma unroll
    for (int i = 0; i < 4; ++i) t4[i] = *(const f32x4*)(wtile + (size_t)(16 * i + (F.lane >> 2)) * 2048 + 4 * (F.lane & 3));
    for (int d0 = 0; d0 < 128; d0 += 16) {
        if (d0 + 16 < 128) {
#pragma unroll
            for (int i = 0; i < 4; ++i) n4[i] = *(const f32x4*)(wtile + (size_t)(16 * i + (F.lane >> 2)) * 2048 + d0 + 16 + 4 * (F.lane & 3)); }
#pragma unroll
        for (int i = 0; i < 4; ++i) *(LAS f32x4*)(scr + (16 * i + (F.lane >> 2)) * 20 + 4 * (F.lane & 3)) = t4[i];
        asm volatile("s_waitcnt lgkmcnt(0)" ::: "memory");
#pragma unroll
        for (int dd = 0; dd < 16; dd += 4) { const f32x4 a = *(LAS const f32x4*)(scr + F.lane * 20 + dd);
#pragma unroll
            for (int j = 0; j < 16; ++j) { const f32x4 kp = *(LAS const f32x4*)(kL + j * 128 + d0 + dd); acc[j] += a[0] * kp[0] + a[1] * kp[1] + a[2] * kp[2] + a[3] * kp[3]; } }
        asm volatile("s_waitcnt lgkmcnt(0)" ::: "memory");
#pragma unroll
        for (int i = 0; i < 4; ++i) t4[i] = n4[i];
    }
    bf16* o = F.Wqk_t() + (size_t)(h * 256 + half * 128 + jq * 16) * 1024 + kb * 64 + F.lane;
#pragma unroll
    for (int j = 0; j < 16; ++j) o[(size_t)j * 1024] = (bf16)f2bf(acc[j]);
}
__device__ __forceinline__ void p0_prologue(Frame& F) {
    if (F.bid < 128) p0_gemv(F);
    asm volatile("s_waitcnt vmcnt(0)" ::: "memory");
    __syncthreads();
    if (F.tid == 0) { __builtin_amdgcn_fence(__ATOMIC_RELEASE, "agent"); asm volatile("s_waitcnt vmcnt(0)" ::: "memory"); (void)xb_add(F.ctl() + CW_GV, 1u); }
    if (F.bid == 128 % F.G) { const int i = F.tid;
        F.lb()[i] = __builtin_amdgcn_rcpf(1.0f + __expf(F.lbg_f()[512 + i] - F.lbg_f()[i]));
        F.lb()[512 + i] = __builtin_amdgcn_rcpf(1.0f + __expf(F.lbg_b()[512 + i] - F.lbg_b()[i])); }
    LAS float* scr = (LAS float*)(F.lds + 32768 + F.wave * 14336);
    const int gw = F.wave * F.G + F.bid, NGW = F.G * NWAVES;
    constexpr int I_QK = 2048, I_IN = (D / 64) * (NIN / 32), I_OUT = (D / 64) * (D / 32), I_TAB = 2 * 16384 / 4;
    constexpr int NITEMS = I_QK + I_IN + I_OUT + I_TAB;
    for (int it = gw; it < NITEMS; it += NGW) {
        int r = it;
        if (r < I_QK) { p0_wqk_item(F, r, scr); continue; } r -= I_QK;
        if (r < I_IN) { p0_transpose_item(F.w_in(), D, NIN, F.Win_t(), scr, r, F.lane); continue; } r -= I_IN;
        if (r < I_OUT) { p0_transpose_item(F.w_out(), D, D, F.Wout_t(), scr, r, F.lane); continue; } r -= I_OUT;
        { const int tab = r >= 4096, rr = (tab ? r - 4096 : r) * 4; const float* src = (tab ? F.vtab() : F.utab()) + (size_t)rr * 1024; unsigned char* dst = tab ? F.V8() : F.U8();
          const float sc = tab ? VSCALE : UQSCALE;
#pragma unroll
          for (int q = 0; q < 16; ++q) { const int row = rr + (q >> 2), qq = q & 3; const f32x4 v = *(const f32x4*)(src + (q >> 2) * 1024 + qq * 256 + 4 * F.lane) * sc;
              int pk;
              if (tab) { pk = __builtin_amdgcn_cvt_pk_fp8_f32(v[0], v[1], 0, false); pk = __builtin_amdgcn_cvt_pk_fp8_f32(v[2], v[3], pk, true); }
              else { int q0 = (int)__builtin_rintf(v[0]), q1 = (int)__builtin_rintf(v[1]), q2 = (int)__builtin_rintf(v[2]), q3 = (int)__builtin_rintf(v[3]);
                  q0 = q0 < -7 ? -7 : (q0 > 7 ? 7 : q0); q1 = q1 < -7 ? -7 : (q1 > 7 ? 7 : q1); q2 = q2 < -7 ? -7 : (q2 > 7 ? 7 : q2); q3 = q3 < -7 ? -7 : (q3 > 7 ? 7 : q3);
                  *(unsigned short*)(dst + ((size_t)qq * 16384 + row) * 128 + 2 * F.lane) = (unsigned short)((q0 & 0xf) | ((q1 & 0xf) << 4) | ((q2 & 0xf) << 8) | ((q3 & 0xf) << 12)); continue; }
              const int sl = 2 * qq + (F.lane >> 5);
              *(int*)(dst + ((size_t)sl * 16384 + row) * CSL + 4 * (F.lane & 31)) = pk; } }
    }
}

__device__ __forceinline__ void p1_norm(Frame& F) {
    const int gwc = F.bid * NWAVES + F.wave, NGW = F.G * NWAVES;
    for (int row0 = gwc * 16; row0 < T; row0 += NGW * 16) {
        const int b = row0 >> 13; const float* mb = F.mod() + b * 6144;
        f32x4 ca[4], cb[4];
#pragma unroll
        for (int j = 0; j < 4; ++j) { const int k = 256 * j + 4 * F.lane; const f32x4 g = *(const f32x4*)(F.g_mix() + k), s = *(const f32x4*)(mb + 1024 + k); ca[j] = g * (s + 1.0f); cb[j] = *(const f32x4*)(mb + k); }
#pragma unroll 4
        for (int r = 0; r < 16; ++r) { const float* xr = F.x() + (size_t)(row0 + r) * D;
            f32x4 v[4]; float ss = 0.f;
#pragma unroll
            for (int j = 0; j < 4; ++j) { v[j] = *(const f32x4*)(xr + 256 * j + 4 * F.lane); ss += v[j][0] * v[j][0] + v[j][1] * v[j][1] + v[j][2] * v[j][2] + v[j][3] * v[j][3]; }
            const float rstd = __builtin_amdgcn_rsqf(wave_sum(ss) * (1.0f / D) + EPS);
            bf16* o = F.bufA() + (size_t)(row0 + r) * D;
#pragma unroll
            for (int j = 0; j < 4; ++j) { const f32x4 y = v[j] * rstd * ca[j] + cb[j]; v2u w; w.x = pk2(y[0], y[1]); w.y = pk2(y[2], y[3]); *(v2u*)(o + 256 * j + 4 * F.lane) = w; } }
    }
}
__device__ __forceinline__ void p3_pre(Frame& F) {
    const int NGW = F.G * NWAVES;
#pragma unroll 2
    for (int i = F.bid * NTHR + F.tid; i < NQK * (D / 8); i += F.G * NTHR) { const int n = i >> 7, k0 = (i & 127) * 8;
        const v4u w = *(const v4u*)(F.Wqk_t() + (size_t)n * D + k0);
        const f32x4 g0 = *(const f32x4*)(F.g_ffn() + k0), g1 = *(const f32x4*)(F.g_ffn() + k0 + 4);
        f32x4 wa, wb; wa[0] = bflo(w[0]) * g0[0]; wa[1] = bfhi(w[0]) * g0[1]; wa[2] = bflo(w[1]) * g0[2]; wa[3] = bfhi(w[1]) * g0[3]; wb[0] = bflo(w[2]) * g1[0]; wb[1] = bfhi(w[2]) * g1[1]; wb[2] = bflo(w[3]) * g1[2]; wb[3] = bfhi(w[3]) * g1[3];
#pragma unroll
        for (int b = 0; b < NB; ++b) { const float* sc = F.mod() + b * 6144 + 4096 + k0; const f32x4 s0 = *(const f32x4*)sc + 1.0f, s1 = *(const f32x4*)(sc + 4) + 1.0f;
            const f32x4 pa = wa * s0, pb = wb * s1;
            v4u o; o.x = cvtpk(pa[0], pa[1]); o.y = cvtpk(pa[2], pa[3]); o.z = cvtpk(pb[0], pb[1]); o.w = cvtpk(pb[2], pb[3]);
            *(v4u*)(F.Wqk_b() + ((size_t)b * NQK + n) * D + k0) = o; } }
    const int gw = F.wave * F.G + F.bid;
    for (int n0 = gw * 8; n0 < NQK; n0 += NGW * 8) {
        float sv[4][16];
#pragma unroll
        for (int b = 0; b < 4; ++b) { const float* sh2 = F.mod() + b * 6144 + 3072;
#pragma unroll
            for (int i = 0; i < 8; ++i) { sv[b][i] = sh2[8 * F.lane + i]; sv[b][8 + i] = sh2[512 + 8 * F.lane + i]; } }
        v4u w0[8], w1[8];
#pragma unroll
        for (int q = 0; q < 8; ++q) { w0[q] = *(const v4u*)(F.Wqk_t() + (size_t)(n0 + q) * 1024 + 8 * F.lane); w1[q] = *(const v4u*)(F.Wqk_t() + (size_t)(n0 + q) * 1024 + 512 + 8 * F.lane); }
        float res[4] = {0.f, 0.f, 0.f, 0.f};
#pragma unroll
        for (int q = 0; q < 8; ++q) {
            float wv[16];
#pragma unroll
            for (int i = 0; i < 4; ++i) { wv[2 * i] = bflo(w0[q][i]); wv[2 * i + 1] = bfhi(w0[q][i]); wv[8 + 2 * i] = bflo(w1[q][i]); wv[8 + 2 * i + 1] = bfhi(w1[q][i]); }
#pragma unroll
            for (int b = 0; b < 4; ++b) { float sm = 0.f;
#pragma unroll
                for (int i = 0; i < 16; ++i) sm += wv[i] * sv[b][i];
                sm = wave_sum(sm); if (F.lane == q) res[b] = sm; } }
        if (F.lane < 8) {
#pragma unroll
            for (int b = 0; b < 4; ++b) F.biasq()[b * 2048 + n0 + F.lane] = res[b]; }
    }
}

__device__ __forceinline__ void conv_item(Frame& F, int item, const float (&cw)[CW], float cbias) {
    LAS bf16* hbuf = (LAS bf16*)(F.lds);
    LAS float* ybuf = (LAS float*)(F.lds + 65536);
    const int tok0 = item * 32, b = tok0 >> 13, t0 = tok0 & (SEQ - 1), c = F.tid;
#pragma unroll
    for (int k = 0; k < 8; ++k) { const int pi = F.tid + NTHR * k; if (pi < 62 * 64) { const int r = pi >> 6, ch = pi & 63, t = t0 - CPAD + r; v4u o = {0u, 0u, 0u, 0u};
            if (t >= 0 && t < SEQ) { const bf16* pr = F.proj() + (size_t)(b * SEQ + t) * NIN + 8 * ch; const v4u a = *(const v4u*)(pr + 2560), g = *(const v4u*)(pr + 3072);
#pragma unroll
                for (int i = 0; i < 4; ++i) o[i] = cvtpk(bflo(a[i]) * bflo(g[i]), bfhi(a[i]) * bfhi(g[i])); }
            *(LAS v4u*)(hbuf + r * 512 + 8 * ch) = o; } }
    __syncthreads();
    f32x2_ hp[31];
#pragma unroll
    for (int m = 0; m < 31; ++m) hp[m] = (f32x2_){bf2f(hbuf[(2 * m) * 512 + c]), bf2f(hbuf[(2 * m + 1) * 512 + c])};
    f32x2_ ce[15], co[15];
#pragma unroll
    for (int m = 0; m < 15; ++m) { ce[m] = (f32x2_){cw[2 * m], cw[2 * m + 1]}; co[m] = (f32x2_){cw[2 * m + 1], cw[2 * m + 2]}; }
#pragma unroll
    for (int e = 0; e < 16; ++e) {
        { f32x2_ a = {cbias, 0.f};
#pragma unroll
          for (int m = 0; m < 15; ++m) a += ce[m] * hp[e + m];
          ybuf[(2 * e) * 512 + c] = (a[0] + a[1]) + cw[30] * hp[e + 15][0]; }
        { f32x2_ a = {cbias, 0.f};
#pragma unroll
          for (int m = 0; m < 15; ++m) a += co[m] * hp[e + m + 1];
          ybuf[(2 * e + 1) * 512 + c] = (a[0] + a[1]) + cw[0] * hp[e][1]; } }
    __syncthreads();
#pragma unroll
    for (int q = 0; q < 4; ++q) { const int tt = F.wave * 4 + q;
        const f32x4 y0 = *(LAS const f32x4*)(ybuf + tt * 512 + 8 * F.lane), y1 = *(LAS const f32x4*)(ybuf + tt * 512 + 8 * F.lane + 4);
        const float mean = wave_sum((y0[0] + y0[1] + y0[2] + y0[3]) + (y1[0] + y1[1] + y1[2] + y1[3])) * (1.0f / DC);
        const f32x4 d0 = y0 - mean, d1 = y1 - mean;
        const float var = wave_sum((d0[0] * d0[0] + d0[1] * d0[1] + d0[2] * d0[2] + d0[3] * d0[3]) + (d1[0] * d1[0] + d1[1] * d1[1] + d1[2] * d1[2] + d1[3] * d1[3])) * (1.0f / DC);
        const float rstd = __builtin_amdgcn_rsqf(var + EPS);
        const f32x4 g0 = *(const f32x4*)(F.cln_g() + 8 * F.lane), g1 = *(const f32x4*)(F.cln_g() + 8 * F.lane + 4), b0 = *(const f32x4*)(F.cln_b() + 8 * F.lane), b1 = *(const f32x4*)(F.cln_b() + 8 * F.lane + 4);
        f32x4 z0 = d0 * rstd * g0 + b0, z1 = d1 * rstd * g1 + b1;
#pragma unroll
        for (int i = 0; i < 4; ++i) { z0[i] = z0[i] * sigmoidf_(z0[i]); z1[i] = z1[i] * sigmoidf_(z1[i]); }
        v4u w; w.x = cvtpk(z0[0], z0[1]); w.y = cvtpk(z0[2], z0[3]); w.z = cvtpk(z1[0], z1[1]); w.w = cvtpk(z1[2], z1[3]);
        *(v4u*)(F.bufA() + (size_t)(tok0 + tt) * D + 512 + 8 * F.lane) = w; }
    __syncthreads();
}

constexpr int PQ = 272, PT = 144;
constexpr int HL_QR = 0, HL_KR = 17408, HL_QE = 34816, HL_KET = 52224, HL_VT = 70656, HL_SCM = 89088, HL_ST = 98304, HL_PBLK = 133120  , HL_AV = 137216, HL_RS = 137728;
static_assert(HL_PBLK + 8 * 128 * 4 <= HL_AV && HL_AV + 512 <= HL_RS && HL_RS + 1024 <= 155648 - 256, "HGRN LDS map");
__device__ __forceinline__ bf16x8 ldf(LAS const unsigned char* base, int row, int pitch, int kbyte) { return *(LAS const bf16x8*)(base + row * pitch + kbyte); }
#define MFMA32(a, b, c) __builtin_amdgcn_mfma_f32_32x32x16_bf16((a), (b), (c), 0, 0, 0)

template <bool FULL>
__device__ __forceinline__ void hgrn_load(Frame& F, int b, int h, int dir, int chunk, unsigned (&rz)[8], unsigned (&rv)[8], unsigned (&rq)[8]) {
    const size_t tokbase = (size_t)b * SEQ + (size_t)chunk * CHK; const int zoff = dir ? 1024 : 512, c0 = 2 * F.lane;
#pragma unroll
    for (int i = 0; i < 8; ++i) { const int p = 8 * F.wave + i, tr = dir ? (63 - p) : p; const bf16* q = F.proj() + (tokbase + tr) * NIN + h * HD;
        rz[i] = *(const unsigned*)(q + zoff + c0); rv[i] = *(const unsigned*)(q + 1536 + c0); if (FULL) rq[i] = *(const unsigned*)(q + c0); }
}
template <bool FULL, int MODE>
__device__ __forceinline__ void hgrn_chunk(Frame& F, int b, int h, int dir, int chunk, int nchunk, f32x16 (&accS)[2], float lb0, float lb1, unsigned (&rz)[8], unsigned (&rv)[8], unsigned (&rq)[8]) {
    LAS unsigned char* lds = F.lds;
    int r = F.lane & 31, hh = F.lane >> 5, c0 = 2 * F.lane;
    asm volatile("" : "+v"(r), "+v"(hh), "+v"(c0));
    const int w = F.wave, rb = w;
    const size_t tokbase = (size_t)b * SEQ + (size_t)chunk * CHK;
    {
        const f32x2_ oml = {1.0f - lb0, 1.0f - lb1};
        f32x2_ f2[8], cf2[8], cr2[8];
        f32x2_ run = {1.f, 1.f};
#pragma unroll
        for (int i = 0; i < 8; ++i) { const f32x2_ kk = {bflo(rz[i]), bfhi(rz[i])}; f2[i] = 1.0f - oml * kk; run *= f2[i]; cf2[i] = run; }
        { f32x2_ q = {1.f, 1.f};
#pragma unroll
          for (int i = 7; i >= 0; --i) { cr2[i] = q; q *= f2[i]; } }
        LAS float* pblk = (LAS float*)(lds + HL_PBLK);
        *(LAS f32x2_*)(pblk + rb * 128 + c0) = run;
        __syncthreads();
        f32x2_ pre = {1.f, 1.f}, post = {1.f, 1.f}, mid = {1.f, 1.f};
        for (int q = 0; q < rb; ++q) pre *= *(LAS const f32x2_*)(pblk + q * 128 + c0);
        for (int q = rb + 1; q < 8; ++q) post *= *(LAS const f32x2_*)(pblk + q * 128 + c0);
        if (rb < 4) { for (int q = rb + 1; q < 4; ++q) mid *= *(LAS const f32x2_*)(pblk + q * 128 + c0); }
        else { for (int q = 4; q < rb; ++q) mid *= *(LAS const f32x2_*)(pblk + q * 128 + c0); }
        if (rb == 0) *(LAS f32x2_*)((LAS float*)(lds + HL_AV) + c0) = run * post;
        f32x2_ ke2[8];
#pragma unroll
        for (int i = 0; i < 8; ++i) ke2[i] = (1.0f - f2[i]) * cr2[i] * post;
        if (FULL) {
            if (rb < 4) {
#pragma unroll
                for (int i = 0; i < 8; ++i) { const int p = 8 * rb + i; const f32x2_ qs = {bflo(rq[i]), bfhi(rq[i])}, k2 = 1.0f - f2[i], G = cr2[i] * mid;
                    f32x2_ iG; iG[0] = __builtin_amdgcn_rcpf(G[0]); iG[1] = __builtin_amdgcn_rcpf(G[1]);
                    const f32x2_ qe = qs * pre * cf2[i], qr = qs * iG, kr = k2 * G;
                    *(LAS unsigned*)(lds + HL_QE + p * PQ + c0 * 2) = cvtpk(qe[0], qe[1]);
                    *(LAS unsigned*)(lds + HL_QR + p * PQ + c0 * 2) = cvtpk(qr[0], qr[1]);
                    *(LAS unsigned*)(lds + HL_KR + p * PQ + c0 * 2) = cvtpk(kr[0], kr[1]); }
            } else {
#pragma unroll
                for (int i = 0; i < 8; ++i) { const int p = 8 * rb + i; const f32x2_ qs = {bflo(rq[i]), bfhi(rq[i])}, k2 = 1.0f - f2[i], G = cf2[i] * mid;
                    f32x2_ iG; iG[0] = __builtin_amdgcn_rcpf(G[0]); iG[1] = __builtin_amdgcn_rcpf(G[1]);
                    const f32x2_ qe = qs * pre * cf2[i], qr = qs * G, kr = k2 * iG;
                    *(LAS unsigned*)(lds + HL_QE + p * PQ + c0 * 2) = cvtpk(qe[0], qe[1]);
                    *(LAS unsigned*)(lds + HL_QR + p * PQ + c0 * 2) = cvtpk(qr[0], qr[1]);
                    *(LAS unsigned*)(lds + HL_KR + p * PQ + c0 * 2) = cvtpk(kr[0], kr[1]); }
            }
        }
        v4u ka, kb, va, vb2;
        ka.x = cvtpk(ke2[0][0], ke2[1][0]); ka.y = cvtpk(ke2[2][0], ke2[3][0]); ka.z = cvtpk(ke2[4][0], ke2[5][0]); ka.w = cvtpk(ke2[6][0], ke2[7][0]);
        kb.x = cvtpk(ke2[0][1], ke2[1][1]); kb.y = cvtpk(ke2[2][1], ke2[3][1]); kb.z = cvtpk(ke2[4][1], ke2[5][1]); kb.w = cvtpk(ke2[6][1], ke2[7][1]);
        va.x = (rv[0] & 0xffffu) | (rv[1] << 16); va.y = (rv[2] & 0xffffu) | (rv[3] << 16); va.z = (rv[4] & 0xffffu) | (rv[5] << 16); va.w = (rv[6] & 0xffffu) | (rv[7] << 16);
        vb2.x = (rv[0] >> 16) | (rv[1] & 0xffff0000u); vb2.y = (rv[2] >> 16) | (rv[3] & 0xffff0000u); vb2.z = (rv[4] >> 16) | (rv[5] & 0xffff0000u); vb2.w = (rv[6] >> 16) | (rv[7] & 0xffff0000u);
        *(LAS v4u*)(lds + HL_KET + c0 * PT + 16 * rb) = ka; *(LAS v4u*)(lds + HL_KET + (c0 + 1) * PT + 16 * rb) = kb;
        *(LAS v4u*)(lds + HL_VT + c0 * PT + 16 * rb) = va; *(LAS v4u*)(lds + HL_VT + (c0 + 1) * PT + 16 * rb) = vb2;
    }
    if (nchunk >= 0) hgrn_load<FULL>(F, b, h, dir, nchunk, rz, rv, rq);
    __syncthreads();
    const int pbO = w & 1, vb = w >> 1;
    f32x16 accO, accU[2];
#pragma unroll
    for (int i = 0; i < 16; ++i) { accO[i] = 0.f; accU[0][i] = 0.f; accU[1][i] = 0.f; }
    if (FULL) {
        if (w < 3) { const int pbS = (w + 1) >> 1, sbS = (w == 2) ? 1 : 0; f32x16 sc;
#pragma unroll
            for (int i = 0; i < 16; ++i) sc[i] = 0.f;
#pragma unroll
            for (int s = 0; s < 8; ++s) sc = MFMA32(ldf(lds + HL_QR, pbS * 32 + r, PQ, 32 * s + 16 * hh), ldf(lds + HL_KR, sbS * 32 + r, PQ, 32 * s + 16 * hh), sc);
#pragma unroll
            for (int i = 0; i < 16; i += 2) { const int p = pbS * 32 + (i & 3) + 8 * (i >> 2) + 4 * hh, s = sbS * 32 + r;
                const unsigned pkd = cvtpk(s <= p ? sc[i] : 0.f, s <= p + 1 ? sc[i + 1] : 0.f);
                *(LAS bf16*)(lds + HL_SCM + p * PT + s * 2) = (bf16)pkd; *(LAS bf16*)(lds + HL_SCM + (p + 1) * PT + s * 2) = (bf16)(pkd >> 16); } }
        __builtin_amdgcn_sched_barrier(0);
#pragma unroll
        for (int s = 0; s < 8; ++s) accO = MFMA32(ldf(lds + HL_QE, pbO * 32 + r, PQ, 32 * s + 16 * hh), ldf(lds + HL_ST, vb * 32 + r, PQ, 32 * s + 16 * hh), accO);
        __builtin_amdgcn_sched_barrier(0);
    }
#pragma unroll
    for (int i = 0; i < 2; ++i) { const int db = 2 * (w & 1) + i;
#pragma unroll
        for (int s = 0; s < 4; ++s) accU[i] = MFMA32(ldf(lds + HL_VT, vb * 32 + r, PT, 32 * s + 16 * hh), ldf(lds + HL_KET, db * 32 + r, PT, 32 * s + 16 * hh), accU[i]); }
    __builtin_amdgcn_sched_barrier(0);
    if (FULL) __syncthreads();
    if (FULL) {
        const unsigned v = vb * 32 + r;
        const unsigned lrow = (MODE == 0 ? (unsigned)hh : (unsigned)(1 - hh)) * 4u;
        const size_t rbase = (MODE == 0) ? (tokbase + pbO * 32) : (tokbase + 63 - pbO * 32 - 4);
        const unsigned lo_of = lrow * DH + v, lo_pr = lrow * NIN + v, lo_a2 = lrow * D + v;
        float ofv[16]; unsigned gv[16];
        if (MODE == 1) {
#pragma unroll
            for (int i = 0; i < 16; ++i) { const int ci = (i & 3) + 8 * (i >> 2); ofv[i] = (F.of() + (rbase - ci) * DH + h * HD)[lo_of]; } }
        for (int sb = 0; sb <= pbO; ++sb)
#pragma unroll
            for (int s2 = 0; s2 < 2; ++s2) accO = MFMA32(ldf(lds + HL_SCM, pbO * 32 + r, PT, 64 * sb + 32 * s2 + 16 * hh), ldf(lds + HL_VT, vb * 32 + r, PT, 64 * sb + 32 * s2 + 16 * hh), accO);
        if (MODE == 0) {
#pragma unroll
            for (int i = 0; i < 16; ++i) { const int ci = (i & 3) + 8 * (i >> 2); (F.of() + (rbase + ci) * DH + h * HD)[lo_of] = accO[i]; }
        } else {
            LAS float* rs = (LAS float*)(lds + HL_RS);
#pragma unroll
            for (int i = 0; i < 16; ++i) { const int ci = (i & 3) + 8 * (i >> 2); gv[i] = (F.proj() + (rbase - ci) * NIN + 2048 + h * HD)[lo_pr]; }
            float ov[16];
            float ssr[16];
#pragma unroll
            for (int i = 0; i < 16; ++i) { ov[i] = accO[i] + ofv[i]; float ss = ov[i] * ov[i];
                ss = DPP_ADD(ss, 0x128); ss = DPP_ADD(ss, 0x124); ss = DPP_ADD(ss, 0x122); ss = DPP_ADD(ss, 0x121);
                ssr[i] = ss + __builtin_bit_cast(float, __builtin_amdgcn_update_dpp(0, __builtin_bit_cast(int, ss), 0x142, 0xA, 0xF, false)); }
            if (r == 16) {
#pragma unroll
                for (int i = 0; i < 16; ++i) { const int ci = (i & 3) + 8 * (i >> 2), p = pbO * 32 + ci + 4 * hh; rs[p * 4 + vb] = ssr[i]; } }
            __syncthreads();
            const float ng = F.hnorm_g()[h * HD + v];
#pragma unroll
            for (int i = 0; i < 16; ++i) { const int ci = (i & 3) + 8 * (i >> 2), p = pbO * 32 + ci + 4 * hh;
                const f32x4 q = *(LAS const f32x4*)(rs + p * 4);
                const float rstd = __builtin_amdgcn_rsqf((q[0] + q[1] + q[2] + q[3]) * (1.0f / HD) + EPS);
                const float g = bf2f(gv[i]);
                (F.bufA() + (rbase - ci) * D + h * HD)[lo_a2] = (bf16)cvtpk(ov[i] * rstd * ng * g, 0.f); }
        }
    }
    {
        const LAS float* av = (const LAS float*)(lds + HL_AV);
#pragma unroll
        for (int i = 0; i < 2; ++i) { const int db = 2 * (w & 1) + i; const float a = av[db * 32 + r];
#pragma unroll
            for (int j = 0; j < 16; j += 2) { const float s0 = accS[i][j] * a + accU[i][j], s1 = accS[i][j + 1] * a + accU[i][j + 1]; accS[i][j] = s0; accS[i][j + 1] = s1;
                if (FULL) { const int vv = vb * 32 + (j & 3) + 8 * (j >> 2) + 4 * hh; const unsigned pkd = cvtpk(s0, s1);
                    *(LAS bf16*)(lds + HL_ST + vv * PQ + (db * 32 + r) * 2) = (bf16)pkd; *(LAS bf16*)(lds + HL_ST + (vv + 1) * PQ + (db * 32 + r) * 2) = (bf16)(pkd >> 16); } } }
    }
    __syncthreads();
}
__device__ __forceinline__ void h1_item(Frame& F, int item) {
    const int seg = item & 15, dir = (item >> 4) & 1, h = (item >> 5) & 3, b = item >> 7;
    const float lb0 = F.lb()[dir * 512 + h * HD + 2 * F.lane], lb1 = F.lb()[dir * 512 + h * HD + 2 * F.lane + 1];
    f32x16 accS[2];
#pragma unroll
    for (int i = 0; i < 16; ++i) { accS[0][i] = 0.f; accS[1][i] = 0.f; }
    float atot = 1.f; const int col = F.tid & 127;
    unsigned rzA[8], rvA[8], rzB[8], rvB[8], rq[8];
#define H1CH(c) (seg * SEGC + (dir ? (SEGC - 1 - (c)) : (c)))
    hgrn_load<false>(F, b, h, dir, H1CH(0), rzA, rvA, rq); hgrn_load<false>(F, b, h, dir, H1CH(1), rzB, rvB, rq);
    for (int c = 0; c < SEGC; c += 2) {
        hgrn_chunk<false, 0>(F, b, h, dir, H1CH(c), (c + 2 < SEGC) ? H1CH(c + 2) : -1, accS, lb0, lb1, rzA, rvA, rq);
        atot *= ((const LAS float*)(F.lds + HL_AV))[col];
        hgrn_chunk<false, 0>(F, b, h, dir, H1CH(c + 1), (c + 3 < SEGC) ? H1CH(c + 3) : -1, accS, lb0, lb1, rzB, rvB, rq);
        atot *= ((const LAS float*)(F.lds + HL_AV))[col]; }
#undef H1CH
    if (F.tid < 128) F.sega()[(size_t)item * 128 + col] = atot;
    float* U = F.segu() + (size_t)item * 16384;
#pragma unroll
    for (int i = 0; i < 2; ++i)
#pragma unroll
        for (int j = 0; j < 16; j += 4) { f32x4 o; o[0] = accS[i][j]; o[1] = accS[i][j + 1]; o[2] = accS[i][j + 2]; o[3] = accS[i][j + 3]; ((f32x4*)(U + (i * 4 + (j >> 2)) * NTHR * 4))[F.tid] = o; }
}
__device__ __forceinline__ void h_scan(Frame& F) {
    for (int g = F.bid; g < NB * NHH * 2 * 8; g += F.G) {
        const int chain = g >> 3, k = g & 7, dir = chain & 1;
        const int aidx = (2 * (F.wave & 1) + (k >> 2)) * 32 + (F.lane & 31);
        float* U = F.segu() + (size_t)chain * NSEG * 16384 + (size_t)k * NTHR * 4 + F.tid * 4;
        const float* A = F.sega() + (size_t)chain * NSEG * 128 + aidx;
        f32x4 u[NSEG]; float av[NSEG];
#pragma unroll
        for (int q = 0; q < NSEG; ++q) { const int sg = dir ? (NSEG - 1 - q) : q; u[q] = *(const f32x4*)(U + (size_t)sg * 16384); av[q] = A[sg * 128]; }
        f32x4 S = {0.f, 0.f, 0.f, 0.f};
#pragma unroll
        for (int q = 0; q < NSEG; ++q) { const int sg = dir ? (NSEG - 1 - q) : q; *(f32x4*)(U + (size_t)sg * 16384) = S; S = S * av[q] + u[q]; }
    }
}
__device__ __forceinline__ void h2_init_state(Frame& F, int b, int h, int dir, int seg, f32x16 (&accS)[2]) {
    const int w = F.wave, r = F.lane & 31, hh = F.lane >> 5, vb = w >> 1;
    const float* U = F.segu() + (size_t)(((b * 4 + h) * 2 + dir) * NSEG + seg) * 16384;
#pragma unroll
    for (int k = 0; k < 8; ++k) { const f32x4 v = ((const f32x4*)(U + k * NTHR * 4))[F.tid]; const int i = k >> 2, j = (k & 3) * 4;
        accS[i][j] = v[0]; accS[i][j + 1] = v[1]; accS[i][j + 2] = v[2]; accS[i][j + 3] = v[3]; }
#pragma unroll
    for (int i = 0; i < 2; ++i) { const int db = 2 * (w & 1) + i;
#pragma unroll
        for (int j = 0; j < 16; ++j) { const int vv = vb * 32 + (j & 3) + 8 * (j >> 2) + 4 * hh; *(LAS bf16*)(F.lds + HL_ST + vv * PQ + (db * 32 + r) * 2) = (bf16)f2bf(accS[i][j]); } }
    __syncthreads();
}
__device__ __forceinline__ void h2_item(Frame& F, int item) {
    const int seg = item & 15, h = (item >> 4) & 3, b = item >> 6;
    f32x16 accS[2];
    unsigned rzA[8], rvA[8], rqA[8], rzB[8], rvB[8], rqB[8];
    { const float lb0 = F.lb()[h * HD + 2 * F.lane], lb1 = F.lb()[h * HD + 2 * F.lane + 1];
      const int c0 = seg * SEGC;
      hgrn_load<true>(F, b, h, 0, c0, rzA, rvA, rqA); hgrn_load<true>(F, b, h, 0, c0 + 1, rzB, rvB, rqB);
      h2_init_state(F, b, h, 0, seg, accS);
      for (int c = 0; c < SEGC; c += 2) {
          hgrn_chunk<true, 0>(F, b, h, 0, c0 + c, (c + 2 < SEGC) ? (c0 + c + 2) : -1, accS, lb0, lb1, rzA, rvA, rqA);
          hgrn_chunk<true, 0>(F, b, h, 0, c0 + c + 1, (c + 3 < SEGC) ? (c0 + c + 3) : -1, accS, lb0, lb1, rzB, rvB, rqB); } }
    asm volatile("s_waitcnt vmcnt(0)" ::: "memory");
    __syncthreads();
    { const float lb0 = F.lb()[512 + h * HD + 2 * F.lane], lb1 = F.lb()[512 + h * HD + 2 * F.lane + 1];
      const int cl = seg * SEGC + SEGC - 1;
      hgrn_load<true>(F, b, h, 1, cl, rzA, rvA, rqA); hgrn_load<true>(F, b, h, 1, cl - 1, rzB, rvB, rqB);
      h2_init_state(F, b, h, 1, seg, accS);
      for (int c = 0; c < SEGC; c += 2) {
          hgrn_chunk<true, 1>(F, b, h, 1, cl - c, (c + 2 < SEGC) ? (cl - c - 2) : -1, accS, lb0, lb1, rzA, rvA, rqA);
          hgrn_chunk<true, 1>(F, b, h, 1, cl - c - 1, (c + 3 < SEGC) ? (cl - c - 3) : -1, accS, lb0, lb1, rzB, rvB, rqB); } }
}

__device__ __forceinline__ unsigned f2key(float f) { return __builtin_bit_cast(unsigned, f); }
__device__ __forceinline__ float key2f(unsigned k) { return __builtin_bit_cast(float, k); }
__device__ __forceinline__ unsigned umax_(unsigned a, unsigned b) { unsigned r; asm("v_max_f32 %0, %1, %2" : "=v"(r) : "v"(a), "v"(b)); return r; }
__device__ __forceinline__ unsigned umin_(unsigned a, unsigned b) { unsigned r; asm("v_min_f32 %0, %1, %2" : "=v"(r) : "v"(a), "v"(b)); return r; }
__device__ __forceinline__ void sort16(unsigned (&a)[16]) {
#define CE_(i, j) { const unsigned x_ = a[i], y_ = a[j]; a[i] = umax_(x_, y_); a[j] = umin_(x_, y_); }
    CE_(0, 13) CE_(1, 12) CE_(2, 15) CE_(3, 14) CE_(4, 8) CE_(5, 6) CE_(7, 11) CE_(9, 10)
    CE_(0, 5) CE_(1, 7) CE_(2, 9) CE_(3, 4) CE_(6, 13) CE_(8, 14) CE_(10, 15) CE_(11, 12)
    CE_(0, 1) CE_(2, 3) CE_(4, 5) CE_(6, 8) CE_(7, 9) CE_(10, 11) CE_(12, 13) CE_(14, 15)
    CE_(0, 2) CE_(1, 3) CE_(4, 10) CE_(5, 11) CE_(6, 7) CE_(8, 9) CE_(12, 14) CE_(13, 15)
    CE_(1, 2) CE_(3, 12) CE_(4, 6) CE_(5, 7) CE_(8, 10) CE_(9, 11) CE_(13, 14)
    CE_(1, 4) CE_(2, 6) CE_(5, 8) CE_(7, 10) CE_(9, 13) CE_(11, 14)
    CE_(2, 4) CE_(3, 6) CE_(9, 12) CE_(11, 13)
    CE_(3, 5) CE_(6, 8) CE_(7, 9) CE_(10, 12)
    CE_(3, 4) CE_(5, 6) CE_(7, 8) CE_(9, 10) CE_(11, 12)
    CE_(6, 7) CE_(8, 9)
#undef CE_
}
__device__ __forceinline__ void merge16(unsigned (&a)[16], const unsigned (&b)[16]) {
#pragma unroll
    for (int i = 0; i < 16; ++i) a[i] = umax_(a[i], b[15 - i]);
#pragma unroll
    for (int j = 8; j > 0; j >>= 1)
#pragma unroll
        for (int i = 0; i < 16; ++i) { const int l = i ^ j; if (l > i) { const unsigned x = a[i], y = a[l]; a[i] = umax_(x, y); a[l] = umin_(x, y); } }
}
__device__ __forceinline__ unsigned dpp_swap1(unsigned v) { return (unsigned)__builtin_amdgcn_update_dpp(0, (int)v, 0xB1, 0xF, 0xF, false); }
__device__ __forceinline__ unsigned pick_byte(const unsigned (&pk)[4], unsigned a) {
    const unsigned wsel = a >> 2; unsigned v = wsel == 0 ? pk[0] : (wsel == 1 ? pk[1] : (wsel == 2 ? pk[2] : pk[3]));
    return (v >> ((a & 3u) * 8u)) & 0xffu;
}
__device__ __forceinline__ void topk_stage2(const unsigned (&top)[16], bool tab0, size_t item, int* esel, float* wsel) {
        float vO[16], vP[16]; unsigned iOpk[4] = {0u, 0u, 0u, 0u}, iPpk[4] = {0u, 0u, 0u, 0u};
#pragma unroll
        for (int i = 0; i < 16; ++i) { const unsigned t = top[i], tp = dpp_swap1(t);
            vO[i] = key2f(t & ~0x7fu); vP[i] = key2f(tp & ~0x7fu);
            iOpk[i >> 2] |= (127u - (t & 0x7fu)) << ((i & 3) * 8); iPpk[i >> 2] |= (127u - (tp & 0x7fu)) << ((i & 3) * 8); }
        unsigned R[16], G1[16], G2[16];
#define CAND(a, b) ((f2key(vO[a] + vP[b]) & ~0xffu) | (unsigned)(((a) << 4) | (b)))
#pragma unroll
        for (int i = 0; i < 16; ++i) R[i] = CAND(0, i);
        G1[0] = CAND(1, 0); G1[1] = CAND(1, 1); G1[2] = CAND(1, 2); G1[3] = CAND(1, 3); G1[4] = CAND(1, 4); G1[5] = CAND(1, 5); G1[6] = CAND(1, 6); G1[7] = CAND(1, 7);
        G1[8] = CAND(2, 0); G1[9] = CAND(2, 1); G1[10] = CAND(2, 2); G1[11] = CAND(2, 3); G1[12] = CAND(2, 4); G1[13] = CAND(3, 0); G1[14] = CAND(3, 1); G1[15] = CAND(3, 2);
        G2[0] = CAND(3, 3); G2[1] = CAND(4, 0); G2[2] = CAND(4, 1); G2[3] = CAND(4, 2); G2[4] = CAND(5, 0); G2[5] = CAND(5, 1); G2[6] = CAND(6, 0); G2[7] = CAND(6, 1);
        G2[8] = CAND(7, 0); G2[9] = CAND(7, 1); G2[10] = CAND(8, 0); G2[11] = CAND(9, 0); G2[12] = CAND(10, 0); G2[13] = CAND(11, 0); G2[14] = CAND(12, 0); G2[15] = CAND(13, 0);
        const unsigned g30 = CAND(14, 0), g31 = CAND(15, 0);
#undef CAND
        sort16(G1); sort16(G2);
        merge16(R, G1); merge16(R, G2);
        { const unsigned hi = umax_(g30, g31), lo = umin_(g30, g31); R[15] = umax_(R[15], hi); R[14] = umax_(R[14], lo);
#pragma unroll
          for (int j = 8; j > 0; j >>= 1)
#pragma unroll
              for (int i = 0; i < 16; ++i) { const int l = i ^ j; if (l > i) { const unsigned x = R[i], y = R[l]; R[i] = umax_(x, y); R[l] = umin_(x, y); } } }
        float sc[16], ex[16]; float sum = 0.f; unsigned eid[16];
        #pragma unroll
        for (int i = 0; i < 16; ++i) { sc[i] = key2f(R[i] & ~0xffu); const unsigned a = (R[i] >> 4) & 15u, bb = R[i] & 15u;
            const unsigned io = pick_byte(iOpk, a), ip = pick_byte(iPpk, bb);
            eid[i] = tab0 ? (io * 128u + ip) : (ip * 128u + io); }
#pragma unroll
        for (int i = 0; i < 16; ++i) { ex[i] = __expf(sc[i] - sc[0]); sum += ex[i]; }
        const float inv = 1.0f / sum;
        if (tab0) { const size_t o = item * 16;
#pragma unroll
            for (int q = 0; q < 4; ++q) { v4u ev; ev.x = eid[4 * q]; ev.y = eid[4 * q + 1]; ev.z = eid[4 * q + 2]; ev.w = eid[4 * q + 3]; *(v4u*)(esel + o + 4 * q) = ev;
                f32x4 wv; wv[0] = ex[4 * q] * inv; wv[1] = ex[4 * q + 1] * inv; wv[2] = ex[4 * q + 2] * inv; wv[3] = ex[4 * q + 3] * inv; *(f32x4*)(wsel + o + 4 * q) = wv; } }
}

struct EpiScoreTopk {
    static constexpr bool PERM = false, AFTER_DRAIN = false;
    float* scr; const float* ssqp; const float* biasq; float* rstd_out; int* esel; float* wsel;
    __device__ __forceinline__ void operator()(const f32x4 (&acc)[2][2][4][2], const pg8::Unit& u, int wr, int wc, int fr, int fq) const {
        asm volatile("" : "+v"(fr), "+v"(fq));
        const int rl0 = wr * 64 + fr, col0 = wc * 32 + 4 * fq, b = (u.pm * 256) >> 13;
        f32x4 bv[2][2];
#pragma unroll
        for (int bj = 0; bj < 2; ++bj)
#pragma unroll
            for (int n = 0; n < 2; ++n) bv[bj][n] = *(const f32x4*)(biasq + b * 2048 + u.pn * 256 + col0 + bj * 128 + n * 16);
#pragma unroll
        for (int ai = 0; ai < 2; ++ai)
#pragma unroll
            for (int m = 0; m < 4; ++m) { const int rl = rl0 + ai * 128 + m * 16, row = u.pm * 256 + rl;
                const f32x4 p0 = *(const f32x4*)(ssqp + (size_t)row * 4), p1 = *(const f32x4*)(ssqp + ((size_t)32768 + row) * 4), p2 = *(const f32x4*)(ssqp + ((size_t)65536 + row) * 4), p3 = *(const f32x4*)(ssqp + ((size_t)98304 + row) * 4);
                const float tot = (p0[0] + p0[1] + p0[2] + p0[3]) + (p1[0] + p1[1] + p1[2] + p1[3]) + (p2[0] + p2[1] + p2[2] + p2[3]) + (p3[0] + p3[1] + p3[2] + p3[3]);
                const float rstd = __builtin_amdgcn_rsqf(tot * (1.0f / 1024.0f) + 1e-6f);
                if (u.pn == 0 && wc == 0 && fq == 0) rstd_out[row] = rstd;
                float* blk = scr + (2 * wr + 4 * ai + (m >> 1)) * 8192 + 8 * wc * 256 + 32 * (m & 1) * 4;
                const unsigned loff4 = (unsigned)(2 * fr + 64 * fq);
#pragma unroll
                for (int bj = 0; bj < 2; ++bj)
#pragma unroll
                    for (int n = 0; n < 2; ++n) ((f32x4*)(blk + (4 * n * 64 + bj) * 4))[loff4] = acc[ai][bj][m][n] * rstd + bv[bj][n]; }
        asm volatile("s_waitcnt vmcnt(0)" ::: "memory");
        __builtin_amdgcn_s_barrier();
        asm volatile("" ::: "memory");
        int tid = threadIdx.x; asm volatile("" : "+v"(tid));
        const int rl = tid >> 1, tab = tid & 1;
        const float* bp = scr + __builtin_amdgcn_readfirstlane(tid >> 6) * 8192;
        const unsigned lo4 = (unsigned)(tid & 63) * 4u;
        unsigned top[16];
        f32x4 cur[4], nxt[4];
#pragma unroll
        for (int q = 0; q < 4; ++q) cur[q] = *(const f32x4*)(bp + q * 256 + lo4);
#pragma unroll
        for (int grp = 0; grp < 8; ++grp) { unsigned k[16];
            if (grp < 7) {
#pragma unroll
                for (int q = 0; q < 4; ++q) nxt[q] = *(const f32x4*)(bp + ((grp + 1) * 4 + q) * 256 + lo4); }
#pragma unroll
            for (int q = 0; q < 4; ++q) { const f32x4 v = cur[q];
#pragma unroll
                for (int e = 0; e < 4; ++e) { const int j = grp * 16 + q * 4 + e; k[q * 4 + e] = (f2key(v[e]) & ~0x7fu) | (unsigned)(127 - j); } }
            sort16(k);
            if (grp == 0) {
#pragma unroll
                for (int i = 0; i < 16; ++i) top[i] = k[i];
            } else merge16(top, k);
#pragma unroll
            for (int q = 0; q < 4; ++q) cur[q] = nxt[q];
            __builtin_amdgcn_sched_barrier(0); }
        topk_stage2(top, tab == 0, (size_t)u.pn * T + (size_t)(u.pm * 256 + rl), esel, wsel);
    }
};

__device__ __forceinline__ void cvt16(const v4u& u, f32x2_ (&f)[8]) {
#pragma unroll
    for (int i = 0; i < 4; ++i) { f[2 * i] = __builtin_amdgcn_cvt_pk_f32_fp8((int)u[i], false); f[2 * i + 1] = __builtin_amdgcn_cvt_pk_f32_fp8((int)u[i], true); }
}
constexpr int PITEM = 8, NPITEM = T / PITEM;
__device__ __forceinline__ int peer_next(unsigned* q, int lane) {
    int idx = 0; if (lane == 0) idx = (int)__hip_atomic_fetch_add(q, 1u, __ATOMIC_RELAXED, __HIP_MEMORY_SCOPE_AGENT);
    return __builtin_amdgcn_readfirstlane(idx);
}
#define PEER_SB() __builtin_amdgcn_sched_barrier(0)
#define DPP_IADD(s, ctrl) ((s) + __builtin_amdgcn_update_dpp(0, (s), (ctrl), 0xF, 0xF, false))
__device__ __forceinline__ void p8_dots(const v4u (&ud)[16], const int (&hh)[4], const int (&hl)[4], int c8, int& r0, int& r1) {
#pragma unroll
    for (int i = 0; i < 16; ++i) { int sh = 0, sl = 0;
#pragma unroll
        for (int d = 0; d < 4; ++d) { sh = __builtin_amdgcn_sdot8((int)ud[i][d], hh[d], sh, false); sl = __builtin_amdgcn_sdot8((int)ud[i][d], hl[d], sl, false); }
        int sm = (sh << 4) + sl;
        sm = DPP_IADD(sm, 0xB1); sm = DPP_IADD(sm, 0x4E); sm = DPP_IADD(sm, 0x141);
        if ((i & 1) == 0) r0 = (c8 == (i >> 1)) ? sm : r0; else r1 = (c8 == (i >> 1)) ? sm : r1; }
}
constexpr int PSLAB = 12288;
__device__ __forceinline__ void p8_item(Frame& F, int sl, int item, int nitem, bool filled, LAS unsigned char* slab) {
    const int c8 = F.lane & 7, q8 = F.lane >> 3, t0 = item * PITEM;
    const unsigned char* ub = F.U8() + (size_t)sl * 16384 * 128 + 16 * c8;
    LAS int* eL = (LAS int*)slab; LAS unsigned char* hL = (LAS unsigned char*)(slab + 4096);
    LAS float* qL = (LAS float*)(slab + 6144);
    v4u t4[4], h2[4]; float rs2[4]; f32x4 sA, sB, gA, gB;
#define P8_BLK_LOAD(tb) do { \
        { const float* sp_ = F.mod() + ((tb) >> 13) * 6144 + 3072 + sl * CSLU + 8 * (F.lane & 31); sA = *(const f32x4*)sp_; sB = *(const f32x4*)(sp_ + 4); \
          const float* gp_ = F.g_ffn() + sl * CSLU + 8 * (F.lane & 31); gA = *(const f32x4*)gp_ * (*(const f32x4*)(sp_ + 1024) + 1.0f); gB = *(const f32x4*)(gp_ + 4) * (*(const f32x4*)(sp_ + 1028) + 1.0f); } \
        _Pragma("unroll") for (int i = 0; i < 4; ++i) rs2[i] = F.rstd()[(tb) + 2 * i + (F.lane >> 5)]; \
        _Pragma("unroll") for (int i = 0; i < 4; ++i) t4[i] = __builtin_nontemporal_load((const v4u*)(F.esel() + ((size_t)(2 * i + (F.lane >> 5)) * T + (tb)) * 16) + (F.lane & 31)); \
        _Pragma("unroll") for (int i = 0; i < 4; ++i) h2[i] = __builtin_nontemporal_load((const v4u*)(F.hg() + (size_t)((tb) + 2 * i + (F.lane >> 5)) * D + sl * CSLU + 8 * (F.lane & 31))); } while (0)
#define DPP_FMAX(v, ctrl) __builtin_fmaxf((v), __builtin_bit_cast(float, __builtin_amdgcn_update_dpp(0, __builtin_bit_cast(int, (v)), (ctrl), 0xF, 0xF, false)))
#define P8_QN(x, k) { const int q_ = (int)__builtin_rintf((x) * qs_), lo_ = ((q_ + 8) & 15) - 8, hi_ = (q_ - lo_) >> 4; wl_ |= (unsigned)(lo_ & 15) << (4 * (k)); wh_ |= (unsigned)(hi_ & 15) << (4 * (k)); }
#define P8_BLK_STORE() do { _Pragma("unroll") for (int i = 0; i < 4; ++i) *(LAS v4u*)(eL + ((F.lane & 31) >> 2) * NSEL + (2 * i + (F.lane >> 5)) * 16 + 4 * (F.lane & 3)) = t4[i]; \
        _Pragma("unroll") for (int i = 0; i < 4; ++i) { const float r_ = rs2[i]; const v4u h_ = h2[i]; \
            const f32x4 ra_ = gA * r_, rb_ = gB * r_; \
            const float x0 = bflo(h_[0]) * ra_[0] + sA[0], x1 = bfhi(h_[0]) * ra_[1] + sA[1], x2 = bflo(h_[1]) * ra_[2] + sA[2], x3 = bfhi(h_[1]) * ra_[3] + sA[3]; \
            const float x4 = bflo(h_[2]) * rb_[0] + sB[0], x5 = bfhi(h_[2]) * rb_[1] + sB[1], x6 = bflo(h_[3]) * rb_[2] + sB[2], x7 = bfhi(h_[3]) * rb_[3] + sB[3]; \
            float m_ = __builtin_fmaxf(__builtin_fmaxf(__builtin_fmaxf(__builtin_fabsf(x0), __builtin_fabsf(x1)), __builtin_fmaxf(__builtin_fabsf(x2), __builtin_fabsf(x3))), \
                                       __builtin_fmaxf(__builtin_fmaxf(__builtin_fabsf(x4), __builtin_fabsf(x5)), __builtin_fmaxf(__builtin_fabsf(x6), __builtin_fabsf(x7)))); \
            m_ = DPP_FMAX(m_, 0x128); m_ = DPP_FMAX(m_, 0x124); m_ = DPP_FMAX(m_, 0x122); m_ = DPP_FMAX(m_, 0x121); m_ = __builtin_fmaxf(m_, __shfl_xor(m_, 16)); m_ = __builtin_fmaxf(m_, 1e-20f); \
            const float qs_ = 119.0f * __builtin_amdgcn_rcpf(m_); \
            const int tk_ = 2 * i + (F.lane >> 5); \
            if ((F.lane & 31) == 0) qL[tk_] = m_ * (1.0f / (119.0f * UQSCALE)); \
            unsigned wl_ = 0u, wh_ = 0u; P8_QN(x0, 0) P8_QN(x1, 1) P8_QN(x2, 2) P8_QN(x3, 3) P8_QN(x4, 4) P8_QN(x5, 5) P8_QN(x6, 6) P8_QN(x7, 7) \
            *(LAS unsigned*)(hL + tk_ * 256 + 4 * (F.lane & 31)) = wh_; *(LAS unsigned*)(hL + tk_ * 256 + 128 + 4 * (F.lane & 31)) = wl_; } \
        asm volatile("s_waitcnt lgkmcnt(0)" ::: "memory"); } while (0)
    if (!filled) { P8_BLK_LOAD(t0); P8_BLK_STORE(); }
    bf16* po = F.pact() + ((size_t)t0 * NSLU + sl) * NSEL + 16 * q8 + 2 * c8;
    v4u udA[16], udB[16];
#define P8_GATHER(dst, tt) do { v4u e_[4]; _Pragma("unroll") for (int k = 0; k < 4; ++k) e_[k] = *(LAS const v4u*)(eL + (tt) * NSEL + 16 * q8 + 4 * k); \
        _Pragma("unroll") for (int i = 0; i < 16; ++i) dst[i] = *(const v4u*)(ub + (size_t)e_[i >> 2][i & 3] * 128); } while (0)
#define P8_HN(tt) int hh[4], hl[4]; { const v4u a_ = *(LAS const v4u*)(hL + (tt) * 256 + 16 * c8), b_ = *(LAS const v4u*)(hL + (tt) * 256 + 128 + 16 * c8); \
        hh[0] = (int)a_[0]; hh[1] = (int)a_[1]; hh[2] = (int)a_[2]; hh[3] = (int)a_[3]; hl[0] = (int)b_[0]; hl[1] = (int)b_[1]; hl[2] = (int)b_[2]; hl[3] = (int)b_[3]; }
#define P8_OUT(tt, r0, r1) do { const float dq_ = qL[tt]; __builtin_nontemporal_store(cvtpk((float)(r0) * dq_, (float)(r1) * dq_), (unsigned*)(po + (size_t)(tt) * NSLU * NSEL)); } while (0)
    P8_GATHER(udA, 0);
    for (int tt = 0; tt < PITEM - 2; tt += 2) {
        P8_GATHER(udB, tt + 1);
        { P8_HN(tt); int r0 = 0, r1 = 0; p8_dots(udA, hh, hl, c8, r0, r1); P8_OUT(tt, r0, r1); }
        P8_GATHER(udA, tt + 2);
        { P8_HN(tt + 1); int r0 = 0, r1 = 0; p8_dots(udB, hh, hl, c8, r0, r1); P8_OUT(tt + 1, r0, r1); }
    }
    {
        P8_GATHER(udB, PITEM - 1);
        { P8_HN(PITEM - 2); int r0 = 0, r1 = 0; p8_dots(udA, hh, hl, c8, r0, r1); P8_OUT(PITEM - 2, r0, r1); }
        if (nitem >= 0) P8_BLK_LOAD(nitem * PITEM);
        { P8_HN(PITEM - 1); int r0 = 0, r1 = 0; p8_dots(udB, hh, hl, c8, r0, r1); P8_OUT(PITEM - 1, r0, r1); }
        if (nitem >= 0) P8_BLK_STORE();
    }
#undef P8_GATHER
#undef P8_HN
#undef P8_OUT
#undef P8_BLK_LOAD
#undef P8_BLK_STORE
#undef P8_QN
#undef DPP_FMAX
}
__device__ __forceinline__ void p8b_coef(Frame& F) {
    const int N8 = T * (NSEL / 8);
#pragma unroll 2
    for (int i = F.bid * NTHR + F.tid; i < N8; i += F.G * NTHR) { const size_t t = (size_t)(i >> 4); const int m = i & 15;
        const bf16* pp = F.pact() + t * NSLU * NSEL + 8 * m;
        v4u p4[NSLU];
#pragma unroll
        for (int q = 0; q < NSLU; ++q) p4[q] = __builtin_nontemporal_load((const v4u*)(pp + q * NSEL));
        const float* wp = F.wsel() + ((size_t)(m >> 1) * T + t) * 16 + 8 * (m & 1);
        const f32x4 w0 = *(const f32x4*)wp, w1 = *(const f32x4*)(wp + 4);
        float a[8];
#pragma unroll
        for (int e = 0; e < 4; ++e) { float lo = 0.f, hi = 0.f;
#pragma unroll
            for (int q = 0; q < NSLU; ++q) { lo += bflo(p4[q][e]); hi += bfhi(p4[q][e]); }
            a[2 * e] = lo; a[2 * e + 1] = hi; }
        f32x4 o0, o1;
#pragma unroll
        for (int e = 0; e < 4; ++e) { o0[e] = w0[e] * 0.5f * a[e] * (1.0f + erff(a[e] * 0.70710678f)); o1[e] = w1[e] * 0.5f * a[4 + e] * (1.0f + erff(a[4 + e] * 0.70710678f)); }
        float* cp = F.coef() + t * NSEL + 8 * m;
        *(f32x4*)cp = o0; *(f32x4*)(cp + 4) = o1; }
}
__device__ __forceinline__ void p9_token(const v4u (&vd)[16], LAS const float* cL, bf16* yo, LAS float* red, int lane, int c8, int q8) {
    f32x4 cc[4];
#pragma unroll
    for (int k = 0; k < 4; ++k) cc[k] = *(LAS const f32x4*)(cL + 16 * q8 + 4 * k);
    f32x2_ y[8];
#pragma unroll
    for (int k = 0; k < 8; ++k) y[k] = (f32x2_){0.f, 0.f};
#pragma unroll
    for (int i = 0; i < 16; ++i) { f32x2_ vf[8]; cvt16(vd[i], vf); const float c = cc[i >> 2][i & 3]; const f32x2_ c2 = {c, c};
#pragma unroll
        for (int k = 0; k < 8; ++k) y[k] += c2 * vf[k];
        PEER_SB(); }
#pragma unroll
    for (int k = 0; k < 4; ++k) { f32x4 o; o[0] = y[2 * k][0]; o[1] = y[2 * k][1]; o[2] = y[2 * k + 1][0]; o[3] = y[2 * k + 1][1]; *(LAS f32x4*)(red + q8 * 128 + 16 * c8 + 4 * k) = o; }
    asm volatile("s_waitcnt lgkmcnt(0)" ::: "memory");
    f32x2_ sm = {0.f, 0.f};
#pragma unroll
    for (int g = 0; g < 8; ++g) sm += *(LAS const f32x2_*)(red + g * 128 + 2 * lane);
    sm = sm * (1.0f / VSCALE);
    __builtin_nontemporal_store(cvtpk(sm[0], sm[1]), (unsigned*)(yo + 2 * lane));
    asm volatile("s_waitcnt lgkmcnt(0)" ::: "memory");
    PEER_SB();
}
__device__ __forceinline__ void p9_item(Frame& F, int sl, int item, int nitem, bool filled, LAS unsigned char* slab) {
    const int c8 = F.lane & 7, q8 = F.lane >> 3, t0 = item * PITEM;
    const unsigned char* vb = F.V8() + (size_t)sl * 16384 * CSL + 16 * c8;
    LAS int* eL = (LAS int*)slab; LAS float* cL = (LAS float*)(slab + 4096); LAS float* red = (LAS float*)(slab + 8192);
    v4u t4[4], c4[4];
#define P9_BLK_LOAD(tb) do { const v4u* cp_ = (const v4u*)(F.coef() + (size_t)(tb) * NSEL); \
        _Pragma("unroll") for (int i = 0; i < 4; ++i) { t4[i] = __builtin_nontemporal_load((const v4u*)(F.esel() + ((size_t)(2 * i + (F.lane >> 5)) * T + (tb)) * 16) + (F.lane & 31)); c4[i] = __builtin_nontemporal_load(cp_ + i * 64 + F.lane); } } while (0)
#define P9_BLK_STORE() do { _Pragma("unroll") for (int i = 0; i < 4; ++i) { *(LAS v4u*)(eL + ((F.lane & 31) >> 2) * NSEL + (2 * i + (F.lane >> 5)) * 16 + 4 * (F.lane & 3)) = t4[i]; *(LAS v4u*)(cL + (i * 64 + F.lane) * 4) = c4[i]; } \
        asm volatile("s_waitcnt lgkmcnt(0)" ::: "memory"); } while (0)
    if (!filled) { P9_BLK_LOAD(t0); P9_BLK_STORE(); }
    bf16* yo = F.ybuf() + (size_t)t0 * D + sl * CSL;
    v4u vdA[16], vdB[16];
#define P9_GATHER(dst, tt) do { v4u e_[4]; _Pragma("unroll") for (int k = 0; k < 4; ++k) e_[k] = *(LAS const v4u*)(eL + (tt) * NSEL + 16 * q8 + 4 * k); \
        _Pragma("unroll") for (int i = 0; i < 16; ++i) dst[i] = *(const v4u*)(vb + (size_t)e_[i >> 2][i & 3] * CSL); } while (0)
    P9_GATHER(vdA, 0);
    for (int tt = 0; tt < PITEM - 2; tt += 2) {
        P9_GATHER(vdB, tt + 1);
        p9_token(vdA, cL + tt * NSEL, yo + (size_t)tt * D, red, F.lane, c8, q8);
        P9_GATHER(vdA, tt + 2);
        p9_token(vdB, cL + (tt + 1) * NSEL, yo + (size_t)(tt + 1) * D, red, F.lane, c8, q8);
    }
    {
        P9_GATHER(vdB, PITEM - 1);
        p9_token(vdA, cL + (PITEM - 2) * NSEL, yo + (size_t)(PITEM - 2) * D, red, F.lane, c8, q8);
        if (nitem >= 0) P9_BLK_LOAD(nitem * PITEM);
        p9_token(vdB, cL + (PITEM - 1) * NSEL, yo + (size_t)(PITEM - 1) * D, red, F.lane, c8, q8);
        if (nitem >= 0) P9_BLK_STORE();
    }
#undef P9_GATHER
#undef P9_BLK_LOAD
#undef P9_BLK_STORE
}
template <int SIDE>
__device__ __forceinline__ void peer_phase(Frame& F0, int rep) {
    Frame F = F0; asm volatile("" : "+v"(F.lane));
    constexpr int NS = (SIDE == 0) ? NSLU : NSL;
    const int s0 = (int)(xb_xcc_id() & (unsigned)(NS - 1));
    unsigned* qbase = F.ctl() + (SIDE == 0 ? CW_QU : CW_QV) + rep * 64 * 32;
    LAS unsigned char* cf = F.lds + F.wave * PSLAB;
    for (int k = 0; k < NS; ++k) { const int sl = (s0 + k) & (NS - 1);
        int item = peer_next(qbase + 64 * sl, F.lane); bool filled = false;
        while (item < NPITEM) { int nitem = peer_next(qbase + 64 * sl, F.lane); if (nitem >= NPITEM) nitem = -1;
            if (SIDE == 0) p8_item(F, sl, item, nitem, filled, cf); else p9_item(F, sl, item, nitem, filled, cf);
            filled = nitem >= 0; item = nitem >= 0 ? nitem : NPITEM; } }
}
__device__ __forceinline__ void p10_final(Frame& F) {
    const int gwc = F.bid * NWAVES + F.wave, NGW = F.G * NWAVES;
    for (int row0 = gwc * 16; row0 < T; row0 += NGW * 16) {
        const int b = row0 >> 13; const float* mb = F.mod() + b * 6144 + 5120; const float* fm = F.fmod() + b * 2048;
        f32x4 g2[4], ca[4], cb[4];
#pragma unroll
        for (int j = 0; j < 4; ++j) { const int k = 256 * j + 4 * F.lane; g2[j] = *(const f32x4*)(mb + k); ca[j] = *(const f32x4*)(F.fnorm_g() + k) * (*(const f32x4*)(fm + 1024 + k) + 1.0f); cb[j] = *(const f32x4*)(fm + k); }
#pragma unroll 4
        for (int r = 0; r < 16; ++r) { float* hr = F.out() + (size_t)(row0 + r) * D; const bf16* yr = F.ybuf() + (size_t)(row0 + r) * D; const bf16* hb = F.hg() + (size_t)(row0 + r) * D;
            f32x4 z[4]; float ss = 0.f;
#pragma unroll
            for (int j = 0; j < 4; ++j) { const v2u hq = *(const v2u*)(hb + 256 * j + 4 * F.lane); f32x4 hv; hv[0] = bflo(hq[0]); hv[1] = bfhi(hq[0]); hv[2] = bflo(hq[1]); hv[3] = bfhi(hq[1]);
                const v2u yq = __builtin_nontemporal_load((const v2u*)(yr + 256 * j + 4 * F.lane)); f32x4 yv; yv[0] = bflo(yq[0]); yv[1] = bfhi(yq[0]); yv[2] = bflo(yq[1]); yv[3] = bfhi(yq[1]);
                z[j] = hv + g2[j] * yv; ss += z[j][0] * z[j][0] + z[j][1] * z[j][1] + z[j][2] * z[j][2] + z[j][3] * z[j][3]; }
            const float rstd = __builtin_amdgcn_rsqf(wave_sum(ss) * (1.0f / D) + EPS);
#pragma unroll
            for (int j = 0; j < 4; ++j) *(f32x4*)(hr + 256 * j + 4 * F.lane) = z[j] * rstd * ca[j] + cb[j]; }
    }
}

constexpr int NPHASE = 12;
__global__ void __launch_bounds__(NTHR, 2) fwd_kernel(Args args) {
    extern __shared__ __attribute__((aligned(16))) unsigned char lds_raw[];
    Frame F;
    F.lds = (LAS unsigned char*)lds_raw;
    F.tid = threadIdx.x; F.lane = F.tid & 63; F.wave = __builtin_amdgcn_readfirstlane(F.tid >> 6); F.G = gridDim.x; F.bid = blockIdx.x;
    unsigned char* ws = args.ws; F.a = &args;
    volatile LAS unsigned* misc = (volatile LAS unsigned*)(F.lds + MISC_OFF);
    if (F.tid < 64) misc[F.tid] = 0u;
    __syncthreads();
    const int lo = args.ph_lo, hi = args.ph_hi;
    const bool multi = (hi - lo) > 1;
    XcdBarrier bar; bar.bar = (unsigned*)(ws + WS_CTL) + CW_BAR; bar.x = 0; bar.st = nullptr;
    if (multi) bar = xcd_barrier_post((unsigned*)(ws + WS_CTL) + CW_BAR, misc + 8);
#ifndef PHMASK
#define PHMASK 0xfff
#endif
#define IN(k) (((PHMASK >> (k)) & 1) && lo <= (k) && (k) < hi)
#define SEAM(k) do { if (IN(k) && IN((k) + 1)) xcd_barrier(bar); } while (0)

#ifndef REPMASK
#define REPMASK 0
#endif
#define REP(k) (((REPMASK) >> (k)) & 1)
#define REPBAR(k) if (REP(k) && rep == 0) xcd_barrier(bar)
    if (IN(0)) p0_prologue(F);
    if (IN(0) && IN(1)) {
        if (F.tid == 0) { XB_SPIN(xb_ld(F.ctl() + CW_GV) < (unsigned)F.G, bar.bar); __builtin_amdgcn_fence(__ATOMIC_ACQUIRE, "agent"); asm volatile("s_waitcnt vmcnt(0)" ::: "memory"); }
        __syncthreads(); }
    if (IN(1)) p1_norm(F);
    SEAM(1);
    if (IN(2)) { { pg8::Gemm g{F.bufA(), F.Win_t(), T, NIN, D}; pg8::StaticOrder S; S.init(T, NIN, F.G, F.bid);
        pg8::EpiProj E{F.proj(), NIN};
        pg8::gemm_phase<pg8::EpiProj, pg8::StaticOrder, true, true>(F.lds, g, S, E); }
#if ((REPMASK) >> 2) & 1
        xcd_barrier(bar); { pg8::Gemm g{F.bufA(), F.Win_t(), T, NIN, D}; pg8::StaticOrder S; S.init(T, NIN, F.G, F.bid);
        pg8::EpiProj E{F.proj(), NIN};
        pg8::gemm_phase<pg8::EpiProj, pg8::StaticOrder, true, true>(F.lds, g, S, E); }
#endif
    } SEAM(2);
    if (IN(3)) { p3_pre(F);
      for (int rep = 0; rep <= REP(3); ++rep) {
        for (int it = F.bid; it < NB * NHH * 2 * NSEG; it += F.G) h1_item(F, it);
        asm volatile("s_waitcnt vmcnt(0)" ::: "memory");
        __syncthreads();
        if (F.tid == 0) { __builtin_amdgcn_fence(__ATOMIC_RELEASE, "agent"); asm volatile("s_waitcnt vmcnt(0)" ::: "memory"); (void)xb_add(F.ctl() + CW_H1, 1u); }
        float cw[CW];
#pragma unroll
        for (int j = 0; j < CW; ++j) cw[j] = F.conv_w()[j * DC + F.tid];
        const float cbias = F.conv_b()[F.tid];
        for (int it = F.bid; it < T / 32; it += F.G) conv_item(F, it, cw, cbias);
        if (F.tid == 0) { const unsigned tgt = (unsigned)F.G * (unsigned)(rep + 1); XB_SPIN(xb_ld(F.ctl() + CW_H1) < tgt, bar.bar); __builtin_amdgcn_fence(__ATOMIC_ACQUIRE, "agent"); asm volatile("s_waitcnt vmcnt(0)" ::: "memory"); }
        __syncthreads();
        h_scan(F);
        REPBAR(3); }
    } SEAM(3);
    if (IN(4)) { for (int rep = 0; rep <= REP(4); ++rep) { for (int it = F.bid; it < NB * NHH * NSEG; it += F.G) h2_item(F, it); REPBAR(4); } } SEAM(4);
    if (IN(5)) { { pg8::Gemm g{F.bufA(), F.Wout_t(), T, D, D}; pg8::StaticOrder S; S.init(T, D, F.G, F.bid);
        pg8::EpiOut E{F.x(), F.hg(), F.mod(), F.ssqp()};
        pg8::gemm_phase<pg8::EpiOut, pg8::StaticOrder, true, true>(F.lds, g, S, E); }
#if ((REPMASK) >> 5) & 1
        xcd_barrier(bar); { pg8::Gemm g{F.bufA(), F.Wout_t(), T, D, D}; pg8::StaticOrder S; S.init(T, D, F.G, F.bid);
        pg8::EpiOut E{F.x(), F.hg(), F.mod(), F.ssqp()};
        pg8::gemm_phase<pg8::EpiOut, pg8::StaticOrder, true, true>(F.lds, g, S, E); }
#endif
    } SEAM(5);
    if (IN(6)) { { pg8::Gemm g{F.hg(), F.Wqk_b(), T, NQK, D, (size_t)NQK * D * 2}; pg8::StaticOrder S; S.init(T, NQK, F.G, F.bid);
        EpiScoreTopk E{F.scores() + (size_t)F.bid * 65536, F.ssqp(), F.biasq(), F.rstd(), F.esel(), F.wsel()};
        pg8::gemm_phase<EpiScoreTopk, pg8::StaticOrder, true, true>(F.lds, g, S, E); }
    } SEAM(6);
    if (IN(8)) { for (int rep = 0; rep <= REP(8); ++rep) { peer_phase<0>(F, rep); REPBAR(8); } } SEAM(8);
    if (IN(9)) { for (int rep = 0; rep <= REP(9); ++rep) { p8b_coef(F); REPBAR(9); } } SEAM(9);
    if (IN(10)) { for (int rep = 0; rep <= REP(10); ++rep) { peer_phase<1>(F, rep); REPBAR(10); } } SEAM(10);
    if (IN(11)) { p10_final(F); }
#undef IN
#undef SEAM
}

#ifndef MK_ONE_LAUNCH
#define MK_ONE_LAUNCH 0
#endif
extern "C" void kernel_launch(void* const* d_in, const int* in_sizes, int n_in, void* d_out, int out_size, void* d_ws, size_t ws_size, hipStream_t stream) {
    static int grid = 0;
    if (grid == 0) {
        if (n_in != 23 || out_size != T * D || ws_size < WS_END) { fprintf(stderr, "kernel_launch: unexpected shapes (n_in %d, out %d, ws %zu)\n", n_in, out_size, ws_size); grid = -1; return; }
        int dev = 0, cus = 0, per_cu = 0;
        if (hipGetDevice(&dev) != hipSuccess || hipDeviceGetAttribute(&cus, hipDeviceAttributeMultiprocessorCount, dev) != hipSuccess) { grid = -1; return; }
        if (hipFuncSetAttribute((const void*)fwd_kernel, hipFuncAttributeMaxDynamicSharedMemorySize, LDS_BYTES) != hipSuccess) { fprintf(stderr, "kernel_launch: hipFuncSetAttribute failed\n"); grid = -1; return; }
        if (hipOccupancyMaxActiveBlocksPerMultiprocessor(&per_cu, (const void*)fwd_kernel, NTHR, LDS_BYTES) != hipSuccess || per_cu < 1) { fprintf(stderr, "kernel_launch: occupancy query reports %d\n", per_cu); }
        (void)hipGetLastError();
        grid = cus;
    }
    if (grid < 0) return;
    (void)hipMemsetAsync((char*)d_ws + WS_CTL, 0, CTL_ZERO_BYTES, stream);
    Args a{};
    for (int i = 0; i < 23; ++i) a.in[i] = (const float*)d_in[i];
    a.out = (float*)d_out; a.ws = (unsigned char*)d_ws;
#if MK_ONE_LAUNCH
    a.ph_lo = 0; a.ph_hi = NPHASE;
    hipLaunchKernelGGL(fwd_kernel, dim3(grid), dim3(NTHR), LDS_BYTES, stream, a);
#else
    for (int p = 0; p < NPHASE; ++p) { a.ph_lo = p; a.ph_hi = p + 1; hipLaunchKernelGGL(fwd_kernel, dim3(grid), dim3(NTHR), LDS_BYTES, stream, a); }
#endif
}
```
